# Optimizing an MI355X kernel written in HIP

```python
import math
import jax, jax.numpy as jnp
from jax import lax
import numpy as np

D_MODEL = 2048
BATCH = 32
SEQ = 256
DEPTH = 2
DEC_BATCH = 8
DEC_SEQ = 4096
PAST_LEN = 256

GRID_W = 64
N_EVEN = (DEPTH + 1) // 2
N_ODD = DEPTH // 2
MIX_WIDTH = D_MODEL // 2
HEAD_DIM = 128
NA_HEADS = MIX_WIDTH // HEAD_DIM
NA_KH = 8
NA_KW = 16
HY_WIDTH = MIX_WIDTH
HY_ORDER = 2
HY_POS_EMB = 33
HY_HIDDEN = 64
S5_WIDTH = MIX_WIDTH
S5_GROUP = 16
S5_GROUPS = S5_WIDTH // S5_GROUP
S5_STATE = 64
DIFF_HEADS = MIX_WIDTH // HEAD_DIM
DIFF_QK_DIM = HEAD_DIM // 2
DIFF_V_DIM = HEAD_DIM
ROPE_BASE = 10000.0
PEER_HEADS = 8
PEER_N_KEYS = 128
PEER_N_EXPERTS = PEER_N_KEYS * PEER_N_KEYS
PEER_QUERY_DIM = 256
PEER_TOPK = 16
Q_BLOCK = 128
TOKEN_BLOCK = 128
NORM_EPS = 1e-6
NEG_INF = -1e30
EVEN_IN = 3 * MIX_WIDTH + (HY_ORDER + 1) * HY_WIDTH
ODD_IN = S5_WIDTH + DIFF_HEADS * (4 * DIFF_QK_DIM + DIFF_V_DIM)

kernel_name = "hybrid_diffusion_prefix_step"


def rmsnorm(x, g):
    xf = x.astype(jnp.float32)
    y = xf * lax.rsqrt(jnp.mean(xf * xf, axis=-1, keepdims=True) + NORM_EPS)
    return (y * g.astype(jnp.float32)).astype(x.dtype)


def adaln(cond, w, b):
    m = jax.nn.silu(cond) @ w + b
    return jnp.split(m[:, None, :], 6, axis=-1)


def modulate(h, shift, scale):
    return h * (1.0 + scale) + shift


def softmax_f32(s):
    return jax.nn.softmax(s.astype(jnp.float32), axis=-1)


def sweep_query_blocks(fn, q):
    b, l = q.shape[:2]
    qb = jnp.moveaxis(q.reshape((b, l // Q_BLOCK, Q_BLOCK) + q.shape[2:]), 1, 0)
    out = jnp.moveaxis(lax.map(fn, qb), 0, 1)
    return out.reshape((b, l) + out.shape[3:])


def grid_rope(l):
    t = jnp.arange(l)
    row = (t // GRID_W).astype(jnp.float32)
    col = (t % GRID_W).astype(jnp.float32)
    nf = DIFF_QK_DIM // 4
    inv = ROPE_BASE ** (-jnp.arange(nf, dtype=jnp.float32) / nf)
    ang = jnp.stack([row[:, None] * inv, col[:, None] * inv], axis=1)
    ang = jnp.stack([ang, ang], axis=2).reshape(l, DIFF_QK_DIM)
    return jnp.cos(ang), jnp.sin(ang)


def apply_rope(x, cos, sin):
    xr = x.reshape(x.shape[:-1] + (2, 2, DIFF_QK_DIM // 4))
    rot = jnp.stack([-xr[..., 1, :], xr[..., 0, :]], axis=-2).reshape(x.shape)
    return (x * cos + rot * sin).astype(x.dtype)


def context_attention(q, k, v):
    scale = q.shape[-1] ** -0.5

    def blk(qb):
        p = softmax_f32(jnp.einsum('bqhd,bkhd->bhqk', qb, k) * scale).astype(v.dtype)
        return jnp.einsum('bhqk,bkhd->bqhd', p, v)
    return sweep_query_blocks(blk, q)


def neighborhood_attention(q, k, v, ctx_k, ctx_v, rpb):
    b, l, h, d = q.shape
    rows = l // GRID_W
    kh = min(NA_KH, rows)
    n_lat = kh * GRID_W
    scale = d ** -0.5
    qg = jnp.moveaxis(q.reshape(b, rows, GRID_W, h, d), 1, 0)
    kg = k.reshape(b, rows, GRID_W, h, d)
    vg = v.reshape(b, rows, GRID_W, h, d)
    r_idx = jnp.arange(rows)
    row_start = jnp.clip(r_idx - kh // 2, 0, rows - kh)
    cols = jnp.arange(GRID_W)
    col_start = jnp.clip(cols - NA_KW // 2, 0, GRID_W - NA_KW)
    col_mask = (cols[None, :] >= col_start[:, None]) & (cols[None, :] < col_start[:, None] + NA_KW)
    mask = jnp.broadcast_to(col_mask[:, None, :], (GRID_W, kh, GRID_W)).reshape(GRID_W, n_lat)
    col_bias_idx = jnp.clip(cols[None, :] - cols[:, None] + NA_KW - 1, 0, 2 * NA_KW - 2)

    def row_fn(args):
        q_r, r0, r = args
        k_blk = lax.dynamic_slice_in_dim(kg, r0, kh, axis=1).reshape(b, n_lat, h, d)
        v_blk = lax.dynamic_slice_in_dim(vg, r0, kh, axis=1).reshape(b, n_lat, h, d)
        row_off = r0 + jnp.arange(kh) - r + NA_KH - 1
        bias = rpb[:, row_off][:, :, col_bias_idx]
        bias = jnp.transpose(bias, (0, 2, 1, 3)).reshape(h, GRID_W, n_lat).astype(jnp.float32)
        s_lat = jnp.einsum('bqhd,bkhd->bhqk', q_r, k_blk).astype(jnp.float32) * scale + bias
        s_lat = jnp.where(mask, s_lat, NEG_INF)
        s_ctx = jnp.einsum('bqhd,bkhd->bhqk', q_r, ctx_k).astype(jnp.float32) * scale
        p = jax.nn.softmax(jnp.concatenate([s_lat, s_ctx], axis=-1), axis=-1).astype(v.dtype)
        return (jnp.einsum('bhqk,bkhd->bqhd', p[..., :n_lat], v_blk)
                + jnp.einsum('bhqk,bkhd->bqhd', p[..., n_lat:], ctx_v))
    out = lax.map(row_fn, (qg, row_start, r_idx))
    return jnp.moveaxis(out, 0, 1).reshape(b, l, h, d)


def hyena_filters(l, w1, b1, f1, w2, b2, f2, w3, decay):
    t = jnp.linspace(0.0, 1.0, l, dtype=jnp.float32)[:, None]
    bands = (HY_POS_EMB - 1) // 2
    w_ang = 2.0 * math.pi * jnp.arange(l, dtype=jnp.float32)[:, None] / l
    freqs = jnp.linspace(1e-4, bands - 1, bands, dtype=jnp.float32)[None, :]
    z = jnp.concatenate([t, jnp.cos(freqs * w_ang), -jnp.sin(freqs * w_ang)], axis=-1)
    h = jnp.sin(f1 * (z @ w1 + b1))
    h = jnp.sin(f2 * (h @ w2 + b2))
    h = (h @ w3).reshape(l, 2, HY_ORDER, HY_WIDTH).astype(jnp.float32)
    h = h * jnp.exp(-t.reshape(l, 1, 1, 1) * jnp.abs(decay.astype(jnp.float32)))
    h_f, h_b = h[:, 0], h[:, 1]
    zero = jnp.zeros((1, HY_ORDER, HY_WIDTH), jnp.float32)
    return jnp.concatenate([h_f, zero, h_b[1:][::-1]], axis=0)


def hyena(u, conv_w, conv_b, filt, bias):
    b, l, _ = u.shape
    up = jnp.pad(u, ((0, 0), (1, 1), (0, 0)))
    u = up[:, :-2] * conv_w[0] + up[:, 1:-1] * conv_w[1] + up[:, 2:] * conv_w[2] + conv_b
    v, x1, x2 = jnp.split(u, 3, axis=-1)
    kf = jnp.fft.rfft(hyena_filters(l, *filt), axis=0)
    z = v
    for o, gate in enumerate((x1, x2)):
        zf = z.astype(jnp.float32)
        y = jnp.fft.irfft(jnp.fft.rfft(zf, n=2 * l, axis=1) * kf[None, :, o], n=2 * l, axis=1)[:, :l]
        z = gate * (y + zf * bias[o].astype(jnp.float32)).astype(u.dtype)
    return z


def s5_combine(e1, e2):
    a1r, a1i, b1r, b1i = e1
    a2r, a2i, b2r, b2i = e2
    return (a2r * a1r - a2i * a1i, a2r * a1i + a2i * a1r,
            a2r * b1r - a2i * b1i + b2r, a2r * b1i + a2i * b1r + b2i)


def s5_scan(ug, h0_re, h0_im, lam_re, lam_im, log_dt, b_re, b_im, c_re, c_im, reverse):
    f32 = jnp.float32
    lam_re, lam_im = lam_re.astype(f32), lam_im.astype(f32)
    b_re, b_im, c_re, c_im = b_re.astype(f32), b_im.astype(f32), c_re.astype(f32), c_im.astype(f32)
    dt = jnp.exp(log_dt.astype(f32))[:, None]
    mag = jnp.exp(lam_re * dt)
    ar, ai = mag * jnp.cos(lam_im * dt), mag * jnp.sin(lam_im * dt)
    den = lam_re * lam_re + lam_im * lam_im
    cr = ((ar - 1.0) * lam_re + ai * lam_im) / den
    ci = (ai * lam_re - (ar - 1.0) * lam_im) / den
    bbr = cr[..., None] * b_re - ci[..., None] * b_im
    bbi = cr[..., None] * b_im + ci[..., None] * b_re
    if reverse:
        ug = jnp.flip(ug, axis=1)

    def one(args):
        ub, hr0, hi0 = args
        bur = jnp.einsum('gnp,lgp->lgn', bbr, ub)
        bui = jnp.einsum('gnp,lgp->lgn', bbi, ub)
        bur = bur.at[0].add(ar * hr0 - ai * hi0)
        bui = bui.at[0].add(ar * hi0 + ai * hr0)
        a_r = jnp.broadcast_to(ar, bur.shape)
        a_i = jnp.broadcast_to(ai, bur.shape)
        _, _, hr, hi = lax.associative_scan(s5_combine, (a_r, a_i, bur, bui), axis=0)
        y = jnp.einsum('gpn,lgn->lgp', c_re, hr) - jnp.einsum('gpn,lgn->lgp', c_im, hi)
        return y, hr[-1], hi[-1]
    y, fr, fi = lax.map(one, (ug, h0_re.astype(f32), h0_im.astype(f32)))
    if reverse:
        y = jnp.flip(y, axis=1)
    return y, fr, fi


def s5_mixer(u, h0_re, h0_im, lam_re, lam_im, log_dt, b_re, b_im, c_re, c_im, d_skip, glu_w, glu_b):
    b, l, _ = u.shape
    ug = u.astype(jnp.float32).reshape(b, l, S5_GROUPS, S5_GROUP)
    y = d_skip.astype(jnp.float32) * ug
    fin_re, fin_im = [], []
    for d in range(2):
        yd, fr, fi = s5_scan(ug, h0_re[:, d], h0_im[:, d], lam_re[d], lam_im[d], log_dt[d],
                             b_re[d], b_im[d], c_re[d], c_im[d], reverse=(d == 1))
        y = y + yd
        fin_re.append(fr)
        fin_im.append(fi)
    y = jax.nn.gelu(y.reshape(b, l, S5_WIDTH)).astype(u.dtype)
    out = y * jax.nn.sigmoid(y @ glu_w + glu_b)
    return out, jnp.stack(fin_re, axis=1), jnp.stack(fin_im, axis=1)


def diff_attention(q, k, v, lam):
    scale = q.shape[-1] ** -0.5

    def blk(qb):
        p = softmax_f32(jnp.einsum('bqhsd,bkhsd->bshqk', qb, k) * scale)
        w = (p[:, 0] - lam * p[:, 1]).astype(v.dtype)
        return jnp.einsum('bhqk,bkhd->bqhd', w, v)
    return sweep_query_blocks(blk, q)


def even_mixer(h, ev, ctx_kv):
    (w_in, w_out, q_g, k_g, rpb, conv_w, conv_b, w1, b1, f1, w2, b2, f2, w3, decay, bias) = ev
    b, l, _ = h.shape
    p = h @ w_in
    qa, ka, va, hb = jnp.split(p, [MIX_WIDTH, 2 * MIX_WIDTH, 3 * MIX_WIDTH], axis=-1)
    shp = (b, l, NA_HEADS, HEAD_DIM)
    qa = rmsnorm(qa.reshape(shp), q_g)
    ka = rmsnorm(ka.reshape(shp), k_g)
    va = va.reshape(shp)
    if ctx_kv is None:
        oa = context_attention(qa, ka, va)
    else:
        oa = neighborhood_attention(qa, ka, va, ctx_kv[0], ctx_kv[1], rpb)
    ob = hyena(hb, conv_w, conv_b, (w1, b1, f1, w2, b2, f2, w3, decay), bias)
    out = jnp.concatenate([oa.reshape(b, l, MIX_WIDTH), ob], axis=-1) @ w_out
    return out, ka, va


def odd_mixer(h, od, lam_init, h0_re, h0_im, ctx_kv, rope):
    (w_in, w_out, lam_re, lam_im, log_dt, b_re, b_im, c_re, c_im, d_skip, glu_w, glu_b,
     q_g, k_g, lq1, lk1, lq2, lk2, subln_g) = od
    b, l, _ = h.shape
    qk = DIFF_HEADS * 2 * DIFF_QK_DIM
    p = h @ w_in
    u, qd, kd, vd = jnp.split(p, [S5_WIDTH, S5_WIDTH + qk, S5_WIDTH + 2 * qk], axis=-1)
    oc, fr, fi = s5_mixer(u, h0_re, h0_im, lam_re, lam_im, log_dt, b_re, b_im, c_re, c_im,
                          d_skip, glu_w, glu_b)
    shp = (b, l, DIFF_HEADS, 2, DIFF_QK_DIM)
    q = rmsnorm(qd.reshape(shp), q_g)
    k = rmsnorm(kd.reshape(shp), k_g)
    v = vd.reshape(b, l, DIFF_HEADS, DIFF_V_DIM)
    lam = (jnp.exp(jnp.sum(lq1 * lk1).astype(jnp.float32))
           - jnp.exp(jnp.sum(lq2 * lk2).astype(jnp.float32)) + lam_init)
    if ctx_kv is None:
        keys, vals = k, v
    else:
        cos, sin = rope
        cos = cos[None, :, None, None, :]
        sin = sin[None, :, None, None, :]
        q = apply_rope(q, cos, sin)
        keys = jnp.concatenate([apply_rope(k, cos, sin).astype(ctx_kv[0].dtype), ctx_kv[0]], axis=1)
        vals = jnp.concatenate([v.astype(ctx_kv[1].dtype), ctx_kv[1]], axis=1)
    o = diff_attention(q, keys, vals, lam)
    o = rmsnorm(o, subln_g) * (1.0 - lam_init)
    out = jnp.concatenate([oc, o.reshape(b, l, DIFF_HEADS * DIFF_V_DIM).astype(oc.dtype)], axis=-1) @ w_out
    return out, k, v, fr, fi


def peer(x, w_q, sub_keys, u_tab, v_tab):
    b, l, d = x.shape
    xt = x.reshape(-1, TOKEN_BLOCK, d)

    def blk(xb):
        q = (xb @ w_q).reshape(TOKEN_BLOCK, PEER_HEADS, 2, PEER_QUERY_DIM // 2)
        s = jnp.einsum('thsk,hsnk->thsn', q, sub_keys).astype(jnp.float32)
        sv, si = lax.top_k(s, PEER_TOPK)
        cand = (sv[:, :, 0, :, None] + sv[:, :, 1, None, :]).reshape(TOKEN_BLOCK, PEER_HEADS, -1)
        cidx = (si[:, :, 0, :, None] * PEER_N_KEYS + si[:, :, 1, None, :]).reshape(TOKEN_BLOCK, PEER_HEADS, -1)
        fv, fi = lax.top_k(cand, PEER_TOPK)
        eidx = jnp.take_along_axis(cidx, fi, axis=-1)
        g = jax.nn.softmax(fv, axis=-1).astype(xb.dtype)
        a = jax.nn.gelu(jnp.einsum('thkd,td->thk', u_tab[eidx], xb))
        return jnp.einsum('thk,thkd->td', g * a, v_tab[eidx])
    return lax.map(blk, xt).reshape(b, l, d)


def setup_inputs(seed: int = 0) -> dict:
    key = jax.random.key(seed)
    keys = iter(jax.random.split(key, 96))
    f32 = jnp.float32

    def nrm(shape, scale):
        return jax.random.normal(next(keys), shape, f32) * scale

    def gain(shape):
        return 1.0 + nrm(shape, 0.02)
    D = D_MODEL
    G, N, P = S5_GROUPS, S5_STATE, S5_GROUP
    C = HY_WIDTH
    dk, dv = DIFF_QK_DIM, DIFF_V_DIM
    decay_base = jnp.abs(jnp.linspace(math.log(1e-2) / 1.5, math.log(1e-2) / 0.3, C, dtype=f32))
    return {
        "x_prompt": nrm((BATCH, SEQ, D), 1.0),
        "x_sample": nrm((DEC_BATCH, DEC_SEQ, D), 1.0),
        "c": nrm((DEC_BATCH, D), 1.0),
        "cache_na_k": nrm((DEC_BATCH, N_EVEN, PAST_LEN, NA_HEADS, HEAD_DIM), 1.0),
        "cache_na_v": nrm((DEC_BATCH, N_EVEN, PAST_LEN, NA_HEADS, HEAD_DIM), 1.0),
        "cache_diff_k": nrm((DEC_BATCH, N_ODD, PAST_LEN, DIFF_HEADS, 2, dk), 1.0),
        "cache_diff_v": nrm((DEC_BATCH, N_ODD, PAST_LEN, DIFF_HEADS, dv), 1.0),
        "state_s5_re": nrm((DEC_BATCH, N_ODD, 2, G, N), 0.5),
        "state_s5_im": nrm((DEC_BATCH, N_ODD, 2, G, N), 0.5),
        "c_ctx": nrm((D,), 1.0),
        "mod_w": nrm((DEPTH, D, 6 * D), 0.5 * D ** -0.5),
        "mod_b": nrm((DEPTH, 6 * D), 0.02),
        "norm_mix_g": gain((DEPTH, D)),
        "norm_ffn_g": gain((DEPTH, D)),
        "ev_w_in": nrm((N_EVEN, D, EVEN_IN), D ** -0.5),
        "ev_w_out": nrm((N_EVEN, D, D), D ** -0.5),
        "na_q_g": gain((N_EVEN, HEAD_DIM)),
        "na_k_g": gain((N_EVEN, HEAD_DIM)),
        "na_rpb": nrm((N_EVEN, NA_HEADS, 2 * NA_KH - 1, 2 * NA_KW - 1), 0.1),
        "hy_conv_w": nrm((N_EVEN, 3, 3 * C), 3 ** -0.5),
        "hy_conv_b": nrm((N_EVEN, 3 * C), 0.02),
        "hy_w1": nrm((N_EVEN, HY_POS_EMB, HY_HIDDEN), HY_POS_EMB ** -0.5),
        "hy_b1": nrm((N_EVEN, HY_HIDDEN), 0.1),
        "hy_f1": 1.0 + nrm((N_EVEN, HY_HIDDEN), 0.05),
        "hy_w2": nrm((N_EVEN, HY_HIDDEN, HY_HIDDEN), HY_HIDDEN ** -0.5),
        "hy_b2": nrm((N_EVEN, HY_HIDDEN), 0.1),
        "hy_f2": 1.0 + nrm((N_EVEN, HY_HIDDEN), 0.05),
        "hy_w3": nrm((N_EVEN, HY_HIDDEN, 2 * HY_ORDER * C), 0.05 * HY_HIDDEN ** -0.5),
        "hy_decay": decay_base + nrm((N_EVEN, 2, HY_ORDER, C), 0.05),
        "hy_bias": nrm((N_EVEN, HY_ORDER, C), 0.5),
        "od_w_in": nrm((N_ODD, D, ODD_IN), D ** -0.5),
        "od_w_out": nrm((N_ODD, D, D), D ** -0.5),
        "s5_lam_re": -0.5 + nrm((N_ODD, 2, G, N), 0.01),
        "s5_lam_im": math.pi * jnp.arange(N, dtype=f32) + nrm((N_ODD, 2, G, N), 0.01),
        "s5_log_dt": jax.random.uniform(next(keys), (N_ODD, 2, G), f32, math.log(1e-3), math.log(1e-1)),
        "s5_b_re": nrm((N_ODD, 2, G, N, P), (2 * P) ** -0.5),
        "s5_b_im": nrm((N_ODD, 2, G, N, P), (2 * P) ** -0.5),
        "s5_c_re": nrm((N_ODD, 2, G, P, N), (2 * N) ** -0.5),
        "s5_c_im": nrm((N_ODD, 2, G, P, N), (2 * N) ** -0.5),
        "s5_d": nrm((N_ODD, G, P), 0.5),
        "s5_glu_w": nrm((N_ODD, S5_WIDTH, S5_WIDTH), S5_WIDTH ** -0.5),
        "s5_glu_b": nrm((N_ODD, S5_WIDTH), 0.02),
        "diff_q_g": gain((N_ODD, dk)),
        "diff_k_g": gain((N_ODD, dk)),
        "diff_lq1": nrm((N_ODD, dk), 0.1),
        "diff_lk1": nrm((N_ODD, dk), 0.1),
        "diff_lq2": nrm((N_ODD, dk), 0.1),
        "diff_lk2": nrm((N_ODD, dk), 0.1),
        "diff_subln_g": gain((N_ODD, dv)),
        "peer_w_q": nrm((DEPTH, D, PEER_HEADS * PEER_QUERY_DIM), D ** -0.5),
        "peer_keys": nrm((DEPTH, PEER_HEADS, 2, PEER_N_KEYS, PEER_QUERY_DIM // 2), (PEER_QUERY_DIM // 2) ** -0.5),
        "peer_u": nrm((DEPTH, PEER_N_EXPERTS, D), D ** -0.5),
        "peer_v": nrm((DEPTH, PEER_N_EXPERTS, D), (PEER_HEADS * PEER_TOPK) ** -0.5),
    }


def reference(x_prompt, x_sample, c, cache_na_k, cache_na_v, cache_diff_k, cache_diff_v,
              state_s5_re, state_s5_im, c_ctx, mod_w, mod_b, norm_mix_g, norm_ffn_g,
              ev_w_in, ev_w_out, na_q_g, na_k_g, na_rpb, hy_conv_w, hy_conv_b,
              hy_w1, hy_b1, hy_f1, hy_w2, hy_b2, hy_f2, hy_w3, hy_decay, hy_bias,
              od_w_in, od_w_out, s5_lam_re, s5_lam_im, s5_log_dt, s5_b_re, s5_b_im,
              s5_c_re, s5_c_im, s5_d, s5_glu_w, s5_glu_b, diff_q_g, diff_k_g,
              diff_lq1, diff_lk1, diff_lq2, diff_lk2, diff_subln_g,
              peer_w_q, peer_keys, peer_u, peer_v):
    rope = grid_rope(x_sample.shape[1])
    xp, xs = x_prompt, x_sample
    new_na_k, new_na_v, new_dk, new_dv, new_sr, new_si = [], [], [], [], [], []
    for i in range(DEPTH):
        mp = adaln(c_ctx[None, :], mod_w[i], mod_b[i])
        ms = adaln(c, mod_w[i], mod_b[i])
        hp = modulate(rmsnorm(xp, norm_mix_g[i]), mp[0], mp[1])
        hs = modulate(rmsnorm(xs, norm_mix_g[i]), ms[0], ms[1])
        j = i // 2
        if i % 2 == 0:
            ev = (ev_w_in[j], ev_w_out[j], na_q_g[j], na_k_g[j], na_rpb[j], hy_conv_w[j], hy_conv_b[j],
                  hy_w1[j], hy_b1[j], hy_f1[j], hy_w2[j], hy_b2[j], hy_f2[j], hy_w3[j], hy_decay[j], hy_bias[j])
            op, kp, vp = even_mixer(hp, ev, None)
            os_, _, _ = even_mixer(hs, ev, (cache_na_k[:, j], cache_na_v[:, j]))
            new_na_k.append(kp)
            new_na_v.append(vp)
        else:
            lam_init = 0.8 - 0.6 * math.exp(-0.3 * i)
            od = (od_w_in[j], od_w_out[j], s5_lam_re[j], s5_lam_im[j], s5_log_dt[j], s5_b_re[j], s5_b_im[j],
                  s5_c_re[j], s5_c_im[j], s5_d[j], s5_glu_w[j], s5_glu_b[j], diff_q_g[j], diff_k_g[j],
                  diff_lq1[j], diff_lk1[j], diff_lq2[j], diff_lk2[j], diff_subln_g[j])
            zeros = jnp.zeros((xp.shape[0], 2, S5_GROUPS, S5_STATE), jnp.float32)
            op, kp, vp, sr, si = odd_mixer(hp, od, lam_init, zeros, zeros, None, None)
            os_, _, _, _, _ = odd_mixer(hs, od, lam_init, state_s5_re[:, j], state_s5_im[:, j],
                                        (cache_diff_k[:, j], cache_diff_v[:, j]), rope)
            new_dk.append(kp)
            new_dv.append(vp)
            new_sr.append(sr)
            new_si.append(si)
        xp = xp + mp[2] * op
        xs = xs + ms[2] * os_
        xp = xp + mp[5] * peer(modulate(rmsnorm(xp, norm_ffn_g[i]), mp[3], mp[4]),
                               peer_w_q[i], peer_keys[i], peer_u[i], peer_v[i])
        xs = xs + ms[5] * peer(modulate(rmsnorm(xs, norm_ffn_g[i]), ms[3], ms[4]),
                               peer_w_q[i], peer_keys[i], peer_u[i], peer_v[i])
    return (xp, xs, jnp.stack(new_na_k, axis=1), jnp.stack(new_na_v, axis=1),
            jnp.stack(new_dk, axis=1), jnp.stack(new_dv, axis=1),
            jnp.stack(new_sr, axis=1), jnp.stack(new_si, axis=1))
```

```cpp
#include <hip/hip_runtime.h>
#include <cstdio>
#include <cstring>
#include <cstdint>

typedef unsigned short bf16_t;
typedef short bf16x8 __attribute__((ext_vector_type(8)));
typedef short s16x4 __attribute__((ext_vector_type(4)));
typedef float f32x2 __attribute__((ext_vector_type(2)));
typedef float f32x4 __attribute__((ext_vector_type(4)));
typedef float f32x16 __attribute__((ext_vector_type(16)));
typedef unsigned u32x2 __attribute__((ext_vector_type(2)));
typedef unsigned u32x4 __attribute__((ext_vector_type(4)));
typedef __bf16 bf16x2_t __attribute__((ext_vector_type(2)));

#define DI __device__ __forceinline__

constexpr int NTHR = 512;
constexpr int DM = 2048;
constexpr int TP = 8192;
constexpr int TS = 32768;
constexpr int TOK = TP + TS;
constexpr int LP = 256, LS = 4096;
constexpr float NORM_EPS = 1e-6f;
constexpr float LOG2E = 1.4426950408889634f;

enum { I_XP = 0, I_XS, I_C, I_CNK, I_CNV, I_CDK, I_CDV, I_S5RE, I_S5IM, I_CCTX, I_MODW, I_MODB, I_NMIXG, I_NFFNG, I_EVWIN, I_EVWOUT, I_NAQG, I_NAKG, I_RPB,
       I_HYCW, I_HYCB, I_HYW1, I_HYB1, I_HYF1, I_HYW2, I_HYB2, I_HYF2, I_HYW3, I_HYDEC, I_HYBIAS, I_ODWIN, I_ODWOUT, I_S5LRE, I_S5LIM, I_S5LDT, I_S5BRE, I_S5BIM,
       I_S5CRE, I_S5CIM, I_S5D, I_GLUW, I_GLUB, I_DQG, I_DKG, I_LQ1, I_LK1, I_LQ2, I_LK2, I_SUBG, I_PWQ, I_PKEYS, I_PU, I_PV, N_IN };

constexpr size_t O_Y = 0;
constexpr size_t O_NAK = 83886080, O_NAV = 92274688, O_DK = 100663296, O_DV = 109051904, O_SR = 117440512, O_SI = 117702656, O_END = 117964800;

constexpr size_t al256(size_t x) { return (x + 255) & ~(size_t)255; }
constexpr size_t WS_CTL = 0;
constexpr size_t WS_MODP = 65536;
constexpr size_t WS_MOD = WS_MODP + (size_t)2 * 16 * 9 * 12288 * 4;
constexpr size_t WS_WEVIN = al256(WS_MOD + (size_t)2 * 9 * 12288 * 4);
constexpr size_t WS_WEVOUT = WS_WEVIN + (size_t)6144 * 2048 * 2;
constexpr size_t WS_WODIN = WS_WEVOUT + (size_t)2048 * 2048 * 2;
constexpr size_t WS_WODOUT = WS_WODIN + (size_t)4096 * 2048 * 2;
constexpr size_t WS_WPQ = WS_WODOUT + (size_t)2048 * 2048 * 2;
constexpr size_t WS_WGLU = WS_WPQ + (size_t)2 * 2048 * 2048 * 2;
constexpr size_t WS_PKEYS = WS_WGLU + (size_t)1024 * 1024 * 2;
constexpr size_t WS_CNK = WS_PKEYS + (size_t)2 * 8 * 2 * 128 * 128 * 2;
constexpr size_t WS_CNVT = WS_CNK + (size_t)8 * 256 * 1024 * 2;
constexpr size_t WS_CDK = WS_CNVT + (size_t)8 * 256 * 1024 * 2;
constexpr size_t WS_CDVT = WS_CDK + (size_t)8 * 256 * 1024 * 2;
constexpr size_t WS_S5A = WS_CDVT + (size_t)8 * 256 * 1024 * 2;
constexpr size_t WS_S5BB = WS_S5A + (size_t)128 * 64 * 2 * 4;
constexpr size_t WS_S5CC = WS_S5BB + (size_t)128 * 128 * 16 * 2;
constexpr int KRL_S = 8208, KRL_P = 528;
constexpr size_t WS_KRS = WS_S5CC + (size_t)128 * 16 * 128 * 2;
constexpr size_t WS_KRP = al256(WS_KRS + (size_t)2 * 1024 * 2 * KRL_S * 2);
constexpr size_t WS_TBLU = al256(WS_KRP + (size_t)2 * 1024 * 2 * KRL_P * 2);
constexpr size_t WS_TBLV = WS_TBLU + (size_t)16384 * 2048 * 2;
constexpr size_t WS_HM = WS_TBLV + (size_t)16384 * 2048 * 2;
constexpr size_t WS_RA = WS_HM + (size_t)TOK * 2048 * 2;
constexpr size_t WS_RB = WS_RA + (size_t)TOK * 4096 * 2;
constexpr size_t WS_VT = WS_RB + (size_t)3072 * TOK * 2;
constexpr size_t WS_END = WS_VT + (size_t)TOK * 1024 * 2;
constexpr size_t RA_Q = 0;
constexpr size_t RA_SELI = (size_t)TOK * 2048 * 2;
constexpr size_t RA_SELW = RA_SELI + (size_t)TOK * 128 * 4;
constexpr size_t RB_YF = 0, RB_YB = (size_t)TOK * 1024 * 2, RB_Y = (size_t)2 * TOK * 1024 * 2;
constexpr size_t VT_S = (size_t)TP * 1024 * 2;

constexpr int LDS_BYTES = 147456;

struct Params { const float* in[N_IN]; float* out; unsigned char* ws; int ph_lo, ph_hi; };

DI float bf2f(bf16_t b) { return __uint_as_float(((unsigned)b) << 16); }
DI float bflo(unsigned w) { return __uint_as_float(w << 16); }
DI float bfhi(unsigned w) { return __uint_as_float(w & 0xffff0000u); }
DI unsigned pk2(float a, float b) { f32x2 v = {a, b}; return __builtin_bit_cast(unsigned, __builtin_convertvector(v, bf16x2_t)); }
DI float dot2bf(unsigned a, unsigned b, float c) { return __builtin_amdgcn_fdot2_f32_bf16(__builtin_bit_cast(bf16x2_t, a), __builtin_bit_cast(bf16x2_t, b), c, false); }
DI bf16_t f2bf(float a) { return (bf16_t)(pk2(a, 0.f) & 0xffffu); }
DI float dpp_xor1(float v) { return __builtin_bit_cast(float, __builtin_amdgcn_update_dpp(0, __builtin_bit_cast(int, v), 0xB1, 0xF, 0xF, true)); }
DI float dpp_xor2(float v) { return __builtin_bit_cast(float, __builtin_amdgcn_update_dpp(0, __builtin_bit_cast(int, v), 0x4E, 0xF, 0xF, true)); }
DI float wave_sum(float v) {
    v += dpp_xor1(v); v += dpp_xor2(v);
    v += __builtin_bit_cast(float, __builtin_amdgcn_update_dpp(0, __builtin_bit_cast(int, v), 0x141, 0xF, 0xF, true));
    v += __builtin_bit_cast(float, __builtin_amdgcn_update_dpp(0, __builtin_bit_cast(int, v), 0x140, 0xF, 0xF, true));
    v += __builtin_bit_cast(float, __builtin_amdgcn_update_dpp(0, __builtin_bit_cast(int, v), 0x142, 0xA, 0xF, false));
    v += __builtin_bit_cast(float, __builtin_amdgcn_update_dpp(0, __builtin_bit_cast(int, v), 0x143, 0xC, 0xF, false));
    return __builtin_bit_cast(float, __builtin_amdgcn_readlane(__builtin_bit_cast(int, v), 63));
}
DI float gelu_tanh(float x) {
    const float u = 0.7978845608028654f * (x + 0.044715f * x * x * x);
    const float e = __expf(2.f * u);
    const float t = 1.f - 2.f / (e + 1.f);
    return 0.5f * x * (1.f + t);
}
DI int cond_of(int T) { return T < TP ? 0 : 1 + ((T - TP) >> 12); }
#define XB_TMO      128
#define XB_XCNT(j)  (256  + 64 * (j))
#define XB_XSUB(j)  (1280 + 64 * (j))
#define XB_XGEN(j)  (2304 + 64 * (j))
#define XB_TOP      3328
#define XB_TOPGEN   3392
#define XCD_BAR_WORDS 3456
#define XB_SPIN_CAP (1u << 26)
#define LAS __attribute__((address_space(3)))

__device__ __forceinline__ unsigned xb_ld(unsigned* p)              { return __hip_atomic_load(p, __ATOMIC_RELAXED, __HIP_MEMORY_SCOPE_AGENT); }
__device__ __forceinline__ unsigned xb_add(unsigned* p, unsigned v) { return __hip_atomic_fetch_add(p, v, __ATOMIC_RELAXED, __HIP_MEMORY_SCOPE_AGENT); }
__device__ __forceinline__ unsigned xb_xcc_id() { return (unsigned)__builtin_amdgcn_s_getreg((3 << 11) | 20) & 0xFu; }
#define XB_SPIN(cond, bar) do { unsigned _sp = 0; while (cond) { __builtin_amdgcn_s_sleep(1); \
    if ((++_sp & 255u) == 0u) { if (xb_ld(&(bar)[XB_TMO])) break; if (_sp > XB_SPIN_CAP) { atomicAdd(&(bar)[XB_TMO], 1u); break; } } } } while (0)

struct XcdBarrier {
    unsigned* bar; unsigned x;
    volatile LAS unsigned* st;
};

__device__ __forceinline__ XcdBarrier xcd_barrier_post(unsigned* bar, volatile LAS unsigned* st) {
    XcdBarrier b; b.bar = bar; b.x = xb_xcc_id(); b.st = st;
    if (threadIdx.x == 0) (void)xb_add(&bar[XB_XCNT(b.x)], 1u);
    return b;
}
__device__ __forceinline__ void xcd_barrier_complete(unsigned* bar, unsigned x, unsigned& nloc, unsigned& nx) {
    const unsigned G = gridDim.x * gridDim.y * gridDim.z;
    unsigned sum, cnt, mine, sp = 0u;
    for (;;) {
        sum = 0u; cnt = 0u; mine = 0u;
#pragma unroll
        for (unsigned j = 0; j < 16; ++j) { const unsigned c = xb_ld(&bar[XB_XCNT(j)]); sum += c; cnt += (c > 0u) ? 1u : 0u; mine = (j == x) ? c : mine; }
        if (sum == G) break;
        __builtin_amdgcn_s_sleep(1);
        if ((++sp & 255u) == 0u) { if (xb_ld(&bar[XB_TMO])) break; if (sp > XB_SPIN_CAP) { atomicAdd(&bar[XB_TMO], 1u); break; } }
    }
    nloc = mine > 0u ? mine : 1u; nx = cnt > 0u ? cnt : 1u;
}

__device__ __forceinline__ void xcd_barrier(const XcdBarrier& b) {
    asm volatile("s_waitcnt vmcnt(0)" ::: "memory");
    __syncthreads();
    if (threadIdx.x == 0) {
        unsigned* bar = b.bar;
        __builtin_amdgcn_s_waitcnt(0);
        unsigned nloc = b.st[0], nx = b.st[1];
        if (nloc == 0u) { xcd_barrier_complete(bar, b.x, nloc, nx); b.st[0] = nloc; b.st[1] = nx; }
        const unsigned old = xb_add(&bar[XB_XSUB(b.x)], 1u);
        const unsigned gen = old / nloc;
        if (old + 1u == (gen + 1u) * nloc) {
            __builtin_amdgcn_fence(__ATOMIC_RELEASE, "agent");
            asm volatile("s_waitcnt vmcnt(0)" ::: "memory");
            const unsigned og = xb_add(&bar[XB_TOP], 1u);
            const unsigned tg = og / nx;
            if (og + 1u == (tg + 1u) * nx) xb_add(&bar[XB_TOPGEN], 1u);
            else XB_SPIN(xb_ld(&bar[XB_TOPGEN]) == tg, bar);
            __builtin_amdgcn_fence(__ATOMIC_ACQUIRE, "agent");
            xb_add(&bar[XB_XGEN(b.x)], 1u);
            asm volatile("s_waitcnt vmcnt(0)" ::: "memory");
        } else {
            XB_SPIN(xb_ld(&bar[XB_XGEN(b.x)]) == gen, bar);
            __builtin_amdgcn_fence(__ATOMIC_ACQUIRE, "agent");
            asm volatile("s_waitcnt vmcnt(0)" ::: "memory");
        }
    }
    __syncthreads();
}
namespace pg8 {
#define PG8_LAS __attribute__((address_space(3)))
typedef unsigned short bf16_t;
typedef short bf16x8 __attribute__((ext_vector_type(8)));
typedef float f32x4 __attribute__((ext_vector_type(4)));
typedef unsigned u32x4 __attribute__((ext_vector_type(4)));
constexpr int BM = 256, BK = 64, HALF = 128, HTB = HALF * BK * 2  , STAGE_BYTES = 8 * HTB, NXCD = 8, WGM = 8;

__host__ __device__ __forceinline__ int lds_byte(int r, int c) { const int st = (r >> 4) * 2 + (c >> 5), rr = r & 15, cc = c & 31, ob = rr * 64 + cc * 2; return st * 1024 + (ob ^ (((ob >> 9) & 1) << 5)); }
__host__ __device__ __forceinline__ void stage_rc(int b, int& R, int& C) { const int st = b / 1024, sb = b % 1024, swz = sb ^ (((sb >> 9) & 1) << 5); R = (st >> 1) * 16 + swz / 64; C = (st & 1) * 32 + (swz % 64) / 2; }
__host__ __device__ __forceinline__ int perm32(int rho) { const int n = rho >> 4, i = rho & 15; return 8 * (i >> 2) + 4 * n + (i & 3); }

struct Unit { int pm, pn; };
struct Gemm { const bf16_t* A; const bf16_t* Bt; int M, N, K; };

struct StaticOrder {
    int nM, nN, nwg, G, c;
    __host__ __device__ void init(int M, int N, int G_, int c_) { nM = M / BM; nN = N / BM; nwg = nM * nN; G = G_; c = c_; }
    __host__ __device__ bool next(int i, Unit& u) const {
        const long L = (long)i * G + c; if (L >= nwg) return false;
        int wgid = (int)L; { const int q = nwg / NXCD, r = nwg % NXCD, xcd = wgid % NXCD, off = wgid / NXCD; wgid = (xcd < r ? xcd * (q + 1) : r * (q + 1) + (xcd - r) * q) + off; }
        const int nig = WGM * nN, gid = wgid / nig, fm = gid * WGM, gsz = (nM - fm) < WGM ? (nM - fm) : WGM;
        u.pm = fm + ((wgid % nig) % gsz); u.pn = (wgid % nig) / gsz; return true;
    }
    __device__ __forceinline__ void a_ready(const Unit&) const {}
    __device__ __forceinline__ void done(const Unit&) const {}
};
__device__ __forceinline__ unsigned cvt_pk_bf16(float lo, float hi) { unsigned r; asm volatile("v_cvt_pk_bf16_f32 %0, %1, %2" : "=v"(r) : "v"(lo), "v"(hi)); return r; }
template <class Epi, class Sched, bool STAMP = false>
__device__ __forceinline__ void gemm_phase(PG8_LAS unsigned char* lds, const Gemm g, const Sched& S, const Epi& E, unsigned long long* stamps) {
    const int tid = threadIdx.x, wid = __builtin_amdgcn_readfirstlane(tid >> 6), lane = tid & 63, wr = wid >> 2, wc = wid & 3, fr = lane & 15, fq = lane >> 4;
    const int K = g.K, nt = K / BK;
    int ts_lo = 0, ts_hi = 0, nts = 0; const unsigned long long rt_entry = STAMP ? (unsigned long long)wall_clock64() : 0ull;
#define PG8_STAMP() do { if (STAMP && wid == 0 && nts < 64) { const unsigned long long _c = (unsigned long long)clock64(); \
        ts_lo = (lane == nts) ? (int)(unsigned)_c : ts_lo; ts_hi = (lane == nts) ? (int)(unsigned)(_c >> 32) : ts_hi; ++nts; } } while (0)
    PG8_STAMP();
    unsigned voffA[2], voffB[2];
#pragma unroll
    for (int i = 0; i < 2; ++i) { int R, C; stage_rc(tid * 16 + i * 8192, R, C); const int Rb = Epi::PERM ? ((R & ~31) + perm32(R & 31)) : R;
        voffA[i] = (unsigned)(R * K + C) * 2u; voffB[i] = (unsigned)(Rb * K + C) * 2u; }
    const size_t kstep = (size_t)(BK * 2);
    const size_t hstep = (size_t)HALF * K * 2;
    const size_t tstep = 2 * hstep;
    const unsigned ldsw = (unsigned)wid * 1024u;
    const int aoff = lds_byte(wr * 64 + fr, fq * 8), boff = lds_byte(wc * 32 + fr, fq * 8);
#define PG8_SA(b, h) (((b) * 2 + (h)) * HTB)
#define PG8_SB(b, h) ((4 + (b) * 2 + (h)) * HTB)
#define PG8_STAGE(bufoff, gbase, voff) do { _Pragma("unroll") for (int _i = 0; _i < 2; ++_i) \
        __builtin_amdgcn_global_load_lds((const unsigned*)((const char*)(gbase) + (voff)[_i]), (PG8_LAS unsigned*)(lds + (bufoff) + ldsw + _i * 8192), 16, 0, 0); } while (0)
#define PG8_LDA(dst, b, h) do { _Pragma("unroll") for (int m = 0; m < 4; ++m) _Pragma("unroll") for (int k = 0; k < 2; ++k) dst[m][k] = *(const PG8_LAS bf16x8*)(lds + PG8_SA(b, h) + aoff + m * 2048 + k * 1024); } while (0)
#define PG8_LDB(dst, b, h) do { _Pragma("unroll") for (int n = 0; n < 2; ++n) _Pragma("unroll") for (int k = 0; k < 2; ++k) dst[n][k] = *(const PG8_LAS bf16x8*)(lds + PG8_SB(b, h) + boff + n * 2048 + k * 1024); } while (0)
#define PG8_MMA(ai, bj, At, Bt) do { __builtin_amdgcn_s_setprio(1); _Pragma("unroll") for (int m = 0; m < 4; ++m) _Pragma("unroll") for (int n = 0; n < 2; ++n) _Pragma("unroll") for (int k = 0; k < 2; ++k) \
        acc[ai][bj][m][n] = __builtin_amdgcn_mfma_f32_16x16x32_bf16(Bt[n][k], At[m][k], acc[ai][bj][m][n], 0, 0, 0); __builtin_amdgcn_s_setprio(0); } while (0)
#define PG8_WAIT_V(n) asm volatile("s_waitcnt vmcnt(" #n ")" ::: "memory")
#define PG8_WAIT_L(n) asm volatile("s_waitcnt lgkmcnt(" #n ")" ::: "memory")
#define PG8_BAR __builtin_amdgcn_s_barrier()
#define PG8_SCHED __builtin_amdgcn_sched_barrier(0)
    Unit cur, nxt; int ui = 0;
    if (!S.next(0, cur)) return;
    f32x4 acc[2][2][4][2];
#pragma unroll
    for (int a = 0; a < 2; ++a)
#pragma unroll
        for (int b = 0; b < 2; ++b)
#pragma unroll
            for (int m = 0; m < 4; ++m)
#pragma unroll
                for (int n = 0; n < 2; ++n) acc[a][b][m][n] = (f32x4){0.f, 0.f, 0.f, 0.f};
    bf16x8 At[4][2], B0[2][2], B1[2][2];
    const char* cA = (const char*)g.A + (size_t)cur.pm * tstep; const char* cB = (const char*)g.Bt + (size_t)cur.pn * tstep;
    S.a_ready(cur);
    PG8_STAGE(PG8_SB(0, 0), cB, voffB); PG8_STAGE(PG8_SA(0, 0), cA, voffA); PG8_STAGE(PG8_SB(0, 1), cB + hstep, voffB); PG8_STAGE(PG8_SA(0, 1), cA + hstep, voffA);
    if (wr == 1) PG8_BAR;
    PG8_WAIT_V(4); PG8_BAR;
    PG8_STAGE(PG8_SB(1, 0), cB + kstep, voffB); PG8_STAGE(PG8_SA(1, 0), cA + kstep, voffA); PG8_STAGE(PG8_SB(1, 1), cB + hstep + kstep, voffB);
    PG8_WAIT_V(6); PG8_BAR;
    PG8_STAMP();
    for (;;) {
        const bool has_next = S.next(ui + 1, nxt);
        const char* nA = has_next ? (const char*)g.A + (size_t)nxt.pm * tstep : cA; const char* nB = has_next ? (const char*)g.Bt + (size_t)nxt.pn * tstep : cB;
        for (int t = 0; t < nt; t += 2) {
            const bool last = (t == nt - 2);
            const char* a1 = cA + (size_t)(t + 1) * kstep;
            const char* a2 = last ? nA : cA + (size_t)(t + 2) * kstep; const char* b2 = last ? nB : cB + (size_t)(t + 2) * kstep;
            const char* a3 = a2 + kstep; const char* b3 = b2 + kstep;
            if (last && has_next) S.a_ready(nxt);
            PG8_LDB(B0, 0, 0); PG8_SCHED; PG8_LDA(At, 0, 0); PG8_STAGE(PG8_SA(1, 1), a1 + hstep, voffA);
            PG8_WAIT_L(8); PG8_BAR; PG8_WAIT_L(0); PG8_MMA(0, 0, At, B0); PG8_BAR; PG8_SCHED;
            PG8_LDB(B1, 0, 1); PG8_STAGE(PG8_SB(0, 0), b2, voffB);
            PG8_BAR; PG8_WAIT_L(0); PG8_MMA(0, 1, At, B1); PG8_BAR;
            PG8_LDA(At, 0, 1); PG8_STAGE(PG8_SA(0, 0), a2, voffA);
            PG8_BAR; PG8_WAIT_L(0); PG8_MMA(1, 0, At, B0); PG8_BAR; PG8_SCHED;
            PG8_STAGE(PG8_SB(0, 1), b2 + hstep, voffB);
            PG8_WAIT_V(6); PG8_BAR; PG8_MMA(1, 1, At, B1); PG8_BAR;
            PG8_LDB(B0, 1, 0); PG8_SCHED; PG8_LDA(At, 1, 0); PG8_STAGE(PG8_SA(0, 1), a2 + hstep, voffA);
            PG8_WAIT_L(8); PG8_BAR; PG8_WAIT_L(0); PG8_MMA(0, 0, At, B0); PG8_BAR; PG8_SCHED;
            PG8_LDB(B1, 1, 1); PG8_STAGE(PG8_SB(1, 0), b3, voffB);
            PG8_BAR; PG8_WAIT_L(0); PG8_MMA(0, 1, At, B1); PG8_BAR;
            PG8_LDA(At, 1, 1); PG8_STAGE(PG8_SA(1, 0), a3, voffA);
            PG8_BAR; PG8_WAIT_L(0); PG8_MMA(1, 0, At, B0); PG8_BAR; PG8_SCHED;
            PG8_STAGE(PG8_SB(1, 1), b3 + hstep, voffB);
            PG8_WAIT_V(6); PG8_BAR; PG8_MMA(1, 1, At, B1); PG8_BAR;
        }
        PG8_STAMP();
        if constexpr (!Epi::AFTER_DRAIN) { E(acc, cur, wr, wc, fr, fq); S.done(cur); }
        PG8_STAMP();
        if (!has_next) break;
#pragma unroll
        for (int a = 0; a < 2; ++a)
#pragma unroll
            for (int b = 0; b < 2; ++b)
#pragma unroll
                for (int m = 0; m < 4; ++m)
#pragma unroll
                    for (int n = 0; n < 2; ++n) acc[a][b][m][n] = (f32x4){0.f, 0.f, 0.f, 0.f};
        cur = nxt; cA = nA; cB = nB; ++ui;
    }
    PG8_WAIT_V(0);
    if (wr == 0) PG8_BAR;
    PG8_BAR;
    if constexpr (Epi::AFTER_DRAIN) { E.fused(acc, cur, wr, wc, fr, fq, lds, wid, lane); S.done(cur); }
    PG8_STAMP();
    if (STAMP && wid == 0) { stamps[lane] = lane < nts ? (((unsigned long long)(unsigned)ts_hi << 32) | (unsigned)ts_lo) : 0ull;
        if (lane == 62) stamps[62] = rt_entry; if (lane == 63) stamps[63] = (unsigned long long)wall_clock64(); }
#undef PG8_STAMP
#undef PG8_SA
#undef PG8_SB
#undef PG8_STAGE
#undef PG8_LDA
#undef PG8_LDB
#undef PG8_MMA
#undef PG8_WAIT_V
#undef PG8_WAIT_L
#undef PG8_BAR
#undef PG8_SCHED
}
}
struct Ctx {
    LAS unsigned char* lds; int tid, lane, wave, G, bid;
};

DI void cvt_rows(const Ctx& F, const float* src, bf16_t* dst, size_t n) {
    const size_t n8 = n >> 3;
    for (size_t i = (size_t)F.bid * NTHR + F.tid; i < n8; i += (size_t)F.G * NTHR) {
        const f32x4 a = *(const f32x4*)(src + i * 8), b = *(const f32x4*)(src + i * 8 + 4);
        u32x4 w; w.x = pk2(a.x, a.y); w.y = pk2(a.z, a.w); w.z = pk2(b.x, b.y); w.w = pk2(b.z, b.w);
        *(u32x4*)(dst + i * 8) = w;
    }
}

DI void tr_tile_f32(const Ctx& F, const float* src, size_t lds_, bf16_t* dst, size_t ldd, LAS bf16_t* tile) {
#pragma unroll
    for (int j = 0; j < 2; ++j) {
        const int id = F.tid + NTHR * j, kr = id >> 4, nc = (id & 15) * 4;
        const f32x4 v = *(const f32x4*)(src + (size_t)kr * lds_ + nc);
        tile[(nc + 0) * 72 + kr] = f2bf(v.x); tile[(nc + 1) * 72 + kr] = f2bf(v.y); tile[(nc + 2) * 72 + kr] = f2bf(v.z); tile[(nc + 3) * 72 + kr] = f2bf(v.w);
    }
    __syncthreads();
    { const int n = F.tid >> 3, kc = (F.tid & 7) * 8; const u32x4 v = *(const LAS u32x4*)(tile + n * 72 + kc); *(u32x4*)(dst + (size_t)n * ldd + kc) = v; }
    __syncthreads();
}
DI void tr_tile_bf16(const Ctx& F, const bf16_t* src, size_t lds_, bf16_t* dst, size_t ldd, LAS bf16_t* tile) {
    { const int kr = F.tid >> 3, nc = (F.tid & 7) * 8; const u32x4 v = *(const u32x4*)(src + (size_t)kr * lds_ + nc);
      tile[(nc + 0) * 72 + kr] = (bf16_t)(v.x & 0xffff); tile[(nc + 1) * 72 + kr] = (bf16_t)(v.x >> 16); tile[(nc + 2) * 72 + kr] = (bf16_t)(v.y & 0xffff); tile[(nc + 3) * 72 + kr] = (bf16_t)(v.y >> 16);
      tile[(nc + 4) * 72 + kr] = (bf16_t)(v.z & 0xffff); tile[(nc + 5) * 72 + kr] = (bf16_t)(v.z >> 16); tile[(nc + 6) * 72 + kr] = (bf16_t)(v.w & 0xffff); tile[(nc + 7) * 72 + kr] = (bf16_t)(v.w >> 16); }
    __syncthreads();
    { const int n = F.tid >> 3, kc = (F.tid & 7) * 8; const u32x4 v = *(const LAS u32x4*)(tile + n * 72 + kc); *(u32x4*)(dst + (size_t)n * ldd + kc) = v; }
    __syncthreads();
}
DI void transpose_weight(const Ctx& F, const float* W, int K, int N, bf16_t* Wt) {
    const int tk = K / 64, tn = N / 64;
    for (int t = F.bid; t < tk * tn; t += F.G) {
        const int k0 = (t / tn) * 64, n0 = (t % tn) * 64;
        tr_tile_f32(F, W + (size_t)k0 * N + n0, (size_t)N, Wt + (size_t)n0 * K + k0, (size_t)K, (LAS bf16_t*)F.lds);
    }
}
DI void transpose_cache_v(const Ctx& F, const float* V, bf16_t* VT) {
    for (int t = F.bid; t < 64 * 8; t += F.G) {
        const int bh = t >> 3, sub = t & 7, k0 = (sub >> 1) * 64, d0 = (sub & 1) * 64, b = bh >> 3, h = bh & 7;
        tr_tile_f32(F, V + ((size_t)b * 256 + k0) * 1024 + h * 128 + d0, 1024, VT + ((size_t)bh * 128 + d0) * 256 + k0, 256, (LAS bf16_t*)F.lds);
    }
}

DI void adaln_partials(const Ctx& F, const Params& P) {
    LAS float* s = (LAS float*)F.lds;
    const float* modw = P.in[I_MODW]; const float* cv = P.in[I_C]; const float* cctx = P.in[I_CCTX];
    float* modp = (float*)(P.ws + WS_MODP);
    for (int it = F.bid; it < 192; it += F.G) {
        const int i = it / 96, r = it % 96, ks = r / 6, cg = r % 6;
        __syncthreads();
        for (int e = F.tid; e < 9 * 128; e += NTHR) { const int j = e >> 7, k = e & 127; const float c = (j == 0) ? cctx[ks * 128 + k] : cv[(j - 1) * 2048 + ks * 128 + k]; s[e] = c / (1.f + __expf(-c)); }
        __syncthreads();
        f32x4 acc[9];
#pragma unroll
        for (int j = 0; j < 9; ++j) acc[j] = (f32x4){0.f, 0.f, 0.f, 0.f};
        const float* w = modw + ((size_t)i * 2048 + ks * 128) * 12288 + cg * 2048 + F.tid * 4;
#pragma unroll 8
        for (int k = 0; k < 128; ++k) {
            const f32x4 w4 = *(const f32x4*)(w + (size_t)k * 12288);
#pragma unroll
            for (int j = 0; j < 9; ++j) acc[j] += w4 * s[j * 128 + k];
        }
#pragma unroll
        for (int j = 0; j < 9; ++j) *(f32x4*)(modp + ((size_t)(i * 16 + ks) * 9 + j) * 12288 + cg * 2048 + F.tid * 4) = acc[j];
    }
    __syncthreads();
}
DI void adaln_reduce(const Ctx& F, const Params& P) {
    const float* modp = (const float*)(P.ws + WS_MODP); float* mod = (float*)(P.ws + WS_MOD); const float* modb = P.in[I_MODB];
    for (int e = F.bid * NTHR + F.tid; e < 2 * 9 * 12288; e += F.G * NTHR) {
        const int i = e / (9 * 12288), r = e % (9 * 12288), j = r / 12288, n = r % 12288;
        float a = modb[i * 12288 + n];
#pragma unroll
        for (int ks = 0; ks < 16; ++ks) a += modp[((size_t)(i * 16 + ks) * 9 + j) * 12288 + n];
        mod[e] = a;
    }
}

DI void hyena_filters(const Ctx& F, const Params& P) {
    LAS float* z = (LAS float*)F.lds;
    LAS float* h1 = z + 8 * 33;
    LAS float* h2 = h1 + 8 * 64;
    const float* w1 = P.in[I_HYW1]; const float* b1 = P.in[I_HYB1]; const float* f1 = P.in[I_HYF1];
    const float* w2 = P.in[I_HYW2]; const float* b2 = P.in[I_HYB2]; const float* f2 = P.in[I_HYF2];
    const float* w3 = P.in[I_HYW3]; const float* dec = P.in[I_HYDEC];
    for (int it = F.bid; it < 544; it += F.G) {
        const bool smp = it < 512; const int L = smp ? LS : LP, p0 = (smp ? it : it - 512) * 8, RL = smp ? KRL_S : KRL_P;
        bf16_t* KR = (bf16_t*)(P.ws + (smp ? WS_KRS : WS_KRP));
        __syncthreads();
        if (F.tid < 8 * 33) {
            const int ps = F.tid / 33, k = F.tid % 33, i = p0 + ps;
            const float t = (float)i / (float)(L - 1), wang = 6.283185307179586f * (float)i / (float)L;
            float val;
            if (k == 0) val = t;
            else { const int f = (k - 1) & 15; const float fr = 1e-4f + (float)f * ((15.0f - 1e-4f) / 15.0f); val = (k <= 16) ? cosf(fr * wang) : -sinf(fr * wang); }
            z[F.tid] = val;
        }
        __syncthreads();
        { const int ps = F.tid >> 6, j = F.tid & 63; float a = b1[j];
          for (int k = 0; k < 33; ++k) a += z[ps * 33 + k] * w1[k * 64 + j];
          h1[F.tid] = sinf(f1[j] * a); }
        __syncthreads();
        { const int ps = F.tid >> 6, j = F.tid & 63; float a = b2[j];
          for (int k = 0; k < 64; ++k) a += h1[ps * 64 + k] * w2[k * 64 + j];
          h2[F.tid] = sinf(f2[j] * a); }
        __syncthreads();
#pragma unroll 1
        for (int qh = 0; qh < 2; ++qh) {
            float acc[8][4];
#pragma unroll
            for (int ps = 0; ps < 8; ++ps)
#pragma unroll
                for (int q = 0; q < 4; ++q) acc[ps][q] = 0.f;
#pragma unroll 2
            for (int k = 0; k < 64; ++k) {
                float w[4];
#pragma unroll
                for (int q = 0; q < 4; ++q) w[q] = w3[k * 4096 + F.tid + NTHR * (qh * 4 + q)];
#pragma unroll
                for (int ps = 0; ps < 8; ++ps) { const float hv = h2[ps * 64 + k];
#pragma unroll
                    for (int q = 0; q < 4; ++q) acc[ps][q] += hv * w[q]; }
            }
#pragma unroll
            for (int q = 0; q < 4; ++q) {
                const int n = F.tid + NTHR * (qh * 4 + q), dir = n >> 11, o = (n >> 10) & 1, c = n & 1023;
                const float dc = fabsf(dec[n]);
                bf16_t* row0 = KR + ((size_t)(o * 1024 + c) * 2) * RL; bf16_t* row1 = row0 + RL;
#pragma unroll
                for (int ps = 0; ps < 8; ++ps) {
                    const int i = p0 + ps; const float t = (float)i / (float)(L - 1);
                    const bf16_t v = f2bf(acc[ps][q] * __expf(-t * dc));
                    if (dir == 0) { const int x = L - i; row0[x] = v; row1[x - 1] = v; }
                    else if (i > 0) { const int x = L + i; row0[x] = v; row1[x - 1] = v; }
                }
            }
        }
    }
    __syncthreads();
    for (int e = F.bid * NTHR + F.tid; e < 2 * 2048; e += F.G * NTHR) {
        const bool smp = e < 2048; const int r = e & 2047, L = smp ? LS : LP, RL = smp ? KRL_S : KRL_P;
        bf16_t* row0 = (bf16_t*)(P.ws + (smp ? WS_KRS : WS_KRP)) + ((size_t)r * 2) * RL; bf16_t* row1 = row0 + RL;
        row0[0] = 0;
        for (int x = 2 * L; x < RL; ++x) row0[x] = 0;
        for (int x = 2 * L - 1; x < RL; ++x) row1[x] = 0;
    }
}

DI void s5_consts(const Ctx& F, const Params& P) {
    float* S5A = (float*)(P.ws + WS_S5A); bf16_t* BB = (bf16_t*)(P.ws + WS_S5BB); bf16_t* CC = (bf16_t*)(P.ws + WS_S5CC);
    const float* lre = P.in[I_S5LRE]; const float* lim = P.in[I_S5LIM]; const float* ldt = P.in[I_S5LDT];
    const float* bre = P.in[I_S5BRE]; const float* bim = P.in[I_S5BIM]; const float* cre = P.in[I_S5CRE]; const float* cim = P.in[I_S5CIM];
    for (int e = F.bid * NTHR + F.tid; e < 8192; e += F.G * NTHR) {
        const int dg = e >> 6, n = e & 63;
        const float dt = expf(ldt[dg]), lr = lre[e], li = lim[e];
        const float mag = expf(lr * dt), ar = mag * cosf(li * dt), ai = mag * sinf(li * dt), den = lr * lr + li * li;
        const float cr = ((ar - 1.f) * lr + ai * li) / den, ci = (ai * lr - (ar - 1.f) * li) / den;
        S5A[e * 2] = ar; S5A[e * 2 + 1] = ai;
#pragma unroll
        for (int p = 0; p < 16; ++p) {
            const float br = bre[(size_t)e * 16 + p], bi = bim[(size_t)e * 16 + p];
            BB[((size_t)dg * 128 + n) * 16 + p] = f2bf(cr * br - ci * bi);
            BB[((size_t)dg * 128 + 64 + n) * 16 + p] = f2bf(cr * bi + ci * br);
            CC[((size_t)dg * 16 + p) * 128 + n] = f2bf(cre[((size_t)dg * 16 + p) * 64 + n]);
            CC[((size_t)dg * 16 + p) * 128 + 64 + n] = f2bf(-cim[((size_t)dg * 16 + p) * 64 + n]);
        }
    }
}

DI void convert_peer_tables(const Ctx& F, const Params& P, int layer) {
    cvt_rows(F, P.in[I_PU] + (size_t)layer * 16384 * 2048, (bf16_t*)(P.ws + WS_TBLU), (size_t)16384 * 2048);
    cvt_rows(F, P.in[I_PV] + (size_t)layer * 16384 * 2048, (bf16_t*)(P.ws + WS_TBLV), (size_t)16384 * 2048);
}

DI void prologue(const Ctx& F, const Params& P) {
    adaln_partials(F, P);
    transpose_weight(F, P.in[I_EVWIN], 2048, 6144, (bf16_t*)(P.ws + WS_WEVIN));
    transpose_weight(F, P.in[I_EVWOUT], 2048, 2048, (bf16_t*)(P.ws + WS_WEVOUT));
    transpose_weight(F, P.in[I_ODWIN], 2048, 4096, (bf16_t*)(P.ws + WS_WODIN));
    transpose_weight(F, P.in[I_ODWOUT], 2048, 2048, (bf16_t*)(P.ws + WS_WODOUT));
    transpose_weight(F, P.in[I_PWQ], 2048, 2048, (bf16_t*)(P.ws + WS_WPQ));
    transpose_weight(F, P.in[I_PWQ] + (size_t)2048 * 2048, 2048, 2048, (bf16_t*)(P.ws + WS_WPQ) + (size_t)2048 * 2048);
    transpose_weight(F, P.in[I_GLUW], 1024, 1024, (bf16_t*)(P.ws + WS_WGLU));
    cvt_rows(F, P.in[I_PKEYS], (bf16_t*)(P.ws + WS_PKEYS), (size_t)2 * 8 * 2 * 128 * 128);
    cvt_rows(F, P.in[I_CNK], (bf16_t*)(P.ws + WS_CNK), (size_t)8 * 256 * 1024);
    cvt_rows(F, P.in[I_CDK], (bf16_t*)(P.ws + WS_CDK), (size_t)8 * 256 * 1024);
    transpose_cache_v(F, P.in[I_CNV], (bf16_t*)(P.ws + WS_CNVT));
    transpose_cache_v(F, P.in[I_CDV], (bf16_t*)(P.ws + WS_CDVT));
    hyena_filters(F, P);
    s5_consts(F, P);
    convert_peer_tables(F, P, 0);
}
DI void norm_phase(const Ctx& F, const float* xa, const float* xb, const float* gvec, const float* modl, int sidx, bf16_t* H) {
    for (int T = F.bid * 8 + F.wave; T < TOK; T += F.G * 8) {
        const float* xr = T < TP ? xa + (size_t)T * DM : xb + (size_t)(T - TP) * DM;
        f32x4 v[8]; float ss = 0.f;
#pragma unroll
        for (int j = 0; j < 8; ++j) { v[j] = *(const f32x4*)(xr + (j * 64 + F.lane) * 4); ss += v[j].x * v[j].x + v[j].y * v[j].y + v[j].z * v[j].z + v[j].w * v[j].w; }
        ss = wave_sum(ss);
        const float rstd = rsqrtf(ss * (1.f / DM) + NORM_EPS);
        const float* sh = modl + (size_t)(cond_of(T) * 6 + sidx) * DM; const float* sc = sh + DM;
#pragma unroll
        for (int j = 0; j < 8; ++j) {
            const int col = (j * 64 + F.lane) * 4;
            const f32x4 g4 = *(const f32x4*)(gvec + col), s4 = *(const f32x4*)(sc + col), h4 = *(const f32x4*)(sh + col);
            const f32x4 o = v[j] * rstd * g4 * (s4 + 1.f) + h4;
            u32x2 w; w.x = pk2(o.x, o.y); w.y = pk2(o.z, o.w);
            *(u32x2*)(H + (size_t)T * DM + col) = w;
        }
    }
}

struct EpiBf16 {
    static constexpr bool PERM = true, AFTER_DRAIN = false;
    bf16_t* O; int ldc;
    DI void operator()(const f32x4 (&acc)[2][2][4][2], const pg8::Unit& u, int wr, int wc, int fr, int fq) const {
        const int row0 = u.pm * 256 + wr * 64 + fr, col0 = u.pn * 256 + wc * 32 + 8 * fq;
#pragma unroll
        for (int ai = 0; ai < 2; ++ai)
#pragma unroll
            for (int m = 0; m < 4; ++m) { bf16_t* rowp = O + (size_t)(row0 + ai * 128 + m * 16) * ldc + col0;
#pragma unroll
                for (int bj = 0; bj < 2; ++bj) { const f32x4 v0 = acc[ai][bj][m][0], v1 = acc[ai][bj][m][1];
                    u32x4 w; w.x = pk2(v0[0], v0[1]); w.y = pk2(v0[2], v0[3]); w.z = pk2(v1[0], v1[1]); w.w = pk2(v1[2], v1[3]);
                    *(u32x4*)(rowp + bj * 128) = w; } }
    }
};
struct EpiResid {
    static constexpr bool PERM = false, AFTER_DRAIN = false;
    const float* xa; const float* xb; float* out; const float* modl; int gidx;
    DI void operator()(const f32x4 (&acc)[2][2][4][2], const pg8::Unit& u, int wr, int wc, int fr, int fq) const {
        const int row0 = u.pm * 256 + wr * 64 + fr, col0 = u.pn * 256 + wc * 32 + 4 * fq;
        const float* xbase = (u.pm < 32) ? xa : xb - (size_t)TP * DM;
        const float* gate = modl + (size_t)(cond_of(u.pm * 256) * 6 + gidx) * DM;
        f32x4 gv[2][2];
#pragma unroll
        for (int bj = 0; bj < 2; ++bj)
#pragma unroll
            for (int n = 0; n < 2; ++n) gv[bj][n] = *(const f32x4*)(gate + col0 + bj * 128 + n * 16);
#pragma unroll
        for (int ai = 0; ai < 2; ++ai)
#pragma unroll
            for (int m = 0; m < 4; ++m) { const size_t ro = (size_t)(row0 + ai * 128 + m * 16) * DM + col0;
#pragma unroll
                for (int bj = 0; bj < 2; ++bj)
#pragma unroll
                    for (int n = 0; n < 2; ++n) { const f32x4 x4 = *(const f32x4*)(xbase + ro + bj * 128 + n * 16);
                        *(f32x4*)(out + ro + bj * 128 + n * 16) = x4 + gv[bj][n] * acc[ai][bj][m][n]; } }
    }
};
struct EpiGlu {
    static constexpr bool PERM = true, AFTER_DRAIN = false;
    const bf16_t* Y; bf16_t* O; const float* bias;
    DI void operator()(const f32x4 (&acc)[2][2][4][2], const pg8::Unit& u, int wr, int wc, int fr, int fq) const {
        const int row0 = u.pm * 256 + wr * 64 + fr, col0 = u.pn * 256 + wc * 32 + 8 * fq;
#pragma unroll
        for (int bj = 0; bj < 2; ++bj) {
            const f32x4 b0 = *(const f32x4*)(bias + col0 + bj * 128), b1 = *(const f32x4*)(bias + col0 + bj * 128 + 4);
#pragma unroll
            for (int ai = 0; ai < 2; ++ai)
#pragma unroll
                for (int m = 0; m < 4; ++m) { const size_t r = (size_t)(row0 + ai * 128 + m * 16);
                    const u32x4 yv = *(const u32x4*)(Y + r * 1024 + col0 + bj * 128);
                    const f32x4 a0 = acc[ai][bj][m][0] + b0, a1 = acc[ai][bj][m][1] + b1;
                    float o[8];
                    o[0] = bflo(yv.x) / (1.f + __expf(-a0[0])); o[1] = bfhi(yv.x) / (1.f + __expf(-a0[1]));
                    o[2] = bflo(yv.y) / (1.f + __expf(-a0[2])); o[3] = bfhi(yv.y) / (1.f + __expf(-a0[3]));
                    o[4] = bflo(yv.z) / (1.f + __expf(-a1[0])); o[5] = bfhi(yv.z) / (1.f + __expf(-a1[1]));
                    o[6] = bflo(yv.w) / (1.f + __expf(-a1[2])); o[7] = bfhi(yv.w) / (1.f + __expf(-a1[3]));
                    u32x4 w; w.x = pk2(o[0], o[1]); w.y = pk2(o[2], o[3]); w.z = pk2(o[4], o[5]); w.w = pk2(o[6], o[7]);
                    *(u32x4*)(O + r * DM + col0 + bj * 128) = w; }
        }
    }
};
template <class Epi> DI void run_gemm(const Ctx& F, const bf16_t* A, const bf16_t* Bt, int N, int K, const Epi& E) {
    pg8::Gemm g{A, Bt, TOK, N, K}; pg8::StaticOrder S; S.init(TOK, N, F.G, F.bid);
    pg8::gemm_phase<Epi, pg8::StaticOrder, false>(F.lds, g, S, E, nullptr);
    __syncthreads();
}

DI void prep_a(const Ctx& F, const Params& P) {
    const bf16_t* T1 = (const bf16_t*)(P.ws + WS_RA);
    bf16_t* VTp = (bf16_t*)(P.ws + WS_VT); bf16_t* VTs = (bf16_t*)(P.ws + WS_VT + VT_S);
    for (int t = F.bid; t < 2048 + 8192; t += F.G) {
        if (t < 2048) { const int bh = t >> 3, sub = t & 7, tk = sub >> 1, dd = sub & 1, b = bh >> 3, h = bh & 7;
            tr_tile_bf16(F, T1 + ((size_t)(b * 256 + tk * 64)) * 4096 + h * 128 + dd * 64, 4096, VTp + ((size_t)bh * 128 + dd * 64) * 256 + tk * 64, 256, (LAS bf16_t*)F.lds); }
        else { const int u = t - 2048, bh = u >> 7, sub = u & 127, tk = sub >> 1, dd = sub & 1, b = bh >> 3, h = bh & 7;
            tr_tile_bf16(F, T1 + ((size_t)(TP + b * 4096 + tk * 64)) * 4096 + h * 128 + dd * 64, 4096, VTs + ((size_t)bh * 128 + dd * 64) * 4096 + tk * 64, 4096, (LAS bf16_t*)F.lds); }
    }
    { float* o = P.out + O_NAV;
      for (int e = F.bid * NTHR + F.tid; e < TP * 128; e += F.G * NTHR) { const int T = e >> 7, c8 = (e & 127) * 8;
          const u32x4 v = *(const u32x4*)(T1 + (size_t)T * 4096 + c8);
          *(f32x4*)(o + (size_t)T * 1024 + c8) = (f32x4){bflo(v.x), bfhi(v.x), bflo(v.y), bfhi(v.y)};
          *(f32x4*)(o + (size_t)T * 1024 + c8 + 4) = (f32x4){bflo(v.z), bfhi(v.z), bflo(v.w), bfhi(v.w)}; } }
    { LAS bf16_t* tl = (LAS bf16_t*)F.lds;
      bf16_t* CM = (bf16_t*)(P.ws + WS_RB);
      const float* cw = P.in[I_HYCW]; const float* cb = P.in[I_HYCB];
      for (int t = F.bid; t < 48 * 160; t += F.G) {
          const int cg = t % 48, tg = t / 48, ch0 = cg * 64, t0 = tg * 256;
          const bool lz = (t0 < TP) ? true : (((t0 - TP) & 4095) == 0);
          const bool rz = (t0 < TP) ? true : (((t0 + 256 - TP) & 4095) == 0);
          __syncthreads();
#pragma unroll
          for (int j = 0; j < 4; ++j) { const int id = F.tid + NTHR * j, tk = id >> 3, c8 = (id & 7) * 8;
              const u32x4 v = *(const u32x4*)(T1 + (size_t)(t0 + tk) * 4096 + 1024 + ch0 + c8);
              LAS bf16_t* d = tl + tk + 1;
              d[(c8 + 0) * 264] = (bf16_t)(v.x & 0xffff); d[(c8 + 1) * 264] = (bf16_t)(v.x >> 16); d[(c8 + 2) * 264] = (bf16_t)(v.y & 0xffff); d[(c8 + 3) * 264] = (bf16_t)(v.y >> 16);
              d[(c8 + 4) * 264] = (bf16_t)(v.z & 0xffff); d[(c8 + 5) * 264] = (bf16_t)(v.z >> 16); d[(c8 + 6) * 264] = (bf16_t)(v.w & 0xffff); d[(c8 + 7) * 264] = (bf16_t)(v.w >> 16); }
          if (F.tid < 16) { const int side = F.tid >> 3, c8 = (F.tid & 7) * 8; const bool zero = side ? rz : lz; const int tk = side ? t0 + 256 : t0 - 1;
              u32x4 v = (u32x4){0u, 0u, 0u, 0u};
              if (!zero) v = *(const u32x4*)(T1 + (size_t)tk * 4096 + 1024 + ch0 + c8);
              LAS bf16_t* d = tl + (side ? 257 : 0);
              d[(c8 + 0) * 264] = (bf16_t)(v.x & 0xffff); d[(c8 + 1) * 264] = (bf16_t)(v.x >> 16); d[(c8 + 2) * 264] = (bf16_t)(v.y & 0xffff); d[(c8 + 3) * 264] = (bf16_t)(v.y >> 16);
              d[(c8 + 4) * 264] = (bf16_t)(v.z & 0xffff); d[(c8 + 5) * 264] = (bf16_t)(v.z >> 16); d[(c8 + 6) * 264] = (bf16_t)(v.w & 0xffff); d[(c8 + 7) * 264] = (bf16_t)(v.w >> 16); }
          __syncthreads();
#pragma unroll
          for (int j = 0; j < 4; ++j) { const int id = F.tid + NTHR * j, ch = id >> 5, to = (id & 31) * 8, cgl = ch0 + ch;
              const float w0 = cw[cgl], w1 = cw[3072 + cgl], w2 = cw[6144 + cgl], bb = cb[cgl];
              const LAS bf16_t* s = tl + ch * 264 + to;
              float r[10];
#pragma unroll
              for (int i = 0; i < 10; ++i) r[i] = bf2f(s[i]);
              float o[8];
#pragma unroll
              for (int i = 0; i < 8; ++i) o[i] = w0 * r[i] + w1 * r[i + 1] + w2 * r[i + 2] + bb;
              u32x4 w; w.x = pk2(o[0], o[1]); w.y = pk2(o[2], o[3]); w.z = pk2(o[4], o[5]); w.w = pk2(o[6], o[7]);
              *(u32x4*)(CM + (size_t)cgl * TOK + t0 + to) = w; }
      }
      __syncthreads(); }
}

DI void prep_b(const Ctx& F, const Params& P) {
    bf16_t* Pq = (bf16_t*)(P.ws + WS_RA); const float* qg = P.in[I_NAQG]; const float* kg = P.in[I_NAKG]; float* ok = P.out + O_NAK;
    const float* gsrc = (F.lane < 32 ? qg : kg) + (F.lane & 3) * 32;
    float g[32];
#pragma unroll
    for (int i = 0; i < 32; ++i) g[i] = gsrc[i];
    for (int T = F.bid * 8 + F.wave; T < TOK; T += F.G * 8) {
        bf16_t* rp = Pq + (size_t)T * 2048 + F.lane * 32;
        u32x4 v[4]; float x[32]; float ss = 0.f;
#pragma unroll
        for (int j = 0; j < 4; ++j) { v[j] = *(const u32x4*)(rp + j * 8);
            x[j * 8 + 0] = bflo(v[j].x); x[j * 8 + 1] = bfhi(v[j].x); x[j * 8 + 2] = bflo(v[j].y); x[j * 8 + 3] = bfhi(v[j].y);
            x[j * 8 + 4] = bflo(v[j].z); x[j * 8 + 5] = bfhi(v[j].z); x[j * 8 + 6] = bflo(v[j].w); x[j * 8 + 7] = bfhi(v[j].w); }
#pragma unroll
        for (int i = 0; i < 32; ++i) ss += x[i] * x[i];
        ss += dpp_xor1(ss); ss += dpp_xor2(ss);
        const float rstd = rsqrtf(ss * (1.f / 128.f) + NORM_EPS);
#pragma unroll
        for (int i = 0; i < 32; ++i) x[i] = x[i] * rstd * g[i];
#pragma unroll
        for (int j = 0; j < 4; ++j) { u32x4 w; w.x = pk2(x[j * 8 + 0], x[j * 8 + 1]); w.y = pk2(x[j * 8 + 2], x[j * 8 + 3]); w.z = pk2(x[j * 8 + 4], x[j * 8 + 5]); w.w = pk2(x[j * 8 + 6], x[j * 8 + 7]);
            *(u32x4*)(rp + j * 8) = w; }
        if (T < TP && F.lane >= 32) { float* o = ok + (size_t)T * 1024 + (F.lane - 32) * 32;
#pragma unroll
            for (int j = 0; j < 8; ++j) *(f32x4*)(o + j * 4) = (f32x4){x[j * 4], x[j * 4 + 1], x[j * 4 + 2], x[j * 4 + 3]}; }
    }
}
constexpr int AT_KROW = 272, AT_VROW = 136, AT_KTB = 64 * AT_KROW, AT_VTB = 128 * AT_VROW;
constexpr int AT_K0 = 0, AT_V0 = 2 * AT_KTB, AT_RPB = AT_V0 + 2 * AT_VTB;
constexpr float AT_OFF = 8.0f;

struct TileMap { const bf16_t* latK; int latKld; const bf16_t* latV; int latVld; int nlat; const bf16_t* ctxK; const bf16_t* ctxV; int ntiles; };
struct TileRegs { u32x4 k[2], v[2]; };

DI void tile_src(const TileMap& M, int j, const bf16_t*& kp, int& kld, const bf16_t*& vp, int& vld) {
    if (j < M.nlat) { kp = M.latK + (size_t)j * 64 * M.latKld; kld = M.latKld; vp = M.latV + j * 64; vld = M.latVld; }
    else { const int c = j - M.nlat; kp = M.ctxK + (size_t)c * 64 * 1024; kld = 1024; vp = M.ctxV + c * 64; vld = 256; }
}
DI void tile_load(const Ctx& F, TileRegs& R, const bf16_t* kp, int kld, const bf16_t* vp, int vld) {
#pragma unroll
    for (int j = 0; j < 2; ++j) { const int id = F.tid + NTHR * j;
        const unsigned ko = (unsigned)((id >> 4) * kld + (id & 15) * 8) * 2u, vo = (unsigned)((id >> 3) * vld + (id & 7) * 8) * 2u;
        R.k[j] = *(const u32x4*)((const char*)kp + ko);
        R.v[j] = *(const u32x4*)((const char*)vp + vo); }
}
DI void tile_store(const Ctx& F, const TileRegs& R, LAS unsigned char* kt, LAS unsigned char* vt) {
#pragma unroll
    for (int j = 0; j < 2; ++j) { const int id = F.tid + NTHR * j;
        *(LAS u32x4*)(kt + (id >> 4) * AT_KROW + (id & 15) * 16) = R.k[j];
        LAS unsigned char* vp = vt + (id >> 3) * AT_VROW + (id & 7) * 16;
        *(LAS u32x2*)(vp) = (u32x2){R.v[j].x, R.v[j].y}; *(LAS u32x2*)(vp + 8) = (u32x2){R.v[j].z, R.v[j].w}; }
}

template <int KS>
DI f32x16 qk_tile(LAS const unsigned char* kt, const bf16x8 (&Qf)[8], int kb, int kk0, int q, int hh) {
    f32x16 S;
#pragma unroll
    for (int i = 0; i < 16; ++i) S[i] = 0.f;
#pragma unroll
    for (int ks = 0; ks < KS; ++ks) { const int kk = kk0 + ks;
        const bf16x8 A = *(const LAS bf16x8*)(kt + (kb * 32 + q) * AT_KROW + (kk * 16 + hh * 8) * 2);
        S = __builtin_amdgcn_mfma_f32_32x32x16_bf16(A, Qf[kk], S, 0, 0, 0); }
    return S;
}
DI void pv_tile(LAS const unsigned char* vt, const float (&p)[16], f32x16 (&O)[4], int kb, int q, int hh) {
#pragma unroll
    for (int s = 0; s < 2; ++s) {
        u32x4 pw; pw.x = pk2(p[8 * s + 0], p[8 * s + 1]); pw.y = pk2(p[8 * s + 2], p[8 * s + 3]); pw.z = pk2(p[8 * s + 4], p[8 * s + 5]); pw.w = pk2(p[8 * s + 6], p[8 * s + 7]);
        const bf16x8 Pf = __builtin_bit_cast(bf16x8, pw);
#pragma unroll
        for (int db = 0; db < 4; ++db) {
            LAS const unsigned char* ap = vt + (db * 32 + q) * AT_VROW + (kb * 32 + 16 * s + 4 * hh) * 2;
            const u32x2 lo = *(const LAS u32x2*)(ap), hi = *(const LAS u32x2*)(ap + 16);
            const bf16x8 A2 = __builtin_bit_cast(bf16x8, (u32x4){lo.x, lo.y, hi.x, hi.y});
            O[db] = __builtin_amdgcn_mfma_f32_32x32x16_bf16(A2, Pf, O[db], 0, 0, 0);
        }
        asm volatile("" ::: "memory");
    }
}
template <bool LAT>
DI void attn_compute1(LAS const unsigned char* kt, LAS const unsigned char* vt, const bf16x8 (&Qf)[8], f32x16 (&O)[4], float& ls, float c1, float c0, int lane, const LAS float* brow, int cq) {
    const int q = lane & 31, hh = lane >> 5;
    const int cs = min(max(cq - 8, 0), 48);
#pragma unroll 1
    for (int kb = 0; kb < 2; ++kb) {
        const f32x16 S = qk_tile<8>(kt, Qf, kb, 0, q, hh);
        float p[16];
#pragma unroll
        for (int i = 0; i < 16; ++i) {
            float arg = S[i] * c1 + c0;
            if (LAT) { const int ck = kb * 32 + (i & 3) + 8 * (i >> 2) + 4 * hh;
                arg += brow[min(max(ck - cq + 15, 0), 30)];
                p[i] = ((unsigned)(ck - cs) < 16u) ? __builtin_amdgcn_exp2f(arg) : 0.f; }
            else p[i] = __builtin_amdgcn_exp2f(arg);
            ls += p[i];
        }
        pv_tile(vt, p, O, kb, q, hh);
    }
}
DI void diff_pass1(LAS const unsigned char* kt, const bf16x8 (&Qf)[8], float (&ls)[2], float c1, float c0, int lane) {
    const int q = lane & 31, hh = lane >> 5;
#pragma unroll 1
    for (int kb = 0; kb < 2; ++kb) {
#pragma unroll
        for (int mp = 0; mp < 2; ++mp) { const f32x16 S = qk_tile<4>(kt, Qf, kb, mp * 4, q, hh);
#pragma unroll
            for (int i = 0; i < 16; ++i) ls[mp] += __builtin_amdgcn_exp2f(S[i] * c1 + c0); }
    }
}
DI void diff_pass2(LAS const unsigned char* kt, LAS const unsigned char* vt, const bf16x8 (&Qf)[8], f32x16 (&O)[4], float w0, float w1, float c1, float c0, int lane) {
    const int q = lane & 31, hh = lane >> 5;
#pragma unroll 1
    for (int kb = 0; kb < 2; ++kb) {
        float p[16];
        { const f32x16 S0 = qk_tile<4>(kt, Qf, kb, 0, q, hh);
#pragma unroll
          for (int i = 0; i < 16; ++i) p[i] = __builtin_amdgcn_exp2f(S0[i] * c1 + c0) * w0; }
        { const f32x16 S1 = qk_tile<4>(kt, Qf, kb, 4, q, hh);
#pragma unroll
          for (int i = 0; i < 16; ++i) p[i] -= __builtin_amdgcn_exp2f(S1[i] * c1 + c0) * w1; }
        pv_tile(vt, p, O, kb, q, hh);
    }
}

template <int MODE>
DI void attn_phase(const Ctx& F, const Params& P) {
    constexpr bool DIFF = (MODE >= 2);
    constexpr bool NA = (MODE == 1);
    LAS unsigned char* lds = F.lds;
    LAS float* rpbl = (LAS float*)(lds + AT_RPB);
    const bf16_t* PA = (const bf16_t*)(P.ws + WS_RA);
    bf16_t* MIX = (bf16_t*)(P.ws + WS_HM);
    const bf16_t* VTp = (const bf16_t*)(P.ws + WS_VT); const bf16_t* VTs = (const bf16_t*)(P.ws + WS_VT + VT_S);
    const int q = F.lane & 31, hh = F.lane >> 5;
    const float c1 = (DIFF ? 0.125f : 0.08838834764831845f) * LOG2E, c0 = -AT_OFF * LOG2E;
    float lam = 0.f;
    if (DIFF) {
        const float a = wave_sum(P.in[I_LQ1][F.lane] * P.in[I_LK1][F.lane]), b = wave_sum(P.in[I_LQ2][F.lane] * P.in[I_LK2][F.lane]);
        lam = __expf(a) - __expf(b) + 0.35550906759096924f;
    }
    const int nunits = (MODE == 0 || MODE == 2) ? 256 : 1024;
    for (int u = F.bid; u < nunits; u += F.G) {
        int b, h, tok0, r = 0, rlo = 0; TileMap M;
        const bf16_t* qptr;
        if (MODE == 0) { b = u >> 3; h = u & 7; tok0 = b * 256 + F.wave * 32;
            qptr = PA + (size_t)(tok0 + q) * 2048 + h * 128;
            M.latK = PA + (size_t)(b * 256) * 2048 + 1024 + h * 128; M.latKld = 2048; M.latV = VTp + (size_t)(b * 8 + h) * 128 * 256; M.latVld = 256; M.nlat = 4; M.ctxK = nullptr; M.ctxV = nullptr; M.ntiles = 4; }
        else if (MODE == 1) { b = u >> 7; h = (u >> 4) & 7; const int rg = u & 15; r = 4 * rg + (F.wave >> 1);
            rlo = min(max(4 * rg - 4, 0), 56); const int rhi = min(max(4 * rg + 3 - 4, 0), 56) + 8;
            tok0 = TP + b * 4096 + r * 64 + (F.wave & 1) * 32;
            qptr = PA + (size_t)(tok0 + q) * 2048 + h * 128;
            M.latK = PA + (size_t)(TP + b * 4096 + rlo * 64) * 2048 + 1024 + h * 128; M.latKld = 2048; M.latV = VTs + (size_t)(b * 8 + h) * 128 * 4096 + rlo * 64; M.latVld = 4096; M.nlat = rhi - rlo;
            M.ctxK = (const bf16_t*)(P.ws + WS_CNK) + (size_t)b * 256 * 1024 + h * 128; M.ctxV = (const bf16_t*)(P.ws + WS_CNVT) + (size_t)(b * 8 + h) * 128 * 256; M.ntiles = M.nlat + 4;
            if (F.tid < 465) rpbl[F.tid] = P.in[I_RPB][h * 465 + F.tid] * LOG2E; }
        else if (MODE == 2) { b = u >> 3; h = u & 7; tok0 = b * 256 + F.wave * 32;
            qptr = PA + (size_t)(tok0 + q) * 4096 + 1024 + h * 128;
            M.latK = PA + (size_t)(b * 256) * 4096 + 2048 + h * 128; M.latKld = 4096; M.latV = VTp + (size_t)(b * 8 + h) * 128 * 256; M.latVld = 256; M.nlat = 4; M.ctxK = nullptr; M.ctxV = nullptr; M.ntiles = 4; }
        else { b = u >> 7; h = (u >> 4) & 7; const int qb = u & 15; tok0 = TP + b * 4096 + qb * 256 + F.wave * 32;
            qptr = PA + (size_t)(tok0 + q) * 4096 + 1024 + h * 128;
            M.latK = PA + (size_t)(TP + b * 4096) * 4096 + 2048 + h * 128; M.latKld = 4096; M.latV = VTs + (size_t)(b * 8 + h) * 128 * 4096; M.latVld = 4096; M.nlat = 64;
            M.ctxK = (const bf16_t*)(P.ws + WS_CDK) + (size_t)b * 256 * 1024 + h * 128; M.ctxV = (const bf16_t*)(P.ws + WS_CDVT) + (size_t)(b * 8 + h) * 128 * 256; M.ntiles = 68; }
        bf16x8 Qf[8];
#pragma unroll
        for (int ks = 0; ks < 8; ++ks) Qf[ks] = *(const bf16x8*)(qptr + ks * 16 + hh * 8);
        f32x16 O[4]; float ls[2] = {0.f, 0.f}; float w0 = 0.f, w1 = 0.f;
#pragma unroll
        for (int db = 0; db < 4; ++db)
#pragma unroll
            for (int i = 0; i < 16; ++i) O[db][i] = 0.f;
        const int cq = (F.wave & 1) * 32 + q;
        const int r0w = min(max(r - 4, 0), 56);
        const int nt = M.ntiles;
        TileRegs R;
        { const bf16_t* kp; const bf16_t* vp; int kld, vld; tile_src(M, 0, kp, kld, vp, vld); tile_load(F, R, kp, kld, vp, vld); }
        tile_store(F, R, lds + AT_K0, lds + AT_V0);
        __syncthreads();
        if constexpr (DIFF) {
#pragma unroll 1
            for (int j = 0; j < nt; ++j) {
                const int cur = j & 1, jn = (j + 1 < nt) ? j + 1 : 0;
                { const bf16_t* kp; const bf16_t* vp; int kld, vld; tile_src(M, jn, kp, kld, vp, vld); tile_load(F, R, kp, kld, vp, vld); }
                diff_pass1(lds + AT_K0 + cur * AT_KTB, Qf, ls, c1, c0, F.lane);
                tile_store(F, R, lds + AT_K0 + (cur ^ 1) * AT_KTB, lds + AT_V0 + (cur ^ 1) * AT_VTB);
                __syncthreads();
            }
            { const float l0 = ls[0] + __shfl_xor(ls[0], 32), l1 = ls[1] + __shfl_xor(ls[1], 32); w0 = 1.f / l0; w1 = lam / l1; }
#pragma unroll 1
            for (int j = 0; j < nt; ++j) {
                const int cur = (nt + j) & 1;
                if (j + 1 < nt) { const bf16_t* kp; const bf16_t* vp; int kld, vld; tile_src(M, j + 1, kp, kld, vp, vld); tile_load(F, R, kp, kld, vp, vld); }
                diff_pass2(lds + AT_K0 + cur * AT_KTB, lds + AT_V0 + cur * AT_VTB, Qf, O, w0, w1, c1, c0, F.lane);
                if (j + 1 < nt) tile_store(F, R, lds + AT_K0 + (cur ^ 1) * AT_KTB, lds + AT_V0 + (cur ^ 1) * AT_VTB);
                __syncthreads();
            }
        } else {
#pragma unroll 1
            for (int j = 0; j < nt; ++j) {
                const int cur = j & 1;
                if (j + 1 < nt) { const bf16_t* kp; const bf16_t* vp; int kld, vld; tile_src(M, j + 1, kp, kld, vp, vld); tile_load(F, R, kp, kld, vp, vld); }
                LAS const unsigned char* kt = lds + AT_K0 + cur * AT_KTB; LAS const unsigned char* vt = lds + AT_V0 + cur * AT_VTB;
                if constexpr (NA) {
                    if (j < M.nlat) { const int kr = rlo + j;
                        if (kr >= r0w && kr < r0w + 8) attn_compute1<true>(kt, vt, Qf, O, ls[0], c1, c0, F.lane, rpbl + (kr - r + 7) * 31, cq); }
                    else attn_compute1<false>(kt, vt, Qf, O, ls[0], c1, c0, F.lane, rpbl, cq);
                } else attn_compute1<false>(kt, vt, Qf, O, ls[0], c1, c0, F.lane, rpbl, cq);
                if (j + 1 < nt) tile_store(F, R, lds + AT_K0 + (cur ^ 1) * AT_KTB, lds + AT_V0 + (cur ^ 1) * AT_VTB);
                __syncthreads();
            }
        }
        if constexpr (!DIFF) {
            const float inv = 1.f / (ls[0] + __shfl_xor(ls[0], 32));
            bf16_t* op = MIX + (size_t)(tok0 + q) * DM + h * 128 + 4 * hh;
#pragma unroll
            for (int db = 0; db < 4; ++db)
#pragma unroll
                for (int g = 0; g < 4; ++g) { u32x2 w; w.x = pk2(O[db][4 * g] * inv, O[db][4 * g + 1] * inv); w.y = pk2(O[db][4 * g + 2] * inv, O[db][4 * g + 3] * inv);
                    *(u32x2*)(op + db * 32 + 8 * g) = w; }
        } else {
            float ss = 0.f;
#pragma unroll
            for (int db = 0; db < 4; ++db)
#pragma unroll
                for (int i = 0; i < 16; ++i) ss += O[db][i] * O[db][i];
            ss += __shfl_xor(ss, 32);
            const float sc = rsqrtf(ss * (1.f / 128.f) + NORM_EPS) * (1.f - 0.35550906759096924f);
            const float* sg = P.in[I_SUBG];
            bf16_t* op = MIX + (size_t)(tok0 + q) * DM + 1024 + h * 128 + 4 * hh;
#pragma unroll
            for (int db = 0; db < 4; ++db)
#pragma unroll
                for (int g = 0; g < 4; ++g) { const f32x4 g4 = *(const f32x4*)(sg + db * 32 + 8 * g + 4 * hh);
                    u32x2 w; w.x = pk2(O[db][4 * g] * sc * g4.x, O[db][4 * g + 1] * sc * g4.y); w.y = pk2(O[db][4 * g + 2] * sc * g4.z, O[db][4 * g + 3] * sc * g4.w);
                    *(u32x2*)(op + db * 32 + 8 * g) = w; }
        }
    }
}
template <int L, int BATCH> struct HyCfg {
    static constexpr int NB = L / 64, TPT = 32 / BATCH, NTILES = NB / TPT, LOGB = (BATCH == 8) ? 3 : 5;
    static constexpr int ZROWB = (L + 384) * 2 + 16, ZBYTES = BATCH * ZROWB, RL = 2 * L + 16;
    static constexpr int TPW = (NTILES + 7) / 8;
};
constexpr int HY_KR_OFF = 71808;

template <int L, int BATCH>
DI void hyena_part(const Ctx& F, const Params& P, int c, int tokbase  , const bf16_t* KRG  ) {
    typedef HyCfg<L, BATCH> C;
    LAS unsigned char* lds = F.lds;
    bf16_t* CM = (bf16_t*)(P.ws + WS_RB);
    const float* hbias = P.in[I_HYBIAS];
    const int q = F.lane & 31, hh = F.lane >> 5;
    __syncthreads();
    for (int id = F.tid; id < BATCH * (L / 8); id += NTHR) { const int b = id / (L / 8), s8 = (id % (L / 8)) * 8;
        *(LAS u32x4*)(lds + b * C::ZROWB + (192 + s8) * 2) = *(const u32x4*)(CM + (size_t)c * TOK + tokbase + b * L + s8); }
    for (int id = F.tid; id < BATCH * 48; id += NTHR) { const int b = id / 48, k = id % 48, e = (k < 24) ? k * 8 : (192 + L + (k - 24) * 8);
        *(LAS u32x4*)(lds + b * C::ZROWB + e * 2) = (u32x4){0u, 0u, 0u, 0u}; }
#pragma unroll 1
    for (int o = 0; o < 2; ++o) {
        { const bf16_t* src = KRG + ((size_t)(o * 1024 + c) * 2) * C::RL;
          for (int id = F.tid; id < 2 * C::RL / 8; id += NTHR) *(LAS u32x4*)(lds + HY_KR_OFF + id * 16) = *(const u32x4*)(src + id * 8); }
        __syncthreads();
        f32x16 acc[C::TPW][2];
#pragma unroll
        for (int t = 0; t < C::TPW; ++t)
#pragma unroll
            for (int mt = 0; mt < 2; ++mt)
#pragma unroll
                for (int i = 0; i < 16; ++i) acc[t][mt][i] = 0.f;
        const int tq0 = F.wave * C::TPW;
        if (tq0 < C::NTILES) {
            const int d1lo = C::TPT * tq0 - (C::NB - 1), d1hi = C::TPT * (tq0 + C::TPW - 1) + C::TPT - 1;
            const int abase = HY_KR_OFF + (F.lane & 1) * (C::RL * 2) + (L - (F.lane & 31) + 8 * hh - (F.lane & 1)) * 2;
            for (int d1 = d1lo; d1 <= d1hi; ++d1) {
                bf16x8 A[2][4];
#pragma unroll
                for (int mt = 0; mt < 2; ++mt)
#pragma unroll
                    for (int ks = 0; ks < 4; ++ks) { LAS const unsigned* ap = (LAS const unsigned*)(lds + abase + (16 * ks - 64 * d1 - 32 * mt) * 2);
                        A[mt][ks] = __builtin_bit_cast(bf16x8, (u32x4){ap[0], ap[1], ap[2], ap[3]}); }
#pragma unroll
                for (int t = 0; t < C::TPW; ++t) { const int tq = tq0 + t;
                    if (d1 >= C::TPT * tq - (C::NB - 1) && d1 <= C::TPT * tq + C::TPT - 1) {
                        const int t1 = C::TPT * tq + (q >> C::LOGB), b = q & (BATCH - 1), s1 = t1 - d1;
                        LAS const unsigned char* bp = lds + b * C::ZROWB + (192 + 64 * s1 + 8 * hh) * 2;
#pragma unroll
                        for (int ks = 0; ks < 4; ++ks) { const bf16x8 B = *(const LAS bf16x8*)(bp + ks * 32);
#pragma unroll
                            for (int mt = 0; mt < 2; ++mt) acc[t][mt] = __builtin_amdgcn_mfma_f32_32x32x16_bf16(A[mt][ks], B, acc[t][mt], 0, 0, 0); }
                    } }
            }
        }
        __syncthreads();
        if (tq0 < C::NTILES) {
            const float bo = hbias[o * 1024 + c];
            const bf16_t* gate = CM + (size_t)((1 + o) * 1024 + c) * TOK + tokbase;
            bf16_t* zout = CM + (size_t)c * TOK + tokbase;
#pragma unroll
            for (int t = 0; t < C::TPW; ++t) { const int tq = tq0 + t, t1 = C::TPT * tq + (q >> C::LOGB), b = q & (BATCH - 1);
#pragma unroll
                for (int mt = 0; mt < 2; ++mt)
#pragma unroll
                    for (int g = 0; g < 4; ++g) { const int s = 64 * t1 + 32 * mt + 8 * g + 4 * hh;
                        LAS u32x2* zp = (LAS u32x2*)(lds + b * C::ZROWB + (192 + s) * 2);
                        const u32x2 zv = *zp, gv = *(const u32x2*)(gate + (size_t)b * L + s);
                        const float r0 = bflo(gv.x) * (acc[t][mt][4 * g] + bflo(zv.x) * bo), r1 = bfhi(gv.x) * (acc[t][mt][4 * g + 1] + bfhi(zv.x) * bo);
                        const float r2 = bflo(gv.y) * (acc[t][mt][4 * g + 2] + bflo(zv.y) * bo), r3 = bfhi(gv.y) * (acc[t][mt][4 * g + 3] + bfhi(zv.y) * bo);
                        const u32x2 w = (u32x2){pk2(r0, r1), pk2(r2, r3)};
                        if (o == 0) *zp = w; else *(u32x2*)(zout + (size_t)b * L + s) = w; } }
        }
        __syncthreads();
    }
}

DI void hyena_phase(const Ctx& F, const Params& P) {
    for (int c = F.bid; c < 1024; c += F.G) {
        hyena_part<LS, 8>(F, P, c, TP, (const bf16_t*)(P.ws + WS_KRS));
        hyena_part<LP, 32>(F, P, c, 0, (const bf16_t*)(P.ws + WS_KRP));
    }
}

DI void hyena_post(const Ctx& F, const Params& P) {
    const bf16_t* CM = (const bf16_t*)(P.ws + WS_RB); bf16_t* MIX = (bf16_t*)(P.ws + WS_HM);
    for (int t = F.bid; t < 16 * 640; t += F.G) { const int cg = t & 15, tg = t >> 4;
        tr_tile_bf16(F, CM + (size_t)(cg * 64) * TOK + tg * 64, TOK, MIX + (size_t)(tg * 64) * DM + 1024 + cg * 64, DM, (LAS bf16_t*)F.lds); }
}
DI void prep_c(const Ctx& F, const Params& P) {
    bf16_t* PA = (bf16_t*)(P.ws + WS_RA);
    LAS float* rope = (LAS float*)(F.lds + 16384);
    __syncthreads();
    for (int e = F.tid; e < 1024; e += NTHR) { const int pos = e >> 4, f = e & 15; const float inv = exp2f(-(float)f * (13.287712379549449f / 16.f)); const float a = (float)pos * inv;
        rope[e * 2] = cosf(a); rope[e * 2 + 1] = sinf(a); }
    __syncthreads();
    { const float* gsrc = (F.lane < 32 ? P.in[I_DQG] : P.in[I_DKG]) + (F.lane & 1) * 32; float* ok = P.out + O_DK;
      float g[32];
#pragma unroll
      for (int i = 0; i < 32; ++i) g[i] = gsrc[i];
      for (int T = F.bid * 8 + F.wave; T < TOK; T += F.G * 8) {
          bf16_t* rp = PA + (size_t)T * 4096 + 1024 + F.lane * 32;
          u32x4 v[4]; float x[32]; float ss = 0.f;
#pragma unroll
          for (int j = 0; j < 4; ++j) { v[j] = *(const u32x4*)(rp + j * 8);
              x[j * 8 + 0] = bflo(v[j].x); x[j * 8 + 1] = bfhi(v[j].x); x[j * 8 + 2] = bflo(v[j].y); x[j * 8 + 3] = bfhi(v[j].y);
              x[j * 8 + 4] = bflo(v[j].z); x[j * 8 + 5] = bfhi(v[j].z); x[j * 8 + 6] = bflo(v[j].w); x[j * 8 + 7] = bfhi(v[j].w); }
#pragma unroll
          for (int i = 0; i < 32; ++i) ss += x[i] * x[i];
          ss += dpp_xor1(ss);
          const float rstd = rsqrtf(ss * (1.f / 64.f) + NORM_EPS);
#pragma unroll
          for (int i = 0; i < 32; ++i) x[i] = x[i] * rstd * g[i];
          if (T < TP) { if (F.lane >= 32) { float* o = ok + (size_t)T * 1024 + (F.lane - 32) * 32;
#pragma unroll
                  for (int j = 0; j < 8; ++j) *(f32x4*)(o + j * 4) = (f32x4){x[j * 4], x[j * 4 + 1], x[j * 4 + 2], x[j * 4 + 3]}; } }
          else { const int t = (T - TP) & 4095, pos = (F.lane & 1) ? (t & 63) : (t >> 6);
              const LAS float* rt = rope + pos * 32;
#pragma unroll
              for (int f = 0; f < 16; ++f) { const float cs = rt[2 * f], sn = rt[2 * f + 1], a = x[f], b = x[16 + f]; x[f] = a * cs - b * sn; x[16 + f] = b * cs + a * sn; } }
#pragma unroll
          for (int j = 0; j < 4; ++j) { u32x4 w; w.x = pk2(x[j * 8 + 0], x[j * 8 + 1]); w.y = pk2(x[j * 8 + 2], x[j * 8 + 3]); w.z = pk2(x[j * 8 + 4], x[j * 8 + 5]); w.w = pk2(x[j * 8 + 6], x[j * 8 + 7]);
              *(u32x4*)(rp + j * 8) = w; }
      } }
    __syncthreads();
    bf16_t* VTp = (bf16_t*)(P.ws + WS_VT); bf16_t* VTs = (bf16_t*)(P.ws + WS_VT + VT_S);
    for (int t = F.bid; t < 2048 + 8192; t += F.G) {
        if (t < 2048) { const int bh = t >> 3, sub = t & 7, tk = sub >> 1, dd = sub & 1, b = bh >> 3, h = bh & 7;
            tr_tile_bf16(F, PA + ((size_t)(b * 256 + tk * 64)) * 4096 + 3072 + h * 128 + dd * 64, 4096, VTp + ((size_t)bh * 128 + dd * 64) * 256 + tk * 64, 256, (LAS bf16_t*)F.lds); }
        else { const int u = t - 2048, bh = u >> 7, sub = u & 127, tk = sub >> 1, dd = sub & 1, b = bh >> 3, h = bh & 7;
            tr_tile_bf16(F, PA + ((size_t)(TP + b * 4096 + tk * 64)) * 4096 + 3072 + h * 128 + dd * 64, 4096, VTs + ((size_t)bh * 128 + dd * 64) * 4096 + tk * 64, 4096, (LAS bf16_t*)F.lds); }
    }
    { float* o = P.out + O_DV;
      for (int e = F.bid * NTHR + F.tid; e < TP * 128; e += F.G * NTHR) { const int T = e >> 7, c8 = (e & 127) * 8;
          const u32x4 v = *(const u32x4*)(PA + (size_t)T * 4096 + 3072 + c8);
          *(f32x4*)(o + (size_t)T * 1024 + c8) = (f32x4){bflo(v.x), bfhi(v.x), bflo(v.y), bfhi(v.y)};
          *(f32x4*)(o + (size_t)T * 1024 + c8 + 4) = (f32x4){bflo(v.z), bfhi(v.z), bflo(v.w), bfhi(v.w)}; } }
}

constexpr int S5_BUROW = 132 * 4, S5_HROW = 272, S5_WLDS = 16 * S5_BUROW + 16 * S5_HROW;
DI void s5_chain(const Ctx& F, const Params& P, int dg, int tok0, int L, const float* h0re, const float* h0im, float* fre, float* fim, bf16_t* Yout) {
    LAS unsigned char* wl = F.lds + F.wave * S5_WLDS; LAS unsigned char* hl = wl + 16 * S5_BUROW;
    const int g = dg & 63, dir = dg >> 6, lane = F.lane, st = lane & 15, gq = lane >> 4;
    const float* S5A = (const float*)(P.ws + WS_S5A); const bf16_t* BB = (const bf16_t*)(P.ws + WS_S5BB); const bf16_t* CC = (const bf16_t*)(P.ws + WS_S5CC);
    const bf16_t* PA = (const bf16_t*)(P.ws + WS_RA);
    const float ar = S5A[(dg * 64 + lane) * 2], ai = S5A[(dg * 64 + lane) * 2 + 1];
    float hr = h0re ? h0re[lane] : 0.f, hi = h0im ? h0im[lane] : 0.f;
    const bf16x8 zero8 = (bf16x8){0, 0, 0, 0, 0, 0, 0, 0};
    bf16x8 BBf[8], CCf[4];
#pragma unroll
    for (int mt = 0; mt < 8; ++mt) BBf[mt] = (gq < 2) ? *(const bf16x8*)(BB + ((size_t)dg * 128 + mt * 16 + st) * 16 + gq * 8) : zero8;
#pragma unroll
    for (int kk = 0; kk < 4; ++kk) CCf[kk] = *(const bf16x8*)(CC + ((size_t)dg * 16 + st) * 128 + kk * 32 + gq * 8);
    const int nch = L / 16;
    const int sgn = dir ? -1 : 1, tstart = dir ? tok0 + L - 1 : tok0;
    bf16x8 Uf = (gq < 2) ? *(const bf16x8*)(PA + (size_t)(tstart + sgn * st) * 4096 + g * 16 + gq * 8) : zero8;
    for (int ch = 0; ch < nch; ++ch) {
        bf16x8 Un = zero8;
        if (ch + 1 < nch && gq < 2) Un = *(const bf16x8*)(PA + (size_t)(tstart + sgn * ((ch + 1) * 16 + st)) * 4096 + g * 16 + gq * 8);
#pragma unroll
        for (int mt = 0; mt < 8; ++mt) { f32x4 d = (f32x4){0.f, 0.f, 0.f, 0.f};
            d = __builtin_amdgcn_mfma_f32_16x16x32_bf16(BBf[mt], Uf, d, 0, 0, 0);
            *(LAS f32x4*)(wl + st * S5_BUROW + (mt * 16 + gq * 4) * 4) = d; }
        asm volatile("" ::: "memory");
#pragma unroll
        for (int s = 0; s < 16; ++s) {
            const float bur = *(const LAS float*)(wl + s * S5_BUROW + lane * 4), bui = *(const LAS float*)(wl + s * S5_BUROW + (64 + lane) * 4);
            const float nr = ar * hr - ai * hi + bur, ni = ar * hi + ai * hr + bui; hr = nr; hi = ni;
            *(LAS bf16_t*)(hl + s * S5_HROW + lane * 2) = f2bf(hr); *(LAS bf16_t*)(hl + s * S5_HROW + (64 + lane) * 2) = f2bf(hi);
        }
        asm volatile("" ::: "memory");
        f32x4 y = (f32x4){0.f, 0.f, 0.f, 0.f};
#pragma unroll
        for (int kk = 0; kk < 4; ++kk) { const bf16x8 Bh = *(const LAS bf16x8*)(hl + st * S5_HROW + (kk * 32 + gq * 8) * 2);
            y = __builtin_amdgcn_mfma_f32_16x16x32_bf16(CCf[kk], Bh, y, 0, 0, 0); }
        { const int tok = tstart + sgn * (ch * 16 + st);
          *(u32x2*)(Yout + (size_t)tok * 1024 + g * 16 + gq * 4) = (u32x2){pk2(y[0], y[1]), pk2(y[2], y[3])}; }
        asm volatile("" ::: "memory");
        Uf = Un;
    }
    if (fre) { fre[lane] = hr; fim[lane] = hi; }
}

DI void s5_phase(const Ctx& F, const Params& P) {
    bf16_t* YF = (bf16_t*)(P.ws + WS_RB + RB_YF); bf16_t* YB = (bf16_t*)(P.ws + WS_RB + RB_YB);
    for (int cs = F.bid; cs < 256; cs += F.G) {
        if (F.wave < 4) { const int sc = cs * 4 + F.wave, dg = sc & 127, b = sc >> 7;
            s5_chain(F, P, dg, TP + b * 4096, LS, P.in[I_S5RE] + (size_t)sc * 64, P.in[I_S5IM] + (size_t)sc * 64, nullptr, nullptr, (dg >> 6) ? YB : YF); }
        else { for (int k = 0; k < 4; ++k) { const int pc = (cs * 4 + (F.wave - 4)) * 4 + k, dg = pc & 127, b = pc >> 7;
            s5_chain(F, P, dg, b * 256, LP, nullptr, nullptr, P.out + O_SR + (size_t)pc * 64, P.out + O_SI + (size_t)pc * 64, (dg >> 6) ? YB : YF); } }
    }
}

DI void s5_combine(const Ctx& F, const Params& P) {
    const bf16_t* PA = (const bf16_t*)(P.ws + WS_RA); const bf16_t* YF = (const bf16_t*)(P.ws + WS_RB + RB_YF); const bf16_t* YB = (const bf16_t*)(P.ws + WS_RB + RB_YB);
    bf16_t* Y = (bf16_t*)(P.ws + WS_RB + RB_Y); const float* dsk = P.in[I_S5D];
    for (size_t e = (size_t)F.bid * NTHR + F.tid; e < (size_t)TOK * 128; e += (size_t)F.G * NTHR) { const size_t T = e >> 7; const int c8 = (int)(e & 127) * 8;
        const u32x4 uv = *(const u32x4*)(PA + T * 4096 + c8), fv = *(const u32x4*)(YF + T * 1024 + c8), bv = *(const u32x4*)(YB + T * 1024 + c8);
        const f32x4 d0 = *(const f32x4*)(dsk + c8), d1 = *(const f32x4*)(dsk + c8 + 4);
        float o[8];
        o[0] = gelu_tanh(d0.x * bflo(uv.x) + bflo(fv.x) + bflo(bv.x)); o[1] = gelu_tanh(d0.y * bfhi(uv.x) + bfhi(fv.x) + bfhi(bv.x));
        o[2] = gelu_tanh(d0.z * bflo(uv.y) + bflo(fv.y) + bflo(bv.y)); o[3] = gelu_tanh(d0.w * bfhi(uv.y) + bfhi(fv.y) + bfhi(bv.y));
        o[4] = gelu_tanh(d1.x * bflo(uv.z) + bflo(fv.z) + bflo(bv.z)); o[5] = gelu_tanh(d1.y * bfhi(uv.z) + bfhi(fv.z) + bfhi(bv.z));
        o[6] = gelu_tanh(d1.z * bflo(uv.w) + bflo(fv.w) + bflo(bv.w)); o[7] = gelu_tanh(d1.w * bfhi(uv.w) + bfhi(fv.w) + bfhi(bv.w));
        u32x4 w; w.x = pk2(o[0], o[1]); w.y = pk2(o[2], o[3]); w.z = pk2(o[4], o[5]); w.w = pk2(o[6], o[7]);
        *(u32x4*)(Y + T * 1024 + c8) = w; }
}
constexpr int PS_KROW = 272;
constexpr int PS_IDX_OFF = 2 * 128 * PS_KROW;
constexpr int PS_TAB_OFF = PS_IDX_OFF + 512 * 32;

DI void topk_insert(float (&a)[16], float x) {
#pragma unroll
    for (int j = 15; j >= 1; --j) a[j] = __builtin_amdgcn_fmed3f(a[j - 1], a[j], x);
    a[0] = fmaxf(a[0], x);
}

DI void peer_select(const Ctx& F, const Params& P, int layer) {
    LAS unsigned char* lds = F.lds;
    const bf16_t* Q = (const bf16_t*)(P.ws + WS_RA + RA_Q);
    int* SELI = (int*)(P.ws + WS_RA + RA_SELI); float* SELW = (float*)(P.ws + WS_RA + RA_SELW);
    const bf16_t* KEYS = (const bf16_t*)(P.ws + WS_PKEYS) + (size_t)layer * 8 * 2 * 128 * 128;
    const int q = F.lane & 31, hh = F.lane >> 5;
    LAS unsigned char* myidx = lds + PS_IDX_OFF + F.tid * 32;
    LAS unsigned char* tab = lds + PS_TAB_OFF;
    for (int wu = F.bid; wu < 256; wu += F.G) {
        const int h = wu & 7, chunk = wu >> 3;
        __syncthreads();
        for (int id = F.tid; id < 2 * 128 * 16; id += NTHR) { const int row = id >> 4, c16 = id & 15;
            *(LAS u32x4*)(lds + row * PS_KROW + c16 * 16) = *(const u32x4*)(KEYS + ((size_t)h * 256 + row) * 128 + c16 * 8); }
        if (F.tid < 16) { int cnt = 0;
            for (int a = 0; a < F.tid; ++a) cnt += 16 / (a + 1);
            for (int b = 0; b < 16 / (F.tid + 1); ++b) { tab[(cnt + b) * 2] = (unsigned char)F.tid; tab[(cnt + b) * 2 + 1] = (unsigned char)b; } }
        __syncthreads();
        for (int blk = F.wave; blk < 40; blk += 8) {
            const int T0 = chunk * 1280 + blk * 32;
            float lst[2][16];
#pragma unroll
            for (int side = 0; side < 2; ++side) {
                bf16x8 Qf[8];
                const bf16_t* qp = Q + (size_t)(T0 + q) * 2048 + h * 256 + side * 128 + hh * 8;
#pragma unroll
                for (int ks = 0; ks < 8; ++ks) Qf[ks] = *(const bf16x8*)(qp + ks * 16);
                float a[16];
#pragma unroll
                for (int j = 0; j < 16; ++j) a[j] = -3.0e38f;
#pragma unroll
                for (int nt = 0; nt < 4; ++nt) {
                    f32x16 S;
#pragma unroll
                    for (int i = 0; i < 16; ++i) S[i] = 0.f;
#pragma unroll
                    for (int ks = 0; ks < 8; ++ks) { const bf16x8 A = *(const LAS bf16x8*)(lds + (side * 128 + nt * 32 + q) * PS_KROW + (ks * 16 + hh * 8) * 2);
                        S = __builtin_amdgcn_mfma_f32_32x32x16_bf16(A, Qf[ks], S, 0, 0, 0); }
#pragma unroll
                    for (int i = 0; i < 16; ++i) { const int n = nt * 32 + (i & 3) + 8 * (i >> 2) + 4 * hh;
                        topk_insert(a, __uint_as_float((__float_as_uint(S[i]) & 0xffffff80u) | (unsigned)n)); }
                }
                float pb[16];
#pragma unroll
                for (int j = 0; j < 16; ++j) pb[j] = __shfl_xor(a[j], 32);
#pragma unroll
                for (int j = 0; j < 16; ++j) topk_insert(a, pb[j]);
#pragma unroll
                for (int j = 0; j < 16; ++j) { lst[side][j] = a[j]; myidx[side * 16 + j] = (unsigned char)(__float_as_uint(a[j]) & 0x7fu); }
            }
            float cb[16];
#pragma unroll
            for (int j = 0; j < 16; ++j) cb[j] = -3.0e38f;
            { int cid = 0;
#pragma unroll
              for (int a = 0; a < 16; ++a)
#pragma unroll
                  for (int b = 0; b < 16 / (a + 1); ++b) {
                      const float sa = __uint_as_float(__float_as_uint(lst[0][a]) & 0xffffff80u), sb = __uint_as_float(__float_as_uint(lst[1][b]) & 0xffffff80u);
                      topk_insert(cb, __uint_as_float((__float_as_uint(sa + sb) & 0xffffffc0u) | (unsigned)cid)); ++cid; } }
            const float mx = __uint_as_float(__float_as_uint(cb[0]) & 0xffffffc0u);
            float e[16], den = 0.f;
#pragma unroll
            for (int j = 0; j < 16; ++j) { e[j] = __expf(__uint_as_float(__float_as_uint(cb[j]) & 0xffffffc0u) - mx); den += e[j]; }
            const float rden = 1.f / den;
#pragma unroll
            for (int j = 0; j < 16; ++j) {
                if ((j >> 3) == hh) { const int cid = (int)(__float_as_uint(cb[j]) & 0x3fu);
                    const int a = tab[cid * 2], b = tab[cid * 2 + 1];
                    const int eidx = (int)myidx[a] * 128 + (int)myidx[16 + b];
                    SELI[(size_t)(T0 + q) * 128 + h * 16 + j] = eidx; SELW[(size_t)(T0 + q) * 128 + h * 16 + j] = e[j] * rden; }
            }
        }
    }
    __syncthreads();
}

DI void peer_gather(const Ctx& F, const Params& P, const float* modl) {
    const bf16_t* H2 = (const bf16_t*)(P.ws + WS_HM); const bf16_t* TU = (const bf16_t*)(P.ws + WS_TBLU); const bf16_t* TV = (const bf16_t*)(P.ws + WS_TBLV);
    const int* SELI = (const int*)(P.ws + WS_RA + RA_SELI); const float* SELW = (const float*)(P.ws + WS_RA + RA_SELW);
    float* X = P.out + O_Y;
    const int lane = F.lane;
    for (int T = F.bid * 8 + F.wave; T < TOK; T += F.G * 8) {
        u32x4 xh[4];
#pragma unroll
        for (int c = 0; c < 4; ++c) xh[c] = *(const u32x4*)(H2 + (size_t)T * DM + (c * 64 + lane) * 8);
        const int e0 = SELI[(size_t)T * 128 + lane], e1 = SELI[(size_t)T * 128 + 64 + lane];
        const float g0 = SELW[(size_t)T * 128 + lane], g1 = SELW[(size_t)T * 128 + 64 + lane];
        float cf0 = 0.f, cf1 = 0.f;
#pragma unroll 1
        for (int kb = 0; kb < 128; kb += 4) {
            u32x4 ur[4][4];
#pragma unroll
            for (int j = 0; j < 4; ++j) { const int k = kb + j; const int e = __builtin_amdgcn_readlane(k < 64 ? e0 : e1, k & 63);
                const bf16_t* up = TU + (size_t)e * DM + lane * 8;
#pragma unroll
                for (int c = 0; c < 4; ++c) ur[j][c] = *(const u32x4*)(up + c * 512); }
#pragma unroll
            for (int j = 0; j < 4; ++j) { float s = 0.f;
#pragma unroll
                for (int c = 0; c < 4; ++c) {
                    s = dot2bf(ur[j][c].x, xh[c].x, s);
                    s = dot2bf(ur[j][c].y, xh[c].y, s);
                    s = dot2bf(ur[j][c].z, xh[c].z, s);
                    s = dot2bf(ur[j][c].w, xh[c].w, s); }
                const float a = gelu_tanh(wave_sum(s)); const int k = kb + j;
                if (k < 64) { if (lane == k) cf0 = g0 * a; } else { if (lane == k - 64) cf1 = g1 * a; } }
        }
        float acc[32];
#pragma unroll
        for (int i = 0; i < 32; ++i) acc[i] = 0.f;
#pragma unroll 1
        for (int kb = 0; kb < 128; kb += 4) {
            u32x4 vr[4][4]; float cf[4];
#pragma unroll
            for (int j = 0; j < 4; ++j) { const int k = kb + j; const int e = __builtin_amdgcn_readlane(k < 64 ? e0 : e1, k & 63);
                cf[j] = __builtin_bit_cast(float, __builtin_amdgcn_readlane(__builtin_bit_cast(int, k < 64 ? cf0 : cf1), k & 63));
                const bf16_t* vp = TV + (size_t)e * DM + lane * 8;
#pragma unroll
                for (int c = 0; c < 4; ++c) vr[j][c] = *(const u32x4*)(vp + c * 512); }
#pragma unroll
            for (int j = 0; j < 4; ++j)
#pragma unroll
                for (int c = 0; c < 4; ++c) {
                    acc[c * 8 + 0] += cf[j] * bflo(vr[j][c].x); acc[c * 8 + 1] += cf[j] * bfhi(vr[j][c].x); acc[c * 8 + 2] += cf[j] * bflo(vr[j][c].y); acc[c * 8 + 3] += cf[j] * bfhi(vr[j][c].y);
                    acc[c * 8 + 4] += cf[j] * bflo(vr[j][c].z); acc[c * 8 + 5] += cf[j] * bfhi(vr[j][c].z); acc[c * 8 + 6] += cf[j] * bflo(vr[j][c].w); acc[c * 8 + 7] += cf[j] * bfhi(vr[j][c].w); }
        }
        const float* gate = modl + (size_t)(cond_of(T) * 6 + 5) * DM;
#pragma unroll
        for (int c = 0; c < 4; ++c) { const int col = (c * 64 + lane) * 8; float* xp = X + (size_t)T * DM + col;
            const f32x4 g0v = *(const f32x4*)(gate + col), g1v = *(const f32x4*)(gate + col + 4), x0 = *(const f32x4*)(xp), x1 = *(const f32x4*)(xp + 4);
            *(f32x4*)(xp) = x0 + g0v * (f32x4){acc[c * 8], acc[c * 8 + 1], acc[c * 8 + 2], acc[c * 8 + 3]};
            *(f32x4*)(xp + 4) = x1 + g1v * (f32x4){acc[c * 8 + 4], acc[c * 8 + 5], acc[c * 8 + 6], acc[c * 8 + 7]}; }
    }
}

DI void peer_gather_dbg(const Ctx& F, const Params& P, const float* modl) {
    const bf16_t* H2 = (const bf16_t*)(P.ws + WS_HM); const bf16_t* TU = (const bf16_t*)(P.ws + WS_TBLU); const bf16_t* TV = (const bf16_t*)(P.ws + WS_TBLV);
    const int* SELI = (const int*)(P.ws + WS_RA + RA_SELI); const float* SELW = (const float*)(P.ws + WS_RA + RA_SELW);
    float* X = P.out + O_Y;
    const int lane = F.lane;
    for (int T = F.bid * 8 + F.wave; T < TOK; T += F.G * 8) {
        u32x4 xh[4];
#pragma unroll
        for (int c = 0; c < 4; ++c) xh[c] = *(const u32x4*)(H2 + (size_t)T * DM + (c * 64 + lane) * 8);
        const int e0 = SELI[(size_t)T * 128 + lane], e1 = SELI[(size_t)T * 128 + 64 + lane];
        const float g0 = SELW[(size_t)T * 128 + lane], g1 = SELW[(size_t)T * 128 + 64 + lane];
        float cf0 = 0.f, cf1 = 0.f;
#pragma unroll 1
        for (int kb = 0; kb < 128; kb += 4) {
            u32x4 ur[4][4];
#pragma unroll
            for (int j = 0; j < 4; ++j) { const int k = kb + j; const int e = __builtin_amdgcn_readlane(k < 64 ? e0 : e1, k & 63);
                const bf16_t* up = TU + (size_t)e * DM + lane * 8;
#pragma unroll
                for (int c = 0; c < 4; ++c) ur[j][c] = *(const u32x4*)(up + c * 512); }
#pragma unroll
            for (int j = 0; j < 4; ++j) { float s = 0.f;
#pragma unroll
                for (int c = 0; c < 4; ++c) {
                    s += bflo(ur[j][c].x) * bflo(xh[c].x) + bfhi(ur[j][c].x) * bfhi(xh[c].x) + bflo(ur[j][c].y) * bflo(xh[c].y) + bfhi(ur[j][c].y) * bfhi(xh[c].y)
                       + bflo(ur[j][c].z) * bflo(xh[c].z) + bfhi(ur[j][c].z) * bfhi(xh[c].z) + bflo(ur[j][c].w) * bflo(xh[c].w) + bfhi(ur[j][c].w) * bfhi(xh[c].w); }
                for (int m = 32; m >= 1; m >>= 1) s += __shfl_xor(s, m);
                const float a = gelu_tanh(s); const int k = kb + j;
                if (k < 64) { if (lane == k) cf0 = g0 * a; } else { if (lane == k - 64) cf1 = g1 * a; } }
        }
        float acc[32];
#pragma unroll
        for (int i = 0; i < 32; ++i) acc[i] = 0.f;
#pragma unroll 1
        for (int kb = 0; kb < 128; kb += 4) {
            u32x4 vr[4][4]; float cf[4];
#pragma unroll
            for (int j = 0; j < 4; ++j) { const int k = kb + j; const int e = __builtin_amdgcn_readlane(k < 64 ? e0 : e1, k & 63);
                cf[j] = __builtin_bit_cast(float, __builtin_amdgcn_readlane(__builtin_bit_cast(int, k < 64 ? cf0 : cf1), k & 63));
                const bf16_t* vp = TV + (size_t)e * DM + lane * 8;
#pragma unroll
                for (int c = 0; c < 4; ++c) vr[j][c] = *(const u32x4*)(vp + c * 512); }
#pragma unroll
            for (int j = 0; j < 4; ++j)
#pragma unroll
                for (int c = 0; c < 4; ++c) {
                    acc[c * 8 + 0] += cf[j] * bflo(vr[j][c].x); acc[c * 8 + 1] += cf[j] * bfhi(vr[j][c].x); acc[c * 8 + 2] += cf[j] * bflo(vr[j][c].y); acc[c * 8 + 3] += cf[j] * bfhi(vr[j][c].y);
                    acc[c * 8 + 4] += cf[j] * bflo(vr[j][c].z); acc[c * 8 + 5] += cf[j] * bfhi(vr[j][c].z); acc[c * 8 + 6] += cf[j] * bflo(vr[j][c].w); acc[c * 8 + 7] += cf[j] * bfhi(vr[j][c].w); }
        }
        const float* gate = modl + (size_t)(cond_of(T) * 6 + 5) * DM;
#pragma unroll
        for (int c = 0; c < 4; ++c) { const int col = (c * 64 + lane) * 8; float* xp = X + (size_t)T * DM + col;
            const f32x4 g0v = *(const f32x4*)(gate + col), g1v = *(const f32x4*)(gate + col + 4), x0 = *(const f32x4*)(xp), x1 = *(const f32x4*)(xp + 4);
            *(f32x4*)(xp) = x0 + g0v * (f32x4){acc[c * 8], acc[c * 8 + 1], acc[c * 8 + 2], acc[c * 8 + 3]};
            *(f32x4*)(xp + 4) = x1 + g1v * (f32x4){acc[c * 8 + 4], acc[c * 8 + 5], acc[c * 8 + 6], acc[c * 8 + 7]}; }
    }
}

DI void peer_select_naive(const Ctx& F, const Params& P, int layer) {
    LAS float* sc = (LAS float*)F.lds;
    LAS float* lv = sc + 4 * 16 * 128;
    LAS int* li = (LAS int*)(lv + 4 * 16 * 16);
    const bf16_t* Q = (const bf16_t*)(P.ws + WS_RA + RA_Q);
    int* SELI = (int*)(P.ws + WS_RA + RA_SELI); float* SELW = (float*)(P.ws + WS_RA + RA_SELW);
    const float* KEYS = P.in[I_PKEYS] + (size_t)layer * 8 * 2 * 128 * 128;
    for (int tb = F.bid; tb < TOK / 4; tb += F.G) {
        __syncthreads();
        { const int tl = F.tid >> 7, hs = (F.tid >> 3) & 15, part = F.tid & 7, T = tb * 4 + tl;
          const bf16_t* qp = Q + (size_t)T * 2048 + hs * 128;
          for (int n = part * 16; n < part * 16 + 16; ++n) { const float* kp = KEYS + ((size_t)hs * 128 + n) * 128; float s = 0.f;
              for (int d = 0; d < 128; ++d) s += bf2f(qp[d]) * kp[d];
              sc[(tl * 16 + hs) * 128 + n] = s; } }
        __syncthreads();
        if (F.tid < 64) { LAS float* s = sc + F.tid * 128;
            for (int r = 0; r < 16; ++r) { float best = -3e38f; int bi = 0;
                for (int n = 0; n < 128; ++n) { const float v = s[n]; if (v > best) { best = v; bi = n; } }
                lv[F.tid * 16 + r] = best; li[F.tid * 16 + r] = bi; s[bi] = -3e38f; } }
        __syncthreads();
        if (F.tid < 32) { const int tl = F.tid >> 3, h = F.tid & 7, T = tb * 4 + tl;
            LAS float* cand = sc + F.tid * 256;
            const LAS float* v0 = lv + ((tl * 16 + h * 2) * 16); const LAS float* v1 = v0 + 16;
            const LAS int* i0 = li + ((tl * 16 + h * 2) * 16); const LAS int* i1 = i0 + 16;
            for (int a = 0; a < 16; ++a) for (int b = 0; b < 16; ++b) cand[a * 16 + b] = v0[a] + v1[b];
            float fv[16]; int fe[16];
            for (int r = 0; r < 16; ++r) { float best = -3e38f; int bi = 0;
                for (int c = 0; c < 256; ++c) { const float v = cand[c]; if (v > best) { best = v; bi = c; } }
                fv[r] = best; fe[r] = i0[bi >> 4] * 128 + i1[bi & 15]; cand[bi] = -3e38f; }
            float den = 0.f; for (int r = 0; r < 16; ++r) { fv[r] = __expf(fv[r] - fv[0]); den += fv[r]; }
            for (int r = 0; r < 16; ++r) { SELI[(size_t)T * 128 + h * 16 + r] = fe[r]; SELW[(size_t)T * 128 + h * 16 + r] = fv[r] / den; } }
    }
    __syncthreads();
}
constexpr int NPHASE = 27;
#ifndef DBG_SKIP
#define DBG_SKIP 0
#endif
#ifndef LAUNCH_PER_PHASE
#define LAUNCH_PER_PHASE 0
#endif

__global__ void __launch_bounds__(NTHR, 2) mega(Params P) {
    extern __shared__ __attribute__((aligned(16))) unsigned char lds_raw[];
    Ctx F;
    F.lds = (LAS unsigned char*)lds_raw; F.tid = threadIdx.x; F.lane = F.tid & 63; F.wave = __builtin_amdgcn_readfirstlane(F.tid >> 6); F.G = gridDim.x; F.bid = blockIdx.x;
    const int lo = P.ph_lo, hi = P.ph_hi;
    volatile LAS unsigned* xbw = (volatile LAS unsigned*)(F.lds + LDS_BYTES - 16);
    if (F.tid == 0) { xbw[0] = 0u; xbw[1] = 0u; xbw[2] = 0u; xbw[3] = 0u; }
    __syncthreads();
    XcdBarrier bar; bar.bar = (unsigned*)(P.ws + WS_CTL); bar.x = 0; bar.st = xbw;
    if (hi - lo > 1) bar = xcd_barrier_post((unsigned*)(P.ws + WS_CTL), xbw);
#ifdef ONLY_PH
#define PH_ON(k) ((k) == ONLY_PH)
#else
#define PH_ON(k) true
#endif
#define PH_BEGIN(k) if (PH_ON(k) && lo <= (k) && (k) < hi) {
#define PH_END(k) if ((k) + 1 < hi) xcd_barrier(bar); }
    const float* MOD0 = (const float*)(P.ws + WS_MOD); const float* MOD1 = MOD0 + 9 * 12288;
    bf16_t* HM = (bf16_t*)(P.ws + WS_HM); bf16_t* RA = (bf16_t*)(P.ws + WS_RA);
    float* X = P.out + O_Y;

    PH_BEGIN(0) prologue(F, P); PH_END(0)
    PH_BEGIN(1) adaln_reduce(F, P); PH_END(1)
    PH_BEGIN(2) norm_phase(F, P.in[I_XP], P.in[I_XS], P.in[I_NMIXG], MOD0, 0, HM); PH_END(2)
    PH_BEGIN(3) { EpiBf16 E{RA, 4096}; run_gemm(F, HM, (const bf16_t*)(P.ws + WS_WEVIN) + (size_t)2048 * 2048, 4096, 2048, E); } PH_END(3)
    PH_BEGIN(4) prep_a(F, P); PH_END(4)
    PH_BEGIN(5) { EpiBf16 E{RA, 2048}; run_gemm(F, HM, (const bf16_t*)(P.ws + WS_WEVIN), 2048, 2048, E); } PH_END(5)
    PH_BEGIN(6) prep_b(F, P); PH_END(6)
    PH_BEGIN(7) attn_phase<0>(F, P); attn_phase<1>(F, P); PH_END(7)
    PH_BEGIN(8) hyena_phase(F, P); PH_END(8)
    PH_BEGIN(9) hyena_post(F, P); PH_END(9)
    PH_BEGIN(10) { EpiResid E{P.in[I_XP], P.in[I_XS], X, MOD0, 2}; run_gemm(F, HM, (const bf16_t*)(P.ws + WS_WEVOUT), 2048, 2048, E); } PH_END(10)
    PH_BEGIN(11) norm_phase(F, X, X + (size_t)TP * DM, P.in[I_NFFNG], MOD0, 3, HM); PH_END(11)
    PH_BEGIN(12) { EpiBf16 E{RA, 2048}; run_gemm(F, HM, (const bf16_t*)(P.ws + WS_WPQ), 2048, 2048, E); } PH_END(12)
    PH_BEGIN(13) if (DBG_SKIP & 4) peer_select_naive(F, P, 0); else peer_select(F, P, 0); PH_END(13)
    PH_BEGIN(14) if (DBG_SKIP & 8) peer_gather_dbg(F, P, MOD0); else if (!(DBG_SKIP & 1)) peer_gather(F, P, MOD0); PH_END(14)
    PH_BEGIN(15) convert_peer_tables(F, P, 1); norm_phase(F, X, X + (size_t)TP * DM, P.in[I_NMIXG] + DM, MOD1, 0, HM); PH_END(15)
    PH_BEGIN(16) { EpiBf16 E{RA, 4096}; run_gemm(F, HM, (const bf16_t*)(P.ws + WS_WODIN), 4096, 2048, E); } PH_END(16)
    PH_BEGIN(17) prep_c(F, P); PH_END(17)
    PH_BEGIN(18) s5_phase(F, P); PH_END(18)
    PH_BEGIN(19) attn_phase<2>(F, P); attn_phase<3>(F, P); PH_END(19)
    PH_BEGIN(20) s5_combine(F, P); PH_END(20)
    PH_BEGIN(21) { EpiGlu E{(const bf16_t*)(P.ws + WS_RB + RB_Y), HM, P.in[I_GLUB]}; run_gemm(F, (const bf16_t*)(P.ws + WS_RB + RB_Y), (const bf16_t*)(P.ws + WS_WGLU), 1024, 1024, E); } PH_END(21)
    PH_BEGIN(22) { EpiResid E{X, X + (size_t)TP * DM, X, MOD1, 2}; run_gemm(F, HM, (const bf16_t*)(P.ws + WS_WODOUT), 2048, 2048, E); } PH_END(22)
    PH_BEGIN(23) norm_phase(F, X, X + (size_t)TP * DM, P.in[I_NFFNG] + DM, MOD1, 3, HM); PH_END(23)
    PH_BEGIN(24) { EpiBf16 E{RA, 2048}; run_gemm(F, HM, (const bf16_t*)(P.ws + WS_WPQ) + (size_t)2048 * 2048, 2048, 2048, E); } PH_END(24)
    PH_BEGIN(25) if (DBG_SKIP & 4) peer_select_naive(F, P, 1); else peer_select(F, P, 1); PH_END(25)
    PH_BEGIN(26) if (DBG_SKIP & 8) peer_gather_dbg(F, P, MOD1); else if (!(DBG_SKIP & 2)) peer_gather(F, P, MOD1); PH_END(26)
}

extern "C" void kernel_launch(void* const* d_in, const int* in_sizes, int n_in, void* d_out, int out_size, void* d_ws, size_t ws_size, hipStream_t stream) {
    static int grid = 0;
    if (grid == 0) {
        if (n_in != N_IN || (size_t)out_size != O_END || ws_size < WS_END) { fprintf(stderr, "kernel_launch: unexpected shapes (n_in %d, out %d, ws %zu, need %zu)\n", n_in, out_size, ws_size, (size_t)WS_END); grid = -1; return; }
        int dev = 0, cus = 0;
        if (hipGetDevice(&dev) != hipSuccess || hipDeviceGetAttribute(&cus, hipDeviceAttributeMultiprocessorCount, dev) != hipSuccess) { grid = -1; return; }
        if (hipFuncSetAttribute((const void*)mega, hipFuncAttributeMaxDynamicSharedMemorySize, LDS_BYTES) != hipSuccess) { fprintf(stderr, "kernel_launch: hipFuncSetAttribute failed\n"); grid = -1; return; }
        int per_cu = 0;
        if (hipOccupancyMaxActiveBlocksPerMultiprocessor(&per_cu, (const void*)mega, NTHR, LDS_BYTES) != hipSuccess || per_cu < 1) { fprintf(stderr, "kernel_launch: occupancy query says %d blocks per CU\n", per_cu); }
        (void)hipGetLastError();
        grid = cus;
    }
    if (grid < 0) return;
    (void)hipMemsetAsync((char*)d_ws + WS_CTL, 0, 65536, stream);
    Params p; memset(&p, 0, sizeof(p));
    for (int i = 0; i < N_IN; ++i) p.in[i] = (const float*)d_in[i];
    p.out = (float*)d_out; p.ws = (unsigned char*)d_ws;
#if LAUNCH_PER_PHASE
    for (int k = 0; k < NPHASE; ++k) { p.ph_lo = k; p.ph_hi = k + 1; hipLaunchKernelGGL(mega, dim3(grid), dim3(NTHR), LDS_BYTES, stream, p); }
#else
    p.ph_lo = 0; p.ph_hi = NPHASE;
    hipLaunchKernelGGL(mega, dim3(grid), dim3(NTHR), LDS_BYTES, stream, p);
#endif
}
```

```cpp
#include <hip/hip_runtime.h>
#include <cstdio>
#include <cstring>
#include <cstdint>

typedef unsigned short bf16_t;
typedef short bf16x8 __attribute__((ext_vector_type(8)));
typedef short s16x4 __attribute__((ext_vector_type(4)));
typedef float f32x2 __attribute__((ext_vector_type(2)));
typedef float f32x4 __attribute__((ext_vector_type(4)));
typedef float f32x16 __attribute__((ext_vector_type(16)));
typedef unsigned u32x2 __attribute__((ext_vector_type(2)));
typedef unsigned u32x4 __attribute__((ext_vector_type(4)));
typedef __bf16 bf16x2_t __attribute__((ext_vector_type(2)));

#define DI __device__ __forceinline__

constexpr int NTHR = 512;
constexpr int DM = 2048;
constexpr int TP = 8192;
constexpr int TS = 32768;
constexpr int TOK = TP + TS;
constexpr int LP = 256, LS = 4096;
constexpr float NORM_EPS = 1e-6f;
constexpr float LOG2E = 1.4426950408889634f;

enum { I_XP = 0, I_XS, I_C, I_CNK, I_CNV, I_CDK, I_CDV, I_S5RE, I_S5IM, I_CCTX, I_MODW, I_MODB, I_NMIXG, I_NFFNG, I_EVWIN, I_EVWOUT, I_NAQG, I_NAKG, I_RPB,
       I_HYCW, I_HYCB, I_HYW1, I_HYB1, I_HYF1, I_HYW2, I_HYB2, I_HYF2, I_HYW3, I_HYDEC, I_HYBIAS, I_ODWIN, I_ODWOUT, I_S5LRE, I_S5LIM, I_S5LDT, I_S5BRE, I_S5BIM,
       I_S5CRE, I_S5CIM, I_S5D, I_GLUW, I_GLUB, I_DQG, I_DKG, I_LQ1, I_LK1, I_LQ2, I_LK2, I_SUBG, I_PWQ, I_PKEYS, I_PU, I_PV, N_IN };

constexpr size_t O_Y = 0;
constexpr size_t O_NAK = 83886080, O_NAV = 92274688, O_DK = 100663296, O_DV = 109051904, O_SR = 117440512, O_SI = 117702656, O_END = 117964800;

constexpr size_t al256(size_t x) { return (x + 255) & ~(size_t)255; }
constexpr size_t WS_CTL = 0;
constexpr size_t WS_MODP = 65536;
constexpr size_t WS_MOD = WS_MODP + (size_t)2 * 16 * 9 * 12288 * 4;
constexpr size_t WS_WEVIN = al256(WS_MOD + (size_t)2 * 9 * 12288 * 4);
constexpr size_t WS_WEVOUT = WS_WEVIN + (size_t)6144 * 2048 * 2;
constexpr size_t WS_WODIN = WS_WEVOUT + (size_t)2048 * 2048 * 2;
constexpr size_t WS_WODOUT = WS_WODIN + (size_t)4096 * 2048 * 2;
constexpr size_t WS_WPQ = WS_WODOUT + (size_t)2048 * 2048 * 2;
constexpr size_t WS_WGLU = WS_WPQ + (size_t)2 * 2048 * 2048 * 2;
constexpr size_t WS_PKEYS = WS_WGLU + (size_t)1024 * 1024 * 2;
constexpr size_t WS_CNK = WS_PKEYS + (size_t)2 * 8 * 2 * 128 * 128 * 2;
constexpr size_t WS_CNVT = WS_CNK + (size_t)8 * 256 * 1024 * 2;
constexpr size_t WS_CDK = WS_CNVT + (size_t)8 * 256 * 1024 * 2;
constexpr size_t WS_CDVT = WS_CDK + (size_t)8 * 256 * 1024 * 2;
constexpr size_t WS_S5A = WS_CDVT + (size_t)8 * 256 * 1024 * 2;
constexpr size_t WS_S5BB = WS_S5A + (size_t)128 * 64 * 2 * 4;
constexpr size_t WS_S5CC = WS_S5BB + (size_t)128 * 128 * 16 * 2;
constexpr int KRL_S = 8208, KRL_P = 528;
constexpr size_t WS_KRS = WS_S5CC + (size_t)128 * 16 * 128 * 2;
constexpr size_t WS_KRP = al256(WS_KRS + (size_t)2 * 1024 * KRL_S * 2);
constexpr size_t WS_TBLU = al256(WS_KRP + (size_t)2 * 1024 * KRL_P * 2);
constexpr size_t WS_TBLV = WS_TBLU + (size_t)16384 * 2048 * 2;
constexpr size_t WS_HM = WS_TBLV + (size_t)16384 * 2048 * 2;
constexpr size_t WS_RA = WS_HM + (size_t)TOK * 2048 * 2;
constexpr size_t WS_RB = WS_RA + (size_t)TOK * 4096 * 2;
constexpr size_t WS_VT = WS_RB + (size_t)3072 * TOK * 2;
constexpr size_t WS_SC = WS_VT + (size_t)TOK * 1024 * 2;
constexpr size_t WS_END = WS_SC + (size_t)4 * 16384 * 4;
constexpr size_t RA_Q = 0;
constexpr size_t RA_SELI = (size_t)TOK * 2048 * 2;
constexpr size_t RA_SELW = RA_SELI + (size_t)TOK * 128 * 4;
constexpr size_t RA_CF = RA_SELW + (size_t)TOK * 128 * 4;
constexpr size_t RA_ZC = (size_t)TOK * 2048 * 2;
constexpr size_t RB_YF = 0, RB_YB = (size_t)TOK * 1024 * 2, RB_Y = (size_t)2 * TOK * 1024 * 2;
constexpr size_t VT_S = (size_t)TP * 1024 * 2;

constexpr int LDS_BYTES = 147456;

struct Params { const float* in[N_IN]; float* out; unsigned char* ws; int ph_lo, ph_hi; };

DI float bf2f(bf16_t b) { return __uint_as_float(((unsigned)b) << 16); }
DI float bflo(unsigned w) { return __uint_as_float(w << 16); }
DI float bfhi(unsigned w) { return __uint_as_float(w & 0xffff0000u); }
DI unsigned pk2(float a, float b) { f32x2 v = {a, b}; return __builtin_bit_cast(unsigned, __builtin_convertvector(v, bf16x2_t)); }
DI float dot2bf(unsigned a, unsigned b, float c) { return __builtin_amdgcn_fdot2_f32_bf16(__builtin_bit_cast(bf16x2_t, a), __builtin_bit_cast(bf16x2_t, b), c, false); }
DI bf16_t f2bf(float a) { return (bf16_t)(pk2(a, 0.f) & 0xffffu); }
DI float dpp_xor1(float v) { return __builtin_bit_cast(float, __builtin_amdgcn_update_dpp(0, __builtin_bit_cast(int, v), 0xB1, 0xF, 0xF, true)); }
DI float dpp_xor2(float v) { return __builtin_bit_cast(float, __builtin_amdgcn_update_dpp(0, __builtin_bit_cast(int, v), 0x4E, 0xF, 0xF, true)); }
DI float wave_sum(float v) {
    v += dpp_xor1(v); v += dpp_xor2(v);
    v += __builtin_bit_cast(float, __builtin_amdgcn_update_dpp(0, __builtin_bit_cast(int, v), 0x141, 0xF, 0xF, true));
    v += __builtin_bit_cast(float, __builtin_amdgcn_update_dpp(0, __builtin_bit_cast(int, v), 0x140, 0xF, 0xF, true));
    v += __builtin_bit_cast(float, __builtin_amdgcn_update_dpp(0, __builtin_bit_cast(int, v), 0x142, 0xA, 0xF, false));
    v += __builtin_bit_cast(float, __builtin_amdgcn_update_dpp(0, __builtin_bit_cast(int, v), 0x143, 0xC, 0xF, false));
    return __builtin_bit_cast(float, __builtin_amdgcn_readlane(__builtin_bit_cast(int, v), 63));
}
DI float gelu_tanh(float x) {
    const float u = 0.7978845608028654f * (x + 0.044715f * x * x * x);
    const float e = __expf(2.f * u);
    const float t = 1.f - 2.f / (e + 1.f);
    return 0.5f * x * (1.f + t);
}
DI float wave_max(float v) {
    v = fmaxf(v, dpp_xor1(v)); v = fmaxf(v, dpp_xor2(v));
    v = fmaxf(v, __builtin_bit_cast(float, __builtin_amdgcn_update_dpp(0, __builtin_bit_cast(int, v), 0x141, 0xF, 0xF, true)));
    v = fmaxf(v, __builtin_bit_cast(float, __builtin_amdgcn_update_dpp(0, __builtin_bit_cast(int, v), 0x140, 0xF, 0xF, true)));
    v = fmaxf(v, __builtin_bit_cast(float, __builtin_amdgcn_update_dpp(0, __builtin_bit_cast(int, v), 0x142, 0xA, 0xF, false)));
    v = fmaxf(v, __builtin_bit_cast(float, __builtin_amdgcn_update_dpp(0, __builtin_bit_cast(int, v), 0x143, 0xC, 0xF, false)));
    return __builtin_bit_cast(float, __builtin_amdgcn_readlane(__builtin_bit_cast(int, v), 63));
}
DI f32x2 fp8x2_lo(unsigned w) { return __builtin_amdgcn_cvt_pk_f32_fp8((int)w, false); }
DI f32x2 fp8x2_hi(unsigned w) { return __builtin_amdgcn_cvt_pk_f32_fp8((int)w, true); }
DI unsigned pk_fp8x4(float a, float b, float c, float d) { int r = 0; r = __builtin_amdgcn_cvt_pk_fp8_f32(a, b, r, false); r = __builtin_amdgcn_cvt_pk_fp8_f32(c, d, r, true); return (unsigned)r; }
DI int cond_of(int T) { return T < TP ? 0 : 1 + ((T - TP) >> 12); }
#define XB_TMO      128
#define XB_XCNT(j)  (256  + 64 * (j))
#define XB_XSUB(j)  (1280 + 64 * (j))
#define XB_XGEN(j)  (2304 + 64 * (j))
#define XB_TOP      3328
#define XB_TOPGEN   3392
#define XCD_BAR_WORDS 3456
#define XB_SPIN_CAP (1u << 26)
#define LAS __attribute__((address_space(3)))

__device__ __forceinline__ unsigned xb_ld(unsigned* p)              { return __hip_atomic_load(p, __ATOMIC_RELAXED, __HIP_MEMORY_SCOPE_AGENT); }
__device__ __forceinline__ unsigned xb_add(unsigned* p, unsigned v) { return __hip_atomic_fetch_add(p, v, __ATOMIC_RELAXED, __HIP_MEMORY_SCOPE_AGENT); }
__device__ __forceinline__ unsigned xb_xcc_id() { return (unsigned)__builtin_amdgcn_s_getreg((3 << 11) | 20) & 0xFu; }
#define XB_SPIN(cond, bar) do { unsigned _sp = 0; while (cond) { __builtin_amdgcn_s_sleep(1); \
    if ((++_sp & 255u) == 0u) { if (xb_ld(&(bar)[XB_TMO])) break; if (_sp > XB_SPIN_CAP) { atomicAdd(&(bar)[XB_TMO], 1u); break; } } } } while (0)

struct XcdBarrier {
    unsigned* bar; unsigned x;
    volatile LAS unsigned* st;
};

__device__ __forceinline__ XcdBarrier xcd_barrier_post(unsigned* bar, volatile LAS unsigned* st) {
    XcdBarrier b; b.bar = bar; b.x = xb_xcc_id(); b.st = st;
    if (threadIdx.x == 0) (void)xb_add(&bar[XB_XCNT(b.x)], 1u);
    return b;
}
__device__ __forceinline__ void xcd_barrier_complete(unsigned* bar, unsigned x, unsigned& nloc, unsigned& nx) {
    const unsigned G = gridDim.x * gridDim.y * gridDim.z;
    unsigned sum, cnt, mine, sp = 0u;
    for (;;) {
        sum = 0u; cnt = 0u; mine = 0u;
#pragma unroll
        for (unsigned j = 0; j < 16; ++j) { const unsigned c = xb_ld(&bar[XB_XCNT(j)]); sum += c; cnt += (c > 0u) ? 1u : 0u; mine = (j == x) ? c : mine; }
        if (sum == G) break;
        __builtin_amdgcn_s_sleep(1);
        if ((++sp & 255u) == 0u) { if (xb_ld(&bar[XB_TMO])) break; if (sp > XB_SPIN_CAP) { atomicAdd(&bar[XB_TMO], 1u); break; } }
    }
    nloc = mine > 0u ? mine : 1u; nx = cnt > 0u ? cnt : 1u;
}

__device__ __forceinline__ void xcd_barrier(const XcdBarrier& b) {
    asm volatile("s_waitcnt vmcnt(0)" ::: "memory");
    __syncthreads();
    if (threadIdx.x == 0) {
        unsigned* bar = b.bar;
        __builtin_amdgcn_s_waitcnt(0);
        unsigned nloc = b.st[0], nx = b.st[1];
        if (nloc == 0u) { xcd_barrier_complete(bar, b.x, nloc, nx); b.st[0] = nloc; b.st[1] = nx; }
        const unsigned old = xb_add(&bar[XB_XSUB(b.x)], 1u);
        const unsigned gen = old / nloc;
        if (old + 1u == (gen + 1u) * nloc) {
            __builtin_amdgcn_fence(__ATOMIC_RELEASE, "agent");
            asm volatile("s_waitcnt vmcnt(0)" ::: "memory");
            const unsigned og = xb_add(&bar[XB_TOP], 1u);
            const unsigned tg = og / nx;
            if (og + 1u == (tg + 1u) * nx) xb_add(&bar[XB_TOPGEN], 1u);
            else XB_SPIN(xb_ld(&bar[XB_TOPGEN]) == tg, bar);
            __builtin_amdgcn_fence(__ATOMIC_ACQUIRE, "agent");
            xb_add(&bar[XB_XGEN(b.x)], 1u);
            asm volatile("s_waitcnt vmcnt(0)" ::: "memory");
        } else {
            XB_SPIN(xb_ld(&bar[XB_XGEN(b.x)]) == gen, bar);
            __builtin_amdgcn_fence(__ATOMIC_ACQUIRE, "agent");
            asm volatile("s_waitcnt vmcnt(0)" ::: "memory");
        }
    }
    __syncthreads();
}
namespace pg8 {
#define PG8_LAS __attribute__((address_space(3)))
typedef unsigned short bf16_t;
typedef short bf16x8 __attribute__((ext_vector_type(8)));
typedef float f32x4 __attribute__((ext_vector_type(4)));
typedef unsigned u32x4 __attribute__((ext_vector_type(4)));
constexpr int BM = 256, BK = 64, HALF = 128, HTB = HALF * BK * 2  , STAGE_BYTES = 8 * HTB, NXCD = 8, WGM = 8;

__host__ __device__ __forceinline__ int lds_byte(int r, int c) { const int st = (r >> 4) * 2 + (c >> 5), rr = r & 15, cc = c & 31, ob = rr * 64 + cc * 2; return st * 1024 + (ob ^ (((ob >> 9) & 1) << 5)); }
__host__ __device__ __forceinline__ void stage_rc(int b, int& R, int& C) { const int st = b / 1024, sb = b % 1024, swz = sb ^ (((sb >> 9) & 1) << 5); R = (st >> 1) * 16 + swz / 64; C = (st & 1) * 32 + (swz % 64) / 2; }
__host__ __device__ __forceinline__ int perm32(int rho) { const int n = rho >> 4, i = rho & 15; return 8 * (i >> 2) + 4 * n + (i & 3); }

struct Unit { int pm, pn; };
struct Gemm { const bf16_t* A; const bf16_t* Bt; int M, N, K; };

struct StaticOrder {
    int nM, nN, nwg, G, c;
    __host__ __device__ void init(int M, int N, int G_, int c_) { nM = M / BM; nN = N / BM; nwg = nM * nN; G = G_; c = c_; }
    __host__ __device__ bool next(int i, Unit& u) const {
        const long L = (long)i * G + c; if (L >= nwg) return false;
        int wgid = (int)L; { const int q = nwg / NXCD, r = nwg % NXCD, xcd = wgid % NXCD, off = wgid / NXCD; wgid = (xcd < r ? xcd * (q + 1) : r * (q + 1) + (xcd - r) * q) + off; }
        const int nig = WGM * nN, gid = wgid / nig, fm = gid * WGM, gsz = (nM - fm) < WGM ? (nM - fm) : WGM;
        u.pm = fm + ((wgid % nig) % gsz); u.pn = (wgid % nig) / gsz; return true;
    }
    __device__ __forceinline__ void a_ready(const Unit&) const {}
    __device__ __forceinline__ void done(const Unit&) const {}
};
__device__ __forceinline__ unsigned cvt_pk_bf16(float lo, float hi) { unsigned r; asm volatile("v_cvt_pk_bf16_f32 %0, %1, %2" : "=v"(r) : "v"(lo), "v"(hi)); return r; }
template <class Epi, class Sched, bool STAMP = false>
__device__ __forceinline__ void gemm_phase(PG8_LAS unsigned char* lds, const Gemm g, const Sched& S, const Epi& E, unsigned long long* stamps) {
    const int tid = threadIdx.x, wid = __builtin_amdgcn_readfirstlane(tid >> 6), lane = tid & 63, wr = wid >> 2, wc = wid & 3, fr = lane & 15, fq = lane >> 4;
    const int K = g.K, nt = K / BK;
    int ts_lo = 0, ts_hi = 0, nts = 0; const unsigned long long rt_entry = STAMP ? (unsigned long long)wall_clock64() : 0ull;
#define PG8_STAMP() do { if (STAMP && wid == 0 && nts < 64) { const unsigned long long _c = (unsigned long long)clock64(); \
        ts_lo = (lane == nts) ? (int)(unsigned)_c : ts_lo; ts_hi = (lane == nts) ? (int)(unsigned)(_c >> 32) : ts_hi; ++nts; } } while (0)
    PG8_STAMP();
    unsigned voffA[2], voffB[2];
#pragma unroll
    for (int i = 0; i < 2; ++i) { int R, C; stage_rc(tid * 16 + i * 8192, R, C); const int Rb = Epi::PERM ? ((R & ~31) + perm32(R & 31)) : R;
        voffA[i] = (unsigned)(R * K + C) * 2u; voffB[i] = (unsigned)(Rb * K + C) * 2u; }
    const size_t kstep = (size_t)(BK * 2);
    const size_t hstep = (size_t)HALF * K * 2;
    const size_t tstep = 2 * hstep;
    const unsigned ldsw = (unsigned)wid * 1024u;
    const int aoff = lds_byte(wr * 64 + fr, fq * 8), boff = lds_byte(wc * 32 + fr, fq * 8);
#define PG8_SA(b, h) (((b) * 2 + (h)) * HTB)
#define PG8_SB(b, h) ((4 + (b) * 2 + (h)) * HTB)
#define PG8_STAGE(bufoff, gbase, voff) do { _Pragma("unroll") for (int _i = 0; _i < 2; ++_i) \
        __builtin_amdgcn_global_load_lds((const unsigned*)((const char*)(gbase) + (voff)[_i]), (PG8_LAS unsigned*)(lds + (bufoff) + ldsw + _i * 8192), 16, 0, 0); } while (0)
#define PG8_LDA(dst, b, h) do { _Pragma("unroll") for (int m = 0; m < 4; ++m) _Pragma("unroll") for (int k = 0; k < 2; ++k) dst[m][k] = *(const PG8_LAS bf16x8*)(lds + PG8_SA(b, h) + aoff + m * 2048 + k * 1024); } while (0)
#define PG8_LDB(dst, b, h) do { _Pragma("unroll") for (int n = 0; n < 2; ++n) _Pragma("unroll") for (int k = 0; k < 2; ++k) dst[n][k] = *(const PG8_LAS bf16x8*)(lds + PG8_SB(b, h) + boff + n * 2048 + k * 1024); } while (0)
#define PG8_MMA(ai, bj, At, Bt) do { __builtin_amdgcn_s_setprio(1); _Pragma("unroll") for (int m = 0; m < 4; ++m) _Pragma("unroll") for (int n = 0; n < 2; ++n) _Pragma("unroll") for (int k = 0; k < 2; ++k) \
        acc[ai][bj][m][n] = __builtin_amdgcn_mfma_f32_16x16x32_bf16(Bt[n][k], At[m][k], acc[ai][bj][m][n], 0, 0, 0); __builtin_amdgcn_s_setprio(0); } while (0)
#define PG8_WAIT_V(n) asm volatile("s_waitcnt vmcnt(" #n ")" ::: "memory")
#define PG8_WAIT_L(n) asm volatile("s_waitcnt lgkmcnt(" #n ")" ::: "memory")
#define PG8_BAR __builtin_amdgcn_s_barrier()
#define PG8_SCHED __builtin_amdgcn_sched_barrier(0)
    Unit cur, nxt; int ui = 0;
    if (!S.next(0, cur)) return;
    f32x4 acc[2][2][4][2];
#pragma unroll
    for (int a = 0; a < 2; ++a)
#pragma unroll
        for (int b = 0; b < 2; ++b)
#pragma unroll
            for (int m = 0; m < 4; ++m)
#pragma unroll
                for (int n = 0; n < 2; ++n) acc[a][b][m][n] = (f32x4){0.f, 0.f, 0.f, 0.f};
    bf16x8 At[4][2], B0[2][2], B1[2][2];
    const char* cA = (const char*)g.A + (size_t)cur.pm * tstep; const char* cB = (const char*)g.Bt + (size_t)cur.pn * tstep;
    S.a_ready(cur);
    PG8_STAGE(PG8_SB(0, 0), cB, voffB); PG8_STAGE(PG8_SA(0, 0), cA, voffA); PG8_STAGE(PG8_SB(0, 1), cB + hstep, voffB); PG8_STAGE(PG8_SA(0, 1), cA + hstep, voffA);
    if (wr == 1) PG8_BAR;
    PG8_WAIT_V(4); PG8_BAR;
    PG8_STAGE(PG8_SB(1, 0), cB + kstep, voffB); PG8_STAGE(PG8_SA(1, 0), cA + kstep, voffA); PG8_STAGE(PG8_SB(1, 1), cB + hstep + kstep, voffB);
    PG8_WAIT_V(6); PG8_BAR;
    PG8_STAMP();
    for (;;) {
        const bool has_next = S.next(ui + 1, nxt);
        const char* nA = has_next ? (const char*)g.A + (size_t)nxt.pm * tstep : cA; const char* nB = has_next ? (const char*)g.Bt + (size_t)nxt.pn * tstep : cB;
        for (int t = 0; t < nt; t += 2) {
            const bool last = (t == nt - 2);
            const char* a1 = cA + (size_t)(t + 1) * kstep;
            const char* a2 = last ? nA : cA + (size_t)(t + 2) * kstep; const char* b2 = last ? nB : cB + (size_t)(t + 2) * kstep;
            const char* a3 = a2 + kstep; const char* b3 = b2 + kstep;
            if (last && has_next) S.a_ready(nxt);
            PG8_LDB(B0, 0, 0); PG8_SCHED; PG8_LDA(At, 0, 0); PG8_STAGE(PG8_SA(1, 1), a1 + hstep, voffA);
            PG8_WAIT_L(8); PG8_BAR; PG8_WAIT_L(0); PG8_MMA(0, 0, At, B0); PG8_BAR; PG8_SCHED;
            PG8_LDB(B1, 0, 1); PG8_STAGE(PG8_SB(0, 0), b2, voffB);
            PG8_BAR; PG8_WAIT_L(0); PG8_MMA(0, 1, At, B1); PG8_BAR;
            PG8_LDA(At, 0, 1); PG8_STAGE(PG8_SA(0, 0), a2, voffA);
            PG8_BAR; PG8_WAIT_L(0); PG8_MMA(1, 0, At, B0); PG8_BAR; PG8_SCHED;
            PG8_STAGE(PG8_SB(0, 1), b2 + hstep, voffB);
            PG8_WAIT_V(6); PG8_BAR; PG8_MMA(1, 1, At, B1); PG8_BAR;
            PG8_LDB(B0, 1, 0); PG8_SCHED; PG8_LDA(At, 1, 0); PG8_STAGE(PG8_SA(0, 1), a2 + hstep, voffA);
            PG8_WAIT_L(8); PG8_BAR; PG8_WAIT_L(0); PG8_MMA(0, 0, At, B0); PG8_BAR; PG8_SCHED;
            PG8_LDB(B1, 1, 1); PG8_STAGE(PG8_SB(1, 0), b3, voffB);
            PG8_BAR; PG8_WAIT_L(0); PG8_MMA(0, 1, At, B1); PG8_BAR;
            PG8_LDA(At, 1, 1); PG8_STAGE(PG8_SA(1, 0), a3, voffA);
            PG8_BAR; PG8_WAIT_L(0); PG8_MMA(1, 0, At, B0); PG8_BAR; PG8_SCHED;
            PG8_STAGE(PG8_SB(1, 1), b3 + hstep, voffB);
            PG8_WAIT_V(6); PG8_BAR; PG8_MMA(1, 1, At, B1); PG8_BAR;
        }
        PG8_STAMP();
        if constexpr (!Epi::AFTER_DRAIN) { E(acc, cur, wr, wc, fr, fq); S.done(cur); }
        PG8_STAMP();
        if (!has_next) break;
#pragma unroll
        for (int a = 0; a < 2; ++a)
#pragma unroll
            for (int b = 0; b < 2; ++b)
#pragma unroll
                for (int m = 0; m < 4; ++m)
#pragma unroll
                    for (int n = 0; n < 2; ++n) acc[a][b][m][n] = (f32x4){0.f, 0.f, 0.f, 0.f};
        cur = nxt; cA = nA; cB = nB; ++ui;
    }
    PG8_WAIT_V(0);
    if (wr == 0) PG8_BAR;
    PG8_BAR;
    if constexpr (Epi::AFTER_DRAIN) { E.fused(acc, cur, wr, wc, fr, fq, lds, wid, lane); S.done(cur); }
    PG8_STAMP();
    if (STAMP && wid == 0) { stamps[lane] = lane < nts ? (((unsigned long long)(unsigned)ts_hi << 32) | (unsigned)ts_lo) : 0ull;
        if (lane == 62) stamps[62] = rt_entry; if (lane == 63) stamps[63] = (unsigned long long)wall_clock64(); }
#undef PG8_STAMP
#undef PG8_SA
#undef PG8_SB
#undef PG8_STAGE
#undef PG8_LDA
#undef PG8_LDB
#undef PG8_MMA
#undef PG8_WAIT_V
#undef PG8_WAIT_L
#undef PG8_BAR
#undef PG8_SCHED
}
}
struct Ctx {
    LAS unsigned char* lds; int tid, lane, wave, G, bid;
};

DI void cvt_rows(const Ctx& F, const float* src, bf16_t* dst, size_t n) {
    const size_t n8 = n >> 3;
    for (size_t i = (size_t)F.bid * NTHR + F.tid; i < n8; i += (size_t)F.G * NTHR) {
        const f32x4 a = *(const f32x4*)(src + i * 8), b = *(const f32x4*)(src + i * 8 + 4);
        u32x4 w; w.x = pk2(a.x, a.y); w.y = pk2(a.z, a.w); w.z = pk2(b.x, b.y); w.w = pk2(b.z, b.w);
        *(u32x4*)(dst + i * 8) = w;
    }
}

DI void tr_tile_f32(const Ctx& F, const float* src, size_t lds_, bf16_t* dst, size_t ldd, LAS bf16_t* tile) {
#pragma unroll
    for (int j = 0; j < 2; ++j) {
        const int id = F.tid + NTHR * j, kr = id >> 4, nc = (id & 15) * 4;
        const f32x4 v = *(const f32x4*)(src + (size_t)kr * lds_ + nc);
        tile[(nc + 0) * 72 + kr] = f2bf(v.x); tile[(nc + 1) * 72 + kr] = f2bf(v.y); tile[(nc + 2) * 72 + kr] = f2bf(v.z); tile[(nc + 3) * 72 + kr] = f2bf(v.w);
    }
    __syncthreads();
    { const int n = F.tid >> 3, kc = (F.tid & 7) * 8; const u32x4 v = *(const LAS u32x4*)(tile + n * 72 + kc); *(u32x4*)(dst + (size_t)n * ldd + kc) = v; }
    __syncthreads();
}
DI void tr_tile_bf16(const Ctx& F, const bf16_t* src, size_t lds_, bf16_t* dst, size_t ldd, LAS bf16_t* tile) {
    { const int kr = F.tid >> 3, nc = (F.tid & 7) * 8; const u32x4 v = *(const u32x4*)(src + (size_t)kr * lds_ + nc);
      tile[(nc + 0) * 72 + kr] = (bf16_t)(v.x & 0xffff); tile[(nc + 1) * 72 + kr] = (bf16_t)(v.x >> 16); tile[(nc + 2) * 72 + kr] = (bf16_t)(v.y & 0xffff); tile[(nc + 3) * 72 + kr] = (bf16_t)(v.y >> 16);
      tile[(nc + 4) * 72 + kr] = (bf16_t)(v.z & 0xffff); tile[(nc + 5) * 72 + kr] = (bf16_t)(v.z >> 16); tile[(nc + 6) * 72 + kr] = (bf16_t)(v.w & 0xffff); tile[(nc + 7) * 72 + kr] = (bf16_t)(v.w >> 16); }
    __syncthreads();
    { const int n = F.tid >> 3, kc = (F.tid & 7) * 8; const u32x4 v = *(const LAS u32x4*)(tile + n * 72 + kc); *(u32x4*)(dst + (size_t)n * ldd + kc) = v; }
    __syncthreads();
}
DI void transpose_weight(const Ctx& F, const float* W, int K, int N, bf16_t* Wt) {
    const int tk = K / 64, tn = N / 64;
    for (int t = F.bid; t < tk * tn; t += F.G) {
        const int k0 = (t / tn) * 64, n0 = (t % tn) * 64;
        tr_tile_f32(F, W + (size_t)k0 * N + n0, (size_t)N, Wt + (size_t)n0 * K + k0, (size_t)K, (LAS bf16_t*)F.lds);
    }
}
DI void transpose_cache_v(const Ctx& F, const float* V, bf16_t* VT) {
    for (int t = F.bid; t < 64 * 8; t += F.G) {
        const int bh = t >> 3, sub = t & 7, k0 = (sub >> 1) * 64, d0 = (sub & 1) * 64, b = bh >> 3, h = bh & 7;
        tr_tile_f32(F, V + ((size_t)b * 256 + k0) * 1024 + h * 128 + d0, 1024, VT + ((size_t)bh * 128 + d0) * 256 + k0, 256, (LAS bf16_t*)F.lds);
    }
}

DI void adaln_partials(const Ctx& F, const Params& P) {
    LAS float* s = (LAS float*)F.lds;
    const float* modw = P.in[I_MODW]; const float* cv = P.in[I_C]; const float* cctx = P.in[I_CCTX];
    float* modp = (float*)(P.ws + WS_MODP);
    for (int it = F.bid; it < 192; it += F.G) {
        const int i = it / 96, r = it % 96, ks = r / 6, cg = r % 6;
        __syncthreads();
        for (int e = F.tid; e < 9 * 128; e += NTHR) { const int j = e >> 7, k = e & 127; const float c = (j == 0) ? cctx[ks * 128 + k] : cv[(j - 1) * 2048 + ks * 128 + k]; s[e] = c / (1.f + __expf(-c)); }
        __syncthreads();
        f32x4 acc[9];
#pragma unroll
        for (int j = 0; j < 9; ++j) acc[j] = (f32x4){0.f, 0.f, 0.f, 0.f};
        const float* w = modw + ((size_t)i * 2048 + ks * 128) * 12288 + cg * 2048 + F.tid * 4;
#pragma unroll 8
        for (int k = 0; k < 128; ++k) {
            const f32x4 w4 = *(const f32x4*)(w + (size_t)k * 12288);
#pragma unroll
            for (int j = 0; j < 9; ++j) acc[j] += w4 * s[j * 128 + k];
        }
#pragma unroll
        for (int j = 0; j < 9; ++j) *(f32x4*)(modp + ((size_t)(i * 16 + ks) * 9 + j) * 12288 + cg * 2048 + F.tid * 4) = acc[j];
    }
    __syncthreads();
}
DI void adaln_reduce(const Ctx& F, const Params& P) {
    const float* modp = (const float*)(P.ws + WS_MODP); float* mod = (float*)(P.ws + WS_MOD); const float* modb = P.in[I_MODB];
    for (int e = F.bid * NTHR + F.tid; e < 2 * 9 * 12288; e += F.G * NTHR) {
        const int i = e / (9 * 12288), r = e % (9 * 12288), j = r / 12288, n = r % 12288;
        float a = modb[i * 12288 + n];
#pragma unroll
        for (int ks = 0; ks < 16; ++ks) a += modp[((size_t)(i * 16 + ks) * 9 + j) * 12288 + n];
        mod[e] = a;
    }
}

DI void hyena_filters(const Ctx& F, const Params& P) {
    LAS float* z = (LAS float*)F.lds;
    LAS float* h1 = z + 320;
    LAS float* h2 = h1 + 576;
    const float* w1 = P.in[I_HYW1]; const float* b1 = P.in[I_HYB1]; const float* f1 = P.in[I_HYF1];
    const float* w2 = P.in[I_HYW2]; const float* b2 = P.in[I_HYB2]; const float* f2 = P.in[I_HYF2];
    const float* w3 = P.in[I_HYW3]; const float* dec = P.in[I_HYDEC];
    for (int it = F.bid; it < 544; it += F.G) {
        const bool smp = it < 512; const int L = smp ? LS : LP, p0 = (smp ? it : it - 512) * 8, RL = smp ? KRL_S : KRL_P;
        bf16_t* KR = (bf16_t*)(P.ws + (smp ? WS_KRS : WS_KRP));
        __syncthreads();
        if (F.tid < 9 * 33) {
            const int ps = F.tid / 33, k = F.tid % 33, i = p0 + ps;
            const float t = (float)i / (float)(L - 1), wang = 6.283185307179586f * (float)i / (float)L;
            float val;
            if (k == 0) val = t;
            else { const int f = (k - 1) & 15; const float fr = 1e-4f + (float)f * ((15.0f - 1e-4f) / 15.0f); val = (k <= 16) ? cosf(fr * wang) : -sinf(fr * wang); }
            z[F.tid] = val;
        }
        __syncthreads();
        for (int e = F.tid; e < 9 * 64; e += NTHR) { const int ps = e >> 6, j = e & 63; float a = b1[j];
            for (int k = 0; k < 33; ++k) a += z[ps * 33 + k] * w1[k * 64 + j];
            h1[e] = sinf(f1[j] * a); }
        __syncthreads();
        for (int e = F.tid; e < 9 * 64; e += NTHR) { const int ps = e >> 6, j = e & 63; float a = b2[j];
            for (int k = 0; k < 64; ++k) a += h1[ps * 64 + k] * w2[k * 64 + j];
            h2[e] = sinf(f2[j] * a); }
        __syncthreads();
#pragma unroll 1
        for (int qh = 0; qh < 2; ++qh) {
            float acc[9][4];
#pragma unroll
            for (int ps = 0; ps < 9; ++ps)
#pragma unroll
                for (int q = 0; q < 4; ++q) acc[ps][q] = 0.f;
#pragma unroll 2
            for (int k = 0; k < 64; ++k) {
                float w[4];
#pragma unroll
                for (int q = 0; q < 4; ++q) w[q] = w3[k * 4096 + F.tid + NTHR * (qh * 4 + q)];
#pragma unroll
                for (int ps = 0; ps < 9; ++ps) { const float hv = h2[ps * 64 + k];
#pragma unroll
                    for (int q = 0; q < 4; ++q) acc[ps][q] += hv * w[q]; }
            }
#pragma unroll
            for (int q = 0; q < 4; ++q) {
                const int n = F.tid + NTHR * (qh * 4 + q), o = (n >> 10) & 1, c = n & 1023;
                const float dc = fabsf(dec[n]);
                bf16_t* row = KR + (size_t)(o * 1024 + c) * RL;
                float v[9];
#pragma unroll
                for (int ps = 0; ps < 9; ++ps) { const int i = p0 + ps; v[ps] = (i < L) ? acc[ps][q] * __expf(-((float)i / (float)(L - 1)) * dc) : 0.f; }
                if (qh == 0) {
                    u32x4 wv; wv.x = pk2(v[8], v[7]); wv.y = pk2(v[6], v[5]); wv.z = pk2(v[4], v[3]); wv.w = pk2(v[2], v[1]);
                    *(u32x4*)(row + (L - p0 - 8)) = wv;
                    if (p0 == 0) row[L] = f2bf(v[0]);
                } else if (p0 > 0) {
                    u32x4 wv; wv.x = pk2(v[0], v[1]); wv.y = pk2(v[2], v[3]); wv.z = pk2(v[4], v[5]); wv.w = pk2(v[6], v[7]);
                    *(u32x4*)(row + (L + p0)) = wv;
                } else {
#pragma unroll
                    for (int ps = 1; ps < 8; ++ps) row[L + ps] = f2bf(v[ps]);
                }
            }
        }
    }
    __syncthreads();
    for (int e = F.bid * NTHR + F.tid; e < 2 * 2048; e += F.G * NTHR) {
        const bool smp = e < 2048; const int r = e & 2047, L = smp ? LS : LP, RL = smp ? KRL_S : KRL_P;
        bf16_t* row = (bf16_t*)(P.ws + (smp ? WS_KRS : WS_KRP)) + (size_t)r * RL;
        for (int x = 2 * L; x < RL; ++x) row[x] = 0;
    }
}

DI void s5_consts(const Ctx& F, const Params& P) {
    float* S5A = (float*)(P.ws + WS_S5A); bf16_t* BB = (bf16_t*)(P.ws + WS_S5BB); bf16_t* CC = (bf16_t*)(P.ws + WS_S5CC);
    const float* lre = P.in[I_S5LRE]; const float* lim = P.in[I_S5LIM]; const float* ldt = P.in[I_S5LDT];
    const float* bre = P.in[I_S5BRE]; const float* bim = P.in[I_S5BIM]; const float* cre = P.in[I_S5CRE]; const float* cim = P.in[I_S5CIM];
    for (int e = F.bid * NTHR + F.tid; e < 8192; e += F.G * NTHR) {
        const int dg = e >> 6, n = e & 63;
        const float dt = expf(ldt[dg]), lr = lre[e], li = lim[e];
        const float mag = expf(lr * dt), ar = mag * cosf(li * dt), ai = mag * sinf(li * dt), den = lr * lr + li * li;
        const float cr = ((ar - 1.f) * lr + ai * li) / den, ci = (ai * lr - (ar - 1.f) * li) / den;
        S5A[e * 2] = ar; S5A[e * 2 + 1] = ai;
#pragma unroll
        for (int p = 0; p < 16; ++p) {
            const float br = bre[(size_t)e * 16 + p], bi = bim[(size_t)e * 16 + p];
            BB[((size_t)dg * 128 + n) * 16 + p] = f2bf(cr * br - ci * bi);
            BB[((size_t)dg * 128 + 64 + n) * 16 + p] = f2bf(cr * bi + ci * br);
            CC[((size_t)dg * 16 + p) * 128 + n] = f2bf(cre[((size_t)dg * 16 + p) * 64 + n]);
            CC[((size_t)dg * 16 + p) * 128 + 64 + n] = f2bf(-cim[((size_t)dg * 16 + p) * 64 + n]);
        }
    }
}

DI void cvt_table_fp8(const Ctx& F, const float* src, unsigned char* dst, float* scales) {
    for (int r = F.bid * 8 + F.wave; r < 16384; r += F.G * 8) {
        f32x4 v[8]; float m = 0.f;
#pragma unroll
        for (int c = 0; c < 2; ++c)
#pragma unroll
            for (int j = 0; j < 4; ++j) { v[c * 4 + j] = *(const f32x4*)(src + (size_t)r * 2048 + (c * 64 + F.lane) * 16 + j * 4);
                m = fmaxf(m, fmaxf(fmaxf(fabsf(v[c * 4 + j].x), fabsf(v[c * 4 + j].y)), fmaxf(fabsf(v[c * 4 + j].z), fabsf(v[c * 4 + j].w)))); }
        m = wave_max(m);
        const float inv = (m > 0.f) ? 440.f / m : 0.f, sc = (m > 0.f) ? m / 440.f : 0.f;
#pragma unroll
        for (int c = 0; c < 2; ++c) { u32x4 w;
            w.x = pk_fp8x4(v[c * 4 + 0].x * inv, v[c * 4 + 0].y * inv, v[c * 4 + 0].z * inv, v[c * 4 + 0].w * inv);
            w.y = pk_fp8x4(v[c * 4 + 1].x * inv, v[c * 4 + 1].y * inv, v[c * 4 + 1].z * inv, v[c * 4 + 1].w * inv);
            w.z = pk_fp8x4(v[c * 4 + 2].x * inv, v[c * 4 + 2].y * inv, v[c * 4 + 2].z * inv, v[c * 4 + 2].w * inv);
            w.w = pk_fp8x4(v[c * 4 + 3].x * inv, v[c * 4 + 3].y * inv, v[c * 4 + 3].z * inv, v[c * 4 + 3].w * inv);
            *(u32x4*)(dst + (size_t)r * 2048 + (c * 64 + F.lane) * 16) = w; }
        if (F.lane == 0) scales[r] = sc;
    }
}
DI void convert_peer_tables(const Ctx& F, const Params& P) {
    float* SC = (float*)(P.ws + WS_SC);
    for (int layer = 0; layer < 2; ++layer) {
        cvt_table_fp8(F, P.in[I_PU] + (size_t)layer * 16384 * 2048, P.ws + WS_TBLU + (size_t)layer * 16384 * 2048, SC + layer * 16384);
        cvt_table_fp8(F, P.in[I_PV] + (size_t)layer * 16384 * 2048, P.ws + WS_TBLV + (size_t)layer * 16384 * 2048, SC + (2 + layer) * 16384);
    }
}

DI void prologue(const Ctx& F, const Params& P) {
    adaln_partials(F, P);
    transpose_weight(F, P.in[I_EVWIN], 2048, 6144, (bf16_t*)(P.ws + WS_WEVIN));
    transpose_weight(F, P.in[I_EVWOUT], 2048, 2048, (bf16_t*)(P.ws + WS_WEVOUT));
    transpose_weight(F, P.in[I_ODWIN], 2048, 4096, (bf16_t*)(P.ws + WS_WODIN));
    transpose_weight(F, P.in[I_ODWOUT], 2048, 2048, (bf16_t*)(P.ws + WS_WODOUT));
    transpose_weight(F, P.in[I_PWQ], 2048, 2048, (bf16_t*)(P.ws + WS_WPQ));
    transpose_weight(F, P.in[I_PWQ] + (size_t)2048 * 2048, 2048, 2048, (bf16_t*)(P.ws + WS_WPQ) + (size_t)2048 * 2048);
    transpose_weight(F, P.in[I_GLUW], 1024, 1024, (bf16_t*)(P.ws + WS_WGLU));
    cvt_rows(F, P.in[I_PKEYS], (bf16_t*)(P.ws + WS_PKEYS), (size_t)2 * 8 * 2 * 128 * 128);
    cvt_rows(F, P.in[I_CNK], (bf16_t*)(P.ws + WS_CNK), (size_t)8 * 256 * 1024);
    cvt_rows(F, P.in[I_CDK], (bf16_t*)(P.ws + WS_CDK), (size_t)8 * 256 * 1024);
    transpose_cache_v(F, P.in[I_CNV], (bf16_t*)(P.ws + WS_CNVT));
    transpose_cache_v(F, P.in[I_CDV], (bf16_t*)(P.ws + WS_CDVT));
    hyena_filters(F, P);
    s5_consts(F, P);
    convert_peer_tables(F, P);
}
DI void norm_phase(const Ctx& F, const float* xa, const float* xb, const float* gvec, const float* modl, int sidx, bf16_t* H) {
    for (int T = F.bid * 8 + F.wave; T < TOK; T += F.G * 8) {
        const float* xr = T < TP ? xa + (size_t)T * DM : xb + (size_t)(T - TP) * DM;
        f32x4 v[8]; float ss = 0.f;
#pragma unroll
        for (int j = 0; j < 8; ++j) { v[j] = *(const f32x4*)(xr + (j * 64 + F.lane) * 4); ss += v[j].x * v[j].x + v[j].y * v[j].y + v[j].z * v[j].z + v[j].w * v[j].w; }
        ss = wave_sum(ss);
        const float rstd = rsqrtf(ss * (1.f / DM) + NORM_EPS);
        const float* sh = modl + (size_t)(cond_of(T) * 6 + sidx) * DM; const float* sc = sh + DM;
#pragma unroll
        for (int j = 0; j < 8; ++j) {
            const int col = (j * 64 + F.lane) * 4;
            const f32x4 g4 = *(const f32x4*)(gvec + col), s4 = *(const f32x4*)(sc + col), h4 = *(const f32x4*)(sh + col);
            const f32x4 o = v[j] * rstd * g4 * (s4 + 1.f) + h4;
            u32x2 w; w.x = pk2(o.x, o.y); w.y = pk2(o.z, o.w);
            *(u32x2*)(H + (size_t)T * DM + col) = w;
        }
    }
}

struct EpiBf16 {
    static constexpr bool PERM = true, AFTER_DRAIN = false;
    bf16_t* O; int ldc;
    DI void operator()(const f32x4 (&acc)[2][2][4][2], const pg8::Unit& u, int wr, int wc, int fr, int fq) const {
        const int row0 = u.pm * 256 + wr * 64 + fr, col0 = u.pn * 256 + wc * 32 + 8 * fq;
#pragma unroll
        for (int ai = 0; ai < 2; ++ai)
#pragma unroll
            for (int m = 0; m < 4; ++m) { bf16_t* rowp = O + (size_t)(row0 + ai * 128 + m * 16) * ldc + col0;
#pragma unroll
                for (int bj = 0; bj < 2; ++bj) { const f32x4 v0 = acc[ai][bj][m][0], v1 = acc[ai][bj][m][1];
                    u32x4 w; w.x = pk2(v0[0], v0[1]); w.y = pk2(v0[2], v0[3]); w.z = pk2(v1[0], v1[1]); w.w = pk2(v1[2], v1[3]);
                    *(u32x4*)(rowp + bj * 128) = w; } }
    }
};
struct EpiResid {
    static constexpr bool PERM = false, AFTER_DRAIN = false;
    const float* xa; const float* xb; float* out; const float* modl; int gidx;
    DI void operator()(const f32x4 (&acc)[2][2][4][2], const pg8::Unit& u, int wr, int wc, int fr, int fq) const {
        const int row0 = u.pm * 256 + wr * 64 + fr, col0 = u.pn * 256 + wc * 32 + 4 * fq;
        const float* xbase = (u.pm < 32) ? xa : xb - (size_t)TP * DM;
        const float* gate = modl + (size_t)(cond_of(u.pm * 256) * 6 + gidx) * DM;
        f32x4 gv[2][2];
#pragma unroll
        for (int bj = 0; bj < 2; ++bj)
#pragma unroll
            for (int n = 0; n < 2; ++n) gv[bj][n] = *(const f32x4*)(gate + col0 + bj * 128 + n * 16);
#pragma unroll
        for (int ai = 0; ai < 2; ++ai)
#pragma unroll
            for (int m = 0; m < 4; ++m) { const size_t ro = (size_t)(row0 + ai * 128 + m * 16) * DM + col0;
#pragma unroll
                for (int bj = 0; bj < 2; ++bj)
#pragma unroll
                    for (int n = 0; n < 2; ++n) { const f32x4 x4 = *(const f32x4*)(xbase + ro + bj * 128 + n * 16);
                        *(f32x4*)(out + ro + bj * 128 + n * 16) = x4 + gv[bj][n] * acc[ai][bj][m][n]; } }
    }
};
struct EpiGlu {
    static constexpr bool PERM = true, AFTER_DRAIN = false;
    const bf16_t* Y; bf16_t* O; const float* bias;
    DI void operator()(const f32x4 (&acc)[2][2][4][2], const pg8::Unit& u, int wr, int wc, int fr, int fq) const {
        const int row0 = u.pm * 256 + wr * 64 + fr, col0 = u.pn * 256 + wc * 32 + 8 * fq;
#pragma unroll
        for (int bj = 0; bj < 2; ++bj) {
            const f32x4 b0 = *(const f32x4*)(bias + col0 + bj * 128), b1 = *(const f32x4*)(bias + col0 + bj * 128 + 4);
#pragma unroll
            for (int ai = 0; ai < 2; ++ai)
#pragma unroll
                for (int m = 0; m < 4; ++m) { const size_t r = (size_t)(row0 + ai * 128 + m * 16);
                    const u32x4 yv = *(const u32x4*)(Y + r * 1024 + col0 + bj * 128);
                    const f32x4 a0 = acc[ai][bj][m][0] + b0, a1 = acc[ai][bj][m][1] + b1;
                    float o[8];
                    o[0] = bflo(yv.x) / (1.f + __expf(-a0[0])); o[1] = bfhi(yv.x) / (1.f + __expf(-a0[1]));
                    o[2] = bflo(yv.y) / (1.f + __expf(-a0[2])); o[3] = bfhi(yv.y) / (1.f + __expf(-a0[3]));
                    o[4] = bflo(yv.z) / (1.f + __expf(-a1[0])); o[5] = bfhi(yv.z) / (1.f + __expf(-a1[1]));
                    o[6] = bflo(yv.w) / (1.f + __expf(-a1[2])); o[7] = bfhi(yv.w) / (1.f + __expf(-a1[3]));
                    u32x4 w; w.x = pk2(o[0], o[1]); w.y = pk2(o[2], o[3]); w.z = pk2(o[4], o[5]); w.w = pk2(o[6], o[7]);
                    *(u32x4*)(O + r * DM + col0 + bj * 128) = w; }
        }
    }
};
template <class Epi> DI void run_gemm(const Ctx& F, const bf16_t* A, const bf16_t* Bt, int N, int K, const Epi& E) {
    pg8::Gemm g{A, Bt, TOK, N, K}; pg8::StaticOrder S; S.init(TOK, N, F.G, F.bid);
    pg8::gemm_phase<Epi, pg8::StaticOrder, false>(F.lds, g, S, E, nullptr);
    __syncthreads();
}

DI void prep_a(const Ctx& F, const Params& P) {
    const bf16_t* T1 = (const bf16_t*)(P.ws + WS_RA);
    bf16_t* VTp = (bf16_t*)(P.ws + WS_VT); bf16_t* VTs = (bf16_t*)(P.ws + WS_VT + VT_S);
    for (int t = F.bid; t < 2048 + 8192; t += F.G) {
        if (t < 2048) { const int bh = t >> 3, sub = t & 7, tk = sub >> 1, dd = sub & 1, b = bh >> 3, h = bh & 7;
            tr_tile_bf16(F, T1 + ((size_t)(b * 256 + tk * 64)) * 4096 + h * 128 + dd * 64, 4096, VTp + ((size_t)bh * 128 + dd * 64) * 256 + tk * 64, 256, (LAS bf16_t*)F.lds); }
        else { const int u = t - 2048, bh = u >> 7, sub = u & 127, tk = sub >> 1, dd = sub & 1, b = bh >> 3, h = bh & 7;
            tr_tile_bf16(F, T1 + ((size_t)(TP + b * 4096 + tk * 64)) * 4096 + h * 128 + dd * 64, 4096, VTs + ((size_t)bh * 128 + dd * 64) * 4096 + tk * 64, 4096, (LAS bf16_t*)F.lds); }
    }
    { float* o = P.out + O_NAV;
      for (int e = F.bid * NTHR + F.tid; e < TP * 128; e += F.G * NTHR) { const int T = e >> 7, c8 = (e & 127) * 8;
          const u32x4 v = *(const u32x4*)(T1 + (size_t)T * 4096 + c8);
          *(f32x4*)(o + (size_t)T * 1024 + c8) = (f32x4){bflo(v.x), bfhi(v.x), bflo(v.y), bfhi(v.y)};
          *(f32x4*)(o + (size_t)T * 1024 + c8 + 4) = (f32x4){bflo(v.z), bfhi(v.z), bflo(v.w), bfhi(v.w)}; } }
    { LAS bf16_t* tl = (LAS bf16_t*)F.lds;
      bf16_t* CM = (bf16_t*)(P.ws + WS_RB);
      const float* cw = P.in[I_HYCW]; const float* cb = P.in[I_HYCB];
      for (int t = F.bid; t < 48 * 160; t += F.G) {
          const int cg = t % 48, tg = t / 48, ch0 = cg * 64, t0 = tg * 256;
          const bool lz = (t0 < TP) ? true : (((t0 - TP) & 4095) == 0);
          const bool rz = (t0 < TP) ? true : (((t0 + 256 - TP) & 4095) == 0);
          __syncthreads();
#pragma unroll
          for (int j = 0; j < 4; ++j) { const int id = F.tid + NTHR * j, tk = id >> 3, c8 = (id & 7) * 8;
              const u32x4 v = *(const u32x4*)(T1 + (size_t)(t0 + tk) * 4096 + 1024 + ch0 + c8);
              LAS bf16_t* d = tl + tk + 1;
              d[(c8 + 0) * 264] = (bf16_t)(v.x & 0xffff); d[(c8 + 1) * 264] = (bf16_t)(v.x >> 16); d[(c8 + 2) * 264] = (bf16_t)(v.y & 0xffff); d[(c8 + 3) * 264] = (bf16_t)(v.y >> 16);
              d[(c8 + 4) * 264] = (bf16_t)(v.z & 0xffff); d[(c8 + 5) * 264] = (bf16_t)(v.z >> 16); d[(c8 + 6) * 264] = (bf16_t)(v.w & 0xffff); d[(c8 + 7) * 264] = (bf16_t)(v.w >> 16); }
          if (F.tid < 16) { const int side = F.tid >> 3, c8 = (F.tid & 7) * 8; const bool zero = side ? rz : lz; const int tk = side ? t0 + 256 : t0 - 1;
              u32x4 v = (u32x4){0u, 0u, 0u, 0u};
              if (!zero) v = *(const u32x4*)(T1 + (size_t)tk * 4096 + 1024 + ch0 + c8);
              LAS bf16_t* d = tl + (side ? 257 : 0);
              d[(c8 + 0) * 264] = (bf16_t)(v.x & 0xffff); d[(c8 + 1) * 264] = (bf16_t)(v.x >> 16); d[(c8 + 2) * 264] = (bf16_t)(v.y & 0xffff); d[(c8 + 3) * 264] = (bf16_t)(v.y >> 16);
              d[(c8 + 4) * 264] = (bf16_t)(v.z & 0xffff); d[(c8 + 5) * 264] = (bf16_t)(v.z >> 16); d[(c8 + 6) * 264] = (bf16_t)(v.w & 0xffff); d[(c8 + 7) * 264] = (bf16_t)(v.w >> 16); }
          __syncthreads();
#pragma unroll
          for (int j = 0; j < 4; ++j) { const int id = F.tid + NTHR * j, ch = id >> 5, to = (id & 31) * 8, cgl = ch0 + ch;
              const float w0 = cw[cgl], w1 = cw[3072 + cgl], w2 = cw[6144 + cgl], bb = cb[cgl];
              const LAS bf16_t* s = tl + ch * 264 + to;
              float r[10];
#pragma unroll
              for (int i = 0; i < 10; ++i) r[i] = bf2f(s[i]);
              float o[8];
#pragma unroll
              for (int i = 0; i < 8; ++i) o[i] = w0 * r[i] + w1 * r[i + 1] + w2 * r[i + 2] + bb;
              u32x4 w; w.x = pk2(o[0], o[1]); w.y = pk2(o[2], o[3]); w.z = pk2(o[4], o[5]); w.w = pk2(o[6], o[7]);
              *(u32x4*)(CM + (size_t)cgl * TOK + t0 + to) = w; }
      }
      __syncthreads(); }
}

DI void prep_b(const Ctx& F, const Params& P) {
    bf16_t* Pq = (bf16_t*)(P.ws + WS_RA); const float* qg = P.in[I_NAQG]; const float* kg = P.in[I_NAKG]; float* ok = P.out + O_NAK;
    const float* gsrc = (F.lane < 32 ? qg : kg) + (F.lane & 3) * 32;
    float g[32];
#pragma unroll
    for (int i = 0; i < 32; ++i) g[i] = gsrc[i];
    for (int T = F.bid * 8 + F.wave; T < TOK; T += F.G * 8) {
        bf16_t* rp = Pq + (size_t)T * 2048 + F.lane * 32;
        u32x4 v[4]; float x[32]; float ss = 0.f;
#pragma unroll
        for (int j = 0; j < 4; ++j) { v[j] = *(const u32x4*)(rp + j * 8);
            x[j * 8 + 0] = bflo(v[j].x); x[j * 8 + 1] = bfhi(v[j].x); x[j * 8 + 2] = bflo(v[j].y); x[j * 8 + 3] = bfhi(v[j].y);
            x[j * 8 + 4] = bflo(v[j].z); x[j * 8 + 5] = bfhi(v[j].z); x[j * 8 + 6] = bflo(v[j].w); x[j * 8 + 7] = bfhi(v[j].w); }
#pragma unroll
        for (int i = 0; i < 32; ++i) ss += x[i] * x[i];
        ss += dpp_xor1(ss); ss += dpp_xor2(ss);
        const float rstd = rsqrtf(ss * (1.f / 128.f) + NORM_EPS);
#pragma unroll
        for (int i = 0; i < 32; ++i) x[i] = x[i] * rstd * g[i];
#pragma unroll
        for (int j = 0; j < 4; ++j) { u32x4 w; w.x = pk2(x[j * 8 + 0], x[j * 8 + 1]); w.y = pk2(x[j * 8 + 2], x[j * 8 + 3]); w.z = pk2(x[j * 8 + 4], x[j * 8 + 5]); w.w = pk2(x[j * 8 + 6], x[j * 8 + 7]);
            *(u32x4*)(rp + j * 8) = w; }
        if (T < TP && F.lane >= 32) { float* o = ok + (size_t)T * 1024 + (F.lane - 32) * 32;
#pragma unroll
            for (int j = 0; j < 8; ++j) *(f32x4*)(o + j * 4) = (f32x4){x[j * 4], x[j * 4 + 1], x[j * 4 + 2], x[j * 4 + 3]}; }
    }
}
constexpr int AT_KROW = 272, AT_VROW = 136, AT_KTB = 64 * AT_KROW, AT_VTB = 128 * AT_VROW;
constexpr int AT_K0 = 0, AT_V0 = 2 * AT_KTB, AT_RPB = AT_V0 + 2 * AT_VTB;

struct TileMap { const bf16_t* latK; int latKld; const bf16_t* latV; int latVld; int nlat; const bf16_t* ctxK; const bf16_t* ctxV; int ntiles; };
struct TileRegs { u32x4 k[2], v[2]; };

DI void tile_src(const TileMap& M, int j, const bf16_t*& kp, int& kld, const bf16_t*& vp, int& vld) {
    if (j < M.nlat) { kp = M.latK + (size_t)j * 64 * M.latKld; kld = M.latKld; vp = M.latV + j * 64; vld = M.latVld; }
    else { const int c = j - M.nlat; kp = M.ctxK + (size_t)c * 64 * 1024; kld = 1024; vp = M.ctxV + c * 64; vld = 256; }
}
DI void tile_load(const Ctx& F, TileRegs& R, const bf16_t* kp, int kld, const bf16_t* vp, int vld, bool withV = true) {
#pragma unroll
    for (int j = 0; j < 2; ++j) { const int id = F.tid + NTHR * j;
        const unsigned ko = (unsigned)((id >> 4) * kld + (id & 15) * 8) * 2u, vo = (unsigned)((id >> 3) * vld + (id & 7) * 8) * 2u;
        R.k[j] = *(const u32x4*)((const char*)kp + ko);
        if (withV) R.v[j] = *(const u32x4*)((const char*)vp + vo); }
}
DI void tile_store(const Ctx& F, const TileRegs& R, LAS unsigned char* kt, LAS unsigned char* vt, bool withV = true) {
#pragma unroll
    for (int j = 0; j < 2; ++j) { const int id = F.tid + NTHR * j;
        *(LAS u32x4*)(kt + (id >> 4) * AT_KROW + (id & 15) * 16) = R.k[j];
        if (withV) { LAS unsigned char* vp = vt + (id >> 3) * AT_VROW + (id & 7) * 16;
            *(LAS u32x2*)(vp) = (u32x2){R.v[j].x, R.v[j].y}; *(LAS u32x2*)(vp + 8) = (u32x2){R.v[j].z, R.v[j].w}; } }
}

DI void tile_norm_k(const Ctx& F, TileRegs& R, const LAS float* kgain, float* nk, int nkld) {
#pragma unroll
    for (int j = 0; j < 2; ++j) { const int id = F.tid + NTHR * j;
        float x[8] = {bflo(R.k[j].x), bfhi(R.k[j].x), bflo(R.k[j].y), bfhi(R.k[j].y), bflo(R.k[j].z), bfhi(R.k[j].z), bflo(R.k[j].w), bfhi(R.k[j].w)};
        float ss = 0.f;
#pragma unroll
        for (int i = 0; i < 8; ++i) ss += x[i] * x[i];
        ss += dpp_xor1(ss); ss += dpp_xor2(ss);
        ss += __builtin_bit_cast(float, __builtin_amdgcn_update_dpp(0, __builtin_bit_cast(int, ss), 0x141, 0xF, 0xF, true));
        ss += __builtin_bit_cast(float, __builtin_amdgcn_update_dpp(0, __builtin_bit_cast(int, ss), 0x140, 0xF, 0xF, true));
        const float rstd = rsqrtf(ss * (1.f / 128.f) + NORM_EPS);
        const f32x4 g0 = *(const LAS f32x4*)(kgain + (id & 15) * 8), g1 = *(const LAS f32x4*)(kgain + (id & 15) * 8 + 4);
        x[0] *= rstd * g0.x; x[1] *= rstd * g0.y; x[2] *= rstd * g0.z; x[3] *= rstd * g0.w; x[4] *= rstd * g1.x; x[5] *= rstd * g1.y; x[6] *= rstd * g1.z; x[7] *= rstd * g1.w;
        R.k[j] = (u32x4){pk2(x[0], x[1]), pk2(x[2], x[3]), pk2(x[4], x[5]), pk2(x[6], x[7])};
        if (nk) { float* o = nk + (size_t)(id >> 4) * nkld + (id & 15) * 8; *(f32x4*)(o) = (f32x4){x[0], x[1], x[2], x[3]}; *(f32x4*)(o + 4) = (f32x4){x[4], x[5], x[6], x[7]}; }
    }
}

template <int KS>
DI f32x16 qk_tile(LAS const unsigned char* kt, const bf16x8 (&Qf)[8], int kb, int kk0, int q, int hh) {
    f32x16 S;
#pragma unroll
    for (int i = 0; i < 16; ++i) S[i] = 0.f;
#pragma unroll
    for (int ks = 0; ks < KS; ++ks) { const int kk = kk0 + ks;
        const bf16x8 A = *(const LAS bf16x8*)(kt + (kb * 32 + q) * AT_KROW + (kk * 16 + hh * 8) * 2);
        S = __builtin_amdgcn_mfma_f32_32x32x16_bf16(A, Qf[kk], S, 0, 0, 0); }
    return S;
}
DI void pv_tile(LAS const unsigned char* vt, const float (&p)[16], f32x16 (&O)[4], int kb, int q, int hh) {
#pragma unroll
    for (int s = 0; s < 2; ++s) {
        u32x4 pw; pw.x = pk2(p[8 * s + 0], p[8 * s + 1]); pw.y = pk2(p[8 * s + 2], p[8 * s + 3]); pw.z = pk2(p[8 * s + 4], p[8 * s + 5]); pw.w = pk2(p[8 * s + 6], p[8 * s + 7]);
        const bf16x8 Pf = __builtin_bit_cast(bf16x8, pw);
#pragma unroll
        for (int db = 0; db < 4; ++db) {
            LAS const unsigned char* ap = vt + (db * 32 + q) * AT_VROW + (kb * 32 + 16 * s + 4 * hh) * 2;
            const u32x2 lo = *(const LAS u32x2*)(ap), hi = *(const LAS u32x2*)(ap + 16);
            const bf16x8 A2 = __builtin_bit_cast(bf16x8, (u32x4){lo.x, lo.y, hi.x, hi.y});
            O[db] = __builtin_amdgcn_mfma_f32_32x32x16_bf16(A2, Pf, O[db], 0, 0, 0);
        }
        asm volatile("" ::: "memory");
    }
}
template <bool LAT>
DI void attn_compute1(LAS const unsigned char* kt, LAS const unsigned char* vt, const bf16x8 (&Qf)[8], f32x16 (&O)[4], float& ls, int lane, const LAS float* brow, int cq) {
    const int q = lane & 31, hh = lane >> 5;
    const int cs = min(max(cq - 8, 0), 48);
#pragma unroll 1
    for (int kb = 0; kb < 2; ++kb) {
        const f32x16 S = qk_tile<8>(kt, Qf, kb, 0, q, hh);
        float p[16];
#pragma unroll
        for (int i = 0; i < 16; ++i) {
            float arg = S[i];
            if (LAT) { const int ck = kb * 32 + (i & 3) + 8 * (i >> 2) + 4 * hh;
                arg += brow[min(max(ck - cq + 15, 0), 30)];
                p[i] = ((unsigned)(ck - cs) < 16u) ? __builtin_amdgcn_exp2f(arg) : 0.f; }
            else p[i] = __builtin_amdgcn_exp2f(arg);
            ls += p[i];
        }
        pv_tile(vt, p, O, kb, q, hh);
    }
}
DI void diff_pass1(LAS const unsigned char* kt, const bf16x8 (&Qf)[8], float (&ls)[2], int lane) {
    const int q = lane & 31, hh = lane >> 5;
#pragma unroll
    for (int kb = 0; kb < 2; ++kb) {
#pragma unroll
        for (int mp = 0; mp < 2; ++mp) { const f32x16 S = qk_tile<4>(kt, Qf, kb, mp * 4, q, hh);
#pragma unroll
            for (int i = 0; i < 16; ++i) ls[mp] += __builtin_amdgcn_exp2f(S[i]); }
    }
}
DI void diff_pass2(LAS const unsigned char* kt, LAS const unsigned char* vt, const bf16x8 (&Qf)[8], f32x16 (&O)[4], float w0, float w1, int lane) {
    const int q = lane & 31, hh = lane >> 5;
#pragma unroll
    for (int kb = 0; kb < 2; ++kb) {
        float p[16];
        { const f32x16 S0 = qk_tile<4>(kt, Qf, kb, 0, q, hh);
#pragma unroll
          for (int i = 0; i < 16; ++i) p[i] = __builtin_amdgcn_exp2f(S0[i]) * w0; }
        { const f32x16 S1 = qk_tile<4>(kt, Qf, kb, 4, q, hh);
#pragma unroll
          for (int i = 0; i < 16; ++i) p[i] -= __builtin_amdgcn_exp2f(S1[i]) * w1; }
        pv_tile(vt, p, O, kb, q, hh);
    }
}

template <int MODE>
DI void attn_phase(const Ctx& F, const Params& P) {
    constexpr bool DIFF = (MODE >= 2);
    constexpr bool NA = (MODE == 1);
    LAS unsigned char* lds = F.lds;
    LAS float* rpbl = (LAS float*)(lds + AT_RPB);
    LAS float* kgl = (LAS float*)(lds + AT_RPB + 2048);
    if (!DIFF) { __syncthreads(); if (F.tid < 128) kgl[F.tid] = P.in[I_NAKG][F.tid]; __syncthreads(); }
    const bf16_t* PA = (const bf16_t*)(P.ws + WS_RA);
    bf16_t* MIX = (bf16_t*)(P.ws + WS_HM);
    const bf16_t* VTp = (const bf16_t*)(P.ws + WS_VT); const bf16_t* VTs = (const bf16_t*)(P.ws + WS_VT + VT_S);
    const int q = F.lane & 31, hh = F.lane >> 5;
    const float c1 = (DIFF ? 0.125f : 0.08838834764831845f) * LOG2E;
    float lam = 0.f;
    if (DIFF) {
        const float a = wave_sum(P.in[I_LQ1][F.lane] * P.in[I_LK1][F.lane]), b = wave_sum(P.in[I_LQ2][F.lane] * P.in[I_LK2][F.lane]);
        lam = __expf(a) - __expf(b) + 0.35550906759096924f;
    }
    const int nunits = (MODE == 0 || MODE == 2) ? 256 : 1024;
    for (int u0 = F.bid; u0 < nunits; u0 += F.G) {
        int u = u0;
        if ((MODE == 1 || MODE == 3) && F.G == 256) { const int i = u0 >> 8, x = F.bid & 7, y = F.bid >> 3; u = ((2 * i + (y >> 4)) * 8 + x) * 16 + (y & 15); }
        int b, h, tok0, r = 0, rlo = 0; TileMap M;
        const bf16_t* qptr;
        if (MODE == 0) { b = u >> 3; h = u & 7; tok0 = b * 256 + F.wave * 32;
            qptr = PA + (size_t)(tok0 + q) * 2048 + h * 128;
            M.latK = PA + (size_t)(b * 256) * 2048 + 1024 + h * 128; M.latKld = 2048; M.latV = VTp + (size_t)(b * 8 + h) * 128 * 256; M.latVld = 256; M.nlat = 4; M.ctxK = nullptr; M.ctxV = nullptr; M.ntiles = 4; }
        else if (MODE == 1) { b = u >> 7; h = (u >> 4) & 7; const int rg = u & 15; r = 4 * rg + (F.wave >> 1);
            rlo = min(max(4 * rg - 4, 0), 56); const int rhi = min(max(4 * rg + 3 - 4, 0), 56) + 8;
            tok0 = TP + b * 4096 + r * 64 + (F.wave & 1) * 32;
            qptr = PA + (size_t)(tok0 + q) * 2048 + h * 128;
            M.latK = PA + (size_t)(TP + b * 4096 + rlo * 64) * 2048 + 1024 + h * 128; M.latKld = 2048; M.latV = VTs + (size_t)(b * 8 + h) * 128 * 4096 + rlo * 64; M.latVld = 4096; M.nlat = rhi - rlo;
            M.ctxK = (const bf16_t*)(P.ws + WS_CNK) + (size_t)b * 256 * 1024 + h * 128; M.ctxV = (const bf16_t*)(P.ws + WS_CNVT) + (size_t)(b * 8 + h) * 128 * 256; M.ntiles = M.nlat + 4;
            if (F.tid < 465) rpbl[F.tid] = P.in[I_RPB][h * 465 + F.tid] * LOG2E; }
        else if (MODE == 2) { b = u >> 3; h = u & 7; tok0 = b * 256 + F.wave * 32;
            qptr = PA + (size_t)(tok0 + q) * 4096 + 1024 + h * 128;
            M.latK = PA + (size_t)(b * 256) * 4096 + 2048 + h * 128; M.latKld = 4096; M.latV = VTp + (size_t)(b * 8 + h) * 128 * 256; M.latVld = 256; M.nlat = 4; M.ctxK = nullptr; M.ctxV = nullptr; M.ntiles = 4; }
        else { b = u >> 7; h = (u >> 4) & 7; const int qb = u & 15; tok0 = TP + b * 4096 + qb * 256 + F.wave * 32;
            qptr = PA + (size_t)(tok0 + q) * 4096 + 1024 + h * 128;
            M.latK = PA + (size_t)(TP + b * 4096) * 4096 + 2048 + h * 128; M.latKld = 4096; M.latV = VTs + (size_t)(b * 8 + h) * 128 * 4096; M.latVld = 4096; M.nlat = 64;
            M.ctxK = (const bf16_t*)(P.ws + WS_CDK) + (size_t)b * 256 * 1024 + h * 128; M.ctxV = (const bf16_t*)(P.ws + WS_CDVT) + (size_t)(b * 8 + h) * 128 * 256; M.ntiles = 68; }
        bf16x8 Qf[8];
        if constexpr (!DIFF) {
            u32x4 w[8]; float ss = 0.f;
#pragma unroll
            for (int ks = 0; ks < 8; ++ks) { w[ks] = *(const u32x4*)(qptr + ks * 16 + hh * 8);
                ss += bflo(w[ks].x) * bflo(w[ks].x) + bfhi(w[ks].x) * bfhi(w[ks].x) + bflo(w[ks].y) * bflo(w[ks].y) + bfhi(w[ks].y) * bfhi(w[ks].y)
                    + bflo(w[ks].z) * bflo(w[ks].z) + bfhi(w[ks].z) * bfhi(w[ks].z) + bflo(w[ks].w) * bflo(w[ks].w) + bfhi(w[ks].w) * bfhi(w[ks].w); }
            ss += __shfl_xor(ss, 32);
            const float qs = rsqrtf(ss * (1.f / 128.f) + NORM_EPS) * c1;
            const float* qg = P.in[I_NAQG];
#pragma unroll
            for (int ks = 0; ks < 8; ++ks) { const f32x4 g0 = *(const f32x4*)(qg + ks * 16 + hh * 8), g1 = *(const f32x4*)(qg + ks * 16 + hh * 8 + 4);
                const u32x4 ws = (u32x4){pk2(bflo(w[ks].x) * qs * g0.x, bfhi(w[ks].x) * qs * g0.y), pk2(bflo(w[ks].y) * qs * g0.z, bfhi(w[ks].y) * qs * g0.w),
                                         pk2(bflo(w[ks].z) * qs * g1.x, bfhi(w[ks].z) * qs * g1.y), pk2(bflo(w[ks].w) * qs * g1.z, bfhi(w[ks].w) * qs * g1.w)};
                Qf[ks] = __builtin_bit_cast(bf16x8, ws); }
        } else {
#pragma unroll
        for (int ks = 0; ks < 8; ++ks) { const u32x4 w = *(const u32x4*)(qptr + ks * 16 + hh * 8);
            const u32x4 ws = (u32x4){pk2(bflo(w.x) * c1, bfhi(w.x) * c1), pk2(bflo(w.y) * c1, bfhi(w.y) * c1), pk2(bflo(w.z) * c1, bfhi(w.z) * c1), pk2(bflo(w.w) * c1, bfhi(w.w) * c1)};
            Qf[ks] = __builtin_bit_cast(bf16x8, ws); }
        }
        f32x16 O[4]; float ls[2] = {0.f, 0.f}; float w0 = 0.f, w1 = 0.f;
#pragma unroll
        for (int db = 0; db < 4; ++db)
#pragma unroll
            for (int i = 0; i < 16; ++i) O[db][i] = 0.f;
        const int cq = (F.wave & 1) * 32 + q;
        const int r0w = min(max(r - 4, 0), 56);
        const int nt = M.ntiles;
        TileRegs R;
        { const bf16_t* kp; const bf16_t* vp; int kld, vld; tile_src(M, 0, kp, kld, vp, vld); tile_load(F, R, kp, kld, vp, vld); }
        if constexpr (!DIFF) tile_norm_k(F, R, kgl, (MODE == 0) ? P.out + O_NAK + (size_t)(b * 256) * 1024 + h * 128 : nullptr, 1024);
        tile_store(F, R, lds + AT_K0, lds + AT_V0);
        __syncthreads();
        if constexpr (DIFF) {
#pragma unroll 1
            for (int j = 0; j < nt; ++j) {
                const int cur = j & 1, jn = (j + 1 < nt) ? j + 1 : 0;
                const bool wv = (j + 1 == nt);
                { const bf16_t* kp; const bf16_t* vp; int kld, vld; tile_src(M, jn, kp, kld, vp, vld); tile_load(F, R, kp, kld, vp, vld, wv); }
                diff_pass1(lds + AT_K0 + cur * AT_KTB, Qf, ls, F.lane);
                tile_store(F, R, lds + AT_K0 + (cur ^ 1) * AT_KTB, lds + AT_V0 + (cur ^ 1) * AT_VTB, wv);
                __syncthreads();
            }
            { const float l0 = ls[0] + __shfl_xor(ls[0], 32), l1 = ls[1] + __shfl_xor(ls[1], 32); w0 = 1.f / l0; w1 = lam / l1; }
#pragma unroll 1
            for (int j = 0; j < nt; ++j) {
                const int cur = (nt + j) & 1;
                if (j + 1 < nt) { const bf16_t* kp; const bf16_t* vp; int kld, vld; tile_src(M, j + 1, kp, kld, vp, vld); tile_load(F, R, kp, kld, vp, vld); }
                diff_pass2(lds + AT_K0 + cur * AT_KTB, lds + AT_V0 + cur * AT_VTB, Qf, O, w0, w1, F.lane);
                if (j + 1 < nt) tile_store(F, R, lds + AT_K0 + (cur ^ 1) * AT_KTB, lds + AT_V0 + (cur ^ 1) * AT_VTB);
                __syncthreads();
            }
        } else {
#pragma unroll 1
            for (int j = 0; j < nt; ++j) {
                const int cur = j & 1;
                if (j + 1 < nt) { const bf16_t* kp; const bf16_t* vp; int kld, vld; tile_src(M, j + 1, kp, kld, vp, vld); tile_load(F, R, kp, kld, vp, vld); }
                LAS const unsigned char* kt = lds + AT_K0 + cur * AT_KTB; LAS const unsigned char* vt = lds + AT_V0 + cur * AT_VTB;
                if constexpr (NA) {
                    if (j < M.nlat) { const int kr = rlo + j;
                        if (kr >= r0w && kr < r0w + 8) attn_compute1<true>(kt, vt, Qf, O, ls[0], F.lane, rpbl + (kr - r + 7) * 31, cq); }
                    else attn_compute1<false>(kt, vt, Qf, O, ls[0], F.lane, rpbl, cq);
                } else attn_compute1<false>(kt, vt, Qf, O, ls[0], F.lane, rpbl, cq);
                if (j + 1 < nt) {
                    if (j + 1 < M.nlat) tile_norm_k(F, R, kgl, (MODE == 0) ? P.out + O_NAK + (size_t)(b * 256 + (j + 1) * 64) * 1024 + h * 128 : nullptr, 1024);
                    tile_store(F, R, lds + AT_K0 + (cur ^ 1) * AT_KTB, lds + AT_V0 + (cur ^ 1) * AT_VTB); }
                __syncthreads();
            }
        }
        if constexpr (!DIFF) {
            const float inv = 1.f / (ls[0] + __shfl_xor(ls[0], 32));
            bf16_t* op = MIX + (size_t)(tok0 + q) * DM + h * 128 + 4 * hh;
#pragma unroll
            for (int db = 0; db < 4; ++db)
#pragma unroll
                for (int g = 0; g < 4; ++g) { u32x2 w; w.x = pk2(O[db][4 * g] * inv, O[db][4 * g + 1] * inv); w.y = pk2(O[db][4 * g + 2] * inv, O[db][4 * g + 3] * inv);
                    *(u32x2*)(op + db * 32 + 8 * g) = w; }
        } else {
            float ss = 0.f;
#pragma unroll
            for (int db = 0; db < 4; ++db)
#pragma unroll
                for (int i = 0; i < 16; ++i) ss += O[db][i] * O[db][i];
            ss += __shfl_xor(ss, 32);
            const float sc = rsqrtf(ss * (1.f / 128.f) + NORM_EPS) * (1.f - 0.35550906759096924f);
            const float* sg = P.in[I_SUBG];
            bf16_t* op = MIX + (size_t)(tok0 + q) * DM + 1024 + h * 128 + 4 * hh;
#pragma unroll
            for (int db = 0; db < 4; ++db)
#pragma unroll
                for (int g = 0; g < 4; ++g) { const f32x4 g4 = *(const f32x4*)(sg + db * 32 + 8 * g + 4 * hh);
                    u32x2 w; w.x = pk2(O[db][4 * g] * sc * g4.x, O[db][4 * g + 1] * sc * g4.y); w.y = pk2(O[db][4 * g + 2] * sc * g4.z, O[db][4 * g + 3] * sc * g4.w);
                    *(u32x2*)(op + db * 32 + 8 * g) = w; }
        }
    }
}
template <int L, int BATCH> struct HyCfg {
    static constexpr int NB = L / 64, TPT = 32 / BATCH, NTILES = NB / TPT, LOGB = (BATCH == 8) ? 3 : 5;
    static constexpr int ZROWB = (L + 384) * 2 + 16, ZBYTES = BATCH * ZROWB, RL = 2 * L + 16;
    static constexpr int TPW = (NTILES + 7) / 8;
};
constexpr int HY_KR_OFF = 71808;

template <int L, int BATCH>
DI void hyena_part(const Ctx& F, const Params& P, int c, int tokbase  , const bf16_t* KRG  ) {
    typedef HyCfg<L, BATCH> C;
    LAS unsigned char* lds = F.lds;
    bf16_t* CM = (bf16_t*)(P.ws + WS_RB);
    const float* hbias = P.in[I_HYBIAS];
    const int q = F.lane & 31, hh = F.lane >> 5;
    __syncthreads();
    for (int id = F.tid; id < BATCH * (L / 8); id += NTHR) { const int b = id / (L / 8), s8 = (id % (L / 8)) * 8;
        *(LAS u32x4*)(lds + b * C::ZROWB + (192 + s8) * 2) = *(const u32x4*)(CM + (size_t)c * TOK + tokbase + b * L + s8); }
    for (int id = F.tid; id < BATCH * 48; id += NTHR) { const int b = id / 48, k = id % 48, e = (k < 24) ? k * 8 : (192 + L + (k - 24) * 8);
        *(LAS u32x4*)(lds + b * C::ZROWB + e * 2) = (u32x4){0u, 0u, 0u, 0u}; }
#pragma unroll 1
    for (int o = 0; o < 2; ++o) {
        { const bf16_t* src = KRG + (size_t)(o * 1024 + c) * C::RL;
          for (int id = F.tid; id < C::RL / 8; id += NTHR) { const u32x4 v = *(const u32x4*)(src + id * 8);
              *(LAS u32x4*)(lds + HY_KR_OFF + id * 16) = v;
              LAS bf16_t* c1 = (LAS bf16_t*)(lds + HY_KR_OFF + C::RL * 2) + id * 8 - 1;
              if (id > 0) c1[0] = (bf16_t)(v.x & 0xffff);
              c1[1] = (bf16_t)(v.x >> 16); c1[2] = (bf16_t)(v.y & 0xffff); c1[3] = (bf16_t)(v.y >> 16); c1[4] = (bf16_t)(v.z & 0xffff); c1[5] = (bf16_t)(v.z >> 16);
              c1[6] = (bf16_t)(v.w & 0xffff); c1[7] = (bf16_t)(v.w >> 16); } }
        __syncthreads();
        f32x16 acc[C::TPW][2];
#pragma unroll
        for (int t = 0; t < C::TPW; ++t)
#pragma unroll
            for (int mt = 0; mt < 2; ++mt)
#pragma unroll
                for (int i = 0; i < 16; ++i) acc[t][mt][i] = 0.f;
        const int tq0 = F.wave * C::TPW;
        if (tq0 < C::NTILES) {
            const int d1lo = C::TPT * tq0 - (C::NB - 1), d1hi = C::TPT * (tq0 + C::TPW - 1) + C::TPT - 1;
            const int abase = HY_KR_OFF + (F.lane & 1) * (C::RL * 2) + (L - (F.lane & 31) + 8 * hh - (F.lane & 1)) * 2;
            bf16x8 W0[6], W1[6], B0[C::TPW][4];
#define HY_LDW(Wv, d1v, i) do { LAS const unsigned* ap_ = (LAS const unsigned*)(lds + abase + (-4 * (d1v) - 2 + (i)) * 32); Wv[i] = __builtin_bit_cast(bf16x8, (u32x4){ap_[0], ap_[1], ap_[2], ap_[3]}); } while (0)
#define HY_LDB(Bv, d1v) do { _Pragma("unroll") for (int t_ = 0; t_ < C::TPW; ++t_) { const int tq_ = tq0 + t_; \
            const int t1_ = C::TPT * tq_ + (q >> C::LOGB), b_ = q & (BATCH - 1); int s1_ = t1_ - (d1v); s1_ = min(max(s1_, -3), C::NB + 2); \
            LAS const unsigned char* bp_ = lds + b_ * C::ZROWB + (192 + 64 * s1_ + 8 * hh) * 2; \
            _Pragma("unroll") for (int ks_ = 0; ks_ < 4; ++ks_) Bv[t_][ks_] = *(const LAS bf16x8*)(bp_ + ks_ * 32); } } while (0)
#define HY_MM(Wv, Bv, d1v) do { _Pragma("unroll") for (int t_ = 0; t_ < C::TPW; ++t_) { const int tq_ = tq0 + t_; \
            if ((d1v) >= C::TPT * tq_ - (C::NB - 1) && (d1v) <= C::TPT * tq_ + C::TPT - 1) { \
                _Pragma("unroll") for (int ks_ = 0; ks_ < 4; ++ks_) _Pragma("unroll") for (int mt_ = 0; mt_ < 2; ++mt_) \
                    acc[t_][mt_] = __builtin_amdgcn_mfma_f32_32x32x16_bf16(Wv[ks_ - 2 * mt_ + 2], Bv[t_][ks_], acc[t_][mt_], 0, 0, 0); } } } while (0)
#pragma unroll
            for (int i = 0; i < 6; ++i) HY_LDW(W0, d1lo, i);
            int d1 = d1lo;
#pragma unroll 1
            for (; d1 + 1 <= d1hi; d1 += 2) {
                HY_LDB(B0, d1);
#pragma unroll
                for (int i = 0; i < 4; ++i) HY_LDW(W1, d1 + 1, i);
                W1[4] = W0[0]; W1[5] = W0[1];
                HY_MM(W0, B0, d1);
                HY_LDB(B0, d1 + 1);
                if (d1 + 2 <= d1hi) {
#pragma unroll
                    for (int i = 0; i < 4; ++i) HY_LDW(W0, d1 + 2, i);
                    W0[4] = W1[0]; W0[5] = W1[1];
                }
                HY_MM(W1, B0, d1 + 1);
            }
            if (d1 <= d1hi) { HY_LDB(B0, d1); HY_MM(W0, B0, d1); }
#undef HY_LDW
#undef HY_LDB
#undef HY_MM
        }
        __syncthreads();
        if (tq0 < C::NTILES) {
            const float bo = hbias[o * 1024 + c];
            const bf16_t* gate = CM + (size_t)((1 + o) * 1024 + c) * TOK + tokbase;
            bf16_t* zout = (bf16_t*)(P.ws + WS_RA + RA_ZC) + (size_t)c * TOK + tokbase;
#pragma unroll
            for (int t = 0; t < C::TPW; ++t) { const int tq = tq0 + t, t1 = C::TPT * tq + (q >> C::LOGB), b = q & (BATCH - 1);
#pragma unroll
                for (int mt = 0; mt < 2; ++mt)
#pragma unroll
                    for (int g = 0; g < 4; ++g) { const int s = 64 * t1 + 32 * mt + 8 * g + 4 * hh;
                        LAS u32x2* zp = (LAS u32x2*)(lds + b * C::ZROWB + (192 + s) * 2);
                        const u32x2 zv = *zp, gv = *(const u32x2*)(gate + (size_t)b * L + s);
                        const float r0 = bflo(gv.x) * (acc[t][mt][4 * g] + bflo(zv.x) * bo), r1 = bfhi(gv.x) * (acc[t][mt][4 * g + 1] + bfhi(zv.x) * bo);
                        const float r2 = bflo(gv.y) * (acc[t][mt][4 * g + 2] + bflo(zv.y) * bo), r3 = bfhi(gv.y) * (acc[t][mt][4 * g + 3] + bfhi(zv.y) * bo);
                        const u32x2 w = (u32x2){pk2(r0, r1), pk2(r2, r3)};
                        if (o == 0) *zp = w; else *(u32x2*)(zout + (size_t)b * L + s) = w; } }
        }
        __syncthreads();
    }
}

DI void hyena_phase(const Ctx& F, const Params& P) {
    for (int c = F.bid; c < 1024; c += F.G) {
        hyena_part<LS, 8>(F, P, c, TP, (const bf16_t*)(P.ws + WS_KRS));
        hyena_part<LP, 32>(F, P, c, 0, (const bf16_t*)(P.ws + WS_KRP));
    }
}

DI void hyena_post(const Ctx& F, const Params& P) {
    const bf16_t* CM = (const bf16_t*)(P.ws + WS_RA + RA_ZC); bf16_t* MIX = (bf16_t*)(P.ws + WS_HM);
    for (int t = F.bid; t < 16 * 640; t += F.G) { const int cg = t & 15, tg = t >> 4;
        tr_tile_bf16(F, CM + (size_t)(cg * 64) * TOK + tg * 64, TOK, MIX + (size_t)(tg * 64) * DM + 1024 + cg * 64, DM, (LAS bf16_t*)F.lds); }
}
DI void prep_c(const Ctx& F, const Params& P) {
    bf16_t* PA = (bf16_t*)(P.ws + WS_RA);
    LAS float* rope = (LAS float*)(F.lds + 16384);
    __syncthreads();
    for (int e = F.tid; e < 1024; e += NTHR) { const int pos = e >> 4, f = e & 15; const float inv = exp2f(-(float)f * (13.287712379549449f / 16.f)); const float a = (float)pos * inv;
        rope[e * 2] = cosf(a); rope[e * 2 + 1] = sinf(a); }
    __syncthreads();
    { const float* gsrc = (F.lane < 32 ? P.in[I_DQG] : P.in[I_DKG]) + (F.lane & 1) * 32; float* ok = P.out + O_DK;
      float g[32];
#pragma unroll
      for (int i = 0; i < 32; ++i) g[i] = gsrc[i];
      for (int T = F.bid * 8 + F.wave; T < TOK; T += F.G * 8) {
          bf16_t* rp = PA + (size_t)T * 4096 + 1024 + F.lane * 32;
          u32x4 v[4]; float x[32]; float ss = 0.f;
#pragma unroll
          for (int j = 0; j < 4; ++j) { v[j] = *(const u32x4*)(rp + j * 8);
              x[j * 8 + 0] = bflo(v[j].x); x[j * 8 + 1] = bfhi(v[j].x); x[j * 8 + 2] = bflo(v[j].y); x[j * 8 + 3] = bfhi(v[j].y);
              x[j * 8 + 4] = bflo(v[j].z); x[j * 8 + 5] = bfhi(v[j].z); x[j * 8 + 6] = bflo(v[j].w); x[j * 8 + 7] = bfhi(v[j].w); }
#pragma unroll
          for (int i = 0; i < 32; ++i) ss += x[i] * x[i];
          ss += dpp_xor1(ss);
          const float rstd = rsqrtf(ss * (1.f / 64.f) + NORM_EPS);
#pragma unroll
          for (int i = 0; i < 32; ++i) x[i] = x[i] * rstd * g[i];
          if (T < TP) { if (F.lane >= 32) { float* o = ok + (size_t)T * 1024 + (F.lane - 32) * 32;
#pragma unroll
                  for (int j = 0; j < 8; ++j) *(f32x4*)(o + j * 4) = (f32x4){x[j * 4], x[j * 4 + 1], x[j * 4 + 2], x[j * 4 + 3]}; } }
          else { const int t = (T - TP) & 4095, pos = (F.lane & 1) ? (t & 63) : (t >> 6);
              const LAS float* rt = rope + pos * 32;
#pragma unroll
              for (int f = 0; f < 16; ++f) { const float cs = rt[2 * f], sn = rt[2 * f + 1], a = x[f], b = x[16 + f]; x[f] = a * cs - b * sn; x[16 + f] = b * cs + a * sn; } }
#pragma unroll
          for (int j = 0; j < 4; ++j) { u32x4 w; w.x = pk2(x[j * 8 + 0], x[j * 8 + 1]); w.y = pk2(x[j * 8 + 2], x[j * 8 + 3]); w.z = pk2(x[j * 8 + 4], x[j * 8 + 5]); w.w = pk2(x[j * 8 + 6], x[j * 8 + 7]);
              *(u32x4*)(rp + j * 8) = w; }
      } }
    __syncthreads();
    bf16_t* VTp = (bf16_t*)(P.ws + WS_VT); bf16_t* VTs = (bf16_t*)(P.ws + WS_VT + VT_S);
    for (int t = F.bid; t < 2048 + 8192; t += F.G) {
        if (t < 2048) { const int bh = t >> 3, sub = t & 7, tk = sub >> 1, dd = sub & 1, b = bh >> 3, h = bh & 7;
            tr_tile_bf16(F, PA + ((size_t)(b * 256 + tk * 64)) * 4096 + 3072 + h * 128 + dd * 64, 4096, VTp + ((size_t)bh * 128 + dd * 64) * 256 + tk * 64, 256, (LAS bf16_t*)F.lds); }
        else { const int u = t - 2048, bh = u >> 7, sub = u & 127, tk = sub >> 1, dd = sub & 1, b = bh >> 3, h = bh & 7;
            tr_tile_bf16(F, PA + ((size_t)(TP + b * 4096 + tk * 64)) * 4096 + 3072 + h * 128 + dd * 64, 4096, VTs + ((size_t)bh * 128 + dd * 64) * 4096 + tk * 64, 4096, (LAS bf16_t*)F.lds); }
    }
    { float* o = P.out + O_DV;
      for (int e = F.bid * NTHR + F.tid; e < TP * 128; e += F.G * NTHR) { const int T = e >> 7, c8 = (e & 127) * 8;
          const u32x4 v = *(const u32x4*)(PA + (size_t)T * 4096 + 3072 + c8);
          *(f32x4*)(o + (size_t)T * 1024 + c8) = (f32x4){bflo(v.x), bfhi(v.x), bflo(v.y), bfhi(v.y)};
          *(f32x4*)(o + (size_t)T * 1024 + c8 + 4) = (f32x4){bflo(v.z), bfhi(v.z), bflo(v.w), bfhi(v.w)}; } }
}

constexpr int S5_BUROW = 132 * 4, S5_HROW = 272, S5_WLDS = 16 * S5_BUROW + 16 * S5_HROW;
DI void s5_chain(const Ctx& F, const Params& P, int dg, int tok0, int L, const float* h0re, const float* h0im, float* fre, float* fim, bf16_t* Yout) {
    LAS unsigned char* wl = F.lds + F.wave * S5_WLDS; LAS unsigned char* hl = wl + 16 * S5_BUROW;
    const int g = dg & 63, dir = dg >> 6, lane = F.lane, st = lane & 15, gq = lane >> 4;
    const float* S5A = (const float*)(P.ws + WS_S5A); const bf16_t* BB = (const bf16_t*)(P.ws + WS_S5BB); const bf16_t* CC = (const bf16_t*)(P.ws + WS_S5CC);
    const bf16_t* PA = (const bf16_t*)(P.ws + WS_RA);
    const float ar = S5A[(dg * 64 + lane) * 2], ai = S5A[(dg * 64 + lane) * 2 + 1];
    float hr = h0re ? h0re[lane] : 0.f, hi = h0im ? h0im[lane] : 0.f;
    const bf16x8 zero8 = (bf16x8){0, 0, 0, 0, 0, 0, 0, 0};
    bf16x8 BBf[8], CCf[4];
#pragma unroll
    for (int mt = 0; mt < 8; ++mt) BBf[mt] = (gq < 2) ? *(const bf16x8*)(BB + ((size_t)dg * 128 + mt * 16 + st) * 16 + gq * 8) : zero8;
#pragma unroll
    for (int kk = 0; kk < 4; ++kk) CCf[kk] = *(const bf16x8*)(CC + ((size_t)dg * 16 + st) * 128 + kk * 32 + gq * 8);
    const int nch = L / 16;
    const int sgn = dir ? -1 : 1, tstart = dir ? tok0 + L - 1 : tok0;
    bf16x8 Uf = zero8, U1 = zero8, U2 = zero8;
    if (gq < 2) { Uf = *(const bf16x8*)(PA + (size_t)(tstart + sgn * st) * 4096 + g * 16 + gq * 8);
        if (1 < nch) U1 = *(const bf16x8*)(PA + (size_t)(tstart + sgn * (16 + st)) * 4096 + g * 16 + gq * 8);
        if (2 < nch) U2 = *(const bf16x8*)(PA + (size_t)(tstart + sgn * (32 + st)) * 4096 + g * 16 + gq * 8); }
    for (int ch = 0; ch < nch; ++ch) {
        bf16x8 Un = zero8;
        if (ch + 3 < nch && gq < 2) Un = *(const bf16x8*)(PA + (size_t)(tstart + sgn * ((ch + 3) * 16 + st)) * 4096 + g * 16 + gq * 8);
#pragma unroll
        for (int mt = 0; mt < 8; ++mt) { f32x4 d = (f32x4){0.f, 0.f, 0.f, 0.f};
            d = __builtin_amdgcn_mfma_f32_16x16x32_bf16(BBf[mt], Uf, d, 0, 0, 0);
            *(LAS f32x4*)(wl + st * S5_BUROW + (mt * 16 + gq * 4) * 4) = d; }
        asm volatile("" ::: "memory");
#pragma unroll
        for (int s = 0; s < 16; ++s) {
            const float bur = *(const LAS float*)(wl + s * S5_BUROW + lane * 4), bui = *(const LAS float*)(wl + s * S5_BUROW + (64 + lane) * 4);
            const float nr = ar * hr - ai * hi + bur, ni = ar * hi + ai * hr + bui; hr = nr; hi = ni;
            *(LAS bf16_t*)(hl + s * S5_HROW + lane * 2) = f2bf(hr); *(LAS bf16_t*)(hl + s * S5_HROW + (64 + lane) * 2) = f2bf(hi);
        }
        asm volatile("" ::: "memory");
        f32x4 y = (f32x4){0.f, 0.f, 0.f, 0.f};
#pragma unroll
        for (int kk = 0; kk < 4; ++kk) { const bf16x8 Bh = *(const LAS bf16x8*)(hl + st * S5_HROW + (kk * 32 + gq * 8) * 2);
            y = __builtin_amdgcn_mfma_f32_16x16x32_bf16(CCf[kk], Bh, y, 0, 0, 0); }
        { const int tok = tstart + sgn * (ch * 16 + st);
          *(u32x2*)(Yout + (size_t)tok * 1024 + g * 16 + gq * 4) = (u32x2){pk2(y[0], y[1]), pk2(y[2], y[3])}; }
        asm volatile("" ::: "memory");
        Uf = U1; U1 = U2; U2 = Un;
    }
    if (fre) { fre[lane] = hr; fim[lane] = hi; }
}

DI void s5_phase(const Ctx& F, const Params& P) {
    bf16_t* YF = (bf16_t*)(P.ws + WS_RB + RB_YF); bf16_t* YB = (bf16_t*)(P.ws + WS_RB + RB_YB);
    for (int cs = F.bid; cs < 256; cs += F.G) {
        if (F.wave < 4) { const int sc = cs * 4 + F.wave, dg = sc & 127, b = sc >> 7;
            s5_chain(F, P, dg, TP + b * 4096, LS, P.in[I_S5RE] + (size_t)sc * 64, P.in[I_S5IM] + (size_t)sc * 64, nullptr, nullptr, (dg >> 6) ? YB : YF); }
        else { for (int k = 0; k < 4; ++k) { const int pc = (cs * 4 + (F.wave - 4)) * 4 + k, dg = pc & 127, b = pc >> 7;
            s5_chain(F, P, dg, b * 256, LP, nullptr, nullptr, P.out + O_SR + (size_t)pc * 64, P.out + O_SI + (size_t)pc * 64, (dg >> 6) ? YB : YF); } }
    }
}

DI void s5_combine(const Ctx& F, const Params& P) {
    const bf16_t* PA = (const bf16_t*)(P.ws + WS_RA); const bf16_t* YF = (const bf16_t*)(P.ws + WS_RB + RB_YF); const bf16_t* YB = (const bf16_t*)(P.ws + WS_RB + RB_YB);
    bf16_t* Y = (bf16_t*)(P.ws + WS_RB + RB_Y); const float* dsk = P.in[I_S5D];
    for (size_t e = (size_t)F.bid * NTHR + F.tid; e < (size_t)TOK * 128; e += (size_t)F.G * NTHR) { const size_t T = e >> 7; const int c8 = (int)(e & 127) * 8;
        const u32x4 uv = *(const u32x4*)(PA + T * 4096 + c8), fv = *(const u32x4*)(YF + T * 1024 + c8), bv = *(const u32x4*)(YB + T * 1024 + c8);
        const f32x4 d0 = *(const f32x4*)(dsk + c8), d1 = *(const f32x4*)(dsk + c8 + 4);
        float o[8];
        o[0] = gelu_tanh(d0.x * bflo(uv.x) + bflo(fv.x) + bflo(bv.x)); o[1] = gelu_tanh(d0.y * bfhi(uv.x) + bfhi(fv.x) + bfhi(bv.x));
        o[2] = gelu_tanh(d0.z * bflo(uv.y) + bflo(fv.y) + bflo(bv.y)); o[3] = gelu_tanh(d0.w * bfhi(uv.y) + bfhi(fv.y) + bfhi(bv.y));
        o[4] = gelu_tanh(d1.x * bflo(uv.z) + bflo(fv.z) + bflo(bv.z)); o[5] = gelu_tanh(d1.y * bfhi(uv.z) + bfhi(fv.z) + bfhi(bv.z));
        o[6] = gelu_tanh(d1.z * bflo(uv.w) + bflo(fv.w) + bflo(bv.w)); o[7] = gelu_tanh(d1.w * bfhi(uv.w) + bfhi(fv.w) + bfhi(bv.w));
        u32x4 w; w.x = pk2(o[0], o[1]); w.y = pk2(o[2], o[3]); w.z = pk2(o[4], o[5]); w.w = pk2(o[6], o[7]);
        *(u32x4*)(Y + T * 1024 + c8) = w; }
}
constexpr int PS_KROW = 272;
constexpr int PS_IDX_OFF = 2 * 128 * PS_KROW;
constexpr int PS_TAB_OFF = PS_IDX_OFF + 512 * 32;

DI void topk_insert(float (&a)[16], float x) {
#pragma unroll
    for (int j = 15; j >= 1; --j) a[j] = __builtin_amdgcn_fmed3f(a[j - 1], a[j], x);
    a[0] = fmaxf(a[0], x);
}

DI void peer_select(const Ctx& F, const Params& P, int layer) {
    LAS unsigned char* lds = F.lds;
    const bf16_t* Q = (const bf16_t*)(P.ws + WS_RA + RA_Q);
    int* SELI = (int*)(P.ws + WS_RA + RA_SELI); float* SELW = (float*)(P.ws + WS_RA + RA_SELW);
    const bf16_t* KEYS = (const bf16_t*)(P.ws + WS_PKEYS) + (size_t)layer * 8 * 2 * 128 * 128;
    const int q = F.lane & 31, hh = F.lane >> 5;
    LAS unsigned char* myidx = lds + PS_IDX_OFF + F.tid * 32;
    LAS unsigned char* tab = lds + PS_TAB_OFF;
    for (int wu = F.bid; wu < 256; wu += F.G) {
        const int h = wu & 7, chunk = wu >> 3;
        __syncthreads();
        for (int id = F.tid; id < 2 * 128 * 16; id += NTHR) { const int row = id >> 4, c16 = id & 15;
            *(LAS u32x4*)(lds + row * PS_KROW + c16 * 16) = *(const u32x4*)(KEYS + ((size_t)h * 256 + row) * 128 + c16 * 8); }
        if (F.tid < 16) { int cnt = 0;
            for (int a = 0; a < F.tid; ++a) cnt += 16 / (a + 1);
            for (int b = 0; b < 16 / (F.tid + 1); ++b) { tab[(cnt + b) * 2] = (unsigned char)F.tid; tab[(cnt + b) * 2 + 1] = (unsigned char)b; } }
        __syncthreads();
        for (int blk = F.wave; blk < 40; blk += 8) {
            const int T0 = chunk * 1280 + blk * 32;
            float lst[2][16];
#pragma unroll
            for (int side = 0; side < 2; ++side) {
                bf16x8 Qf[8];
                const bf16_t* qp = Q + (size_t)(T0 + q) * 2048 + h * 256 + side * 128 + hh * 8;
#pragma unroll
                for (int ks = 0; ks < 8; ++ks) Qf[ks] = *(const bf16x8*)(qp + ks * 16);
                float a[16];
#pragma unroll
                for (int j = 0; j < 16; ++j) a[j] = -3.0e38f;
#pragma unroll
                for (int nt = 0; nt < 4; ++nt) {
                    f32x16 S;
#pragma unroll
                    for (int i = 0; i < 16; ++i) S[i] = 0.f;
#pragma unroll
                    for (int ks = 0; ks < 8; ++ks) { const bf16x8 A = *(const LAS bf16x8*)(lds + (side * 128 + nt * 32 + q) * PS_KROW + (ks * 16 + hh * 8) * 2);
                        S = __builtin_amdgcn_mfma_f32_32x32x16_bf16(A, Qf[ks], S, 0, 0, 0); }
#pragma unroll
                    for (int i = 0; i < 16; ++i) { const int n = nt * 32 + (i & 3) + 8 * (i >> 2) + 4 * hh;
                        topk_insert(a, __uint_as_float((__float_as_uint(S[i]) & 0xffffff80u) | (unsigned)n)); }
                }
                float pb[16];
#pragma unroll
                for (int j = 0; j < 16; ++j) pb[j] = __shfl_xor(a[j], 32);
#pragma unroll
                for (int j = 0; j < 16; ++j) topk_insert(a, pb[j]);
#pragma unroll
                for (int j = 0; j < 16; ++j) { lst[side][j] = a[j]; myidx[side * 16 + j] = (unsigned char)(__float_as_uint(a[j]) & 0x7fu); }
            }
            float cb[16];
#pragma unroll
            for (int j = 0; j < 16; ++j) cb[j] = -3.0e38f;
            { int cid = 0;
#pragma unroll
              for (int a = 0; a < 16; ++a)
#pragma unroll
                  for (int b = 0; b < 16 / (a + 1); ++b) {
                      const float sa = __uint_as_float(__float_as_uint(lst[0][a]) & 0xffffff80u), sb = __uint_as_float(__float_as_uint(lst[1][b]) & 0xffffff80u);
                      topk_insert(cb, __uint_as_float((__float_as_uint(sa + sb) & 0xffffffc0u) | (unsigned)cid)); ++cid; } }
            const float mx = __uint_as_float(__float_as_uint(cb[0]) & 0xffffffc0u);
            float e[16], den = 0.f;
#pragma unroll
            for (int j = 0; j < 16; ++j) { e[j] = __expf(__uint_as_float(__float_as_uint(cb[j]) & 0xffffffc0u) - mx); den += e[j]; }
            const float rden = 1.f / den;
#pragma unroll
            for (int j = 0; j < 16; ++j) {
                if ((j >> 3) == hh) { const int cid = (int)(__float_as_uint(cb[j]) & 0x3fu);
                    const int a = tab[cid * 2], b = tab[cid * 2 + 1];
                    const int eidx = (int)myidx[a] * 128 + (int)myidx[16 + b];
                    SELI[(size_t)(T0 + q) * 128 + h * 16 + j] = eidx; SELW[(size_t)(T0 + q) * 128 + h * 16 + j] = e[j] * rden; }
            }
        }
    }
    __syncthreads();
}

template <bool NEXTNORM>
DI void peer_gather(const Ctx& F, const Params& P, const float* modl, int layer, const float* ngain, const float* nmodl) {
    const bf16_t* H2 = (const bf16_t*)(P.ws + WS_HM);
    const unsigned char* TU = P.ws + WS_TBLU + (size_t)layer * 16384 * 2048; const unsigned char* TV = P.ws + WS_TBLV + (size_t)layer * 16384 * 2048;
    const float* SCU = (const float*)(P.ws + WS_SC) + layer * 16384; const float* SCV = (const float*)(P.ws + WS_SC) + (2 + layer) * 16384;
    const int* SELI = (const int*)(P.ws + WS_RA + RA_SELI); const float* SELW = (const float*)(P.ws + WS_RA + RA_SELW);
    float* X = P.out + O_Y;
    const int lane = F.lane;
    for (int T = F.bid * 8 + F.wave; T < TOK; T += F.G * 8) {
        f32x2 xf[16];
#pragma unroll
        for (int c = 0; c < 2; ++c)
#pragma unroll
            for (int hf = 0; hf < 2; ++hf) { const u32x4 w = *(const u32x4*)(H2 + (size_t)T * DM + (c * 64 + lane) * 16 + hf * 8);
                xf[c * 8 + hf * 4 + 0] = (f32x2){bflo(w.x), bfhi(w.x)}; xf[c * 8 + hf * 4 + 1] = (f32x2){bflo(w.y), bfhi(w.y)};
                xf[c * 8 + hf * 4 + 2] = (f32x2){bflo(w.z), bfhi(w.z)}; xf[c * 8 + hf * 4 + 3] = (f32x2){bflo(w.w), bfhi(w.w)}; }
        const int e0 = SELI[(size_t)T * 128 + lane], e1 = SELI[(size_t)T * 128 + 64 + lane];
        const float g0 = SELW[(size_t)T * 128 + lane], g1 = SELW[(size_t)T * 128 + 64 + lane];
        float cf0 = 0.f, cf1 = 0.f;
#pragma unroll 1
        for (int kb = 0; kb < 128; kb += 4) {
            u32x4 ur[4][2]; float su[4];
#pragma unroll
            for (int j = 0; j < 4; ++j) { const int k = kb + j; const int e = __builtin_amdgcn_readlane(k < 64 ? e0 : e1, k & 63);
                su[j] = SCU[e];
                const unsigned char* up = TU + (size_t)e * 2048 + lane * 16;
                ur[j][0] = *(const u32x4*)(up); ur[j][1] = *(const u32x4*)(up + 1024); }
#pragma unroll
            for (int j = 0; j < 4; ++j) { f32x2 s2 = (f32x2){0.f, 0.f};
#pragma unroll
                for (int c = 0; c < 2; ++c) { const unsigned w0 = ur[j][c].x, w1 = ur[j][c].y, w2 = ur[j][c].z, w3 = ur[j][c].w;
                    s2 += fp8x2_lo(w0) * xf[c * 8 + 0]; s2 += fp8x2_hi(w0) * xf[c * 8 + 1]; s2 += fp8x2_lo(w1) * xf[c * 8 + 2]; s2 += fp8x2_hi(w1) * xf[c * 8 + 3];
                    s2 += fp8x2_lo(w2) * xf[c * 8 + 4]; s2 += fp8x2_hi(w2) * xf[c * 8 + 5]; s2 += fp8x2_lo(w3) * xf[c * 8 + 6]; s2 += fp8x2_hi(w3) * xf[c * 8 + 7]; }
                const float a = gelu_tanh(wave_sum(s2.x + s2.y) * su[j]); const int k = kb + j;
                if (k < 64) { if (lane == k) cf0 = g0 * a; } else { if (lane == k - 64) cf1 = g1 * a; } }
        }
        f32x2 acc[16];
#pragma unroll
        for (int i = 0; i < 16; ++i) acc[i] = (f32x2){0.f, 0.f};
#pragma unroll 1
        for (int kb = 0; kb < 128; kb += 4) {
            u32x4 vr[4][2]; float cf[4];
#pragma unroll
            for (int j = 0; j < 4; ++j) { const int k = kb + j; const int e = __builtin_amdgcn_readlane(k < 64 ? e0 : e1, k & 63);
                cf[j] = __builtin_bit_cast(float, __builtin_amdgcn_readlane(__builtin_bit_cast(int, k < 64 ? cf0 : cf1), k & 63)) * SCV[e];
                const unsigned char* vp = TV + (size_t)e * 2048 + lane * 16;
                vr[j][0] = *(const u32x4*)(vp); vr[j][1] = *(const u32x4*)(vp + 1024); }
#pragma unroll
            for (int j = 0; j < 4; ++j) { const f32x2 c2 = (f32x2){cf[j], cf[j]};
#pragma unroll
                for (int c = 0; c < 2; ++c) { const unsigned w0 = vr[j][c].x, w1 = vr[j][c].y, w2 = vr[j][c].z, w3 = vr[j][c].w;
                    acc[c * 8 + 0] += c2 * fp8x2_lo(w0); acc[c * 8 + 1] += c2 * fp8x2_hi(w0); acc[c * 8 + 2] += c2 * fp8x2_lo(w1); acc[c * 8 + 3] += c2 * fp8x2_hi(w1);
                    acc[c * 8 + 4] += c2 * fp8x2_lo(w2); acc[c * 8 + 5] += c2 * fp8x2_hi(w2); acc[c * 8 + 6] += c2 * fp8x2_lo(w3); acc[c * 8 + 7] += c2 * fp8x2_hi(w3); } }
        }
        const float* gate = modl + (size_t)(cond_of(T) * 6 + 5) * DM;
        f32x4 xn[8]; float ss = 0.f;
#pragma unroll
        for (int c = 0; c < 2; ++c)
#pragma unroll
            for (int qd = 0; qd < 4; ++qd) { const int col = (c * 64 + lane) * 16 + qd * 4; float* xp = X + (size_t)T * DM + col;
                const f32x4 gv = *(const f32x4*)(gate + col), x0 = *(const f32x4*)(xp);
                const f32x4 r = x0 + gv * (f32x4){acc[c * 8 + qd * 2].x, acc[c * 8 + qd * 2].y, acc[c * 8 + qd * 2 + 1].x, acc[c * 8 + qd * 2 + 1].y};
                *(f32x4*)(xp) = r; xn[c * 4 + qd] = r; ss += r.x * r.x + r.y * r.y + r.z * r.z + r.w * r.w; }
        if (NEXTNORM) {
            ss = wave_sum(ss);
            const float rstd = rsqrtf(ss * (1.f / DM) + NORM_EPS);
            const float* sh = nmodl + (size_t)(cond_of(T) * 6 + 0) * DM; const float* sc = sh + DM;
            bf16_t* H = (bf16_t*)(P.ws + WS_HM);
#pragma unroll
            for (int c = 0; c < 2; ++c)
#pragma unroll
                for (int qd = 0; qd < 4; ++qd) { const int col = (c * 64 + lane) * 16 + qd * 4;
                    const f32x4 g4 = *(const f32x4*)(ngain + col), s4 = *(const f32x4*)(sc + col), h4 = *(const f32x4*)(sh + col);
                    const f32x4 o = xn[c * 4 + qd] * rstd * g4 * (s4 + 1.f) + h4;
                    *(u32x2*)(H + (size_t)T * DM + col) = (u32x2){pk2(o.x, o.y), pk2(o.z, o.w)}; }
        }
    }
}
constexpr int NPHASE = 22;

__global__ void __launch_bounds__(NTHR, 2) mega(Params P) {
    extern __shared__ __attribute__((aligned(16))) unsigned char lds_raw[];
    Ctx F;
    F.lds = (LAS unsigned char*)lds_raw; F.tid = threadIdx.x; F.lane = F.tid & 63; F.wave = __builtin_amdgcn_readfirstlane(F.tid >> 6); F.G = gridDim.x; F.bid = blockIdx.x;
    const int lo = P.ph_lo, hi = P.ph_hi;
    volatile LAS unsigned* xbw = (volatile LAS unsigned*)(F.lds + LDS_BYTES - 16);
    if (F.tid == 0) { xbw[0] = 0u; xbw[1] = 0u; xbw[2] = 0u; xbw[3] = 0u; }
    __syncthreads();
    XcdBarrier bar; bar.bar = (unsigned*)(P.ws + WS_CTL); bar.x = 0; bar.st = xbw;
    if (hi - lo > 1) bar = xcd_barrier_post((unsigned*)(P.ws + WS_CTL), xbw);
#define PH(k, ...) if (lo <= (k) && (k) < hi) { { __VA_ARGS__ } if ((k) + 1 < hi) xcd_barrier(bar); }
#define MOD0 ((const float*)(P.ws + WS_MOD))
#define MOD1 ((const float*)(P.ws + WS_MOD) + 9 * 12288)
#define HM ((bf16_t*)(P.ws + WS_HM))
#define RA ((bf16_t*)(P.ws + WS_RA))
#define X (P.out + O_Y)

    PH(0, prologue(F, P);)
    PH(1, adaln_reduce(F, P);)
    PH(2, norm_phase(F, P.in[I_XP], P.in[I_XS], P.in[I_NMIXG], MOD0, 0, HM);)
    PH(3, { EpiBf16 E{RA, 4096}; run_gemm(F, HM, (const bf16_t*)(P.ws + WS_WEVIN) + (size_t)2048 * 2048, 4096, 2048, E); })
    PH(4, prep_a(F, P);)
    PH(5, { EpiBf16 E{RA, 2048}; run_gemm(F, HM, (const bf16_t*)(P.ws + WS_WEVIN), 2048, 2048, E); })
    PH(6, attn_phase<0>(F, P); attn_phase<1>(F, P); hyena_phase(F, P);)
    PH(7, hyena_post(F, P);)
    PH(8, { EpiResid E{P.in[I_XP], P.in[I_XS], X, MOD0, 2}; run_gemm(F, HM, (const bf16_t*)(P.ws + WS_WEVOUT), 2048, 2048, E); })
    PH(9, norm_phase(F, X, X + (size_t)TP * DM, P.in[I_NFFNG], MOD0, 3, HM);)
    PH(10, { EpiBf16 E{RA, 2048}; run_gemm(F, HM, (const bf16_t*)(P.ws + WS_WPQ), 2048, 2048, E); })
    PH(11, peer_select(F, P, 0);)
    PH(12, peer_gather<true>(F, P, MOD0, 0, P.in[I_NMIXG] + DM, MOD1);)
    PH(13, { EpiBf16 E{RA, 4096}; run_gemm(F, HM, (const bf16_t*)(P.ws + WS_WODIN), 4096, 2048, E); })
    PH(14, prep_c(F, P); s5_phase(F, P);)
    PH(15, attn_phase<2>(F, P); attn_phase<3>(F, P); s5_combine(F, P);)
    PH(16, { EpiGlu E{(const bf16_t*)(P.ws + WS_RB + RB_Y), HM, P.in[I_GLUB]}; run_gemm(F, (const bf16_t*)(P.ws + WS_RB + RB_Y), (const bf16_t*)(P.ws + WS_WGLU), 1024, 1024, E); })
    PH(17, { EpiResid E{X, X + (size_t)TP * DM, X, MOD1, 2}; run_gemm(F, HM, (const bf16_t*)(P.ws + WS_WODOUT), 2048, 2048, E); })
    PH(18, norm_phase(F, X, X + (size_t)TP * DM, P.in[I_NFFNG] + DM, MOD1, 3, HM);)
    PH(19, { EpiBf16 E{RA, 2048}; run_gemm(F, HM, (const bf16_t*)(P.ws + WS_WPQ) + (size_t)2048 * 2048, 2048, 2048, E); })
    PH(20, peer_select(F, P, 1);)
    PH(21, peer_gather<false>(F, P, MOD1, 1, nullptr, nullptr);)
#undef MOD0
#undef MOD1
#undef HM
#undef RA
#undef X
#undef PH
}

extern "C" void kernel_launch(void* const* d_in, const int* in_sizes, int n_in, void* d_out, int out_size, void* d_ws, size_t ws_size, hipStream_t stream) {
    static int grid = 0;
    if (grid == 0) {
        if (n_in != N_IN || (size_t)out_size != O_END || ws_size < WS_END) { fprintf(stderr, "kernel_launch: unexpected shapes (n_in %d, out %d, ws %zu, need %zu)\n", n_in, out_size, ws_size, (size_t)WS_END); grid = -1; return; }
        int dev = 0, cus = 0;
        if (hipGetDevice(&dev) != hipSuccess || hipDeviceGetAttribute(&cus, hipDeviceAttributeMultiprocessorCount, dev) != hipSuccess) { grid = -1; return; }
        if (hipFuncSetAttribute((const void*)mega, hipFuncAttributeMaxDynamicSharedMemorySize, LDS_BYTES) != hipSuccess) { fprintf(stderr, "kernel_launch: hipFuncSetAttribute failed\n"); grid = -1; return; }
        int per_cu = 0;
        if (hipOccupancyMaxActiveBlocksPerMultiprocessor(&per_cu, (const void*)mega, NTHR, LDS_BYTES) != hipSuccess || per_cu < 1) { fprintf(stderr, "kernel_launch: occupancy query says %d blocks per CU\n", per_cu); }
        (void)hipGetLastError();
        grid = cus;
    }
    if (grid < 0) return;
    (void)hipMemsetAsync((char*)d_ws + WS_CTL, 0, 65536, stream);
    Params p; memset(&p, 0, sizeof(p));
    for (int i = 0; i < N_IN; ++i) p.in[i] = (const float*)d_in[i];
    p.out = (float*)d_out; p.ws = (unsigned char*)d_ws;
    p.ph_lo = 0; p.ph_hi = NPHASE;
    hipLaunchKernelGGL(mega, dim3(grid), dim3(NTHR), LDS_BYTES, stream, p);
}
```

```cpp
#include <hip/hip_runtime.h>
#include <cstdio>
#include <cstring>
#include <cstdint>

typedef unsigned short bf16_t;
typedef short bf16x8 __attribute__((ext_vector_type(8)));
typedef short s16x4 __attribute__((ext_vector_type(4)));
typedef float f32x2 __attribute__((ext_vector_type(2)));
typedef float f32x4 __attribute__((ext_vector_type(4)));
typedef float f32x16 __attribute__((ext_vector_type(16)));
typedef unsigned u32x2 __attribute__((ext_vector_type(2)));
typedef unsigned u32x4 __attribute__((ext_vector_type(4)));
typedef __bf16 bf16x2_t __attribute__((ext_vector_type(2)));
typedef float f32x32 __attribute__((ext_vector_type(32)));
typedef unsigned u32x6 __attribute__((ext_vector_type(6)));

#define DI __device__ __forceinline__

constexpr int NTHR = 512;
constexpr int DM = 2048;
constexpr int TP = 8192;
constexpr int TS = 32768;
constexpr int TOK = TP + TS;
constexpr int LP = 256, LS = 4096;
constexpr float NORM_EPS = 1e-6f;
constexpr float LOG2E = 1.4426950408889634f;

enum { I_XP = 0, I_XS, I_C, I_CNK, I_CNV, I_CDK, I_CDV, I_S5RE, I_S5IM, I_CCTX, I_MODW, I_MODB, I_NMIXG, I_NFFNG, I_EVWIN, I_EVWOUT, I_NAQG, I_NAKG, I_RPB,
       I_HYCW, I_HYCB, I_HYW1, I_HYB1, I_HYF1, I_HYW2, I_HYB2, I_HYF2, I_HYW3, I_HYDEC, I_HYBIAS, I_ODWIN, I_ODWOUT, I_S5LRE, I_S5LIM, I_S5LDT, I_S5BRE, I_S5BIM,
       I_S5CRE, I_S5CIM, I_S5D, I_GLUW, I_GLUB, I_DQG, I_DKG, I_LQ1, I_LK1, I_LQ2, I_LK2, I_SUBG, I_PWQ, I_PKEYS, I_PU, I_PV, N_IN };

constexpr size_t O_Y = 0;
constexpr size_t O_NAK = 83886080, O_NAV = 92274688, O_DK = 100663296, O_DV = 109051904, O_SR = 117440512, O_SI = 117702656, O_END = 117964800;

constexpr size_t al256(size_t x) { return (x + 255) & ~(size_t)255; }
constexpr size_t WS_CTL = 0;
constexpr size_t WS_MODP = 65536;
constexpr size_t WS_MOD = WS_MODP + (size_t)2 * 16 * 9 * 12288 * 4;
constexpr size_t WS_WEVIN = al256(WS_MOD + (size_t)2 * 9 * 12288 * 4);
constexpr size_t WS_WEVOUT = WS_WEVIN + (size_t)6144 * 2048 * 2;
constexpr size_t WS_WODIN = WS_WEVOUT + (size_t)2048 * 2048 * 2;
constexpr size_t WS_WODOUT = WS_WODIN + (size_t)4096 * 2048 * 2;
constexpr size_t WS_WPQ = WS_WODOUT + (size_t)2048 * 2048 * 2;
constexpr size_t WS_WGLU = WS_WPQ + (size_t)2 * 2048 * 2048 * 2;
constexpr size_t WS_PKEYS = WS_WGLU + (size_t)1024 * 1024 * 2;
constexpr size_t WS_CNK = WS_PKEYS + (size_t)2 * 8 * 2 * 128 * 128 * 2;
constexpr size_t WS_CNVT = WS_CNK + (size_t)8 * 256 * 1024 * 2;
constexpr size_t WS_CDK = WS_CNVT + (size_t)8 * 256 * 1024 * 2;
constexpr size_t WS_CDVT = WS_CDK + (size_t)8 * 256 * 1024 * 2;
constexpr size_t WS_S5A = WS_CDVT + (size_t)8 * 256 * 1024 * 2;
constexpr size_t WS_S5BB = WS_S5A + (size_t)128 * 64 * 2 * 4;
constexpr size_t WS_S5CC = WS_S5BB + (size_t)128 * 128 * 16 * 2;
constexpr int KRL_S = 8208, KRL_P = 528;
constexpr size_t WS_KRS = WS_S5CC + (size_t)128 * 16 * 128 * 2;
constexpr size_t WS_KRP = al256(WS_KRS + (size_t)2 * 1024 * KRL_S * 2);
constexpr size_t WS_TBLU = al256(WS_KRP + (size_t)2 * 1024 * KRL_P * 2);
constexpr size_t WS_TBLV = WS_TBLU + (size_t)16384 * 2048 * 2;
constexpr size_t WS_HM = WS_TBLV + (size_t)16384 * 2048 * 2;
constexpr size_t WS_RA = WS_HM + (size_t)TOK * 2048 * 2;
constexpr size_t WS_RB = WS_RA + (size_t)TOK * 4096 * 2;
constexpr size_t WS_VT = WS_RB + (size_t)3072 * TOK * 2;
constexpr size_t WS_SC = WS_VT + (size_t)TOK * 1024 * 2;
constexpr size_t WS_END = WS_SC + (size_t)4 * 16384 * 4;
constexpr size_t RA_Q = 0;
constexpr size_t RA_SELI = (size_t)TOK * 2048 * 2;
constexpr size_t RA_SELW = RA_SELI + (size_t)TOK * 128 * 4;
constexpr size_t RA_CF = RA_SELW + (size_t)TOK * 128 * 4;
constexpr size_t RA_ZC = (size_t)TOK * 2048 * 2;
constexpr size_t RB_YF = 0, RB_YB = (size_t)TOK * 1024 * 2, RB_Y = (size_t)2 * TOK * 1024 * 2;
constexpr size_t VT_S = (size_t)TP * 1024 * 2;

constexpr int LDS_BYTES = 147456;

struct Params { const float* in[N_IN]; float* out; unsigned char* ws; int ph_lo, ph_hi; };

DI float bf2f(bf16_t b) { return __uint_as_float(((unsigned)b) << 16); }
DI float bflo(unsigned w) { return __uint_as_float(w << 16); }
DI float bfhi(unsigned w) { return __uint_as_float(w & 0xffff0000u); }
DI unsigned pk2(float a, float b) { f32x2 v = {a, b}; return __builtin_bit_cast(unsigned, __builtin_convertvector(v, bf16x2_t)); }
DI float dot2bf(unsigned a, unsigned b, float c) { return __builtin_amdgcn_fdot2_f32_bf16(__builtin_bit_cast(bf16x2_t, a), __builtin_bit_cast(bf16x2_t, b), c, false); }
DI bf16_t f2bf(float a) { return (bf16_t)(pk2(a, 0.f) & 0xffffu); }
DI float dpp_xor1(float v) { return __builtin_bit_cast(float, __builtin_amdgcn_update_dpp(0, __builtin_bit_cast(int, v), 0xB1, 0xF, 0xF, true)); }
DI float dpp_xor2(float v) { return __builtin_bit_cast(float, __builtin_amdgcn_update_dpp(0, __builtin_bit_cast(int, v), 0x4E, 0xF, 0xF, true)); }
DI float wave_sum(float v) {
    v += dpp_xor1(v); v += dpp_xor2(v);
    v += __builtin_bit_cast(float, __builtin_amdgcn_update_dpp(0, __builtin_bit_cast(int, v), 0x141, 0xF, 0xF, true));
    v += __builtin_bit_cast(float, __builtin_amdgcn_update_dpp(0, __builtin_bit_cast(int, v), 0x140, 0xF, 0xF, true));
    v += __builtin_bit_cast(float, __builtin_amdgcn_update_dpp(0, __builtin_bit_cast(int, v), 0x142, 0xA, 0xF, false));
    v += __builtin_bit_cast(float, __builtin_amdgcn_update_dpp(0, __builtin_bit_cast(int, v), 0x143, 0xC, 0xF, false));
    return __builtin_bit_cast(float, __builtin_amdgcn_readlane(__builtin_bit_cast(int, v), 63));
}
DI float gelu_tanh(float x) {
    const float u = 0.7978845608028654f * (x + 0.044715f * x * x * x);
    const float e = __expf(2.f * u);
    const float t = 1.f - 2.f / (e + 1.f);
    return 0.5f * x * (1.f + t);
}
DI float wave_max(float v) {
    v = fmaxf(v, dpp_xor1(v)); v = fmaxf(v, dpp_xor2(v));
    v = fmaxf(v, __builtin_bit_cast(float, __builtin_amdgcn_update_dpp(0, __builtin_bit_cast(int, v), 0x141, 0xF, 0xF, true)));
    v = fmaxf(v, __builtin_bit_cast(float, __builtin_amdgcn_update_dpp(0, __builtin_bit_cast(int, v), 0x140, 0xF, 0xF, true)));
    v = fmaxf(v, __builtin_bit_cast(float, __builtin_amdgcn_update_dpp(0, __builtin_bit_cast(int, v), 0x142, 0xA, 0xF, false)));
    v = fmaxf(v, __builtin_bit_cast(float, __builtin_amdgcn_update_dpp(0, __builtin_bit_cast(int, v), 0x143, 0xC, 0xF, false)));
    return __builtin_bit_cast(float, __builtin_amdgcn_readlane(__builtin_bit_cast(int, v), 63));
}
DI f32x2 fp8x2_lo(unsigned w) { return __builtin_amdgcn_cvt_pk_f32_fp8((int)w, false); }
DI f32x2 fp8x2_hi(unsigned w) { return __builtin_amdgcn_cvt_pk_f32_fp8((int)w, true); }
DI unsigned pk_fp8x4(float a, float b, float c, float d) { int r = 0; r = __builtin_amdgcn_cvt_pk_fp8_f32(a, b, r, false); r = __builtin_amdgcn_cvt_pk_fp8_f32(c, d, r, true); return (unsigned)r; }
DI int lane_id() { return (int)__builtin_amdgcn_mbcnt_hi(~0u, __builtin_amdgcn_mbcnt_lo(~0u, 0u)); }
DI int cond_of(int T) { return T < TP ? 0 : 1 + ((T - TP) >> 12); }
#define XB_TMO      128
#define XB_XCNT(j)  (256  + 64 * (j))
#define XB_XSUB(j)  (1280 + 64 * (j))
#define XB_XGEN(j)  (2304 + 64 * (j))
#define XB_TOP      3328
#define XB_TOPGEN   3392
#define XCD_BAR_WORDS 3456
#define XB_SPIN_CAP (1u << 26)
#define LAS __attribute__((address_space(3)))

__device__ __forceinline__ unsigned xb_ld(unsigned* p)              { return __hip_atomic_load(p, __ATOMIC_RELAXED, __HIP_MEMORY_SCOPE_AGENT); }
__device__ __forceinline__ unsigned xb_add(unsigned* p, unsigned v) { return __hip_atomic_fetch_add(p, v, __ATOMIC_RELAXED, __HIP_MEMORY_SCOPE_AGENT); }
__device__ __forceinline__ unsigned xb_xcc_id() { return (unsigned)__builtin_amdgcn_s_getreg((3 << 11) | 20) & 0xFu; }
#define XB_SPIN(cond, bar) do { unsigned _sp = 0; while (cond) { __builtin_amdgcn_s_sleep(1); \
    if ((++_sp & 255u) == 0u) { if (xb_ld(&(bar)[XB_TMO])) break; if (_sp > XB_SPIN_CAP) { atomicAdd(&(bar)[XB_TMO], 1u); break; } } } } while (0)

struct XcdBarrier {
    unsigned* bar; unsigned x;
    volatile LAS unsigned* st;
};

__device__ __forceinline__ XcdBarrier xcd_barrier_post(unsigned* bar, volatile LAS unsigned* st) {
    XcdBarrier b; b.bar = bar; b.x = xb_xcc_id(); b.st = st;
    if (threadIdx.x == 0) (void)xb_add(&bar[XB_XCNT(b.x)], 1u);
    return b;
}
__device__ __forceinline__ void xcd_barrier_complete(unsigned* bar, unsigned x, unsigned& nloc, unsigned& nx) {
    const unsigned G = gridDim.x * gridDim.y * gridDim.z;
    unsigned sum, cnt, mine, sp = 0u;
    for (;;) {
        sum = 0u; cnt = 0u; mine = 0u;
#pragma unroll
        for (unsigned j = 0; j < 16; ++j) { const unsigned c = xb_ld(&bar[XB_XCNT(j)]); sum += c; cnt += (c > 0u) ? 1u : 0u; mine = (j == x) ? c : mine; }
        if (sum == G) break;
        __builtin_amdgcn_s_sleep(1);
        if ((++sp & 255u) == 0u) { if (xb_ld(&bar[XB_TMO])) break; if (sp > XB_SPIN_CAP) { atomicAdd(&bar[XB_TMO], 1u); break; } }
    }
    nloc = mine > 0u ? mine : 1u; nx = cnt > 0u ? cnt : 1u;
}

__device__ __forceinline__ void xcd_barrier(const XcdBarrier& b) {
    asm volatile("s_waitcnt vmcnt(0)" ::: "memory");
    __syncthreads();
    if (threadIdx.x == 0) {
        unsigned* bar = b.bar;
        __builtin_amdgcn_s_waitcnt(0);
        unsigned nloc = b.st[0], nx = b.st[1];
        if (nloc == 0u) { xcd_barrier_complete(bar, b.x, nloc, nx); b.st[0] = nloc; b.st[1] = nx; }
        const unsigned old = xb_add(&bar[XB_XSUB(b.x)], 1u);
        const unsigned gen = old / nloc;
        if (old + 1u == (gen + 1u) * nloc) {
            __builtin_amdgcn_fence(__ATOMIC_RELEASE, "agent");
            asm volatile("s_waitcnt vmcnt(0)" ::: "memory");
            const unsigned og = xb_add(&bar[XB_TOP], 1u);
            const unsigned tg = og / nx;
            if (og + 1u == (tg + 1u) * nx) xb_add(&bar[XB_TOPGEN], 1u);
            else XB_SPIN(xb_ld(&bar[XB_TOPGEN]) == tg, bar);
            __builtin_amdgcn_fence(__ATOMIC_ACQUIRE, "agent");
            xb_add(&bar[XB_XGEN(b.x)], 1u);
            asm volatile("s_waitcnt vmcnt(0)" ::: "memory");
        } else {
            XB_SPIN(xb_ld(&bar[XB_XGEN(b.x)]) == gen, bar);
            __builtin_amdgcn_fence(__ATOMIC_ACQUIRE, "agent");
            asm volatile("s_waitcnt vmcnt(0)" ::: "memory");
        }
    }
    __syncthreads();
}
namespace pg8 {
#define PG8_LAS __attribute__((address_space(3)))
typedef unsigned short bf16_t;
typedef short bf16x8 __attribute__((ext_vector_type(8)));
typedef float f32x4 __attribute__((ext_vector_type(4)));
typedef unsigned u32x4 __attribute__((ext_vector_type(4)));
constexpr int BM = 256, BK = 64, HALF = 128, HTB = HALF * BK * 2  , STAGE_BYTES = 8 * HTB, NXCD = 8, WGM = 8;

__host__ __device__ __forceinline__ int lds_byte(int r, int c) { const int st = (r >> 4) * 2 + (c >> 5), rr = r & 15, cc = c & 31, ob = rr * 64 + cc * 2; return st * 1024 + (ob ^ (((ob >> 9) & 1) << 5)); }
__host__ __device__ __forceinline__ void stage_rc(int b, int& R, int& C) { const int st = b / 1024, sb = b % 1024, swz = sb ^ (((sb >> 9) & 1) << 5); R = (st >> 1) * 16 + swz / 64; C = (st & 1) * 32 + (swz % 64) / 2; }
__host__ __device__ __forceinline__ int perm32(int rho) { const int n = rho >> 4, i = rho & 15; return 8 * (i >> 2) + 4 * n + (i & 3); }

struct Unit { int pm, pn; };
struct Gemm { const bf16_t* A; const bf16_t* Bt; int M, N, K; };

struct StaticOrder {
    int nM, nN, nwg, G, c;
    __host__ __device__ void init(int M, int N, int G_, int c_) { nM = M / BM; nN = N / BM; nwg = nM * nN; G = G_; c = c_; }
    __host__ __device__ bool next(int i, Unit& u) const {
        const long L = (long)i * G + c; if (L >= nwg) return false;
        int wgid = (int)L; { const int q = nwg / NXCD, r = nwg % NXCD, xcd = wgid % NXCD, off = wgid / NXCD; wgid = (xcd < r ? xcd * (q + 1) : r * (q + 1) + (xcd - r) * q) + off; }
        const int nig = WGM * nN, gid = wgid / nig, fm = gid * WGM, gsz = (nM - fm) < WGM ? (nM - fm) : WGM;
        u.pm = fm + ((wgid % nig) % gsz); u.pn = (wgid % nig) / gsz; return true;
    }
    __device__ __forceinline__ void a_ready(const Unit&) const {}
    __device__ __forceinline__ void done(const Unit&) const {}
};
__device__ __forceinline__ unsigned cvt_pk_bf16(float lo, float hi) { unsigned r; asm volatile("v_cvt_pk_bf16_f32 %0, %1, %2" : "=v"(r) : "v"(lo), "v"(hi)); return r; }
template <class Epi, class Sched, bool STAMP = false>
__device__ __forceinline__ void gemm_phase(PG8_LAS unsigned char* lds, const Gemm g, const Sched& S, const Epi& E, unsigned long long* stamps) {
    const int tid = threadIdx.x, wid = __builtin_amdgcn_readfirstlane(tid >> 6), lane = tid & 63, wr = wid >> 2, wc = wid & 3, fr = lane & 15, fq = lane >> 4;
    const int K = g.K, nt = K / BK;
    int ts_lo = 0, ts_hi = 0, nts = 0; const unsigned long long rt_entry = STAMP ? (unsigned long long)wall_clock64() : 0ull;
#define PG8_STAMP() do { if (STAMP && wid == 0 && nts < 64) { const unsigned long long _c = (unsigned long long)clock64(); \
        ts_lo = (lane == nts) ? (int)(unsigned)_c : ts_lo; ts_hi = (lane == nts) ? (int)(unsigned)(_c >> 32) : ts_hi; ++nts; } } while (0)
    PG8_STAMP();
    unsigned voffA[2], voffB[2];
#pragma unroll
    for (int i = 0; i < 2; ++i) { int R, C; stage_rc(tid * 16 + i * 8192, R, C); const int Rb = Epi::PERM ? ((R & ~31) + perm32(R & 31)) : R;
        voffA[i] = (unsigned)(R * K + C) * 2u; voffB[i] = (unsigned)(Rb * K + C) * 2u; }
    const size_t kstep = (size_t)(BK * 2);
    const size_t hstep = (size_t)HALF * K * 2;
    const size_t tstep = 2 * hstep;
    const unsigned ldsw = (unsigned)wid * 1024u;
    const int aoff = lds_byte(wr * 64 + fr, fq * 8), boff = lds_byte(wc * 32 + fr, fq * 8);
#define PG8_SA(b, h) (((b) * 2 + (h)) * HTB)
#define PG8_SB(b, h) ((4 + (b) * 2 + (h)) * HTB)
#define PG8_STAGE(bufoff, gbase, voff) do { _Pragma("unroll") for (int _i = 0; _i < 2; ++_i) \
        __builtin_amdgcn_global_load_lds((const unsigned*)((const char*)(gbase) + (voff)[_i]), (PG8_LAS unsigned*)(lds + (bufoff) + ldsw + _i * 8192), 16, 0, 0); } while (0)
#define PG8_LDA(dst, b, h) do { _Pragma("unroll") for (int m = 0; m < 4; ++m) _Pragma("unroll") for (int k = 0; k < 2; ++k) dst[m][k] = *(const PG8_LAS bf16x8*)(lds + PG8_SA(b, h) + aoff + m * 2048 + k * 1024); } while (0)
#define PG8_LDB(dst, b, h) do { _Pragma("unroll") for (int n = 0; n < 2; ++n) _Pragma("unroll") for (int k = 0; k < 2; ++k) dst[n][k] = *(const PG8_LAS bf16x8*)(lds + PG8_SB(b, h) + boff + n * 2048 + k * 1024); } while (0)
#define PG8_MMA(ai, bj, At, Bt) do { __builtin_amdgcn_s_setprio(1); _Pragma("unroll") for (int m = 0; m < 4; ++m) _Pragma("unroll") for (int n = 0; n < 2; ++n) _Pragma("unroll") for (int k = 0; k < 2; ++k) \
        acc[ai][bj][m][n] = __builtin_amdgcn_mfma_f32_16x16x32_bf16(Bt[n][k], At[m][k], acc[ai][bj][m][n], 0, 0, 0); __builtin_amdgcn_s_setprio(0); } while (0)
#define PG8_WAIT_V(n) asm volatile("s_waitcnt vmcnt(" #n ")" ::: "memory")
#define PG8_WAIT_L(n) asm volatile("s_waitcnt lgkmcnt(" #n ")" ::: "memory")
#define PG8_BAR __builtin_amdgcn_s_barrier()
#define PG8_SCHED __builtin_amdgcn_sched_barrier(0)
    Unit cur, nxt; int ui = 0;
    if (!S.next(0, cur)) return;
    f32x4 acc[2][2][4][2];
#pragma unroll
    for (int a = 0; a < 2; ++a)
#pragma unroll
        for (int b = 0; b < 2; ++b)
#pragma unroll
            for (int m = 0; m < 4; ++m)
#pragma unroll
                for (int n = 0; n < 2; ++n) acc[a][b][m][n] = (f32x4){0.f, 0.f, 0.f, 0.f};
    bf16x8 At[4][2], B0[2][2], B1[2][2];
    const char* cA = (const char*)g.A + (size_t)cur.pm * tstep; const char* cB = (const char*)g.Bt + (size_t)cur.pn * tstep;
    S.a_ready(cur);
    PG8_STAGE(PG8_SB(0, 0), cB, voffB); PG8_STAGE(PG8_SA(0, 0), cA, voffA); PG8_STAGE(PG8_SB(0, 1), cB + hstep, voffB); PG8_STAGE(PG8_SA(0, 1), cA + hstep, voffA);
    if (wr == 1) PG8_BAR;
    PG8_WAIT_V(4); PG8_BAR;
    PG8_STAGE(PG8_SB(1, 0), cB + kstep, voffB); PG8_STAGE(PG8_SA(1, 0), cA + kstep, voffA); PG8_STAGE(PG8_SB(1, 1), cB + hstep + kstep, voffB);
    PG8_WAIT_V(6); PG8_BAR;
    PG8_STAMP();
    for (;;) {
        const bool has_next = S.next(ui + 1, nxt);
        const char* nA = has_next ? (const char*)g.A + (size_t)nxt.pm * tstep : cA; const char* nB = has_next ? (const char*)g.Bt + (size_t)nxt.pn * tstep : cB;
        for (int t = 0; t < nt; t += 2) {
            const bool last = (t == nt - 2);
            const char* a1 = cA + (size_t)(t + 1) * kstep;
            const char* a2 = last ? nA : cA + (size_t)(t + 2) * kstep; const char* b2 = last ? nB : cB + (size_t)(t + 2) * kstep;
            const char* a3 = a2 + kstep; const char* b3 = b2 + kstep;
            if (last && has_next) S.a_ready(nxt);
            PG8_LDB(B0, 0, 0); PG8_SCHED; PG8_LDA(At, 0, 0); PG8_STAGE(PG8_SA(1, 1), a1 + hstep, voffA);
            PG8_WAIT_L(8); PG8_BAR; PG8_WAIT_L(0); PG8_MMA(0, 0, At, B0); PG8_BAR; PG8_SCHED;
            PG8_LDB(B1, 0, 1); PG8_STAGE(PG8_SB(0, 0), b2, voffB);
            PG8_BAR; PG8_WAIT_L(0); PG8_MMA(0, 1, At, B1); PG8_BAR;
            PG8_LDA(At, 0, 1); PG8_STAGE(PG8_SA(0, 0), a2, voffA);
            PG8_BAR; PG8_WAIT_L(0); PG8_MMA(1, 0, At, B0); PG8_BAR; PG8_SCHED;
            PG8_STAGE(PG8_SB(0, 1), b2 + hstep, voffB);
            PG8_WAIT_V(6); PG8_BAR; PG8_MMA(1, 1, At, B1); PG8_BAR;
            PG8_LDB(B0, 1, 0); PG8_SCHED; PG8_LDA(At, 1, 0); PG8_STAGE(PG8_SA(0, 1), a2 + hstep, voffA);
            PG8_WAIT_L(8); PG8_BAR; PG8_WAIT_L(0); PG8_MMA(0, 0, At, B0); PG8_BAR; PG8_SCHED;
            PG8_LDB(B1, 1, 1); PG8_STAGE(PG8_SB(1, 0), b3, voffB);
            PG8_BAR; PG8_WAIT_L(0); PG8_MMA(0, 1, At, B1); PG8_BAR;
            PG8_LDA(At, 1, 1); PG8_STAGE(PG8_SA(1, 0), a3, voffA);
            PG8_BAR; PG8_WAIT_L(0); PG8_MMA(1, 0, At, B0); PG8_BAR; PG8_SCHED;
            PG8_STAGE(PG8_SB(1, 1), b3 + hstep, voffB);
            PG8_WAIT_V(6); PG8_BAR; PG8_MMA(1, 1, At, B1); PG8_BAR;
        }
        PG8_STAMP();
        if constexpr (!Epi::AFTER_DRAIN) { E(acc, cur, wr, wc, fr, fq); S.done(cur); }
        PG8_STAMP();
        if (!has_next) break;
#pragma unroll
        for (int a = 0; a < 2; ++a)
#pragma unroll
            for (int b = 0; b < 2; ++b)
#pragma unroll
                for (int m = 0; m < 4; ++m)
#pragma unroll
                    for (int n = 0; n < 2; ++n) acc[a][b][m][n] = (f32x4){0.f, 0.f, 0.f, 0.f};
        cur = nxt; cA = nA; cB = nB; ++ui;
    }
    PG8_WAIT_V(0);
    if (wr == 0) PG8_BAR;
    PG8_BAR;
    if constexpr (Epi::AFTER_DRAIN) { E.fused(acc, cur, wr, wc, fr, fq, lds, wid, lane); S.done(cur); }
    PG8_STAMP();
    if (STAMP && wid == 0) { stamps[lane] = lane < nts ? (((unsigned long long)(unsigned)ts_hi << 32) | (unsigned)ts_lo) : 0ull;
        if (lane == 62) stamps[62] = rt_entry; if (lane == 63) stamps[63] = (unsigned long long)wall_clock64(); }
#undef PG8_STAMP
#undef PG8_SA
#undef PG8_SB
#undef PG8_STAGE
#undef PG8_LDA
#undef PG8_LDB
#undef PG8_MMA
#undef PG8_WAIT_V
#undef PG8_WAIT_L
#undef PG8_BAR
#undef PG8_SCHED
}
}
struct Ctx {
    LAS unsigned char* lds; int tid, lane, wave, G, bid;
};

DI void cvt_rows(const Ctx& F, const float* src, bf16_t* dst, size_t n) {
    const size_t n8 = n >> 3;
    for (size_t i = (size_t)F.bid * NTHR + F.tid; i < n8; i += (size_t)F.G * NTHR) {
        const f32x4 a = *(const f32x4*)(src + i * 8), b = *(const f32x4*)(src + i * 8 + 4);
        u32x4 w; w.x = pk2(a.x, a.y); w.y = pk2(a.z, a.w); w.z = pk2(b.x, b.y); w.w = pk2(b.z, b.w);
        *(u32x4*)(dst + i * 8) = w;
    }
}

DI void tr_tile_f32(const Ctx& F, const float* src, size_t lds_, bf16_t* dst, size_t ldd, LAS bf16_t* tile) {
#pragma unroll
    for (int j = 0; j < 2; ++j) {
        const int id = F.tid + NTHR * j, kr = id >> 4, nc = (id & 15) * 4;
        const f32x4 v = *(const f32x4*)(src + (size_t)kr * lds_ + nc);
        tile[(nc + 0) * 72 + kr] = f2bf(v.x); tile[(nc + 1) * 72 + kr] = f2bf(v.y); tile[(nc + 2) * 72 + kr] = f2bf(v.z); tile[(nc + 3) * 72 + kr] = f2bf(v.w);
    }
    __syncthreads();
    { const int n = F.tid >> 3, kc = (F.tid & 7) * 8; const u32x4 v = *(const LAS u32x4*)(tile + n * 72 + kc); *(u32x4*)(dst + (size_t)n * ldd + kc) = v; }
    __syncthreads();
}
DI void tr_tile_bf16(const Ctx& F, const bf16_t* src, size_t lds_, bf16_t* dst, size_t ldd, LAS bf16_t* tile) {
    { const int kr = F.tid >> 3, nc = (F.tid & 7) * 8; const u32x4 v = *(const u32x4*)(src + (size_t)kr * lds_ + nc);
      tile[(nc + 0) * 72 + kr] = (bf16_t)(v.x & 0xffff); tile[(nc + 1) * 72 + kr] = (bf16_t)(v.x >> 16); tile[(nc + 2) * 72 + kr] = (bf16_t)(v.y & 0xffff); tile[(nc + 3) * 72 + kr] = (bf16_t)(v.y >> 16);
      tile[(nc + 4) * 72 + kr] = (bf16_t)(v.z & 0xffff); tile[(nc + 5) * 72 + kr] = (bf16_t)(v.z >> 16); tile[(nc + 6) * 72 + kr] = (bf16_t)(v.w & 0xffff); tile[(nc + 7) * 72 + kr] = (bf16_t)(v.w >> 16); }
    __syncthreads();
    { const int n = F.tid >> 3, kc = (F.tid & 7) * 8; const u32x4 v = *(const LAS u32x4*)(tile + n * 72 + kc); *(u32x4*)(dst + (size_t)n * ldd + kc) = v; }
    __syncthreads();
}
DI void transpose_weight(const Ctx& F, const float* W, int K, int N, bf16_t* Wt) {
    const int tk = K / 64, tn = N / 64;
    for (int t = F.bid; t < tk * tn; t += F.G) {
        const int k0 = (t / tn) * 64, n0 = (t % tn) * 64;
        tr_tile_f32(F, W + (size_t)k0 * N + n0, (size_t)N, Wt + (size_t)n0 * K + k0, (size_t)K, (LAS bf16_t*)F.lds);
    }
}
DI void transpose_cache_v(const Ctx& F, const float* V, bf16_t* VT) {
    for (int t = F.bid; t < 64 * 8; t += F.G) {
        const int bh = t >> 3, sub = t & 7, k0 = (sub >> 1) * 64, d0 = (sub & 1) * 64, b = bh >> 3, h = bh & 7;
        tr_tile_f32(F, V + ((size_t)b * 256 + k0) * 1024 + h * 128 + d0, 1024, VT + ((size_t)bh * 128 + d0) * 256 + k0, 256, (LAS bf16_t*)F.lds);
    }
}

DI void adaln_partials(const Ctx& F, const Params& P) {
    LAS float* s = (LAS float*)F.lds;
    const float* modw = P.in[I_MODW]; const float* cv = P.in[I_C]; const float* cctx = P.in[I_CCTX];
    float* modp = (float*)(P.ws + WS_MODP);
    for (int it = F.bid; it < 192; it += F.G) {
        const int i = it / 96, r = it % 96, ks = r / 6, cg = r % 6;
        __syncthreads();
        for (int e = F.tid; e < 9 * 128; e += NTHR) { const int j = e >> 7, k = e & 127; const float c = (j == 0) ? cctx[ks * 128 + k] : cv[(j - 1) * 2048 + ks * 128 + k]; s[e] = c / (1.f + __expf(-c)); }
        __syncthreads();
        f32x4 acc[9];
#pragma unroll
        for (int j = 0; j < 9; ++j) acc[j] = (f32x4){0.f, 0.f, 0.f, 0.f};
        const float* w = modw + ((size_t)i * 2048 + ks * 128) * 12288 + cg * 2048 + F.tid * 4;
#pragma unroll 8
        for (int k = 0; k < 128; ++k) {
            const f32x4 w4 = *(const f32x4*)(w + (size_t)k * 12288);
#pragma unroll
            for (int j = 0; j < 9; ++j) acc[j] += w4 * s[j * 128 + k];
        }
#pragma unroll
        for (int j = 0; j < 9; ++j) *(f32x4*)(modp + ((size_t)(i * 16 + ks) * 9 + j) * 12288 + cg * 2048 + F.tid * 4) = acc[j];
    }
    __syncthreads();
}
DI void adaln_reduce(const Ctx& F, const Params& P) {
    const float* modp = (const float*)(P.ws + WS_MODP); float* mod = (float*)(P.ws + WS_MOD); const float* modb = P.in[I_MODB];
    for (int e = F.bid * NTHR + F.tid; e < 2 * 9 * 12288; e += F.G * NTHR) {
        const int i = e / (9 * 12288), r = e % (9 * 12288), j = r / 12288, n = r % 12288;
        float a = modb[i * 12288 + n];
#pragma unroll
        for (int ks = 0; ks < 16; ++ks) a += modp[((size_t)(i * 16 + ks) * 9 + j) * 12288 + n];
        mod[e] = a;
    }
}

DI void hyena_filters(const Ctx& F, const Params& P) {
    LAS float* z = (LAS float*)F.lds;
    LAS float* h1 = z + 320;
    LAS float* h2 = h1 + 576;
    const float* w1 = P.in[I_HYW1]; const float* b1 = P.in[I_HYB1]; const float* f1 = P.in[I_HYF1];
    const float* w2 = P.in[I_HYW2]; const float* b2 = P.in[I_HYB2]; const float* f2 = P.in[I_HYF2];
    const float* w3 = P.in[I_HYW3]; const float* dec = P.in[I_HYDEC];
    for (int it = F.bid; it < 544; it += F.G) {
        const bool smp = it < 512; const int L = smp ? LS : LP, p0 = (smp ? it : it - 512) * 8, RL = smp ? KRL_S : KRL_P;
        bf16_t* KR = (bf16_t*)(P.ws + (smp ? WS_KRS : WS_KRP));
        __syncthreads();
        if (F.tid < 9 * 33) {
            const int ps = F.tid / 33, k = F.tid % 33, i = p0 + ps;
            const float t = (float)i / (float)(L - 1), wang = 6.283185307179586f * (float)i / (float)L;
            float val;
            if (k == 0) val = t;
            else { const int f = (k - 1) & 15; const float fr = 1e-4f + (float)f * ((15.0f - 1e-4f) / 15.0f); val = (k <= 16) ? cosf(fr * wang) : -sinf(fr * wang); }
            z[F.tid] = val;
        }
        __syncthreads();
        for (int e = F.tid; e < 9 * 64; e += NTHR) { const int ps = e >> 6, j = e & 63; float a = b1[j];
            for (int k = 0; k < 33; ++k) a += z[ps * 33 + k] * w1[k * 64 + j];
            h1[e] = sinf(f1[j] * a); }
        __syncthreads();
        for (int e = F.tid; e < 9 * 64; e += NTHR) { const int ps = e >> 6, j = e & 63; float a = b2[j];
            for (int k = 0; k < 64; ++k) a += h1[ps * 64 + k] * w2[k * 64 + j];
            h2[e] = sinf(f2[j] * a); }
        __syncthreads();
#pragma unroll 1
        for (int qh = 0; qh < 2; ++qh) {
            float acc[9][4];
#pragma unroll
            for (int ps = 0; ps < 9; ++ps)
#pragma unroll
                for (int q = 0; q < 4; ++q) acc[ps][q] = 0.f;
#pragma unroll 2
            for (int k = 0; k < 64; ++k) {
                float w[4];
#pragma unroll
                for (int q = 0; q < 4; ++q) w[q] = w3[k * 4096 + F.tid + NTHR * (qh * 4 + q)];
#pragma unroll
                for (int ps = 0; ps < 9; ++ps) { const float hv = h2[ps * 64 + k];
#pragma unroll
                    for (int q = 0; q < 4; ++q) acc[ps][q] += hv * w[q]; }
            }
#pragma unroll
            for (int q = 0; q < 4; ++q) {
                const int n = F.tid + NTHR * (qh * 4 + q), o = (n >> 10) & 1, c = n & 1023;
                const float dc = fabsf(dec[n]);
                bf16_t* row = KR + (size_t)(o * 1024 + c) * RL;
                float v[9];
#pragma unroll
                for (int ps = 0; ps < 9; ++ps) { const int i = p0 + ps; v[ps] = (i < L) ? acc[ps][q] * __expf(-((float)i / (float)(L - 1)) * dc) : 0.f; }
                if (qh == 0) {
                    u32x4 wv; wv.x = pk2(v[8], v[7]); wv.y = pk2(v[6], v[5]); wv.z = pk2(v[4], v[3]); wv.w = pk2(v[2], v[1]);
                    *(u32x4*)(row + (L - p0 - 8)) = wv;
                    if (p0 == 0) row[L] = f2bf(v[0]);
                } else if (p0 > 0) {
                    u32x4 wv; wv.x = pk2(v[0], v[1]); wv.y = pk2(v[2], v[3]); wv.z = pk2(v[4], v[5]); wv.w = pk2(v[6], v[7]);
                    *(u32x4*)(row + (L + p0)) = wv;
                } else {
#pragma unroll
                    for (int ps = 1; ps < 8; ++ps) row[L + ps] = f2bf(v[ps]);
                }
            }
        }
    }
    __syncthreads();
    for (int e = F.bid * NTHR + F.tid; e < 2 * 2048; e += F.G * NTHR) {
        const bool smp = e < 2048; const int r = e & 2047, L = smp ? LS : LP, RL = smp ? KRL_S : KRL_P;
        bf16_t* row = (bf16_t*)(P.ws + (smp ? WS_KRS : WS_KRP)) + (size_t)r * RL;
        for (int x = 2 * L; x < RL; ++x) row[x] = 0;
    }
}

DI void s5_consts(const Ctx& F, const Params& P) {
    float* S5A = (float*)(P.ws + WS_S5A); bf16_t* BB = (bf16_t*)(P.ws + WS_S5BB); bf16_t* CC = (bf16_t*)(P.ws + WS_S5CC);
    const float* lre = P.in[I_S5LRE]; const float* lim = P.in[I_S5LIM]; const float* ldt = P.in[I_S5LDT];
    const float* bre = P.in[I_S5BRE]; const float* bim = P.in[I_S5BIM]; const float* cre = P.in[I_S5CRE]; const float* cim = P.in[I_S5CIM];
    for (int e = F.bid * NTHR + F.tid; e < 8192; e += F.G * NTHR) {
        const int dg = e >> 6, n = e & 63;
        const float dt = expf(ldt[dg]), lr = lre[e], li = lim[e];
        const float mag = expf(lr * dt), ar = mag * cosf(li * dt), ai = mag * sinf(li * dt), den = lr * lr + li * li;
        const float cr = ((ar - 1.f) * lr + ai * li) / den, ci = (ai * lr - (ar - 1.f) * li) / den;
        S5A[e * 2] = ar; S5A[e * 2 + 1] = ai;
#pragma unroll
        for (int p = 0; p < 16; ++p) {
            const float br = bre[(size_t)e * 16 + p], bi = bim[(size_t)e * 16 + p];
            BB[((size_t)dg * 128 + n) * 16 + p] = f2bf(cr * br - ci * bi);
            BB[((size_t)dg * 128 + 64 + n) * 16 + p] = f2bf(cr * bi + ci * br);
            CC[((size_t)dg * 16 + p) * 128 + n] = f2bf(cre[((size_t)dg * 16 + p) * 64 + n]);
            CC[((size_t)dg * 16 + p) * 128 + 64 + n] = f2bf(-cim[((size_t)dg * 16 + p) * 64 + n]);
        }
    }
}

constexpr int PT_ROWB = 1536;
DI void cvt_table_fp6(const Ctx& F, const float* src, unsigned char* dst, float* scales, const int (&perm)[32]) {
    LAS float* scr = (LAS float*)(F.lds) + F.tid * 32;
    for (int r = F.bid * 8 + F.wave; r < 16384; r += F.G * 8) {
        f32x4 v[8]; float m = 0.f;
#pragma unroll
        for (int j = 0; j < 8; ++j) { v[j] = *(const f32x4*)(src + (size_t)r * 2048 + F.lane * 32 + j * 4);
            m = fmaxf(m, fmaxf(fmaxf(fabsf(v[j].x), fabsf(v[j].y)), fmaxf(fabsf(v[j].z), fabsf(v[j].w)))); }
        m = wave_max(m);
        const float inv = (m > 0.f) ? 7.0f / m : 0.f, sc = (m > 0.f) ? m / 7.0f : 0.f;
#pragma unroll
        for (int j = 0; j < 8; ++j) { scr[perm[j * 4 + 0]] = v[j].x * inv; scr[perm[j * 4 + 1]] = v[j].y * inv; scr[perm[j * 4 + 2]] = v[j].z * inv; scr[perm[j * 4 + 3]] = v[j].w * inv; }
        asm volatile("" ::: "memory");
        f32x16 a, b;
#pragma unroll
        for (int i = 0; i < 16; ++i) { a[i] = scr[i]; b[i] = scr[16 + i]; }
        asm volatile("" ::: "memory");
        const u32x6 pk = __builtin_amdgcn_cvt_scalef32_2xpk16_fp6_f32(a, b, 1.0f);
        unsigned char* o = dst + (size_t)r * PT_ROWB;
        *(u32x4*)(o + F.lane * 16) = (u32x4){pk[0], pk[1], pk[2], pk[3]}; *(u32x2*)(o + 1024 + F.lane * 8) = (u32x2){pk[4], pk[5]};
        if (F.lane == 0) scales[r] = sc;
    }
}
DI void convert_peer_tables(const Ctx& F, const Params& P) {
    int perm[32];
    { f32x16 a, b;
#pragma unroll
      for (int j = 0; j < 16; ++j) { a[j] = 0.125f * (float)j; b[j] = (j < 8) ? 2.0f + 0.25f * (float)j : 4.0f + 0.5f * (float)(j - 8); }
      const u32x6 pk = __builtin_amdgcn_cvt_scalef32_2xpk16_fp6_f32(a, b, 1.0f);
      const f32x32 rt = __builtin_amdgcn_cvt_scalef32_pk32_f32_fp6(pk, 1.0f);
#pragma unroll
      for (int i = 0; i < 32; ++i) { const float x = rt[i]; const int o = (x < 2.0f) ? (int)(x * 8.0f + 0.5f) : ((x < 4.0f) ? 16 + (int)((x - 2.0f) * 4.0f + 0.5f) : 24 + (int)((x - 4.0f) * 2.0f + 0.5f)); perm[i] = min(max(o, 0), 31); } }
    float* SC = (float*)(P.ws + WS_SC);
    __syncthreads();
    for (int layer = 0; layer < 2; ++layer) {
        cvt_table_fp6(F, P.in[I_PU] + (size_t)layer * 16384 * 2048, P.ws + WS_TBLU + (size_t)layer * 16384 * PT_ROWB, SC + layer * 16384, perm);
        cvt_table_fp6(F, P.in[I_PV] + (size_t)layer * 16384 * 2048, P.ws + WS_TBLV + (size_t)layer * 16384 * PT_ROWB, SC + (2 + layer) * 16384, perm);
    }
    __syncthreads();
}

DI void prologue(const Ctx& F, const Params& P) {
    adaln_partials(F, P);
    transpose_weight(F, P.in[I_EVWIN], 2048, 6144, (bf16_t*)(P.ws + WS_WEVIN));
    transpose_weight(F, P.in[I_EVWOUT], 2048, 2048, (bf16_t*)(P.ws + WS_WEVOUT));
    transpose_weight(F, P.in[I_ODWIN], 2048, 4096, (bf16_t*)(P.ws + WS_WODIN));
    transpose_weight(F, P.in[I_ODWOUT], 2048, 2048, (bf16_t*)(P.ws + WS_WODOUT));
    transpose_weight(F, P.in[I_PWQ], 2048, 2048, (bf16_t*)(P.ws + WS_WPQ));
    transpose_weight(F, P.in[I_PWQ] + (size_t)2048 * 2048, 2048, 2048, (bf16_t*)(P.ws + WS_WPQ) + (size_t)2048 * 2048);
    transpose_weight(F, P.in[I_GLUW], 1024, 1024, (bf16_t*)(P.ws + WS_WGLU));
    cvt_rows(F, P.in[I_PKEYS], (bf16_t*)(P.ws + WS_PKEYS), (size_t)2 * 8 * 2 * 128 * 128);
    cvt_rows(F, P.in[I_CNK], (bf16_t*)(P.ws + WS_CNK), (size_t)8 * 256 * 1024);
    cvt_rows(F, P.in[I_CDK], (bf16_t*)(P.ws + WS_CDK), (size_t)8 * 256 * 1024);
    transpose_cache_v(F, P.in[I_CNV], (bf16_t*)(P.ws + WS_CNVT));
    transpose_cache_v(F, P.in[I_CDV], (bf16_t*)(P.ws + WS_CDVT));
    hyena_filters(F, P);
    s5_consts(F, P);
    convert_peer_tables(F, P);
}
DI void norm_phase(const Ctx& F, const float* xa, const float* xb, const float* gvec, const float* modl, int sidx, bf16_t* H) {
    for (int T = F.bid * 8 + F.wave; T < TOK; T += F.G * 8) {
        const float* xr = T < TP ? xa + (size_t)T * DM : xb + (size_t)(T - TP) * DM;
        f32x4 v[8]; float ss = 0.f;
#pragma unroll
        for (int j = 0; j < 8; ++j) { v[j] = *(const f32x4*)(xr + (j * 64 + F.lane) * 4); ss += v[j].x * v[j].x + v[j].y * v[j].y + v[j].z * v[j].z + v[j].w * v[j].w; }
        ss = wave_sum(ss);
        const float rstd = rsqrtf(ss * (1.f / DM) + NORM_EPS);
        const float* sh = modl + (size_t)(cond_of(T) * 6 + sidx) * DM; const float* sc = sh + DM;
#pragma unroll
        for (int j = 0; j < 8; ++j) {
            const int col = (j * 64 + F.lane) * 4;
            const f32x4 g4 = *(const f32x4*)(gvec + col), s4 = *(const f32x4*)(sc + col), h4 = *(const f32x4*)(sh + col);
            const f32x4 o = v[j] * rstd * g4 * (s4 + 1.f) + h4;
            u32x2 w; w.x = pk2(o.x, o.y); w.y = pk2(o.z, o.w);
            *(u32x2*)(H + (size_t)T * DM + col) = w;
        }
    }
}

struct EpiBf16 {
    static constexpr bool PERM = true, AFTER_DRAIN = false;
    bf16_t* O; int ldc;
    DI void operator()(const f32x4 (&acc)[2][2][4][2], const pg8::Unit& u, int wr, int wc, int fr, int fq) const {
        const int row0 = u.pm * 256 + wr * 64 + fr, col0 = u.pn * 256 + wc * 32 + 8 * fq;
#pragma unroll
        for (int ai = 0; ai < 2; ++ai)
#pragma unroll
            for (int m = 0; m < 4; ++m) { bf16_t* rowp = O + (size_t)(row0 + ai * 128 + m * 16) * ldc + col0;
#pragma unroll
                for (int bj = 0; bj < 2; ++bj) { const f32x4 v0 = acc[ai][bj][m][0], v1 = acc[ai][bj][m][1];
                    u32x4 w; w.x = pk2(v0[0], v0[1]); w.y = pk2(v0[2], v0[3]); w.z = pk2(v1[0], v1[1]); w.w = pk2(v1[2], v1[3]);
                    *(u32x4*)(rowp + bj * 128) = w; } }
    }
};
struct EpiResid {
    static constexpr bool PERM = false, AFTER_DRAIN = false;
    const float* xa; const float* xb; float* out; const float* modl; int gidx;
    DI void operator()(const f32x4 (&acc)[2][2][4][2], const pg8::Unit& u, int wr, int wc, int fr, int fq) const {
        const int row0 = u.pm * 256 + wr * 64 + fr, col0 = u.pn * 256 + wc * 32 + 4 * fq;
        const float* xbase = (u.pm < 32) ? xa : xb - (size_t)TP * DM;
        const float* gate = modl + (size_t)(cond_of(u.pm * 256) * 6 + gidx) * DM;
        f32x4 gv[2][2];
#pragma unroll
        for (int bj = 0; bj < 2; ++bj)
#pragma unroll
            for (int n = 0; n < 2; ++n) gv[bj][n] = *(const f32x4*)(gate + col0 + bj * 128 + n * 16);
#pragma unroll
        for (int ai = 0; ai < 2; ++ai)
#pragma unroll
            for (int m = 0; m < 4; ++m) { const size_t ro = (size_t)(row0 + ai * 128 + m * 16) * DM + col0;
#pragma unroll
                for (int bj = 0; bj < 2; ++bj)
#pragma unroll
                    for (int n = 0; n < 2; ++n) { const f32x4 x4 = *(const f32x4*)(xbase + ro + bj * 128 + n * 16);
                        *(f32x4*)(out + ro + bj * 128 + n * 16) = x4 + gv[bj][n] * acc[ai][bj][m][n]; } }
    }
};
struct EpiGlu {
    static constexpr bool PERM = true, AFTER_DRAIN = false;
    const bf16_t* Y; bf16_t* O; const float* bias;
    DI void operator()(const f32x4 (&acc)[2][2][4][2], const pg8::Unit& u, int wr, int wc, int fr, int fq) const {
        const int row0 = u.pm * 256 + wr * 64 + fr, col0 = u.pn * 256 + wc * 32 + 8 * fq;
#pragma unroll
        for (int bj = 0; bj < 2; ++bj) {
            const f32x4 b0 = *(const f32x4*)(bias + col0 + bj * 128), b1 = *(const f32x4*)(bias + col0 + bj * 128 + 4);
#pragma unroll
            for (int ai = 0; ai < 2; ++ai)
#pragma unroll
                for (int m = 0; m < 4; ++m) { const size_t r = (size_t)(row0 + ai * 128 + m * 16);
                    const u32x4 yv = *(const u32x4*)(Y + r * 1024 + col0 + bj * 128);
                    const f32x4 a0 = acc[ai][bj][m][0] + b0, a1 = acc[ai][bj][m][1] + b1;
                    float o[8];
                    o[0] = bflo(yv.x) / (1.f + __expf(-a0[0])); o[1] = bfhi(yv.x) / (1.f + __expf(-a0[1]));
                    o[2] = bflo(yv.y) / (1.f + __expf(-a0[2])); o[3] = bfhi(yv.y) / (1.f + __expf(-a0[3]));
                    o[4] = bflo(yv.z) / (1.f + __expf(-a1[0])); o[5] = bfhi(yv.z) / (1.f + __expf(-a1[1]));
                    o[6] = bflo(yv.w) / (1.f + __expf(-a1[2])); o[7] = bfhi(yv.w) / (1.f + __expf(-a1[3]));
                    u32x4 w; w.x = pk2(o[0], o[1]); w.y = pk2(o[2], o[3]); w.z = pk2(o[4], o[5]); w.w = pk2(o[6], o[7]);
                    *(u32x4*)(O + r * DM + col0 + bj * 128) = w; }
        }
    }
};
template <class Epi> DI void run_gemm(const Ctx& F, const bf16_t* A, const bf16_t* Bt, int N, int K, const Epi& E) {
    pg8::Gemm g{A, Bt, TOK, N, K}; pg8::StaticOrder S; S.init(TOK, N, F.G, F.bid);
    pg8::gemm_phase<Epi, pg8::StaticOrder, false>(F.lds, g, S, E, nullptr);
    __syncthreads();
}

DI void prep_a(const Ctx& F, const Params& P) {
    const bf16_t* T1 = (const bf16_t*)(P.ws + WS_RA);
    bf16_t* VTp = (bf16_t*)(P.ws + WS_VT); bf16_t* VTs = (bf16_t*)(P.ws + WS_VT + VT_S);
    for (int t = F.bid; t < 2048 + 8192; t += F.G) {
        if (t < 2048) { const int bh = t >> 3, sub = t & 7, tk = sub >> 1, dd = sub & 1, b = bh >> 3, h = bh & 7;
            tr_tile_bf16(F, T1 + ((size_t)(b * 256 + tk * 64)) * 4096 + h * 128 + dd * 64, 4096, VTp + ((size_t)bh * 128 + dd * 64) * 256 + tk * 64, 256, (LAS bf16_t*)F.lds); }
        else { const int u = t - 2048, bh = u >> 7, sub = u & 127, tk = sub >> 1, dd = sub & 1, b = bh >> 3, h = bh & 7;
            tr_tile_bf16(F, T1 + ((size_t)(TP + b * 4096 + tk * 64)) * 4096 + h * 128 + dd * 64, 4096, VTs + ((size_t)bh * 128 + dd * 64) * 4096 + tk * 64, 4096, (LAS bf16_t*)F.lds); }
    }
    { float* o = P.out + O_NAV;
      for (int e = F.bid * NTHR + F.tid; e < TP * 128; e += F.G * NTHR) { const int T = e >> 7, c8 = (e & 127) * 8;
          const u32x4 v = *(const u32x4*)(T1 + (size_t)T * 4096 + c8);
          *(f32x4*)(o + (size_t)T * 1024 + c8) = (f32x4){bflo(v.x), bfhi(v.x), bflo(v.y), bfhi(v.y)};
          *(f32x4*)(o + (size_t)T * 1024 + c8 + 4) = (f32x4){bflo(v.z), bfhi(v.z), bflo(v.w), bfhi(v.w)}; } }
    { LAS bf16_t* tl = (LAS bf16_t*)F.lds;
      bf16_t* CM = (bf16_t*)(P.ws + WS_RB);
      const float* cw = P.in[I_HYCW]; const float* cb = P.in[I_HYCB];
      for (int t = F.bid; t < 48 * 160; t += F.G) {
          const int cg = t % 48, tg = t / 48, ch0 = cg * 64, t0 = tg * 256;
          const bool lz = (t0 < TP) ? true : (((t0 - TP) & 4095) == 0);
          const bool rz = (t0 < TP) ? true : (((t0 + 256 - TP) & 4095) == 0);
          __syncthreads();
#pragma unroll
          for (int j = 0; j < 4; ++j) { const int id = F.tid + NTHR * j, tk = id >> 3, c8 = (id & 7) * 8;
              const u32x4 v = *(const u32x4*)(T1 + (size_t)(t0 + tk) * 4096 + 1024 + ch0 + c8);
              LAS bf16_t* d = tl + tk + 1;
              d[(c8 + 0) * 264] = (bf16_t)(v.x & 0xffff); d[(c8 + 1) * 264] = (bf16_t)(v.x >> 16); d[(c8 + 2) * 264] = (bf16_t)(v.y & 0xffff); d[(c8 + 3) * 264] = (bf16_t)(v.y >> 16);
              d[(c8 + 4) * 264] = (bf16_t)(v.z & 0xffff); d[(c8 + 5) * 264] = (bf16_t)(v.z >> 16); d[(c8 + 6) * 264] = (bf16_t)(v.w & 0xffff); d[(c8 + 7) * 264] = (bf16_t)(v.w >> 16); }
          if (F.tid < 16) { const int side = F.tid >> 3, c8 = (F.tid & 7) * 8; const bool zero = side ? rz : lz; const int tk = side ? t0 + 256 : t0 - 1;
              u32x4 v = (u32x4){0u, 0u, 0u, 0u};
              if (!zero) v = *(const u32x4*)(T1 + (size_t)tk * 4096 + 1024 + ch0 + c8);
              LAS bf16_t* d = tl + (side ? 257 : 0);
              d[(c8 + 0) * 264] = (bf16_t)(v.x & 0xffff); d[(c8 + 1) * 264] = (bf16_t)(v.x >> 16); d[(c8 + 2) * 264] = (bf16_t)(v.y & 0xffff); d[(c8 + 3) * 264] = (bf16_t)(v.y >> 16);
              d[(c8 + 4) * 264] = (bf16_t)(v.z & 0xffff); d[(c8 + 5) * 264] = (bf16_t)(v.z >> 16); d[(c8 + 6) * 264] = (bf16_t)(v.w & 0xffff); d[(c8 + 7) * 264] = (bf16_t)(v.w >> 16); }
          __syncthreads();
#pragma unroll
          for (int j = 0; j < 4; ++j) { const int id = F.tid + NTHR * j, ch = id >> 5, to = (id & 31) * 8, cgl = ch0 + ch;
              const float w0 = cw[cgl], w1 = cw[3072 + cgl], w2 = cw[6144 + cgl], bb = cb[cgl];
              const LAS bf16_t* s = tl + ch * 264 + to;
              float r[10];
#pragma unroll
              for (int i = 0; i < 10; ++i) r[i] = bf2f(s[i]);
              float o[8];
#pragma unroll
              for (int i = 0; i < 8; ++i) o[i] = w0 * r[i] + w1 * r[i + 1] + w2 * r[i + 2] + bb;
              u32x4 w; w.x = pk2(o[0], o[1]); w.y = pk2(o[2], o[3]); w.z = pk2(o[4], o[5]); w.w = pk2(o[6], o[7]);
              *(u32x4*)(CM + (size_t)cgl * TOK + t0 + to) = w; }
      }
      __syncthreads(); }
}

DI void prep_b(const Ctx& F, const Params& P) {
    bf16_t* Pq = (bf16_t*)(P.ws + WS_RA); const float* qg = P.in[I_NAQG]; const float* kg = P.in[I_NAKG]; float* ok = P.out + O_NAK;
    const float* gsrc = (F.lane < 32 ? qg : kg) + (F.lane & 3) * 32;
    float g[32];
#pragma unroll
    for (int i = 0; i < 32; ++i) g[i] = gsrc[i];
    for (int T = F.bid * 8 + F.wave; T < TOK; T += F.G * 8) {
        bf16_t* rp = Pq + (size_t)T * 2048 + F.lane * 32;
        u32x4 v[4]; float x[32]; float ss = 0.f;
#pragma unroll
        for (int j = 0; j < 4; ++j) { v[j] = *(const u32x4*)(rp + j * 8);
            x[j * 8 + 0] = bflo(v[j].x); x[j * 8 + 1] = bfhi(v[j].x); x[j * 8 + 2] = bflo(v[j].y); x[j * 8 + 3] = bfhi(v[j].y);
            x[j * 8 + 4] = bflo(v[j].z); x[j * 8 + 5] = bfhi(v[j].z); x[j * 8 + 6] = bflo(v[j].w); x[j * 8 + 7] = bfhi(v[j].w); }
#pragma unroll
        for (int i = 0; i < 32; ++i) ss += x[i] * x[i];
        ss += dpp_xor1(ss); ss += dpp_xor2(ss);
        const float rstd = rsqrtf(ss * (1.f / 128.f) + NORM_EPS);
#pragma unroll
        for (int i = 0; i < 32; ++i) x[i] = x[i] * rstd * g[i];
#pragma unroll
        for (int j = 0; j < 4; ++j) { u32x4 w; w.x = pk2(x[j * 8 + 0], x[j * 8 + 1]); w.y = pk2(x[j * 8 + 2], x[j * 8 + 3]); w.z = pk2(x[j * 8 + 4], x[j * 8 + 5]); w.w = pk2(x[j * 8 + 6], x[j * 8 + 7]);
            *(u32x4*)(rp + j * 8) = w; }
        if (T < TP && F.lane >= 32) { float* o = ok + (size_t)T * 1024 + (F.lane - 32) * 32;
#pragma unroll
            for (int j = 0; j < 8; ++j) *(f32x4*)(o + j * 4) = (f32x4){x[j * 4], x[j * 4 + 1], x[j * 4 + 2], x[j * 4 + 3]}; }
    }
}
constexpr int AT_KROW = 272, AT_VROW = 136, AT_KTB = 64 * AT_KROW, AT_VTB = 128 * AT_VROW;
constexpr int AT_K0 = 0, AT_V0 = 2 * AT_KTB, AT_RPB = AT_V0 + 2 * AT_VTB;

struct TileMap { const bf16_t* latK; int latKld; const bf16_t* latV; int latVld; int nlat; const bf16_t* ctxK; const bf16_t* ctxV; int ntiles; };
struct TileRegs { u32x4 k[2], v[2]; };

DI void tile_src(const TileMap& M, int j, const bf16_t*& kp, int& kld, const bf16_t*& vp, int& vld) {
    if (j < M.nlat) { kp = M.latK + (size_t)j * 64 * M.latKld; kld = M.latKld; vp = M.latV + j * 64; vld = M.latVld; }
    else { const int c = j - M.nlat; kp = M.ctxK + (size_t)c * 64 * 1024; kld = 1024; vp = M.ctxV + c * 64; vld = 256; }
}
DI void tile_load(const Ctx& F, TileRegs& R, const bf16_t* kp, int kld, const bf16_t* vp, int vld, bool withV = true) {
#pragma unroll
    for (int j = 0; j < 2; ++j) { const int id = F.tid + NTHR * j;
        const unsigned ko = (unsigned)((id >> 4) * kld + (id & 15) * 8) * 2u, vo = (unsigned)((id >> 3) * vld + (id & 7) * 8) * 2u;
        R.k[j] = *(const u32x4*)((const char*)kp + ko);
        if (withV) R.v[j] = *(const u32x4*)((const char*)vp + vo); }
}
DI void tile_store(const Ctx& F, const TileRegs& R, LAS unsigned char* kt, LAS unsigned char* vt, bool withV = true) {
#pragma unroll
    for (int j = 0; j < 2; ++j) { const int id = F.tid + NTHR * j;
        *(LAS u32x4*)(kt + (id >> 4) * AT_KROW + (id & 15) * 16) = R.k[j];
        if (withV) { LAS unsigned char* vp = vt + (id >> 3) * AT_VROW + (id & 7) * 16;
            *(LAS u32x2*)(vp) = (u32x2){R.v[j].x, R.v[j].y}; *(LAS u32x2*)(vp + 8) = (u32x2){R.v[j].z, R.v[j].w}; } }
}

DI void tile_norm_k(const Ctx& F, TileRegs& R, const LAS float* kgain, float* nk, int nkld) {
#pragma unroll
    for (int j = 0; j < 2; ++j) { const int id = F.tid + NTHR * j;
        float x[8] = {bflo(R.k[j].x), bfhi(R.k[j].x), bflo(R.k[j].y), bfhi(R.k[j].y), bflo(R.k[j].z), bfhi(R.k[j].z), bflo(R.k[j].w), bfhi(R.k[j].w)};
        float ss = 0.f;
#pragma unroll
        for (int i = 0; i < 8; ++i) ss += x[i] * x[i];
        ss += dpp_xor1(ss); ss += dpp_xor2(ss);
        ss += __builtin_bit_cast(float, __builtin_amdgcn_update_dpp(0, __builtin_bit_cast(int, ss), 0x141, 0xF, 0xF, true));
        ss += __builtin_bit_cast(float, __builtin_amdgcn_update_dpp(0, __builtin_bit_cast(int, ss), 0x140, 0xF, 0xF, true));
        const float rstd = rsqrtf(ss * (1.f / 128.f) + NORM_EPS);
        const f32x4 g0 = *(const LAS f32x4*)(kgain + (id & 15) * 8), g1 = *(const LAS f32x4*)(kgain + (id & 15) * 8 + 4);
        x[0] *= rstd * g0.x; x[1] *= rstd * g0.y; x[2] *= rstd * g0.z; x[3] *= rstd * g0.w; x[4] *= rstd * g1.x; x[5] *= rstd * g1.y; x[6] *= rstd * g1.z; x[7] *= rstd * g1.w;
        R.k[j] = (u32x4){pk2(x[0], x[1]), pk2(x[2], x[3]), pk2(x[4], x[5]), pk2(x[6], x[7])};
        if (nk) { float* o = nk + (size_t)(id >> 4) * nkld + (id & 15) * 8; *(f32x4*)(o) = (f32x4){x[0], x[1], x[2], x[3]}; *(f32x4*)(o + 4) = (f32x4){x[4], x[5], x[6], x[7]}; }
    }
}

template <int KS>
DI f32x16 qk_tile(LAS const unsigned char* kt, const bf16x8 (&Qf)[8], int kb, int kk0, int q, int hh) {
    f32x16 S;
#pragma unroll
    for (int i = 0; i < 16; ++i) S[i] = 0.f;
#pragma unroll
    for (int ks = 0; ks < KS; ++ks) { const int kk = kk0 + ks;
        const bf16x8 A = *(const LAS bf16x8*)(kt + (kb * 32 + q) * AT_KROW + (kk * 16 + hh * 8) * 2);
        S = __builtin_amdgcn_mfma_f32_32x32x16_bf16(A, Qf[kk], S, 0, 0, 0); }
    return S;
}
DI void pv_tile(LAS const unsigned char* vt, const float (&p)[16], f32x16 (&O)[4], int kb, int q, int hh) {
#pragma unroll
    for (int s = 0; s < 2; ++s) {
        u32x4 pw; pw.x = pk2(p[8 * s + 0], p[8 * s + 1]); pw.y = pk2(p[8 * s + 2], p[8 * s + 3]); pw.z = pk2(p[8 * s + 4], p[8 * s + 5]); pw.w = pk2(p[8 * s + 6], p[8 * s + 7]);
        const bf16x8 Pf = __builtin_bit_cast(bf16x8, pw);
#pragma unroll
        for (int db = 0; db < 4; ++db) {
            LAS const unsigned char* ap = vt + (db * 32 + q) * AT_VROW + (kb * 32 + 16 * s + 4 * hh) * 2;
            const u32x2 lo = *(const LAS u32x2*)(ap), hi = *(const LAS u32x2*)(ap + 16);
            const bf16x8 A2 = __builtin_bit_cast(bf16x8, (u32x4){lo.x, lo.y, hi.x, hi.y});
            O[db] = __builtin_amdgcn_mfma_f32_32x32x16_bf16(A2, Pf, O[db], 0, 0, 0);
        }
        asm volatile("" ::: "memory");
    }
}
template <bool LAT>
DI void attn_compute1(LAS const unsigned char* kt, LAS const unsigned char* vt, const bf16x8 (&Qf)[8], f32x16 (&O)[4], float& ls, int lane, const LAS float* brow, int cq) {
    const int q = lane & 31, hh = lane >> 5;
    const int cs = min(max(cq - 8, 0), 48);
#pragma unroll 1
    for (int kb = 0; kb < 2; ++kb) {
        const f32x16 S = qk_tile<8>(kt, Qf, kb, 0, q, hh);
        float p[16];
#pragma unroll
        for (int i = 0; i < 16; ++i) {
            float arg = S[i];
            if (LAT) { const int ck = kb * 32 + (i & 3) + 8 * (i >> 2) + 4 * hh;
                arg += brow[min(max(ck - cq + 15, 0), 30)];
                p[i] = ((unsigned)(ck - cs) < 16u) ? __builtin_amdgcn_exp2f(arg) : 0.f; }
            else p[i] = __builtin_amdgcn_exp2f(arg);
            ls += p[i];
        }
        pv_tile(vt, p, O, kb, q, hh);
    }
}
DI void diff_pass1(LAS const unsigned char* kt, const bf16x8 (&Qf)[8], float (&ls)[2], int lane) {
    const int q = lane & 31, hh = lane >> 5;
#pragma unroll
    for (int kb = 0; kb < 2; ++kb) {
#pragma unroll
        for (int mp = 0; mp < 2; ++mp) { const f32x16 S = qk_tile<4>(kt, Qf, kb, mp * 4, q, hh);
#pragma unroll
            for (int i = 0; i < 16; ++i) ls[mp] += __builtin_amdgcn_exp2f(S[i]); }
    }
}
DI void diff_pass2(LAS const unsigned char* kt, LAS const unsigned char* vt, const bf16x8 (&Qf)[8], f32x16 (&O)[4], float w0, float w1, int lane) {
    const int q = lane & 31, hh = lane >> 5;
#pragma unroll
    for (int kb = 0; kb < 2; ++kb) {
        float p[16];
        { const f32x16 S0 = qk_tile<4>(kt, Qf, kb, 0, q, hh);
#pragma unroll
          for (int i = 0; i < 16; ++i) p[i] = __builtin_amdgcn_exp2f(S0[i]) * w0; }
        { const f32x16 S1 = qk_tile<4>(kt, Qf, kb, 4, q, hh);
#pragma unroll
          for (int i = 0; i < 16; ++i) p[i] -= __builtin_amdgcn_exp2f(S1[i]) * w1; }
        pv_tile(vt, p, O, kb, q, hh);
    }
}

template <int MODE>
DI void attn_phase(const Ctx& F, const Params& P) {
    constexpr bool DIFF = (MODE >= 2);
    constexpr bool NA = (MODE == 1);
    LAS unsigned char* lds = F.lds;
    LAS float* rpbl = (LAS float*)(lds + AT_RPB);
    LAS float* kgl = (LAS float*)(lds + AT_RPB + 2048);
    if (!DIFF) { __syncthreads(); if (F.tid < 128) kgl[F.tid] = P.in[I_NAKG][F.tid]; __syncthreads(); }
    const bf16_t* PA = (const bf16_t*)(P.ws + WS_RA);
    bf16_t* MIX = (bf16_t*)(P.ws + WS_HM);
    const bf16_t* VTp = (const bf16_t*)(P.ws + WS_VT); const bf16_t* VTs = (const bf16_t*)(P.ws + WS_VT + VT_S);
    const int q = F.lane & 31, hh = F.lane >> 5;
    const float c1 = (DIFF ? 0.125f : 0.08838834764831845f) * LOG2E;
    float lam = 0.f;
    if (DIFF) {
        const float a = wave_sum(P.in[I_LQ1][F.lane] * P.in[I_LK1][F.lane]), b = wave_sum(P.in[I_LQ2][F.lane] * P.in[I_LK2][F.lane]);
        lam = __expf(a) - __expf(b) + 0.35550906759096924f;
    }
    const int nunits = (MODE == 0 || MODE == 2) ? 256 : 1024;
    for (int u0 = F.bid; u0 < nunits; u0 += F.G) {
        int u = u0;
        if ((MODE == 1 || MODE == 3) && F.G == 256) { const int i = u0 >> 8, x = F.bid & 7, y = F.bid >> 3; u = ((2 * i + (y >> 4)) * 8 + x) * 16 + (y & 15); }
        int b, h, tok0, r = 0, rlo = 0; TileMap M;
        const bf16_t* qptr;
        if (MODE == 0) { b = u >> 3; h = u & 7; tok0 = b * 256 + F.wave * 32;
            qptr = PA + (size_t)(tok0 + q) * 2048 + h * 128;
            M.latK = PA + (size_t)(b * 256) * 2048 + 1024 + h * 128; M.latKld = 2048; M.latV = VTp + (size_t)(b * 8 + h) * 128 * 256; M.latVld = 256; M.nlat = 4; M.ctxK = nullptr; M.ctxV = nullptr; M.ntiles = 4; }
        else if (MODE == 1) { b = u >> 7; h = (u >> 4) & 7; const int rg = u & 15; r = 4 * rg + (F.wave >> 1);
            rlo = min(max(4 * rg - 4, 0), 56); const int rhi = min(max(4 * rg + 3 - 4, 0), 56) + 8;
            tok0 = TP + b * 4096 + r * 64 + (F.wave & 1) * 32;
            qptr = PA + (size_t)(tok0 + q) * 2048 + h * 128;
            M.latK = PA + (size_t)(TP + b * 4096 + rlo * 64) * 2048 + 1024 + h * 128; M.latKld = 2048; M.latV = VTs + (size_t)(b * 8 + h) * 128 * 4096 + rlo * 64; M.latVld = 4096; M.nlat = rhi - rlo;
            M.ctxK = (const bf16_t*)(P.ws + WS_CNK) + (size_t)b * 256 * 1024 + h * 128; M.ctxV = (const bf16_t*)(P.ws + WS_CNVT) + (size_t)(b * 8 + h) * 128 * 256; M.ntiles = M.nlat + 4;
            if (F.tid < 465) rpbl[F.tid] = P.in[I_RPB][h * 465 + F.tid] * LOG2E; }
        else if (MODE == 2) { b = u >> 3; h = u & 7; tok0 = b * 256 + F.wave * 32;
            qptr = PA + (size_t)(tok0 + q) * 4096 + 1024 + h * 128;
            M.latK = PA + (size_t)(b * 256) * 4096 + 2048 + h * 128; M.latKld = 4096; M.latV = VTp + (size_t)(b * 8 + h) * 128 * 256; M.latVld = 256; M.nlat = 4; M.ctxK = nullptr; M.ctxV = nullptr; M.ntiles = 4; }
        else { b = u >> 7; h = (u >> 4) & 7; const int qb = u & 15; tok0 = TP + b * 4096 + qb * 256 + F.wave * 32;
            qptr = PA + (size_t)(tok0 + q) * 4096 + 1024 + h * 128;
            M.latK = PA + (size_t)(TP + b * 4096) * 4096 + 2048 + h * 128; M.latKld = 4096; M.latV = VTs + (size_t)(b * 8 + h) * 128 * 4096; M.latVld = 4096; M.nlat = 64;
            M.ctxK = (const bf16_t*)(P.ws + WS_CDK) + (size_t)b * 256 * 1024 + h * 128; M.ctxV = (const bf16_t*)(P.ws + WS_CDVT) + (size_t)(b * 8 + h) * 128 * 256; M.ntiles = 68; }
        bf16x8 Qf[8];
        if constexpr (!DIFF) {
            u32x4 w[8]; float ss = 0.f;
#pragma unroll
            for (int ks = 0; ks < 8; ++ks) { w[ks] = *(const u32x4*)(qptr + ks * 16 + hh * 8);
                ss += bflo(w[ks].x) * bflo(w[ks].x) + bfhi(w[ks].x) * bfhi(w[ks].x) + bflo(w[ks].y) * bflo(w[ks].y) + bfhi(w[ks].y) * bfhi(w[ks].y)
                    + bflo(w[ks].z) * bflo(w[ks].z) + bfhi(w[ks].z) * bfhi(w[ks].z) + bflo(w[ks].w) * bflo(w[ks].w) + bfhi(w[ks].w) * bfhi(w[ks].w); }
            ss += __shfl_xor(ss, 32);
            const float qs = rsqrtf(ss * (1.f / 128.f) + NORM_EPS) * c1;
            const float* qg = P.in[I_NAQG];
#pragma unroll
            for (int ks = 0; ks < 8; ++ks) { const f32x4 g0 = *(const f32x4*)(qg + ks * 16 + hh * 8), g1 = *(const f32x4*)(qg + ks * 16 + hh * 8 + 4);
                const u32x4 ws = (u32x4){pk2(bflo(w[ks].x) * qs * g0.x, bfhi(w[ks].x) * qs * g0.y), pk2(bflo(w[ks].y) * qs * g0.z, bfhi(w[ks].y) * qs * g0.w),
                                         pk2(bflo(w[ks].z) * qs * g1.x, bfhi(w[ks].z) * qs * g1.y), pk2(bflo(w[ks].w) * qs * g1.z, bfhi(w[ks].w) * qs * g1.w)};
                Qf[ks] = __builtin_bit_cast(bf16x8, ws); }
        } else {
#pragma unroll
        for (int ks = 0; ks < 8; ++ks) { const u32x4 w = *(const u32x4*)(qptr + ks * 16 + hh * 8);
            const u32x4 ws = (u32x4){pk2(bflo(w.x) * c1, bfhi(w.x) * c1), pk2(bflo(w.y) * c1, bfhi(w.y) * c1), pk2(bflo(w.z) * c1, bfhi(w.z) * c1), pk2(bflo(w.w) * c1, bfhi(w.w) * c1)};
            Qf[ks] = __builtin_bit_cast(bf16x8, ws); }
        }
        f32x16 O[4]; float ls[2] = {0.f, 0.f}; float w0 = 0.f, w1 = 0.f;
#pragma unroll
        for (int db = 0; db < 4; ++db)
#pragma unroll
            for (int i = 0; i < 16; ++i) O[db][i] = 0.f;
        const int cq = (F.wave & 1) * 32 + q;
        const int r0w = min(max(r - 4, 0), 56);
        const int nt = M.ntiles;
        TileRegs R;
        { const bf16_t* kp; const bf16_t* vp; int kld, vld; tile_src(M, 0, kp, kld, vp, vld); tile_load(F, R, kp, kld, vp, vld); }
        if constexpr (!DIFF) tile_norm_k(F, R, kgl, (MODE == 0) ? P.out + O_NAK + (size_t)(b * 256) * 1024 + h * 128 : nullptr, 1024);
        tile_store(F, R, lds + AT_K0, lds + AT_V0);
        __syncthreads();
        if constexpr (DIFF) {
#pragma unroll 1
            for (int j = 0; j < nt; ++j) {
                const int cur = j & 1, jn = (j + 1 < nt) ? j + 1 : 0;
                const bool wv = (j + 1 == nt);
                { const bf16_t* kp; const bf16_t* vp; int kld, vld; tile_src(M, jn, kp, kld, vp, vld); tile_load(F, R, kp, kld, vp, vld, wv); }
                diff_pass1(lds + AT_K0 + cur * AT_KTB, Qf, ls, F.lane);
                tile_store(F, R, lds + AT_K0 + (cur ^ 1) * AT_KTB, lds + AT_V0 + (cur ^ 1) * AT_VTB, wv);
                __syncthreads();
            }
            { const float l0 = ls[0] + __shfl_xor(ls[0], 32), l1 = ls[1] + __shfl_xor(ls[1], 32); w0 = 1.f / l0; w1 = lam / l1; }
#pragma unroll 1
            for (int j = 0; j < nt; ++j) {
                const int cur = (nt + j) & 1;
                if (j + 1 < nt) { const bf16_t* kp; const bf16_t* vp; int kld, vld; tile_src(M, j + 1, kp, kld, vp, vld); tile_load(F, R, kp, kld, vp, vld); }
                diff_pass2(lds + AT_K0 + cur * AT_KTB, lds + AT_V0 + cur * AT_VTB, Qf, O, w0, w1, F.lane);
                if (j + 1 < nt) tile_store(F, R, lds + AT_K0 + (cur ^ 1) * AT_KTB, lds + AT_V0 + (cur ^ 1) * AT_VTB);
                __syncthreads();
            }
        } else {
#pragma unroll 1
            for (int j = 0; j < nt; ++j) {
                const int cur = j & 1;
                if (j + 1 < nt) { const bf16_t* kp; const bf16_t* vp; int kld, vld; tile_src(M, j + 1, kp, kld, vp, vld); tile_load(F, R, kp, kld, vp, vld); }
                LAS const unsigned char* kt = lds + AT_K0 + cur * AT_KTB; LAS const unsigned char* vt = lds + AT_V0 + cur * AT_VTB;
                if constexpr (NA) {
                    if (j < M.nlat) { const int kr = rlo + j;
                        if (kr >= r0w && kr < r0w + 8) attn_compute1<true>(kt, vt, Qf, O, ls[0], F.lane, rpbl + (kr - r + 7) * 31, cq); }
                    else attn_compute1<false>(kt, vt, Qf, O, ls[0], F.lane, rpbl, cq);
                } else attn_compute1<false>(kt, vt, Qf, O, ls[0], F.lane, rpbl, cq);
                if (j + 1 < nt) {
                    if (j + 1 < M.nlat) tile_norm_k(F, R, kgl, (MODE == 0) ? P.out + O_NAK + (size_t)(b * 256 + (j + 1) * 64) * 1024 + h * 128 : nullptr, 1024);
                    tile_store(F, R, lds + AT_K0 + (cur ^ 1) * AT_KTB, lds + AT_V0 + (cur ^ 1) * AT_VTB); }
                __syncthreads();
            }
        }
        if constexpr (!DIFF) {
            const float inv = 1.f / (ls[0] + __shfl_xor(ls[0], 32));
            bf16_t* op = MIX + (size_t)(tok0 + q) * DM + h * 128 + 4 * hh;
#pragma unroll
            for (int db = 0; db < 4; ++db)
#pragma unroll
                for (int g = 0; g < 4; ++g) { u32x2 w; w.x = pk2(O[db][4 * g] * inv, O[db][4 * g + 1] * inv); w.y = pk2(O[db][4 * g + 2] * inv, O[db][4 * g + 3] * inv);
                    *(u32x2*)(op + db * 32 + 8 * g) = w; }
        } else {
            float ss = 0.f;
#pragma unroll
            for (int db = 0; db < 4; ++db)
#pragma unroll
                for (int i = 0; i < 16; ++i) ss += O[db][i] * O[db][i];
            ss += __shfl_xor(ss, 32);
            const float sc = rsqrtf(ss * (1.f / 128.f) + NORM_EPS) * (1.f - 0.35550906759096924f);
            const float* sg = P.in[I_SUBG];
            bf16_t* op = MIX + (size_t)(tok0 + q) * DM + 1024 + h * 128 + 4 * hh;
#pragma unroll
            for (int db = 0; db < 4; ++db)
#pragma unroll
                for (int g = 0; g < 4; ++g) { const f32x4 g4 = *(const f32x4*)(sg + db * 32 + 8 * g + 4 * hh);
                    u32x2 w; w.x = pk2(O[db][4 * g] * sc * g4.x, O[db][4 * g + 1] * sc * g4.y); w.y = pk2(O[db][4 * g + 2] * sc * g4.z, O[db][4 * g + 3] * sc * g4.w);
                    *(u32x2*)(op + db * 32 + 8 * g) = w; }
        }
    }
}
template <int L, int BATCH> struct HyCfg {
    static constexpr int NB = L / 64, TPT = 32 / BATCH, NTILES = NB / TPT, LOGB = (BATCH == 8) ? 3 : 5;
    static constexpr int ZROWB = (L + 384) * 2 + 16, ZBYTES = BATCH * ZROWB, RL = 2 * L + 16;
    static constexpr int TPW = (NTILES + 7) / 8;
};
constexpr int HY_KR_OFF = 71808;

template <int L, int BATCH>
DI void hyena_part(const Ctx& F, const Params& P, int c, int tokbase  , const bf16_t* KRG  ) {
    typedef HyCfg<L, BATCH> C;
    LAS unsigned char* lds = F.lds;
    bf16_t* CM = (bf16_t*)(P.ws + WS_RB);
    const float* hbias = P.in[I_HYBIAS];
    const int q = F.lane & 31, hh = F.lane >> 5;
    __syncthreads();
    for (int id = F.tid; id < BATCH * (L / 8); id += NTHR) { const int b = id / (L / 8), s8 = (id % (L / 8)) * 8;
        *(LAS u32x4*)(lds + b * C::ZROWB + (192 + s8) * 2) = *(const u32x4*)(CM + (size_t)c * TOK + tokbase + b * L + s8); }
    for (int id = F.tid; id < BATCH * 48; id += NTHR) { const int b = id / 48, k = id % 48, e = (k < 24) ? k * 8 : (192 + L + (k - 24) * 8);
        *(LAS u32x4*)(lds + b * C::ZROWB + e * 2) = (u32x4){0u, 0u, 0u, 0u}; }
#pragma unroll 1
    for (int o = 0; o < 2; ++o) {
        { const bf16_t* src = KRG + (size_t)(o * 1024 + c) * C::RL;
          for (int id = F.tid; id < C::RL / 8; id += NTHR) { const u32x4 v = *(const u32x4*)(src + id * 8);
              *(LAS u32x4*)(lds + HY_KR_OFF + id * 16) = v;
              LAS bf16_t* c1 = (LAS bf16_t*)(lds + HY_KR_OFF + C::RL * 2) + id * 8 - 1;
              if (id > 0) c1[0] = (bf16_t)(v.x & 0xffff);
              c1[1] = (bf16_t)(v.x >> 16); c1[2] = (bf16_t)(v.y & 0xffff); c1[3] = (bf16_t)(v.y >> 16); c1[4] = (bf16_t)(v.z & 0xffff); c1[5] = (bf16_t)(v.z >> 16);
              c1[6] = (bf16_t)(v.w & 0xffff); c1[7] = (bf16_t)(v.w >> 16); } }
        __syncthreads();
        f32x16 acc[C::TPW][2];
#pragma unroll
        for (int t = 0; t < C::TPW; ++t)
#pragma unroll
            for (int mt = 0; mt < 2; ++mt)
#pragma unroll
                for (int i = 0; i < 16; ++i) acc[t][mt][i] = 0.f;
        const int tq0 = F.wave * C::TPW;
        if (tq0 < C::NTILES) {
            const int d1lo = C::TPT * tq0 - (C::NB - 1), d1hi = C::TPT * (tq0 + C::TPW - 1) + C::TPT - 1;
            const int abase = HY_KR_OFF + (F.lane & 1) * (C::RL * 2) + (L - (F.lane & 31) + 8 * hh - (F.lane & 1)) * 2;
            bf16x8 W0[6], W1[6], B0[C::TPW][4];
#define HY_LDW(Wv, d1v, i) do { LAS const unsigned* ap_ = (LAS const unsigned*)(lds + abase + (-4 * (d1v) - 2 + (i)) * 32); Wv[i] = __builtin_bit_cast(bf16x8, (u32x4){ap_[0], ap_[1], ap_[2], ap_[3]}); } while (0)
#define HY_LDB(Bv, d1v) do { _Pragma("unroll") for (int t_ = 0; t_ < C::TPW; ++t_) { const int tq_ = tq0 + t_; \
            const int t1_ = C::TPT * tq_ + (q >> C::LOGB), b_ = q & (BATCH - 1); int s1_ = t1_ - (d1v); s1_ = min(max(s1_, -3), C::NB + 2); \
            LAS const unsigned char* bp_ = lds + b_ * C::ZROWB + (192 + 64 * s1_ + 8 * hh) * 2; \
            _Pragma("unroll") for (int ks_ = 0; ks_ < 4; ++ks_) Bv[t_][ks_] = *(const LAS bf16x8*)(bp_ + ks_ * 32); } } while (0)
#define HY_MM(Wv, Bv, d1v) do { _Pragma("unroll") for (int t_ = 0; t_ < C::TPW; ++t_) { const int tq_ = tq0 + t_; \
            if ((d1v) >= C::TPT * tq_ - (C::NB - 1) && (d1v) <= C::TPT * tq_ + C::TPT - 1) { \
                _Pragma("unroll") for (int ks_ = 0; ks_ < 4; ++ks_) _Pragma("unroll") for (int mt_ = 0; mt_ < 2; ++mt_) \
                    acc[t_][mt_] = __builtin_amdgcn_mfma_f32_32x32x16_bf16(Wv[ks_ - 2 * mt_ + 2], Bv[t_][ks_], acc[t_][mt_], 0, 0, 0); } } } while (0)
#pragma unroll
            for (int i = 0; i < 6; ++i) HY_LDW(W0, d1lo, i);
            int d1 = d1lo;
#pragma unroll 1
            for (; d1 + 1 <= d1hi; d1 += 2) {
                HY_LDB(B0, d1);
#pragma unroll
                for (int i = 0; i < 4; ++i) HY_LDW(W1, d1 + 1, i);
                W1[4] = W0[0]; W1[5] = W0[1];
                HY_MM(W0, B0, d1);
                HY_LDB(B0, d1 + 1);
                if (d1 + 2 <= d1hi) {
#pragma unroll
                    for (int i = 0; i < 4; ++i) HY_LDW(W0, d1 + 2, i);
                    W0[4] = W1[0]; W0[5] = W1[1];
                }
                HY_MM(W1, B0, d1 + 1);
            }
            if (d1 <= d1hi) { HY_LDB(B0, d1); HY_MM(W0, B0, d1); }
#undef HY_LDW
#undef HY_LDB
#undef HY_MM
        }
        __syncthreads();
        if (tq0 < C::NTILES) {
            const float bo = hbias[o * 1024 + c];
            const bf16_t* gate = CM + (size_t)((1 + o) * 1024 + c) * TOK + tokbase;
            bf16_t* zout = (bf16_t*)(P.ws + WS_RA + RA_ZC) + (size_t)c * TOK + tokbase;
#pragma unroll
            for (int t = 0; t < C::TPW; ++t) { const int tq = tq0 + t, t1 = C::TPT * tq + (q >> C::LOGB), b = q & (BATCH - 1);
#pragma unroll
                for (int mt = 0; mt < 2; ++mt)
#pragma unroll
                    for (int g = 0; g < 4; ++g) { const int s = 64 * t1 + 32 * mt + 8 * g + 4 * hh;
                        LAS u32x2* zp = (LAS u32x2*)(lds + b * C::ZROWB + (192 + s) * 2);
                        const u32x2 zv = *zp, gv = *(const u32x2*)(gate + (size_t)b * L + s);
                        const float r0 = bflo(gv.x) * (acc[t][mt][4 * g] + bflo(zv.x) * bo), r1 = bfhi(gv.x) * (acc[t][mt][4 * g + 1] + bfhi(zv.x) * bo);
                        const float r2 = bflo(gv.y) * (acc[t][mt][4 * g + 2] + bflo(zv.y) * bo), r3 = bfhi(gv.y) * (acc[t][mt][4 * g + 3] + bfhi(zv.y) * bo);
                        const u32x2 w = (u32x2){pk2(r0, r1), pk2(r2, r3)};
                        if (o == 0) *zp = w; else *(u32x2*)(zout + (size_t)b * L + s) = w; } }
        }
        __syncthreads();
    }
}

DI void hyena_phase(const Ctx& F, const Params& P) {
    for (int c = F.bid; c < 1024; c += F.G) {
        hyena_part<LS, 8>(F, P, c, TP, (const bf16_t*)(P.ws + WS_KRS));
        hyena_part<LP, 32>(F, P, c, 0, (const bf16_t*)(P.ws + WS_KRP));
    }
}

DI void hyena_post(const Ctx& F, const Params& P) {
    const bf16_t* CM = (const bf16_t*)(P.ws + WS_RA + RA_ZC); bf16_t* MIX = (bf16_t*)(P.ws + WS_HM);
    for (int t = F.bid; t < 16 * 640; t += F.G) { const int cg = t & 15, tg = t >> 4;
        tr_tile_bf16(F, CM + (size_t)(cg * 64) * TOK + tg * 64, TOK, MIX + (size_t)(tg * 64) * DM + 1024 + cg * 64, DM, (LAS bf16_t*)F.lds); }
}
DI void prep_c(const Ctx& F, const Params& P) {
    bf16_t* PA = (bf16_t*)(P.ws + WS_RA);
    LAS float* rope = (LAS float*)(F.lds + 16384);
    __syncthreads();
    for (int e = F.tid; e < 1024; e += NTHR) { const int pos = e >> 4, f = e & 15; const float inv = exp2f(-(float)f * (13.287712379549449f / 16.f)); const float a = (float)pos * inv;
        rope[e * 2] = cosf(a); rope[e * 2 + 1] = sinf(a); }
    __syncthreads();
    { const float* gsrc = (F.lane < 32 ? P.in[I_DQG] : P.in[I_DKG]) + (F.lane & 1) * 32; float* ok = P.out + O_DK;
      float g[32];
#pragma unroll
      for (int i = 0; i < 32; ++i) g[i] = gsrc[i];
      for (int T = F.bid * 8 + F.wave; T < TOK; T += F.G * 8) {
          bf16_t* rp = PA + (size_t)T * 4096 + 1024 + F.lane * 32;
          u32x4 v[4]; float x[32]; float ss = 0.f;
#pragma unroll
          for (int j = 0; j < 4; ++j) { v[j] = *(const u32x4*)(rp + j * 8);
              x[j * 8 + 0] = bflo(v[j].x); x[j * 8 + 1] = bfhi(v[j].x); x[j * 8 + 2] = bflo(v[j].y); x[j * 8 + 3] = bfhi(v[j].y);
              x[j * 8 + 4] = bflo(v[j].z); x[j * 8 + 5] = bfhi(v[j].z); x[j * 8 + 6] = bflo(v[j].w); x[j * 8 + 7] = bfhi(v[j].w); }
#pragma unroll
          for (int i = 0; i < 32; ++i) ss += x[i] * x[i];
          ss += dpp_xor1(ss);
          const float rstd = rsqrtf(ss * (1.f / 64.f) + NORM_EPS);
#pragma unroll
          for (int i = 0; i < 32; ++i) x[i] = x[i] * rstd * g[i];
          if (T < TP) { if (F.lane >= 32) { float* o = ok + (size_t)T * 1024 + (F.lane - 32) * 32;
#pragma unroll
                  for (int j = 0; j < 8; ++j) *(f32x4*)(o + j * 4) = (f32x4){x[j * 4], x[j * 4 + 1], x[j * 4 + 2], x[j * 4 + 3]}; } }
          else { const int t = (T - TP) & 4095, pos = (F.lane & 1) ? (t & 63) : (t >> 6);
              const LAS float* rt = rope + pos * 32;
#pragma unroll
              for (int f = 0; f < 16; ++f) { const float cs = rt[2 * f], sn = rt[2 * f + 1], a = x[f], b = x[16 + f]; x[f] = a * cs - b * sn; x[16 + f] = b * cs + a * sn; } }
#pragma unroll
          for (int j = 0; j < 4; ++j) { u32x4 w; w.x = pk2(x[j * 8 + 0], x[j * 8 + 1]); w.y = pk2(x[j * 8 + 2], x[j * 8 + 3]); w.z = pk2(x[j * 8 + 4], x[j * 8 + 5]); w.w = pk2(x[j * 8 + 6], x[j * 8 + 7]);
              *(u32x4*)(rp + j * 8) = w; }
      } }
    __syncthreads();
    bf16_t* VTp = (bf16_t*)(P.ws + WS_VT); bf16_t* VTs = (bf16_t*)(P.ws + WS_VT + VT_S);
    for (int t = F.bid; t < 2048 + 8192; t += F.G) {
        if (t < 2048) { const int bh = t >> 3, sub = t & 7, tk = sub >> 1, dd = sub & 1, b = bh >> 3, h = bh & 7;
            tr_tile_bf16(F, PA + ((size_t)(b * 256 + tk * 64)) * 4096 + 3072 + h * 128 + dd * 64, 4096, VTp + ((size_t)bh * 128 + dd * 64) * 256 + tk * 64, 256, (LAS bf16_t*)F.lds); }
        else { const int u = t - 2048, bh = u >> 7, sub = u & 127, tk = sub >> 1, dd = sub & 1, b = bh >> 3, h = bh & 7;
            tr_tile_bf16(F, PA + ((size_t)(TP + b * 4096 + tk * 64)) * 4096 + 3072 + h * 128 + dd * 64, 4096, VTs + ((size_t)bh * 128 + dd * 64) * 4096 + tk * 64, 4096, (LAS bf16_t*)F.lds); }
    }
    { float* o = P.out + O_DV;
      for (int e = F.bid * NTHR + F.tid; e < TP * 128; e += F.G * NTHR) { const int T = e >> 7, c8 = (e & 127) * 8;
          const u32x4 v = *(const u32x4*)(PA + (size_t)T * 4096 + 3072 + c8);
          *(f32x4*)(o + (size_t)T * 1024 + c8) = (f32x4){bflo(v.x), bfhi(v.x), bflo(v.y), bfhi(v.y)};
          *(f32x4*)(o + (size_t)T * 1024 + c8 + 4) = (f32x4){bflo(v.z), bfhi(v.z), bflo(v.w), bfhi(v.w)}; } }
}

constexpr int S5_BUROW = 132 * 4, S5_HROW = 272, S5_WLDS = 16 * S5_BUROW + 16 * S5_HROW;
DI void s5_chain(const Ctx& F, const Params& P, int dg, int tok0, int L, const float* h0re, const float* h0im, float* fre, float* fim, bf16_t* Yout) {
    LAS unsigned char* wl = F.lds + F.wave * S5_WLDS; LAS unsigned char* hl = wl + 16 * S5_BUROW;
    const int g = dg & 63, dir = dg >> 6, lane = F.lane, st = lane & 15, gq = lane >> 4;
    const float* S5A = (const float*)(P.ws + WS_S5A); const bf16_t* BB = (const bf16_t*)(P.ws + WS_S5BB); const bf16_t* CC = (const bf16_t*)(P.ws + WS_S5CC);
    const bf16_t* PA = (const bf16_t*)(P.ws + WS_RA);
    const float ar = S5A[(dg * 64 + lane) * 2], ai = S5A[(dg * 64 + lane) * 2 + 1];
    float hr = h0re ? h0re[lane] : 0.f, hi = h0im ? h0im[lane] : 0.f;
    const bf16x8 zero8 = (bf16x8){0, 0, 0, 0, 0, 0, 0, 0};
    bf16x8 BBf[8], CCf[4];
#pragma unroll
    for (int mt = 0; mt < 8; ++mt) BBf[mt] = (gq < 2) ? *(const bf16x8*)(BB + ((size_t)dg * 128 + mt * 16 + st) * 16 + gq * 8) : zero8;
#pragma unroll
    for (int kk = 0; kk < 4; ++kk) CCf[kk] = *(const bf16x8*)(CC + ((size_t)dg * 16 + st) * 128 + kk * 32 + gq * 8);
    const int nch = L / 16;
    const int sgn = dir ? -1 : 1, tstart = dir ? tok0 + L - 1 : tok0;
    bf16x8 Uf = zero8, U1 = zero8, U2 = zero8;
    if (gq < 2) { Uf = *(const bf16x8*)(PA + (size_t)(tstart + sgn * st) * 4096 + g * 16 + gq * 8);
        if (1 < nch) U1 = *(const bf16x8*)(PA + (size_t)(tstart + sgn * (16 + st)) * 4096 + g * 16 + gq * 8);
        if (2 < nch) U2 = *(const bf16x8*)(PA + (size_t)(tstart + sgn * (32 + st)) * 4096 + g * 16 + gq * 8); }
    for (int ch = 0; ch < nch; ++ch) {
        bf16x8 Un = zero8;
        if (ch + 3 < nch && gq < 2) Un = *(const bf16x8*)(PA + (size_t)(tstart + sgn * ((ch + 3) * 16 + st)) * 4096 + g * 16 + gq * 8);
#pragma unroll
        for (int mt = 0; mt < 8; ++mt) { f32x4 d = (f32x4){0.f, 0.f, 0.f, 0.f};
            d = __builtin_amdgcn_mfma_f32_16x16x32_bf16(BBf[mt], Uf, d, 0, 0, 0);
            *(LAS f32x4*)(wl + st * S5_BUROW + (mt * 16 + gq * 4) * 4) = d; }
        asm volatile("" ::: "memory");
#pragma unroll
        for (int s = 0; s < 16; ++s) {
            const float bur = *(const LAS float*)(wl + s * S5_BUROW + lane * 4), bui = *(const LAS float*)(wl + s * S5_BUROW + (64 + lane) * 4);
            const float nr = ar * hr - ai * hi + bur, ni = ar * hi + ai * hr + bui; hr = nr; hi = ni;
            *(LAS bf16_t*)(hl + s * S5_HROW + lane * 2) = f2bf(hr); *(LAS bf16_t*)(hl + s * S5_HROW + (64 + lane) * 2) = f2bf(hi);
        }
        asm volatile("" ::: "memory");
        f32x4 y = (f32x4){0.f, 0.f, 0.f, 0.f};
#pragma unroll
        for (int kk = 0; kk < 4; ++kk) { const bf16x8 Bh = *(const LAS bf16x8*)(hl + st * S5_HROW + (kk * 32 + gq * 8) * 2);
            y = __builtin_amdgcn_mfma_f32_16x16x32_bf16(CCf[kk], Bh, y, 0, 0, 0); }
        { const int tok = tstart + sgn * (ch * 16 + st);
          *(u32x2*)(Yout + (size_t)tok * 1024 + g * 16 + gq * 4) = (u32x2){pk2(y[0], y[1]), pk2(y[2], y[3])}; }
        asm volatile("" ::: "memory");
        Uf = U1; U1 = U2; U2 = Un;
    }
    if (fre) { fre[lane] = hr; fim[lane] = hi; }
}

DI void s5_phase(const Ctx& F, const Params& P) {
    bf16_t* YF = (bf16_t*)(P.ws + WS_RB + RB_YF); bf16_t* YB = (bf16_t*)(P.ws + WS_RB + RB_YB);
    for (int cs = F.bid; cs < 256; cs += F.G) {
        if (F.wave < 4) { const int sc = cs * 4 + F.wave, dg = sc & 127, b = sc >> 7;
            s5_chain(F, P, dg, TP + b * 4096, LS, P.in[I_S5RE] + (size_t)sc * 64, P.in[I_S5IM] + (size_t)sc * 64, nullptr, nullptr, (dg >> 6) ? YB : YF); }
        else { for (int k = 0; k < 4; ++k) { const int pc = (cs * 4 + (F.wave - 4)) * 4 + k, dg = pc & 127, b = pc >> 7;
            s5_chain(F, P, dg, b * 256, LP, nullptr, nullptr, P.out + O_SR + (size_t)pc * 64, P.out + O_SI + (size_t)pc * 64, (dg >> 6) ? YB : YF); } }
    }
}

DI void s5_combine(const Ctx& F, const Params& P) {
    const bf16_t* PA = (const bf16_t*)(P.ws + WS_RA); const bf16_t* YF = (const bf16_t*)(P.ws + WS_RB + RB_YF); const bf16_t* YB = (const bf16_t*)(P.ws + WS_RB + RB_YB);
    bf16_t* Y = (bf16_t*)(P.ws + WS_RB + RB_Y); const float* dsk = P.in[I_S5D];
    for (size_t e = (size_t)F.bid * NTHR + F.tid; e < (size_t)TOK * 128; e += (size_t)F.G * NTHR) { const size_t T = e >> 7; const int c8 = (int)(e & 127) * 8;
        const u32x4 uv = *(const u32x4*)(PA + T * 4096 + c8), fv = *(const u32x4*)(YF + T * 1024 + c8), bv = *(const u32x4*)(YB + T * 1024 + c8);
        const f32x4 d0 = *(const f32x4*)(dsk + c8), d1 = *(const f32x4*)(dsk + c8 + 4);
        float o[8];
        o[0] = gelu_tanh(d0.x * bflo(uv.x) + bflo(fv.x) + bflo(bv.x)); o[1] = gelu_tanh(d0.y * bfhi(uv.x) + bfhi(fv.x) + bfhi(bv.x));
        o[2] = gelu_tanh(d0.z * bflo(uv.y) + bflo(fv.y) + bflo(bv.y)); o[3] = gelu_tanh(d0.w * bfhi(uv.y) + bfhi(fv.y) + bfhi(bv.y));
        o[4] = gelu_tanh(d1.x * bflo(uv.z) + bflo(fv.z) + bflo(bv.z)); o[5] = gelu_tanh(d1.y * bfhi(uv.z) + bfhi(fv.z) + bfhi(bv.z));
        o[6] = gelu_tanh(d1.z * bflo(uv.w) + bflo(fv.w) + bflo(bv.w)); o[7] = gelu_tanh(d1.w * bfhi(uv.w) + bfhi(fv.w) + bfhi(bv.w));
        u32x4 w; w.x = pk2(o[0], o[1]); w.y = pk2(o[2], o[3]); w.z = pk2(o[4], o[5]); w.w = pk2(o[6], o[7]);
        *(u32x4*)(Y + T * 1024 + c8) = w; }
}
constexpr int PS_KROW = 272;
constexpr int PS_IDX_OFF = 2 * 128 * PS_KROW;
constexpr int PS_TAB_OFF = PS_IDX_OFF + 512 * 32;

DI void topk_insert(float (&a)[16], float x) {
#pragma unroll
    for (int j = 15; j >= 1; --j) a[j] = __builtin_amdgcn_fmed3f(a[j - 1], a[j], x);
    a[0] = fmaxf(a[0], x);
}

DI void peer_select(const Ctx& F, const Params& P, int layer) {
    LAS unsigned char* lds = F.lds;
    const bf16_t* Q = (const bf16_t*)(P.ws + WS_RA + RA_Q);
    int* SELI = (int*)(P.ws + WS_RA + RA_SELI); float* SELW = (float*)(P.ws + WS_RA + RA_SELW);
    const bf16_t* KEYS = (const bf16_t*)(P.ws + WS_PKEYS) + (size_t)layer * 8 * 2 * 128 * 128;
    const int q = F.lane & 31, hh = F.lane >> 5;
    LAS unsigned char* myidx = lds + PS_IDX_OFF + F.tid * 32;
    LAS unsigned char* tab = lds + PS_TAB_OFF;
    for (int wu = F.bid; wu < 256; wu += F.G) {
        const int h = wu & 7, chunk = wu >> 3;
        __syncthreads();
        for (int id = F.tid; id < 2 * 128 * 16; id += NTHR) { const int row = id >> 4, c16 = id & 15;
            *(LAS u32x4*)(lds + row * PS_KROW + c16 * 16) = *(const u32x4*)(KEYS + ((size_t)h * 256 + row) * 128 + c16 * 8); }
        if (F.tid < 16) { int cnt = 0;
            for (int a = 0; a < F.tid; ++a) cnt += 16 / (a + 1);
            for (int b = 0; b < 16 / (F.tid + 1); ++b) { tab[(cnt + b) * 2] = (unsigned char)F.tid; tab[(cnt + b) * 2 + 1] = (unsigned char)b; } }
        __syncthreads();
        for (int blk = F.wave; blk < 40; blk += 8) {
            const int T0 = chunk * 1280 + blk * 32;
            float lst[2][16];
#pragma unroll
            for (int side = 0; side < 2; ++side) {
                bf16x8 Qf[8];
                const bf16_t* qp = Q + (size_t)(T0 + q) * 2048 + h * 256 + side * 128 + hh * 8;
#pragma unroll
                for (int ks = 0; ks < 8; ++ks) Qf[ks] = *(const bf16x8*)(qp + ks * 16);
                float a[16];
#pragma unroll
                for (int j = 0; j < 16; ++j) a[j] = -3.0e38f;
#pragma unroll
                for (int nt = 0; nt < 4; ++nt) {
                    f32x16 S;
#pragma unroll
                    for (int i = 0; i < 16; ++i) S[i] = 0.f;
#pragma unroll
                    for (int ks = 0; ks < 8; ++ks) { const bf16x8 A = *(const LAS bf16x8*)(lds + (side * 128 + nt * 32 + q) * PS_KROW + (ks * 16 + hh * 8) * 2);
                        S = __builtin_amdgcn_mfma_f32_32x32x16_bf16(A, Qf[ks], S, 0, 0, 0); }
#pragma unroll
                    for (int i = 0; i < 16; ++i) { const int n = nt * 32 + (i & 3) + 8 * (i >> 2) + 4 * hh;
                        topk_insert(a, __uint_as_float((__float_as_uint(S[i]) & 0xffffff80u) | (unsigned)n)); }
                }
                float pb[16];
#pragma unroll
                for (int j = 0; j < 16; ++j) pb[j] = __shfl_xor(a[j], 32);
#pragma unroll
                for (int j = 0; j < 16; ++j) topk_insert(a, pb[j]);
#pragma unroll
                for (int j = 0; j < 16; ++j) { lst[side][j] = a[j]; myidx[side * 16 + j] = (unsigned char)(__float_as_uint(a[j]) & 0x7fu); }
            }
            float cb[16];
#pragma unroll
            for (int j = 0; j < 16; ++j) cb[j] = -3.0e38f;
            { int cid = 0;
#pragma unroll
              for (int a = 0; a < 16; ++a)
#pragma unroll
                  for (int b = 0; b < 16 / (a + 1); ++b) {
                      const float sa = __uint_as_float(__float_as_uint(lst[0][a]) & 0xffffff80u), sb = __uint_as_float(__float_as_uint(lst[1][b]) & 0xffffff80u);
                      topk_insert(cb, __uint_as_float((__float_as_uint(sa + sb) & 0xffffffc0u) | (unsigned)cid)); ++cid; } }
            const float mx = __uint_as_float(__float_as_uint(cb[0]) & 0xffffffc0u);
            float e[16], den = 0.f;
#pragma unroll
            for (int j = 0; j < 16; ++j) { e[j] = __expf(__uint_as_float(__float_as_uint(cb[j]) & 0xffffffc0u) - mx); den += e[j]; }
            const float rden = 1.f / den;
#pragma unroll
            for (int j = 0; j < 16; ++j) {
                if ((j >> 3) == hh) { const int cid = (int)(__float_as_uint(cb[j]) & 0x3fu);
                    const int a = tab[cid * 2], b = tab[cid * 2 + 1];
                    const int eidx = (int)myidx[a] * 128 + (int)myidx[16 + b];
                    SELI[(size_t)(T0 + q) * 128 + h * 16 + j] = eidx; SELW[(size_t)(T0 + q) * 128 + h * 16 + j] = e[j] * rden; }
            }
        }
    }
    __syncthreads();
}

DI f32x32 fp6_unpack(u32x4 a, u32x2 b) { const u32x6 pk = {a.x, a.y, a.z, a.w, b.x, b.y}; return __builtin_amdgcn_cvt_scalef32_pk32_f32_fp6(pk, 1.0f); }
constexpr int GN = 8;
template <bool NEXTNORM>
DI void peer_gather(const Ctx& F, const Params& P, const float* modl, int layer, const float* ngain, const float* nmodl) {
    const bf16_t* H2 = (const bf16_t*)(P.ws + WS_HM);
    const unsigned char* TU = P.ws + WS_TBLU + (size_t)layer * 16384 * PT_ROWB; const unsigned char* TV = P.ws + WS_TBLV + (size_t)layer * 16384 * PT_ROWB;
    const float* SCU = (const float*)(P.ws + WS_SC) + layer * 16384; const float* SCV = (const float*)(P.ws + WS_SC) + (2 + layer) * 16384;
    const int* SELI = (const int*)(P.ws + WS_RA + RA_SELI); const float* SELW = (const float*)(P.ws + WS_RA + RA_SELW);
    float* X = P.out + O_Y;
    const int lane = lane_id();
    for (int T = F.bid * 8 + F.wave; T < TOK; T += F.G * 8) {
        f32x2 xf[16];
#pragma unroll
        for (int q4 = 0; q4 < 4; ++q4) { const u32x4 w = *(const u32x4*)(H2 + (size_t)T * DM + lane * 32 + q4 * 8);
            xf[q4 * 4 + 0] = (f32x2){bflo(w.x), bfhi(w.x)}; xf[q4 * 4 + 1] = (f32x2){bflo(w.y), bfhi(w.y)};
            xf[q4 * 4 + 2] = (f32x2){bflo(w.z), bfhi(w.z)}; xf[q4 * 4 + 3] = (f32x2){bflo(w.w), bfhi(w.w)}; }
        const int e0 = SELI[(size_t)T * 128 + lane], e1 = SELI[(size_t)T * 128 + 64 + lane];
        const float g0 = SELW[(size_t)T * 128 + lane], g1 = SELW[(size_t)T * 128 + 64 + lane];
        float d0 = 0.f, d1 = 0.f;
#pragma unroll 1
        for (int kb = 0; kb < 128; kb += GN) {
            u32x4 ura[GN]; u32x2 urb[GN];
#pragma unroll
            for (int j = 0; j < GN; ++j) { const int k = kb + j; const int e = __builtin_amdgcn_readlane(k < 64 ? e0 : e1, k & 63);
                const unsigned char* up = TU + (size_t)e * PT_ROWB;
                ura[j] = *(const u32x4*)(up + lane * 16); urb[j] = *(const u32x2*)(up + 1024 + lane * 8); }
#pragma unroll
            for (int j = 0; j < GN; ++j) { const f32x32 r = fp6_unpack(ura[j], urb[j]);
                f32x2 sa = (f32x2){0.f, 0.f}, sb = (f32x2){0.f, 0.f}, sc2 = (f32x2){0.f, 0.f}, sd = (f32x2){0.f, 0.f};
#pragma unroll
                for (int i = 0; i < 4; ++i) { sa += (f32x2){r[8 * i], r[8 * i + 1]} * xf[4 * i]; sb += (f32x2){r[8 * i + 2], r[8 * i + 3]} * xf[4 * i + 1];
                    sc2 += (f32x2){r[8 * i + 4], r[8 * i + 5]} * xf[4 * i + 2]; sd += (f32x2){r[8 * i + 6], r[8 * i + 7]} * xf[4 * i + 3]; }
                const f32x2 st = (sa + sb) + (sc2 + sd);
                const float sm = wave_sum(st.x + st.y); const int k = kb + j;
                if (k < 64) { if (lane == k) d0 = sm; } else { if (lane == k - 64) d1 = sm; } }
        }
        const float cf0 = g0 * gelu_tanh(d0 * SCU[e0]) * SCV[e0], cf1 = g1 * gelu_tanh(d1 * SCU[e1]) * SCV[e1];
        f32x2 acc[16];
#pragma unroll
        for (int i = 0; i < 16; ++i) acc[i] = (f32x2){0.f, 0.f};
#pragma unroll 1
        for (int kb = 0; kb < 128; kb += GN) {
            u32x4 vra[GN]; u32x2 vrb[GN]; float cf[GN];
#pragma unroll
            for (int j = 0; j < GN; ++j) { const int k = kb + j; const int e = __builtin_amdgcn_readlane(k < 64 ? e0 : e1, k & 63);
                cf[j] = __builtin_bit_cast(float, __builtin_amdgcn_readlane(__builtin_bit_cast(int, k < 64 ? cf0 : cf1), k & 63));
                const unsigned char* vp = TV + (size_t)e * PT_ROWB;
                vra[j] = *(const u32x4*)(vp + lane * 16); vrb[j] = *(const u32x2*)(vp + 1024 + lane * 8); }
#pragma unroll
            for (int j = 0; j < GN; ++j) { const f32x32 r = fp6_unpack(vra[j], vrb[j]);
                const f32x2 c2 = (f32x2){cf[j], cf[j]};
#pragma unroll
                for (int i = 0; i < 16; ++i) acc[i] += c2 * (f32x2){r[2 * i], r[2 * i + 1]}; }
        }
        const float* gate = modl + (size_t)(cond_of(T) * 6 + 5) * DM;
        f32x4 xn[8]; float ss = 0.f;
#pragma unroll
        for (int q4 = 0; q4 < 8; ++q4) { const int col = lane * 32 + q4 * 4; float* xp = X + (size_t)T * DM + col;
            const f32x4 gv = *(const f32x4*)(gate + col), x0 = *(const f32x4*)(xp);
            const f32x4 r = x0 + gv * (f32x4){acc[q4 * 2].x, acc[q4 * 2].y, acc[q4 * 2 + 1].x, acc[q4 * 2 + 1].y};
            *(f32x4*)(xp) = r; xn[q4] = r; ss += r.x * r.x + r.y * r.y + r.z * r.z + r.w * r.w; }
        if (NEXTNORM) {
            ss = wave_sum(ss);
            const float rstd = rsqrtf(ss * (1.f / DM) + NORM_EPS);
            const float* sh = nmodl + (size_t)(cond_of(T) * 6 + 0) * DM; const float* sc = sh + DM;
            bf16_t* H = (bf16_t*)(P.ws + WS_HM);
#pragma unroll
            for (int q4 = 0; q4 < 8; ++q4) { const int col = lane * 32 + q4 * 4;
                const f32x4 g4 = *(const f32x4*)(ngain + col), s4 = *(const f32x4*)(sc + col), h4 = *(const f32x4*)(sh + col);
                const f32x4 o = xn[q4] * rstd * g4 * (s4 + 1.f) + h4;
                *(u32x2*)(H + (size_t)T * DM + col) = (u32x2){pk2(o.x, o.y), pk2(o.z, o.w)}; }
        }
    }
}
constexpr int NPHASE = 22;

__global__ void __launch_bounds__(NTHR, 2) mega(Params P) {
    extern __shared__ __attribute__((aligned(16))) unsigned char lds_raw[];
    Ctx F;
    F.lds = (LAS unsigned char*)lds_raw; F.tid = threadIdx.x; F.lane = F.tid & 63; F.wave = __builtin_amdgcn_readfirstlane(F.tid >> 6); F.G = gridDim.x; F.bid = blockIdx.x;
    const int lo = P.ph_lo, hi = P.ph_hi;
    volatile LAS unsigned* xbw = (volatile LAS unsigned*)(F.lds + LDS_BYTES - 16);
    if (F.tid == 0) { xbw[0] = 0u; xbw[1] = 0u; xbw[2] = 0u; xbw[3] = 0u; }
    __syncthreads();
    if (hi - lo > 1) (void)xcd_barrier_post((unsigned*)(P.ws + WS_CTL), xbw);
#define GRID_BARRIER() do { XcdBarrier bar_; bar_.bar = (unsigned*)(P.ws + WS_CTL); bar_.x = xb_xcc_id(); bar_.st = (volatile LAS unsigned*)(F.lds + LDS_BYTES - 16); xcd_barrier(bar_); } while (0)
#define PH(k, ...) if (lo <= (k) && (k) < hi) { { __VA_ARGS__ } if ((k) + 1 < hi) GRID_BARRIER(); }
#define MOD0 ((const float*)(P.ws + WS_MOD))
#define MOD1 ((const float*)(P.ws + WS_MOD) + 9 * 12288)
#define HM ((bf16_t*)(P.ws + WS_HM))
#define RA ((bf16_t*)(P.ws + WS_RA))
#define X (P.out + O_Y)

    PH(0, prologue(F, P);)
    PH(1, adaln_reduce(F, P);)
    PH(2, norm_phase(F, P.in[I_XP], P.in[I_XS], P.in[I_NMIXG], MOD0, 0, HM);)
    PH(3, { EpiBf16 E{RA, 4096}; run_gemm(F, HM, (const bf16_t*)(P.ws + WS_WEVIN) + (size_t)2048 * 2048, 4096, 2048, E); })
    PH(4, prep_a(F, P);)
    PH(5, { EpiBf16 E{RA, 2048}; run_gemm(F, HM, (const bf16_t*)(P.ws + WS_WEVIN), 2048, 2048, E); })
    PH(6, attn_phase<0>(F, P); attn_phase<1>(F, P); hyena_phase(F, P);)
    PH(7, hyena_post(F, P);)
    PH(8, { EpiResid E{P.in[I_XP], P.in[I_XS], X, MOD0, 2}; run_gemm(F, HM, (const bf16_t*)(P.ws + WS_WEVOUT), 2048, 2048, E); })
    PH(9, norm_phase(F, X, X + (size_t)TP * DM, P.in[I_NFFNG], MOD0, 3, HM);)
    PH(10, { EpiBf16 E{RA, 2048}; run_gemm(F, HM, (const bf16_t*)(P.ws + WS_WPQ), 2048, 2048, E); })
    PH(11, peer_select(F, P, 0);)
    PH(12, peer_gather<true>(F, P, MOD0, 0, P.in[I_NMIXG] + DM, MOD1);)
    PH(13, { EpiBf16 E{RA, 4096}; run_gemm(F, HM, (const bf16_t*)(P.ws + WS_WODIN), 4096, 2048, E); })
    PH(14, prep_c(F, P); s5_phase(F, P);)
    PH(15, attn_phase<2>(F, P); attn_phase<3>(F, P); s5_combine(F, P);)
    PH(16, { EpiGlu E{(const bf16_t*)(P.ws + WS_RB + RB_Y), HM, P.in[I_GLUB]}; run_gemm(F, (const bf16_t*)(P.ws + WS_RB + RB_Y), (const bf16_t*)(P.ws + WS_WGLU), 1024, 1024, E); })
    PH(17, { EpiResid E{X, X + (size_t)TP * DM, X, MOD1, 2}; run_gemm(F, HM, (const bf16_t*)(P.ws + WS_WODOUT), 2048, 2048, E); })
    PH(18, norm_phase(F, X, X + (size_t)TP * DM, P.in[I_NFFNG] + DM, MOD1, 3, HM);)
    PH(19, { EpiBf16 E{RA, 2048}; run_gemm(F, HM, (const bf16_t*)(P.ws + WS_WPQ) + (size_t)2048 * 2048, 2048, 2048, E); })
    PH(20, peer_select(F, P, 1);)
    PH(21, peer_gather<false>(F, P, MOD1, 1, nullptr, nullptr);)
#undef MOD0
#undef MOD1
#undef HM
#undef RA
#undef X
#undef PH
#undef GRID_BARRIER
}

extern "C" void kernel_launch(void* const* d_in, const int* in_sizes, int n_in, void* d_out, int out_size, void* d_ws, size_t ws_size, hipStream_t stream) {
    static int grid = 0;
    if (grid == 0) {
        if (n_in != N_IN || (size_t)out_size != O_END || ws_size < WS_END) { fprintf(stderr, "kernel_launch: unexpected shapes (n_in %d, out %d, ws %zu, need %zu)\n", n_in, out_size, ws_size, (size_t)WS_END); grid = -1; return; }
        int dev = 0, cus = 0;
        if (hipGetDevice(&dev) != hipSuccess || hipDeviceGetAttribute(&cus, hipDeviceAttributeMultiprocessorCount, dev) != hipSuccess) { grid = -1; return; }
        if (hipFuncSetAttribute((const void*)mega, hipFuncAttributeMaxDynamicSharedMemorySize, LDS_BYTES) != hipSuccess) { fprintf(stderr, "kernel_launch: hipFuncSetAttribute failed\n"); grid = -1; return; }
        int per_cu = 0;
        if (hipOccupancyMaxActiveBlocksPerMultiprocessor(&per_cu, (const void*)mega, NTHR, LDS_BYTES) != hipSuccess || per_cu < 1) { fprintf(stderr, "kernel_launch: occupancy query says %d blocks per CU\n", per_cu); }
        (void)hipGetLastError();
        grid = cus;
    }
    if (grid < 0) return;
    (void)hipMemsetAsync((char*)d_ws + WS_CTL, 0, 65536, stream);
    Params p; memset(&p, 0, sizeof(p));
    for (int i = 0; i < N_IN; ++i) p.in[i] = (const float*)d_in[i];
    p.out = (float*)d_out; p.ws = (unsigned char*)d_ws;
    p.ph_lo = 0; p.ph_hi = NPHASE;
    hipLaunchKernelGGL(mega, dim3(grid), dim3(NTHR), LDS_BYTES, stream, p);
}
```

```cpp
#include <hip/hip_runtime.h>
#include <cstdio>
#include <cstring>
#include <cstdint>

typedef unsigned short bf16_t;
typedef short bf16x8 __attribute__((ext_vector_type(8)));
typedef short s16x4 __attribute__((ext_vector_type(4)));
typedef float f32x2 __attribute__((ext_vector_type(2)));
typedef float f32x4 __attribute__((ext_vector_type(4)));
typedef float f32x16 __attribute__((ext_vector_type(16)));
typedef unsigned u32x2 __attribute__((ext_vector_type(2)));
typedef unsigned u32x4 __attribute__((ext_vector_type(4)));
typedef __bf16 bf16x2_t __attribute__((ext_vector_type(2)));
typedef float f32x32 __attribute__((ext_vector_type(32)));
typedef unsigned u32x6 __attribute__((ext_vector_type(6)));
typedef unsigned u32x16 __attribute__((ext_vector_type(16)));
typedef __bf16 bf16x32_t __attribute__((ext_vector_type(32)));

#define DI __device__ __forceinline__

constexpr int NTHR = 512;
constexpr int DM = 2048;
constexpr int TP = 8192;
constexpr int TS = 32768;
constexpr int TOK = TP + TS;
constexpr int LP = 256, LS = 4096;
constexpr float NORM_EPS = 1e-6f;
constexpr float LOG2E = 1.4426950408889634f;

enum { I_XP = 0, I_XS, I_C, I_CNK, I_CNV, I_CDK, I_CDV, I_S5RE, I_S5IM, I_CCTX, I_MODW, I_MODB, I_NMIXG, I_NFFNG, I_EVWIN, I_EVWOUT, I_NAQG, I_NAKG, I_RPB,
       I_HYCW, I_HYCB, I_HYW1, I_HYB1, I_HYF1, I_HYW2, I_HYB2, I_HYF2, I_HYW3, I_HYDEC, I_HYBIAS, I_ODWIN, I_ODWOUT, I_S5LRE, I_S5LIM, I_S5LDT, I_S5BRE, I_S5BIM,
       I_S5CRE, I_S5CIM, I_S5D, I_GLUW, I_GLUB, I_DQG, I_DKG, I_LQ1, I_LK1, I_LQ2, I_LK2, I_SUBG, I_PWQ, I_PKEYS, I_PU, I_PV, N_IN };

constexpr size_t O_Y = 0;
constexpr size_t O_NAK = 83886080, O_NAV = 92274688, O_DK = 100663296, O_DV = 109051904, O_SR = 117440512, O_SI = 117702656, O_END = 117964800;

constexpr size_t al256(size_t x) { return (x + 255) & ~(size_t)255; }
constexpr size_t WS_CTL = 0;
constexpr size_t WS_MODP = 65536;
constexpr size_t WS_MOD = WS_MODP + (size_t)2 * 16 * 9 * 12288 * 4;
constexpr size_t WS_WEVIN = al256(WS_MOD + (size_t)2 * 9 * 12288 * 4);
constexpr size_t WS_WEVOUT = WS_WEVIN + (size_t)6144 * 2048 * 2;
constexpr size_t WS_WODIN = WS_WEVOUT + (size_t)2048 * 2048 * 2;
constexpr size_t WS_WODOUT = WS_WODIN + (size_t)4096 * 2048 * 2;
constexpr size_t WS_WPQ = WS_WODOUT + (size_t)2048 * 2048 * 2;
constexpr size_t WS_WGLU = WS_WPQ + (size_t)2 * 2048 * 2048 * 2;
constexpr size_t WS_PKEYS = WS_WGLU + (size_t)1024 * 1024 * 2;
constexpr size_t WS_CNK = WS_PKEYS + (size_t)2 * 8 * 2 * 128 * 128 * 2;
constexpr size_t WS_CNVT = WS_CNK + (size_t)8 * 256 * 1024 * 2;
constexpr size_t WS_CDK = WS_CNVT + (size_t)8 * 256 * 1024 * 2;
constexpr size_t WS_CDVT = WS_CDK + (size_t)8 * 256 * 1024 * 2;
constexpr size_t WS_S5A = WS_CDVT + (size_t)8 * 256 * 1024 * 2;
constexpr size_t WS_S5BB = WS_S5A + (size_t)128 * 64 * 2 * 4;
constexpr size_t WS_S5CC = WS_S5BB + (size_t)128 * 128 * 16 * 2;
constexpr int KRL_S = 8208, KRL_P = 528;
constexpr size_t WS_KRS = WS_S5CC + (size_t)128 * 16 * 128 * 2;
constexpr size_t WS_KRP = al256(WS_KRS + (size_t)2 * 1024 * KRL_S * 2);
constexpr size_t WS_TBLU = al256(WS_KRP + (size_t)2 * 1024 * KRL_P * 2);
constexpr size_t WS_TBLV = WS_TBLU + (size_t)16384 * 2048 * 2;
constexpr size_t WS_HM = WS_TBLV + (size_t)16384 * 2048 * 2;
constexpr size_t WS_RA = WS_HM + (size_t)TOK * 2048 * 2;
constexpr size_t WS_RB = WS_RA + (size_t)TOK * 4096 * 2;
constexpr size_t WS_VT = WS_RB + (size_t)3072 * TOK * 2;
constexpr size_t WS_SC = WS_VT + (size_t)TOK * 1024 * 2;
constexpr size_t WS_END = WS_SC + (size_t)4 * 16384 * 4;
constexpr size_t RA_Q = 0;
constexpr size_t RA_SELI = (size_t)TOK * 2048 * 2;
constexpr size_t RA_SELW = RA_SELI + (size_t)TOK * 128 * 4;
constexpr size_t RA_CF = RA_SELW + (size_t)TOK * 128 * 4;
constexpr size_t RA_ZC = (size_t)TOK * 2048 * 2;
constexpr size_t RB_YF = 0, RB_YB = (size_t)TOK * 1024 * 2, RB_Y = (size_t)2 * TOK * 1024 * 2;
constexpr size_t VT_S = (size_t)TP * 1024 * 2;

constexpr int LDS_BYTES = 147456;

struct Params { const float* in[N_IN]; float* out; unsigned char* ws; int ph_lo, ph_hi; };

DI float bf2f(bf16_t b) { return __uint_as_float(((unsigned)b) << 16); }
DI float bflo(unsigned w) { return __uint_as_float(w << 16); }
DI float bfhi(unsigned w) { return __uint_as_float(w & 0xffff0000u); }
DI unsigned pk2(float a, float b) { f32x2 v = {a, b}; return __builtin_bit_cast(unsigned, __builtin_convertvector(v, bf16x2_t)); }
DI float dot2bf(unsigned a, unsigned b, float c) { return __builtin_amdgcn_fdot2_f32_bf16(__builtin_bit_cast(bf16x2_t, a), __builtin_bit_cast(bf16x2_t, b), c, false); }
DI bf16_t f2bf(float a) { return (bf16_t)(pk2(a, 0.f) & 0xffffu); }
DI float dpp_xor1(float v) { return __builtin_bit_cast(float, __builtin_amdgcn_update_dpp(0, __builtin_bit_cast(int, v), 0xB1, 0xF, 0xF, true)); }
DI float dpp_xor2(float v) { return __builtin_bit_cast(float, __builtin_amdgcn_update_dpp(0, __builtin_bit_cast(int, v), 0x4E, 0xF, 0xF, true)); }
DI float wave_sum(float v) {
    v += dpp_xor1(v); v += dpp_xor2(v);
    v += __builtin_bit_cast(float, __builtin_amdgcn_update_dpp(0, __builtin_bit_cast(int, v), 0x141, 0xF, 0xF, true));
    v += __builtin_bit_cast(float, __builtin_amdgcn_update_dpp(0, __builtin_bit_cast(int, v), 0x140, 0xF, 0xF, true));
    v += __builtin_bit_cast(float, __builtin_amdgcn_update_dpp(0, __builtin_bit_cast(int, v), 0x142, 0xA, 0xF, false));
    v += __builtin_bit_cast(float, __builtin_amdgcn_update_dpp(0, __builtin_bit_cast(int, v), 0x143, 0xC, 0xF, false));
    return __builtin_bit_cast(float, __builtin_amdgcn_readlane(__builtin_bit_cast(int, v), 63));
}
DI float gelu_tanh(float x) {
    const float u = 0.7978845608028654f * (x + 0.044715f * x * x * x);
    const float e = __expf(2.f * u);
    const float t = 1.f - 2.f / (e + 1.f);
    return 0.5f * x * (1.f + t);
}
DI float wave_max(float v) {
    v = fmaxf(v, dpp_xor1(v)); v = fmaxf(v, dpp_xor2(v));
    v = fmaxf(v, __builtin_bit_cast(float, __builtin_amdgcn_update_dpp(0, __builtin_bit_cast(int, v), 0x141, 0xF, 0xF, true)));
    v = fmaxf(v, __builtin_bit_cast(float, __builtin_amdgcn_update_dpp(0, __builtin_bit_cast(int, v), 0x140, 0xF, 0xF, true)));
    v = fmaxf(v, __builtin_bit_cast(float, __builtin_amdgcn_update_dpp(0, __builtin_bit_cast(int, v), 0x142, 0xA, 0xF, false)));
    v = fmaxf(v, __builtin_bit_cast(float, __builtin_amdgcn_update_dpp(0, __builtin_bit_cast(int, v), 0x143, 0xC, 0xF, false)));
    return __builtin_bit_cast(float, __builtin_amdgcn_readlane(__builtin_bit_cast(int, v), 63));
}
DI f32x2 fp8x2_lo(unsigned w) { return __builtin_amdgcn_cvt_pk_f32_fp8((int)w, false); }
DI f32x2 fp8x2_hi(unsigned w) { return __builtin_amdgcn_cvt_pk_f32_fp8((int)w, true); }
DI unsigned pk_fp8x4(float a, float b, float c, float d) { int r = 0; r = __builtin_amdgcn_cvt_pk_fp8_f32(a, b, r, false); r = __builtin_amdgcn_cvt_pk_fp8_f32(c, d, r, true); return (unsigned)r; }
DI int lane_id() { return (int)__builtin_amdgcn_mbcnt_hi(~0u, __builtin_amdgcn_mbcnt_lo(~0u, 0u)); }
DI int cond_of(int T) { return T < TP ? 0 : 1 + ((T - TP) >> 12); }
#define XB_TMO      128
#define XB_XCNT(j)  (256  + 64 * (j))
#define XB_XSUB(j)  (1280 + 64 * (j))
#define XB_XGEN(j)  (2304 + 64 * (j))
#define XB_TOP      3328
#define XB_TOPGEN   3392
#define XCD_BAR_WORDS 3456
#define XB_SPIN_CAP (1u << 26)
#define LAS __attribute__((address_space(3)))

__device__ __forceinline__ unsigned xb_ld(unsigned* p)              { return __hip_atomic_load(p, __ATOMIC_RELAXED, __HIP_MEMORY_SCOPE_AGENT); }
__device__ __forceinline__ unsigned xb_add(unsigned* p, unsigned v) { return __hip_atomic_fetch_add(p, v, __ATOMIC_RELAXED, __HIP_MEMORY_SCOPE_AGENT); }
__device__ __forceinline__ unsigned xb_xcc_id() { return (unsigned)__builtin_amdgcn_s_getreg((3 << 11) | 20) & 0xFu; }
#define XB_SPIN(cond, bar) do { unsigned _sp = 0; while (cond) { __builtin_amdgcn_s_sleep(1); \
    if ((++_sp & 255u) == 0u) { if (xb_ld(&(bar)[XB_TMO])) break; if (_sp > XB_SPIN_CAP) { atomicAdd(&(bar)[XB_TMO], 1u); break; } } } } while (0)

struct XcdBarrier {
    unsigned* bar; unsigned x;
    volatile LAS unsigned* st;
};

__device__ __forceinline__ XcdBarrier xcd_barrier_post(unsigned* bar, volatile LAS unsigned* st) {
    XcdBarrier b; b.bar = bar; b.x = xb_xcc_id(); b.st = st;
    if (threadIdx.x == 0) (void)xb_add(&bar[XB_XCNT(b.x)], 1u);
    return b;
}
__device__ __forceinline__ void xcd_barrier_complete(unsigned* bar, unsigned x, unsigned& nloc, unsigned& nx) {
    const unsigned G = gridDim.x * gridDim.y * gridDim.z;
    unsigned sum, cnt, mine, sp = 0u;
    for (;;) {
        sum = 0u; cnt = 0u; mine = 0u;
#pragma unroll
        for (unsigned j = 0; j < 16; ++j) { const unsigned c = xb_ld(&bar[XB_XCNT(j)]); sum += c; cnt += (c > 0u) ? 1u : 0u; mine = (j == x) ? c : mine; }
        if (sum == G) break;
        __builtin_amdgcn_s_sleep(1);
        if ((++sp & 255u) == 0u) { if (xb_ld(&bar[XB_TMO])) break; if (sp > XB_SPIN_CAP) { atomicAdd(&bar[XB_TMO], 1u); break; } }
    }
    nloc = mine > 0u ? mine : 1u; nx = cnt > 0u ? cnt : 1u;
}

__device__ __forceinline__ void xcd_barrier(const XcdBarrier& b) {
    asm volatile("s_waitcnt vmcnt(0)" ::: "memory");
    __syncthreads();
    if (threadIdx.x == 0) {
        unsigned* bar = b.bar;
        __builtin_amdgcn_s_waitcnt(0);
        unsigned nloc = b.st[0], nx = b.st[1];
        if (nloc == 0u) { xcd_barrier_complete(bar, b.x, nloc, nx); b.st[0] = nloc; b.st[1] = nx; }
        const unsigned old = xb_add(&bar[XB_XSUB(b.x)], 1u);
        const unsigned gen = old / nloc;
        if (old + 1u == (gen + 1u) * nloc) {
            __builtin_amdgcn_fence(__ATOMIC_RELEASE, "agent");
            asm volatile("s_waitcnt vmcnt(0)" ::: "memory");
            const unsigned og = xb_add(&bar[XB_TOP], 1u);
            const unsigned tg = og / nx;
            if (og + 1u == (tg + 1u) * nx) xb_add(&bar[XB_TOPGEN], 1u);
            else XB_SPIN(xb_ld(&bar[XB_TOPGEN]) == tg, bar);
            __builtin_amdgcn_fence(__ATOMIC_ACQUIRE, "agent");
            xb_add(&bar[XB_XGEN(b.x)], 1u);
            asm volatile("s_waitcnt vmcnt(0)" ::: "memory");
        } else {
            XB_SPIN(xb_ld(&bar[XB_XGEN(b.x)]) == gen, bar);
            __builtin_amdgcn_fence(__ATOMIC_ACQUIRE, "agent");
            asm volatile("s_waitcnt vmcnt(0)" ::: "memory");
        }
    }
    __syncthreads();
}
namespace pg8 {
#define PG8_LAS __attribute__((address_space(3)))
typedef unsigned short bf16_t;
typedef short bf16x8 __attribute__((ext_vector_type(8)));
typedef float f32x4 __attribute__((ext_vector_type(4)));
typedef unsigned u32x4 __attribute__((ext_vector_type(4)));
constexpr int BM = 256, BK = 64, HALF = 128, HTB = HALF * BK * 2  , STAGE_BYTES = 8 * HTB, NXCD = 8, WGM = 8;

__host__ __device__ __forceinline__ int lds_byte(int r, int c) { const int st = (r >> 4) * 2 + (c >> 5), rr = r & 15, cc = c & 31, ob = rr * 64 + cc * 2; return st * 1024 + (ob ^ (((ob >> 9) & 1) << 5)); }
__host__ __device__ __forceinline__ void stage_rc(int b, int& R, int& C) { const int st = b / 1024, sb = b % 1024, swz = sb ^ (((sb >> 9) & 1) << 5); R = (st >> 1) * 16 + swz / 64; C = (st & 1) * 32 + (swz % 64) / 2; }
__host__ __device__ __forceinline__ int perm32(int rho) { const int n = rho >> 4, i = rho & 15; return 8 * (i >> 2) + 4 * n + (i & 3); }

struct Unit { int pm, pn; };
struct Gemm { const bf16_t* A; const bf16_t* Bt; int M, N, K; };

struct StaticOrder {
    int nM, nN, nwg, G, c;
    __host__ __device__ void init(int M, int N, int G_, int c_) { nM = M / BM; nN = N / BM; nwg = nM * nN; G = G_; c = c_; }
    __host__ __device__ bool next(int i, Unit& u) const {
        const long L = (long)i * G + c; if (L >= nwg) return false;
        int wgid = (int)L; { const int q = nwg / NXCD, r = nwg % NXCD, xcd = wgid % NXCD, off = wgid / NXCD; wgid = (xcd < r ? xcd * (q + 1) : r * (q + 1) + (xcd - r) * q) + off; }
        const int nig = WGM * nN, gid = wgid / nig, fm = gid * WGM, gsz = (nM - fm) < WGM ? (nM - fm) : WGM;
        u.pm = fm + ((wgid % nig) % gsz); u.pn = (wgid % nig) / gsz; return true;
    }
    __device__ __forceinline__ void a_ready(const Unit&) const {}
    __device__ __forceinline__ void done(const Unit&) const {}
};
__device__ __forceinline__ unsigned cvt_pk_bf16(float lo, float hi) { unsigned r; asm volatile("v_cvt_pk_bf16_f32 %0, %1, %2" : "=v"(r) : "v"(lo), "v"(hi)); return r; }
template <class Epi, class Sched, bool STAMP = false>
__device__ __forceinline__ void gemm_phase(PG8_LAS unsigned char* lds, const Gemm g, const Sched& S, const Epi& E, unsigned long long* stamps) {
    const int tid = threadIdx.x, wid = __builtin_amdgcn_readfirstlane(tid >> 6), lane = tid & 63, wr = wid >> 2, wc = wid & 3, fr = lane & 15, fq = lane >> 4;
    const int K = g.K, nt = K / BK;
    int ts_lo = 0, ts_hi = 0, nts = 0; const unsigned long long rt_entry = STAMP ? (unsigned long long)wall_clock64() : 0ull;
#define PG8_STAMP() do { if (STAMP && wid == 0 && nts < 64) { const unsigned long long _c = (unsigned long long)clock64(); \
        ts_lo = (lane == nts) ? (int)(unsigned)_c : ts_lo; ts_hi = (lane == nts) ? (int)(unsigned)(_c >> 32) : ts_hi; ++nts; } } while (0)
    PG8_STAMP();
    unsigned voffA[2], voffB[2];
#pragma unroll
    for (int i = 0; i < 2; ++i) { int R, C; stage_rc(tid * 16 + i * 8192, R, C); const int Rb = Epi::PERM ? ((R & ~31) + perm32(R & 31)) : R;
        voffA[i] = (unsigned)(R * K + C) * 2u; voffB[i] = (unsigned)(Rb * K + C) * 2u; }
    const size_t kstep = (size_t)(BK * 2);
    const size_t hstep = (size_t)HALF * K * 2;
    const size_t tstep = 2 * hstep;
    const unsigned ldsw = (unsigned)wid * 1024u;
    const int aoff = lds_byte(wr * 64 + fr, fq * 8), boff = lds_byte(wc * 32 + fr, fq * 8);
#define PG8_SA(b, h) (((b) * 2 + (h)) * HTB)
#define PG8_SB(b, h) ((4 + (b) * 2 + (h)) * HTB)
#define PG8_STAGE(bufoff, gbase, voff) do { _Pragma("unroll") for (int _i = 0; _i < 2; ++_i) \
        __builtin_amdgcn_global_load_lds((const unsigned*)((const char*)(gbase) + (voff)[_i]), (PG8_LAS unsigned*)(lds + (bufoff) + ldsw + _i * 8192), 16, 0, 0); } while (0)
#define PG8_LDA(dst, b, h) do { _Pragma("unroll") for (int m = 0; m < 4; ++m) _Pragma("unroll") for (int k = 0; k < 2; ++k) dst[m][k] = *(const PG8_LAS bf16x8*)(lds + PG8_SA(b, h) + aoff + m * 2048 + k * 1024); } while (0)
#define PG8_LDB(dst, b, h) do { _Pragma("unroll") for (int n = 0; n < 2; ++n) _Pragma("unroll") for (int k = 0; k < 2; ++k) dst[n][k] = *(const PG8_LAS bf16x8*)(lds + PG8_SB(b, h) + boff + n * 2048 + k * 1024); } while (0)
#define PG8_MMA(ai, bj, At, Bt) do { __builtin_amdgcn_s_setprio(1); _Pragma("unroll") for (int m = 0; m < 4; ++m) _Pragma("unroll") for (int n = 0; n < 2; ++n) _Pragma("unroll") for (int k = 0; k < 2; ++k) \
        acc[ai][bj][m][n] = __builtin_amdgcn_mfma_f32_16x16x32_bf16(Bt[n][k], At[m][k], acc[ai][bj][m][n], 0, 0, 0); __builtin_amdgcn_s_setprio(0); } while (0)
#define PG8_WAIT_V(n) asm volatile("s_waitcnt vmcnt(" #n ")" ::: "memory")
#define PG8_WAIT_L(n) asm volatile("s_waitcnt lgkmcnt(" #n ")" ::: "memory")
#define PG8_BAR __builtin_amdgcn_s_barrier()
#define PG8_SCHED __builtin_amdgcn_sched_barrier(0)
    Unit cur, nxt; int ui = 0;
    if (!S.next(0, cur)) return;
    f32x4 acc[2][2][4][2];
#pragma unroll
    for (int a = 0; a < 2; ++a)
#pragma unroll
        for (int b = 0; b < 2; ++b)
#pragma unroll
            for (int m = 0; m < 4; ++m)
#pragma unroll
                for (int n = 0; n < 2; ++n) acc[a][b][m][n] = (f32x4){0.f, 0.f, 0.f, 0.f};
    bf16x8 At[4][2], B0[2][2], B1[2][2];
    const char* cA = (const char*)g.A + (size_t)cur.pm * tstep; const char* cB = (const char*)g.Bt + (size_t)cur.pn * tstep;
    S.a_ready(cur);
    PG8_STAGE(PG8_SB(0, 0), cB, voffB); PG8_STAGE(PG8_SA(0, 0), cA, voffA); PG8_STAGE(PG8_SB(0, 1), cB + hstep, voffB); PG8_STAGE(PG8_SA(0, 1), cA + hstep, voffA);
    if (wr == 1) PG8_BAR;
    PG8_WAIT_V(4); PG8_BAR;
    PG8_STAGE(PG8_SB(1, 0), cB + kstep, voffB); PG8_STAGE(PG8_SA(1, 0), cA + kstep, voffA); PG8_STAGE(PG8_SB(1, 1), cB + hstep + kstep, voffB);
    PG8_WAIT_V(6); PG8_BAR;
    PG8_STAMP();
    for (;;) {
        const bool has_next = S.next(ui + 1, nxt);
        const char* nA = has_next ? (const char*)g.A + (size_t)nxt.pm * tstep : cA; const char* nB = has_next ? (const char*)g.Bt + (size_t)nxt.pn * tstep : cB;
        for (int t = 0; t < nt; t += 2) {
            const bool last = (t == nt - 2);
            const char* a1 = cA + (size_t)(t + 1) * kstep;
            const char* a2 = last ? nA : cA + (size_t)(t + 2) * kstep; const char* b2 = last ? nB : cB + (size_t)(t + 2) * kstep;
            const char* a3 = a2 + kstep; const char* b3 = b2 + kstep;
            if (last && has_next) S.a_ready(nxt);
            PG8_LDB(B0, 0, 0); PG8_SCHED; PG8_LDA(At, 0, 0); PG8_STAGE(PG8_SA(1, 1), a1 + hstep, voffA);
            PG8_WAIT_L(8); PG8_BAR; PG8_WAIT_L(0); PG8_MMA(0, 0, At, B0); PG8_BAR; PG8_SCHED;
            PG8_LDB(B1, 0, 1); PG8_STAGE(PG8_SB(0, 0), b2, voffB);
            PG8_BAR; PG8_WAIT_L(0); PG8_MMA(0, 1, At, B1); PG8_BAR;
            PG8_LDA(At, 0, 1); PG8_STAGE(PG8_SA(0, 0), a2, voffA);
            PG8_BAR; PG8_WAIT_L(0); PG8_MMA(1, 0, At, B0); PG8_BAR; PG8_SCHED;
            PG8_STAGE(PG8_SB(0, 1), b2 + hstep, voffB);
            PG8_WAIT_V(6); PG8_BAR; PG8_MMA(1, 1, At, B1); PG8_BAR;
            PG8_LDB(B0, 1, 0); PG8_SCHED; PG8_LDA(At, 1, 0); PG8_STAGE(PG8_SA(0, 1), a2 + hstep, voffA);
            PG8_WAIT_L(8); PG8_BAR; PG8_WAIT_L(0); PG8_MMA(0, 0, At, B0); PG8_BAR; PG8_SCHED;
            PG8_LDB(B1, 1, 1); PG8_STAGE(PG8_SB(1, 0), b3, voffB);
            PG8_BAR; PG8_WAIT_L(0); PG8_MMA(0, 1, At, B1); PG8_BAR;
            PG8_LDA(At, 1, 1); PG8_STAGE(PG8_SA(1, 0), a3, voffA);
            PG8_BAR; PG8_WAIT_L(0); PG8_MMA(1, 0, At, B0); PG8_BAR; PG8_SCHED;
            PG8_STAGE(PG8_SB(1, 1), b3 + hstep, voffB);
            PG8_WAIT_V(6); PG8_BAR; PG8_MMA(1, 1, At, B1); PG8_BAR;
        }
        PG8_STAMP();
        if constexpr (!Epi::AFTER_DRAIN) { E(acc, cur, wr, wc, fr, fq); S.done(cur); }
        PG8_STAMP();
        if (!has_next) break;
#pragma unroll
        for (int a = 0; a < 2; ++a)
#pragma unroll
            for (int b = 0; b < 2; ++b)
#pragma unroll
                for (int m = 0; m < 4; ++m)
#pragma unroll
                    for (int n = 0; n < 2; ++n) acc[a][b][m][n] = (f32x4){0.f, 0.f, 0.f, 0.f};
        cur = nxt; cA = nA; cB = nB; ++ui;
    }
    PG8_WAIT_V(0);
    if (wr == 0) PG8_BAR;
    PG8_BAR;
    if constexpr (Epi::AFTER_DRAIN) { E.fused(acc, cur, wr, wc, fr, fq, lds, wid, lane); S.done(cur); }
    PG8_STAMP();
    if (STAMP && wid == 0) { stamps[lane] = lane < nts ? (((unsigned long long)(unsigned)ts_hi << 32) | (unsigned)ts_lo) : 0ull;
        if (lane == 62) stamps[62] = rt_entry; if (lane == 63) stamps[63] = (unsigned long long)wall_clock64(); }
#undef PG8_STAMP
#undef PG8_SA
#undef PG8_SB
#undef PG8_STAGE
#undef PG8_LDA
#undef PG8_LDB
#undef PG8_MMA
#undef PG8_WAIT_V
#undef PG8_WAIT_L
#undef PG8_BAR
#undef PG8_SCHED
}
}
struct Ctx {
    LAS unsigned char* lds; int tid, lane, wave, G, bid;
};

DI void cvt_rows(const Ctx& F, const float* src, bf16_t* dst, size_t n) {
    const size_t n8 = n >> 3;
    for (size_t i = (size_t)F.bid * NTHR + F.tid; i < n8; i += (size_t)F.G * NTHR) {
        const f32x4 a = *(const f32x4*)(src + i * 8), b = *(const f32x4*)(src + i * 8 + 4);
        u32x4 w; w.x = pk2(a.x, a.y); w.y = pk2(a.z, a.w); w.z = pk2(b.x, b.y); w.w = pk2(b.z, b.w);
        *(u32x4*)(dst + i * 8) = w;
    }
}

DI void tr_tile_f32(const Ctx& F, const float* src, size_t lds_, bf16_t* dst, size_t ldd, LAS bf16_t* tile) {
#pragma unroll
    for (int j = 0; j < 2; ++j) {
        const int id = F.tid + NTHR * j, kr = id >> 4, nc = (id & 15) * 4;
        const f32x4 v = *(const f32x4*)(src + (size_t)kr * lds_ + nc);
        tile[(nc + 0) * 72 + kr] = f2bf(v.x); tile[(nc + 1) * 72 + kr] = f2bf(v.y); tile[(nc + 2) * 72 + kr] = f2bf(v.z); tile[(nc + 3) * 72 + kr] = f2bf(v.w);
    }
    __syncthreads();
    { const int n = F.tid >> 3, kc = (F.tid & 7) * 8; const u32x4 v = *(const LAS u32x4*)(tile + n * 72 + kc); *(u32x4*)(dst + (size_t)n * ldd + kc) = v; }
    __syncthreads();
}
DI void tr_tile_bf16(const Ctx& F, const bf16_t* src, size_t lds_, bf16_t* dst, size_t ldd, LAS bf16_t* tile) {
    { const int kr = F.tid >> 3, nc = (F.tid & 7) * 8; const u32x4 v = *(const u32x4*)(src + (size_t)kr * lds_ + nc);
      tile[(nc + 0) * 72 + kr] = (bf16_t)(v.x & 0xffff); tile[(nc + 1) * 72 + kr] = (bf16_t)(v.x >> 16); tile[(nc + 2) * 72 + kr] = (bf16_t)(v.y & 0xffff); tile[(nc + 3) * 72 + kr] = (bf16_t)(v.y >> 16);
      tile[(nc + 4) * 72 + kr] = (bf16_t)(v.z & 0xffff); tile[(nc + 5) * 72 + kr] = (bf16_t)(v.z >> 16); tile[(nc + 6) * 72 + kr] = (bf16_t)(v.w & 0xffff); tile[(nc + 7) * 72 + kr] = (bf16_t)(v.w >> 16); }
    __syncthreads();
    { const int n = F.tid >> 3, kc = (F.tid & 7) * 8; const u32x4 v = *(const LAS u32x4*)(tile + n * 72 + kc); *(u32x4*)(dst + (size_t)n * ldd + kc) = v; }
    __syncthreads();
}
DI void transpose_weight(const Ctx& F, const float* W, int K, int N, bf16_t* Wt) {
    const int tk = K / 64, tn = N / 64;
    for (int t = F.bid; t < tk * tn; t += F.G) {
        const int k0 = (t / tn) * 64, n0 = (t % tn) * 64;
        tr_tile_f32(F, W + (size_t)k0 * N + n0, (size_t)N, Wt + (size_t)n0 * K + k0, (size_t)K, (LAS bf16_t*)F.lds);
    }
}
DI void transpose_cache_v(const Ctx& F, const float* V, bf16_t* VT) {
    for (int t = F.bid; t < 64 * 8; t += F.G) {
        const int bh = t >> 3, sub = t & 7, k0 = (sub >> 1) * 64, d0 = (sub & 1) * 64, b = bh >> 3, h = bh & 7;
        tr_tile_f32(F, V + ((size_t)b * 256 + k0) * 1024 + h * 128 + d0, 1024, VT + ((size_t)bh * 128 + d0) * 256 + k0, 256, (LAS bf16_t*)F.lds);
    }
}

DI void adaln_partials(const Ctx& F, const Params& P) {
    LAS float* s = (LAS float*)F.lds;
    const float* modw = P.in[I_MODW]; const float* cv = P.in[I_C]; const float* cctx = P.in[I_CCTX];
    float* modp = (float*)(P.ws + WS_MODP);
    for (int it = F.bid; it < 192; it += F.G) {
        const int i = it / 96, r = it % 96, ks = r / 6, cg = r % 6;
        __syncthreads();
        for (int e = F.tid; e < 9 * 128; e += NTHR) { const int j = e >> 7, k = e & 127; const float c = (j == 0) ? cctx[ks * 128 + k] : cv[(j - 1) * 2048 + ks * 128 + k]; s[e] = c / (1.f + __expf(-c)); }
        __syncthreads();
        f32x4 acc[9];
#pragma unroll
        for (int j = 0; j < 9; ++j) acc[j] = (f32x4){0.f, 0.f, 0.f, 0.f};
        const float* w = modw + ((size_t)i * 2048 + ks * 128) * 12288 + cg * 2048 + F.tid * 4;
#pragma unroll 8
        for (int k = 0; k < 128; ++k) {
            const f32x4 w4 = *(const f32x4*)(w + (size_t)k * 12288);
#pragma unroll
            for (int j = 0; j < 9; ++j) acc[j] += w4 * s[j * 128 + k];
        }
#pragma unroll
        for (int j = 0; j < 9; ++j) *(f32x4*)(modp + ((size_t)(i * 16 + ks) * 9 + j) * 12288 + cg * 2048 + F.tid * 4) = acc[j];
    }
    __syncthreads();
}
DI void adaln_reduce(const Ctx& F, const Params& P) {
    const float* modp = (const float*)(P.ws + WS_MODP); float* mod = (float*)(P.ws + WS_MOD); const float* modb = P.in[I_MODB];
    for (int e = F.bid * NTHR + F.tid; e < 2 * 9 * 12288; e += F.G * NTHR) {
        const int i = e / (9 * 12288), r = e % (9 * 12288), j = r / 12288, n = r % 12288;
        float a = modb[i * 12288 + n];
#pragma unroll
        for (int ks = 0; ks < 16; ++ks) a += modp[((size_t)(i * 16 + ks) * 9 + j) * 12288 + n];
        mod[e] = a;
    }
}

DI void hyena_filters(const Ctx& F, const Params& P) {
    LAS float* z = (LAS float*)F.lds;
    LAS float* h1 = z + 320;
    LAS float* h2 = h1 + 576;
    const float* w1 = P.in[I_HYW1]; const float* b1 = P.in[I_HYB1]; const float* f1 = P.in[I_HYF1];
    const float* w2 = P.in[I_HYW2]; const float* b2 = P.in[I_HYB2]; const float* f2 = P.in[I_HYF2];
    const float* w3 = P.in[I_HYW3]; const float* dec = P.in[I_HYDEC];
    for (int it = F.bid; it < 544; it += F.G) {
        const bool smp = it < 512; const int L = smp ? LS : LP, p0 = (smp ? it : it - 512) * 8, RL = smp ? KRL_S : KRL_P;
        bf16_t* KR = (bf16_t*)(P.ws + (smp ? WS_KRS : WS_KRP));
        __syncthreads();
        if (F.tid < 9 * 33) {
            const int ps = F.tid / 33, k = F.tid % 33, i = p0 + ps;
            const float t = (float)i / (float)(L - 1), wang = 6.283185307179586f * (float)i / (float)L;
            float val;
            if (k == 0) val = t;
            else { const int f = (k - 1) & 15; const float fr = 1e-4f + (float)f * ((15.0f - 1e-4f) / 15.0f); val = (k <= 16) ? cosf(fr * wang) : -sinf(fr * wang); }
            z[F.tid] = val;
        }
        __syncthreads();
        for (int e = F.tid; e < 9 * 64; e += NTHR) { const int ps = e >> 6, j = e & 63; float a = b1[j];
            for (int k = 0; k < 33; ++k) a += z[ps * 33 + k] * w1[k * 64 + j];
            h1[e] = sinf(f1[j] * a); }
        __syncthreads();
        for (int e = F.tid; e < 9 * 64; e += NTHR) { const int ps = e >> 6, j = e & 63; float a = b2[j];
            for (int k = 0; k < 64; ++k) a += h1[ps * 64 + k] * w2[k * 64 + j];
            h2[e] = sinf(f2[j] * a); }
        __syncthreads();
#pragma unroll 1
        for (int qh = 0; qh < 2; ++qh) {
            float acc[9][4];
#pragma unroll
            for (int ps = 0; ps < 9; ++ps)
#pragma unroll
                for (int q = 0; q < 4; ++q) acc[ps][q] = 0.f;
#pragma unroll 2
            for (int k = 0; k < 64; ++k) {
                float w[4];
#pragma unroll
                for (int q = 0; q < 4; ++q) w[q] = w3[k * 4096 + F.tid + NTHR * (qh * 4 + q)];
#pragma unroll
                for (int ps = 0; ps < 9; ++ps) { const float hv = h2[ps * 64 + k];
#pragma unroll
                    for (int q = 0; q < 4; ++q) acc[ps][q] += hv * w[q]; }
            }
#pragma unroll
            for (int q = 0; q < 4; ++q) {
                const int n = F.tid + NTHR * (qh * 4 + q), o = (n >> 10) & 1, c = n & 1023;
                const float dc = fabsf(dec[n]);
                bf16_t* row = KR + (size_t)(o * 1024 + c) * RL;
                float v[9];
#pragma unroll
                for (int ps = 0; ps < 9; ++ps) { const int i = p0 + ps; v[ps] = (i < L) ? acc[ps][q] * __expf(-((float)i / (float)(L - 1)) * dc) : 0.f; }
                if (qh == 0) {
                    u32x4 wv; wv.x = pk2(v[8], v[7]); wv.y = pk2(v[6], v[5]); wv.z = pk2(v[4], v[3]); wv.w = pk2(v[2], v[1]);
                    *(u32x4*)(row + (L - p0 - 8)) = wv;
                    if (p0 == 0) row[L] = f2bf(v[0]);
                } else if (p0 > 0) {
                    u32x4 wv; wv.x = pk2(v[0], v[1]); wv.y = pk2(v[2], v[3]); wv.z = pk2(v[4], v[5]); wv.w = pk2(v[6], v[7]);
                    *(u32x4*)(row + (L + p0)) = wv;
                } else {
#pragma unroll
                    for (int ps = 1; ps < 8; ++ps) row[L + ps] = f2bf(v[ps]);
                }
            }
        }
    }
    __syncthreads();
    for (int e = F.bid * NTHR + F.tid; e < 2 * 2048; e += F.G * NTHR) {
        const bool smp = e < 2048; const int r = e & 2047, L = smp ? LS : LP, RL = smp ? KRL_S : KRL_P;
        bf16_t* row = (bf16_t*)(P.ws + (smp ? WS_KRS : WS_KRP)) + (size_t)r * RL;
        for (int x = 2 * L; x < RL; ++x) row[x] = 0;
    }
}

DI void s5_consts(const Ctx& F, const Params& P) {
    float* S5A = (float*)(P.ws + WS_S5A); bf16_t* BB = (bf16_t*)(P.ws + WS_S5BB); bf16_t* CC = (bf16_t*)(P.ws + WS_S5CC);
    const float* lre = P.in[I_S5LRE]; const float* lim = P.in[I_S5LIM]; const float* ldt = P.in[I_S5LDT];
    const float* bre = P.in[I_S5BRE]; const float* bim = P.in[I_S5BIM]; const float* cre = P.in[I_S5CRE]; const float* cim = P.in[I_S5CIM];
    for (int e = F.bid * NTHR + F.tid; e < 8192; e += F.G * NTHR) {
        const int dg = e >> 6, n = e & 63;
        const float dt = expf(ldt[dg]), lr = lre[e], li = lim[e];
        const float mag = expf(lr * dt), ar = mag * cosf(li * dt), ai = mag * sinf(li * dt), den = lr * lr + li * li;
        const float cr = ((ar - 1.f) * lr + ai * li) / den, ci = (ai * lr - (ar - 1.f) * li) / den;
        S5A[e * 2] = ar; S5A[e * 2 + 1] = ai;
#pragma unroll
        for (int p = 0; p < 16; ++p) {
            const float br = bre[(size_t)e * 16 + p], bi = bim[(size_t)e * 16 + p];
            BB[((size_t)dg * 128 + n) * 16 + p] = f2bf(cr * br - ci * bi);
            BB[((size_t)dg * 128 + 64 + n) * 16 + p] = f2bf(cr * bi + ci * br);
            CC[((size_t)dg * 16 + p) * 128 + n] = f2bf(cre[((size_t)dg * 16 + p) * 64 + n]);
            CC[((size_t)dg * 16 + p) * 128 + 64 + n] = f2bf(-cim[((size_t)dg * 16 + p) * 64 + n]);
        }
    }
}

constexpr int PT_ROWB = 1536;
DI void cvt_table_fp6(const Ctx& F, const float* src, unsigned char* dst, float* scales, const int (&perm)[32]) {
    LAS float* scr = (LAS float*)(F.lds) + F.tid * 32;
    for (int r = F.bid * 8 + F.wave; r < 16384; r += F.G * 8) {
        f32x4 v[8]; float m = 0.f;
#pragma unroll
        for (int j = 0; j < 8; ++j) { v[j] = *(const f32x4*)(src + (size_t)r * 2048 + F.lane * 32 + j * 4);
            m = fmaxf(m, fmaxf(fmaxf(fabsf(v[j].x), fabsf(v[j].y)), fmaxf(fabsf(v[j].z), fabsf(v[j].w)))); }
        m = wave_max(m);
        const float inv = (m > 0.f) ? 7.0f / m : 0.f, sc = (m > 0.f) ? m / 7.0f : 0.f;
#pragma unroll
        for (int j = 0; j < 8; ++j) { scr[perm[j * 4 + 0]] = v[j].x * inv; scr[perm[j * 4 + 1]] = v[j].y * inv; scr[perm[j * 4 + 2]] = v[j].z * inv; scr[perm[j * 4 + 3]] = v[j].w * inv; }
        asm volatile("" ::: "memory");
        f32x16 a, b;
#pragma unroll
        for (int i = 0; i < 16; ++i) { a[i] = scr[i]; b[i] = scr[16 + i]; }
        asm volatile("" ::: "memory");
        const u32x6 pk = __builtin_amdgcn_cvt_scalef32_2xpk16_fp6_f32(a, b, 1.0f);
        unsigned char* o = dst + (size_t)r * PT_ROWB;
        *(u32x4*)(o + F.lane * 16) = (u32x4){pk[0], pk[1], pk[2], pk[3]}; *(u32x2*)(o + 1024 + F.lane * 8) = (u32x2){pk[4], pk[5]};
        if (F.lane == 0) scales[r] = sc;
    }
}
DI void convert_peer_tables(const Ctx& F, const Params& P) {
    int perm[32];
    { f32x16 a, b;
#pragma unroll
      for (int j = 0; j < 16; ++j) { a[j] = 0.125f * (float)j; b[j] = (j < 8) ? 2.0f + 0.25f * (float)j : 4.0f + 0.5f * (float)(j - 8); }
      const u32x6 pk = __builtin_amdgcn_cvt_scalef32_2xpk16_fp6_f32(a, b, 1.0f);
      const f32x32 rt = __builtin_amdgcn_cvt_scalef32_pk32_f32_fp6(pk, 1.0f);
#pragma unroll
      for (int i = 0; i < 32; ++i) { const float x = rt[i]; const int o = (x < 2.0f) ? (int)(x * 8.0f + 0.5f) : ((x < 4.0f) ? 16 + (int)((x - 2.0f) * 4.0f + 0.5f) : 24 + (int)((x - 4.0f) * 2.0f + 0.5f)); perm[i] = min(max(o, 0), 31); } }
    float* SC = (float*)(P.ws + WS_SC);
    __syncthreads();
    for (int layer = 0; layer < 2; ++layer) {
        cvt_table_fp6(F, P.in[I_PU] + (size_t)layer * 16384 * 2048, P.ws + WS_TBLU + (size_t)layer * 16384 * PT_ROWB, SC + layer * 16384, perm);
        cvt_table_fp6(F, P.in[I_PV] + (size_t)layer * 16384 * 2048, P.ws + WS_TBLV + (size_t)layer * 16384 * PT_ROWB, SC + (2 + layer) * 16384, perm);
    }
    __syncthreads();
}

DI void prologue(const Ctx& F, const Params& P) {
    adaln_partials(F, P);
    transpose_weight(F, P.in[I_EVWIN], 2048, 6144, (bf16_t*)(P.ws + WS_WEVIN));
    transpose_weight(F, P.in[I_EVWOUT], 2048, 2048, (bf16_t*)(P.ws + WS_WEVOUT));
    transpose_weight(F, P.in[I_ODWIN], 2048, 4096, (bf16_t*)(P.ws + WS_WODIN));
    transpose_weight(F, P.in[I_ODWOUT], 2048, 2048, (bf16_t*)(P.ws + WS_WODOUT));
    transpose_weight(F, P.in[I_PWQ], 2048, 2048, (bf16_t*)(P.ws + WS_WPQ));
    transpose_weight(F, P.in[I_PWQ] + (size_t)2048 * 2048, 2048, 2048, (bf16_t*)(P.ws + WS_WPQ) + (size_t)2048 * 2048);
    transpose_weight(F, P.in[I_GLUW], 1024, 1024, (bf16_t*)(P.ws + WS_WGLU));
    cvt_rows(F, P.in[I_PKEYS], (bf16_t*)(P.ws + WS_PKEYS), (size_t)2 * 8 * 2 * 128 * 128);
    cvt_rows(F, P.in[I_CNK], (bf16_t*)(P.ws + WS_CNK), (size_t)8 * 256 * 1024);
    cvt_rows(F, P.in[I_CDK], (bf16_t*)(P.ws + WS_CDK), (size_t)8 * 256 * 1024);
    transpose_cache_v(F, P.in[I_CNV], (bf16_t*)(P.ws + WS_CNVT));
    transpose_cache_v(F, P.in[I_CDV], (bf16_t*)(P.ws + WS_CDVT));
    hyena_filters(F, P);
    s5_consts(F, P);
    convert_peer_tables(F, P);
}
DI void norm_phase(const Ctx& F, const float* xa, const float* xb, const float* gvec, const float* modl, int sidx, bf16_t* H) {
    for (int T = F.bid * 8 + F.wave; T < TOK; T += F.G * 8) {
        const float* xr = T < TP ? xa + (size_t)T * DM : xb + (size_t)(T - TP) * DM;
        f32x4 v[8]; float ss = 0.f;
#pragma unroll
        for (int j = 0; j < 8; ++j) { v[j] = *(const f32x4*)(xr + (j * 64 + F.lane) * 4); ss += v[j].x * v[j].x + v[j].y * v[j].y + v[j].z * v[j].z + v[j].w * v[j].w; }
        ss = wave_sum(ss);
        const float rstd = rsqrtf(ss * (1.f / DM) + NORM_EPS);
        const float* sh = modl + (size_t)(cond_of(T) * 6 + sidx) * DM; const float* sc = sh + DM;
#pragma unroll
        for (int j = 0; j < 8; ++j) {
            const int col = (j * 64 + F.lane) * 4;
            const f32x4 g4 = *(const f32x4*)(gvec + col), s4 = *(const f32x4*)(sc + col), h4 = *(const f32x4*)(sh + col);
            const f32x4 o = v[j] * rstd * g4 * (s4 + 1.f) + h4;
            u32x2 w; w.x = pk2(o.x, o.y); w.y = pk2(o.z, o.w);
            *(u32x2*)(H + (size_t)T * DM + col) = w;
        }
    }
}

struct EpiBf16 {
    static constexpr bool PERM = true, AFTER_DRAIN = false;
    bf16_t* O; int ldc;
    DI void operator()(const f32x4 (&acc)[2][2][4][2], const pg8::Unit& u, int wr, int wc, int fr, int fq) const {
        const int row0 = u.pm * 256 + wr * 64 + fr, col0 = u.pn * 256 + wc * 32 + 8 * fq;
#pragma unroll
        for (int ai = 0; ai < 2; ++ai)
#pragma unroll
            for (int m = 0; m < 4; ++m) { bf16_t* rowp = O + (size_t)(row0 + ai * 128 + m * 16) * ldc + col0;
#pragma unroll
                for (int bj = 0; bj < 2; ++bj) { const f32x4 v0 = acc[ai][bj][m][0], v1 = acc[ai][bj][m][1];
                    u32x4 w; w.x = pk2(v0[0], v0[1]); w.y = pk2(v0[2], v0[3]); w.z = pk2(v1[0], v1[1]); w.w = pk2(v1[2], v1[3]);
                    *(u32x4*)(rowp + bj * 128) = w; } }
    }
};
struct EpiResid {
    static constexpr bool PERM = false, AFTER_DRAIN = false;
    const float* xa; const float* xb; float* out; const float* modl; int gidx;
    DI void operator()(const f32x4 (&acc)[2][2][4][2], const pg8::Unit& u, int wr, int wc, int fr, int fq) const {
        const int row0 = u.pm * 256 + wr * 64 + fr, col0 = u.pn * 256 + wc * 32 + 4 * fq;
        const float* xbase = (u.pm < 32) ? xa : xb - (size_t)TP * DM;
        const float* gate = modl + (size_t)(cond_of(u.pm * 256) * 6 + gidx) * DM;
        f32x4 gv[2][2];
#pragma unroll
        for (int bj = 0; bj < 2; ++bj)
#pragma unroll
            for (int n = 0; n < 2; ++n) gv[bj][n] = *(const f32x4*)(gate + col0 + bj * 128 + n * 16);
#pragma unroll
        for (int ai = 0; ai < 2; ++ai)
#pragma unroll
            for (int m = 0; m < 4; ++m) { const size_t ro = (size_t)(row0 + ai * 128 + m * 16) * DM + col0;
#pragma unroll
                for (int bj = 0; bj < 2; ++bj)
#pragma unroll
                    for (int n = 0; n < 2; ++n) { const f32x4 x4 = *(const f32x4*)(xbase + ro + bj * 128 + n * 16);
                        *(f32x4*)(out + ro + bj * 128 + n * 16) = x4 + gv[bj][n] * acc[ai][bj][m][n]; } }
    }
};
struct EpiGlu {
    static constexpr bool PERM = true, AFTER_DRAIN = false;
    const bf16_t* Y; bf16_t* O; const float* bias;
    DI void operator()(const f32x4 (&acc)[2][2][4][2], const pg8::Unit& u, int wr, int wc, int fr, int fq) const {
        const int row0 = u.pm * 256 + wr * 64 + fr, col0 = u.pn * 256 + wc * 32 + 8 * fq;
#pragma unroll
        for (int bj = 0; bj < 2; ++bj) {
            const f32x4 b0 = *(const f32x4*)(bias + col0 + bj * 128), b1 = *(const f32x4*)(bias + col0 + bj * 128 + 4);
#pragma unroll
            for (int ai = 0; ai < 2; ++ai)
#pragma unroll
                for (int m = 0; m < 4; ++m) { const size_t r = (size_t)(row0 + ai * 128 + m * 16);
                    const u32x4 yv = *(const u32x4*)(Y + r * 1024 + col0 + bj * 128);
                    const f32x4 a0 = acc[ai][bj][m][0] + b0, a1 = acc[ai][bj][m][1] + b1;
                    float o[8];
                    o[0] = bflo(yv.x) / (1.f + __expf(-a0[0])); o[1] = bfhi(yv.x) / (1.f + __expf(-a0[1]));
                    o[2] = bflo(yv.y) / (1.f + __expf(-a0[2])); o[3] = bfhi(yv.y) / (1.f + __expf(-a0[3]));
                    o[4] = bflo(yv.z) / (1.f + __expf(-a1[0])); o[5] = bfhi(yv.z) / (1.f + __expf(-a1[1]));
                    o[6] = bflo(yv.w) / (1.f + __expf(-a1[2])); o[7] = bfhi(yv.w) / (1.f + __expf(-a1[3]));
                    u32x4 w; w.x = pk2(o[0], o[1]); w.y = pk2(o[2], o[3]); w.z = pk2(o[4], o[5]); w.w = pk2(o[6], o[7]);
                    *(u32x4*)(O + r * DM + col0 + bj * 128) = w; }
        }
    }
};
template <class Epi> DI void run_gemm(const Ctx& F, const bf16_t* A, const bf16_t* Bt, int N, int K, const Epi& E) {
    pg8::Gemm g{A, Bt, TOK, N, K}; pg8::StaticOrder S; S.init(TOK, N, F.G, F.bid);
    pg8::gemm_phase<Epi, pg8::StaticOrder, false>(F.lds, g, S, E, nullptr);
    __syncthreads();
}

DI void prep_a(const Ctx& F, const Params& P) {
    const bf16_t* T1 = (const bf16_t*)(P.ws + WS_RA);
    bf16_t* VTp = (bf16_t*)(P.ws + WS_VT); bf16_t* VTs = (bf16_t*)(P.ws + WS_VT + VT_S);
    for (int t = F.bid; t < 2048 + 8192; t += F.G) {
        if (t < 2048) { const int bh = t >> 3, sub = t & 7, tk = sub >> 1, dd = sub & 1, b = bh >> 3, h = bh & 7;
            tr_tile_bf16(F, T1 + ((size_t)(b * 256 + tk * 64)) * 4096 + h * 128 + dd * 64, 4096, VTp + ((size_t)bh * 128 + dd * 64) * 256 + tk * 64, 256, (LAS bf16_t*)F.lds); }
        else { const int u = t - 2048, bh = u >> 7, sub = u & 127, tk = sub >> 1, dd = sub & 1, b = bh >> 3, h = bh & 7;
            tr_tile_bf16(F, T1 + ((size_t)(TP + b * 4096 + tk * 64)) * 4096 + h * 128 + dd * 64, 4096, VTs + ((size_t)bh * 128 + dd * 64) * 4096 + tk * 64, 4096, (LAS bf16_t*)F.lds); }
    }
    { float* o = P.out + O_NAV;
      for (int e = F.bid * NTHR + F.tid; e < TP * 128; e += F.G * NTHR) { const int T = e >> 7, c8 = (e & 127) * 8;
          const u32x4 v = *(const u32x4*)(T1 + (size_t)T * 4096 + c8);
          *(f32x4*)(o + (size_t)T * 1024 + c8) = (f32x4){bflo(v.x), bfhi(v.x), bflo(v.y), bfhi(v.y)};
          *(f32x4*)(o + (size_t)T * 1024 + c8 + 4) = (f32x4){bflo(v.z), bfhi(v.z), bflo(v.w), bfhi(v.w)}; } }
    { LAS bf16_t* tl = (LAS bf16_t*)F.lds;
      bf16_t* CM = (bf16_t*)(P.ws + WS_RB);
      const float* cw = P.in[I_HYCW]; const float* cb = P.in[I_HYCB];
      for (int t = F.bid; t < 48 * 160; t += F.G) {
          const int cg = t % 48, tg = t / 48, ch0 = cg * 64, t0 = tg * 256;
          const bool lz = (t0 < TP) ? true : (((t0 - TP) & 4095) == 0);
          const bool rz = (t0 < TP) ? true : (((t0 + 256 - TP) & 4095) == 0);
          __syncthreads();
#pragma unroll
          for (int j = 0; j < 4; ++j) { const int id = F.tid + NTHR * j, tk = id >> 3, c8 = (id & 7) * 8;
              const u32x4 v = *(const u32x4*)(T1 + (size_t)(t0 + tk) * 4096 + 1024 + ch0 + c8);
              LAS bf16_t* d = tl + tk + 1;
              d[(c8 + 0) * 264] = (bf16_t)(v.x & 0xffff); d[(c8 + 1) * 264] = (bf16_t)(v.x >> 16); d[(c8 + 2) * 264] = (bf16_t)(v.y & 0xffff); d[(c8 + 3) * 264] = (bf16_t)(v.y >> 16);
              d[(c8 + 4) * 264] = (bf16_t)(v.z & 0xffff); d[(c8 + 5) * 264] = (bf16_t)(v.z >> 16); d[(c8 + 6) * 264] = (bf16_t)(v.w & 0xffff); d[(c8 + 7) * 264] = (bf16_t)(v.w >> 16); }
          if (F.tid < 16) { const int side = F.tid >> 3, c8 = (F.tid & 7) * 8; const bool zero = side ? rz : lz; const int tk = side ? t0 + 256 : t0 - 1;
              u32x4 v = (u32x4){0u, 0u, 0u, 0u};
              if (!zero) v = *(const u32x4*)(T1 + (size_t)tk * 4096 + 1024 + ch0 + c8);
              LAS bf16_t* d = tl + (side ? 257 : 0);
              d[(c8 + 0) * 264] = (bf16_t)(v.x & 0xffff); d[(c8 + 1) * 264] = (bf16_t)(v.x >> 16); d[(c8 + 2) * 264] = (bf16_t)(v.y & 0xffff); d[(c8 + 3) * 264] = (bf16_t)(v.y >> 16);
              d[(c8 + 4) * 264] = (bf16_t)(v.z & 0xffff); d[(c8 + 5) * 264] = (bf16_t)(v.z >> 16); d[(c8 + 6) * 264] = (bf16_t)(v.w & 0xffff); d[(c8 + 7) * 264] = (bf16_t)(v.w >> 16); }
          __syncthreads();
#pragma unroll
          for (int j = 0; j < 4; ++j) { const int id = F.tid + NTHR * j, ch = id >> 5, to = (id & 31) * 8, cgl = ch0 + ch;
              const float w0 = cw[cgl], w1 = cw[3072 + cgl], w2 = cw[6144 + cgl], bb = cb[cgl];
              const LAS bf16_t* s = tl + ch * 264 + to;
              float r[10];
#pragma unroll
              for (int i = 0; i < 10; ++i) r[i] = bf2f(s[i]);
              float o[8];
#pragma unroll
              for (int i = 0; i < 8; ++i) o[i] = w0 * r[i] + w1 * r[i + 1] + w2 * r[i + 2] + bb;
              u32x4 w; w.x = pk2(o[0], o[1]); w.y = pk2(o[2], o[3]); w.z = pk2(o[4], o[5]); w.w = pk2(o[6], o[7]);
              *(u32x4*)(CM + (size_t)cgl * TOK + t0 + to) = w; }
      }
      __syncthreads(); }
}

DI void prep_b(const Ctx& F, const Params& P) {
    bf16_t* Pq = (bf16_t*)(P.ws + WS_RA); const float* qg = P.in[I_NAQG]; const float* kg = P.in[I_NAKG]; float* ok = P.out + O_NAK;
    const float* gsrc = (F.lane < 32 ? qg : kg) + (F.lane & 3) * 32;
    float g[32];
#pragma unroll
    for (int i = 0; i < 32; ++i) g[i] = gsrc[i];
    for (int T = F.bid * 8 + F.wave; T < TOK; T += F.G * 8) {
        bf16_t* rp = Pq + (size_t)T * 2048 + F.lane * 32;
        u32x4 v[4]; float x[32]; float ss = 0.f;
#pragma unroll
        for (int j = 0; j < 4; ++j) { v[j] = *(const u32x4*)(rp + j * 8);
            x[j * 8 + 0] = bflo(v[j].x); x[j * 8 + 1] = bfhi(v[j].x); x[j * 8 + 2] = bflo(v[j].y); x[j * 8 + 3] = bfhi(v[j].y);
            x[j * 8 + 4] = bflo(v[j].z); x[j * 8 + 5] = bfhi(v[j].z); x[j * 8 + 6] = bflo(v[j].w); x[j * 8 + 7] = bfhi(v[j].w); }
#pragma unroll
        for (int i = 0; i < 32; ++i) ss += x[i] * x[i];
        ss += dpp_xor1(ss); ss += dpp_xor2(ss);
        const float rstd = rsqrtf(ss * (1.f / 128.f) + NORM_EPS);
#pragma unroll
        for (int i = 0; i < 32; ++i) x[i] = x[i] * rstd * g[i];
#pragma unroll
        for (int j = 0; j < 4; ++j) { u32x4 w; w.x = pk2(x[j * 8 + 0], x[j * 8 + 1]); w.y = pk2(x[j * 8 + 2], x[j * 8 + 3]); w.z = pk2(x[j * 8 + 4], x[j * 8 + 5]); w.w = pk2(x[j * 8 + 6], x[j * 8 + 7]);
            *(u32x4*)(rp + j * 8) = w; }
        if (T < TP && F.lane >= 32) { float* o = ok + (size_t)T * 1024 + (F.lane - 32) * 32;
#pragma unroll
            for (int j = 0; j < 8; ++j) *(f32x4*)(o + j * 4) = (f32x4){x[j * 4], x[j * 4 + 1], x[j * 4 + 2], x[j * 4 + 3]}; }
    }
}
constexpr int AT_KROW = 272, AT_VROW = 136, AT_KTB = 64 * AT_KROW, AT_VTB = 128 * AT_VROW;
constexpr int AT_K0 = 0, AT_V0 = 2 * AT_KTB, AT_RPB = AT_V0 + 2 * AT_VTB;

struct TileMap { const bf16_t* latK; int latKld; const bf16_t* latV; int latVld; int nlat; const bf16_t* ctxK; const bf16_t* ctxV; int ntiles; };
struct TileRegs { u32x4 k[2], v[2]; };

DI void tile_src(const TileMap& M, int j, const bf16_t*& kp, int& kld, const bf16_t*& vp, int& vld) {
    if (j < M.nlat) { kp = M.latK + (size_t)j * 64 * M.latKld; kld = M.latKld; vp = M.latV + j * 64; vld = M.latVld; }
    else { const int c = j - M.nlat; kp = M.ctxK + (size_t)c * 64 * 1024; kld = 1024; vp = M.ctxV + c * 64; vld = 256; }
}
DI void tile_load(const Ctx& F, TileRegs& R, const bf16_t* kp, int kld, const bf16_t* vp, int vld, bool withV = true) {
#pragma unroll
    for (int j = 0; j < 2; ++j) { const int id = F.tid + NTHR * j;
        const unsigned ko = (unsigned)((id >> 4) * kld + (id & 15) * 8) * 2u, vo = (unsigned)((id >> 3) * vld + (id & 7) * 8) * 2u;
        R.k[j] = *(const u32x4*)((const char*)kp + ko);
        if (withV) R.v[j] = *(const u32x4*)((const char*)vp + vo); }
}
DI void tile_store(const Ctx& F, const TileRegs& R, LAS unsigned char* kt, LAS unsigned char* vt, bool withV = true) {
#pragma unroll
    for (int j = 0; j < 2; ++j) { const int id = F.tid + NTHR * j;
        *(LAS u32x4*)(kt + (id >> 4) * AT_KROW + (id & 15) * 16) = R.k[j];
        if (withV) { LAS unsigned char* vp = vt + (id >> 3) * AT_VROW + (id & 7) * 16;
            *(LAS u32x2*)(vp) = (u32x2){R.v[j].x, R.v[j].y}; *(LAS u32x2*)(vp + 8) = (u32x2){R.v[j].z, R.v[j].w}; } }
}

DI void tile_norm_k(const Ctx& F, TileRegs& R, const LAS float* kgain, float* nk, int nkld) {
#pragma unroll
    for (int j = 0; j < 2; ++j) { const int id = F.tid + NTHR * j;
        float x[8] = {bflo(R.k[j].x), bfhi(R.k[j].x), bflo(R.k[j].y), bfhi(R.k[j].y), bflo(R.k[j].z), bfhi(R.k[j].z), bflo(R.k[j].w), bfhi(R.k[j].w)};
        float ss = 0.f;
#pragma unroll
        for (int i = 0; i < 8; ++i) ss += x[i] * x[i];
        ss += dpp_xor1(ss); ss += dpp_xor2(ss);
        ss += __builtin_bit_cast(float, __builtin_amdgcn_update_dpp(0, __builtin_bit_cast(int, ss), 0x141, 0xF, 0xF, true));
        ss += __builtin_bit_cast(float, __builtin_amdgcn_update_dpp(0, __builtin_bit_cast(int, ss), 0x140, 0xF, 0xF, true));
        const float rstd = rsqrtf(ss * (1.f / 128.f) + NORM_EPS);
        const f32x4 g0 = *(const LAS f32x4*)(kgain + (id & 15) * 8), g1 = *(const LAS f32x4*)(kgain + (id & 15) * 8 + 4);
        x[0] *= rstd * g0.x; x[1] *= rstd * g0.y; x[2] *= rstd * g0.z; x[3] *= rstd * g0.w; x[4] *= rstd * g1.x; x[5] *= rstd * g1.y; x[6] *= rstd * g1.z; x[7] *= rstd * g1.w;
        R.k[j] = (u32x4){pk2(x[0], x[1]), pk2(x[2], x[3]), pk2(x[4], x[5]), pk2(x[6], x[7])};
        if (nk) { float* o = nk + (size_t)(id >> 4) * nkld + (id & 15) * 8; *(f32x4*)(o) = (f32x4){x[0], x[1], x[2], x[3]}; *(f32x4*)(o + 4) = (f32x4){x[4], x[5], x[6], x[7]}; }
    }
}

template <int KS>
DI f32x16 qk_tile(LAS const unsigned char* kt, const bf16x8 (&Qf)[8], int kb, int kk0, int q, int hh) {
    f32x16 S;
#pragma unroll
    for (int i = 0; i < 16; ++i) S[i] = 0.f;
#pragma unroll
    for (int ks = 0; ks < KS; ++ks) { const int kk = kk0 + ks;
        const bf16x8 A = *(const LAS bf16x8*)(kt + (kb * 32 + q) * AT_KROW + (kk * 16 + hh * 8) * 2);
        S = __builtin_amdgcn_mfma_f32_32x32x16_bf16(A, Qf[kk], S, 0, 0, 0); }
    return S;
}
DI void pv_tile(LAS const unsigned char* vt, const float (&p)[16], f32x16 (&O)[4], int kb, int q, int hh) {
#pragma unroll
    for (int s = 0; s < 2; ++s) {
        u32x4 pw; pw.x = pk2(p[8 * s + 0], p[8 * s + 1]); pw.y = pk2(p[8 * s + 2], p[8 * s + 3]); pw.z = pk2(p[8 * s + 4], p[8 * s + 5]); pw.w = pk2(p[8 * s + 6], p[8 * s + 7]);
        const bf16x8 Pf = __builtin_bit_cast(bf16x8, pw);
#pragma unroll
        for (int db = 0; db < 4; ++db) {
            LAS const unsigned char* ap = vt + (db * 32 + q) * AT_VROW + (kb * 32 + 16 * s + 4 * hh) * 2;
            const u32x2 lo = *(const LAS u32x2*)(ap), hi = *(const LAS u32x2*)(ap + 16);
            const bf16x8 A2 = __builtin_bit_cast(bf16x8, (u32x4){lo.x, lo.y, hi.x, hi.y});
            O[db] = __builtin_amdgcn_mfma_f32_32x32x16_bf16(A2, Pf, O[db], 0, 0, 0);
        }
        asm volatile("" ::: "memory");
    }
}
template <bool LAT>
DI void attn_compute1(LAS const unsigned char* kt, LAS const unsigned char* vt, const bf16x8 (&Qf)[8], f32x16 (&O)[4], float& ls, int lane, const LAS float* brow, int cq) {
    const int q = lane & 31, hh = lane >> 5;
    const int cs = min(max(cq - 8, 0), 48);
#pragma unroll 1
    for (int kb = 0; kb < 2; ++kb) {
        const f32x16 S = qk_tile<8>(kt, Qf, kb, 0, q, hh);
        float p[16];
#pragma unroll
        for (int i = 0; i < 16; ++i) {
            float arg = S[i];
            if (LAT) { const int ck = kb * 32 + (i & 3) + 8 * (i >> 2) + 4 * hh;
                arg += brow[min(max(ck - cq + 15, 0), 30)];
                p[i] = ((unsigned)(ck - cs) < 16u) ? __builtin_amdgcn_exp2f(arg) : 0.f; }
            else p[i] = __builtin_amdgcn_exp2f(arg);
            ls += p[i];
        }
        pv_tile(vt, p, O, kb, q, hh);
    }
}
DI void diff_pass1(LAS const unsigned char* kt, const bf16x8 (&Qf)[8], float (&ls)[2], int lane) {
    const int q = lane & 31, hh = lane >> 5;
#pragma unroll
    for (int kb = 0; kb < 2; ++kb) {
#pragma unroll
        for (int mp = 0; mp < 2; ++mp) { const f32x16 S = qk_tile<4>(kt, Qf, kb, mp * 4, q, hh);
#pragma unroll
            for (int i = 0; i < 16; ++i) ls[mp] += __builtin_amdgcn_exp2f(S[i]); }
    }
}
DI void diff_pass2(LAS const unsigned char* kt, LAS const unsigned char* vt, const bf16x8 (&Qf)[8], f32x16 (&O)[4], float w0, float w1, int lane) {
    const int q = lane & 31, hh = lane >> 5;
#pragma unroll
    for (int kb = 0; kb < 2; ++kb) {
        float p[16];
        { const f32x16 S0 = qk_tile<4>(kt, Qf, kb, 0, q, hh);
#pragma unroll
          for (int i = 0; i < 16; ++i) p[i] = __builtin_amdgcn_exp2f(S0[i]) * w0; }
        { const f32x16 S1 = qk_tile<4>(kt, Qf, kb, 4, q, hh);
#pragma unroll
          for (int i = 0; i < 16; ++i) p[i] -= __builtin_amdgcn_exp2f(S1[i]) * w1; }
        pv_tile(vt, p, O, kb, q, hh);
    }
}

template <int MODE>
DI void attn_phase(const Ctx& F, const Params& P) {
    constexpr bool DIFF = (MODE >= 2);
    constexpr bool NA = (MODE == 1);
    LAS unsigned char* lds = F.lds;
    LAS float* rpbl = (LAS float*)(lds + AT_RPB);
    LAS float* kgl = (LAS float*)(lds + AT_RPB + 2048);
    if (!DIFF) { __syncthreads(); if (F.tid < 128) kgl[F.tid] = P.in[I_NAKG][F.tid]; __syncthreads(); }
    const bf16_t* PA = (const bf16_t*)(P.ws + WS_RA);
    bf16_t* MIX = (bf16_t*)(P.ws + WS_HM);
    const bf16_t* VTp = (const bf16_t*)(P.ws + WS_VT); const bf16_t* VTs = (const bf16_t*)(P.ws + WS_VT + VT_S);
    const int q = F.lane & 31, hh = F.lane >> 5;
    const float c1 = (DIFF ? 0.125f : 0.08838834764831845f) * LOG2E;
    float lam = 0.f;
    if (DIFF) {
        const float a = wave_sum(P.in[I_LQ1][F.lane] * P.in[I_LK1][F.lane]), b = wave_sum(P.in[I_LQ2][F.lane] * P.in[I_LK2][F.lane]);
        lam = __expf(a) - __expf(b) + 0.35550906759096924f;
    }
    const int nunits = (MODE == 0 || MODE == 2) ? 256 : 1024;
    for (int u0 = F.bid; u0 < nunits; u0 += F.G) {
        int u = u0;
        if ((MODE == 1 || MODE == 3) && F.G == 256) { const int i = u0 >> 8, x = F.bid & 7, y = F.bid >> 3; u = ((2 * i + (y >> 4)) * 8 + x) * 16 + (y & 15); }
        int b, h, tok0, r = 0, rlo = 0; TileMap M;
        const bf16_t* qptr;
        if (MODE == 0) { b = u >> 3; h = u & 7; tok0 = b * 256 + F.wave * 32;
            qptr = PA + (size_t)(tok0 + q) * 2048 + h * 128;
            M.latK = PA + (size_t)(b * 256) * 2048 + 1024 + h * 128; M.latKld = 2048; M.latV = VTp + (size_t)(b * 8 + h) * 128 * 256; M.latVld = 256; M.nlat = 4; M.ctxK = nullptr; M.ctxV = nullptr; M.ntiles = 4; }
        else if (MODE == 1) { b = u >> 7; h = (u >> 4) & 7; const int rg = u & 15; r = 4 * rg + (F.wave >> 1);
            rlo = min(max(4 * rg - 4, 0), 56); const int rhi = min(max(4 * rg + 3 - 4, 0), 56) + 8;
            tok0 = TP + b * 4096 + r * 64 + (F.wave & 1) * 32;
            qptr = PA + (size_t)(tok0 + q) * 2048 + h * 128;
            M.latK = PA + (size_t)(TP + b * 4096 + rlo * 64) * 2048 + 1024 + h * 128; M.latKld = 2048; M.latV = VTs + (size_t)(b * 8 + h) * 128 * 4096 + rlo * 64; M.latVld = 4096; M.nlat = rhi - rlo;
            M.ctxK = (const bf16_t*)(P.ws + WS_CNK) + (size_t)b * 256 * 1024 + h * 128; M.ctxV = (const bf16_t*)(P.ws + WS_CNVT) + (size_t)(b * 8 + h) * 128 * 256; M.ntiles = M.nlat + 4;
            if (F.tid < 465) rpbl[F.tid] = P.in[I_RPB][h * 465 + F.tid] * LOG2E; }
        else if (MODE == 2) { b = u >> 3; h = u & 7; tok0 = b * 256 + F.wave * 32;
            qptr = PA + (size_t)(tok0 + q) * 4096 + 1024 + h * 128;
            M.latK = PA + (size_t)(b * 256) * 4096 + 2048 + h * 128; M.latKld = 4096; M.latV = VTp + (size_t)(b * 8 + h) * 128 * 256; M.latVld = 256; M.nlat = 4; M.ctxK = nullptr; M.ctxV = nullptr; M.ntiles = 4; }
        else { b = u >> 7; h = (u >> 4) & 7; const int qb = u & 15; tok0 = TP + b * 4096 + qb * 256 + F.wave * 32;
            qptr = PA + (size_t)(tok0 + q) * 4096 + 1024 + h * 128;
            M.latK = PA + (size_t)(TP + b * 4096) * 4096 + 2048 + h * 128; M.latKld = 4096; M.latV = VTs + (size_t)(b * 8 + h) * 128 * 4096; M.latVld = 4096; M.nlat = 64;
            M.ctxK = (const bf16_t*)(P.ws + WS_CDK) + (size_t)b * 256 * 1024 + h * 128; M.ctxV = (const bf16_t*)(P.ws + WS_CDVT) + (size_t)(b * 8 + h) * 128 * 256; M.ntiles = 68; }
        bf16x8 Qf[8];
        if constexpr (!DIFF) {
            u32x4 w[8]; float ss = 0.f;
#pragma unroll
            for (int ks = 0; ks < 8; ++ks) { w[ks] = *(const u32x4*)(qptr + ks * 16 + hh * 8);
                ss += bflo(w[ks].x) * bflo(w[ks].x) + bfhi(w[ks].x) * bfhi(w[ks].x) + bflo(w[ks].y) * bflo(w[ks].y) + bfhi(w[ks].y) * bfhi(w[ks].y)
                    + bflo(w[ks].z) * bflo(w[ks].z) + bfhi(w[ks].z) * bfhi(w[ks].z) + bflo(w[ks].w) * bflo(w[ks].w) + bfhi(w[ks].w) * bfhi(w[ks].w); }
            ss += __shfl_xor(ss, 32);
            const float qs = rsqrtf(ss * (1.f / 128.f) + NORM_EPS) * c1;
            const float* qg = P.in[I_NAQG];
#pragma unroll
            for (int ks = 0; ks < 8; ++ks) { const f32x4 g0 = *(const f32x4*)(qg + ks * 16 + hh * 8), g1 = *(const f32x4*)(qg + ks * 16 + hh * 8 + 4);
                const u32x4 ws = (u32x4){pk2(bflo(w[ks].x) * qs * g0.x, bfhi(w[ks].x) * qs * g0.y), pk2(bflo(w[ks].y) * qs * g0.z, bfhi(w[ks].y) * qs * g0.w),
                                         pk2(bflo(w[ks].z) * qs * g1.x, bfhi(w[ks].z) * qs * g1.y), pk2(bflo(w[ks].w) * qs * g1.z, bfhi(w[ks].w) * qs * g1.w)};
                Qf[ks] = __builtin_bit_cast(bf16x8, ws); }
        } else {
#pragma unroll
        for (int ks = 0; ks < 8; ++ks) { const u32x4 w = *(const u32x4*)(qptr + ks * 16 + hh * 8);
            const u32x4 ws = (u32x4){pk2(bflo(w.x) * c1, bfhi(w.x) * c1), pk2(bflo(w.y) * c1, bfhi(w.y) * c1), pk2(bflo(w.z) * c1, bfhi(w.z) * c1), pk2(bflo(w.w) * c1, bfhi(w.w) * c1)};
            Qf[ks] = __builtin_bit_cast(bf16x8, ws); }
        }
        f32x16 O[4]; float ls[2] = {0.f, 0.f}; float w0 = 0.f, w1 = 0.f;
#pragma unroll
        for (int db = 0; db < 4; ++db)
#pragma unroll
            for (int i = 0; i < 16; ++i) O[db][i] = 0.f;
        const int cq = (F.wave & 1) * 32 + q;
        const int r0w = min(max(r - 4, 0), 56);
        const int nt = M.ntiles;
        TileRegs R;
        { const bf16_t* kp; const bf16_t* vp; int kld, vld; tile_src(M, 0, kp, kld, vp, vld); tile_load(F, R, kp, kld, vp, vld); }
        if constexpr (!DIFF) tile_norm_k(F, R, kgl, (MODE == 0) ? P.out + O_NAK + (size_t)(b * 256) * 1024 + h * 128 : nullptr, 1024);
        tile_store(F, R, lds + AT_K0, lds + AT_V0);
        __syncthreads();
        if constexpr (DIFF) {
#pragma unroll 1
            for (int j = 0; j < nt; ++j) {
                const int cur = j & 1, jn = (j + 1 < nt) ? j + 1 : 0;
                const bool wv = (j + 1 == nt);
                { const bf16_t* kp; const bf16_t* vp; int kld, vld; tile_src(M, jn, kp, kld, vp, vld); tile_load(F, R, kp, kld, vp, vld, wv); }
                diff_pass1(lds + AT_K0 + cur * AT_KTB, Qf, ls, F.lane);
                tile_store(F, R, lds + AT_K0 + (cur ^ 1) * AT_KTB, lds + AT_V0 + (cur ^ 1) * AT_VTB, wv);
                __syncthreads();
            }
            { const float l0 = ls[0] + __shfl_xor(ls[0], 32), l1 = ls[1] + __shfl_xor(ls[1], 32); w0 = 1.f / l0; w1 = lam / l1; }
#pragma unroll 1
            for (int j = 0; j < nt; ++j) {
                const int cur = (nt + j) & 1;
                if (j + 1 < nt) { const bf16_t* kp; const bf16_t* vp; int kld, vld; tile_src(M, j + 1, kp, kld, vp, vld); tile_load(F, R, kp, kld, vp, vld); }
                diff_pass2(lds + AT_K0 + cur * AT_KTB, lds + AT_V0 + cur * AT_VTB, Qf, O, w0, w1, F.lane);
                if (j + 1 < nt) tile_store(F, R, lds + AT_K0 + (cur ^ 1) * AT_KTB, lds + AT_V0 + (cur ^ 1) * AT_VTB);
                __syncthreads();
            }
        } else {
#pragma unroll 1
            for (int j = 0; j < nt; ++j) {
                const int cur = j & 1;
                if (j + 1 < nt) { const bf16_t* kp; const bf16_t* vp; int kld, vld; tile_src(M, j + 1, kp, kld, vp, vld); tile_load(F, R, kp, kld, vp, vld); }
                LAS const unsigned char* kt = lds + AT_K0 + cur * AT_KTB; LAS const unsigned char* vt = lds + AT_V0 + cur * AT_VTB;
                if constexpr (NA) {
                    if (j < M.nlat) { const int kr = rlo + j;
                        if (kr >= r0w && kr < r0w + 8) attn_compute1<true>(kt, vt, Qf, O, ls[0], F.lane, rpbl + (kr - r + 7) * 31, cq); }
                    else attn_compute1<false>(kt, vt, Qf, O, ls[0], F.lane, rpbl, cq);
                } else attn_compute1<false>(kt, vt, Qf, O, ls[0], F.lane, rpbl, cq);
                if (j + 1 < nt) {
                    if (j + 1 < M.nlat) tile_norm_k(F, R, kgl, (MODE == 0) ? P.out + O_NAK + (size_t)(b * 256 + (j + 1) * 64) * 1024 + h * 128 : nullptr, 1024);
                    tile_store(F, R, lds + AT_K0 + (cur ^ 1) * AT_KTB, lds + AT_V0 + (cur ^ 1) * AT_VTB); }
                __syncthreads();
            }
        }
        if constexpr (!DIFF) {
            const float inv = 1.f / (ls[0] + __shfl_xor(ls[0], 32));
            bf16_t* op = MIX + (size_t)(tok0 + q) * DM + h * 128 + 4 * hh;
#pragma unroll
            for (int db = 0; db < 4; ++db)
#pragma unroll
                for (int g = 0; g < 4; ++g) { u32x2 w; w.x = pk2(O[db][4 * g] * inv, O[db][4 * g + 1] * inv); w.y = pk2(O[db][4 * g + 2] * inv, O[db][4 * g + 3] * inv);
                    *(u32x2*)(op + db * 32 + 8 * g) = w; }
        } else {
            float ss = 0.f;
#pragma unroll
            for (int db = 0; db < 4; ++db)
#pragma unroll
                for (int i = 0; i < 16; ++i) ss += O[db][i] * O[db][i];
            ss += __shfl_xor(ss, 32);
            const float sc = rsqrtf(ss * (1.f / 128.f) + NORM_EPS) * (1.f - 0.35550906759096924f);
            const float* sg = P.in[I_SUBG];
            bf16_t* op = MIX + (size_t)(tok0 + q) * DM + 1024 + h * 128 + 4 * hh;
#pragma unroll
            for (int db = 0; db < 4; ++db)
#pragma unroll
                for (int g = 0; g < 4; ++g) { const f32x4 g4 = *(const f32x4*)(sg + db * 32 + 8 * g + 4 * hh);
                    u32x2 w; w.x = pk2(O[db][4 * g] * sc * g4.x, O[db][4 * g + 1] * sc * g4.y); w.y = pk2(O[db][4 * g + 2] * sc * g4.z, O[db][4 * g + 3] * sc * g4.w);
                    *(u32x2*)(op + db * 32 + 8 * g) = w; }
        }
    }
}
template <int L, int BATCH> struct HyCfg {
    static constexpr int NB = L / 64, TPT = 32 / BATCH, NTILES = NB / TPT, LOGB = (BATCH == 8) ? 3 : 5;
    static constexpr int ZROWB = (L + 384) * 2 + 16, ZBYTES = BATCH * ZROWB, RL = 2 * L + 16;
    static constexpr int TPW = (NTILES + 7) / 8;
};
constexpr int HY_KR_OFF = 71808;

template <int L, int BATCH>
DI void hyena_part(const Ctx& F, const Params& P, int c, int tokbase  , const bf16_t* KRG  ) {
    typedef HyCfg<L, BATCH> C;
    LAS unsigned char* lds = F.lds;
    bf16_t* CM = (bf16_t*)(P.ws + WS_RB);
    const float* hbias = P.in[I_HYBIAS];
    const int q = F.lane & 31, hh = F.lane >> 5;
    __syncthreads();
    for (int id = F.tid; id < BATCH * (L / 8); id += NTHR) { const int b = id / (L / 8), s8 = (id % (L / 8)) * 8;
        *(LAS u32x4*)(lds + b * C::ZROWB + (192 + s8) * 2) = *(const u32x4*)(CM + (size_t)c * TOK + tokbase + b * L + s8); }
    for (int id = F.tid; id < BATCH * 48; id += NTHR) { const int b = id / 48, k = id % 48, e = (k < 24) ? k * 8 : (192 + L + (k - 24) * 8);
        *(LAS u32x4*)(lds + b * C::ZROWB + e * 2) = (u32x4){0u, 0u, 0u, 0u}; }
#pragma unroll 1
    for (int o = 0; o < 2; ++o) {
        { const bf16_t* src = KRG + (size_t)(o * 1024 + c) * C::RL;
          for (int id = F.tid; id < C::RL / 8; id += NTHR) { const u32x4 v = *(const u32x4*)(src + id * 8);
              *(LAS u32x4*)(lds + HY_KR_OFF + id * 16) = v;
              LAS bf16_t* c1 = (LAS bf16_t*)(lds + HY_KR_OFF + C::RL * 2) + id * 8 - 1;
              if (id > 0) c1[0] = (bf16_t)(v.x & 0xffff);
              c1[1] = (bf16_t)(v.x >> 16); c1[2] = (bf16_t)(v.y & 0xffff); c1[3] = (bf16_t)(v.y >> 16); c1[4] = (bf16_t)(v.z & 0xffff); c1[5] = (bf16_t)(v.z >> 16);
              c1[6] = (bf16_t)(v.w & 0xffff); c1[7] = (bf16_t)(v.w >> 16); } }
        __syncthreads();
        f32x16 acc[C::TPW][2];
#pragma unroll
        for (int t = 0; t < C::TPW; ++t)
#pragma unroll
            for (int mt = 0; mt < 2; ++mt)
#pragma unroll
                for (int i = 0; i < 16; ++i) acc[t][mt][i] = 0.f;
        const int tq0 = F.wave * C::TPW;
        if (tq0 < C::NTILES) {
            const int d1lo = C::TPT * tq0 - (C::NB - 1), d1hi = C::TPT * (tq0 + C::TPW - 1) + C::TPT - 1;
            const int abase = HY_KR_OFF + (F.lane & 1) * (C::RL * 2) + (L - (F.lane & 31) + 8 * hh - (F.lane & 1)) * 2;
            bf16x8 W0[6], W1[6], B0[C::TPW][4];
#define HY_LDW(Wv, d1v, i) do { LAS const unsigned* ap_ = (LAS const unsigned*)(lds + abase + (-4 * (d1v) - 2 + (i)) * 32); Wv[i] = __builtin_bit_cast(bf16x8, (u32x4){ap_[0], ap_[1], ap_[2], ap_[3]}); } while (0)
#define HY_LDB(Bv, d1v) do { _Pragma("unroll") for (int t_ = 0; t_ < C::TPW; ++t_) { const int tq_ = tq0 + t_; \
            const int t1_ = C::TPT * tq_ + (q >> C::LOGB), b_ = q & (BATCH - 1); int s1_ = t1_ - (d1v); s1_ = min(max(s1_, -3), C::NB + 2); \
            LAS const unsigned char* bp_ = lds + b_ * C::ZROWB + (192 + 64 * s1_ + 8 * hh) * 2; \
            _Pragma("unroll") for (int ks_ = 0; ks_ < 4; ++ks_) Bv[t_][ks_] = *(const LAS bf16x8*)(bp_ + ks_ * 32); } } while (0)
#define HY_MM(Wv, Bv, d1v) do { _Pragma("unroll") for (int t_ = 0; t_ < C::TPW; ++t_) { const int tq_ = tq0 + t_; \
            if ((d1v) >= C::TPT * tq_ - (C::NB - 1) && (d1v) <= C::TPT * tq_ + C::TPT - 1) { \
                _Pragma("unroll") for (int ks_ = 0; ks_ < 4; ++ks_) _Pragma("unroll") for (int mt_ = 0; mt_ < 2; ++mt_) \
                    acc[t_][mt_] = __builtin_amdgcn_mfma_f32_32x32x16_bf16(Wv[ks_ - 2 * mt_ + 2], Bv[t_][ks_], acc[t_][mt_], 0, 0, 0); } } } while (0)
#pragma unroll
            for (int i = 0; i < 6; ++i) HY_LDW(W0, d1lo, i);
            int d1 = d1lo;
#pragma unroll 1
            for (; d1 + 1 <= d1hi; d1 += 2) {
                HY_LDB(B0, d1);
#pragma unroll
                for (int i = 0; i < 4; ++i) HY_LDW(W1, d1 + 1, i);
                W1[4] = W0[0]; W1[5] = W0[1];
                HY_MM(W0, B0, d1);
                HY_LDB(B0, d1 + 1);
                if (d1 + 2 <= d1hi) {
#pragma unroll
                    for (int i = 0; i < 4; ++i) HY_LDW(W0, d1 + 2, i);
                    W0[4] = W1[0]; W0[5] = W1[1];
                }
                HY_MM(W1, B0, d1 + 1);
            }
            if (d1 <= d1hi) { HY_LDB(B0, d1); HY_MM(W0, B0, d1); }
#undef HY_LDW
#undef HY_LDB
#undef HY_MM
        }
        __syncthreads();
        if (tq0 < C::NTILES) {
            const float bo = hbias[o * 1024 + c];
            const bf16_t* gate = CM + (size_t)((1 + o) * 1024 + c) * TOK + tokbase;
            bf16_t* zout = (bf16_t*)(P.ws + WS_RA + RA_ZC) + (size_t)c * TOK + tokbase;
#pragma unroll
            for (int t = 0; t < C::TPW; ++t) { const int tq = tq0 + t, t1 = C::TPT * tq + (q >> C::LOGB), b = q & (BATCH - 1);
#pragma unroll
                for (int mt = 0; mt < 2; ++mt)
#pragma unroll
                    for (int g = 0; g < 4; ++g) { const int s = 64 * t1 + 32 * mt + 8 * g + 4 * hh;
                        LAS u32x2* zp = (LAS u32x2*)(lds + b * C::ZROWB + (192 + s) * 2);
                        const u32x2 zv = *zp, gv = *(const u32x2*)(gate + (size_t)b * L + s);
                        const float r0 = bflo(gv.x) * (acc[t][mt][4 * g] + bflo(zv.x) * bo), r1 = bfhi(gv.x) * (acc[t][mt][4 * g + 1] + bfhi(zv.x) * bo);
                        const float r2 = bflo(gv.y) * (acc[t][mt][4 * g + 2] + bflo(zv.y) * bo), r3 = bfhi(gv.y) * (acc[t][mt][4 * g + 3] + bfhi(zv.y) * bo);
                        const u32x2 w = (u32x2){pk2(r0, r1), pk2(r2, r3)};
                        if (o == 0) *zp = w; else *(u32x2*)(zout + (size_t)b * L + s) = w; } }
        }
        __syncthreads();
    }
}

DI void hyena_phase(const Ctx& F, const Params& P) {
    for (int c = F.bid; c < 1024; c += F.G) {
        hyena_part<LS, 8>(F, P, c, TP, (const bf16_t*)(P.ws + WS_KRS));
        hyena_part<LP, 32>(F, P, c, 0, (const bf16_t*)(P.ws + WS_KRP));
    }
}

DI void hyena_post(const Ctx& F, const Params& P) {
    const bf16_t* CM = (const bf16_t*)(P.ws + WS_RA + RA_ZC); bf16_t* MIX = (bf16_t*)(P.ws + WS_HM);
    for (int t = F.bid; t < 16 * 640; t += F.G) { const int cg = t & 15, tg = t >> 4;
        tr_tile_bf16(F, CM + (size_t)(cg * 64) * TOK + tg * 64, TOK, MIX + (size_t)(tg * 64) * DM + 1024 + cg * 64, DM, (LAS bf16_t*)F.lds); }
}
DI void prep_c(const Ctx& F, const Params& P) {
    bf16_t* PA = (bf16_t*)(P.ws + WS_RA);
    LAS float* rope = (LAS float*)(F.lds + 16384);
    __syncthreads();
    for (int e = F.tid; e < 1024; e += NTHR) { const int pos = e >> 4, f = e & 15; const float inv = exp2f(-(float)f * (13.287712379549449f / 16.f)); const float a = (float)pos * inv;
        rope[e * 2] = cosf(a); rope[e * 2 + 1] = sinf(a); }
    __syncthreads();
    { const float* gsrc = (F.lane < 32 ? P.in[I_DQG] : P.in[I_DKG]) + (F.lane & 1) * 32; float* ok = P.out + O_DK;
      float g[32];
#pragma unroll
      for (int i = 0; i < 32; ++i) g[i] = gsrc[i];
      for (int T = F.bid * 8 + F.wave; T < TOK; T += F.G * 8) {
          bf16_t* rp = PA + (size_t)T * 4096 + 1024 + F.lane * 32;
          u32x4 v[4]; float x[32]; float ss = 0.f;
#pragma unroll
          for (int j = 0; j < 4; ++j) { v[j] = *(const u32x4*)(rp + j * 8);
              x[j * 8 + 0] = bflo(v[j].x); x[j * 8 + 1] = bfhi(v[j].x); x[j * 8 + 2] = bflo(v[j].y); x[j * 8 + 3] = bfhi(v[j].y);
              x[j * 8 + 4] = bflo(v[j].z); x[j * 8 + 5] = bfhi(v[j].z); x[j * 8 + 6] = bflo(v[j].w); x[j * 8 + 7] = bfhi(v[j].w); }
#pragma unroll
          for (int i = 0; i < 32; ++i) ss += x[i] * x[i];
          ss += dpp_xor1(ss);
          const float rstd = rsqrtf(ss * (1.f / 64.f) + NORM_EPS);
#pragma unroll
          for (int i = 0; i < 32; ++i) x[i] = x[i] * rstd * g[i];
          if (T < TP) { if (F.lane >= 32) { float* o = ok + (size_t)T * 1024 + (F.lane - 32) * 32;
#pragma unroll
                  for (int j = 0; j < 8; ++j) *(f32x4*)(o + j * 4) = (f32x4){x[j * 4], x[j * 4 + 1], x[j * 4 + 2], x[j * 4 + 3]}; } }
          else { const int t = (T - TP) & 4095, pos = (F.lane & 1) ? (t & 63) : (t >> 6);
              const LAS float* rt = rope + pos * 32;
#pragma unroll
              for (int f = 0; f < 16; ++f) { const float cs = rt[2 * f], sn = rt[2 * f + 1], a = x[f], b = x[16 + f]; x[f] = a * cs - b * sn; x[16 + f] = b * cs + a * sn; } }
#pragma unroll
          for (int j = 0; j < 4; ++j) { u32x4 w; w.x = pk2(x[j * 8 + 0], x[j * 8 + 1]); w.y = pk2(x[j * 8 + 2], x[j * 8 + 3]); w.z = pk2(x[j * 8 + 4], x[j * 8 + 5]); w.w = pk2(x[j * 8 + 6], x[j * 8 + 7]);
              *(u32x4*)(rp + j * 8) = w; }
      } }
    __syncthreads();
    bf16_t* VTp = (bf16_t*)(P.ws + WS_VT); bf16_t* VTs = (bf16_t*)(P.ws + WS_VT + VT_S);
    for (int t = F.bid; t < 2048 + 8192; t += F.G) {
        if (t < 2048) { const int bh = t >> 3, sub = t & 7, tk = sub >> 1, dd = sub & 1, b = bh >> 3, h = bh & 7;
            tr_tile_bf16(F, PA + ((size_t)(b * 256 + tk * 64)) * 4096 + 3072 + h * 128 + dd * 64, 4096, VTp + ((size_t)bh * 128 + dd * 64) * 256 + tk * 64, 256, (LAS bf16_t*)F.lds); }
        else { const int u = t - 2048, bh = u >> 7, sub = u & 127, tk = sub >> 1, dd = sub & 1, b = bh >> 3, h = bh & 7;
            tr_tile_bf16(F, PA + ((size_t)(TP + b * 4096 + tk * 64)) * 4096 + 3072 + h * 128 + dd * 64, 4096, VTs + ((size_t)bh * 128 + dd * 64) * 4096 + tk * 64, 4096, (LAS bf16_t*)F.lds); }
    }
    { float* o = P.out + O_DV;
      for (int e = F.bid * NTHR + F.tid; e < TP * 128; e += F.G * NTHR) { const int T = e >> 7, c8 = (e & 127) * 8;
          const u32x4 v = *(const u32x4*)(PA + (size_t)T * 4096 + 3072 + c8);
          *(f32x4*)(o + (size_t)T * 1024 + c8) = (f32x4){bflo(v.x), bfhi(v.x), bflo(v.y), bfhi(v.y)};
          *(f32x4*)(o + (size_t)T * 1024 + c8 + 4) = (f32x4){bflo(v.z), bfhi(v.z), bflo(v.w), bfhi(v.w)}; } }
}

constexpr int S5_BUROW = 132 * 4, S5_HROW = 272, S5_WLDS = 16 * S5_BUROW + 16 * S5_HROW;
DI void s5_chain(const Ctx& F, const Params& P, int dg, int tok0, int L, const float* h0re, const float* h0im, float* fre, float* fim, bf16_t* Yout) {
    LAS unsigned char* wl = F.lds + F.wave * S5_WLDS; LAS unsigned char* hl = wl + 16 * S5_BUROW;
    const int g = dg & 63, dir = dg >> 6, lane = F.lane, st = lane & 15, gq = lane >> 4;
    const float* S5A = (const float*)(P.ws + WS_S5A); const bf16_t* BB = (const bf16_t*)(P.ws + WS_S5BB); const bf16_t* CC = (const bf16_t*)(P.ws + WS_S5CC);
    const bf16_t* PA = (const bf16_t*)(P.ws + WS_RA);
    const float ar = S5A[(dg * 64 + lane) * 2], ai = S5A[(dg * 64 + lane) * 2 + 1];
    float hr = h0re ? h0re[lane] : 0.f, hi = h0im ? h0im[lane] : 0.f;
    const bf16x8 zero8 = (bf16x8){0, 0, 0, 0, 0, 0, 0, 0};
    bf16x8 BBf[8], CCf[4];
#pragma unroll
    for (int mt = 0; mt < 8; ++mt) BBf[mt] = (gq < 2) ? *(const bf16x8*)(BB + ((size_t)dg * 128 + mt * 16 + st) * 16 + gq * 8) : zero8;
#pragma unroll
    for (int kk = 0; kk < 4; ++kk) CCf[kk] = *(const bf16x8*)(CC + ((size_t)dg * 16 + st) * 128 + kk * 32 + gq * 8);
    const int nch = L / 16;
    const int sgn = dir ? -1 : 1, tstart = dir ? tok0 + L - 1 : tok0;
    bf16x8 Uf = zero8, U1 = zero8, U2 = zero8;
    if (gq < 2) { Uf = *(const bf16x8*)(PA + (size_t)(tstart + sgn * st) * 4096 + g * 16 + gq * 8);
        if (1 < nch) U1 = *(const bf16x8*)(PA + (size_t)(tstart + sgn * (16 + st)) * 4096 + g * 16 + gq * 8);
        if (2 < nch) U2 = *(const bf16x8*)(PA + (size_t)(tstart + sgn * (32 + st)) * 4096 + g * 16 + gq * 8); }
    for (int ch = 0; ch < nch; ++ch) {
        bf16x8 Un = zero8;
        if (ch + 3 < nch && gq < 2) Un = *(const bf16x8*)(PA + (size_t)(tstart + sgn * ((ch + 3) * 16 + st)) * 4096 + g * 16 + gq * 8);
#pragma unroll
        for (int mt = 0; mt < 8; ++mt) { f32x4 d = (f32x4){0.f, 0.f, 0.f, 0.f};
            d = __builtin_amdgcn_mfma_f32_16x16x32_bf16(BBf[mt], Uf, d, 0, 0, 0);
            *(LAS f32x4*)(wl + st * S5_BUROW + (mt * 16 + gq * 4) * 4) = d; }
        asm volatile("" ::: "memory");
#pragma unroll
        for (int s = 0; s < 16; ++s) {
            const float bur = *(const LAS float*)(wl + s * S5_BUROW + lane * 4), bui = *(const LAS float*)(wl + s * S5_BUROW + (64 + lane) * 4);
            const float nr = ar * hr - ai * hi + bur, ni = ar * hi + ai * hr + bui; hr = nr; hi = ni;
            *(LAS bf16_t*)(hl + s * S5_HROW + lane * 2) = f2bf(hr); *(LAS bf16_t*)(hl + s * S5_HROW + (64 + lane) * 2) = f2bf(hi);
        }
        asm volatile("" ::: "memory");
        f32x4 y = (f32x4){0.f, 0.f, 0.f, 0.f};
#pragma unroll
        for (int kk = 0; kk < 4; ++kk) { const bf16x8 Bh = *(const LAS bf16x8*)(hl + st * S5_HROW + (kk * 32 + gq * 8) * 2);
            y = __builtin_amdgcn_mfma_f32_16x16x32_bf16(CCf[kk], Bh, y, 0, 0, 0); }
        { const int tok = tstart + sgn * (ch * 16 + st);
          *(u32x2*)(Yout + (size_t)tok * 1024 + g * 16 + gq * 4) = (u32x2){pk2(y[0], y[1]), pk2(y[2], y[3])}; }
        asm volatile("" ::: "memory");
        Uf = U1; U1 = U2; U2 = Un;
    }
    if (fre) { fre[lane] = hr; fim[lane] = hi; }
}

DI void s5_phase(const Ctx& F, const Params& P) {
    bf16_t* YF = (bf16_t*)(P.ws + WS_RB + RB_YF); bf16_t* YB = (bf16_t*)(P.ws + WS_RB + RB_YB);
    for (int cs = F.bid; cs < 256; cs += F.G) {
        if (F.wave < 4) { const int sc = cs * 4 + F.wave, dg = sc & 127, b = sc >> 7;
            s5_chain(F, P, dg, TP + b * 4096, LS, P.in[I_S5RE] + (size_t)sc * 64, P.in[I_S5IM] + (size_t)sc * 64, nullptr, nullptr, (dg >> 6) ? YB : YF); }
        else { for (int k = 0; k < 4; ++k) { const int pc = (cs * 4 + (F.wave - 4)) * 4 + k, dg = pc & 127, b = pc >> 7;
            s5_chain(F, P, dg, b * 256, LP, nullptr, nullptr, P.out + O_SR + (size_t)pc * 64, P.out + O_SI + (size_t)pc * 64, (dg >> 6) ? YB : YF); } }
    }
}

DI void s5_combine(const Ctx& F, const Params& P) {
    const bf16_t* PA = (const bf16_t*)(P.ws + WS_RA); const bf16_t* YF = (const bf16_t*)(P.ws + WS_RB + RB_YF); const bf16_t* YB = (const bf16_t*)(P.ws + WS_RB + RB_YB);
    bf16_t* Y = (bf16_t*)(P.ws + WS_RB + RB_Y); const float* dsk = P.in[I_S5D];
    for (size_t e = (size_t)F.bid * NTHR + F.tid; e < (size_t)TOK * 128; e += (size_t)F.G * NTHR) { const size_t T = e >> 7; const int c8 = (int)(e & 127) * 8;
        const u32x4 uv = *(const u32x4*)(PA + T * 4096 + c8), fv = *(const u32x4*)(YF + T * 1024 + c8), bv = *(const u32x4*)(YB + T * 1024 + c8);
        const f32x4 d0 = *(const f32x4*)(dsk + c8), d1 = *(const f32x4*)(dsk + c8 + 4);
        float o[8];
        o[0] = gelu_tanh(d0.x * bflo(uv.x) + bflo(fv.x) + bflo(bv.x)); o[1] = gelu_tanh(d0.y * bfhi(uv.x) + bfhi(fv.x) + bfhi(bv.x));
        o[2] = gelu_tanh(d0.z * bflo(uv.y) + bflo(fv.y) + bflo(bv.y)); o[3] = gelu_tanh(d0.w * bfhi(uv.y) + bfhi(fv.y) + bfhi(bv.y));
        o[4] = gelu_tanh(d1.x * bflo(uv.z) + bflo(fv.z) + bflo(bv.z)); o[5] = gelu_tanh(d1.y * bfhi(uv.z) + bfhi(fv.z) + bfhi(bv.z));
        o[6] = gelu_tanh(d1.z * bflo(uv.w) + bflo(fv.w) + bflo(bv.w)); o[7] = gelu_tanh(d1.w * bfhi(uv.w) + bfhi(fv.w) + bfhi(bv.w));
        u32x4 w; w.x = pk2(o[0], o[1]); w.y = pk2(o[2], o[3]); w.z = pk2(o[4], o[5]); w.w = pk2(o[6], o[7]);
        *(u32x4*)(Y + T * 1024 + c8) = w; }
}
constexpr int PS_KROW = 272;
constexpr int PS_IDX_OFF = 2 * 128 * PS_KROW;
constexpr int PS_TAB_OFF = PS_IDX_OFF + 512 * 32;

DI void topk_insert(float (&a)[16], float x) {
#pragma unroll
    for (int j = 15; j >= 1; --j) a[j] = __builtin_amdgcn_fmed3f(a[j - 1], a[j], x);
    a[0] = fmaxf(a[0], x);
}

DI void peer_select(const Ctx& F, const Params& P, int layer) {
    LAS unsigned char* lds = F.lds;
    const bf16_t* Q = (const bf16_t*)(P.ws + WS_RA + RA_Q);
    int* SELI = (int*)(P.ws + WS_RA + RA_SELI); float* SELW = (float*)(P.ws + WS_RA + RA_SELW);
    const bf16_t* KEYS = (const bf16_t*)(P.ws + WS_PKEYS) + (size_t)layer * 8 * 2 * 128 * 128;
    const int q = F.lane & 31, hh = F.lane >> 5;
    LAS unsigned char* myidx = lds + PS_IDX_OFF + F.tid * 32;
    LAS unsigned char* tab = lds + PS_TAB_OFF;
    for (int wu = F.bid; wu < 256; wu += F.G) {
        const int h = wu & 7, chunk = wu >> 3;
        __syncthreads();
        for (int id = F.tid; id < 2 * 128 * 16; id += NTHR) { const int row = id >> 4, c16 = id & 15;
            *(LAS u32x4*)(lds + row * PS_KROW + c16 * 16) = *(const u32x4*)(KEYS + ((size_t)h * 256 + row) * 128 + c16 * 8); }
        if (F.tid < 16) { int cnt = 0;
            for (int a = 0; a < F.tid; ++a) cnt += 16 / (a + 1);
            for (int b = 0; b < 16 / (F.tid + 1); ++b) { tab[(cnt + b) * 2] = (unsigned char)F.tid; tab[(cnt + b) * 2 + 1] = (unsigned char)b; } }
        __syncthreads();
        for (int blk = F.wave; blk < 40; blk += 8) {
            const int T0 = chunk * 1280 + blk * 32;
            float lst[2][16];
#pragma unroll
            for (int side = 0; side < 2; ++side) {
                bf16x8 Qf[8];
                const bf16_t* qp = Q + (size_t)(T0 + q) * 2048 + h * 256 + side * 128 + hh * 8;
#pragma unroll
                for (int ks = 0; ks < 8; ++ks) Qf[ks] = *(const bf16x8*)(qp + ks * 16);
                float a[16];
#pragma unroll
                for (int j = 0; j < 16; ++j) a[j] = -3.0e38f;
#pragma unroll
                for (int nt = 0; nt < 4; ++nt) {
                    f32x16 S;
#pragma unroll
                    for (int i = 0; i < 16; ++i) S[i] = 0.f;
#pragma unroll
                    for (int ks = 0; ks < 8; ++ks) { const bf16x8 A = *(const LAS bf16x8*)(lds + (side * 128 + nt * 32 + q) * PS_KROW + (ks * 16 + hh * 8) * 2);
                        S = __builtin_amdgcn_mfma_f32_32x32x16_bf16(A, Qf[ks], S, 0, 0, 0); }
#pragma unroll
                    for (int i = 0; i < 16; ++i) { const int n = nt * 32 + (i & 3) + 8 * (i >> 2) + 4 * hh;
                        topk_insert(a, __uint_as_float((__float_as_uint(S[i]) & 0xffffff80u) | (unsigned)n)); }
                }
                float pb[16];
#pragma unroll
                for (int j = 0; j < 16; ++j) pb[j] = __shfl_xor(a[j], 32);
#pragma unroll
                for (int j = 0; j < 16; ++j) topk_insert(a, pb[j]);
#pragma unroll
                for (int j = 0; j < 16; ++j) { lst[side][j] = a[j]; myidx[side * 16 + j] = (unsigned char)(__float_as_uint(a[j]) & 0x7fu); }
            }
            float cb[16];
#pragma unroll
            for (int j = 0; j < 16; ++j) cb[j] = -3.0e38f;
            { int cid = 0;
#pragma unroll
              for (int a = 0; a < 16; ++a)
#pragma unroll
                  for (int b = 0; b < 16 / (a + 1); ++b) {
                      const float sa = __uint_as_float(__float_as_uint(lst[0][a]) & 0xffffff80u), sb = __uint_as_float(__float_as_uint(lst[1][b]) & 0xffffff80u);
                      topk_insert(cb, __uint_as_float((__float_as_uint(sa + sb) & 0xffffffc0u) | (unsigned)cid)); ++cid; } }
            const float mx = __uint_as_float(__float_as_uint(cb[0]) & 0xffffffc0u);
            float e[16], den = 0.f;
#pragma unroll
            for (int j = 0; j < 16; ++j) { e[j] = __expf(__uint_as_float(__float_as_uint(cb[j]) & 0xffffffc0u) - mx); den += e[j]; }
            const float rden = 1.f / den;
#pragma unroll
            for (int j = 0; j < 16; ++j) {
                if ((j >> 3) == hh) { const int cid = (int)(__float_as_uint(cb[j]) & 0x3fu);
                    const int a = tab[cid * 2], b = tab[cid * 2 + 1];
                    const int eidx = (int)myidx[a] * 128 + (int)myidx[16 + b];
                    SELI[(size_t)(T0 + q) * 128 + h * 16 + j] = eidx; SELW[(size_t)(T0 + q) * 128 + h * 16 + j] = e[j] * rden; }
            }
        }
    }
    __syncthreads();
}

DI u32x16 fp6_unpack_bf16(u32x4 a, u32x2 b) { const u32x6 pk = {a.x, a.y, a.z, a.w, b.x, b.y}; return __builtin_bit_cast(u32x16, __builtin_amdgcn_cvt_scalef32_pk32_bf16_fp6(pk, 1.0f)); }
DI f32x32 fp6_unpack(u32x4 a, u32x2 b) { const u32x6 pk = {a.x, a.y, a.z, a.w, b.x, b.y}; return __builtin_amdgcn_cvt_scalef32_pk32_f32_fp6(pk, 1.0f); }
constexpr int GN = 8;
template <bool NEXTNORM>
DI void peer_gather(const Ctx& F, const Params& P, const float* modl, int layer, const float* ngain, const float* nmodl) {
    const bf16_t* H2 = (const bf16_t*)(P.ws + WS_HM);
    const unsigned char* TU = P.ws + WS_TBLU + (size_t)layer * 16384 * PT_ROWB; const unsigned char* TV = P.ws + WS_TBLV + (size_t)layer * 16384 * PT_ROWB;
    const float* SCU = (const float*)(P.ws + WS_SC) + layer * 16384; const float* SCV = (const float*)(P.ws + WS_SC) + (2 + layer) * 16384;
    const int* SELI = (const int*)(P.ws + WS_RA + RA_SELI); const float* SELW = (const float*)(P.ws + WS_RA + RA_SELW);
    float* X = P.out + O_Y;
    const int lane = lane_id();
    for (int T = F.bid * 8 + F.wave; T < TOK; T += F.G * 8) {
        u32x4 xw[4];
#pragma unroll
        for (int q4 = 0; q4 < 4; ++q4) xw[q4] = *(const u32x4*)(H2 + (size_t)T * DM + lane * 32 + q4 * 8);
        const int e0 = SELI[(size_t)T * 128 + lane], e1 = SELI[(size_t)T * 128 + 64 + lane];
        const float g0 = SELW[(size_t)T * 128 + lane], g1 = SELW[(size_t)T * 128 + 64 + lane];
        float d0 = 0.f, d1 = 0.f;
#pragma unroll 1
        for (int kb = 0; kb < 128; kb += GN) {
            u32x4 ura[GN]; u32x2 urb[GN];
#pragma unroll
            for (int j = 0; j < GN; ++j) { const int k = kb + j; const int e = __builtin_amdgcn_readlane(k < 64 ? e0 : e1, k & 63);
                const unsigned char* up = TU + (size_t)e * PT_ROWB;
                ura[j] = *(const u32x4*)(up + lane * 16); urb[j] = *(const u32x2*)(up + 1024 + lane * 8); }
#pragma unroll
            for (int j = 0; j < GN; ++j) { const u32x16 r = fp6_unpack_bf16(ura[j], urb[j]);
                float sa = 0.f, sb = 0.f, sc2 = 0.f, sd = 0.f;
#pragma unroll
                for (int i = 0; i < 4; ++i) { const unsigned x0 = xw[i].x, x1 = xw[i].y, x2 = xw[i].z, x3 = xw[i].w;
                    sa = dot2bf(r[4 * i], x0, sa); sb = dot2bf(r[4 * i + 1], x1, sb); sc2 = dot2bf(r[4 * i + 2], x2, sc2); sd = dot2bf(r[4 * i + 3], x3, sd); }
                const float sm = wave_sum((sa + sb) + (sc2 + sd)); const int k = kb + j;
                if (k < 64) { if (lane == k) d0 = sm; } else { if (lane == k - 64) d1 = sm; } }
        }
        const float cf0 = g0 * gelu_tanh(d0 * SCU[e0]) * SCV[e0], cf1 = g1 * gelu_tanh(d1 * SCU[e1]) * SCV[e1];
        f32x2 acc[16];
#pragma unroll
        for (int i = 0; i < 16; ++i) acc[i] = (f32x2){0.f, 0.f};
#pragma unroll 1
        for (int kb = 0; kb < 128; kb += GN) {
            u32x4 vra[GN]; u32x2 vrb[GN]; float cf[GN];
#pragma unroll
            for (int j = 0; j < GN; ++j) { const int k = kb + j; const int e = __builtin_amdgcn_readlane(k < 64 ? e0 : e1, k & 63);
                cf[j] = __builtin_bit_cast(float, __builtin_amdgcn_readlane(__builtin_bit_cast(int, k < 64 ? cf0 : cf1), k & 63));
                const unsigned char* vp = TV + (size_t)e * PT_ROWB;
                vra[j] = *(const u32x4*)(vp + lane * 16); vrb[j] = *(const u32x2*)(vp + 1024 + lane * 8); }
#pragma unroll
            for (int j = 0; j < GN; ++j) { const f32x32 r = fp6_unpack(vra[j], vrb[j]);
                const f32x2 c2 = (f32x2){cf[j], cf[j]};
#pragma unroll
                for (int i = 0; i < 16; ++i) acc[i] += c2 * (f32x2){r[2 * i], r[2 * i + 1]}; }
        }
        const float* gate = modl + (size_t)(cond_of(T) * 6 + 5) * DM;
        f32x4 xn[8]; float ss = 0.f;
#pragma unroll
        for (int q4 = 0; q4 < 8; ++q4) { const int col = lane * 32 + q4 * 4; float* xp = X + (size_t)T * DM + col;
            const f32x4 gv = *(const f32x4*)(gate + col), x0 = *(const f32x4*)(xp);
            const f32x4 r = x0 + gv * (f32x4){acc[q4 * 2].x, acc[q4 * 2].y, acc[q4 * 2 + 1].x, acc[q4 * 2 + 1].y};
            *(f32x4*)(xp) = r; xn[q4] = r; ss += r.x * r.x + r.y * r.y + r.z * r.z + r.w * r.w; }
        if (NEXTNORM) {
            ss = wave_sum(ss);
            const float rstd = rsqrtf(ss * (1.f / DM) + NORM_EPS);
            const float* sh = nmodl + (size_t)(cond_of(T) * 6 + 0) * DM; const float* sc = sh + DM;
            bf16_t* H = (bf16_t*)(P.ws + WS_HM);
#pragma unroll
            for (int q4 = 0; q4 < 8; ++q4) { const int col = lane * 32 + q4 * 4;
                const f32x4 g4 = *(const f32x4*)(ngain + col), s4 = *(const f32x4*)(sc + col), h4 = *(const f32x4*)(sh + col);
                const f32x4 o = xn[q4] * rstd * g4 * (s4 + 1.f) + h4;
                *(u32x2*)(H + (size_t)T * DM + col) = (u32x2){pk2(o.x, o.y), pk2(o.z, o.w)}; }
        }
    }
}
constexpr int NPHASE = 22;

__global__ void __launch_bounds__(NTHR, 2) mega(Params P) {
    extern __shared__ __attribute__((aligned(16))) unsigned char lds_raw[];
    Ctx F;
    F.lds = (LAS unsigned char*)lds_raw; F.tid = threadIdx.x; F.lane = F.tid & 63; F.wave = __builtin_amdgcn_readfirstlane(F.tid >> 6); F.G = gridDim.x; F.bid = blockIdx.x;
    const int lo = P.ph_lo, hi = P.ph_hi;
    volatile LAS unsigned* xbw = (volatile LAS unsigned*)(F.lds + LDS_BYTES - 16);
    if (F.tid == 0) { xbw[0] = 0u; xbw[1] = 0u; xbw[2] = 0u; xbw[3] = 0u; }
    __syncthreads();
    if (hi - lo > 1) (void)xcd_barrier_post((unsigned*)(P.ws + WS_CTL), xbw);
#define GRID_BARRIER() do { XcdBarrier bar_; bar_.bar = (unsigned*)(P.ws + WS_CTL); bar_.x = xb_xcc_id(); bar_.st = (volatile LAS unsigned*)(F.lds + LDS_BYTES - 16); xcd_barrier(bar_); } while (0)
#define PH(k, ...) if (lo <= (k) && (k) < hi) { { __VA_ARGS__ } if ((k) + 1 < hi) GRID_BARRIER(); }
#define MOD0 ((const float*)(P.ws + WS_MOD))
#define MOD1 ((const float*)(P.ws + WS_MOD) + 9 * 12288)
#define HM ((bf16_t*)(P.ws + WS_HM))
#define RA ((bf16_t*)(P.ws + WS_RA))
#define X (P.out + O_Y)

    PH(0, prologue(F, P);)
    PH(1, adaln_reduce(F, P);)
    PH(2, norm_phase(F, P.in[I_XP], P.in[I_XS], P.in[I_NMIXG], MOD0, 0, HM);)
    PH(3, { EpiBf16 E{RA, 4096}; run_gemm(F, HM, (const bf16_t*)(P.ws + WS_WEVIN) + (size_t)2048 * 2048, 4096, 2048, E); })
    PH(4, prep_a(F, P);)
    PH(5, { EpiBf16 E{RA, 2048}; run_gemm(F, HM, (const bf16_t*)(P.ws + WS_WEVIN), 2048, 2048, E); })
    PH(6, attn_phase<0>(F, P); attn_phase<1>(F, P); hyena_phase(F, P);)
    PH(7, hyena_post(F, P);)
    PH(8, { EpiResid E{P.in[I_XP], P.in[I_XS], X, MOD0, 2}; run_gemm(F, HM, (const bf16_t*)(P.ws + WS_WEVOUT), 2048, 2048, E); })
    PH(9, norm_phase(F, X, X + (size_t)TP * DM, P.in[I_NFFNG], MOD0, 3, HM);)
    PH(10, { EpiBf16 E{RA, 2048}; run_gemm(F, HM, (const bf16_t*)(P.ws + WS_WPQ), 2048, 2048, E); })
    PH(11, peer_select(F, P, 0);)
    PH(12, peer_gather<true>(F, P, MOD0, 0, P.in[I_NMIXG] + DM, MOD1);)
    PH(13, { EpiBf16 E{RA, 4096}; run_gemm(F, HM, (const bf16_t*)(P.ws + WS_WODIN), 4096, 2048, E); })
    PH(14, prep_c(F, P); s5_phase(F, P);)
    PH(15, attn_phase<2>(F, P); attn_phase<3>(F, P); s5_combine(F, P);)
    PH(16, { EpiGlu E{(const bf16_t*)(P.ws + WS_RB + RB_Y), HM, P.in[I_GLUB]}; run_gemm(F, (const bf16_t*)(P.ws + WS_RB + RB_Y), (const bf16_t*)(P.ws + WS_WGLU), 1024, 1024, E); })
    PH(17, { EpiResid E{X, X + (size_t)TP * DM, X, MOD1, 2}; run_gemm(F, HM, (const bf16_t*)(P.ws + WS_WODOUT), 2048, 2048, E); })
    PH(18, norm_phase(F, X, X + (size_t)TP * DM, P.in[I_NFFNG] + DM, MOD1, 3, HM);)
    PH(19, { EpiBf16 E{RA, 2048}; run_gemm(F, HM, (const bf16_t*)(P.ws + WS_WPQ) + (size_t)2048 * 2048, 2048, 2048, E); })
    PH(20, peer_select(F, P, 1);)
    PH(21, peer_gather<false>(F, P, MOD1, 1, nullptr, nullptr);)
#undef MOD0
#undef MOD1
#undef HM
#undef RA
#undef X
#undef PH
#undef GRID_BARRIER
}

extern "C" void kernel_launch(void* const* d_in, const int* in_sizes, int n_in, void* d_out, int out_size, void* d_ws, size_t ws_size, hipStream_t stream) {
    static int grid = 0;
    if (grid == 0) {
        if (n_in != N_IN || (size_t)out_size != O_END || ws_size < WS_END) { fprintf(stderr, "kernel_launch: unexpected shapes (n_in %d, out %d, ws %zu, need %zu)\n", n_in, out_size, ws_size, (size_t)WS_END); grid = -1; return; }
        int dev = 0, cus = 0;
        if (hipGetDevice(&dev) != hipSuccess || hipDeviceGetAttribute(&cus, hipDeviceAttributeMultiprocessorCount, dev) != hipSuccess) { grid = -1; return; }
        if (hipFuncSetAttribute((const void*)mega, hipFuncAttributeMaxDynamicSharedMemorySize, LDS_BYTES) != hipSuccess) { fprintf(stderr, "kernel_launch: hipFuncSetAttribute failed\n"); grid = -1; return; }
        int per_cu = 0;
        if (hipOccupancyMaxActiveBlocksPerMultiprocessor(&per_cu, (const void*)mega, NTHR, LDS_BYTES) != hipSuccess || per_cu < 1) { fprintf(stderr, "kernel_launch: occupancy query says %d blocks per CU\n", per_cu); }
        (void)hipGetLastError();
        grid = cus;
    }
    if (grid < 0) return;
    (void)hipMemsetAsync((char*)d_ws + WS_CTL, 0, 65536, stream);
    Params p; memset(&p, 0, sizeof(p));
    for (int i = 0; i < N_IN; ++i) p.in[i] = (const float*)d_in[i];
    p.out = (float*)d_out; p.ws = (unsigned char*)d_ws;
    p.ph_lo = 0; p.ph_hi = NPHASE;
    hipLaunchKernelGGL(mega, dim3(grid), dim3(NTHR), LDS_BYTES, stream, p);
}
```

```cpp
#include <hip/hip_runtime.h>
#include <cstdio>
#include <cstring>
#include <cstdint>

typedef unsigned short bf16_t;
typedef short bf16x8 __attribute__((ext_vector_type(8)));
typedef short s16x4 __attribute__((ext_vector_type(4)));
typedef float f32x2 __attribute__((ext_vector_type(2)));
typedef float f32x4 __attribute__((ext_vector_type(4)));
typedef float f32x16 __attribute__((ext_vector_type(16)));
typedef unsigned u32x2 __attribute__((ext_vector_type(2)));
typedef unsigned u32x4 __attribute__((ext_vector_type(4)));
typedef __bf16 bf16x2_t __attribute__((ext_vector_type(2)));
typedef float f32x32 __attribute__((ext_vector_type(32)));
typedef unsigned u32x6 __attribute__((ext_vector_type(6)));
typedef unsigned u32x16 __attribute__((ext_vector_type(16)));
typedef __bf16 bf16x32_t __attribute__((ext_vector_type(32)));

#define DI __device__ __forceinline__

constexpr int NTHR = 512;
constexpr int DM = 2048;
constexpr int TP = 8192;
constexpr int TS = 32768;
constexpr int TOK = TP + TS;
constexpr int LP = 256, LS = 4096;
constexpr float NORM_EPS = 1e-6f;
constexpr float LOG2E = 1.4426950408889634f;

enum { I_XP = 0, I_XS, I_C, I_CNK, I_CNV, I_CDK, I_CDV, I_S5RE, I_S5IM, I_CCTX, I_MODW, I_MODB, I_NMIXG, I_NFFNG, I_EVWIN, I_EVWOUT, I_NAQG, I_NAKG, I_RPB,
       I_HYCW, I_HYCB, I_HYW1, I_HYB1, I_HYF1, I_HYW2, I_HYB2, I_HYF2, I_HYW3, I_HYDEC, I_HYBIAS, I_ODWIN, I_ODWOUT, I_S5LRE, I_S5LIM, I_S5LDT, I_S5BRE, I_S5BIM,
       I_S5CRE, I_S5CIM, I_S5D, I_GLUW, I_GLUB, I_DQG, I_DKG, I_LQ1, I_LK1, I_LQ2, I_LK2, I_SUBG, I_PWQ, I_PKEYS, I_PU, I_PV, N_IN };

constexpr size_t O_Y = 0;
constexpr size_t O_NAK = 83886080, O_NAV = 92274688, O_DK = 100663296, O_DV = 109051904, O_SR = 117440512, O_SI = 117702656, O_END = 117964800;

constexpr size_t al256(size_t x) { return (x + 255) & ~(size_t)255; }
constexpr size_t WS_CTL = 0;
constexpr size_t WS_MODP = 65536;
constexpr size_t WS_MOD = WS_MODP + (size_t)2 * 16 * 9 * 12288 * 4;
constexpr size_t WS_WEVIN = al256(WS_MOD + (size_t)2 * 9 * 12288 * 4);
constexpr size_t WS_WEVOUT = WS_WEVIN + (size_t)6144 * 2048 * 2;
constexpr size_t WS_WODIN = WS_WEVOUT + (size_t)2048 * 2048 * 2;
constexpr size_t WS_WODOUT = WS_WODIN + (size_t)4096 * 2048 * 2;
constexpr size_t WS_WPQ = WS_WODOUT + (size_t)2048 * 2048 * 2;
constexpr size_t WS_WGLU = WS_WPQ + (size_t)2 * 2048 * 2048 * 2;
constexpr size_t WS_PKEYS = WS_WGLU + (size_t)1024 * 1024 * 2;
constexpr size_t WS_CNK = WS_PKEYS + (size_t)2 * 8 * 2 * 128 * 128 * 2;
constexpr size_t WS_CNVT = WS_CNK + (size_t)8 * 256 * 1024 * 2;
constexpr size_t WS_CDK = WS_CNVT + (size_t)8 * 256 * 1024 * 2;
constexpr size_t WS_CDVT = WS_CDK + (size_t)8 * 256 * 1024 * 2;
constexpr size_t WS_S5A = WS_CDVT + (size_t)8 * 256 * 1024 * 2;
constexpr size_t WS_S5BB = WS_S5A + (size_t)128 * 64 * 2 * 4;
constexpr size_t WS_S5CC = WS_S5BB + (size_t)128 * 128 * 16 * 2;
constexpr int KRL_S = 8208, KRL_P = 528;
constexpr size_t WS_KRS = WS_S5CC + (size_t)128 * 16 * 128 * 2;
constexpr size_t WS_KRP = al256(WS_KRS + (size_t)2 * 1024 * KRL_S * 2);
constexpr size_t WS_TBLU = al256(WS_KRP + (size_t)2 * 1024 * KRL_P * 2);
constexpr size_t WS_TBLV = WS_TBLU + (size_t)16384 * 2048 * 2;
constexpr size_t WS_HM = WS_TBLV + (size_t)16384 * 2048 * 2;
constexpr size_t WS_RA = WS_HM + (size_t)TOK * 2048 * 2;
constexpr size_t WS_RB = WS_RA + (size_t)TOK * 4096 * 2;
constexpr size_t WS_VT = WS_RB + (size_t)3072 * TOK * 2;
constexpr size_t WS_SC = WS_VT + (size_t)TOK * 1024 * 2;
constexpr size_t WS_END = WS_SC + (size_t)4 * 16384 * 4;
constexpr size_t RA_Q = 0;
constexpr size_t RA_SELI = (size_t)TOK * 2048 * 2;
constexpr size_t RA_SELW = RA_SELI + (size_t)TOK * 128 * 4;
constexpr size_t RA_CF = RA_SELW + (size_t)TOK * 128 * 4;
constexpr size_t RA_ZC = (size_t)TOK * 2048 * 2;
constexpr size_t RB_YF = 0, RB_YB = (size_t)TOK * 1024 * 2, RB_Y = (size_t)2 * TOK * 1024 * 2;
constexpr size_t VT_S = (size_t)TP * 1024 * 2;

constexpr int LDS_BYTES = 147456;

struct Params { const float* in[N_IN]; float* out; unsigned char* ws; int ph_lo, ph_hi; };

DI float bf2f(bf16_t b) { return __uint_as_float(((unsigned)b) << 16); }
DI float bflo(unsigned w) { return __uint_as_float(w << 16); }
DI float bfhi(unsigned w) { return __uint_as_float(w & 0xffff0000u); }
DI unsigned pk2(float a, float b) { f32x2 v = {a, b}; return __builtin_bit_cast(unsigned, __builtin_convertvector(v, bf16x2_t)); }
DI float dot2bf(unsigned a, unsigned b, float c) { return __builtin_amdgcn_fdot2_f32_bf16(__builtin_bit_cast(bf16x2_t, a), __builtin_bit_cast(bf16x2_t, b), c, false); }
DI bf16_t f2bf(float a) { return (bf16_t)(pk2(a, 0.f) & 0xffffu); }
DI float dpp_xor1(float v) { return __builtin_bit_cast(float, __builtin_amdgcn_update_dpp(0, __builtin_bit_cast(int, v), 0xB1, 0xF, 0xF, true)); }
DI float dpp_xor2(float v) { return __builtin_bit_cast(float, __builtin_amdgcn_update_dpp(0, __builtin_bit_cast(int, v), 0x4E, 0xF, 0xF, true)); }
DI float wave_sum(float v) {
    v += dpp_xor1(v); v += dpp_xor2(v);
    v += __builtin_bit_cast(float, __builtin_amdgcn_update_dpp(0, __builtin_bit_cast(int, v), 0x141, 0xF, 0xF, true));
    v += __builtin_bit_cast(float, __builtin_amdgcn_update_dpp(0, __builtin_bit_cast(int, v), 0x140, 0xF, 0xF, true));
    v += __builtin_bit_cast(float, __builtin_amdgcn_update_dpp(0, __builtin_bit_cast(int, v), 0x142, 0xA, 0xF, false));
    v += __builtin_bit_cast(float, __builtin_amdgcn_update_dpp(0, __builtin_bit_cast(int, v), 0x143, 0xC, 0xF, false));
    return __builtin_bit_cast(float, __builtin_amdgcn_readlane(__builtin_bit_cast(int, v), 63));
}
DI float gelu_tanh(float x) {
    const float u = 0.7978845608028654f * (x + 0.044715f * x * x * x);
    const float e = __expf(2.f * u);
    const float t = 1.f - 2.f / (e + 1.f);
    return 0.5f * x * (1.f + t);
}
DI float wave_max(float v) {
    v = fmaxf(v, dpp_xor1(v)); v = fmaxf(v, dpp_xor2(v));
    v = fmaxf(v, __builtin_bit_cast(float, __builtin_amdgcn_update_dpp(0, __builtin_bit_cast(int, v), 0x141, 0xF, 0xF, true)));
    v = fmaxf(v, __builtin_bit_cast(float, __builtin_amdgcn_update_dpp(0, __builtin_bit_cast(int, v), 0x140, 0xF, 0xF, true)));
    v = fmaxf(v, __builtin_bit_cast(float, __builtin_amdgcn_update_dpp(0, __builtin_bit_cast(int, v), 0x142, 0xA, 0xF, false)));
    v = fmaxf(v, __builtin_bit_cast(float, __builtin_amdgcn_update_dpp(0, __builtin_bit_cast(int, v), 0x143, 0xC, 0xF, false)));
    return __builtin_bit_cast(float, __builtin_amdgcn_readlane(__builtin_bit_cast(int, v), 63));
}
DI f32x2 fp8x2_lo(unsigned w) { return __builtin_amdgcn_cvt_pk_f32_fp8((int)w, false); }
DI f32x2 fp8x2_hi(unsigned w) { return __builtin_amdgcn_cvt_pk_f32_fp8((int)w, true); }
DI unsigned pk_fp8x4(float a, float b, float c, float d) { int r = 0; r = __builtin_amdgcn_cvt_pk_fp8_f32(a, b, r, false); r = __builtin_amdgcn_cvt_pk_fp8_f32(c, d, r, true); return (unsigned)r; }
DI int lane_id() { return (int)__builtin_amdgcn_mbcnt_hi(~0u, __builtin_amdgcn_mbcnt_lo(~0u, 0u)); }
DI int cond_of(int T) { return T < TP ? 0 : 1 + ((T - TP) >> 12); }
#define XB_TMO      128
#define XB_XCNT(j)  (256  + 64 * (j))
#define XB_XSUB(j)  (1280 + 64 * (j))
#define XB_XGEN(j)  (2304 + 64 * (j))
#define XB_TOP      3328
#define XB_TOPGEN   3392
#define XCD_BAR_WORDS 3456
#define XB_SPIN_CAP (1u << 26)
#define LAS __attribute__((address_space(3)))

__device__ __forceinline__ unsigned xb_ld(unsigned* p)              { return __hip_atomic_load(p, __ATOMIC_RELAXED, __HIP_MEMORY_SCOPE_AGENT); }
__device__ __forceinline__ unsigned xb_add(unsigned* p, unsigned v) { return __hip_atomic_fetch_add(p, v, __ATOMIC_RELAXED, __HIP_MEMORY_SCOPE_AGENT); }
__device__ __forceinline__ unsigned xb_xcc_id() { return (unsigned)__builtin_amdgcn_s_getreg((3 << 11) | 20) & 0xFu; }
#define XB_SPIN(cond, bar) do { unsigned _sp = 0; while (cond) { __builtin_amdgcn_s_sleep(1); \
    if ((++_sp & 255u) == 0u) { if (xb_ld(&(bar)[XB_TMO])) break; if (_sp > XB_SPIN_CAP) { atomicAdd(&(bar)[XB_TMO], 1u); break; } } } } while (0)

struct XcdBarrier {
    unsigned* bar; unsigned x;
    volatile LAS unsigned* st;
};

__device__ __forceinline__ XcdBarrier xcd_barrier_post(unsigned* bar, volatile LAS unsigned* st) {
    XcdBarrier b; b.bar = bar; b.x = xb_xcc_id(); b.st = st;
    if (threadIdx.x == 0) (void)xb_add(&bar[XB_XCNT(b.x)], 1u);
    return b;
}
__device__ __forceinline__ void xcd_barrier_complete(unsigned* bar, unsigned x, unsigned& nloc, unsigned& nx) {
    const unsigned G = gridDim.x * gridDim.y * gridDim.z;
    unsigned sum, cnt, mine, sp = 0u;
    for (;;) {
        sum = 0u; cnt = 0u; mine = 0u;
#pragma unroll
        for (unsigned j = 0; j < 16; ++j) { const unsigned c = xb_ld(&bar[XB_XCNT(j)]); sum += c; cnt += (c > 0u) ? 1u : 0u; mine = (j == x) ? c : mine; }
        if (sum == G) break;
        __builtin_amdgcn_s_sleep(1);
        if ((++sp & 255u) == 0u) { if (xb_ld(&bar[XB_TMO])) break; if (sp > XB_SPIN_CAP) { atomicAdd(&bar[XB_TMO], 1u); break; } }
    }
    nloc = mine > 0u ? mine : 1u; nx = cnt > 0u ? cnt : 1u;
}

__device__ __forceinline__ void xcd_barrier(const XcdBarrier& b) {
    asm volatile("s_waitcnt vmcnt(0)" ::: "memory");
    __syncthreads();
    if (threadIdx.x == 0) {
        unsigned* bar = b.bar;
        __builtin_amdgcn_s_waitcnt(0);
        unsigned nloc = b.st[0], nx = b.st[1];
        if (nloc == 0u) { xcd_barrier_complete(bar, b.x, nloc, nx); b.st[0] = nloc; b.st[1] = nx; }
        const unsigned old = xb_add(&bar[XB_XSUB(b.x)], 1u);
        const unsigned gen = old / nloc;
        if (old + 1u == (gen + 1u) * nloc) {
            __builtin_amdgcn_fence(__ATOMIC_RELEASE, "agent");
            asm volatile("s_waitcnt vmcnt(0)" ::: "memory");
            const unsigned og = xb_add(&bar[XB_TOP], 1u);
            const unsigned tg = og / nx;
            if (og + 1u == (tg + 1u) * nx) xb_add(&bar[XB_TOPGEN], 1u);
            else XB_SPIN(xb_ld(&bar[XB_TOPGEN]) == tg, bar);
            __builtin_amdgcn_fence(__ATOMIC_ACQUIRE, "agent");
            xb_add(&bar[XB_XGEN(b.x)], 1u);
            asm volatile("s_waitcnt vmcnt(0)" ::: "memory");
        } else {
            XB_SPIN(xb_ld(&bar[XB_XGEN(b.x)]) == gen, bar);
            __builtin_amdgcn_fence(__ATOMIC_ACQUIRE, "agent");
            asm volatile("s_waitcnt vmcnt(0)" ::: "memory");
        }
    }
    __syncthreads();
}
namespace pg8 {
#define PG8_LAS __attribute__((address_space(3)))
typedef unsigned short bf16_t;
typedef short bf16x8 __attribute__((ext_vector_type(8)));
typedef float f32x4 __attribute__((ext_vector_type(4)));
typedef unsigned u32x4 __attribute__((ext_vector_type(4)));
constexpr int BM = 256, BK = 64, HALF = 128, HTB = HALF * BK * 2  , STAGE_BYTES = 8 * HTB, NXCD = 8, WGM = 8;

__host__ __device__ __forceinline__ int lds_byte(int r, int c) { const int st = (r >> 4) * 2 + (c >> 5), rr = r & 15, cc = c & 31, ob = rr * 64 + cc * 2; return st * 1024 + (ob ^ (((ob >> 9) & 1) << 5)); }
__host__ __device__ __forceinline__ void stage_rc(int b, int& R, int& C) { const int st = b / 1024, sb = b % 1024, swz = sb ^ (((sb >> 9) & 1) << 5); R = (st >> 1) * 16 + swz / 64; C = (st & 1) * 32 + (swz % 64) / 2; }
__host__ __device__ __forceinline__ int perm32(int rho) { const int n = rho >> 4, i = rho & 15; return 8 * (i >> 2) + 4 * n + (i & 3); }

struct Unit { int pm, pn; };
struct Gemm { const bf16_t* A; const bf16_t* Bt; int M, N, K; };

struct StaticOrder {
    int nM, nN, nwg, G, c;
    __host__ __device__ void init(int M, int N, int G_, int c_) { nM = M / BM; nN = N / BM; nwg = nM * nN; G = G_; c = c_; }
    __host__ __device__ bool next(int i, Unit& u) const {
        const long L = (long)i * G + c; if (L >= nwg) return false;
        int wgid = (int)L; { const int q = nwg / NXCD, r = nwg % NXCD, xcd = wgid % NXCD, off = wgid / NXCD; wgid = (xcd < r ? xcd * (q + 1) : r * (q + 1) + (xcd - r) * q) + off; }
        const int nig = WGM * nN, gid = wgid / nig, fm = gid * WGM, gsz = (nM - fm) < WGM ? (nM - fm) : WGM;
        u.pm = fm + ((wgid % nig) % gsz); u.pn = (wgid % nig) / gsz; return true;
    }
    __device__ __forceinline__ void a_ready(const Unit&) const {}
    __device__ __forceinline__ void done(const Unit&) const {}
};
__device__ __forceinline__ unsigned cvt_pk_bf16(float lo, float hi) { unsigned r; asm volatile("v_cvt_pk_bf16_f32 %0, %1, %2" : "=v"(r) : "v"(lo), "v"(hi)); return r; }
template <class Epi, class Sched, bool STAMP = false>
__device__ __forceinline__ void gemm_phase(PG8_LAS unsigned char* lds, const Gemm g, const Sched& S, const Epi& E, unsigned long long* stamps) {
    const int tid = threadIdx.x, wid = __builtin_amdgcn_readfirstlane(tid >> 6), lane = tid & 63, wr = wid >> 2, wc = wid & 3, fr = lane & 15, fq = lane >> 4;
    const int K = g.K, nt = K / BK;
    int ts_lo = 0, ts_hi = 0, nts = 0; const unsigned long long rt_entry = STAMP ? (unsigned long long)wall_clock64() : 0ull;
#define PG8_STAMP() do { if (STAMP && wid == 0 && nts < 64) { const unsigned long long _c = (unsigned long long)clock64(); \
        ts_lo = (lane == nts) ? (int)(unsigned)_c : ts_lo; ts_hi = (lane == nts) ? (int)(unsigned)(_c >> 32) : ts_hi; ++nts; } } while (0)
    PG8_STAMP();
    unsigned voffA[2], voffB[2];
#pragma unroll
    for (int i = 0; i < 2; ++i) { int R, C; stage_rc(tid * 16 + i * 8192, R, C); const int Rb = Epi::PERM ? ((R & ~31) + perm32(R & 31)) : R;
        voffA[i] = (unsigned)(R * K + C) * 2u; voffB[i] = (unsigned)(Rb * K + C) * 2u; }
    const size_t kstep = (size_t)(BK * 2);
    const size_t hstep = (size_t)HALF * K * 2;
    const size_t tstep = 2 * hstep;
    const unsigned ldsw = (unsigned)wid * 1024u;
    const int aoff = lds_byte(wr * 64 + fr, fq * 8), boff = lds_byte(wc * 32 + fr, fq * 8);
#define PG8_SA(b, h) (((b) * 2 + (h)) * HTB)
#define PG8_SB(b, h) ((4 + (b) * 2 + (h)) * HTB)
#define PG8_STAGE(bufoff, gbase, voff) do { _Pragma("unroll") for (int _i = 0; _i < 2; ++_i) \
        __builtin_amdgcn_global_load_lds((const unsigned*)((const char*)(gbase) + (voff)[_i]), (PG8_LAS unsigned*)(lds + (bufoff) + ldsw + _i * 8192), 16, 0, 0); } while (0)
#define PG8_LDA(dst, b, h) do { _Pragma("unroll") for (int m = 0; m < 4; ++m) _Pragma("unroll") for (int k = 0; k < 2; ++k) dst[m][k] = *(const PG8_LAS bf16x8*)(lds + PG8_SA(b, h) + aoff + m * 2048 + k * 1024); } while (0)
#define PG8_LDB(dst, b, h) do { _Pragma("unroll") for (int n = 0; n < 2; ++n) _Pragma("unroll") for (int k = 0; k < 2; ++k) dst[n][k] = *(const PG8_LAS bf16x8*)(lds + PG8_SB(b, h) + boff + n * 2048 + k * 1024); } while (0)
#define PG8_MMA(ai, bj, At, Bt) do { __builtin_amdgcn_s_setprio(1); _Pragma("unroll") for (int m = 0; m < 4; ++m) _Pragma("unroll") for (int n = 0; n < 2; ++n) _Pragma("unroll") for (int k = 0; k < 2; ++k) \
        acc[ai][bj][m][n] = __builtin_amdgcn_mfma_f32_16x16x32_bf16(Bt[n][k], At[m][k], acc[ai][bj][m][n], 0, 0, 0); __builtin_amdgcn_s_setprio(0); } while (0)
#define PG8_WAIT_V(n) asm volatile("s_waitcnt vmcnt(" #n ")" ::: "memory")
#define PG8_WAIT_L(n) asm volatile("s_waitcnt lgkmcnt(" #n ")" ::: "memory")
#define PG8_BAR __builtin_amdgcn_s_barrier()
#define PG8_SCHED __builtin_amdgcn_sched_barrier(0)
    Unit cur, nxt; int ui = 0;
    if (!S.next(0, cur)) return;
    f32x4 acc[2][2][4][2];
#pragma unroll
    for (int a = 0; a < 2; ++a)
#pragma unroll
        for (int b = 0; b < 2; ++b)
#pragma unroll
            for (int m = 0; m < 4; ++m)
#pragma unroll
                for (int n = 0; n < 2; ++n) acc[a][b][m][n] = (f32x4){0.f, 0.f, 0.f, 0.f};
    bf16x8 At[4][2], B0[2][2], B1[2][2];
    const char* cA = (const char*)g.A + (size_t)cur.pm * tstep; const char* cB = (const char*)g.Bt + (size_t)cur.pn * tstep;
    S.a_ready(cur);
    PG8_STAGE(PG8_SB(0, 0), cB, voffB); PG8_STAGE(PG8_SA(0, 0), cA, voffA); PG8_STAGE(PG8_SB(0, 1), cB + hstep, voffB); PG8_STAGE(PG8_SA(0, 1), cA + hstep, voffA);
    if (wr == 1) PG8_BAR;
    PG8_WAIT_V(4); PG8_BAR;
    PG8_STAGE(PG8_SB(1, 0), cB + kstep, voffB); PG8_STAGE(PG8_SA(1, 0), cA + kstep, voffA); PG8_STAGE(PG8_SB(1, 1), cB + hstep + kstep, voffB);
    PG8_WAIT_V(6); PG8_BAR;
    PG8_STAMP();
    for (;;) {
        const bool has_next = S.next(ui + 1, nxt);
        const char* nA = has_next ? (const char*)g.A + (size_t)nxt.pm * tstep : cA; const char* nB = has_next ? (const char*)g.Bt + (size_t)nxt.pn * tstep : cB;
        for (int t = 0; t < nt; t += 2) {
            const bool last = (t == nt - 2);
            const char* a1 = cA + (size_t)(t + 1) * kstep;
            const char* a2 = last ? nA : cA + (size_t)(t + 2) * kstep; const char* b2 = last ? nB : cB + (size_t)(t + 2) * kstep;
            const char* a3 = a2 + kstep; const char* b3 = b2 + kstep;
            if (last && has_next) S.a_ready(nxt);
            PG8_LDB(B0, 0, 0); PG8_SCHED; PG8_LDA(At, 0, 0); PG8_STAGE(PG8_SA(1, 1), a1 + hstep, voffA);
            PG8_WAIT_L(8); PG8_BAR; PG8_WAIT_L(0); PG8_MMA(0, 0, At, B0); PG8_BAR; PG8_SCHED;
            PG8_LDB(B1, 0, 1); PG8_STAGE(PG8_SB(0, 0), b2, voffB);
            PG8_BAR; PG8_WAIT_L(0); PG8_MMA(0, 1, At, B1); PG8_BAR;
            PG8_LDA(At, 0, 1); PG8_STAGE(PG8_SA(0, 0), a2, voffA);
            PG8_BAR; PG8_WAIT_L(0); PG8_MMA(1, 0, At, B0); PG8_BAR; PG8_SCHED;
            PG8_STAGE(PG8_SB(0, 1), b2 + hstep, voffB);
            PG8_WAIT_V(6); PG8_BAR; PG8_MMA(1, 1, At, B1); PG8_BAR;
            PG8_LDB(B0, 1, 0); PG8_SCHED; PG8_LDA(At, 1, 0); PG8_STAGE(PG8_SA(0, 1), a2 + hstep, voffA);
            PG8_WAIT_L(8); PG8_BAR; PG8_WAIT_L(0); PG8_MMA(0, 0, At, B0); PG8_BAR; PG8_SCHED;
            PG8_LDB(B1, 1, 1); PG8_STAGE(PG8_SB(1, 0), b3, voffB);
            PG8_BAR; PG8_WAIT_L(0); PG8_MMA(0, 1, At, B1); PG8_BAR;
            PG8_LDA(At, 1, 1); PG8_STAGE(PG8_SA(1, 0), a3, voffA);
            PG8_BAR; PG8_WAIT_L(0); PG8_MMA(1, 0, At, B0); PG8_BAR; PG8_SCHED;
            PG8_STAGE(PG8_SB(1, 1), b3 + hstep, voffB);
            PG8_WAIT_V(6); PG8_BAR; PG8_MMA(1, 1, At, B1); PG8_BAR;
        }
        PG8_STAMP();
        if constexpr (!Epi::AFTER_DRAIN) { E(acc, cur, wr, wc, fr, fq); S.done(cur); }
        PG8_STAMP();
        if (!has_next) break;
#pragma unroll
        for (int a = 0; a < 2; ++a)
#pragma unroll
            for (int b = 0; b < 2; ++b)
#pragma unroll
                for (int m = 0; m < 4; ++m)
#pragma unroll
                    for (int n = 0; n < 2; ++n) acc[a][b][m][n] = (f32x4){0.f, 0.f, 0.f, 0.f};
        cur = nxt; cA = nA; cB = nB; ++ui;
    }
    PG8_WAIT_V(0);
    if (wr == 0) PG8_BAR;
    PG8_BAR;
    if constexpr (Epi::AFTER_DRAIN) { E.fused(acc, cur, wr, wc, fr, fq, lds, wid, lane); S.done(cur); }
    PG8_STAMP();
    if (STAMP && wid == 0) { stamps[lane] = lane < nts ? (((unsigned long long)(unsigned)ts_hi << 32) | (unsigned)ts_lo) : 0ull;
        if (lane == 62) stamps[62] = rt_entry; if (lane == 63) stamps[63] = (unsigned long long)wall_clock64(); }
#undef PG8_STAMP
#undef PG8_SA
#undef PG8_SB
#undef PG8_STAGE
#undef PG8_LDA
#undef PG8_LDB
#undef PG8_MMA
#undef PG8_WAIT_V
#undef PG8_WAIT_L
#undef PG8_BAR
#undef PG8_SCHED
}
}
struct Ctx {
    LAS unsigned char* lds; int tid, lane, wave, G, bid;
};

DI void cvt_rows(const Ctx& F, const float* src, bf16_t* dst, size_t n) {
    const size_t n8 = n >> 3;
    for (size_t i = (size_t)F.bid * NTHR + F.tid; i < n8; i += (size_t)F.G * NTHR) {
        const f32x4 a = *(const f32x4*)(src + i * 8), b = *(const f32x4*)(src + i * 8 + 4);
        u32x4 w; w.x = pk2(a.x, a.y); w.y = pk2(a.z, a.w); w.z = pk2(b.x, b.y); w.w = pk2(b.z, b.w);
        *(u32x4*)(dst + i * 8) = w;
    }
}

DI void tr_tile_f32(const Ctx& F, const float* src, size_t lds_, bf16_t* dst, size_t ldd, LAS bf16_t* tile) {
#pragma unroll
    for (int j = 0; j < 2; ++j) {
        const int id = F.tid + NTHR * j, kr = id >> 4, nc = (id & 15) * 4;
        const f32x4 v = *(const f32x4*)(src + (size_t)kr * lds_ + nc);
        tile[(nc + 0) * 72 + kr] = f2bf(v.x); tile[(nc + 1) * 72 + kr] = f2bf(v.y); tile[(nc + 2) * 72 + kr] = f2bf(v.z); tile[(nc + 3) * 72 + kr] = f2bf(v.w);
    }
    __syncthreads();
    { const int n = F.tid >> 3, kc = (F.tid & 7) * 8; const u32x4 v = *(const LAS u32x4*)(tile + n * 72 + kc); *(u32x4*)(dst + (size_t)n * ldd + kc) = v; }
    __syncthreads();
}
DI void tr_tile_bf16(const Ctx& F, const bf16_t* src, size_t lds_, bf16_t* dst, size_t ldd, LAS bf16_t* tile) {
    { const int kr = F.tid >> 3, nc = (F.tid & 7) * 8; const u32x4 v = *(const u32x4*)(src + (size_t)kr * lds_ + nc);
      tile[(nc + 0) * 72 + kr] = (bf16_t)(v.x & 0xffff); tile[(nc + 1) * 72 + kr] = (bf16_t)(v.x >> 16); tile[(nc + 2) * 72 + kr] = (bf16_t)(v.y & 0xffff); tile[(nc + 3) * 72 + kr] = (bf16_t)(v.y >> 16);
      tile[(nc + 4) * 72 + kr] = (bf16_t)(v.z & 0xffff); tile[(nc + 5) * 72 + kr] = (bf16_t)(v.z >> 16); tile[(nc + 6) * 72 + kr] = (bf16_t)(v.w & 0xffff); tile[(nc + 7) * 72 + kr] = (bf16_t)(v.w >> 16); }
    __syncthreads();
    { const int n = F.tid >> 3, kc = (F.tid & 7) * 8; const u32x4 v = *(const LAS u32x4*)(tile + n * 72 + kc); *(u32x4*)(dst + (size_t)n * ldd + kc) = v; }
    __syncthreads();
}
DI void transpose_weight(const Ctx& F, const float* W, int K, int N, bf16_t* Wt) {
    const int tk = K / 64, tn = N / 64;
    for (int t = F.bid; t < tk * tn; t += F.G) {
        const int k0 = (t / tn) * 64, n0 = (t % tn) * 64;
        tr_tile_f32(F, W + (size_t)k0 * N + n0, (size_t)N, Wt + (size_t)n0 * K + k0, (size_t)K, (LAS bf16_t*)F.lds);
    }
}
DI void transpose_cache_v(const Ctx& F, const float* V, bf16_t* VT) {
    for (int t = F.bid; t < 64 * 8; t += F.G) {
        const int bh = t >> 3, sub = t & 7, k0 = (sub >> 1) * 64, d0 = (sub & 1) * 64, b = bh >> 3, h = bh & 7;
        tr_tile_f32(F, V + ((size_t)b * 256 + k0) * 1024 + h * 128 + d0, 1024, VT + ((size_t)bh * 128 + d0) * 256 + k0, 256, (LAS bf16_t*)F.lds);
    }
}

DI void adaln_partials(const Ctx& F, const Params& P) {
    LAS float* s = (LAS float*)F.lds;
    const float* modw = P.in[I_MODW]; const float* cv = P.in[I_C]; const float* cctx = P.in[I_CCTX];
    float* modp = (float*)(P.ws + WS_MODP);
    for (int it = F.bid; it < 192; it += F.G) {
        const int i = it / 96, r = it % 96, ks = r / 6, cg = r % 6;
        __syncthreads();
        for (int e = F.tid; e < 9 * 128; e += NTHR) { const int j = e >> 7, k = e & 127; const float c = (j == 0) ? cctx[ks * 128 + k] : cv[(j - 1) * 2048 + ks * 128 + k]; s[e] = c / (1.f + __expf(-c)); }
        __syncthreads();
        f32x4 acc[9];
#pragma unroll
        for (int j = 0; j < 9; ++j) acc[j] = (f32x4){0.f, 0.f, 0.f, 0.f};
        const float* w = modw + ((size_t)i * 2048 + ks * 128) * 12288 + cg * 2048 + F.tid * 4;
#pragma unroll 8
        for (int k = 0; k < 128; ++k) {
            const f32x4 w4 = *(const f32x4*)(w + (size_t)k * 12288);
#pragma unroll
            for (int j = 0; j < 9; ++j) acc[j] += w4 * s[j * 128 + k];
        }
#pragma unroll
        for (int j = 0; j < 9; ++j) *(f32x4*)(modp + ((size_t)(i * 16 + ks) * 9 + j) * 12288 + cg * 2048 + F.tid * 4) = acc[j];
    }
    __syncthreads();
}
DI void adaln_reduce(const Ctx& F, const Params& P) {
    const float* modp = (const float*)(P.ws + WS_MODP); float* mod = (float*)(P.ws + WS_MOD); const float* modb = P.in[I_MODB];
    for (int e = F.bid * NTHR + F.tid; e < 2 * 9 * 12288; e += F.G * NTHR) {
        const int i = e / (9 * 12288), r = e % (9 * 12288), j = r / 12288, n = r % 12288;
        float a = modb[i * 12288 + n];
#pragma unroll
        for (int ks = 0; ks < 16; ++ks) a += modp[((size_t)(i * 16 + ks) * 9 + j) * 12288 + n];
        mod[e] = a;
    }
}

DI void hyena_filters(const Ctx& F, const Params& P) {
    LAS float* z = (LAS float*)F.lds;
    LAS float* h1 = z + 320;
    LAS float* h2 = h1 + 576;
    const float* w1 = P.in[I_HYW1]; const float* b1 = P.in[I_HYB1]; const float* f1 = P.in[I_HYF1];
    const float* w2 = P.in[I_HYW2]; const float* b2 = P.in[I_HYB2]; const float* f2 = P.in[I_HYF2];
    const float* w3 = P.in[I_HYW3]; const float* dec = P.in[I_HYDEC];
    for (int it = F.bid; it < 544; it += F.G) {
        const bool smp = it < 512; const int L = smp ? LS : LP, p0 = (smp ? it : it - 512) * 8, RL = smp ? KRL_S : KRL_P;
        bf16_t* KR = (bf16_t*)(P.ws + (smp ? WS_KRS : WS_KRP));
        __syncthreads();
        if (F.tid < 9 * 33) {
            const int ps = F.tid / 33, k = F.tid % 33, i = p0 + ps;
            const float t = (float)i / (float)(L - 1), wang = 6.283185307179586f * (float)i / (float)L;
            float val;
            if (k == 0) val = t;
            else { const int f = (k - 1) & 15; const float fr = 1e-4f + (float)f * ((15.0f - 1e-4f) / 15.0f); val = (k <= 16) ? cosf(fr * wang) : -sinf(fr * wang); }
            z[F.tid] = val;
        }
        __syncthreads();
        for (int e = F.tid; e < 9 * 64; e += NTHR) { const int ps = e >> 6, j = e & 63; float a = b1[j];
            for (int k = 0; k < 33; ++k) a += z[ps * 33 + k] * w1[k * 64 + j];
            h1[e] = sinf(f1[j] * a); }
        __syncthreads();
        for (int e = F.tid; e < 9 * 64; e += NTHR) { const int ps = e >> 6, j = e & 63; float a = b2[j];
            for (int k = 0; k < 64; ++k) a += h1[ps * 64 + k] * w2[k * 64 + j];
            h2[e] = sinf(f2[j] * a); }
        __syncthreads();
#pragma unroll 1
        for (int qh = 0; qh < 2; ++qh) {
            float acc[9][4];
#pragma unroll
            for (int ps = 0; ps < 9; ++ps)
#pragma unroll
                for (int q = 0; q < 4; ++q) acc[ps][q] = 0.f;
#pragma unroll 2
            for (int k = 0; k < 64; ++k) {
                float w[4];
#pragma unroll
                for (int q = 0; q < 4; ++q) w[q] = w3[k * 4096 + F.tid + NTHR * (qh * 4 + q)];
#pragma unroll
                for (int ps = 0; ps < 9; ++ps) { const float hv = h2[ps * 64 + k];
#pragma unroll
                    for (int q = 0; q < 4; ++q) acc[ps][q] += hv * w[q]; }
            }
#pragma unroll
            for (int q = 0; q < 4; ++q) {
                const int n = F.tid + NTHR * (qh * 4 + q), o = (n >> 10) & 1, c = n & 1023;
                const float dc = fabsf(dec[n]);
                bf16_t* row = KR + (size_t)(o * 1024 + c) * RL;
                float v[9];
#pragma unroll
                for (int ps = 0; ps < 9; ++ps) { const int i = p0 + ps; v[ps] = (i < L) ? acc[ps][q] * __expf(-((float)i / (float)(L - 1)) * dc) : 0.f; }
                if (qh == 0) {
                    u32x4 wv; wv.x = pk2(v[8], v[7]); wv.y = pk2(v[6], v[5]); wv.z = pk2(v[4], v[3]); wv.w = pk2(v[2], v[1]);
                    *(u32x4*)(row + (L - p0 - 8)) = wv;
                    if (p0 == 0) row[L] = f2bf(v[0]);
                } else if (p0 > 0) {
                    u32x4 wv; wv.x = pk2(v[0], v[1]); wv.y = pk2(v[2], v[3]); wv.z = pk2(v[4], v[5]); wv.w = pk2(v[6], v[7]);
                    *(u32x4*)(row + (L + p0)) = wv;
                } else {
#pragma unroll
                    for (int ps = 1; ps < 8; ++ps) row[L + ps] = f2bf(v[ps]);
                }
            }
        }
    }
    __syncthreads();
    for (int e = F.bid * NTHR + F.tid; e < 2 * 2048; e += F.G * NTHR) {
        const bool smp = e < 2048; const int r = e & 2047, L = smp ? LS : LP, RL = smp ? KRL_S : KRL_P;
        bf16_t* row = (bf16_t*)(P.ws + (smp ? WS_KRS : WS_KRP)) + (size_t)r * RL;
        for (int x = 2 * L; x < RL; ++x) row[x] = 0;
    }
}

DI void s5_consts(const Ctx& F, const Params& P) {
    float* S5A = (float*)(P.ws + WS_S5A); bf16_t* BB = (bf16_t*)(P.ws + WS_S5BB); bf16_t* CC = (bf16_t*)(P.ws + WS_S5CC);
    const float* lre = P.in[I_S5LRE]; const float* lim = P.in[I_S5LIM]; const float* ldt = P.in[I_S5LDT];
    const float* bre = P.in[I_S5BRE]; const float* bim = P.in[I_S5BIM]; const float* cre = P.in[I_S5CRE]; const float* cim = P.in[I_S5CIM];
    for (int e = F.bid * NTHR + F.tid; e < 8192; e += F.G * NTHR) {
        const int dg = e >> 6, n = e & 63;
        const float dt = expf(ldt[dg]), lr = lre[e], li = lim[e];
        const float mag = expf(lr * dt), ar = mag * cosf(li * dt), ai = mag * sinf(li * dt), den = lr * lr + li * li;
        const float cr = ((ar - 1.f) * lr + ai * li) / den, ci = (ai * lr - (ar - 1.f) * li) / den;
        S5A[e * 2] = ar; S5A[e * 2 + 1] = ai;
#pragma unroll
        for (int p = 0; p < 16; ++p) {
            const float br = bre[(size_t)e * 16 + p], bi = bim[(size_t)e * 16 + p];
            BB[((size_t)dg * 128 + n) * 16 + p] = f2bf(cr * br - ci * bi);
            BB[((size_t)dg * 128 + 64 + n) * 16 + p] = f2bf(cr * bi + ci * br);
            CC[((size_t)dg * 16 + p) * 128 + n] = f2bf(cre[((size_t)dg * 16 + p) * 64 + n]);
            CC[((size_t)dg * 16 + p) * 128 + 64 + n] = f2bf(-cim[((size_t)dg * 16 + p) * 64 + n]);
        }
    }
}

constexpr int PT_ROWB = 1536;
DI void cvt_table_fp6(const Ctx& F, const float* src, unsigned char* dst, float* scales, const int (&perm)[32]) {
    LAS float* scr = (LAS float*)(F.lds) + F.wave * 2048 + F.lane;
    for (int r = F.bid * 8 + F.wave; r < 16384; r += F.G * 8) {
        f32x4 v[8]; float m = 0.f;
#pragma unroll
        for (int j = 0; j < 8; ++j) { v[j] = *(const f32x4*)(src + (size_t)r * 2048 + F.lane * 32 + j * 4);
            m = fmaxf(m, fmaxf(fmaxf(fabsf(v[j].x), fabsf(v[j].y)), fmaxf(fabsf(v[j].z), fabsf(v[j].w)))); }
        m = wave_max(m);
        const float inv = (m > 0.f) ? 7.0f / m : 0.f, sc = (m > 0.f) ? m / 7.0f : 0.f;
#pragma unroll
        for (int j = 0; j < 8; ++j) { scr[perm[j * 4 + 0] * 64] = v[j].x * inv; scr[perm[j * 4 + 1] * 64] = v[j].y * inv; scr[perm[j * 4 + 2] * 64] = v[j].z * inv; scr[perm[j * 4 + 3] * 64] = v[j].w * inv; }
        asm volatile("" ::: "memory");
        f32x16 a, b;
#pragma unroll
        for (int i = 0; i < 16; ++i) { a[i] = scr[i * 64]; b[i] = scr[(16 + i) * 64]; }
        asm volatile("" ::: "memory");
        const u32x6 pk = __builtin_amdgcn_cvt_scalef32_2xpk16_fp6_f32(a, b, 1.0f);
        unsigned char* o = dst + (size_t)r * PT_ROWB;
        *(u32x4*)(o + F.lane * 16) = (u32x4){pk[0], pk[1], pk[2], pk[3]}; *(u32x2*)(o + 1024 + F.lane * 8) = (u32x2){pk[4], pk[5]};
        if (F.lane == 0) scales[r] = sc;
    }
}
DI void convert_peer_tables(const Ctx& F, const Params& P) {
    int perm[32];
    { f32x16 a, b;
#pragma unroll
      for (int j = 0; j < 16; ++j) { a[j] = 0.125f * (float)j; b[j] = (j < 8) ? 2.0f + 0.25f * (float)j : 4.0f + 0.5f * (float)(j - 8); }
      const u32x6 pk = __builtin_amdgcn_cvt_scalef32_2xpk16_fp6_f32(a, b, 1.0f);
      const f32x32 rt = __builtin_amdgcn_cvt_scalef32_pk32_f32_fp6(pk, 1.0f);
#pragma unroll
      for (int i = 0; i < 32; ++i) { const float x = rt[i]; const int o = (x < 2.0f) ? (int)(x * 8.0f + 0.5f) : ((x < 4.0f) ? 16 + (int)((x - 2.0f) * 4.0f + 0.5f) : 24 + (int)((x - 4.0f) * 2.0f + 0.5f)); perm[i] = min(max(o, 0), 31); } }
    float* SC = (float*)(P.ws + WS_SC);
    __syncthreads();
    for (int layer = 0; layer < 2; ++layer) {
        cvt_table_fp6(F, P.in[I_PU] + (size_t)layer * 16384 * 2048, P.ws + WS_TBLU + (size_t)layer * 16384 * PT_ROWB, SC + layer * 16384, perm);
        cvt_table_fp6(F, P.in[I_PV] + (size_t)layer * 16384 * 2048, P.ws + WS_TBLV + (size_t)layer * 16384 * PT_ROWB, SC + (2 + layer) * 16384, perm);
    }
    __syncthreads();
}

DI void prologue(const Ctx& F, const Params& P) {
    adaln_partials(F, P);
    transpose_weight(F, P.in[I_EVWIN], 2048, 6144, (bf16_t*)(P.ws + WS_WEVIN));
    transpose_weight(F, P.in[I_EVWOUT], 2048, 2048, (bf16_t*)(P.ws + WS_WEVOUT));
    transpose_weight(F, P.in[I_ODWIN], 2048, 4096, (bf16_t*)(P.ws + WS_WODIN));
    transpose_weight(F, P.in[I_ODWOUT], 2048, 2048, (bf16_t*)(P.ws + WS_WODOUT));
    transpose_weight(F, P.in[I_PWQ], 2048, 2048, (bf16_t*)(P.ws + WS_WPQ));
    transpose_weight(F, P.in[I_PWQ] + (size_t)2048 * 2048, 2048, 2048, (bf16_t*)(P.ws + WS_WPQ) + (size_t)2048 * 2048);
    transpose_weight(F, P.in[I_GLUW], 1024, 1024, (bf16_t*)(P.ws + WS_WGLU));
    cvt_rows(F, P.in[I_PKEYS], (bf16_t*)(P.ws + WS_PKEYS), (size_t)2 * 8 * 2 * 128 * 128);
    cvt_rows(F, P.in[I_CNK], (bf16_t*)(P.ws + WS_CNK), (size_t)8 * 256 * 1024);
    cvt_rows(F, P.in[I_CDK], (bf16_t*)(P.ws + WS_CDK), (size_t)8 * 256 * 1024);
    transpose_cache_v(F, P.in[I_CNV], (bf16_t*)(P.ws + WS_CNVT));
    transpose_cache_v(F, P.in[I_CDV], (bf16_t*)(P.ws + WS_CDVT));
    hyena_filters(F, P);
    s5_consts(F, P);
    convert_peer_tables(F, P);
}
DI void norm_phase(const Ctx& F, const float* xa, const float* xb, const float* gvec, const float* modl, int sidx, bf16_t* H) {
    for (int T = F.bid * 8 + F.wave; T < TOK; T += F.G * 8) {
        const float* xr = T < TP ? xa + (size_t)T * DM : xb + (size_t)(T - TP) * DM;
        f32x4 v[8]; float ss = 0.f;
#pragma unroll
        for (int j = 0; j < 8; ++j) { v[j] = *(const f32x4*)(xr + (j * 64 + F.lane) * 4); ss += v[j].x * v[j].x + v[j].y * v[j].y + v[j].z * v[j].z + v[j].w * v[j].w; }
        ss = wave_sum(ss);
        const float rstd = rsqrtf(ss * (1.f / DM) + NORM_EPS);
        const float* sh = modl + (size_t)(cond_of(T) * 6 + sidx) * DM; const float* sc = sh + DM;
#pragma unroll
        for (int j = 0; j < 8; ++j) {
            const int col = (j * 64 + F.lane) * 4;
            const f32x4 g4 = *(const f32x4*)(gvec + col), s4 = *(const f32x4*)(sc + col), h4 = *(const f32x4*)(sh + col);
            const f32x4 o = v[j] * rstd * g4 * (s4 + 1.f) + h4;
            u32x2 w; w.x = pk2(o.x, o.y); w.y = pk2(o.z, o.w);
            *(u32x2*)(H + (size_t)T * DM + col) = w;
        }
    }
}

struct EpiBf16 {
    static constexpr bool PERM = true, AFTER_DRAIN = false;
    bf16_t* O; int ldc;
    DI void operator()(const f32x4 (&acc)[2][2][4][2], const pg8::Unit& u, int wr, int wc, int fr, int fq) const {
        const int row0 = u.pm * 256 + wr * 64 + fr, col0 = u.pn * 256 + wc * 32 + 8 * fq;
#pragma unroll
        for (int ai = 0; ai < 2; ++ai)
#pragma unroll
            for (int m = 0; m < 4; ++m) { bf16_t* rowp = O + (size_t)(row0 + ai * 128 + m * 16) * ldc + col0;
#pragma unroll
                for (int bj = 0; bj < 2; ++bj) { const f32x4 v0 = acc[ai][bj][m][0], v1 = acc[ai][bj][m][1];
                    u32x4 w; w.x = pk2(v0[0], v0[1]); w.y = pk2(v0[2], v0[3]); w.z = pk2(v1[0], v1[1]); w.w = pk2(v1[2], v1[3]);
                    *(u32x4*)(rowp + bj * 128) = w; } }
    }
};
struct EpiResid {
    static constexpr bool PERM = false, AFTER_DRAIN = false;
    const float* xa; const float* xb; float* out; const float* modl; int gidx;
    DI void operator()(const f32x4 (&acc)[2][2][4][2], const pg8::Unit& u, int wr, int wc, int fr, int fq) const {
        const int row0 = u.pm * 256 + wr * 64 + fr, col0 = u.pn * 256 + wc * 32 + 4 * fq;
        const float* xbase = (u.pm < 32) ? xa : xb - (size_t)TP * DM;
        const float* gate = modl + (size_t)(cond_of(u.pm * 256) * 6 + gidx) * DM;
        f32x4 gv[2][2];
#pragma unroll
        for (int bj = 0; bj < 2; ++bj)
#pragma unroll
            for (int n = 0; n < 2; ++n) gv[bj][n] = *(const f32x4*)(gate + col0 + bj * 128 + n * 16);
#pragma unroll
        for (int ai = 0; ai < 2; ++ai)
#pragma unroll
            for (int m = 0; m < 4; ++m) { const size_t ro = (size_t)(row0 + ai * 128 + m * 16) * DM + col0;
#pragma unroll
                for (int bj = 0; bj < 2; ++bj)
#pragma unroll
                    for (int n = 0; n < 2; ++n) { const f32x4 x4 = *(const f32x4*)(xbase + ro + bj * 128 + n * 16);
                        *(f32x4*)(out + ro + bj * 128 + n * 16) = x4 + gv[bj][n] * acc[ai][bj][m][n]; } }
    }
};
struct EpiGlu {
    static constexpr bool PERM = true, AFTER_DRAIN = false;
    const bf16_t* Y; bf16_t* O; const float* bias;
    DI void operator()(const f32x4 (&acc)[2][2][4][2], const pg8::Unit& u, int wr, int wc, int fr, int fq) const {
        const int row0 = u.pm * 256 + wr * 64 + fr, col0 = u.pn * 256 + wc * 32 + 8 * fq;
#pragma unroll
        for (int bj = 0; bj < 2; ++bj) {
            const f32x4 b0 = *(const f32x4*)(bias + col0 + bj * 128), b1 = *(const f32x4*)(bias + col0 + bj * 128 + 4);
#pragma unroll
            for (int ai = 0; ai < 2; ++ai)
#pragma unroll
                for (int m = 0; m < 4; ++m) { const size_t r = (size_t)(row0 + ai * 128 + m * 16);
                    const u32x4 yv = *(const u32x4*)(Y + r * 1024 + col0 + bj * 128);
                    const f32x4 a0 = acc[ai][bj][m][0] + b0, a1 = acc[ai][bj][m][1] + b1;
                    float o[8];
                    o[0] = bflo(yv.x) / (1.f + __expf(-a0[0])); o[1] = bfhi(yv.x) / (1.f + __expf(-a0[1]));
                    o[2] = bflo(yv.y) / (1.f + __expf(-a0[2])); o[3] = bfhi(yv.y) / (1.f + __expf(-a0[3]));
                    o[4] = bflo(yv.z) / (1.f + __expf(-a1[0])); o[5] = bfhi(yv.z) / (1.f + __expf(-a1[1]));
                    o[6] = bflo(yv.w) / (1.f + __expf(-a1[2])); o[7] = bfhi(yv.w) / (1.f + __expf(-a1[3]));
                    u32x4 w; w.x = pk2(o[0], o[1]); w.y = pk2(o[2], o[3]); w.z = pk2(o[4], o[5]); w.w = pk2(o[6], o[7]);
                    *(u32x4*)(O + r * DM + col0 + bj * 128) = w; }
        }
    }
};
template <class Epi> DI void run_gemm(const Ctx& F, const bf16_t* A, const bf16_t* Bt, int N, int K, const Epi& E) {
    pg8::Gemm g{A, Bt, TOK, N, K}; pg8::StaticOrder S; S.init(TOK, N, F.G, F.bid);
    pg8::gemm_phase<Epi, pg8::StaticOrder, false>(F.lds, g, S, E, nullptr);
    __syncthreads();
}

DI void prep_a(const Ctx& F, const Params& P) {
    const bf16_t* T1 = (const bf16_t*)(P.ws + WS_RA);
    bf16_t* VTp = (bf16_t*)(P.ws + WS_VT); bf16_t* VTs = (bf16_t*)(P.ws + WS_VT + VT_S);
    for (int t = F.bid; t < 2048 + 8192; t += F.G) {
        if (t < 2048) { const int bh = t >> 3, sub = t & 7, tk = sub >> 1, dd = sub & 1, b = bh >> 3, h = bh & 7;
            tr_tile_bf16(F, T1 + ((size_t)(b * 256 + tk * 64)) * 4096 + h * 128 + dd * 64, 4096, VTp + ((size_t)bh * 128 + dd * 64) * 256 + tk * 64, 256, (LAS bf16_t*)F.lds); }
        else { const int u = t - 2048, bh = u >> 7, sub = u & 127, tk = sub >> 1, dd = sub & 1, b = bh >> 3, h = bh & 7;
            tr_tile_bf16(F, T1 + ((size_t)(TP + b * 4096 + tk * 64)) * 4096 + h * 128 + dd * 64, 4096, VTs + ((size_t)bh * 128 + dd * 64) * 4096 + tk * 64, 4096, (LAS bf16_t*)F.lds); }
    }
    { float* o = P.out + O_NAV;
      for (int e = F.bid * NTHR + F.tid; e < TP * 128; e += F.G * NTHR) { const int T = e >> 7, c8 = (e & 127) * 8;
          const u32x4 v = *(const u32x4*)(T1 + (size_t)T * 4096 + c8);
          *(f32x4*)(o + (size_t)T * 1024 + c8) = (f32x4){bflo(v.x), bfhi(v.x), bflo(v.y), bfhi(v.y)};
          *(f32x4*)(o + (size_t)T * 1024 + c8 + 4) = (f32x4){bflo(v.z), bfhi(v.z), bflo(v.w), bfhi(v.w)}; } }
    { LAS bf16_t* tl = (LAS bf16_t*)F.lds;
      bf16_t* CM = (bf16_t*)(P.ws + WS_RB);
      const float* cw = P.in[I_HYCW]; const float* cb = P.in[I_HYCB];
      for (int t = F.bid; t < 48 * 160; t += F.G) {
          const int cg = t % 48, tg = t / 48, ch0 = cg * 64, t0 = tg * 256;
          const bool lz = (t0 < TP) ? true : (((t0 - TP) & 4095) == 0);
          const bool rz = (t0 < TP) ? true : (((t0 + 256 - TP) & 4095) == 0);
          __syncthreads();
#pragma unroll
          for (int j = 0; j < 4; ++j) { const int id = F.tid + NTHR * j, tk = id >> 3, c8 = (id & 7) * 8;
              const u32x4 v = *(const u32x4*)(T1 + (size_t)(t0 + tk) * 4096 + 1024 + ch0 + c8);
              LAS bf16_t* d = tl + tk + 1;
              d[(c8 + 0) * 264] = (bf16_t)(v.x & 0xffff); d[(c8 + 1) * 264] = (bf16_t)(v.x >> 16); d[(c8 + 2) * 264] = (bf16_t)(v.y & 0xffff); d[(c8 + 3) * 264] = (bf16_t)(v.y >> 16);
              d[(c8 + 4) * 264] = (bf16_t)(v.z & 0xffff); d[(c8 + 5) * 264] = (bf16_t)(v.z >> 16); d[(c8 + 6) * 264] = (bf16_t)(v.w & 0xffff); d[(c8 + 7) * 264] = (bf16_t)(v.w >> 16); }
          if (F.tid < 16) { const int side = F.tid >> 3, c8 = (F.tid & 7) * 8; const bool zero = side ? rz : lz; const int tk = side ? t0 + 256 : t0 - 1;
              u32x4 v = (u32x4){0u, 0u, 0u, 0u};
              if (!zero) v = *(const u32x4*)(T1 + (size_t)tk * 4096 + 1024 + ch0 + c8);
              LAS bf16_t* d = tl + (side ? 257 : 0);
              d[(c8 + 0) * 264] = (bf16_t)(v.x & 0xffff); d[(c8 + 1) * 264] = (bf16_t)(v.x >> 16); d[(c8 + 2) * 264] = (bf16_t)(v.y & 0xffff); d[(c8 + 3) * 264] = (bf16_t)(v.y >> 16);
              d[(c8 + 4) * 264] = (bf16_t)(v.z & 0xffff); d[(c8 + 5) * 264] = (bf16_t)(v.z >> 16); d[(c8 + 6) * 264] = (bf16_t)(v.w & 0xffff); d[(c8 + 7) * 264] = (bf16_t)(v.w >> 16); }
          __syncthreads();
#pragma unroll
          for (int j = 0; j < 4; ++j) { const int id = F.tid + NTHR * j, ch = id >> 5, to = (id & 31) * 8, cgl = ch0 + ch;
              const float w0 = cw[cgl], w1 = cw[3072 + cgl], w2 = cw[6144 + cgl], bb = cb[cgl];
              const LAS bf16_t* s = tl + ch * 264 + to;
              float r[10];
#pragma unroll
              for (int i = 0; i < 10; ++i) r[i] = bf2f(s[i]);
              float o[8];
#pragma unroll
              for (int i = 0; i < 8; ++i) o[i] = w0 * r[i] + w1 * r[i + 1] + w2 * r[i + 2] + bb;
              u32x4 w; w.x = pk2(o[0], o[1]); w.y = pk2(o[2], o[3]); w.z = pk2(o[4], o[5]); w.w = pk2(o[6], o[7]);
              *(u32x4*)(CM + (size_t)cgl * TOK + t0 + to) = w; }
      }
      __syncthreads(); }
}

DI void prep_b(const Ctx& F, const Params& P) {
    bf16_t* Pq = (bf16_t*)(P.ws + WS_RA); const float* qg = P.in[I_NAQG]; const float* kg = P.in[I_NAKG]; float* ok = P.out + O_NAK;
    const float* gsrc = (F.lane < 32 ? qg : kg) + (F.lane & 3) * 32;
    float g[32];
#pragma unroll
    for (int i = 0; i < 32; ++i) g[i] = gsrc[i];
    for (int T = F.bid * 8 + F.wave; T < TOK; T += F.G * 8) {
        bf16_t* rp = Pq + (size_t)T * 2048 + F.lane * 32;
        u32x4 v[4]; float x[32]; float ss = 0.f;
#pragma unroll
        for (int j = 0; j < 4; ++j) { v[j] = *(const u32x4*)(rp + j * 8);
            x[j * 8 + 0] = bflo(v[j].x); x[j * 8 + 1] = bfhi(v[j].x); x[j * 8 + 2] = bflo(v[j].y); x[j * 8 + 3] = bfhi(v[j].y);
            x[j * 8 + 4] = bflo(v[j].z); x[j * 8 + 5] = bfhi(v[j].z); x[j * 8 + 6] = bflo(v[j].w); x[j * 8 + 7] = bfhi(v[j].w); }
#pragma unroll
        for (int i = 0; i < 32; ++i) ss += x[i] * x[i];
        ss += dpp_xor1(ss); ss += dpp_xor2(ss);
        const float rstd = rsqrtf(ss * (1.f / 128.f) + NORM_EPS);
#pragma unroll
        for (int i = 0; i < 32; ++i) x[i] = x[i] * rstd * g[i];
#pragma unroll
        for (int j = 0; j < 4; ++j) { u32x4 w; w.x = pk2(x[j * 8 + 0], x[j * 8 + 1]); w.y = pk2(x[j * 8 + 2], x[j * 8 + 3]); w.z = pk2(x[j * 8 + 4], x[j * 8 + 5]); w.w = pk2(x[j * 8 + 6], x[j * 8 + 7]);
            *(u32x4*)(rp + j * 8) = w; }
        if (T < TP && F.lane >= 32) { float* o = ok + (size_t)T * 1024 + (F.lane - 32) * 32;
#pragma unroll
            for (int j = 0; j < 8; ++j) *(f32x4*)(o + j * 4) = (f32x4){x[j * 4], x[j * 4 + 1], x[j * 4 + 2], x[j * 4 + 3]}; }
    }
}
constexpr int AT_KROW = 272, AT_VROW = 136, AT_KTB = 64 * AT_KROW, AT_VTB = 128 * AT_VROW;
constexpr int AT_K0 = 0, AT_V0 = 2 * AT_KTB, AT_RPB = AT_V0 + 2 * AT_VTB;

struct TileMap { const bf16_t* latK; int latKld; const bf16_t* latV; int latVld; int nlat; const bf16_t* ctxK; const bf16_t* ctxV; int ntiles; };
struct TileRegs { u32x4 k[2], v[2]; };

DI void tile_src(const TileMap& M, int j, const bf16_t*& kp, int& kld, const bf16_t*& vp, int& vld) {
    if (j < M.nlat) { kp = M.latK + (size_t)j * 64 * M.latKld; kld = M.latKld; vp = M.latV + j * 64; vld = M.latVld; }
    else { const int c = j - M.nlat; kp = M.ctxK + (size_t)c * 64 * 1024; kld = 1024; vp = M.ctxV + c * 64; vld = 256; }
}
DI void tile_load(const Ctx& F, TileRegs& R, const bf16_t* kp, int kld, const bf16_t* vp, int vld, bool withV = true) {
#pragma unroll
    for (int j = 0; j < 2; ++j) { const int id = F.tid + NTHR * j;
        const unsigned ko = (unsigned)((id >> 4) * kld + (id & 15) * 8) * 2u, vo = (unsigned)((id >> 3) * vld + (id & 7) * 8) * 2u;
        R.k[j] = *(const u32x4*)((const char*)kp + ko);
        if (withV) R.v[j] = *(const u32x4*)((const char*)vp + vo); }
}
DI void tile_store(const Ctx& F, const TileRegs& R, LAS unsigned char* kt, LAS unsigned char* vt, bool withV = true) {
#pragma unroll
    for (int j = 0; j < 2; ++j) { const int id = F.tid + NTHR * j;
        *(LAS u32x4*)(kt + (id >> 4) * AT_KROW + (id & 15) * 16) = R.k[j];
        if (withV) { LAS unsigned char* vp = vt + (id >> 3) * AT_VROW + (id & 7) * 16;
            *(LAS u32x2*)(vp) = (u32x2){R.v[j].x, R.v[j].y}; *(LAS u32x2*)(vp + 8) = (u32x2){R.v[j].z, R.v[j].w}; } }
}

DI void tile_norm_k(const Ctx& F, TileRegs& R, const LAS float* kgain, float* nk, int nkld) {
#pragma unroll
    for (int j = 0; j < 2; ++j) { const int id = F.tid + NTHR * j;
        float x[8] = {bflo(R.k[j].x), bfhi(R.k[j].x), bflo(R.k[j].y), bfhi(R.k[j].y), bflo(R.k[j].z), bfhi(R.k[j].z), bflo(R.k[j].w), bfhi(R.k[j].w)};
        float ss = 0.f;
#pragma unroll
        for (int i = 0; i < 8; ++i) ss += x[i] * x[i];
        ss += dpp_xor1(ss); ss += dpp_xor2(ss);
        ss += __builtin_bit_cast(float, __builtin_amdgcn_update_dpp(0, __builtin_bit_cast(int, ss), 0x141, 0xF, 0xF, true));
        ss += __builtin_bit_cast(float, __builtin_amdgcn_update_dpp(0, __builtin_bit_cast(int, ss), 0x140, 0xF, 0xF, true));
        const float rstd = rsqrtf(ss * (1.f / 128.f) + NORM_EPS);
        const f32x4 g0 = *(const LAS f32x4*)(kgain + (id & 15) * 8), g1 = *(const LAS f32x4*)(kgain + (id & 15) * 8 + 4);
        x[0] *= rstd * g0.x; x[1] *= rstd * g0.y; x[2] *= rstd * g0.z; x[3] *= rstd * g0.w; x[4] *= rstd * g1.x; x[5] *= rstd * g1.y; x[6] *= rstd * g1.z; x[7] *= rstd * g1.w;
        R.k[j] = (u32x4){pk2(x[0], x[1]), pk2(x[2], x[3]), pk2(x[4], x[5]), pk2(x[6], x[7])};
        if (nk) { float* o = nk + (size_t)(id >> 4) * nkld + (id & 15) * 8; *(f32x4*)(o) = (f32x4){x[0], x[1], x[2], x[3]}; *(f32x4*)(o + 4) = (f32x4){x[4], x[5], x[6], x[7]}; }
    }
}

template <int KS>
DI f32x16 qk_tile(LAS const unsigned char* kt, const bf16x8 (&Qf)[8], int kb, int kk0, int q, int hh) {
    f32x16 S;
#pragma unroll
    for (int i = 0; i < 16; ++i) S[i] = 0.f;
#pragma unroll
    for (int ks = 0; ks < KS; ++ks) { const int kk = kk0 + ks;
        const bf16x8 A = *(const LAS bf16x8*)(kt + (kb * 32 + q) * AT_KROW + (kk * 16 + hh * 8) * 2);
        S = __builtin_amdgcn_mfma_f32_32x32x16_bf16(A, Qf[kk], S, 0, 0, 0); }
    return S;
}
DI void pv_tile(LAS const unsigned char* vt, const float (&p)[16], f32x16 (&O)[4], int kb, int q, int hh) {
#pragma unroll
    for (int s = 0; s < 2; ++s) {
        u32x4 pw; pw.x = pk2(p[8 * s + 0], p[8 * s + 1]); pw.y = pk2(p[8 * s + 2], p[8 * s + 3]); pw.z = pk2(p[8 * s + 4], p[8 * s + 5]); pw.w = pk2(p[8 * s + 6], p[8 * s + 7]);
        const bf16x8 Pf = __builtin_bit_cast(bf16x8, pw);
#pragma unroll
        for (int db = 0; db < 4; ++db) {
            LAS const unsigned char* ap = vt + (db * 32 + q) * AT_VROW + (kb * 32 + 16 * s + 4 * hh) * 2;
            const u32x2 lo = *(const LAS u32x2*)(ap), hi = *(const LAS u32x2*)(ap + 16);
            const bf16x8 A2 = __builtin_bit_cast(bf16x8, (u32x4){lo.x, lo.y, hi.x, hi.y});
            O[db] = __builtin_amdgcn_mfma_f32_32x32x16_bf16(A2, Pf, O[db], 0, 0, 0);
        }
        asm volatile("" ::: "memory");
    }
}
template <bool LAT>
DI void attn_compute1(LAS const unsigned char* kt, LAS const unsigned char* vt, const bf16x8 (&Qf)[8], f32x16 (&O)[4], float& ls, int lane, const LAS float* brow, int cq) {
    const int q = lane & 31, hh = lane >> 5;
    const int cs = min(max(cq - 8, 0), 48);
#pragma unroll 1
    for (int kb = 0; kb < 2; ++kb) {
        const f32x16 S = qk_tile<8>(kt, Qf, kb, 0, q, hh);
        float p[16];
#pragma unroll
        for (int i = 0; i < 16; ++i) {
            float arg = S[i];
            if (LAT) { const int ck = kb * 32 + (i & 3) + 8 * (i >> 2) + 4 * hh;
                arg += brow[min(max(ck - cq + 15, 0), 30)];
                p[i] = ((unsigned)(ck - cs) < 16u) ? __builtin_amdgcn_exp2f(arg) : 0.f; }
            else p[i] = __builtin_amdgcn_exp2f(arg);
            ls += p[i];
        }
        pv_tile(vt, p, O, kb, q, hh);
    }
}
DI void diff_pass1(LAS const unsigned char* kt, const bf16x8 (&Qf)[8], float (&ls)[2], int lane) {
    const int q = lane & 31, hh = lane >> 5;
#pragma unroll
    for (int kb = 0; kb < 2; ++kb) {
#pragma unroll
        for (int mp = 0; mp < 2; ++mp) { const f32x16 S = qk_tile<4>(kt, Qf, kb, mp * 4, q, hh);
#pragma unroll
            for (int i = 0; i < 16; ++i) ls[mp] += __builtin_amdgcn_exp2f(S[i]); }
    }
}
DI void diff_pass2(LAS const unsigned char* kt, LAS const unsigned char* vt, const bf16x8 (&Qf)[8], f32x16 (&O)[4], float w0, float w1, int lane) {
    const int q = lane & 31, hh = lane >> 5;
#pragma unroll
    for (int kb = 0; kb < 2; ++kb) {
        float p[16];
        { const f32x16 S0 = qk_tile<4>(kt, Qf, kb, 0, q, hh);
#pragma unroll
          for (int i = 0; i < 16; ++i) p[i] = __builtin_amdgcn_exp2f(S0[i]) * w0; }
        { const f32x16 S1 = qk_tile<4>(kt, Qf, kb, 4, q, hh);
#pragma unroll
          for (int i = 0; i < 16; ++i) p[i] -= __builtin_amdgcn_exp2f(S1[i]) * w1; }
        pv_tile(vt, p, O, kb, q, hh);
    }
}

template <int MODE>
DI void attn_phase(const Ctx& F, const Params& P) {
    constexpr bool DIFF = (MODE >= 2);
    constexpr bool NA = (MODE == 1);
    LAS unsigned char* lds = F.lds;
    LAS float* rpbl = (LAS float*)(lds + AT_RPB);
    LAS float* kgl = (LAS float*)(lds + AT_RPB + 2048);
    if (!DIFF) { __syncthreads(); if (F.tid < 128) kgl[F.tid] = P.in[I_NAKG][F.tid]; __syncthreads(); }
    const bf16_t* PA = (const bf16_t*)(P.ws + WS_RA);
    bf16_t* MIX = (bf16_t*)(P.ws + WS_HM);
    const bf16_t* VTp = (const bf16_t*)(P.ws + WS_VT); const bf16_t* VTs = (const bf16_t*)(P.ws + WS_VT + VT_S);
    const int q = F.lane & 31, hh = F.lane >> 5;
    const float c1 = (DIFF ? 0.125f : 0.08838834764831845f) * LOG2E;
    float lam = 0.f;
    if (DIFF) {
        const float a = wave_sum(P.in[I_LQ1][F.lane] * P.in[I_LK1][F.lane]), b = wave_sum(P.in[I_LQ2][F.lane] * P.in[I_LK2][F.lane]);
        lam = __expf(a) - __expf(b) + 0.35550906759096924f;
    }
    const int nunits = (MODE == 0 || MODE == 2) ? 256 : 1024;
    for (int u0 = F.bid; u0 < nunits; u0 += F.G) {
        int u = u0;
        if ((MODE == 1 || MODE == 3) && F.G == 256) { const int i = u0 >> 8, x = F.bid & 7, y = F.bid >> 3; u = ((2 * i + (y >> 4)) * 8 + x) * 16 + (y & 15); }
        int b, h, tok0, r = 0, rlo = 0; TileMap M;
        const bf16_t* qptr;
        if (MODE == 0) { b = u >> 3; h = u & 7; tok0 = b * 256 + F.wave * 32;
            qptr = PA + (size_t)(tok0 + q) * 2048 + h * 128;
            M.latK = PA + (size_t)(b * 256) * 2048 + 1024 + h * 128; M.latKld = 2048; M.latV = VTp + (size_t)(b * 8 + h) * 128 * 256; M.latVld = 256; M.nlat = 4; M.ctxK = nullptr; M.ctxV = nullptr; M.ntiles = 4; }
        else if (MODE == 1) { b = u >> 7; h = (u >> 4) & 7; const int rg = u & 15; r = 4 * rg + (F.wave >> 1);
            rlo = min(max(4 * rg - 4, 0), 56); const int rhi = min(max(4 * rg + 3 - 4, 0), 56) + 8;
            tok0 = TP + b * 4096 + r * 64 + (F.wave & 1) * 32;
            qptr = PA + (size_t)(tok0 + q) * 2048 + h * 128;
            M.latK = PA + (size_t)(TP + b * 4096 + rlo * 64) * 2048 + 1024 + h * 128; M.latKld = 2048; M.latV = VTs + (size_t)(b * 8 + h) * 128 * 4096 + rlo * 64; M.latVld = 4096; M.nlat = rhi - rlo;
            M.ctxK = (const bf16_t*)(P.ws + WS_CNK) + (size_t)b * 256 * 1024 + h * 128; M.ctxV = (const bf16_t*)(P.ws + WS_CNVT) + (size_t)(b * 8 + h) * 128 * 256; M.ntiles = M.nlat + 4;
            if (F.tid < 465) rpbl[F.tid] = P.in[I_RPB][h * 465 + F.tid] * LOG2E; }
        else if (MODE == 2) { b = u >> 3; h = u & 7; tok0 = b * 256 + F.wave * 32;
            qptr = PA + (size_t)(tok0 + q) * 4096 + 1024 + h * 128;
            M.latK = PA + (size_t)(b * 256) * 4096 + 2048 + h * 128; M.latKld = 4096; M.latV = VTp + (size_t)(b * 8 + h) * 128 * 256; M.latVld = 256; M.nlat = 4; M.ctxK = nullptr; M.ctxV = nullptr; M.ntiles = 4; }
        else { b = u >> 7; h = (u >> 4) & 7; const int qb = u & 15; tok0 = TP + b * 4096 + qb * 256 + F.wave * 32;
            qptr = PA + (size_t)(tok0 + q) * 4096 + 1024 + h * 128;
            M.latK = PA + (size_t)(TP + b * 4096) * 4096 + 2048 + h * 128; M.latKld = 4096; M.latV = VTs + (size_t)(b * 8 + h) * 128 * 4096; M.latVld = 4096; M.nlat = 64;
            M.ctxK = (const bf16_t*)(P.ws + WS_CDK) + (size_t)b * 256 * 1024 + h * 128; M.ctxV = (const bf16_t*)(P.ws + WS_CDVT) + (size_t)(b * 8 + h) * 128 * 256; M.ntiles = 68; }
        bf16x8 Qf[8];
        if constexpr (!DIFF) {
            u32x4 w[8]; float ss = 0.f;
#pragma unroll
            for (int ks = 0; ks < 8; ++ks) { w[ks] = *(const u32x4*)(qptr + ks * 16 + hh * 8);
                ss += bflo(w[ks].x) * bflo(w[ks].x) + bfhi(w[ks].x) * bfhi(w[ks].x) + bflo(w[ks].y) * bflo(w[ks].y) + bfhi(w[ks].y) * bfhi(w[ks].y)
                    + bflo(w[ks].z) * bflo(w[ks].z) + bfhi(w[ks].z) * bfhi(w[ks].z) + bflo(w[ks].w) * bflo(w[ks].w) + bfhi(w[ks].w) * bfhi(w[ks].w); }
            ss += __shfl_xor(ss, 32);
            const float qs = rsqrtf(ss * (1.f / 128.f) + NORM_EPS) * c1;
            const float* qg = P.in[I_NAQG];
#pragma unroll
            for (int ks = 0; ks < 8; ++ks) { const f32x4 g0 = *(const f32x4*)(qg + ks * 16 + hh * 8), g1 = *(const f32x4*)(qg + ks * 16 + hh * 8 + 4);
                const u32x4 ws = (u32x4){pk2(bflo(w[ks].x) * qs * g0.x, bfhi(w[ks].x) * qs * g0.y), pk2(bflo(w[ks].y) * qs * g0.z, bfhi(w[ks].y) * qs * g0.w),
                                         pk2(bflo(w[ks].z) * qs * g1.x, bfhi(w[ks].z) * qs * g1.y), pk2(bflo(w[ks].w) * qs * g1.z, bfhi(w[ks].w) * qs * g1.w)};
                Qf[ks] = __builtin_bit_cast(bf16x8, ws); }
        } else {
#pragma unroll
        for (int ks = 0; ks < 8; ++ks) { const u32x4 w = *(const u32x4*)(qptr + ks * 16 + hh * 8);
            const u32x4 ws = (u32x4){pk2(bflo(w.x) * c1, bfhi(w.x) * c1), pk2(bflo(w.y) * c1, bfhi(w.y) * c1), pk2(bflo(w.z) * c1, bfhi(w.z) * c1), pk2(bflo(w.w) * c1, bfhi(w.w) * c1)};
            Qf[ks] = __builtin_bit_cast(bf16x8, ws); }
        }
        f32x16 O[4]; float ls[2] = {0.f, 0.f}; float w0 = 0.f, w1 = 0.f;
#pragma unroll
        for (int db = 0; db < 4; ++db)
#pragma unroll
            for (int i = 0; i < 16; ++i) O[db][i] = 0.f;
        const int cq = (F.wave & 1) * 32 + q;
        const int r0w = min(max(r - 4, 0), 56);
        const int nt = M.ntiles;
        TileRegs R;
        { const bf16_t* kp; const bf16_t* vp; int kld, vld; tile_src(M, 0, kp, kld, vp, vld); tile_load(F, R, kp, kld, vp, vld); }
        if constexpr (!DIFF) tile_norm_k(F, R, kgl, (MODE == 0) ? P.out + O_NAK + (size_t)(b * 256) * 1024 + h * 128 : nullptr, 1024);
        tile_store(F, R, lds + AT_K0, lds + AT_V0);
        __syncthreads();
        if constexpr (DIFF) {
#pragma unroll 1
            for (int j = 0; j < nt; ++j) {
                const int cur = j & 1, jn = (j + 1 < nt) ? j + 1 : 0;
                const bool wv = (j + 1 == nt);
                { const bf16_t* kp; const bf16_t* vp; int kld, vld; tile_src(M, jn, kp, kld, vp, vld); tile_load(F, R, kp, kld, vp, vld, wv); }
                diff_pass1(lds + AT_K0 + cur * AT_KTB, Qf, ls, F.lane);
                tile_store(F, R, lds + AT_K0 + (cur ^ 1) * AT_KTB, lds + AT_V0 + (cur ^ 1) * AT_VTB, wv);
                __syncthreads();
            }
            { const float l0 = ls[0] + __shfl_xor(ls[0], 32), l1 = ls[1] + __shfl_xor(ls[1], 32); w0 = 1.f / l0; w1 = lam / l1; }
#pragma unroll 1
            for (int j = 0; j < nt; ++j) {
                const int cur = (nt + j) & 1;
                if (j + 1 < nt) { const bf16_t* kp; const bf16_t* vp; int kld, vld; tile_src(M, j + 1, kp, kld, vp, vld); tile_load(F, R, kp, kld, vp, vld); }
                diff_pass2(lds + AT_K0 + cur * AT_KTB, lds + AT_V0 + cur * AT_VTB, Qf, O, w0, w1, F.lane);
                if (j + 1 < nt) tile_store(F, R, lds + AT_K0 + (cur ^ 1) * AT_KTB, lds + AT_V0 + (cur ^ 1) * AT_VTB);
                __syncthreads();
            }
        } else {
#pragma unroll 1
            for (int j = 0; j < nt; ++j) {
                const int cur = j & 1;
                if (j + 1 < nt) { const bf16_t* kp; const bf16_t* vp; int kld, vld; tile_src(M, j + 1, kp, kld, vp, vld); tile_load(F, R, kp, kld, vp, vld); }
                LAS const unsigned char* kt = lds + AT_K0 + cur * AT_KTB; LAS const unsigned char* vt = lds + AT_V0 + cur * AT_VTB;
                if constexpr (NA) {
                    if (j < M.nlat) { const int kr = rlo + j;
                        if (kr >= r0w && kr < r0w + 8) attn_compute1<true>(kt, vt, Qf, O, ls[0], F.lane, rpbl + (kr - r + 7) * 31, cq); }
                    else attn_compute1<false>(kt, vt, Qf, O, ls[0], F.lane, rpbl, cq);
                } else attn_compute1<false>(kt, vt, Qf, O, ls[0], F.lane, rpbl, cq);
                if (j + 1 < nt) {
                    if (j + 1 < M.nlat) tile_norm_k(F, R, kgl, (MODE == 0) ? P.out + O_NAK + (size_t)(b * 256 + (j + 1) * 64) * 1024 + h * 128 : nullptr, 1024);
                    tile_store(F, R, lds + AT_K0 + (cur ^ 1) * AT_KTB, lds + AT_V0 + (cur ^ 1) * AT_VTB); }
                __syncthreads();
            }
        }
        if constexpr (!DIFF) {
            const float inv = 1.f / (ls[0] + __shfl_xor(ls[0], 32));
            bf16_t* op = MIX + (size_t)(tok0 + q) * DM + h * 128 + 4 * hh;
#pragma unroll
            for (int db = 0; db < 4; ++db)
#pragma unroll
                for (int g = 0; g < 4; ++g) { u32x2 w; w.x = pk2(O[db][4 * g] * inv, O[db][4 * g + 1] * inv); w.y = pk2(O[db][4 * g + 2] * inv, O[db][4 * g + 3] * inv);
                    *(u32x2*)(op + db * 32 + 8 * g) = w; }
        } else {
            float ss = 0.f;
#pragma unroll
            for (int db = 0; db < 4; ++db)
#pragma unroll
                for (int i = 0; i < 16; ++i) ss += O[db][i] * O[db][i];
            ss += __shfl_xor(ss, 32);
            const float sc = rsqrtf(ss * (1.f / 128.f) + NORM_EPS) * (1.f - 0.35550906759096924f);
            const float* sg = P.in[I_SUBG];
            bf16_t* op = MIX + (size_t)(tok0 + q) * DM + 1024 + h * 128 + 4 * hh;
#pragma unroll
            for (int db = 0; db < 4; ++db)
#pragma unroll
                for (int g = 0; g < 4; ++g) { const f32x4 g4 = *(const f32x4*)(sg + db * 32 + 8 * g + 4 * hh);
                    u32x2 w; w.x = pk2(O[db][4 * g] * sc * g4.x, O[db][4 * g + 1] * sc * g4.y); w.y = pk2(O[db][4 * g + 2] * sc * g4.z, O[db][4 * g + 3] * sc * g4.w);
                    *(u32x2*)(op + db * 32 + 8 * g) = w; }
        }
    }
}
template <int L, int BATCH> struct HyCfg {
    static constexpr int NB = L / 64, TPT = 32 / BATCH, NTILES = NB / TPT, LOGB = (BATCH == 8) ? 3 : 5;
    static constexpr int ZROWB = (L + 384) * 2 + 16, ZBYTES = BATCH * ZROWB, RL = 2 * L + 16;
    static constexpr int TPW = (NTILES + 7) / 8;
};
constexpr int HY_KR_OFF = 71808;

template <int L, int BATCH>
DI void hyena_part(const Ctx& F, const Params& P, int c, int tokbase  , const bf16_t* KRG  ) {
    typedef HyCfg<L, BATCH> C;
    LAS unsigned char* lds = F.lds;
    bf16_t* CM = (bf16_t*)(P.ws + WS_RB);
    const float* hbias = P.in[I_HYBIAS];
    const int q = F.lane & 31, hh = F.lane >> 5;
    __syncthreads();
    for (int id = F.tid; id < BATCH * (L / 8); id += NTHR) { const int b = id / (L / 8), s8 = (id % (L / 8)) * 8;
        *(LAS u32x4*)(lds + b * C::ZROWB + (192 + s8) * 2) = *(const u32x4*)(CM + (size_t)c * TOK + tokbase + b * L + s8); }
    for (int id = F.tid; id < BATCH * 48; id += NTHR) { const int b = id / 48, k = id % 48, e = (k < 24) ? k * 8 : (192 + L + (k - 24) * 8);
        *(LAS u32x4*)(lds + b * C::ZROWB + e * 2) = (u32x4){0u, 0u, 0u, 0u}; }
#pragma unroll 1
    for (int o = 0; o < 2; ++o) {
        { const bf16_t* src = KRG + (size_t)(o * 1024 + c) * C::RL;
          for (int id = F.tid; id < C::RL / 8; id += NTHR) { const u32x4 v = *(const u32x4*)(src + id * 8);
              *(LAS u32x4*)(lds + HY_KR_OFF + id * 16) = v;
              LAS bf16_t* c1 = (LAS bf16_t*)(lds + HY_KR_OFF + C::RL * 2) + id * 8 - 1;
              if (id > 0) c1[0] = (bf16_t)(v.x & 0xffff);
              c1[1] = (bf16_t)(v.x >> 16); c1[2] = (bf16_t)(v.y & 0xffff); c1[3] = (bf16_t)(v.y >> 16); c1[4] = (bf16_t)(v.z & 0xffff); c1[5] = (bf16_t)(v.z >> 16);
              c1[6] = (bf16_t)(v.w & 0xffff); c1[7] = (bf16_t)(v.w >> 16); } }
        __syncthreads();
        f32x16 acc[C::TPW][2];
#pragma unroll
        for (int t = 0; t < C::TPW; ++t)
#pragma unroll
            for (int mt = 0; mt < 2; ++mt)
#pragma unroll
                for (int i = 0; i < 16; ++i) acc[t][mt][i] = 0.f;
        const int tq0 = F.wave * C::TPW;
        if (tq0 < C::NTILES) {
            const int d1lo = C::TPT * tq0 - (C::NB - 1), d1hi = C::TPT * (tq0 + C::TPW - 1) + C::TPT - 1;
            const int abase = HY_KR_OFF + (F.lane & 1) * (C::RL * 2) + (L - (F.lane & 31) + 8 * hh - (F.lane & 1)) * 2;
            bf16x8 W0[6], W1[6], B0[C::TPW][4];
#define HY_LDW(Wv, d1v, i) do { LAS const unsigned* ap_ = (LAS const unsigned*)(lds + abase + (-4 * (d1v) - 2 + (i)) * 32); Wv[i] = __builtin_bit_cast(bf16x8, (u32x4){ap_[0], ap_[1], ap_[2], ap_[3]}); } while (0)
#define HY_LDB(Bv, d1v) do { _Pragma("unroll") for (int t_ = 0; t_ < C::TPW; ++t_) { const int tq_ = tq0 + t_; \
            const int t1_ = C::TPT * tq_ + (q >> C::LOGB), b_ = q & (BATCH - 1); int s1_ = t1_ - (d1v); s1_ = min(max(s1_, -3), C::NB + 2); \
            LAS const unsigned char* bp_ = lds + b_ * C::ZROWB + (192 + 64 * s1_ + 8 * hh) * 2; \
            _Pragma("unroll") for (int ks_ = 0; ks_ < 4; ++ks_) Bv[t_][ks_] = *(const LAS bf16x8*)(bp_ + ks_ * 32); } } while (0)
#define HY_MM(Wv, Bv, d1v) do { _Pragma("unroll") for (int t_ = 0; t_ < C::TPW; ++t_) { const int tq_ = tq0 + t_; \
            if ((d1v) >= C::TPT * tq_ - (C::NB - 1) && (d1v) <= C::TPT * tq_ + C::TPT - 1) { \
                _Pragma("unroll") for (int ks_ = 0; ks_ < 4; ++ks_) _Pragma("unroll") for (int mt_ = 0; mt_ < 2; ++mt_) \
                    acc[t_][mt_] = __builtin_amdgcn_mfma_f32_32x32x16_bf16(Wv[ks_ - 2 * mt_ + 2], Bv[t_][ks_], acc[t_][mt_], 0, 0, 0); } } } while (0)
#pragma unroll
            for (int i = 0; i < 6; ++i) HY_LDW(W0, d1lo, i);
            int d1 = d1lo;
#pragma unroll 1
            for (; d1 + 1 <= d1hi; d1 += 2) {
                HY_LDB(B0, d1);
#pragma unroll
                for (int i = 0; i < 4; ++i) HY_LDW(W1, d1 + 1, i);
                W1[4] = W0[0]; W1[5] = W0[1];
                HY_MM(W0, B0, d1);
                HY_LDB(B0, d1 + 1);
                if (d1 + 2 <= d1hi) {
#pragma unroll
                    for (int i = 0; i < 4; ++i) HY_LDW(W0, d1 + 2, i);
                    W0[4] = W1[0]; W0[5] = W1[1];
                }
                HY_MM(W1, B0, d1 + 1);
            }
            if (d1 <= d1hi) { HY_LDB(B0, d1); HY_MM(W0, B0, d1); }
#undef HY_LDW
#undef HY_LDB
#undef HY_MM
        }
        __syncthreads();
        if (tq0 < C::NTILES) {
            const float bo = hbias[o * 1024 + c];
            const bf16_t* gate = CM + (size_t)((1 + o) * 1024 + c) * TOK + tokbase;
            bf16_t* zout = (bf16_t*)(P.ws + WS_RA + RA_ZC) + (size_t)c * TOK + tokbase;
#pragma unroll
            for (int t = 0; t < C::TPW; ++t) { const int tq = tq0 + t, t1 = C::TPT * tq + (q >> C::LOGB), b = q & (BATCH - 1);
#pragma unroll
                for (int mt = 0; mt < 2; ++mt)
#pragma unroll
                    for (int g = 0; g < 4; ++g) { const int s = 64 * t1 + 32 * mt + 8 * g + 4 * hh;
                        LAS u32x2* zp = (LAS u32x2*)(lds + b * C::ZROWB + (192 + s) * 2);
                        const u32x2 zv = *zp, gv = *(const u32x2*)(gate + (size_t)b * L + s);
                        const float r0 = bflo(gv.x) * (acc[t][mt][4 * g] + bflo(zv.x) * bo), r1 = bfhi(gv.x) * (acc[t][mt][4 * g + 1] + bfhi(zv.x) * bo);
                        const float r2 = bflo(gv.y) * (acc[t][mt][4 * g + 2] + bflo(zv.y) * bo), r3 = bfhi(gv.y) * (acc[t][mt][4 * g + 3] + bfhi(zv.y) * bo);
                        const u32x2 w = (u32x2){pk2(r0, r1), pk2(r2, r3)};
                        if (o == 0) *zp = w; else *(u32x2*)(zout + (size_t)b * L + s) = w; } }
        }
        __syncthreads();
    }
}

DI void hyena_phase(const Ctx& F, const Params& P) {
    for (int c = F.bid; c < 1024; c += F.G) {
        hyena_part<LS, 8>(F, P, c, TP, (const bf16_t*)(P.ws + WS_KRS));
        hyena_part<LP, 32>(F, P, c, 0, (const bf16_t*)(P.ws + WS_KRP));
    }
}

DI void hyena_post(const Ctx& F, const Params& P) {
    const bf16_t* CM = (const bf16_t*)(P.ws + WS_RA + RA_ZC); bf16_t* MIX = (bf16_t*)(P.ws + WS_HM);
    for (int t = F.bid; t < 16 * 640; t += F.G) { const int cg = t & 15, tg = t >> 4;
        tr_tile_bf16(F, CM + (size_t)(cg * 64) * TOK + tg * 64, TOK, MIX + (size_t)(tg * 64) * DM + 1024 + cg * 64, DM, (LAS bf16_t*)F.lds); }
}
DI void prep_c(const Ctx& F, const Params& P) {
    bf16_t* PA = (bf16_t*)(P.ws + WS_RA);
    LAS float* rope = (LAS float*)(F.lds + 16384);
    __syncthreads();
    for (int e = F.tid; e < 1024; e += NTHR) { const int pos = e >> 4, f = e & 15; const float inv = exp2f(-(float)f * (13.287712379549449f / 16.f)); const float a = (float)pos * inv;
        rope[e * 2] = cosf(a); rope[e * 2 + 1] = sinf(a); }
    __syncthreads();
    { const float* gsrc = (F.lane < 32 ? P.in[I_DQG] : P.in[I_DKG]) + (F.lane & 1) * 32; float* ok = P.out + O_DK;
      float g[32];
#pragma unroll
      for (int i = 0; i < 32; ++i) g[i] = gsrc[i];
      for (int T = F.bid * 8 + F.wave; T < TOK; T += F.G * 8) {
          bf16_t* rp = PA + (size_t)T * 4096 + 1024 + F.lane * 32;
          u32x4 v[4]; float x[32]; float ss = 0.f;
#pragma unroll
          for (int j = 0; j < 4; ++j) { v[j] = *(const u32x4*)(rp + j * 8);
              x[j * 8 + 0] = bflo(v[j].x); x[j * 8 + 1] = bfhi(v[j].x); x[j * 8 + 2] = bflo(v[j].y); x[j * 8 + 3] = bfhi(v[j].y);
              x[j * 8 + 4] = bflo(v[j].z); x[j * 8 + 5] = bfhi(v[j].z); x[j * 8 + 6] = bflo(v[j].w); x[j * 8 + 7] = bfhi(v[j].w); }
#pragma unroll
          for (int i = 0; i < 32; ++i) ss += x[i] * x[i];
          ss += dpp_xor1(ss);
          const float rstd = rsqrtf(ss * (1.f / 64.f) + NORM_EPS);
#pragma unroll
          for (int i = 0; i < 32; ++i) x[i] = x[i] * rstd * g[i];
          if (T < TP) { if (F.lane >= 32) { float* o = ok + (size_t)T * 1024 + (F.lane - 32) * 32;
#pragma unroll
                  for (int j = 0; j < 8; ++j) *(f32x4*)(o + j * 4) = (f32x4){x[j * 4], x[j * 4 + 1], x[j * 4 + 2], x[j * 4 + 3]}; } }
          else { const int t = (T - TP) & 4095, pos = (F.lane & 1) ? (t & 63) : (t >> 6);
              const LAS float* rt = rope + pos * 32;
#pragma unroll
              for (int f = 0; f < 16; ++f) { const float cs = rt[2 * f], sn = rt[2 * f + 1], a = x[f], b = x[16 + f]; x[f] = a * cs - b * sn; x[16 + f] = b * cs + a * sn; } }
#pragma unroll
          for (int j = 0; j < 4; ++j) { u32x4 w; w.x = pk2(x[j * 8 + 0], x[j * 8 + 1]); w.y = pk2(x[j * 8 + 2], x[j * 8 + 3]); w.z = pk2(x[j * 8 + 4], x[j * 8 + 5]); w.w = pk2(x[j * 8 + 6], x[j * 8 + 7]);
              *(u32x4*)(rp + j * 8) = w; }
      } }
    __syncthreads();
    bf16_t* VTp = (bf16_t*)(P.ws + WS_VT); bf16_t* VTs = (bf16_t*)(P.ws + WS_VT + VT_S);
    for (int t = F.bid; t < 2048 + 8192; t += F.G) {
        if (t < 2048) { const int bh = t >> 3, sub = t & 7, tk = sub >> 1, dd = sub & 1, b = bh >> 3, h = bh & 7;
            tr_tile_bf16(F, PA + ((size_t)(b * 256 + tk * 64)) * 4096 + 3072 + h * 128 + dd * 64, 4096, VTp + ((size_t)bh * 128 + dd * 64) * 256 + tk * 64, 256, (LAS bf16_t*)F.lds); }
        else { const int u = t - 2048, bh = u >> 7, sub = u & 127, tk = sub >> 1, dd = sub & 1, b = bh >> 3, h = bh & 7;
            tr_tile_bf16(F, PA + ((size_t)(TP + b * 4096 + tk * 64)) * 4096 + 3072 + h * 128 + dd * 64, 4096, VTs + ((size_t)bh * 128 + dd * 64) * 4096 + tk * 64, 4096, (LAS bf16_t*)F.lds); }
    }
    { float* o = P.out + O_DV;
      for (int e = F.bid * NTHR + F.tid; e < TP * 128; e += F.G * NTHR) { const int T = e >> 7, c8 = (e & 127) * 8;
          const u32x4 v = *(const u32x4*)(PA + (size_t)T * 4096 + 3072 + c8);
          *(f32x4*)(o + (size_t)T * 1024 + c8) = (f32x4){bflo(v.x), bfhi(v.x), bflo(v.y), bfhi(v.y)};
          *(f32x4*)(o + (size_t)T * 1024 + c8 + 4) = (f32x4){bflo(v.z), bfhi(v.z), bflo(v.w), bfhi(v.w)}; } }
}

constexpr int S5_BUROW = 132 * 4, S5_HROW = 272, S5_WLDS = 16 * S5_BUROW + 16 * S5_HROW;
DI void s5_chain(const Ctx& F, const Params& P, int dg, int tok0, int L, const float* h0re, const float* h0im, float* fre, float* fim, bf16_t* Yout) {
    LAS unsigned char* wl = F.lds + F.wave * S5_WLDS; LAS unsigned char* hl = wl + 16 * S5_BUROW;
    const int g = dg & 63, dir = dg >> 6, lane = F.lane, st = lane & 15, gq = lane >> 4;
    const float* S5A = (const float*)(P.ws + WS_S5A); const bf16_t* BB = (const bf16_t*)(P.ws + WS_S5BB); const bf16_t* CC = (const bf16_t*)(P.ws + WS_S5CC);
    const bf16_t* PA = (const bf16_t*)(P.ws + WS_RA);
    const float ar = S5A[(dg * 64 + lane) * 2], ai = S5A[(dg * 64 + lane) * 2 + 1];
    float hr = h0re ? h0re[lane] : 0.f, hi = h0im ? h0im[lane] : 0.f;
    const bf16x8 zero8 = (bf16x8){0, 0, 0, 0, 0, 0, 0, 0};
    bf16x8 BBf[8], CCf[4];
#pragma unroll
    for (int mt = 0; mt < 8; ++mt) BBf[mt] = (gq < 2) ? *(const bf16x8*)(BB + ((size_t)dg * 128 + mt * 16 + st) * 16 + gq * 8) : zero8;
#pragma unroll
    for (int kk = 0; kk < 4; ++kk) CCf[kk] = *(const bf16x8*)(CC + ((size_t)dg * 16 + st) * 128 + kk * 32 + gq * 8);
    const int nch = L / 16;
    const int sgn = dir ? -1 : 1, tstart = dir ? tok0 + L - 1 : tok0;
    bf16x8 Uf = zero8, U1 = zero8, U2 = zero8;
    if (gq < 2) { Uf = *(const bf16x8*)(PA + (size_t)(tstart + sgn * st) * 4096 + g * 16 + gq * 8);
        if (1 < nch) U1 = *(const bf16x8*)(PA + (size_t)(tstart + sgn * (16 + st)) * 4096 + g * 16 + gq * 8);
        if (2 < nch) U2 = *(const bf16x8*)(PA + (size_t)(tstart + sgn * (32 + st)) * 4096 + g * 16 + gq * 8); }
    for (int ch = 0; ch < nch; ++ch) {
        bf16x8 Un = zero8;
        if (ch + 3 < nch && gq < 2) Un = *(const bf16x8*)(PA + (size_t)(tstart + sgn * ((ch + 3) * 16 + st)) * 4096 + g * 16 + gq * 8);
#pragma unroll
        for (int mt = 0; mt < 8; ++mt) { f32x4 d = (f32x4){0.f, 0.f, 0.f, 0.f};
            d = __builtin_amdgcn_mfma_f32_16x16x32_bf16(BBf[mt], Uf, d, 0, 0, 0);
            *(LAS f32x4*)(wl + st * S5_BUROW + (mt * 16 + gq * 4) * 4) = d; }
        asm volatile("" ::: "memory");
#pragma unroll
        for (int s = 0; s < 16; ++s) {
            const float bur = *(const LAS float*)(wl + s * S5_BUROW + lane * 4), bui = *(const LAS float*)(wl + s * S5_BUROW + (64 + lane) * 4);
            const float nr = ar * hr - ai * hi + bur, ni = ar * hi + ai * hr + bui; hr = nr; hi = ni;
            *(LAS bf16_t*)(hl + s * S5_HROW + lane * 2) = f2bf(hr); *(LAS bf16_t*)(hl + s * S5_HROW + (64 + lane) * 2) = f2bf(hi);
        }
        asm volatile("" ::: "memory");
        f32x4 y = (f32x4){0.f, 0.f, 0.f, 0.f};
#pragma unroll
        for (int kk = 0; kk < 4; ++kk) { const bf16x8 Bh = *(const LAS bf16x8*)(hl + st * S5_HROW + (kk * 32 + gq * 8) * 2);
            y = __builtin_amdgcn_mfma_f32_16x16x32_bf16(CCf[kk], Bh, y, 0, 0, 0); }
        { const int tok = tstart + sgn * (ch * 16 + st);
          *(u32x2*)(Yout + (size_t)tok * 1024 + g * 16 + gq * 4) = (u32x2){pk2(y[0], y[1]), pk2(y[2], y[3])}; }
        asm volatile("" ::: "memory");
        Uf = U1; U1 = U2; U2 = Un;
    }
    if (fre) { fre[lane] = hr; fim[lane] = hi; }
}

DI void s5_phase(const Ctx& F, const Params& P) {
    bf16_t* YF = (bf16_t*)(P.ws + WS_RB + RB_YF); bf16_t* YB = (bf16_t*)(P.ws + WS_RB + RB_YB);
    for (int cs = F.bid; cs < 256; cs += F.G) {
        if (F.wave < 4) { const int sc = cs * 4 + F.wave, dg = sc & 127, b = sc >> 7;
            s5_chain(F, P, dg, TP + b * 4096, LS, P.in[I_S5RE] + (size_t)sc * 64, P.in[I_S5IM] + (size_t)sc * 64, nullptr, nullptr, (dg >> 6) ? YB : YF); }
        else { for (int k = 0; k < 4; ++k) { const int pc = (cs * 4 + (F.wave - 4)) * 4 + k, dg = pc & 127, b = pc >> 7;
            s5_chain(F, P, dg, b * 256, LP, nullptr, nullptr, P.out + O_SR + (size_t)pc * 64, P.out + O_SI + (size_t)pc * 64, (dg >> 6) ? YB : YF); } }
    }
}

DI void s5_combine(const Ctx& F, const Params& P) {
    const bf16_t* PA = (const bf16_t*)(P.ws + WS_RA); const bf16_t* YF = (const bf16_t*)(P.ws + WS_RB + RB_YF); const bf16_t* YB = (const bf16_t*)(P.ws + WS_RB + RB_YB);
    bf16_t* Y = (bf16_t*)(P.ws + WS_RB + RB_Y); const float* dsk = P.in[I_S5D];
    for (size_t e = (size_t)F.bid * NTHR + F.tid; e < (size_t)TOK * 128; e += (size_t)F.G * NTHR) { const size_t T = e >> 7; const int c8 = (int)(e & 127) * 8;
        const u32x4 uv = *(const u32x4*)(PA + T * 4096 + c8), fv = *(const u32x4*)(YF + T * 1024 + c8), bv = *(const u32x4*)(YB + T * 1024 + c8);
        const f32x4 d0 = *(const f32x4*)(dsk + c8), d1 = *(const f32x4*)(dsk + c8 + 4);
        float o[8];
        o[0] = gelu_tanh(d0.x * bflo(uv.x) + bflo(fv.x) + bflo(bv.x)); o[1] = gelu_tanh(d0.y * bfhi(uv.x) + bfhi(fv.x) + bfhi(bv.x));
        o[2] = gelu_tanh(d0.z * bflo(uv.y) + bflo(fv.y) + bflo(bv.y)); o[3] = gelu_tanh(d0.w * bfhi(uv.y) + bfhi(fv.y) + bfhi(bv.y));
        o[4] = gelu_tanh(d1.x * bflo(uv.z) + bflo(fv.z) + bflo(bv.z)); o[5] = gelu_tanh(d1.y * bfhi(uv.z) + bfhi(fv.z) + bfhi(bv.z));
        o[6] = gelu_tanh(d1.z * bflo(uv.w) + bflo(fv.w) + bflo(bv.w)); o[7] = gelu_tanh(d1.w * bfhi(uv.w) + bfhi(fv.w) + bfhi(bv.w));
        u32x4 w; w.x = pk2(o[0], o[1]); w.y = pk2(o[2], o[3]); w.z = pk2(o[4], o[5]); w.w = pk2(o[6], o[7]);
        *(u32x4*)(Y + T * 1024 + c8) = w; }
}
constexpr int PS_KROW = 272;
constexpr int PS_IDX_OFF = 2 * 128 * PS_KROW;
constexpr int PS_TAB_OFF = PS_IDX_OFF + 512 * 32;

DI void topk_insert(float (&a)[16], float x) {
#pragma unroll
    for (int j = 15; j >= 1; --j) a[j] = __builtin_amdgcn_fmed3f(a[j - 1], a[j], x);
    a[0] = fmaxf(a[0], x);
}

DI void peer_select(const Ctx& F, const Params& P, int layer) {
    LAS unsigned char* lds = F.lds;
    const bf16_t* Q = (const bf16_t*)(P.ws + WS_RA + RA_Q);
    int* SELI = (int*)(P.ws + WS_RA + RA_SELI); float* SELW = (float*)(P.ws + WS_RA + RA_SELW);
    const bf16_t* KEYS = (const bf16_t*)(P.ws + WS_PKEYS) + (size_t)layer * 8 * 2 * 128 * 128;
    const int q = F.lane & 31, hh = F.lane >> 5;
    LAS unsigned char* myidx = lds + PS_IDX_OFF + F.tid * 32;
    LAS unsigned char* tab = lds + PS_TAB_OFF;
    for (int wu = F.bid; wu < 256; wu += F.G) {
        const int h = wu & 7, chunk = wu >> 3;
        __syncthreads();
        for (int id = F.tid; id < 2 * 128 * 16; id += NTHR) { const int row = id >> 4, c16 = id & 15;
            *(LAS u32x4*)(lds + row * PS_KROW + c16 * 16) = *(const u32x4*)(KEYS + ((size_t)h * 256 + row) * 128 + c16 * 8); }
        if (F.tid < 16) { int cnt = 0;
            for (int a = 0; a < F.tid; ++a) cnt += 16 / (a + 1);
            for (int b = 0; b < 16 / (F.tid + 1); ++b) { tab[(cnt + b) * 2] = (unsigned char)F.tid; tab[(cnt + b) * 2 + 1] = (unsigned char)b; } }
        __syncthreads();
        for (int blk = F.wave; blk < 40; blk += 8) {
            const int T0 = chunk * 1280 + blk * 32;
            float lst[2][16];
#pragma unroll
            for (int side = 0; side < 2; ++side) {
                bf16x8 Qf[8];
                const bf16_t* qp = Q + (size_t)(T0 + q) * 2048 + h * 256 + side * 128 + hh * 8;
#pragma unroll
                for (int ks = 0; ks < 8; ++ks) Qf[ks] = *(const bf16x8*)(qp + ks * 16);
                float a[16];
#pragma unroll
                for (int j = 0; j < 16; ++j) a[j] = -3.0e38f;
#pragma unroll
                for (int nt = 0; nt < 4; ++nt) {
                    f32x16 S;
#pragma unroll
                    for (int i = 0; i < 16; ++i) S[i] = 0.f;
#pragma unroll
                    for (int ks = 0; ks < 8; ++ks) { const bf16x8 A = *(const LAS bf16x8*)(lds + (side * 128 + nt * 32 + q) * PS_KROW + (ks * 16 + hh * 8) * 2);
                        S = __builtin_amdgcn_mfma_f32_32x32x16_bf16(A, Qf[ks], S, 0, 0, 0); }
#pragma unroll
                    for (int i = 0; i < 16; ++i) { const int n = nt * 32 + (i & 3) + 8 * (i >> 2) + 4 * hh;
                        topk_insert(a, __uint_as_float((__float_as_uint(S[i]) & 0xffffff80u) | (unsigned)n)); }
                }
                float pb[16];
#pragma unroll
                for (int j = 0; j < 16; ++j) pb[j] = __shfl_xor(a[j], 32);
#pragma unroll
                for (int j = 0; j < 16; ++j) topk_insert(a, pb[j]);
#pragma unroll
                for (int j = 0; j < 16; ++j) { lst[side][j] = a[j]; myidx[side * 16 + j] = (unsigned char)(__float_as_uint(a[j]) & 0x7fu); }
            }
            float cb[16];
#pragma unroll
            for (int j = 0; j < 16; ++j) cb[j] = -3.0e38f;
            { int cid = 0;
#pragma unroll
              for (int a = 0; a < 16; ++a)
#pragma unroll
                  for (int b = 0; b < 16 / (a + 1); ++b) {
                      const float sa = __uint_as_float(__float_as_uint(lst[0][a]) & 0xffffff80u), sb = __uint_as_float(__float_as_uint(lst[1][b]) & 0xffffff80u);
                      topk_insert(cb, __uint_as_float((__float_as_uint(sa + sb) & 0xffffffc0u) | (unsigned)cid)); ++cid; } }
            const float mx = __uint_as_float(__float_as_uint(cb[0]) & 0xffffffc0u);
            float e[16], den = 0.f;
#pragma unroll
            for (int j = 0; j < 16; ++j) { e[j] = __expf(__uint_as_float(__float_as_uint(cb[j]) & 0xffffffc0u) - mx); den += e[j]; }
            const float rden = 1.f / den;
#pragma unroll
            for (int j = 0; j < 16; ++j) {
                if ((j >> 3) == hh) { const int cid = (int)(__float_as_uint(cb[j]) & 0x3fu);
                    const int a = tab[cid * 2], b = tab[cid * 2 + 1];
                    const int eidx = (int)myidx[a] * 128 + (int)myidx[16 + b];
                    SELI[(size_t)(T0 + q) * 128 + h * 16 + j] = eidx; SELW[(size_t)(T0 + q) * 128 + h * 16 + j] = e[j] * rden; }
            }
        }
    }
    __syncthreads();
}

DI u32x16 fp6_unpack_bf16(u32x4 a, u32x2 b) { const u32x6 pk = {a.x, a.y, a.z, a.w, b.x, b.y}; return __builtin_bit_cast(u32x16, __builtin_amdgcn_cvt_scalef32_pk32_bf16_fp6(pk, 1.0f)); }
DI f32x32 fp6_unpack(u32x4 a, u32x2 b) { const u32x6 pk = {a.x, a.y, a.z, a.w, b.x, b.y}; return __builtin_amdgcn_cvt_scalef32_pk32_f32_fp6(pk, 1.0f); }
constexpr int GN = 8;
template <bool NEXTNORM>
DI void peer_gather(const Ctx& F, const Params& P, const float* modl, int layer, const float* ngain, const float* nmodl) {
    const bf16_t* H2 = (const bf16_t*)(P.ws + WS_HM);
    const unsigned char* TU = P.ws + WS_TBLU + (size_t)layer * 16384 * PT_ROWB; const unsigned char* TV = P.ws + WS_TBLV + (size_t)layer * 16384 * PT_ROWB;
    const float* SCU = (const float*)(P.ws + WS_SC) + layer * 16384; const float* SCV = (const float*)(P.ws + WS_SC) + (2 + layer) * 16384;
    const int* SELI = (const int*)(P.ws + WS_RA + RA_SELI); const float* SELW = (const float*)(P.ws + WS_RA + RA_SELW);
    float* X = P.out + O_Y;
    const int lane = lane_id();
    for (int T = F.bid * 8 + F.wave; T < TOK; T += F.G * 8) {
        u32x4 xw[4];
#pragma unroll
        for (int q4 = 0; q4 < 4; ++q4) xw[q4] = *(const u32x4*)(H2 + (size_t)T * DM + lane * 32 + q4 * 8);
        const int e0 = SELI[(size_t)T * 128 + lane], e1 = SELI[(size_t)T * 128 + 64 + lane];
        const float g0 = SELW[(size_t)T * 128 + lane], g1 = SELW[(size_t)T * 128 + 64 + lane];
        float d0 = 0.f, d1 = 0.f;
#pragma unroll 1
        for (int kb = 0; kb < 128; kb += GN) {
            u32x4 ura[GN]; u32x2 urb[GN];
#pragma unroll
            for (int j = 0; j < GN; ++j) { const int k = kb + j; const int e = __builtin_amdgcn_readlane(k < 64 ? e0 : e1, k & 63);
                const unsigned char* up = TU + (size_t)e * PT_ROWB;
                ura[j] = *(const u32x4*)(up + lane * 16); urb[j] = *(const u32x2*)(up + 1024 + lane * 8); }
#pragma unroll
            for (int j = 0; j < GN; ++j) { const u32x16 r = fp6_unpack_bf16(ura[j], urb[j]);
                float sa = 0.f, sb = 0.f, sc2 = 0.f, sd = 0.f;
#pragma unroll
                for (int i = 0; i < 4; ++i) { const unsigned x0 = xw[i].x, x1 = xw[i].y, x2 = xw[i].z, x3 = xw[i].w;
                    sa = dot2bf(r[4 * i], x0, sa); sb = dot2bf(r[4 * i + 1], x1, sb); sc2 = dot2bf(r[4 * i + 2], x2, sc2); sd = dot2bf(r[4 * i + 3], x3, sd); }
                const float sm = wave_sum((sa + sb) + (sc2 + sd)); const int k = kb + j;
                if (k < 64) { if (lane == k) d0 = sm; } else { if (lane == k - 64) d1 = sm; } }
        }
        const float cf0 = g0 * gelu_tanh(d0 * SCU[e0]) * SCV[e0], cf1 = g1 * gelu_tanh(d1 * SCU[e1]) * SCV[e1];
        f32x2 acc[16];
#pragma unroll
        for (int i = 0; i < 16; ++i) acc[i] = (f32x2){0.f, 0.f};
#pragma unroll 1
        for (int kb = 0; kb < 128; kb += GN) {
            u32x4 vra[GN]; u32x2 vrb[GN]; float cf[GN];
#pragma unroll
            for (int j = 0; j < GN; ++j) { const int k = kb + j; const int e = __builtin_amdgcn_readlane(k < 64 ? e0 : e1, k & 63);
                cf[j] = __builtin_bit_cast(float, __builtin_amdgcn_readlane(__builtin_bit_cast(int, k < 64 ? cf0 : cf1), k & 63));
                const unsigned char* vp = TV + (size_t)e * PT_ROWB;
                vra[j] = *(const u32x4*)(vp + lane * 16); vrb[j] = *(const u32x2*)(vp + 1024 + lane * 8); }
#pragma unroll
            for (int j = 0; j < GN; ++j) { const f32x32 r = fp6_unpack(vra[j], vrb[j]);
                const f32x2 c2 = (f32x2){cf[j], cf[j]};
#pragma unroll
                for (int i = 0; i < 16; ++i) acc[i] += c2 * (f32x2){r[2 * i], r[2 * i + 1]}; }
        }
        const float* gate = modl + (size_t)(cond_of(T) * 6 + 5) * DM;
        f32x4 xn[8]; float ss = 0.f;
#pragma unroll
        for (int q4 = 0; q4 < 8; ++q4) { const int col = lane * 32 + q4 * 4; float* xp = X + (size_t)T * DM + col;
            const f32x4 gv = *(const f32x4*)(gate + col), x0 = *(const f32x4*)(xp);
            const f32x4 r = x0 + gv * (f32x4){acc[q4 * 2].x, acc[q4 * 2].y, acc[q4 * 2 + 1].x, acc[q4 * 2 + 1].y};
            *(f32x4*)(xp) = r; xn[q4] = r; ss += r.x * r.x + r.y * r.y + r.z * r.z + r.w * r.w; }
        if (NEXTNORM) {
            ss = wave_sum(ss);
            const float rstd = rsqrtf(ss * (1.f / DM) + NORM_EPS);
            const float* sh = nmodl + (size_t)(cond_of(T) * 6 + 0) * DM; const float* sc = sh + DM;
            bf16_t* H = (bf16_t*)(P.ws + WS_HM);
#pragma unroll
            for (int q4 = 0; q4 < 8; ++q4) { const int col = lane * 32 + q4 * 4;
                const f32x4 g4 = *(const f32x4*)(ngain + col), s4 = *(const f32x4*)(sc + col), h4 = *(const f32x4*)(sh + col);
                const f32x4 o = xn[q4] * rstd * g4 * (s4 + 1.f) + h4;
                *(u32x2*)(H + (size_t)T * DM + col) = (u32x2){pk2(o.x, o.y), pk2(o.z, o.w)}; }
        }
    }
}
constexpr int NPHASE = 22;

__global__ void __launch_bounds__(NTHR, 2) mega(Params P) {
    extern __shared__ __attribute__((aligned(16))) unsigned char lds_raw[];
    Ctx F;
    F.lds = (LAS unsigned char*)lds_raw; F.tid = threadIdx.x; F.lane = F.tid & 63; F.wave = __builtin_amdgcn_readfirstlane(F.tid >> 6); F.G = gridDim.x; F.bid = blockIdx.x;
    const int lo = P.ph_lo, hi = P.ph_hi;
    volatile LAS unsigned* xbw = (volatile LAS unsigned*)(F.lds + LDS_BYTES - 16);
    if (F.tid == 0) { xbw[0] = 0u; xbw[1] = 0u; xbw[2] = 0u; xbw[3] = 0u; }
    __syncthreads();
    if (hi - lo > 1) (void)xcd_barrier_post((unsigned*)(P.ws + WS_CTL), xbw);
#define GRID_BARRIER() do { XcdBarrier bar_; bar_.bar = (unsigned*)(P.ws + WS_CTL); bar_.x = xb_xcc_id(); bar_.st = (volatile LAS unsigned*)(F.lds + LDS_BYTES - 16); xcd_barrier(bar_); } while (0)
#define PH(k, ...) if (lo <= (k) && (k) < hi) { { __VA_ARGS__ } if ((k) + 1 < hi) GRID_BARRIER(); }
#define MOD0 ((const float*)(P.ws + WS_MOD))
#define MOD1 ((const float*)(P.ws + WS_MOD) + 9 * 12288)
#define HM ((bf16_t*)(P.ws + WS_HM))
#define RA ((bf16_t*)(P.ws + WS_RA))
#define X (P.out + O_Y)

    PH(0, prologue(F, P);)
    PH(1, adaln_reduce(F, P);)
    PH(2, norm_phase(F, P.in[I_XP], P.in[I_XS], P.in[I_NMIXG], MOD0, 0, HM);)
    PH(3, { EpiBf16 E{RA, 4096}; run_gemm(F, HM, (const bf16_t*)(P.ws + WS_WEVIN) + (size_t)2048 * 2048, 4096, 2048, E); })
    PH(4, prep_a(F, P);)
    PH(5, { EpiBf16 E{RA, 2048}; run_gemm(F, HM, (const bf16_t*)(P.ws + WS_WEVIN), 2048, 2048, E); })
    PH(6, attn_phase<0>(F, P); attn_phase<1>(F, P); hyena_phase(F, P);)
    PH(7, hyena_post(F, P);)
    PH(8, { EpiResid E{P.in[I_XP], P.in[I_XS], X, MOD0, 2}; run_gemm(F, HM, (const bf16_t*)(P.ws + WS_WEVOUT), 2048, 2048, E); })
    PH(9, norm_phase(F, X, X + (size_t)TP * DM, P.in[I_NFFNG], MOD0, 3, HM);)
    PH(10, { EpiBf16 E{RA, 2048}; run_gemm(F, HM, (const bf16_t*)(P.ws + WS_WPQ), 2048, 2048, E); })
    PH(11, peer_select(F, P, 0);)
    PH(12, peer_gather<true>(F, P, MOD0, 0, P.in[I_NMIXG] + DM, MOD1);)
    PH(13, { EpiBf16 E{RA, 4096}; run_gemm(F, HM, (const bf16_t*)(P.ws + WS_WODIN), 4096, 2048, E); })
    PH(14, prep_c(F, P); s5_phase(F, P);)
    PH(15, attn_phase<2>(F, P); attn_phase<3>(F, P); s5_combine(F, P);)
    PH(16, { EpiGlu E{(const bf16_t*)(P.ws + WS_RB + RB_Y), HM, P.in[I_GLUB]}; run_gemm(F, (const bf16_t*)(P.ws + WS_RB + RB_Y), (const bf16_t*)(P.ws + WS_WGLU), 1024, 1024, E); })
    PH(17, { EpiResid E{X, X + (size_t)TP * DM, X, MOD1, 2}; run_gemm(F, HM, (const bf16_t*)(P.ws + WS_WODOUT), 2048, 2048, E); })
    PH(18, norm_phase(F, X, X + (size_t)TP * DM, P.in[I_NFFNG] + DM, MOD1, 3, HM);)
    PH(19, { EpiBf16 E{RA, 2048}; run_gemm(F, HM, (const bf16_t*)(P.ws + WS_WPQ) + (size_t)2048 * 2048, 2048, 2048, E); })
    PH(20, peer_select(F, P, 1);)
    PH(21, peer_gather<false>(F, P, MOD1, 1, nullptr, nullptr);)
#undef MOD0
#undef MOD1
#undef HM
#undef RA
#undef X
#undef PH
#undef GRID_BARRIER
}

extern "C" void kernel_launch(void* const* d_in, const int* in_sizes, int n_in, void* d_out, int out_size, void* d_ws, size_t ws_size, hipStream_t stream) {
    static int grid = 0;
    if (grid == 0) {
        if (n_in != N_IN || (size_t)out_size != O_END || ws_size < WS_END) { fprintf(stderr, "kernel_launch: unexpected shapes (n_in %d, out %d, ws %zu, need %zu)\n", n_in, out_size, ws_size, (size_t)WS_END); grid = -1; return; }
        int dev = 0, cus = 0;
        if (hipGetDevice(&dev) != hipSuccess || hipDeviceGetAttribute(&cus, hipDeviceAttributeMultiprocessorCount, dev) != hipSuccess) { grid = -1; return; }
        if (hipFuncSetAttribute((const void*)mega, hipFuncAttributeMaxDynamicSharedMemorySize, LDS_BYTES) != hipSuccess) { fprintf(stderr, "kernel_launch: hipFuncSetAttribute failed\n"); grid = -1; return; }
        int per_cu = 0;
        if (hipOccupancyMaxActiveBlocksPerMultiprocessor(&per_cu, (const void*)mega, NTHR, LDS_BYTES) != hipSuccess || per_cu < 1) { fprintf(stderr, "kernel_launch: occupancy query says %d blocks per CU\n", per_cu); }
        (void)hipGetLastError();
        grid = cus;
    }
    if (grid < 0) return;
    (void)hipMemsetAsync((char*)d_ws + WS_CTL, 0, 65536, stream);
    Params p; memset(&p, 0, sizeof(p));
    for (int i = 0; i < N_IN; ++i) p.in[i] = (const float*)d_in[i];
    p.out = (float*)d_out; p.ws = (unsigned char*)d_ws;
    p.ph_lo = 0; p.ph_hi = NPHASE;
    hipLaunchKernelGGL(mega, dim3(grid), dim3(NTHR), LDS_BYTES, stream, p);
}
```

```cpp
#include <hip/hip_runtime.h>
#include <cstdio>
#include <cstring>
#include <cstdint>

typedef unsigned short bf16_t;
typedef short bf16x8 __attribute__((ext_vector_type(8)));
typedef short s16x4 __attribute__((ext_vector_type(4)));
typedef float f32x2 __attribute__((ext_vector_type(2)));
typedef float f32x4 __attribute__((ext_vector_type(4)));
typedef float f32x16 __attribute__((ext_vector_type(16)));
typedef unsigned u32x2 __attribute__((ext_vector_type(2)));
typedef unsigned u32x4 __attribute__((ext_vector_type(4)));
typedef __bf16 bf16x2_t __attribute__((ext_vector_type(2)));
typedef float f32x32 __attribute__((ext_vector_type(32)));
typedef unsigned u32x6 __attribute__((ext_vector_type(6)));
typedef unsigned u32x16 __attribute__((ext_vector_type(16)));
typedef __bf16 bf16x32_t __attribute__((ext_vector_type(32)));

#define DI __device__ __forceinline__

constexpr int NTHR = 512;
constexpr int DM = 2048;
constexpr int TP = 8192;
constexpr int TS = 32768;
constexpr int TOK = TP + TS;
constexpr int LP = 256, LS = 4096;
constexpr float NORM_EPS = 1e-6f;
constexpr float LOG2E = 1.4426950408889634f;

enum { I_XP = 0, I_XS, I_C, I_CNK, I_CNV, I_CDK, I_CDV, I_S5RE, I_S5IM, I_CCTX, I_MODW, I_MODB, I_NMIXG, I_NFFNG, I_EVWIN, I_EVWOUT, I_NAQG, I_NAKG, I_RPB,
       I_HYCW, I_HYCB, I_HYW1, I_HYB1, I_HYF1, I_HYW2, I_HYB2, I_HYF2, I_HYW3, I_HYDEC, I_HYBIAS, I_ODWIN, I_ODWOUT, I_S5LRE, I_S5LIM, I_S5LDT, I_S5BRE, I_S5BIM,
       I_S5CRE, I_S5CIM, I_S5D, I_GLUW, I_GLUB, I_DQG, I_DKG, I_LQ1, I_LK1, I_LQ2, I_LK2, I_SUBG, I_PWQ, I_PKEYS, I_PU, I_PV, N_IN };

constexpr size_t O_Y = 0;
constexpr size_t O_NAK = 83886080, O_NAV = 92274688, O_DK = 100663296, O_DV = 109051904, O_SR = 117440512, O_SI = 117702656, O_END = 117964800;

constexpr size_t al256(size_t x) { return (x + 255) & ~(size_t)255; }
constexpr size_t WS_CTL = 0;
constexpr size_t WS_MODP = 65536;
constexpr size_t WS_MOD = WS_MODP + (size_t)2 * 16 * 9 * 12288 * 4;
constexpr size_t WS_WEVIN = al256(WS_MOD + (size_t)2 * 9 * 12288 * 4);
constexpr size_t WS_WEVOUT = WS_WEVIN + (size_t)6144 * 2048 * 2;
constexpr size_t WS_WODIN = WS_WEVOUT + (size_t)2048 * 2048 * 2;
constexpr size_t WS_WODOUT = WS_WODIN + (size_t)4096 * 2048 * 2;
constexpr size_t WS_WPQ = WS_WODOUT + (size_t)2048 * 2048 * 2;
constexpr size_t WS_WGLU = WS_WPQ + (size_t)2 * 2048 * 2048 * 2;
constexpr size_t WS_PKEYS = WS_WGLU + (size_t)1024 * 1024 * 2;
constexpr size_t WS_CNK = WS_PKEYS + (size_t)2 * 8 * 2 * 128 * 128 * 2;
constexpr size_t WS_CNVT = WS_CNK + (size_t)8 * 256 * 1024 * 2;
constexpr size_t WS_CDK = WS_CNVT + (size_t)8 * 256 * 1024 * 2;
constexpr size_t WS_CDVT = WS_CDK + (size_t)8 * 256 * 1024 * 2;
constexpr size_t WS_S5A = WS_CDVT + (size_t)8 * 256 * 1024 * 2;
constexpr size_t WS_S5BB = WS_S5A + (size_t)128 * 64 * 2 * 4;
constexpr size_t WS_S5CC = WS_S5BB + (size_t)128 * 128 * 16 * 2;
constexpr int KRL_S = 8208, KRL_P = 528;
constexpr size_t WS_KRS = WS_S5CC + (size_t)128 * 16 * 128 * 2;
constexpr size_t WS_KRP = al256(WS_KRS + (size_t)2 * 1024 * KRL_S * 2);
constexpr size_t WS_TBLU = al256(WS_KRP + (size_t)2 * 1024 * KRL_P * 2);
constexpr size_t WS_TBLV = WS_TBLU + (size_t)16384 * 2048 * 2;
constexpr size_t WS_HM = WS_TBLV + (size_t)16384 * 2048 * 2;
constexpr size_t WS_RA = WS_HM + (size_t)TOK * 2048 * 2;
constexpr size_t WS_RB = WS_RA + (size_t)TOK * 4096 * 2;
constexpr size_t WS_VT = WS_RB + (size_t)3072 * TOK * 2;
constexpr size_t WS_SC = WS_VT + (size_t)TOK * 1024 * 2;
constexpr size_t WS_END = WS_SC + (size_t)4 * 16384 * 4;
constexpr size_t RA_Q = 0;
constexpr size_t RA_SELI = (size_t)TOK * 2048 * 2;
constexpr size_t RA_SELW = RA_SELI + (size_t)TOK * 128 * 4;
constexpr size_t RA_CF = RA_SELW + (size_t)TOK * 128 * 4;
constexpr size_t RA_ZC = (size_t)TOK * 2048 * 2;
constexpr size_t RB_YF = 0, RB_YB = (size_t)TOK * 1024 * 2, RB_Y = (size_t)2 * TOK * 1024 * 2;
constexpr size_t VT_S = (size_t)TP * 1024 * 2;

constexpr int LDS_BYTES = 147456;

struct Params { const float* in[N_IN]; float* out; unsigned char* ws; int ph_lo, ph_hi; };

DI float bf2f(bf16_t b) { return __uint_as_float(((unsigned)b) << 16); }
DI float bflo(unsigned w) { return __uint_as_float(w << 16); }
DI float bfhi(unsigned w) { return __uint_as_float(w & 0xffff0000u); }
DI unsigned pk2(float a, float b) { f32x2 v = {a, b}; return __builtin_bit_cast(unsigned, __builtin_convertvector(v, bf16x2_t)); }
DI float dot2bf(unsigned a, unsigned b, float c) { return __builtin_amdgcn_fdot2_f32_bf16(__builtin_bit_cast(bf16x2_t, a), __builtin_bit_cast(bf16x2_t, b), c, false); }
DI bf16_t f2bf(float a) { return (bf16_t)(pk2(a, 0.f) & 0xffffu); }
DI float dpp_xor1(float v) { return __builtin_bit_cast(float, __builtin_amdgcn_update_dpp(0, __builtin_bit_cast(int, v), 0xB1, 0xF, 0xF, true)); }
DI float dpp_xor2(float v) { return __builtin_bit_cast(float, __builtin_amdgcn_update_dpp(0, __builtin_bit_cast(int, v), 0x4E, 0xF, 0xF, true)); }
DI float wave_sum(float v) {
    v += dpp_xor1(v); v += dpp_xor2(v);
    v += __builtin_bit_cast(float, __builtin_amdgcn_update_dpp(0, __builtin_bit_cast(int, v), 0x141, 0xF, 0xF, true));
    v += __builtin_bit_cast(float, __builtin_amdgcn_update_dpp(0, __builtin_bit_cast(int, v), 0x140, 0xF, 0xF, true));
    v += __builtin_bit_cast(float, __builtin_amdgcn_update_dpp(0, __builtin_bit_cast(int, v), 0x142, 0xA, 0xF, false));
    v += __builtin_bit_cast(float, __builtin_amdgcn_update_dpp(0, __builtin_bit_cast(int, v), 0x143, 0xC, 0xF, false));
    return __builtin_bit_cast(float, __builtin_amdgcn_readlane(__builtin_bit_cast(int, v), 63));
}
DI float gelu_tanh(float x) {
    const float u = 0.7978845608028654f * (x + 0.044715f * x * x * x);
    const float e = __expf(2.f * u);
    const float t = 1.f - 2.f / (e + 1.f);
    return 0.5f * x * (1.f + t);
}
DI float wave_max(float v) {
    v = fmaxf(v, dpp_xor1(v)); v = fmaxf(v, dpp_xor2(v));
    v = fmaxf(v, __builtin_bit_cast(float, __builtin_amdgcn_update_dpp(0, __builtin_bit_cast(int, v), 0x141, 0xF, 0xF, true)));
    v = fmaxf(v, __builtin_bit_cast(float, __builtin_amdgcn_update_dpp(0, __builtin_bit_cast(int, v), 0x140, 0xF, 0xF, true)));
    v = fmaxf(v, __builtin_bit_cast(float, __builtin_amdgcn_update_dpp(0, __builtin_bit_cast(int, v), 0x142, 0xA, 0xF, false)));
    v = fmaxf(v, __builtin_bit_cast(float, __builtin_amdgcn_update_dpp(0, __builtin_bit_cast(int, v), 0x143, 0xC, 0xF, false)));
    return __builtin_bit_cast(float, __builtin_amdgcn_readlane(__builtin_bit_cast(int, v), 63));
}
DI f32x2 fp8x2_lo(unsigned w) { return __builtin_amdgcn_cvt_pk_f32_fp8((int)w, false); }
DI f32x2 fp8x2_hi(unsigned w) { return __builtin_amdgcn_cvt_pk_f32_fp8((int)w, true); }
DI unsigned pk_fp8x4(float a, float b, float c, float d) { int r = 0; r = __builtin_amdgcn_cvt_pk_fp8_f32(a, b, r, false); r = __builtin_amdgcn_cvt_pk_fp8_f32(c, d, r, true); return (unsigned)r; }
DI int lane_id() { return (int)__builtin_amdgcn_mbcnt_hi(~0u, __builtin_amdgcn_mbcnt_lo(~0u, 0u)); }
DI int cond_of(int T) { return T < TP ? 0 : 1 + ((T - TP) >> 12); }
#define XB_TMO      128
#define XB_XCNT(j)  (256  + 64 * (j))
#define XB_XSUB(j)  (1280 + 64 * (j))
#define XB_XGEN(j)  (2304 + 64 * (j))
#define XB_TOP      3328
#define XB_TOPGEN   3392
#define XCD_BAR_WORDS 3456
#define XB_SPIN_CAP (1u << 26)
#define LAS __attribute__((address_space(3)))

__device__ __forceinline__ unsigned xb_ld(unsigned* p)              { return __hip_atomic_load(p, __ATOMIC_RELAXED, __HIP_MEMORY_SCOPE_AGENT); }
__device__ __forceinline__ unsigned xb_add(unsigned* p, unsigned v) { return __hip_atomic_fetch_add(p, v, __ATOMIC_RELAXED, __HIP_MEMORY_SCOPE_AGENT); }
__device__ __forceinline__ unsigned xb_xcc_id() { return (unsigned)__builtin_amdgcn_s_getreg((3 << 11) | 20) & 0xFu; }
#define XB_SPIN(cond, bar) do { unsigned _sp = 0; while (cond) { __builtin_amdgcn_s_sleep(1); \
    if ((++_sp & 255u) == 0u) { if (xb_ld(&(bar)[XB_TMO])) break; if (_sp > XB_SPIN_CAP) { atomicAdd(&(bar)[XB_TMO], 1u); break; } } } } while (0)

struct XcdBarrier {
    unsigned* bar; unsigned x;
    volatile LAS unsigned* st;
};

__device__ __forceinline__ XcdBarrier xcd_barrier_post(unsigned* bar, volatile LAS unsigned* st) {
    XcdBarrier b; b.bar = bar; b.x = xb_xcc_id(); b.st = st;
    if (threadIdx.x == 0) (void)xb_add(&bar[XB_XCNT(b.x)], 1u);
    return b;
}
__device__ __forceinline__ void xcd_barrier_complete(unsigned* bar, unsigned x, unsigned& nloc, unsigned& nx) {
    const unsigned G = gridDim.x * gridDim.y * gridDim.z;
    unsigned sum, cnt, mine, sp = 0u;
    for (;;) {
        sum = 0u; cnt = 0u; mine = 0u;
#pragma unroll
        for (unsigned j = 0; j < 16; ++j) { const unsigned c = xb_ld(&bar[XB_XCNT(j)]); sum += c; cnt += (c > 0u) ? 1u : 0u; mine = (j == x) ? c : mine; }
        if (sum == G) break;
        __builtin_amdgcn_s_sleep(1);
        if ((++sp & 255u) == 0u) { if (xb_ld(&bar[XB_TMO])) break; if (sp > XB_SPIN_CAP) { atomicAdd(&bar[XB_TMO], 1u); break; } }
    }
    nloc = mine > 0u ? mine : 1u; nx = cnt > 0u ? cnt : 1u;
}

__device__ __forceinline__ void xcd_barrier(const XcdBarrier& b) {
    asm volatile("s_waitcnt vmcnt(0)" ::: "memory");
    __syncthreads();
    if (threadIdx.x == 0) {
        unsigned* bar = b.bar;
        __builtin_amdgcn_s_waitcnt(0);
        unsigned nloc = b.st[0], nx = b.st[1];
        if (nloc == 0u) { xcd_barrier_complete(bar, b.x, nloc, nx); b.st[0] = nloc; b.st[1] = nx; }
        const unsigned old = xb_add(&bar[XB_XSUB(b.x)], 1u);
        const unsigned gen = old / nloc;
        if (old + 1u == (gen + 1u) * nloc) {
            __builtin_amdgcn_fence(__ATOMIC_RELEASE, "agent");
            asm volatile("s_waitcnt vmcnt(0)" ::: "memory");
            const unsigned og = xb_add(&bar[XB_TOP], 1u);
            const unsigned tg = og / nx;
            if (og + 1u == (tg + 1u) * nx) xb_add(&bar[XB_TOPGEN], 1u);
            else XB_SPIN(xb_ld(&bar[XB_TOPGEN]) == tg, bar);
            __builtin_amdgcn_fence(__ATOMIC_ACQUIRE, "agent");
            xb_add(&bar[XB_XGEN(b.x)], 1u);
            asm volatile("s_waitcnt vmcnt(0)" ::: "memory");
        } else {
            XB_SPIN(xb_ld(&bar[XB_XGEN(b.x)]) == gen, bar);
            __builtin_amdgcn_fence(__ATOMIC_ACQUIRE, "agent");
            asm volatile("s_waitcnt vmcnt(0)" ::: "memory");
        }
    }
    __syncthreads();
}
namespace pg8 {
#define PG8_LAS __attribute__((address_space(3)))
typedef unsigned short bf16_t;
typedef short bf16x8 __attribute__((ext_vector_type(8)));
typedef float f32x4 __attribute__((ext_vector_type(4)));
typedef unsigned u32x4 __attribute__((ext_vector_type(4)));
constexpr int BM = 256, BK = 64, HALF = 128, HTB = HALF * BK * 2  , STAGE_BYTES = 8 * HTB, NXCD = 8, WGM = 8;

__host__ __device__ __forceinline__ int lds_byte(int r, int c) { const int st = (r >> 4) * 2 + (c >> 5), rr = r & 15, cc = c & 31, ob = rr * 64 + cc * 2; return st * 1024 + (ob ^ (((ob >> 9) & 1) << 5)); }
__host__ __device__ __forceinline__ void stage_rc(int b, int& R, int& C) { const int st = b / 1024, sb = b % 1024, swz = sb ^ (((sb >> 9) & 1) << 5); R = (st >> 1) * 16 + swz / 64; C = (st & 1) * 32 + (swz % 64) / 2; }
__host__ __device__ __forceinline__ int perm32(int rho) { const int n = rho >> 4, i = rho & 15; return 8 * (i >> 2) + 4 * n + (i & 3); }

struct Unit { int pm, pn; };
struct Gemm { const bf16_t* A; const bf16_t* Bt; int M, N, K; };

struct StaticOrder {
    int nM, nN, nwg, G, c;
    __host__ __device__ void init(int M, int N, int G_, int c_) { nM = M / BM; nN = N / BM; nwg = nM * nN; G = G_; c = c_; }
    __host__ __device__ bool next(int i, Unit& u) const {
        const long L = (long)i * G + c; if (L >= nwg) return false;
        int wgid = (int)L; { const int q = nwg / NXCD, r = nwg % NXCD, xcd = wgid % NXCD, off = wgid / NXCD; wgid = (xcd < r ? xcd * (q + 1) : r * (q + 1) + (xcd - r) * q) + off; }
        const int nig = WGM * nN, gid = wgid / nig, fm = gid * WGM, gsz = (nM - fm) < WGM ? (nM - fm) : WGM;
        u.pm = fm + ((wgid % nig) % gsz); u.pn = (wgid % nig) / gsz; return true;
    }
    __device__ __forceinline__ void a_ready(const Unit&) const {}
    __device__ __forceinline__ void done(const Unit&) const {}
};
__device__ __forceinline__ unsigned cvt_pk_bf16(float lo, float hi) { unsigned r; asm volatile("v_cvt_pk_bf16_f32 %0, %1, %2" : "=v"(r) : "v"(lo), "v"(hi)); return r; }
template <class Epi, class Sched, bool STAMP = false>
__device__ __forceinline__ void gemm_phase(PG8_LAS unsigned char* lds, const Gemm g, const Sched& S, const Epi& E, unsigned long long* stamps) {
    const int tid = threadIdx.x, wid = __builtin_amdgcn_readfirstlane(tid >> 6), lane = tid & 63, wr = wid >> 2, wc = wid & 3, fr = lane & 15, fq = lane >> 4;
    const int K = g.K, nt = K / BK;
    int ts_lo = 0, ts_hi = 0, nts = 0; const unsigned long long rt_entry = STAMP ? (unsigned long long)wall_clock64() : 0ull;
#define PG8_STAMP() do { if (STAMP && wid == 0 && nts < 64) { const unsigned long long _c = (unsigned long long)clock64(); \
        ts_lo = (lane == nts) ? (int)(unsigned)_c : ts_lo; ts_hi = (lane == nts) ? (int)(unsigned)(_c >> 32) : ts_hi; ++nts; } } while (0)
    PG8_STAMP();
    unsigned voffA[2], voffB[2];
#pragma unroll
    for (int i = 0; i < 2; ++i) { int R, C; stage_rc(tid * 16 + i * 8192, R, C); const int Rb = Epi::PERM ? ((R & ~31) + perm32(R & 31)) : R;
        voffA[i] = (unsigned)(R * K + C) * 2u; voffB[i] = (unsigned)(Rb * K + C) * 2u; }
    const size_t kstep = (size_t)(BK * 2);
    const size_t hstep = (size_t)HALF * K * 2;
    const size_t tstep = 2 * hstep;
    const unsigned ldsw = (unsigned)wid * 1024u;
    const int aoff = lds_byte(wr * 64 + fr, fq * 8), boff = lds_byte(wc * 32 + fr, fq * 8);
#define PG8_SA(b, h) (((b) * 2 + (h)) * HTB)
#define PG8_SB(b, h) ((4 + (b) * 2 + (h)) * HTB)
#define PG8_STAGE(bufoff, gbase, voff) do { _Pragma("unroll") for (int _i = 0; _i < 2; ++_i) \
        __builtin_amdgcn_global_load_lds((const unsigned*)((const char*)(gbase) + (voff)[_i]), (PG8_LAS unsigned*)(lds + (bufoff) + ldsw + _i * 8192), 16, 0, 0); } while (0)
#define PG8_LDA(dst, b, h) do { _Pragma("unroll") for (int m = 0; m < 4; ++m) _Pragma("unroll") for (int k = 0; k < 2; ++k) dst[m][k] = *(const PG8_LAS bf16x8*)(lds + PG8_SA(b, h) + aoff + m * 2048 + k * 1024); } while (0)
#define PG8_LDB(dst, b, h) do { _Pragma("unroll") for (int n = 0; n < 2; ++n) _Pragma("unroll") for (int k = 0; k < 2; ++k) dst[n][k] = *(const PG8_LAS bf16x8*)(lds + PG8_SB(b, h) + boff + n * 2048 + k * 1024); } while (0)
#define PG8_MMA(ai, bj, At, Bt) do { __builtin_amdgcn_s_setprio(1); _Pragma("unroll") for (int m = 0; m < 4; ++m) _Pragma("unroll") for (int n = 0; n < 2; ++n) _Pragma("unroll") for (int k = 0; k < 2; ++k) \
        acc[ai][bj][m][n] = __builtin_amdgcn_mfma_f32_16x16x32_bf16(Bt[n][k], At[m][k], acc[ai][bj][m][n], 0, 0, 0); __builtin_amdgcn_s_setprio(0); } while (0)
#define PG8_WAIT_V(n) asm volatile("s_waitcnt vmcnt(" #n ")" ::: "memory")
#define PG8_WAIT_L(n) asm volatile("s_waitcnt lgkmcnt(" #n ")" ::: "memory")
#define PG8_BAR __builtin_amdgcn_s_barrier()
#define PG8_SCHED __builtin_amdgcn_sched_barrier(0)
    Unit cur, nxt; int ui = 0;
    if (!S.next(0, cur)) return;
    f32x4 acc[2][2][4][2];
#pragma unroll
    for (int a = 0; a < 2; ++a)
#pragma unroll
        for (int b = 0; b < 2; ++b)
#pragma unroll
            for (int m = 0; m < 4; ++m)
#pragma unroll
                for (int n = 0; n < 2; ++n) acc[a][b][m][n] = (f32x4){0.f, 0.f, 0.f, 0.f};
    bf16x8 At[4][2], B0[2][2], B1[2][2];
    const char* cA = (const char*)g.A + (size_t)cur.pm * tstep; const char* cB = (const char*)g.Bt + (size_t)cur.pn * tstep;
    S.a_ready(cur);
    PG8_STAGE(PG8_SB(0, 0), cB, voffB); PG8_STAGE(PG8_SA(0, 0), cA, voffA); PG8_STAGE(PG8_SB(0, 1), cB + hstep, voffB); PG8_STAGE(PG8_SA(0, 1), cA + hstep, voffA);
    if (wr == 1) PG8_BAR;
    PG8_WAIT_V(4); PG8_BAR;
    PG8_STAGE(PG8_SB(1, 0), cB + kstep, voffB); PG8_STAGE(PG8_SA(1, 0), cA + kstep, voffA); PG8_STAGE(PG8_SB(1, 1), cB + hstep + kstep, voffB);
    PG8_WAIT_V(6); PG8_BAR;
    PG8_STAMP();
    for (;;) {
        const bool has_next = S.next(ui + 1, nxt);
        const char* nA = has_next ? (const char*)g.A + (size_t)nxt.pm * tstep : cA; const char* nB = has_next ? (const char*)g.Bt + (size_t)nxt.pn * tstep : cB;
        for (int t = 0; t < nt; t += 2) {
            const bool last = (t == nt - 2);
            const char* a1 = cA + (size_t)(t + 1) * kstep;
            const char* a2 = last ? nA : cA + (size_t)(t + 2) * kstep; const char* b2 = last ? nB : cB + (size_t)(t + 2) * kstep;
            const char* a3 = a2 + kstep; const char* b3 = b2 + kstep;
            if (last && has_next) S.a_ready(nxt);
            PG8_LDB(B0, 0, 0); PG8_SCHED; PG8_LDA(At, 0, 0); PG8_STAGE(PG8_SA(1, 1), a1 + hstep, voffA);
            PG8_WAIT_L(8); PG8_BAR; PG8_WAIT_L(0); PG8_MMA(0, 0, At, B0); PG8_BAR; PG8_SCHED;
            PG8_LDB(B1, 0, 1); PG8_STAGE(PG8_SB(0, 0), b2, voffB);
            PG8_BAR; PG8_WAIT_L(0); PG8_MMA(0, 1, At, B1); PG8_BAR;
            PG8_LDA(At, 0, 1); PG8_STAGE(PG8_SA(0, 0), a2, voffA);
            PG8_BAR; PG8_WAIT_L(0); PG8_MMA(1, 0, At, B0); PG8_BAR; PG8_SCHED;
            PG8_STAGE(PG8_SB(0, 1), b2 + hstep, voffB);
            PG8_WAIT_V(6); PG8_BAR; PG8_MMA(1, 1, At, B1); PG8_BAR;
            PG8_LDB(B0, 1, 0); PG8_SCHED; PG8_LDA(At, 1, 0); PG8_STAGE(PG8_SA(0, 1), a2 + hstep, voffA);
            PG8_WAIT_L(8); PG8_BAR; PG8_WAIT_L(0); PG8_MMA(0, 0, At, B0); PG8_BAR; PG8_SCHED;
            PG8_LDB(B1, 1, 1); PG8_STAGE(PG8_SB(1, 0), b3, voffB);
            PG8_BAR; PG8_WAIT_L(0); PG8_MMA(0, 1, At, B1); PG8_BAR;
            PG8_LDA(At, 1, 1); PG8_STAGE(PG8_SA(1, 0), a3, voffA);
            PG8_BAR; PG8_WAIT_L(0); PG8_MMA(1, 0, At, B0); PG8_BAR; PG8_SCHED;
            PG8_STAGE(PG8_SB(1, 1), b3 + hstep, voffB);
            PG8_WAIT_V(6); PG8_BAR; PG8_MMA(1, 1, At, B1); PG8_BAR;
        }
        PG8_STAMP();
        if constexpr (!Epi::AFTER_DRAIN) { E(acc, cur, wr, wc, fr, fq); S.done(cur); }
        PG8_STAMP();
        if (!has_next) break;
#pragma unroll
        for (int a = 0; a < 2; ++a)
#pragma unroll
            for (int b = 0; b < 2; ++b)
#pragma unroll
                for (int m = 0; m < 4; ++m)
#pragma unroll
                    for (int n = 0; n < 2; ++n) acc[a][b][m][n] = (f32x4){0.f, 0.f, 0.f, 0.f};
        cur = nxt; cA = nA; cB = nB; ++ui;
    }
    PG8_WAIT_V(0);
    if (wr == 0) PG8_BAR;
    PG8_BAR;
    if constexpr (Epi::AFTER_DRAIN) { E.fused(acc, cur, wr, wc, fr, fq, lds, wid, lane); S.done(cur); }
    PG8_STAMP();
    if (STAMP && wid == 0) { stamps[lane] = lane < nts ? (((unsigned long long)(unsigned)ts_hi << 32) | (unsigned)ts_lo) : 0ull;
        if (lane == 62) stamps[62] = rt_entry; if (lane == 63) stamps[63] = (unsigned long long)wall_clock64(); }
#undef PG8_STAMP
#undef PG8_SA
#undef PG8_SB
#undef PG8_STAGE
#undef PG8_LDA
#undef PG8_LDB
#undef PG8_MMA
#undef PG8_WAIT_V
#undef PG8_WAIT_L
#undef PG8_BAR
#undef PG8_SCHED
}
}
struct Ctx {
    LAS unsigned char* lds; int tid, lane, wave, G, bid;
};

DI void cvt_rows(const Ctx& F, const float* src, bf16_t* dst, size_t n) {
    const size_t n8 = n >> 3;
    for (size_t i = (size_t)F.bid * NTHR + F.tid; i < n8; i += (size_t)F.G * NTHR) {
        const f32x4 a = *(const f32x4*)(src + i * 8), b = *(const f32x4*)(src + i * 8 + 4);
        u32x4 w; w.x = pk2(a.x, a.y); w.y = pk2(a.z, a.w); w.z = pk2(b.x, b.y); w.w = pk2(b.z, b.w);
        *(u32x4*)(dst + i * 8) = w;
    }
}

constexpr int TR_S = 68;
DI void tr_tile_out(const Ctx& F, bf16_t* dst, size_t ldd, const LAS bf16_t* tile) {
    const int n = F.tid >> 3, kc = (F.tid & 7) * 8;
    const LAS bf16_t* t = tile + kc * TR_S + n;
    u32x4 v;
    v.x = (unsigned)t[0] | ((unsigned)t[TR_S] << 16); v.y = (unsigned)t[2 * TR_S] | ((unsigned)t[3 * TR_S] << 16);
    v.z = (unsigned)t[4 * TR_S] | ((unsigned)t[5 * TR_S] << 16); v.w = (unsigned)t[6 * TR_S] | ((unsigned)t[7 * TR_S] << 16);
    *(u32x4*)(dst + (size_t)n * ldd + kc) = v;
}
DI void tr_tile_f32(const Ctx& F, const float* src, size_t lds_, bf16_t* dst, size_t ldd, LAS bf16_t* tile) {
#pragma unroll
    for (int j = 0; j < 2; ++j) {
        const int id = F.tid + NTHR * j, kr = id >> 4, nc = (id & 15) * 4;
        const f32x4 v = *(const f32x4*)(src + (size_t)kr * lds_ + nc);
        *(LAS u32x2*)(tile + kr * TR_S + nc) = (u32x2){pk2(v.x, v.y), pk2(v.z, v.w)};
    }
    __syncthreads();
    tr_tile_out(F, dst, ldd, tile);
    __syncthreads();
}
DI void tr_tile_bf16(const Ctx& F, const bf16_t* src, size_t lds_, bf16_t* dst, size_t ldd, LAS bf16_t* tile) {
    { const int kr = F.tid >> 3, nc = (F.tid & 7) * 8; const u32x4 v = *(const u32x4*)(src + (size_t)kr * lds_ + nc);
      *(LAS u32x2*)(tile + kr * TR_S + nc) = (u32x2){v.x, v.y}; *(LAS u32x2*)(tile + kr * TR_S + nc + 4) = (u32x2){v.z, v.w}; }
    __syncthreads();
    tr_tile_out(F, dst, ldd, tile);
    __syncthreads();
}
DI void transpose_weight(const Ctx& F, const float* W, int K, int N, bf16_t* Wt) {
    const int tk = K / 64, tn = N / 64;
    for (int t = F.bid; t < tk * tn; t += F.G) {
        const int k0 = (t / tn) * 64, n0 = (t % tn) * 64;
        tr_tile_f32(F, W + (size_t)k0 * N + n0, (size_t)N, Wt + (size_t)n0 * K + k0, (size_t)K, (LAS bf16_t*)F.lds);
    }
}
DI void transpose_cache_v(const Ctx& F, const float* V, bf16_t* VT) {
    for (int t = F.bid; t < 64 * 8; t += F.G) {
        const int bh = t >> 3, sub = t & 7, k0 = (sub >> 1) * 64, d0 = (sub & 1) * 64, b = bh >> 3, h = bh & 7;
        tr_tile_f32(F, V + ((size_t)b * 256 + k0) * 1024 + h * 128 + d0, 1024, VT + ((size_t)bh * 128 + d0) * 256 + k0, 256, (LAS bf16_t*)F.lds);
    }
}

DI void adaln_partials(const Ctx& F, const Params& P) {
    LAS float* s = (LAS float*)F.lds;
    const float* modw = P.in[I_MODW]; const float* cv = P.in[I_C]; const float* cctx = P.in[I_CCTX];
    float* modp = (float*)(P.ws + WS_MODP);
    for (int it = F.bid; it < 192; it += F.G) {
        const int i = it / 96, r = it % 96, ks = r / 6, cg = r % 6;
        __syncthreads();
        for (int e = F.tid; e < 9 * 128; e += NTHR) { const int j = e >> 7, k = e & 127; const float c = (j == 0) ? cctx[ks * 128 + k] : cv[(j - 1) * 2048 + ks * 128 + k]; s[e] = c / (1.f + __expf(-c)); }
        __syncthreads();
        f32x4 acc[9];
#pragma unroll
        for (int j = 0; j < 9; ++j) acc[j] = (f32x4){0.f, 0.f, 0.f, 0.f};
        const float* w = modw + ((size_t)i * 2048 + ks * 128) * 12288 + cg * 2048 + F.tid * 4;
#pragma unroll 8
        for (int k = 0; k < 128; ++k) {
            const f32x4 w4 = *(const f32x4*)(w + (size_t)k * 12288);
#pragma unroll
            for (int j = 0; j < 9; ++j) acc[j] += w4 * s[j * 128 + k];
        }
#pragma unroll
        for (int j = 0; j < 9; ++j) *(f32x4*)(modp + ((size_t)(i * 16 + ks) * 9 + j) * 12288 + cg * 2048 + F.tid * 4) = acc[j];
    }
    __syncthreads();
}
DI void adaln_reduce(const Ctx& F, const Params& P) {
    const float* modp = (const float*)(P.ws + WS_MODP); float* mod = (float*)(P.ws + WS_MOD); const float* modb = P.in[I_MODB];
    for (int e = F.bid * NTHR + F.tid; e < 2 * 9 * 12288; e += F.G * NTHR) {
        const int i = e / (9 * 12288), r = e % (9 * 12288), j = r / 12288, n = r % 12288;
        float a = modb[i * 12288 + n];
#pragma unroll
        for (int ks = 0; ks < 16; ++ks) a += modp[((size_t)(i * 16 + ks) * 9 + j) * 12288 + n];
        mod[e] = a;
    }
}

DI void hyena_filters(const Ctx& F, const Params& P) {
    LAS float* z = (LAS float*)F.lds;
    LAS float* h1 = z + 320;
    LAS float* h2 = h1 + 576;
    const float* w1 = P.in[I_HYW1]; const float* b1 = P.in[I_HYB1]; const float* f1 = P.in[I_HYF1];
    const float* w2 = P.in[I_HYW2]; const float* b2 = P.in[I_HYB2]; const float* f2 = P.in[I_HYF2];
    const float* w3 = P.in[I_HYW3]; const float* dec = P.in[I_HYDEC];
    for (int it = F.bid; it < 544; it += F.G) {
        const bool smp = it < 512; const int L = smp ? LS : LP, p0 = (smp ? it : it - 512) * 8, RL = smp ? KRL_S : KRL_P;
        bf16_t* KR = (bf16_t*)(P.ws + (smp ? WS_KRS : WS_KRP));
        __syncthreads();
        if (F.tid < 9 * 33) {
            const int ps = F.tid / 33, k = F.tid % 33, i = p0 + ps;
            const float t = (float)i / (float)(L - 1), wang = 6.283185307179586f * (float)i / (float)L;
            float val;
            if (k == 0) val = t;
            else { const int f = (k - 1) & 15; const float fr = 1e-4f + (float)f * ((15.0f - 1e-4f) / 15.0f); val = (k <= 16) ? cosf(fr * wang) : -sinf(fr * wang); }
            z[F.tid] = val;
        }
        __syncthreads();
        for (int e = F.tid; e < 9 * 64; e += NTHR) { const int ps = e >> 6, j = e & 63; float a = b1[j];
            for (int k = 0; k < 33; ++k) a += z[ps * 33 + k] * w1[k * 64 + j];
            h1[e] = sinf(f1[j] * a); }
        __syncthreads();
        for (int e = F.tid; e < 9 * 64; e += NTHR) { const int ps = e >> 6, j = e & 63; float a = b2[j];
            for (int k = 0; k < 64; ++k) a += h1[ps * 64 + k] * w2[k * 64 + j];
            h2[e] = sinf(f2[j] * a); }
        __syncthreads();
#pragma unroll 1
        for (int qh = 0; qh < 2; ++qh) {
            float acc[9][4];
#pragma unroll
            for (int ps = 0; ps < 9; ++ps)
#pragma unroll
                for (int q = 0; q < 4; ++q) acc[ps][q] = 0.f;
#pragma unroll 2
            for (int k = 0; k < 64; ++k) {
                float w[4];
#pragma unroll
                for (int q = 0; q < 4; ++q) w[q] = w3[k * 4096 + F.tid + NTHR * (qh * 4 + q)];
#pragma unroll
                for (int ps = 0; ps < 9; ++ps) { const float hv = h2[ps * 64 + k];
#pragma unroll
                    for (int q = 0; q < 4; ++q) acc[ps][q] += hv * w[q]; }
            }
#pragma unroll
            for (int q = 0; q < 4; ++q) {
                const int n = F.tid + NTHR * (qh * 4 + q), o = (n >> 10) & 1, c = n & 1023;
                const float dc = fabsf(dec[n]);
                bf16_t* row = KR + (size_t)(o * 1024 + c) * RL;
                float v[9];
#pragma unroll
                for (int ps = 0; ps < 9; ++ps) { const int i = p0 + ps; v[ps] = (i < L) ? acc[ps][q] * __expf(-((float)i / (float)(L - 1)) * dc) : 0.f; }
                if (qh == 0) {
                    u32x4 wv; wv.x = pk2(v[8], v[7]); wv.y = pk2(v[6], v[5]); wv.z = pk2(v[4], v[3]); wv.w = pk2(v[2], v[1]);
                    *(u32x4*)(row + (L - p0 - 8)) = wv;
                    if (p0 == 0) row[L] = f2bf(v[0]);
                } else if (p0 > 0) {
                    u32x4 wv; wv.x = pk2(v[0], v[1]); wv.y = pk2(v[2], v[3]); wv.z = pk2(v[4], v[5]); wv.w = pk2(v[6], v[7]);
                    *(u32x4*)(row + (L + p0)) = wv;
                } else {
#pragma unroll
                    for (int ps = 1; ps < 8; ++ps) row[L + ps] = f2bf(v[ps]);
                }
            }
        }
    }
    __syncthreads();
    for (int e = F.bid * NTHR + F.tid; e < 2 * 2048; e += F.G * NTHR) {
        const bool smp = e < 2048; const int r = e & 2047, L = smp ? LS : LP, RL = smp ? KRL_S : KRL_P;
        bf16_t* row = (bf16_t*)(P.ws + (smp ? WS_KRS : WS_KRP)) + (size_t)r * RL;
        for (int x = 2 * L; x < RL; ++x) row[x] = 0;
    }
}

DI void s5_consts(const Ctx& F, const Params& P) {
    float* S5A = (float*)(P.ws + WS_S5A); bf16_t* BB = (bf16_t*)(P.ws + WS_S5BB); bf16_t* CC = (bf16_t*)(P.ws + WS_S5CC);
    const float* lre = P.in[I_S5LRE]; const float* lim = P.in[I_S5LIM]; const float* ldt = P.in[I_S5LDT];
    const float* bre = P.in[I_S5BRE]; const float* bim = P.in[I_S5BIM]; const float* cre = P.in[I_S5CRE]; const float* cim = P.in[I_S5CIM];
    for (int e = F.bid * NTHR + F.tid; e < 8192; e += F.G * NTHR) {
        const int dg = e >> 6, n = e & 63;
        const float dt = expf(ldt[dg]), lr = lre[e], li = lim[e];
        const float mag = expf(lr * dt), ar = mag * cosf(li * dt), ai = mag * sinf(li * dt), den = lr * lr + li * li;
        const float cr = ((ar - 1.f) * lr + ai * li) / den, ci = (ai * lr - (ar - 1.f) * li) / den;
        S5A[e * 2] = ar; S5A[e * 2 + 1] = ai;
#pragma unroll
        for (int p = 0; p < 16; ++p) {
            const float br = bre[(size_t)e * 16 + p], bi = bim[(size_t)e * 16 + p];
            BB[((size_t)dg * 128 + n) * 16 + p] = f2bf(cr * br - ci * bi);
            BB[((size_t)dg * 128 + 64 + n) * 16 + p] = f2bf(cr * bi + ci * br);
            CC[((size_t)dg * 16 + p) * 128 + n] = f2bf(cre[((size_t)dg * 16 + p) * 64 + n]);
            CC[((size_t)dg * 16 + p) * 128 + 64 + n] = f2bf(-cim[((size_t)dg * 16 + p) * 64 + n]);
        }
    }
}

constexpr int PT_ROWB = 1536;
DI void cvt_table_fp6(const Ctx& F, const float* src, unsigned char* dst, float* scales, const int (&perm)[32]) {
    LAS float* scr = (LAS float*)(F.lds) + F.wave * 2048 + F.lane;
    for (int r = F.bid * 8 + F.wave; r < 16384; r += F.G * 8) {
        f32x4 v[8]; float m = 0.f;
#pragma unroll
        for (int j = 0; j < 8; ++j) { v[j] = *(const f32x4*)(src + (size_t)r * 2048 + F.lane * 32 + j * 4);
            m = fmaxf(m, fmaxf(fmaxf(fabsf(v[j].x), fabsf(v[j].y)), fmaxf(fabsf(v[j].z), fabsf(v[j].w)))); }
        m = wave_max(m);
        const float inv = (m > 0.f) ? 7.0f / m : 0.f, sc = (m > 0.f) ? m / 7.0f : 0.f;
#pragma unroll
        for (int j = 0; j < 8; ++j) { scr[perm[j * 4 + 0] * 64] = v[j].x * inv; scr[perm[j * 4 + 1] * 64] = v[j].y * inv; scr[perm[j * 4 + 2] * 64] = v[j].z * inv; scr[perm[j * 4 + 3] * 64] = v[j].w * inv; }
        asm volatile("" ::: "memory");
        f32x16 a, b;
#pragma unroll
        for (int i = 0; i < 16; ++i) { a[i] = scr[i * 64]; b[i] = scr[(16 + i) * 64]; }
        asm volatile("" ::: "memory");
        const u32x6 pk = __builtin_amdgcn_cvt_scalef32_2xpk16_fp6_f32(a, b, 1.0f);
        unsigned char* o = dst + (size_t)r * PT_ROWB;
        *(u32x4*)(o + F.lane * 16) = (u32x4){pk[0], pk[1], pk[2], pk[3]}; *(u32x2*)(o + 1024 + F.lane * 8) = (u32x2){pk[4], pk[5]};
        if (F.lane == 0) scales[r] = sc;
    }
}
DI void convert_peer_tables(const Ctx& F, const Params& P) {
    int perm[32];
    { f32x16 a, b;
#pragma unroll
      for (int j = 0; j < 16; ++j) { a[j] = 0.125f * (float)j; b[j] = (j < 8) ? 2.0f + 0.25f * (float)j : 4.0f + 0.5f * (float)(j - 8); }
      const u32x6 pk = __builtin_amdgcn_cvt_scalef32_2xpk16_fp6_f32(a, b, 1.0f);
      const f32x32 rt = __builtin_amdgcn_cvt_scalef32_pk32_f32_fp6(pk, 1.0f);
#pragma unroll
      for (int i = 0; i < 32; ++i) { const float x = rt[i]; const int o = (x < 2.0f) ? (int)(x * 8.0f + 0.5f) : ((x < 4.0f) ? 16 + (int)((x - 2.0f) * 4.0f + 0.5f) : 24 + (int)((x - 4.0f) * 2.0f + 0.5f)); perm[i] = min(max(o, 0), 31); } }
    float* SC = (float*)(P.ws + WS_SC);
    __syncthreads();
    for (int layer = 0; layer < 2; ++layer) {
        cvt_table_fp6(F, P.in[I_PU] + (size_t)layer * 16384 * 2048, P.ws + WS_TBLU + (size_t)layer * 16384 * PT_ROWB, SC + layer * 16384, perm);
        cvt_table_fp6(F, P.in[I_PV] + (size_t)layer * 16384 * 2048, P.ws + WS_TBLV + (size_t)layer * 16384 * PT_ROWB, SC + (2 + layer) * 16384, perm);
    }
    __syncthreads();
}

DI void prologue(const Ctx& F, const Params& P) {
    adaln_partials(F, P);
    transpose_weight(F, P.in[I_EVWIN], 2048, 6144, (bf16_t*)(P.ws + WS_WEVIN));
    transpose_weight(F, P.in[I_EVWOUT], 2048, 2048, (bf16_t*)(P.ws + WS_WEVOUT));
    transpose_weight(F, P.in[I_ODWIN], 2048, 4096, (bf16_t*)(P.ws + WS_WODIN));
    transpose_weight(F, P.in[I_ODWOUT], 2048, 2048, (bf16_t*)(P.ws + WS_WODOUT));
    transpose_weight(F, P.in[I_PWQ], 2048, 2048, (bf16_t*)(P.ws + WS_WPQ));
    transpose_weight(F, P.in[I_PWQ] + (size_t)2048 * 2048, 2048, 2048, (bf16_t*)(P.ws + WS_WPQ) + (size_t)2048 * 2048);
    transpose_weight(F, P.in[I_GLUW], 1024, 1024, (bf16_t*)(P.ws + WS_WGLU));
    cvt_rows(F, P.in[I_PKEYS], (bf16_t*)(P.ws + WS_PKEYS), (size_t)2 * 8 * 2 * 128 * 128);
    cvt_rows(F, P.in[I_CNK], (bf16_t*)(P.ws + WS_CNK), (size_t)8 * 256 * 1024);
    cvt_rows(F, P.in[I_CDK], (bf16_t*)(P.ws + WS_CDK), (size_t)8 * 256 * 1024);
    transpose_cache_v(F, P.in[I_CNV], (bf16_t*)(P.ws + WS_CNVT));
    transpose_cache_v(F, P.in[I_CDV], (bf16_t*)(P.ws + WS_CDVT));
    hyena_filters(F, P);
    s5_consts(F, P);
    convert_peer_tables(F, P);
}
DI void norm_phase(const Ctx& F, const float* xa, const float* xb, const float* gvec, const float* modl, int sidx, bf16_t* H) {
    for (int T = F.bid * 8 + F.wave; T < TOK; T += F.G * 8) {
        const float* xr = T < TP ? xa + (size_t)T * DM : xb + (size_t)(T - TP) * DM;
        f32x4 v[8]; float ss = 0.f;
#pragma unroll
        for (int j = 0; j < 8; ++j) { v[j] = *(const f32x4*)(xr + (j * 64 + F.lane) * 4); ss += v[j].x * v[j].x + v[j].y * v[j].y + v[j].z * v[j].z + v[j].w * v[j].w; }
        ss = wave_sum(ss);
        const float rstd = rsqrtf(ss * (1.f / DM) + NORM_EPS);
        const float* sh = modl + (size_t)(cond_of(T) * 6 + sidx) * DM; const float* sc = sh + DM;
#pragma unroll
        for (int j = 0; j < 8; ++j) {
            const int col = (j * 64 + F.lane) * 4;
            const f32x4 g4 = *(const f32x4*)(gvec + col), s4 = *(const f32x4*)(sc + col), h4 = *(const f32x4*)(sh + col);
            const f32x4 o = v[j] * rstd * g4 * (s4 + 1.f) + h4;
            u32x2 w; w.x = pk2(o.x, o.y); w.y = pk2(o.z, o.w);
            *(u32x2*)(H + (size_t)T * DM + col) = w;
        }
    }
}

struct EpiBf16 {
    static constexpr bool PERM = true, AFTER_DRAIN = false;
    bf16_t* O; int ldc;
    DI void operator()(const f32x4 (&acc)[2][2][4][2], const pg8::Unit& u, int wr, int wc, int fr, int fq) const {
        const int row0 = u.pm * 256 + wr * 64 + fr, col0 = u.pn * 256 + wc * 32 + 8 * fq;
#pragma unroll
        for (int ai = 0; ai < 2; ++ai)
#pragma unroll
            for (int m = 0; m < 4; ++m) { bf16_t* rowp = O + (size_t)(row0 + ai * 128 + m * 16) * ldc + col0;
#pragma unroll
                for (int bj = 0; bj < 2; ++bj) { const f32x4 v0 = acc[ai][bj][m][0], v1 = acc[ai][bj][m][1];
                    u32x4 w; w.x = pk2(v0[0], v0[1]); w.y = pk2(v0[2], v0[3]); w.z = pk2(v1[0], v1[1]); w.w = pk2(v1[2], v1[3]);
                    *(u32x4*)(rowp + bj * 128) = w; } }
    }
};
struct EpiResid {
    static constexpr bool PERM = false, AFTER_DRAIN = false;
    const float* xa; const float* xb; float* out; const float* modl; int gidx;
    DI void operator()(const f32x4 (&acc)[2][2][4][2], const pg8::Unit& u, int wr, int wc, int fr, int fq) const {
        const int row0 = u.pm * 256 + wr * 64 + fr, col0 = u.pn * 256 + wc * 32 + 4 * fq;
        const float* xbase = (u.pm < 32) ? xa : xb - (size_t)TP * DM;
        const float* gate = modl + (size_t)(cond_of(u.pm * 256) * 6 + gidx) * DM;
        f32x4 gv[2][2];
#pragma unroll
        for (int bj = 0; bj < 2; ++bj)
#pragma unroll
            for (int n = 0; n < 2; ++n) gv[bj][n] = *(const f32x4*)(gate + col0 + bj * 128 + n * 16);
#pragma unroll
        for (int ai = 0; ai < 2; ++ai)
#pragma unroll
            for (int m = 0; m < 4; ++m) { const size_t ro = (size_t)(row0 + ai * 128 + m * 16) * DM + col0;
#pragma unroll
                for (int bj = 0; bj < 2; ++bj)
#pragma unroll
                    for (int n = 0; n < 2; ++n) { const f32x4 x4 = *(const f32x4*)(xbase + ro + bj * 128 + n * 16);
                        *(f32x4*)(out + ro + bj * 128 + n * 16) = x4 + gv[bj][n] * acc[ai][bj][m][n]; } }
    }
};
struct EpiGlu {
    static constexpr bool PERM = true, AFTER_DRAIN = false;
    const bf16_t* Y; bf16_t* O; const float* bias;
    DI void operator()(const f32x4 (&acc)[2][2][4][2], const pg8::Unit& u, int wr, int wc, int fr, int fq) const {
        const int row0 = u.pm * 256 + wr * 64 + fr, col0 = u.pn * 256 + wc * 32 + 8 * fq;
#pragma unroll
        for (int bj = 0; bj < 2; ++bj) {
            const f32x4 b0 = *(const f32x4*)(bias + col0 + bj * 128), b1 = *(const f32x4*)(bias + col0 + bj * 128 + 4);
#pragma unroll
            for (int ai = 0; ai < 2; ++ai)
#pragma unroll
                for (int m = 0; m < 4; ++m) { const size_t r = (size_t)(row0 + ai * 128 + m * 16);
                    const u32x4 yv = *(const u32x4*)(Y + r * 1024 + col0 + bj * 128);
                    const f32x4 a0 = acc[ai][bj][m][0] + b0, a1 = acc[ai][bj][m][1] + b1;
                    float o[8];
                    o[0] = bflo(yv.x) / (1.f + __expf(-a0[0])); o[1] = bfhi(yv.x) / (1.f + __expf(-a0[1]));
                    o[2] = bflo(yv.y) / (1.f + __expf(-a0[2])); o[3] = bfhi(yv.y) / (1.f + __expf(-a0[3]));
                    o[4] = bflo(yv.z) / (1.f + __expf(-a1[0])); o[5] = bfhi(yv.z) / (1.f + __expf(-a1[1]));
                    o[6] = bflo(yv.w) / (1.f + __expf(-a1[2])); o[7] = bfhi(yv.w) / (1.f + __expf(-a1[3]));
                    u32x4 w; w.x = pk2(o[0], o[1]); w.y = pk2(o[2], o[3]); w.z = pk2(o[4], o[5]); w.w = pk2(o[6], o[7]);
                    *(u32x4*)(O + r * DM + col0 + bj * 128) = w; }
        }
    }
};
template <class Epi> DI void run_gemm(const Ctx& F, const bf16_t* A, const bf16_t* Bt, int N, int K, const Epi& E) {
    pg8::Gemm g{A, Bt, TOK, N, K}; pg8::StaticOrder S; S.init(TOK, N, F.G, F.bid);
    pg8::gemm_phase<Epi, pg8::StaticOrder, false>(F.lds, g, S, E, nullptr);
    __syncthreads();
}

DI void prep_a(const Ctx& F, const Params& P) {
    const bf16_t* T1 = (const bf16_t*)(P.ws + WS_RA);
    bf16_t* VTp = (bf16_t*)(P.ws + WS_VT); bf16_t* VTs = (bf16_t*)(P.ws + WS_VT + VT_S);
    for (int t = F.bid; t < 2048 + 8192; t += F.G) {
        if (t < 2048) { const int bh = t >> 3, sub = t & 7, tk = sub >> 1, dd = sub & 1, b = bh >> 3, h = bh & 7;
            tr_tile_bf16(F, T1 + ((size_t)(b * 256 + tk * 64)) * 4096 + h * 128 + dd * 64, 4096, VTp + ((size_t)bh * 128 + dd * 64) * 256 + tk * 64, 256, (LAS bf16_t*)F.lds); }
        else { const int u = t - 2048, bh = u >> 7, sub = u & 127, tk = sub >> 1, dd = sub & 1, b = bh >> 3, h = bh & 7;
            tr_tile_bf16(F, T1 + ((size_t)(TP + b * 4096 + tk * 64)) * 4096 + h * 128 + dd * 64, 4096, VTs + ((size_t)bh * 128 + dd * 64) * 4096 + tk * 64, 4096, (LAS bf16_t*)F.lds); }
    }
    { float* o = P.out + O_NAV;
      for (int e = F.bid * NTHR + F.tid; e < TP * 128; e += F.G * NTHR) { const int T = e >> 7, c8 = (e & 127) * 8;
          const u32x4 v = *(const u32x4*)(T1 + (size_t)T * 4096 + c8);
          *(f32x4*)(o + (size_t)T * 1024 + c8) = (f32x4){bflo(v.x), bfhi(v.x), bflo(v.y), bfhi(v.y)};
          *(f32x4*)(o + (size_t)T * 1024 + c8 + 4) = (f32x4){bflo(v.z), bfhi(v.z), bflo(v.w), bfhi(v.w)}; } }
    { LAS bf16_t* tl = (LAS bf16_t*)F.lds;
      bf16_t* CM = (bf16_t*)(P.ws + WS_RB);
      const float* cw = P.in[I_HYCW]; const float* cb = P.in[I_HYCB];
      for (int t = F.bid; t < 48 * 160; t += F.G) {
          const int cg = t % 48, tg = t / 48, ch0 = cg * 64, t0 = tg * 256;
          const bool lz = (t0 < TP) ? true : (((t0 - TP) & 4095) == 0);
          const bool rz = (t0 < TP) ? true : (((t0 + 256 - TP) & 4095) == 0);
          __syncthreads();
#pragma unroll
          for (int j = 0; j < 4; ++j) { const int id = F.tid + NTHR * j, tk = id >> 3, c8 = (id & 7) * 8;
              const u32x4 v = *(const u32x4*)(T1 + (size_t)(t0 + tk) * 4096 + 1024 + ch0 + c8);
              LAS bf16_t* d = tl + tk + 1;
              d[(c8 + 0) * 264] = (bf16_t)(v.x & 0xffff); d[(c8 + 1) * 264] = (bf16_t)(v.x >> 16); d[(c8 + 2) * 264] = (bf16_t)(v.y & 0xffff); d[(c8 + 3) * 264] = (bf16_t)(v.y >> 16);
              d[(c8 + 4) * 264] = (bf16_t)(v.z & 0xffff); d[(c8 + 5) * 264] = (bf16_t)(v.z >> 16); d[(c8 + 6) * 264] = (bf16_t)(v.w & 0xffff); d[(c8 + 7) * 264] = (bf16_t)(v.w >> 16); }
          if (F.tid < 16) { const int side = F.tid >> 3, c8 = (F.tid & 7) * 8; const bool zero = side ? rz : lz; const int tk = side ? t0 + 256 : t0 - 1;
              u32x4 v = (u32x4){0u, 0u, 0u, 0u};
              if (!zero) v = *(const u32x4*)(T1 + (size_t)tk * 4096 + 1024 + ch0 + c8);
              LAS bf16_t* d = tl + (side ? 257 : 0);
              d[(c8 + 0) * 264] = (bf16_t)(v.x & 0xffff); d[(c8 + 1) * 264] = (bf16_t)(v.x >> 16); d[(c8 + 2) * 264] = (bf16_t)(v.y & 0xffff); d[(c8 + 3) * 264] = (bf16_t)(v.y >> 16);
              d[(c8 + 4) * 264] = (bf16_t)(v.z & 0xffff); d[(c8 + 5) * 264] = (bf16_t)(v.z >> 16); d[(c8 + 6) * 264] = (bf16_t)(v.w & 0xffff); d[(c8 + 7) * 264] = (bf16_t)(v.w >> 16); }
          __syncthreads();
#pragma unroll
          for (int j = 0; j < 4; ++j) { const int id = F.tid + NTHR * j, ch = id >> 5, to = (id & 31) * 8, cgl = ch0 + ch;
              const float w0 = cw[cgl], w1 = cw[3072 + cgl], w2 = cw[6144 + cgl], bb = cb[cgl];
              const LAS bf16_t* s = tl + ch * 264 + to;
              float r[10];
#pragma unroll
              for (int i = 0; i < 10; ++i) r[i] = bf2f(s[i]);
              float o[8];
#pragma unroll
              for (int i = 0; i < 8; ++i) o[i] = w0 * r[i] + w1 * r[i + 1] + w2 * r[i + 2] + bb;
              u32x4 w; w.x = pk2(o[0], o[1]); w.y = pk2(o[2], o[3]); w.z = pk2(o[4], o[5]); w.w = pk2(o[6], o[7]);
              *(u32x4*)(CM + (size_t)cgl * TOK + t0 + to) = w; }
      }
      __syncthreads(); }
}

DI void prep_b(const Ctx& F, const Params& P) {
    bf16_t* Pq = (bf16_t*)(P.ws + WS_RA); const float* qg = P.in[I_NAQG]; const float* kg = P.in[I_NAKG]; float* ok = P.out + O_NAK;
    const float* gsrc = (F.lane < 32 ? qg : kg) + (F.lane & 3) * 32;
    float g[32];
#pragma unroll
    for (int i = 0; i < 32; ++i) g[i] = gsrc[i];
    for (int T = F.bid * 8 + F.wave; T < TOK; T += F.G * 8) {
        bf16_t* rp = Pq + (size_t)T * 2048 + F.lane * 32;
        u32x4 v[4]; float x[32]; float ss = 0.f;
#pragma unroll
        for (int j = 0; j < 4; ++j) { v[j] = *(const u32x4*)(rp + j * 8);
            x[j * 8 + 0] = bflo(v[j].x); x[j * 8 + 1] = bfhi(v[j].x); x[j * 8 + 2] = bflo(v[j].y); x[j * 8 + 3] = bfhi(v[j].y);
            x[j * 8 + 4] = bflo(v[j].z); x[j * 8 + 5] = bfhi(v[j].z); x[j * 8 + 6] = bflo(v[j].w); x[j * 8 + 7] = bfhi(v[j].w); }
#pragma unroll
        for (int i = 0; i < 32; ++i) ss += x[i] * x[i];
        ss += dpp_xor1(ss); ss += dpp_xor2(ss);
        const float rstd = rsqrtf(ss * (1.f / 128.f) + NORM_EPS);
#pragma unroll
        for (int i = 0; i < 32; ++i) x[i] = x[i] * rstd * g[i];
#pragma unroll
        for (int j = 0; j < 4; ++j) { u32x4 w; w.x = pk2(x[j * 8 + 0], x[j * 8 + 1]); w.y = pk2(x[j * 8 + 2], x[j * 8 + 3]); w.z = pk2(x[j * 8 + 4], x[j * 8 + 5]); w.w = pk2(x[j * 8 + 6], x[j * 8 + 7]);
            *(u32x4*)(rp + j * 8) = w; }
        if (T < TP && F.lane >= 32) { float* o = ok + (size_t)T * 1024 + (F.lane - 32) * 32;
#pragma unroll
            for (int j = 0; j < 8; ++j) *(f32x4*)(o + j * 4) = (f32x4){x[j * 4], x[j * 4 + 1], x[j * 4 + 2], x[j * 4 + 3]}; }
    }
}
constexpr int AT_KROW = 272, AT_VROW = 136, AT_KTB = 64 * AT_KROW, AT_VTB = 128 * AT_VROW;
constexpr int AT_K0 = 0, AT_V0 = 2 * AT_KTB, AT_RPB = AT_V0 + 2 * AT_VTB;

struct TileMap { const bf16_t* latK; int latKld; const bf16_t* latV; int latVld; int nlat; const bf16_t* ctxK; const bf16_t* ctxV; int ntiles; };
struct TileRegs { u32x4 k[2], v[2]; };

DI void tile_src(const TileMap& M, int j, const bf16_t*& kp, int& kld, const bf16_t*& vp, int& vld) {
    if (j < M.nlat) { kp = M.latK + (size_t)j * 64 * M.latKld; kld = M.latKld; vp = M.latV + j * 64; vld = M.latVld; }
    else { const int c = j - M.nlat; kp = M.ctxK + (size_t)c * 64 * 1024; kld = 1024; vp = M.ctxV + c * 64; vld = 256; }
}
DI void tile_load(const Ctx& F, TileRegs& R, const bf16_t* kp, int kld, const bf16_t* vp, int vld, bool withV = true) {
#pragma unroll
    for (int j = 0; j < 2; ++j) { const int id = F.tid + NTHR * j;
        const unsigned ko = (unsigned)((id >> 4) * kld + (id & 15) * 8) * 2u, vo = (unsigned)((id >> 3) * vld + (id & 7) * 8) * 2u;
        R.k[j] = *(const u32x4*)((const char*)kp + ko);
        if (withV) R.v[j] = *(const u32x4*)((const char*)vp + vo); }
}
DI void tile_store(const Ctx& F, const TileRegs& R, LAS unsigned char* kt, LAS unsigned char* vt, bool withV = true) {
#pragma unroll
    for (int j = 0; j < 2; ++j) { const int id = F.tid + NTHR * j;
        *(LAS u32x4*)(kt + (id >> 4) * AT_KROW + (id & 15) * 16) = R.k[j];
        if (withV) { LAS unsigned char* vp = vt + (id >> 3) * AT_VROW + (id & 7) * 16;
            *(LAS u32x2*)(vp) = (u32x2){R.v[j].x, R.v[j].y}; *(LAS u32x2*)(vp + 8) = (u32x2){R.v[j].z, R.v[j].w}; } }
}

DI void tile_norm_k(const Ctx& F, TileRegs& R, const LAS float* kgain, float* nk, int nkld) {
#pragma unroll
    for (int j = 0; j < 2; ++j) { const int id = F.tid + NTHR * j;
        float x[8] = {bflo(R.k[j].x), bfhi(R.k[j].x), bflo(R.k[j].y), bfhi(R.k[j].y), bflo(R.k[j].z), bfhi(R.k[j].z), bflo(R.k[j].w), bfhi(R.k[j].w)};
        float ss = 0.f;
#pragma unroll
        for (int i = 0; i < 8; ++i) ss += x[i] * x[i];
        ss += dpp_xor1(ss); ss += dpp_xor2(ss);
        ss += __builtin_bit_cast(float, __builtin_amdgcn_update_dpp(0, __builtin_bit_cast(int, ss), 0x141, 0xF, 0xF, true));
        ss += __builtin_bit_cast(float, __builtin_amdgcn_update_dpp(0, __builtin_bit_cast(int, ss), 0x140, 0xF, 0xF, true));
        const float rstd = rsqrtf(ss * (1.f / 128.f) + NORM_EPS);
        const f32x4 g0 = *(const LAS f32x4*)(kgain + (id & 15) * 8), g1 = *(const LAS f32x4*)(kgain + (id & 15) * 8 + 4);
        x[0] *= rstd * g0.x; x[1] *= rstd * g0.y; x[2] *= rstd * g0.z; x[3] *= rstd * g0.w; x[4] *= rstd * g1.x; x[5] *= rstd * g1.y; x[6] *= rstd * g1.z; x[7] *= rstd * g1.w;
        R.k[j] = (u32x4){pk2(x[0], x[1]), pk2(x[2], x[3]), pk2(x[4], x[5]), pk2(x[6], x[7])};
        if (nk) { float* o = nk + (size_t)(id >> 4) * nkld + (id & 15) * 8; *(f32x4*)(o) = (f32x4){x[0], x[1], x[2], x[3]}; *(f32x4*)(o + 4) = (f32x4){x[4], x[5], x[6], x[7]}; }
    }
}

template <int KS>
DI f32x16 qk_tile(LAS const unsigned char* kt, const bf16x8 (&Qf)[8], int kb, int kk0, int q, int hh) {
    f32x16 S;
#pragma unroll
    for (int i = 0; i < 16; ++i) S[i] = 0.f;
#pragma unroll
    for (int ks = 0; ks < KS; ++ks) { const int kk = kk0 + ks;
        const bf16x8 A = *(const LAS bf16x8*)(kt + (kb * 32 + q) * AT_KROW + (kk * 16 + hh * 8) * 2);
        S = __builtin_amdgcn_mfma_f32_32x32x16_bf16(A, Qf[kk], S, 0, 0, 0); }
    return S;
}
DI void pv_tile(LAS const unsigned char* vt, const float (&p)[16], f32x16 (&O)[4], int kb, int q, int hh) {
#pragma unroll
    for (int s = 0; s < 2; ++s) {
        u32x4 pw; pw.x = pk2(p[8 * s + 0], p[8 * s + 1]); pw.y = pk2(p[8 * s + 2], p[8 * s + 3]); pw.z = pk2(p[8 * s + 4], p[8 * s + 5]); pw.w = pk2(p[8 * s + 6], p[8 * s + 7]);
        const bf16x8 Pf = __builtin_bit_cast(bf16x8, pw);
#pragma unroll
        for (int db = 0; db < 4; ++db) {
            LAS const unsigned char* ap = vt + (db * 32 + q) * AT_VROW + (kb * 32 + 16 * s + 4 * hh) * 2;
            const u32x2 lo = *(const LAS u32x2*)(ap), hi = *(const LAS u32x2*)(ap + 16);
            const bf16x8 A2 = __builtin_bit_cast(bf16x8, (u32x4){lo.x, lo.y, hi.x, hi.y});
            O[db] = __builtin_amdgcn_mfma_f32_32x32x16_bf16(A2, Pf, O[db], 0, 0, 0);
        }
        asm volatile("" ::: "memory");
    }
}
template <bool LAT>
DI void attn_compute1(LAS const unsigned char* kt, LAS const unsigned char* vt, const bf16x8 (&Qf)[8], f32x16 (&O)[4], float& ls, int lane, const LAS float* brow, int cq) {
    const int q = lane & 31, hh = lane >> 5;
    const int cs = min(max(cq - 8, 0), 48);
#pragma unroll 1
    for (int kb = 0; kb < 2; ++kb) {
        const f32x16 S = qk_tile<8>(kt, Qf, kb, 0, q, hh);
        float p[16];
#pragma unroll
        for (int i = 0; i < 16; ++i) {
            float arg = S[i];
            if (LAT) { const int ck = kb * 32 + (i & 3) + 8 * (i >> 2) + 4 * hh;
                arg += brow[min(max(ck - cq + 15, 0), 30)];
                p[i] = ((unsigned)(ck - cs) < 16u) ? __builtin_amdgcn_exp2f(arg) : 0.f; }
            else p[i] = __builtin_amdgcn_exp2f(arg);
            ls += p[i];
        }
        pv_tile(vt, p, O, kb, q, hh);
    }
}
DI void diff_pass1(LAS const unsigned char* kt, const bf16x8 (&Qf)[8], float (&ls)[2], int lane) {
    const int q = lane & 31, hh = lane >> 5;
#pragma unroll
    for (int kb = 0; kb < 2; ++kb) {
#pragma unroll
        for (int mp = 0; mp < 2; ++mp) { const f32x16 S = qk_tile<4>(kt, Qf, kb, mp * 4, q, hh);
#pragma unroll
            for (int i = 0; i < 16; ++i) ls[mp] += __builtin_amdgcn_exp2f(S[i]); }
    }
}
DI void diff_pass2(LAS const unsigned char* kt, LAS const unsigned char* vt, const bf16x8 (&Qf)[8], f32x16 (&O)[4], float w0, float w1, int lane) {
    const int q = lane & 31, hh = lane >> 5;
#pragma unroll
    for (int kb = 0; kb < 2; ++kb) {
        float p[16];
        { const f32x16 S0 = qk_tile<4>(kt, Qf, kb, 0, q, hh);
#pragma unroll
          for (int i = 0; i < 16; ++i) p[i] = __builtin_amdgcn_exp2f(S0[i]) * w0; }
        { const f32x16 S1 = qk_tile<4>(kt, Qf, kb, 4, q, hh);
#pragma unroll
          for (int i = 0; i < 16; ++i) p[i] -= __builtin_amdgcn_exp2f(S1[i]) * w1; }
        pv_tile(vt, p, O, kb, q, hh);
    }
}

template <int MODE>
DI void attn_phase(const Ctx& F, const Params& P) {
    constexpr bool DIFF = (MODE >= 2);
    constexpr bool NA = (MODE == 1);
    LAS unsigned char* lds = F.lds;
    LAS float* rpbl = (LAS float*)(lds + AT_RPB);
    LAS float* kgl = (LAS float*)(lds + AT_RPB + 2048);
    if (!DIFF) { __syncthreads(); if (F.tid < 128) kgl[F.tid] = P.in[I_NAKG][F.tid]; __syncthreads(); }
    const bf16_t* PA = (const bf16_t*)(P.ws + WS_RA);
    bf16_t* MIX = (bf16_t*)(P.ws + WS_HM);
    const bf16_t* VTp = (const bf16_t*)(P.ws + WS_VT); const bf16_t* VTs = (const bf16_t*)(P.ws + WS_VT + VT_S);
    const int q = F.lane & 31, hh = F.lane >> 5;
    const float c1 = (DIFF ? 0.125f : 0.08838834764831845f) * LOG2E;
    float lam = 0.f;
    if (DIFF) {
        const float a = wave_sum(P.in[I_LQ1][F.lane] * P.in[I_LK1][F.lane]), b = wave_sum(P.in[I_LQ2][F.lane] * P.in[I_LK2][F.lane]);
        lam = __expf(a) - __expf(b) + 0.35550906759096924f;
    }
    const int nunits = (MODE == 0 || MODE == 2) ? 256 : 1024;
    for (int u0 = F.bid; u0 < nunits; u0 += F.G) {
        int u = u0;
        if ((MODE == 1 || MODE == 3) && F.G == 256) { const int i = u0 >> 8, x = F.bid & 7, y = F.bid >> 3; u = ((2 * i + (y >> 4)) * 8 + x) * 16 + (y & 15); }
        int b, h, tok0, r = 0, rlo = 0; TileMap M;
        const bf16_t* qptr;
        if (MODE == 0) { b = u >> 3; h = u & 7; tok0 = b * 256 + F.wave * 32;
            qptr = PA + (size_t)(tok0 + q) * 2048 + h * 128;
            M.latK = PA + (size_t)(b * 256) * 2048 + 1024 + h * 128; M.latKld = 2048; M.latV = VTp + (size_t)(b * 8 + h) * 128 * 256; M.latVld = 256; M.nlat = 4; M.ctxK = nullptr; M.ctxV = nullptr; M.ntiles = 4; }
        else if (MODE == 1) { b = u >> 7; h = (u >> 4) & 7; const int rg = u & 15; r = 4 * rg + (F.wave >> 1);
            rlo = min(max(4 * rg - 4, 0), 56); const int rhi = min(max(4 * rg + 3 - 4, 0), 56) + 8;
            tok0 = TP + b * 4096 + r * 64 + (F.wave & 1) * 32;
            qptr = PA + (size_t)(tok0 + q) * 2048 + h * 128;
            M.latK = PA + (size_t)(TP + b * 4096 + rlo * 64) * 2048 + 1024 + h * 128; M.latKld = 2048; M.latV = VTs + (size_t)(b * 8 + h) * 128 * 4096 + rlo * 64; M.latVld = 4096; M.nlat = rhi - rlo;
            M.ctxK = (const bf16_t*)(P.ws + WS_CNK) + (size_t)b * 256 * 1024 + h * 128; M.ctxV = (const bf16_t*)(P.ws + WS_CNVT) + (size_t)(b * 8 + h) * 128 * 256; M.ntiles = M.nlat + 4;
            if (F.tid < 465) rpbl[F.tid] = P.in[I_RPB][h * 465 + F.tid] * LOG2E; }
        else if (MODE == 2) { b = u >> 3; h = u & 7; tok0 = b * 256 + F.wave * 32;
            qptr = PA + (size_t)(tok0 + q) * 4096 + 1024 + h * 128;
            M.latK = PA + (size_t)(b * 256) * 4096 + 2048 + h * 128; M.latKld = 4096; M.latV = VTp + (size_t)(b * 8 + h) * 128 * 256; M.latVld = 256; M.nlat = 4; M.ctxK = nullptr; M.ctxV = nullptr; M.ntiles = 4; }
        else { b = u >> 7; h = (u >> 4) & 7; const int qb = u & 15; tok0 = TP + b * 4096 + qb * 256 + F.wave * 32;
            qptr = PA + (size_t)(tok0 + q) * 4096 + 1024 + h * 128;
            M.latK = PA + (size_t)(TP + b * 4096) * 4096 + 2048 + h * 128; M.latKld = 4096; M.latV = VTs + (size_t)(b * 8 + h) * 128 * 4096; M.latVld = 4096; M.nlat = 64;
            M.ctxK = (const bf16_t*)(P.ws + WS_CDK) + (size_t)b * 256 * 1024 + h * 128; M.ctxV = (const bf16_t*)(P.ws + WS_CDVT) + (size_t)(b * 8 + h) * 128 * 256; M.ntiles = 68; }
        bf16x8 Qf[8];
        if constexpr (!DIFF) {
            u32x4 w[8]; float ss = 0.f;
#pragma unroll
            for (int ks = 0; ks < 8; ++ks) { w[ks] = *(const u32x4*)(qptr + ks * 16 + hh * 8);
                ss += bflo(w[ks].x) * bflo(w[ks].x) + bfhi(w[ks].x) * bfhi(w[ks].x) + bflo(w[ks].y) * bflo(w[ks].y) + bfhi(w[ks].y) * bfhi(w[ks].y)
                    + bflo(w[ks].z) * bflo(w[ks].z) + bfhi(w[ks].z) * bfhi(w[ks].z) + bflo(w[ks].w) * bflo(w[ks].w) + bfhi(w[ks].w) * bfhi(w[ks].w); }
            ss += __shfl_xor(ss, 32);
            const float qs = rsqrtf(ss * (1.f / 128.f) + NORM_EPS) * c1;
            const float* qg = P.in[I_NAQG];
#pragma unroll
            for (int ks = 0; ks < 8; ++ks) { const f32x4 g0 = *(const f32x4*)(qg + ks * 16 + hh * 8), g1 = *(const f32x4*)(qg + ks * 16 + hh * 8 + 4);
                const u32x4 ws = (u32x4){pk2(bflo(w[ks].x) * qs * g0.x, bfhi(w[ks].x) * qs * g0.y), pk2(bflo(w[ks].y) * qs * g0.z, bfhi(w[ks].y) * qs * g0.w),
                                         pk2(bflo(w[ks].z) * qs * g1.x, bfhi(w[ks].z) * qs * g1.y), pk2(bflo(w[ks].w) * qs * g1.z, bfhi(w[ks].w) * qs * g1.w)};
                Qf[ks] = __builtin_bit_cast(bf16x8, ws); }
        } else {
#pragma unroll
        for (int ks = 0; ks < 8; ++ks) { const u32x4 w = *(const u32x4*)(qptr + ks * 16 + hh * 8);
            const u32x4 ws = (u32x4){pk2(bflo(w.x) * c1, bfhi(w.x) * c1), pk2(bflo(w.y) * c1, bfhi(w.y) * c1), pk2(bflo(w.z) * c1, bfhi(w.z) * c1), pk2(bflo(w.w) * c1, bfhi(w.w) * c1)};
            Qf[ks] = __builtin_bit_cast(bf16x8, ws); }
        }
        f32x16 O[4]; float ls[2] = {0.f, 0.f}; float w0 = 0.f, w1 = 0.f;
#pragma unroll
        for (int db = 0; db < 4; ++db)
#pragma unroll
            for (int i = 0; i < 16; ++i) O[db][i] = 0.f;
        const int cq = (F.wave & 1) * 32 + q;
        const int r0w = min(max(r - 4, 0), 56);
        const int nt = M.ntiles;
        TileRegs R;
        { const bf16_t* kp; const bf16_t* vp; int kld, vld; tile_src(M, 0, kp, kld, vp, vld); tile_load(F, R, kp, kld, vp, vld); }
        if constexpr (!DIFF) tile_norm_k(F, R, kgl, (MODE == 0) ? P.out + O_NAK + (size_t)(b * 256) * 1024 + h * 128 : nullptr, 1024);
        tile_store(F, R, lds + AT_K0, lds + AT_V0);
        __syncthreads();
        if constexpr (DIFF) {
#pragma unroll 1
            for (int j = 0; j < nt; ++j) {
                const int cur = j & 1, jn = (j + 1 < nt) ? j + 1 : 0;
                const bool wv = (j + 1 == nt);
                { const bf16_t* kp; const bf16_t* vp; int kld, vld; tile_src(M, jn, kp, kld, vp, vld); tile_load(F, R, kp, kld, vp, vld, wv); }
                diff_pass1(lds + AT_K0 + cur * AT_KTB, Qf, ls, F.lane);
                tile_store(F, R, lds + AT_K0 + (cur ^ 1) * AT_KTB, lds + AT_V0 + (cur ^ 1) * AT_VTB, wv);
                __syncthreads();
            }
            { const float l0 = ls[0] + __shfl_xor(ls[0], 32), l1 = ls[1] + __shfl_xor(ls[1], 32); w0 = 1.f / l0; w1 = lam / l1; }
#pragma unroll 1
            for (int j = 0; j < nt; ++j) {
                const int cur = (nt + j) & 1;
                if (j + 1 < nt) { const bf16_t* kp; const bf16_t* vp; int kld, vld; tile_src(M, j + 1, kp, kld, vp, vld); tile_load(F, R, kp, kld, vp, vld); }
                diff_pass2(lds + AT_K0 + cur * AT_KTB, lds + AT_V0 + cur * AT_VTB, Qf, O, w0, w1, F.lane);
                if (j + 1 < nt) tile_store(F, R, lds + AT_K0 + (cur ^ 1) * AT_KTB, lds + AT_V0 + (cur ^ 1) * AT_VTB);
                __syncthreads();
            }
        } else {
#pragma unroll 1
            for (int j = 0; j < nt; ++j) {
                const int cur = j & 1;
                if (j + 1 < nt) { const bf16_t* kp; const bf16_t* vp; int kld, vld; tile_src(M, j + 1, kp, kld, vp, vld); tile_load(F, R, kp, kld, vp, vld); }
                LAS const unsigned char* kt = lds + AT_K0 + cur * AT_KTB; LAS const unsigned char* vt = lds + AT_V0 + cur * AT_VTB;
                if constexpr (NA) {
                    if (j < M.nlat) { const int kr = rlo + j;
                        if (kr >= r0w && kr < r0w + 8) attn_compute1<true>(kt, vt, Qf, O, ls[0], F.lane, rpbl + (kr - r + 7) * 31, cq); }
                    else attn_compute1<false>(kt, vt, Qf, O, ls[0], F.lane, rpbl, cq);
                } else attn_compute1<false>(kt, vt, Qf, O, ls[0], F.lane, rpbl, cq);
                if (j + 1 < nt) {
                    if (j + 1 < M.nlat) tile_norm_k(F, R, kgl, (MODE == 0) ? P.out + O_NAK + (size_t)(b * 256 + (j + 1) * 64) * 1024 + h * 128 : nullptr, 1024);
                    tile_store(F, R, lds + AT_K0 + (cur ^ 1) * AT_KTB, lds + AT_V0 + (cur ^ 1) * AT_VTB); }
                __syncthreads();
            }
        }
        if constexpr (!DIFF) {
            const float inv = 1.f / (ls[0] + __shfl_xor(ls[0], 32));
            bf16_t* op = MIX + (size_t)(tok0 + q) * DM + h * 128 + 4 * hh;
#pragma unroll
            for (int db = 0; db < 4; ++db)
#pragma unroll
                for (int g = 0; g < 4; ++g) { u32x2 w; w.x = pk2(O[db][4 * g] * inv, O[db][4 * g + 1] * inv); w.y = pk2(O[db][4 * g + 2] * inv, O[db][4 * g + 3] * inv);
                    *(u32x2*)(op + db * 32 + 8 * g) = w; }
        } else {
            float ss = 0.f;
#pragma unroll
            for (int db = 0; db < 4; ++db)
#pragma unroll
                for (int i = 0; i < 16; ++i) ss += O[db][i] * O[db][i];
            ss += __shfl_xor(ss, 32);
            const float sc = rsqrtf(ss * (1.f / 128.f) + NORM_EPS) * (1.f - 0.35550906759096924f);
            const float* sg = P.in[I_SUBG];
            bf16_t* op = MIX + (size_t)(tok0 + q) * DM + 1024 + h * 128 + 4 * hh;
#pragma unroll
            for (int db = 0; db < 4; ++db)
#pragma unroll
                for (int g = 0; g < 4; ++g) { const f32x4 g4 = *(const f32x4*)(sg + db * 32 + 8 * g + 4 * hh);
                    u32x2 w; w.x = pk2(O[db][4 * g] * sc * g4.x, O[db][4 * g + 1] * sc * g4.y); w.y = pk2(O[db][4 * g + 2] * sc * g4.z, O[db][4 * g + 3] * sc * g4.w);
                    *(u32x2*)(op + db * 32 + 8 * g) = w; }
        }
    }
}
template <int L, int BATCH> struct HyCfg {
    static constexpr int NB = L / 64, TPT = 32 / BATCH, NTILES = NB / TPT, LOGB = (BATCH == 8) ? 3 : 5;
    static constexpr int ZROWB = (L + 384) * 2 + 16, ZBYTES = BATCH * ZROWB, RL = 2 * L + 16;
    static constexpr int TPW = (NTILES + 7) / 8;
};
constexpr int HY_KR_OFF = 71808;

template <int L, int BATCH>
DI void hyena_part(const Ctx& F, const Params& P, int c, int tokbase  , const bf16_t* KRG  ) {
    typedef HyCfg<L, BATCH> C;
    LAS unsigned char* lds = F.lds;
    bf16_t* CM = (bf16_t*)(P.ws + WS_RB);
    const float* hbias = P.in[I_HYBIAS];
    const int q = F.lane & 31, hh = F.lane >> 5;
    __syncthreads();
    for (int id = F.tid; id < BATCH * (L / 8); id += NTHR) { const int b = id / (L / 8), s8 = (id % (L / 8)) * 8;
        *(LAS u32x4*)(lds + b * C::ZROWB + (192 + s8) * 2) = *(const u32x4*)(CM + (size_t)c * TOK + tokbase + b * L + s8); }
    for (int id = F.tid; id < BATCH * 48; id += NTHR) { const int b = id / 48, k = id % 48, e = (k < 24) ? k * 8 : (192 + L + (k - 24) * 8);
        *(LAS u32x4*)(lds + b * C::ZROWB + e * 2) = (u32x4){0u, 0u, 0u, 0u}; }
#pragma unroll 1
    for (int o = 0; o < 2; ++o) {
        { const bf16_t* src = KRG + (size_t)(o * 1024 + c) * C::RL;
          for (int id = F.tid; id < C::RL / 8; id += NTHR) { const u32x4 v = *(const u32x4*)(src + id * 8);
              *(LAS u32x4*)(lds + HY_KR_OFF + id * 16) = v;
              LAS bf16_t* c1 = (LAS bf16_t*)(lds + HY_KR_OFF + C::RL * 2) + id * 8 - 1;
              if (id > 0) c1[0] = (bf16_t)(v.x & 0xffff);
              c1[1] = (bf16_t)(v.x >> 16); c1[2] = (bf16_t)(v.y & 0xffff); c1[3] = (bf16_t)(v.y >> 16); c1[4] = (bf16_t)(v.z & 0xffff); c1[5] = (bf16_t)(v.z >> 16);
              c1[6] = (bf16_t)(v.w & 0xffff); c1[7] = (bf16_t)(v.w >> 16); } }
        __syncthreads();
        f32x16 acc[C::TPW][2];
#pragma unroll
        for (int t = 0; t < C::TPW; ++t)
#pragma unroll
            for (int mt = 0; mt < 2; ++mt)
#pragma unroll
                for (int i = 0; i < 16; ++i) acc[t][mt][i] = 0.f;
        const int tq0 = F.wave * C::TPW;
        if (tq0 < C::NTILES) {
            const int d1lo = C::TPT * tq0 - (C::NB - 1), d1hi = C::TPT * (tq0 + C::TPW - 1) + C::TPT - 1;
            const int abase = HY_KR_OFF + (F.lane & 1) * (C::RL * 2) + (L - (F.lane & 31) + 8 * hh - (F.lane & 1)) * 2;
            bf16x8 W0[6], W1[6], B0[C::TPW][4];
#define HY_LDW(Wv, d1v, i) do { LAS const unsigned* ap_ = (LAS const unsigned*)(lds + abase + (-4 * (d1v) - 2 + (i)) * 32); Wv[i] = __builtin_bit_cast(bf16x8, (u32x4){ap_[0], ap_[1], ap_[2], ap_[3]}); } while (0)
#define HY_LDB(Bv, d1v) do { _Pragma("unroll") for (int t_ = 0; t_ < C::TPW; ++t_) { const int tq_ = tq0 + t_; \
            const int t1_ = C::TPT * tq_ + (q >> C::LOGB), b_ = q & (BATCH - 1); int s1_ = t1_ - (d1v); s1_ = min(max(s1_, -3), C::NB + 2); \
            LAS const unsigned char* bp_ = lds + b_ * C::ZROWB + (192 + 64 * s1_ + 8 * hh) * 2; \
            _Pragma("unroll") for (int ks_ = 0; ks_ < 4; ++ks_) Bv[t_][ks_] = *(const LAS bf16x8*)(bp_ + ks_ * 32); } } while (0)
#define HY_MM(Wv, Bv, d1v) do { _Pragma("unroll") for (int t_ = 0; t_ < C::TPW; ++t_) { const int tq_ = tq0 + t_; \
            if ((d1v) >= C::TPT * tq_ - (C::NB - 1) && (d1v) <= C::TPT * tq_ + C::TPT - 1) { \
                _Pragma("unroll") for (int ks_ = 0; ks_ < 4; ++ks_) _Pragma("unroll") for (int mt_ = 0; mt_ < 2; ++mt_) \
                    acc[t_][mt_] = __builtin_amdgcn_mfma_f32_32x32x16_bf16(Wv[ks_ - 2 * mt_ + 2], Bv[t_][ks_], acc[t_][mt_], 0, 0, 0); } } } while (0)
#pragma unroll
            for (int i = 0; i < 6; ++i) HY_LDW(W0, d1lo, i);
            int d1 = d1lo;
#pragma unroll 1
            for (; d1 + 1 <= d1hi; d1 += 2) {
                HY_LDB(B0, d1);
#pragma unroll
                for (int i = 0; i < 4; ++i) HY_LDW(W1, d1 + 1, i);
                W1[4] = W0[0]; W1[5] = W0[1];
                HY_MM(W0, B0, d1);
                HY_LDB(B0, d1 + 1);
                if (d1 + 2 <= d1hi) {
#pragma unroll
                    for (int i = 0; i < 4; ++i) HY_LDW(W0, d1 + 2, i);
                    W0[4] = W1[0]; W0[5] = W1[1];
                }
                HY_MM(W1, B0, d1 + 1);
            }
            if (d1 <= d1hi) { HY_LDB(B0, d1); HY_MM(W0, B0, d1); }
#undef HY_LDW
#undef HY_LDB
#undef HY_MM
        }
        __syncthreads();
        if (tq0 < C::NTILES) {
            const float bo = hbias[o * 1024 + c];
            const bf16_t* gate = CM + (size_t)((1 + o) * 1024 + c) * TOK + tokbase;
            bf16_t* zout = (bf16_t*)(P.ws + WS_RA + RA_ZC) + (size_t)c * TOK + tokbase;
#pragma unroll
            for (int t = 0; t < C::TPW; ++t) { const int tq = tq0 + t, t1 = C::TPT * tq + (q >> C::LOGB), b = q & (BATCH - 1);
#pragma unroll
                for (int mt = 0; mt < 2; ++mt)
#pragma unroll
                    for (int g = 0; g < 4; ++g) { const int s = 64 * t1 + 32 * mt + 8 * g + 4 * hh;
                        LAS u32x2* zp = (LAS u32x2*)(lds + b * C::ZROWB + (192 + s) * 2);
                        const u32x2 zv = *zp, gv = *(const u32x2*)(gate + (size_t)b * L + s);
                        const float r0 = bflo(gv.x) * (acc[t][mt][4 * g] + bflo(zv.x) * bo), r1 = bfhi(gv.x) * (acc[t][mt][4 * g + 1] + bfhi(zv.x) * bo);
                        const float r2 = bflo(gv.y) * (acc[t][mt][4 * g + 2] + bflo(zv.y) * bo), r3 = bfhi(gv.y) * (acc[t][mt][4 * g + 3] + bfhi(zv.y) * bo);
                        const u32x2 w = (u32x2){pk2(r0, r1), pk2(r2, r3)};
                        if (o == 0) *zp = w; else *(u32x2*)(zout + (size_t)b * L + s) = w; } }
        }
        __syncthreads();
    }
}

DI void hyena_phase(const Ctx& F, const Params& P) {
    for (int c = F.bid; c < 1024; c += F.G) {
        hyena_part<LS, 8>(F, P, c, TP, (const bf16_t*)(P.ws + WS_KRS));
        hyena_part<LP, 32>(F, P, c, 0, (const bf16_t*)(P.ws + WS_KRP));
    }
}

DI void hyena_post(const Ctx& F, const Params& P) {
    const bf16_t* CM = (const bf16_t*)(P.ws + WS_RA + RA_ZC); bf16_t* MIX = (bf16_t*)(P.ws + WS_HM);
    for (int t = F.bid; t < 16 * 640; t += F.G) { const int cg = t & 15, tg = t >> 4;
        tr_tile_bf16(F, CM + (size_t)(cg * 64) * TOK + tg * 64, TOK, MIX + (size_t)(tg * 64) * DM + 1024 + cg * 64, DM, (LAS bf16_t*)F.lds); }
}
DI void prep_c(const Ctx& F, const Params& P) {
    bf16_t* PA = (bf16_t*)(P.ws + WS_RA);
    LAS float* rope = (LAS float*)(F.lds + 16384);
    __syncthreads();
    for (int e = F.tid; e < 1024; e += NTHR) { const int pos = e >> 4, f = e & 15; const float inv = exp2f(-(float)f * (13.287712379549449f / 16.f)); const float a = (float)pos * inv;
        rope[e * 2] = cosf(a); rope[e * 2 + 1] = sinf(a); }
    __syncthreads();
    { const float* gsrc = (F.lane < 32 ? P.in[I_DQG] : P.in[I_DKG]) + (F.lane & 1) * 32; float* ok = P.out + O_DK;
      float g[32];
#pragma unroll
      for (int i = 0; i < 32; ++i) g[i] = gsrc[i];
      for (int T = F.bid * 8 + F.wave; T < TOK; T += F.G * 8) {
          bf16_t* rp = PA + (size_t)T * 4096 + 1024 + F.lane * 32;
          u32x4 v[4]; float x[32]; float ss = 0.f;
#pragma unroll
          for (int j = 0; j < 4; ++j) { v[j] = *(const u32x4*)(rp + j * 8);
              x[j * 8 + 0] = bflo(v[j].x); x[j * 8 + 1] = bfhi(v[j].x); x[j * 8 + 2] = bflo(v[j].y); x[j * 8 + 3] = bfhi(v[j].y);
              x[j * 8 + 4] = bflo(v[j].z); x[j * 8 + 5] = bfhi(v[j].z); x[j * 8 + 6] = bflo(v[j].w); x[j * 8 + 7] = bfhi(v[j].w); }
#pragma unroll
          for (int i = 0; i < 32; ++i) ss += x[i] * x[i];
          ss += dpp_xor1(ss);
          const float rstd = rsqrtf(ss * (1.f / 64.f) + NORM_EPS);
#pragma unroll
          for (int i = 0; i < 32; ++i) x[i] = x[i] * rstd * g[i];
          if (T < TP) { if (F.lane >= 32) { float* o = ok + (size_t)T * 1024 + (F.lane - 32) * 32;
#pragma unroll
                  for (int j = 0; j < 8; ++j) *(f32x4*)(o + j * 4) = (f32x4){x[j * 4], x[j * 4 + 1], x[j * 4 + 2], x[j * 4 + 3]}; } }
          else { const int t = (T - TP) & 4095, pos = (F.lane & 1) ? (t & 63) : (t >> 6);
              const LAS float* rt = rope + pos * 32;
#pragma unroll
              for (int f = 0; f < 16; ++f) { const float cs = rt[2 * f], sn = rt[2 * f + 1], a = x[f], b = x[16 + f]; x[f] = a * cs - b * sn; x[16 + f] = b * cs + a * sn; } }
#pragma unroll
          for (int j = 0; j < 4; ++j) { u32x4 w; w.x = pk2(x[j * 8 + 0], x[j * 8 + 1]); w.y = pk2(x[j * 8 + 2], x[j * 8 + 3]); w.z = pk2(x[j * 8 + 4], x[j * 8 + 5]); w.w = pk2(x[j * 8 + 6], x[j * 8 + 7]);
              *(u32x4*)(rp + j * 8) = w; }
      } }
    __syncthreads();
    bf16_t* VTp = (bf16_t*)(P.ws + WS_VT); bf16_t* VTs = (bf16_t*)(P.ws + WS_VT + VT_S);
    for (int t = F.bid; t < 2048 + 8192; t += F.G) {
        if (t < 2048) { const int bh = t >> 3, sub = t & 7, tk = sub >> 1, dd = sub & 1, b = bh >> 3, h = bh & 7;
            tr_tile_bf16(F, PA + ((size_t)(b * 256 + tk * 64)) * 4096 + 3072 + h * 128 + dd * 64, 4096, VTp + ((size_t)bh * 128 + dd * 64) * 256 + tk * 64, 256, (LAS bf16_t*)F.lds); }
        else { const int u = t - 2048, bh = u >> 7, sub = u & 127, tk = sub >> 1, dd = sub & 1, b = bh >> 3, h = bh & 7;
            tr_tile_bf16(F, PA + ((size_t)(TP + b * 4096 + tk * 64)) * 4096 + 3072 + h * 128 + dd * 64, 4096, VTs + ((size_t)bh * 128 + dd * 64) * 4096 + tk * 64, 4096, (LAS bf16_t*)F.lds); }
    }
    { float* o = P.out + O_DV;
      for (int e = F.bid * NTHR + F.tid; e < TP * 128; e += F.G * NTHR) { const int T = e >> 7, c8 = (e & 127) * 8;
          const u32x4 v = *(const u32x4*)(PA + (size_t)T * 4096 + 3072 + c8);
          *(f32x4*)(o + (size_t)T * 1024 + c8) = (f32x4){bflo(v.x), bfhi(v.x), bflo(v.y), bfhi(v.y)};
          *(f32x4*)(o + (size_t)T * 1024 + c8 + 4) = (f32x4){bflo(v.z), bfhi(v.z), bflo(v.w), bfhi(v.w)}; } }
}

constexpr int S5_BUROW = 132 * 4, S5_HROW = 272, S5_WLDS = 16 * S5_BUROW + 16 * S5_HROW;
DI void s5_chain(const Ctx& F, const Params& P, int dg, int tok0, int L, const float* h0re, const float* h0im, float* fre, float* fim, bf16_t* Yout) {
    LAS unsigned char* wl = F.lds + F.wave * S5_WLDS; LAS unsigned char* hl = wl + 16 * S5_BUROW;
    const int g = dg & 63, dir = dg >> 6, lane = F.lane, st = lane & 15, gq = lane >> 4;
    const float* S5A = (const float*)(P.ws + WS_S5A); const bf16_t* BB = (const bf16_t*)(P.ws + WS_S5BB); const bf16_t* CC = (const bf16_t*)(P.ws + WS_S5CC);
    const bf16_t* PA = (const bf16_t*)(P.ws + WS_RA);
    const float ar = S5A[(dg * 64 + lane) * 2], ai = S5A[(dg * 64 + lane) * 2 + 1];
    float hr = h0re ? h0re[lane] : 0.f, hi = h0im ? h0im[lane] : 0.f;
    const bf16x8 zero8 = (bf16x8){0, 0, 0, 0, 0, 0, 0, 0};
    bf16x8 BBf[8], CCf[4];
#pragma unroll
    for (int mt = 0; mt < 8; ++mt) BBf[mt] = (gq < 2) ? *(const bf16x8*)(BB + ((size_t)dg * 128 + mt * 16 + st) * 16 + gq * 8) : zero8;
#pragma unroll
    for (int kk = 0; kk < 4; ++kk) CCf[kk] = *(const bf16x8*)(CC + ((size_t)dg * 16 + st) * 128 + kk * 32 + gq * 8);
    const int nch = L / 16;
    const int sgn = dir ? -1 : 1, tstart = dir ? tok0 + L - 1 : tok0;
    bf16x8 Uf = zero8, U1 = zero8, U2 = zero8;
    if (gq < 2) { Uf = *(const bf16x8*)(PA + (size_t)(tstart + sgn * st) * 4096 + g * 16 + gq * 8);
        if (1 < nch) U1 = *(const bf16x8*)(PA + (size_t)(tstart + sgn * (16 + st)) * 4096 + g * 16 + gq * 8);
        if (2 < nch) U2 = *(const bf16x8*)(PA + (size_t)(tstart + sgn * (32 + st)) * 4096 + g * 16 + gq * 8); }
    for (int ch = 0; ch < nch; ++ch) {
        bf16x8 Un = zero8;
        if (ch + 3 < nch && gq < 2) Un = *(const bf16x8*)(PA + (size_t)(tstart + sgn * ((ch + 3) * 16 + st)) * 4096 + g * 16 + gq * 8);
#pragma unroll
        for (int mt = 0; mt < 8; ++mt) { f32x4 d = (f32x4){0.f, 0.f, 0.f, 0.f};
            d = __builtin_amdgcn_mfma_f32_16x16x32_bf16(BBf[mt], Uf, d, 0, 0, 0);
            *(LAS f32x4*)(wl + st * S5_BUROW + (mt * 16 + gq * 4) * 4) = d; }
        asm volatile("" ::: "memory");
#pragma unroll
        for (int s = 0; s < 16; ++s) {
            const float bur = *(const LAS float*)(wl + s * S5_BUROW + lane * 4), bui = *(const LAS float*)(wl + s * S5_BUROW + (64 + lane) * 4);
            const float nr = ar * hr - ai * hi + bur, ni = ar * hi + ai * hr + bui; hr = nr; hi = ni;
            *(LAS bf16_t*)(hl + s * S5_HROW + lane * 2) = f2bf(hr); *(LAS bf16_t*)(hl + s * S5_HROW + (64 + lane) * 2) = f2bf(hi);
        }
        asm volatile("" ::: "memory");
        f32x4 y = (f32x4){0.f, 0.f, 0.f, 0.f};
#pragma unroll
        for (int kk = 0; kk < 4; ++kk) { const bf16x8 Bh = *(const LAS bf16x8*)(hl + st * S5_HROW + (kk * 32 + gq * 8) * 2);
            y = __builtin_amdgcn_mfma_f32_16x16x32_bf16(CCf[kk], Bh, y, 0, 0, 0); }
        { const int tok = tstart + sgn * (ch * 16 + st);
          *(u32x2*)(Yout + (size_t)tok * 1024 + g * 16 + gq * 4) = (u32x2){pk2(y[0], y[1]), pk2(y[2], y[3])}; }
        asm volatile("" ::: "memory");
        Uf = U1; U1 = U2; U2 = Un;
    }
    if (fre) { fre[lane] = hr; fim[lane] = hi; }
}

DI void s5_phase(const Ctx& F, const Params& P) {
    bf16_t* YF = (bf16_t*)(P.ws + WS_RB + RB_YF); bf16_t* YB = (bf16_t*)(P.ws + WS_RB + RB_YB);
    for (int cs = F.bid; cs < 256; cs += F.G) {
        if (F.wave < 4) { const int sc = cs * 4 + F.wave, dg = sc & 127, b = sc >> 7;
            s5_chain(F, P, dg, TP + b * 4096, LS, P.in[I_S5RE] + (size_t)sc * 64, P.in[I_S5IM] + (size_t)sc * 64, nullptr, nullptr, (dg >> 6) ? YB : YF); }
        else { for (int k = 0; k < 4; ++k) { const int pc = (cs * 4 + (F.wave - 4)) * 4 + k, dg = pc & 127, b = pc >> 7;
            s5_chain(F, P, dg, b * 256, LP, nullptr, nullptr, P.out + O_SR + (size_t)pc * 64, P.out + O_SI + (size_t)pc * 64, (dg >> 6) ? YB : YF); } }
    }
}

DI void s5_combine(const Ctx& F, const Params& P) {
    const bf16_t* PA = (const bf16_t*)(P.ws + WS_RA); const bf16_t* YF = (const bf16_t*)(P.ws + WS_RB + RB_YF); const bf16_t* YB = (const bf16_t*)(P.ws + WS_RB + RB_YB);
    bf16_t* Y = (bf16_t*)(P.ws + WS_RB + RB_Y); const float* dsk = P.in[I_S5D];
    for (size_t e = (size_t)F.bid * NTHR + F.tid; e < (size_t)TOK * 128; e += (size_t)F.G * NTHR) { const size_t T = e >> 7; const int c8 = (int)(e & 127) * 8;
        const u32x4 uv = *(const u32x4*)(PA + T * 4096 + c8), fv = *(const u32x4*)(YF + T * 1024 + c8), bv = *(const u32x4*)(YB + T * 1024 + c8);
        const f32x4 d0 = *(const f32x4*)(dsk + c8), d1 = *(const f32x4*)(dsk + c8 + 4);
        float o[8];
        o[0] = gelu_tanh(d0.x * bflo(uv.x) + bflo(fv.x) + bflo(bv.x)); o[1] = gelu_tanh(d0.y * bfhi(uv.x) + bfhi(fv.x) + bfhi(bv.x));
        o[2] = gelu_tanh(d0.z * bflo(uv.y) + bflo(fv.y) + bflo(bv.y)); o[3] = gelu_tanh(d0.w * bfhi(uv.y) + bfhi(fv.y) + bfhi(bv.y));
        o[4] = gelu_tanh(d1.x * bflo(uv.z) + bflo(fv.z) + bflo(bv.z)); o[5] = gelu_tanh(d1.y * bfhi(uv.z) + bfhi(fv.z) + bfhi(bv.z));
        o[6] = gelu_tanh(d1.z * bflo(uv.w) + bflo(fv.w) + bflo(bv.w)); o[7] = gelu_tanh(d1.w * bfhi(uv.w) + bfhi(fv.w) + bfhi(bv.w));
        u32x4 w; w.x = pk2(o[0], o[1]); w.y = pk2(o[2], o[3]); w.z = pk2(o[4], o[5]); w.w = pk2(o[6], o[7]);
        *(u32x4*)(Y + T * 1024 + c8) = w; }
}
constexpr int PS_KROW = 272;
constexpr int PS_IDX_OFF = 2 * 128 * PS_KROW;
constexpr int PS_TAB_OFF = PS_IDX_OFF + 512 * 32;

DI void topk_insert(float (&a)[16], float x) {
#pragma unroll
    for (int j = 15; j >= 1; --j) a[j] = __builtin_amdgcn_fmed3f(a[j - 1], a[j], x);
    a[0] = fmaxf(a[0], x);
}

DI void peer_select(const Ctx& F, const Params& P, int layer) {
    LAS unsigned char* lds = F.lds;
    const bf16_t* Q = (const bf16_t*)(P.ws + WS_RA + RA_Q);
    int* SELI = (int*)(P.ws + WS_RA + RA_SELI); float* SELW = (float*)(P.ws + WS_RA + RA_SELW);
    const bf16_t* KEYS = (const bf16_t*)(P.ws + WS_PKEYS) + (size_t)layer * 8 * 2 * 128 * 128;
    const int q = F.lane & 31, hh = F.lane >> 5;
    LAS unsigned char* myidx = lds + PS_IDX_OFF + F.tid * 32;
    LAS unsigned char* tab = lds + PS_TAB_OFF;
    for (int wu = F.bid; wu < 256; wu += F.G) {
        const int h = wu & 7, chunk = wu >> 3;
        __syncthreads();
        for (int id = F.tid; id < 2 * 128 * 16; id += NTHR) { const int row = id >> 4, c16 = id & 15;
            *(LAS u32x4*)(lds + row * PS_KROW + c16 * 16) = *(const u32x4*)(KEYS + ((size_t)h * 256 + row) * 128 + c16 * 8); }
        if (F.tid < 16) { int cnt = 0;
            for (int a = 0; a < F.tid; ++a) cnt += 16 / (a + 1);
            for (int b = 0; b < 16 / (F.tid + 1); ++b) { tab[(cnt + b) * 2] = (unsigned char)F.tid; tab[(cnt + b) * 2 + 1] = (unsigned char)b; } }
        __syncthreads();
        for (int blk = F.wave; blk < 40; blk += 8) {
            const int T0 = chunk * 1280 + blk * 32;
            float lst[2][16];
#pragma unroll
            for (int side = 0; side < 2; ++side) {
                bf16x8 Qf[8];
                const bf16_t* qp = Q + (size_t)(T0 + q) * 2048 + h * 256 + side * 128 + hh * 8;
#pragma unroll
                for (int ks = 0; ks < 8; ++ks) Qf[ks] = *(const bf16x8*)(qp + ks * 16);
                float a[16];
#pragma unroll
                for (int j = 0; j < 16; ++j) a[j] = -3.0e38f;
#pragma unroll
                for (int nt = 0; nt < 4; ++nt) {
                    f32x16 S;
#pragma unroll
                    for (int i = 0; i < 16; ++i) S[i] = 0.f;
#pragma unroll
                    for (int ks = 0; ks < 8; ++ks) { const bf16x8 A = *(const LAS bf16x8*)(lds + (side * 128 + nt * 32 + q) * PS_KROW + (ks * 16 + hh * 8) * 2);
                        S = __builtin_amdgcn_mfma_f32_32x32x16_bf16(A, Qf[ks], S, 0, 0, 0); }
#pragma unroll
                    for (int i = 0; i < 16; ++i) { const int n = nt * 32 + (i & 3) + 8 * (i >> 2) + 4 * hh;
                        topk_insert(a, __uint_as_float((__float_as_uint(S[i]) & 0xffffff80u) | (unsigned)n)); }
                }
                float pb[16];
#pragma unroll
                for (int j = 0; j < 16; ++j) pb[j] = __shfl_xor(a[j], 32);
#pragma unroll
                for (int j = 0; j < 16; ++j) topk_insert(a, pb[j]);
#pragma unroll
                for (int j = 0; j < 16; ++j) { lst[side][j] = a[j]; myidx[side * 16 + j] = (unsigned char)(__float_as_uint(a[j]) & 0x7fu); }
            }
            float cb[16];
#pragma unroll
            for (int j = 0; j < 16; ++j) cb[j] = -3.0e38f;
            { int cid = 0;
#pragma unroll
              for (int a = 0; a < 16; ++a)
#pragma unroll
                  for (int b = 0; b < 16 / (a + 1); ++b) {
                      const float sa = __uint_as_float(__float_as_uint(lst[0][a]) & 0xffffff80u), sb = __uint_as_float(__float_as_uint(lst[1][b]) & 0xffffff80u);
                      topk_insert(cb, __uint_as_float((__float_as_uint(sa + sb) & 0xffffffc0u) | (unsigned)cid)); ++cid; } }
            const float mx = __uint_as_float(__float_as_uint(cb[0]) & 0xffffffc0u);
            float e[16], den = 0.f;
#pragma unroll
            for (int j = 0; j < 16; ++j) { e[j] = __expf(__uint_as_float(__float_as_uint(cb[j]) & 0xffffffc0u) - mx); den += e[j]; }
            const float rden = 1.f / den;
#pragma unroll
            for (int j = 0; j < 16; ++j) {
                if ((j >> 3) == hh) { const int cid = (int)(__float_as_uint(cb[j]) & 0x3fu);
                    const int a = tab[cid * 2], b = tab[cid * 2 + 1];
                    const int eidx = (int)myidx[a] * 128 + (int)myidx[16 + b];
                    SELI[(size_t)(T0 + q) * 128 + h * 16 + j] = eidx; SELW[(size_t)(T0 + q) * 128 + h * 16 + j] = e[j] * rden; }
            }
        }
    }
    __syncthreads();
}

DI u32x16 fp6_unpack_bf16(u32x4 a, u32x2 b) { const u32x6 pk = {a.x, a.y, a.z, a.w, b.x, b.y}; return __builtin_bit_cast(u32x16, __builtin_amdgcn_cvt_scalef32_pk32_bf16_fp6(pk, 1.0f)); }
DI f32x32 fp6_unpack(u32x4 a, u32x2 b) { const u32x6 pk = {a.x, a.y, a.z, a.w, b.x, b.y}; return __builtin_amdgcn_cvt_scalef32_pk32_f32_fp6(pk, 1.0f); }
constexpr int GN = 8;
template <bool NEXTNORM>
DI void peer_gather(const Ctx& F, const Params& P, const float* modl, int layer, const float* ngain, const float* nmodl) {
    const bf16_t* H2 = (const bf16_t*)(P.ws + WS_HM);
    const unsigned char* TU = P.ws + WS_TBLU + (size_t)layer * 16384 * PT_ROWB; const unsigned char* TV = P.ws + WS_TBLV + (size_t)layer * 16384 * PT_ROWB;
    const float* SCU = (const float*)(P.ws + WS_SC) + layer * 16384; const float* SCV = (const float*)(P.ws + WS_SC) + (2 + layer) * 16384;
    const int* SELI = (const int*)(P.ws + WS_RA + RA_SELI); const float* SELW = (const float*)(P.ws + WS_RA + RA_SELW);
    float* X = P.out + O_Y;
    const int lane = lane_id();
    for (int T = F.bid * 8 + F.wave; T < TOK; T += F.G * 8) {
        u32x4 xw[4];
#pragma unroll
        for (int q4 = 0; q4 < 4; ++q4) xw[q4] = *(const u32x4*)(H2 + (size_t)T * DM + lane * 32 + q4 * 8);
        const int e0 = SELI[(size_t)T * 128 + lane], e1 = SELI[(size_t)T * 128 + 64 + lane];
        const float g0 = SELW[(size_t)T * 128 + lane], g1 = SELW[(size_t)T * 128 + 64 + lane];
        float d0 = 0.f, d1 = 0.f;
#pragma unroll 1
        for (int kb = 0; kb < 128; kb += GN) {
            u32x4 ura[GN]; u32x2 urb[GN];
#pragma unroll
            for (int j = 0; j < GN; ++j) { const int k = kb + j; const int e = __builtin_amdgcn_readlane(k < 64 ? e0 : e1, k & 63);
                const unsigned char* up = TU + (size_t)e * PT_ROWB;
                ura[j] = *(const u32x4*)(up + lane * 16); urb[j] = *(const u32x2*)(up + 1024 + lane * 8); }
#pragma unroll
            for (int j = 0; j < GN; ++j) { const u32x16 r = fp6_unpack_bf16(ura[j], urb[j]);
                float sa = 0.f, sb = 0.f, sc2 = 0.f, sd = 0.f;
#pragma unroll
                for (int i = 0; i < 4; ++i) { const unsigned x0 = xw[i].x, x1 = xw[i].y, x2 = xw[i].z, x3 = xw[i].w;
                    sa = dot2bf(r[4 * i], x0, sa); sb = dot2bf(r[4 * i + 1], x1, sb); sc2 = dot2bf(r[4 * i + 2], x2, sc2); sd = dot2bf(r[4 * i + 3], x3, sd); }
                const float sm = wave_sum((sa + sb) + (sc2 + sd)); const int k = kb + j;
                if (k < 64) { if (lane == k) d0 = sm; } else { if (lane == k - 64) d1 = sm; } }
        }
        const float cf0 = g0 * gelu_tanh(d0 * SCU[e0]) * SCV[e0], cf1 = g1 * gelu_tanh(d1 * SCU[e1]) * SCV[e1];
        f32x2 acc[16];
#pragma unroll
        for (int i = 0; i < 16; ++i) acc[i] = (f32x2){0.f, 0.f};
#pragma unroll 1
        for (int kb = 0; kb < 128; kb += GN) {
            u32x4 vra[GN]; u32x2 vrb[GN]; float cf[GN];
#pragma unroll
            for (int j = 0; j < GN; ++j) { const int k = kb + j; const int e = __builtin_amdgcn_readlane(k < 64 ? e0 : e1, k & 63);
                cf[j] = __builtin_bit_cast(float, __builtin_amdgcn_readlane(__builtin_bit_cast(int, k < 64 ? cf0 : cf1), k & 63));
                const unsigned char* vp = TV + (size_t)e * PT_ROWB;
                vra[j] = *(const u32x4*)(vp + lane * 16); vrb[j] = *(const u32x2*)(vp + 1024 + lane * 8); }
#pragma unroll
            for (int j = 0; j < GN; ++j) { const f32x32 r = fp6_unpack(vra[j], vrb[j]);
                const f32x2 c2 = (f32x2){cf[j], cf[j]};
#pragma unroll
                for (int i = 0; i < 16; ++i) acc[i] += c2 * (f32x2){r[2 * i], r[2 * i + 1]}; }
        }
        const float* gate = modl + (size_t)(cond_of(T) * 6 + 5) * DM;
        f32x4 xn[8]; float ss = 0.f;
#pragma unroll
        for (int q4 = 0; q4 < 8; ++q4) { const int col = lane * 32 + q4 * 4; float* xp = X + (size_t)T * DM + col;
            const f32x4 gv = *(const f32x4*)(gate + col), x0 = *(const f32x4*)(xp);
            const f32x4 r = x0 + gv * (f32x4){acc[q4 * 2].x, acc[q4 * 2].y, acc[q4 * 2 + 1].x, acc[q4 * 2 + 1].y};
            *(f32x4*)(xp) = r; xn[q4] = r; ss += r.x * r.x + r.y * r.y + r.z * r.z + r.w * r.w; }
        if (NEXTNORM) {
            ss = wave_sum(ss);
            const float rstd = rsqrtf(ss * (1.f / DM) + NORM_EPS);
            const float* sh = nmodl + (size_t)(cond_of(T) * 6 + 0) * DM; const float* sc = sh + DM;
            bf16_t* H = (bf16_t*)(P.ws + WS_HM);
#pragma unroll
            for (int q4 = 0; q4 < 8; ++q4) { const int col = lane * 32 + q4 * 4;
                const f32x4 g4 = *(const f32x4*)(ngain + col), s4 = *(const f32x4*)(sc + col), h4 = *(const f32x4*)(sh + col);
                const f32x4 o = xn[q4] * rstd * g4 * (s4 + 1.f) + h4;
                *(u32x2*)(H + (size_t)T * DM + col) = (u32x2){pk2(o.x, o.y), pk2(o.z, o.w)}; }
        }
    }
}
constexpr int NPHASE = 22;

__global__ void __launch_bounds__(NTHR, 2) mega(Params P) {
    extern __shared__ __attribute__((aligned(16))) unsigned char lds_raw[];
    Ctx F;
    F.lds = (LAS unsigned char*)lds_raw; F.tid = threadIdx.x; F.lane = F.tid & 63; F.wave = __builtin_amdgcn_readfirstlane(F.tid >> 6); F.G = gridDim.x; F.bid = blockIdx.x;
    const int lo = P.ph_lo, hi = P.ph_hi;
    volatile LAS unsigned* xbw = (volatile LAS unsigned*)(F.lds + LDS_BYTES - 16);
    if (F.tid == 0) { xbw[0] = 0u; xbw[1] = 0u; xbw[2] = 0u; xbw[3] = 0u; }
    __syncthreads();
    if (hi - lo > 1) (void)xcd_barrier_post((unsigned*)(P.ws + WS_CTL), xbw);
#define GRID_BARRIER() do { XcdBarrier bar_; bar_.bar = (unsigned*)(P.ws + WS_CTL); bar_.x = xb_xcc_id(); bar_.st = (volatile LAS unsigned*)(F.lds + LDS_BYTES - 16); xcd_barrier(bar_); } while (0)
#define PH(k, ...) if (lo <= (k) && (k) < hi) { { __VA_ARGS__ } if ((k) + 1 < hi) GRID_BARRIER(); }
#define MOD0 ((const float*)(P.ws + WS_MOD))
#define MOD1 ((const float*)(P.ws + WS_MOD) + 9 * 12288)
#define HM ((bf16_t*)(P.ws + WS_HM))
#define RA ((bf16_t*)(P.ws + WS_RA))
#define X (P.out + O_Y)

    PH(0, prologue(F, P);)
    PH(1, adaln_reduce(F, P);)
    PH(2, norm_phase(F, P.in[I_XP], P.in[I_XS], P.in[I_NMIXG], MOD0, 0, HM);)
    PH(3, { EpiBf16 E{RA, 4096}; run_gemm(F, HM, (const bf16_t*)(P.ws + WS_WEVIN) + (size_t)2048 * 2048, 4096, 2048, E); })
    PH(4, prep_a(F, P);)
    PH(5, { EpiBf16 E{RA, 2048}; run_gemm(F, HM, (const bf16_t*)(P.ws + WS_WEVIN), 2048, 2048, E); })
    PH(6, attn_phase<0>(F, P); attn_phase<1>(F, P); hyena_phase(F, P);)
    PH(7, hyena_post(F, P);)
    PH(8, { EpiResid E{P.in[I_XP], P.in[I_XS], X, MOD0, 2}; run_gemm(F, HM, (const bf16_t*)(P.ws + WS_WEVOUT), 2048, 2048, E); })
    PH(9, norm_phase(F, X, X + (size_t)TP * DM, P.in[I_NFFNG], MOD0, 3, HM);)
    PH(10, { EpiBf16 E{RA, 2048}; run_gemm(F, HM, (const bf16_t*)(P.ws + WS_WPQ), 2048, 2048, E); })
    PH(11, peer_select(F, P, 0);)
    PH(12, peer_gather<true>(F, P, MOD0, 0, P.in[I_NMIXG] + DM, MOD1);)
    PH(13, { EpiBf16 E{RA, 4096}; run_gemm(F, HM, (const bf16_t*)(P.ws + WS_WODIN), 4096, 2048, E); })
    PH(14, prep_c(F, P); s5_phase(F, P);)
    PH(15, attn_phase<2>(F, P); attn_phase<3>(F, P); s5_combine(F, P);)
    PH(16, { EpiGlu E{(const bf16_t*)(P.ws + WS_RB + RB_Y), HM, P.in[I_GLUB]}; run_gemm(F, (const bf16_t*)(P.ws + WS_RB + RB_Y), (const bf16_t*)(P.ws + WS_WGLU), 1024, 1024, E); })
    PH(17, { EpiResid E{X, X + (size_t)TP * DM, X, MOD1, 2}; run_gemm(F, HM, (const bf16_t*)(P.ws + WS_WODOUT), 2048, 2048, E); })
    PH(18, norm_phase(F, X, X + (size_t)TP * DM, P.in[I_NFFNG] + DM, MOD1, 3, HM);)
    PH(19, { EpiBf16 E{RA, 2048}; run_gemm(F, HM, (const bf16_t*)(P.ws + WS_WPQ) + (size_t)2048 * 2048, 2048, 2048, E); })
    PH(20, peer_select(F, P, 1);)
    PH(21, peer_gather<false>(F, P, MOD1, 1, nullptr, nullptr);)
#undef MOD0
#undef MOD1
#undef HM
#undef RA
#undef X
#undef PH
#undef GRID_BARRIER
}

extern "C" void kernel_launch(void* const* d_in, const int* in_sizes, int n_in, void* d_out, int out_size, void* d_ws, size_t ws_size, hipStream_t stream) {
    static int grid = 0;
    if (grid == 0) {
        if (n_in != N_IN || (size_t)out_size != O_END || ws_size < WS_END) { fprintf(stderr, "kernel_launch: unexpected shapes (n_in %d, out %d, ws %zu, need %zu)\n", n_in, out_size, ws_size, (size_t)WS_END); grid = -1; return; }
        int dev = 0, cus = 0;
        if (hipGetDevice(&dev) != hipSuccess || hipDeviceGetAttribute(&cus, hipDeviceAttributeMultiprocessorCount, dev) != hipSuccess) { grid = -1; return; }
        if (hipFuncSetAttribute((const void*)mega, hipFuncAttributeMaxDynamicSharedMemorySize, LDS_BYTES) != hipSuccess) { fprintf(stderr, "kernel_launch: hipFuncSetAttribute failed\n"); grid = -1; return; }
        int per_cu = 0;
        if (hipOccupancyMaxActiveBlocksPerMultiprocessor(&per_cu, (const void*)mega, NTHR, LDS_BYTES) != hipSuccess || per_cu < 1) { fprintf(stderr, "kernel_launch: occupancy query says %d blocks per CU\n", per_cu); }
        (void)hipGetLastError();
        grid = cus;
    }
    if (grid < 0) return;
    (void)hipMemsetAsync((char*)d_ws + WS_CTL, 0, 65536, stream);
    Params p; memset(&p, 0, sizeof(p));
    for (int i = 0; i < N_IN; ++i) p.in[i] = (const float*)d_in[i];
    p.out = (float*)d_out; p.ws = (unsigned char*)d_ws;
    p.ph_lo = 0; p.ph_hi = NPHASE;
    hipLaunchKernelGGL(mega, dim3(grid), dim3(NTHR), LDS_BYTES, stream, p);
}
```

```cpp
#include <hip/hip_runtime.h>
#include <cstdio>
#include <cstring>
#include <cstdint>

typedef unsigned short bf16_t;
typedef short bf16x8 __attribute__((ext_vector_type(8)));
typedef short s16x4 __attribute__((ext_vector_type(4)));
typedef float f32x2 __attribute__((ext_vector_type(2)));
typedef float f32x4 __attribute__((ext_vector_type(4)));
typedef float f32x16 __attribute__((ext_vector_type(16)));
typedef unsigned u32x2 __attribute__((ext_vector_type(2)));
typedef unsigned u32x4 __attribute__((ext_vector_type(4)));
typedef __bf16 bf16x2_t __attribute__((ext_vector_type(2)));
typedef float f32x32 __attribute__((ext_vector_type(32)));
typedef unsigned u32x6 __attribute__((ext_vector_type(6)));
typedef unsigned u32x16 __attribute__((ext_vector_type(16)));
typedef __bf16 bf16x32_t __attribute__((ext_vector_type(32)));

#define DI __device__ __forceinline__

constexpr int NTHR = 512;
constexpr int DM = 2048;
constexpr int TP = 8192;
constexpr int TS = 32768;
constexpr int TOK = TP + TS;
constexpr int LP = 256, LS = 4096;
constexpr float NORM_EPS = 1e-6f;
constexpr float LOG2E = 1.4426950408889634f;

enum { I_XP = 0, I_XS, I_C, I_CNK, I_CNV, I_CDK, I_CDV, I_S5RE, I_S5IM, I_CCTX, I_MODW, I_MODB, I_NMIXG, I_NFFNG, I_EVWIN, I_EVWOUT, I_NAQG, I_NAKG, I_RPB,
       I_HYCW, I_HYCB, I_HYW1, I_HYB1, I_HYF1, I_HYW2, I_HYB2, I_HYF2, I_HYW3, I_HYDEC, I_HYBIAS, I_ODWIN, I_ODWOUT, I_S5LRE, I_S5LIM, I_S5LDT, I_S5BRE, I_S5BIM,
       I_S5CRE, I_S5CIM, I_S5D, I_GLUW, I_GLUB, I_DQG, I_DKG, I_LQ1, I_LK1, I_LQ2, I_LK2, I_SUBG, I_PWQ, I_PKEYS, I_PU, I_PV, N_IN };

constexpr size_t O_Y = 0;
constexpr size_t O_NAK = 83886080, O_NAV = 92274688, O_DK = 100663296, O_DV = 109051904, O_SR = 117440512, O_SI = 117702656, O_END = 117964800;

constexpr size_t al256(size_t x) { return (x + 255) & ~(size_t)255; }
constexpr size_t WS_CTL = 0;
constexpr size_t WS_MODP = 65536;
constexpr size_t WS_MOD = WS_MODP + (size_t)2 * 16 * 9 * 12288 * 4;
constexpr size_t WS_WEVIN = al256(WS_MOD + (size_t)2 * 9 * 12288 * 4);
constexpr size_t WS_WEVOUT = WS_WEVIN + (size_t)6144 * 2048 * 2;
constexpr size_t WS_WODIN = WS_WEVOUT + (size_t)2048 * 2048 * 2;
constexpr size_t WS_WODOUT = WS_WODIN + (size_t)4096 * 2048 * 2;
constexpr size_t WS_WPQ = WS_WODOUT + (size_t)2048 * 2048 * 2;
constexpr size_t WS_WGLU = WS_WPQ + (size_t)2 * 2048 * 2048 * 2;
constexpr size_t WS_PKEYS = WS_WGLU + (size_t)1024 * 1024 * 2;
constexpr size_t WS_CNK = WS_PKEYS + (size_t)2 * 8 * 2 * 128 * 128 * 2;
constexpr size_t WS_CNVT = WS_CNK + (size_t)8 * 256 * 1024 * 2;
constexpr size_t WS_CDK = WS_CNVT + (size_t)8 * 256 * 1024 * 2;
constexpr size_t WS_CDVT = WS_CDK + (size_t)8 * 256 * 1024 * 2;
constexpr size_t WS_S5A = WS_CDVT + (size_t)8 * 256 * 1024 * 2;
constexpr size_t WS_S5BB = WS_S5A + (size_t)128 * 64 * 2 * 4;
constexpr size_t WS_S5CC = WS_S5BB + (size_t)128 * 128 * 16 * 2;
constexpr int KRL_S = 8208, KRL_P = 528;
constexpr size_t WS_KRS = WS_S5CC + (size_t)128 * 16 * 128 * 2;
constexpr size_t WS_KRP = al256(WS_KRS + (size_t)2 * 1024 * KRL_S * 2);
constexpr size_t WS_TBLU = al256(WS_KRP + (size_t)2 * 1024 * KRL_P * 2);
constexpr size_t WS_TBLV = WS_TBLU + (size_t)16384 * 2048 * 2;
constexpr size_t WS_HM = WS_TBLV + (size_t)16384 * 2048 * 2;
constexpr size_t WS_RA = WS_HM + (size_t)TOK * 2048 * 2;
constexpr size_t WS_RB = WS_RA + (size_t)TOK * 4096 * 2;
constexpr size_t WS_VT = WS_RB + (size_t)3072 * TOK * 2;
constexpr size_t WS_SC = WS_VT + (size_t)TOK * 1024 * 2;
constexpr size_t WS_END = WS_SC + (size_t)4 * 16384 * 4;
constexpr size_t RA_Q = 0;
constexpr size_t RA_SELI = (size_t)TOK * 2048 * 2;
constexpr size_t RA_SELW = RA_SELI + (size_t)TOK * 128 * 4;
constexpr size_t RA_CF = RA_SELW + (size_t)TOK * 128 * 4;
constexpr size_t RA_ZC = (size_t)TOK * 2048 * 2;
constexpr size_t RB_YF = 0, RB_YB = (size_t)TOK * 1024 * 2, RB_Y = (size_t)2 * TOK * 1024 * 2;
constexpr size_t VT_S = (size_t)TP * 1024 * 2;

constexpr int LDS_BYTES = 147456;

struct Params { const float* in[N_IN]; float* out; unsigned char* ws; int ph_lo, ph_hi; };

DI float bf2f(bf16_t b) { return __uint_as_float(((unsigned)b) << 16); }
DI float bflo(unsigned w) { return __uint_as_float(w << 16); }
DI float bfhi(unsigned w) { return __uint_as_float(w & 0xffff0000u); }
DI unsigned pk2(float a, float b) { f32x2 v = {a, b}; return __builtin_bit_cast(unsigned, __builtin_convertvector(v, bf16x2_t)); }
DI float dot2bf(unsigned a, unsigned b, float c) { return __builtin_amdgcn_fdot2_f32_bf16(__builtin_bit_cast(bf16x2_t, a), __builtin_bit_cast(bf16x2_t, b), c, false); }
DI bf16_t f2bf(float a) { return (bf16_t)(pk2(a, 0.f) & 0xffffu); }
DI float dpp_xor1(float v) { return __builtin_bit_cast(float, __builtin_amdgcn_update_dpp(0, __builtin_bit_cast(int, v), 0xB1, 0xF, 0xF, true)); }
DI float dpp_xor2(float v) { return __builtin_bit_cast(float, __builtin_amdgcn_update_dpp(0, __builtin_bit_cast(int, v), 0x4E, 0xF, 0xF, true)); }
DI float wave_sum(float v) {
    v += dpp_xor1(v); v += dpp_xor2(v);
    v += __builtin_bit_cast(float, __builtin_amdgcn_update_dpp(0, __builtin_bit_cast(int, v), 0x141, 0xF, 0xF, true));
    v += __builtin_bit_cast(float, __builtin_amdgcn_update_dpp(0, __builtin_bit_cast(int, v), 0x140, 0xF, 0xF, true));
    v += __builtin_bit_cast(float, __builtin_amdgcn_update_dpp(0, __builtin_bit_cast(int, v), 0x142, 0xA, 0xF, false));
    v += __builtin_bit_cast(float, __builtin_amdgcn_update_dpp(0, __builtin_bit_cast(int, v), 0x143, 0xC, 0xF, false));
    return __builtin_bit_cast(float, __builtin_amdgcn_readlane(__builtin_bit_cast(int, v), 63));
}
DI float gelu_tanh(float x) {
    const float u = 0.7978845608028654f * (x + 0.044715f * x * x * x);
    const float e = __expf(2.f * u);
    const float t = 1.f - 2.f / (e + 1.f);
    return 0.5f * x * (1.f + t);
}
DI float wave_max(float v) {
    v = fmaxf(v, dpp_xor1(v)); v = fmaxf(v, dpp_xor2(v));
    v = fmaxf(v, __builtin_bit_cast(float, __builtin_amdgcn_update_dpp(0, __builtin_bit_cast(int, v), 0x141, 0xF, 0xF, true)));
    v = fmaxf(v, __builtin_bit_cast(float, __builtin_amdgcn_update_dpp(0, __builtin_bit_cast(int, v), 0x140, 0xF, 0xF, true)));
    v = fmaxf(v, __builtin_bit_cast(float, __builtin_amdgcn_update_dpp(0, __builtin_bit_cast(int, v), 0x142, 0xA, 0xF, false)));
    v = fmaxf(v, __builtin_bit_cast(float, __builtin_amdgcn_update_dpp(0, __builtin_bit_cast(int, v), 0x143, 0xC, 0xF, false)));
    return __builtin_bit_cast(float, __builtin_amdgcn_readlane(__builtin_bit_cast(int, v), 63));
}
DI f32x2 fp8x2_lo(unsigned w) { return __builtin_amdgcn_cvt_pk_f32_fp8((int)w, false); }
DI f32x2 fp8x2_hi(unsigned w) { return __builtin_amdgcn_cvt_pk_f32_fp8((int)w, true); }
DI unsigned pk_fp8x4(float a, float b, float c, float d) { int r = 0; r = __builtin_amdgcn_cvt_pk_fp8_f32(a, b, r, false); r = __builtin_amdgcn_cvt_pk_fp8_f32(c, d, r, true); return (unsigned)r; }
DI int lane_id() { return (int)__builtin_amdgcn_mbcnt_hi(~0u, __builtin_amdgcn_mbcnt_lo(~0u, 0u)); }
DI int cond_of(int T) { return T < TP ? 0 : 1 + ((T - TP) >> 12); }
#define XB_TMO      128
#define XB_XCNT(j)  (256  + 64 * (j))
#define XB_XSUB(j)  (1280 + 64 * (j))
#define XB_XGEN(j)  (2304 + 64 * (j))
#define XB_TOP      3328
#define XB_TOPGEN   3392
#define XCD_BAR_WORDS 3456
#define XB_SPIN_CAP (1u << 26)
#define LAS __attribute__((address_space(3)))

__device__ __forceinline__ unsigned xb_ld(unsigned* p)              { return __hip_atomic_load(p, __ATOMIC_RELAXED, __HIP_MEMORY_SCOPE_AGENT); }
__device__ __forceinline__ unsigned xb_add(unsigned* p, unsigned v) { return __hip_atomic_fetch_add(p, v, __ATOMIC_RELAXED, __HIP_MEMORY_SCOPE_AGENT); }
__device__ __forceinline__ unsigned xb_xcc_id() { return (unsigned)__builtin_amdgcn_s_getreg((3 << 11) | 20) & 0xFu; }
#define XB_SPIN(cond, bar) do { unsigned _sp = 0; while (cond) { __builtin_amdgcn_s_sleep(1); \
    if ((++_sp & 255u) == 0u) { if (xb_ld(&(bar)[XB_TMO])) break; if (_sp > XB_SPIN_CAP) { atomicAdd(&(bar)[XB_TMO], 1u); break; } } } } while (0)

struct XcdBarrier {
    unsigned* bar; unsigned x;
    volatile LAS unsigned* st;
};

__device__ __forceinline__ XcdBarrier xcd_barrier_post(unsigned* bar, volatile LAS unsigned* st) {
    XcdBarrier b; b.bar = bar; b.x = xb_xcc_id(); b.st = st;
    if (threadIdx.x == 0) (void)xb_add(&bar[XB_XCNT(b.x)], 1u);
    return b;
}
__device__ __forceinline__ void xcd_barrier_complete(unsigned* bar, unsigned x, unsigned& nloc, unsigned& nx) {
    const unsigned G = gridDim.x * gridDim.y * gridDim.z;
    unsigned sum, cnt, mine, sp = 0u;
    for (;;) {
        sum = 0u; cnt = 0u; mine = 0u;
#pragma unroll
        for (unsigned j = 0; j < 16; ++j) { const unsigned c = xb_ld(&bar[XB_XCNT(j)]); sum += c; cnt += (c > 0u) ? 1u : 0u; mine = (j == x) ? c : mine; }
        if (sum == G) break;
        __builtin_amdgcn_s_sleep(1);
        if ((++sp & 255u) == 0u) { if (xb_ld(&bar[XB_TMO])) break; if (sp > XB_SPIN_CAP) { atomicAdd(&bar[XB_TMO], 1u); break; } }
    }
    nloc = mine > 0u ? mine : 1u; nx = cnt > 0u ? cnt : 1u;
}

__device__ __forceinline__ void xcd_barrier(const XcdBarrier& b) {
    asm volatile("s_waitcnt vmcnt(0)" ::: "memory");
    __syncthreads();
    if (threadIdx.x == 0) {
        unsigned* bar = b.bar;
        __builtin_amdgcn_s_waitcnt(0);
        unsigned nloc = b.st[0], nx = b.st[1];
        if (nloc == 0u) { xcd_barrier_complete(bar, b.x, nloc, nx); b.st[0] = nloc; b.st[1] = nx; }
        const unsigned old = xb_add(&bar[XB_XSUB(b.x)], 1u);
        const unsigned gen = old / nloc;
        if (old + 1u == (gen + 1u) * nloc) {
            __builtin_amdgcn_fence(__ATOMIC_RELEASE, "agent");
            asm volatile("s_waitcnt vmcnt(0)" ::: "memory");
            const unsigned og = xb_add(&bar[XB_TOP], 1u);
            const unsigned tg = og / nx;
            if (og + 1u == (tg + 1u) * nx) xb_add(&bar[XB_TOPGEN], 1u);
            else XB_SPIN(xb_ld(&bar[XB_TOPGEN]) == tg, bar);
            __builtin_amdgcn_fence(__ATOMIC_ACQUIRE, "agent");
            xb_add(&bar[XB_XGEN(b.x)], 1u);
            asm volatile("s_waitcnt vmcnt(0)" ::: "memory");
        } else {
            XB_SPIN(xb_ld(&bar[XB_XGEN(b.x)]) == gen, bar);
            __builtin_amdgcn_fence(__ATOMIC_ACQUIRE, "agent");
            asm volatile("s_waitcnt vmcnt(0)" ::: "memory");
        }
    }
    __syncthreads();
}
namespace pg8 {
#define PG8_LAS __attribute__((address_space(3)))
typedef unsigned short bf16_t;
typedef short bf16x8 __attribute__((ext_vector_type(8)));
typedef float f32x4 __attribute__((ext_vector_type(4)));
typedef unsigned u32x4 __attribute__((ext_vector_type(4)));
constexpr int BM = 256, BK = 64, HALF = 128, HTB = HALF * BK * 2  , STAGE_BYTES = 8 * HTB, NXCD = 8, WGM = 8;

__host__ __device__ __forceinline__ int lds_byte(int r, int c) { const int st = (r >> 4) * 2 + (c >> 5), rr = r & 15, cc = c & 31, ob = rr * 64 + cc * 2; return st * 1024 + (ob ^ (((ob >> 9) & 1) << 5)); }
__host__ __device__ __forceinline__ void stage_rc(int b, int& R, int& C) { const int st = b / 1024, sb = b % 1024, swz = sb ^ (((sb >> 9) & 1) << 5); R = (st >> 1) * 16 + swz / 64; C = (st & 1) * 32 + (swz % 64) / 2; }
__host__ __device__ __forceinline__ int perm32(int rho) { const int n = rho >> 4, i = rho & 15; return 8 * (i >> 2) + 4 * n + (i & 3); }

struct Unit { int pm, pn; };
struct Gemm { const bf16_t* A; const bf16_t* Bt; int M, N, K; };

struct StaticOrder {
    int nM, nN, nwg, G, c;
    __host__ __device__ void init(int M, int N, int G_, int c_) { nM = M / BM; nN = N / BM; nwg = nM * nN; G = G_; c = c_; }
    __host__ __device__ bool next(int i, Unit& u) const {
        const long L = (long)i * G + c; if (L >= nwg) return false;
        int wgid = (int)L; { const int q = nwg / NXCD, r = nwg % NXCD, xcd = wgid % NXCD, off = wgid / NXCD; wgid = (xcd < r ? xcd * (q + 1) : r * (q + 1) + (xcd - r) * q) + off; }
        const int nig = WGM * nN, gid = wgid / nig, fm = gid * WGM, gsz = (nM - fm) < WGM ? (nM - fm) : WGM;
        u.pm = fm + ((wgid % nig) % gsz); u.pn = (wgid % nig) / gsz; return true;
    }
    __device__ __forceinline__ void a_ready(const Unit&) const {}
    __device__ __forceinline__ void done(const Unit&) const {}
};
__device__ __forceinline__ unsigned cvt_pk_bf16(float lo, float hi) { unsigned r; asm volatile("v_cvt_pk_bf16_f32 %0, %1, %2" : "=v"(r) : "v"(lo), "v"(hi)); return r; }
template <class Epi, class Sched, bool STAMP = false>
__device__ __forceinline__ void gemm_phase(PG8_LAS unsigned char* lds, const Gemm g, const Sched& S, const Epi& E, unsigned long long* stamps) {
    const int tid = threadIdx.x, wid = __builtin_amdgcn_readfirstlane(tid >> 6), lane = tid & 63, wr = wid >> 2, wc = wid & 3, fr = lane & 15, fq = lane >> 4;
    const int K = g.K, nt = K / BK;
    int ts_lo = 0, ts_hi = 0, nts = 0; const unsigned long long rt_entry = STAMP ? (unsigned long long)wall_clock64() : 0ull;
#define PG8_STAMP() do { if (STAMP && wid == 0 && nts < 64) { const unsigned long long _c = (unsigned long long)clock64(); \
        ts_lo = (lane == nts) ? (int)(unsigned)_c : ts_lo; ts_hi = (lane == nts) ? (int)(unsigned)(_c >> 32) : ts_hi; ++nts; } } while (0)
    PG8_STAMP();
    unsigned voffA[2], voffB[2];
#pragma unroll
    for (int i = 0; i < 2; ++i) { int R, C; stage_rc(tid * 16 + i * 8192, R, C); const int Rb = Epi::PERM ? ((R & ~31) + perm32(R & 31)) : R;
        voffA[i] = (unsigned)(R * K + C) * 2u; voffB[i] = (unsigned)(Rb * K + C) * 2u; }
    const size_t kstep = (size_t)(BK * 2);
    const size_t hstep = (size_t)HALF * K * 2;
    const size_t tstep = 2 * hstep;
    const unsigned ldsw = (unsigned)wid * 1024u;
    const int aoff = lds_byte(wr * 64 + fr, fq * 8), boff = lds_byte(wc * 32 + fr, fq * 8);
#define PG8_SA(b, h) (((b) * 2 + (h)) * HTB)
#define PG8_SB(b, h) ((4 + (b) * 2 + (h)) * HTB)
#define PG8_STAGE(bufoff, gbase, voff) do { _Pragma("unroll") for (int _i = 0; _i < 2; ++_i) \
        __builtin_amdgcn_global_load_lds((const unsigned*)((const char*)(gbase) + (voff)[_i]), (PG8_LAS unsigned*)(lds + (bufoff) + ldsw + _i * 8192), 16, 0, 0); } while (0)
#define PG8_LDA(dst, b, h) do { _Pragma("unroll") for (int m = 0; m < 4; ++m) _Pragma("unroll") for (int k = 0; k < 2; ++k) dst[m][k] = *(const PG8_LAS bf16x8*)(lds + PG8_SA(b, h) + aoff + m * 2048 + k * 1024); } while (0)
#define PG8_LDB(dst, b, h) do { _Pragma("unroll") for (int n = 0; n < 2; ++n) _Pragma("unroll") for (int k = 0; k < 2; ++k) dst[n][k] = *(const PG8_LAS bf16x8*)(lds + PG8_SB(b, h) + boff + n * 2048 + k * 1024); } while (0)
#define PG8_MMA(ai, bj, At, Bt) do { __builtin_amdgcn_s_setprio(1); _Pragma("unroll") for (int m = 0; m < 4; ++m) _Pragma("unroll") for (int n = 0; n < 2; ++n) _Pragma("unroll") for (int k = 0; k < 2; ++k) \
        acc[ai][bj][m][n] = __builtin_amdgcn_mfma_f32_16x16x32_bf16(Bt[n][k], At[m][k], acc[ai][bj][m][n], 0, 0, 0); __builtin_amdgcn_s_setprio(0); } while (0)
#define PG8_WAIT_V(n) asm volatile("s_waitcnt vmcnt(" #n ")" ::: "memory")
#define PG8_WAIT_L(n) asm volatile("s_waitcnt lgkmcnt(" #n ")" ::: "memory")
#define PG8_BAR __builtin_amdgcn_s_barrier()
#define PG8_SCHED __builtin_amdgcn_sched_barrier(0)
    Unit cur, nxt; int ui = 0;
    if (!S.next(0, cur)) return;
    f32x4 acc[2][2][4][2];
#pragma unroll
    for (int a = 0; a < 2; ++a)
#pragma unroll
        for (int b = 0; b < 2; ++b)
#pragma unroll
            for (int m = 0; m < 4; ++m)
#pragma unroll
                for (int n = 0; n < 2; ++n) acc[a][b][m][n] = (f32x4){0.f, 0.f, 0.f, 0.f};
    bf16x8 At[4][2], B0[2][2], B1[2][2];
    const char* cA = (const char*)g.A + (size_t)cur.pm * tstep; const char* cB = (const char*)g.Bt + (size_t)cur.pn * tstep;
    S.a_ready(cur);
    PG8_STAGE(PG8_SB(0, 0), cB, voffB); PG8_STAGE(PG8_SA(0, 0), cA, voffA); PG8_STAGE(PG8_SB(0, 1), cB + hstep, voffB); PG8_STAGE(PG8_SA(0, 1), cA + hstep, voffA);
    if (wr == 1) PG8_BAR;
    PG8_WAIT_V(4); PG8_BAR;
    PG8_STAGE(PG8_SB(1, 0), cB + kstep, voffB); PG8_STAGE(PG8_SA(1, 0), cA + kstep, voffA); PG8_STAGE(PG8_SB(1, 1), cB + hstep + kstep, voffB);
    PG8_WAIT_V(6); PG8_BAR;
    PG8_STAMP();
    for (;;) {
        const bool has_next = S.next(ui + 1, nxt);
        const char* nA = has_next ? (const char*)g.A + (size_t)nxt.pm * tstep : cA; const char* nB = has_next ? (const char*)g.Bt + (size_t)nxt.pn * tstep : cB;
        for (int t = 0; t < nt; t += 2) {
            const bool last = (t == nt - 2);
            const char* a1 = cA + (size_t)(t + 1) * kstep;
            const char* a2 = last ? nA : cA + (size_t)(t + 2) * kstep; const char* b2 = last ? nB : cB + (size_t)(t + 2) * kstep;
            const char* a3 = a2 + kstep; const char* b3 = b2 + kstep;
            if (last && has_next) S.a_ready(nxt);
            PG8_LDB(B0, 0, 0); PG8_SCHED; PG8_LDA(At, 0, 0); PG8_STAGE(PG8_SA(1, 1), a1 + hstep, voffA);
            PG8_WAIT_L(8); PG8_BAR; PG8_WAIT_L(0); PG8_MMA(0, 0, At, B0); PG8_BAR; PG8_SCHED;
            PG8_LDB(B1, 0, 1); PG8_STAGE(PG8_SB(0, 0), b2, voffB);
            PG8_BAR; PG8_WAIT_L(0); PG8_MMA(0, 1, At, B1); PG8_BAR;
            PG8_LDA(At, 0, 1); PG8_STAGE(PG8_SA(0, 0), a2, voffA);
            PG8_BAR; PG8_WAIT_L(0); PG8_MMA(1, 0, At, B0); PG8_BAR; PG8_SCHED;
            PG8_STAGE(PG8_SB(0, 1), b2 + hstep, voffB);
            PG8_WAIT_V(6); PG8_BAR; PG8_MMA(1, 1, At, B1); PG8_BAR;
            PG8_LDB(B0, 1, 0); PG8_SCHED; PG8_LDA(At, 1, 0); PG8_STAGE(PG8_SA(0, 1), a2 + hstep, voffA);
            PG8_WAIT_L(8); PG8_BAR; PG8_WAIT_L(0); PG8_MMA(0, 0, At, B0); PG8_BAR; PG8_SCHED;
            PG8_LDB(B1, 1, 1); PG8_STAGE(PG8_SB(1, 0), b3, voffB);
            PG8_BAR; PG8_WAIT_L(0); PG8_MMA(0, 1, At, B1); PG8_BAR;
            PG8_LDA(At, 1, 1); PG8_STAGE(PG8_SA(1, 0), a3, voffA);
            PG8_BAR; PG8_WAIT_L(0); PG8_MMA(1, 0, At, B0); PG8_BAR; PG8_SCHED;
            PG8_STAGE(PG8_SB(1, 1), b3 + hstep, voffB);
            PG8_WAIT_V(6); PG8_BAR; PG8_MMA(1, 1, At, B1); PG8_BAR;
        }
        PG8_STAMP();
        if constexpr (!Epi::AFTER_DRAIN) { E(acc, cur, wr, wc, fr, fq); S.done(cur); }
        PG8_STAMP();
        if (!has_next) break;
#pragma unroll
        for (int a = 0; a < 2; ++a)
#pragma unroll
            for (int b = 0; b < 2; ++b)
#pragma unroll
                for (int m = 0; m < 4; ++m)
#pragma unroll
                    for (int n = 0; n < 2; ++n) acc[a][b][m][n] = (f32x4){0.f, 0.f, 0.f, 0.f};
        cur = nxt; cA = nA; cB = nB; ++ui;
    }
    PG8_WAIT_V(0);
    if (wr == 0) PG8_BAR;
    PG8_BAR;
    if constexpr (Epi::AFTER_DRAIN) { E.fused(acc, cur, wr, wc, fr, fq, lds, wid, lane); S.done(cur); }
    PG8_STAMP();
    if (STAMP && wid == 0) { stamps[lane] = lane < nts ? (((unsigned long long)(unsigned)ts_hi << 32) | (unsigned)ts_lo) : 0ull;
        if (lane == 62) stamps[62] = rt_entry; if (lane == 63) stamps[63] = (unsigned long long)wall_clock64(); }
#undef PG8_STAMP
#undef PG8_SA
#undef PG8_SB
#undef PG8_STAGE
#undef PG8_LDA
#undef PG8_LDB
#undef PG8_MMA
#undef PG8_WAIT_V
#undef PG8_WAIT_L
#undef PG8_BAR
#undef PG8_SCHED
}
}
struct Ctx {
    LAS unsigned char* lds; int tid, lane, wave, G, bid;
};

DI void cvt_rows(const Ctx& F, const float* src, bf16_t* dst, size_t n) {
    const size_t n8 = n >> 3;
    for (size_t i = (size_t)F.bid * NTHR + F.tid; i < n8; i += (size_t)F.G * NTHR) {
        const f32x4 a = *(const f32x4*)(src + i * 8), b = *(const f32x4*)(src + i * 8 + 4);
        u32x4 w; w.x = pk2(a.x, a.y); w.y = pk2(a.z, a.w); w.z = pk2(b.x, b.y); w.w = pk2(b.z, b.w);
        *(u32x4*)(dst + i * 8) = w;
    }
}

constexpr int TR_S = 68;
DI void tr_tile_out(const Ctx& F, bf16_t* dst, size_t ldd, const LAS bf16_t* tile) {
    const int n = F.tid >> 3, kc = (F.tid & 7) * 8;
    const LAS bf16_t* t = tile + kc * TR_S + n;
    u32x4 v;
    v.x = (unsigned)t[0] | ((unsigned)t[TR_S] << 16); v.y = (unsigned)t[2 * TR_S] | ((unsigned)t[3 * TR_S] << 16);
    v.z = (unsigned)t[4 * TR_S] | ((unsigned)t[5 * TR_S] << 16); v.w = (unsigned)t[6 * TR_S] | ((unsigned)t[7 * TR_S] << 16);
    *(u32x4*)(dst + (size_t)n * ldd + kc) = v;
}
DI void tr_tile_f32(const Ctx& F, const float* src, size_t lds_, bf16_t* dst, size_t ldd, LAS bf16_t* tile) {
#pragma unroll
    for (int j = 0; j < 2; ++j) {
        const int id = F.tid + NTHR * j, kr = id >> 4, nc = (id & 15) * 4;
        const f32x4 v = *(const f32x4*)(src + (size_t)kr * lds_ + nc);
        *(LAS u32x2*)(tile + kr * TR_S + nc) = (u32x2){pk2(v.x, v.y), pk2(v.z, v.w)};
    }
    __syncthreads();
    tr_tile_out(F, dst, ldd, tile);
    __syncthreads();
}
DI void tr_tile_bf16(const Ctx& F, const bf16_t* src, size_t lds_, bf16_t* dst, size_t ldd, LAS bf16_t* tile) {
    { const int kr = F.tid >> 3, nc = (F.tid & 7) * 8; const u32x4 v = *(const u32x4*)(src + (size_t)kr * lds_ + nc);
      *(LAS u32x2*)(tile + kr * TR_S + nc) = (u32x2){v.x, v.y}; *(LAS u32x2*)(tile + kr * TR_S + nc + 4) = (u32x2){v.z, v.w}; }
    __syncthreads();
    tr_tile_out(F, dst, ldd, tile);
    __syncthreads();
}
DI void transpose_weight(const Ctx& F, const float* W, int K, int N, bf16_t* Wt) {
    const int tk = K / 64, tn = N / 64;
    for (int t = F.bid; t < tk * tn; t += F.G) {
        const int k0 = (t / tn) * 64, n0 = (t % tn) * 64;
        tr_tile_f32(F, W + (size_t)k0 * N + n0, (size_t)N, Wt + (size_t)n0 * K + k0, (size_t)K, (LAS bf16_t*)F.lds);
    }
}
DI void transpose_cache_v(const Ctx& F, const float* V, bf16_t* VT) {
    for (int t = F.bid; t < 64 * 8; t += F.G) {
        const int bh = t >> 3, sub = t & 7, k0 = (sub >> 1) * 64, d0 = (sub & 1) * 64, b = bh >> 3, h = bh & 7;
        tr_tile_f32(F, V + ((size_t)b * 256 + k0) * 1024 + h * 128 + d0, 1024, VT + ((size_t)bh * 128 + d0) * 256 + k0, 256, (LAS bf16_t*)F.lds);
    }
}

DI void adaln_partials(const Ctx& F, const Params& P) {
    LAS float* s = (LAS float*)F.lds;
    const float* modw = P.in[I_MODW]; const float* cv = P.in[I_C]; const float* cctx = P.in[I_CCTX];
    float* modp = (float*)(P.ws + WS_MODP);
    for (int it = F.bid; it < 192; it += F.G) {
        const int i = it / 96, r = it % 96, ks = r / 6, cg = r % 6;
        __syncthreads();
        for (int e = F.tid; e < 9 * 128; e += NTHR) { const int j = e >> 7, k = e & 127; const float c = (j == 0) ? cctx[ks * 128 + k] : cv[(j - 1) * 2048 + ks * 128 + k]; s[e] = c / (1.f + __expf(-c)); }
        __syncthreads();
        f32x4 acc[9];
#pragma unroll
        for (int j = 0; j < 9; ++j) acc[j] = (f32x4){0.f, 0.f, 0.f, 0.f};
        const float* w = modw + ((size_t)i * 2048 + ks * 128) * 12288 + cg * 2048 + F.tid * 4;
#pragma unroll 8
        for (int k = 0; k < 128; ++k) {
            const f32x4 w4 = *(const f32x4*)(w + (size_t)k * 12288);
#pragma unroll
            for (int j = 0; j < 9; ++j) acc[j] += w4 * s[j * 128 + k];
        }
#pragma unroll
        for (int j = 0; j < 9; ++j) *(f32x4*)(modp + ((size_t)(i * 16 + ks) * 9 + j) * 12288 + cg * 2048 + F.tid * 4) = acc[j];
    }
    __syncthreads();
}
DI void adaln_reduce(const Ctx& F, const Params& P) {
    const float* modp = (const float*)(P.ws + WS_MODP); float* mod = (float*)(P.ws + WS_MOD); const float* modb = P.in[I_MODB];
    for (int e = F.bid * NTHR + F.tid; e < 2 * 9 * 12288; e += F.G * NTHR) {
        const int i = e / (9 * 12288), r = e % (9 * 12288), j = r / 12288, n = r % 12288;
        float a = modb[i * 12288 + n];
#pragma unroll
        for (int ks = 0; ks < 16; ++ks) a += modp[((size_t)(i * 16 + ks) * 9 + j) * 12288 + n];
        mod[e] = a;
    }
}

DI void hyena_filters(const Ctx& F, const Params& P) {
    LAS float* z = (LAS float*)F.lds;
    LAS float* h1 = z + 320;
    LAS float* h2 = h1 + 576;
    const float* w1 = P.in[I_HYW1]; const float* b1 = P.in[I_HYB1]; const float* f1 = P.in[I_HYF1];
    const float* w2 = P.in[I_HYW2]; const float* b2 = P.in[I_HYB2]; const float* f2 = P.in[I_HYF2];
    const float* w3 = P.in[I_HYW3]; const float* dec = P.in[I_HYDEC];
    for (int it = F.bid; it < 544; it += F.G) {
        const bool smp = it < 512; const int L = smp ? LS : LP, p0 = (smp ? it : it - 512) * 8, RL = smp ? KRL_S : KRL_P;
        bf16_t* KR = (bf16_t*)(P.ws + (smp ? WS_KRS : WS_KRP));
        __syncthreads();
        if (F.tid < 9 * 33) {
            const int ps = F.tid / 33, k = F.tid % 33, i = p0 + ps;
            const float t = (float)i / (float)(L - 1), wang = 6.283185307179586f * (float)i / (float)L;
            float val;
            if (k == 0) val = t;
            else { const int f = (k - 1) & 15; const float fr = 1e-4f + (float)f * ((15.0f - 1e-4f) / 15.0f); val = (k <= 16) ? cosf(fr * wang) : -sinf(fr * wang); }
            z[F.tid] = val;
        }
        __syncthreads();
        for (int e = F.tid; e < 9 * 64; e += NTHR) { const int ps = e >> 6, j = e & 63; float a = b1[j];
            for (int k = 0; k < 33; ++k) a += z[ps * 33 + k] * w1[k * 64 + j];
            h1[e] = sinf(f1[j] * a); }
        __syncthreads();
        for (int e = F.tid; e < 9 * 64; e += NTHR) { const int ps = e >> 6, j = e & 63; float a = b2[j];
            for (int k = 0; k < 64; ++k) a += h1[ps * 64 + k] * w2[k * 64 + j];
            h2[e] = sinf(f2[j] * a); }
        __syncthreads();
#pragma unroll 1
        for (int qh = 0; qh < 2; ++qh) {
            float acc[9][4];
#pragma unroll
            for (int ps = 0; ps < 9; ++ps)
#pragma unroll
                for (int q = 0; q < 4; ++q) acc[ps][q] = 0.f;
#pragma unroll 2
            for (int k = 0; k < 64; ++k) {
                float w[4];
#pragma unroll
                for (int q = 0; q < 4; ++q) w[q] = w3[k * 4096 + F.tid + NTHR * (qh * 4 + q)];
#pragma unroll
                for (int ps = 0; ps < 9; ++ps) { const float hv = h2[ps * 64 + k];
#pragma unroll
                    for (int q = 0; q < 4; ++q) acc[ps][q] += hv * w[q]; }
            }
#pragma unroll
            for (int q = 0; q < 4; ++q) {
                const int n = F.tid + NTHR * (qh * 4 + q), o = (n >> 10) & 1, c = n & 1023;
                const float dc = fabsf(dec[n]);
                bf16_t* row = KR + (size_t)(o * 1024 + c) * RL;
                float v[9];
#pragma unroll
                for (int ps = 0; ps < 9; ++ps) { const int i = p0 + ps; v[ps] = (i < L) ? acc[ps][q] * __expf(-((float)i / (float)(L - 1)) * dc) : 0.f; }
                if (qh == 0) {
                    u32x4 wv; wv.x = pk2(v[8], v[7]); wv.y = pk2(v[6], v[5]); wv.z = pk2(v[4], v[3]); wv.w = pk2(v[2], v[1]);
                    *(u32x4*)(row + (L - p0 - 8)) = wv;
                    if (p0 == 0) row[L] = f2bf(v[0]);
                } else if (p0 > 0) {
                    u32x4 wv; wv.x = pk2(v[0], v[1]); wv.y = pk2(v[2], v[3]); wv.z = pk2(v[4], v[5]); wv.w = pk2(v[6], v[7]);
                    *(u32x4*)(row + (L + p0)) = wv;
                } else {
#pragma unroll
                    for (int ps = 1; ps < 8; ++ps) row[L + ps] = f2bf(v[ps]);
                }
            }
        }
    }
    __syncthreads();
    for (int e = F.bid * NTHR + F.tid; e < 2 * 2048; e += F.G * NTHR) {
        const bool smp = e < 2048; const int r = e & 2047, L = smp ? LS : LP, RL = smp ? KRL_S : KRL_P;
        bf16_t* row = (bf16_t*)(P.ws + (smp ? WS_KRS : WS_KRP)) + (size_t)r * RL;
        for (int x = 2 * L; x < RL; ++x) row[x] = 0;
    }
}

DI void s5_consts(const Ctx& F, const Params& P) {
    float* S5A = (float*)(P.ws + WS_S5A); bf16_t* BB = (bf16_t*)(P.ws + WS_S5BB); bf16_t* CC = (bf16_t*)(P.ws + WS_S5CC);
    const float* lre = P.in[I_S5LRE]; const float* lim = P.in[I_S5LIM]; const float* ldt = P.in[I_S5LDT];
    const float* bre = P.in[I_S5BRE]; const float* bim = P.in[I_S5BIM]; const float* cre = P.in[I_S5CRE]; const float* cim = P.in[I_S5CIM];
    for (int e = F.bid * NTHR + F.tid; e < 8192; e += F.G * NTHR) {
        const int dg = e >> 6, n = e & 63;
        const float dt = expf(ldt[dg]), lr = lre[e], li = lim[e];
        const float mag = expf(lr * dt), ar = mag * cosf(li * dt), ai = mag * sinf(li * dt), den = lr * lr + li * li;
        const float cr = ((ar - 1.f) * lr + ai * li) / den, ci = (ai * lr - (ar - 1.f) * li) / den;
        S5A[e * 2] = ar; S5A[e * 2 + 1] = ai;
#pragma unroll
        for (int p = 0; p < 16; ++p) {
            const float br = bre[(size_t)e * 16 + p], bi = bim[(size_t)e * 16 + p];
            BB[((size_t)dg * 128 + n) * 16 + p] = f2bf(cr * br - ci * bi);
            BB[((size_t)dg * 128 + 64 + n) * 16 + p] = f2bf(cr * bi + ci * br);
            CC[((size_t)dg * 16 + p) * 128 + n] = f2bf(cre[((size_t)dg * 16 + p) * 64 + n]);
            CC[((size_t)dg * 16 + p) * 128 + 64 + n] = f2bf(-cim[((size_t)dg * 16 + p) * 64 + n]);
        }
    }
}

constexpr int PT_ROWB = 1536;
DI void cvt_table_fp6(const Ctx& F, const float* src, unsigned char* dst, float* scales, const int (&perm)[32]) {
    LAS float* scr = (LAS float*)(F.lds) + F.wave * 2048 + F.lane;
    for (int r = F.bid * 8 + F.wave; r < 16384; r += F.G * 8) {
        f32x4 v[8]; float m = 0.f;
#pragma unroll
        for (int j = 0; j < 8; ++j) { v[j] = *(const f32x4*)(src + (size_t)r * 2048 + F.lane * 32 + j * 4);
            m = fmaxf(m, fmaxf(fmaxf(fabsf(v[j].x), fabsf(v[j].y)), fmaxf(fabsf(v[j].z), fabsf(v[j].w)))); }
        m = wave_max(m);
        const float inv = (m > 0.f) ? 7.0f / m : 0.f, sc = (m > 0.f) ? m / 7.0f : 0.f;
#pragma unroll
        for (int j = 0; j < 8; ++j) { scr[perm[j * 4 + 0] * 64] = v[j].x * inv; scr[perm[j * 4 + 1] * 64] = v[j].y * inv; scr[perm[j * 4 + 2] * 64] = v[j].z * inv; scr[perm[j * 4 + 3] * 64] = v[j].w * inv; }
        asm volatile("" ::: "memory");
        f32x16 a, b;
#pragma unroll
        for (int i = 0; i < 16; ++i) { a[i] = scr[i * 64]; b[i] = scr[(16 + i) * 64]; }
        asm volatile("" ::: "memory");
        const u32x6 pk = __builtin_amdgcn_cvt_scalef32_2xpk16_fp6_f32(a, b, 1.0f);
        unsigned char* o = dst + (size_t)r * PT_ROWB;
        *(u32x4*)(o + F.lane * 16) = (u32x4){pk[0], pk[1], pk[2], pk[3]}; *(u32x2*)(o + 1024 + F.lane * 8) = (u32x2){pk[4], pk[5]};
        if (F.lane == 0) scales[r] = sc;
    }
}
DI void convert_peer_tables(const Ctx& F, const Params& P) {
    int perm[32];
    { f32x16 a, b;
#pragma unroll
      for (int j = 0; j < 16; ++j) { a[j] = 0.125f * (float)j; b[j] = (j < 8) ? 2.0f + 0.25f * (float)j : 4.0f + 0.5f * (float)(j - 8); }
      const u32x6 pk = __builtin_amdgcn_cvt_scalef32_2xpk16_fp6_f32(a, b, 1.0f);
      const f32x32 rt = __builtin_amdgcn_cvt_scalef32_pk32_f32_fp6(pk, 1.0f);
#pragma unroll
      for (int i = 0; i < 32; ++i) { const float x = rt[i]; const int o = (x < 2.0f) ? (int)(x * 8.0f + 0.5f) : ((x < 4.0f) ? 16 + (int)((x - 2.0f) * 4.0f + 0.5f) : 24 + (int)((x - 4.0f) * 2.0f + 0.5f)); perm[i] = min(max(o, 0), 31); } }
    float* SC = (float*)(P.ws + WS_SC);
    __syncthreads();
    for (int layer = 0; layer < 2; ++layer) {
        cvt_table_fp6(F, P.in[I_PU] + (size_t)layer * 16384 * 2048, P.ws + WS_TBLU + (size_t)layer * 16384 * PT_ROWB, SC + layer * 16384, perm);
        cvt_table_fp6(F, P.in[I_PV] + (size_t)layer * 16384 * 2048, P.ws + WS_TBLV + (size_t)layer * 16384 * PT_ROWB, SC + (2 + layer) * 16384, perm);
    }
    __syncthreads();
}

DI void prologue(const Ctx& F, const Params& P) {
    adaln_partials(F, P);
    transpose_weight(F, P.in[I_EVWIN], 2048, 6144, (bf16_t*)(P.ws + WS_WEVIN));
    transpose_weight(F, P.in[I_EVWOUT], 2048, 2048, (bf16_t*)(P.ws + WS_WEVOUT));
    transpose_weight(F, P.in[I_ODWIN], 2048, 4096, (bf16_t*)(P.ws + WS_WODIN));
    transpose_weight(F, P.in[I_ODWOUT], 2048, 2048, (bf16_t*)(P.ws + WS_WODOUT));
    transpose_weight(F, P.in[I_PWQ], 2048, 2048, (bf16_t*)(P.ws + WS_WPQ));
    transpose_weight(F, P.in[I_PWQ] + (size_t)2048 * 2048, 2048, 2048, (bf16_t*)(P.ws + WS_WPQ) + (size_t)2048 * 2048);
    transpose_weight(F, P.in[I_GLUW], 1024, 1024, (bf16_t*)(P.ws + WS_WGLU));
    cvt_rows(F, P.in[I_PKEYS], (bf16_t*)(P.ws + WS_PKEYS), (size_t)2 * 8 * 2 * 128 * 128);
    cvt_rows(F, P.in[I_CNK], (bf16_t*)(P.ws + WS_CNK), (size_t)8 * 256 * 1024);
    cvt_rows(F, P.in[I_CDK], (bf16_t*)(P.ws + WS_CDK), (size_t)8 * 256 * 1024);
    transpose_cache_v(F, P.in[I_CNV], (bf16_t*)(P.ws + WS_CNVT));
    transpose_cache_v(F, P.in[I_CDV], (bf16_t*)(P.ws + WS_CDVT));
    hyena_filters(F, P);
    s5_consts(F, P);
    convert_peer_tables(F, P);
}
DI void norm_phase(const Ctx& F, const float* xa, const float* xb, const float* gvec, const float* modl, int sidx, bf16_t* H) {
    for (int T = F.bid * 8 + F.wave; T < TOK; T += F.G * 8) {
        const float* xr = T < TP ? xa + (size_t)T * DM : xb + (size_t)(T - TP) * DM;
        f32x4 v[8]; float ss = 0.f;
#pragma unroll
        for (int j = 0; j < 8; ++j) { v[j] = *(const f32x4*)(xr + (j * 64 + F.lane) * 4); ss += v[j].x * v[j].x + v[j].y * v[j].y + v[j].z * v[j].z + v[j].w * v[j].w; }
        ss = wave_sum(ss);
        const float rstd = rsqrtf(ss * (1.f / DM) + NORM_EPS);
        const float* sh = modl + (size_t)(cond_of(T) * 6 + sidx) * DM; const float* sc = sh + DM;
#pragma unroll
        for (int j = 0; j < 8; ++j) {
            const int col = (j * 64 + F.lane) * 4;
            const f32x4 g4 = *(const f32x4*)(gvec + col), s4 = *(const f32x4*)(sc + col), h4 = *(const f32x4*)(sh + col);
            const f32x4 o = v[j] * rstd * g4 * (s4 + 1.f) + h4;
            u32x2 w; w.x = pk2(o.x, o.y); w.y = pk2(o.z, o.w);
            *(u32x2*)(H + (size_t)T * DM + col) = w;
        }
    }
}

struct EpiBf16 {
    static constexpr bool PERM = true, AFTER_DRAIN = false;
    bf16_t* O; int ldc;
    DI void operator()(const f32x4 (&acc)[2][2][4][2], const pg8::Unit& u, int wr, int wc, int fr, int fq) const {
        const int row0 = u.pm * 256 + wr * 64 + fr, col0 = u.pn * 256 + wc * 32 + 8 * fq;
#pragma unroll
        for (int ai = 0; ai < 2; ++ai)
#pragma unroll
            for (int m = 0; m < 4; ++m) { bf16_t* rowp = O + (size_t)(row0 + ai * 128 + m * 16) * ldc + col0;
#pragma unroll
                for (int bj = 0; bj < 2; ++bj) { const f32x4 v0 = acc[ai][bj][m][0], v1 = acc[ai][bj][m][1];
                    u32x4 w; w.x = pk2(v0[0], v0[1]); w.y = pk2(v0[2], v0[3]); w.z = pk2(v1[0], v1[1]); w.w = pk2(v1[2], v1[3]);
                    *(u32x4*)(rowp + bj * 128) = w; } }
    }
};
struct EpiResid {
    static constexpr bool PERM = false, AFTER_DRAIN = false;
    const float* xa; const float* xb; float* out; const float* modl; int gidx;
    DI void operator()(const f32x4 (&acc)[2][2][4][2], const pg8::Unit& u, int wr, int wc, int fr, int fq) const {
        const int row0 = u.pm * 256 + wr * 64 + fr, col0 = u.pn * 256 + wc * 32 + 4 * fq;
        const float* xbase = (u.pm < 32) ? xa : xb - (size_t)TP * DM;
        const float* gate = modl + (size_t)(cond_of(u.pm * 256) * 6 + gidx) * DM;
        f32x4 gv[2][2];
#pragma unroll
        for (int bj = 0; bj < 2; ++bj)
#pragma unroll
            for (int n = 0; n < 2; ++n) gv[bj][n] = *(const f32x4*)(gate + col0 + bj * 128 + n * 16);
#pragma unroll
        for (int ai = 0; ai < 2; ++ai)
#pragma unroll
            for (int m = 0; m < 4; ++m) { const size_t ro = (size_t)(row0 + ai * 128 + m * 16) * DM + col0;
#pragma unroll
                for (int bj = 0; bj < 2; ++bj)
#pragma unroll
                    for (int n = 0; n < 2; ++n) { const f32x4 x4 = *(const f32x4*)(xbase + ro + bj * 128 + n * 16);
                        *(f32x4*)(out + ro + bj * 128 + n * 16) = x4 + gv[bj][n] * acc[ai][bj][m][n]; } }
    }
};
struct EpiGlu {
    static constexpr bool PERM = true, AFTER_DRAIN = false;
    const bf16_t* Y; bf16_t* O; const float* bias;
    DI void operator()(const f32x4 (&acc)[2][2][4][2], const pg8::Unit& u, int wr, int wc, int fr, int fq) const {
        const int row0 = u.pm * 256 + wr * 64 + fr, col0 = u.pn * 256 + wc * 32 + 8 * fq;
#pragma unroll
        for (int bj = 0; bj < 2; ++bj) {
            const f32x4 b0 = *(const f32x4*)(bias + col0 + bj * 128), b1 = *(const f32x4*)(bias + col0 + bj * 128 + 4);
#pragma unroll
            for (int ai = 0; ai < 2; ++ai)
#pragma unroll
                for (int m = 0; m < 4; ++m) { const size_t r = (size_t)(row0 + ai * 128 + m * 16);
                    const u32x4 yv = *(const u32x4*)(Y + r * 1024 + col0 + bj * 128);
                    const f32x4 a0 = acc[ai][bj][m][0] + b0, a1 = acc[ai][bj][m][1] + b1;
                    float o[8];
                    o[0] = bflo(yv.x) / (1.f + __expf(-a0[0])); o[1] = bfhi(yv.x) / (1.f + __expf(-a0[1]));
                    o[2] = bflo(yv.y) / (1.f + __expf(-a0[2])); o[3] = bfhi(yv.y) / (1.f + __expf(-a0[3]));
                    o[4] = bflo(yv.z) / (1.f + __expf(-a1[0])); o[5] = bfhi(yv.z) / (1.f + __expf(-a1[1]));
                    o[6] = bflo(yv.w) / (1.f + __expf(-a1[2])); o[7] = bfhi(yv.w) / (1.f + __expf(-a1[3]));
                    u32x4 w; w.x = pk2(o[0], o[1]); w.y = pk2(o[2], o[3]); w.z = pk2(o[4], o[5]); w.w = pk2(o[6], o[7]);
                    *(u32x4*)(O + r * DM + col0 + bj * 128) = w; }
        }
    }
};
template <class Epi> DI void run_gemm(const Ctx& F, const bf16_t* A, const bf16_t* Bt, int N, int K, const Epi& E) {
    pg8::Gemm g{A, Bt, TOK, N, K}; pg8::StaticOrder S; S.init(TOK, N, F.G, F.bid);
    pg8::gemm_phase<Epi, pg8::StaticOrder, false>(F.lds, g, S, E, nullptr);
    __syncthreads();
}

DI void prep_a(const Ctx& F, const Params& P) {
    const bf16_t* T1 = (const bf16_t*)(P.ws + WS_RA);
    bf16_t* VTp = (bf16_t*)(P.ws + WS_VT); bf16_t* VTs = (bf16_t*)(P.ws + WS_VT + VT_S);
    for (int t = F.bid; t < 2048 + 8192; t += F.G) {
        if (t < 2048) { const int bh = t >> 3, sub = t & 7, tk = sub >> 1, dd = sub & 1, b = bh >> 3, h = bh & 7;
            tr_tile_bf16(F, T1 + ((size_t)(b * 256 + tk * 64)) * 4096 + h * 128 + dd * 64, 4096, VTp + ((size_t)bh * 128 + dd * 64) * 256 + tk * 64, 256, (LAS bf16_t*)F.lds); }
        else { const int u = t - 2048, bh = u >> 7, sub = u & 127, tk = sub >> 1, dd = sub & 1, b = bh >> 3, h = bh & 7;
            tr_tile_bf16(F, T1 + ((size_t)(TP + b * 4096 + tk * 64)) * 4096 + h * 128 + dd * 64, 4096, VTs + ((size_t)bh * 128 + dd * 64) * 4096 + tk * 64, 4096, (LAS bf16_t*)F.lds); }
    }
    { float* o = P.out + O_NAV;
      for (int e = F.bid * NTHR + F.tid; e < TP * 128; e += F.G * NTHR) { const int T = e >> 7, c8 = (e & 127) * 8;
          const u32x4 v = *(const u32x4*)(T1 + (size_t)T * 4096 + c8);
          *(f32x4*)(o + (size_t)T * 1024 + c8) = (f32x4){bflo(v.x), bfhi(v.x), bflo(v.y), bfhi(v.y)};
          *(f32x4*)(o + (size_t)T * 1024 + c8 + 4) = (f32x4){bflo(v.z), bfhi(v.z), bflo(v.w), bfhi(v.w)}; } }
    { LAS bf16_t* tl = (LAS bf16_t*)F.lds;
      bf16_t* CM = (bf16_t*)(P.ws + WS_RB);
      const float* cw = P.in[I_HYCW]; const float* cb = P.in[I_HYCB];
      for (int t = F.bid; t < 48 * 160; t += F.G) {
          const int cg = t % 48, tg = t / 48, ch0 = cg * 64, t0 = tg * 256;
          const bool lz = (t0 < TP) ? true : (((t0 - TP) & 4095) == 0);
          const bool rz = (t0 < TP) ? true : (((t0 + 256 - TP) & 4095) == 0);
          __syncthreads();
#pragma unroll
          for (int j = 0; j < 4; ++j) { const int id = F.tid + NTHR * j, tk = id >> 3, c8 = (id & 7) * 8;
              const u32x4 v = *(const u32x4*)(T1 + (size_t)(t0 + tk) * 4096 + 1024 + ch0 + c8);
              LAS bf16_t* d = tl + tk + 1;
              d[(c8 + 0) * 264] = (bf16_t)(v.x & 0xffff); d[(c8 + 1) * 264] = (bf16_t)(v.x >> 16); d[(c8 + 2) * 264] = (bf16_t)(v.y & 0xffff); d[(c8 + 3) * 264] = (bf16_t)(v.y >> 16);
              d[(c8 + 4) * 264] = (bf16_t)(v.z & 0xffff); d[(c8 + 5) * 264] = (bf16_t)(v.z >> 16); d[(c8 + 6) * 264] = (bf16_t)(v.w & 0xffff); d[(c8 + 7) * 264] = (bf16_t)(v.w >> 16); }
          if (F.tid < 16) { const int side = F.tid >> 3, c8 = (F.tid & 7) * 8; const bool zero = side ? rz : lz; const int tk = side ? t0 + 256 : t0 - 1;
              u32x4 v = (u32x4){0u, 0u, 0u, 0u};
              if (!zero) v = *(const u32x4*)(T1 + (size_t)tk * 4096 + 1024 + ch0 + c8);
              LAS bf16_t* d = tl + (side ? 257 : 0);
              d[(c8 + 0) * 264] = (bf16_t)(v.x & 0xffff); d[(c8 + 1) * 264] = (bf16_t)(v.x >> 16); d[(c8 + 2) * 264] = (bf16_t)(v.y & 0xffff); d[(c8 + 3) * 264] = (bf16_t)(v.y >> 16);
              d[(c8 + 4) * 264] = (bf16_t)(v.z & 0xffff); d[(c8 + 5) * 264] = (bf16_t)(v.z >> 16); d[(c8 + 6) * 264] = (bf16_t)(v.w & 0xffff); d[(c8 + 7) * 264] = (bf16_t)(v.w >> 16); }
          __syncthreads();
#pragma unroll
          for (int j = 0; j < 4; ++j) { const int id = F.tid + NTHR * j, ch = id >> 5, to = (id & 31) * 8, cgl = ch0 + ch;
              const float w0 = cw[cgl], w1 = cw[3072 + cgl], w2 = cw[6144 + cgl], bb = cb[cgl];
              const LAS bf16_t* s = tl + ch * 264 + to;
              float r[10];
#pragma unroll
              for (int i = 0; i < 10; ++i) r[i] = bf2f(s[i]);
              float o[8];
#pragma unroll
              for (int i = 0; i < 8; ++i) o[i] = w0 * r[i] + w1 * r[i + 1] + w2 * r[i + 2] + bb;
              u32x4 w; w.x = pk2(o[0], o[1]); w.y = pk2(o[2], o[3]); w.z = pk2(o[4], o[5]); w.w = pk2(o[6], o[7]);
              *(u32x4*)(CM + (size_t)cgl * TOK + t0 + to) = w; }
      }
      __syncthreads(); }
}

DI void prep_b(const Ctx& F, const Params& P) {
    bf16_t* Pq = (bf16_t*)(P.ws + WS_RA); const float* qg = P.in[I_NAQG]; const float* kg = P.in[I_NAKG]; float* ok = P.out + O_NAK;
    const float* gsrc = (F.lane < 32 ? qg : kg) + (F.lane & 3) * 32;
    float g[32];
#pragma unroll
    for (int i = 0; i < 32; ++i) g[i] = gsrc[i];
    for (int T = F.bid * 8 + F.wave; T < TOK; T += F.G * 8) {
        bf16_t* rp = Pq + (size_t)T * 2048 + F.lane * 32;
        u32x4 v[4]; float x[32]; float ss = 0.f;
#pragma unroll
        for (int j = 0; j < 4; ++j) { v[j] = *(const u32x4*)(rp + j * 8);
            x[j * 8 + 0] = bflo(v[j].x); x[j * 8 + 1] = bfhi(v[j].x); x[j * 8 + 2] = bflo(v[j].y); x[j * 8 + 3] = bfhi(v[j].y);
            x[j * 8 + 4] = bflo(v[j].z); x[j * 8 + 5] = bfhi(v[j].z); x[j * 8 + 6] = bflo(v[j].w); x[j * 8 + 7] = bfhi(v[j].w); }
#pragma unroll
        for (int i = 0; i < 32; ++i) ss += x[i] * x[i];
        ss += dpp_xor1(ss); ss += dpp_xor2(ss);
        const float rstd = rsqrtf(ss * (1.f / 128.f) + NORM_EPS);
#pragma unroll
        for (int i = 0; i < 32; ++i) x[i] = x[i] * rstd * g[i];
#pragma unroll
        for (int j = 0; j < 4; ++j) { u32x4 w; w.x = pk2(x[j * 8 + 0], x[j * 8 + 1]); w.y = pk2(x[j * 8 + 2], x[j * 8 + 3]); w.z = pk2(x[j * 8 + 4], x[j * 8 + 5]); w.w = pk2(x[j * 8 + 6], x[j * 8 + 7]);
            *(u32x4*)(rp + j * 8) = w; }
        if (T < TP && F.lane >= 32) { float* o = ok + (size_t)T * 1024 + (F.lane - 32) * 32;
#pragma unroll
            for (int j = 0; j < 8; ++j) *(f32x4*)(o + j * 4) = (f32x4){x[j * 4], x[j * 4 + 1], x[j * 4 + 2], x[j * 4 + 3]}; }
    }
}
constexpr int AT_KROW = 272, AT_VROW = 136, AT_KTB = 64 * AT_KROW, AT_VTB = 128 * AT_VROW;
constexpr int AT_K0 = 0, AT_V0 = 2 * AT_KTB, AT_RPB = AT_V0 + 2 * AT_VTB;

struct TileMap { const bf16_t* latK; int latKld; const bf16_t* latV; int latVld; int nlat; const bf16_t* ctxK; const bf16_t* ctxV; int ntiles; };
struct TileRegs { u32x4 k[2], v[2]; };

DI void tile_src(const TileMap& M, int j, const bf16_t*& kp, int& kld, const bf16_t*& vp, int& vld) {
    if (j < M.nlat) { kp = M.latK + (size_t)j * 64 * M.latKld; kld = M.latKld; vp = M.latV + j * 64; vld = M.latVld; }
    else { const int c = j - M.nlat; kp = M.ctxK + (size_t)c * 64 * 1024; kld = 1024; vp = M.ctxV + c * 64; vld = 256; }
}
DI void tile_load(const Ctx& F, TileRegs& R, const bf16_t* kp, int kld, const bf16_t* vp, int vld, bool withV = true) {
#pragma unroll
    for (int j = 0; j < 2; ++j) { const int id = F.tid + NTHR * j;
        const unsigned ko = (unsigned)((id >> 4) * kld + (id & 15) * 8) * 2u, vo = (unsigned)((id >> 3) * vld + (id & 7) * 8) * 2u;
        R.k[j] = *(const u32x4*)((const char*)kp + ko);
        if (withV) R.v[j] = *(const u32x4*)((const char*)vp + vo); }
}
DI void tile_store(const Ctx& F, const TileRegs& R, LAS unsigned char* kt, LAS unsigned char* vt, bool withV = true) {
#pragma unroll
    for (int j = 0; j < 2; ++j) { const int id = F.tid + NTHR * j;
        *(LAS u32x4*)(kt + (id >> 4) * AT_KROW + (id & 15) * 16) = R.k[j];
        if (withV) { LAS unsigned char* vp = vt + (id >> 3) * AT_VROW + (id & 7) * 16;
            *(LAS u32x2*)(vp) = (u32x2){R.v[j].x, R.v[j].y}; *(LAS u32x2*)(vp + 8) = (u32x2){R.v[j].z, R.v[j].w}; } }
}

DI void tile_norm_k(const Ctx& F, TileRegs& R, const LAS float* kgain, float* nk, int nkld) {
#pragma unroll
    for (int j = 0; j < 2; ++j) { const int id = F.tid + NTHR * j;
        float x[8] = {bflo(R.k[j].x), bfhi(R.k[j].x), bflo(R.k[j].y), bfhi(R.k[j].y), bflo(R.k[j].z), bfhi(R.k[j].z), bflo(R.k[j].w), bfhi(R.k[j].w)};
        float ss = 0.f;
#pragma unroll
        for (int i = 0; i < 8; ++i) ss += x[i] * x[i];
        ss += dpp_xor1(ss); ss += dpp_xor2(ss);
        ss += __builtin_bit_cast(float, __builtin_amdgcn_update_dpp(0, __builtin_bit_cast(int, ss), 0x141, 0xF, 0xF, true));
        ss += __builtin_bit_cast(float, __builtin_amdgcn_update_dpp(0, __builtin_bit_cast(int, ss), 0x140, 0xF, 0xF, true));
        const float rstd = rsqrtf(ss * (1.f / 128.f) + NORM_EPS);
        const f32x4 g0 = *(const LAS f32x4*)(kgain + (id & 15) * 8), g1 = *(const LAS f32x4*)(kgain + (id & 15) * 8 + 4);
        x[0] *= rstd * g0.x; x[1] *= rstd * g0.y; x[2] *= rstd * g0.z; x[3] *= rstd * g0.w; x[4] *= rstd * g1.x; x[5] *= rstd * g1.y; x[6] *= rstd * g1.z; x[7] *= rstd * g1.w;
        R.k[j] = (u32x4){pk2(x[0], x[1]), pk2(x[2], x[3]), pk2(x[4], x[5]), pk2(x[6], x[7])};
        if (nk) { float* o = nk + (size_t)(id >> 4) * nkld + (id & 15) * 8; *(f32x4*)(o) = (f32x4){x[0], x[1], x[2], x[3]}; *(f32x4*)(o + 4) = (f32x4){x[4], x[5], x[6], x[7]}; }
    }
}

template <int KS>
DI f32x16 qk_tile(LAS const unsigned char* kt, const bf16x8 (&Qf)[8], int kb, int kk0, int q, int hh) {
    f32x16 S;
#pragma unroll
    for (int i = 0; i < 16; ++i) S[i] = 0.f;
#pragma unroll
    for (int ks = 0; ks < KS; ++ks) { const int kk = kk0 + ks;
        const bf16x8 A = *(const LAS bf16x8*)(kt + (kb * 32 + q) * AT_KROW + (kk * 16 + hh * 8) * 2);
        S = __builtin_amdgcn_mfma_f32_32x32x16_bf16(A, Qf[kk], S, 0, 0, 0); }
    return S;
}
DI void pv_tile(LAS const unsigned char* vt, const float (&p)[16], f32x16 (&O)[4], int kb, int q, int hh) {
#pragma unroll
    for (int s = 0; s < 2; ++s) {
        u32x4 pw; pw.x = pk2(p[8 * s + 0], p[8 * s + 1]); pw.y = pk2(p[8 * s + 2], p[8 * s + 3]); pw.z = pk2(p[8 * s + 4], p[8 * s + 5]); pw.w = pk2(p[8 * s + 6], p[8 * s + 7]);
        const bf16x8 Pf = __builtin_bit_cast(bf16x8, pw);
#pragma unroll
        for (int db = 0; db < 4; ++db) {
            LAS const unsigned char* ap = vt + (db * 32 + q) * AT_VROW + (kb * 32 + 16 * s + 4 * hh) * 2;
            const u32x2 lo = *(const LAS u32x2*)(ap), hi = *(const LAS u32x2*)(ap + 16);
            const bf16x8 A2 = __builtin_bit_cast(bf16x8, (u32x4){lo.x, lo.y, hi.x, hi.y});
            O[db] = __builtin_amdgcn_mfma_f32_32x32x16_bf16(A2, Pf, O[db], 0, 0, 0);
        }
        asm volatile("" ::: "memory");
    }
}
template <bool LAT>
DI void attn_compute1(LAS const unsigned char* kt, LAS const unsigned char* vt, const bf16x8 (&Qf)[8], f32x16 (&O)[4], float& ls, int lane, const LAS float* brow, int cq) {
    const int q = lane & 31, hh = lane >> 5;
    const int cs = min(max(cq - 8, 0), 48);
#pragma unroll 1
    for (int kb = 0; kb < 2; ++kb) {
        const f32x16 S = qk_tile<8>(kt, Qf, kb, 0, q, hh);
        float p[16];
#pragma unroll
        for (int i = 0; i < 16; ++i) {
            float arg = S[i];
            if (LAT) { const int ck = kb * 32 + (i & 3) + 8 * (i >> 2) + 4 * hh;
                arg += brow[min(max(ck - cq + 15, 0), 30)];
                p[i] = ((unsigned)(ck - cs) < 16u) ? __builtin_amdgcn_exp2f(arg) : 0.f; }
            else p[i] = __builtin_amdgcn_exp2f(arg);
            ls += p[i];
        }
        pv_tile(vt, p, O, kb, q, hh);
    }
}
DI void diff_pass1(LAS const unsigned char* kt, const bf16x8 (&Qf)[8], float (&ls)[2], int lane) {
    const int q = lane & 31, hh = lane >> 5;
#pragma unroll
    for (int kb = 0; kb < 2; ++kb) {
#pragma unroll
        for (int mp = 0; mp < 2; ++mp) { const f32x16 S = qk_tile<4>(kt, Qf, kb, mp * 4, q, hh);
#pragma unroll
            for (int i = 0; i < 16; ++i) ls[mp] += __builtin_amdgcn_exp2f(S[i]); }
    }
}
DI void diff_pass2(LAS const unsigned char* kt, LAS const unsigned char* vt, const bf16x8 (&Qf)[8], f32x16 (&O)[4], float w0, float w1, int lane) {
    const int q = lane & 31, hh = lane >> 5;
#pragma unroll
    for (int kb = 0; kb < 2; ++kb) {
        float p[16];
        { const f32x16 S0 = qk_tile<4>(kt, Qf, kb, 0, q, hh);
#pragma unroll
          for (int i = 0; i < 16; ++i) p[i] = __builtin_amdgcn_exp2f(S0[i]) * w0; }
        { const f32x16 S1 = qk_tile<4>(kt, Qf, kb, 4, q, hh);
#pragma unroll
          for (int i = 0; i < 16; ++i) p[i] -= __builtin_amdgcn_exp2f(S1[i]) * w1; }
        pv_tile(vt, p, O, kb, q, hh);
    }
}

template <int MODE>
DI void attn_phase(const Ctx& F, const Params& P) {
    constexpr bool DIFF = (MODE >= 2);
    constexpr bool NA = (MODE == 1);
    LAS unsigned char* lds = F.lds;
    LAS float* rpbl = (LAS float*)(lds + AT_RPB);
    LAS float* kgl = (LAS float*)(lds + AT_RPB + 2048);
    if (!DIFF) { __syncthreads(); if (F.tid < 128) kgl[F.tid] = P.in[I_NAKG][F.tid]; __syncthreads(); }
    const bf16_t* PA = (const bf16_t*)(P.ws + WS_RA);
    bf16_t* MIX = (bf16_t*)(P.ws + WS_HM);
    const bf16_t* VTp = (const bf16_t*)(P.ws + WS_VT); const bf16_t* VTs = (const bf16_t*)(P.ws + WS_VT + VT_S);
    const int q = F.lane & 31, hh = F.lane >> 5;
    const float c1 = (DIFF ? 0.125f : 0.08838834764831845f) * LOG2E;
    float lam = 0.f;
    if (DIFF) {
        const float a = wave_sum(P.in[I_LQ1][F.lane] * P.in[I_LK1][F.lane]), b = wave_sum(P.in[I_LQ2][F.lane] * P.in[I_LK2][F.lane]);
        lam = __expf(a) - __expf(b) + 0.35550906759096924f;
    }
    const int nunits = (MODE == 0 || MODE == 2) ? 256 : 1024;
    for (int u0 = F.bid; u0 < nunits; u0 += F.G) {
        int u = u0;
        if ((MODE == 1 || MODE == 3) && F.G == 256) { const int i = u0 >> 8, x = F.bid & 7, y = F.bid >> 3; u = ((2 * i + (y >> 4)) * 8 + x) * 16 + (y & 15); }
        int b, h, tok0, r = 0, rlo = 0; TileMap M;
        const bf16_t* qptr;
        if (MODE == 0) { b = u >> 3; h = u & 7; tok0 = b * 256 + F.wave * 32;
            qptr = PA + (size_t)(tok0 + q) * 2048 + h * 128;
            M.latK = PA + (size_t)(b * 256) * 2048 + 1024 + h * 128; M.latKld = 2048; M.latV = VTp + (size_t)(b * 8 + h) * 128 * 256; M.latVld = 256; M.nlat = 4; M.ctxK = nullptr; M.ctxV = nullptr; M.ntiles = 4; }
        else if (MODE == 1) { b = u >> 7; h = (u >> 4) & 7; const int rg = u & 15; r = 4 * rg + (F.wave >> 1);
            rlo = min(max(4 * rg - 4, 0), 56); const int rhi = min(max(4 * rg + 3 - 4, 0), 56) + 8;
            tok0 = TP + b * 4096 + r * 64 + (F.wave & 1) * 32;
            qptr = PA + (size_t)(tok0 + q) * 2048 + h * 128;
            M.latK = PA + (size_t)(TP + b * 4096 + rlo * 64) * 2048 + 1024 + h * 128; M.latKld = 2048; M.latV = VTs + (size_t)(b * 8 + h) * 128 * 4096 + rlo * 64; M.latVld = 4096; M.nlat = rhi - rlo;
            M.ctxK = (const bf16_t*)(P.ws + WS_CNK) + (size_t)b * 256 * 1024 + h * 128; M.ctxV = (const bf16_t*)(P.ws + WS_CNVT) + (size_t)(b * 8 + h) * 128 * 256; M.ntiles = M.nlat + 4;
            if (F.tid < 465) rpbl[F.tid] = P.in[I_RPB][h * 465 + F.tid] * LOG2E; }
        else if (MODE == 2) { b = u >> 3; h = u & 7; tok0 = b * 256 + F.wave * 32;
            qptr = PA + (size_t)(tok0 + q) * 4096 + 1024 + h * 128;
            M.latK = PA + (size_t)(b * 256) * 4096 + 2048 + h * 128; M.latKld = 4096; M.latV = VTp + (size_t)(b * 8 + h) * 128 * 256; M.latVld = 256; M.nlat = 4; M.ctxK = nullptr; M.ctxV = nullptr; M.ntiles = 4; }
        else { b = u >> 7; h = (u >> 4) & 7; const int qb = u & 15; tok0 = TP + b * 4096 + qb * 256 + F.wave * 32;
            qptr = PA + (size_t)(tok0 + q) * 4096 + 1024 + h * 128;
            M.latK = PA + (size_t)(TP + b * 4096) * 4096 + 2048 + h * 128; M.latKld = 4096; M.latV = VTs + (size_t)(b * 8 + h) * 128 * 4096; M.latVld = 4096; M.nlat = 64;
            M.ctxK = (const bf16_t*)(P.ws + WS_CDK) + (size_t)b * 256 * 1024 + h * 128; M.ctxV = (const bf16_t*)(P.ws + WS_CDVT) + (size_t)(b * 8 + h) * 128 * 256; M.ntiles = 68; }
        bf16x8 Qf[8];
        if constexpr (!DIFF) {
            u32x4 w[8]; float ss = 0.f;
#pragma unroll
            for (int ks = 0; ks < 8; ++ks) { w[ks] = *(const u32x4*)(qptr + ks * 16 + hh * 8);
                ss += bflo(w[ks].x) * bflo(w[ks].x) + bfhi(w[ks].x) * bfhi(w[ks].x) + bflo(w[ks].y) * bflo(w[ks].y) + bfhi(w[ks].y) * bfhi(w[ks].y)
                    + bflo(w[ks].z) * bflo(w[ks].z) + bfhi(w[ks].z) * bfhi(w[ks].z) + bflo(w[ks].w) * bflo(w[ks].w) + bfhi(w[ks].w) * bfhi(w[ks].w); }
            ss += __shfl_xor(ss, 32);
            const float qs = rsqrtf(ss * (1.f / 128.f) + NORM_EPS) * c1;
            const float* qg = P.in[I_NAQG];
#pragma unroll
            for (int ks = 0; ks < 8; ++ks) { const f32x4 g0 = *(const f32x4*)(qg + ks * 16 + hh * 8), g1 = *(const f32x4*)(qg + ks * 16 + hh * 8 + 4);
                const u32x4 ws = (u32x4){pk2(bflo(w[ks].x) * qs * g0.x, bfhi(w[ks].x) * qs * g0.y), pk2(bflo(w[ks].y) * qs * g0.z, bfhi(w[ks].y) * qs * g0.w),
                                         pk2(bflo(w[ks].z) * qs * g1.x, bfhi(w[ks].z) * qs * g1.y), pk2(bflo(w[ks].w) * qs * g1.z, bfhi(w[ks].w) * qs * g1.w)};
                Qf[ks] = __builtin_bit_cast(bf16x8, ws); }
        } else {
#pragma unroll
        for (int ks = 0; ks < 8; ++ks) { const u32x4 w = *(const u32x4*)(qptr + ks * 16 + hh * 8);
            const u32x4 ws = (u32x4){pk2(bflo(w.x) * c1, bfhi(w.x) * c1), pk2(bflo(w.y) * c1, bfhi(w.y) * c1), pk2(bflo(w.z) * c1, bfhi(w.z) * c1), pk2(bflo(w.w) * c1, bfhi(w.w) * c1)};
            Qf[ks] = __builtin_bit_cast(bf16x8, ws); }
        }
        f32x16 O[4]; float ls[2] = {0.f, 0.f}; float w0 = 0.f, w1 = 0.f;
#pragma unroll
        for (int db = 0; db < 4; ++db)
#pragma unroll
            for (int i = 0; i < 16; ++i) O[db][i] = 0.f;
        const int cq = (F.wave & 1) * 32 + q;
        const int r0w = min(max(r - 4, 0), 56);
        const int nt = M.ntiles;
        TileRegs R;
        { const bf16_t* kp; const bf16_t* vp; int kld, vld; tile_src(M, 0, kp, kld, vp, vld); tile_load(F, R, kp, kld, vp, vld); }
        if constexpr (!DIFF) tile_norm_k(F, R, kgl, (MODE == 0) ? P.out + O_NAK + (size_t)(b * 256) * 1024 + h * 128 : nullptr, 1024);
        tile_store(F, R, lds + AT_K0, lds + AT_V0);
        __syncthreads();
        if constexpr (DIFF) {
#pragma unroll 1
            for (int j = 0; j < nt; ++j) {
                const int cur = j & 1, jn = (j + 1 < nt) ? j + 1 : 0;
                const bool wv = (j + 1 == nt);
                { const bf16_t* kp; const bf16_t* vp; int kld, vld; tile_src(M, jn, kp, kld, vp, vld); tile_load(F, R, kp, kld, vp, vld, wv); }
                diff_pass1(lds + AT_K0 + cur * AT_KTB, Qf, ls, F.lane);
                tile_store(F, R, lds + AT_K0 + (cur ^ 1) * AT_KTB, lds + AT_V0 + (cur ^ 1) * AT_VTB, wv);
                __syncthreads();
            }
            { const float l0 = ls[0] + __shfl_xor(ls[0], 32), l1 = ls[1] + __shfl_xor(ls[1], 32); w0 = 1.f / l0; w1 = lam / l1; }
#pragma unroll 1
            for (int j = 0; j < nt; ++j) {
                const int cur = (nt + j) & 1;
                if (j + 1 < nt) { const bf16_t* kp; const bf16_t* vp; int kld, vld; tile_src(M, j + 1, kp, kld, vp, vld); tile_load(F, R, kp, kld, vp, vld); }
                diff_pass2(lds + AT_K0 + cur * AT_KTB, lds + AT_V0 + cur * AT_VTB, Qf, O, w0, w1, F.lane);
                if (j + 1 < nt) tile_store(F, R, lds + AT_K0 + (cur ^ 1) * AT_KTB, lds + AT_V0 + (cur ^ 1) * AT_VTB);
                __syncthreads();
            }
        } else {
#pragma unroll 1
            for (int j = 0; j < nt; ++j) {
                const int cur = j & 1;
                if (j + 1 < nt) { const bf16_t* kp; const bf16_t* vp; int kld, vld; tile_src(M, j + 1, kp, kld, vp, vld); tile_load(F, R, kp, kld, vp, vld); }
                LAS const unsigned char* kt = lds + AT_K0 + cur * AT_KTB; LAS const unsigned char* vt = lds + AT_V0 + cur * AT_VTB;
                if constexpr (NA) {
                    if (j < M.nlat) { const int kr = rlo + j;
                        if (kr >= r0w && kr < r0w + 8) attn_compute1<true>(kt, vt, Qf, O, ls[0], F.lane, rpbl + (kr - r + 7) * 31, cq); }
                    else attn_compute1<false>(kt, vt, Qf, O, ls[0], F.lane, rpbl, cq);
                } else attn_compute1<false>(kt, vt, Qf, O, ls[0], F.lane, rpbl, cq);
                if (j + 1 < nt) {
                    if (j + 1 < M.nlat) tile_norm_k(F, R, kgl, (MODE == 0) ? P.out + O_NAK + (size_t)(b * 256 + (j + 1) * 64) * 1024 + h * 128 : nullptr, 1024);
                    tile_store(F, R, lds + AT_K0 + (cur ^ 1) * AT_KTB, lds + AT_V0 + (cur ^ 1) * AT_VTB); }
                __syncthreads();
            }
        }
        if constexpr (!DIFF) {
            const float inv = 1.f / (ls[0] + __shfl_xor(ls[0], 32));
            bf16_t* op = MIX + (size_t)(tok0 + q) * DM + h * 128 + 4 * hh;
#pragma unroll
            for (int db = 0; db < 4; ++db)
#pragma unroll
                for (int g = 0; g < 4; ++g) { u32x2 w; w.x = pk2(O[db][4 * g] * inv, O[db][4 * g + 1] * inv); w.y = pk2(O[db][4 * g + 2] * inv, O[db][4 * g + 3] * inv);
                    *(u32x2*)(op + db * 32 + 8 * g) = w; }
        } else {
            float ss = 0.f;
#pragma unroll
            for (int db = 0; db < 4; ++db)
#pragma unroll
                for (int i = 0; i < 16; ++i) ss += O[db][i] * O[db][i];
            ss += __shfl_xor(ss, 32);
            const float sc = rsqrtf(ss * (1.f / 128.f) + NORM_EPS) * (1.f - 0.35550906759096924f);
            const float* sg = P.in[I_SUBG];
            bf16_t* op = MIX + (size_t)(tok0 + q) * DM + 1024 + h * 128 + 4 * hh;
#pragma unroll
            for (int db = 0; db < 4; ++db)
#pragma unroll
                for (int g = 0; g < 4; ++g) { const f32x4 g4 = *(const f32x4*)(sg + db * 32 + 8 * g + 4 * hh);
                    u32x2 w; w.x = pk2(O[db][4 * g] * sc * g4.x, O[db][4 * g + 1] * sc * g4.y); w.y = pk2(O[db][4 * g + 2] * sc * g4.z, O[db][4 * g + 3] * sc * g4.w);
                    *(u32x2*)(op + db * 32 + 8 * g) = w; }
        }
    }
}
template <int L, int BATCH> struct HyCfg {
    static constexpr int NB = L / 64, TPT = 32 / BATCH, NTILES = NB / TPT, LOGB = (BATCH == 8) ? 3 : 5;
    static constexpr int ZROWB = (L + 384) * 2 + 16, ZBYTES = BATCH * ZROWB, RL = 2 * L + 16;
    static constexpr int TPW = (NTILES + 7) / 8;
};
constexpr int HY_KR_OFF = 71808;

template <int L, int BATCH>
DI void hyena_part(const Ctx& F, const Params& P, int c, int tokbase  , const bf16_t* KRG  ) {
    typedef HyCfg<L, BATCH> C;
    LAS unsigned char* lds = F.lds;
    bf16_t* CM = (bf16_t*)(P.ws + WS_RB);
    const float* hbias = P.in[I_HYBIAS];
    const int q = F.lane & 31, hh = F.lane >> 5;
    __syncthreads();
    for (int id = F.tid; id < BATCH * (L / 8); id += NTHR) { const int b = id / (L / 8), s8 = (id % (L / 8)) * 8;
        *(LAS u32x4*)(lds + b * C::ZROWB + (192 + s8) * 2) = *(const u32x4*)(CM + (size_t)c * TOK + tokbase + b * L + s8); }
    for (int id = F.tid; id < BATCH * 48; id += NTHR) { const int b = id / 48, k = id % 48, e = (k < 24) ? k * 8 : (192 + L + (k - 24) * 8);
        *(LAS u32x4*)(lds + b * C::ZROWB + e * 2) = (u32x4){0u, 0u, 0u, 0u}; }
#pragma unroll 1
    for (int o = 0; o < 2; ++o) {
        { const bf16_t* src = KRG + (size_t)(o * 1024 + c) * C::RL;
          for (int id = F.tid; id < C::RL / 8; id += NTHR) { const u32x4 v = *(const u32x4*)(src + id * 8);
              *(LAS u32x4*)(lds + HY_KR_OFF + id * 16) = v;
              LAS bf16_t* c1 = (LAS bf16_t*)(lds + HY_KR_OFF + C::RL * 2) + id * 8 - 1;
              if (id > 0) c1[0] = (bf16_t)(v.x & 0xffff);
              c1[1] = (bf16_t)(v.x >> 16); c1[2] = (bf16_t)(v.y & 0xffff); c1[3] = (bf16_t)(v.y >> 16); c1[4] = (bf16_t)(v.z & 0xffff); c1[5] = (bf16_t)(v.z >> 16);
              c1[6] = (bf16_t)(v.w & 0xffff); c1[7] = (bf16_t)(v.w >> 16); } }
        __syncthreads();
        f32x16 acc[C::TPW][2];
#pragma unroll
        for (int t = 0; t < C::TPW; ++t)
#pragma unroll
            for (int mt = 0; mt < 2; ++mt)
#pragma unroll
                for (int i = 0; i < 16; ++i) acc[t][mt][i] = 0.f;
        const int tq0 = F.wave * C::TPW;
        if (tq0 < C::NTILES) {
            const int d1lo = C::TPT * tq0 - (C::NB - 1), d1hi = C::TPT * (tq0 + C::TPW - 1) + C::TPT - 1;
            const int abase = HY_KR_OFF + (F.lane & 1) * (C::RL * 2) + (L - (F.lane & 31) + 8 * hh - (F.lane & 1)) * 2;
            bf16x8 W0[6], W1[6], B0[C::TPW][4];
#define HY_LDW(Wv, d1v, i) do { LAS const unsigned* ap_ = (LAS const unsigned*)(lds + abase + (-4 * (d1v) - 2 + (i)) * 32); Wv[i] = __builtin_bit_cast(bf16x8, (u32x4){ap_[0], ap_[1], ap_[2], ap_[3]}); } while (0)
#define HY_LDB(Bv, d1v) do { _Pragma("unroll") for (int t_ = 0; t_ < C::TPW; ++t_) { const int tq_ = tq0 + t_; \
            const int t1_ = C::TPT * tq_ + (q >> C::LOGB), b_ = q & (BATCH - 1); int s1_ = t1_ - (d1v); s1_ = min(max(s1_, -3), C::NB + 2); \
            LAS const unsigned char* bp_ = lds + b_ * C::ZROWB + (192 + 64 * s1_ + 8 * hh) * 2; \
            _Pragma("unroll") for (int ks_ = 0; ks_ < 4; ++ks_) Bv[t_][ks_] = *(const LAS bf16x8*)(bp_ + ks_ * 32); } } while (0)
#define HY_MM(Wv, Bv, d1v) do { _Pragma("unroll") for (int t_ = 0; t_ < C::TPW; ++t_) { const int tq_ = tq0 + t_; \
            if ((d1v) >= C::TPT * tq_ - (C::NB - 1) && (d1v) <= C::TPT * tq_ + C::TPT - 1) { \
                _Pragma("unroll") for (int ks_ = 0; ks_ < 4; ++ks_) _Pragma("unroll") for (int mt_ = 0; mt_ < 2; ++mt_) \
                    acc[t_][mt_] = __builtin_amdgcn_mfma_f32_32x32x16_bf16(Wv[ks_ - 2 * mt_ + 2], Bv[t_][ks_], acc[t_][mt_], 0, 0, 0); } } } while (0)
#pragma unroll
            for (int i = 0; i < 6; ++i) HY_LDW(W0, d1lo, i);
            int d1 = d1lo;
#pragma unroll 1
            for (; d1 + 1 <= d1hi; d1 += 2) {
                HY_LDB(B0, d1);
#pragma unroll
                for (int i = 0; i < 4; ++i) HY_LDW(W1, d1 + 1, i);
                W1[4] = W0[0]; W1[5] = W0[1];
                HY_MM(W0, B0, d1);
                HY_LDB(B0, d1 + 1);
                if (d1 + 2 <= d1hi) {
#pragma unroll
                    for (int i = 0; i < 4; ++i) HY_LDW(W0, d1 + 2, i);
                    W0[4] = W1[0]; W0[5] = W1[1];
                }
                HY_MM(W1, B0, d1 + 1);
            }
            if (d1 <= d1hi) { HY_LDB(B0, d1); HY_MM(W0, B0, d1); }
#undef HY_LDW
#undef HY_LDB
#undef HY_MM
        }
        __syncthreads();
        if (tq0 < C::NTILES) {
            const float bo = hbias[o * 1024 + c];
            const bf16_t* gate = CM + (size_t)((1 + o) * 1024 + c) * TOK + tokbase;
            bf16_t* zout = (bf16_t*)(P.ws + WS_RA + RA_ZC) + (size_t)c * TOK + tokbase;
#pragma unroll
            for (int t = 0; t < C::TPW; ++t) { const int tq = tq0 + t, t1 = C::TPT * tq + (q >> C::LOGB), b = q & (BATCH - 1);
#pragma unroll
                for (int mt = 0; mt < 2; ++mt)
#pragma unroll
                    for (int g = 0; g < 4; ++g) { const int s = 64 * t1 + 32 * mt + 8 * g + 4 * hh;
                        LAS u32x2* zp = (LAS u32x2*)(lds + b * C::ZROWB + (192 + s) * 2);
                        const u32x2 zv = *zp, gv = *(const u32x2*)(gate + (size_t)b * L + s);
                        const float r0 = bflo(gv.x) * (acc[t][mt][4 * g] + bflo(zv.x) * bo), r1 = bfhi(gv.x) * (acc[t][mt][4 * g + 1] + bfhi(zv.x) * bo);
                        const float r2 = bflo(gv.y) * (acc[t][mt][4 * g + 2] + bflo(zv.y) * bo), r3 = bfhi(gv.y) * (acc[t][mt][4 * g + 3] + bfhi(zv.y) * bo);
                        const u32x2 w = (u32x2){pk2(r0, r1), pk2(r2, r3)};
                        if (o == 0) *zp = w; else *(u32x2*)(zout + (size_t)b * L + s) = w; } }
        }
        __syncthreads();
    }
}

DI void hyena_phase(const Ctx& F, const Params& P) {
    for (int c = F.bid; c < 1024; c += F.G) {
        hyena_part<LS, 8>(F, P, c, TP, (const bf16_t*)(P.ws + WS_KRS));
        hyena_part<LP, 32>(F, P, c, 0, (const bf16_t*)(P.ws + WS_KRP));
    }
}

DI void hyena_post(const Ctx& F, const Params& P) {
    const bf16_t* CM = (const bf16_t*)(P.ws + WS_RA + RA_ZC); bf16_t* MIX = (bf16_t*)(P.ws + WS_HM);
    for (int t = F.bid; t < 16 * 640; t += F.G) { const int cg = t & 15, tg = t >> 4;
        tr_tile_bf16(F, CM + (size_t)(cg * 64) * TOK + tg * 64, TOK, MIX + (size_t)(tg * 64) * DM + 1024 + cg * 64, DM, (LAS bf16_t*)F.lds); }
}
DI void prep_c(const Ctx& F, const Params& P) {
    bf16_t* PA = (bf16_t*)(P.ws + WS_RA);
    LAS float* rope = (LAS float*)(F.lds + 16384);
    __syncthreads();
    for (int e = F.tid; e < 1024; e += NTHR) { const int pos = e >> 4, f = e & 15; const float inv = exp2f(-(float)f * (13.287712379549449f / 16.f)); const float a = (float)pos * inv;
        rope[e * 2] = cosf(a); rope[e * 2 + 1] = sinf(a); }
    __syncthreads();
    { const float* gsrc = (F.lane < 32 ? P.in[I_DQG] : P.in[I_DKG]) + (F.lane & 1) * 32; float* ok = P.out + O_DK;
      float g[32];
#pragma unroll
      for (int i = 0; i < 32; ++i) g[i] = gsrc[i];
      for (int T = F.bid * 8 + F.wave; T < TOK; T += F.G * 8) {
          bf16_t* rp = PA + (size_t)T * 4096 + 1024 + F.lane * 32;
          u32x4 v[4]; float x[32]; float ss = 0.f;
#pragma unroll
          for (int j = 0; j < 4; ++j) { v[j] = *(const u32x4*)(rp + j * 8);
              x[j * 8 + 0] = bflo(v[j].x); x[j * 8 + 1] = bfhi(v[j].x); x[j * 8 + 2] = bflo(v[j].y); x[j * 8 + 3] = bfhi(v[j].y);
              x[j * 8 + 4] = bflo(v[j].z); x[j * 8 + 5] = bfhi(v[j].z); x[j * 8 + 6] = bflo(v[j].w); x[j * 8 + 7] = bfhi(v[j].w); }
#pragma unroll
          for (int i = 0; i < 32; ++i) ss += x[i] * x[i];
          ss += dpp_xor1(ss);
          const float rstd = rsqrtf(ss * (1.f / 64.f) + NORM_EPS);
#pragma unroll
          for (int i = 0; i < 32; ++i) x[i] = x[i] * rstd * g[i];
          if (T < TP) { if (F.lane >= 32) { float* o = ok + (size_t)T * 1024 + (F.lane - 32) * 32;
#pragma unroll
                  for (int j = 0; j < 8; ++j) *(f32x4*)(o + j * 4) = (f32x4){x[j * 4], x[j * 4 + 1], x[j * 4 + 2], x[j * 4 + 3]}; } }
          else { const int t = (T - TP) & 4095, pos = (F.lane & 1) ? (t & 63) : (t >> 6);
              const LAS float* rt = rope + pos * 32;
#pragma unroll
              for (int f = 0; f < 16; ++f) { const float cs = rt[2 * f], sn = rt[2 * f + 1], a = x[f], b = x[16 + f]; x[f] = a * cs - b * sn; x[16 + f] = b * cs + a * sn; } }
#pragma unroll
          for (int j = 0; j < 4; ++j) { u32x4 w; w.x = pk2(x[j * 8 + 0], x[j * 8 + 1]); w.y = pk2(x[j * 8 + 2], x[j * 8 + 3]); w.z = pk2(x[j * 8 + 4], x[j * 8 + 5]); w.w = pk2(x[j * 8 + 6], x[j * 8 + 7]);
              *(u32x4*)(rp + j * 8) = w; }
      } }
    __syncthreads();
    bf16_t* VTp = (bf16_t*)(P.ws + WS_VT); bf16_t* VTs = (bf16_t*)(P.ws + WS_VT + VT_S);
    for (int t = F.bid; t < 2048 + 8192; t += F.G) {
        if (t < 2048) { const int bh = t >> 3, sub = t & 7, tk = sub >> 1, dd = sub & 1, b = bh >> 3, h = bh & 7;
            tr_tile_bf16(F, PA + ((size_t)(b * 256 + tk * 64)) * 4096 + 3072 + h * 128 + dd * 64, 4096, VTp + ((size_t)bh * 128 + dd * 64) * 256 + tk * 64, 256, (LAS bf16_t*)F.lds); }
        else { const int u = t - 2048, bh = u >> 7, sub = u & 127, tk = sub >> 1, dd = sub & 1, b = bh >> 3, h = bh & 7;
            tr_tile_bf16(F, PA + ((size_t)(TP + b * 4096 + tk * 64)) * 4096 + 3072 + h * 128 + dd * 64, 4096, VTs + ((size_t)bh * 128 + dd * 64) * 4096 + tk * 64, 4096, (LAS bf16_t*)F.lds); }
    }
    { float* o = P.out + O_DV;
      for (int e = F.bid * NTHR + F.tid; e < TP * 128; e += F.G * NTHR) { const int T = e >> 7, c8 = (e & 127) * 8;
          const u32x4 v = *(const u32x4*)(PA + (size_t)T * 4096 + 3072 + c8);
          *(f32x4*)(o + (size_t)T * 1024 + c8) = (f32x4){bflo(v.x), bfhi(v.x), bflo(v.y), bfhi(v.y)};
          *(f32x4*)(o + (size_t)T * 1024 + c8 + 4) = (f32x4){bflo(v.z), bfhi(v.z), bflo(v.w), bfhi(v.w)}; } }
}

constexpr int S5_BUROW = 132 * 4, S5_HROW = 272, S5_WLDS = 16 * S5_BUROW + 16 * S5_HROW;
DI void s5_chain(const Ctx& F, const Params& P, int dg, int tok0, int L, const float* h0re, const float* h0im, float* fre, float* fim, bf16_t* Yout) {
    LAS unsigned char* wl = F.lds + F.wave * S5_WLDS; LAS unsigned char* hl = wl + 16 * S5_BUROW;
    const int g = dg & 63, dir = dg >> 6, lane = F.lane, st = lane & 15, gq = lane >> 4;
    const float* S5A = (const float*)(P.ws + WS_S5A); const bf16_t* BB = (const bf16_t*)(P.ws + WS_S5BB); const bf16_t* CC = (const bf16_t*)(P.ws + WS_S5CC);
    const bf16_t* PA = (const bf16_t*)(P.ws + WS_RA);
    const float ar = S5A[(dg * 64 + lane) * 2], ai = S5A[(dg * 64 + lane) * 2 + 1];
    float hr = h0re ? h0re[lane] : 0.f, hi = h0im ? h0im[lane] : 0.f;
    const bf16x8 zero8 = (bf16x8){0, 0, 0, 0, 0, 0, 0, 0};
    bf16x8 BBf[8], CCf[4];
#pragma unroll
    for (int mt = 0; mt < 8; ++mt) BBf[mt] = (gq < 2) ? *(const bf16x8*)(BB + ((size_t)dg * 128 + mt * 16 + st) * 16 + gq * 8) : zero8;
#pragma unroll
    for (int kk = 0; kk < 4; ++kk) CCf[kk] = *(const bf16x8*)(CC + ((size_t)dg * 16 + st) * 128 + kk * 32 + gq * 8);
    const int nch = L / 16;
    const int sgn = dir ? -1 : 1, tstart = dir ? tok0 + L - 1 : tok0;
    bf16x8 Uf = zero8, U1 = zero8, U2 = zero8;
    if (gq < 2) { Uf = *(const bf16x8*)(PA + (size_t)(tstart + sgn * st) * 4096 + g * 16 + gq * 8);
        if (1 < nch) U1 = *(const bf16x8*)(PA + (size_t)(tstart + sgn * (16 + st)) * 4096 + g * 16 + gq * 8);
        if (2 < nch) U2 = *(const bf16x8*)(PA + (size_t)(tstart + sgn * (32 + st)) * 4096 + g * 16 + gq * 8); }
    for (int ch = 0; ch < nch; ++ch) {
        bf16x8 Un = zero8;
        if (ch + 3 < nch && gq < 2) Un = *(const bf16x8*)(PA + (size_t)(tstart + sgn * ((ch + 3) * 16 + st)) * 4096 + g * 16 + gq * 8);
#pragma unroll
        for (int mt = 0; mt < 8; ++mt) { f32x4 d = (f32x4){0.f, 0.f, 0.f, 0.f};
            d = __builtin_amdgcn_mfma_f32_16x16x32_bf16(BBf[mt], Uf, d, 0, 0, 0);
            *(LAS f32x4*)(wl + st * S5_BUROW + (mt * 16 + gq * 4) * 4) = d; }
        asm volatile("" ::: "memory");
#pragma unroll
        for (int s = 0; s < 16; ++s) {
            const float bur = *(const LAS float*)(wl + s * S5_BUROW + lane * 4), bui = *(const LAS float*)(wl + s * S5_BUROW + (64 + lane) * 4);
            const float nr = ar * hr - ai * hi + bur, ni = ar * hi + ai * hr + bui; hr = nr; hi = ni;
            *(LAS bf16_t*)(hl + s * S5_HROW + lane * 2) = f2bf(hr); *(LAS bf16_t*)(hl + s * S5_HROW + (64 + lane) * 2) = f2bf(hi);
        }
        asm volatile("" ::: "memory");
        f32x4 y = (f32x4){0.f, 0.f, 0.f, 0.f};
#pragma unroll
        for (int kk = 0; kk < 4; ++kk) { const bf16x8 Bh = *(const LAS bf16x8*)(hl + st * S5_HROW + (kk * 32 + gq * 8) * 2);
            y = __builtin_amdgcn_mfma_f32_16x16x32_bf16(CCf[kk], Bh, y, 0, 0, 0); }
        { const int tok = tstart + sgn * (ch * 16 + st);
          *(u32x2*)(Yout + (size_t)tok * 1024 + g * 16 + gq * 4) = (u32x2){pk2(y[0], y[1]), pk2(y[2], y[3])}; }
        asm volatile("" ::: "memory");
        Uf = U1; U1 = U2; U2 = Un;
    }
    if (fre) { fre[lane] = hr; fim[lane] = hi; }
}

DI void s5_phase(const Ctx& F, const Params& P) {
    bf16_t* YF = (bf16_t*)(P.ws + WS_RB + RB_YF); bf16_t* YB = (bf16_t*)(P.ws + WS_RB + RB_YB);
    for (int cs = F.bid; cs < 256; cs += F.G) {
        if (F.wave < 4) { const int sc = cs * 4 + F.wave, dg = sc & 127, b = sc >> 7;
            s5_chain(F, P, dg, TP + b * 4096, LS, P.in[I_S5RE] + (size_t)sc * 64, P.in[I_S5IM] + (size_t)sc * 64, nullptr, nullptr, (dg >> 6) ? YB : YF); }
        else { for (int k = 0; k < 4; ++k) { const int pc = (cs * 4 + (F.wave - 4)) * 4 + k, dg = pc & 127, b = pc >> 7;
            s5_chain(F, P, dg, b * 256, LP, nullptr, nullptr, P.out + O_SR + (size_t)pc * 64, P.out + O_SI + (size_t)pc * 64, (dg >> 6) ? YB : YF); } }
    }
}

DI void s5_combine(const Ctx& F, const Params& P) {
    const bf16_t* PA = (const bf16_t*)(P.ws + WS_RA); const bf16_t* YF = (const bf16_t*)(P.ws + WS_RB + RB_YF); const bf16_t* YB = (const bf16_t*)(P.ws + WS_RB + RB_YB);
    bf16_t* Y = (bf16_t*)(P.ws + WS_RB + RB_Y); const float* dsk = P.in[I_S5D];
    for (size_t e = (size_t)F.bid * NTHR + F.tid; e < (size_t)TOK * 128; e += (size_t)F.G * NTHR) { const size_t T = e >> 7; const int c8 = (int)(e & 127) * 8;
        const u32x4 uv = *(const u32x4*)(PA + T * 4096 + c8), fv = *(const u32x4*)(YF + T * 1024 + c8), bv = *(const u32x4*)(YB + T * 1024 + c8);
        const f32x4 d0 = *(const f32x4*)(dsk + c8), d1 = *(const f32x4*)(dsk + c8 + 4);
        float o[8];
        o[0] = gelu_tanh(d0.x * bflo(uv.x) + bflo(fv.x) + bflo(bv.x)); o[1] = gelu_tanh(d0.y * bfhi(uv.x) + bfhi(fv.x) + bfhi(bv.x));
        o[2] = gelu_tanh(d0.z * bflo(uv.y) + bflo(fv.y) + bflo(bv.y)); o[3] = gelu_tanh(d0.w * bfhi(uv.y) + bfhi(fv.y) + bfhi(bv.y));
        o[4] = gelu_tanh(d1.x * bflo(uv.z) + bflo(fv.z) + bflo(bv.z)); o[5] = gelu_tanh(d1.y * bfhi(uv.z) + bfhi(fv.z) + bfhi(bv.z));
        o[6] = gelu_tanh(d1.z * bflo(uv.w) + bflo(fv.w) + bflo(bv.w)); o[7] = gelu_tanh(d1.w * bfhi(uv.w) + bfhi(fv.w) + bfhi(bv.w));
        u32x4 w; w.x = pk2(o[0], o[1]); w.y = pk2(o[2], o[3]); w.z = pk2(o[4], o[5]); w.w = pk2(o[6], o[7]);
        *(u32x4*)(Y + T * 1024 + c8) = w; }
}
constexpr int PS_KROW = 272;
constexpr int PS_IDX_OFF = 2 * 128 * PS_KROW;
constexpr int PS_TAB_OFF = PS_IDX_OFF + 512 * 32;

DI void topk_insert(float (&a)[16], float x) {
#pragma unroll
    for (int j = 15; j >= 1; --j) a[j] = __builtin_amdgcn_fmed3f(a[j - 1], a[j], x);
    a[0] = fmaxf(a[0], x);
}

DI void peer_select(const Ctx& F, const Params& P, int layer) {
    LAS unsigned char* lds = F.lds;
    const bf16_t* Q = (const bf16_t*)(P.ws + WS_RA + RA_Q);
    int* SELI = (int*)(P.ws + WS_RA + RA_SELI); float* SELW = (float*)(P.ws + WS_RA + RA_SELW);
    const bf16_t* KEYS = (const bf16_t*)(P.ws + WS_PKEYS) + (size_t)layer * 8 * 2 * 128 * 128;
    const int q = F.lane & 31, hh = F.lane >> 5;
    LAS unsigned char* myidx = lds + PS_IDX_OFF + F.tid * 32;
    LAS unsigned char* tab = lds + PS_TAB_OFF;
    for (int wu = F.bid; wu < 256; wu += F.G) {
        const int h = wu & 7, chunk = wu >> 3;
        __syncthreads();
        for (int id = F.tid; id < 2 * 128 * 16; id += NTHR) { const int row = id >> 4, c16 = id & 15;
            *(LAS u32x4*)(lds + row * PS_KROW + c16 * 16) = *(const u32x4*)(KEYS + ((size_t)h * 256 + row) * 128 + c16 * 8); }
        if (F.tid < 16) { int cnt = 0;
            for (int a = 0; a < F.tid; ++a) cnt += 16 / (a + 1);
            for (int b = 0; b < 16 / (F.tid + 1); ++b) { tab[(cnt + b) * 2] = (unsigned char)F.tid; tab[(cnt + b) * 2 + 1] = (unsigned char)b; } }
        __syncthreads();
        for (int blk = F.wave; blk < 40; blk += 8) {
            const int T0 = chunk * 1280 + blk * 32;
            float lst[2][16];
#pragma unroll
            for (int side = 0; side < 2; ++side) {
                bf16x8 Qf[8];
                const bf16_t* qp = Q + (size_t)(T0 + q) * 2048 + h * 256 + side * 128 + hh * 8;
#pragma unroll
                for (int ks = 0; ks < 8; ++ks) Qf[ks] = *(const bf16x8*)(qp + ks * 16);
                float a[16];
#pragma unroll
                for (int j = 0; j < 16; ++j) a[j] = -3.0e38f;
#pragma unroll
                for (int nt = 0; nt < 4; ++nt) {
                    f32x16 S;
#pragma unroll
                    for (int i = 0; i < 16; ++i) S[i] = 0.f;
#pragma unroll
                    for (int ks = 0; ks < 8; ++ks) { const bf16x8 A = *(const LAS bf16x8*)(lds + (side * 128 + nt * 32 + q) * PS_KROW + (ks * 16 + hh * 8) * 2);
                        S = __builtin_amdgcn_mfma_f32_32x32x16_bf16(A, Qf[ks], S, 0, 0, 0); }
#pragma unroll
                    for (int i = 0; i < 16; ++i) { const int n = nt * 32 + (i & 3) + 8 * (i >> 2) + 4 * hh;
                        topk_insert(a, __uint_as_float((__float_as_uint(S[i]) & 0xffffff80u) | (unsigned)n)); }
                }
                float pb[16];
#pragma unroll
                for (int j = 0; j < 16; ++j) pb[j] = __shfl_xor(a[j], 32);
#pragma unroll
                for (int j = 0; j < 16; ++j) topk_insert(a, pb[j]);
#pragma unroll
                for (int j = 0; j < 16; ++j) { lst[side][j] = a[j]; myidx[side * 16 + j] = (unsigned char)(__float_as_uint(a[j]) & 0x7fu); }
            }
            float cb[16];
#pragma unroll
            for (int j = 0; j < 16; ++j) cb[j] = -3.0e38f;
            { int cid = 0;
#pragma unroll
              for (int a = 0; a < 16; ++a)
#pragma unroll
                  for (int b = 0; b < 16 / (a + 1); ++b) {
                      const float sa = __uint_as_float(__float_as_uint(lst[0][a]) & 0xffffff80u), sb = __uint_as_float(__float_as_uint(lst[1][b]) & 0xffffff80u);
                      topk_insert(cb, __uint_as_float((__float_as_uint(sa + sb) & 0xffffffc0u) | (unsigned)cid)); ++cid; } }
            const float mx = __uint_as_float(__float_as_uint(cb[0]) & 0xffffffc0u);
            float e[16], den = 0.f;
#pragma unroll
            for (int j = 0; j < 16; ++j) { e[j] = __expf(__uint_as_float(__float_as_uint(cb[j]) & 0xffffffc0u) - mx); den += e[j]; }
            const float rden = 1.f / den;
#pragma unroll
            for (int j = 0; j < 16; ++j) {
                if ((j >> 3) == hh) { const int cid = (int)(__float_as_uint(cb[j]) & 0x3fu);
                    const int a = tab[cid * 2], b = tab[cid * 2 + 1];
                    const int eidx = (int)myidx[a] * 128 + (int)myidx[16 + b];
                    SELI[(size_t)(T0 + q) * 128 + h * 16 + j] = eidx; SELW[(size_t)(T0 + q) * 128 + h * 16 + j] = e[j] * rden; }
            }
        }
    }
    __syncthreads();
}

DI u32x16 fp6_unpack_bf16(u32x4 a, u32x2 b) { const u32x6 pk = {a.x, a.y, a.z, a.w, b.x, b.y}; return __builtin_bit_cast(u32x16, __builtin_amdgcn_cvt_scalef32_pk32_bf16_fp6(pk, 1.0f)); }
DI f32x32 fp6_unpack(u32x4 a, u32x2 b) { const u32x6 pk = {a.x, a.y, a.z, a.w, b.x, b.y}; return __builtin_amdgcn_cvt_scalef32_pk32_f32_fp6(pk, 1.0f); }
constexpr int GN = 4;
template <bool NEXTNORM>
DI void peer_gather(const Ctx& F, const Params& P, const float* modl, int layer, const float* ngain, const float* nmodl) {
    const bf16_t* H2 = (const bf16_t*)(P.ws + WS_HM);
    const unsigned char* TU = P.ws + WS_TBLU + (size_t)layer * 16384 * PT_ROWB; const unsigned char* TV = P.ws + WS_TBLV + (size_t)layer * 16384 * PT_ROWB;
    const float* SCU = (const float*)(P.ws + WS_SC) + layer * 16384; const float* SCV = (const float*)(P.ws + WS_SC) + (2 + layer) * 16384;
    const int* SELI = (const int*)(P.ws + WS_RA + RA_SELI); const float* SELW = (const float*)(P.ws + WS_RA + RA_SELW);
    float* X = P.out + O_Y;
    const int lane = lane_id();
    const int stride = F.G * 8;
    for (int T0 = F.bid * 8 + F.wave; T0 < TOK; T0 += 2 * stride) {
        const bool two = (T0 + stride < TOK);
        const int Tt[2] = {T0, two ? T0 + stride : T0};
        u32x4 xw[2][4]; int e0[2], e1[2]; float g0[2], g1[2], d0[2], d1[2];
#pragma unroll
        for (int t = 0; t < 2; ++t) {
#pragma unroll
            for (int q4 = 0; q4 < 4; ++q4) xw[t][q4] = *(const u32x4*)(H2 + (size_t)Tt[t] * DM + lane * 32 + q4 * 8);
            e0[t] = SELI[(size_t)Tt[t] * 128 + lane]; e1[t] = SELI[(size_t)Tt[t] * 128 + 64 + lane];
            g0[t] = SELW[(size_t)Tt[t] * 128 + lane]; g1[t] = SELW[(size_t)Tt[t] * 128 + 64 + lane]; d0[t] = 0.f; d1[t] = 0.f; }
#pragma unroll 1
        for (int kb = 0; kb < 128; kb += GN) {
            u32x4 ura[2][GN]; u32x2 urb[2][GN];
#pragma unroll
            for (int j = 0; j < GN; ++j)
#pragma unroll
                for (int t = 0; t < 2; ++t) { const int k = kb + j; const int e = __builtin_amdgcn_readlane(k < 64 ? e0[t] : e1[t], k & 63);
                    const unsigned char* up = TU + (size_t)e * PT_ROWB;
                    ura[t][j] = *(const u32x4*)(up + lane * 16); urb[t][j] = *(const u32x2*)(up + 1024 + lane * 8); }
#pragma unroll
            for (int j = 0; j < GN; ++j) { float pt[2];
#pragma unroll
                for (int t = 0; t < 2; ++t) { const u32x16 r = fp6_unpack_bf16(ura[t][j], urb[t][j]);
                    float sa = 0.f, sb = 0.f, sc2 = 0.f, sd = 0.f;
#pragma unroll
                    for (int i = 0; i < 4; ++i) { const unsigned x0 = xw[t][i].x, x1 = xw[t][i].y, x2 = xw[t][i].z, x3 = xw[t][i].w;
                        sa = dot2bf(r[4 * i], x0, sa); sb = dot2bf(r[4 * i + 1], x1, sb); sc2 = dot2bf(r[4 * i + 2], x2, sc2); sd = dot2bf(r[4 * i + 3], x3, sd); }
                    pt[t] = (sa + sb) + (sc2 + sd); }
                const float sm0 = wave_sum(pt[0]), sm1 = wave_sum(pt[1]); const int k = kb + j;
                if (k < 64) { if (lane == k) { d0[0] = sm0; d0[1] = sm1; } } else { if (lane == k - 64) { d1[0] = sm0; d1[1] = sm1; } } }
        }
        float cf0[2], cf1[2];
#pragma unroll
        for (int t = 0; t < 2; ++t) { cf0[t] = g0[t] * gelu_tanh(d0[t] * SCU[e0[t]]) * SCV[e0[t]]; cf1[t] = g1[t] * gelu_tanh(d1[t] * SCU[e1[t]]) * SCV[e1[t]]; }
        f32x2 acc[2][16];
#pragma unroll
        for (int t = 0; t < 2; ++t)
#pragma unroll
            for (int i = 0; i < 16; ++i) acc[t][i] = (f32x2){0.f, 0.f};
#pragma unroll 1
        for (int kb = 0; kb < 128; kb += GN) {
            u32x4 vra[2][GN]; u32x2 vrb[2][GN]; float cf[2][GN];
#pragma unroll
            for (int j = 0; j < GN; ++j)
#pragma unroll
                for (int t = 0; t < 2; ++t) { const int k = kb + j; const int e = __builtin_amdgcn_readlane(k < 64 ? e0[t] : e1[t], k & 63);
                    cf[t][j] = __builtin_bit_cast(float, __builtin_amdgcn_readlane(__builtin_bit_cast(int, k < 64 ? cf0[t] : cf1[t]), k & 63));
                    const unsigned char* vp = TV + (size_t)e * PT_ROWB;
                    vra[t][j] = *(const u32x4*)(vp + lane * 16); vrb[t][j] = *(const u32x2*)(vp + 1024 + lane * 8); }
#pragma unroll
            for (int j = 0; j < GN; ++j)
#pragma unroll
                for (int t = 0; t < 2; ++t) { const f32x32 r = fp6_unpack(vra[t][j], vrb[t][j]);
                    const f32x2 c2 = (f32x2){cf[t][j], cf[t][j]};
#pragma unroll
                    for (int i = 0; i < 16; ++i) acc[t][i] += c2 * (f32x2){r[2 * i], r[2 * i + 1]}; }
        }
#pragma unroll
        for (int t = 0; t < 2; ++t) {
            if (t == 1 && !two) break;
            const int T = Tt[t];
            const float* gate = modl + (size_t)(cond_of(T) * 6 + 5) * DM;
            f32x4 xn[8]; float ss = 0.f;
#pragma unroll
            for (int q4 = 0; q4 < 8; ++q4) { const int col = lane * 32 + q4 * 4; float* xp = X + (size_t)T * DM + col;
                const f32x4 gv = *(const f32x4*)(gate + col), x0 = *(const f32x4*)(xp);
                const f32x4 r = x0 + gv * (f32x4){acc[t][q4 * 2].x, acc[t][q4 * 2].y, acc[t][q4 * 2 + 1].x, acc[t][q4 * 2 + 1].y};
                *(f32x4*)(xp) = r; xn[q4] = r; ss += r.x * r.x + r.y * r.y + r.z * r.z + r.w * r.w; }
            if (NEXTNORM) {
                ss = wave_sum(ss);
                const float rstd = rsqrtf(ss * (1.f / DM) + NORM_EPS);
                const float* sh = nmodl + (size_t)(cond_of(T) * 6 + 0) * DM; const float* sc = sh + DM;
                bf16_t* H = (bf16_t*)(P.ws + WS_HM);
#pragma unroll
                for (int q4 = 0; q4 < 8; ++q4) { const int col = lane * 32 + q4 * 4;
                    const f32x4 g4 = *(const f32x4*)(ngain + col), s4 = *(const f32x4*)(sc + col), h4 = *(const f32x4*)(sh + col);
                    const f32x4 o = xn[q4] * rstd * g4 * (s4 + 1.f) + h4;
                    *(u32x2*)(H + (size_t)T * DM + col) = (u32x2){pk2(o.x, o.y), pk2(o.z, o.w)}; }
            }
        }
    }
}
constexpr int NPHASE = 22;

__global__ void __launch_bounds__(NTHR, 2) mega(Params P) {
    extern __shared__ __attribute__((aligned(16))) unsigned char lds_raw[];
    Ctx F;
    F.lds = (LAS unsigned char*)lds_raw; F.tid = threadIdx.x; F.lane = F.tid & 63; F.wave = __builtin_amdgcn_readfirstlane(F.tid >> 6); F.G = gridDim.x; F.bid = blockIdx.x;
    const int lo = P.ph_lo, hi = P.ph_hi;
    volatile LAS unsigned* xbw = (volatile LAS unsigned*)(F.lds + LDS_BYTES - 16);
    if (F.tid == 0) { xbw[0] = 0u; xbw[1] = 0u; xbw[2] = 0u; xbw[3] = 0u; }
    __syncthreads();
    if (hi - lo > 1) (void)xcd_barrier_post((unsigned*)(P.ws + WS_CTL), xbw);
#define GRID_BARRIER() do { XcdBarrier bar_; bar_.bar = (unsigned*)(P.ws + WS_CTL); bar_.x = xb_xcc_id(); bar_.st = (volatile LAS unsigned*)(F.lds + LDS_BYTES - 16); xcd_barrier(bar_); } while (0)
#define PH(k, ...) if (lo <= (k) && (k) < hi) { { __VA_ARGS__ } if ((k) + 1 < hi) GRID_BARRIER(); }
#define MOD0 ((const float*)(P.ws + WS_MOD))
#define MOD1 ((const float*)(P.ws + WS_MOD) + 9 * 12288)
#define HM ((bf16_t*)(P.ws + WS_HM))
#define RA ((bf16_t*)(P.ws + WS_RA))
#define X (P.out + O_Y)

    PH(0, prologue(F, P);)
    PH(1, adaln_reduce(F, P);)
    PH(2, norm_phase(F, P.in[I_XP], P.in[I_XS], P.in[I_NMIXG], MOD0, 0, HM);)
    PH(3, { EpiBf16 E{RA, 4096}; run_gemm(F, HM, (const bf16_t*)(P.ws + WS_WEVIN) + (size_t)2048 * 2048, 4096, 2048, E); })
    PH(4, prep_a(F, P);)
    PH(5, { EpiBf16 E{RA, 2048}; run_gemm(F, HM, (const bf16_t*)(P.ws + WS_WEVIN), 2048, 2048, E); })
    PH(6, attn_phase<0>(F, P); attn_phase<1>(F, P); hyena_phase(F, P);)
    PH(7, hyena_post(F, P);)
    PH(8, { EpiResid E{P.in[I_XP], P.in[I_XS], X, MOD0, 2}; run_gemm(F, HM, (const bf16_t*)(P.ws + WS_WEVOUT), 2048, 2048, E); })
    PH(9, norm_phase(F, X, X + (size_t)TP * DM, P.in[I_NFFNG], MOD0, 3, HM);)
    PH(10, { EpiBf16 E{RA, 2048}; run_gemm(F, HM, (const bf16_t*)(P.ws + WS_WPQ), 2048, 2048, E); })
    PH(11, peer_select(F, P, 0);)
    PH(12, peer_gather<true>(F, P, MOD0, 0, P.in[I_NMIXG] + DM, MOD1);)
    PH(13, { EpiBf16 E{RA, 4096}; run_gemm(F, HM, (const bf16_t*)(P.ws + WS_WODIN), 4096, 2048, E); })
    PH(14, prep_c(F, P); s5_phase(F, P);)
    PH(15, attn_phase<2>(F, P); attn_phase<3>(F, P); s5_combine(F, P);)
    PH(16, { EpiGlu E{(const bf16_t*)(P.ws + WS_RB + RB_Y), HM, P.in[I_GLUB]}; run_gemm(F, (const bf16_t*)(P.ws + WS_RB + RB_Y), (const bf16_t*)(P.ws + WS_WGLU), 1024, 1024, E); })
    PH(17, { EpiResid E{X, X + (size_t)TP * DM, X, MOD1, 2}; run_gemm(F, HM, (const bf16_t*)(P.ws + WS_WODOUT), 2048, 2048, E); })
    PH(18, norm_phase(F, X, X + (size_t)TP * DM, P.in[I_NFFNG] + DM, MOD1, 3, HM);)
    PH(19, { EpiBf16 E{RA, 2048}; run_gemm(F, HM, (const bf16_t*)(P.ws + WS_WPQ) + (size_t)2048 * 2048, 2048, 2048, E); })
    PH(20, peer_select(F, P, 1);)
    PH(21, peer_gather<false>(F, P, MOD1, 1, nullptr, nullptr);)
#undef MOD0
#undef MOD1
#undef HM
#undef RA
#undef X
#undef PH
#undef GRID_BARRIER
}

extern "C" void kernel_launch(void* const* d_in, const int* in_sizes, int n_in, void* d_out, int out_size, void* d_ws, size_t ws_size, hipStream_t stream) {
    static int grid = 0;
    if (grid == 0) {
        if (n_in != N_IN || (size_t)out_size != O_END || ws_size < WS_END) { fprintf(stderr, "kernel_launch: unexpected shapes (n_in %d, out %d, ws %zu, need %zu)\n", n_in, out_size, ws_size, (size_t)WS_END); grid = -1; return; }
        int dev = 0, cus = 0;
        if (hipGetDevice(&dev) != hipSuccess || hipDeviceGetAttribute(&cus, hipDeviceAttributeMultiprocessorCount, dev) != hipSuccess) { grid = -1; return; }
        if (hipFuncSetAttribute((const void*)mega, hipFuncAttributeMaxDynamicSharedMemorySize, LDS_BYTES) != hipSuccess) { fprintf(stderr, "kernel_launch: hipFuncSetAttribute failed\n"); grid = -1; return; }
        int per_cu = 0;
        if (hipOccupancyMaxActiveBlocksPerMultiprocessor(&per_cu, (const void*)mega, NTHR, LDS_BYTES) != hipSuccess || per_cu < 1) { fprintf(stderr, "kernel_launch: occupancy query says %d blocks per CU\n", per_cu); }
        (void)hipGetLastError();
        grid = cus;
    }
    if (grid < 0) return;
    (void)hipMemsetAsync((char*)d_ws + WS_CTL, 0, 65536, stream);
    Params p; memset(&p, 0, sizeof(p));
    for (int i = 0; i < N_IN; ++i) p.in[i] = (const float*)d_in[i];
    p.out = (float*)d_out; p.ws = (unsigned char*)d_ws;
    p.ph_lo = 0; p.ph_hi = NPHASE;
    hipLaunchKernelGGL(mega, dim3(grid), dim3(NTHR), LDS_BYTES, stream, p);
}
```

```cpp
#include <hip/hip_runtime.h>
#include <cstdio>
#include <cstring>
#include <cstdint>

typedef unsigned short bf16_t;
typedef short bf16x8 __attribute__((ext_vector_type(8)));
typedef short s16x4 __attribute__((ext_vector_type(4)));
typedef float f32x2 __attribute__((ext_vector_type(2)));
typedef float f32x4 __attribute__((ext_vector_type(4)));
typedef float f32x16 __attribute__((ext_vector_type(16)));
typedef unsigned u32x2 __attribute__((ext_vector_type(2)));
typedef unsigned u32x4 __attribute__((ext_vector_type(4)));
typedef __bf16 bf16x2_t __attribute__((ext_vector_type(2)));
typedef float f32x32 __attribute__((ext_vector_type(32)));
typedef unsigned u32x6 __attribute__((ext_vector_type(6)));
typedef unsigned u32x16 __attribute__((ext_vector_type(16)));
typedef __bf16 bf16x32_t __attribute__((ext_vector_type(32)));

#define DI __device__ __forceinline__

constexpr int NTHR = 512;
constexpr int DM = 2048;
constexpr int TP = 8192;
constexpr int TS = 32768;
constexpr int TOK = TP + TS;
constexpr int LP = 256, LS = 4096;
constexpr float NORM_EPS = 1e-6f;
constexpr float LOG2E = 1.4426950408889634f;

enum { I_XP = 0, I_XS, I_C, I_CNK, I_CNV, I_CDK, I_CDV, I_S5RE, I_S5IM, I_CCTX, I_MODW, I_MODB, I_NMIXG, I_NFFNG, I_EVWIN, I_EVWOUT, I_NAQG, I_NAKG, I_RPB,
       I_HYCW, I_HYCB, I_HYW1, I_HYB1, I_HYF1, I_HYW2, I_HYB2, I_HYF2, I_HYW3, I_HYDEC, I_HYBIAS, I_ODWIN, I_ODWOUT, I_S5LRE, I_S5LIM, I_S5LDT, I_S5BRE, I_S5BIM,
       I_S5CRE, I_S5CIM, I_S5D, I_GLUW, I_GLUB, I_DQG, I_DKG, I_LQ1, I_LK1, I_LQ2, I_LK2, I_SUBG, I_PWQ, I_PKEYS, I_PU, I_PV, N_IN };

constexpr size_t O_Y = 0;
constexpr size_t O_NAK = 83886080, O_NAV = 92274688, O_DK = 100663296, O_DV = 109051904, O_SR = 117440512, O_SI = 117702656, O_END = 117964800;

constexpr size_t al256(size_t x) { return (x + 255) & ~(size_t)255; }
constexpr size_t WS_CTL = 0;
constexpr size_t WS_MODP = 65536;
constexpr size_t WS_MOD = WS_MODP + (size_t)2 * 16 * 9 * 12288 * 4;
constexpr size_t WS_WEVIN = al256(WS_MOD + (size_t)2 * 9 * 12288 * 4);
constexpr size_t WS_WEVOUT = WS_WEVIN + (size_t)6144 * 2048 * 2;
constexpr size_t WS_WODIN = WS_WEVOUT + (size_t)2048 * 2048 * 2;
constexpr size_t WS_WODOUT = WS_WODIN + (size_t)4096 * 2048 * 2;
constexpr size_t WS_WPQ = WS_WODOUT + (size_t)2048 * 2048 * 2;
constexpr size_t WS_WGLU = WS_WPQ + (size_t)2 * 2048 * 2048 * 2;
constexpr size_t WS_PKEYS = WS_WGLU + (size_t)1024 * 1024 * 2;
constexpr size_t WS_CNK = WS_PKEYS + (size_t)2 * 8 * 2 * 128 * 128 * 2;
constexpr size_t WS_CNVT = WS_CNK + (size_t)8 * 256 * 1024 * 2;
constexpr size_t WS_CDK = WS_CNVT + (size_t)8 * 256 * 1024 * 2;
constexpr size_t WS_CDVT = WS_CDK + (size_t)8 * 256 * 1024 * 2;
constexpr size_t WS_S5A = WS_CDVT + (size_t)8 * 256 * 1024 * 2;
constexpr size_t WS_S5BB = WS_S5A + (size_t)128 * 64 * 2 * 4;
constexpr size_t WS_S5CC = WS_S5BB + (size_t)128 * 128 * 16 * 2;
constexpr int KRL_S = 8208, KRL_P = 528;
constexpr size_t WS_KRS = WS_S5CC + (size_t)128 * 16 * 128 * 2;
constexpr size_t WS_KRP = al256(WS_KRS + (size_t)2 * 1024 * KRL_S * 2);
constexpr size_t WS_TBLU = al256(WS_KRP + (size_t)2 * 1024 * KRL_P * 2);
constexpr size_t WS_TBLV = WS_TBLU + (size_t)16384 * 2048 * 2;
constexpr size_t WS_HM = WS_TBLV + (size_t)16384 * 2048 * 2;
constexpr size_t WS_RA = WS_HM + (size_t)TOK * 2048 * 2;
constexpr size_t WS_RB = WS_RA + (size_t)TOK * 4096 * 2;
constexpr size_t WS_VT = WS_RB + (size_t)3072 * TOK * 2;
constexpr size_t WS_SC = WS_VT + (size_t)TOK * 1024 * 2;
constexpr size_t WS_END = WS_SC + (size_t)4 * 16384 * 4;
constexpr size_t RA_Q = 0;
constexpr size_t RA_SELI = (size_t)TOK * 2048 * 2;
constexpr size_t RA_SELW = RA_SELI + (size_t)TOK * 128 * 4;
constexpr size_t RA_CF = RA_SELW + (size_t)TOK * 128 * 4;
constexpr size_t RA_ZC = (size_t)TOK * 2048 * 2;
constexpr size_t RB_YF = 0, RB_YB = (size_t)TOK * 1024 * 2, RB_Y = (size_t)2 * TOK * 1024 * 2;
constexpr size_t VT_S = (size_t)TP * 1024 * 2;

constexpr int LDS_BYTES = 147456;

struct Params { const float* in[N_IN]; float* out; unsigned char* ws; int ph_lo, ph_hi; };

DI float bf2f(bf16_t b) { return __uint_as_float(((unsigned)b) << 16); }
DI float bflo(unsigned w) { return __uint_as_float(w << 16); }
DI float bfhi(unsigned w) { return __uint_as_float(w & 0xffff0000u); }
DI unsigned pk2(float a, float b) { f32x2 v = {a, b}; return __builtin_bit_cast(unsigned, __builtin_convertvector(v, bf16x2_t)); }
DI float dot2bf(unsigned a, unsigned b, float c) { return __builtin_amdgcn_fdot2_f32_bf16(__builtin_bit_cast(bf16x2_t, a), __builtin_bit_cast(bf16x2_t, b), c, false); }
DI bf16_t f2bf(float a) { return (bf16_t)(pk2(a, 0.f) & 0xffffu); }
DI float dpp_xor1(float v) { return __builtin_bit_cast(float, __builtin_amdgcn_update_dpp(0, __builtin_bit_cast(int, v), 0xB1, 0xF, 0xF, true)); }
DI float dpp_xor2(float v) { return __builtin_bit_cast(float, __builtin_amdgcn_update_dpp(0, __builtin_bit_cast(int, v), 0x4E, 0xF, 0xF, true)); }
DI float wave_sum(float v) {
    v += dpp_xor1(v); v += dpp_xor2(v);
    v += __builtin_bit_cast(float, __builtin_amdgcn_update_dpp(0, __builtin_bit_cast(int, v), 0x141, 0xF, 0xF, true));
    v += __builtin_bit_cast(float, __builtin_amdgcn_update_dpp(0, __builtin_bit_cast(int, v), 0x140, 0xF, 0xF, true));
    v += __builtin_bit_cast(float, __builtin_amdgcn_update_dpp(0, __builtin_bit_cast(int, v), 0x142, 0xA, 0xF, false));
    v += __builtin_bit_cast(float, __builtin_amdgcn_update_dpp(0, __builtin_bit_cast(int, v), 0x143, 0xC, 0xF, false));
    return __builtin_bit_cast(float, __builtin_amdgcn_readlane(__builtin_bit_cast(int, v), 63));
}
DI float gelu_tanh(float x) {
    const float u = 0.7978845608028654f * (x + 0.044715f * x * x * x);
    const float e = __expf(2.f * u);
    const float t = 1.f - 2.f / (e + 1.f);
    return 0.5f * x * (1.f + t);
}
DI float wave_max(float v) {
    v = fmaxf(v, dpp_xor1(v)); v = fmaxf(v, dpp_xor2(v));
    v = fmaxf(v, __builtin_bit_cast(float, __builtin_amdgcn_update_dpp(0, __builtin_bit_cast(int, v), 0x141, 0xF, 0xF, true)));
    v = fmaxf(v, __builtin_bit_cast(float, __builtin_amdgcn_update_dpp(0, __builtin_bit_cast(int, v), 0x140, 0xF, 0xF, true)));
    v = fmaxf(v, __builtin_bit_cast(float, __builtin_amdgcn_update_dpp(0, __builtin_bit_cast(int, v), 0x142, 0xA, 0xF, false)));
    v = fmaxf(v, __builtin_bit_cast(float, __builtin_amdgcn_update_dpp(0, __builtin_bit_cast(int, v), 0x143, 0xC, 0xF, false)));
    return __builtin_bit_cast(float, __builtin_amdgcn_readlane(__builtin_bit_cast(int, v), 63));
}
DI f32x2 fp8x2_lo(unsigned w) { return __builtin_amdgcn_cvt_pk_f32_fp8((int)w, false); }
DI f32x2 fp8x2_hi(unsigned w) { return __builtin_amdgcn_cvt_pk_f32_fp8((int)w, true); }
DI unsigned pk_fp8x4(float a, float b, float c, float d) { int r = 0; r = __builtin_amdgcn_cvt_pk_fp8_f32(a, b, r, false); r = __builtin_amdgcn_cvt_pk_fp8_f32(c, d, r, true); return (unsigned)r; }
DI int lane_id() { return (int)__builtin_amdgcn_mbcnt_hi(~0u, __builtin_amdgcn_mbcnt_lo(~0u, 0u)); }
DI int cond_of(int T) { return T < TP ? 0 : 1 + ((T - TP) >> 12); }
#define XB_TMO      128
#define XB_XCNT(j)  (256  + 64 * (j))
#define XB_XSUB(j)  (1280 + 64 * (j))
#define XB_XGEN(j)  (2304 + 64 * (j))
#define XB_TOP      3328
#define XB_TOPGEN   3392
#define XCD_BAR_WORDS 3456
#define XB_SPIN_CAP (1u << 26)
#define LAS __attribute__((address_space(3)))

__device__ __forceinline__ unsigned xb_ld(unsigned* p)              { return __hip_atomic_load(p, __ATOMIC_RELAXED, __HIP_MEMORY_SCOPE_AGENT); }
__device__ __forceinline__ unsigned xb_add(unsigned* p, unsigned v) { return __hip_atomic_fetch_add(p, v, __ATOMIC_RELAXED, __HIP_MEMORY_SCOPE_AGENT); }
__device__ __forceinline__ unsigned xb_xcc_id() { return (unsigned)__builtin_amdgcn_s_getreg((3 << 11) | 20) & 0xFu; }
#define XB_SPIN(cond, bar) do { unsigned _sp = 0; while (cond) { __builtin_amdgcn_s_sleep(1); \
    if ((++_sp & 255u) == 0u) { if (xb_ld(&(bar)[XB_TMO])) break; if (_sp > XB_SPIN_CAP) { atomicAdd(&(bar)[XB_TMO], 1u); break; } } } } while (0)

struct XcdBarrier {
    unsigned* bar; unsigned x;
    volatile LAS unsigned* st;
};

__device__ __forceinline__ XcdBarrier xcd_barrier_post(unsigned* bar, volatile LAS unsigned* st) {
    XcdBarrier b; b.bar = bar; b.x = xb_xcc_id(); b.st = st;
    if (threadIdx.x == 0) (void)xb_add(&bar[XB_XCNT(b.x)], 1u);
    return b;
}
__device__ __forceinline__ void xcd_barrier_complete(unsigned* bar, unsigned x, unsigned& nloc, unsigned& nx) {
    const unsigned G = gridDim.x * gridDim.y * gridDim.z;
    unsigned sum, cnt, mine, sp = 0u;
    for (;;) {
        sum = 0u; cnt = 0u; mine = 0u;
#pragma unroll
        for (unsigned j = 0; j < 16; ++j) { const unsigned c = xb_ld(&bar[XB_XCNT(j)]); sum += c; cnt += (c > 0u) ? 1u : 0u; mine = (j == x) ? c : mine; }
        if (sum == G) break;
        __builtin_amdgcn_s_sleep(1);
        if ((++sp & 255u) == 0u) { if (xb_ld(&bar[XB_TMO])) break; if (sp > XB_SPIN_CAP) { atomicAdd(&bar[XB_TMO], 1u); break; } }
    }
    nloc = mine > 0u ? mine : 1u; nx = cnt > 0u ? cnt : 1u;
}

__device__ __forceinline__ void xcd_barrier(const XcdBarrier& b) {
    asm volatile("s_waitcnt vmcnt(0)" ::: "memory");
    __syncthreads();
    if (threadIdx.x == 0) {
        unsigned* bar = b.bar;
        __builtin_amdgcn_s_waitcnt(0);
        unsigned nloc = b.st[0], nx = b.st[1];
        if (nloc == 0u) { xcd_barrier_complete(bar, b.x, nloc, nx); b.st[0] = nloc; b.st[1] = nx; }
        const unsigned old = xb_add(&bar[XB_XSUB(b.x)], 1u);
        const unsigned gen = old / nloc;
        if (old + 1u == (gen + 1u) * nloc) {
            __builtin_amdgcn_fence(__ATOMIC_RELEASE, "agent");
            asm volatile("s_waitcnt vmcnt(0)" ::: "memory");
            const unsigned og = xb_add(&bar[XB_TOP], 1u);
            const unsigned tg = og / nx;
            if (og + 1u == (tg + 1u) * nx) xb_add(&bar[XB_TOPGEN], 1u);
            else XB_SPIN(xb_ld(&bar[XB_TOPGEN]) == tg, bar);
            __builtin_amdgcn_fence(__ATOMIC_ACQUIRE, "agent");
            xb_add(&bar[XB_XGEN(b.x)], 1u);
            asm volatile("s_waitcnt vmcnt(0)" ::: "memory");
        } else {
            XB_SPIN(xb_ld(&bar[XB_XGEN(b.x)]) == gen, bar);
            __builtin_amdgcn_fence(__ATOMIC_ACQUIRE, "agent");
            asm volatile("s_waitcnt vmcnt(0)" ::: "memory");
        }
    }
    __syncthreads();
}
namespace pg8 {
#define PG8_LAS __attribute__((address_space(3)))
typedef unsigned short bf16_t;
typedef short bf16x8 __attribute__((ext_vector_type(8)));
typedef float f32x4 __attribute__((ext_vector_type(4)));
typedef unsigned u32x4 __attribute__((ext_vector_type(4)));
constexpr int BM = 256, BK = 64, HALF = 128, HTB = HALF * BK * 2  , STAGE_BYTES = 8 * HTB, NXCD = 8, WGM = 8;

__host__ __device__ __forceinline__ int lds_byte(int r, int c) { const int st = (r >> 4) * 2 + (c >> 5), rr = r & 15, cc = c & 31, ob = rr * 64 + cc * 2; return st * 1024 + (ob ^ (((ob >> 9) & 1) << 5)); }
__host__ __device__ __forceinline__ void stage_rc(int b, int& R, int& C) { const int st = b / 1024, sb = b % 1024, swz = sb ^ (((sb >> 9) & 1) << 5); R = (st >> 1) * 16 + swz / 64; C = (st & 1) * 32 + (swz % 64) / 2; }
__host__ __device__ __forceinline__ int perm32(int rho) { const int n = rho >> 4, i = rho & 15; return 8 * (i >> 2) + 4 * n + (i & 3); }

struct Unit { int pm, pn; };
struct Gemm { const bf16_t* A; const bf16_t* Bt; int M, N, K; };

struct StaticOrder {
    int nM, nN, nwg, G, c;
    __host__ __device__ void init(int M, int N, int G_, int c_) { nM = M / BM; nN = N / BM; nwg = nM * nN; G = G_; c = c_; }
    __host__ __device__ bool next(int i, Unit& u) const {
        const long L = (long)i * G + c; if (L >= nwg) return false;
        int wgid = (int)L; { const int q = nwg / NXCD, r = nwg % NXCD, xcd = wgid % NXCD, off = wgid / NXCD; wgid = (xcd < r ? xcd * (q + 1) : r * (q + 1) + (xcd - r) * q) + off; }
        const int nig = WGM * nN, gid = wgid / nig, fm = gid * WGM, gsz = (nM - fm) < WGM ? (nM - fm) : WGM;
        u.pm = fm + ((wgid % nig) % gsz); u.pn = (wgid % nig) / gsz; return true;
    }
    __device__ __forceinline__ void a_ready(const Unit&) const {}
    __device__ __forceinline__ void done(const Unit&) const {}
};
__device__ __forceinline__ unsigned cvt_pk_bf16(float lo, float hi) { unsigned r; asm volatile("v_cvt_pk_bf16_f32 %0, %1, %2" : "=v"(r) : "v"(lo), "v"(hi)); return r; }
template <class Epi, class Sched, bool STAMP = false>
__device__ __forceinline__ void gemm_phase(PG8_LAS unsigned char* lds, const Gemm g, const Sched& S, const Epi& E, unsigned long long* stamps) {
    const int tid = threadIdx.x, wid = __builtin_amdgcn_readfirstlane(tid >> 6), lane = tid & 63, wr = wid >> 2, wc = wid & 3, fr = lane & 15, fq = lane >> 4;
    const int K = g.K, nt = K / BK;
    int ts_lo = 0, ts_hi = 0, nts = 0; const unsigned long long rt_entry = STAMP ? (unsigned long long)wall_clock64() : 0ull;
#define PG8_STAMP() do { if (STAMP && wid == 0 && nts < 64) { const unsigned long long _c = (unsigned long long)clock64(); \
        ts_lo = (lane == nts) ? (int)(unsigned)_c : ts_lo; ts_hi = (lane == nts) ? (int)(unsigned)(_c >> 32) : ts_hi; ++nts; } } while (0)
    PG8_STAMP();
    unsigned voffA[2], voffB[2];
#pragma unroll
    for (int i = 0; i < 2; ++i) { int R, C; stage_rc(tid * 16 + i * 8192, R, C); const int Rb = Epi::PERM ? ((R & ~31) + perm32(R & 31)) : R;
        voffA[i] = (unsigned)(R * K + C) * 2u; voffB[i] = (unsigned)(Rb * K + C) * 2u; }
    const size_t kstep = (size_t)(BK * 2);
    const size_t hstep = (size_t)HALF * K * 2;
    const size_t tstep = 2 * hstep;
    const unsigned ldsw = (unsigned)wid * 1024u;
    const int aoff = lds_byte(wr * 64 + fr, fq * 8), boff = lds_byte(wc * 32 + fr, fq * 8);
#define PG8_SA(b, h) (((b) * 2 + (h)) * HTB)
#define PG8_SB(b, h) ((4 + (b) * 2 + (h)) * HTB)
#define PG8_STAGE(bufoff, gbase, voff) do { _Pragma("unroll") for (int _i = 0; _i < 2; ++_i) \
        __builtin_amdgcn_global_load_lds((const unsigned*)((const char*)(gbase) + (voff)[_i]), (PG8_LAS unsigned*)(lds + (bufoff) + ldsw + _i * 8192), 16, 0, 0); } while (0)
#define PG8_LDA(dst, b, h) do { _Pragma("unroll") for (int m = 0; m < 4; ++m) _Pragma("unroll") for (int k = 0; k < 2; ++k) dst[m][k] = *(const PG8_LAS bf16x8*)(lds + PG8_SA(b, h) + aoff + m * 2048 + k * 1024); } while (0)
#define PG8_LDB(dst, b, h) do { _Pragma("unroll") for (int n = 0; n < 2; ++n) _Pragma("unroll") for (int k = 0; k < 2; ++k) dst[n][k] = *(const PG8_LAS bf16x8*)(lds + PG8_SB(b, h) + boff + n * 2048 + k * 1024); } while (0)
#define PG8_MMA(ai, bj, At, Bt) do { __builtin_amdgcn_s_setprio(1); _Pragma("unroll") for (int m = 0; m < 4; ++m) _Pragma("unroll") for (int n = 0; n < 2; ++n) _Pragma("unroll") for (int k = 0; k < 2; ++k) \
        acc[ai][bj][m][n] = __builtin_amdgcn_mfma_f32_16x16x32_bf16(Bt[n][k], At[m][k], acc[ai][bj][m][n], 0, 0, 0); __builtin_amdgcn_s_setprio(0); } while (0)
#define PG8_WAIT_V(n) asm volatile("s_waitcnt vmcnt(" #n ")" ::: "memory")
#define PG8_WAIT_L(n) asm volatile("s_waitcnt lgkmcnt(" #n ")" ::: "memory")
#define PG8_BAR __builtin_amdgcn_s_barrier()
#define PG8_SCHED __builtin_amdgcn_sched_barrier(0)
    Unit cur, nxt; int ui = 0;
    if (!S.next(0, cur)) return;
    f32x4 acc[2][2][4][2];
#pragma unroll
    for (int a = 0; a < 2; ++a)
#pragma unroll
        for (int b = 0; b < 2; ++b)
#pragma unroll
            for (int m = 0; m < 4; ++m)
#pragma unroll
                for (int n = 0; n < 2; ++n) acc[a][b][m][n] = (f32x4){0.f, 0.f, 0.f, 0.f};
    bf16x8 At[4][2], B0[2][2], B1[2][2];
    const char* cA = (const char*)g.A + (size_t)cur.pm * tstep; const char* cB = (const char*)g.Bt + (size_t)cur.pn * tstep;
    S.a_ready(cur);
    PG8_STAGE(PG8_SB(0, 0), cB, voffB); PG8_STAGE(PG8_SA(0, 0), cA, voffA); PG8_STAGE(PG8_SB(0, 1), cB + hstep, voffB); PG8_STAGE(PG8_SA(0, 1), cA + hstep, voffA);
    if (wr == 1) PG8_BAR;
    PG8_WAIT_V(4); PG8_BAR;
    PG8_STAGE(PG8_SB(1, 0), cB + kstep, voffB); PG8_STAGE(PG8_SA(1, 0), cA + kstep, voffA); PG8_STAGE(PG8_SB(1, 1), cB + hstep + kstep, voffB);
    PG8_WAIT_V(6); PG8_BAR;
    PG8_STAMP();
    for (;;) {
        const bool has_next = S.next(ui + 1, nxt);
        const char* nA = has_next ? (const char*)g.A + (size_t)nxt.pm * tstep : cA; const char* nB = has_next ? (const char*)g.Bt + (size_t)nxt.pn * tstep : cB;
        for (int t = 0; t < nt; t += 2) {
            const bool last = (t == nt - 2);
            const char* a1 = cA + (size_t)(t + 1) * kstep;
            const char* a2 = last ? nA : cA + (size_t)(t + 2) * kstep; const char* b2 = last ? nB : cB + (size_t)(t + 2) * kstep;
            const char* a3 = a2 + kstep; const char* b3 = b2 + kstep;
            if (last && has_next) S.a_ready(nxt);
            PG8_LDB(B0, 0, 0); PG8_SCHED; PG8_LDA(At, 0, 0); PG8_STAGE(PG8_SA(1, 1), a1 + hstep, voffA);
            PG8_WAIT_L(8); PG8_BAR; PG8_WAIT_L(0); PG8_MMA(0, 0, At, B0); PG8_BAR; PG8_SCHED;
            PG8_LDB(B1, 0, 1); PG8_STAGE(PG8_SB(0, 0), b2, voffB);
            PG8_BAR; PG8_WAIT_L(0); PG8_MMA(0, 1, At, B1); PG8_BAR;
            PG8_LDA(At, 0, 1); PG8_STAGE(PG8_SA(0, 0), a2, voffA);
            PG8_BAR; PG8_WAIT_L(0); PG8_MMA(1, 0, At, B0); PG8_BAR; PG8_SCHED;
            PG8_STAGE(PG8_SB(0, 1), b2 + hstep, voffB);
            PG8_WAIT_V(6); PG8_BAR; PG8_MMA(1, 1, At, B1); PG8_BAR;
            PG8_LDB(B0, 1, 0); PG8_SCHED; PG8_LDA(At, 1, 0); PG8_STAGE(PG8_SA(0, 1), a2 + hstep, voffA);
            PG8_WAIT_L(8); PG8_BAR; PG8_WAIT_L(0); PG8_MMA(0, 0, At, B0); PG8_BAR; PG8_SCHED;
            PG8_LDB(B1, 1, 1); PG8_STAGE(PG8_SB(1, 0), b3, voffB);
            PG8_BAR; PG8_WAIT_L(0); PG8_MMA(0, 1, At, B1); PG8_BAR;
            PG8_LDA(At, 1, 1); PG8_STAGE(PG8_SA(1, 0), a3, voffA);
            PG8_BAR; PG8_WAIT_L(0); PG8_MMA(1, 0, At, B0); PG8_BAR; PG8_SCHED;
            PG8_STAGE(PG8_SB(1, 1), b3 + hstep, voffB);
            PG8_WAIT_V(6); PG8_BAR; PG8_MMA(1, 1, At, B1); PG8_BAR;
        }
        PG8_STAMP();
        if constexpr (!Epi::AFTER_DRAIN) { E(acc, cur, wr, wc, fr, fq); S.done(cur); }
        PG8_STAMP();
        if (!has_next) break;
#pragma unroll
        for (int a = 0; a < 2; ++a)
#pragma unroll
            for (int b = 0; b < 2; ++b)
#pragma unroll
                for (int m = 0; m < 4; ++m)
#pragma unroll
                    for (int n = 0; n < 2; ++n) acc[a][b][m][n] = (f32x4){0.f, 0.f, 0.f, 0.f};
        cur = nxt; cA = nA; cB = nB; ++ui;
    }
    PG8_WAIT_V(0);
    if (wr == 0) PG8_BAR;
    PG8_BAR;
    if constexpr (Epi::AFTER_DRAIN) { E.fused(acc, cur, wr, wc, fr, fq, lds, wid, lane); S.done(cur); }
    PG8_STAMP();
    if (STAMP && wid == 0) { stamps[lane] = lane < nts ? (((unsigned long long)(unsigned)ts_hi << 32) | (unsigned)ts_lo) : 0ull;
        if (lane == 62) stamps[62] = rt_entry; if (lane == 63) stamps[63] = (unsigned long long)wall_clock64(); }
#undef PG8_STAMP
#undef PG8_SA
#undef PG8_SB
#undef PG8_STAGE
#undef PG8_LDA
#undef PG8_LDB
#undef PG8_MMA
#undef PG8_WAIT_V
#undef PG8_WAIT_L
#undef PG8_BAR
#undef PG8_SCHED
}
}
struct Ctx {
    LAS unsigned char* lds; int tid, lane, wave, G, bid;
};

DI void cvt_rows(const Ctx& F, const float* src, bf16_t* dst, size_t n) {
    const size_t n8 = n >> 3;
    for (size_t i = (size_t)F.bid * NTHR + F.tid; i < n8; i += (size_t)F.G * NTHR) {
        const f32x4 a = *(const f32x4*)(src + i * 8), b = *(const f32x4*)(src + i * 8 + 4);
        u32x4 w; w.x = pk2(a.x, a.y); w.y = pk2(a.z, a.w); w.z = pk2(b.x, b.y); w.w = pk2(b.z, b.w);
        *(u32x4*)(dst + i * 8) = w;
    }
}

constexpr int TR_S = 68;
DI void tr_tile_out(const Ctx& F, bf16_t* dst, size_t ldd, const LAS bf16_t* tile) {
    const int n = F.tid >> 3, kc = (F.tid & 7) * 8;
    const LAS bf16_t* t = tile + kc * TR_S + n;
    u32x4 v;
    v.x = (unsigned)t[0] | ((unsigned)t[TR_S] << 16); v.y = (unsigned)t[2 * TR_S] | ((unsigned)t[3 * TR_S] << 16);
    v.z = (unsigned)t[4 * TR_S] | ((unsigned)t[5 * TR_S] << 16); v.w = (unsigned)t[6 * TR_S] | ((unsigned)t[7 * TR_S] << 16);
    *(u32x4*)(dst + (size_t)n * ldd + kc) = v;
}
DI void tr_tile_f32(const Ctx& F, const float* src, size_t lds_, bf16_t* dst, size_t ldd, LAS bf16_t* tile) {
#pragma unroll
    for (int j = 0; j < 2; ++j) {
        const int id = F.tid + NTHR * j, kr = id >> 4, nc = (id & 15) * 4;
        const f32x4 v = *(const f32x4*)(src + (size_t)kr * lds_ + nc);
        *(LAS u32x2*)(tile + kr * TR_S + nc) = (u32x2){pk2(v.x, v.y), pk2(v.z, v.w)};
    }
    __syncthreads();
    tr_tile_out(F, dst, ldd, tile);
    __syncthreads();
}
DI void tr_tile_bf16(const Ctx& F, const bf16_t* src, size_t lds_, bf16_t* dst, size_t ldd, LAS bf16_t* tile) {
    { const int kr = F.tid >> 3, nc = (F.tid & 7) * 8; const u32x4 v = *(const u32x4*)(src + (size_t)kr * lds_ + nc);
      *(LAS u32x2*)(tile + kr * TR_S + nc) = (u32x2){v.x, v.y}; *(LAS u32x2*)(tile + kr * TR_S + nc + 4) = (u32x2){v.z, v.w}; }
    __syncthreads();
    tr_tile_out(F, dst, ldd, tile);
    __syncthreads();
}
DI void transpose_weight(const Ctx& F, const float* W, int K, int N, bf16_t* Wt) {
    const int tk = K / 64, tn = N / 64;
    for (int t = F.bid; t < tk * tn; t += F.G) {
        const int k0 = (t / tn) * 64, n0 = (t % tn) * 64;
        tr_tile_f32(F, W + (size_t)k0 * N + n0, (size_t)N, Wt + (size_t)n0 * K + k0, (size_t)K, (LAS bf16_t*)F.lds);
    }
}
DI void transpose_cache_v(const Ctx& F, const float* V, bf16_t* VT) {
    for (int t = F.bid; t < 64 * 8; t += F.G) {
        const int bh = t >> 3, sub = t & 7, k0 = (sub >> 1) * 64, d0 = (sub & 1) * 64, b = bh >> 3, h = bh & 7;
        tr_tile_f32(F, V + ((size_t)b * 256 + k0) * 1024 + h * 128 + d0, 1024, VT + ((size_t)bh * 128 + d0) * 256 + k0, 256, (LAS bf16_t*)F.lds);
    }
}

DI void adaln_partials(const Ctx& F, const Params& P) {
    LAS float* s = (LAS float*)F.lds;
    const float* modw = P.in[I_MODW]; const float* cv = P.in[I_C]; const float* cctx = P.in[I_CCTX];
    float* modp = (float*)(P.ws + WS_MODP);
    for (int it = F.bid; it < 192; it += F.G) {
        const int i = it / 96, r = it % 96, ks = r / 6, cg = r % 6;
        __syncthreads();
        for (int e = F.tid; e < 9 * 128; e += NTHR) { const int j = e >> 7, k = e & 127; const float c = (j == 0) ? cctx[ks * 128 + k] : cv[(j - 1) * 2048 + ks * 128 + k]; s[e] = c / (1.f + __expf(-c)); }
        __syncthreads();
        f32x4 acc[9];
#pragma unroll
        for (int j = 0; j < 9; ++j) acc[j] = (f32x4){0.f, 0.f, 0.f, 0.f};
        const float* w = modw + ((size_t)i * 2048 + ks * 128) * 12288 + cg * 2048 + F.tid * 4;
#pragma unroll 8
        for (int k = 0; k < 128; ++k) {
            const f32x4 w4 = *(const f32x4*)(w + (size_t)k * 12288);
#pragma unroll
            for (int j = 0; j < 9; ++j) acc[j] += w4 * s[j * 128 + k];
        }
#pragma unroll
        for (int j = 0; j < 9; ++j) *(f32x4*)(modp + ((size_t)(i * 16 + ks) * 9 + j) * 12288 + cg * 2048 + F.tid * 4) = acc[j];
    }
    __syncthreads();
}
DI void adaln_reduce(const Ctx& F, const Params& P) {
    const float* modp = (const float*)(P.ws + WS_MODP); float* mod = (float*)(P.ws + WS_MOD); const float* modb = P.in[I_MODB];
    for (int e = F.bid * NTHR + F.tid; e < 2 * 9 * 12288; e += F.G * NTHR) {
        const int i = e / (9 * 12288), r = e % (9 * 12288), j = r / 12288, n = r % 12288;
        float a = modb[i * 12288 + n];
#pragma unroll
        for (int ks = 0; ks < 16; ++ks) a += modp[((size_t)(i * 16 + ks) * 9 + j) * 12288 + n];
        mod[e] = a;
    }
}

DI void hyena_filters(const Ctx& F, const Params& P) {
    LAS float* z = (LAS float*)F.lds;
    LAS float* h1 = z + 320;
    LAS float* h2 = h1 + 576;
    const float* w1 = P.in[I_HYW1]; const float* b1 = P.in[I_HYB1]; const float* f1 = P.in[I_HYF1];
    const float* w2 = P.in[I_HYW2]; const float* b2 = P.in[I_HYB2]; const float* f2 = P.in[I_HYF2];
    const float* w3 = P.in[I_HYW3]; const float* dec = P.in[I_HYDEC];
    for (int it = F.bid; it < 544; it += F.G) {
        const bool smp = it < 512; const int L = smp ? LS : LP, p0 = (smp ? it : it - 512) * 8, RL = smp ? KRL_S : KRL_P;
        bf16_t* KR = (bf16_t*)(P.ws + (smp ? WS_KRS : WS_KRP));
        __syncthreads();
        if (F.tid < 9 * 33) {
            const int ps = F.tid / 33, k = F.tid % 33, i = p0 + ps;
            const float t = (float)i / (float)(L - 1), wang = 6.283185307179586f * (float)i / (float)L;
            float val;
            if (k == 0) val = t;
            else { const int f = (k - 1) & 15; const float fr = 1e-4f + (float)f * ((15.0f - 1e-4f) / 15.0f); val = (k <= 16) ? cosf(fr * wang) : -sinf(fr * wang); }
            z[F.tid] = val;
        }
        __syncthreads();
        for (int e = F.tid; e < 9 * 64; e += NTHR) { const int ps = e >> 6, j = e & 63; float a = b1[j];
            for (int k = 0; k < 33; ++k) a += z[ps * 33 + k] * w1[k * 64 + j];
            h1[e] = sinf(f1[j] * a); }
        __syncthreads();
        for (int e = F.tid; e < 9 * 64; e += NTHR) { const int ps = e >> 6, j = e & 63; float a = b2[j];
            for (int k = 0; k < 64; ++k) a += h1[ps * 64 + k] * w2[k * 64 + j];
            h2[e] = sinf(f2[j] * a); }
        __syncthreads();
#pragma unroll 1
        for (int qh = 0; qh < 2; ++qh) {
            float acc[9][4];
#pragma unroll
            for (int ps = 0; ps < 9; ++ps)
#pragma unroll
                for (int q = 0; q < 4; ++q) acc[ps][q] = 0.f;
#pragma unroll 2
            for (int k = 0; k < 64; ++k) {
                float w[4];
#pragma unroll
                for (int q = 0; q < 4; ++q) w[q] = w3[k * 4096 + F.tid + NTHR * (qh * 4 + q)];
#pragma unroll
                for (int ps = 0; ps < 9; ++ps) { const float hv = h2[ps * 64 + k];
#pragma unroll
                    for (int q = 0; q < 4; ++q) acc[ps][q] += hv * w[q]; }
            }
#pragma unroll
            for (int q = 0; q < 4; ++q) {
                const int n = F.tid + NTHR * (qh * 4 + q), o = (n >> 10) & 1, c = n & 1023;
                const float dc = fabsf(dec[n]);
                bf16_t* row = KR + (size_t)(o * 1024 + c) * RL;
                float v[9];
#pragma unroll
                for (int ps = 0; ps < 9; ++ps) { const int i = p0 + ps; v[ps] = (i < L) ? acc[ps][q] * __expf(-((float)i / (float)(L - 1)) * dc) : 0.f; }
                if (qh == 0) {
                    u32x4 wv; wv.x = pk2(v[8], v[7]); wv.y = pk2(v[6], v[5]); wv.z = pk2(v[4], v[3]); wv.w = pk2(v[2], v[1]);
                    *(u32x4*)(row + (L - p0 - 8)) = wv;
                    if (p0 == 0) row[L] = f2bf(v[0]);
                } else if (p0 > 0) {
                    u32x4 wv; wv.x = pk2(v[0], v[1]); wv.y = pk2(v[2], v[3]); wv.z = pk2(v[4], v[5]); wv.w = pk2(v[6], v[7]);
                    *(u32x4*)(row + (L + p0)) = wv;
                } else {
#pragma unroll
                    for (int ps = 1; ps < 8; ++ps) row[L + ps] = f2bf(v[ps]);
                }
            }
        }
    }
    __syncthreads();
    for (int e = F.bid * NTHR + F.tid; e < 2 * 2048; e += F.G * NTHR) {
        const bool smp = e < 2048; const int r = e & 2047, L = smp ? LS : LP, RL = smp ? KRL_S : KRL_P;
        bf16_t* row = (bf16_t*)(P.ws + (smp ? WS_KRS : WS_KRP)) + (size_t)r * RL;
        for (int x = 2 * L; x < RL; ++x) row[x] = 0;
    }
}

DI void s5_consts(const Ctx& F, const Params& P) {
    float* S5A = (float*)(P.ws + WS_S5A); bf16_t* BB = (bf16_t*)(P.ws + WS_S5BB); bf16_t* CC = (bf16_t*)(P.ws + WS_S5CC);
    const float* lre = P.in[I_S5LRE]; const float* lim = P.in[I_S5LIM]; const float* ldt = P.in[I_S5LDT];
    const float* bre = P.in[I_S5BRE]; const float* bim = P.in[I_S5BIM]; const float* cre = P.in[I_S5CRE]; const float* cim = P.in[I_S5CIM];
    for (int e = F.bid * NTHR + F.tid; e < 8192; e += F.G * NTHR) {
        const int dg = e >> 6, n = e & 63;
        const float dt = expf(ldt[dg]), lr = lre[e], li = lim[e];
        const float mag = expf(lr * dt), ar = mag * cosf(li * dt), ai = mag * sinf(li * dt), den = lr * lr + li * li;
        const float cr = ((ar - 1.f) * lr + ai * li) / den, ci = (ai * lr - (ar - 1.f) * li) / den;
        S5A[e * 2] = ar; S5A[e * 2 + 1] = ai;
#pragma unroll
        for (int p = 0; p < 16; ++p) {
            const float br = bre[(size_t)e * 16 + p], bi = bim[(size_t)e * 16 + p];
            BB[((size_t)dg * 128 + n) * 16 + p] = f2bf(cr * br - ci * bi);
            BB[((size_t)dg * 128 + 64 + n) * 16 + p] = f2bf(cr * bi + ci * br);
            CC[((size_t)dg * 16 + p) * 128 + n] = f2bf(cre[((size_t)dg * 16 + p) * 64 + n]);
            CC[((size_t)dg * 16 + p) * 128 + 64 + n] = f2bf(-cim[((size_t)dg * 16 + p) * 64 + n]);
        }
    }
}

constexpr int PT_ROWB = 1536;
DI void cvt_table_fp6(const Ctx& F, const float* src, unsigned char* dst, float* scales, const int (&perm)[32]) {
    LAS float* scr = (LAS float*)(F.lds) + F.wave * 2048 + F.lane;
    for (int r = F.bid * 8 + F.wave; r < 16384; r += F.G * 8) {
        f32x4 v[8]; float m = 0.f;
#pragma unroll
        for (int j = 0; j < 8; ++j) { v[j] = *(const f32x4*)(src + (size_t)r * 2048 + F.lane * 32 + j * 4);
            m = fmaxf(m, fmaxf(fmaxf(fabsf(v[j].x), fabsf(v[j].y)), fmaxf(fabsf(v[j].z), fabsf(v[j].w)))); }
        m = wave_max(m);
        const float inv = (m > 0.f) ? 7.0f / m : 0.f, sc = (m > 0.f) ? m / 7.0f : 0.f;
#pragma unroll
        for (int j = 0; j < 8; ++j) { scr[perm[j * 4 + 0] * 64] = v[j].x * inv; scr[perm[j * 4 + 1] * 64] = v[j].y * inv; scr[perm[j * 4 + 2] * 64] = v[j].z * inv; scr[perm[j * 4 + 3] * 64] = v[j].w * inv; }
        asm volatile("" ::: "memory");
        f32x16 a, b;
#pragma unroll
        for (int i = 0; i < 16; ++i) { a[i] = scr[i * 64]; b[i] = scr[(16 + i) * 64]; }
        asm volatile("" ::: "memory");
        const u32x6 pk = __builtin_amdgcn_cvt_scalef32_2xpk16_fp6_f32(a, b, 1.0f);
        unsigned char* o = dst + (size_t)r * PT_ROWB;
        *(u32x4*)(o + F.lane * 16) = (u32x4){pk[0], pk[1], pk[2], pk[3]}; *(u32x2*)(o + 1024 + F.lane * 8) = (u32x2){pk[4], pk[5]};
        if (F.lane == 0) scales[r] = sc;
    }
}
DI void convert_peer_tables(const Ctx& F, const Params& P) {
    int perm[32];
    { f32x16 a, b;
#pragma unroll
      for (int j = 0; j < 16; ++j) { a[j] = 0.125f * (float)j; b[j] = (j < 8) ? 2.0f + 0.25f * (float)j : 4.0f + 0.5f * (float)(j - 8); }
      const u32x6 pk = __builtin_amdgcn_cvt_scalef32_2xpk16_fp6_f32(a, b, 1.0f);
      const f32x32 rt = __builtin_amdgcn_cvt_scalef32_pk32_f32_fp6(pk, 1.0f);
#pragma unroll
      for (int i = 0; i < 32; ++i) { const float x = rt[i]; const int o = (x < 2.0f) ? (int)(x * 8.0f + 0.5f) : ((x < 4.0f) ? 16 + (int)((x - 2.0f) * 4.0f + 0.5f) : 24 + (int)((x - 4.0f) * 2.0f + 0.5f)); perm[i] = min(max(o, 0), 31); } }
    float* SC = (float*)(P.ws + WS_SC);
    __syncthreads();
    for (int layer = 0; layer < 2; ++layer) {
        cvt_table_fp6(F, P.in[I_PU] + (size_t)layer * 16384 * 2048, P.ws + WS_TBLU + (size_t)layer * 16384 * PT_ROWB, SC + layer * 16384, perm);
        cvt_table_fp6(F, P.in[I_PV] + (size_t)layer * 16384 * 2048, P.ws + WS_TBLV + (size_t)layer * 16384 * PT_ROWB, SC + (2 + layer) * 16384, perm);
    }
    __syncthreads();
}

DI void prologue(const Ctx& F, const Params& P) {
    adaln_partials(F, P);
    transpose_weight(F, P.in[I_EVWIN], 2048, 6144, (bf16_t*)(P.ws + WS_WEVIN));
    transpose_weight(F, P.in[I_EVWOUT], 2048, 2048, (bf16_t*)(P.ws + WS_WEVOUT));
    transpose_weight(F, P.in[I_ODWIN], 2048, 4096, (bf16_t*)(P.ws + WS_WODIN));
    transpose_weight(F, P.in[I_ODWOUT], 2048, 2048, (bf16_t*)(P.ws + WS_WODOUT));
    transpose_weight(F, P.in[I_PWQ], 2048, 2048, (bf16_t*)(P.ws + WS_WPQ));
    transpose_weight(F, P.in[I_PWQ] + (size_t)2048 * 2048, 2048, 2048, (bf16_t*)(P.ws + WS_WPQ) + (size_t)2048 * 2048);
    transpose_weight(F, P.in[I_GLUW], 1024, 1024, (bf16_t*)(P.ws + WS_WGLU));
    cvt_rows(F, P.in[I_PKEYS], (bf16_t*)(P.ws + WS_PKEYS), (size_t)2 * 8 * 2 * 128 * 128);
    cvt_rows(F, P.in[I_CNK], (bf16_t*)(P.ws + WS_CNK), (size_t)8 * 256 * 1024);
    cvt_rows(F, P.in[I_CDK], (bf16_t*)(P.ws + WS_CDK), (size_t)8 * 256 * 1024);
    transpose_cache_v(F, P.in[I_CNV], (bf16_t*)(P.ws + WS_CNVT));
    transpose_cache_v(F, P.in[I_CDV], (bf16_t*)(P.ws + WS_CDVT));
    hyena_filters(F, P);
    s5_consts(F, P);
    convert_peer_tables(F, P);
}
DI void norm_phase(const Ctx& F, const float* xa, const float* xb, const float* gvec, const float* modl, int sidx, bf16_t* H) {
    for (int T = F.bid * 8 + F.wave; T < TOK; T += F.G * 8) {
        const float* xr = T < TP ? xa + (size_t)T * DM : xb + (size_t)(T - TP) * DM;
        f32x4 v[8]; float ss = 0.f;
#pragma unroll
        for (int j = 0; j < 8; ++j) { v[j] = *(const f32x4*)(xr + (j * 64 + F.lane) * 4); ss += v[j].x * v[j].x + v[j].y * v[j].y + v[j].z * v[j].z + v[j].w * v[j].w; }
        ss = wave_sum(ss);
        const float rstd = rsqrtf(ss * (1.f / DM) + NORM_EPS);
        const float* sh = modl + (size_t)(cond_of(T) * 6 + sidx) * DM; const float* sc = sh + DM;
#pragma unroll
        for (int j = 0; j < 8; ++j) {
            const int col = (j * 64 + F.lane) * 4;
            const f32x4 g4 = *(const f32x4*)(gvec + col), s4 = *(const f32x4*)(sc + col), h4 = *(const f32x4*)(sh + col);
            const f32x4 o = v[j] * rstd * g4 * (s4 + 1.f) + h4;
            u32x2 w; w.x = pk2(o.x, o.y); w.y = pk2(o.z, o.w);
            *(u32x2*)(H + (size_t)T * DM + col) = w;
        }
    }
}

struct EpiBf16 {
    static constexpr bool PERM = true, AFTER_DRAIN = false;
    bf16_t* O; int ldc;
    DI void operator()(const f32x4 (&acc)[2][2][4][2], const pg8::Unit& u, int wr, int wc, int fr, int fq) const {
        const int row0 = u.pm * 256 + wr * 64 + fr, col0 = u.pn * 256 + wc * 32 + 8 * fq;
#pragma unroll
        for (int ai = 0; ai < 2; ++ai)
#pragma unroll
            for (int m = 0; m < 4; ++m) { bf16_t* rowp = O + (size_t)(row0 + ai * 128 + m * 16) * ldc + col0;
#pragma unroll
                for (int bj = 0; bj < 2; ++bj) { const f32x4 v0 = acc[ai][bj][m][0], v1 = acc[ai][bj][m][1];
                    u32x4 w; w.x = pk2(v0[0], v0[1]); w.y = pk2(v0[2], v0[3]); w.z = pk2(v1[0], v1[1]); w.w = pk2(v1[2], v1[3]);
                    *(u32x4*)(rowp + bj * 128) = w; } }
    }
};
struct EpiResid {
    static constexpr bool PERM = false, AFTER_DRAIN = false;
    const float* xa; const float* xb; float* out; const float* modl; int gidx;
    DI void operator()(const f32x4 (&acc)[2][2][4][2], const pg8::Unit& u, int wr, int wc, int fr, int fq) const {
        const int row0 = u.pm * 256 + wr * 64 + fr, col0 = u.pn * 256 + wc * 32 + 4 * fq;
        const float* xbase = (u.pm < 32) ? xa : xb - (size_t)TP * DM;
        const float* gate = modl + (size_t)(cond_of(u.pm * 256) * 6 + gidx) * DM;
        f32x4 gv[2][2];
#pragma unroll
        for (int bj = 0; bj < 2; ++bj)
#pragma unroll
            for (int n = 0; n < 2; ++n) gv[bj][n] = *(const f32x4*)(gate + col0 + bj * 128 + n * 16);
#pragma unroll
        for (int ai = 0; ai < 2; ++ai)
#pragma unroll
            for (int m = 0; m < 4; ++m) { const size_t ro = (size_t)(row0 + ai * 128 + m * 16) * DM + col0;
#pragma unroll
                for (int bj = 0; bj < 2; ++bj)
#pragma unroll
                    for (int n = 0; n < 2; ++n) { const f32x4 x4 = *(const f32x4*)(xbase + ro + bj * 128 + n * 16);
                        *(f32x4*)(out + ro + bj * 128 + n * 16) = x4 + gv[bj][n] * acc[ai][bj][m][n]; } }
    }
};
struct EpiGlu {
    static constexpr bool PERM = true, AFTER_DRAIN = false;
    const bf16_t* Y; bf16_t* O; const float* bias;
    DI void operator()(const f32x4 (&acc)[2][2][4][2], const pg8::Unit& u, int wr, int wc, int fr, int fq) const {
        const int row0 = u.pm * 256 + wr * 64 + fr, col0 = u.pn * 256 + wc * 32 + 8 * fq;
#pragma unroll
        for (int bj = 0; bj < 2; ++bj) {
            const f32x4 b0 = *(const f32x4*)(bias + col0 + bj * 128), b1 = *(const f32x4*)(bias + col0 + bj * 128 + 4);
#pragma unroll
            for (int ai = 0; ai < 2; ++ai)
#pragma unroll
                for (int m = 0; m < 4; ++m) { const size_t r = (size_t)(row0 + ai * 128 + m * 16);
                    const u32x4 yv = *(const u32x4*)(Y + r * 1024 + col0 + bj * 128);
                    const f32x4 a0 = acc[ai][bj][m][0] + b0, a1 = acc[ai][bj][m][1] + b1;
                    float o[8];
                    o[0] = bflo(yv.x) / (1.f + __expf(-a0[0])); o[1] = bfhi(yv.x) / (1.f + __expf(-a0[1]));
                    o[2] = bflo(yv.y) / (1.f + __expf(-a0[2])); o[3] = bfhi(yv.y) / (1.f + __expf(-a0[3]));
                    o[4] = bflo(yv.z) / (1.f + __expf(-a1[0])); o[5] = bfhi(yv.z) / (1.f + __expf(-a1[1]));
                    o[6] = bflo(yv.w) / (1.f + __expf(-a1[2])); o[7] = bfhi(yv.w) / (1.f + __expf(-a1[3]));
                    u32x4 w; w.x = pk2(o[0], o[1]); w.y = pk2(o[2], o[3]); w.z = pk2(o[4], o[5]); w.w = pk2(o[6], o[7]);
                    *(u32x4*)(O + r * DM + col0 + bj * 128) = w; }
        }
    }
};
template <class Epi> DI void run_gemm(const Ctx& F, const bf16_t* A, const bf16_t* Bt, int N, int K, const Epi& E) {
    pg8::Gemm g{A, Bt, TOK, N, K}; pg8::StaticOrder S; S.init(TOK, N, F.G, F.bid);
    pg8::gemm_phase<Epi, pg8::StaticOrder, false>(F.lds, g, S, E, nullptr);
    __syncthreads();
}

DI void prep_a(const Ctx& F, const Params& P) {
    const bf16_t* T1 = (const bf16_t*)(P.ws + WS_RA);
    bf16_t* VTp = (bf16_t*)(P.ws + WS_VT); bf16_t* VTs = (bf16_t*)(P.ws + WS_VT + VT_S);
    for (int t = F.bid; t < 2048 + 8192; t += F.G) {
        if (t < 2048) { const int bh = t >> 3, sub = t & 7, tk = sub >> 1, dd = sub & 1, b = bh >> 3, h = bh & 7;
            tr_tile_bf16(F, T1 + ((size_t)(b * 256 + tk * 64)) * 4096 + h * 128 + dd * 64, 4096, VTp + ((size_t)bh * 128 + dd * 64) * 256 + tk * 64, 256, (LAS bf16_t*)F.lds); }
        else { const int u = t - 2048, bh = u >> 7, sub = u & 127, tk = sub >> 1, dd = sub & 1, b = bh >> 3, h = bh & 7;
            tr_tile_bf16(F, T1 + ((size_t)(TP + b * 4096 + tk * 64)) * 4096 + h * 128 + dd * 64, 4096, VTs + ((size_t)bh * 128 + dd * 64) * 4096 + tk * 64, 4096, (LAS bf16_t*)F.lds); }
    }
    { float* o = P.out + O_NAV;
      for (int e = F.bid * NTHR + F.tid; e < TP * 128; e += F.G * NTHR) { const int T = e >> 7, c8 = (e & 127) * 8;
          const u32x4 v = *(const u32x4*)(T1 + (size_t)T * 4096 + c8);
          *(f32x4*)(o + (size_t)T * 1024 + c8) = (f32x4){bflo(v.x), bfhi(v.x), bflo(v.y), bfhi(v.y)};
          *(f32x4*)(o + (size_t)T * 1024 + c8 + 4) = (f32x4){bflo(v.z), bfhi(v.z), bflo(v.w), bfhi(v.w)}; } }
    { LAS bf16_t* tl = (LAS bf16_t*)F.lds;
      bf16_t* CM = (bf16_t*)(P.ws + WS_RB);
      const float* cw = P.in[I_HYCW]; const float* cb = P.in[I_HYCB];
      for (int t = F.bid; t < 48 * 160; t += F.G) {
          const int cg = t % 48, tg = t / 48, ch0 = cg * 64, t0 = tg * 256;
          const bool lz = (t0 < TP) ? true : (((t0 - TP) & 4095) == 0);
          const bool rz = (t0 < TP) ? true : (((t0 + 256 - TP) & 4095) == 0);
          __syncthreads();
#pragma unroll
          for (int j = 0; j < 4; ++j) { const int id = F.tid + NTHR * j, tk = id >> 3, c8 = (id & 7) * 8;
              const u32x4 v = *(const u32x4*)(T1 + (size_t)(t0 + tk) * 4096 + 1024 + ch0 + c8);
              LAS bf16_t* d = tl + tk + 1;
              d[(c8 + 0) * 264] = (bf16_t)(v.x & 0xffff); d[(c8 + 1) * 264] = (bf16_t)(v.x >> 16); d[(c8 + 2) * 264] = (bf16_t)(v.y & 0xffff); d[(c8 + 3) * 264] = (bf16_t)(v.y >> 16);
              d[(c8 + 4) * 264] = (bf16_t)(v.z & 0xffff); d[(c8 + 5) * 264] = (bf16_t)(v.z >> 16); d[(c8 + 6) * 264] = (bf16_t)(v.w & 0xffff); d[(c8 + 7) * 264] = (bf16_t)(v.w >> 16); }
          if (F.tid < 16) { const int side = F.tid >> 3, c8 = (F.tid & 7) * 8; const bool zero = side ? rz : lz; const int tk = side ? t0 + 256 : t0 - 1;
              u32x4 v = (u32x4){0u, 0u, 0u, 0u};
              if (!zero) v = *(const u32x4*)(T1 + (size_t)tk * 4096 + 1024 + ch0 + c8);
              LAS bf16_t* d = tl + (side ? 257 : 0);
              d[(c8 + 0) * 264] = (bf16_t)(v.x & 0xffff); d[(c8 + 1) * 264] = (bf16_t)(v.x >> 16); d[(c8 + 2) * 264] = (bf16_t)(v.y & 0xffff); d[(c8 + 3) * 264] = (bf16_t)(v.y >> 16);
              d[(c8 + 4) * 264] = (bf16_t)(v.z & 0xffff); d[(c8 + 5) * 264] = (bf16_t)(v.z >> 16); d[(c8 + 6) * 264] = (bf16_t)(v.w & 0xffff); d[(c8 + 7) * 264] = (bf16_t)(v.w >> 16); }
          __syncthreads();
#pragma unroll
          for (int j = 0; j < 4; ++j) { const int id = F.tid + NTHR * j, ch = id >> 5, to = (id & 31) * 8, cgl = ch0 + ch;
              const float w0 = cw[cgl], w1 = cw[3072 + cgl], w2 = cw[6144 + cgl], bb = cb[cgl];
              const LAS bf16_t* s = tl + ch * 264 + to;
              float r[10];
#pragma unroll
              for (int i = 0; i < 10; ++i) r[i] = bf2f(s[i]);
              float o[8];
#pragma unroll
              for (int i = 0; i < 8; ++i) o[i] = w0 * r[i] + w1 * r[i + 1] + w2 * r[i + 2] + bb;
              u32x4 w; w.x = pk2(o[0], o[1]); w.y = pk2(o[2], o[3]); w.z = pk2(o[4], o[5]); w.w = pk2(o[6], o[7]);
              *(u32x4*)(CM + (size_t)cgl * TOK + t0 + to) = w; }
      }
      __syncthreads(); }
}

DI void prep_b(const Ctx& F, const Params& P) {
    bf16_t* Pq = (bf16_t*)(P.ws + WS_RA); const float* qg = P.in[I_NAQG]; const float* kg = P.in[I_NAKG]; float* ok = P.out + O_NAK;
    const float* gsrc = (F.lane < 32 ? qg : kg) + (F.lane & 3) * 32;
    float g[32];
#pragma unroll
    for (int i = 0; i < 32; ++i) g[i] = gsrc[i];
    for (int T = F.bid * 8 + F.wave; T < TOK; T += F.G * 8) {
        bf16_t* rp = Pq + (size_t)T * 2048 + F.lane * 32;
        u32x4 v[4]; float x[32]; float ss = 0.f;
#pragma unroll
        for (int j = 0; j < 4; ++j) { v[j] = *(const u32x4*)(rp + j * 8);
            x[j * 8 + 0] = bflo(v[j].x); x[j * 8 + 1] = bfhi(v[j].x); x[j * 8 + 2] = bflo(v[j].y); x[j * 8 + 3] = bfhi(v[j].y);
            x[j * 8 + 4] = bflo(v[j].z); x[j * 8 + 5] = bfhi(v[j].z); x[j * 8 + 6] = bflo(v[j].w); x[j * 8 + 7] = bfhi(v[j].w); }
#pragma unroll
        for (int i = 0; i < 32; ++i) ss += x[i] * x[i];
        ss += dpp_xor1(ss); ss += dpp_xor2(ss);
        const float rstd = rsqrtf(ss * (1.f / 128.f) + NORM_EPS);
#pragma unroll
        for (int i = 0; i < 32; ++i) x[i] = x[i] * rstd * g[i];
#pragma unroll
        for (int j = 0; j < 4; ++j) { u32x4 w; w.x = pk2(x[j * 8 + 0], x[j * 8 + 1]); w.y = pk2(x[j * 8 + 2], x[j * 8 + 3]); w.z = pk2(x[j * 8 + 4], x[j * 8 + 5]); w.w = pk2(x[j * 8 + 6], x[j * 8 + 7]);
            *(u32x4*)(rp + j * 8) = w; }
        if (T < TP && F.lane >= 32) { float* o = ok + (size_t)T * 1024 + (F.lane - 32) * 32;
#pragma unroll
            for (int j = 0; j < 8; ++j) *(f32x4*)(o + j * 4) = (f32x4){x[j * 4], x[j * 4 + 1], x[j * 4 + 2], x[j * 4 + 3]}; }
    }
}
constexpr int AT_KROW = 272, AT_VROW = 136, AT_KTB = 64 * AT_KROW, AT_VTB = 128 * AT_VROW;
constexpr int AT_K0 = 0, AT_V0 = 2 * AT_KTB, AT_RPB = AT_V0 + 2 * AT_VTB;

struct TileMap { const bf16_t* latK; int latKld; const bf16_t* latV; int latVld; int nlat; const bf16_t* ctxK; const bf16_t* ctxV; int ntiles; };
struct TileRegs { u32x4 k[2], v[2]; };

DI void tile_src(const TileMap& M, int j, const bf16_t*& kp, int& kld, const bf16_t*& vp, int& vld) {
    if (j < M.nlat) { kp = M.latK + (size_t)j * 64 * M.latKld; kld = M.latKld; vp = M.latV + j * 64; vld = M.latVld; }
    else { const int c = j - M.nlat; kp = M.ctxK + (size_t)c * 64 * 1024; kld = 1024; vp = M.ctxV + c * 64; vld = 256; }
}
DI void tile_load(const Ctx& F, TileRegs& R, const bf16_t* kp, int kld, const bf16_t* vp, int vld, bool withV = true) {
#pragma unroll
    for (int j = 0; j < 2; ++j) { const int id = F.tid + NTHR * j;
        const unsigned ko = (unsigned)((id >> 4) * kld + (id & 15) * 8) * 2u, vo = (unsigned)((id >> 3) * vld + (id & 7) * 8) * 2u;
        R.k[j] = *(const u32x4*)((const char*)kp + ko);
        if (withV) R.v[j] = *(const u32x4*)((const char*)vp + vo); }
}
DI void tile_store(const Ctx& F, const TileRegs& R, LAS unsigned char* kt, LAS unsigned char* vt, bool withV = true) {
#pragma unroll
    for (int j = 0; j < 2; ++j) { const int id = F.tid + NTHR * j;
        *(LAS u32x4*)(kt + (id >> 4) * AT_KROW + (id & 15) * 16) = R.k[j];
        if (withV) { LAS unsigned char* vp = vt + (id >> 3) * AT_VROW + (id & 7) * 16;
            *(LAS u32x2*)(vp) = (u32x2){R.v[j].x, R.v[j].y}; *(LAS u32x2*)(vp + 8) = (u32x2){R.v[j].z, R.v[j].w}; } }
}

DI void tile_norm_k(const Ctx& F, TileRegs& R, const LAS float* kgain, float* nk, int nkld) {
#pragma unroll
    for (int j = 0; j < 2; ++j) { const int id = F.tid + NTHR * j;
        float x[8] = {bflo(R.k[j].x), bfhi(R.k[j].x), bflo(R.k[j].y), bfhi(R.k[j].y), bflo(R.k[j].z), bfhi(R.k[j].z), bflo(R.k[j].w), bfhi(R.k[j].w)};
        float ss = 0.f;
#pragma unroll
        for (int i = 0; i < 8; ++i) ss += x[i] * x[i];
        ss += dpp_xor1(ss); ss += dpp_xor2(ss);
        ss += __builtin_bit_cast(float, __builtin_amdgcn_update_dpp(0, __builtin_bit_cast(int, ss), 0x141, 0xF, 0xF, true));
        ss += __builtin_bit_cast(float, __builtin_amdgcn_update_dpp(0, __builtin_bit_cast(int, ss), 0x140, 0xF, 0xF, true));
        const float rstd = rsqrtf(ss * (1.f / 128.f) + NORM_EPS);
        const f32x4 g0 = *(const LAS f32x4*)(kgain + (id & 15) * 8), g1 = *(const LAS f32x4*)(kgain + (id & 15) * 8 + 4);
        x[0] *= rstd * g0.x; x[1] *= rstd * g0.y; x[2] *= rstd * g0.z; x[3] *= rstd * g0.w; x[4] *= rstd * g1.x; x[5] *= rstd * g1.y; x[6] *= rstd * g1.z; x[7] *= rstd * g1.w;
        R.k[j] = (u32x4){pk2(x[0], x[1]), pk2(x[2], x[3]), pk2(x[4], x[5]), pk2(x[6], x[7])};
        if (nk) { float* o = nk + (size_t)(id >> 4) * nkld + (id & 15) * 8; *(f32x4*)(o) = (f32x4){x[0], x[1], x[2], x[3]}; *(f32x4*)(o + 4) = (f32x4){x[4], x[5], x[6], x[7]}; }
    }
}

template <int KS>
DI f32x16 qk_tile(LAS const unsigned char* kt, const bf16x8 (&Qf)[8], int kb, int kk0, int q, int hh) {
    f32x16 S;
#pragma unroll
    for (int i = 0; i < 16; ++i) S[i] = 0.f;
#pragma unroll
    for (int ks = 0; ks < KS; ++ks) { const int kk = kk0 + ks;
        const bf16x8 A = *(const LAS bf16x8*)(kt + (kb * 32 + q) * AT_KROW + (kk * 16 + hh * 8) * 2);
        S = __builtin_amdgcn_mfma_f32_32x32x16_bf16(A, Qf[kk], S, 0, 0, 0); }
    return S;
}
DI void pv_tile(LAS const unsigned char* vt, const float (&p)[16], f32x16 (&O)[4], int kb, int q, int hh) {
#pragma unroll
    for (int s = 0; s < 2; ++s) {
        u32x4 pw; pw.x = pk2(p[8 * s + 0], p[8 * s + 1]); pw.y = pk2(p[8 * s + 2], p[8 * s + 3]); pw.z = pk2(p[8 * s + 4], p[8 * s + 5]); pw.w = pk2(p[8 * s + 6], p[8 * s + 7]);
        const bf16x8 Pf = __builtin_bit_cast(bf16x8, pw);
#pragma unroll
        for (int db = 0; db < 4; ++db) {
            LAS const unsigned char* ap = vt + (db * 32 + q) * AT_VROW + (kb * 32 + 16 * s + 4 * hh) * 2;
            const u32x2 lo = *(const LAS u32x2*)(ap), hi = *(const LAS u32x2*)(ap + 16);
            const bf16x8 A2 = __builtin_bit_cast(bf16x8, (u32x4){lo.x, lo.y, hi.x, hi.y});
            O[db] = __builtin_amdgcn_mfma_f32_32x32x16_bf16(A2, Pf, O[db], 0, 0, 0);
        }
        asm volatile("" ::: "memory");
    }
}
template <bool LAT>
DI void attn_compute1(LAS const unsigned char* kt, LAS const unsigned char* vt, const bf16x8 (&Qf)[8], f32x16 (&O)[4], float& ls, int lane, const LAS float* brow, int cq) {
    const int q = lane & 31, hh = lane >> 5;
    const int cs = min(max(cq - 8, 0), 48);
#pragma unroll 1
    for (int kb = 0; kb < 2; ++kb) {
        const f32x16 S = qk_tile<8>(kt, Qf, kb, 0, q, hh);
        float p[16];
#pragma unroll
        for (int i = 0; i < 16; ++i) {
            float arg = S[i];
            if (LAT) { const int ck = kb * 32 + (i & 3) + 8 * (i >> 2) + 4 * hh;
                arg += brow[min(max(ck - cq + 15, 0), 30)];
                p[i] = ((unsigned)(ck - cs) < 16u) ? __builtin_amdgcn_exp2f(arg) : 0.f; }
            else p[i] = __builtin_amdgcn_exp2f(arg);
            ls += p[i];
        }
        pv_tile(vt, p, O, kb, q, hh);
    }
}
DI void diff_pass1(LAS const unsigned char* kt, const bf16x8 (&Qf)[8], float (&ls)[2], int lane) {
    const int q = lane & 31, hh = lane >> 5;
#pragma unroll
    for (int kb = 0; kb < 2; ++kb) {
#pragma unroll
        for (int mp = 0; mp < 2; ++mp) { const f32x16 S = qk_tile<4>(kt, Qf, kb, mp * 4, q, hh);
#pragma unroll
            for (int i = 0; i < 16; ++i) ls[mp] += __builtin_amdgcn_exp2f(S[i]); }
    }
}
DI void diff_pass2(LAS const unsigned char* kt, LAS const unsigned char* vt, const bf16x8 (&Qf)[8], f32x16 (&O)[4], float w0, float w1, int lane) {
    const int q = lane & 31, hh = lane >> 5;
#pragma unroll
    for (int kb = 0; kb < 2; ++kb) {
        float p[16];
        { const f32x16 S0 = qk_tile<4>(kt, Qf, kb, 0, q, hh);
#pragma unroll
          for (int i = 0; i < 16; ++i) p[i] = __builtin_amdgcn_exp2f(S0[i]) * w0; }
        { const f32x16 S1 = qk_tile<4>(kt, Qf, kb, 4, q, hh);
#pragma unroll
          for (int i = 0; i < 16; ++i) p[i] -= __builtin_amdgcn_exp2f(S1[i]) * w1; }
        pv_tile(vt, p, O, kb, q, hh);
    }
}

template <int MODE>
DI void attn_phase(const Ctx& F, const Params& P) {
    constexpr bool DIFF = (MODE >= 2);
    constexpr bool NA = (MODE == 1);
    LAS unsigned char* lds = F.lds;
    LAS float* rpbl = (LAS float*)(lds + AT_RPB);
    LAS float* kgl = (LAS float*)(lds + AT_RPB + 2048);
    if (!DIFF) { __syncthreads(); if (F.tid < 128) kgl[F.tid] = P.in[I_NAKG][F.tid]; __syncthreads(); }
    const bf16_t* PA = (const bf16_t*)(P.ws + WS_RA);
    bf16_t* MIX = (bf16_t*)(P.ws + WS_HM);
    const bf16_t* VTp = (const bf16_t*)(P.ws + WS_VT); const bf16_t* VTs = (const bf16_t*)(P.ws + WS_VT + VT_S);
    const int q = F.lane & 31, hh = F.lane >> 5;
    const float c1 = (DIFF ? 0.125f : 0.08838834764831845f) * LOG2E;
    float lam = 0.f;
    if (DIFF) {
        const float a = wave_sum(P.in[I_LQ1][F.lane] * P.in[I_LK1][F.lane]), b = wave_sum(P.in[I_LQ2][F.lane] * P.in[I_LK2][F.lane]);
        lam = __expf(a) - __expf(b) + 0.35550906759096924f;
    }
    const int nunits = (MODE == 0 || MODE == 2) ? 256 : 1024;
    for (int u0 = F.bid; u0 < nunits; u0 += F.G) {
        int u = u0;
        if ((MODE == 1 || MODE == 3) && F.G == 256) { const int i = u0 >> 8, x = F.bid & 7, y = F.bid >> 3; u = ((2 * i + (y >> 4)) * 8 + x) * 16 + (y & 15); }
        int b, h, tok0, r = 0, rlo = 0; TileMap M;
        const bf16_t* qptr;
        if (MODE == 0) { b = u >> 3; h = u & 7; tok0 = b * 256 + F.wave * 32;
            qptr = PA + (size_t)(tok0 + q) * 2048 + h * 128;
            M.latK = PA + (size_t)(b * 256) * 2048 + 1024 + h * 128; M.latKld = 2048; M.latV = VTp + (size_t)(b * 8 + h) * 128 * 256; M.latVld = 256; M.nlat = 4; M.ctxK = nullptr; M.ctxV = nullptr; M.ntiles = 4; }
        else if (MODE == 1) { b = u >> 7; h = (u >> 4) & 7; const int rg = u & 15; r = 4 * rg + (F.wave >> 1);
            rlo = min(max(4 * rg - 4, 0), 56); const int rhi = min(max(4 * rg + 3 - 4, 0), 56) + 8;
            tok0 = TP + b * 4096 + r * 64 + (F.wave & 1) * 32;
            qptr = PA + (size_t)(tok0 + q) * 2048 + h * 128;
            M.latK = PA + (size_t)(TP + b * 4096 + rlo * 64) * 2048 + 1024 + h * 128; M.latKld = 2048; M.latV = VTs + (size_t)(b * 8 + h) * 128 * 4096 + rlo * 64; M.latVld = 4096; M.nlat = rhi - rlo;
            M.ctxK = (const bf16_t*)(P.ws + WS_CNK) + (size_t)b * 256 * 1024 + h * 128; M.ctxV = (const bf16_t*)(P.ws + WS_CNVT) + (size_t)(b * 8 + h) * 128 * 256; M.ntiles = M.nlat + 4;
            if (F.tid < 465) rpbl[F.tid] = P.in[I_RPB][h * 465 + F.tid] * LOG2E; }
        else if (MODE == 2) { b = u >> 3; h = u & 7; tok0 = b * 256 + F.wave * 32;
            qptr = PA + (size_t)(tok0 + q) * 4096 + 1024 + h * 128;
            M.latK = PA + (size_t)(b * 256) * 4096 + 2048 + h * 128; M.latKld = 4096; M.latV = VTp + (size_t)(b * 8 + h) * 128 * 256; M.latVld = 256; M.nlat = 4; M.ctxK = nullptr; M.ctxV = nullptr; M.ntiles = 4; }
        else { b = u >> 7; h = (u >> 4) & 7; const int qb = u & 15; tok0 = TP + b * 4096 + qb * 256 + F.wave * 32;
            qptr = PA + (size_t)(tok0 + q) * 4096 + 1024 + h * 128;
            M.latK = PA + (size_t)(TP + b * 4096) * 4096 + 2048 + h * 128; M.latKld = 4096; M.latV = VTs + (size_t)(b * 8 + h) * 128 * 4096; M.latVld = 4096; M.nlat = 64;
            M.ctxK = (const bf16_t*)(P.ws + WS_CDK) + (size_t)b * 256 * 1024 + h * 128; M.ctxV = (const bf16_t*)(P.ws + WS_CDVT) + (size_t)(b * 8 + h) * 128 * 256; M.ntiles = 68; }
        bf16x8 Qf[8];
        if constexpr (!DIFF) {
            u32x4 w[8]; float ss = 0.f;
#pragma unroll
            for (int ks = 0; ks < 8; ++ks) { w[ks] = *(const u32x4*)(qptr + ks * 16 + hh * 8);
                ss += bflo(w[ks].x) * bflo(w[ks].x) + bfhi(w[ks].x) * bfhi(w[ks].x) + bflo(w[ks].y) * bflo(w[ks].y) + bfhi(w[ks].y) * bfhi(w[ks].y)
                    + bflo(w[ks].z) * bflo(w[ks].z) + bfhi(w[ks].z) * bfhi(w[ks].z) + bflo(w[ks].w) * bflo(w[ks].w) + bfhi(w[ks].w) * bfhi(w[ks].w); }
            ss += __shfl_xor(ss, 32);
            const float qs = rsqrtf(ss * (1.f / 128.f) + NORM_EPS) * c1;
            const float* qg = P.in[I_NAQG];
#pragma unroll
            for (int ks = 0; ks < 8; ++ks) { const f32x4 g0 = *(const f32x4*)(qg + ks * 16 + hh * 8), g1 = *(const f32x4*)(qg + ks * 16 + hh * 8 + 4);
                const u32x4 ws = (u32x4){pk2(bflo(w[ks].x) * qs * g0.x, bfhi(w[ks].x) * qs * g0.y), pk2(bflo(w[ks].y) * qs * g0.z, bfhi(w[ks].y) * qs * g0.w),
                                         pk2(bflo(w[ks].z) * qs * g1.x, bfhi(w[ks].z) * qs * g1.y), pk2(bflo(w[ks].w) * qs * g1.z, bfhi(w[ks].w) * qs * g1.w)};
                Qf[ks] = __builtin_bit_cast(bf16x8, ws); }
        } else {
#pragma unroll
        for (int ks = 0; ks < 8; ++ks) { const u32x4 w = *(const u32x4*)(qptr + ks * 16 + hh * 8);
            const u32x4 ws = (u32x4){pk2(bflo(w.x) * c1, bfhi(w.x) * c1), pk2(bflo(w.y) * c1, bfhi(w.y) * c1), pk2(bflo(w.z) * c1, bfhi(w.z) * c1), pk2(bflo(w.w) * c1, bfhi(w.w) * c1)};
            Qf[ks] = __builtin_bit_cast(bf16x8, ws); }
        }
        f32x16 O[4]; float ls[2] = {0.f, 0.f}; float w0 = 0.f, w1 = 0.f;
#pragma unroll
        for (int db = 0; db < 4; ++db)
#pragma unroll
            for (int i = 0; i < 16; ++i) O[db][i] = 0.f;
        const int cq = (F.wave & 1) * 32 + q;
        const int r0w = min(max(r - 4, 0), 56);
        const int nt = M.ntiles;
        TileRegs R;
        { const bf16_t* kp; const bf16_t* vp; int kld, vld; tile_src(M, 0, kp, kld, vp, vld); tile_load(F, R, kp, kld, vp, vld); }
        if constexpr (!DIFF) tile_norm_k(F, R, kgl, (MODE == 0) ? P.out + O_NAK + (size_t)(b * 256) * 1024 + h * 128 : nullptr, 1024);
        tile_store(F, R, lds + AT_K0, lds + AT_V0);
        __syncthreads();
        if constexpr (DIFF) {
#pragma unroll 1
            for (int j = 0; j < nt; ++j) {
                const int cur = j & 1, jn = (j + 1 < nt) ? j + 1 : 0;
                const bool wv = (j + 1 == nt);
                { const bf16_t* kp; const bf16_t* vp; int kld, vld; tile_src(M, jn, kp, kld, vp, vld); tile_load(F, R, kp, kld, vp, vld, wv); }
                diff_pass1(lds + AT_K0 + cur * AT_KTB, Qf, ls, F.lane);
                tile_store(F, R, lds + AT_K0 + (cur ^ 1) * AT_KTB, lds + AT_V0 + (cur ^ 1) * AT_VTB, wv);
                __syncthreads();
            }
            { const float l0 = ls[0] + __shfl_xor(ls[0], 32), l1 = ls[1] + __shfl_xor(ls[1], 32); w0 = 1.f / l0; w1 = lam / l1; }
#pragma unroll 1
            for (int j = 0; j < nt; ++j) {
                const int cur = (nt + j) & 1;
                if (j + 1 < nt) { const bf16_t* kp; const bf16_t* vp; int kld, vld; tile_src(M, j + 1, kp, kld, vp, vld); tile_load(F, R, kp, kld, vp, vld); }
                diff_pass2(lds + AT_K0 + cur * AT_KTB, lds + AT_V0 + cur * AT_VTB, Qf, O, w0, w1, F.lane);
                if (j + 1 < nt) tile_store(F, R, lds + AT_K0 + (cur ^ 1) * AT_KTB, lds + AT_V0 + (cur ^ 1) * AT_VTB);
                __syncthreads();
            }
        } else {
#pragma unroll 1
            for (int j = 0; j < nt; ++j) {
                const int cur = j & 1;
                if (j + 1 < nt) { const bf16_t* kp; const bf16_t* vp; int kld, vld; tile_src(M, j + 1, kp, kld, vp, vld); tile_load(F, R, kp, kld, vp, vld); }
                LAS const unsigned char* kt = lds + AT_K0 + cur * AT_KTB; LAS const unsigned char* vt = lds + AT_V0 + cur * AT_VTB;
                if constexpr (NA) {
                    if (j < M.nlat) { const int kr = rlo + j;
                        if (kr >= r0w && kr < r0w + 8) attn_compute1<true>(kt, vt, Qf, O, ls[0], F.lane, rpbl + (kr - r + 7) * 31, cq); }
                    else attn_compute1<false>(kt, vt, Qf, O, ls[0], F.lane, rpbl, cq);
                } else attn_compute1<false>(kt, vt, Qf, O, ls[0], F.lane, rpbl, cq);
                if (j + 1 < nt) {
                    if (j + 1 < M.nlat) tile_norm_k(F, R, kgl, (MODE == 0) ? P.out + O_NAK + (size_t)(b * 256 + (j + 1) * 64) * 1024 + h * 128 : nullptr, 1024);
                    tile_store(F, R, lds + AT_K0 + (cur ^ 1) * AT_KTB, lds + AT_V0 + (cur ^ 1) * AT_VTB); }
                __syncthreads();
            }
        }
        if constexpr (!DIFF) {
            const float inv = 1.f / (ls[0] + __shfl_xor(ls[0], 32));
            bf16_t* op = MIX + (size_t)(tok0 + q) * DM + h * 128 + 4 * hh;
#pragma unroll
            for (int db = 0; db < 4; ++db)
#pragma unroll
                for (int g = 0; g < 4; ++g) { u32x2 w; w.x = pk2(O[db][4 * g] * inv, O[db][4 * g + 1] * inv); w.y = pk2(O[db][4 * g + 2] * inv, O[db][4 * g + 3] * inv);
                    *(u32x2*)(op + db * 32 + 8 * g) = w; }
        } else {
            float ss = 0.f;
#pragma unroll
            for (int db = 0; db < 4; ++db)
#pragma unroll
                for (int i = 0; i < 16; ++i) ss += O[db][i] * O[db][i];
            ss += __shfl_xor(ss, 32);
            const float sc = rsqrtf(ss * (1.f / 128.f) + NORM_EPS) * (1.f - 0.35550906759096924f);
            const float* sg = P.in[I_SUBG];
            bf16_t* op = MIX + (size_t)(tok0 + q) * DM + 1024 + h * 128 + 4 * hh;
#pragma unroll
            for (int db = 0; db < 4; ++db)
#pragma unroll
                for (int g = 0; g < 4; ++g) { const f32x4 g4 = *(const f32x4*)(sg + db * 32 + 8 * g + 4 * hh);
                    u32x2 w; w.x = pk2(O[db][4 * g] * sc * g4.x, O[db][4 * g + 1] * sc * g4.y); w.y = pk2(O[db][4 * g + 2] * sc * g4.z, O[db][4 * g + 3] * sc * g4.w);
                    *(u32x2*)(op + db * 32 + 8 * g) = w; }
        }
    }
}

template <bool SAMPLE>
DI void attn_diff_phase(const Ctx& F, const Params& P) {
    LAS unsigned char* lds = F.lds;
    const bf16_t* PA = (const bf16_t*)(P.ws + WS_RA);
    bf16_t* MIX = (bf16_t*)(P.ws + WS_HM);
    const bf16_t* VTp = (const bf16_t*)(P.ws + WS_VT); const bf16_t* VTs = (const bf16_t*)(P.ws + WS_VT + VT_S);
    const int q = F.lane & 31, hh = F.lane >> 5, mp = F.wave >> 2, qg = F.wave & 3;
    const float c1 = 0.125f * LOG2E;
    const float la = wave_sum(P.in[I_LQ1][F.lane] * P.in[I_LK1][F.lane]), lb = wave_sum(P.in[I_LQ2][F.lane] * P.in[I_LK2][F.lane]);
    const float lam = __expf(la) - __expf(lb) + 0.35550906759096924f;
    const int nunits = SAMPLE ? 2048 : 512;
    for (int u0 = F.bid; u0 < nunits; u0 += F.G) {
        int u = u0;
        if (SAMPLE && F.G == 256) { const int i = u0 >> 8, x = F.bid & 7, y = F.bid >> 3; u = ((i * 8 + x) << 5) + y; }
        int b, h, tok0; TileMap M;
        if (!SAMPLE) { const int bh = u >> 1; b = bh >> 3; h = bh & 7; tok0 = b * 256 + (u & 1) * 128 + qg * 32;
            M.latK = PA + (size_t)(b * 256) * 4096 + 2048 + h * 128; M.latKld = 4096; M.latV = VTp + (size_t)(b * 8 + h) * 128 * 256; M.latVld = 256; M.nlat = 4; M.ctxK = nullptr; M.ctxV = nullptr; M.ntiles = 4; }
        else { const int bh = u >> 5; b = bh >> 3; h = bh & 7; tok0 = TP + b * 4096 + (u & 31) * 128 + qg * 32;
            M.latK = PA + (size_t)(TP + b * 4096) * 4096 + 2048 + h * 128; M.latKld = 4096; M.latV = VTs + (size_t)(b * 8 + h) * 128 * 4096; M.latVld = 4096; M.nlat = 64;
            M.ctxK = (const bf16_t*)(P.ws + WS_CDK) + (size_t)b * 256 * 1024 + h * 128; M.ctxV = (const bf16_t*)(P.ws + WS_CDVT) + (size_t)(b * 8 + h) * 128 * 256; M.ntiles = 68; }
        bf16x8 Qf[4];
        { const bf16_t* qptr = PA + (size_t)(tok0 + q) * 4096 + 1024 + h * 128 + mp * 64;
#pragma unroll
          for (int ks = 0; ks < 4; ++ks) { const u32x4 w = *(const u32x4*)(qptr + ks * 16 + hh * 8);
              const u32x4 ws = (u32x4){pk2(bflo(w.x) * c1, bfhi(w.x) * c1), pk2(bflo(w.y) * c1, bfhi(w.y) * c1), pk2(bflo(w.z) * c1, bfhi(w.z) * c1), pk2(bflo(w.w) * c1, bfhi(w.w) * c1)};
              Qf[ks] = __builtin_bit_cast(bf16x8, ws); } }
        f32x16 O[4]; float ls = 0.f;
#pragma unroll
        for (int db = 0; db < 4; ++db)
#pragma unroll
            for (int i = 0; i < 16; ++i) O[db][i] = 0.f;
        const int nt = M.ntiles;
        TileRegs R;
        { const bf16_t* kp; const bf16_t* vp; int kld, vld; tile_src(M, 0, kp, kld, vp, vld); tile_load(F, R, kp, kld, vp, vld); }
        tile_store(F, R, lds + AT_K0, lds + AT_V0);
        __syncthreads();
#pragma unroll 1
        for (int j = 0; j < nt; ++j) {
            const int cur = j & 1;
            if (j + 1 < nt) { const bf16_t* kp; const bf16_t* vp; int kld, vld; tile_src(M, j + 1, kp, kld, vp, vld); tile_load(F, R, kp, kld, vp, vld); }
            LAS const unsigned char* kt = lds + AT_K0 + cur * AT_KTB; LAS const unsigned char* vt = lds + AT_V0 + cur * AT_VTB;
#pragma unroll
            for (int kb = 0; kb < 2; ++kb) {
                f32x16 S;
#pragma unroll
                for (int i = 0; i < 16; ++i) S[i] = 0.f;
#pragma unroll
                for (int ks = 0; ks < 4; ++ks) { const bf16x8 A = *(const LAS bf16x8*)(kt + (kb * 32 + q) * AT_KROW + ((mp * 4 + ks) * 16 + hh * 8) * 2);
                    S = __builtin_amdgcn_mfma_f32_32x32x16_bf16(A, Qf[ks], S, 0, 0, 0); }
                float p[16];
#pragma unroll
                for (int i = 0; i < 16; ++i) { p[i] = __builtin_amdgcn_exp2f(S[i]); ls += p[i]; }
                pv_tile(vt, p, O, kb, q, hh);
            }
            if (j + 1 < nt) tile_store(F, R, lds + AT_K0 + (cur ^ 1) * AT_KTB, lds + AT_V0 + (cur ^ 1) * AT_VTB);
            __syncthreads();
        }
        const float lt = ls + __shfl_xor(ls, 32);
        LAS float* xch = (LAS float*)lds + qg * 4096 + F.lane;
        if (mp == 1) { const float w1 = lam / lt;
#pragma unroll
            for (int db = 0; db < 4; ++db)
#pragma unroll
                for (int i = 0; i < 16; ++i) xch[(db * 16 + i) * 64] = O[db][i] * w1; }
        __syncthreads();
        if (mp == 0) { const float w0 = 1.f / lt; float ss = 0.f;
#pragma unroll
            for (int db = 0; db < 4; ++db)
#pragma unroll
                for (int i = 0; i < 16; ++i) { const float o = O[db][i] * w0 - xch[(db * 16 + i) * 64]; O[db][i] = o; ss += o * o; }
            ss += __shfl_xor(ss, 32);
            const float sc = rsqrtf(ss * (1.f / 128.f) + NORM_EPS) * (1.f - 0.35550906759096924f);
            const float* sg = P.in[I_SUBG];
            bf16_t* op = MIX + (size_t)(tok0 + q) * DM + 1024 + h * 128 + 4 * hh;
#pragma unroll
            for (int db = 0; db < 4; ++db)
#pragma unroll
                for (int g = 0; g < 4; ++g) { const f32x4 g4 = *(const f32x4*)(sg + db * 32 + 8 * g + 4 * hh);
                    u32x2 w; w.x = pk2(O[db][4 * g] * sc * g4.x, O[db][4 * g + 1] * sc * g4.y); w.y = pk2(O[db][4 * g + 2] * sc * g4.z, O[db][4 * g + 3] * sc * g4.w);
                    *(u32x2*)(op + db * 32 + 8 * g) = w; } }
        __syncthreads();
    }
}
template <int L, int BATCH> struct HyCfg {
    static constexpr int NB = L / 64, TPT = 32 / BATCH, NTILES = NB / TPT, LOGB = (BATCH == 8) ? 3 : 5;
    static constexpr int ZROWB = (L + 384) * 2 + 16, ZBYTES = BATCH * ZROWB, RL = 2 * L + 16;
    static constexpr int TPW = (NTILES + 7) / 8;
};
constexpr int HY_KR_OFF = 71808;

template <int L, int BATCH>
DI void hyena_part(const Ctx& F, const Params& P, int c, int tokbase  , const bf16_t* KRG  ) {
    typedef HyCfg<L, BATCH> C;
    LAS unsigned char* lds = F.lds;
    bf16_t* CM = (bf16_t*)(P.ws + WS_RB);
    const float* hbias = P.in[I_HYBIAS];
    const int q = F.lane & 31, hh = F.lane >> 5;
    __syncthreads();
    for (int id = F.tid; id < BATCH * (L / 8); id += NTHR) { const int b = id / (L / 8), s8 = (id % (L / 8)) * 8;
        *(LAS u32x4*)(lds + b * C::ZROWB + (192 + s8) * 2) = *(const u32x4*)(CM + (size_t)c * TOK + tokbase + b * L + s8); }
    for (int id = F.tid; id < BATCH * 48; id += NTHR) { const int b = id / 48, k = id % 48, e = (k < 24) ? k * 8 : (192 + L + (k - 24) * 8);
        *(LAS u32x4*)(lds + b * C::ZROWB + e * 2) = (u32x4){0u, 0u, 0u, 0u}; }
#pragma unroll 1
    for (int o = 0; o < 2; ++o) {
        { const bf16_t* src = KRG + (size_t)(o * 1024 + c) * C::RL;
          for (int id = F.tid; id < C::RL / 8; id += NTHR) { const u32x4 v = *(const u32x4*)(src + id * 8);
              *(LAS u32x4*)(lds + HY_KR_OFF + id * 16) = v;
              LAS bf16_t* c1 = (LAS bf16_t*)(lds + HY_KR_OFF + C::RL * 2) + id * 8 - 1;
              if (id > 0) c1[0] = (bf16_t)(v.x & 0xffff);
              c1[1] = (bf16_t)(v.x >> 16); c1[2] = (bf16_t)(v.y & 0xffff); c1[3] = (bf16_t)(v.y >> 16); c1[4] = (bf16_t)(v.z & 0xffff); c1[5] = (bf16_t)(v.z >> 16);
              c1[6] = (bf16_t)(v.w & 0xffff); c1[7] = (bf16_t)(v.w >> 16); } }
        __syncthreads();
        f32x16 acc[C::TPW][2];
#pragma unroll
        for (int t = 0; t < C::TPW; ++t)
#pragma unroll
            for (int mt = 0; mt < 2; ++mt)
#pragma unroll
                for (int i = 0; i < 16; ++i) acc[t][mt][i] = 0.f;
        const int tq0 = F.wave * C::TPW;
        if (tq0 < C::NTILES) {
            const int d1lo = C::TPT * tq0 - (C::NB - 1), d1hi = C::TPT * (tq0 + C::TPW - 1) + C::TPT - 1;
            const int abase = HY_KR_OFF + (F.lane & 1) * (C::RL * 2) + (L - (F.lane & 31) + 8 * hh - (F.lane & 1)) * 2;
            bf16x8 W0[6], W1[6], B0[C::TPW][4];
#define HY_LDW(Wv, d1v, i) do { LAS const unsigned* ap_ = (LAS const unsigned*)(lds + abase + (-4 * (d1v) - 2 + (i)) * 32); Wv[i] = __builtin_bit_cast(bf16x8, (u32x4){ap_[0], ap_[1], ap_[2], ap_[3]}); } while (0)
#define HY_LDB(Bv, d1v) do { _Pragma("unroll") for (int t_ = 0; t_ < C::TPW; ++t_) { const int tq_ = tq0 + t_; \
            const int t1_ = C::TPT * tq_ + (q >> C::LOGB), b_ = q & (BATCH - 1); int s1_ = t1_ - (d1v); s1_ = min(max(s1_, -3), C::NB + 2); \
            LAS const unsigned char* bp_ = lds + b_ * C::ZROWB + (192 + 64 * s1_ + 8 * hh) * 2; \
            _Pragma("unroll") for (int ks_ = 0; ks_ < 4; ++ks_) Bv[t_][ks_] = *(const LAS bf16x8*)(bp_ + ks_ * 32); } } while (0)
#define HY_MM(Wv, Bv, d1v) do { _Pragma("unroll") for (int t_ = 0; t_ < C::TPW; ++t_) { const int tq_ = tq0 + t_; \
            if ((d1v) >= C::TPT * tq_ - (C::NB - 1) && (d1v) <= C::TPT * tq_ + C::TPT - 1) { \
                _Pragma("unroll") for (int ks_ = 0; ks_ < 4; ++ks_) _Pragma("unroll") for (int mt_ = 0; mt_ < 2; ++mt_) \
                    acc[t_][mt_] = __builtin_amdgcn_mfma_f32_32x32x16_bf16(Wv[ks_ - 2 * mt_ + 2], Bv[t_][ks_], acc[t_][mt_], 0, 0, 0); } } } while (0)
#pragma unroll
            for (int i = 0; i < 6; ++i) HY_LDW(W0, d1lo, i);
            int d1 = d1lo;
#pragma unroll 1
            for (; d1 + 1 <= d1hi; d1 += 2) {
                HY_LDB(B0, d1);
#pragma unroll
                for (int i = 0; i < 4; ++i) HY_LDW(W1, d1 + 1, i);
                W1[4] = W0[0]; W1[5] = W0[1];
                HY_MM(W0, B0, d1);
                HY_LDB(B0, d1 + 1);
                if (d1 + 2 <= d1hi) {
#pragma unroll
                    for (int i = 0; i < 4; ++i) HY_LDW(W0, d1 + 2, i);
                    W0[4] = W1[0]; W0[5] = W1[1];
                }
                HY_MM(W1, B0, d1 + 1);
            }
            if (d1 <= d1hi) { HY_LDB(B0, d1); HY_MM(W0, B0, d1); }
#undef HY_LDW
#undef HY_LDB
#undef HY_MM
        }
        __syncthreads();
        if (tq0 < C::NTILES) {
            const float bo = hbias[o * 1024 + c];
            const bf16_t* gate = CM + (size_t)((1 + o) * 1024 + c) * TOK + tokbase;
            bf16_t* zout = (bf16_t*)(P.ws + WS_RA + RA_ZC) + (size_t)c * TOK + tokbase;
#pragma unroll
            for (int t = 0; t < C::TPW; ++t) { const int tq = tq0 + t, t1 = C::TPT * tq + (q >> C::LOGB), b = q & (BATCH - 1);
#pragma unroll
                for (int mt = 0; mt < 2; ++mt)
#pragma unroll
                    for (int g = 0; g < 4; ++g) { const int s = 64 * t1 + 32 * mt + 8 * g + 4 * hh;
                        LAS u32x2* zp = (LAS u32x2*)(lds + b * C::ZROWB + (192 + s) * 2);
                        const u32x2 zv = *zp, gv = *(const u32x2*)(gate + (size_t)b * L + s);
                        const float r0 = bflo(gv.x) * (acc[t][mt][4 * g] + bflo(zv.x) * bo), r1 = bfhi(gv.x) * (acc[t][mt][4 * g + 1] + bfhi(zv.x) * bo);
                        const float r2 = bflo(gv.y) * (acc[t][mt][4 * g + 2] + bflo(zv.y) * bo), r3 = bfhi(gv.y) * (acc[t][mt][4 * g + 3] + bfhi(zv.y) * bo);
                        const u32x2 w = (u32x2){pk2(r0, r1), pk2(r2, r3)};
                        if (o == 0) *zp = w; else *(u32x2*)(zout + (size_t)b * L + s) = w; } }
        }
        __syncthreads();
    }
}

DI void hyena_phase(const Ctx& F, const Params& P) {
    for (int c = F.bid; c < 1024; c += F.G) {
        hyena_part<LS, 8>(F, P, c, TP, (const bf16_t*)(P.ws + WS_KRS));
        hyena_part<LP, 32>(F, P, c, 0, (const bf16_t*)(P.ws + WS_KRP));
    }
}

DI void hyena_post(const Ctx& F, const Params& P) {
    const bf16_t* CM = (const bf16_t*)(P.ws + WS_RA + RA_ZC); bf16_t* MIX = (bf16_t*)(P.ws + WS_HM);
    for (int t = F.bid; t < 16 * 640; t += F.G) { const int cg = t & 15, tg = t >> 4;
        tr_tile_bf16(F, CM + (size_t)(cg * 64) * TOK + tg * 64, TOK, MIX + (size_t)(tg * 64) * DM + 1024 + cg * 64, DM, (LAS bf16_t*)F.lds); }
}
DI void prep_c(const Ctx& F, const Params& P) {
    bf16_t* PA = (bf16_t*)(P.ws + WS_RA);
    LAS float* rope = (LAS float*)(F.lds + 16384);
    __syncthreads();
    for (int e = F.tid; e < 1024; e += NTHR) { const int pos = e >> 4, f = e & 15; const float inv = exp2f(-(float)f * (13.287712379549449f / 16.f)); const float a = (float)pos * inv;
        rope[e * 2] = cosf(a); rope[e * 2 + 1] = sinf(a); }
    __syncthreads();
    { const float* gsrc = (F.lane < 32 ? P.in[I_DQG] : P.in[I_DKG]) + (F.lane & 1) * 32; float* ok = P.out + O_DK;
      float g[32];
#pragma unroll
      for (int i = 0; i < 32; ++i) g[i] = gsrc[i];
      for (int T = F.bid * 8 + F.wave; T < TOK; T += F.G * 8) {
          bf16_t* rp = PA + (size_t)T * 4096 + 1024 + F.lane * 32;
          u32x4 v[4]; float x[32]; float ss = 0.f;
#pragma unroll
          for (int j = 0; j < 4; ++j) { v[j] = *(const u32x4*)(rp + j * 8);
              x[j * 8 + 0] = bflo(v[j].x); x[j * 8 + 1] = bfhi(v[j].x); x[j * 8 + 2] = bflo(v[j].y); x[j * 8 + 3] = bfhi(v[j].y);
              x[j * 8 + 4] = bflo(v[j].z); x[j * 8 + 5] = bfhi(v[j].z); x[j * 8 + 6] = bflo(v[j].w); x[j * 8 + 7] = bfhi(v[j].w); }
#pragma unroll
          for (int i = 0; i < 32; ++i) ss += x[i] * x[i];
          ss += dpp_xor1(ss);
          const float rstd = rsqrtf(ss * (1.f / 64.f) + NORM_EPS);
#pragma unroll
          for (int i = 0; i < 32; ++i) x[i] = x[i] * rstd * g[i];
          if (T < TP) { if (F.lane >= 32) { float* o = ok + (size_t)T * 1024 + (F.lane - 32) * 32;
#pragma unroll
                  for (int j = 0; j < 8; ++j) *(f32x4*)(o + j * 4) = (f32x4){x[j * 4], x[j * 4 + 1], x[j * 4 + 2], x[j * 4 + 3]}; } }
          else { const int t = (T - TP) & 4095, pos = (F.lane & 1) ? (t & 63) : (t >> 6);
              const LAS float* rt = rope + pos * 32;
#pragma unroll
              for (int f = 0; f < 16; ++f) { const float cs = rt[2 * f], sn = rt[2 * f + 1], a = x[f], b = x[16 + f]; x[f] = a * cs - b * sn; x[16 + f] = b * cs + a * sn; } }
#pragma unroll
          for (int j = 0; j < 4; ++j) { u32x4 w; w.x = pk2(x[j * 8 + 0], x[j * 8 + 1]); w.y = pk2(x[j * 8 + 2], x[j * 8 + 3]); w.z = pk2(x[j * 8 + 4], x[j * 8 + 5]); w.w = pk2(x[j * 8 + 6], x[j * 8 + 7]);
              *(u32x4*)(rp + j * 8) = w; }
      } }
    __syncthreads();
    bf16_t* VTp = (bf16_t*)(P.ws + WS_VT); bf16_t* VTs = (bf16_t*)(P.ws + WS_VT + VT_S);
    for (int t = F.bid; t < 2048 + 8192; t += F.G) {
        if (t < 2048) { const int bh = t >> 3, sub = t & 7, tk = sub >> 1, dd = sub & 1, b = bh >> 3, h = bh & 7;
            tr_tile_bf16(F, PA + ((size_t)(b * 256 + tk * 64)) * 4096 + 3072 + h * 128 + dd * 64, 4096, VTp + ((size_t)bh * 128 + dd * 64) * 256 + tk * 64, 256, (LAS bf16_t*)F.lds); }
        else { const int u = t - 2048, bh = u >> 7, sub = u & 127, tk = sub >> 1, dd = sub & 1, b = bh >> 3, h = bh & 7;
            tr_tile_bf16(F, PA + ((size_t)(TP + b * 4096 + tk * 64)) * 4096 + 3072 + h * 128 + dd * 64, 4096, VTs + ((size_t)bh * 128 + dd * 64) * 4096 + tk * 64, 4096, (LAS bf16_t*)F.lds); }
    }
    { float* o = P.out + O_DV;
      for (int e = F.bid * NTHR + F.tid; e < TP * 128; e += F.G * NTHR) { const int T = e >> 7, c8 = (e & 127) * 8;
          const u32x4 v = *(const u32x4*)(PA + (size_t)T * 4096 + 3072 + c8);
          *(f32x4*)(o + (size_t)T * 1024 + c8) = (f32x4){bflo(v.x), bfhi(v.x), bflo(v.y), bfhi(v.y)};
          *(f32x4*)(o + (size_t)T * 1024 + c8 + 4) = (f32x4){bflo(v.z), bfhi(v.z), bflo(v.w), bfhi(v.w)}; } }
}

constexpr int S5_BUROW = 132 * 4, S5_HROW = 272, S5_WLDS = 16 * S5_BUROW + 16 * S5_HROW;
DI void s5_chain(const Ctx& F, const Params& P, int dg, int tok0, int L, const float* h0re, const float* h0im, float* fre, float* fim, bf16_t* Yout) {
    LAS unsigned char* wl = F.lds + F.wave * S5_WLDS; LAS unsigned char* hl = wl + 16 * S5_BUROW;
    const int g = dg & 63, dir = dg >> 6, lane = F.lane, st = lane & 15, gq = lane >> 4;
    const float* S5A = (const float*)(P.ws + WS_S5A); const bf16_t* BB = (const bf16_t*)(P.ws + WS_S5BB); const bf16_t* CC = (const bf16_t*)(P.ws + WS_S5CC);
    const bf16_t* PA = (const bf16_t*)(P.ws + WS_RA);
    const float ar = S5A[(dg * 64 + lane) * 2], ai = S5A[(dg * 64 + lane) * 2 + 1];
    float hr = h0re ? h0re[lane] : 0.f, hi = h0im ? h0im[lane] : 0.f;
    const bf16x8 zero8 = (bf16x8){0, 0, 0, 0, 0, 0, 0, 0};
    bf16x8 BBf[8], CCf[4];
#pragma unroll
    for (int mt = 0; mt < 8; ++mt) BBf[mt] = (gq < 2) ? *(const bf16x8*)(BB + ((size_t)dg * 128 + mt * 16 + st) * 16 + gq * 8) : zero8;
#pragma unroll
    for (int kk = 0; kk < 4; ++kk) CCf[kk] = *(const bf16x8*)(CC + ((size_t)dg * 16 + st) * 128 + kk * 32 + gq * 8);
    const int nch = L / 16;
    const int sgn = dir ? -1 : 1, tstart = dir ? tok0 + L - 1 : tok0;
    bf16x8 Uf = zero8, U1 = zero8, U2 = zero8;
    if (gq < 2) { Uf = *(const bf16x8*)(PA + (size_t)(tstart + sgn * st) * 4096 + g * 16 + gq * 8);
        if (1 < nch) U1 = *(const bf16x8*)(PA + (size_t)(tstart + sgn * (16 + st)) * 4096 + g * 16 + gq * 8);
        if (2 < nch) U2 = *(const bf16x8*)(PA + (size_t)(tstart + sgn * (32 + st)) * 4096 + g * 16 + gq * 8); }
    for (int ch = 0; ch < nch; ++ch) {
        bf16x8 Un = zero8;
        if (ch + 3 < nch && gq < 2) Un = *(const bf16x8*)(PA + (size_t)(tstart + sgn * ((ch + 3) * 16 + st)) * 4096 + g * 16 + gq * 8);
#pragma unroll
        for (int mt = 0; mt < 8; ++mt) { f32x4 d = (f32x4){0.f, 0.f, 0.f, 0.f};
            d = __builtin_amdgcn_mfma_f32_16x16x32_bf16(BBf[mt], Uf, d, 0, 0, 0);
            *(LAS f32x4*)(wl + st * S5_BUROW + (mt * 16 + gq * 4) * 4) = d; }
        asm volatile("" ::: "memory");
#pragma unroll
        for (int s = 0; s < 16; ++s) {
            const float bur = *(const LAS float*)(wl + s * S5_BUROW + lane * 4), bui = *(const LAS float*)(wl + s * S5_BUROW + (64 + lane) * 4);
            const float nr = ar * hr - ai * hi + bur, ni = ar * hi + ai * hr + bui; hr = nr; hi = ni;
            *(LAS bf16_t*)(hl + s * S5_HROW + lane * 2) = f2bf(hr); *(LAS bf16_t*)(hl + s * S5_HROW + (64 + lane) * 2) = f2bf(hi);
        }
        asm volatile("" ::: "memory");
        f32x4 y = (f32x4){0.f, 0.f, 0.f, 0.f};
#pragma unroll
        for (int kk = 0; kk < 4; ++kk) { const bf16x8 Bh = *(const LAS bf16x8*)(hl + st * S5_HROW + (kk * 32 + gq * 8) * 2);
            y = __builtin_amdgcn_mfma_f32_16x16x32_bf16(CCf[kk], Bh, y, 0, 0, 0); }
        { const int tok = tstart + sgn * (ch * 16 + st);
          *(u32x2*)(Yout + (size_t)tok * 1024 + g * 16 + gq * 4) = (u32x2){pk2(y[0], y[1]), pk2(y[2], y[3])}; }
        asm volatile("" ::: "memory");
        Uf = U1; U1 = U2; U2 = Un;
    }
    if (fre) { fre[lane] = hr; fim[lane] = hi; }
}

DI void s5_phase(const Ctx& F, const Params& P) {
    bf16_t* YF = (bf16_t*)(P.ws + WS_RB + RB_YF); bf16_t* YB = (bf16_t*)(P.ws + WS_RB + RB_YB);
    for (int cs = F.bid; cs < 256; cs += F.G) {
        if (F.wave < 4) { const int sc = cs * 4 + F.wave, dg = sc & 127, b = sc >> 7;
            s5_chain(F, P, dg, TP + b * 4096, LS, P.in[I_S5RE] + (size_t)sc * 64, P.in[I_S5IM] + (size_t)sc * 64, nullptr, nullptr, (dg >> 6) ? YB : YF); }
        else { for (int k = 0; k < 4; ++k) { const int pc = (cs * 4 + (F.wave - 4)) * 4 + k, dg = pc & 127, b = pc >> 7;
            s5_chain(F, P, dg, b * 256, LP, nullptr, nullptr, P.out + O_SR + (size_t)pc * 64, P.out + O_SI + (size_t)pc * 64, (dg >> 6) ? YB : YF); } }
    }
}

DI void s5_combine(const Ctx& F, const Params& P) {
    const bf16_t* PA = (const bf16_t*)(P.ws + WS_RA); const bf16_t* YF = (const bf16_t*)(P.ws + WS_RB + RB_YF); const bf16_t* YB = (const bf16_t*)(P.ws + WS_RB + RB_YB);
    bf16_t* Y = (bf16_t*)(P.ws + WS_RB + RB_Y); const float* dsk = P.in[I_S5D];
    for (size_t e = (size_t)F.bid * NTHR + F.tid; e < (size_t)TOK * 128; e += (size_t)F.G * NTHR) { const size_t T = e >> 7; const int c8 = (int)(e & 127) * 8;
        const u32x4 uv = *(const u32x4*)(PA + T * 4096 + c8), fv = *(const u32x4*)(YF + T * 1024 + c8), bv = *(const u32x4*)(YB + T * 1024 + c8);
        const f32x4 d0 = *(const f32x4*)(dsk + c8), d1 = *(const f32x4*)(dsk + c8 + 4);
        float o[8];
        o[0] = gelu_tanh(d0.x * bflo(uv.x) + bflo(fv.x) + bflo(bv.x)); o[1] = gelu_tanh(d0.y * bfhi(uv.x) + bfhi(fv.x) + bfhi(bv.x));
        o[2] = gelu_tanh(d0.z * bflo(uv.y) + bflo(fv.y) + bflo(bv.y)); o[3] = gelu_tanh(d0.w * bfhi(uv.y) + bfhi(fv.y) + bfhi(bv.y));
        o[4] = gelu_tanh(d1.x * bflo(uv.z) + bflo(fv.z) + bflo(bv.z)); o[5] = gelu_tanh(d1.y * bfhi(uv.z) + bfhi(fv.z) + bfhi(bv.z));
        o[6] = gelu_tanh(d1.z * bflo(uv.w) + bflo(fv.w) + bflo(bv.w)); o[7] = gelu_tanh(d1.w * bfhi(uv.w) + bfhi(fv.w) + bfhi(bv.w));
        u32x4 w; w.x = pk2(o[0], o[1]); w.y = pk2(o[2], o[3]); w.z = pk2(o[4], o[5]); w.w = pk2(o[6], o[7]);
        *(u32x4*)(Y + T * 1024 + c8) = w; }
}
constexpr int PS_KROW = 272;
constexpr int PS_IDX_OFF = 2 * 128 * PS_KROW;
constexpr int PS_TAB_OFF = PS_IDX_OFF + 512 * 32;

DI void topk_insert(float (&a)[16], float x) {
#pragma unroll
    for (int j = 15; j >= 1; --j) a[j] = __builtin_amdgcn_fmed3f(a[j - 1], a[j], x);
    a[0] = fmaxf(a[0], x);
}

DI void peer_select(const Ctx& F, const Params& P, int layer) {
    LAS unsigned char* lds = F.lds;
    const bf16_t* Q = (const bf16_t*)(P.ws + WS_RA + RA_Q);
    int* SELI = (int*)(P.ws + WS_RA + RA_SELI); float* SELW = (float*)(P.ws + WS_RA + RA_SELW);
    const bf16_t* KEYS = (const bf16_t*)(P.ws + WS_PKEYS) + (size_t)layer * 8 * 2 * 128 * 128;
    const int q = F.lane & 31, hh = F.lane >> 5;
    LAS unsigned char* myidx = lds + PS_IDX_OFF + F.tid * 32;
    LAS unsigned char* tab = lds + PS_TAB_OFF;
    for (int wu = F.bid; wu < 256; wu += F.G) {
        const int h = wu & 7, chunk = wu >> 3;
        __syncthreads();
        for (int id = F.tid; id < 2 * 128 * 16; id += NTHR) { const int row = id >> 4, c16 = id & 15;
            *(LAS u32x4*)(lds + row * PS_KROW + c16 * 16) = *(const u32x4*)(KEYS + ((size_t)h * 256 + row) * 128 + c16 * 8); }
        if (F.tid < 16) { int cnt = 0;
            for (int a = 0; a < F.tid; ++a) cnt += 16 / (a + 1);
            for (int b = 0; b < 16 / (F.tid + 1); ++b) { tab[(cnt + b) * 2] = (unsigned char)F.tid; tab[(cnt + b) * 2 + 1] = (unsigned char)b; } }
        __syncthreads();
        for (int blk = F.wave; blk < 40; blk += 8) {
            const int T0 = chunk * 1280 + blk * 32;
            float lst[2][16];
#pragma unroll
            for (int side = 0; side < 2; ++side) {
                bf16x8 Qf[8];
                const bf16_t* qp = Q + (size_t)(T0 + q) * 2048 + h * 256 + side * 128 + hh * 8;
#pragma unroll
                for (int ks = 0; ks < 8; ++ks) Qf[ks] = *(const bf16x8*)(qp + ks * 16);
                float a[16];
#pragma unroll
                for (int j = 0; j < 16; ++j) a[j] = -3.0e38f;
#pragma unroll
                for (int nt = 0; nt < 4; ++nt) {
                    f32x16 S;
#pragma unroll
                    for (int i = 0; i < 16; ++i) S[i] = 0.f;
#pragma unroll
                    for (int ks = 0; ks < 8; ++ks) { const bf16x8 A = *(const LAS bf16x8*)(lds + (side * 128 + nt * 32 + q) * PS_KROW + (ks * 16 + hh * 8) * 2);
                        S = __builtin_amdgcn_mfma_f32_32x32x16_bf16(A, Qf[ks], S, 0, 0, 0); }
#pragma unroll
                    for (int i = 0; i < 16; ++i) { const int n = nt * 32 + (i & 3) + 8 * (i >> 2) + 4 * hh;
                        topk_insert(a, __uint_as_float((__float_as_uint(S[i]) & 0xffffff80u) | (unsigned)n)); }
                }
                float pb[16];
#pragma unroll
                for (int j = 0; j < 16; ++j) pb[j] = __shfl_xor(a[j], 32);
#pragma unroll
                for (int j = 0; j < 16; ++j) topk_insert(a, pb[j]);
#pragma unroll
                for (int j = 0; j < 16; ++j) { lst[side][j] = a[j]; myidx[side * 16 + j] = (unsigned char)(__float_as_uint(a[j]) & 0x7fu); }
            }
            float cb[16];
#pragma unroll
            for (int j = 0; j < 16; ++j) cb[j] = -3.0e38f;
            { int cid = 0;
#pragma unroll
              for (int a = 0; a < 16; ++a)
#pragma unroll
                  for (int b = 0; b < 16 / (a + 1); ++b) {
                      const float sa = __uint_as_float(__float_as_uint(lst[0][a]) & 0xffffff80u), sb = __uint_as_float(__float_as_uint(lst[1][b]) & 0xffffff80u);
                      topk_insert(cb, __uint_as_float((__float_as_uint(sa + sb) & 0xffffffc0u) | (unsigned)cid)); ++cid; } }
            const float mx = __uint_as_float(__float_as_uint(cb[0]) & 0xffffffc0u);
            float e[16], den = 0.f;
#pragma unroll
            for (int j = 0; j < 16; ++j) { e[j] = __expf(__uint_as_float(__float_as_uint(cb[j]) & 0xffffffc0u) - mx); den += e[j]; }
            const float rden = 1.f / den;
#pragma unroll
            for (int j = 0; j < 16; ++j) {
                if ((j >> 3) == hh) { const int cid = (int)(__float_as_uint(cb[j]) & 0x3fu);
                    const int a = tab[cid * 2], b = tab[cid * 2 + 1];
                    const int eidx = (int)myidx[a] * 128 + (int)myidx[16 + b];
                    SELI[(size_t)(T0 + q) * 128 + h * 16 + j] = eidx; SELW[(size_t)(T0 + q) * 128 + h * 16 + j] = e[j] * rden; }
            }
        }
    }
    __syncthreads();
}

DI u32x16 fp6_unpack_bf16(u32x4 a, u32x2 b) { const u32x6 pk = {a.x, a.y, a.z, a.w, b.x, b.y}; return __builtin_bit_cast(u32x16, __builtin_amdgcn_cvt_scalef32_pk32_bf16_fp6(pk, 1.0f)); }
DI f32x32 fp6_unpack(u32x4 a, u32x2 b) { const u32x6 pk = {a.x, a.y, a.z, a.w, b.x, b.y}; return __builtin_amdgcn_cvt_scalef32_pk32_f32_fp6(pk, 1.0f); }
constexpr int GN = 4;
template <bool NEXTNORM>
DI void peer_gather(const Ctx& F, const Params& P, const float* modl, int layer, const float* ngain, const float* nmodl) {
    const bf16_t* H2 = (const bf16_t*)(P.ws + WS_HM);
    const unsigned char* TU = P.ws + WS_TBLU + (size_t)layer * 16384 * PT_ROWB; const unsigned char* TV = P.ws + WS_TBLV + (size_t)layer * 16384 * PT_ROWB;
    const float* SCU = (const float*)(P.ws + WS_SC) + layer * 16384; const float* SCV = (const float*)(P.ws + WS_SC) + (2 + layer) * 16384;
    const int* SELI = (const int*)(P.ws + WS_RA + RA_SELI); const float* SELW = (const float*)(P.ws + WS_RA + RA_SELW);
    float* X = P.out + O_Y;
    const int lane = lane_id();
    const int stride = F.G * 8;
    for (int T0 = F.bid * 8 + F.wave; T0 < TOK; T0 += 2 * stride) {
        const bool two = (T0 + stride < TOK);
        const int Tt[2] = {T0, two ? T0 + stride : T0};
        u32x4 xw[2][4]; int e0[2], e1[2]; float g0[2], g1[2], d0[2], d1[2];
#pragma unroll
        for (int t = 0; t < 2; ++t) {
#pragma unroll
            for (int q4 = 0; q4 < 4; ++q4) xw[t][q4] = *(const u32x4*)(H2 + (size_t)Tt[t] * DM + lane * 32 + q4 * 8);
            e0[t] = SELI[(size_t)Tt[t] * 128 + lane]; e1[t] = SELI[(size_t)Tt[t] * 128 + 64 + lane];
            g0[t] = SELW[(size_t)Tt[t] * 128 + lane]; g1[t] = SELW[(size_t)Tt[t] * 128 + 64 + lane]; d0[t] = 0.f; d1[t] = 0.f; }
#pragma unroll 1
        for (int kb = 0; kb < 128; kb += GN) {
            u32x4 ura[2][GN]; u32x2 urb[2][GN];
#pragma unroll
            for (int j = 0; j < GN; ++j)
#pragma unroll
                for (int t = 0; t < 2; ++t) { const int k = kb + j; const int e = __builtin_amdgcn_readlane(k < 64 ? e0[t] : e1[t], k & 63);
                    const unsigned char* up = TU + (size_t)e * PT_ROWB;
                    ura[t][j] = *(const u32x4*)(up + lane * 16); urb[t][j] = *(const u32x2*)(up + 1024 + lane * 8); }
#pragma unroll
            for (int j = 0; j < GN; ++j) { float pt[2];
#pragma unroll
                for (int t = 0; t < 2; ++t) { const u32x16 r = fp6_unpack_bf16(ura[t][j], urb[t][j]);
                    float sa = 0.f, sb = 0.f, sc2 = 0.f, sd = 0.f;
#pragma unroll
                    for (int i = 0; i < 4; ++i) { const unsigned x0 = xw[t][i].x, x1 = xw[t][i].y, x2 = xw[t][i].z, x3 = xw[t][i].w;
                        sa = dot2bf(r[4 * i], x0, sa); sb = dot2bf(r[4 * i + 1], x1, sb); sc2 = dot2bf(r[4 * i + 2], x2, sc2); sd = dot2bf(r[4 * i + 3], x3, sd); }
                    pt[t] = (sa + sb) + (sc2 + sd); }
                const float sm0 = wave_sum(pt[0]), sm1 = wave_sum(pt[1]); const int k = kb + j;
                if (k < 64) { if (lane == k) { d0[0] = sm0; d0[1] = sm1; } } else { if (lane == k - 64) { d1[0] = sm0; d1[1] = sm1; } } }
        }
        float cf0[2], cf1[2];
#pragma unroll
        for (int t = 0; t < 2; ++t) { cf0[t] = g0[t] * gelu_tanh(d0[t] * SCU[e0[t]]) * SCV[e0[t]]; cf1[t] = g1[t] * gelu_tanh(d1[t] * SCU[e1[t]]) * SCV[e1[t]]; }
        f32x2 acc[2][16];
#pragma unroll
        for (int t = 0; t < 2; ++t)
#pragma unroll
            for (int i = 0; i < 16; ++i) acc[t][i] = (f32x2){0.f, 0.f};
#pragma unroll 1
        for (int kb = 0; kb < 128; kb += GN) {
            u32x4 vra[2][GN]; u32x2 vrb[2][GN]; float cf[2][GN];
#pragma unroll
            for (int j = 0; j < GN; ++j)
#pragma unroll
                for (int t = 0; t < 2; ++t) { const int k = kb + j; const int e = __builtin_amdgcn_readlane(k < 64 ? e0[t] : e1[t], k & 63);
                    cf[t][j] = __builtin_bit_cast(float, __builtin_amdgcn_readlane(__builtin_bit_cast(int, k < 64 ? cf0[t] : cf1[t]), k & 63));
                    const unsigned char* vp = TV + (size_t)e * PT_ROWB;
                    vra[t][j] = *(const u32x4*)(vp + lane * 16); vrb[t][j] = *(const u32x2*)(vp + 1024 + lane * 8); }
#pragma unroll
            for (int j = 0; j < GN; ++j)
#pragma unroll
                for (int t = 0; t < 2; ++t) { const f32x32 r = fp6_unpack(vra[t][j], vrb[t][j]);
                    const f32x2 c2 = (f32x2){cf[t][j], cf[t][j]};
#pragma unroll
                    for (int i = 0; i < 16; ++i) acc[t][i] += c2 * (f32x2){r[2 * i], r[2 * i + 1]}; }
        }
#pragma unroll
        for (int t = 0; t < 2; ++t) {
            if (t == 1 && !two) break;
            const int T = Tt[t];
            const float* gate = modl + (size_t)(cond_of(T) * 6 + 5) * DM;
            f32x4 xn[8]; float ss = 0.f;
#pragma unroll
            for (int q4 = 0; q4 < 8; ++q4) { const int col = lane * 32 + q4 * 4; float* xp = X + (size_t)T * DM + col;
                const f32x4 gv = *(const f32x4*)(gate + col), x0 = *(const f32x4*)(xp);
                const f32x4 r = x0 + gv * (f32x4){acc[t][q4 * 2].x, acc[t][q4 * 2].y, acc[t][q4 * 2 + 1].x, acc[t][q4 * 2 + 1].y};
                *(f32x4*)(xp) = r; xn[q4] = r; ss += r.x * r.x + r.y * r.y + r.z * r.z + r.w * r.w; }
            if (NEXTNORM) {
                ss = wave_sum(ss);
                const float rstd = rsqrtf(ss * (1.f / DM) + NORM_EPS);
                const float* sh = nmodl + (size_t)(cond_of(T) * 6 + 0) * DM; const float* sc = sh + DM;
                bf16_t* H = (bf16_t*)(P.ws + WS_HM);
#pragma unroll
                for (int q4 = 0; q4 < 8; ++q4) { const int col = lane * 32 + q4 * 4;
                    const f32x4 g4 = *(const f32x4*)(ngain + col), s4 = *(const f32x4*)(sc + col), h4 = *(const f32x4*)(sh + col);
                    const f32x4 o = xn[q4] * rstd * g4 * (s4 + 1.f) + h4;
                    *(u32x2*)(H + (size_t)T * DM + col) = (u32x2){pk2(o.x, o.y), pk2(o.z, o.w)}; }
            }
        }
    }
}
constexpr int NPHASE = 22;

__global__ void __launch_bounds__(NTHR, 2) mega(Params P) {
    extern __shared__ __attribute__((aligned(16))) unsigned char lds_raw[];
    Ctx F;
    F.lds = (LAS unsigned char*)lds_raw; F.tid = threadIdx.x; F.lane = F.tid & 63; F.wave = __builtin_amdgcn_readfirstlane(F.tid >> 6); F.G = gridDim.x; F.bid = blockIdx.x;
    const int lo = P.ph_lo, hi = P.ph_hi;
    volatile LAS unsigned* xbw = (volatile LAS unsigned*)(F.lds + LDS_BYTES - 16);
    if (F.tid == 0) { xbw[0] = 0u; xbw[1] = 0u; xbw[2] = 0u; xbw[3] = 0u; }
    __syncthreads();
    if (hi - lo > 1) (void)xcd_barrier_post((unsigned*)(P.ws + WS_CTL), xbw);
#define GRID_BARRIER() do { XcdBarrier bar_; bar_.bar = (unsigned*)(P.ws + WS_CTL); bar_.x = xb_xcc_id(); bar_.st = (volatile LAS unsigned*)(F.lds + LDS_BYTES - 16); xcd_barrier(bar_); } while (0)
#define PH(k, ...) if (lo <= (k) && (k) < hi) { { __VA_ARGS__ } if ((k) + 1 < hi) GRID_BARRIER(); }
#define MOD0 ((const float*)(P.ws + WS_MOD))
#define MOD1 ((const float*)(P.ws + WS_MOD) + 9 * 12288)
#define HM ((bf16_t*)(P.ws + WS_HM))
#define RA ((bf16_t*)(P.ws + WS_RA))
#define X (P.out + O_Y)

    PH(0, prologue(F, P);)
    PH(1, adaln_reduce(F, P);)
    PH(2, norm_phase(F, P.in[I_XP], P.in[I_XS], P.in[I_NMIXG], MOD0, 0, HM);)
    PH(3, { EpiBf16 E{RA, 4096}; run_gemm(F, HM, (const bf16_t*)(P.ws + WS_WEVIN) + (size_t)2048 * 2048, 4096, 2048, E); })
    PH(4, prep_a(F, P);)
    PH(5, { EpiBf16 E{RA, 2048}; run_gemm(F, HM, (const bf16_t*)(P.ws + WS_WEVIN), 2048, 2048, E); })
    PH(6, attn_phase<0>(F, P); attn_phase<1>(F, P); hyena_phase(F, P);)
    PH(7, hyena_post(F, P);)
    PH(8, { EpiResid E{P.in[I_XP], P.in[I_XS], X, MOD0, 2}; run_gemm(F, HM, (const bf16_t*)(P.ws + WS_WEVOUT), 2048, 2048, E); })
    PH(9, norm_phase(F, X, X + (size_t)TP * DM, P.in[I_NFFNG], MOD0, 3, HM);)
    PH(10, { EpiBf16 E{RA, 2048}; run_gemm(F, HM, (const bf16_t*)(P.ws + WS_WPQ), 2048, 2048, E); })
    PH(11, peer_select(F, P, 0);)
    PH(12, peer_gather<true>(F, P, MOD0, 0, P.in[I_NMIXG] + DM, MOD1);)
    PH(13, { EpiBf16 E{RA, 4096}; run_gemm(F, HM, (const bf16_t*)(P.ws + WS_WODIN), 4096, 2048, E); })
    PH(14, prep_c(F, P); s5_phase(F, P);)
    PH(15, attn_diff_phase<false>(F, P); attn_diff_phase<true>(F, P); s5_combine(F, P);)
    PH(16, { EpiGlu E{(const bf16_t*)(P.ws + WS_RB + RB_Y), HM, P.in[I_GLUB]}; run_gemm(F, (const bf16_t*)(P.ws + WS_RB + RB_Y), (const bf16_t*)(P.ws + WS_WGLU), 1024, 1024, E); })
    PH(17, { EpiResid E{X, X + (size_t)TP * DM, X, MOD1, 2}; run_gemm(F, HM, (const bf16_t*)(P.ws + WS_WODOUT), 2048, 2048, E); })
    PH(18, norm_phase(F, X, X + (size_t)TP * DM, P.in[I_NFFNG] + DM, MOD1, 3, HM);)
    PH(19, { EpiBf16 E{RA, 2048}; run_gemm(F, HM, (const bf16_t*)(P.ws + WS_WPQ) + (size_t)2048 * 2048, 2048, 2048, E); })
    PH(20, peer_select(F, P, 1);)
    PH(21, peer_gather<false>(F, P, MOD1, 1, nullptr, nullptr);)
#undef MOD0
#undef MOD1
#undef HM
#undef RA
#undef X
#undef PH
#undef GRID_BARRIER
}

extern "C" void kernel_launch(void* const* d_in, const int* in_sizes, int n_in, void* d_out, int out_size, void* d_ws, size_t ws_size, hipStream_t stream) {
    static int grid = 0;
    if (grid == 0) {
        if (n_in != N_IN || (size_t)out_size != O_END || ws_size < WS_END) { fprintf(stderr, "kernel_launch: unexpected shapes (n_in %d, out %d, ws %zu, need %zu)\n", n_in, out_size, ws_size, (size_t)WS_END); grid = -1; return; }
        int dev = 0, cus = 0;
        if (hipGetDevice(&dev) != hipSuccess || hipDeviceGetAttribute(&cus, hipDeviceAttributeMultiprocessorCount, dev) != hipSuccess) { grid = -1; return; }
        if (hipFuncSetAttribute((const void*)mega, hipFuncAttributeMaxDynamicSharedMemorySize, LDS_BYTES) != hipSuccess) { fprintf(stderr, "kernel_launch: hipFuncSetAttribute failed\n"); grid = -1; return; }
        int per_cu = 0;
        if (hipOccupancyMaxActiveBlocksPerMultiprocessor(&per_cu, (const void*)mega, NTHR, LDS_BYTES) != hipSuccess || per_cu < 1) { fprintf(stderr, "kernel_launch: occupancy query says %d blocks per CU\n", per_cu); }
        (void)hipGetLastError();
        grid = cus;
    }
    if (grid < 0) return;
    (void)hipMemsetAsync((char*)d_ws + WS_CTL, 0, 65536, stream);
    Params p; memset(&p, 0, sizeof(p));
    for (int i = 0; i < N_IN; ++i) p.in[i] = (const float*)d_in[i];
    p.out = (float*)d_out; p.ws = (unsigned char*)d_ws;
    p.ph_lo = 0; p.ph_hi = NPHASE;
    hipLaunchKernelGGL(mega, dim3(grid), dim3(NTHR), LDS_BYTES, stream, p);
}
```

```cpp
#include <hip/hip_runtime.h>
#include <cstdio>
#include <cstring>
#include <cstdint>

typedef unsigned short bf16_t;
typedef short bf16x8 __attribute__((ext_vector_type(8)));
typedef short s16x4 __attribute__((ext_vector_type(4)));
typedef float f32x2 __attribute__((ext_vector_type(2)));
typedef float f32x4 __attribute__((ext_vector_type(4)));
typedef float f32x16 __attribute__((ext_vector_type(16)));
typedef unsigned u32x2 __attribute__((ext_vector_type(2)));
typedef unsigned u32x4 __attribute__((ext_vector_type(4)));
typedef __bf16 bf16x2_t __attribute__((ext_vector_type(2)));
typedef float f32x32 __attribute__((ext_vector_type(32)));
typedef unsigned u32x6 __attribute__((ext_vector_type(6)));
typedef unsigned u32x16 __attribute__((ext_vector_type(16)));
typedef __bf16 bf16x32_t __attribute__((ext_vector_type(32)));

#define DI __device__ __forceinline__

constexpr int NTHR = 512;
constexpr int DM = 2048;
constexpr int TP = 8192;
constexpr int TS = 32768;
constexpr int TOK = TP + TS;
constexpr int LP = 256, LS = 4096;
constexpr float NORM_EPS = 1e-6f;
constexpr float LOG2E = 1.4426950408889634f;

enum { I_XP = 0, I_XS, I_C, I_CNK, I_CNV, I_CDK, I_CDV, I_S5RE, I_S5IM, I_CCTX, I_MODW, I_MODB, I_NMIXG, I_NFFNG, I_EVWIN, I_EVWOUT, I_NAQG, I_NAKG, I_RPB,
       I_HYCW, I_HYCB, I_HYW1, I_HYB1, I_HYF1, I_HYW2, I_HYB2, I_HYF2, I_HYW3, I_HYDEC, I_HYBIAS, I_ODWIN, I_ODWOUT, I_S5LRE, I_S5LIM, I_S5LDT, I_S5BRE, I_S5BIM,
       I_S5CRE, I_S5CIM, I_S5D, I_GLUW, I_GLUB, I_DQG, I_DKG, I_LQ1, I_LK1, I_LQ2, I_LK2, I_SUBG, I_PWQ, I_PKEYS, I_PU, I_PV, N_IN };

constexpr size_t O_Y = 0;
constexpr size_t O_NAK = 83886080, O_NAV = 92274688, O_DK = 100663296, O_DV = 109051904, O_SR = 117440512, O_SI = 117702656, O_END = 117964800;

constexpr size_t al256(size_t x) { return (x + 255) & ~(size_t)255; }
constexpr size_t WS_CTL = 0;
constexpr size_t WS_MODP = 65536;
constexpr size_t WS_MOD = WS_MODP + (size_t)2 * 16 * 9 * 12288 * 4;
constexpr size_t WS_WEVIN = al256(WS_MOD + (size_t)2 * 9 * 12288 * 4);
constexpr size_t WS_WEVOUT = WS_WEVIN + (size_t)6144 * 2048 * 2;
constexpr size_t WS_WODIN = WS_WEVOUT + (size_t)2048 * 2048 * 2;
constexpr size_t WS_WODOUT = WS_WODIN + (size_t)4096 * 2048 * 2;
constexpr size_t WS_WPQ = WS_WODOUT + (size_t)2048 * 2048 * 2;
constexpr size_t WS_WGLU = WS_WPQ + (size_t)2 * 2048 * 2048 * 2;
constexpr size_t WS_PKEYS = WS_WGLU + (size_t)1024 * 1024 * 2;
constexpr size_t WS_CNK = WS_PKEYS + (size_t)2 * 8 * 2 * 128 * 128 * 2;
constexpr size_t WS_CNVT = WS_CNK + (size_t)8 * 256 * 1024 * 2;
constexpr size_t WS_CDK = WS_CNVT + (size_t)8 * 256 * 1024 * 2;
constexpr size_t WS_CDVT = WS_CDK + (size_t)8 * 256 * 1024 * 2;
constexpr size_t WS_S5A = WS_CDVT + (size_t)8 * 256 * 1024 * 2;
constexpr size_t WS_S5BB = WS_S5A + (size_t)128 * 64 * 2 * 4;
constexpr size_t WS_S5CC = WS_S5BB + (size_t)128 * 128 * 16 * 2;
constexpr int KRL_S = 8208, KRL_P = 528;
constexpr size_t WS_KRS = WS_S5CC + (size_t)128 * 16 * 128 * 2;
constexpr size_t WS_KRP = al256(WS_KRS + (size_t)2 * 1024 * KRL_S * 2);
constexpr size_t WS_TBLU = al256(WS_KRP + (size_t)2 * 1024 * KRL_P * 2);
constexpr size_t WS_TBLV = WS_TBLU + (size_t)16384 * 2048 * 2;
constexpr size_t WS_HM = WS_TBLV + (size_t)16384 * 2048 * 2;
constexpr size_t WS_RA = WS_HM + (size_t)TOK * 2048 * 2;
constexpr size_t WS_RB = WS_RA + (size_t)TOK * 4096 * 2;
constexpr size_t WS_VT = WS_RB + (size_t)3072 * TOK * 2;
constexpr size_t WS_SC = WS_VT + (size_t)TOK * 1024 * 2;
constexpr size_t WS_END = WS_SC + (size_t)4 * 16384 * 4;
constexpr size_t RA_Q = 0;
constexpr size_t RA_SELI = (size_t)TOK * 2048 * 2;
constexpr size_t RA_SELW = RA_SELI + (size_t)TOK * 128 * 4;
constexpr size_t RA_CF = RA_SELW + (size_t)TOK * 128 * 4;
constexpr size_t RA_ZC = (size_t)TOK * 2048 * 2;
constexpr size_t RB_YF = 0, RB_YB = (size_t)TOK * 1024 * 2, RB_Y = (size_t)2 * TOK * 1024 * 2;
constexpr size_t VT_S = (size_t)TP * 1024 * 2;

constexpr int LDS_BYTES = 147456;

struct Params { const float* in[N_IN]; float* out; unsigned char* ws; int ph_lo, ph_hi; };

DI float bf2f(bf16_t b) { return __uint_as_float(((unsigned)b) << 16); }
DI float bflo(unsigned w) { return __uint_as_float(w << 16); }
DI float bfhi(unsigned w) { return __uint_as_float(w & 0xffff0000u); }
DI unsigned pk2(float a, float b) { f32x2 v = {a, b}; return __builtin_bit_cast(unsigned, __builtin_convertvector(v, bf16x2_t)); }
DI float dot2bf(unsigned a, unsigned b, float c) { return __builtin_amdgcn_fdot2_f32_bf16(__builtin_bit_cast(bf16x2_t, a), __builtin_bit_cast(bf16x2_t, b), c, false); }
DI bf16_t f2bf(float a) { return (bf16_t)(pk2(a, 0.f) & 0xffffu); }
DI float dpp_xor1(float v) { return __builtin_bit_cast(float, __builtin_amdgcn_update_dpp(0, __builtin_bit_cast(int, v), 0xB1, 0xF, 0xF, true)); }
DI float dpp_xor2(float v) { return __builtin_bit_cast(float, __builtin_amdgcn_update_dpp(0, __builtin_bit_cast(int, v), 0x4E, 0xF, 0xF, true)); }
DI float wave_sum(float v) {
    v += dpp_xor1(v); v += dpp_xor2(v);
    v += __builtin_bit_cast(float, __builtin_amdgcn_update_dpp(0, __builtin_bit_cast(int, v), 0x141, 0xF, 0xF, true));
    v += __builtin_bit_cast(float, __builtin_amdgcn_update_dpp(0, __builtin_bit_cast(int, v), 0x140, 0xF, 0xF, true));
    v += __builtin_bit_cast(float, __builtin_amdgcn_update_dpp(0, __builtin_bit_cast(int, v), 0x142, 0xA, 0xF, false));
    v += __builtin_bit_cast(float, __builtin_amdgcn_update_dpp(0, __builtin_bit_cast(int, v), 0x143, 0xC, 0xF, false));
    return __builtin_bit_cast(float, __builtin_amdgcn_readlane(__builtin_bit_cast(int, v), 63));
}
DI float gelu_tanh(float x) {
    const float u = 0.7978845608028654f * (x + 0.044715f * x * x * x);
    const float e = __expf(2.f * u);
    const float t = 1.f - 2.f / (e + 1.f);
    return 0.5f * x * (1.f + t);
}
DI float wave_max(float v) {
    v = fmaxf(v, dpp_xor1(v)); v = fmaxf(v, dpp_xor2(v));
    v = fmaxf(v, __builtin_bit_cast(float, __builtin_amdgcn_update_dpp(0, __builtin_bit_cast(int, v), 0x141, 0xF, 0xF, true)));
    v = fmaxf(v, __builtin_bit_cast(float, __builtin_amdgcn_update_dpp(0, __builtin_bit_cast(int, v), 0x140, 0xF, 0xF, true)));
    v = fmaxf(v, __builtin_bit_cast(float, __builtin_amdgcn_update_dpp(0, __builtin_bit_cast(int, v), 0x142, 0xA, 0xF, false)));
    v = fmaxf(v, __builtin_bit_cast(float, __builtin_amdgcn_update_dpp(0, __builtin_bit_cast(int, v), 0x143, 0xC, 0xF, false)));
    return __builtin_bit_cast(float, __builtin_amdgcn_readlane(__builtin_bit_cast(int, v), 63));
}
DI f32x2 fp8x2_lo(unsigned w) { return __builtin_amdgcn_cvt_pk_f32_fp8((int)w, false); }
DI f32x2 fp8x2_hi(unsigned w) { return __builtin_amdgcn_cvt_pk_f32_fp8((int)w, true); }
DI unsigned pk_fp8x4(float a, float b, float c, float d) { int r = 0; r = __builtin_amdgcn_cvt_pk_fp8_f32(a, b, r, false); r = __builtin_amdgcn_cvt_pk_fp8_f32(c, d, r, true); return (unsigned)r; }
DI int lane_id() { return (int)__builtin_amdgcn_mbcnt_hi(~0u, __builtin_amdgcn_mbcnt_lo(~0u, 0u)); }
DI int cond_of(int T) { return T < TP ? 0 : 1 + ((T - TP) >> 12); }
#define XB_TMO      128
#define XB_XCNT(j)  (256  + 64 * (j))
#define XB_XSUB(j)  (1280 + 64 * (j))
#define XB_XGEN(j)  (2304 + 64 * (j))
#define XB_TOP      3328
#define XB_TOPGEN   3392
#define XCD_BAR_WORDS 3456
#define XB_SPIN_CAP (1u << 26)
#define LAS __attribute__((address_space(3)))

__device__ __forceinline__ unsigned xb_ld(unsigned* p)              { return __hip_atomic_load(p, __ATOMIC_RELAXED, __HIP_MEMORY_SCOPE_AGENT); }
__device__ __forceinline__ unsigned xb_add(unsigned* p, unsigned v) { return __hip_atomic_fetch_add(p, v, __ATOMIC_RELAXED, __HIP_MEMORY_SCOPE_AGENT); }
__device__ __forceinline__ unsigned xb_xcc_id() { return (unsigned)__builtin_amdgcn_s_getreg((3 << 11) | 20) & 0xFu; }
#define XB_SPIN(cond, bar) do { unsigned _sp = 0; while (cond) { __builtin_amdgcn_s_sleep(1); \
    if ((++_sp & 255u) == 0u) { if (xb_ld(&(bar)[XB_TMO])) break; if (_sp > XB_SPIN_CAP) { atomicAdd(&(bar)[XB_TMO], 1u); break; } } } } while (0)

struct XcdBarrier {
    unsigned* bar; unsigned x;
    volatile LAS unsigned* st;
};

__device__ __forceinline__ XcdBarrier xcd_barrier_post(unsigned* bar, volatile LAS unsigned* st) {
    XcdBarrier b; b.bar = bar; b.x = xb_xcc_id(); b.st = st;
    if (threadIdx.x == 0) (void)xb_add(&bar[XB_XCNT(b.x)], 1u);
    return b;
}
__device__ __forceinline__ void xcd_barrier_complete(unsigned* bar, unsigned x, unsigned& nloc, unsigned& nx) {
    const unsigned G = gridDim.x * gridDim.y * gridDim.z;
    unsigned sum, cnt, mine, sp = 0u;
    for (;;) {
        sum = 0u; cnt = 0u; mine = 0u;
#pragma unroll
        for (unsigned j = 0; j < 16; ++j) { const unsigned c = xb_ld(&bar[XB_XCNT(j)]); sum += c; cnt += (c > 0u) ? 1u : 0u; mine = (j == x) ? c : mine; }
        if (sum == G) break;
        __builtin_amdgcn_s_sleep(1);
        if ((++sp & 255u) == 0u) { if (xb_ld(&bar[XB_TMO])) break; if (sp > XB_SPIN_CAP) { atomicAdd(&bar[XB_TMO], 1u); break; } }
    }
    nloc = mine > 0u ? mine : 1u; nx = cnt > 0u ? cnt : 1u;
}

__device__ __forceinline__ void xcd_barrier(const XcdBarrier& b) {
    asm volatile("s_waitcnt vmcnt(0)" ::: "memory");
    __syncthreads();
    if (threadIdx.x == 0) {
        unsigned* bar = b.bar;
        __builtin_amdgcn_s_waitcnt(0);
        unsigned nloc = b.st[0], nx = b.st[1];
        if (nloc == 0u) { xcd_barrier_complete(bar, b.x, nloc, nx); b.st[0] = nloc; b.st[1] = nx; }
        const unsigned old = xb_add(&bar[XB_XSUB(b.x)], 1u);
        const unsigned gen = old / nloc;
        if (old + 1u == (gen + 1u) * nloc) {
            __builtin_amdgcn_fence(__ATOMIC_RELEASE, "agent");
            asm volatile("s_waitcnt vmcnt(0)" ::: "memory");
            const unsigned og = xb_add(&bar[XB_TOP], 1u);
            const unsigned tg = og / nx;
            if (og + 1u == (tg + 1u) * nx) xb_add(&bar[XB_TOPGEN], 1u);
            else XB_SPIN(xb_ld(&bar[XB_TOPGEN]) == tg, bar);
            __builtin_amdgcn_fence(__ATOMIC_ACQUIRE, "agent");
            xb_add(&bar[XB_XGEN(b.x)], 1u);
            asm volatile("s_waitcnt vmcnt(0)" ::: "memory");
        } else {
            XB_SPIN(xb_ld(&bar[XB_XGEN(b.x)]) == gen, bar);
            __builtin_amdgcn_fence(__ATOMIC_ACQUIRE, "agent");
            asm volatile("s_waitcnt vmcnt(0)" ::: "memory");
        }
    }
    __syncthreads();
}
namespace pg8 {
#define PG8_LAS __attribute__((address_space(3)))
typedef unsigned short bf16_t;
typedef short bf16x8 __attribute__((ext_vector_type(8)));
typedef float f32x4 __attribute__((ext_vector_type(4)));
typedef unsigned u32x4 __attribute__((ext_vector_type(4)));
constexpr int BM = 256, BK = 64, HALF = 128, HTB = HALF * BK * 2  , STAGE_BYTES = 8 * HTB, NXCD = 8, WGM = 8;

__host__ __device__ __forceinline__ int lds_byte(int r, int c) { const int st = (r >> 4) * 2 + (c >> 5), rr = r & 15, cc = c & 31, ob = rr * 64 + cc * 2; return st * 1024 + (ob ^ (((ob >> 9) & 1) << 5)); }
__host__ __device__ __forceinline__ void stage_rc(int b, int& R, int& C) { const int st = b / 1024, sb = b % 1024, swz = sb ^ (((sb >> 9) & 1) << 5); R = (st >> 1) * 16 + swz / 64; C = (st & 1) * 32 + (swz % 64) / 2; }
__host__ __device__ __forceinline__ int perm32(int rho) { const int n = rho >> 4, i = rho & 15; return 8 * (i >> 2) + 4 * n + (i & 3); }

struct Unit { int pm, pn; };
struct Gemm { const bf16_t* A; const bf16_t* Bt; int M, N, K; };

struct StaticOrder {
    int nM, nN, nwg, G, c;
    __host__ __device__ void init(int M, int N, int G_, int c_) { nM = M / BM; nN = N / BM; nwg = nM * nN; G = G_; c = c_; }
    __host__ __device__ bool next(int i, Unit& u) const {
        const long L = (long)i * G + c; if (L >= nwg) return false;
        int wgid = (int)L; { const int q = nwg / NXCD, r = nwg % NXCD, xcd = wgid % NXCD, off = wgid / NXCD; wgid = (xcd < r ? xcd * (q + 1) : r * (q + 1) + (xcd - r) * q) + off; }
        const int nig = WGM * nN, gid = wgid / nig, fm = gid * WGM, gsz = (nM - fm) < WGM ? (nM - fm) : WGM;
        u.pm = fm + ((wgid % nig) % gsz); u.pn = (wgid % nig) / gsz; return true;
    }
    __device__ __forceinline__ void a_ready(const Unit&) const {}
    __device__ __forceinline__ void done(const Unit&) const {}
};
__device__ __forceinline__ unsigned cvt_pk_bf16(float lo, float hi) { unsigned r; asm volatile("v_cvt_pk_bf16_f32 %0, %1, %2" : "=v"(r) : "v"(lo), "v"(hi)); return r; }
template <class Epi, class Sched, bool STAMP = false>
__device__ __forceinline__ void gemm_phase(PG8_LAS unsigned char* lds, const Gemm g, const Sched& S, const Epi& E, unsigned long long* stamps) {
    const int tid = threadIdx.x, wid = __builtin_amdgcn_readfirstlane(tid >> 6), lane = tid & 63, wr = wid >> 2, wc = wid & 3, fr = lane & 15, fq = lane >> 4;
    const int K = g.K, nt = K / BK;
    int ts_lo = 0, ts_hi = 0, nts = 0; const unsigned long long rt_entry = STAMP ? (unsigned long long)wall_clock64() : 0ull;
#define PG8_STAMP() do { if (STAMP && wid == 0 && nts < 64) { const unsigned long long _c = (unsigned long long)clock64(); \
        ts_lo = (lane == nts) ? (int)(unsigned)_c : ts_lo; ts_hi = (lane == nts) ? (int)(unsigned)(_c >> 32) : ts_hi; ++nts; } } while (0)
    PG8_STAMP();
    unsigned voffA[2], voffB[2];
#pragma unroll
    for (int i = 0; i < 2; ++i) { int R, C; stage_rc(tid * 16 + i * 8192, R, C); const int Rb = Epi::PERM ? ((R & ~31) + perm32(R & 31)) : R;
        voffA[i] = (unsigned)(R * K + C) * 2u; voffB[i] = (unsigned)(Rb * K + C) * 2u; }
    const size_t kstep = (size_t)(BK * 2);
    const size_t hstep = (size_t)HALF * K * 2;
    const size_t tstep = 2 * hstep;
    const unsigned ldsw = (unsigned)wid * 1024u;
    const int aoff = lds_byte(wr * 64 + fr, fq * 8), boff = lds_byte(wc * 32 + fr, fq * 8);
#define PG8_SA(b, h) (((b) * 2 + (h)) * HTB)
#define PG8_SB(b, h) ((4 + (b) * 2 + (h)) * HTB)
#define PG8_STAGE(bufoff, gbase, voff) do { _Pragma("unroll") for (int _i = 0; _i < 2; ++_i) \
        __builtin_amdgcn_global_load_lds((const unsigned*)((const char*)(gbase) + (voff)[_i]), (PG8_LAS unsigned*)(lds + (bufoff) + ldsw + _i * 8192), 16, 0, 0); } while (0)
#define PG8_LDA(dst, b, h) do { _Pragma("unroll") for (int m = 0; m < 4; ++m) _Pragma("unroll") for (int k = 0; k < 2; ++k) dst[m][k] = *(const PG8_LAS bf16x8*)(lds + PG8_SA(b, h) + aoff + m * 2048 + k * 1024); } while (0)
#define PG8_LDB(dst, b, h) do { _Pragma("unroll") for (int n = 0; n < 2; ++n) _Pragma("unroll") for (int k = 0; k < 2; ++k) dst[n][k] = *(const PG8_LAS bf16x8*)(lds + PG8_SB(b, h) + boff + n * 2048 + k * 1024); } while (0)
#define PG8_MMA(ai, bj, At, Bt) do { __builtin_amdgcn_s_setprio(1); _Pragma("unroll") for (int m = 0; m < 4; ++m) _Pragma("unroll") for (int n = 0; n < 2; ++n) _Pragma("unroll") for (int k = 0; k < 2; ++k) \
        acc[ai][bj][m][n] = __builtin_amdgcn_mfma_f32_16x16x32_bf16(Bt[n][k], At[m][k], acc[ai][bj][m][n], 0, 0, 0); __builtin_amdgcn_s_setprio(0); } while (0)
#define PG8_WAIT_V(n) asm volatile("s_waitcnt vmcnt(" #n ")" ::: "memory")
#define PG8_WAIT_L(n) asm volatile("s_waitcnt lgkmcnt(" #n ")" ::: "memory")
#define PG8_BAR __builtin_amdgcn_s_barrier()
#define PG8_SCHED __builtin_amdgcn_sched_barrier(0)
    Unit cur, nxt; int ui = 0;
    if (!S.next(0, cur)) return;
    f32x4 acc[2][2][4][2];
#pragma unroll
    for (int a = 0; a < 2; ++a)
#pragma unroll
        for (int b = 0; b < 2; ++b)
#pragma unroll
            for (int m = 0; m < 4; ++m)
#pragma unroll
                for (int n = 0; n < 2; ++n) acc[a][b][m][n] = (f32x4){0.f, 0.f, 0.f, 0.f};
    bf16x8 At[4][2], B0[2][2], B1[2][2];
    const char* cA = (const char*)g.A + (size_t)cur.pm * tstep; const char* cB = (const char*)g.Bt + (size_t)cur.pn * tstep;
    S.a_ready(cur);
    PG8_STAGE(PG8_SB(0, 0), cB, voffB); PG8_STAGE(PG8_SA(0, 0), cA, voffA); PG8_STAGE(PG8_SB(0, 1), cB + hstep, voffB); PG8_STAGE(PG8_SA(0, 1), cA + hstep, voffA);
    if (wr == 1) PG8_BAR;
    PG8_WAIT_V(4); PG8_BAR;
    PG8_STAGE(PG8_SB(1, 0), cB + kstep, voffB); PG8_STAGE(PG8_SA(1, 0), cA + kstep, voffA); PG8_STAGE(PG8_SB(1, 1), cB + hstep + kstep, voffB);
    PG8_WAIT_V(6); PG8_BAR;
    PG8_STAMP();
    for (;;) {
        const bool has_next = S.next(ui + 1, nxt);
        const char* nA = has_next ? (const char*)g.A + (size_t)nxt.pm * tstep : cA; const char* nB = has_next ? (const char*)g.Bt + (size_t)nxt.pn * tstep : cB;
        for (int t = 0; t < nt; t += 2) {
            const bool last = (t == nt - 2);
            const char* a1 = cA + (size_t)(t + 1) * kstep;
            const char* a2 = last ? nA : cA + (size_t)(t + 2) * kstep; const char* b2 = last ? nB : cB + (size_t)(t + 2) * kstep;
            const char* a3 = a2 + kstep; const char* b3 = b2 + kstep;
            if (last && has_next) S.a_ready(nxt);
            PG8_LDB(B0, 0, 0); PG8_SCHED; PG8_LDA(At, 0, 0); PG8_STAGE(PG8_SA(1, 1), a1 + hstep, voffA);
            PG8_WAIT_L(8); PG8_BAR; PG8_WAIT_L(0); PG8_MMA(0, 0, At, B0); PG8_BAR; PG8_SCHED;
            PG8_LDB(B1, 0, 1); PG8_STAGE(PG8_SB(0, 0), b2, voffB);
            PG8_BAR; PG8_WAIT_L(0); PG8_MMA(0, 1, At, B1); PG8_BAR;
            PG8_LDA(At, 0, 1); PG8_STAGE(PG8_SA(0, 0), a2, voffA);
            PG8_BAR; PG8_WAIT_L(0); PG8_MMA(1, 0, At, B0); PG8_BAR; PG8_SCHED;
            PG8_STAGE(PG8_SB(0, 1), b2 + hstep, voffB);
            PG8_WAIT_V(6); PG8_BAR; PG8_MMA(1, 1, At, B1); PG8_BAR;
            PG8_LDB(B0, 1, 0); PG8_SCHED; PG8_LDA(At, 1, 0); PG8_STAGE(PG8_SA(0, 1), a2 + hstep, voffA);
            PG8_WAIT_L(8); PG8_BAR; PG8_WAIT_L(0); PG8_MMA(0, 0, At, B0); PG8_BAR; PG8_SCHED;
            PG8_LDB(B1, 1, 1); PG8_STAGE(PG8_SB(1, 0), b3, voffB);
            PG8_BAR; PG8_WAIT_L(0); PG8_MMA(0, 1, At, B1); PG8_BAR;
            PG8_LDA(At, 1, 1); PG8_STAGE(PG8_SA(1, 0), a3, voffA);
            PG8_BAR; PG8_WAIT_L(0); PG8_MMA(1, 0, At, B0); PG8_BAR; PG8_SCHED;
            PG8_STAGE(PG8_SB(1, 1), b3 + hstep, voffB);
            PG8_WAIT_V(6); PG8_BAR; PG8_MMA(1, 1, At, B1); PG8_BAR;
        }
        PG8_STAMP();
        if constexpr (!Epi::AFTER_DRAIN) { E(acc, cur, wr, wc, fr, fq); S.done(cur); }
        PG8_STAMP();
        if (!has_next) break;
#pragma unroll
        for (int a = 0; a < 2; ++a)
#pragma unroll
            for (int b = 0; b < 2; ++b)
#pragma unroll
                for (int m = 0; m < 4; ++m)
#pragma unroll
                    for (int n = 0; n < 2; ++n) acc[a][b][m][n] = (f32x4){0.f, 0.f, 0.f, 0.f};
        cur = nxt; cA = nA; cB = nB; ++ui;
    }
    PG8_WAIT_V(0);
    if (wr == 0) PG8_BAR;
    PG8_BAR;
    if constexpr (Epi::AFTER_DRAIN) { E.fused(acc, cur, wr, wc, fr, fq, lds, wid, lane); S.done(cur); }
    PG8_STAMP();
    if (STAMP && wid == 0) { stamps[lane] = lane < nts ? (((unsigned long long)(unsigned)ts_hi << 32) | (unsigned)ts_lo) : 0ull;
        if (lane == 62) stamps[62] = rt_entry; if (lane == 63) stamps[63] = (unsigned long long)wall_clock64(); }
#undef PG8_STAMP
#undef PG8_SA
#undef PG8_SB
#undef PG8_STAGE
#undef PG8_LDA
#undef PG8_LDB
#undef PG8_MMA
#undef PG8_WAIT_V
#undef PG8_WAIT_L
#undef PG8_BAR
#undef PG8_SCHED
}
}
struct Ctx {
    LAS unsigned char* lds; int tid, lane, wave, G, bid;
};

DI void cvt_rows(const Ctx& F, const float* src, bf16_t* dst, size_t n) {
    const size_t n8 = n >> 3;
    for (size_t i = (size_t)F.bid * NTHR + F.tid; i < n8; i += (size_t)F.G * NTHR) {
        const f32x4 a = *(const f32x4*)(src + i * 8), b = *(const f32x4*)(src + i * 8 + 4);
        u32x4 w; w.x = pk2(a.x, a.y); w.y = pk2(a.z, a.w); w.z = pk2(b.x, b.y); w.w = pk2(b.z, b.w);
        *(u32x4*)(dst + i * 8) = w;
    }
}

constexpr int TR_S = 68;
DI void tr_tile_out(const Ctx& F, bf16_t* dst, size_t ldd, const LAS bf16_t* tile) {
    const int n = F.tid >> 3, kc = (F.tid & 7) * 8;
    const LAS bf16_t* t = tile + kc * TR_S + n;
    u32x4 v;
    v.x = (unsigned)t[0] | ((unsigned)t[TR_S] << 16); v.y = (unsigned)t[2 * TR_S] | ((unsigned)t[3 * TR_S] << 16);
    v.z = (unsigned)t[4 * TR_S] | ((unsigned)t[5 * TR_S] << 16); v.w = (unsigned)t[6 * TR_S] | ((unsigned)t[7 * TR_S] << 16);
    *(u32x4*)(dst + (size_t)n * ldd + kc) = v;
}
DI void tr_tile_f32(const Ctx& F, const float* src, size_t lds_, bf16_t* dst, size_t ldd, LAS bf16_t* tile) {
#pragma unroll
    for (int j = 0; j < 2; ++j) {
        const int id = F.tid + NTHR * j, kr = id >> 4, nc = (id & 15) * 4;
        const f32x4 v = *(const f32x4*)(src + (size_t)kr * lds_ + nc);
        *(LAS u32x2*)(tile + kr * TR_S + nc) = (u32x2){pk2(v.x, v.y), pk2(v.z, v.w)};
    }
    __syncthreads();
    tr_tile_out(F, dst, ldd, tile);
    __syncthreads();
}
DI void tr_tile_bf16(const Ctx& F, const bf16_t* src, size_t lds_, bf16_t* dst, size_t ldd, LAS bf16_t* tile) {
    { const int kr = F.tid >> 3, nc = (F.tid & 7) * 8; const u32x4 v = *(const u32x4*)(src + (size_t)kr * lds_ + nc);
      *(LAS u32x2*)(tile + kr * TR_S + nc) = (u32x2){v.x, v.y}; *(LAS u32x2*)(tile + kr * TR_S + nc + 4) = (u32x2){v.z, v.w}; }
    __syncthreads();
    tr_tile_out(F, dst, ldd, tile);
    __syncthreads();
}
DI void transpose_weight(const Ctx& F, const float* W, int K, int N, bf16_t* Wt) {
    const int tk = K / 64, tn = N / 64;
    for (int t = F.bid; t < tk * tn; t += F.G) {
        const int k0 = (t / tn) * 64, n0 = (t % tn) * 64;
        tr_tile_f32(F, W + (size_t)k0 * N + n0, (size_t)N, Wt + (size_t)n0 * K + k0, (size_t)K, (LAS bf16_t*)F.lds);
    }
}
DI void transpose_cache_v(const Ctx& F, const float* V, bf16_t* VT) {
    for (int t = F.bid; t < 64 * 8; t += F.G) {
        const int bh = t >> 3, sub = t & 7, k0 = (sub >> 1) * 64, d0 = (sub & 1) * 64, b = bh >> 3, h = bh & 7;
        tr_tile_f32(F, V + ((size_t)b * 256 + k0) * 1024 + h * 128 + d0, 1024, VT + ((size_t)bh * 128 + d0) * 256 + k0, 256, (LAS bf16_t*)F.lds);
    }
}

DI void adaln_partials(const Ctx& F, const Params& P) {
    LAS float* s = (LAS float*)F.lds;
    const float* modw = P.in[I_MODW]; const float* cv = P.in[I_C]; const float* cctx = P.in[I_CCTX];
    float* modp = (float*)(P.ws + WS_MODP);
    for (int it = F.bid; it < 192; it += F.G) {
        const int i = it / 96, r = it % 96, ks = r / 6, cg = r % 6;
        __syncthreads();
        for (int e = F.tid; e < 9 * 128; e += NTHR) { const int j = e >> 7, k = e & 127; const float c = (j == 0) ? cctx[ks * 128 + k] : cv[(j - 1) * 2048 + ks * 128 + k]; s[e] = c / (1.f + __expf(-c)); }
        __syncthreads();
        f32x4 acc[9];
#pragma unroll
        for (int j = 0; j < 9; ++j) acc[j] = (f32x4){0.f, 0.f, 0.f, 0.f};
        const float* w = modw + ((size_t)i * 2048 + ks * 128) * 12288 + cg * 2048 + F.tid * 4;
#pragma unroll 8
        for (int k = 0; k < 128; ++k) {
            const f32x4 w4 = *(const f32x4*)(w + (size_t)k * 12288);
#pragma unroll
            for (int j = 0; j < 9; ++j) acc[j] += w4 * s[j * 128 + k];
        }
#pragma unroll
        for (int j = 0; j < 9; ++j) *(f32x4*)(modp + ((size_t)(i * 16 + ks) * 9 + j) * 12288 + cg * 2048 + F.tid * 4) = acc[j];
    }
    __syncthreads();
}
DI void adaln_reduce(const Ctx& F, const Params& P) {
    const float* modp = (const float*)(P.ws + WS_MODP); float* mod = (float*)(P.ws + WS_MOD); const float* modb = P.in[I_MODB];
    for (int e = F.bid * NTHR + F.tid; e < 2 * 9 * 12288; e += F.G * NTHR) {
        const int i = e / (9 * 12288), r = e % (9 * 12288), j = r / 12288, n = r % 12288;
        float a = modb[i * 12288 + n];
#pragma unroll
        for (int ks = 0; ks < 16; ++ks) a += modp[((size_t)(i * 16 + ks) * 9 + j) * 12288 + n];
        mod[e] = a;
    }
}

DI void hyena_filters(const Ctx& F, const Params& P) {
    LAS float* z = (LAS float*)F.lds;
    LAS float* h1 = z + 320;
    LAS float* h2 = h1 + 576;
    const float* w1 = P.in[I_HYW1]; const float* b1 = P.in[I_HYB1]; const float* f1 = P.in[I_HYF1];
    const float* w2 = P.in[I_HYW2]; const float* b2 = P.in[I_HYB2]; const float* f2 = P.in[I_HYF2];
    const float* w3 = P.in[I_HYW3]; const float* dec = P.in[I_HYDEC];
    for (int it = F.bid; it < 544; it += F.G) {
        const bool smp = it < 512; const int L = smp ? LS : LP, p0 = (smp ? it : it - 512) * 8, RL = smp ? KRL_S : KRL_P;
        bf16_t* KR = (bf16_t*)(P.ws + (smp ? WS_KRS : WS_KRP));
        __syncthreads();
        if (F.tid < 9 * 33) {
            const int ps = F.tid / 33, k = F.tid % 33, i = p0 + ps;
            const float t = (float)i / (float)(L - 1), wang = 6.283185307179586f * (float)i / (float)L;
            float val;
            if (k == 0) val = t;
            else { const int f = (k - 1) & 15; const float fr = 1e-4f + (float)f * ((15.0f - 1e-4f) / 15.0f); val = (k <= 16) ? cosf(fr * wang) : -sinf(fr * wang); }
            z[F.tid] = val;
        }
        __syncthreads();
        for (int e = F.tid; e < 9 * 64; e += NTHR) { const int ps = e >> 6, j = e & 63; float a = b1[j];
            for (int k = 0; k < 33; ++k) a += z[ps * 33 + k] * w1[k * 64 + j];
            h1[e] = sinf(f1[j] * a); }
        __syncthreads();
        for (int e = F.tid; e < 9 * 64; e += NTHR) { const int ps = e >> 6, j = e & 63; float a = b2[j];
            for (int k = 0; k < 64; ++k) a += h1[ps * 64 + k] * w2[k * 64 + j];
            h2[e] = sinf(f2[j] * a); }
        __syncthreads();
#pragma unroll 1
        for (int qh = 0; qh < 2; ++qh) {
            float acc[9][4];
#pragma unroll
            for (int ps = 0; ps < 9; ++ps)
#pragma unroll
                for (int q = 0; q < 4; ++q) acc[ps][q] = 0.f;
#pragma unroll 2
            for (int k = 0; k < 64; ++k) {
                float w[4];
#pragma unroll
                for (int q = 0; q < 4; ++q) w[q] = w3[k * 4096 + F.tid + NTHR * (qh * 4 + q)];
#pragma unroll
                for (int ps = 0; ps < 9; ++ps) { const float hv = h2[ps * 64 + k];
#pragma unroll
                    for (int q = 0; q < 4; ++q) acc[ps][q] += hv * w[q]; }
            }
#pragma unroll
            for (int q = 0; q < 4; ++q) {
                const int n = F.tid + NTHR * (qh * 4 + q), o = (n >> 10) & 1, c = n & 1023;
                const float dc = fabsf(dec[n]);
                bf16_t* row = KR + (size_t)(o * 1024 + c) * RL;
                float v[9];
#pragma unroll
                for (int ps = 0; ps < 9; ++ps) { const int i = p0 + ps; v[ps] = (i < L) ? acc[ps][q] * __expf(-((float)i / (float)(L - 1)) * dc) : 0.f; }
                if (qh == 0) {
                    u32x4 wv; wv.x = pk2(v[8], v[7]); wv.y = pk2(v[6], v[5]); wv.z = pk2(v[4], v[3]); wv.w = pk2(v[2], v[1]);
                    *(u32x4*)(row + (L - p0 - 8)) = wv;
                    if (p0 == 0) row[L] = f2bf(v[0]);
                } else if (p0 > 0) {
                    u32x4 wv; wv.x = pk2(v[0], v[1]); wv.y = pk2(v[2], v[3]); wv.z = pk2(v[4], v[5]); wv.w = pk2(v[6], v[7]);
                    *(u32x4*)(row + (L + p0)) = wv;
                } else {
#pragma unroll
                    for (int ps = 1; ps < 8; ++ps) row[L + ps] = f2bf(v[ps]);
                }
            }
        }
    }
    __syncthreads();
    for (int e = F.bid * NTHR + F.tid; e < 2 * 2048; e += F.G * NTHR) {
        const bool smp = e < 2048; const int r = e & 2047, L = smp ? LS : LP, RL = smp ? KRL_S : KRL_P;
        bf16_t* row = (bf16_t*)(P.ws + (smp ? WS_KRS : WS_KRP)) + (size_t)r * RL;
        for (int x = 2 * L; x < RL; ++x) row[x] = 0;
    }
}

DI void s5_consts(const Ctx& F, const Params& P) {
    float* S5A = (float*)(P.ws + WS_S5A); bf16_t* BB = (bf16_t*)(P.ws + WS_S5BB); bf16_t* CC = (bf16_t*)(P.ws + WS_S5CC);
    const float* lre = P.in[I_S5LRE]; const float* lim = P.in[I_S5LIM]; const float* ldt = P.in[I_S5LDT];
    const float* bre = P.in[I_S5BRE]; const float* bim = P.in[I_S5BIM]; const float* cre = P.in[I_S5CRE]; const float* cim = P.in[I_S5CIM];
    for (int e = F.bid * NTHR + F.tid; e < 8192; e += F.G * NTHR) {
        const int dg = e >> 6, n = e & 63;
        const float dt = expf(ldt[dg]), lr = lre[e], li = lim[e];
        const float mag = expf(lr * dt), ar = mag * cosf(li * dt), ai = mag * sinf(li * dt), den = lr * lr + li * li;
        const float cr = ((ar - 1.f) * lr + ai * li) / den, ci = (ai * lr - (ar - 1.f) * li) / den;
        S5A[e * 2] = ar; S5A[e * 2 + 1] = ai;
#pragma unroll
        for (int p = 0; p < 16; ++p) {
            const float br = bre[(size_t)e * 16 + p], bi = bim[(size_t)e * 16 + p];
            BB[((size_t)dg * 128 + n) * 16 + p] = f2bf(cr * br - ci * bi);
            BB[((size_t)dg * 128 + 64 + n) * 16 + p] = f2bf(cr * bi + ci * br);
            CC[((size_t)dg * 16 + p) * 128 + n] = f2bf(cre[((size_t)dg * 16 + p) * 64 + n]);
            CC[((size_t)dg * 16 + p) * 128 + 64 + n] = f2bf(-cim[((size_t)dg * 16 + p) * 64 + n]);
        }
    }
}

constexpr int PT_ROWB = 1536;
DI void cvt_table_fp6(const Ctx& F, const float* src, unsigned char* dst, float* scales, const int (&perm)[32]) {
    LAS float* scr = (LAS float*)(F.lds) + F.wave * 2048 + F.lane;
    for (int r = F.bid * 8 + F.wave; r < 16384; r += F.G * 8) {
        f32x4 v[8]; float m = 0.f;
#pragma unroll
        for (int j = 0; j < 8; ++j) { v[j] = *(const f32x4*)(src + (size_t)r * 2048 + F.lane * 32 + j * 4);
            m = fmaxf(m, fmaxf(fmaxf(fabsf(v[j].x), fabsf(v[j].y)), fmaxf(fabsf(v[j].z), fabsf(v[j].w)))); }
        m = wave_max(m);
        const float inv = (m > 0.f) ? 7.0f / m : 0.f, sc = (m > 0.f) ? m / 7.0f : 0.f;
#pragma unroll
        for (int j = 0; j < 8; ++j) { scr[perm[j * 4 + 0] * 64] = v[j].x * inv; scr[perm[j * 4 + 1] * 64] = v[j].y * inv; scr[perm[j * 4 + 2] * 64] = v[j].z * inv; scr[perm[j * 4 + 3] * 64] = v[j].w * inv; }
        asm volatile("" ::: "memory");
        f32x16 a, b;
#pragma unroll
        for (int i = 0; i < 16; ++i) { a[i] = scr[i * 64]; b[i] = scr[(16 + i) * 64]; }
        asm volatile("" ::: "memory");
        const u32x6 pk = __builtin_amdgcn_cvt_scalef32_2xpk16_fp6_f32(a, b, 1.0f);
        unsigned char* o = dst + (size_t)r * PT_ROWB;
        *(u32x4*)(o + F.lane * 16) = (u32x4){pk[0], pk[1], pk[2], pk[3]}; *(u32x2*)(o + 1024 + F.lane * 8) = (u32x2){pk[4], pk[5]};
        if (F.lane == 0) scales[r] = sc;
    }
}
DI void convert_peer_tables(const Ctx& F, const Params& P) {
    int perm[32];
    { f32x16 a, b;
#pragma unroll
      for (int j = 0; j < 16; ++j) { a[j] = 0.125f * (float)j; b[j] = (j < 8) ? 2.0f + 0.25f * (float)j : 4.0f + 0.5f * (float)(j - 8); }
      const u32x6 pk = __builtin_amdgcn_cvt_scalef32_2xpk16_fp6_f32(a, b, 1.0f);
      const f32x32 rt = __builtin_amdgcn_cvt_scalef32_pk32_f32_fp6(pk, 1.0f);
#pragma unroll
      for (int i = 0; i < 32; ++i) { const float x = rt[i]; const int o = (x < 2.0f) ? (int)(x * 8.0f + 0.5f) : ((x < 4.0f) ? 16 + (int)((x - 2.0f) * 4.0f + 0.5f) : 24 + (int)((x - 4.0f) * 2.0f + 0.5f)); perm[i] = min(max(o, 0), 31); } }
    float* SC = (float*)(P.ws + WS_SC);
    __syncthreads();
    for (int layer = 0; layer < 2; ++layer) {
        cvt_table_fp6(F, P.in[I_PU] + (size_t)layer * 16384 * 2048, P.ws + WS_TBLU + (size_t)layer * 16384 * PT_ROWB, SC + layer * 16384, perm);
        cvt_table_fp6(F, P.in[I_PV] + (size_t)layer * 16384 * 2048, P.ws + WS_TBLV + (size_t)layer * 16384 * PT_ROWB, SC + (2 + layer) * 16384, perm);
    }
    __syncthreads();
}

DI void prologue(const Ctx& F, const Params& P) {
    adaln_partials(F, P);
    transpose_weight(F, P.in[I_EVWIN], 2048, 6144, (bf16_t*)(P.ws + WS_WEVIN));
    transpose_weight(F, P.in[I_EVWOUT], 2048, 2048, (bf16_t*)(P.ws + WS_WEVOUT));
    transpose_weight(F, P.in[I_ODWIN], 2048, 4096, (bf16_t*)(P.ws + WS_WODIN));
    transpose_weight(F, P.in[I_ODWOUT], 2048, 2048, (bf16_t*)(P.ws + WS_WODOUT));
    transpose_weight(F, P.in[I_PWQ], 2048, 2048, (bf16_t*)(P.ws + WS_WPQ));
    transpose_weight(F, P.in[I_PWQ] + (size_t)2048 * 2048, 2048, 2048, (bf16_t*)(P.ws + WS_WPQ) + (size_t)2048 * 2048);
    transpose_weight(F, P.in[I_GLUW], 1024, 1024, (bf16_t*)(P.ws + WS_WGLU));
    cvt_rows(F, P.in[I_PKEYS], (bf16_t*)(P.ws + WS_PKEYS), (size_t)2 * 8 * 2 * 128 * 128);
    cvt_rows(F, P.in[I_CNK], (bf16_t*)(P.ws + WS_CNK), (size_t)8 * 256 * 1024);
    cvt_rows(F, P.in[I_CDK], (bf16_t*)(P.ws + WS_CDK), (size_t)8 * 256 * 1024);
    transpose_cache_v(F, P.in[I_CNV], (bf16_t*)(P.ws + WS_CNVT));
    transpose_cache_v(F, P.in[I_CDV], (bf16_t*)(P.ws + WS_CDVT));
    hyena_filters(F, P);
    s5_consts(F, P);
    convert_peer_tables(F, P);
}
DI void norm_phase(const Ctx& F, const float* xa, const float* xb, const float* gvec, const float* modl, int sidx, bf16_t* H) {
    for (int T = F.bid * 8 + F.wave; T < TOK; T += F.G * 8) {
        const float* xr = T < TP ? xa + (size_t)T * DM : xb + (size_t)(T - TP) * DM;
        f32x4 v[8]; float ss = 0.f;
#pragma unroll
        for (int j = 0; j < 8; ++j) { v[j] = *(const f32x4*)(xr + (j * 64 + F.lane) * 4); ss += v[j].x * v[j].x + v[j].y * v[j].y + v[j].z * v[j].z + v[j].w * v[j].w; }
        ss = wave_sum(ss);
        const float rstd = rsqrtf(ss * (1.f / DM) + NORM_EPS);
        const float* sh = modl + (size_t)(cond_of(T) * 6 + sidx) * DM; const float* sc = sh + DM;
#pragma unroll
        for (int j = 0; j < 8; ++j) {
            const int col = (j * 64 + F.lane) * 4;
            const f32x4 g4 = *(const f32x4*)(gvec + col), s4 = *(const f32x4*)(sc + col), h4 = *(const f32x4*)(sh + col);
            const f32x4 o = v[j] * rstd * g4 * (s4 + 1.f) + h4;
            u32x2 w; w.x = pk2(o.x, o.y); w.y = pk2(o.z, o.w);
            *(u32x2*)(H + (size_t)T * DM + col) = w;
        }
    }
}

struct EpiBf16 {
    static constexpr bool PERM = true, AFTER_DRAIN = false;
    bf16_t* O; int ldc;
    DI void operator()(const f32x4 (&acc)[2][2][4][2], const pg8::Unit& u, int wr, int wc, int fr, int fq) const {
        const int row0 = u.pm * 256 + wr * 64 + fr, col0 = u.pn * 256 + wc * 32 + 8 * fq;
#pragma unroll
        for (int ai = 0; ai < 2; ++ai)
#pragma unroll
            for (int m = 0; m < 4; ++m) { bf16_t* rowp = O + (size_t)(row0 + ai * 128 + m * 16) * ldc + col0;
#pragma unroll
                for (int bj = 0; bj < 2; ++bj) { const f32x4 v0 = acc[ai][bj][m][0], v1 = acc[ai][bj][m][1];
                    u32x4 w; w.x = pk2(v0[0], v0[1]); w.y = pk2(v0[2], v0[3]); w.z = pk2(v1[0], v1[1]); w.w = pk2(v1[2], v1[3]);
                    *(u32x4*)(rowp + bj * 128) = w; } }
    }
};
struct EpiResid {
    static constexpr bool PERM = false, AFTER_DRAIN = false;
    const float* xa; const float* xb; float* out; const float* modl; int gidx;
    DI void operator()(const f32x4 (&acc)[2][2][4][2], const pg8::Unit& u, int wr, int wc, int fr, int fq) const {
        const int row0 = u.pm * 256 + wr * 64 + fr, col0 = u.pn * 256 + wc * 32 + 4 * fq;
        const float* xbase = (u.pm < 32) ? xa : xb - (size_t)TP * DM;
        const float* gate = modl + (size_t)(cond_of(u.pm * 256) * 6 + gidx) * DM;
        f32x4 gv[2][2];
#pragma unroll
        for (int bj = 0; bj < 2; ++bj)
#pragma unroll
            for (int n = 0; n < 2; ++n) gv[bj][n] = *(const f32x4*)(gate + col0 + bj * 128 + n * 16);
#pragma unroll
        for (int ai = 0; ai < 2; ++ai)
#pragma unroll
            for (int m = 0; m < 4; ++m) { const size_t ro = (size_t)(row0 + ai * 128 + m * 16) * DM + col0;
#pragma unroll
                for (int bj = 0; bj < 2; ++bj)
#pragma unroll
                    for (int n = 0; n < 2; ++n) { const f32x4 x4 = *(const f32x4*)(xbase + ro + bj * 128 + n * 16);
                        *(f32x4*)(out + ro + bj * 128 + n * 16) = x4 + gv[bj][n] * acc[ai][bj][m][n]; } }
    }
};
struct EpiGlu {
    static constexpr bool PERM = true, AFTER_DRAIN = false;
    const bf16_t* Y; bf16_t* O; const float* bias;
    DI void operator()(const f32x4 (&acc)[2][2][4][2], const pg8::Unit& u, int wr, int wc, int fr, int fq) const {
        const int row0 = u.pm * 256 + wr * 64 + fr, col0 = u.pn * 256 + wc * 32 + 8 * fq;
#pragma unroll
        for (int bj = 0; bj < 2; ++bj) {
            const f32x4 b0 = *(const f32x4*)(bias + col0 + bj * 128), b1 = *(const f32x4*)(bias + col0 + bj * 128 + 4);
#pragma unroll
            for (int ai = 0; ai < 2; ++ai)
#pragma unroll
                for (int m = 0; m < 4; ++m) { const size_t r = (size_t)(row0 + ai * 128 + m * 16);
                    const u32x4 yv = *(const u32x4*)(Y + r * 1024 + col0 + bj * 128);
                    const f32x4 a0 = acc[ai][bj][m][0] + b0, a1 = acc[ai][bj][m][1] + b1;
                    float o[8];
                    o[0] = bflo(yv.x) / (1.f + __expf(-a0[0])); o[1] = bfhi(yv.x) / (1.f + __expf(-a0[1]));
                    o[2] = bflo(yv.y) / (1.f + __expf(-a0[2])); o[3] = bfhi(yv.y) / (1.f + __expf(-a0[3]));
                    o[4] = bflo(yv.z) / (1.f + __expf(-a1[0])); o[5] = bfhi(yv.z) / (1.f + __expf(-a1[1]));
                    o[6] = bflo(yv.w) / (1.f + __expf(-a1[2])); o[7] = bfhi(yv.w) / (1.f + __expf(-a1[3]));
                    u32x4 w; w.x = pk2(o[0], o[1]); w.y = pk2(o[2], o[3]); w.z = pk2(o[4], o[5]); w.w = pk2(o[6], o[7]);
                    *(u32x4*)(O + r * DM + col0 + bj * 128) = w; }
        }
    }
};
template <class Epi> DI void run_gemm(const Ctx& F, const bf16_t* A, const bf16_t* Bt, int N, int K, const Epi& E) {
    pg8::Gemm g{A, Bt, TOK, N, K}; pg8::StaticOrder S; S.init(TOK, N, F.G, F.bid);
    pg8::gemm_phase<Epi, pg8::StaticOrder, false>(F.lds, g, S, E, nullptr);
    __syncthreads();
}

DI void prep_a(const Ctx& F, const Params& P) {
    const bf16_t* T1 = (const bf16_t*)(P.ws + WS_RA);
    bf16_t* VTp = (bf16_t*)(P.ws + WS_VT); bf16_t* VTs = (bf16_t*)(P.ws + WS_VT + VT_S);
    for (int t = F.bid; t < 2048 + 8192; t += F.G) {
        if (t < 2048) { const int bh = t >> 3, sub = t & 7, tk = sub >> 1, dd = sub & 1, b = bh >> 3, h = bh & 7;
            tr_tile_bf16(F, T1 + ((size_t)(b * 256 + tk * 64)) * 4096 + h * 128 + dd * 64, 4096, VTp + ((size_t)bh * 128 + dd * 64) * 256 + tk * 64, 256, (LAS bf16_t*)F.lds); }
        else { const int u = t - 2048, bh = u >> 7, sub = u & 127, tk = sub >> 1, dd = sub & 1, b = bh >> 3, h = bh & 7;
            tr_tile_bf16(F, T1 + ((size_t)(TP + b * 4096 + tk * 64)) * 4096 + h * 128 + dd * 64, 4096, VTs + ((size_t)bh * 128 + dd * 64) * 4096 + tk * 64, 4096, (LAS bf16_t*)F.lds); }
    }
    { float* o = P.out + O_NAV;
      for (int e = F.bid * NTHR + F.tid; e < TP * 128; e += F.G * NTHR) { const int T = e >> 7, c8 = (e & 127) * 8;
          const u32x4 v = *(const u32x4*)(T1 + (size_t)T * 4096 + c8);
          *(f32x4*)(o + (size_t)T * 1024 + c8) = (f32x4){bflo(v.x), bfhi(v.x), bflo(v.y), bfhi(v.y)};
          *(f32x4*)(o + (size_t)T * 1024 + c8 + 4) = (f32x4){bflo(v.z), bfhi(v.z), bflo(v.w), bfhi(v.w)}; } }
    { LAS bf16_t* tl = (LAS bf16_t*)F.lds;
      bf16_t* CM = (bf16_t*)(P.ws + WS_RB);
      const float* cw = P.in[I_HYCW]; const float* cb = P.in[I_HYCB];
      for (int t = F.bid; t < 48 * 160; t += F.G) {
          const int cg = t % 48, tg = t / 48, ch0 = cg * 64, t0 = tg * 256;
          const bool lz = (t0 < TP) ? true : (((t0 - TP) & 4095) == 0);
          const bool rz = (t0 < TP) ? true : (((t0 + 256 - TP) & 4095) == 0);
          __syncthreads();
#pragma unroll
          for (int j = 0; j < 4; ++j) { const int id = F.tid + NTHR * j, tk = id >> 3, c8 = (id & 7) * 8;
              const u32x4 v = *(const u32x4*)(T1 + (size_t)(t0 + tk) * 4096 + 1024 + ch0 + c8);
              LAS bf16_t* d = tl + tk + 1;
              d[(c8 + 0) * 264] = (bf16_t)(v.x & 0xffff); d[(c8 + 1) * 264] = (bf16_t)(v.x >> 16); d[(c8 + 2) * 264] = (bf16_t)(v.y & 0xffff); d[(c8 + 3) * 264] = (bf16_t)(v.y >> 16);
              d[(c8 + 4) * 264] = (bf16_t)(v.z & 0xffff); d[(c8 + 5) * 264] = (bf16_t)(v.z >> 16); d[(c8 + 6) * 264] = (bf16_t)(v.w & 0xffff); d[(c8 + 7) * 264] = (bf16_t)(v.w >> 16); }
          if (F.tid < 16) { const int side = F.tid >> 3, c8 = (F.tid & 7) * 8; const bool zero = side ? rz : lz; const int tk = side ? t0 + 256 : t0 - 1;
              u32x4 v = (u32x4){0u, 0u, 0u, 0u};
              if (!zero) v = *(const u32x4*)(T1 + (size_t)tk * 4096 + 1024 + ch0 + c8);
              LAS bf16_t* d = tl + (side ? 257 : 0);
              d[(c8 + 0) * 264] = (bf16_t)(v.x & 0xffff); d[(c8 + 1) * 264] = (bf16_t)(v.x >> 16); d[(c8 + 2) * 264] = (bf16_t)(v.y & 0xffff); d[(c8 + 3) * 264] = (bf16_t)(v.y >> 16);
              d[(c8 + 4) * 264] = (bf16_t)(v.z & 0xffff); d[(c8 + 5) * 264] = (bf16_t)(v.z >> 16); d[(c8 + 6) * 264] = (bf16_t)(v.w & 0xffff); d[(c8 + 7) * 264] = (bf16_t)(v.w >> 16); }
          __syncthreads();
#pragma unroll
          for (int j = 0; j < 4; ++j) { const int id = F.tid + NTHR * j, ch = id >> 5, to = (id & 31) * 8, cgl = ch0 + ch;
              const float w0 = cw[cgl], w1 = cw[3072 + cgl], w2 = cw[6144 + cgl], bb = cb[cgl];
              const LAS bf16_t* s = tl + ch * 264 + to;
              float r[10];
#pragma unroll
              for (int i = 0; i < 10; ++i) r[i] = bf2f(s[i]);
              float o[8];
#pragma unroll
              for (int i = 0; i < 8; ++i) o[i] = w0 * r[i] + w1 * r[i + 1] + w2 * r[i + 2] + bb;
              u32x4 w; w.x = pk2(o[0], o[1]); w.y = pk2(o[2], o[3]); w.z = pk2(o[4], o[5]); w.w = pk2(o[6], o[7]);
              *(u32x4*)(CM + (size_t)cgl * TOK + t0 + to) = w; }
      }
      __syncthreads(); }
}

DI void prep_b(const Ctx& F, const Params& P) {
    bf16_t* Pq = (bf16_t*)(P.ws + WS_RA); const float* qg = P.in[I_NAQG]; const float* kg = P.in[I_NAKG]; float* ok = P.out + O_NAK;
    const float* gsrc = (F.lane < 32 ? qg : kg) + (F.lane & 3) * 32;
    float g[32];
#pragma unroll
    for (int i = 0; i < 32; ++i) g[i] = gsrc[i];
    for (int T = F.bid * 8 + F.wave; T < TOK; T += F.G * 8) {
        bf16_t* rp = Pq + (size_t)T * 2048 + F.lane * 32;
        u32x4 v[4]; float x[32]; float ss = 0.f;
#pragma unroll
        for (int j = 0; j < 4; ++j) { v[j] = *(const u32x4*)(rp + j * 8);
            x[j * 8 + 0] = bflo(v[j].x); x[j * 8 + 1] = bfhi(v[j].x); x[j * 8 + 2] = bflo(v[j].y); x[j * 8 + 3] = bfhi(v[j].y);
            x[j * 8 + 4] = bflo(v[j].z); x[j * 8 + 5] = bfhi(v[j].z); x[j * 8 + 6] = bflo(v[j].w); x[j * 8 + 7] = bfhi(v[j].w); }
#pragma unroll
        for (int i = 0; i < 32; ++i) ss += x[i] * x[i];
        ss += dpp_xor1(ss); ss += dpp_xor2(ss);
        const float rstd = rsqrtf(ss * (1.f / 128.f) + NORM_EPS);
#pragma unroll
        for (int i = 0; i < 32; ++i) x[i] = x[i] * rstd * g[i];
#pragma unroll
        for (int j = 0; j < 4; ++j) { u32x4 w; w.x = pk2(x[j * 8 + 0], x[j * 8 + 1]); w.y = pk2(x[j * 8 + 2], x[j * 8 + 3]); w.z = pk2(x[j * 8 + 4], x[j * 8 + 5]); w.w = pk2(x[j * 8 + 6], x[j * 8 + 7]);
            *(u32x4*)(rp + j * 8) = w; }
        if (T < TP && F.lane >= 32) { float* o = ok + (size_t)T * 1024 + (F.lane - 32) * 32;
#pragma unroll
            for (int j = 0; j < 8; ++j) *(f32x4*)(o + j * 4) = (f32x4){x[j * 4], x[j * 4 + 1], x[j * 4 + 2], x[j * 4 + 3]}; }
    }
}
constexpr int AT_KROW = 272, AT_VROW = 136, AT_KTB = 64 * AT_KROW, AT_VTB = 128 * AT_VROW;
constexpr int AT_K0 = 0, AT_V0 = 2 * AT_KTB, AT_RPB = AT_V0 + 2 * AT_VTB;

struct TileMap { const bf16_t* latK; int latKld; const bf16_t* latV; int latVld; int nlat; const bf16_t* ctxK; const bf16_t* ctxV; int ntiles; };
struct TileRegs { u32x4 k[2], v[2]; };

DI void tile_src(const TileMap& M, int j, const bf16_t*& kp, int& kld, const bf16_t*& vp, int& vld) {
    if (j < M.nlat) { kp = M.latK + (size_t)j * 64 * M.latKld; kld = M.latKld; vp = M.latV + j * 64; vld = M.latVld; }
    else { const int c = j - M.nlat; kp = M.ctxK + (size_t)c * 64 * 1024; kld = 1024; vp = M.ctxV + c * 64; vld = 256; }
}
DI void tile_load(const Ctx& F, TileRegs& R, const bf16_t* kp, int kld, const bf16_t* vp, int vld, bool withV = true) {
#pragma unroll
    for (int j = 0; j < 2; ++j) { const int id = F.tid + NTHR * j;
        const unsigned ko = (unsigned)((id >> 4) * kld + (id & 15) * 8) * 2u, vo = (unsigned)((id >> 3) * vld + (id & 7) * 8) * 2u;
        R.k[j] = *(const u32x4*)((const char*)kp + ko);
        if (withV) R.v[j] = *(const u32x4*)((const char*)vp + vo); }
}
DI void tile_store(const Ctx& F, const TileRegs& R, LAS unsigned char* kt, LAS unsigned char* vt, bool withV = true) {
#pragma unroll
    for (int j = 0; j < 2; ++j) { const int id = F.tid + NTHR * j;
        *(LAS u32x4*)(kt + (id >> 4) * AT_KROW + (id & 15) * 16) = R.k[j];
        if (withV) { LAS unsigned char* vp = vt + (id >> 3) * AT_VROW + (id & 7) * 16;
            *(LAS u32x2*)(vp) = (u32x2){R.v[j].x, R.v[j].y}; *(LAS u32x2*)(vp + 8) = (u32x2){R.v[j].z, R.v[j].w}; } }
}

DI void tile_norm_k(const Ctx& F, TileRegs& R, const LAS float* kgain, float* nk, int nkld) {
#pragma unroll
    for (int j = 0; j < 2; ++j) { const int id = F.tid + NTHR * j;
        float x[8] = {bflo(R.k[j].x), bfhi(R.k[j].x), bflo(R.k[j].y), bfhi(R.k[j].y), bflo(R.k[j].z), bfhi(R.k[j].z), bflo(R.k[j].w), bfhi(R.k[j].w)};
        float ss = 0.f;
#pragma unroll
        for (int i = 0; i < 8; ++i) ss += x[i] * x[i];
        ss += dpp_xor1(ss); ss += dpp_xor2(ss);
        ss += __builtin_bit_cast(float, __builtin_amdgcn_update_dpp(0, __builtin_bit_cast(int, ss), 0x141, 0xF, 0xF, true));
        ss += __builtin_bit_cast(float, __builtin_amdgcn_update_dpp(0, __builtin_bit_cast(int, ss), 0x140, 0xF, 0xF, true));
        const float rstd = rsqrtf(ss * (1.f / 128.f) + NORM_EPS);
        const f32x4 g0 = *(const LAS f32x4*)(kgain + (id & 15) * 8), g1 = *(const LAS f32x4*)(kgain + (id & 15) * 8 + 4);
        x[0] *= rstd * g0.x; x[1] *= rstd * g0.y; x[2] *= rstd * g0.z; x[3] *= rstd * g0.w; x[4] *= rstd * g1.x; x[5] *= rstd * g1.y; x[6] *= rstd * g1.z; x[7] *= rstd * g1.w;
        R.k[j] = (u32x4){pk2(x[0], x[1]), pk2(x[2], x[3]), pk2(x[4], x[5]), pk2(x[6], x[7])};
        if (nk) { float* o = nk + (size_t)(id >> 4) * nkld + (id & 15) * 8; *(f32x4*)(o) = (f32x4){x[0], x[1], x[2], x[3]}; *(f32x4*)(o + 4) = (f32x4){x[4], x[5], x[6], x[7]}; }
    }
}

template <int KS>
DI f32x16 qk_tile(LAS const unsigned char* kt, const bf16x8 (&Qf)[8], int kb, int kk0, int q, int hh) {
    f32x16 S;
#pragma unroll
    for (int i = 0; i < 16; ++i) S[i] = 0.f;
#pragma unroll
    for (int ks = 0; ks < KS; ++ks) { const int kk = kk0 + ks;
        const bf16x8 A = *(const LAS bf16x8*)(kt + (kb * 32 + q) * AT_KROW + (kk * 16 + hh * 8) * 2);
        S = __builtin_amdgcn_mfma_f32_32x32x16_bf16(A, Qf[kk], S, 0, 0, 0); }
    return S;
}
DI void pv_tile(LAS const unsigned char* vt, const float (&p)[16], f32x16 (&O)[4], int kb, int q, int hh) {
#pragma unroll
    for (int s = 0; s < 2; ++s) {
        u32x4 pw; pw.x = pk2(p[8 * s + 0], p[8 * s + 1]); pw.y = pk2(p[8 * s + 2], p[8 * s + 3]); pw.z = pk2(p[8 * s + 4], p[8 * s + 5]); pw.w = pk2(p[8 * s + 6], p[8 * s + 7]);
        const bf16x8 Pf = __builtin_bit_cast(bf16x8, pw);
#pragma unroll
        for (int db = 0; db < 4; ++db) {
            LAS const unsigned char* ap = vt + (db * 32 + q) * AT_VROW + (kb * 32 + 16 * s + 4 * hh) * 2;
            const u32x2 lo = *(const LAS u32x2*)(ap), hi = *(const LAS u32x2*)(ap + 16);
            const bf16x8 A2 = __builtin_bit_cast(bf16x8, (u32x4){lo.x, lo.y, hi.x, hi.y});
            O[db] = __builtin_amdgcn_mfma_f32_32x32x16_bf16(A2, Pf, O[db], 0, 0, 0);
        }
        asm volatile("" ::: "memory");
    }
}
template <bool LAT>
DI void attn_compute1(LAS const unsigned char* kt, LAS const unsigned char* vt, const bf16x8 (&Qf)[8], f32x16 (&O)[4], float& ls, int lane, const LAS float* brow, int cq) {
    const int q = lane & 31, hh = lane >> 5;
    const int cs = min(max(cq - 8, 0), 48);
#pragma unroll 1
    for (int kb = 0; kb < 2; ++kb) {
        const f32x16 S = qk_tile<8>(kt, Qf, kb, 0, q, hh);
        float p[16];
#pragma unroll
        for (int i = 0; i < 16; ++i) {
            float arg = S[i];
            if (LAT) { const int ck = kb * 32 + (i & 3) + 8 * (i >> 2) + 4 * hh;
                arg += brow[min(max(ck - cq + 15, 0), 30)];
                p[i] = ((unsigned)(ck - cs) < 16u) ? __builtin_amdgcn_exp2f(arg) : 0.f; }
            else p[i] = __builtin_amdgcn_exp2f(arg);
            ls += p[i];
        }
        pv_tile(vt, p, O, kb, q, hh);
    }
}
DI void diff_pass1(LAS const unsigned char* kt, const bf16x8 (&Qf)[8], float (&ls)[2], int lane) {
    const int q = lane & 31, hh = lane >> 5;
#pragma unroll
    for (int kb = 0; kb < 2; ++kb) {
#pragma unroll
        for (int mp = 0; mp < 2; ++mp) { const f32x16 S = qk_tile<4>(kt, Qf, kb, mp * 4, q, hh);
#pragma unroll
            for (int i = 0; i < 16; ++i) ls[mp] += __builtin_amdgcn_exp2f(S[i]); }
    }
}
DI void diff_pass2(LAS const unsigned char* kt, LAS const unsigned char* vt, const bf16x8 (&Qf)[8], f32x16 (&O)[4], float w0, float w1, int lane) {
    const int q = lane & 31, hh = lane >> 5;
#pragma unroll
    for (int kb = 0; kb < 2; ++kb) {
        float p[16];
        { const f32x16 S0 = qk_tile<4>(kt, Qf, kb, 0, q, hh);
#pragma unroll
          for (int i = 0; i < 16; ++i) p[i] = __builtin_amdgcn_exp2f(S0[i]) * w0; }
        { const f32x16 S1 = qk_tile<4>(kt, Qf, kb, 4, q, hh);
#pragma unroll
          for (int i = 0; i < 16; ++i) p[i] -= __builtin_amdgcn_exp2f(S1[i]) * w1; }
        pv_tile(vt, p, O, kb, q, hh);
    }
}

template <int MODE>
DI void attn_phase(const Ctx& F, const Params& P) {
    constexpr bool DIFF = (MODE >= 2);
    constexpr bool NA = (MODE == 1);
    LAS unsigned char* lds = F.lds;
    LAS float* rpbl = (LAS float*)(lds + AT_RPB);
    LAS float* kgl = (LAS float*)(lds + AT_RPB + 2048);
    if (!DIFF) { __syncthreads(); if (F.tid < 128) kgl[F.tid] = P.in[I_NAKG][F.tid]; __syncthreads(); }
    const bf16_t* PA = (const bf16_t*)(P.ws + WS_RA);
    bf16_t* MIX = (bf16_t*)(P.ws + WS_HM);
    const bf16_t* VTp = (const bf16_t*)(P.ws + WS_VT); const bf16_t* VTs = (const bf16_t*)(P.ws + WS_VT + VT_S);
    const int q = F.lane & 31, hh = F.lane >> 5;
    const float c1 = (DIFF ? 0.125f : 0.08838834764831845f) * LOG2E;
    float lam = 0.f;
    if (DIFF) {
        const float a = wave_sum(P.in[I_LQ1][F.lane] * P.in[I_LK1][F.lane]), b = wave_sum(P.in[I_LQ2][F.lane] * P.in[I_LK2][F.lane]);
        lam = __expf(a) - __expf(b) + 0.35550906759096924f;
    }
    const int nunits = (MODE == 0 || MODE == 2) ? 256 : 1024;
    for (int u0 = F.bid; u0 < nunits; u0 += F.G) {
        int u = u0;
        if ((MODE == 1 || MODE == 3) && F.G == 256) { const int i = u0 >> 8, x = F.bid & 7, y = F.bid >> 3; u = ((2 * i + (y >> 4)) * 8 + x) * 16 + (y & 15); }
        int b, h, tok0, r = 0, rlo = 0; TileMap M;
        const bf16_t* qptr;
        if (MODE == 0) { b = u >> 3; h = u & 7; tok0 = b * 256 + F.wave * 32;
            qptr = PA + (size_t)(tok0 + q) * 2048 + h * 128;
            M.latK = PA + (size_t)(b * 256) * 2048 + 1024 + h * 128; M.latKld = 2048; M.latV = VTp + (size_t)(b * 8 + h) * 128 * 256; M.latVld = 256; M.nlat = 4; M.ctxK = nullptr; M.ctxV = nullptr; M.ntiles = 4; }
        else if (MODE == 1) { b = u >> 7; h = (u >> 4) & 7; const int rg = u & 15; r = 4 * rg + (F.wave >> 1);
            rlo = min(max(4 * rg - 4, 0), 56); const int rhi = min(max(4 * rg + 3 - 4, 0), 56) + 8;
            tok0 = TP + b * 4096 + r * 64 + (F.wave & 1) * 32;
            qptr = PA + (size_t)(tok0 + q) * 2048 + h * 128;
            M.latK = PA + (size_t)(TP + b * 4096 + rlo * 64) * 2048 + 1024 + h * 128; M.latKld = 2048; M.latV = VTs + (size_t)(b * 8 + h) * 128 * 4096 + rlo * 64; M.latVld = 4096; M.nlat = rhi - rlo;
            M.ctxK = (const bf16_t*)(P.ws + WS_CNK) + (size_t)b * 256 * 1024 + h * 128; M.ctxV = (const bf16_t*)(P.ws + WS_CNVT) + (size_t)(b * 8 + h) * 128 * 256; M.ntiles = M.nlat + 4;
            if (F.tid < 465) rpbl[F.tid] = P.in[I_RPB][h * 465 + F.tid] * LOG2E; }
        else if (MODE == 2) { b = u >> 3; h = u & 7; tok0 = b * 256 + F.wave * 32;
            qptr = PA + (size_t)(tok0 + q) * 4096 + 1024 + h * 128;
            M.latK = PA + (size_t)(b * 256) * 4096 + 2048 + h * 128; M.latKld = 4096; M.latV = VTp + (size_t)(b * 8 + h) * 128 * 256; M.latVld = 256; M.nlat = 4; M.ctxK = nullptr; M.ctxV = nullptr; M.ntiles = 4; }
        else { b = u >> 7; h = (u >> 4) & 7; const int qb = u & 15; tok0 = TP + b * 4096 + qb * 256 + F.wave * 32;
            qptr = PA + (size_t)(tok0 + q) * 4096 + 1024 + h * 128;
            M.latK = PA + (size_t)(TP + b * 4096) * 4096 + 2048 + h * 128; M.latKld = 4096; M.latV = VTs + (size_t)(b * 8 + h) * 128 * 4096; M.latVld = 4096; M.nlat = 64;
            M.ctxK = (const bf16_t*)(P.ws + WS_CDK) + (size_t)b * 256 * 1024 + h * 128; M.ctxV = (const bf16_t*)(P.ws + WS_CDVT) + (size_t)(b * 8 + h) * 128 * 256; M.ntiles = 68; }
        bf16x8 Qf[8];
        if constexpr (!DIFF) {
            u32x4 w[8]; float ss = 0.f;
#pragma unroll
            for (int ks = 0; ks < 8; ++ks) { w[ks] = *(const u32x4*)(qptr + ks * 16 + hh * 8);
                ss += bflo(w[ks].x) * bflo(w[ks].x) + bfhi(w[ks].x) * bfhi(w[ks].x) + bflo(w[ks].y) * bflo(w[ks].y) + bfhi(w[ks].y) * bfhi(w[ks].y)
                    + bflo(w[ks].z) * bflo(w[ks].z) + bfhi(w[ks].z) * bfhi(w[ks].z) + bflo(w[ks].w) * bflo(w[ks].w) + bfhi(w[ks].w) * bfhi(w[ks].w); }
            ss += __shfl_xor(ss, 32);
            const float qs = rsqrtf(ss * (1.f / 128.f) + NORM_EPS) * c1;
            const float* qg = P.in[I_NAQG];
#pragma unroll
            for (int ks = 0; ks < 8; ++ks) { const f32x4 g0 = *(const f32x4*)(qg + ks * 16 + hh * 8), g1 = *(const f32x4*)(qg + ks * 16 + hh * 8 + 4);
                const u32x4 ws = (u32x4){pk2(bflo(w[ks].x) * qs * g0.x, bfhi(w[ks].x) * qs * g0.y), pk2(bflo(w[ks].y) * qs * g0.z, bfhi(w[ks].y) * qs * g0.w),
                                         pk2(bflo(w[ks].z) * qs * g1.x, bfhi(w[ks].z) * qs * g1.y), pk2(bflo(w[ks].w) * qs * g1.z, bfhi(w[ks].w) * qs * g1.w)};
                Qf[ks] = __builtin_bit_cast(bf16x8, ws); }
        } else {
#pragma unroll
        for (int ks = 0; ks < 8; ++ks) { const u32x4 w = *(const u32x4*)(qptr + ks * 16 + hh * 8);
            const u32x4 ws = (u32x4){pk2(bflo(w.x) * c1, bfhi(w.x) * c1), pk2(bflo(w.y) * c1, bfhi(w.y) * c1), pk2(bflo(w.z) * c1, bfhi(w.z) * c1), pk2(bflo(w.w) * c1, bfhi(w.w) * c1)};
            Qf[ks] = __builtin_bit_cast(bf16x8, ws); }
        }
        f32x16 O[4]; float ls[2] = {0.f, 0.f}; float w0 = 0.f, w1 = 0.f;
#pragma unroll
        for (int db = 0; db < 4; ++db)
#pragma unroll
            for (int i = 0; i < 16; ++i) O[db][i] = 0.f;
        const int cq = (F.wave & 1) * 32 + q;
        const int r0w = min(max(r - 4, 0), 56);
        const int nt = M.ntiles;
        TileRegs R;
        { const bf16_t* kp; const bf16_t* vp; int kld, vld; tile_src(M, 0, kp, kld, vp, vld); tile_load(F, R, kp, kld, vp, vld); }
        if constexpr (!DIFF) tile_norm_k(F, R, kgl, (MODE == 0) ? P.out + O_NAK + (size_t)(b * 256) * 1024 + h * 128 : nullptr, 1024);
        tile_store(F, R, lds + AT_K0, lds + AT_V0);
        __syncthreads();
        if constexpr (DIFF) {
#pragma unroll 1
            for (int j = 0; j < nt; ++j) {
                const int cur = j & 1, jn = (j + 1 < nt) ? j + 1 : 0;
                const bool wv = (j + 1 == nt);
                { const bf16_t* kp; const bf16_t* vp; int kld, vld; tile_src(M, jn, kp, kld, vp, vld); tile_load(F, R, kp, kld, vp, vld, wv); }
                diff_pass1(lds + AT_K0 + cur * AT_KTB, Qf, ls, F.lane);
                tile_store(F, R, lds + AT_K0 + (cur ^ 1) * AT_KTB, lds + AT_V0 + (cur ^ 1) * AT_VTB, wv);
                __syncthreads();
            }
            { const float l0 = ls[0] + __shfl_xor(ls[0], 32), l1 = ls[1] + __shfl_xor(ls[1], 32); w0 = 1.f / l0; w1 = lam / l1; }
#pragma unroll 1
            for (int j = 0; j < nt; ++j) {
                const int cur = (nt + j) & 1;
                if (j + 1 < nt) { const bf16_t* kp; const bf16_t* vp; int kld, vld; tile_src(M, j + 1, kp, kld, vp, vld); tile_load(F, R, kp, kld, vp, vld); }
                diff_pass2(lds + AT_K0 + cur * AT_KTB, lds + AT_V0 + cur * AT_VTB, Qf, O, w0, w1, F.lane);
                if (j + 1 < nt) tile_store(F, R, lds + AT_K0 + (cur ^ 1) * AT_KTB, lds + AT_V0 + (cur ^ 1) * AT_VTB);
                __syncthreads();
            }
        } else {
#pragma unroll 1
            for (int j = 0; j < nt; ++j) {
                const int cur = j & 1;
                if (j + 1 < nt) { const bf16_t* kp; const bf16_t* vp; int kld, vld; tile_src(M, j + 1, kp, kld, vp, vld); tile_load(F, R, kp, kld, vp, vld); }
                LAS const unsigned char* kt = lds + AT_K0 + cur * AT_KTB; LAS const unsigned char* vt = lds + AT_V0 + cur * AT_VTB;
                if constexpr (NA) {
                    if (j < M.nlat) { const int kr = rlo + j;
                        if (kr >= r0w && kr < r0w + 8) attn_compute1<true>(kt, vt, Qf, O, ls[0], F.lane, rpbl + (kr - r + 7) * 31, cq); }
                    else attn_compute1<false>(kt, vt, Qf, O, ls[0], F.lane, rpbl, cq);
                } else attn_compute1<false>(kt, vt, Qf, O, ls[0], F.lane, rpbl, cq);
                if (j + 1 < nt) {
                    if (j + 1 < M.nlat) tile_norm_k(F, R, kgl, (MODE == 0) ? P.out + O_NAK + (size_t)(b * 256 + (j + 1) * 64) * 1024 + h * 128 : nullptr, 1024);
                    tile_store(F, R, lds + AT_K0 + (cur ^ 1) * AT_KTB, lds + AT_V0 + (cur ^ 1) * AT_VTB); }
                __syncthreads();
            }
        }
        if constexpr (!DIFF) {
            const float inv = 1.f / (ls[0] + __shfl_xor(ls[0], 32));
            bf16_t* op = MIX + (size_t)(tok0 + q) * DM + h * 128 + 4 * hh;
#pragma unroll
            for (int db = 0; db < 4; ++db)
#pragma unroll
                for (int g = 0; g < 4; ++g) { u32x2 w; w.x = pk2(O[db][4 * g] * inv, O[db][4 * g + 1] * inv); w.y = pk2(O[db][4 * g + 2] * inv, O[db][4 * g + 3] * inv);
                    *(u32x2*)(op + db * 32 + 8 * g) = w; }
        } else {
            float ss = 0.f;
#pragma unroll
            for (int db = 0; db < 4; ++db)
#pragma unroll
                for (int i = 0; i < 16; ++i) ss += O[db][i] * O[db][i];
            ss += __shfl_xor(ss, 32);
            const float sc = rsqrtf(ss * (1.f / 128.f) + NORM_EPS) * (1.f - 0.35550906759096924f);
            const float* sg = P.in[I_SUBG];
            bf16_t* op = MIX + (size_t)(tok0 + q) * DM + 1024 + h * 128 + 4 * hh;
#pragma unroll
            for (int db = 0; db < 4; ++db)
#pragma unroll
                for (int g = 0; g < 4; ++g) { const f32x4 g4 = *(const f32x4*)(sg + db * 32 + 8 * g + 4 * hh);
                    u32x2 w; w.x = pk2(O[db][4 * g] * sc * g4.x, O[db][4 * g + 1] * sc * g4.y); w.y = pk2(O[db][4 * g + 2] * sc * g4.z, O[db][4 * g + 3] * sc * g4.w);
                    *(u32x2*)(op + db * 32 + 8 * g) = w; }
        }
    }
}

DI float diff_lambda(const Ctx& F, const Params& P) {
    const float la = wave_sum(P.in[I_LQ1][F.lane] * P.in[I_LK1][F.lane]), lb = wave_sum(P.in[I_LQ2][F.lane] * P.in[I_LK2][F.lane]);
    return __expf(la) - __expf(lb) + 0.35550906759096924f;
}
template <bool SAMPLE>
DI void attn_diff_phase(const Ctx& F, const Params& P, const float lam) {
    LAS unsigned char* lds = F.lds;
    const bf16_t* PA = (const bf16_t*)(P.ws + WS_RA);
    bf16_t* MIX = (bf16_t*)(P.ws + WS_HM);
    const bf16_t* VTp = (const bf16_t*)(P.ws + WS_VT); const bf16_t* VTs = (const bf16_t*)(P.ws + WS_VT + VT_S);
    const int q = F.lane & 31, hh = F.lane >> 5, mp = F.wave >> 2, qg = F.wave & 3;
    const float c1 = 0.125f * LOG2E;
    const int nunits = SAMPLE ? 1024 : 256;
    for (int u0 = F.bid; u0 < nunits; u0 += F.G) {
        int u = u0;
        if (SAMPLE && F.G == 256) { const int i = u0 >> 8, x = F.bid & 7, y = F.bid >> 3; u = ((2 * i + (y >> 4)) * 8 + x) * 16 + (y & 15); }
        int b, h, tok0; TileMap M;
        if (!SAMPLE) { b = u >> 3; h = u & 7; tok0 = b * 256 + qg * 64;
            M.latK = PA + (size_t)(b * 256) * 4096 + 2048 + h * 128; M.latKld = 4096; M.latV = VTp + (size_t)(b * 8 + h) * 128 * 256; M.latVld = 256; M.nlat = 4; M.ctxK = nullptr; M.ctxV = nullptr; M.ntiles = 4; }
        else { b = u >> 7; h = (u >> 4) & 7; tok0 = TP + b * 4096 + (u & 15) * 256 + qg * 64;
            M.latK = PA + (size_t)(TP + b * 4096) * 4096 + 2048 + h * 128; M.latKld = 4096; M.latV = VTs + (size_t)(b * 8 + h) * 128 * 4096; M.latVld = 4096; M.nlat = 64;
            M.ctxK = (const bf16_t*)(P.ws + WS_CDK) + (size_t)b * 256 * 1024 + h * 128; M.ctxV = (const bf16_t*)(P.ws + WS_CDVT) + (size_t)(b * 8 + h) * 128 * 256; M.ntiles = 68; }
        LAS unsigned char* qst = lds + 73728 + F.wave * 8192 + F.lane * 16;
#pragma unroll
        for (int sb = 0; sb < 2; ++sb) { const bf16_t* qptr = PA + (size_t)(tok0 + sb * 32 + q) * 4096 + 1024 + h * 128 + mp * 64;
#pragma unroll
            for (int ks = 0; ks < 4; ++ks) { const u32x4 w = *(const u32x4*)(qptr + ks * 16 + hh * 8);
                const u32x4 ws = (u32x4){pk2(bflo(w.x) * c1, bfhi(w.x) * c1), pk2(bflo(w.y) * c1, bfhi(w.y) * c1), pk2(bflo(w.z) * c1, bfhi(w.z) * c1), pk2(bflo(w.w) * c1, bfhi(w.w) * c1)};
                *(LAS u32x4*)(qst + (sb * 4 + ks) * 1024) = ws; } }
        f32x16 O[2][4]; float ls[2] = {0.f, 0.f};
#pragma unroll
        for (int sb = 0; sb < 2; ++sb)
#pragma unroll
            for (int db = 0; db < 4; ++db)
#pragma unroll
                for (int i = 0; i < 16; ++i) O[sb][db][i] = 0.f;
        const int nt = M.ntiles;
        TileRegs R;
        { const bf16_t* kp; const bf16_t* vp; int kld, vld; tile_src(M, 0, kp, kld, vp, vld); tile_load(F, R, kp, kld, vp, vld); }
        tile_store(F, R, lds + AT_K0, lds + AT_V0);
        __syncthreads();
#pragma unroll 1
        for (int j = 0; j < nt; ++j) {
            const int cur = j & 1;
            if (j + 1 < nt) { const bf16_t* kp; const bf16_t* vp; int kld, vld; tile_src(M, j + 1, kp, kld, vp, vld); tile_load(F, R, kp, kld, vp, vld); }
            LAS const unsigned char* kt = lds + AT_K0 + cur * AT_KTB; LAS const unsigned char* vt = lds + AT_V0 + cur * AT_VTB;
#pragma unroll 1
            for (int kb = 0; kb < 2; ++kb) {
                u32x4 pa[2], pb[2];
#pragma unroll
                for (int sb = 0; sb < 2; ++sb) {
                    f32x16 S;
#pragma unroll
                    for (int i = 0; i < 16; ++i) S[i] = 0.f;
#pragma unroll
                    for (int ks = 0; ks < 4; ++ks) { const bf16x8 A = *(const LAS bf16x8*)(kt + (kb * 32 + q) * AT_KROW + ((mp * 4 + ks) * 16 + hh * 8) * 2);
                        S = __builtin_amdgcn_mfma_f32_32x32x16_bf16(A, *(const LAS bf16x8*)(qst + (sb * 4 + ks) * 1024), S, 0, 0, 0); }
                    float lsum = 0.f;
#pragma unroll
                    for (int sp = 0; sp < 2; ++sp) { float e[8];
#pragma unroll
                        for (int i = 0; i < 8; ++i) { e[i] = __builtin_amdgcn_exp2f(S[8 * sp + i]); lsum += e[i]; }
                        const u32x4 pk = (u32x4){pk2(e[0], e[1]), pk2(e[2], e[3]), pk2(e[4], e[5]), pk2(e[6], e[7])};
                        if (sb == 0) pa[sp] = pk; else pb[sp] = pk; }
                    ls[sb] += lsum;
                }
#pragma unroll
                for (int sp = 0; sp < 2; ++sp) {
                    const bf16x8 Pa = __builtin_bit_cast(bf16x8, pa[sp]), Pb = __builtin_bit_cast(bf16x8, pb[sp]);
#pragma unroll
                    for (int db = 0; db < 4; ++db) {
                        LAS const unsigned char* ap = vt + (db * 32 + q) * AT_VROW + (kb * 32 + 16 * sp + 4 * hh) * 2;
                        const u32x2 lo = *(const LAS u32x2*)(ap), hi = *(const LAS u32x2*)(ap + 16);
                        const bf16x8 A2 = __builtin_bit_cast(bf16x8, (u32x4){lo.x, lo.y, hi.x, hi.y});
                        O[0][db] = __builtin_amdgcn_mfma_f32_32x32x16_bf16(A2, Pa, O[0][db], 0, 0, 0);
                        O[1][db] = __builtin_amdgcn_mfma_f32_32x32x16_bf16(A2, Pb, O[1][db], 0, 0, 0);
                    }
                    asm volatile("" ::: "memory");
                }
            }
            if (j + 1 < nt) tile_store(F, R, lds + AT_K0 + (cur ^ 1) * AT_KTB, lds + AT_V0 + (cur ^ 1) * AT_VTB);
            __syncthreads();
        }
        LAS float* xch = (LAS float*)lds + qg * 8192 + F.lane;
        float lt[2];
#pragma unroll
        for (int sb = 0; sb < 2; ++sb) lt[sb] = ls[sb] + __shfl_xor(ls[sb], 32);
        if (mp == 1) {
#pragma unroll
            for (int sb = 0; sb < 2; ++sb) { const float w1 = lam / lt[sb];
#pragma unroll
                for (int db = 0; db < 4; ++db)
#pragma unroll
                    for (int i = 0; i < 16; ++i) xch[((sb * 4 + db) * 16 + i) * 64] = O[sb][db][i] * w1; } }
        __syncthreads();
        if (mp == 0) {
            const float* sg = P.in[I_SUBG];
#pragma unroll
            for (int sb = 0; sb < 2; ++sb) { const float w0 = 1.f / lt[sb]; float ss = 0.f;
#pragma unroll
                for (int db = 0; db < 4; ++db)
#pragma unroll
                    for (int i = 0; i < 16; ++i) { const float o = O[sb][db][i] * w0 - xch[((sb * 4 + db) * 16 + i) * 64]; O[sb][db][i] = o; ss += o * o; }
                ss += __shfl_xor(ss, 32);
                const float sc = rsqrtf(ss * (1.f / 128.f) + NORM_EPS) * (1.f - 0.35550906759096924f);
                bf16_t* op = MIX + (size_t)(tok0 + sb * 32 + q) * DM + 1024 + h * 128 + 4 * hh;
#pragma unroll
                for (int db = 0; db < 4; ++db)
#pragma unroll
                    for (int g = 0; g < 4; ++g) { const f32x4 g4 = *(const f32x4*)(sg + db * 32 + 8 * g + 4 * hh);
                        u32x2 w; w.x = pk2(O[sb][db][4 * g] * sc * g4.x, O[sb][db][4 * g + 1] * sc * g4.y); w.y = pk2(O[sb][db][4 * g + 2] * sc * g4.z, O[sb][db][4 * g + 3] * sc * g4.w);
                        *(u32x2*)(op + db * 32 + 8 * g) = w; } } }
        __syncthreads();
    }
}
template <int L, int BATCH> struct HyCfg {
    static constexpr int NB = L / 64, TPT = 32 / BATCH, NTILES = NB / TPT, LOGB = (BATCH == 8) ? 3 : 5;
    static constexpr int ZROWB = (L + 384) * 2 + 16, ZBYTES = BATCH * ZROWB, RL = 2 * L + 16;
    static constexpr int TPW = (NTILES + 7) / 8;
};
constexpr int HY_KR_OFF = 71808;

template <int L, int BATCH>
DI void hyena_part(const Ctx& F, const Params& P, int c, int tokbase  , const bf16_t* KRG  ) {
    typedef HyCfg<L, BATCH> C;
    LAS unsigned char* lds = F.lds;
    bf16_t* CM = (bf16_t*)(P.ws + WS_RB);
    const float* hbias = P.in[I_HYBIAS];
    const int q = F.lane & 31, hh = F.lane >> 5;
    __syncthreads();
    for (int id = F.tid; id < BATCH * (L / 8); id += NTHR) { const int b = id / (L / 8), s8 = (id % (L / 8)) * 8;
        *(LAS u32x4*)(lds + b * C::ZROWB + (192 + s8) * 2) = *(const u32x4*)(CM + (size_t)c * TOK + tokbase + b * L + s8); }
    for (int id = F.tid; id < BATCH * 48; id += NTHR) { const int b = id / 48, k = id % 48, e = (k < 24) ? k * 8 : (192 + L + (k - 24) * 8);
        *(LAS u32x4*)(lds + b * C::ZROWB + e * 2) = (u32x4){0u, 0u, 0u, 0u}; }
#pragma unroll 1
    for (int o = 0; o < 2; ++o) {
        { const bf16_t* src = KRG + (size_t)(o * 1024 + c) * C::RL;
          for (int id = F.tid; id < C::RL / 8; id += NTHR) { const u32x4 v = *(const u32x4*)(src + id * 8);
              *(LAS u32x4*)(lds + HY_KR_OFF + id * 16) = v;
              LAS bf16_t* c1 = (LAS bf16_t*)(lds + HY_KR_OFF + C::RL * 2) + id * 8 - 1;
              if (id > 0) c1[0] = (bf16_t)(v.x & 0xffff);
              c1[1] = (bf16_t)(v.x >> 16); c1[2] = (bf16_t)(v.y & 0xffff); c1[3] = (bf16_t)(v.y >> 16); c1[4] = (bf16_t)(v.z & 0xffff); c1[5] = (bf16_t)(v.z >> 16);
              c1[6] = (bf16_t)(v.w & 0xffff); c1[7] = (bf16_t)(v.w >> 16); } }
        __syncthreads();
        f32x16 acc[C::TPW][2];
#pragma unroll
        for (int t = 0; t < C::TPW; ++t)
#pragma unroll
            for (int mt = 0; mt < 2; ++mt)
#pragma unroll
                for (int i = 0; i < 16; ++i) acc[t][mt][i] = 0.f;
        const int tq0 = F.wave * C::TPW;
        if (tq0 < C::NTILES) {
            const int d1lo = C::TPT * tq0 - (C::NB - 1), d1hi = C::TPT * (tq0 + C::TPW - 1) + C::TPT - 1;
            const int abase = HY_KR_OFF + (F.lane & 1) * (C::RL * 2) + (L - (F.lane & 31) + 8 * hh - (F.lane & 1)) * 2;
            bf16x8 W0[6], W1[6], B0[C::TPW][4];
#define HY_LDW(Wv, d1v, i) do { LAS const unsigned* ap_ = (LAS const unsigned*)(lds + abase + (-4 * (d1v) - 2 + (i)) * 32); Wv[i] = __builtin_bit_cast(bf16x8, (u32x4){ap_[0], ap_[1], ap_[2], ap_[3]}); } while (0)
#define HY_LDB(Bv, d1v) do { _Pragma("unroll") for (int t_ = 0; t_ < C::TPW; ++t_) { const int tq_ = tq0 + t_; \
            const int t1_ = C::TPT * tq_ + (q >> C::LOGB), b_ = q & (BATCH - 1); int s1_ = t1_ - (d1v); s1_ = min(max(s1_, -3), C::NB + 2); \
            LAS const unsigned char* bp_ = lds + b_ * C::ZROWB + (192 + 64 * s1_ + 8 * hh) * 2; \
            _Pragma("unroll") for (int ks_ = 0; ks_ < 4; ++ks_) Bv[t_][ks_] = *(const LAS bf16x8*)(bp_ + ks_ * 32); } } while (0)
#define HY_MM(Wv, Bv, d1v) do { _Pragma("unroll") for (int t_ = 0; t_ < C::TPW; ++t_) { const int tq_ = tq0 + t_; \
            if ((d1v) >= C::TPT * tq_ - (C::NB - 1) && (d1v) <= C::TPT * tq_ + C::TPT - 1) { \
                _Pragma("unroll") for (int ks_ = 0; ks_ < 4; ++ks_) _Pragma("unroll") for (int mt_ = 0; mt_ < 2; ++mt_) \
                    acc[t_][mt_] = __builtin_amdgcn_mfma_f32_32x32x16_bf16(Wv[ks_ - 2 * mt_ + 2], Bv[t_][ks_], acc[t_][mt_], 0, 0, 0); } } } while (0)
#pragma unroll
            for (int i = 0; i < 6; ++i) HY_LDW(W0, d1lo, i);
            int d1 = d1lo;
#pragma unroll 1
            for (; d1 + 1 <= d1hi; d1 += 2) {
                HY_LDB(B0, d1);
#pragma unroll
                for (int i = 0; i < 4; ++i) HY_LDW(W1, d1 + 1, i);
                W1[4] = W0[0]; W1[5] = W0[1];
                HY_MM(W0, B0, d1);
                HY_LDB(B0, d1 + 1);
                if (d1 + 2 <= d1hi) {
#pragma unroll
                    for (int i = 0; i < 4; ++i) HY_LDW(W0, d1 + 2, i);
                    W0[4] = W1[0]; W0[5] = W1[1];
                }
                HY_MM(W1, B0, d1 + 1);
            }
            if (d1 <= d1hi) { HY_LDB(B0, d1); HY_MM(W0, B0, d1); }
#undef HY_LDW
#undef HY_LDB
#undef HY_MM
        }
        __syncthreads();
        if (tq0 < C::NTILES) {
            const float bo = hbias[o * 1024 + c];
            const bf16_t* gate = CM + (size_t)((1 + o) * 1024 + c) * TOK + tokbase;
            bf16_t* zout = (bf16_t*)(P.ws + WS_RA + RA_ZC) + (size_t)c * TOK + tokbase;
#pragma unroll
            for (int t = 0; t < C::TPW; ++t) { const int tq = tq0 + t, t1 = C::TPT * tq + (q >> C::LOGB), b = q & (BATCH - 1);
#pragma unroll
                for (int mt = 0; mt < 2; ++mt)
#pragma unroll
                    for (int g = 0; g < 4; ++g) { const int s = 64 * t1 + 32 * mt + 8 * g + 4 * hh;
                        LAS u32x2* zp = (LAS u32x2*)(lds + b * C::ZROWB + (192 + s) * 2);
                        const u32x2 zv = *zp, gv = *(const u32x2*)(gate + (size_t)b * L + s);
                        const float r0 = bflo(gv.x) * (acc[t][mt][4 * g] + bflo(zv.x) * bo), r1 = bfhi(gv.x) * (acc[t][mt][4 * g + 1] + bfhi(zv.x) * bo);
                        const float r2 = bflo(gv.y) * (acc[t][mt][4 * g + 2] + bflo(zv.y) * bo), r3 = bfhi(gv.y) * (acc[t][mt][4 * g + 3] + bfhi(zv.y) * bo);
                        const u32x2 w = (u32x2){pk2(r0, r1), pk2(r2, r3)};
                        if (o == 0) *zp = w; else *(u32x2*)(zout + (size_t)b * L + s) = w; } }
        }
        __syncthreads();
    }
}

DI void hyena_phase(const Ctx& F, const Params& P) {
    for (int c = F.bid; c < 1024; c += F.G) {
        hyena_part<LS, 8>(F, P, c, TP, (const bf16_t*)(P.ws + WS_KRS));
        hyena_part<LP, 32>(F, P, c, 0, (const bf16_t*)(P.ws + WS_KRP));
    }
}

DI void hyena_post(const Ctx& F, const Params& P) {
    const bf16_t* CM = (const bf16_t*)(P.ws + WS_RA + RA_ZC); bf16_t* MIX = (bf16_t*)(P.ws + WS_HM);
    for (int t = F.bid; t < 16 * 640; t += F.G) { const int cg = t & 15, tg = t >> 4;
        tr_tile_bf16(F, CM + (size_t)(cg * 64) * TOK + tg * 64, TOK, MIX + (size_t)(tg * 64) * DM + 1024 + cg * 64, DM, (LAS bf16_t*)F.lds); }
}
DI void prep_c(const Ctx& F, const Params& P) {
    bf16_t* PA = (bf16_t*)(P.ws + WS_RA);
    LAS float* rope = (LAS float*)(F.lds + 16384);
    __syncthreads();
    for (int e = F.tid; e < 1024; e += NTHR) { const int pos = e >> 4, f = e & 15; const float inv = exp2f(-(float)f * (13.287712379549449f / 16.f)); const float a = (float)pos * inv;
        rope[e * 2] = cosf(a); rope[e * 2 + 1] = sinf(a); }
    __syncthreads();
    { const float* gsrc = (F.lane < 32 ? P.in[I_DQG] : P.in[I_DKG]) + (F.lane & 1) * 32; float* ok = P.out + O_DK;
      float g[32];
#pragma unroll
      for (int i = 0; i < 32; ++i) g[i] = gsrc[i];
      for (int T = F.bid * 8 + F.wave; T < TOK; T += F.G * 8) {
          bf16_t* rp = PA + (size_t)T * 4096 + 1024 + F.lane * 32;
          u32x4 v[4]; float x[32]; float ss = 0.f;
#pragma unroll
          for (int j = 0; j < 4; ++j) { v[j] = *(const u32x4*)(rp + j * 8);
              x[j * 8 + 0] = bflo(v[j].x); x[j * 8 + 1] = bfhi(v[j].x); x[j * 8 + 2] = bflo(v[j].y); x[j * 8 + 3] = bfhi(v[j].y);
              x[j * 8 + 4] = bflo(v[j].z); x[j * 8 + 5] = bfhi(v[j].z); x[j * 8 + 6] = bflo(v[j].w); x[j * 8 + 7] = bfhi(v[j].w); }
#pragma unroll
          for (int i = 0; i < 32; ++i) ss += x[i] * x[i];
          ss += dpp_xor1(ss);
          const float rstd = rsqrtf(ss * (1.f / 64.f) + NORM_EPS);
#pragma unroll
          for (int i = 0; i < 32; ++i) x[i] = x[i] * rstd * g[i];
          if (T < TP) { if (F.lane >= 32) { float* o = ok + (size_t)T * 1024 + (F.lane - 32) * 32;
#pragma unroll
                  for (int j = 0; j < 8; ++j) *(f32x4*)(o + j * 4) = (f32x4){x[j * 4], x[j * 4 + 1], x[j * 4 + 2], x[j * 4 + 3]}; } }
          else { const int t = (T - TP) & 4095, pos = (F.lane & 1) ? (t & 63) : (t >> 6);
              const LAS float* rt = rope + pos * 32;
#pragma unroll
              for (int f = 0; f < 16; ++f) { const float cs = rt[2 * f], sn = rt[2 * f + 1], a = x[f], b = x[16 + f]; x[f] = a * cs - b * sn; x[16 + f] = b * cs + a * sn; } }
#pragma unroll
          for (int j = 0; j < 4; ++j) { u32x4 w; w.x = pk2(x[j * 8 + 0], x[j * 8 + 1]); w.y = pk2(x[j * 8 + 2], x[j * 8 + 3]); w.z = pk2(x[j * 8 + 4], x[j * 8 + 5]); w.w = pk2(x[j * 8 + 6], x[j * 8 + 7]);
              *(u32x4*)(rp + j * 8) = w; }
      } }
    __syncthreads();
    bf16_t* VTp = (bf16_t*)(P.ws + WS_VT); bf16_t* VTs = (bf16_t*)(P.ws + WS_VT + VT_S);
    for (int t = F.bid; t < 2048 + 8192; t += F.G) {
        if (t < 2048) { const int bh = t >> 3, sub = t & 7, tk = sub >> 1, dd = sub & 1, b = bh >> 3, h = bh & 7;
            tr_tile_bf16(F, PA + ((size_t)(b * 256 + tk * 64)) * 4096 + 3072 + h * 128 + dd * 64, 4096, VTp + ((size_t)bh * 128 + dd * 64) * 256 + tk * 64, 256, (LAS bf16_t*)F.lds); }
        else { const int u = t - 2048, bh = u >> 7, sub = u & 127, tk = sub >> 1, dd = sub & 1, b = bh >> 3, h = bh & 7;
            tr_tile_bf16(F, PA + ((size_t)(TP + b * 4096 + tk * 64)) * 4096 + 3072 + h * 128 + dd * 64, 4096, VTs + ((size_t)bh * 128 + dd * 64) * 4096 + tk * 64, 4096, (LAS bf16_t*)F.lds); }
    }
    { float* o = P.out + O_DV;
      for (int e = F.bid * NTHR + F.tid; e < TP * 128; e += F.G * NTHR) { const int T = e >> 7, c8 = (e & 127) * 8;
          const u32x4 v = *(const u32x4*)(PA + (size_t)T * 4096 + 3072 + c8);
          *(f32x4*)(o + (size_t)T * 1024 + c8) = (f32x4){bflo(v.x), bfhi(v.x), bflo(v.y), bfhi(v.y)};
          *(f32x4*)(o + (size_t)T * 1024 + c8 + 4) = (f32x4){bflo(v.z), bfhi(v.z), bflo(v.w), bfhi(v.w)}; } }
}

constexpr int S5_BUROW = 132 * 4, S5_HROW = 272, S5_WLDS = 16 * S5_BUROW + 16 * S5_HROW;
DI void s5_chain(const Ctx& F, const Params& P, int dg, int tok0, int L, const float* h0re, const float* h0im, float* fre, float* fim, bf16_t* Yout) {
    LAS unsigned char* wl = F.lds + F.wave * S5_WLDS; LAS unsigned char* hl = wl + 16 * S5_BUROW;
    const int g = dg & 63, dir = dg >> 6, lane = F.lane, st = lane & 15, gq = lane >> 4;
    const float* S5A = (const float*)(P.ws + WS_S5A); const bf16_t* BB = (const bf16_t*)(P.ws + WS_S5BB); const bf16_t* CC = (const bf16_t*)(P.ws + WS_S5CC);
    const bf16_t* PA = (const bf16_t*)(P.ws + WS_RA);
    const float ar = S5A[(dg * 64 + lane) * 2], ai = S5A[(dg * 64 + lane) * 2 + 1];
    float hr = h0re ? h0re[lane] : 0.f, hi = h0im ? h0im[lane] : 0.f;
    const bf16x8 zero8 = (bf16x8){0, 0, 0, 0, 0, 0, 0, 0};
    bf16x8 BBf[8], CCf[4];
#pragma unroll
    for (int mt = 0; mt < 8; ++mt) BBf[mt] = (gq < 2) ? *(const bf16x8*)(BB + ((size_t)dg * 128 + mt * 16 + st) * 16 + gq * 8) : zero8;
#pragma unroll
    for (int kk = 0; kk < 4; ++kk) CCf[kk] = *(const bf16x8*)(CC + ((size_t)dg * 16 + st) * 128 + kk * 32 + gq * 8);
    const int nch = L / 16;
    const int sgn = dir ? -1 : 1, tstart = dir ? tok0 + L - 1 : tok0;
    bf16x8 Uf = zero8, U1 = zero8, U2 = zero8;
    if (gq < 2) { Uf = *(const bf16x8*)(PA + (size_t)(tstart + sgn * st) * 4096 + g * 16 + gq * 8);
        if (1 < nch) U1 = *(const bf16x8*)(PA + (size_t)(tstart + sgn * (16 + st)) * 4096 + g * 16 + gq * 8);
        if (2 < nch) U2 = *(const bf16x8*)(PA + (size_t)(tstart + sgn * (32 + st)) * 4096 + g * 16 + gq * 8); }
    for (int ch = 0; ch < nch; ++ch) {
        bf16x8 Un = zero8;
        if (ch + 3 < nch && gq < 2) Un = *(const bf16x8*)(PA + (size_t)(tstart + sgn * ((ch + 3) * 16 + st)) * 4096 + g * 16 + gq * 8);
#pragma unroll
        for (int mt = 0; mt < 8; ++mt) { f32x4 d = (f32x4){0.f, 0.f, 0.f, 0.f};
            d = __builtin_amdgcn_mfma_f32_16x16x32_bf16(BBf[mt], Uf, d, 0, 0, 0);
            *(LAS f32x4*)(wl + st * S5_BUROW + (mt * 16 + gq * 4) * 4) = d; }
        asm volatile("" ::: "memory");
#pragma unroll
        for (int s = 0; s < 16; ++s) {
            const float bur = *(const LAS float*)(wl + s * S5_BUROW + lane * 4), bui = *(const LAS float*)(wl + s * S5_BUROW + (64 + lane) * 4);
            const float nr = ar * hr - ai * hi + bur, ni = ar * hi + ai * hr + bui; hr = nr; hi = ni;
            *(LAS bf16_t*)(hl + s * S5_HROW + lane * 2) = f2bf(hr); *(LAS bf16_t*)(hl + s * S5_HROW + (64 + lane) * 2) = f2bf(hi);
        }
        asm volatile("" ::: "memory");
        f32x4 y = (f32x4){0.f, 0.f, 0.f, 0.f};
#pragma unroll
        for (int kk = 0; kk < 4; ++kk) { const bf16x8 Bh = *(const LAS bf16x8*)(hl + st * S5_HROW + (kk * 32 + gq * 8) * 2);
            y = __builtin_amdgcn_mfma_f32_16x16x32_bf16(CCf[kk], Bh, y, 0, 0, 0); }
        { const int tok = tstart + sgn * (ch * 16 + st);
          *(u32x2*)(Yout + (size_t)tok * 1024 + g * 16 + gq * 4) = (u32x2){pk2(y[0], y[1]), pk2(y[2], y[3])}; }
        asm volatile("" ::: "memory");
        Uf = U1; U1 = U2; U2 = Un;
    }
    if (fre) { fre[lane] = hr; fim[lane] = hi; }
}

DI void s5_phase(const Ctx& F, const Params& P) {
    bf16_t* YF = (bf16_t*)(P.ws + WS_RB + RB_YF); bf16_t* YB = (bf16_t*)(P.ws + WS_RB + RB_YB);
    for (int cs = F.bid; cs < 256; cs += F.G) {
        if (F.wave < 4) { const int sc = cs * 4 + F.wave, dg = sc & 127, b = sc >> 7;
            s5_chain(F, P, dg, TP + b * 4096, LS, P.in[I_S5RE] + (size_t)sc * 64, P.in[I_S5IM] + (size_t)sc * 64, nullptr, nullptr, (dg >> 6) ? YB : YF); }
        else { for (int k = 0; k < 4; ++k) { const int pc = (cs * 4 + (F.wave - 4)) * 4 + k, dg = pc & 127, b = pc >> 7;
            s5_chain(F, P, dg, b * 256, LP, nullptr, nullptr, P.out + O_SR + (size_t)pc * 64, P.out + O_SI + (size_t)pc * 64, (dg >> 6) ? YB : YF); } }
    }
}

DI void s5_combine(const Ctx& F, const Params& P) {
    const bf16_t* PA = (const bf16_t*)(P.ws + WS_RA); const bf16_t* YF = (const bf16_t*)(P.ws + WS_RB + RB_YF); const bf16_t* YB = (const bf16_t*)(P.ws + WS_RB + RB_YB);
    bf16_t* Y = (bf16_t*)(P.ws + WS_RB + RB_Y); const float* dsk = P.in[I_S5D];
    for (size_t e = (size_t)F.bid * NTHR + F.tid; e < (size_t)TOK * 128; e += (size_t)F.G * NTHR) { const size_t T = e >> 7; const int c8 = (int)(e & 127) * 8;
        const u32x4 uv = *(const u32x4*)(PA + T * 4096 + c8), fv = *(const u32x4*)(YF + T * 1024 + c8), bv = *(const u32x4*)(YB + T * 1024 + c8);
        const f32x4 d0 = *(const f32x4*)(dsk + c8), d1 = *(const f32x4*)(dsk + c8 + 4);
        float o[8];
        o[0] = gelu_tanh(d0.x * bflo(uv.x) + bflo(fv.x) + bflo(bv.x)); o[1] = gelu_tanh(d0.y * bfhi(uv.x) + bfhi(fv.x) + bfhi(bv.x));
        o[2] = gelu_tanh(d0.z * bflo(uv.y) + bflo(fv.y) + bflo(bv.y)); o[3] = gelu_tanh(d0.w * bfhi(uv.y) + bfhi(fv.y) + bfhi(bv.y));
        o[4] = gelu_tanh(d1.x * bflo(uv.z) + bflo(fv.z) + bflo(bv.z)); o[5] = gelu_tanh(d1.y * bfhi(uv.z) + bfhi(fv.z) + bfhi(bv.z));
        o[6] = gelu_tanh(d1.z * bflo(uv.w) + bflo(fv.w) + bflo(bv.w)); o[7] = gelu_tanh(d1.w * bfhi(uv.w) + bfhi(fv.w) + bfhi(bv.w));
        u32x4 w; w.x = pk2(o[0], o[1]); w.y = pk2(o[2], o[3]); w.z = pk2(o[4], o[5]); w.w = pk2(o[6], o[7]);
        *(u32x4*)(Y + T * 1024 + c8) = w; }
}
constexpr int PS_KROW = 272;
constexpr int PS_IDX_OFF = 2 * 128 * PS_KROW;
constexpr int PS_TAB_OFF = PS_IDX_OFF + 512 * 32;

DI void topk_insert(float (&a)[16], float x) {
#pragma unroll
    for (int j = 15; j >= 1; --j) a[j] = __builtin_amdgcn_fmed3f(a[j - 1], a[j], x);
    a[0] = fmaxf(a[0], x);
}

DI void peer_select(const Ctx& F, const Params& P, int layer) {
    LAS unsigned char* lds = F.lds;
    const bf16_t* Q = (const bf16_t*)(P.ws + WS_RA + RA_Q);
    int* SELI = (int*)(P.ws + WS_RA + RA_SELI); float* SELW = (float*)(P.ws + WS_RA + RA_SELW);
    const bf16_t* KEYS = (const bf16_t*)(P.ws + WS_PKEYS) + (size_t)layer * 8 * 2 * 128 * 128;
    const int q = F.lane & 31, hh = F.lane >> 5;
    LAS unsigned char* myidx = lds + PS_IDX_OFF + F.tid * 32;
    LAS unsigned char* tab = lds + PS_TAB_OFF;
    for (int wu = F.bid; wu < 256; wu += F.G) {
        const int h = wu & 7, chunk = wu >> 3;
        __syncthreads();
        for (int id = F.tid; id < 2 * 128 * 16; id += NTHR) { const int row = id >> 4, c16 = id & 15;
            *(LAS u32x4*)(lds + row * PS_KROW + c16 * 16) = *(const u32x4*)(KEYS + ((size_t)h * 256 + row) * 128 + c16 * 8); }
        if (F.tid < 16) { int cnt = 0;
            for (int a = 0; a < F.tid; ++a) cnt += 16 / (a + 1);
            for (int b = 0; b < 16 / (F.tid + 1); ++b) { tab[(cnt + b) * 2] = (unsigned char)F.tid; tab[(cnt + b) * 2 + 1] = (unsigned char)b; } }
        __syncthreads();
        for (int blk = F.wave; blk < 40; blk += 8) {
            const int T0 = chunk * 1280 + blk * 32;
            float lst[2][16];
#pragma unroll
            for (int side = 0; side < 2; ++side) {
                bf16x8 Qf[8];
                const bf16_t* qp = Q + (size_t)(T0 + q) * 2048 + h * 256 + side * 128 + hh * 8;
#pragma unroll
                for (int ks = 0; ks < 8; ++ks) Qf[ks] = *(const bf16x8*)(qp + ks * 16);
                float a[16];
#pragma unroll
                for (int j = 0; j < 16; ++j) a[j] = -3.0e38f;
#pragma unroll
                for (int nt = 0; nt < 4; ++nt) {
                    f32x16 S;
#pragma unroll
                    for (int i = 0; i < 16; ++i) S[i] = 0.f;
#pragma unroll
                    for (int ks = 0; ks < 8; ++ks) { const bf16x8 A = *(const LAS bf16x8*)(lds + (side * 128 + nt * 32 + q) * PS_KROW + (ks * 16 + hh * 8) * 2);
                        S = __builtin_amdgcn_mfma_f32_32x32x16_bf16(A, Qf[ks], S, 0, 0, 0); }
#pragma unroll
                    for (int i = 0; i < 16; ++i) { const int n = nt * 32 + (i & 3) + 8 * (i >> 2) + 4 * hh;
                        topk_insert(a, __uint_as_float((__float_as_uint(S[i]) & 0xffffff80u) | (unsigned)n)); }
                }
                float pb[16];
#pragma unroll
                for (int j = 0; j < 16; ++j) pb[j] = __shfl_xor(a[j], 32);
#pragma unroll
                for (int j = 0; j < 16; ++j) topk_insert(a, pb[j]);
#pragma unroll
                for (int j = 0; j < 16; ++j) { lst[side][j] = a[j]; myidx[side * 16 + j] = (unsigned char)(__float_as_uint(a[j]) & 0x7fu); }
            }
            float cb[16];
#pragma unroll
            for (int j = 0; j < 16; ++j) cb[j] = -3.0e38f;
            { int cid = 0;
#pragma unroll
              for (int a = 0; a < 16; ++a)
#pragma unroll
                  for (int b = 0; b < 16 / (a + 1); ++b) {
                      const float sa = __uint_as_float(__float_as_uint(lst[0][a]) & 0xffffff80u), sb = __uint_as_float(__float_as_uint(lst[1][b]) & 0xffffff80u);
                      topk_insert(cb, __uint_as_float((__float_as_uint(sa + sb) & 0xffffffc0u) | (unsigned)cid)); ++cid; } }
            const float mx = __uint_as_float(__float_as_uint(cb[0]) & 0xffffffc0u);
            float e[16], den = 0.f;
#pragma unroll
            for (int j = 0; j < 16; ++j) { e[j] = __expf(__uint_as_float(__float_as_uint(cb[j]) & 0xffffffc0u) - mx); den += e[j]; }
            const float rden = 1.f / den;
#pragma unroll
            for (int j = 0; j < 16; ++j) {
                if ((j >> 3) == hh) { const int cid = (int)(__float_as_uint(cb[j]) & 0x3fu);
                    const int a = tab[cid * 2], b = tab[cid * 2 + 1];
                    const int eidx = (int)myidx[a] * 128 + (int)myidx[16 + b];
                    SELI[(size_t)(T0 + q) * 128 + h * 16 + j] = eidx; SELW[(size_t)(T0 + q) * 128 + h * 16 + j] = e[j] * rden; }
            }
        }
    }
    __syncthreads();
}

DI u32x16 fp6_unpack_bf16(u32x4 a, u32x2 b) { const u32x6 pk = {a.x, a.y, a.z, a.w, b.x, b.y}; return __builtin_bit_cast(u32x16, __builtin_amdgcn_cvt_scalef32_pk32_bf16_fp6(pk, 1.0f)); }
DI f32x32 fp6_unpack(u32x4 a, u32x2 b) { const u32x6 pk = {a.x, a.y, a.z, a.w, b.x, b.y}; return __builtin_amdgcn_cvt_scalef32_pk32_f32_fp6(pk, 1.0f); }
constexpr int GN = 4;
template <bool NEXTNORM>
DI void peer_gather(const Ctx& F, const Params& P, const float* modl, int layer, const float* ngain, const float* nmodl) {
    const bf16_t* H2 = (const bf16_t*)(P.ws + WS_HM);
    const unsigned char* TU = P.ws + WS_TBLU + (size_t)layer * 16384 * PT_ROWB; const unsigned char* TV = P.ws + WS_TBLV + (size_t)layer * 16384 * PT_ROWB;
    const float* SCU = (const float*)(P.ws + WS_SC) + layer * 16384; const float* SCV = (const float*)(P.ws + WS_SC) + (2 + layer) * 16384;
    const int* SELI = (const int*)(P.ws + WS_RA + RA_SELI); const float* SELW = (const float*)(P.ws + WS_RA + RA_SELW);
    float* X = P.out + O_Y;
    const int lane = lane_id();
    const int stride = F.G * 8;
    for (int T0 = F.bid * 8 + F.wave; T0 < TOK; T0 += 2 * stride) {
        const bool two = (T0 + stride < TOK);
        const int Tt[2] = {T0, two ? T0 + stride : T0};
        u32x4 xw[2][4]; int e0[2], e1[2]; float g0[2], g1[2], d0[2], d1[2];
#pragma unroll
        for (int t = 0; t < 2; ++t) {
#pragma unroll
            for (int q4 = 0; q4 < 4; ++q4) xw[t][q4] = *(const u32x4*)(H2 + (size_t)Tt[t] * DM + lane * 32 + q4 * 8);
            e0[t] = SELI[(size_t)Tt[t] * 128 + lane]; e1[t] = SELI[(size_t)Tt[t] * 128 + 64 + lane];
            g0[t] = SELW[(size_t)Tt[t] * 128 + lane]; g1[t] = SELW[(size_t)Tt[t] * 128 + 64 + lane]; d0[t] = 0.f; d1[t] = 0.f; }
#pragma unroll 1
        for (int kb = 0; kb < 128; kb += GN) {
            u32x4 ura[2][GN]; u32x2 urb[2][GN];
#pragma unroll
            for (int j = 0; j < GN; ++j)
#pragma unroll
                for (int t = 0; t < 2; ++t) { const int k = kb + j; const int e = __builtin_amdgcn_readlane(k < 64 ? e0[t] : e1[t], k & 63);
                    const unsigned char* up = TU + (size_t)e * PT_ROWB;
                    ura[t][j] = *(const u32x4*)(up + lane * 16); urb[t][j] = *(const u32x2*)(up + 1024 + lane * 8); }
#pragma unroll
            for (int j = 0; j < GN; ++j) { float pt[2];
#pragma unroll
                for (int t = 0; t < 2; ++t) { const u32x16 r = fp6_unpack_bf16(ura[t][j], urb[t][j]);
                    float sa = 0.f, sb = 0.f, sc2 = 0.f, sd = 0.f;
#pragma unroll
                    for (int i = 0; i < 4; ++i) { const unsigned x0 = xw[t][i].x, x1 = xw[t][i].y, x2 = xw[t][i].z, x3 = xw[t][i].w;
                        sa = dot2bf(r[4 * i], x0, sa); sb = dot2bf(r[4 * i + 1], x1, sb); sc2 = dot2bf(r[4 * i + 2], x2, sc2); sd = dot2bf(r[4 * i + 3], x3, sd); }
                    pt[t] = (sa + sb) + (sc2 + sd); }
                const float sm0 = wave_sum(pt[0]), sm1 = wave_sum(pt[1]); const int k = kb + j;
                if (k < 64) { if (lane == k) { d0[0] = sm0; d0[1] = sm1; } } else { if (lane == k - 64) { d1[0] = sm0; d1[1] = sm1; } } }
        }
        float cf0[2], cf1[2];
#pragma unroll
        for (int t = 0; t < 2; ++t) { cf0[t] = g0[t] * gelu_tanh(d0[t] * SCU[e0[t]]) * SCV[e0[t]]; cf1[t] = g1[t] * gelu_tanh(d1[t] * SCU[e1[t]]) * SCV[e1[t]]; }
        f32x2 acc[2][16];
#pragma unroll
        for (int t = 0; t < 2; ++t)
#pragma unroll
            for (int i = 0; i < 16; ++i) acc[t][i] = (f32x2){0.f, 0.f};
#pragma unroll 1
        for (int kb = 0; kb < 128; kb += GN) {
            u32x4 vra[2][GN]; u32x2 vrb[2][GN]; float cf[2][GN];
#pragma unroll
            for (int j = 0; j < GN; ++j)
#pragma unroll
                for (int t = 0; t < 2; ++t) { const int k = kb + j; const int e = __builtin_amdgcn_readlane(k < 64 ? e0[t] : e1[t], k & 63);
                    cf[t][j] = __builtin_bit_cast(float, __builtin_amdgcn_readlane(__builtin_bit_cast(int, k < 64 ? cf0[t] : cf1[t]), k & 63));
                    const unsigned char* vp = TV + (size_t)e * PT_ROWB;
                    vra[t][j] = *(const u32x4*)(vp + lane * 16); vrb[t][j] = *(const u32x2*)(vp + 1024 + lane * 8); }
#pragma unroll
            for (int j = 0; j < GN; ++j)
#pragma unroll
                for (int t = 0; t < 2; ++t) { const f32x32 r = fp6_unpack(vra[t][j], vrb[t][j]);
                    const f32x2 c2 = (f32x2){cf[t][j], cf[t][j]};
#pragma unroll
                    for (int i = 0; i < 16; ++i) acc[t][i] += c2 * (f32x2){r[2 * i], r[2 * i + 1]}; }
        }
#pragma unroll
        for (int t = 0; t < 2; ++t) {
            if (t == 1 && !two) break;
            const int T = Tt[t];
            const float* gate = modl + (size_t)(cond_of(T) * 6 + 5) * DM;
            f32x4 xn[8]; float ss = 0.f;
#pragma unroll
            for (int q4 = 0; q4 < 8; ++q4) { const int col = lane * 32 + q4 * 4; float* xp = X + (size_t)T * DM + col;
                const f32x4 gv = *(const f32x4*)(gate + col), x0 = *(const f32x4*)(xp);
                const f32x4 r = x0 + gv * (f32x4){acc[t][q4 * 2].x, acc[t][q4 * 2].y, acc[t][q4 * 2 + 1].x, acc[t][q4 * 2 + 1].y};
                *(f32x4*)(xp) = r; xn[q4] = r; ss += r.x * r.x + r.y * r.y + r.z * r.z + r.w * r.w; }
            if (NEXTNORM) {
                ss = wave_sum(ss);
                const float rstd = rsqrtf(ss * (1.f / DM) + NORM_EPS);
                const float* sh = nmodl + (size_t)(cond_of(T) * 6 + 0) * DM; const float* sc = sh + DM;
                bf16_t* H = (bf16_t*)(P.ws + WS_HM);
#pragma unroll
                for (int q4 = 0; q4 < 8; ++q4) { const int col = lane * 32 + q4 * 4;
                    const f32x4 g4 = *(const f32x4*)(ngain + col), s4 = *(const f32x4*)(sc + col), h4 = *(const f32x4*)(sh + col);
                    const f32x4 o = xn[q4] * rstd * g4 * (s4 + 1.f) + h4;
                    *(u32x2*)(H + (size_t)T * DM + col) = (u32x2){pk2(o.x, o.y), pk2(o.z, o.w)}; }
            }
        }
    }
}
constexpr int NPHASE = 22;

__global__ void __launch_bounds__(NTHR, 2) mega(Params P) {
    extern __shared__ __attribute__((aligned(16))) unsigned char lds_raw[];
    Ctx F;
    F.lds = (LAS unsigned char*)lds_raw; F.tid = threadIdx.x; F.lane = F.tid & 63; F.wave = __builtin_amdgcn_readfirstlane(F.tid >> 6); F.G = gridDim.x; F.bid = blockIdx.x;
    const int lo = P.ph_lo, hi = P.ph_hi;
    volatile LAS unsigned* xbw = (volatile LAS unsigned*)(F.lds + LDS_BYTES - 16);
    if (F.tid == 0) { xbw[0] = 0u; xbw[1] = 0u; xbw[2] = 0u; xbw[3] = 0u; }
    __syncthreads();
    if (hi - lo > 1) (void)xcd_barrier_post((unsigned*)(P.ws + WS_CTL), xbw);
#define GRID_BARRIER() do { XcdBarrier bar_; bar_.bar = (unsigned*)(P.ws + WS_CTL); bar_.x = xb_xcc_id(); bar_.st = (volatile LAS unsigned*)(F.lds + LDS_BYTES - 16); xcd_barrier(bar_); } while (0)
#define PH(k, ...) if (lo <= (k) && (k) < hi) { { __VA_ARGS__ } if ((k) + 1 < hi) GRID_BARRIER(); }
#define MOD0 ((const float*)(P.ws + WS_MOD))
#define MOD1 ((const float*)(P.ws + WS_MOD) + 9 * 12288)
#define HM ((bf16_t*)(P.ws + WS_HM))
#define RA ((bf16_t*)(P.ws + WS_RA))
#define X (P.out + O_Y)

    PH(0, prologue(F, P);)
    PH(1, adaln_reduce(F, P);)
    PH(2, norm_phase(F, P.in[I_XP], P.in[I_XS], P.in[I_NMIXG], MOD0, 0, HM);)
    PH(3, { EpiBf16 E{RA, 4096}; run_gemm(F, HM, (const bf16_t*)(P.ws + WS_WEVIN) + (size_t)2048 * 2048, 4096, 2048, E); })
    PH(4, prep_a(F, P);)
    PH(5, { EpiBf16 E{RA, 2048}; run_gemm(F, HM, (const bf16_t*)(P.ws + WS_WEVIN), 2048, 2048, E); })
    PH(6, attn_phase<0>(F, P); attn_phase<1>(F, P); hyena_phase(F, P);)
    PH(7, hyena_post(F, P);)
    PH(8, { EpiResid E{P.in[I_XP], P.in[I_XS], X, MOD0, 2}; run_gemm(F, HM, (const bf16_t*)(P.ws + WS_WEVOUT), 2048, 2048, E); })
    PH(9, norm_phase(F, X, X + (size_t)TP * DM, P.in[I_NFFNG], MOD0, 3, HM);)
    PH(10, { EpiBf16 E{RA, 2048}; run_gemm(F, HM, (const bf16_t*)(P.ws + WS_WPQ), 2048, 2048, E); })
    PH(11, peer_select(F, P, 0);)
    PH(12, peer_gather<true>(F, P, MOD0, 0, P.in[I_NMIXG] + DM, MOD1);)
    PH(13, { EpiBf16 E{RA, 4096}; run_gemm(F, HM, (const bf16_t*)(P.ws + WS_WODIN), 4096, 2048, E); })
    PH(14, prep_c(F, P); s5_phase(F, P);)
    PH(15, { const float lam = diff_lambda(F, P); attn_diff_phase<false>(F, P, lam); attn_diff_phase<true>(F, P, lam); } s5_combine(F, P);)
    PH(16, { EpiGlu E{(const bf16_t*)(P.ws + WS_RB + RB_Y), HM, P.in[I_GLUB]}; run_gemm(F, (const bf16_t*)(P.ws + WS_RB + RB_Y), (const bf16_t*)(P.ws + WS_WGLU), 1024, 1024, E); })
    PH(17, { EpiResid E{X, X + (size_t)TP * DM, X, MOD1, 2}; run_gemm(F, HM, (const bf16_t*)(P.ws + WS_WODOUT), 2048, 2048, E); })
    PH(18, norm_phase(F, X, X + (size_t)TP * DM, P.in[I_NFFNG] + DM, MOD1, 3, HM);)
    PH(19, { EpiBf16 E{RA, 2048}; run_gemm(F, HM, (const bf16_t*)(P.ws + WS_WPQ) + (size_t)2048 * 2048, 2048, 2048, E); })
    PH(20, peer_select(F, P, 1);)
    PH(21, peer_gather<false>(F, P, MOD1, 1, nullptr, nullptr);)
#undef MOD0
#undef MOD1
#undef HM
#undef RA
#undef X
#undef PH
#undef GRID_BARRIER
}

extern "C" void kernel_launch(void* const* d_in, const int* in_sizes, int n_in, void* d_out, int out_size, void* d_ws, size_t ws_size, hipStream_t stream) {
    static int grid = 0;
    if (grid == 0) {
        if (n_in != N_IN || (size_t)out_size != O_END || ws_size < WS_END) { fprintf(stderr, "kernel_launch: unexpected shapes (n_in %d, out %d, ws %zu, need %zu)\n", n_in, out_size, ws_size, (size_t)WS_END); grid = -1; return; }
        int dev = 0, cus = 0;
        if (hipGetDevice(&dev) != hipSuccess || hipDeviceGetAttribute(&cus, hipDeviceAttributeMultiprocessorCount, dev) != hipSuccess) { grid = -1; return; }
        if (hipFuncSetAttribute((const void*)mega, hipFuncAttributeMaxDynamicSharedMemorySize, LDS_BYTES) != hipSuccess) { fprintf(stderr, "kernel_launch: hipFuncSetAttribute failed\n"); grid = -1; return; }
        int per_cu = 0;
        if (hipOccupancyMaxActiveBlocksPerMultiprocessor(&per_cu, (const void*)mega, NTHR, LDS_BYTES) != hipSuccess || per_cu < 1) { fprintf(stderr, "kernel_launch: occupancy query says %d blocks per CU\n", per_cu); }
        (void)hipGetLastError();
        grid = cus;
    }
    if (grid < 0) return;
    (void)hipMemsetAsync((char*)d_ws + WS_CTL, 0, 65536, stream);
    Params p; memset(&p, 0, sizeof(p));
    for (int i = 0; i < N_IN; ++i) p.in[i] = (const float*)d_in[i];
    p.out = (float*)d_out; p.ws = (unsigned char*)d_ws;
    p.ph_lo = 0; p.ph_hi = NPHASE;
    hipLaunchKernelGGL(mega, dim3(grid), dim3(NTHR), LDS_BYTES, stream, p);
}
```

```cpp
#include <hip/hip_runtime.h>
#include <cstdio>
#include <cstring>
#include <cstdint>

typedef unsigned short bf16_t;
typedef short bf16x8 __attribute__((ext_vector_type(8)));
typedef short s16x4 __attribute__((ext_vector_type(4)));
typedef float f32x2 __attribute__((ext_vector_type(2)));
typedef float f32x4 __attribute__((ext_vector_type(4)));
typedef float f32x16 __attribute__((ext_vector_type(16)));
typedef unsigned u32x2 __attribute__((ext_vector_type(2)));
typedef unsigned u32x4 __attribute__((ext_vector_type(4)));
typedef __bf16 bf16x2_t __attribute__((ext_vector_type(2)));
typedef float f32x32 __attribute__((ext_vector_type(32)));
typedef unsigned u32x6 __attribute__((ext_vector_type(6)));
typedef unsigned u32x16 __attribute__((ext_vector_type(16)));
typedef __bf16 bf16x32_t __attribute__((ext_vector_type(32)));

#define DI __device__ __forceinline__

constexpr int NTHR = 512;
constexpr int DM = 2048;
constexpr int TP = 8192;
constexpr int TS = 32768;
constexpr int TOK = TP + TS;
constexpr int LP = 256, LS = 4096;
constexpr float NORM_EPS = 1e-6f;
constexpr float LOG2E = 1.4426950408889634f;

enum { I_XP = 0, I_XS, I_C, I_CNK, I_CNV, I_CDK, I_CDV, I_S5RE, I_S5IM, I_CCTX, I_MODW, I_MODB, I_NMIXG, I_NFFNG, I_EVWIN, I_EVWOUT, I_NAQG, I_NAKG, I_RPB,
       I_HYCW, I_HYCB, I_HYW1, I_HYB1, I_HYF1, I_HYW2, I_HYB2, I_HYF2, I_HYW3, I_HYDEC, I_HYBIAS, I_ODWIN, I_ODWOUT, I_S5LRE, I_S5LIM, I_S5LDT, I_S5BRE, I_S5BIM,
       I_S5CRE, I_S5CIM, I_S5D, I_GLUW, I_GLUB, I_DQG, I_DKG, I_LQ1, I_LK1, I_LQ2, I_LK2, I_SUBG, I_PWQ, I_PKEYS, I_PU, I_PV, N_IN };

constexpr size_t O_Y = 0;
constexpr size_t O_NAK = 83886080, O_NAV = 92274688, O_DK = 100663296, O_DV = 109051904, O_SR = 117440512, O_SI = 117702656, O_END = 117964800;

constexpr size_t al256(size_t x) { return (x + 255) & ~(size_t)255; }
constexpr size_t WS_CTL = 0;
constexpr size_t WS_MODP = 65536;
constexpr size_t WS_MOD = WS_MODP + (size_t)2 * 16 * 9 * 12288 * 4;
constexpr size_t WS_WEVIN = al256(WS_MOD + (size_t)2 * 9 * 12288 * 4);
constexpr size_t WS_WEVOUT = WS_WEVIN + (size_t)6144 * 2048 * 2;
constexpr size_t WS_WODIN = WS_WEVOUT + (size_t)2048 * 2048 * 2;
constexpr size_t WS_WODOUT = WS_WODIN + (size_t)4096 * 2048 * 2;
constexpr size_t WS_WPQ = WS_WODOUT + (size_t)2048 * 2048 * 2;
constexpr size_t WS_WGLU = WS_WPQ + (size_t)2 * 2048 * 2048 * 2;
constexpr size_t WS_PKEYS = WS_WGLU + (size_t)1024 * 1024 * 2;
constexpr size_t WS_CNK = WS_PKEYS + (size_t)2 * 8 * 2 * 128 * 128 * 2;
constexpr size_t WS_CNVT = WS_CNK + (size_t)8 * 256 * 1024 * 2;
constexpr size_t WS_CDK = WS_CNVT + (size_t)8 * 256 * 1024 * 2;
constexpr size_t WS_CDVT = WS_CDK + (size_t)8 * 256 * 1024 * 2;
constexpr size_t WS_S5A = WS_CDVT + (size_t)8 * 256 * 1024 * 2;
constexpr size_t WS_S5BB = WS_S5A + (size_t)128 * 64 * 2 * 4;
constexpr size_t WS_S5CC = WS_S5BB + (size_t)128 * 128 * 16 * 2;
constexpr int KRL_S = 8208, KRL_P = 528;
constexpr size_t WS_KRS = WS_S5CC + (size_t)128 * 16 * 128 * 2;
constexpr size_t WS_KRP = al256(WS_KRS + (size_t)2 * 1024 * KRL_S * 2);
constexpr size_t WS_TBLU = al256(WS_KRP + (size_t)2 * 1024 * KRL_P * 2);
constexpr size_t WS_TBLV = WS_TBLU + (size_t)16384 * 2048 * 2;
constexpr size_t WS_HM = WS_TBLV + (size_t)16384 * 2048 * 2;
constexpr size_t WS_RA = WS_HM + (size_t)TOK * 2048 * 2;
constexpr size_t WS_RB = WS_RA + (size_t)TOK * 4096 * 2;
constexpr size_t WS_VT = WS_RB + (size_t)3072 * TOK * 2;
constexpr size_t WS_SC = WS_VT + (size_t)TOK * 1024 * 2;
constexpr size_t WS_END = WS_SC + (size_t)4 * 16384 * 4;
constexpr size_t RA_Q = 0;
constexpr size_t RA_SELI = (size_t)TOK * 2048 * 2;
constexpr size_t RA_SELW = RA_SELI + (size_t)TOK * 128 * 4;
constexpr size_t RA_CF = RA_SELW + (size_t)TOK * 128 * 4;
constexpr size_t RA_ZC = (size_t)TOK * 2048 * 2;
constexpr size_t RB_YF = 0, RB_YB = (size_t)TOK * 1024 * 2, RB_Y = (size_t)2 * TOK * 1024 * 2;
constexpr size_t VT_S = (size_t)TP * 1024 * 2;

constexpr int LDS_BYTES = 147456;

struct Params { const float* in[N_IN]; float* out; unsigned char* ws; int ph_lo, ph_hi; };

DI float bf2f(bf16_t b) { return __uint_as_float(((unsigned)b) << 16); }
DI float bflo(unsigned w) { return __uint_as_float(w << 16); }
DI float bfhi(unsigned w) { return __uint_as_float(w & 0xffff0000u); }
DI unsigned pk2(float a, float b) { f32x2 v = {a, b}; return __builtin_bit_cast(unsigned, __builtin_convertvector(v, bf16x2_t)); }
DI float dot2bf(unsigned a, unsigned b, float c) { return __builtin_amdgcn_fdot2_f32_bf16(__builtin_bit_cast(bf16x2_t, a), __builtin_bit_cast(bf16x2_t, b), c, false); }
DI bf16_t f2bf(float a) { return (bf16_t)(pk2(a, 0.f) & 0xffffu); }
DI float dpp_xor1(float v) { return __builtin_bit_cast(float, __builtin_amdgcn_update_dpp(0, __builtin_bit_cast(int, v), 0xB1, 0xF, 0xF, true)); }
DI float dpp_xor2(float v) { return __builtin_bit_cast(float, __builtin_amdgcn_update_dpp(0, __builtin_bit_cast(int, v), 0x4E, 0xF, 0xF, true)); }
DI float wave_sum(float v) {
    v += dpp_xor1(v); v += dpp_xor2(v);
    v += __builtin_bit_cast(float, __builtin_amdgcn_update_dpp(0, __builtin_bit_cast(int, v), 0x141, 0xF, 0xF, true));
    v += __builtin_bit_cast(float, __builtin_amdgcn_update_dpp(0, __builtin_bit_cast(int, v), 0x140, 0xF, 0xF, true));
    v += __builtin_bit_cast(float, __builtin_amdgcn_update_dpp(0, __builtin_bit_cast(int, v), 0x142, 0xA, 0xF, false));
    v += __builtin_bit_cast(float, __builtin_amdgcn_update_dpp(0, __builtin_bit_cast(int, v), 0x143, 0xC, 0xF, false));
    return __builtin_bit_cast(float, __builtin_amdgcn_readlane(__builtin_bit_cast(int, v), 63));
}
DI float gelu_tanh(float x) {
    const float u = 0.7978845608028654f * (x + 0.044715f * x * x * x);
    const float e = __expf(2.f * u);
    const float t = 1.f - 2.f / (e + 1.f);
    return 0.5f * x * (1.f + t);
}
DI float wave_max(float v) {
    v = fmaxf(v, dpp_xor1(v)); v = fmaxf(v, dpp_xor2(v));
    v = fmaxf(v, __builtin_bit_cast(float, __builtin_amdgcn_update_dpp(0, __builtin_bit_cast(int, v), 0x141, 0xF, 0xF, true)));
    v = fmaxf(v, __builtin_bit_cast(float, __builtin_amdgcn_update_dpp(0, __builtin_bit_cast(int, v), 0x140, 0xF, 0xF, true)));
    v = fmaxf(v, __builtin_bit_cast(float, __builtin_amdgcn_update_dpp(0, __builtin_bit_cast(int, v), 0x142, 0xA, 0xF, false)));
    v = fmaxf(v, __builtin_bit_cast(float, __builtin_amdgcn_update_dpp(0, __builtin_bit_cast(int, v), 0x143, 0xC, 0xF, false)));
    return __builtin_bit_cast(float, __builtin_amdgcn_readlane(__builtin_bit_cast(int, v), 63));
}
DI f32x2 fp8x2_lo(unsigned w) { return __builtin_amdgcn_cvt_pk_f32_fp8((int)w, false); }
DI f32x2 fp8x2_hi(unsigned w) { return __builtin_amdgcn_cvt_pk_f32_fp8((int)w, true); }
DI unsigned pk_fp8x4(float a, float b, float c, float d) { int r = 0; r = __builtin_amdgcn_cvt_pk_fp8_f32(a, b, r, false); r = __builtin_amdgcn_cvt_pk_fp8_f32(c, d, r, true); return (unsigned)r; }
DI int lane_id() { return (int)__builtin_amdgcn_mbcnt_hi(~0u, __builtin_amdgcn_mbcnt_lo(~0u, 0u)); }
DI int cond_of(int T) { return T < TP ? 0 : 1 + ((T - TP) >> 12); }
#define XB_TMO      128
#define XB_XCNT(j)  (256  + 64 * (j))
#define XB_XSUB(j)  (1280 + 64 * (j))
#define XB_XGEN(j)  (2304 + 64 * (j))
#define XB_TOP      3328
#define XB_TOPGEN   3392
#define XCD_BAR_WORDS 3456
#define XB_SPIN_CAP (1u << 26)
#define LAS __attribute__((address_space(3)))

__device__ __forceinline__ unsigned xb_ld(unsigned* p)              { return __hip_atomic_load(p, __ATOMIC_RELAXED, __HIP_MEMORY_SCOPE_AGENT); }
__device__ __forceinline__ unsigned xb_add(unsigned* p, unsigned v) { return __hip_atomic_fetch_add(p, v, __ATOMIC_RELAXED, __HIP_MEMORY_SCOPE_AGENT); }
__device__ __forceinline__ unsigned xb_xcc_id() { return (unsigned)__builtin_amdgcn_s_getreg((3 << 11) | 20) & 0xFu; }
#define XB_SPIN(cond, bar) do { unsigned _sp = 0; while (cond) { __builtin_amdgcn_s_sleep(1); \
    if ((++_sp & 255u) == 0u) { if (xb_ld(&(bar)[XB_TMO])) break; if (_sp > XB_SPIN_CAP) { atomicAdd(&(bar)[XB_TMO], 1u); break; } } } } while (0)

struct XcdBarrier {
    unsigned* bar; unsigned x;
    volatile LAS unsigned* st;
};

__device__ __forceinline__ XcdBarrier xcd_barrier_post(unsigned* bar, volatile LAS unsigned* st) {
    XcdBarrier b; b.bar = bar; b.x = xb_xcc_id(); b.st = st;
    if (threadIdx.x == 0) (void)xb_add(&bar[XB_XCNT(b.x)], 1u);
    return b;
}
__device__ __forceinline__ void xcd_barrier_complete(unsigned* bar, unsigned x, unsigned& nloc, unsigned& nx) {
    const unsigned G = gridDim.x * gridDim.y * gridDim.z;
    unsigned sum, cnt, mine, sp = 0u;
    for (;;) {
        sum = 0u; cnt = 0u; mine = 0u;
#pragma unroll
        for (unsigned j = 0; j < 16; ++j) { const unsigned c = xb_ld(&bar[XB_XCNT(j)]); sum += c; cnt += (c > 0u) ? 1u : 0u; mine = (j == x) ? c : mine; }
        if (sum == G) break;
        __builtin_amdgcn_s_sleep(1);
        if ((++sp & 255u) == 0u) { if (xb_ld(&bar[XB_TMO])) break; if (sp > XB_SPIN_CAP) { atomicAdd(&bar[XB_TMO], 1u); break; } }
    }
    nloc = mine > 0u ? mine : 1u; nx = cnt > 0u ? cnt : 1u;
}

__device__ __forceinline__ void xcd_barrier(const XcdBarrier& b) {
    asm volatile("s_waitcnt vmcnt(0)" ::: "memory");
    __syncthreads();
    if (threadIdx.x == 0) {
        unsigned* bar = b.bar;
        __builtin_amdgcn_s_waitcnt(0);
        unsigned nloc = b.st[0], nx = b.st[1];
        if (nloc == 0u) { xcd_barrier_complete(bar, b.x, nloc, nx); b.st[0] = nloc; b.st[1] = nx; }
        const unsigned old = xb_add(&bar[XB_XSUB(b.x)], 1u);
        const unsigned gen = old / nloc;
        if (old + 1u == (gen + 1u) * nloc) {
            __builtin_amdgcn_fence(__ATOMIC_RELEASE, "agent");
            asm volatile("s_waitcnt vmcnt(0)" ::: "memory");
            const unsigned og = xb_add(&bar[XB_TOP], 1u);
            const unsigned tg = og / nx;
            if (og + 1u == (tg + 1u) * nx) xb_add(&bar[XB_TOPGEN], 1u);
            else XB_SPIN(xb_ld(&bar[XB_TOPGEN]) == tg, bar);
            __builtin_amdgcn_fence(__ATOMIC_ACQUIRE, "agent");
            xb_add(&bar[XB_XGEN(b.x)], 1u);
            asm volatile("s_waitcnt vmcnt(0)" ::: "memory");
        } else {
            XB_SPIN(xb_ld(&bar[XB_XGEN(b.x)]) == gen, bar);
            __builtin_amdgcn_fence(__ATOMIC_ACQUIRE, "agent");
            asm volatile("s_waitcnt vmcnt(0)" ::: "memory");
        }
    }
    __syncthreads();
}
namespace pg8 {
#define PG8_LAS __attribute__((address_space(3)))
typedef unsigned short bf16_t;
typedef short bf16x8 __attribute__((ext_vector_type(8)));
typedef float f32x4 __attribute__((ext_vector_type(4)));
typedef unsigned u32x4 __attribute__((ext_vector_type(4)));
constexpr int BM = 256, BK = 64, HALF = 128, HTB = HALF * BK * 2  , STAGE_BYTES = 8 * HTB, NXCD = 8, WGM = 8;

__host__ __device__ __forceinline__ int lds_byte(int r, int c) { const int st = (r >> 4) * 2 + (c >> 5), rr = r & 15, cc = c & 31, ob = rr * 64 + cc * 2; return st * 1024 + (ob ^ (((ob >> 9) & 1) << 5)); }
__host__ __device__ __forceinline__ void stage_rc(int b, int& R, int& C) { const int st = b / 1024, sb = b % 1024, swz = sb ^ (((sb >> 9) & 1) << 5); R = (st >> 1) * 16 + swz / 64; C = (st & 1) * 32 + (swz % 64) / 2; }
__host__ __device__ __forceinline__ int perm32(int rho) { const int n = rho >> 4, i = rho & 15; return 8 * (i >> 2) + 4 * n + (i & 3); }

struct Unit { int pm, pn; };
struct Gemm { const bf16_t* A; const bf16_t* Bt; int M, N, K; };

struct StaticOrder {
    int nM, nN, nwg, G, c;
    __host__ __device__ void init(int M, int N, int G_, int c_) { nM = M / BM; nN = N / BM; nwg = nM * nN; G = G_; c = c_; }
    __host__ __device__ bool next(int i, Unit& u) const {
        const long L = (long)i * G + c; if (L >= nwg) return false;
        int wgid = (int)L; { const int q = nwg / NXCD, r = nwg % NXCD, xcd = wgid % NXCD, off = wgid / NXCD; wgid = (xcd < r ? xcd * (q + 1) : r * (q + 1) + (xcd - r) * q) + off; }
        const int nig = WGM * nN, gid = wgid / nig, fm = gid * WGM, gsz = (nM - fm) < WGM ? (nM - fm) : WGM;
        u.pm = fm + ((wgid % nig) % gsz); u.pn = (wgid % nig) / gsz; return true;
    }
    __device__ __forceinline__ void a_ready(const Unit&) const {}
    __device__ __forceinline__ void done(const Unit&) const {}
};
__device__ __forceinline__ unsigned cvt_pk_bf16(float lo, float hi) { unsigned r; asm volatile("v_cvt_pk_bf16_f32 %0, %1, %2" : "=v"(r) : "v"(lo), "v"(hi)); return r; }
template <class Epi, class Sched, bool STAMP = false>
__device__ __forceinline__ void gemm_phase(PG8_LAS unsigned char* lds, const Gemm g, const Sched& S, const Epi& E, unsigned long long* stamps) {
    const int tid = threadIdx.x, wid = __builtin_amdgcn_readfirstlane(tid >> 6), lane = tid & 63, wr = wid >> 2, wc = wid & 3, fr = lane & 15, fq = lane >> 4;
    const int K = g.K, nt = K / BK;
    int ts_lo = 0, ts_hi = 0, nts = 0; const unsigned long long rt_entry = STAMP ? (unsigned long long)wall_clock64() : 0ull;
#define PG8_STAMP() do { if (STAMP && wid == 0 && nts < 64) { const unsigned long long _c = (unsigned long long)clock64(); \
        ts_lo = (lane == nts) ? (int)(unsigned)_c : ts_lo; ts_hi = (lane == nts) ? (int)(unsigned)(_c >> 32) : ts_hi; ++nts; } } while (0)
    PG8_STAMP();
    unsigned voffA[2], voffB[2];
#pragma unroll
    for (int i = 0; i < 2; ++i) { int R, C; stage_rc(tid * 16 + i * 8192, R, C); const int Rb = Epi::PERM ? ((R & ~31) + perm32(R & 31)) : R;
        voffA[i] = (unsigned)(R * K + C) * 2u; voffB[i] = (unsigned)(Rb * K + C) * 2u; }
    const size_t kstep = (size_t)(BK * 2);
    const size_t hstep = (size_t)HALF * K * 2;
    const size_t tstep = 2 * hstep;
    const unsigned ldsw = (unsigned)wid * 1024u;
    const int aoff = lds_byte(wr * 64 + fr, fq * 8), boff = lds_byte(wc * 32 + fr, fq * 8);
#define PG8_SA(b, h) (((b) * 2 + (h)) * HTB)
#define PG8_SB(b, h) ((4 + (b) * 2 + (h)) * HTB)
#define PG8_STAGE(bufoff, gbase, voff) do { _Pragma("unroll") for (int _i = 0; _i < 2; ++_i) \
        __builtin_amdgcn_global_load_lds((const unsigned*)((const char*)(gbase) + (voff)[_i]), (PG8_LAS unsigned*)(lds + (bufoff) + ldsw + _i * 8192), 16, 0, 0); } while (0)
#define PG8_LDA(dst, b, h) do { _Pragma("unroll") for (int m = 0; m < 4; ++m) _Pragma("unroll") for (int k = 0; k < 2; ++k) dst[m][k] = *(const PG8_LAS bf16x8*)(lds + PG8_SA(b, h) + aoff + m * 2048 + k * 1024); } while (0)
#define PG8_LDB(dst, b, h) do { _Pragma("unroll") for (int n = 0; n < 2; ++n) _Pragma("unroll") for (int k = 0; k < 2; ++k) dst[n][k] = *(const PG8_LAS bf16x8*)(lds + PG8_SB(b, h) + boff + n * 2048 + k * 1024); } while (0)
#define PG8_MMA(ai, bj, At, Bt) do { __builtin_amdgcn_s_setprio(1); _Pragma("unroll") for (int m = 0; m < 4; ++m) _Pragma("unroll") for (int n = 0; n < 2; ++n) _Pragma("unroll") for (int k = 0; k < 2; ++k) \
        acc[ai][bj][m][n] = __builtin_amdgcn_mfma_f32_16x16x32_bf16(Bt[n][k], At[m][k], acc[ai][bj][m][n], 0, 0, 0); __builtin_amdgcn_s_setprio(0); } while (0)
#define PG8_WAIT_V(n) asm volatile("s_waitcnt vmcnt(" #n ")" ::: "memory")
#define PG8_WAIT_L(n) asm volatile("s_waitcnt lgkmcnt(" #n ")" ::: "memory")
#define PG8_BAR __builtin_amdgcn_s_barrier()
#define PG8_SCHED __builtin_amdgcn_sched_barrier(0)
    Unit cur, nxt; int ui = 0;
    if (!S.next(0, cur)) return;
    f32x4 acc[2][2][4][2];
#pragma unroll
    for (int a = 0; a < 2; ++a)
#pragma unroll
        for (int b = 0; b < 2; ++b)
#pragma unroll
            for (int m = 0; m < 4; ++m)
#pragma unroll
                for (int n = 0; n < 2; ++n) acc[a][b][m][n] = (f32x4){0.f, 0.f, 0.f, 0.f};
    bf16x8 At[4][2], B0[2][2], B1[2][2];
    const char* cA = (const char*)g.A + (size_t)cur.pm * tstep; const char* cB = (const char*)g.Bt + (size_t)cur.pn * tstep;
    S.a_ready(cur);
    PG8_STAGE(PG8_SB(0, 0), cB, voffB); PG8_STAGE(PG8_SA(0, 0), cA, voffA); PG8_STAGE(PG8_SB(0, 1), cB + hstep, voffB); PG8_STAGE(PG8_SA(0, 1), cA + hstep, voffA);
    if (wr == 1) PG8_BAR;
    PG8_WAIT_V(4); PG8_BAR;
    PG8_STAGE(PG8_SB(1, 0), cB + kstep, voffB); PG8_STAGE(PG8_SA(1, 0), cA + kstep, voffA); PG8_STAGE(PG8_SB(1, 1), cB + hstep + kstep, voffB);
    PG8_WAIT_V(6); PG8_BAR;
    PG8_STAMP();
    for (;;) {
        const bool has_next = S.next(ui + 1, nxt);
        const char* nA = has_next ? (const char*)g.A + (size_t)nxt.pm * tstep : cA; const char* nB = has_next ? (const char*)g.Bt + (size_t)nxt.pn * tstep : cB;
        for (int t = 0; t < nt; t += 2) {
            const bool last = (t == nt - 2);
            const char* a1 = cA + (size_t)(t + 1) * kstep;
            const char* a2 = last ? nA : cA + (size_t)(t + 2) * kstep; const char* b2 = last ? nB : cB + (size_t)(t + 2) * kstep;
            const char* a3 = a2 + kstep; const char* b3 = b2 + kstep;
            if (last && has_next) S.a_ready(nxt);
            PG8_LDB(B0, 0, 0); PG8_SCHED; PG8_LDA(At, 0, 0); PG8_STAGE(PG8_SA(1, 1), a1 + hstep, voffA);
            PG8_WAIT_L(8); PG8_BAR; PG8_WAIT_L(0); PG8_MMA(0, 0, At, B0); PG8_BAR; PG8_SCHED;
            PG8_LDB(B1, 0, 1); PG8_STAGE(PG8_SB(0, 0), b2, voffB);
            PG8_BAR; PG8_WAIT_L(0); PG8_MMA(0, 1, At, B1); PG8_BAR;
            PG8_LDA(At, 0, 1); PG8_STAGE(PG8_SA(0, 0), a2, voffA);
            PG8_BAR; PG8_WAIT_L(0); PG8_MMA(1, 0, At, B0); PG8_BAR; PG8_SCHED;
            PG8_STAGE(PG8_SB(0, 1), b2 + hstep, voffB);
            PG8_WAIT_V(6); PG8_BAR; PG8_MMA(1, 1, At, B1); PG8_BAR;
            PG8_LDB(B0, 1, 0); PG8_SCHED; PG8_LDA(At, 1, 0); PG8_STAGE(PG8_SA(0, 1), a2 + hstep, voffA);
            PG8_WAIT_L(8); PG8_BAR; PG8_WAIT_L(0); PG8_MMA(0, 0, At, B0); PG8_BAR; PG8_SCHED;
            PG8_LDB(B1, 1, 1); PG8_STAGE(PG8_SB(1, 0), b3, voffB);
            PG8_BAR; PG8_WAIT_L(0); PG8_MMA(0, 1, At, B1); PG8_BAR;
            PG8_LDA(At, 1, 1); PG8_STAGE(PG8_SA(1, 0), a3, voffA);
            PG8_BAR; PG8_WAIT_L(0); PG8_MMA(1, 0, At, B0); PG8_BAR; PG8_SCHED;
            PG8_STAGE(PG8_SB(1, 1), b3 + hstep, voffB);
            PG8_WAIT_V(6); PG8_BAR; PG8_MMA(1, 1, At, B1); PG8_BAR;
        }
        PG8_STAMP();
        if constexpr (!Epi::AFTER_DRAIN) { E(acc, cur, wr, wc, fr, fq); S.done(cur); }
        PG8_STAMP();
        if (!has_next) break;
#pragma unroll
        for (int a = 0; a < 2; ++a)
#pragma unroll
            for (int b = 0; b < 2; ++b)
#pragma unroll
                for (int m = 0; m < 4; ++m)
#pragma unroll
                    for (int n = 0; n < 2; ++n) acc[a][b][m][n] = (f32x4){0.f, 0.f, 0.f, 0.f};
        cur = nxt; cA = nA; cB = nB; ++ui;
    }
    PG8_WAIT_V(0);
    if (wr == 0) PG8_BAR;
    PG8_BAR;
    if constexpr (Epi::AFTER_DRAIN) { E.fused(acc, cur, wr, wc, fr, fq, lds, wid, lane); S.done(cur); }
    PG8_STAMP();
    if (STAMP && wid == 0) { stamps[lane] = lane < nts ? (((unsigned long long)(unsigned)ts_hi << 32) | (unsigned)ts_lo) : 0ull;
        if (lane == 62) stamps[62] = rt_entry; if (lane == 63) stamps[63] = (unsigned long long)wall_clock64(); }
#undef PG8_STAMP
#undef PG8_SA
#undef PG8_SB
#undef PG8_STAGE
#undef PG8_LDA
#undef PG8_LDB
#undef PG8_MMA
#undef PG8_WAIT_V
#undef PG8_WAIT_L
#undef PG8_BAR
#undef PG8_SCHED
}
}
struct Ctx {
    LAS unsigned char* lds; int tid, lane, wave, G, bid;
};

DI void cvt_rows(const Ctx& F, const float* src, bf16_t* dst, size_t n) {
    const size_t n8 = n >> 3;
    for (size_t i = (size_t)F.bid * NTHR + F.tid; i < n8; i += (size_t)F.G * NTHR) {
        const f32x4 a = *(const f32x4*)(src + i * 8), b = *(const f32x4*)(src + i * 8 + 4);
        u32x4 w; w.x = pk2(a.x, a.y); w.y = pk2(a.z, a.w); w.z = pk2(b.x, b.y); w.w = pk2(b.z, b.w);
        *(u32x4*)(dst + i * 8) = w;
    }
}

constexpr int TR_S = 68;
DI void tr_tile_out(const Ctx& F, bf16_t* dst, size_t ldd, const LAS bf16_t* tile) {
    const int n = F.tid >> 3, kc = (F.tid & 7) * 8;
    const LAS bf16_t* t = tile + kc * TR_S + n;
    u32x4 v;
    v.x = (unsigned)t[0] | ((unsigned)t[TR_S] << 16); v.y = (unsigned)t[2 * TR_S] | ((unsigned)t[3 * TR_S] << 16);
    v.z = (unsigned)t[4 * TR_S] | ((unsigned)t[5 * TR_S] << 16); v.w = (unsigned)t[6 * TR_S] | ((unsigned)t[7 * TR_S] << 16);
    *(u32x4*)(dst + (size_t)n * ldd + kc) = v;
}
DI void tr_tile_f32(const Ctx& F, const float* src, size_t lds_, bf16_t* dst, size_t ldd, LAS bf16_t* tile) {
#pragma unroll
    for (int j = 0; j < 2; ++j) {
        const int id = F.tid + NTHR * j, kr = id >> 4, nc = (id & 15) * 4;
        const f32x4 v = *(const f32x4*)(src + (size_t)kr * lds_ + nc);
        *(LAS u32x2*)(tile + kr * TR_S + nc) = (u32x2){pk2(v.x, v.y), pk2(v.z, v.w)};
    }
    __syncthreads();
    tr_tile_out(F, dst, ldd, tile);
    __syncthreads();
}
DI void tr_tile_bf16(const Ctx& F, const bf16_t* src, size_t lds_, bf16_t* dst, size_t ldd, LAS bf16_t* tile) {
    { const int kr = F.tid >> 3, nc = (F.tid & 7) * 8; const u32x4 v = *(const u32x4*)(src + (size_t)kr * lds_ + nc);
      *(LAS u32x2*)(tile + kr * TR_S + nc) = (u32x2){v.x, v.y}; *(LAS u32x2*)(tile + kr * TR_S + nc + 4) = (u32x2){v.z, v.w}; }
    __syncthreads();
    tr_tile_out(F, dst, ldd, tile);
    __syncthreads();
}
DI void transpose_weight(const Ctx& F, const float* W, int K, int N, bf16_t* Wt) {
    const int tk = K / 64, tn = N / 64;
    for (int t = F.bid; t < tk * tn; t += F.G) {
        const int k0 = (t / tn) * 64, n0 = (t % tn) * 64;
        tr_tile_f32(F, W + (size_t)k0 * N + n0, (size_t)N, Wt + (size_t)n0 * K + k0, (size_t)K, (LAS bf16_t*)F.lds);
    }
}
DI void transpose_cache_v(const Ctx& F, const float* V, bf16_t* VT) {
    for (int t = F.bid; t < 64 * 8; t += F.G) {
        const int bh = t >> 3, sub = t & 7, k0 = (sub >> 1) * 64, d0 = (sub & 1) * 64, b = bh >> 3, h = bh & 7;
        tr_tile_f32(F, V + ((size_t)b * 256 + k0) * 1024 + h * 128 + d0, 1024, VT + ((size_t)bh * 128 + d0) * 256 + k0, 256, (LAS bf16_t*)F.lds);
    }
}

DI void adaln_partials(const Ctx& F, const Params& P) {
    LAS float* s = (LAS float*)F.lds;
    const float* modw = P.in[I_MODW]; const float* cv = P.in[I_C]; const float* cctx = P.in[I_CCTX];
    float* modp = (float*)(P.ws + WS_MODP);
    for (int it = F.bid; it < 192; it += F.G) {
        const int i = it / 96, r = it % 96, ks = r / 6, cg = r % 6;
        __syncthreads();
        for (int e = F.tid; e < 9 * 128; e += NTHR) { const int j = e >> 7, k = e & 127; const float c = (j == 0) ? cctx[ks * 128 + k] : cv[(j - 1) * 2048 + ks * 128 + k]; s[e] = c / (1.f + __expf(-c)); }
        __syncthreads();
        f32x4 acc[9];
#pragma unroll
        for (int j = 0; j < 9; ++j) acc[j] = (f32x4){0.f, 0.f, 0.f, 0.f};
        const float* w = modw + ((size_t)i * 2048 + ks * 128) * 12288 + cg * 2048 + F.tid * 4;
#pragma unroll 8
        for (int k = 0; k < 128; ++k) {
            const f32x4 w4 = *(const f32x4*)(w + (size_t)k * 12288);
#pragma unroll
            for (int j = 0; j < 9; ++j) acc[j] += w4 * s[j * 128 + k];
        }
#pragma unroll
        for (int j = 0; j < 9; ++j) *(f32x4*)(modp + ((size_t)(i * 16 + ks) * 9 + j) * 12288 + cg * 2048 + F.tid * 4) = acc[j];
    }
    __syncthreads();
}
DI void adaln_reduce(const Ctx& F, const Params& P) {
    const float* modp = (const float*)(P.ws + WS_MODP); float* mod = (float*)(P.ws + WS_MOD); const float* modb = P.in[I_MODB];
    for (int e = F.bid * NTHR + F.tid; e < 2 * 9 * 12288; e += F.G * NTHR) {
        const int i = e / (9 * 12288), r = e % (9 * 12288), j = r / 12288, n = r % 12288;
        float a = modb[i * 12288 + n];
#pragma unroll
        for (int ks = 0; ks < 16; ++ks) a += modp[((size_t)(i * 16 + ks) * 9 + j) * 12288 + n];
        mod[e] = a;
    }
}

DI void hyena_filters(const Ctx& F, const Params& P) {
    LAS float* z = (LAS float*)F.lds;
    LAS float* h1 = z + 320;
    LAS float* h2 = h1 + 576;
    const float* w1 = P.in[I_HYW1]; const float* b1 = P.in[I_HYB1]; const float* f1 = P.in[I_HYF1];
    const float* w2 = P.in[I_HYW2]; const float* b2 = P.in[I_HYB2]; const float* f2 = P.in[I_HYF2];
    const float* w3 = P.in[I_HYW3]; const float* dec = P.in[I_HYDEC];
    for (int it = F.bid; it < 544; it += F.G) {
        const bool smp = it < 512; const int L = smp ? LS : LP, p0 = (smp ? it : it - 512) * 8, RL = smp ? KRL_S : KRL_P;
        bf16_t* KR = (bf16_t*)(P.ws + (smp ? WS_KRS : WS_KRP));
        __syncthreads();
        if (F.tid < 9 * 33) {
            const int ps = F.tid / 33, k = F.tid % 33, i = p0 + ps;
            const float t = (float)i / (float)(L - 1), wang = 6.283185307179586f * (float)i / (float)L;
            float val;
            if (k == 0) val = t;
            else { const int f = (k - 1) & 15; const float fr = 1e-4f + (float)f * ((15.0f - 1e-4f) / 15.0f); val = (k <= 16) ? cosf(fr * wang) : -sinf(fr * wang); }
            z[F.tid] = val;
        }
        __syncthreads();
        for (int e = F.tid; e < 9 * 64; e += NTHR) { const int ps = e >> 6, j = e & 63; float a = b1[j];
            for (int k = 0; k < 33; ++k) a += z[ps * 33 + k] * w1[k * 64 + j];
            h1[e] = sinf(f1[j] * a); }
        __syncthreads();
        for (int e = F.tid; e < 9 * 64; e += NTHR) { const int ps = e >> 6, j = e & 63; float a = b2[j];
            for (int k = 0; k < 64; ++k) a += h1[ps * 64 + k] * w2[k * 64 + j];
            h2[e] = sinf(f2[j] * a); }
        __syncthreads();
#pragma unroll 1
        for (int qh = 0; qh < 2; ++qh) {
            float acc[9][4];
#pragma unroll
            for (int ps = 0; ps < 9; ++ps)
#pragma unroll
                for (int q = 0; q < 4; ++q) acc[ps][q] = 0.f;
#pragma unroll 2
            for (int k = 0; k < 64; ++k) {
                float w[4];
#pragma unroll
                for (int q = 0; q < 4; ++q) w[q] = w3[k * 4096 + F.tid + NTHR * (qh * 4 + q)];
#pragma unroll
                for (int ps = 0; ps < 9; ++ps) { const float hv = h2[ps * 64 + k];
#pragma unroll
                    for (int q = 0; q < 4; ++q) acc[ps][q] += hv * w[q]; }
            }
#pragma unroll
            for (int q = 0; q < 4; ++q) {
                const int n = F.tid + NTHR * (qh * 4 + q), o = (n >> 10) & 1, c = n & 1023;
                const float dc = fabsf(dec[n]);
                bf16_t* row = KR + (size_t)(o * 1024 + c) * RL;
                float v[9];
#pragma unroll
                for (int ps = 0; ps < 9; ++ps) { const int i = p0 + ps; v[ps] = (i < L) ? acc[ps][q] * __expf(-((float)i / (float)(L - 1)) * dc) : 0.f; }
                if (qh == 0) {
                    u32x4 wv; wv.x = pk2(v[8], v[7]); wv.y = pk2(v[6], v[5]); wv.z = pk2(v[4], v[3]); wv.w = pk2(v[2], v[1]);
                    *(u32x4*)(row + (L - p0 - 8)) = wv;
                    if (p0 == 0) row[L] = f2bf(v[0]);
                } else if (p0 > 0) {
                    u32x4 wv; wv.x = pk2(v[0], v[1]); wv.y = pk2(v[2], v[3]); wv.z = pk2(v[4], v[5]); wv.w = pk2(v[6], v[7]);
                    *(u32x4*)(row + (L + p0)) = wv;
                } else {
#pragma unroll
                    for (int ps = 1; ps < 8; ++ps) row[L + ps] = f2bf(v[ps]);
                }
            }
        }
    }
    __syncthreads();
    for (int e = F.bid * NTHR + F.tid; e < 2 * 2048; e += F.G * NTHR) {
        const bool smp = e < 2048; const int r = e & 2047, L = smp ? LS : LP, RL = smp ? KRL_S : KRL_P;
        bf16_t* row = (bf16_t*)(P.ws + (smp ? WS_KRS : WS_KRP)) + (size_t)r * RL;
        for (int x = 2 * L; x < RL; ++x) row[x] = 0;
    }
}

DI void s5_consts(const Ctx& F, const Params& P) {
    float* S5A = (float*)(P.ws + WS_S5A); bf16_t* BB = (bf16_t*)(P.ws + WS_S5BB); bf16_t* CC = (bf16_t*)(P.ws + WS_S5CC);
    const float* lre = P.in[I_S5LRE]; const float* lim = P.in[I_S5LIM]; const float* ldt = P.in[I_S5LDT];
    const float* bre = P.in[I_S5BRE]; const float* bim = P.in[I_S5BIM]; const float* cre = P.in[I_S5CRE]; const float* cim = P.in[I_S5CIM];
    for (int e = F.bid * NTHR + F.tid; e < 8192; e += F.G * NTHR) {
        const int dg = e >> 6, n = e & 63;
        const float dt = expf(ldt[dg]), lr = lre[e], li = lim[e];
        const float mag = expf(lr * dt), ar = mag * cosf(li * dt), ai = mag * sinf(li * dt), den = lr * lr + li * li;
        const float cr = ((ar - 1.f) * lr + ai * li) / den, ci = (ai * lr - (ar - 1.f) * li) / den;
        S5A[e * 2] = ar; S5A[e * 2 + 1] = ai;
#pragma unroll
        for (int p = 0; p < 16; ++p) {
            const float br = bre[(size_t)e * 16 + p], bi = bim[(size_t)e * 16 + p];
            BB[((size_t)dg * 128 + n) * 16 + p] = f2bf(cr * br - ci * bi);
            BB[((size_t)dg * 128 + 64 + n) * 16 + p] = f2bf(cr * bi + ci * br);
            CC[((size_t)dg * 16 + p) * 128 + n] = f2bf(cre[((size_t)dg * 16 + p) * 64 + n]);
            CC[((size_t)dg * 16 + p) * 128 + 64 + n] = f2bf(-cim[((size_t)dg * 16 + p) * 64 + n]);
        }
    }
}

constexpr int PT_ROWB = 1536;
DI void cvt_table_fp6(const Ctx& F, const float* src, unsigned char* dst, float* scales, const int (&perm)[32]) {
    LAS float* scr = (LAS float*)(F.lds) + F.wave * 2048 + F.lane;
    for (int r = F.bid * 8 + F.wave; r < 16384; r += F.G * 8) {
        f32x4 v[8]; float m = 0.f;
#pragma unroll
        for (int j = 0; j < 8; ++j) { v[j] = *(const f32x4*)(src + (size_t)r * 2048 + F.lane * 32 + j * 4);
            m = fmaxf(m, fmaxf(fmaxf(fabsf(v[j].x), fabsf(v[j].y)), fmaxf(fabsf(v[j].z), fabsf(v[j].w)))); }
        m = wave_max(m);
        const float inv = (m > 0.f) ? 7.0f / m : 0.f, sc = (m > 0.f) ? m / 7.0f : 0.f;
#pragma unroll
        for (int j = 0; j < 8; ++j) { scr[perm[j * 4 + 0] * 64] = v[j].x * inv; scr[perm[j * 4 + 1] * 64] = v[j].y * inv; scr[perm[j * 4 + 2] * 64] = v[j].z * inv; scr[perm[j * 4 + 3] * 64] = v[j].w * inv; }
        asm volatile("" ::: "memory");
        f32x16 a, b;
#pragma unroll
        for (int i = 0; i < 16; ++i) { a[i] = scr[i * 64]; b[i] = scr[(16 + i) * 64]; }
        asm volatile("" ::: "memory");
        const u32x6 pk = __builtin_amdgcn_cvt_scalef32_2xpk16_fp6_f32(a, b, 1.0f);
        unsigned char* o = dst + (size_t)r * PT_ROWB;
        *(u32x4*)(o + F.lane * 16) = (u32x4){pk[0], pk[1], pk[2], pk[3]}; *(u32x2*)(o + 1024 + F.lane * 8) = (u32x2){pk[4], pk[5]};
        if (F.lane == 0) scales[r] = sc;
    }
}
DI void convert_peer_tables(const Ctx& F, const Params& P) {
    int perm[32];
    { f32x16 a, b;
#pragma unroll
      for (int j = 0; j < 16; ++j) { a[j] = 0.125f * (float)j; b[j] = (j < 8) ? 2.0f + 0.25f * (float)j : 4.0f + 0.5f * (float)(j - 8); }
      const u32x6 pk = __builtin_amdgcn_cvt_scalef32_2xpk16_fp6_f32(a, b, 1.0f);
      const f32x32 rt = __builtin_amdgcn_cvt_scalef32_pk32_f32_fp6(pk, 1.0f);
#pragma unroll
      for (int i = 0; i < 32; ++i) { const float x = rt[i]; const int o = (x < 2.0f) ? (int)(x * 8.0f + 0.5f) : ((x < 4.0f) ? 16 + (int)((x - 2.0f) * 4.0f + 0.5f) : 24 + (int)((x - 4.0f) * 2.0f + 0.5f)); perm[i] = min(max(o, 0), 31); } }
    float* SC = (float*)(P.ws + WS_SC);
    __syncthreads();
    for (int layer = 0; layer < 2; ++layer) {
        cvt_table_fp6(F, P.in[I_PU] + (size_t)layer * 16384 * 2048, P.ws + WS_TBLU + (size_t)layer * 16384 * PT_ROWB, SC + layer * 16384, perm);
        cvt_table_fp6(F, P.in[I_PV] + (size_t)layer * 16384 * 2048, P.ws + WS_TBLV + (size_t)layer * 16384 * PT_ROWB, SC + (2 + layer) * 16384, perm);
    }
    __syncthreads();
}

DI void prologue(const Ctx& F, const Params& P) {
    adaln_partials(F, P);
    transpose_weight(F, P.in[I_EVWIN], 2048, 6144, (bf16_t*)(P.ws + WS_WEVIN));
    transpose_weight(F, P.in[I_EVWOUT], 2048, 2048, (bf16_t*)(P.ws + WS_WEVOUT));
    transpose_weight(F, P.in[I_ODWIN], 2048, 4096, (bf16_t*)(P.ws + WS_WODIN));
    transpose_weight(F, P.in[I_ODWOUT], 2048, 2048, (bf16_t*)(P.ws + WS_WODOUT));
    transpose_weight(F, P.in[I_PWQ], 2048, 2048, (bf16_t*)(P.ws + WS_WPQ));
    transpose_weight(F, P.in[I_PWQ] + (size_t)2048 * 2048, 2048, 2048, (bf16_t*)(P.ws + WS_WPQ) + (size_t)2048 * 2048);
    transpose_weight(F, P.in[I_GLUW], 1024, 1024, (bf16_t*)(P.ws + WS_WGLU));
    cvt_rows(F, P.in[I_PKEYS], (bf16_t*)(P.ws + WS_PKEYS), (size_t)2 * 8 * 2 * 128 * 128);
    cvt_rows(F, P.in[I_CNK], (bf16_t*)(P.ws + WS_CNK), (size_t)8 * 256 * 1024);
    cvt_rows(F, P.in[I_CDK], (bf16_t*)(P.ws + WS_CDK), (size_t)8 * 256 * 1024);
    transpose_cache_v(F, P.in[I_CNV], (bf16_t*)(P.ws + WS_CNVT));
    transpose_cache_v(F, P.in[I_CDV], (bf16_t*)(P.ws + WS_CDVT));
    hyena_filters(F, P);
    s5_consts(F, P);
    convert_peer_tables(F, P);
}
DI void norm_phase(const Ctx& F, const float* xa, const float* xb, const float* gvec, const float* modl, int sidx, bf16_t* H) {
    for (int T = F.bid * 8 + F.wave; T < TOK; T += F.G * 8) {
        const float* xr = T < TP ? xa + (size_t)T * DM : xb + (size_t)(T - TP) * DM;
        f32x4 v[8]; float ss = 0.f;
#pragma unroll
        for (int j = 0; j < 8; ++j) { v[j] = *(const f32x4*)(xr + (j * 64 + F.lane) * 4); ss += v[j].x * v[j].x + v[j].y * v[j].y + v[j].z * v[j].z + v[j].w * v[j].w; }
        ss = wave_sum(ss);
        const float rstd = rsqrtf(ss * (1.f / DM) + NORM_EPS);
        const float* sh = modl + (size_t)(cond_of(T) * 6 + sidx) * DM; const float* sc = sh + DM;
#pragma unroll
        for (int j = 0; j < 8; ++j) {
            const int col = (j * 64 + F.lane) * 4;
            const f32x4 g4 = *(const f32x4*)(gvec + col), s4 = *(const f32x4*)(sc + col), h4 = *(const f32x4*)(sh + col);
            const f32x4 o = v[j] * rstd * g4 * (s4 + 1.f) + h4;
            u32x2 w; w.x = pk2(o.x, o.y); w.y = pk2(o.z, o.w);
            *(u32x2*)(H + (size_t)T * DM + col) = w;
        }
    }
}

struct EpiBf16 {
    static constexpr bool PERM = true, AFTER_DRAIN = false;
    bf16_t* O; int ldc;
    DI void operator()(const f32x4 (&acc)[2][2][4][2], const pg8::Unit& u, int wr, int wc, int fr, int fq) const {
        const int row0 = u.pm * 256 + wr * 64 + fr, col0 = u.pn * 256 + wc * 32 + 8 * fq;
#pragma unroll
        for (int ai = 0; ai < 2; ++ai)
#pragma unroll
            for (int m = 0; m < 4; ++m) { bf16_t* rowp = O + (size_t)(row0 + ai * 128 + m * 16) * ldc + col0;
#pragma unroll
                for (int bj = 0; bj < 2; ++bj) { const f32x4 v0 = acc[ai][bj][m][0], v1 = acc[ai][bj][m][1];
                    u32x4 w; w.x = pk2(v0[0], v0[1]); w.y = pk2(v0[2], v0[3]); w.z = pk2(v1[0], v1[1]); w.w = pk2(v1[2], v1[3]);
                    *(u32x4*)(rowp + bj * 128) = w; } }
    }
};
struct EpiResid {
    static constexpr bool PERM = false, AFTER_DRAIN = false;
    const float* xa; const float* xb; float* out; const float* modl; int gidx;
    DI void operator()(const f32x4 (&acc)[2][2][4][2], const pg8::Unit& u, int wr, int wc, int fr, int fq) const {
        const int row0 = u.pm * 256 + wr * 64 + fr, col0 = u.pn * 256 + wc * 32 + 4 * fq;
        const float* xbase = (u.pm < 32) ? xa : xb - (size_t)TP * DM;
        const float* gate = modl + (size_t)(cond_of(u.pm * 256) * 6 + gidx) * DM;
        f32x4 gv[2][2];
#pragma unroll
        for (int bj = 0; bj < 2; ++bj)
#pragma unroll
            for (int n = 0; n < 2; ++n) gv[bj][n] = *(const f32x4*)(gate + col0 + bj * 128 + n * 16);
#pragma unroll
        for (int ai = 0; ai < 2; ++ai)
#pragma unroll
            for (int m = 0; m < 4; ++m) { const size_t ro = (size_t)(row0 + ai * 128 + m * 16) * DM + col0;
#pragma unroll
                for (int bj = 0; bj < 2; ++bj)
#pragma unroll
                    for (int n = 0; n < 2; ++n) { const f32x4 x4 = *(const f32x4*)(xbase + ro + bj * 128 + n * 16);
                        *(f32x4*)(out + ro + bj * 128 + n * 16) = x4 + gv[bj][n] * acc[ai][bj][m][n]; } }
    }
};
struct EpiGlu {
    static constexpr bool PERM = true, AFTER_DRAIN = false;
    const bf16_t* Y; bf16_t* O; const float* bias;
    DI void operator()(const f32x4 (&acc)[2][2][4][2], const pg8::Unit& u, int wr, int wc, int fr, int fq) const {
        const int row0 = u.pm * 256 + wr * 64 + fr, col0 = u.pn * 256 + wc * 32 + 8 * fq;
#pragma unroll
        for (int bj = 0; bj < 2; ++bj) {
            const f32x4 b0 = *(const f32x4*)(bias + col0 + bj * 128), b1 = *(const f32x4*)(bias + col0 + bj * 128 + 4);
#pragma unroll
            for (int ai = 0; ai < 2; ++ai)
#pragma unroll
                for (int m = 0; m < 4; ++m) { const size_t r = (size_t)(row0 + ai * 128 + m * 16);
                    const u32x4 yv = *(const u32x4*)(Y + r * 1024 + col0 + bj * 128);
                    const f32x4 a0 = acc[ai][bj][m][0] + b0, a1 = acc[ai][bj][m][1] + b1;
                    float o[8];
                    o[0] = bflo(yv.x) / (1.f + __expf(-a0[0])); o[1] = bfhi(yv.x) / (1.f + __expf(-a0[1]));
                    o[2] = bflo(yv.y) / (1.f + __expf(-a0[2])); o[3] = bfhi(yv.y) / (1.f + __expf(-a0[3]));
                    o[4] = bflo(yv.z) / (1.f + __expf(-a1[0])); o[5] = bfhi(yv.z) / (1.f + __expf(-a1[1]));
                    o[6] = bflo(yv.w) / (1.f + __expf(-a1[2])); o[7] = bfhi(yv.w) / (1.f + __expf(-a1[3]));
                    u32x4 w; w.x = pk2(o[0], o[1]); w.y = pk2(o[2], o[3]); w.z = pk2(o[4], o[5]); w.w = pk2(o[6], o[7]);
                    *(u32x4*)(O + r * DM + col0 + bj * 128) = w; }
        }
    }
};
template <class Epi> DI void run_gemm(const Ctx& F, const bf16_t* A, const bf16_t* Bt, int N, int K, const Epi& E) {
    pg8::Gemm g{A, Bt, TOK, N, K}; pg8::StaticOrder S; S.init(TOK, N, F.G, F.bid);
    pg8::gemm_phase<Epi, pg8::StaticOrder, false>(F.lds, g, S, E, nullptr);
    __syncthreads();
}

DI void prep_a(const Ctx& F, const Params& P) {
    const bf16_t* T1 = (const bf16_t*)(P.ws + WS_RA);
    bf16_t* VTp = (bf16_t*)(P.ws + WS_VT); bf16_t* VTs = (bf16_t*)(P.ws + WS_VT + VT_S);
    for (int t = F.bid; t < 2048 + 8192; t += F.G) {
        if (t < 2048) { const int bh = t >> 3, sub = t & 7, tk = sub >> 1, dd = sub & 1, b = bh >> 3, h = bh & 7;
            tr_tile_bf16(F, T1 + ((size_t)(b * 256 + tk * 64)) * 4096 + h * 128 + dd * 64, 4096, VTp + ((size_t)bh * 128 + dd * 64) * 256 + tk * 64, 256, (LAS bf16_t*)F.lds); }
        else { const int u = t - 2048, bh = u >> 7, sub = u & 127, tk = sub >> 1, dd = sub & 1, b = bh >> 3, h = bh & 7;
            tr_tile_bf16(F, T1 + ((size_t)(TP + b * 4096 + tk * 64)) * 4096 + h * 128 + dd * 64, 4096, VTs + ((size_t)bh * 128 + dd * 64) * 4096 + tk * 64, 4096, (LAS bf16_t*)F.lds); }
    }
    { float* o = P.out + O_NAV;
      for (int e = F.bid * NTHR + F.tid; e < TP * 128; e += F.G * NTHR) { const int T = e >> 7, c8 = (e & 127) * 8;
          const u32x4 v = *(const u32x4*)(T1 + (size_t)T * 4096 + c8);
          *(f32x4*)(o + (size_t)T * 1024 + c8) = (f32x4){bflo(v.x), bfhi(v.x), bflo(v.y), bfhi(v.y)};
          *(f32x4*)(o + (size_t)T * 1024 + c8 + 4) = (f32x4){bflo(v.z), bfhi(v.z), bflo(v.w), bfhi(v.w)}; } }
    { LAS bf16_t* tl = (LAS bf16_t*)F.lds;
      bf16_t* CM = (bf16_t*)(P.ws + WS_RB);
      const float* cw = P.in[I_HYCW]; const float* cb = P.in[I_HYCB];
      for (int t = F.bid; t < 48 * 160; t += F.G) {
          const int cg = t % 48, tg = t / 48, ch0 = cg * 64, t0 = tg * 256;
          const bool lz = (t0 < TP) ? true : (((t0 - TP) & 4095) == 0);
          const bool rz = (t0 < TP) ? true : (((t0 + 256 - TP) & 4095) == 0);
          __syncthreads();
#pragma unroll
          for (int j = 0; j < 4; ++j) { const int id = F.tid + NTHR * j, tk = id >> 3, c8 = (id & 7) * 8;
              const u32x4 v = *(const u32x4*)(T1 + (size_t)(t0 + tk) * 4096 + 1024 + ch0 + c8);
              LAS bf16_t* d = tl + tk + 1;
              d[(c8 + 0) * 264] = (bf16_t)(v.x & 0xffff); d[(c8 + 1) * 264] = (bf16_t)(v.x >> 16); d[(c8 + 2) * 264] = (bf16_t)(v.y & 0xffff); d[(c8 + 3) * 264] = (bf16_t)(v.y >> 16);
              d[(c8 + 4) * 264] = (bf16_t)(v.z & 0xffff); d[(c8 + 5) * 264] = (bf16_t)(v.z >> 16); d[(c8 + 6) * 264] = (bf16_t)(v.w & 0xffff); d[(c8 + 7) * 264] = (bf16_t)(v.w >> 16); }
          if (F.tid < 16) { const int side = F.tid >> 3, c8 = (F.tid & 7) * 8; const bool zero = side ? rz : lz; const int tk = side ? t0 + 256 : t0 - 1;
              u32x4 v = (u32x4){0u, 0u, 0u, 0u};
              if (!zero) v = *(const u32x4*)(T1 + (size_t)tk * 4096 + 1024 + ch0 + c8);
              LAS bf16_t* d = tl + (side ? 257 : 0);
              d[(c8 + 0) * 264] = (bf16_t)(v.x & 0xffff); d[(c8 + 1) * 264] = (bf16_t)(v.x >> 16); d[(c8 + 2) * 264] = (bf16_t)(v.y & 0xffff); d[(c8 + 3) * 264] = (bf16_t)(v.y >> 16);
              d[(c8 + 4) * 264] = (bf16_t)(v.z & 0xffff); d[(c8 + 5) * 264] = (bf16_t)(v.z >> 16); d[(c8 + 6) * 264] = (bf16_t)(v.w & 0xffff); d[(c8 + 7) * 264] = (bf16_t)(v.w >> 16); }
          __syncthreads();
#pragma unroll
          for (int j = 0; j < 4; ++j) { const int id = F.tid + NTHR * j, ch = id >> 5, to = (id & 31) * 8, cgl = ch0 + ch;
              const float w0 = cw[cgl], w1 = cw[3072 + cgl], w2 = cw[6144 + cgl], bb = cb[cgl];
              const LAS bf16_t* s = tl + ch * 264 + to;
              float r[10];
#pragma unroll
              for (int i = 0; i < 10; ++i) r[i] = bf2f(s[i]);
              float o[8];
#pragma unroll
              for (int i = 0; i < 8; ++i) o[i] = w0 * r[i] + w1 * r[i + 1] + w2 * r[i + 2] + bb;
              u32x4 w; w.x = pk2(o[0], o[1]); w.y = pk2(o[2], o[3]); w.z = pk2(o[4], o[5]); w.w = pk2(o[6], o[7]);
              *(u32x4*)(CM + (size_t)cgl * TOK + t0 + to) = w; }
      }
      __syncthreads(); }
}

DI void prep_b(const Ctx& F, const Params& P) {
    bf16_t* Pq = (bf16_t*)(P.ws + WS_RA); const float* qg = P.in[I_NAQG]; const float* kg = P.in[I_NAKG]; float* ok = P.out + O_NAK;
    const float* gsrc = (F.lane < 32 ? qg : kg) + (F.lane & 3) * 32;
    float g[32];
#pragma unroll
    for (int i = 0; i < 32; ++i) g[i] = gsrc[i];
    for (int T = F.bid * 8 + F.wave; T < TOK; T += F.G * 8) {
        bf16_t* rp = Pq + (size_t)T * 2048 + F.lane * 32;
        u32x4 v[4]; float x[32]; float ss = 0.f;
#pragma unroll
        for (int j = 0; j < 4; ++j) { v[j] = *(const u32x4*)(rp + j * 8);
            x[j * 8 + 0] = bflo(v[j].x); x[j * 8 + 1] = bfhi(v[j].x); x[j * 8 + 2] = bflo(v[j].y); x[j * 8 + 3] = bfhi(v[j].y);
            x[j * 8 + 4] = bflo(v[j].z); x[j * 8 + 5] = bfhi(v[j].z); x[j * 8 + 6] = bflo(v[j].w); x[j * 8 + 7] = bfhi(v[j].w); }
#pragma unroll
        for (int i = 0; i < 32; ++i) ss += x[i] * x[i];
        ss += dpp_xor1(ss); ss += dpp_xor2(ss);
        const float rstd = rsqrtf(ss * (1.f / 128.f) + NORM_EPS);
#pragma unroll
        for (int i = 0; i < 32; ++i) x[i] = x[i] * rstd * g[i];
#pragma unroll
        for (int j = 0; j < 4; ++j) { u32x4 w; w.x = pk2(x[j * 8 + 0], x[j * 8 + 1]); w.y = pk2(x[j * 8 + 2], x[j * 8 + 3]); w.z = pk2(x[j * 8 + 4], x[j * 8 + 5]); w.w = pk2(x[j * 8 + 6], x[j * 8 + 7]);
            *(u32x4*)(rp + j * 8) = w; }
        if (T < TP && F.lane >= 32) { float* o = ok + (size_t)T * 1024 + (F.lane - 32) * 32;
#pragma unroll
            for (int j = 0; j < 8; ++j) *(f32x4*)(o + j * 4) = (f32x4){x[j * 4], x[j * 4 + 1], x[j * 4 + 2], x[j * 4 + 3]}; }
    }
}
constexpr int AT_KROW = 272, AT_VROW = 136, AT_KTB = 64 * AT_KROW, AT_VTB = 128 * AT_VROW;
constexpr int AT_K0 = 0, AT_V0 = 2 * AT_KTB, AT_RPB = AT_V0 + 2 * AT_VTB;

struct TileMap { const bf16_t* latK; int latKld; const bf16_t* latV; int latVld; int nlat; const bf16_t* ctxK; const bf16_t* ctxV; int ntiles; };
struct TileRegs { u32x4 k[2], v[2]; };

DI void tile_src(const TileMap& M, int j, const bf16_t*& kp, int& kld, const bf16_t*& vp, int& vld) {
    if (j < M.nlat) { kp = M.latK + (size_t)j * 64 * M.latKld; kld = M.latKld; vp = M.latV + j * 64; vld = M.latVld; }
    else { const int c = j - M.nlat; kp = M.ctxK + (size_t)c * 64 * 1024; kld = 1024; vp = M.ctxV + c * 64; vld = 256; }
}
DI void tile_load(const Ctx& F, TileRegs& R, const bf16_t* kp, int kld, const bf16_t* vp, int vld, bool withV = true) {
#pragma unroll
    for (int j = 0; j < 2; ++j) { const int id = F.tid + NTHR * j;
        const unsigned ko = (unsigned)((id >> 4) * kld + (id & 15) * 8) * 2u, vo = (unsigned)((id >> 3) * vld + (id & 7) * 8) * 2u;
        R.k[j] = *(const u32x4*)((const char*)kp + ko);
        if (withV) R.v[j] = *(const u32x4*)((const char*)vp + vo); }
}
DI void tile_store(const Ctx& F, const TileRegs& R, LAS unsigned char* kt, LAS unsigned char* vt, bool withV = true) {
#pragma unroll
    for (int j = 0; j < 2; ++j) { const int id = F.tid + NTHR * j;
        *(LAS u32x4*)(kt + (id >> 4) * AT_KROW + (id & 15) * 16) = R.k[j];
        if (withV) { LAS unsigned char* vp = vt + (id >> 3) * AT_VROW + (id & 7) * 16;
            *(LAS u32x2*)(vp) = (u32x2){R.v[j].x, R.v[j].y}; *(LAS u32x2*)(vp + 8) = (u32x2){R.v[j].z, R.v[j].w}; } }
}

DI void tile_norm_k(const Ctx& F, TileRegs& R, const LAS float* kgain, float* nk, int nkld) {
#pragma unroll
    for (int j = 0; j < 2; ++j) { const int id = F.tid + NTHR * j;
        float x[8] = {bflo(R.k[j].x), bfhi(R.k[j].x), bflo(R.k[j].y), bfhi(R.k[j].y), bflo(R.k[j].z), bfhi(R.k[j].z), bflo(R.k[j].w), bfhi(R.k[j].w)};
        float ss = 0.f;
#pragma unroll
        for (int i = 0; i < 8; ++i) ss += x[i] * x[i];
        ss += dpp_xor1(ss); ss += dpp_xor2(ss);
        ss += __builtin_bit_cast(float, __builtin_amdgcn_update_dpp(0, __builtin_bit_cast(int, ss), 0x141, 0xF, 0xF, true));
        ss += __builtin_bit_cast(float, __builtin_amdgcn_update_dpp(0, __builtin_bit_cast(int, ss), 0x140, 0xF, 0xF, true));
        const float rstd = rsqrtf(ss * (1.f / 128.f) + NORM_EPS);
        const f32x4 g0 = *(const LAS f32x4*)(kgain + (id & 15) * 8), g1 = *(const LAS f32x4*)(kgain + (id & 15) * 8 + 4);
        x[0] *= rstd * g0.x; x[1] *= rstd * g0.y; x[2] *= rstd * g0.z; x[3] *= rstd * g0.w; x[4] *= rstd * g1.x; x[5] *= rstd * g1.y; x[6] *= rstd * g1.z; x[7] *= rstd * g1.w;
        R.k[j] = (u32x4){pk2(x[0], x[1]), pk2(x[2], x[3]), pk2(x[4], x[5]), pk2(x[6], x[7])};
        if (nk) { float* o = nk + (size_t)(id >> 4) * nkld + (id & 15) * 8; *(f32x4*)(o) = (f32x4){x[0], x[1], x[2], x[3]}; *(f32x4*)(o + 4) = (f32x4){x[4], x[5], x[6], x[7]}; }
    }
}

template <int KS>
DI f32x16 qk_tile(LAS const unsigned char* kt, const bf16x8 (&Qf)[8], int kb, int kk0, int q, int hh) {
    f32x16 S;
#pragma unroll
    for (int i = 0; i < 16; ++i) S[i] = 0.f;
#pragma unroll
    for (int ks = 0; ks < KS; ++ks) { const int kk = kk0 + ks;
        const bf16x8 A = *(const LAS bf16x8*)(kt + (kb * 32 + q) * AT_KROW + (kk * 16 + hh * 8) * 2);
        S = __builtin_amdgcn_mfma_f32_32x32x16_bf16(A, Qf[kk], S, 0, 0, 0); }
    return S;
}
DI void pv_tile(LAS const unsigned char* vt, const float (&p)[16], f32x16 (&O)[4], int kb, int q, int hh) {
#pragma unroll
    for (int s = 0; s < 2; ++s) {
        u32x4 pw; pw.x = pk2(p[8 * s + 0], p[8 * s + 1]); pw.y = pk2(p[8 * s + 2], p[8 * s + 3]); pw.z = pk2(p[8 * s + 4], p[8 * s + 5]); pw.w = pk2(p[8 * s + 6], p[8 * s + 7]);
        const bf16x8 Pf = __builtin_bit_cast(bf16x8, pw);
#pragma unroll
        for (int db = 0; db < 4; ++db) {
            LAS const unsigned char* ap = vt + (db * 32 + q) * AT_VROW + (kb * 32 + 16 * s + 4 * hh) * 2;
            const u32x2 lo = *(const LAS u32x2*)(ap), hi = *(const LAS u32x2*)(ap + 16);
            const bf16x8 A2 = __builtin_bit_cast(bf16x8, (u32x4){lo.x, lo.y, hi.x, hi.y});
            O[db] = __builtin_amdgcn_mfma_f32_32x32x16_bf16(A2, Pf, O[db], 0, 0, 0);
        }
        asm volatile("" ::: "memory");
    }
}
template <bool LAT>
DI void attn_compute1(LAS const unsigned char* kt, LAS const unsigned char* vt, const bf16x8 (&Qf)[8], f32x16 (&O)[4], float& ls, int lane, const LAS float* blane, int mb) {
    const int q = lane & 31, hh = lane >> 5;
#pragma unroll 1
    for (int kb = 0; kb < 2; ++kb) {
        float bb[16];
        if (LAT) {
#pragma unroll
            for (int i = 0; i < 16; ++i) bb[i] = blane[kb * 32 + (i & 3) + 8 * (i >> 2)];
        }
        const f32x16 S = qk_tile<8>(kt, Qf, kb, 0, q, hh);
        float p[16];
#pragma unroll
        for (int i = 0; i < 16; ++i) {
            if (LAT) { const float e = __builtin_amdgcn_exp2f(S[i] + bb[i]);
                p[i] = ((unsigned)(kb * 32 + (i & 3) + 8 * (i >> 2) + mb) < 16u) ? e : 0.f; }
            else p[i] = __builtin_amdgcn_exp2f(S[i]);
            ls += p[i];
        }
        pv_tile(vt, p, O, kb, q, hh);
    }
}
DI void diff_pass1(LAS const unsigned char* kt, const bf16x8 (&Qf)[8], float (&ls)[2], int lane) {
    const int q = lane & 31, hh = lane >> 5;
#pragma unroll
    for (int kb = 0; kb < 2; ++kb) {
#pragma unroll
        for (int mp = 0; mp < 2; ++mp) { const f32x16 S = qk_tile<4>(kt, Qf, kb, mp * 4, q, hh);
#pragma unroll
            for (int i = 0; i < 16; ++i) ls[mp] += __builtin_amdgcn_exp2f(S[i]); }
    }
}
DI void diff_pass2(LAS const unsigned char* kt, LAS const unsigned char* vt, const bf16x8 (&Qf)[8], f32x16 (&O)[4], float w0, float w1, int lane) {
    const int q = lane & 31, hh = lane >> 5;
#pragma unroll
    for (int kb = 0; kb < 2; ++kb) {
        float p[16];
        { const f32x16 S0 = qk_tile<4>(kt, Qf, kb, 0, q, hh);
#pragma unroll
          for (int i = 0; i < 16; ++i) p[i] = __builtin_amdgcn_exp2f(S0[i]) * w0; }
        { const f32x16 S1 = qk_tile<4>(kt, Qf, kb, 4, q, hh);
#pragma unroll
          for (int i = 0; i < 16; ++i) p[i] -= __builtin_amdgcn_exp2f(S1[i]) * w1; }
        pv_tile(vt, p, O, kb, q, hh);
    }
}

template <int MODE>
DI void attn_phase(const Ctx& F, const Params& P) {
    constexpr bool DIFF = (MODE >= 2);
    constexpr bool NA = (MODE == 1);
    LAS unsigned char* lds = F.lds;
    LAS float* rpbl = (LAS float*)(lds + AT_RPB);
    LAS float* kgl = (LAS float*)(lds + AT_RPB + 2048);
    if (!DIFF) { __syncthreads(); if (F.tid < 128) kgl[F.tid] = P.in[I_NAKG][F.tid]; __syncthreads(); }
    const bf16_t* PA = (const bf16_t*)(P.ws + WS_RA);
    bf16_t* MIX = (bf16_t*)(P.ws + WS_HM);
    const bf16_t* VTp = (const bf16_t*)(P.ws + WS_VT); const bf16_t* VTs = (const bf16_t*)(P.ws + WS_VT + VT_S);
    const int q = F.lane & 31, hh = F.lane >> 5;
    const float c1 = (DIFF ? 0.125f : 0.08838834764831845f) * LOG2E;
    float lam = 0.f;
    if (DIFF) {
        const float a = wave_sum(P.in[I_LQ1][F.lane] * P.in[I_LK1][F.lane]), b = wave_sum(P.in[I_LQ2][F.lane] * P.in[I_LK2][F.lane]);
        lam = __expf(a) - __expf(b) + 0.35550906759096924f;
    }
    const int nunits = (MODE == 0 || MODE == 2) ? 256 : 1024;
    for (int u0 = F.bid; u0 < nunits; u0 += F.G) {
        int u = u0;
        if ((MODE == 1 || MODE == 3) && F.G == 256) { const int i = u0 >> 8, x = F.bid & 7, y = F.bid >> 3; u = ((2 * i + (y >> 4)) * 8 + x) * 16 + (y & 15); }
        int b, h, tok0, r = 0, rlo = 0; TileMap M;
        const bf16_t* qptr;
        if (MODE == 0) { b = u >> 3; h = u & 7; tok0 = b * 256 + F.wave * 32;
            qptr = PA + (size_t)(tok0 + q) * 2048 + h * 128;
            M.latK = PA + (size_t)(b * 256) * 2048 + 1024 + h * 128; M.latKld = 2048; M.latV = VTp + (size_t)(b * 8 + h) * 128 * 256; M.latVld = 256; M.nlat = 4; M.ctxK = nullptr; M.ctxV = nullptr; M.ntiles = 4; }
        else if (MODE == 1) { b = u >> 7; h = (u >> 4) & 7; const int rg = u & 15; r = 4 * rg + (F.wave >> 1);
            rlo = min(max(4 * rg - 4, 0), 56); const int rhi = min(max(4 * rg + 3 - 4, 0), 56) + 8;
            tok0 = TP + b * 4096 + r * 64 + (F.wave & 1) * 32;
            qptr = PA + (size_t)(tok0 + q) * 2048 + h * 128;
            M.latK = PA + (size_t)(TP + b * 4096 + rlo * 64) * 2048 + 1024 + h * 128; M.latKld = 2048; M.latV = VTs + (size_t)(b * 8 + h) * 128 * 4096 + rlo * 64; M.latVld = 4096; M.nlat = rhi - rlo;
            M.ctxK = (const bf16_t*)(P.ws + WS_CNK) + (size_t)b * 256 * 1024 + h * 128; M.ctxV = (const bf16_t*)(P.ws + WS_CNVT) + (size_t)(b * 8 + h) * 128 * 256; M.ntiles = M.nlat + 4;
            if (F.tid < 465) rpbl[F.tid] = P.in[I_RPB][h * 465 + F.tid] * LOG2E; }
        else if (MODE == 2) { b = u >> 3; h = u & 7; tok0 = b * 256 + F.wave * 32;
            qptr = PA + (size_t)(tok0 + q) * 4096 + 1024 + h * 128;
            M.latK = PA + (size_t)(b * 256) * 4096 + 2048 + h * 128; M.latKld = 4096; M.latV = VTp + (size_t)(b * 8 + h) * 128 * 256; M.latVld = 256; M.nlat = 4; M.ctxK = nullptr; M.ctxV = nullptr; M.ntiles = 4; }
        else { b = u >> 7; h = (u >> 4) & 7; const int qb = u & 15; tok0 = TP + b * 4096 + qb * 256 + F.wave * 32;
            qptr = PA + (size_t)(tok0 + q) * 4096 + 1024 + h * 128;
            M.latK = PA + (size_t)(TP + b * 4096) * 4096 + 2048 + h * 128; M.latKld = 4096; M.latV = VTs + (size_t)(b * 8 + h) * 128 * 4096; M.latVld = 4096; M.nlat = 64;
            M.ctxK = (const bf16_t*)(P.ws + WS_CDK) + (size_t)b * 256 * 1024 + h * 128; M.ctxV = (const bf16_t*)(P.ws + WS_CDVT) + (size_t)(b * 8 + h) * 128 * 256; M.ntiles = 68; }
        bf16x8 Qf[8];
        if constexpr (!DIFF) {
            u32x4 w[8]; float ss = 0.f;
#pragma unroll
            for (int ks = 0; ks < 8; ++ks) { w[ks] = *(const u32x4*)(qptr + ks * 16 + hh * 8);
                ss += bflo(w[ks].x) * bflo(w[ks].x) + bfhi(w[ks].x) * bfhi(w[ks].x) + bflo(w[ks].y) * bflo(w[ks].y) + bfhi(w[ks].y) * bfhi(w[ks].y)
                    + bflo(w[ks].z) * bflo(w[ks].z) + bfhi(w[ks].z) * bfhi(w[ks].z) + bflo(w[ks].w) * bflo(w[ks].w) + bfhi(w[ks].w) * bfhi(w[ks].w); }
            ss += __shfl_xor(ss, 32);
            const float qs = rsqrtf(ss * (1.f / 128.f) + NORM_EPS) * c1;
            const float* qg = P.in[I_NAQG];
#pragma unroll
            for (int ks = 0; ks < 8; ++ks) { const f32x4 g0 = *(const f32x4*)(qg + ks * 16 + hh * 8), g1 = *(const f32x4*)(qg + ks * 16 + hh * 8 + 4);
                const u32x4 ws = (u32x4){pk2(bflo(w[ks].x) * qs * g0.x, bfhi(w[ks].x) * qs * g0.y), pk2(bflo(w[ks].y) * qs * g0.z, bfhi(w[ks].y) * qs * g0.w),
                                         pk2(bflo(w[ks].z) * qs * g1.x, bfhi(w[ks].z) * qs * g1.y), pk2(bflo(w[ks].w) * qs * g1.z, bfhi(w[ks].w) * qs * g1.w)};
                Qf[ks] = __builtin_bit_cast(bf16x8, ws); }
        } else {
#pragma unroll
        for (int ks = 0; ks < 8; ++ks) { const u32x4 w = *(const u32x4*)(qptr + ks * 16 + hh * 8);
            const u32x4 ws = (u32x4){pk2(bflo(w.x) * c1, bfhi(w.x) * c1), pk2(bflo(w.y) * c1, bfhi(w.y) * c1), pk2(bflo(w.z) * c1, bfhi(w.z) * c1), pk2(bflo(w.w) * c1, bfhi(w.w) * c1)};
            Qf[ks] = __builtin_bit_cast(bf16x8, ws); }
        }
        f32x16 O[4]; float ls[2] = {0.f, 0.f}; float w0 = 0.f, w1 = 0.f;
#pragma unroll
        for (int db = 0; db < 4; ++db)
#pragma unroll
            for (int i = 0; i < 16; ++i) O[db][i] = 0.f;
        const int cq = (F.wave & 1) * 32 + q, cs = min(max(cq - 8, 0), 48);
        const int r0w = min(max(r - 4, 0), 56);
        const int nt = M.ntiles;
        TileRegs R;
        { const bf16_t* kp; const bf16_t* vp; int kld, vld; tile_src(M, 0, kp, kld, vp, vld); tile_load(F, R, kp, kld, vp, vld); }
        if constexpr (!DIFF) tile_norm_k(F, R, kgl, (MODE == 0) ? P.out + O_NAK + (size_t)(b * 256) * 1024 + h * 128 : nullptr, 1024);
        tile_store(F, R, lds + AT_K0, lds + AT_V0);
        __syncthreads();
        if constexpr (DIFF) {
#pragma unroll 1
            for (int j = 0; j < nt; ++j) {
                const int cur = j & 1, jn = (j + 1 < nt) ? j + 1 : 0;
                const bool wv = (j + 1 == nt);
                { const bf16_t* kp; const bf16_t* vp; int kld, vld; tile_src(M, jn, kp, kld, vp, vld); tile_load(F, R, kp, kld, vp, vld, wv); }
                diff_pass1(lds + AT_K0 + cur * AT_KTB, Qf, ls, F.lane);
                tile_store(F, R, lds + AT_K0 + (cur ^ 1) * AT_KTB, lds + AT_V0 + (cur ^ 1) * AT_VTB, wv);
                __syncthreads();
            }
            { const float l0 = ls[0] + __shfl_xor(ls[0], 32), l1 = ls[1] + __shfl_xor(ls[1], 32); w0 = 1.f / l0; w1 = lam / l1; }
#pragma unroll 1
            for (int j = 0; j < nt; ++j) {
                const int cur = (nt + j) & 1;
                if (j + 1 < nt) { const bf16_t* kp; const bf16_t* vp; int kld, vld; tile_src(M, j + 1, kp, kld, vp, vld); tile_load(F, R, kp, kld, vp, vld); }
                diff_pass2(lds + AT_K0 + cur * AT_KTB, lds + AT_V0 + cur * AT_VTB, Qf, O, w0, w1, F.lane);
                if (j + 1 < nt) tile_store(F, R, lds + AT_K0 + (cur ^ 1) * AT_KTB, lds + AT_V0 + (cur ^ 1) * AT_VTB);
                __syncthreads();
            }
        } else {
#pragma unroll 1
            for (int j = 0; j < nt; ++j) {
                const int cur = j & 1;
                if (j + 1 < nt) { const bf16_t* kp; const bf16_t* vp; int kld, vld; tile_src(M, j + 1, kp, kld, vp, vld); tile_load(F, R, kp, kld, vp, vld); }
                LAS const unsigned char* kt = lds + AT_K0 + cur * AT_KTB; LAS const unsigned char* vt = lds + AT_V0 + cur * AT_VTB;
                if constexpr (NA) {
                    if (j < M.nlat) { const int kr = rlo + j;
                        if (kr >= r0w && kr < r0w + 8) attn_compute1<true>(kt, vt, Qf, O, ls[0], F.lane, rpbl + (kr - r + 7) * 31 + (4 * hh - cq + 15), 4 * hh - cs); }
                    else attn_compute1<false>(kt, vt, Qf, O, ls[0], F.lane, rpbl, 0);
                } else attn_compute1<false>(kt, vt, Qf, O, ls[0], F.lane, rpbl, 0);
                if (j + 1 < nt) {
                    if (j + 1 < M.nlat) tile_norm_k(F, R, kgl, (MODE == 0) ? P.out + O_NAK + (size_t)(b * 256 + (j + 1) * 64) * 1024 + h * 128 : nullptr, 1024);
                    tile_store(F, R, lds + AT_K0 + (cur ^ 1) * AT_KTB, lds + AT_V0 + (cur ^ 1) * AT_VTB); }
                __syncthreads();
            }
        }
        if constexpr (!DIFF) {
            const float inv = 1.f / (ls[0] + __shfl_xor(ls[0], 32));
            bf16_t* op = MIX + (size_t)(tok0 + q) * DM + h * 128 + 4 * hh;
#pragma unroll
            for (int db = 0; db < 4; ++db)
#pragma unroll
                for (int g = 0; g < 4; ++g) { u32x2 w; w.x = pk2(O[db][4 * g] * inv, O[db][4 * g + 1] * inv); w.y = pk2(O[db][4 * g + 2] * inv, O[db][4 * g + 3] * inv);
                    *(u32x2*)(op + db * 32 + 8 * g) = w; }
        } else {
            float ss = 0.f;
#pragma unroll
            for (int db = 0; db < 4; ++db)
#pragma unroll
                for (int i = 0; i < 16; ++i) ss += O[db][i] * O[db][i];
            ss += __shfl_xor(ss, 32);
            const float sc = rsqrtf(ss * (1.f / 128.f) + NORM_EPS) * (1.f - 0.35550906759096924f);
            const float* sg = P.in[I_SUBG];
            bf16_t* op = MIX + (size_t)(tok0 + q) * DM + 1024 + h * 128 + 4 * hh;
#pragma unroll
            for (int db = 0; db < 4; ++db)
#pragma unroll
                for (int g = 0; g < 4; ++g) { const f32x4 g4 = *(const f32x4*)(sg + db * 32 + 8 * g + 4 * hh);
                    u32x2 w; w.x = pk2(O[db][4 * g] * sc * g4.x, O[db][4 * g + 1] * sc * g4.y); w.y = pk2(O[db][4 * g + 2] * sc * g4.z, O[db][4 * g + 3] * sc * g4.w);
                    *(u32x2*)(op + db * 32 + 8 * g) = w; }
        }
    }
}

DI float diff_lambda(const Ctx& F, const Params& P) {
    const float la = wave_sum(P.in[I_LQ1][F.lane] * P.in[I_LK1][F.lane]), lb = wave_sum(P.in[I_LQ2][F.lane] * P.in[I_LK2][F.lane]);
    return __expf(la) - __expf(lb) + 0.35550906759096924f;
}
template <bool SAMPLE>
DI void attn_diff_phase(const Ctx& F, const Params& P, const float lam) {
    LAS unsigned char* lds = F.lds;
    const bf16_t* PA = (const bf16_t*)(P.ws + WS_RA);
    bf16_t* MIX = (bf16_t*)(P.ws + WS_HM);
    const bf16_t* VTp = (const bf16_t*)(P.ws + WS_VT); const bf16_t* VTs = (const bf16_t*)(P.ws + WS_VT + VT_S);
    const int q = F.lane & 31, hh = F.lane >> 5, mp = F.wave >> 2, qg = F.wave & 3;
    const float c1 = 0.125f * LOG2E;
    const int nunits = SAMPLE ? 1024 : 256;
    for (int u0 = F.bid; u0 < nunits; u0 += F.G) {
        int u = u0;
        if (SAMPLE && F.G == 256) { const int i = u0 >> 8, x = F.bid & 7, y = F.bid >> 3; u = ((2 * i + (y >> 4)) * 8 + x) * 16 + (y & 15); }
        int b, h, tok0; TileMap M;
        if (!SAMPLE) { b = u >> 3; h = u & 7; tok0 = b * 256 + qg * 64;
            M.latK = PA + (size_t)(b * 256) * 4096 + 2048 + h * 128; M.latKld = 4096; M.latV = VTp + (size_t)(b * 8 + h) * 128 * 256; M.latVld = 256; M.nlat = 4; M.ctxK = nullptr; M.ctxV = nullptr; M.ntiles = 4; }
        else { b = u >> 7; h = (u >> 4) & 7; tok0 = TP + b * 4096 + (u & 15) * 256 + qg * 64;
            M.latK = PA + (size_t)(TP + b * 4096) * 4096 + 2048 + h * 128; M.latKld = 4096; M.latV = VTs + (size_t)(b * 8 + h) * 128 * 4096; M.latVld = 4096; M.nlat = 64;
            M.ctxK = (const bf16_t*)(P.ws + WS_CDK) + (size_t)b * 256 * 1024 + h * 128; M.ctxV = (const bf16_t*)(P.ws + WS_CDVT) + (size_t)(b * 8 + h) * 128 * 256; M.ntiles = 68; }
        LAS unsigned char* qst = lds + 73728 + F.wave * 8192 + F.lane * 16;
#pragma unroll
        for (int sb = 0; sb < 2; ++sb) { const bf16_t* qptr = PA + (size_t)(tok0 + sb * 32 + q) * 4096 + 1024 + h * 128 + mp * 64;
#pragma unroll
            for (int ks = 0; ks < 4; ++ks) { const u32x4 w = *(const u32x4*)(qptr + ks * 16 + hh * 8);
                const u32x4 ws = (u32x4){pk2(bflo(w.x) * c1, bfhi(w.x) * c1), pk2(bflo(w.y) * c1, bfhi(w.y) * c1), pk2(bflo(w.z) * c1, bfhi(w.z) * c1), pk2(bflo(w.w) * c1, bfhi(w.w) * c1)};
                *(LAS u32x4*)(qst + (sb * 4 + ks) * 1024) = ws; } }
        f32x16 O[2][4]; float ls[2] = {0.f, 0.f};
#pragma unroll
        for (int sb = 0; sb < 2; ++sb)
#pragma unroll
            for (int db = 0; db < 4; ++db)
#pragma unroll
                for (int i = 0; i < 16; ++i) O[sb][db][i] = 0.f;
        const int nt = M.ntiles;
        TileRegs R;
        { const bf16_t* kp; const bf16_t* vp; int kld, vld; tile_src(M, 0, kp, kld, vp, vld); tile_load(F, R, kp, kld, vp, vld); }
        tile_store(F, R, lds + AT_K0, lds + AT_V0);
        __syncthreads();
#pragma unroll 1
        for (int j = 0; j < nt; ++j) {
            const int cur = j & 1;
            if (j + 1 < nt) { const bf16_t* kp; const bf16_t* vp; int kld, vld; tile_src(M, j + 1, kp, kld, vp, vld); tile_load(F, R, kp, kld, vp, vld); }
            LAS const unsigned char* kt = lds + AT_K0 + cur * AT_KTB; LAS const unsigned char* vt = lds + AT_V0 + cur * AT_VTB;
#pragma unroll 1
            for (int kb = 0; kb < 2; ++kb) {
                f32x16 S0, S1;
#pragma unroll
                for (int i = 0; i < 16; ++i) { S0[i] = 0.f; S1[i] = 0.f; }
#pragma unroll
                for (int ks = 0; ks < 4; ++ks) { const bf16x8 A = *(const LAS bf16x8*)(kt + (kb * 32 + q) * AT_KROW + ((mp * 4 + ks) * 16 + hh * 8) * 2);
                    S0 = __builtin_amdgcn_mfma_f32_32x32x16_bf16(A, *(const LAS bf16x8*)(qst + ks * 1024), S0, 0, 0, 0);
                    S1 = __builtin_amdgcn_mfma_f32_32x32x16_bf16(A, *(const LAS bf16x8*)(qst + (4 + ks) * 1024), S1, 0, 0, 0); }
                u32x4 pa[2], pb[2];
                { float l0 = 0.f, l1 = 0.f;
#pragma unroll
                for (int sp = 0; sp < 2; ++sp) { float e0[8], e1[8];
#pragma unroll
                    for (int i = 0; i < 8; ++i) { e0[i] = __builtin_amdgcn_exp2f(S0[8 * sp + i]); e1[i] = __builtin_amdgcn_exp2f(S1[8 * sp + i]); l0 += e0[i]; l1 += e1[i]; }
                    pa[sp] = (u32x4){pk2(e0[0], e0[1]), pk2(e0[2], e0[3]), pk2(e0[4], e0[5]), pk2(e0[6], e0[7])};
                    pb[sp] = (u32x4){pk2(e1[0], e1[1]), pk2(e1[2], e1[3]), pk2(e1[4], e1[5]), pk2(e1[6], e1[7])}; }
                ls[0] += l0; ls[1] += l1; }
#pragma unroll
                for (int sp = 0; sp < 2; ++sp) {
                    const bf16x8 Pa = __builtin_bit_cast(bf16x8, pa[sp]), Pb = __builtin_bit_cast(bf16x8, pb[sp]);
#pragma unroll
                    for (int db = 0; db < 4; ++db) {
                        LAS const unsigned char* ap = vt + (db * 32 + q) * AT_VROW + (kb * 32 + 16 * sp + 4 * hh) * 2;
                        const u32x2 lo = *(const LAS u32x2*)(ap), hi = *(const LAS u32x2*)(ap + 16);
                        const bf16x8 A2 = __builtin_bit_cast(bf16x8, (u32x4){lo.x, lo.y, hi.x, hi.y});
                        O[0][db] = __builtin_amdgcn_mfma_f32_32x32x16_bf16(A2, Pa, O[0][db], 0, 0, 0);
                        O[1][db] = __builtin_amdgcn_mfma_f32_32x32x16_bf16(A2, Pb, O[1][db], 0, 0, 0);
                    }
                    asm volatile("" ::: "memory");
                }
            }
            if (j + 1 < nt) tile_store(F, R, lds + AT_K0 + (cur ^ 1) * AT_KTB, lds + AT_V0 + (cur ^ 1) * AT_VTB);
            __syncthreads();
        }
        LAS float* xch = (LAS float*)lds + qg * 8192 + F.lane;
        float lt[2];
#pragma unroll
        for (int sb = 0; sb < 2; ++sb) lt[sb] = ls[sb] + __shfl_xor(ls[sb], 32);
        if (mp == 1) {
#pragma unroll
            for (int sb = 0; sb < 2; ++sb) { const float w1 = lam / lt[sb];
#pragma unroll
                for (int db = 0; db < 4; ++db)
#pragma unroll
                    for (int i = 0; i < 16; ++i) xch[((sb * 4 + db) * 16 + i) * 64] = O[sb][db][i] * w1; } }
        __syncthreads();
        if (mp == 0) {
            const float* sg = P.in[I_SUBG];
#pragma unroll
            for (int sb = 0; sb < 2; ++sb) { const float w0 = 1.f / lt[sb]; float ss = 0.f;
#pragma unroll
                for (int db = 0; db < 4; ++db)
#pragma unroll
                    for (int i = 0; i < 16; ++i) { const float o = O[sb][db][i] * w0 - xch[((sb * 4 + db) * 16 + i) * 64]; O[sb][db][i] = o; ss += o * o; }
                ss += __shfl_xor(ss, 32);
                const float sc = rsqrtf(ss * (1.f / 128.f) + NORM_EPS) * (1.f - 0.35550906759096924f);
                bf16_t* op = MIX + (size_t)(tok0 + sb * 32 + q) * DM + 1024 + h * 128 + 4 * hh;
#pragma unroll
                for (int db = 0; db < 4; ++db)
#pragma unroll
                    for (int g = 0; g < 4; ++g) { const f32x4 g4 = *(const f32x4*)(sg + db * 32 + 8 * g + 4 * hh);
                        u32x2 w; w.x = pk2(O[sb][db][4 * g] * sc * g4.x, O[sb][db][4 * g + 1] * sc * g4.y); w.y = pk2(O[sb][db][4 * g + 2] * sc * g4.z, O[sb][db][4 * g + 3] * sc * g4.w);
                        *(u32x2*)(op + db * 32 + 8 * g) = w; } } }
        __syncthreads();
    }
}
template <int L, int BATCH> struct HyCfg {
    static constexpr int NB = L / 64, TPT = 32 / BATCH, NTILES = NB / TPT, LOGB = (BATCH == 8) ? 3 : 5;
    static constexpr int ZROWB = (L + 384) * 2 + 16, ZBYTES = BATCH * ZROWB, RL = 2 * L + 16;
    static constexpr int TPW = (NTILES + 7) / 8;
};
constexpr int HY_KR_OFF = 71808;

template <int L, int BATCH>
DI void hyena_part(const Ctx& F, const Params& P, int c, int tokbase  , const bf16_t* KRG  ) {
    typedef HyCfg<L, BATCH> C;
    LAS unsigned char* lds = F.lds;
    bf16_t* CM = (bf16_t*)(P.ws + WS_RB);
    const float* hbias = P.in[I_HYBIAS];
    const int q = F.lane & 31, hh = F.lane >> 5;
    __syncthreads();
    for (int id = F.tid; id < BATCH * (L / 8); id += NTHR) { const int b = id / (L / 8), s8 = (id % (L / 8)) * 8;
        *(LAS u32x4*)(lds + b * C::ZROWB + (192 + s8) * 2) = *(const u32x4*)(CM + (size_t)c * TOK + tokbase + b * L + s8); }
    for (int id = F.tid; id < BATCH * 48; id += NTHR) { const int b = id / 48, k = id % 48, e = (k < 24) ? k * 8 : (192 + L + (k - 24) * 8);
        *(LAS u32x4*)(lds + b * C::ZROWB + e * 2) = (u32x4){0u, 0u, 0u, 0u}; }
#pragma unroll 1
    for (int o = 0; o < 2; ++o) {
        { const bf16_t* src = KRG + (size_t)(o * 1024 + c) * C::RL;
          for (int id = F.tid; id < C::RL / 8; id += NTHR) { const u32x4 v = *(const u32x4*)(src + id * 8);
              *(LAS u32x4*)(lds + HY_KR_OFF + id * 16) = v;
              LAS bf16_t* c1 = (LAS bf16_t*)(lds + HY_KR_OFF + C::RL * 2) + id * 8 - 1;
              if (id > 0) c1[0] = (bf16_t)(v.x & 0xffff);
              c1[1] = (bf16_t)(v.x >> 16); c1[2] = (bf16_t)(v.y & 0xffff); c1[3] = (bf16_t)(v.y >> 16); c1[4] = (bf16_t)(v.z & 0xffff); c1[5] = (bf16_t)(v.z >> 16);
              c1[6] = (bf16_t)(v.w & 0xffff); c1[7] = (bf16_t)(v.w >> 16); } }
        __syncthreads();
        f32x16 acc[C::TPW][2];
#pragma unroll
        for (int t = 0; t < C::TPW; ++t)
#pragma unroll
            for (int mt = 0; mt < 2; ++mt)
#pragma unroll
                for (int i = 0; i < 16; ++i) acc[t][mt][i] = 0.f;
        const int tq0 = F.wave * C::TPW;
        if (tq0 < C::NTILES) {
            const int d1lo = C::TPT * tq0 - (C::NB - 1), d1hi = C::TPT * (tq0 + C::TPW - 1) + C::TPT - 1;
            const int abase = HY_KR_OFF + (F.lane & 1) * (C::RL * 2) + (L - (F.lane & 31) + 8 * hh - (F.lane & 1)) * 2;
            bf16x8 W0[6], W1[6], B0[C::TPW][4];
#define HY_LDW(Wv, d1v, i) do { LAS const unsigned* ap_ = (LAS const unsigned*)(lds + abase + (-4 * (d1v) - 2 + (i)) * 32); Wv[i] = __builtin_bit_cast(bf16x8, (u32x4){ap_[0], ap_[1], ap_[2], ap_[3]}); } while (0)
#define HY_LDB(Bv, d1v) do { _Pragma("unroll") for (int t_ = 0; t_ < C::TPW; ++t_) { const int tq_ = tq0 + t_; \
            const int t1_ = C::TPT * tq_ + (q >> C::LOGB), b_ = q & (BATCH - 1); int s1_ = t1_ - (d1v); s1_ = min(max(s1_, -3), C::NB + 2); \
            LAS const unsigned char* bp_ = lds + b_ * C::ZROWB + (192 + 64 * s1_ + 8 * hh) * 2; \
            _Pragma("unroll") for (int ks_ = 0; ks_ < 4; ++ks_) Bv[t_][ks_] = *(const LAS bf16x8*)(bp_ + ks_ * 32); } } while (0)
#define HY_MM(Wv, Bv, d1v) do { _Pragma("unroll") for (int t_ = 0; t_ < C::TPW; ++t_) { const int tq_ = tq0 + t_; \
            if ((d1v) >= C::TPT * tq_ - (C::NB - 1) && (d1v) <= C::TPT * tq_ + C::TPT - 1) { \
                _Pragma("unroll") for (int ks_ = 0; ks_ < 4; ++ks_) _Pragma("unroll") for (int mt_ = 0; mt_ < 2; ++mt_) \
                    acc[t_][mt_] = __builtin_amdgcn_mfma_f32_32x32x16_bf16(Wv[ks_ - 2 * mt_ + 2], Bv[t_][ks_], acc[t_][mt_], 0, 0, 0); } } } while (0)
#pragma unroll
            for (int i = 0; i < 6; ++i) HY_LDW(W0, d1lo, i);
            int d1 = d1lo;
#pragma unroll 1
            for (; d1 + 1 <= d1hi; d1 += 2) {
                HY_LDB(B0, d1);
#pragma unroll
                for (int i = 0; i < 4; ++i) HY_LDW(W1, d1 + 1, i);
                W1[4] = W0[0]; W1[5] = W0[1];
                HY_MM(W0, B0, d1);
                HY_LDB(B0, d1 + 1);
                if (d1 + 2 <= d1hi) {
#pragma unroll
                    for (int i = 0; i < 4; ++i) HY_LDW(W0, d1 + 2, i);
                    W0[4] = W1[0]; W0[5] = W1[1];
                }
                HY_MM(W1, B0, d1 + 1);
            }
            if (d1 <= d1hi) { HY_LDB(B0, d1); HY_MM(W0, B0, d1); }
#undef HY_LDW
#undef HY_LDB
#undef HY_MM
        }
        __syncthreads();
        if (tq0 < C::NTILES) {
            const float bo = hbias[o * 1024 + c];
            const bf16_t* gate = CM + (size_t)((1 + o) * 1024 + c) * TOK + tokbase;
            bf16_t* zout = (bf16_t*)(P.ws + WS_RA + RA_ZC) + (size_t)c * TOK + tokbase;
#pragma unroll
            for (int t = 0; t < C::TPW; ++t) { const int tq = tq0 + t, t1 = C::TPT * tq + (q >> C::LOGB), b = q & (BATCH - 1);
#pragma unroll
                for (int mt = 0; mt < 2; ++mt)
#pragma unroll
                    for (int g = 0; g < 4; ++g) { const int s = 64 * t1 + 32 * mt + 8 * g + 4 * hh;
                        LAS u32x2* zp = (LAS u32x2*)(lds + b * C::ZROWB + (192 + s) * 2);
                        const u32x2 zv = *zp, gv = *(const u32x2*)(gate + (size_t)b * L + s);
                        const float r0 = bflo(gv.x) * (acc[t][mt][4 * g] + bflo(zv.x) * bo), r1 = bfhi(gv.x) * (acc[t][mt][4 * g + 1] + bfhi(zv.x) * bo);
                        const float r2 = bflo(gv.y) * (acc[t][mt][4 * g + 2] + bflo(zv.y) * bo), r3 = bfhi(gv.y) * (acc[t][mt][4 * g + 3] + bfhi(zv.y) * bo);
                        const u32x2 w = (u32x2){pk2(r0, r1), pk2(r2, r3)};
                        if (o == 0) *zp = w; else *(u32x2*)(zout + (size_t)b * L + s) = w; } }
        }
        __syncthreads();
    }
}

DI void hyena_phase(const Ctx& F, const Params& P) {
    for (int c = F.bid; c < 1024; c += F.G) {
        hyena_part<LS, 8>(F, P, c, TP, (const bf16_t*)(P.ws + WS_KRS));
        hyena_part<LP, 32>(F, P, c, 0, (const bf16_t*)(P.ws + WS_KRP));
    }
}

DI void hyena_post(const Ctx& F, const Params& P) {
    const bf16_t* CM = (const bf16_t*)(P.ws + WS_RA + RA_ZC); bf16_t* MIX = (bf16_t*)(P.ws + WS_HM);
    for (int t = F.bid; t < 16 * 640; t += F.G) { const int cg = t & 15, tg = t >> 4;
        tr_tile_bf16(F, CM + (size_t)(cg * 64) * TOK + tg * 64, TOK, MIX + (size_t)(tg * 64) * DM + 1024 + cg * 64, DM, (LAS bf16_t*)F.lds); }
}
DI void prep_c(const Ctx& F, const Params& P) {
    bf16_t* PA = (bf16_t*)(P.ws + WS_RA);
    LAS float* rope = (LAS float*)(F.lds + 16384);
    __syncthreads();
    for (int e = F.tid; e < 1024; e += NTHR) { const int pos = e >> 4, f = e & 15; const float inv = exp2f(-(float)f * (13.287712379549449f / 16.f)); const float a = (float)pos * inv;
        rope[e * 2] = cosf(a); rope[e * 2 + 1] = sinf(a); }
    __syncthreads();
    { const float* gsrc = (F.lane < 32 ? P.in[I_DQG] : P.in[I_DKG]) + (F.lane & 1) * 32; float* ok = P.out + O_DK;
      float g[32];
#pragma unroll
      for (int i = 0; i < 32; ++i) g[i] = gsrc[i];
      for (int T = F.bid * 8 + F.wave; T < TOK; T += F.G * 8) {
          bf16_t* rp = PA + (size_t)T * 4096 + 1024 + F.lane * 32;
          u32x4 v[4]; float x[32]; float ss = 0.f;
#pragma unroll
          for (int j = 0; j < 4; ++j) { v[j] = *(const u32x4*)(rp + j * 8);
              x[j * 8 + 0] = bflo(v[j].x); x[j * 8 + 1] = bfhi(v[j].x); x[j * 8 + 2] = bflo(v[j].y); x[j * 8 + 3] = bfhi(v[j].y);
              x[j * 8 + 4] = bflo(v[j].z); x[j * 8 + 5] = bfhi(v[j].z); x[j * 8 + 6] = bflo(v[j].w); x[j * 8 + 7] = bfhi(v[j].w); }
#pragma unroll
          for (int i = 0; i < 32; ++i) ss += x[i] * x[i];
          ss += dpp_xor1(ss);
          const float rstd = rsqrtf(ss * (1.f / 64.f) + NORM_EPS);
#pragma unroll
          for (int i = 0; i < 32; ++i) x[i] = x[i] * rstd * g[i];
          if (T < TP) { if (F.lane >= 32) { float* o = ok + (size_t)T * 1024 + (F.lane - 32) * 32;
#pragma unroll
                  for (int j = 0; j < 8; ++j) *(f32x4*)(o + j * 4) = (f32x4){x[j * 4], x[j * 4 + 1], x[j * 4 + 2], x[j * 4 + 3]}; } }
          else { const int t = (T - TP) & 4095, pos = (F.lane & 1) ? (t & 63) : (t >> 6);
              const LAS float* rt = rope + pos * 32;
#pragma unroll
              for (int f = 0; f < 16; ++f) { const float cs = rt[2 * f], sn = rt[2 * f + 1], a = x[f], b = x[16 + f]; x[f] = a * cs - b * sn; x[16 + f] = b * cs + a * sn; } }
#pragma unroll
          for (int j = 0; j < 4; ++j) { u32x4 w; w.x = pk2(x[j * 8 + 0], x[j * 8 + 1]); w.y = pk2(x[j * 8 + 2], x[j * 8 + 3]); w.z = pk2(x[j * 8 + 4], x[j * 8 + 5]); w.w = pk2(x[j * 8 + 6], x[j * 8 + 7]);
              *(u32x4*)(rp + j * 8) = w; }
      } }
    __syncthreads();
    bf16_t* VTp = (bf16_t*)(P.ws + WS_VT); bf16_t* VTs = (bf16_t*)(P.ws + WS_VT + VT_S);
    for (int t = F.bid; t < 2048 + 8192; t += F.G) {
        if (t < 2048) { const int bh = t >> 3, sub = t & 7, tk = sub >> 1, dd = sub & 1, b = bh >> 3, h = bh & 7;
            tr_tile_bf16(F, PA + ((size_t)(b * 256 + tk * 64)) * 4096 + 3072 + h * 128 + dd * 64, 4096, VTp + ((size_t)bh * 128 + dd * 64) * 256 + tk * 64, 256, (LAS bf16_t*)F.lds); }
        else { const int u = t - 2048, bh = u >> 7, sub = u & 127, tk = sub >> 1, dd = sub & 1, b = bh >> 3, h = bh & 7;
            tr_tile_bf16(F, PA + ((size_t)(TP + b * 4096 + tk * 64)) * 4096 + 3072 + h * 128 + dd * 64, 4096, VTs + ((size_t)bh * 128 + dd * 64) * 4096 + tk * 64, 4096, (LAS bf16_t*)F.lds); }
    }
    { float* o = P.out + O_DV;
      for (int e = F.bid * NTHR + F.tid; e < TP * 128; e += F.G * NTHR) { const int T = e >> 7, c8 = (e & 127) * 8;
          const u32x4 v = *(const u32x4*)(PA + (size_t)T * 4096 + 3072 + c8);
          *(f32x4*)(o + (size_t)T * 1024 + c8) = (f32x4){bflo(v.x), bfhi(v.x), bflo(v.y), bfhi(v.y)};
          *(f32x4*)(o + (size_t)T * 1024 + c8 + 4) = (f32x4){bflo(v.z), bfhi(v.z), bflo(v.w), bfhi(v.w)}; } }
}

constexpr int S5_BROW = 80, S5_BUB = 128 * S5_BROW, S5_HROW = 272, S5_WLDS = S5_BUB + 16 * S5_HROW;
DI void s5_chain(const Ctx& F, const Params& P, int dg, int tok0, int L, const float* h0re, const float* h0im, float* fre, float* fim, bf16_t* Yout) {
    LAS unsigned char* wl = F.lds + F.wave * S5_WLDS; LAS unsigned char* hl = wl + S5_BUB;
    const int g = dg & 63, dir = dg >> 6, lane = F.lane, st = lane & 15, gq = lane >> 4;
    const float* S5A = (const float*)(P.ws + WS_S5A); const bf16_t* BB = (const bf16_t*)(P.ws + WS_S5BB); const bf16_t* CC = (const bf16_t*)(P.ws + WS_S5CC);
    const bf16_t* PA = (const bf16_t*)(P.ws + WS_RA);
    const float ar = S5A[(dg * 64 + lane) * 2], ai = S5A[(dg * 64 + lane) * 2 + 1];
    float hr = h0re ? h0re[lane] : 0.f, hi = h0im ? h0im[lane] : 0.f;
    const bf16x8 zero8 = (bf16x8){0, 0, 0, 0, 0, 0, 0, 0};
    bf16x8 BBf[8], CCf[4];
#pragma unroll
    for (int mt = 0; mt < 8; ++mt) BBf[mt] = (gq < 2) ? *(const bf16x8*)(BB + ((size_t)dg * 128 + mt * 16 + st) * 16 + gq * 8) : zero8;
#pragma unroll
    for (int kk = 0; kk < 4; ++kk) CCf[kk] = *(const bf16x8*)(CC + ((size_t)dg * 16 + st) * 128 + kk * 32 + gq * 8);
    const int nch = L / 16;
    const int sgn = dir ? -1 : 1, tstart = dir ? tok0 + L - 1 : tok0;
    const bf16_t* ubase = PA + (size_t)tstart * 4096 + g * 16 + gq * 8;
    const long ustep = (long)sgn * 4096;
#define S5_LDU(c_) (((c_) < nch && gq < 2) ? *(const bf16x8*)(ubase + ustep * ((c_) * 16 + st)) : zero8)
#define S5_BU(Uv) do { _Pragma("unroll") for (int mt = 0; mt < 8; ++mt) { f32x4 d_ = (f32x4){0.f, 0.f, 0.f, 0.f}; \
        d_ = __builtin_amdgcn_mfma_f32_16x16x32_bf16(Uv, BBf[mt], d_, 0, 0, 0); *(LAS f32x4*)(wl + (mt * 16 + st) * S5_BROW + gq * 16) = d_; } } while (0)
#define S5_Y(c_) do { f32x4 y_ = (f32x4){0.f, 0.f, 0.f, 0.f}; \
        _Pragma("unroll") for (int kk = 0; kk < 4; ++kk) y_ = __builtin_amdgcn_mfma_f32_16x16x32_bf16(CCf[kk], Bh[kk], y_, 0, 0, 0);        \
        *(u32x2*)(Yout + (size_t)(tstart + sgn * ((c_) * 16 + st)) * 1024 + g * 16 + gq * 4) = (u32x2){pk2(y_[0], y_[1]), pk2(y_[2], y_[3])}; } while (0)
#define S5_ITER(DOY) do { \
        f32x4 br_[4], bi_[4]; \
        _Pragma("unroll") for (int j = 0; j < 4; ++j) { br_[j] = *(const LAS f32x4*)(wl + lane * S5_BROW + j * 16); bi_[j] = *(const LAS f32x4*)(wl + (64 + lane) * S5_BROW + j * 16); } \
        bf16x8 Bh[4]; \
        if (DOY) { _Pragma("unroll") for (int kk = 0; kk < 4; ++kk) Bh[kk] = *(const LAS bf16x8*)(hl + st * S5_HROW + (kk * 32 + gq * 8) * 2); } \
        const bf16x8 Un_ = S5_LDU(ch + 4); \
        S5_BU(Ua); \
        _Pragma("unroll") for (int s = 0; s < 16; ++s) { const float bur = br_[s >> 2][s & 3], bui = bi_[s >> 2][s & 3]; \
            const float nr = ar * hr - ai * hi + bur, ni = ar * hi + ai * hr + bui; hr = nr; hi = ni; \
            *(LAS bf16_t*)(hl + s * S5_HROW + lane * 2) = f2bf(hr); *(LAS bf16_t*)(hl + s * S5_HROW + (64 + lane) * 2) = f2bf(hi); } \
        if (DOY) S5_Y(ch - 1); \
        Ua = Ub; Ub = Uc; Uc = Un_; } while (0)
    bf16x8 Ua = S5_LDU(0), Ub = S5_LDU(1), Uc = S5_LDU(2);
    S5_BU(Ua);
    Ua = Ub; Ub = Uc; Uc = S5_LDU(3);
    int ch = 0;
    S5_ITER(false);
#pragma unroll 1
    for (ch = 1; ch < nch; ++ch) S5_ITER(true);
    { bf16x8 Bh[4];
#pragma unroll
      for (int kk = 0; kk < 4; ++kk) Bh[kk] = *(const LAS bf16x8*)(hl + st * S5_HROW + (kk * 32 + gq * 8) * 2);
      S5_Y(nch - 1); }
#undef S5_LDU
#undef S5_BU
#undef S5_Y
#undef S5_ITER
    if (fre) { fre[lane] = hr; fim[lane] = hi; }
}

DI void s5_phase(const Ctx& F, const Params& P) {
    bf16_t* YF = (bf16_t*)(P.ws + WS_RB + RB_YF); bf16_t* YB = (bf16_t*)(P.ws + WS_RB + RB_YB);
    for (int cs = F.bid; cs < 256; cs += F.G) {
        if (F.wave < 4) { const int sc = cs * 4 + F.wave, dg = sc & 127, b = sc >> 7;
            s5_chain(F, P, dg, TP + b * 4096, LS, P.in[I_S5RE] + (size_t)sc * 64, P.in[I_S5IM] + (size_t)sc * 64, nullptr, nullptr, (dg >> 6) ? YB : YF); }
        else { for (int k = 0; k < 4; ++k) { const int pc = (cs * 4 + (F.wave - 4)) * 4 + k, dg = pc & 127, b = pc >> 7;
            s5_chain(F, P, dg, b * 256, LP, nullptr, nullptr, P.out + O_SR + (size_t)pc * 64, P.out + O_SI + (size_t)pc * 64, (dg >> 6) ? YB : YF); } }
    }
}

DI void s5_combine(const Ctx& F, const Params& P) {
    const bf16_t* PA = (const bf16_t*)(P.ws + WS_RA); const bf16_t* YF = (const bf16_t*)(P.ws + WS_RB + RB_YF); const bf16_t* YB = (const bf16_t*)(P.ws + WS_RB + RB_YB);
    bf16_t* Y = (bf16_t*)(P.ws + WS_RB + RB_Y); const float* dsk = P.in[I_S5D];
    for (size_t e = (size_t)F.bid * NTHR + F.tid; e < (size_t)TOK * 128; e += (size_t)F.G * NTHR) { const size_t T = e >> 7; const int c8 = (int)(e & 127) * 8;
        const u32x4 uv = *(const u32x4*)(PA + T * 4096 + c8), fv = *(const u32x4*)(YF + T * 1024 + c8), bv = *(const u32x4*)(YB + T * 1024 + c8);
        const f32x4 d0 = *(const f32x4*)(dsk + c8), d1 = *(const f32x4*)(dsk + c8 + 4);
        float o[8];
        o[0] = gelu_tanh(d0.x * bflo(uv.x) + bflo(fv.x) + bflo(bv.x)); o[1] = gelu_tanh(d0.y * bfhi(uv.x) + bfhi(fv.x) + bfhi(bv.x));
        o[2] = gelu_tanh(d0.z * bflo(uv.y) + bflo(fv.y) + bflo(bv.y)); o[3] = gelu_tanh(d0.w * bfhi(uv.y) + bfhi(fv.y) + bfhi(bv.y));
        o[4] = gelu_tanh(d1.x * bflo(uv.z) + bflo(fv.z) + bflo(bv.z)); o[5] = gelu_tanh(d1.y * bfhi(uv.z) + bfhi(fv.z) + bfhi(bv.z));
        o[6] = gelu_tanh(d1.z * bflo(uv.w) + bflo(fv.w) + bflo(bv.w)); o[7] = gelu_tanh(d1.w * bfhi(uv.w) + bfhi(fv.w) + bfhi(bv.w));
        u32x4 w; w.x = pk2(o[0], o[1]); w.y = pk2(o[2], o[3]); w.z = pk2(o[4], o[5]); w.w = pk2(o[6], o[7]);
        *(u32x4*)(Y + T * 1024 + c8) = w; }
}
constexpr int PS_KROW = 272;
constexpr int PS_IDX_OFF = 2 * 128 * PS_KROW;
constexpr int PS_TAB_OFF = PS_IDX_OFF + 512 * 32;

DI void topk_insert(float (&a)[16], float x) {
#pragma unroll
    for (int j = 15; j >= 1; --j) a[j] = __builtin_amdgcn_fmed3f(a[j - 1], a[j], x);
    a[0] = fmaxf(a[0], x);
}

DI void peer_select(const Ctx& F, const Params& P, int layer) {
    LAS unsigned char* lds = F.lds;
    const bf16_t* Q = (const bf16_t*)(P.ws + WS_RA + RA_Q);
    int* SELI = (int*)(P.ws + WS_RA + RA_SELI); float* SELW = (float*)(P.ws + WS_RA + RA_SELW);
    const bf16_t* KEYS = (const bf16_t*)(P.ws + WS_PKEYS) + (size_t)layer * 8 * 2 * 128 * 128;
    const int q = F.lane & 31, hh = F.lane >> 5;
    LAS unsigned char* myidx = lds + PS_IDX_OFF + F.tid * 32;
    LAS unsigned char* tab = lds + PS_TAB_OFF;
    for (int wu = F.bid; wu < 256; wu += F.G) {
        const int h = wu & 7, chunk = wu >> 3;
        __syncthreads();
        for (int id = F.tid; id < 2 * 128 * 16; id += NTHR) { const int row = id >> 4, c16 = id & 15;
            *(LAS u32x4*)(lds + row * PS_KROW + c16 * 16) = *(const u32x4*)(KEYS + ((size_t)h * 256 + row) * 128 + c16 * 8); }
        if (F.tid < 16) { int cnt = 0;
            for (int a = 0; a < F.tid; ++a) cnt += 16 / (a + 1);
            for (int b = 0; b < 16 / (F.tid + 1); ++b) { tab[(cnt + b) * 2] = (unsigned char)F.tid; tab[(cnt + b) * 2 + 1] = (unsigned char)b; } }
        __syncthreads();
        for (int blk = F.wave; blk < 40; blk += 8) {
            const int T0 = chunk * 1280 + blk * 32;
            float lst[2][16];
#pragma unroll
            for (int side = 0; side < 2; ++side) {
                bf16x8 Qf[8];
                const bf16_t* qp = Q + (size_t)(T0 + q) * 2048 + h * 256 + side * 128 + hh * 8;
#pragma unroll
                for (int ks = 0; ks < 8; ++ks) Qf[ks] = *(const bf16x8*)(qp + ks * 16);
                float a[16];
#pragma unroll
                for (int j = 0; j < 16; ++j) a[j] = -3.0e38f;
#pragma unroll
                for (int nt = 0; nt < 4; ++nt) {
                    f32x16 S;
#pragma unroll
                    for (int i = 0; i < 16; ++i) S[i] = 0.f;
#pragma unroll
                    for (int ks = 0; ks < 8; ++ks) { const bf16x8 A = *(const LAS bf16x8*)(lds + (side * 128 + nt * 32 + q) * PS_KROW + (ks * 16 + hh * 8) * 2);
                        S = __builtin_amdgcn_mfma_f32_32x32x16_bf16(A, Qf[ks], S, 0, 0, 0); }
#pragma unroll
                    for (int i = 0; i < 16; ++i) { const int n = nt * 32 + (i & 3) + 8 * (i >> 2) + 4 * hh;
                        topk_insert(a, __uint_as_float((__float_as_uint(S[i]) & 0xffffff80u) | (unsigned)n)); }
                }
                float pb[16];
#pragma unroll
                for (int j = 0; j < 16; ++j) pb[j] = __shfl_xor(a[j], 32);
#pragma unroll
                for (int j = 0; j < 16; ++j) topk_insert(a, pb[j]);
#pragma unroll
                for (int j = 0; j < 16; ++j) { lst[side][j] = a[j]; myidx[side * 16 + j] = (unsigned char)(__float_as_uint(a[j]) & 0x7fu); }
            }
            float cb[16];
#pragma unroll
            for (int j = 0; j < 16; ++j) cb[j] = -3.0e38f;
            { int cid = 0;
#pragma unroll
              for (int a = 0; a < 16; ++a)
#pragma unroll
                  for (int b = 0; b < 16 / (a + 1); ++b) {
                      const float sa = __uint_as_float(__float_as_uint(lst[0][a]) & 0xffffff80u), sb = __uint_as_float(__float_as_uint(lst[1][b]) & 0xffffff80u);
                      topk_insert(cb, __uint_as_float((__float_as_uint(sa + sb) & 0xffffffc0u) | (unsigned)cid)); ++cid; } }
            const float mx = __uint_as_float(__float_as_uint(cb[0]) & 0xffffffc0u);
            float e[16], den = 0.f;
#pragma unroll
            for (int j = 0; j < 16; ++j) { e[j] = __expf(__uint_as_float(__float_as_uint(cb[j]) & 0xffffffc0u) - mx); den += e[j]; }
            const float rden = 1.f / den;
#pragma unroll
            for (int j = 0; j < 16; ++j) {
                if ((j >> 3) == hh) { const int cid = (int)(__float_as_uint(cb[j]) & 0x3fu);
                    const int a = tab[cid * 2], b = tab[cid * 2 + 1];
                    const int eidx = (int)myidx[a] * 128 + (int)myidx[16 + b];
                    SELI[(size_t)(T0 + q) * 128 + h * 16 + j] = eidx; SELW[(size_t)(T0 + q) * 128 + h * 16 + j] = e[j] * rden; }
            }
        }
    }
    __syncthreads();
}

DI u32x16 fp6_unpack_bf16(u32x4 a, u32x2 b) { const u32x6 pk = {a.x, a.y, a.z, a.w, b.x, b.y}; return __builtin_bit_cast(u32x16, __builtin_amdgcn_cvt_scalef32_pk32_bf16_fp6(pk, 1.0f)); }
DI f32x32 fp6_unpack(u32x4 a, u32x2 b) { const u32x6 pk = {a.x, a.y, a.z, a.w, b.x, b.y}; return __builtin_amdgcn_cvt_scalef32_pk32_f32_fp6(pk, 1.0f); }
constexpr int GN = 4;
template <bool NEXTNORM>
DI void peer_gather(const Ctx& F, const Params& P, const float* modl, int layer, const float* ngain, const float* nmodl) {
    const bf16_t* H2 = (const bf16_t*)(P.ws + WS_HM);
    const unsigned char* TU = P.ws + WS_TBLU + (size_t)layer * 16384 * PT_ROWB; const unsigned char* TV = P.ws + WS_TBLV + (size_t)layer * 16384 * PT_ROWB;
    const float* SCU = (const float*)(P.ws + WS_SC) + layer * 16384; const float* SCV = (const float*)(P.ws + WS_SC) + (2 + layer) * 16384;
    const int* SELI = (const int*)(P.ws + WS_RA + RA_SELI); const float* SELW = (const float*)(P.ws + WS_RA + RA_SELW);
    float* X = P.out + O_Y;
    const int lane = lane_id();
    const int stride = F.G * 8;
    for (int T0 = F.bid * 8 + F.wave; T0 < TOK; T0 += 2 * stride) {
        const bool two = (T0 + stride < TOK);
        const int Tt[2] = {T0, two ? T0 + stride : T0};
        u32x4 xw[2][4]; int e0[2], e1[2]; float g0[2], g1[2], d0[2], d1[2];
#pragma unroll
        for (int t = 0; t < 2; ++t) {
#pragma unroll
            for (int q4 = 0; q4 < 4; ++q4) xw[t][q4] = *(const u32x4*)(H2 + (size_t)Tt[t] * DM + lane * 32 + q4 * 8);
            e0[t] = SELI[(size_t)Tt[t] * 128 + lane]; e1[t] = SELI[(size_t)Tt[t] * 128 + 64 + lane];
            g0[t] = SELW[(size_t)Tt[t] * 128 + lane]; g1[t] = SELW[(size_t)Tt[t] * 128 + 64 + lane]; d0[t] = 0.f; d1[t] = 0.f; }
#pragma unroll 1
        for (int kb = 0; kb < 128; kb += GN) {
            u32x4 ura[2][GN]; u32x2 urb[2][GN];
#pragma unroll
            for (int j = 0; j < GN; ++j)
#pragma unroll
                for (int t = 0; t < 2; ++t) { const int k = kb + j; const int e = __builtin_amdgcn_readlane(k < 64 ? e0[t] : e1[t], k & 63);
                    const unsigned char* up = TU + (size_t)e * PT_ROWB;
                    ura[t][j] = *(const u32x4*)(up + lane * 16); urb[t][j] = *(const u32x2*)(up + 1024 + lane * 8); }
#pragma unroll
            for (int j = 0; j < GN; ++j) { float pt[2];
#pragma unroll
                for (int t = 0; t < 2; ++t) { const u32x16 r = fp6_unpack_bf16(ura[t][j], urb[t][j]);
                    float sa = 0.f, sb = 0.f, sc2 = 0.f, sd = 0.f;
#pragma unroll
                    for (int i = 0; i < 4; ++i) { const unsigned x0 = xw[t][i].x, x1 = xw[t][i].y, x2 = xw[t][i].z, x3 = xw[t][i].w;
                        sa = dot2bf(r[4 * i], x0, sa); sb = dot2bf(r[4 * i + 1], x1, sb); sc2 = dot2bf(r[4 * i + 2], x2, sc2); sd = dot2bf(r[4 * i + 3], x3, sd); }
                    pt[t] = (sa + sb) + (sc2 + sd); }
                const float sm0 = wave_sum(pt[0]), sm1 = wave_sum(pt[1]); const int k = kb + j;
                if (k < 64) { if (lane == k) { d0[0] = sm0; d0[1] = sm1; } } else { if (lane == k - 64) { d1[0] = sm0; d1[1] = sm1; } } }
        }
        float cf0[2], cf1[2];
#pragma unroll
        for (int t = 0; t < 2; ++t) { cf0[t] = g0[t] * gelu_tanh(d0[t] * SCU[e0[t]]) * SCV[e0[t]]; cf1[t] = g1[t] * gelu_tanh(d1[t] * SCU[e1[t]]) * SCV[e1[t]]; }
        f32x2 acc[2][16];
#pragma unroll
        for (int t = 0; t < 2; ++t)
#pragma unroll
            for (int i = 0; i < 16; ++i) acc[t][i] = (f32x2){0.f, 0.f};
#pragma unroll 1
        for (int kb = 0; kb < 128; kb += GN) {
            u32x4 vra[2][GN]; u32x2 vrb[2][GN]; float cf[2][GN];
#pragma unroll
            for (int j = 0; j < GN; ++j)
#pragma unroll
                for (int t = 0; t < 2; ++t) { const int k = kb + j; const int e = __builtin_amdgcn_readlane(k < 64 ? e0[t] : e1[t], k & 63);
                    cf[t][j] = __builtin_bit_cast(float, __builtin_amdgcn_readlane(__builtin_bit_cast(int, k < 64 ? cf0[t] : cf1[t]), k & 63));
                    const unsigned char* vp = TV + (size_t)e * PT_ROWB;
                    vra[t][j] = *(const u32x4*)(vp + lane * 16); vrb[t][j] = *(const u32x2*)(vp + 1024 + lane * 8); }
#pragma unroll
            for (int j = 0; j < GN; ++j)
#pragma unroll
                for (int t = 0; t < 2; ++t) { const f32x32 r = fp6_unpack(vra[t][j], vrb[t][j]);
                    const f32x2 c2 = (f32x2){cf[t][j], cf[t][j]};
#pragma unroll
                    for (int i = 0; i < 16; ++i) acc[t][i] += c2 * (f32x2){r[2 * i], r[2 * i + 1]}; }
        }
#pragma unroll
        for (int t = 0; t < 2; ++t) {
            if (t == 1 && !two) break;
            const int T = Tt[t];
            const float* gate = modl + (size_t)(cond_of(T) * 6 + 5) * DM;
            f32x4 xn[8]; float ss = 0.f;
#pragma unroll
            for (int q4 = 0; q4 < 8; ++q4) { const int col = lane * 32 + q4 * 4; float* xp = X + (size_t)T * DM + col;
                const f32x4 gv = *(const f32x4*)(gate + col), x0 = *(const f32x4*)(xp);
                const f32x4 r = x0 + gv * (f32x4){acc[t][q4 * 2].x, acc[t][q4 * 2].y, acc[t][q4 * 2 + 1].x, acc[t][q4 * 2 + 1].y};
                *(f32x4*)(xp) = r; xn[q4] = r; ss += r.x * r.x + r.y * r.y + r.z * r.z + r.w * r.w; }
            if (NEXTNORM) {
                ss = wave_sum(ss);
                const float rstd = rsqrtf(ss * (1.f / DM) + NORM_EPS);
                const float* sh = nmodl + (size_t)(cond_of(T) * 6 + 0) * DM; const float* sc = sh + DM;
                bf16_t* H = (bf16_t*)(P.ws + WS_HM);
#pragma unroll
                for (int q4 = 0; q4 < 8; ++q4) { const int col = lane * 32 + q4 * 4;
                    const f32x4 g4 = *(const f32x4*)(ngain + col), s4 = *(const f32x4*)(sc + col), h4 = *(const f32x4*)(sh + col);
                    const f32x4 o = xn[q4] * rstd * g4 * (s4 + 1.f) + h4;
                    *(u32x2*)(H + (size_t)T * DM + col) = (u32x2){pk2(o.x, o.y), pk2(o.z, o.w)}; }
            }
        }
    }
}
constexpr int NPHASE = 22;

__global__ void __launch_bounds__(NTHR, 2) mega(Params P) {
    extern __shared__ __attribute__((aligned(16))) unsigned char lds_raw[];
    Ctx F;
    F.lds = (LAS unsigned char*)lds_raw; F.tid = threadIdx.x; F.lane = F.tid & 63; F.wave = __builtin_amdgcn_readfirstlane(F.tid >> 6); F.G = gridDim.x; F.bid = blockIdx.x;
    const int lo = P.ph_lo, hi = P.ph_hi;
    volatile LAS unsigned* xbw = (volatile LAS unsigned*)(F.lds + LDS_BYTES - 16);
    if (F.tid == 0) { xbw[0] = 0u; xbw[1] = 0u; xbw[2] = 0u; xbw[3] = 0u; }
    __syncthreads();
    if (hi - lo > 1) (void)xcd_barrier_post((unsigned*)(P.ws + WS_CTL), xbw);
#define GRID_BARRIER() do { XcdBarrier bar_; bar_.bar = (unsigned*)(P.ws + WS_CTL); bar_.x = xb_xcc_id(); bar_.st = (volatile LAS unsigned*)(F.lds + LDS_BYTES - 16); xcd_barrier(bar_); } while (0)
#define PH(k, ...) if (lo <= (k) && (k) < hi) { { __VA_ARGS__ } if ((k) + 1 < hi) GRID_BARRIER(); }
#define MOD0 ((const float*)(P.ws + WS_MOD))
#define MOD1 ((const float*)(P.ws + WS_MOD) + 9 * 12288)
#define HM ((bf16_t*)(P.ws + WS_HM))
#define RA ((bf16_t*)(P.ws + WS_RA))
#define X (P.out + O_Y)

    PH(0, prologue(F, P);)
    PH(1, adaln_reduce(F, P);)
    PH(2, norm_phase(F, P.in[I_XP], P.in[I_XS], P.in[I_NMIXG], MOD0, 0, HM);)
    PH(3, { EpiBf16 E{RA, 4096}; run_gemm(F, HM, (const bf16_t*)(P.ws + WS_WEVIN) + (size_t)2048 * 2048, 4096, 2048, E); })
    PH(4, prep_a(F, P);)
    PH(5, { EpiBf16 E{RA, 2048}; run_gemm(F, HM, (const bf16_t*)(P.ws + WS_WEVIN), 2048, 2048, E); })
    PH(6, attn_phase<0>(F, P); attn_phase<1>(F, P); hyena_phase(F, P);)
    PH(7, hyena_post(F, P);)
    PH(8, { EpiResid E{P.in[I_XP], P.in[I_XS], X, MOD0, 2}; run_gemm(F, HM, (const bf16_t*)(P.ws + WS_WEVOUT), 2048, 2048, E); })
    PH(9, norm_phase(F, X, X + (size_t)TP * DM, P.in[I_NFFNG], MOD0, 3, HM);)
    PH(10, { EpiBf16 E{RA, 2048}; run_gemm(F, HM, (const bf16_t*)(P.ws + WS_WPQ), 2048, 2048, E); })
    PH(11, peer_select(F, P, 0);)
    PH(12, peer_gather<true>(F, P, MOD0, 0, P.in[I_NMIXG] + DM, MOD1);)
    PH(13, { EpiBf16 E{RA, 4096}; run_gemm(F, HM, (const bf16_t*)(P.ws + WS_WODIN), 4096, 2048, E); })
    PH(14, prep_c(F, P); s5_phase(F, P);)
    PH(15, { const float lam = diff_lambda(F, P); attn_diff_phase<false>(F, P, lam); attn_diff_phase<true>(F, P, lam); } s5_combine(F, P);)
    PH(16, { EpiGlu E{(const bf16_t*)(P.ws + WS_RB + RB_Y), HM, P.in[I_GLUB]}; run_gemm(F, (const bf16_t*)(P.ws + WS_RB + RB_Y), (const bf16_t*)(P.ws + WS_WGLU), 1024, 1024, E); })
    PH(17, { EpiResid E{X, X + (size_t)TP * DM, X, MOD1, 2}; run_gemm(F, HM, (const bf16_t*)(P.ws + WS_WODOUT), 2048, 2048, E); })
    PH(18, norm_phase(F, X, X + (size_t)TP * DM, P.in[I_NFFNG] + DM, MOD1, 3, HM);)
    PH(19, { EpiBf16 E{RA, 2048}; run_gemm(F, HM, (const bf16_t*)(P.ws + WS_WPQ) + (size_t)2048 * 2048, 2048, 2048, E); })
    PH(20, peer_select(F, P, 1);)
    PH(21, peer_gather<false>(F, P, MOD1, 1, nullptr, nullptr);)
#undef MOD0
#undef MOD1
#undef HM
#undef RA
#undef X
#undef PH
#undef GRID_BARRIER
}

extern "C" void kernel_launch(void* const* d_in, const int* in_sizes, int n_in, void* d_out, int out_size, void* d_ws, size_t ws_size, hipStream_t stream) {
    static int grid = 0;
    if (grid == 0) {
        if (n_in != N_IN || (size_t)out_size != O_END || ws_size < WS_END) { fprintf(stderr, "kernel_launch: unexpected shapes (n_in %d, out %d, ws %zu, need %zu)\n", n_in, out_size, ws_size, (size_t)WS_END); grid = -1; return; }
        int dev = 0, cus = 0;
        if (hipGetDevice(&dev) != hipSuccess || hipDeviceGetAttribute(&cus, hipDeviceAttributeMultiprocessorCount, dev) != hipSuccess) { grid = -1; return; }
        if (hipFuncSetAttribute((const void*)mega, hipFuncAttributeMaxDynamicSharedMemorySize, LDS_BYTES) != hipSuccess) { fprintf(stderr, "kernel_launch: hipFuncSetAttribute failed\n"); grid = -1; return; }
        int per_cu = 0;
        if (hipOccupancyMaxActiveBlocksPerMultiprocessor(&per_cu, (const void*)mega, NTHR, LDS_BYTES) != hipSuccess || per_cu < 1) { fprintf(stderr, "kernel_launch: occupancy query says %d blocks per CU\n", per_cu); }
        (void)hipGetLastError();
        grid = cus;
    }
    if (grid < 0) return;
    (void)hipMemsetAsync((char*)d_ws + WS_CTL, 0, 65536, stream);
    Params p; memset(&p, 0, sizeof(p));
    for (int i = 0; i < N_IN; ++i) p.in[i] = (const float*)d_in[i];
    p.out = (float*)d_out; p.ws = (unsigned char*)d_ws;
    p.ph_lo = 0; p.ph_hi = NPHASE;
    hipLaunchKernelGGL(mega, dim3(grid), dim3(NTHR), LDS_BYTES, stream, p);
}
```

```cpp
#include <hip/hip_runtime.h>
#include <cstdio>
#include <cstring>
#include <cstdint>

typedef unsigned short bf16_t;
typedef short bf16x8 __attribute__((ext_vector_type(8)));
typedef short s16x4 __attribute__((ext_vector_type(4)));
typedef float f32x2 __attribute__((ext_vector_type(2)));
typedef float f32x4 __attribute__((ext_vector_type(4)));
typedef float f32x16 __attribute__((ext_vector_type(16)));
typedef unsigned u32x2 __attribute__((ext_vector_type(2)));
typedef unsigned u32x4 __attribute__((ext_vector_type(4)));
typedef __bf16 bf16x2_t __attribute__((ext_vector_type(2)));
typedef float f32x32 __attribute__((ext_vector_type(32)));
typedef unsigned u32x6 __attribute__((ext_vector_type(6)));
typedef unsigned u32x16 __attribute__((ext_vector_type(16)));
typedef __bf16 bf16x32_t __attribute__((ext_vector_type(32)));

#define DI __device__ __forceinline__

constexpr int NTHR = 512;
constexpr int DM = 2048;
constexpr int TP = 8192;
constexpr int TS = 32768;
constexpr int TOK = TP + TS;
constexpr int LP = 256, LS = 4096;
constexpr float NORM_EPS = 1e-6f;
constexpr float LOG2E = 1.4426950408889634f;

enum { I_XP = 0, I_XS, I_C, I_CNK, I_CNV, I_CDK, I_CDV, I_S5RE, I_S5IM, I_CCTX, I_MODW, I_MODB, I_NMIXG, I_NFFNG, I_EVWIN, I_EVWOUT, I_NAQG, I_NAKG, I_RPB,
       I_HYCW, I_HYCB, I_HYW1, I_HYB1, I_HYF1, I_HYW2, I_HYB2, I_HYF2, I_HYW3, I_HYDEC, I_HYBIAS, I_ODWIN, I_ODWOUT, I_S5LRE, I_S5LIM, I_S5LDT, I_S5BRE, I_S5BIM,
       I_S5CRE, I_S5CIM, I_S5D, I_GLUW, I_GLUB, I_DQG, I_DKG, I_LQ1, I_LK1, I_LQ2, I_LK2, I_SUBG, I_PWQ, I_PKEYS, I_PU, I_PV, N_IN };

constexpr size_t O_Y = 0;
constexpr size_t O_NAK = 83886080, O_NAV = 92274688, O_DK = 100663296, O_DV = 109051904, O_SR = 117440512, O_SI = 117702656, O_END = 117964800;

constexpr size_t al256(size_t x) { return (x + 255) & ~(size_t)255; }
constexpr size_t WS_CTL = 0;
constexpr size_t WS_MODP = 65536;
constexpr size_t WS_MOD = WS_MODP + (size_t)2 * 16 * 9 * 12288 * 4;
constexpr size_t WS_WEVIN = al256(WS_MOD + (size_t)2 * 9 * 12288 * 4);
constexpr size_t WS_WEVOUT = WS_WEVIN + (size_t)6144 * 2048 * 2;
constexpr size_t WS_WODIN = WS_WEVOUT + (size_t)2048 * 2048 * 2;
constexpr size_t WS_WODOUT = WS_WODIN + (size_t)4096 * 2048 * 2;
constexpr size_t WS_WPQ = WS_WODOUT + (size_t)2048 * 2048 * 2;
constexpr size_t WS_WGLU = WS_WPQ + (size_t)2 * 2048 * 2048 * 2;
constexpr size_t WS_PKEYS = WS_WGLU + (size_t)1024 * 1024 * 2;
constexpr size_t WS_CNK = WS_PKEYS + (size_t)2 * 8 * 2 * 128 * 128 * 2;
constexpr size_t WS_CNVT = WS_CNK + (size_t)8 * 256 * 1024 * 2;
constexpr size_t WS_CDK = WS_CNVT + (size_t)8 * 256 * 1024 * 2;
constexpr size_t WS_CDVT = WS_CDK + (size_t)8 * 256 * 1024 * 2;
constexpr size_t WS_S5A = WS_CDVT + (size_t)8 * 256 * 1024 * 2;
constexpr size_t WS_S5BB = WS_S5A + (size_t)128 * 64 * 2 * 4;
constexpr size_t WS_S5CC = WS_S5BB + (size_t)128 * 128 * 16 * 2;
constexpr int KRL_S = 8208, KRL_P = 528;
constexpr size_t WS_KRS = WS_S5CC + (size_t)128 * 16 * 128 * 2;
constexpr size_t WS_KRP = al256(WS_KRS + (size_t)2 * 1024 * KRL_S * 2);
constexpr size_t WS_TBLU = al256(WS_KRP + (size_t)2 * 1024 * KRL_P * 2);
constexpr size_t WS_TBLV = WS_TBLU + (size_t)16384 * 2048 * 2;
constexpr size_t WS_HM = WS_TBLV + (size_t)16384 * 2048 * 2;
constexpr size_t WS_RA = WS_HM + (size_t)TOK * 2048 * 2;
constexpr size_t WS_RB = WS_RA + (size_t)TOK * 4096 * 2;
constexpr size_t WS_VT = WS_RB + (size_t)3072 * TOK * 2;
constexpr size_t WS_SC = WS_VT + (size_t)TOK * 1024 * 2;
constexpr size_t WS_END = WS_SC + (size_t)4 * 16384 * 4;
constexpr size_t RA_Q = 0;
constexpr size_t RA_SELI = (size_t)TOK * 2048 * 2;
constexpr size_t RA_SELW = RA_SELI + (size_t)TOK * 128 * 4;
constexpr size_t RA_CF = RA_SELW + (size_t)TOK * 128 * 4;
constexpr size_t RA_ZC = (size_t)TOK * 2048 * 2;
constexpr size_t RB_YF = 0, RB_YB = (size_t)TOK * 1024 * 2, RB_Y = (size_t)2 * TOK * 1024 * 2;
constexpr size_t VT_S = (size_t)TP * 1024 * 2;

constexpr int LDS_BYTES = 147456;

struct Params { const float* in[N_IN]; float* out; unsigned char* ws; int ph_lo, ph_hi; };

DI float bf2f(bf16_t b) { return __uint_as_float(((unsigned)b) << 16); }
DI float bflo(unsigned w) { return __uint_as_float(w << 16); }
DI float bfhi(unsigned w) { return __uint_as_float(w & 0xffff0000u); }
DI unsigned pk2(float a, float b) { f32x2 v = {a, b}; return __builtin_bit_cast(unsigned, __builtin_convertvector(v, bf16x2_t)); }
DI float dot2bf(unsigned a, unsigned b, float c) { return __builtin_amdgcn_fdot2_f32_bf16(__builtin_bit_cast(bf16x2_t, a), __builtin_bit_cast(bf16x2_t, b), c, false); }
DI bf16_t f2bf(float a) { return (bf16_t)(pk2(a, 0.f) & 0xffffu); }
DI float dpp_xor1(float v) { return __builtin_bit_cast(float, __builtin_amdgcn_update_dpp(0, __builtin_bit_cast(int, v), 0xB1, 0xF, 0xF, true)); }
DI float dpp_xor2(float v) { return __builtin_bit_cast(float, __builtin_amdgcn_update_dpp(0, __builtin_bit_cast(int, v), 0x4E, 0xF, 0xF, true)); }
DI float wave_sum(float v) {
    v += dpp_xor1(v); v += dpp_xor2(v);
    v += __builtin_bit_cast(float, __builtin_amdgcn_update_dpp(0, __builtin_bit_cast(int, v), 0x141, 0xF, 0xF, true));
    v += __builtin_bit_cast(float, __builtin_amdgcn_update_dpp(0, __builtin_bit_cast(int, v), 0x140, 0xF, 0xF, true));
    v += __builtin_bit_cast(float, __builtin_amdgcn_update_dpp(0, __builtin_bit_cast(int, v), 0x142, 0xA, 0xF, false));
    v += __builtin_bit_cast(float, __builtin_amdgcn_update_dpp(0, __builtin_bit_cast(int, v), 0x143, 0xC, 0xF, false));
    return __builtin_bit_cast(float, __builtin_amdgcn_readlane(__builtin_bit_cast(int, v), 63));
}
DI float gelu_tanh(float x) {
    const float u = 0.7978845608028654f * (x + 0.044715f * x * x * x);
    const float e = __expf(2.f * u);
    const float t = 1.f - 2.f / (e + 1.f);
    return 0.5f * x * (1.f + t);
}
DI float wave_max(float v) {
    v = fmaxf(v, dpp_xor1(v)); v = fmaxf(v, dpp_xor2(v));
    v = fmaxf(v, __builtin_bit_cast(float, __builtin_amdgcn_update_dpp(0, __builtin_bit_cast(int, v), 0x141, 0xF, 0xF, true)));
    v = fmaxf(v, __builtin_bit_cast(float, __builtin_amdgcn_update_dpp(0, __builtin_bit_cast(int, v), 0x140, 0xF, 0xF, true)));
    v = fmaxf(v, __builtin_bit_cast(float, __builtin_amdgcn_update_dpp(0, __builtin_bit_cast(int, v), 0x142, 0xA, 0xF, false)));
    v = fmaxf(v, __builtin_bit_cast(float, __builtin_amdgcn_update_dpp(0, __builtin_bit_cast(int, v), 0x143, 0xC, 0xF, false)));
    return __builtin_bit_cast(float, __builtin_amdgcn_readlane(__builtin_bit_cast(int, v), 63));
}
DI f32x2 fp8x2_lo(unsigned w) { return __builtin_amdgcn_cvt_pk_f32_fp8((int)w, false); }
DI f32x2 fp8x2_hi(unsigned w) { return __builtin_amdgcn_cvt_pk_f32_fp8((int)w, true); }
DI unsigned pk_fp8x4(float a, float b, float c, float d) { int r = 0; r = __builtin_amdgcn_cvt_pk_fp8_f32(a, b, r, false); r = __builtin_amdgcn_cvt_pk_fp8_f32(c, d, r, true); return (unsigned)r; }
DI int lane_id() { return (int)__builtin_amdgcn_mbcnt_hi(~0u, __builtin_amdgcn_mbcnt_lo(~0u, 0u)); }
DI int cond_of(int T) { return T < TP ? 0 : 1 + ((T - TP) >> 12); }
#define XB_TMO      128
#define XB_XCNT(j)  (256  + 64 * (j))
#define XB_XSUB(j)  (1280 + 64 * (j))
#define XB_XGEN(j)  (2304 + 64 * (j))
#define XB_TOP      3328
#define XB_TOPGEN   3392
#define XCD_BAR_WORDS 3456
#define XB_SPIN_CAP (1u << 26)
#define LAS __attribute__((address_space(3)))

__device__ __forceinline__ unsigned xb_ld(unsigned* p)              { return __hip_atomic_load(p, __ATOMIC_RELAXED, __HIP_MEMORY_SCOPE_AGENT); }
__device__ __forceinline__ unsigned xb_add(unsigned* p, unsigned v) { return __hip_atomic_fetch_add(p, v, __ATOMIC_RELAXED, __HIP_MEMORY_SCOPE_AGENT); }
__device__ __forceinline__ unsigned xb_xcc_id() { return (unsigned)__builtin_amdgcn_s_getreg((3 << 11) | 20) & 0xFu; }
#define XB_SPIN(cond, bar) do { unsigned _sp = 0; while (cond) { __builtin_amdgcn_s_sleep(1); \
    if ((++_sp & 255u) == 0u) { if (xb_ld(&(bar)[XB_TMO])) break; if (_sp > XB_SPIN_CAP) { atomicAdd(&(bar)[XB_TMO], 1u); break; } } } } while (0)

struct XcdBarrier {
    unsigned* bar; unsigned x;
    volatile LAS unsigned* st;
};

__device__ __forceinline__ XcdBarrier xcd_barrier_post(unsigned* bar, volatile LAS unsigned* st) {
    XcdBarrier b; b.bar = bar; b.x = xb_xcc_id(); b.st = st;
    if (threadIdx.x == 0) (void)xb_add(&bar[XB_XCNT(b.x)], 1u);
    return b;
}
__device__ __forceinline__ void xcd_barrier_complete(unsigned* bar, unsigned x, unsigned& nloc, unsigned& nx) {
    const unsigned G = gridDim.x * gridDim.y * gridDim.z;
    unsigned sum, cnt, mine, sp = 0u;
    for (;;) {
        sum = 0u; cnt = 0u; mine = 0u;
#pragma unroll
        for (unsigned j = 0; j < 16; ++j) { const unsigned c = xb_ld(&bar[XB_XCNT(j)]); sum += c; cnt += (c > 0u) ? 1u : 0u; mine = (j == x) ? c : mine; }
        if (sum == G) break;
        __builtin_amdgcn_s_sleep(1);
        if ((++sp & 255u) == 0u) { if (xb_ld(&bar[XB_TMO])) break; if (sp > XB_SPIN_CAP) { atomicAdd(&bar[XB_TMO], 1u); break; } }
    }
    nloc = mine > 0u ? mine : 1u; nx = cnt > 0u ? cnt : 1u;
}

__device__ __forceinline__ void xcd_barrier(const XcdBarrier& b) {
    asm volatile("s_waitcnt vmcnt(0)" ::: "memory");
    __syncthreads();
    if (threadIdx.x == 0) {
        unsigned* bar = b.bar;
        __builtin_amdgcn_s_waitcnt(0);
        unsigned nloc = b.st[0], nx = b.st[1];
        if (nloc == 0u) { xcd_barrier_complete(bar, b.x, nloc, nx); b.st[0] = nloc; b.st[1] = nx; }
        const unsigned old = xb_add(&bar[XB_XSUB(b.x)], 1u);
        const unsigned gen = old / nloc;
        if (old + 1u == (gen + 1u) * nloc) {
            __builtin_amdgcn_fence(__ATOMIC_RELEASE, "agent");
            asm volatile("s_waitcnt vmcnt(0)" ::: "memory");
            const unsigned og = xb_add(&bar[XB_TOP], 1u);
            const unsigned tg = og / nx;
            if (og + 1u == (tg + 1u) * nx) xb_add(&bar[XB_TOPGEN], 1u);
            else XB_SPIN(xb_ld(&bar[XB_TOPGEN]) == tg, bar);
            __builtin_amdgcn_fence(__ATOMIC_ACQUIRE, "agent");
            xb_add(&bar[XB_XGEN(b.x)], 1u);
            asm volatile("s_waitcnt vmcnt(0)" ::: "memory");
        } else {
            XB_SPIN(xb_ld(&bar[XB_XGEN(b.x)]) == gen, bar);
            __builtin_amdgcn_fence(__ATOMIC_ACQUIRE, "agent");
            asm volatile("s_waitcnt vmcnt(0)" ::: "memory");
        }
    }
    __syncthreads();
}
namespace pg8 {
#define PG8_LAS __attribute__((address_space(3)))
typedef unsigned short bf16_t;
typedef short bf16x8 __attribute__((ext_vector_type(8)));
typedef float f32x4 __attribute__((ext_vector_type(4)));
typedef unsigned u32x4 __attribute__((ext_vector_type(4)));
constexpr int BM = 256, BK = 64, HALF = 128, HTB = HALF * BK * 2  , STAGE_BYTES = 8 * HTB, NXCD = 8, WGM = 8;

__host__ __device__ __forceinline__ int lds_byte(int r, int c) { const int st = (r >> 4) * 2 + (c >> 5), rr = r & 15, cc = c & 31, ob = rr * 64 + cc * 2; return st * 1024 + (ob ^ (((ob >> 9) & 1) << 5)); }
__host__ __device__ __forceinline__ void stage_rc(int b, int& R, int& C) { const int st = b / 1024, sb = b % 1024, swz = sb ^ (((sb >> 9) & 1) << 5); R = (st >> 1) * 16 + swz / 64; C = (st & 1) * 32 + (swz % 64) / 2; }
__host__ __device__ __forceinline__ int perm32(int rho) { const int n = rho >> 4, i = rho & 15; return 8 * (i >> 2) + 4 * n + (i & 3); }

struct Unit { int pm, pn; };
struct Gemm { const bf16_t* A; const bf16_t* Bt; int M, N, K; };

struct StaticOrder {
    int nM, nN, nwg, G, c;
    __host__ __device__ void init(int M, int N, int G_, int c_) { nM = M / BM; nN = N / BM; nwg = nM * nN; G = G_; c = c_; }
    __host__ __device__ bool next(int i, Unit& u) const {
        const long L = (long)i * G + c; if (L >= nwg) return false;
        int wgid = (int)L; { const int q = nwg / NXCD, r = nwg % NXCD, xcd = wgid % NXCD, off = wgid / NXCD; wgid = (xcd < r ? xcd * (q + 1) : r * (q + 1) + (xcd - r) * q) + off; }
        const int nig = WGM * nN, gid = wgid / nig, fm = gid * WGM, gsz = (nM - fm) < WGM ? (nM - fm) : WGM;
        u.pm = fm + ((wgid % nig) % gsz); u.pn = (wgid % nig) / gsz; return true;
    }
    __device__ __forceinline__ void a_ready(const Unit&) const {}
    __device__ __forceinline__ void done(const Unit&) const {}
};
__device__ __forceinline__ unsigned cvt_pk_bf16(float lo, float hi) { unsigned r; asm volatile("v_cvt_pk_bf16_f32 %0, %1, %2" : "=v"(r) : "v"(lo), "v"(hi)); return r; }
template <class Epi, class Sched, bool STAMP = false>
__device__ __forceinline__ void gemm_phase(PG8_LAS unsigned char* lds, const Gemm g, const Sched& S, const Epi& E, unsigned long long* stamps) {
    const int tid = threadIdx.x, wid = __builtin_amdgcn_readfirstlane(tid >> 6), lane = tid & 63, wr = wid >> 2, wc = wid & 3, fr = lane & 15, fq = lane >> 4;
    const int K = g.K, nt = K / BK;
    int ts_lo = 0, ts_hi = 0, nts = 0; const unsigned long long rt_entry = STAMP ? (unsigned long long)wall_clock64() : 0ull;
#define PG8_STAMP() do { if (STAMP && wid == 0 && nts < 64) { const unsigned long long _c = (unsigned long long)clock64(); \
        ts_lo = (lane == nts) ? (int)(unsigned)_c : ts_lo; ts_hi = (lane == nts) ? (int)(unsigned)(_c >> 32) : ts_hi; ++nts; } } while (0)
    PG8_STAMP();
    unsigned voffA[2], voffB[2];
#pragma unroll
    for (int i = 0; i < 2; ++i) { int R, C; stage_rc(tid * 16 + i * 8192, R, C); const int Rb = Epi::PERM ? ((R & ~31) + perm32(R & 31)) : R;
        voffA[i] = (unsigned)(R * K + C) * 2u; voffB[i] = (unsigned)(Rb * K + C) * 2u; }
    const size_t kstep = (size_t)(BK * 2);
    const size_t hstep = (size_t)HALF * K * 2;
    const size_t tstep = 2 * hstep;
    const unsigned ldsw = (unsigned)wid * 1024u;
    const int aoff = lds_byte(wr * 64 + fr, fq * 8), boff = lds_byte(wc * 32 + fr, fq * 8);
#define PG8_SA(b, h) (((b) * 2 + (h)) * HTB)
#define PG8_SB(b, h) ((4 + (b) * 2 + (h)) * HTB)
#define PG8_STAGE(bufoff, gbase, voff) do { _Pragma("unroll") for (int _i = 0; _i < 2; ++_i) \
        __builtin_amdgcn_global_load_lds((const unsigned*)((const char*)(gbase) + (voff)[_i]), (PG8_LAS unsigned*)(lds + (bufoff) + ldsw + _i * 8192), 16, 0, 0); } while (0)
#define PG8_LDA(dst, b, h) do { _Pragma("unroll") for (int m = 0; m < 4; ++m) _Pragma("unroll") for (int k = 0; k < 2; ++k) dst[m][k] = *(const PG8_LAS bf16x8*)(lds + PG8_SA(b, h) + aoff + m * 2048 + k * 1024); } while (0)
#define PG8_LDB(dst, b, h) do { _Pragma("unroll") for (int n = 0; n < 2; ++n) _Pragma("unroll") for (int k = 0; k < 2; ++k) dst[n][k] = *(const PG8_LAS bf16x8*)(lds + PG8_SB(b, h) + boff + n * 2048 + k * 1024); } while (0)
#define PG8_MMA(ai, bj, At, Bt) do { __builtin_amdgcn_s_setprio(1); _Pragma("unroll") for (int m = 0; m < 4; ++m) _Pragma("unroll") for (int n = 0; n < 2; ++n) _Pragma("unroll") for (int k = 0; k < 2; ++k) \
        acc[ai][bj][m][n] = __builtin_amdgcn_mfma_f32_16x16x32_bf16(Bt[n][k], At[m][k], acc[ai][bj][m][n], 0, 0, 0); __builtin_amdgcn_s_setprio(0); } while (0)
#define PG8_WAIT_V(n) asm volatile("s_waitcnt vmcnt(" #n ")" ::: "memory")
#define PG8_WAIT_L(n) asm volatile("s_waitcnt lgkmcnt(" #n ")" ::: "memory")
#define PG8_BAR __builtin_amdgcn_s_barrier()
#define PG8_SCHED __builtin_amdgcn_sched_barrier(0)
    Unit cur, nxt; int ui = 0;
    if (!S.next(0, cur)) return;
    f32x4 acc[2][2][4][2];
#pragma unroll
    for (int a = 0; a < 2; ++a)
#pragma unroll
        for (int b = 0; b < 2; ++b)
#pragma unroll
            for (int m = 0; m < 4; ++m)
#pragma unroll
                for (int n = 0; n < 2; ++n) acc[a][b][m][n] = (f32x4){0.f, 0.f, 0.f, 0.f};
    bf16x8 At[4][2], B0[2][2], B1[2][2];
    const char* cA = (const char*)g.A + (size_t)cur.pm * tstep; const char* cB = (const char*)g.Bt + (size_t)cur.pn * tstep;
    S.a_ready(cur);
    PG8_STAGE(PG8_SB(0, 0), cB, voffB); PG8_STAGE(PG8_SA(0, 0), cA, voffA); PG8_STAGE(PG8_SB(0, 1), cB + hstep, voffB); PG8_STAGE(PG8_SA(0, 1), cA + hstep, voffA);
    if (wr == 1) PG8_BAR;
    PG8_WAIT_V(4); PG8_BAR;
    PG8_STAGE(PG8_SB(1, 0), cB + kstep, voffB); PG8_STAGE(PG8_SA(1, 0), cA + kstep, voffA); PG8_STAGE(PG8_SB(1, 1), cB + hstep + kstep, voffB);
    PG8_WAIT_V(6); PG8_BAR;
    PG8_STAMP();
    for (;;) {
        const bool has_next = S.next(ui + 1, nxt);
        const char* nA = has_next ? (const char*)g.A + (size_t)nxt.pm * tstep : cA; const char* nB = has_next ? (const char*)g.Bt + (size_t)nxt.pn * tstep : cB;
        for (int t = 0; t < nt; t += 2) {
            const bool last = (t == nt - 2);
            const char* a1 = cA + (size_t)(t + 1) * kstep;
            const char* a2 = last ? nA : cA + (size_t)(t + 2) * kstep; const char* b2 = last ? nB : cB + (size_t)(t + 2) * kstep;
            const char* a3 = a2 + kstep; const char* b3 = b2 + kstep;
            if (last && has_next) S.a_ready(nxt);
            PG8_LDB(B0, 0, 0); PG8_SCHED; PG8_LDA(At, 0, 0); PG8_STAGE(PG8_SA(1, 1), a1 + hstep, voffA);
            PG8_WAIT_L(8); PG8_BAR; PG8_WAIT_L(0); PG8_MMA(0, 0, At, B0); PG8_BAR; PG8_SCHED;
            PG8_LDB(B1, 0, 1); PG8_STAGE(PG8_SB(0, 0), b2, voffB);
            PG8_BAR; PG8_WAIT_L(0); PG8_MMA(0, 1, At, B1); PG8_BAR;
            PG8_LDA(At, 0, 1); PG8_STAGE(PG8_SA(0, 0), a2, voffA);
            PG8_BAR; PG8_WAIT_L(0); PG8_MMA(1, 0, At, B0); PG8_BAR; PG8_SCHED;
            PG8_STAGE(PG8_SB(0, 1), b2 + hstep, voffB);
            PG8_WAIT_V(6); PG8_BAR; PG8_MMA(1, 1, At, B1); PG8_BAR;
            PG8_LDB(B0, 1, 0); PG8_SCHED; PG8_LDA(At, 1, 0); PG8_STAGE(PG8_SA(0, 1), a2 + hstep, voffA);
            PG8_WAIT_L(8); PG8_BAR; PG8_WAIT_L(0); PG8_MMA(0, 0, At, B0); PG8_BAR; PG8_SCHED;
            PG8_LDB(B1, 1, 1); PG8_STAGE(PG8_SB(1, 0), b3, voffB);
            PG8_BAR; PG8_WAIT_L(0); PG8_MMA(0, 1, At, B1); PG8_BAR;
            PG8_LDA(At, 1, 1); PG8_STAGE(PG8_SA(1, 0), a3, voffA);
            PG8_BAR; PG8_WAIT_L(0); PG8_MMA(1, 0, At, B0); PG8_BAR; PG8_SCHED;
            PG8_STAGE(PG8_SB(1, 1), b3 + hstep, voffB);
            PG8_WAIT_V(6); PG8_BAR; PG8_MMA(1, 1, At, B1); PG8_BAR;
        }
        PG8_STAMP();
        if constexpr (!Epi::AFTER_DRAIN) { E(acc, cur, wr, wc, fr, fq); S.done(cur); }
        PG8_STAMP();
        if (!has_next) break;
#pragma unroll
        for (int a = 0; a < 2; ++a)
#pragma unroll
            for (int b = 0; b < 2; ++b)
#pragma unroll
                for (int m = 0; m < 4; ++m)
#pragma unroll
                    for (int n = 0; n < 2; ++n) acc[a][b][m][n] = (f32x4){0.f, 0.f, 0.f, 0.f};
        cur = nxt; cA = nA; cB = nB; ++ui;
    }
    PG8_WAIT_V(0);
    if (wr == 0) PG8_BAR;
    PG8_BAR;
    if constexpr (Epi::AFTER_DRAIN) { E.fused(acc, cur, wr, wc, fr, fq, lds, wid, lane); S.done(cur); }
    PG8_STAMP();
    if (STAMP && wid == 0) { stamps[lane] = lane < nts ? (((unsigned long long)(unsigned)ts_hi << 32) | (unsigned)ts_lo) : 0ull;
        if (lane == 62) stamps[62] = rt_entry; if (lane == 63) stamps[63] = (unsigned long long)wall_clock64(); }
#undef PG8_STAMP
#undef PG8_SA
#undef PG8_SB
#undef PG8_STAGE
#undef PG8_LDA
#undef PG8_LDB
#undef PG8_MMA
#undef PG8_WAIT_V
#undef PG8_WAIT_L
#undef PG8_BAR
#undef PG8_SCHED
}
}
struct Ctx {
    LAS unsigned char* lds; int tid, lane, wave, G, bid;
};

DI void cvt_rows(const Ctx& F, const float* src, bf16_t* dst, size_t n) {
    const size_t n8 = n >> 3;
    for (size_t i = (size_t)F.bid * NTHR + F.tid; i < n8; i += (size_t)F.G * NTHR) {
        const f32x4 a = *(const f32x4*)(src + i * 8), b = *(const f32x4*)(src + i * 8 + 4);
        u32x4 w; w.x = pk2(a.x, a.y); w.y = pk2(a.z, a.w); w.z = pk2(b.x, b.y); w.w = pk2(b.z, b.w);
        *(u32x4*)(dst + i * 8) = w;
    }
}

constexpr int TR_S = 68;
DI void tr_tile_out(const Ctx& F, bf16_t* dst, size_t ldd, const LAS bf16_t* tile) {
    const int n = F.tid >> 3, kc = (F.tid & 7) * 8;
    const LAS bf16_t* t = tile + kc * TR_S + n;
    u32x4 v;
    v.x = (unsigned)t[0] | ((unsigned)t[TR_S] << 16); v.y = (unsigned)t[2 * TR_S] | ((unsigned)t[3 * TR_S] << 16);
    v.z = (unsigned)t[4 * TR_S] | ((unsigned)t[5 * TR_S] << 16); v.w = (unsigned)t[6 * TR_S] | ((unsigned)t[7 * TR_S] << 16);
    *(u32x4*)(dst + (size_t)n * ldd + kc) = v;
}
DI void tr_tile_f32(const Ctx& F, const float* src, size_t lds_, bf16_t* dst, size_t ldd, LAS bf16_t* tile) {
#pragma unroll
    for (int j = 0; j < 2; ++j) {
        const int id = F.tid + NTHR * j, kr = id >> 4, nc = (id & 15) * 4;
        const f32x4 v = *(const f32x4*)(src + (size_t)kr * lds_ + nc);
        *(LAS u32x2*)(tile + kr * TR_S + nc) = (u32x2){pk2(v.x, v.y), pk2(v.z, v.w)};
    }
    __syncthreads();
    tr_tile_out(F, dst, ldd, tile);
    __syncthreads();
}
DI void tr_tile_bf16(const Ctx& F, const bf16_t* src, size_t lds_, bf16_t* dst, size_t ldd, LAS bf16_t* tile) {
    { const int kr = F.tid >> 3, nc = (F.tid & 7) * 8; const u32x4 v = *(const u32x4*)(src + (size_t)kr * lds_ + nc);
      *(LAS u32x2*)(tile + kr * TR_S + nc) = (u32x2){v.x, v.y}; *(LAS u32x2*)(tile + kr * TR_S + nc + 4) = (u32x2){v.z, v.w}; }
    __syncthreads();
    tr_tile_out(F, dst, ldd, tile);
    __syncthreads();
}
DI void transpose_weight(const Ctx& F, const float* W, int K, int N, bf16_t* Wt) {
    const int tk = K / 64, tn = N / 64;
    for (int t = F.bid; t < tk * tn; t += F.G) {
        const int k0 = (t / tn) * 64, n0 = (t % tn) * 64;
        tr_tile_f32(F, W + (size_t)k0 * N + n0, (size_t)N, Wt + (size_t)n0 * K + k0, (size_t)K, (LAS bf16_t*)F.lds);
    }
}
DI void transpose_cache_v(const Ctx& F, const float* V, bf16_t* VT) {
    for (int t = F.bid; t < 64 * 8; t += F.G) {
        const int bh = t >> 3, sub = t & 7, k0 = (sub >> 1) * 64, d0 = (sub & 1) * 64, b = bh >> 3, h = bh & 7;
        tr_tile_f32(F, V + ((size_t)b * 256 + k0) * 1024 + h * 128 + d0, 1024, VT + ((size_t)bh * 128 + d0) * 256 + k0, 256, (LAS bf16_t*)F.lds);
    }
}

DI void adaln_partials(const Ctx& F, const Params& P) {
    LAS float* s = (LAS float*)F.lds;
    const float* modw = P.in[I_MODW]; const float* cv = P.in[I_C]; const float* cctx = P.in[I_CCTX];
    float* modp = (float*)(P.ws + WS_MODP);
    for (int it = F.bid; it < 192; it += F.G) {
        const int i = it / 96, r = it % 96, ks = r / 6, cg = r % 6;
        __syncthreads();
        for (int e = F.tid; e < 9 * 128; e += NTHR) { const int j = e >> 7, k = e & 127; const float c = (j == 0) ? cctx[ks * 128 + k] : cv[(j - 1) * 2048 + ks * 128 + k]; s[e] = c / (1.f + __expf(-c)); }
        __syncthreads();
        f32x4 acc[9];
#pragma unroll
        for (int j = 0; j < 9; ++j) acc[j] = (f32x4){0.f, 0.f, 0.f, 0.f};
        const float* w = modw + ((size_t)i * 2048 + ks * 128) * 12288 + cg * 2048 + F.tid * 4;
#pragma unroll 8
        for (int k = 0; k < 128; ++k) {
            const f32x4 w4 = *(const f32x4*)(w + (size_t)k * 12288);
#pragma unroll
            for (int j = 0; j < 9; ++j) acc[j] += w4 * s[j * 128 + k];
        }
#pragma unroll
        for (int j = 0; j < 9; ++j) *(f32x4*)(modp + ((size_t)(i * 16 + ks) * 9 + j) * 12288 + cg * 2048 + F.tid * 4) = acc[j];
    }
    __syncthreads();
}
DI void adaln_reduce(const Ctx& F, const Params& P) {
    const float* modp = (const float*)(P.ws + WS_MODP); float* mod = (float*)(P.ws + WS_MOD); const float* modb = P.in[I_MODB];
    for (int e = F.bid * NTHR + F.tid; e < 2 * 9 * 12288; e += F.G * NTHR) {
        const int i = e / (9 * 12288), r = e % (9 * 12288), j = r / 12288, n = r % 12288;
        float a = modb[i * 12288 + n];
#pragma unroll
        for (int ks = 0; ks < 16; ++ks) a += modp[((size_t)(i * 16 + ks) * 9 + j) * 12288 + n];
        mod[e] = a;
    }
}

DI void hyena_filters(const Ctx& F, const Params& P) {
    LAS float* z = (LAS float*)F.lds;
    LAS float* h1 = z + 320;
    LAS float* h2 = h1 + 576;
    const float* w1 = P.in[I_HYW1]; const float* b1 = P.in[I_HYB1]; const float* f1 = P.in[I_HYF1];
    const float* w2 = P.in[I_HYW2]; const float* b2 = P.in[I_HYB2]; const float* f2 = P.in[I_HYF2];
    const float* w3 = P.in[I_HYW3]; const float* dec = P.in[I_HYDEC];
    for (int it = F.bid; it < 544; it += F.G) {
        const bool smp = it < 512; const int L = smp ? LS : LP, p0 = (smp ? it : it - 512) * 8, RL = smp ? KRL_S : KRL_P;
        bf16_t* KR = (bf16_t*)(P.ws + (smp ? WS_KRS : WS_KRP));
        __syncthreads();
        if (F.tid < 9 * 33) {
            const int ps = F.tid / 33, k = F.tid % 33, i = p0 + ps;
            const float t = (float)i / (float)(L - 1), wang = 6.283185307179586f * (float)i / (float)L;
            float val;
            if (k == 0) val = t;
            else { const int f = (k - 1) & 15; const float fr = 1e-4f + (float)f * ((15.0f - 1e-4f) / 15.0f); val = (k <= 16) ? cosf(fr * wang) : -sinf(fr * wang); }
            z[F.tid] = val;
        }
        __syncthreads();
        for (int e = F.tid; e < 9 * 64; e += NTHR) { const int ps = e >> 6, j = e & 63; float a = b1[j];
            for (int k = 0; k < 33; ++k) a += z[ps * 33 + k] * w1[k * 64 + j];
            h1[e] = sinf(f1[j] * a); }
        __syncthreads();
        for (int e = F.tid; e < 9 * 64; e += NTHR) { const int ps = e >> 6, j = e & 63; float a = b2[j];
            for (int k = 0; k < 64; ++k) a += h1[ps * 64 + k] * w2[k * 64 + j];
            h2[e] = sinf(f2[j] * a); }
        __syncthreads();
#pragma unroll 1
        for (int qh = 0; qh < 2; ++qh) {
            float acc[9][4];
#pragma unroll
            for (int ps = 0; ps < 9; ++ps)
#pragma unroll
                for (int q = 0; q < 4; ++q) acc[ps][q] = 0.f;
#pragma unroll 2
            for (int k = 0; k < 64; ++k) {
                float w[4];
#pragma unroll
                for (int q = 0; q < 4; ++q) w[q] = w3[k * 4096 + F.tid + NTHR * (qh * 4 + q)];
#pragma unroll
                for (int ps = 0; ps < 9; ++ps) { const float hv = h2[ps * 64 + k];
#pragma unroll
                    for (int q = 0; q < 4; ++q) acc[ps][q] += hv * w[q]; }
            }
#pragma unroll
            for (int q = 0; q < 4; ++q) {
                const int n = F.tid + NTHR * (qh * 4 + q), o = (n >> 10) & 1, c = n & 1023;
                const float dc = fabsf(dec[n]);
                bf16_t* row = KR + (size_t)(o * 1024 + c) * RL;
                float v[9];
#pragma unroll
                for (int ps = 0; ps < 9; ++ps) { const int i = p0 + ps; v[ps] = (i < L) ? acc[ps][q] * __expf(-((float)i / (float)(L - 1)) * dc) : 0.f; }
                if (qh == 0) {
                    u32x4 wv; wv.x = pk2(v[8], v[7]); wv.y = pk2(v[6], v[5]); wv.z = pk2(v[4], v[3]); wv.w = pk2(v[2], v[1]);
                    *(u32x4*)(row + (L - p0 - 8)) = wv;
                    if (p0 == 0) row[L] = f2bf(v[0]);
                } else if (p0 > 0) {
                    u32x4 wv; wv.x = pk2(v[0], v[1]); wv.y = pk2(v[2], v[3]); wv.z = pk2(v[4], v[5]); wv.w = pk2(v[6], v[7]);
                    *(u32x4*)(row + (L + p0)) = wv;
                } else {
#pragma unroll
                    for (int ps = 1; ps < 8; ++ps) row[L + ps] = f2bf(v[ps]);
                }
            }
        }
    }
    __syncthreads();
    for (int e = F.bid * NTHR + F.tid; e < 2 * 2048; e += F.G * NTHR) {
        const bool smp = e < 2048; const int r = e & 2047, L = smp ? LS : LP, RL = smp ? KRL_S : KRL_P;
        bf16_t* row = (bf16_t*)(P.ws + (smp ? WS_KRS : WS_KRP)) + (size_t)r * RL;
        for (int x = 2 * L; x < RL; ++x) row[x] = 0;
    }
}

DI void s5_consts(const Ctx& F, const Params& P) {
    float* S5A = (float*)(P.ws + WS_S5A); bf16_t* BB = (bf16_t*)(P.ws + WS_S5BB); bf16_t* CC = (bf16_t*)(P.ws + WS_S5CC);
    const float* lre = P.in[I_S5LRE]; const float* lim = P.in[I_S5LIM]; const float* ldt = P.in[I_S5LDT];
    const float* bre = P.in[I_S5BRE]; const float* bim = P.in[I_S5BIM]; const float* cre = P.in[I_S5CRE]; const float* cim = P.in[I_S5CIM];
    for (int e = F.bid * NTHR + F.tid; e < 8192; e += F.G * NTHR) {
        const int dg = e >> 6, n = e & 63;
        const float dt = expf(ldt[dg]), lr = lre[e], li = lim[e];
        const float mag = expf(lr * dt), ar = mag * cosf(li * dt), ai = mag * sinf(li * dt), den = lr * lr + li * li;
        const float cr = ((ar - 1.f) * lr + ai * li) / den, ci = (ai * lr - (ar - 1.f) * li) / den;
        S5A[e * 2] = ar; S5A[e * 2 + 1] = ai;
#pragma unroll
        for (int p = 0; p < 16; ++p) {
            const float br = bre[(size_t)e * 16 + p], bi = bim[(size_t)e * 16 + p];
            BB[((size_t)dg * 128 + n) * 16 + p] = f2bf(cr * br - ci * bi);
            BB[((size_t)dg * 128 + 64 + n) * 16 + p] = f2bf(cr * bi + ci * br);
            CC[((size_t)dg * 16 + p) * 128 + n] = f2bf(cre[((size_t)dg * 16 + p) * 64 + n]);
            CC[((size_t)dg * 16 + p) * 128 + 64 + n] = f2bf(-cim[((size_t)dg * 16 + p) * 64 + n]);
        }
    }
}

constexpr int PT_ROWB = 1536;
DI void cvt_table_fp6(const Ctx& F, const float* src, unsigned char* dst, float* scales, const int (&perm)[32]) {
    LAS float* scr = (LAS float*)(F.lds) + F.wave * 2048 + F.lane;
    for (int r = F.bid * 8 + F.wave; r < 16384; r += F.G * 8) {
        f32x4 v[8]; float m = 0.f;
#pragma unroll
        for (int j = 0; j < 8; ++j) { v[j] = *(const f32x4*)(src + (size_t)r * 2048 + F.lane * 32 + j * 4);
            m = fmaxf(m, fmaxf(fmaxf(fabsf(v[j].x), fabsf(v[j].y)), fmaxf(fabsf(v[j].z), fabsf(v[j].w)))); }
        m = wave_max(m);
        const float inv = (m > 0.f) ? 7.0f / m : 0.f, sc = (m > 0.f) ? m / 7.0f : 0.f;
#pragma unroll
        for (int j = 0; j < 8; ++j) { scr[perm[j * 4 + 0] * 64] = v[j].x * inv; scr[perm[j * 4 + 1] * 64] = v[j].y * inv; scr[perm[j * 4 + 2] * 64] = v[j].z * inv; scr[perm[j * 4 + 3] * 64] = v[j].w * inv; }
        asm volatile("" ::: "memory");
        f32x16 a, b;
#pragma unroll
        for (int i = 0; i < 16; ++i) { a[i] = scr[i * 64]; b[i] = scr[(16 + i) * 64]; }
        asm volatile("" ::: "memory");
        const u32x6 pk = __builtin_amdgcn_cvt_scalef32_2xpk16_fp6_f32(a, b, 1.0f);
        unsigned char* o = dst + (size_t)r * PT_ROWB;
        *(u32x4*)(o + F.lane * 16) = (u32x4){pk[0], pk[1], pk[2], pk[3]}; *(u32x2*)(o + 1024 + F.lane * 8) = (u32x2){pk[4], pk[5]};
        if (F.lane == 0) scales[r] = sc;
    }
}
DI void convert_peer_tables(const Ctx& F, const Params& P) {
    int perm[32];
    { f32x16 a, b;
#pragma unroll
      for (int j = 0; j < 16; ++j) { a[j] = 0.125f * (float)j; b[j] = (j < 8) ? 2.0f + 0.25f * (float)j : 4.0f + 0.5f * (float)(j - 8); }
      const u32x6 pk = __builtin_amdgcn_cvt_scalef32_2xpk16_fp6_f32(a, b, 1.0f);
      const f32x32 rt = __builtin_amdgcn_cvt_scalef32_pk32_f32_fp6(pk, 1.0f);
#pragma unroll
      for (int i = 0; i < 32; ++i) { const float x = rt[i]; const int o = (x < 2.0f) ? (int)(x * 8.0f + 0.5f) : ((x < 4.0f) ? 16 + (int)((x - 2.0f) * 4.0f + 0.5f) : 24 + (int)((x - 4.0f) * 2.0f + 0.5f)); perm[i] = min(max(o, 0), 31); } }
    float* SC = (float*)(P.ws + WS_SC);
    __syncthreads();
    for (int layer = 0; layer < 2; ++layer) {
        cvt_table_fp6(F, P.in[I_PU] + (size_t)layer * 16384 * 2048, P.ws + WS_TBLU + (size_t)layer * 16384 * PT_ROWB, SC + layer * 16384, perm);
        cvt_table_fp6(F, P.in[I_PV] + (size_t)layer * 16384 * 2048, P.ws + WS_TBLV + (size_t)layer * 16384 * PT_ROWB, SC + (2 + layer) * 16384, perm);
    }
    __syncthreads();
}

DI void prologue(const Ctx& F, const Params& P) {
    adaln_partials(F, P);
    transpose_weight(F, P.in[I_EVWIN], 2048, 6144, (bf16_t*)(P.ws + WS_WEVIN));
    transpose_weight(F, P.in[I_EVWOUT], 2048, 2048, (bf16_t*)(P.ws + WS_WEVOUT));
    transpose_weight(F, P.in[I_ODWIN], 2048, 4096, (bf16_t*)(P.ws + WS_WODIN));
    transpose_weight(F, P.in[I_ODWOUT], 2048, 2048, (bf16_t*)(P.ws + WS_WODOUT));
    transpose_weight(F, P.in[I_PWQ], 2048, 2048, (bf16_t*)(P.ws + WS_WPQ));
    transpose_weight(F, P.in[I_PWQ] + (size_t)2048 * 2048, 2048, 2048, (bf16_t*)(P.ws + WS_WPQ) + (size_t)2048 * 2048);
    transpose_weight(F, P.in[I_GLUW], 1024, 1024, (bf16_t*)(P.ws + WS_WGLU));
    cvt_rows(F, P.in[I_PKEYS], (bf16_t*)(P.ws + WS_PKEYS), (size_t)2 * 8 * 2 * 128 * 128);
    cvt_rows(F, P.in[I_CNK], (bf16_t*)(P.ws + WS_CNK), (size_t)8 * 256 * 1024);
    cvt_rows(F, P.in[I_CDK], (bf16_t*)(P.ws + WS_CDK), (size_t)8 * 256 * 1024);
    transpose_cache_v(F, P.in[I_CNV], (bf16_t*)(P.ws + WS_CNVT));
    transpose_cache_v(F, P.in[I_CDV], (bf16_t*)(P.ws + WS_CDVT));
    hyena_filters(F, P);
    s5_consts(F, P);
    convert_peer_tables(F, P);
}
DI void norm_phase(const Ctx& F, const float* xa, const float* xb, const float* gvec, const float* modl, int sidx, bf16_t* H) {
    for (int T = F.bid * 8 + F.wave; T < TOK; T += F.G * 8) {
        const float* xr = T < TP ? xa + (size_t)T * DM : xb + (size_t)(T - TP) * DM;
        f32x4 v[8]; float ss = 0.f;
#pragma unroll
        for (int j = 0; j < 8; ++j) { v[j] = *(const f32x4*)(xr + (j * 64 + F.lane) * 4); ss += v[j].x * v[j].x + v[j].y * v[j].y + v[j].z * v[j].z + v[j].w * v[j].w; }
        ss = wave_sum(ss);
        const float rstd = rsqrtf(ss * (1.f / DM) + NORM_EPS);
        const float* sh = modl + (size_t)(cond_of(T) * 6 + sidx) * DM; const float* sc = sh + DM;
#pragma unroll
        for (int j = 0; j < 8; ++j) {
            const int col = (j * 64 + F.lane) * 4;
            const f32x4 g4 = *(const f32x4*)(gvec + col), s4 = *(const f32x4*)(sc + col), h4 = *(const f32x4*)(sh + col);
            const f32x4 o = v[j] * rstd * g4 * (s4 + 1.f) + h4;
            u32x2 w; w.x = pk2(o.x, o.y); w.y = pk2(o.z, o.w);
            *(u32x2*)(H + (size_t)T * DM + col) = w;
        }
    }
}

struct EpiBf16 {
    static constexpr bool PERM = true, AFTER_DRAIN = false;
    bf16_t* O; int ldc;
    DI void operator()(const f32x4 (&acc)[2][2][4][2], const pg8::Unit& u, int wr, int wc, int fr, int fq) const {
        const int row0 = u.pm * 256 + wr * 64 + fr, col0 = u.pn * 256 + wc * 32 + 8 * fq;
#pragma unroll
        for (int ai = 0; ai < 2; ++ai)
#pragma unroll
            for (int m = 0; m < 4; ++m) { bf16_t* rowp = O + (size_t)(row0 + ai * 128 + m * 16) * ldc + col0;
#pragma unroll
                for (int bj = 0; bj < 2; ++bj) { const f32x4 v0 = acc[ai][bj][m][0], v1 = acc[ai][bj][m][1];
                    u32x4 w; w.x = pk2(v0[0], v0[1]); w.y = pk2(v0[2], v0[3]); w.z = pk2(v1[0], v1[1]); w.w = pk2(v1[2], v1[3]);
                    *(u32x4*)(rowp + bj * 128) = w; } }
    }
};
struct EpiResid {
    static constexpr bool PERM = false, AFTER_DRAIN = false;
    const float* xa; const float* xb; float* out; const float* modl; int gidx;
    DI void operator()(const f32x4 (&acc)[2][2][4][2], const pg8::Unit& u, int wr, int wc, int fr, int fq) const {
        const int row0 = u.pm * 256 + wr * 64 + fr, col0 = u.pn * 256 + wc * 32 + 4 * fq;
        const float* xbase = (u.pm < 32) ? xa : xb - (size_t)TP * DM;
        const float* gate = modl + (size_t)(cond_of(u.pm * 256) * 6 + gidx) * DM;
        f32x4 gv[2][2];
#pragma unroll
        for (int bj = 0; bj < 2; ++bj)
#pragma unroll
            for (int n = 0; n < 2; ++n) gv[bj][n] = *(const f32x4*)(gate + col0 + bj * 128 + n * 16);
#pragma unroll
        for (int ai = 0; ai < 2; ++ai)
#pragma unroll
            for (int m = 0; m < 4; ++m) { const size_t ro = (size_t)(row0 + ai * 128 + m * 16) * DM + col0;
#pragma unroll
                for (int bj = 0; bj < 2; ++bj)
#pragma unroll
                    for (int n = 0; n < 2; ++n) { const f32x4 x4 = *(const f32x4*)(xbase + ro + bj * 128 + n * 16);
                        *(f32x4*)(out + ro + bj * 128 + n * 16) = x4 + gv[bj][n] * acc[ai][bj][m][n]; } }
    }
};
struct EpiGlu {
    static constexpr bool PERM = true, AFTER_DRAIN = false;
    const bf16_t* Y; bf16_t* O; const float* bias;
    DI void operator()(const f32x4 (&acc)[2][2][4][2], const pg8::Unit& u, int wr, int wc, int fr, int fq) const {
        const int row0 = u.pm * 256 + wr * 64 + fr, col0 = u.pn * 256 + wc * 32 + 8 * fq;
#pragma unroll
        for (int bj = 0; bj < 2; ++bj) {
            const f32x4 b0 = *(const f32x4*)(bias + col0 + bj * 128), b1 = *(const f32x4*)(bias + col0 + bj * 128 + 4);
#pragma unroll
            for (int ai = 0; ai < 2; ++ai)
#pragma unroll
                for (int m = 0; m < 4; ++m) { const size_t r = (size_t)(row0 + ai * 128 + m * 16);
                    const u32x4 yv = *(const u32x4*)(Y + r * 1024 + col0 + bj * 128);
                    const f32x4 a0 = acc[ai][bj][m][0] + b0, a1 = acc[ai][bj][m][1] + b1;
                    float o[8];
                    o[0] = bflo(yv.x) / (1.f + __expf(-a0[0])); o[1] = bfhi(yv.x) / (1.f + __expf(-a0[1]));
                    o[2] = bflo(yv.y) / (1.f + __expf(-a0[2])); o[3] = bfhi(yv.y) / (1.f + __expf(-a0[3]));
                    o[4] = bflo(yv.z) / (1.f + __expf(-a1[0])); o[5] = bfhi(yv.z) / (1.f + __expf(-a1[1]));
                    o[6] = bflo(yv.w) / (1.f + __expf(-a1[2])); o[7] = bfhi(yv.w) / (1.f + __expf(-a1[3]));
                    u32x4 w; w.x = pk2(o[0], o[1]); w.y = pk2(o[2], o[3]); w.z = pk2(o[4], o[5]); w.w = pk2(o[6], o[7]);
                    *(u32x4*)(O + r * DM + col0 + bj * 128) = w; }
        }
    }
};
template <class Epi> DI void run_gemm(const Ctx& F, const bf16_t* A, const bf16_t* Bt, int N, int K, const Epi& E) {
    pg8::Gemm g{A, Bt, TOK, N, K}; pg8::StaticOrder S; S.init(TOK, N, F.G, F.bid);
    pg8::gemm_phase<Epi, pg8::StaticOrder, false>(F.lds, g, S, E, nullptr);
    __syncthreads();
}

DI void prep_a(const Ctx& F, const Params& P) {
    const bf16_t* T1 = (const bf16_t*)(P.ws + WS_RA);
    bf16_t* VTp = (bf16_t*)(P.ws + WS_VT); bf16_t* VTs = (bf16_t*)(P.ws + WS_VT + VT_S);
    for (int t = F.bid; t < 2048 + 8192; t += F.G) {
        if (t < 2048) { const int bh = t >> 3, sub = t & 7, tk = sub >> 1, dd = sub & 1, b = bh >> 3, h = bh & 7;
            tr_tile_bf16(F, T1 + ((size_t)(b * 256 + tk * 64)) * 4096 + h * 128 + dd * 64, 4096, VTp + ((size_t)bh * 128 + dd * 64) * 256 + tk * 64, 256, (LAS bf16_t*)F.lds); }
        else { const int u = t - 2048, bh = u >> 7, sub = u & 127, tk = sub >> 1, dd = sub & 1, b = bh >> 3, h = bh & 7;
            tr_tile_bf16(F, T1 + ((size_t)(TP + b * 4096 + tk * 64)) * 4096 + h * 128 + dd * 64, 4096, VTs + ((size_t)bh * 128 + dd * 64) * 4096 + tk * 64, 4096, (LAS bf16_t*)F.lds); }
    }
    { float* o = P.out + O_NAV;
      for (int e = F.bid * NTHR + F.tid; e < TP * 128; e += F.G * NTHR) { const int T = e >> 7, c8 = (e & 127) * 8;
          const u32x4 v = *(const u32x4*)(T1 + (size_t)T * 4096 + c8);
          *(f32x4*)(o + (size_t)T * 1024 + c8) = (f32x4){bflo(v.x), bfhi(v.x), bflo(v.y), bfhi(v.y)};
          *(f32x4*)(o + (size_t)T * 1024 + c8 + 4) = (f32x4){bflo(v.z), bfhi(v.z), bflo(v.w), bfhi(v.w)}; } }
    { LAS bf16_t* tl = (LAS bf16_t*)F.lds;
      bf16_t* CM = (bf16_t*)(P.ws + WS_RB);
      const float* cw = P.in[I_HYCW]; const float* cb = P.in[I_HYCB];
      for (int t = F.bid; t < 48 * 160; t += F.G) {
          const int cg = t % 48, tg = t / 48, ch0 = cg * 64, t0 = tg * 256;
          const bool lz = (t0 < TP) ? true : (((t0 - TP) & 4095) == 0);
          const bool rz = (t0 < TP) ? true : (((t0 + 256 - TP) & 4095) == 0);
          __syncthreads();
#pragma unroll
          for (int j = 0; j < 4; ++j) { const int id = F.tid + NTHR * j, tk = id >> 3, c8 = (id & 7) * 8;
              const u32x4 v = *(const u32x4*)(T1 + (size_t)(t0 + tk) * 4096 + 1024 + ch0 + c8);
              LAS bf16_t* d = tl + tk + 1;
              d[(c8 + 0) * 264] = (bf16_t)(v.x & 0xffff); d[(c8 + 1) * 264] = (bf16_t)(v.x >> 16); d[(c8 + 2) * 264] = (bf16_t)(v.y & 0xffff); d[(c8 + 3) * 264] = (bf16_t)(v.y >> 16);
              d[(c8 + 4) * 264] = (bf16_t)(v.z & 0xffff); d[(c8 + 5) * 264] = (bf16_t)(v.z >> 16); d[(c8 + 6) * 264] = (bf16_t)(v.w & 0xffff); d[(c8 + 7) * 264] = (bf16_t)(v.w >> 16); }
          if (F.tid < 16) { const int side = F.tid >> 3, c8 = (F.tid & 7) * 8; const bool zero = side ? rz : lz; const int tk = side ? t0 + 256 : t0 - 1;
              u32x4 v = (u32x4){0u, 0u, 0u, 0u};
              if (!zero) v = *(const u32x4*)(T1 + (size_t)tk * 4096 + 1024 + ch0 + c8);
              LAS bf16_t* d = tl + (side ? 257 : 0);
              d[(c8 + 0) * 264] = (bf16_t)(v.x & 0xffff); d[(c8 + 1) * 264] = (bf16_t)(v.x >> 16); d[(c8 + 2) * 264] = (bf16_t)(v.y & 0xffff); d[(c8 + 3) * 264] = (bf16_t)(v.y >> 16);
              d[(c8 + 4) * 264] = (bf16_t)(v.z & 0xffff); d[(c8 + 5) * 264] = (bf16_t)(v.z >> 16); d[(c8 + 6) * 264] = (bf16_t)(v.w & 0xffff); d[(c8 + 7) * 264] = (bf16_t)(v.w >> 16); }
          __syncthreads();
#pragma unroll
          for (int j = 0; j < 4; ++j) { const int id = F.tid + NTHR * j, ch = id >> 5, to = (id & 31) * 8, cgl = ch0 + ch;
              const float w0 = cw[cgl], w1 = cw[3072 + cgl], w2 = cw[6144 + cgl], bb = cb[cgl];
              const LAS bf16_t* s = tl + ch * 264 + to;
              float r[10];
#pragma unroll
              for (int i = 0; i < 10; ++i) r[i] = bf2f(s[i]);
              float o[8];
#pragma unroll
              for (int i = 0; i < 8; ++i) o[i] = w0 * r[i] + w1 * r[i + 1] + w2 * r[i + 2] + bb;
              u32x4 w; w.x = pk2(o[0], o[1]); w.y = pk2(o[2], o[3]); w.z = pk2(o[4], o[5]); w.w = pk2(o[6], o[7]);
              *(u32x4*)(CM + (size_t)cgl * TOK + t0 + to) = w; }
      }
      __syncthreads(); }
}

DI void prep_b(const Ctx& F, const Params& P) {
    bf16_t* Pq = (bf16_t*)(P.ws + WS_RA); const float* qg = P.in[I_NAQG]; const float* kg = P.in[I_NAKG]; float* ok = P.out + O_NAK;
    const float* gsrc = (F.lane < 32 ? qg : kg) + (F.lane & 3) * 32;
    float g[32];
#pragma unroll
    for (int i = 0; i < 32; ++i) g[i] = gsrc[i];
    for (int T = F.bid * 8 + F.wave; T < TOK; T += F.G * 8) {
        bf16_t* rp = Pq + (size_t)T * 2048 + F.lane * 32;
        u32x4 v[4]; float x[32]; float ss = 0.f;
#pragma unroll
        for (int j = 0; j < 4; ++j) { v[j] = *(const u32x4*)(rp + j * 8);
            x[j * 8 + 0] = bflo(v[j].x); x[j * 8 + 1] = bfhi(v[j].x); x[j * 8 + 2] = bflo(v[j].y); x[j * 8 + 3] = bfhi(v[j].y);
            x[j * 8 + 4] = bflo(v[j].z); x[j * 8 + 5] = bfhi(v[j].z); x[j * 8 + 6] = bflo(v[j].w); x[j * 8 + 7] = bfhi(v[j].w); }
#pragma unroll
        for (int i = 0; i < 32; ++i) ss += x[i] * x[i];
        ss += dpp_xor1(ss); ss += dpp_xor2(ss);
        const float rstd = rsqrtf(ss * (1.f / 128.f) + NORM_EPS);
#pragma unroll
        for (int i = 0; i < 32; ++i) x[i] = x[i] * rstd * g[i];
#pragma unroll
        for (int j = 0; j < 4; ++j) { u32x4 w; w.x = pk2(x[j * 8 + 0], x[j * 8 + 1]); w.y = pk2(x[j * 8 + 2], x[j * 8 + 3]); w.z = pk2(x[j * 8 + 4], x[j * 8 + 5]); w.w = pk2(x[j * 8 + 6], x[j * 8 + 7]);
            *(u32x4*)(rp + j * 8) = w; }
        if (T < TP && F.lane >= 32) { float* o = ok + (size_t)T * 1024 + (F.lane - 32) * 32;
#pragma unroll
            for (int j = 0; j < 8; ++j) *(f32x4*)(o + j * 4) = (f32x4){x[j * 4], x[j * 4 + 1], x[j * 4 + 2], x[j * 4 + 3]}; }
    }
}
constexpr int AT_KROW = 272, AT_VROW = 136, AT_KTB = 64 * AT_KROW, AT_VTB = 128 * AT_VROW;
constexpr int AT_K0 = 0, AT_V0 = 2 * AT_KTB, AT_RPB = AT_V0 + 2 * AT_VTB;

struct TileMap { const bf16_t* latK; int latKld; const bf16_t* latV; int latVld; int nlat; const bf16_t* ctxK; const bf16_t* ctxV; int ntiles; };
struct TileRegs { u32x4 k[2], v[2]; };

DI void tile_src(const TileMap& M, int j, const bf16_t*& kp, int& kld, const bf16_t*& vp, int& vld) {
    if (j < M.nlat) { kp = M.latK + (size_t)j * 64 * M.latKld; kld = M.latKld; vp = M.latV + j * 64; vld = M.latVld; }
    else { const int c = j - M.nlat; kp = M.ctxK + (size_t)c * 64 * 1024; kld = 1024; vp = M.ctxV + c * 64; vld = 256; }
}
DI void tile_load(const Ctx& F, TileRegs& R, const bf16_t* kp, int kld, const bf16_t* vp, int vld, bool withV = true) {
#pragma unroll
    for (int j = 0; j < 2; ++j) { const int id = F.tid + NTHR * j;
        const unsigned ko = (unsigned)((id >> 4) * kld + (id & 15) * 8) * 2u, vo = (unsigned)((id >> 3) * vld + (id & 7) * 8) * 2u;
        R.k[j] = *(const u32x4*)((const char*)kp + ko);
        if (withV) R.v[j] = *(const u32x4*)((const char*)vp + vo); }
}
DI void tile_store(const Ctx& F, const TileRegs& R, LAS unsigned char* kt, LAS unsigned char* vt, bool withV = true) {
#pragma unroll
    for (int j = 0; j < 2; ++j) { const int id = F.tid + NTHR * j;
        *(LAS u32x4*)(kt + (id >> 4) * AT_KROW + (id & 15) * 16) = R.k[j];
        if (withV) { LAS unsigned char* vp = vt + (id >> 3) * AT_VROW + (id & 7) * 16;
            *(LAS u32x2*)(vp) = (u32x2){R.v[j].x, R.v[j].y}; *(LAS u32x2*)(vp + 8) = (u32x2){R.v[j].z, R.v[j].w}; } }
}

DI void tile_norm_k(const Ctx& F, TileRegs& R, const LAS float* kgain, float* nk, int nkld) {
#pragma unroll
    for (int j = 0; j < 2; ++j) { const int id = F.tid + NTHR * j;
        float x[8] = {bflo(R.k[j].x), bfhi(R.k[j].x), bflo(R.k[j].y), bfhi(R.k[j].y), bflo(R.k[j].z), bfhi(R.k[j].z), bflo(R.k[j].w), bfhi(R.k[j].w)};
        float ss = 0.f;
#pragma unroll
        for (int i = 0; i < 8; ++i) ss += x[i] * x[i];
        ss += dpp_xor1(ss); ss += dpp_xor2(ss);
        ss += __builtin_bit_cast(float, __builtin_amdgcn_update_dpp(0, __builtin_bit_cast(int, ss), 0x141, 0xF, 0xF, true));
        ss += __builtin_bit_cast(float, __builtin_amdgcn_update_dpp(0, __builtin_bit_cast(int, ss), 0x140, 0xF, 0xF, true));
        const float rstd = rsqrtf(ss * (1.f / 128.f) + NORM_EPS);
        const f32x4 g0 = *(const LAS f32x4*)(kgain + (id & 15) * 8), g1 = *(const LAS f32x4*)(kgain + (id & 15) * 8 + 4);
        x[0] *= rstd * g0.x; x[1] *= rstd * g0.y; x[2] *= rstd * g0.z; x[3] *= rstd * g0.w; x[4] *= rstd * g1.x; x[5] *= rstd * g1.y; x[6] *= rstd * g1.z; x[7] *= rstd * g1.w;
        R.k[j] = (u32x4){pk2(x[0], x[1]), pk2(x[2], x[3]), pk2(x[4], x[5]), pk2(x[6], x[7])};
        if (nk) { float* o = nk + (size_t)(id >> 4) * nkld + (id & 15) * 8; *(f32x4*)(o) = (f32x4){x[0], x[1], x[2], x[3]}; *(f32x4*)(o + 4) = (f32x4){x[4], x[5], x[6], x[7]}; }
    }
}

template <int KS>
DI f32x16 qk_tile(LAS const unsigned char* kt, const bf16x8 (&Qf)[8], int kb, int kk0, int q, int hh) {
    f32x16 S;
#pragma unroll
    for (int i = 0; i < 16; ++i) S[i] = 0.f;
#pragma unroll
    for (int ks = 0; ks < KS; ++ks) { const int kk = kk0 + ks;
        const bf16x8 A = *(const LAS bf16x8*)(kt + (kb * 32 + q) * AT_KROW + (kk * 16 + hh * 8) * 2);
        S = __builtin_amdgcn_mfma_f32_32x32x16_bf16(A, Qf[kk], S, 0, 0, 0); }
    return S;
}
DI void pv_tile(LAS const unsigned char* vt, const float (&p)[16], f32x16 (&O)[4], int kb, int q, int hh) {
#pragma unroll
    for (int s = 0; s < 2; ++s) {
        u32x4 pw; pw.x = pk2(p[8 * s + 0], p[8 * s + 1]); pw.y = pk2(p[8 * s + 2], p[8 * s + 3]); pw.z = pk2(p[8 * s + 4], p[8 * s + 5]); pw.w = pk2(p[8 * s + 6], p[8 * s + 7]);
        const bf16x8 Pf = __builtin_bit_cast(bf16x8, pw);
#pragma unroll
        for (int db = 0; db < 4; ++db) {
            LAS const unsigned char* ap = vt + (db * 32 + q) * AT_VROW + (kb * 32 + 16 * s + 4 * hh) * 2;
            const u32x2 lo = *(const LAS u32x2*)(ap), hi = *(const LAS u32x2*)(ap + 16);
            const bf16x8 A2 = __builtin_bit_cast(bf16x8, (u32x4){lo.x, lo.y, hi.x, hi.y});
            O[db] = __builtin_amdgcn_mfma_f32_32x32x16_bf16(A2, Pf, O[db], 0, 0, 0);
        }
        asm volatile("" ::: "memory");
    }
}
template <bool LAT>
DI void attn_compute1(LAS const unsigned char* kt, LAS const unsigned char* vt, const bf16x8 (&Qf)[8], f32x16 (&O)[4], float& ls, int lane, const LAS float* blane, int mb) {
    const int q = lane & 31, hh = lane >> 5;
#pragma unroll 1
    for (int kb = 0; kb < 2; ++kb) {
        float bb[16];
        if (LAT) {
#pragma unroll
            for (int i = 0; i < 16; ++i) bb[i] = blane[kb * 32 + (i & 3) + 8 * (i >> 2)];
        }
        const f32x16 S = qk_tile<8>(kt, Qf, kb, 0, q, hh);
        float p[16];
#pragma unroll
        for (int i = 0; i < 16; ++i) {
            if (LAT) { const float e = __builtin_amdgcn_exp2f(S[i] + bb[i]);
                p[i] = ((unsigned)(kb * 32 + (i & 3) + 8 * (i >> 2) + mb) < 16u) ? e : 0.f; }
            else p[i] = __builtin_amdgcn_exp2f(S[i]);
            ls += p[i];
        }
        pv_tile(vt, p, O, kb, q, hh);
    }
}
DI void diff_pass1(LAS const unsigned char* kt, const bf16x8 (&Qf)[8], float (&ls)[2], int lane) {
    const int q = lane & 31, hh = lane >> 5;
#pragma unroll
    for (int kb = 0; kb < 2; ++kb) {
#pragma unroll
        for (int mp = 0; mp < 2; ++mp) { const f32x16 S = qk_tile<4>(kt, Qf, kb, mp * 4, q, hh);
#pragma unroll
            for (int i = 0; i < 16; ++i) ls[mp] += __builtin_amdgcn_exp2f(S[i]); }
    }
}
DI void diff_pass2(LAS const unsigned char* kt, LAS const unsigned char* vt, const bf16x8 (&Qf)[8], f32x16 (&O)[4], float w0, float w1, int lane) {
    const int q = lane & 31, hh = lane >> 5;
#pragma unroll
    for (int kb = 0; kb < 2; ++kb) {
        float p[16];
        { const f32x16 S0 = qk_tile<4>(kt, Qf, kb, 0, q, hh);
#pragma unroll
          for (int i = 0; i < 16; ++i) p[i] = __builtin_amdgcn_exp2f(S0[i]) * w0; }
        { const f32x16 S1 = qk_tile<4>(kt, Qf, kb, 4, q, hh);
#pragma unroll
          for (int i = 0; i < 16; ++i) p[i] -= __builtin_amdgcn_exp2f(S1[i]) * w1; }
        pv_tile(vt, p, O, kb, q, hh);
    }
}

template <int MODE>
DI void attn_phase(const Ctx& F, const Params& P) {
    constexpr bool DIFF = (MODE >= 2);
    constexpr bool NA = (MODE == 1);
    LAS unsigned char* lds = F.lds;
    LAS float* rpbl = (LAS float*)(lds + AT_RPB);
    LAS float* kgl = (LAS float*)(lds + AT_RPB + 2048);
    if (!DIFF) { __syncthreads(); if (F.tid < 128) kgl[F.tid] = P.in[I_NAKG][F.tid]; __syncthreads(); }
    const bf16_t* PA = (const bf16_t*)(P.ws + WS_RA);
    bf16_t* MIX = (bf16_t*)(P.ws + WS_HM);
    const bf16_t* VTp = (const bf16_t*)(P.ws + WS_VT); const bf16_t* VTs = (const bf16_t*)(P.ws + WS_VT + VT_S);
    const int q = F.lane & 31, hh = F.lane >> 5;
    const float c1 = (DIFF ? 0.125f : 0.08838834764831845f) * LOG2E;
    float lam = 0.f;
    if (DIFF) {
        const float a = wave_sum(P.in[I_LQ1][F.lane] * P.in[I_LK1][F.lane]), b = wave_sum(P.in[I_LQ2][F.lane] * P.in[I_LK2][F.lane]);
        lam = __expf(a) - __expf(b) + 0.35550906759096924f;
    }
    const int nunits = (MODE == 0 || MODE == 2) ? 256 : 1024;
    for (int u0 = F.bid; u0 < nunits; u0 += F.G) {
        int u = u0;
        if ((MODE == 1 || MODE == 3) && F.G == 256) { const int i = u0 >> 8, x = F.bid & 7, y = F.bid >> 3; u = ((2 * i + (y >> 4)) * 8 + x) * 16 + (y & 15); }
        int b, h, tok0, r = 0, rlo = 0; TileMap M;
        const bf16_t* qptr;
        if (MODE == 0) { b = u >> 3; h = u & 7; tok0 = b * 256 + F.wave * 32;
            qptr = PA + (size_t)(tok0 + q) * 2048 + h * 128;
            M.latK = PA + (size_t)(b * 256) * 2048 + 1024 + h * 128; M.latKld = 2048; M.latV = VTp + (size_t)(b * 8 + h) * 128 * 256; M.latVld = 256; M.nlat = 4; M.ctxK = nullptr; M.ctxV = nullptr; M.ntiles = 4; }
        else if (MODE == 1) { b = u >> 7; h = (u >> 4) & 7; const int rg = u & 15; r = 4 * rg + (F.wave >> 1);
            rlo = min(max(4 * rg - 4, 0), 56); const int rhi = min(max(4 * rg + 3 - 4, 0), 56) + 8;
            tok0 = TP + b * 4096 + r * 64 + (F.wave & 1) * 32;
            qptr = PA + (size_t)(tok0 + q) * 2048 + h * 128;
            M.latK = PA + (size_t)(TP + b * 4096 + rlo * 64) * 2048 + 1024 + h * 128; M.latKld = 2048; M.latV = VTs + (size_t)(b * 8 + h) * 128 * 4096 + rlo * 64; M.latVld = 4096; M.nlat = rhi - rlo;
            M.ctxK = (const bf16_t*)(P.ws + WS_CNK) + (size_t)b * 256 * 1024 + h * 128; M.ctxV = (const bf16_t*)(P.ws + WS_CNVT) + (size_t)(b * 8 + h) * 128 * 256; M.ntiles = M.nlat + 4;
            if (F.tid < 465) rpbl[F.tid] = P.in[I_RPB][h * 465 + F.tid] * LOG2E; }
        else if (MODE == 2) { b = u >> 3; h = u & 7; tok0 = b * 256 + F.wave * 32;
            qptr = PA + (size_t)(tok0 + q) * 4096 + 1024 + h * 128;
            M.latK = PA + (size_t)(b * 256) * 4096 + 2048 + h * 128; M.latKld = 4096; M.latV = VTp + (size_t)(b * 8 + h) * 128 * 256; M.latVld = 256; M.nlat = 4; M.ctxK = nullptr; M.ctxV = nullptr; M.ntiles = 4; }
        else { b = u >> 7; h = (u >> 4) & 7; const int qb = u & 15; tok0 = TP + b * 4096 + qb * 256 + F.wave * 32;
            qptr = PA + (size_t)(tok0 + q) * 4096 + 1024 + h * 128;
            M.latK = PA + (size_t)(TP + b * 4096) * 4096 + 2048 + h * 128; M.latKld = 4096; M.latV = VTs + (size_t)(b * 8 + h) * 128 * 4096; M.latVld = 4096; M.nlat = 64;
            M.ctxK = (const bf16_t*)(P.ws + WS_CDK) + (size_t)b * 256 * 1024 + h * 128; M.ctxV = (const bf16_t*)(P.ws + WS_CDVT) + (size_t)(b * 8 + h) * 128 * 256; M.ntiles = 68; }
        bf16x8 Qf[8];
        if constexpr (!DIFF) {
            u32x4 w[8]; float ss = 0.f;
#pragma unroll
            for (int ks = 0; ks < 8; ++ks) { w[ks] = *(const u32x4*)(qptr + ks * 16 + hh * 8);
                ss += bflo(w[ks].x) * bflo(w[ks].x) + bfhi(w[ks].x) * bfhi(w[ks].x) + bflo(w[ks].y) * bflo(w[ks].y) + bfhi(w[ks].y) * bfhi(w[ks].y)
                    + bflo(w[ks].z) * bflo(w[ks].z) + bfhi(w[ks].z) * bfhi(w[ks].z) + bflo(w[ks].w) * bflo(w[ks].w) + bfhi(w[ks].w) * bfhi(w[ks].w); }
            ss += __shfl_xor(ss, 32);
            const float qs = rsqrtf(ss * (1.f / 128.f) + NORM_EPS) * c1;
            const float* qg = P.in[I_NAQG];
#pragma unroll
            for (int ks = 0; ks < 8; ++ks) { const f32x4 g0 = *(const f32x4*)(qg + ks * 16 + hh * 8), g1 = *(const f32x4*)(qg + ks * 16 + hh * 8 + 4);
                const u32x4 ws = (u32x4){pk2(bflo(w[ks].x) * qs * g0.x, bfhi(w[ks].x) * qs * g0.y), pk2(bflo(w[ks].y) * qs * g0.z, bfhi(w[ks].y) * qs * g0.w),
                                         pk2(bflo(w[ks].z) * qs * g1.x, bfhi(w[ks].z) * qs * g1.y), pk2(bflo(w[ks].w) * qs * g1.z, bfhi(w[ks].w) * qs * g1.w)};
                Qf[ks] = __builtin_bit_cast(bf16x8, ws); }
        } else {
#pragma unroll
        for (int ks = 0; ks < 8; ++ks) { const u32x4 w = *(const u32x4*)(qptr + ks * 16 + hh * 8);
            const u32x4 ws = (u32x4){pk2(bflo(w.x) * c1, bfhi(w.x) * c1), pk2(bflo(w.y) * c1, bfhi(w.y) * c1), pk2(bflo(w.z) * c1, bfhi(w.z) * c1), pk2(bflo(w.w) * c1, bfhi(w.w) * c1)};
            Qf[ks] = __builtin_bit_cast(bf16x8, ws); }
        }
        f32x16 O[4]; float ls[2] = {0.f, 0.f}; float w0 = 0.f, w1 = 0.f;
#pragma unroll
        for (int db = 0; db < 4; ++db)
#pragma unroll
            for (int i = 0; i < 16; ++i) O[db][i] = 0.f;
        const int cq = (F.wave & 1) * 32 + q, cs = min(max(cq - 8, 0), 48);
        const int r0w = min(max(r - 4, 0), 56);
        const int nt = M.ntiles;
        TileRegs R;
        { const bf16_t* kp; const bf16_t* vp; int kld, vld; tile_src(M, 0, kp, kld, vp, vld); tile_load(F, R, kp, kld, vp, vld); }
        if constexpr (!DIFF) tile_norm_k(F, R, kgl, (MODE == 0) ? P.out + O_NAK + (size_t)(b * 256) * 1024 + h * 128 : nullptr, 1024);
        tile_store(F, R, lds + AT_K0, lds + AT_V0);
        __syncthreads();
        if constexpr (DIFF) {
#pragma unroll 1
            for (int j = 0; j < nt; ++j) {
                const int cur = j & 1, jn = (j + 1 < nt) ? j + 1 : 0;
                const bool wv = (j + 1 == nt);
                { const bf16_t* kp; const bf16_t* vp; int kld, vld; tile_src(M, jn, kp, kld, vp, vld); tile_load(F, R, kp, kld, vp, vld, wv); }
                diff_pass1(lds + AT_K0 + cur * AT_KTB, Qf, ls, F.lane);
                tile_store(F, R, lds + AT_K0 + (cur ^ 1) * AT_KTB, lds + AT_V0 + (cur ^ 1) * AT_VTB, wv);
                __syncthreads();
            }
            { const float l0 = ls[0] + __shfl_xor(ls[0], 32), l1 = ls[1] + __shfl_xor(ls[1], 32); w0 = 1.f / l0; w1 = lam / l1; }
#pragma unroll 1
            for (int j = 0; j < nt; ++j) {
                const int cur = (nt + j) & 1;
                if (j + 1 < nt) { const bf16_t* kp; const bf16_t* vp; int kld, vld; tile_src(M, j + 1, kp, kld, vp, vld); tile_load(F, R, kp, kld, vp, vld); }
                diff_pass2(lds + AT_K0 + cur * AT_KTB, lds + AT_V0 + cur * AT_VTB, Qf, O, w0, w1, F.lane);
                if (j + 1 < nt) tile_store(F, R, lds + AT_K0 + (cur ^ 1) * AT_KTB, lds + AT_V0 + (cur ^ 1) * AT_VTB);
                __syncthreads();
            }
        } else {
#pragma unroll 1
            for (int j = 0; j < nt; ++j) {
                const int cur = j & 1;
                if (j + 1 < nt) { const bf16_t* kp; const bf16_t* vp; int kld, vld; tile_src(M, j + 1, kp, kld, vp, vld); tile_load(F, R, kp, kld, vp, vld); }
                LAS const unsigned char* kt = lds + AT_K0 + cur * AT_KTB; LAS const unsigned char* vt = lds + AT_V0 + cur * AT_VTB;
                if constexpr (NA) {
                    if (j < M.nlat) { const int kr = rlo + j;
                        if (kr >= r0w && kr < r0w + 8) attn_compute1<true>(kt, vt, Qf, O, ls[0], F.lane, rpbl + (kr - r + 7) * 31 + (4 * hh - cq + 15), 4 * hh - cs); }
                    else attn_compute1<false>(kt, vt, Qf, O, ls[0], F.lane, rpbl, 0);
                } else attn_compute1<false>(kt, vt, Qf, O, ls[0], F.lane, rpbl, 0);
                if (j + 1 < nt) {
                    if (j + 1 < M.nlat) tile_norm_k(F, R, kgl, (MODE == 0) ? P.out + O_NAK + (size_t)(b * 256 + (j + 1) * 64) * 1024 + h * 128 : nullptr, 1024);
                    tile_store(F, R, lds + AT_K0 + (cur ^ 1) * AT_KTB, lds + AT_V0 + (cur ^ 1) * AT_VTB); }
                __syncthreads();
            }
        }
        if constexpr (!DIFF) {
            const float inv = 1.f / (ls[0] + __shfl_xor(ls[0], 32));
            bf16_t* op = MIX + (size_t)(tok0 + q) * DM + h * 128 + 4 * hh;
#pragma unroll
            for (int db = 0; db < 4; ++db)
#pragma unroll
                for (int g = 0; g < 4; ++g) { u32x2 w; w.x = pk2(O[db][4 * g] * inv, O[db][4 * g + 1] * inv); w.y = pk2(O[db][4 * g + 2] * inv, O[db][4 * g + 3] * inv);
                    *(u32x2*)(op + db * 32 + 8 * g) = w; }
        } else {
            float ss = 0.f;
#pragma unroll
            for (int db = 0; db < 4; ++db)
#pragma unroll
                for (int i = 0; i < 16; ++i) ss += O[db][i] * O[db][i];
            ss += __shfl_xor(ss, 32);
            const float sc = rsqrtf(ss * (1.f / 128.f) + NORM_EPS) * (1.f - 0.35550906759096924f);
            const float* sg = P.in[I_SUBG];
            bf16_t* op = MIX + (size_t)(tok0 + q) * DM + 1024 + h * 128 + 4 * hh;
#pragma unroll
            for (int db = 0; db < 4; ++db)
#pragma unroll
                for (int g = 0; g < 4; ++g) { const f32x4 g4 = *(const f32x4*)(sg + db * 32 + 8 * g + 4 * hh);
                    u32x2 w; w.x = pk2(O[db][4 * g] * sc * g4.x, O[db][4 * g + 1] * sc * g4.y); w.y = pk2(O[db][4 * g + 2] * sc * g4.z, O[db][4 * g + 3] * sc * g4.w);
                    *(u32x2*)(op + db * 32 + 8 * g) = w; }
        }
    }
}

DI float diff_lambda(const Ctx& F, const Params& P) {
    const float la = wave_sum(P.in[I_LQ1][F.lane] * P.in[I_LK1][F.lane]), lb = wave_sum(P.in[I_LQ2][F.lane] * P.in[I_LK2][F.lane]);
    return __expf(la) - __expf(lb) + 0.35550906759096924f;
}
template <bool SAMPLE>
DI void attn_diff_phase(const Ctx& F, const Params& P, const float lam) {
    LAS unsigned char* lds = F.lds;
    const bf16_t* PA = (const bf16_t*)(P.ws + WS_RA);
    bf16_t* MIX = (bf16_t*)(P.ws + WS_HM);
    const bf16_t* VTp = (const bf16_t*)(P.ws + WS_VT); const bf16_t* VTs = (const bf16_t*)(P.ws + WS_VT + VT_S);
    const int q = F.lane & 31, hh = F.lane >> 5, mp = F.wave >> 2, qg = F.wave & 3;
    const float c1 = 0.125f * LOG2E;
    const int nunits = SAMPLE ? 1024 : 256;
    for (int u0 = F.bid; u0 < nunits; u0 += F.G) {
        int u = u0;
        if (SAMPLE && F.G == 256) { const int i = u0 >> 8, x = F.bid & 7, y = F.bid >> 3; u = ((2 * i + (y >> 4)) * 8 + x) * 16 + (y & 15); }
        int b, h, tok0; TileMap M;
        if (!SAMPLE) { b = u >> 3; h = u & 7; tok0 = b * 256 + qg * 64;
            M.latK = PA + (size_t)(b * 256) * 4096 + 2048 + h * 128; M.latKld = 4096; M.latV = VTp + (size_t)(b * 8 + h) * 128 * 256; M.latVld = 256; M.nlat = 4; M.ctxK = nullptr; M.ctxV = nullptr; M.ntiles = 4; }
        else { b = u >> 7; h = (u >> 4) & 7; tok0 = TP + b * 4096 + (u & 15) * 256 + qg * 64;
            M.latK = PA + (size_t)(TP + b * 4096) * 4096 + 2048 + h * 128; M.latKld = 4096; M.latV = VTs + (size_t)(b * 8 + h) * 128 * 4096; M.latVld = 4096; M.nlat = 64;
            M.ctxK = (const bf16_t*)(P.ws + WS_CDK) + (size_t)b * 256 * 1024 + h * 128; M.ctxV = (const bf16_t*)(P.ws + WS_CDVT) + (size_t)(b * 8 + h) * 128 * 256; M.ntiles = 68; }
        LAS unsigned char* qst = lds + 73728 + F.wave * 8192 + F.lane * 16;
#pragma unroll
        for (int sb = 0; sb < 2; ++sb) { const bf16_t* qptr = PA + (size_t)(tok0 + sb * 32 + q) * 4096 + 1024 + h * 128 + mp * 64;
#pragma unroll
            for (int ks = 0; ks < 4; ++ks) { const u32x4 w = *(const u32x4*)(qptr + ks * 16 + hh * 8);
                const u32x4 ws = (u32x4){pk2(bflo(w.x) * c1, bfhi(w.x) * c1), pk2(bflo(w.y) * c1, bfhi(w.y) * c1), pk2(bflo(w.z) * c1, bfhi(w.z) * c1), pk2(bflo(w.w) * c1, bfhi(w.w) * c1)};
                *(LAS u32x4*)(qst + (sb * 4 + ks) * 1024) = ws; } }
        f32x16 O[2][4]; float ls[2] = {0.f, 0.f};
#pragma unroll
        for (int sb = 0; sb < 2; ++sb)
#pragma unroll
            for (int db = 0; db < 4; ++db)
#pragma unroll
                for (int i = 0; i < 16; ++i) O[sb][db][i] = 0.f;
        const int nt = M.ntiles;
        TileRegs R;
        { const bf16_t* kp; const bf16_t* vp; int kld, vld; tile_src(M, 0, kp, kld, vp, vld); tile_load(F, R, kp, kld, vp, vld); }
        tile_store(F, R, lds + AT_K0, lds + AT_V0);
        __syncthreads();
#pragma unroll 1
        for (int j = 0; j < nt; ++j) {
            const int cur = j & 1;
            if (j + 1 < nt) { const bf16_t* kp; const bf16_t* vp; int kld, vld; tile_src(M, j + 1, kp, kld, vp, vld); tile_load(F, R, kp, kld, vp, vld); }
            LAS const unsigned char* kt = lds + AT_K0 + cur * AT_KTB; LAS const unsigned char* vt = lds + AT_V0 + cur * AT_VTB;
#pragma unroll 1
            for (int kb = 0; kb < 2; ++kb) {
                f32x16 S0, S1;
#pragma unroll
                for (int i = 0; i < 16; ++i) { S0[i] = 0.f; S1[i] = 0.f; }
#pragma unroll
                for (int ks = 0; ks < 4; ++ks) { const bf16x8 A = *(const LAS bf16x8*)(kt + (kb * 32 + q) * AT_KROW + ((mp * 4 + ks) * 16 + hh * 8) * 2);
                    S0 = __builtin_amdgcn_mfma_f32_32x32x16_bf16(A, *(const LAS bf16x8*)(qst + ks * 1024), S0, 0, 0, 0);
                    S1 = __builtin_amdgcn_mfma_f32_32x32x16_bf16(A, *(const LAS bf16x8*)(qst + (4 + ks) * 1024), S1, 0, 0, 0); }
                u32x4 pa[2], pb[2];
                { float l0 = 0.f, l1 = 0.f;
#pragma unroll
                for (int sp = 0; sp < 2; ++sp) { float e0[8], e1[8];
#pragma unroll
                    for (int i = 0; i < 8; ++i) { e0[i] = __builtin_amdgcn_exp2f(S0[8 * sp + i]); e1[i] = __builtin_amdgcn_exp2f(S1[8 * sp + i]); l0 += e0[i]; l1 += e1[i]; }
                    pa[sp] = (u32x4){pk2(e0[0], e0[1]), pk2(e0[2], e0[3]), pk2(e0[4], e0[5]), pk2(e0[6], e0[7])};
                    pb[sp] = (u32x4){pk2(e1[0], e1[1]), pk2(e1[2], e1[3]), pk2(e1[4], e1[5]), pk2(e1[6], e1[7])}; }
                ls[0] += l0; ls[1] += l1; }
#pragma unroll
                for (int sp = 0; sp < 2; ++sp) {
                    const bf16x8 Pa = __builtin_bit_cast(bf16x8, pa[sp]), Pb = __builtin_bit_cast(bf16x8, pb[sp]);
#pragma unroll
                    for (int db = 0; db < 4; ++db) {
                        LAS const unsigned char* ap = vt + (db * 32 + q) * AT_VROW + (kb * 32 + 16 * sp + 4 * hh) * 2;
                        const u32x2 lo = *(const LAS u32x2*)(ap), hi = *(const LAS u32x2*)(ap + 16);
                        const bf16x8 A2 = __builtin_bit_cast(bf16x8, (u32x4){lo.x, lo.y, hi.x, hi.y});
                        O[0][db] = __builtin_amdgcn_mfma_f32_32x32x16_bf16(A2, Pa, O[0][db], 0, 0, 0);
                        O[1][db] = __builtin_amdgcn_mfma_f32_32x32x16_bf16(A2, Pb, O[1][db], 0, 0, 0);
                    }
                    asm volatile("" ::: "memory");
                }
            }
            if (j + 1 < nt) tile_store(F, R, lds + AT_K0 + (cur ^ 1) * AT_KTB, lds + AT_V0 + (cur ^ 1) * AT_VTB);
            __syncthreads();
        }
        LAS float* xch = (LAS float*)lds + qg * 8192 + F.lane;
        float lt[2];
#pragma unroll
        for (int sb = 0; sb < 2; ++sb) lt[sb] = ls[sb] + __shfl_xor(ls[sb], 32);
        if (mp == 1) {
#pragma unroll
            for (int sb = 0; sb < 2; ++sb) { const float w1 = lam / lt[sb];
#pragma unroll
                for (int db = 0; db < 4; ++db)
#pragma unroll
                    for (int i = 0; i < 16; ++i) xch[((sb * 4 + db) * 16 + i) * 64] = O[sb][db][i] * w1; } }
        __syncthreads();
        if (mp == 0) {
            const float* sg = P.in[I_SUBG];
#pragma unroll
            for (int sb = 0; sb < 2; ++sb) { const float w0 = 1.f / lt[sb]; float ss = 0.f;
#pragma unroll
                for (int db = 0; db < 4; ++db)
#pragma unroll
                    for (int i = 0; i < 16; ++i) { const float o = O[sb][db][i] * w0 - xch[((sb * 4 + db) * 16 + i) * 64]; O[sb][db][i] = o; ss += o * o; }
                ss += __shfl_xor(ss, 32);
                const float sc = rsqrtf(ss * (1.f / 128.f) + NORM_EPS) * (1.f - 0.35550906759096924f);
                bf16_t* op = MIX + (size_t)(tok0 + sb * 32 + q) * DM + 1024 + h * 128 + 4 * hh;
#pragma unroll
                for (int db = 0; db < 4; ++db)
#pragma unroll
                    for (int g = 0; g < 4; ++g) { const f32x4 g4 = *(const f32x4*)(sg + db * 32 + 8 * g + 4 * hh);
                        u32x2 w; w.x = pk2(O[sb][db][4 * g] * sc * g4.x, O[sb][db][4 * g + 1] * sc * g4.y); w.y = pk2(O[sb][db][4 * g + 2] * sc * g4.z, O[sb][db][4 * g + 3] * sc * g4.w);
                        *(u32x2*)(op + db * 32 + 8 * g) = w; } } }
        __syncthreads();
    }
}
template <int L, int BATCH> struct HyCfg {
    static constexpr int NB = L / 64, TPT = 32 / BATCH, NTILES = NB / TPT, LOGB = (BATCH == 8) ? 3 : 5;
    static constexpr int ZROWB = (L + 384) * 2 + 16, ZBYTES = BATCH * ZROWB, RL = 2 * L + 16;
    static constexpr int TPW = (NTILES + 7) / 8;
};
constexpr int HY_KR_OFF = 71808;

template <int L, int BATCH>
DI void hyena_part(const Ctx& F, const Params& P, int c, int tokbase  , const bf16_t* KRG  ) {
    typedef HyCfg<L, BATCH> C;
    LAS unsigned char* lds = F.lds;
    bf16_t* CM = (bf16_t*)(P.ws + WS_RB);
    const float* hbias = P.in[I_HYBIAS];
    const int q = F.lane & 31, hh = F.lane >> 5;
    __syncthreads();
    for (int id = F.tid; id < BATCH * (L / 8); id += NTHR) { const int b = id / (L / 8), s8 = (id % (L / 8)) * 8;
        *(LAS u32x4*)(lds + b * C::ZROWB + (192 + s8) * 2) = *(const u32x4*)(CM + (size_t)c * TOK + tokbase + b * L + s8); }
    for (int id = F.tid; id < BATCH * 48; id += NTHR) { const int b = id / 48, k = id % 48, e = (k < 24) ? k * 8 : (192 + L + (k - 24) * 8);
        *(LAS u32x4*)(lds + b * C::ZROWB + e * 2) = (u32x4){0u, 0u, 0u, 0u}; }
#pragma unroll 1
    for (int o = 0; o < 2; ++o) {
        { const bf16_t* src = KRG + (size_t)(o * 1024 + c) * C::RL;
          for (int id = F.tid; id < C::RL / 8; id += NTHR) { const u32x4 v = *(const u32x4*)(src + id * 8);
              *(LAS u32x4*)(lds + HY_KR_OFF + id * 16) = v;
              LAS bf16_t* c1 = (LAS bf16_t*)(lds + HY_KR_OFF + C::RL * 2) + id * 8 - 1;
              if (id > 0) c1[0] = (bf16_t)(v.x & 0xffff);
              c1[1] = (bf16_t)(v.x >> 16); c1[2] = (bf16_t)(v.y & 0xffff); c1[3] = (bf16_t)(v.y >> 16); c1[4] = (bf16_t)(v.z & 0xffff); c1[5] = (bf16_t)(v.z >> 16);
              c1[6] = (bf16_t)(v.w & 0xffff); c1[7] = (bf16_t)(v.w >> 16); } }
        __syncthreads();
        f32x16 acc[C::TPW][2];
#pragma unroll
        for (int t = 0; t < C::TPW; ++t)
#pragma unroll
            for (int mt = 0; mt < 2; ++mt)
#pragma unroll
                for (int i = 0; i < 16; ++i) acc[t][mt][i] = 0.f;
        const int tq0 = F.wave * C::TPW;
        if (tq0 < C::NTILES) {
            const int d1lo = C::TPT * tq0 - (C::NB - 1), d1hi = C::TPT * (tq0 + C::TPW - 1) + C::TPT - 1;
            const int abase = HY_KR_OFF + (F.lane & 1) * (C::RL * 2) + (L - (F.lane & 31) + 8 * hh - (F.lane & 1)) * 2;
            bf16x8 W0[6], W1[6], B0[C::TPW][4];
#define HY_LDW(Wv, d1v, i) do { LAS const unsigned* ap_ = (LAS const unsigned*)(lds + abase + (-4 * (d1v) - 2 + (i)) * 32); Wv[i] = __builtin_bit_cast(bf16x8, (u32x4){ap_[0], ap_[1], ap_[2], ap_[3]}); } while (0)
#define HY_LDB(Bv, d1v) do { _Pragma("unroll") for (int t_ = 0; t_ < C::TPW; ++t_) { const int tq_ = tq0 + t_; \
            const int t1_ = C::TPT * tq_ + (q >> C::LOGB), b_ = q & (BATCH - 1); int s1_ = t1_ - (d1v); s1_ = min(max(s1_, -3), C::NB + 2); \
            LAS const unsigned char* bp_ = lds + b_ * C::ZROWB + (192 + 64 * s1_ + 8 * hh) * 2; \
            _Pragma("unroll") for (int ks_ = 0; ks_ < 4; ++ks_) Bv[t_][ks_] = *(const LAS bf16x8*)(bp_ + ks_ * 32); } } while (0)
#define HY_MM(Wv, Bv, d1v) do { _Pragma("unroll") for (int t_ = 0; t_ < C::TPW; ++t_) { const int tq_ = tq0 + t_; \
            if ((d1v) >= C::TPT * tq_ - (C::NB - 1) && (d1v) <= C::TPT * tq_ + C::TPT - 1) { \
                _Pragma("unroll") for (int ks_ = 0; ks_ < 4; ++ks_) _Pragma("unroll") for (int mt_ = 0; mt_ < 2; ++mt_) \
                    acc[t_][mt_] = __builtin_amdgcn_mfma_f32_32x32x16_bf16(Wv[ks_ - 2 * mt_ + 2], Bv[t_][ks_], acc[t_][mt_], 0, 0, 0); } } } while (0)
#pragma unroll
            for (int i = 0; i < 6; ++i) HY_LDW(W0, d1lo, i);
            int d1 = d1lo;
#pragma unroll 1
            for (; d1 + 1 <= d1hi; d1 += 2) {
                HY_LDB(B0, d1);
#pragma unroll
                for (int i = 0; i < 4; ++i) HY_LDW(W1, d1 + 1, i);
                W1[4] = W0[0]; W1[5] = W0[1];
                HY_MM(W0, B0, d1);
                HY_LDB(B0, d1 + 1);
                if (d1 + 2 <= d1hi) {
#pragma unroll
                    for (int i = 0; i < 4; ++i) HY_LDW(W0, d1 + 2, i);
                    W0[4] = W1[0]; W0[5] = W1[1];
                }
                HY_MM(W1, B0, d1 + 1);
            }
            if (d1 <= d1hi) { HY_LDB(B0, d1); HY_MM(W0, B0, d1); }
#undef HY_LDW
#undef HY_LDB
#undef HY_MM
        }
        __syncthreads();
        if (tq0 < C::NTILES) {
            const float bo = hbias[o * 1024 + c];
            const bf16_t* gate = CM + (size_t)((1 + o) * 1024 + c) * TOK + tokbase;
            bf16_t* zout = (bf16_t*)(P.ws + WS_RA + RA_ZC) + (size_t)c * TOK + tokbase;
#pragma unroll
            for (int t = 0; t < C::TPW; ++t) { const int tq = tq0 + t, t1 = C::TPT * tq + (q >> C::LOGB), b = q & (BATCH - 1);
#pragma unroll
                for (int mt = 0; mt < 2; ++mt)
#pragma unroll
                    for (int g = 0; g < 4; ++g) { const int s = 64 * t1 + 32 * mt + 8 * g + 4 * hh;
                        LAS u32x2* zp = (LAS u32x2*)(lds + b * C::ZROWB + (192 + s) * 2);
                        const u32x2 zv = *zp, gv = *(const u32x2*)(gate + (size_t)b * L + s);
                        const float r0 = bflo(gv.x) * (acc[t][mt][4 * g] + bflo(zv.x) * bo), r1 = bfhi(gv.x) * (acc[t][mt][4 * g + 1] + bfhi(zv.x) * bo);
                        const float r2 = bflo(gv.y) * (acc[t][mt][4 * g + 2] + bflo(zv.y) * bo), r3 = bfhi(gv.y) * (acc[t][mt][4 * g + 3] + bfhi(zv.y) * bo);
                        const u32x2 w = (u32x2){pk2(r0, r1), pk2(r2, r3)};
                        if (o == 0) *zp = w; else *(u32x2*)(zout + (size_t)b * L + s) = w; } }
        }
        __syncthreads();
    }
}

DI void hyena_phase(const Ctx& F, const Params& P) {
    for (int c = F.bid; c < 1024; c += F.G) {
        hyena_part<LS, 8>(F, P, c, TP, (const bf16_t*)(P.ws + WS_KRS));
        hyena_part<LP, 32>(F, P, c, 0, (const bf16_t*)(P.ws + WS_KRP));
    }
}

DI void hyena_post(const Ctx& F, const Params& P) {
    const bf16_t* CM = (const bf16_t*)(P.ws + WS_RA + RA_ZC); bf16_t* MIX = (bf16_t*)(P.ws + WS_HM);
    for (int t = F.bid; t < 16 * 640; t += F.G) { const int cg = t & 15, tg = t >> 4;
        tr_tile_bf16(F, CM + (size_t)(cg * 64) * TOK + tg * 64, TOK, MIX + (size_t)(tg * 64) * DM + 1024 + cg * 64, DM, (LAS bf16_t*)F.lds); }
}
DI void prep_c(const Ctx& F, const Params& P) {
    bf16_t* PA = (bf16_t*)(P.ws + WS_RA);
    LAS float* rope = (LAS float*)(F.lds + 16384);
    __syncthreads();
    for (int e = F.tid; e < 1024; e += NTHR) { const int pos = e >> 4, f = e & 15; const float inv = exp2f(-(float)f * (13.287712379549449f / 16.f)); const float a = (float)pos * inv;
        rope[e * 2] = cosf(a); rope[e * 2 + 1] = sinf(a); }
    __syncthreads();
    { const float* gsrc = (F.lane < 32 ? P.in[I_DQG] : P.in[I_DKG]) + (F.lane & 1) * 32; float* ok = P.out + O_DK;
      float g[32];
#pragma unroll
      for (int i = 0; i < 32; ++i) g[i] = gsrc[i];
      for (int T = F.bid * 8 + F.wave; T < TOK; T += F.G * 8) {
          bf16_t* rp = PA + (size_t)T * 4096 + 1024 + F.lane * 32;
          u32x4 v[4]; float x[32]; float ss = 0.f;
#pragma unroll
          for (int j = 0; j < 4; ++j) { v[j] = *(const u32x4*)(rp + j * 8);
              x[j * 8 + 0] = bflo(v[j].x); x[j * 8 + 1] = bfhi(v[j].x); x[j * 8 + 2] = bflo(v[j].y); x[j * 8 + 3] = bfhi(v[j].y);
              x[j * 8 + 4] = bflo(v[j].z); x[j * 8 + 5] = bfhi(v[j].z); x[j * 8 + 6] = bflo(v[j].w); x[j * 8 + 7] = bfhi(v[j].w); }
#pragma unroll
          for (int i = 0; i < 32; ++i) ss += x[i] * x[i];
          ss += dpp_xor1(ss);
          const float rstd = rsqrtf(ss * (1.f / 64.f) + NORM_EPS);
#pragma unroll
          for (int i = 0; i < 32; ++i) x[i] = x[i] * rstd * g[i];
          if (T < TP) { if (F.lane >= 32) { float* o = ok + (size_t)T * 1024 + (F.lane - 32) * 32;
#pragma unroll
                  for (int j = 0; j < 8; ++j) *(f32x4*)(o + j * 4) = (f32x4){x[j * 4], x[j * 4 + 1], x[j * 4 + 2], x[j * 4 + 3]}; } }
          else { const int t = (T - TP) & 4095, pos = (F.lane & 1) ? (t & 63) : (t >> 6);
              const LAS float* rt = rope + pos * 32;
#pragma unroll
              for (int f = 0; f < 16; ++f) { const float cs = rt[2 * f], sn = rt[2 * f + 1], a = x[f], b = x[16 + f]; x[f] = a * cs - b * sn; x[16 + f] = b * cs + a * sn; } }
#pragma unroll
          for (int j = 0; j < 4; ++j) { u32x4 w; w.x = pk2(x[j * 8 + 0], x[j * 8 + 1]); w.y = pk2(x[j * 8 + 2], x[j * 8 + 3]); w.z = pk2(x[j * 8 + 4], x[j * 8 + 5]); w.w = pk2(x[j * 8 + 6], x[j * 8 + 7]);
              *(u32x4*)(rp + j * 8) = w; }
      } }
    __syncthreads();
    bf16_t* VTp = (bf16_t*)(P.ws + WS_VT); bf16_t* VTs = (bf16_t*)(P.ws + WS_VT + VT_S);
    for (int t = F.bid; t < 2048 + 8192; t += F.G) {
        if (t < 2048) { const int bh = t >> 3, sub = t & 7, tk = sub >> 1, dd = sub & 1, b = bh >> 3, h = bh & 7;
            tr_tile_bf16(F, PA + ((size_t)(b * 256 + tk * 64)) * 4096 + 3072 + h * 128 + dd * 64, 4096, VTp + ((size_t)bh * 128 + dd * 64) * 256 + tk * 64, 256, (LAS bf16_t*)F.lds); }
        else { const int u = t - 2048, bh = u >> 7, sub = u & 127, tk = sub >> 1, dd = sub & 1, b = bh >> 3, h = bh & 7;
            tr_tile_bf16(F, PA + ((size_t)(TP + b * 4096 + tk * 64)) * 4096 + 3072 + h * 128 + dd * 64, 4096, VTs + ((size_t)bh * 128 + dd * 64) * 4096 + tk * 64, 4096, (LAS bf16_t*)F.lds); }
    }
    { float* o = P.out + O_DV;
      for (int e = F.bid * NTHR + F.tid; e < TP * 128; e += F.G * NTHR) { const int T = e >> 7, c8 = (e & 127) * 8;
          const u32x4 v = *(const u32x4*)(PA + (size_t)T * 4096 + 3072 + c8);
          *(f32x4*)(o + (size_t)T * 1024 + c8) = (f32x4){bflo(v.x), bfhi(v.x), bflo(v.y), bfhi(v.y)};
          *(f32x4*)(o + (size_t)T * 1024 + c8 + 4) = (f32x4){bflo(v.z), bfhi(v.z), bflo(v.w), bfhi(v.w)}; } }
}

constexpr int S5_BROW = 80, S5_BUB = 128 * S5_BROW, S5_HROW = 272, S5_WLDS = S5_BUB + 16 * S5_HROW;
DI void s5_chain(const Ctx& F, const Params& P, int dg, int tok0, int L, const float* h0re, const float* h0im, float* fre, float* fim, bf16_t* Yout) {
    LAS unsigned char* wl = F.lds + F.wave * S5_WLDS; LAS unsigned char* hl = wl + S5_BUB;
    const int g = dg & 63, dir = dg >> 6, lane = F.lane, st = lane & 15, gq = lane >> 4;
    const float* S5A = (const float*)(P.ws + WS_S5A); const bf16_t* BB = (const bf16_t*)(P.ws + WS_S5BB); const bf16_t* CC = (const bf16_t*)(P.ws + WS_S5CC);
    const bf16_t* PA = (const bf16_t*)(P.ws + WS_RA);
    const float ar = S5A[(dg * 64 + lane) * 2], ai = S5A[(dg * 64 + lane) * 2 + 1];
    float hr = h0re ? h0re[lane] : 0.f, hi = h0im ? h0im[lane] : 0.f;
    const bf16x8 zero8 = (bf16x8){0, 0, 0, 0, 0, 0, 0, 0};
    bf16x8 BBf[8], CCf[4];
#pragma unroll
    for (int mt = 0; mt < 8; ++mt) BBf[mt] = (gq < 2) ? *(const bf16x8*)(BB + ((size_t)dg * 128 + mt * 16 + st) * 16 + gq * 8) : zero8;
#pragma unroll
    for (int kk = 0; kk < 4; ++kk) CCf[kk] = *(const bf16x8*)(CC + ((size_t)dg * 16 + st) * 128 + kk * 32 + gq * 8);
    const int nch = L / 16;
    const int sgn = dir ? -1 : 1, tstart = dir ? tok0 + L - 1 : tok0;
    const bf16_t* ubase = PA + (size_t)tstart * 4096 + g * 16 + gq * 8;
    const long ustep = (long)sgn * 4096;
#define S5_LDU(c_) (((c_) < nch && gq < 2) ? *(const bf16x8*)(ubase + ustep * ((c_) * 16 + st)) : zero8)
#define S5_BU(Uv) do { _Pragma("unroll") for (int mt = 0; mt < 8; ++mt) { f32x4 d_ = (f32x4){0.f, 0.f, 0.f, 0.f}; \
        d_ = __builtin_amdgcn_mfma_f32_16x16x32_bf16(Uv, BBf[mt], d_, 0, 0, 0); *(LAS f32x4*)(wl + (mt * 16 + st) * S5_BROW + gq * 16) = d_; } } while (0)
#define S5_Y(c_) do { f32x4 y_ = (f32x4){0.f, 0.f, 0.f, 0.f}; \
        _Pragma("unroll") for (int kk = 0; kk < 4; ++kk) y_ = __builtin_amdgcn_mfma_f32_16x16x32_bf16(CCf[kk], Bh[kk], y_, 0, 0, 0);        \
        *(u32x2*)(Yout + (size_t)(tstart + sgn * ((c_) * 16 + st)) * 1024 + g * 16 + gq * 4) = (u32x2){pk2(y_[0], y_[1]), pk2(y_[2], y_[3])}; } while (0)
#define S5_ITER(DOY) do { \
        f32x4 br_[4], bi_[4]; \
        _Pragma("unroll") for (int j = 0; j < 4; ++j) { br_[j] = *(const LAS f32x4*)(wl + lane * S5_BROW + j * 16); bi_[j] = *(const LAS f32x4*)(wl + (64 + lane) * S5_BROW + j * 16); } \
        bf16x8 Bh[4]; \
        if (DOY) { _Pragma("unroll") for (int kk = 0; kk < 4; ++kk) Bh[kk] = *(const LAS bf16x8*)(hl + st * S5_HROW + (kk * 32 + gq * 8) * 2); } \
        const bf16x8 Un_ = S5_LDU(ch + 4); \
        S5_BU(Ua); \
        _Pragma("unroll") for (int s = 0; s < 16; ++s) { const float bur = br_[s >> 2][s & 3], bui = bi_[s >> 2][s & 3]; \
            float t0_ = __builtin_fmaf(-ai, hi, bur), t1_ = __builtin_fmaf(ai, hr, bui); \
            asm volatile("" : "+v"(t0_), "+v"(t1_));                       \
            const float nr = __builtin_fmaf(ar, hr, t0_), ni = __builtin_fmaf(ar, hi, t1_); hr = nr; hi = ni; \
            asm volatile("" : "+v"(hr), "+v"(hi)); \
            const unsigned hw_ = pk2(hr, hi); \
            *(LAS bf16_t*)(hl + s * S5_HROW + lane * 2) = (bf16_t)(hw_ & 0xffffu); *(LAS bf16_t*)(hl + s * S5_HROW + (64 + lane) * 2) = (bf16_t)(hw_ >> 16); } \
        if (DOY) S5_Y(ch - 1); \
        Ua = Ub; Ub = Uc; Uc = Un_; } while (0)
    bf16x8 Ua = S5_LDU(0), Ub = S5_LDU(1), Uc = S5_LDU(2);
    S5_BU(Ua);
    Ua = Ub; Ub = Uc; Uc = S5_LDU(3);
    int ch = 0;
    S5_ITER(false);
#pragma unroll 1
    for (ch = 1; ch < nch; ++ch) S5_ITER(true);
    { bf16x8 Bh[4];
#pragma unroll
      for (int kk = 0; kk < 4; ++kk) Bh[kk] = *(const LAS bf16x8*)(hl + st * S5_HROW + (kk * 32 + gq * 8) * 2);
      S5_Y(nch - 1); }
#undef S5_LDU
#undef S5_BU
#undef S5_Y
#undef S5_ITER
    if (fre) { fre[lane] = hr; fim[lane] = hi; }
}

DI void s5_phase(const Ctx& F, const Params& P) {
    bf16_t* YF = (bf16_t*)(P.ws + WS_RB + RB_YF); bf16_t* YB = (bf16_t*)(P.ws + WS_RB + RB_YB);
    for (int cs = F.bid; cs < 256; cs += F.G) {
        if (F.wave < 4) { const int sc = cs * 4 + F.wave, dg = sc & 127, b = sc >> 7;
            s5_chain(F, P, dg, TP + b * 4096, LS, P.in[I_S5RE] + (size_t)sc * 64, P.in[I_S5IM] + (size_t)sc * 64, nullptr, nullptr, (dg >> 6) ? YB : YF); }
        else { for (int k = 0; k < 4; ++k) { const int pc = (cs * 4 + (F.wave - 4)) * 4 + k, dg = pc & 127, b = pc >> 7;
            s5_chain(F, P, dg, b * 256, LP, nullptr, nullptr, P.out + O_SR + (size_t)pc * 64, P.out + O_SI + (size_t)pc * 64, (dg >> 6) ? YB : YF); } }
    }
}

DI void s5_combine(const Ctx& F, const Params& P) {
    const bf16_t* PA = (const bf16_t*)(P.ws + WS_RA); const bf16_t* YF = (const bf16_t*)(P.ws + WS_RB + RB_YF); const bf16_t* YB = (const bf16_t*)(P.ws + WS_RB + RB_YB);
    bf16_t* Y = (bf16_t*)(P.ws + WS_RB + RB_Y); const float* dsk = P.in[I_S5D];
    for (size_t e = (size_t)F.bid * NTHR + F.tid; e < (size_t)TOK * 128; e += (size_t)F.G * NTHR) { const size_t T = e >> 7; const int c8 = (int)(e & 127) * 8;
        const u32x4 uv = *(const u32x4*)(PA + T * 4096 + c8), fv = *(const u32x4*)(YF + T * 1024 + c8), bv = *(const u32x4*)(YB + T * 1024 + c8);
        const f32x4 d0 = *(const f32x4*)(dsk + c8), d1 = *(const f32x4*)(dsk + c8 + 4);
        float o[8];
        o[0] = gelu_tanh(d0.x * bflo(uv.x) + bflo(fv.x) + bflo(bv.x)); o[1] = gelu_tanh(d0.y * bfhi(uv.x) + bfhi(fv.x) + bfhi(bv.x));
        o[2] = gelu_tanh(d0.z * bflo(uv.y) + bflo(fv.y) + bflo(bv.y)); o[3] = gelu_tanh(d0.w * bfhi(uv.y) + bfhi(fv.y) + bfhi(bv.y));
        o[4] = gelu_tanh(d1.x * bflo(uv.z) + bflo(fv.z) + bflo(bv.z)); o[5] = gelu_tanh(d1.y * bfhi(uv.z) + bfhi(fv.z) + bfhi(bv.z));
        o[6] = gelu_tanh(d1.z * bflo(uv.w) + bflo(fv.w) + bflo(bv.w)); o[7] = gelu_tanh(d1.w * bfhi(uv.w) + bfhi(fv.w) + bfhi(bv.w));
        u32x4 w; w.x = pk2(o[0], o[1]); w.y = pk2(o[2], o[3]); w.z = pk2(o[4], o[5]); w.w = pk2(o[6], o[7]);
        *(u32x4*)(Y + T * 1024 + c8) = w; }
}
constexpr int PS_KROW = 272;
constexpr int PS_IDX_OFF = 2 * 128 * PS_KROW;
constexpr int PS_TAB_OFF = PS_IDX_OFF + 512 * 32;

DI void topk_insert(float (&a)[16], float x) {
#pragma unroll
    for (int j = 15; j >= 1; --j) a[j] = __builtin_amdgcn_fmed3f(a[j - 1], a[j], x);
    a[0] = fmaxf(a[0], x);
}

DI void peer_select(const Ctx& F, const Params& P, int layer) {
    LAS unsigned char* lds = F.lds;
    const bf16_t* Q = (const bf16_t*)(P.ws + WS_RA + RA_Q);
    int* SELI = (int*)(P.ws + WS_RA + RA_SELI); float* SELW = (float*)(P.ws + WS_RA + RA_SELW);
    const bf16_t* KEYS = (const bf16_t*)(P.ws + WS_PKEYS) + (size_t)layer * 8 * 2 * 128 * 128;
    const int q = F.lane & 31, hh = F.lane >> 5;
    LAS unsigned char* myidx = lds + PS_IDX_OFF + F.tid * 32;
    LAS unsigned char* tab = lds + PS_TAB_OFF;
    for (int wu = F.bid; wu < 256; wu += F.G) {
        const int h = wu & 7, chunk = wu >> 3;
        __syncthreads();
        for (int id = F.tid; id < 2 * 128 * 16; id += NTHR) { const int row = id >> 4, c16 = id & 15;
            *(LAS u32x4*)(lds + row * PS_KROW + c16 * 16) = *(const u32x4*)(KEYS + ((size_t)h * 256 + row) * 128 + c16 * 8); }
        if (F.tid < 16) { int cnt = 0;
            for (int a = 0; a < F.tid; ++a) cnt += 16 / (a + 1);
            for (int b = 0; b < 16 / (F.tid + 1); ++b) { tab[(cnt + b) * 2] = (unsigned char)F.tid; tab[(cnt + b) * 2 + 1] = (unsigned char)b; } }
        __syncthreads();
        for (int blk = F.wave; blk < 40; blk += 8) {
            const int T0 = chunk * 1280 + blk * 32;
            float lst[2][16];
#pragma unroll
            for (int side = 0; side < 2; ++side) {
                bf16x8 Qf[8];
                const bf16_t* qp = Q + (size_t)(T0 + q) * 2048 + h * 256 + side * 128 + hh * 8;
#pragma unroll
                for (int ks = 0; ks < 8; ++ks) Qf[ks] = *(const bf16x8*)(qp + ks * 16);
                float a[16];
#pragma unroll
                for (int j = 0; j < 16; ++j) a[j] = -3.0e38f;
#pragma unroll
                for (int nt = 0; nt < 4; ++nt) {
                    f32x16 S;
#pragma unroll
                    for (int i = 0; i < 16; ++i) S[i] = 0.f;
#pragma unroll
                    for (int ks = 0; ks < 8; ++ks) { const bf16x8 A = *(const LAS bf16x8*)(lds + (side * 128 + nt * 32 + q) * PS_KROW + (ks * 16 + hh * 8) * 2);
                        S = __builtin_amdgcn_mfma_f32_32x32x16_bf16(A, Qf[ks], S, 0, 0, 0); }
#pragma unroll
                    for (int i = 0; i < 16; ++i) { const int n = nt * 32 + (i & 3) + 8 * (i >> 2) + 4 * hh;
                        topk_insert(a, __uint_as_float((__float_as_uint(S[i]) & 0xffffff80u) | (unsigned)n)); }
                }
                float pb[16];
#pragma unroll
                for (int j = 0; j < 16; ++j) pb[j] = __shfl_xor(a[j], 32);
#pragma unroll
                for (int j = 0; j < 16; ++j) topk_insert(a, pb[j]);
#pragma unroll
                for (int j = 0; j < 16; ++j) { lst[side][j] = a[j]; myidx[side * 16 + j] = (unsigned char)(__float_as_uint(a[j]) & 0x7fu); }
            }
            float cb[16];
#pragma unroll
            for (int j = 0; j < 16; ++j) cb[j] = -3.0e38f;
            { int cid = 0;
#pragma unroll
              for (int a = 0; a < 16; ++a)
#pragma unroll
                  for (int b = 0; b < 16 / (a + 1); ++b) {
                      const float sa = __uint_as_float(__float_as_uint(lst[0][a]) & 0xffffff80u), sb = __uint_as_float(__float_as_uint(lst[1][b]) & 0xffffff80u);
                      topk_insert(cb, __uint_as_float((__float_as_uint(sa + sb) & 0xffffffc0u) | (unsigned)cid)); ++cid; } }
            const float mx = __uint_as_float(__float_as_uint(cb[0]) & 0xffffffc0u);
            float e[16], den = 0.f;
#pragma unroll
            for (int j = 0; j < 16; ++j) { e[j] = __expf(__uint_as_float(__float_as_uint(cb[j]) & 0xffffffc0u) - mx); den += e[j]; }
            const float rden = 1.f / den;
#pragma unroll
            for (int j = 0; j < 16; ++j) {
                if ((j >> 3) == hh) { const int cid = (int)(__float_as_uint(cb[j]) & 0x3fu);
                    const int a = tab[cid * 2], b = tab[cid * 2 + 1];
                    const int eidx = (int)myidx[a] * 128 + (int)myidx[16 + b];
                    SELI[(size_t)(T0 + q) * 128 + h * 16 + j] = eidx; SELW[(size_t)(T0 + q) * 128 + h * 16 + j] = e[j] * rden; }
            }
        }
    }
    __syncthreads();
}

DI u32x16 fp6_unpack_bf16(u32x4 a, u32x2 b) { const u32x6 pk = {a.x, a.y, a.z, a.w, b.x, b.y}; return __builtin_bit_cast(u32x16, __builtin_amdgcn_cvt_scalef32_pk32_bf16_fp6(pk, 1.0f)); }
DI f32x32 fp6_unpack(u32x4 a, u32x2 b) { const u32x6 pk = {a.x, a.y, a.z, a.w, b.x, b.y}; return __builtin_amdgcn_cvt_scalef32_pk32_f32_fp6(pk, 1.0f); }
constexpr int GN = 4;
template <bool NEXTNORM>
DI void peer_gather(const Ctx& F, const Params& P, const float* modl, int layer, const float* ngain, const float* nmodl) {
    const bf16_t* H2 = (const bf16_t*)(P.ws + WS_HM);
    const unsigned char* TU = P.ws + WS_TBLU + (size_t)layer * 16384 * PT_ROWB; const unsigned char* TV = P.ws + WS_TBLV + (size_t)layer * 16384 * PT_ROWB;
    const float* SCU = (const float*)(P.ws + WS_SC) + layer * 16384; const float* SCV = (const float*)(P.ws + WS_SC) + (2 + layer) * 16384;
    const int* SELI = (const int*)(P.ws + WS_RA + RA_SELI); const float* SELW = (const float*)(P.ws + WS_RA + RA_SELW);
    float* X = P.out + O_Y;
    const int lane = lane_id();
    const int stride = F.G * 8;
    for (int T0 = F.bid * 8 + F.wave; T0 < TOK; T0 += 2 * stride) {
        const bool two = (T0 + stride < TOK);
        const int Tt[2] = {T0, two ? T0 + stride : T0};
        u32x4 xw[2][4]; int e0[2], e1[2]; float g0[2], g1[2], d0[2], d1[2];
#pragma unroll
        for (int t = 0; t < 2; ++t) {
#pragma unroll
            for (int q4 = 0; q4 < 4; ++q4) xw[t][q4] = *(const u32x4*)(H2 + (size_t)Tt[t] * DM + lane * 32 + q4 * 8);
            e0[t] = SELI[(size_t)Tt[t] * 128 + lane]; e1[t] = SELI[(size_t)Tt[t] * 128 + 64 + lane];
            g0[t] = SELW[(size_t)Tt[t] * 128 + lane]; g1[t] = SELW[(size_t)Tt[t] * 128 + 64 + lane]; d0[t] = 0.f; d1[t] = 0.f; }
#pragma unroll 1
        for (int kb = 0; kb < 128; kb += GN) {
            u32x4 ura[2][GN]; u32x2 urb[2][GN];
#pragma unroll
            for (int j = 0; j < GN; ++j)
#pragma unroll
                for (int t = 0; t < 2; ++t) { const int k = kb + j; const int e = __builtin_amdgcn_readlane(k < 64 ? e0[t] : e1[t], k & 63);
                    const unsigned char* up = TU + (size_t)e * PT_ROWB;
                    ura[t][j] = *(const u32x4*)(up + lane * 16); urb[t][j] = *(const u32x2*)(up + 1024 + lane * 8); }
#pragma unroll
            for (int j = 0; j < GN; ++j) { float pt[2];
#pragma unroll
                for (int t = 0; t < 2; ++t) { const u32x16 r = fp6_unpack_bf16(ura[t][j], urb[t][j]);
                    float sa = 0.f, sb = 0.f, sc2 = 0.f, sd = 0.f;
#pragma unroll
                    for (int i = 0; i < 4; ++i) { const unsigned x0 = xw[t][i].x, x1 = xw[t][i].y, x2 = xw[t][i].z, x3 = xw[t][i].w;
                        sa = dot2bf(r[4 * i], x0, sa); sb = dot2bf(r[4 * i + 1], x1, sb); sc2 = dot2bf(r[4 * i + 2], x2, sc2); sd = dot2bf(r[4 * i + 3], x3, sd); }
                    pt[t] = (sa + sb) + (sc2 + sd); }
                const float sm0 = wave_sum(pt[0]), sm1 = wave_sum(pt[1]); const int k = kb + j;
                if (k < 64) { if (lane == k) { d0[0] = sm0; d0[1] = sm1; } } else { if (lane == k - 64) { d1[0] = sm0; d1[1] = sm1; } } }
        }
        float cf0[2], cf1[2];
#pragma unroll
        for (int t = 0; t < 2; ++t) { cf0[t] = g0[t] * gelu_tanh(d0[t] * SCU[e0[t]]) * SCV[e0[t]]; cf1[t] = g1[t] * gelu_tanh(d1[t] * SCU[e1[t]]) * SCV[e1[t]]; }
        f32x2 acc[2][16];
#pragma unroll
        for (int t = 0; t < 2; ++t)
#pragma unroll
            for (int i = 0; i < 16; ++i) acc[t][i] = (f32x2){0.f, 0.f};
#pragma unroll 1
        for (int kb = 0; kb < 128; kb += GN) {
            u32x4 vra[2][GN]; u32x2 vrb[2][GN]; float cf[2][GN];
#pragma unroll
            for (int j = 0; j < GN; ++j)
#pragma unroll
                for (int t = 0; t < 2; ++t) { const int k = kb + j; const int e = __builtin_amdgcn_readlane(k < 64 ? e0[t] : e1[t], k & 63);
                    cf[t][j] = __builtin_bit_cast(float, __builtin_amdgcn_readlane(__builtin_bit_cast(int, k < 64 ? cf0[t] : cf1[t]), k & 63));
                    const unsigned char* vp = TV + (size_t)e * PT_ROWB;
                    vra[t][j] = *(const u32x4*)(vp + lane * 16); vrb[t][j] = *(const u32x2*)(vp + 1024 + lane * 8); }
#pragma unroll
            for (int j = 0; j < GN; ++j)
#pragma unroll
                for (int t = 0; t < 2; ++t) { const f32x32 r = fp6_unpack(vra[t][j], vrb[t][j]);
                    const f32x2 c2 = (f32x2){cf[t][j], cf[t][j]};
#pragma unroll
                    for (int i = 0; i < 16; ++i) acc[t][i] += c2 * (f32x2){r[2 * i], r[2 * i + 1]}; }
        }
#pragma unroll
        for (int t = 0; t < 2; ++t) {
            if (t == 1 && !two) break;
            const int T = Tt[t];
            const float* gate = modl + (size_t)(cond_of(T) * 6 + 5) * DM;
            f32x4 xn[8]; float ss = 0.f;
#pragma unroll
            for (int q4 = 0; q4 < 8; ++q4) { const int col = lane * 32 + q4 * 4; float* xp = X + (size_t)T * DM + col;
                const f32x4 gv = *(const f32x4*)(gate + col), x0 = *(const f32x4*)(xp);
                const f32x4 r = x0 + gv * (f32x4){acc[t][q4 * 2].x, acc[t][q4 * 2].y, acc[t][q4 * 2 + 1].x, acc[t][q4 * 2 + 1].y};
                *(f32x4*)(xp) = r; xn[q4] = r; ss += r.x * r.x + r.y * r.y + r.z * r.z + r.w * r.w; }
            if (NEXTNORM) {
                ss = wave_sum(ss);
                const float rstd = rsqrtf(ss * (1.f / DM) + NORM_EPS);
                const float* sh = nmodl + (size_t)(cond_of(T) * 6 + 0) * DM; const float* sc = sh + DM;
                bf16_t* H = (bf16_t*)(P.ws + WS_HM);
#pragma unroll
                for (int q4 = 0; q4 < 8; ++q4) { const int col = lane * 32 + q4 * 4;
                    const f32x4 g4 = *(const f32x4*)(ngain + col), s4 = *(const f32x4*)(sc + col), h4 = *(const f32x4*)(sh + col);
                    const f32x4 o = xn[q4] * rstd * g4 * (s4 + 1.f) + h4;
                    *(u32x2*)(H + (size_t)T * DM + col) = (u32x2){pk2(o.x, o.y), pk2(o.z, o.w)}; }
            }
        }
    }
}
constexpr int NPHASE = 22;

__global__ void __launch_bounds__(NTHR, 2) mega(Params P) {
    extern __shared__ __attribute__((aligned(16))) unsigned char lds_raw[];
    Ctx F;
    F.lds = (LAS unsigned char*)lds_raw; F.tid = threadIdx.x; F.lane = F.tid & 63; F.wave = __builtin_amdgcn_readfirstlane(F.tid >> 6); F.G = gridDim.x; F.bid = blockIdx.x;
    const int lo = P.ph_lo, hi = P.ph_hi;
    volatile LAS unsigned* xbw = (volatile LAS unsigned*)(F.lds + LDS_BYTES - 16);
    if (F.tid == 0) { xbw[0] = 0u; xbw[1] = 0u; xbw[2] = 0u; xbw[3] = 0u; }
    __syncthreads();
    if (hi - lo > 1) (void)xcd_barrier_post((unsigned*)(P.ws + WS_CTL), xbw);
#define GRID_BARRIER() do { XcdBarrier bar_; bar_.bar = (unsigned*)(P.ws + WS_CTL); bar_.x = xb_xcc_id(); bar_.st = (volatile LAS unsigned*)(F.lds + LDS_BYTES - 16); xcd_barrier(bar_); } while (0)
#define PH(k, ...) if (lo <= (k) && (k) < hi) { { __VA_ARGS__ } if ((k) + 1 < hi) GRID_BARRIER(); }
#define MOD0 ((const float*)(P.ws + WS_MOD))
#define MOD1 ((const float*)(P.ws + WS_MOD) + 9 * 12288)
#define HM ((bf16_t*)(P.ws + WS_HM))
#define RA ((bf16_t*)(P.ws + WS_RA))
#define X (P.out + O_Y)

    PH(0, prologue(F, P);)
    PH(1, adaln_reduce(F, P);)
    PH(2, norm_phase(F, P.in[I_XP], P.in[I_XS], P.in[I_NMIXG], MOD0, 0, HM);)
    PH(3, { EpiBf16 E{RA, 4096}; run_gemm(F, HM, (const bf16_t*)(P.ws + WS_WEVIN) + (size_t)2048 * 2048, 4096, 2048, E); })
    PH(4, prep_a(F, P);)
    PH(5, { EpiBf16 E{RA, 2048}; run_gemm(F, HM, (const bf16_t*)(P.ws + WS_WEVIN), 2048, 2048, E); })
    PH(6, attn_phase<0>(F, P); attn_phase<1>(F, P); hyena_phase(F, P);)
    PH(7, hyena_post(F, P);)
    PH(8, { EpiResid E{P.in[I_XP], P.in[I_XS], X, MOD0, 2}; run_gemm(F, HM, (const bf16_t*)(P.ws + WS_WEVOUT), 2048, 2048, E); })
    PH(9, norm_phase(F, X, X + (size_t)TP * DM, P.in[I_NFFNG], MOD0, 3, HM);)
    PH(10, { EpiBf16 E{RA, 2048}; run_gemm(F, HM, (const bf16_t*)(P.ws + WS_WPQ), 2048, 2048, E); })
    PH(11, peer_select(F, P, 0);)
    PH(12, peer_gather<true>(F, P, MOD0, 0, P.in[I_NMIXG] + DM, MOD1);)
    PH(13, { EpiBf16 E{RA, 4096}; run_gemm(F, HM, (const bf16_t*)(P.ws + WS_WODIN), 4096, 2048, E); })
    PH(14, prep_c(F, P); s5_phase(F, P);)
    PH(15, { const float lam = diff_lambda(F, P); attn_diff_phase<false>(F, P, lam); attn_diff_phase<true>(F, P, lam); } s5_combine(F, P);)
    PH(16, { EpiGlu E{(const bf16_t*)(P.ws + WS_RB + RB_Y), HM, P.in[I_GLUB]}; run_gemm(F, (const bf16_t*)(P.ws + WS_RB + RB_Y), (const bf16_t*)(P.ws + WS_WGLU), 1024, 1024, E); })
    PH(17, { EpiResid E{X, X + (size_t)TP * DM, X, MOD1, 2}; run_gemm(F, HM, (const bf16_t*)(P.ws + WS_WODOUT), 2048, 2048, E); })
    PH(18, norm_phase(F, X, X + (size_t)TP * DM, P.in[I_NFFNG] + DM, MOD1, 3, HM);)
    PH(19, { EpiBf16 E{RA, 2048}; run_gemm(F, HM, (const bf16_t*)(P.ws + WS_WPQ) + (size_t)2048 * 2048, 2048, 2048, E); })
    PH(20, peer_select(F, P, 1);)
    PH(21, peer_gather<false>(F, P, MOD1, 1, nullptr, nullptr);)
#undef MOD0
#undef MOD1
#undef HM
#undef RA
#undef X
#undef PH
#undef GRID_BARRIER
}

extern "C" void kernel_launch(void* const* d_in, const int* in_sizes, int n_in, void* d_out, int out_size, void* d_ws, size_t ws_size, hipStream_t stream) {
    static int grid = 0;
    if (grid == 0) {
        if (n_in != N_IN || (size_t)out_size != O_END || ws_size < WS_END) { fprintf(stderr, "kernel_launch: unexpected shapes (n_in %d, out %d, ws %zu, need %zu)\n", n_in, out_size, ws_size, (size_t)WS_END); grid = -1; return; }
        int dev = 0, cus = 0;
        if (hipGetDevice(&dev) != hipSuccess || hipDeviceGetAttribute(&cus, hipDeviceAttributeMultiprocessorCount, dev) != hipSuccess) { grid = -1; return; }
        if (hipFuncSetAttribute((const void*)mega, hipFuncAttributeMaxDynamicSharedMemorySize, LDS_BYTES) != hipSuccess) { fprintf(stderr, "kernel_launch: hipFuncSetAttribute failed\n"); grid = -1; return; }
        int per_cu = 0;
        if (hipOccupancyMaxActiveBlocksPerMultiprocessor(&per_cu, (const void*)mega, NTHR, LDS_BYTES) != hipSuccess || per_cu < 1) { fprintf(stderr, "kernel_launch: occupancy query says %d blocks per CU\n", per_cu); }
        (void)hipGetLastError();
        grid = cus;
    }
    if (grid < 0) return;
    (void)hipMemsetAsync((char*)d_ws + WS_CTL, 0, 65536, stream);
    Params p; memset(&p, 0, sizeof(p));
    for (int i = 0; i < N_IN; ++i) p.in[i] = (const float*)d_in[i];
    p.out = (float*)d_out; p.ws = (unsigned char*)d_ws;
    p.ph_lo = 0; p.ph_hi = NPHASE;
    hipLaunchKernelGGL(mega, dim3(grid), dim3(NTHR), LDS_BYTES, stream, p);
}
```

```cpp
#include <hip/hip_runtime.h>
#include <cstdio>
#include <cstring>
#include <cstdint>

typedef unsigned short bf16_t;
typedef short bf16x8 __attribute__((ext_vector_type(8)));
typedef short s16x4 __attribute__((ext_vector_type(4)));
typedef float f32x2 __attribute__((ext_vector_type(2)));
typedef float f32x4 __attribute__((ext_vector_type(4)));
typedef float f32x16 __attribute__((ext_vector_type(16)));
typedef unsigned u32x2 __attribute__((ext_vector_type(2)));
typedef unsigned u32x4 __attribute__((ext_vector_type(4)));
typedef __bf16 bf16x2_t __attribute__((ext_vector_type(2)));
typedef float f32x32 __attribute__((ext_vector_type(32)));
typedef unsigned u32x6 __attribute__((ext_vector_type(6)));
typedef unsigned u32x16 __attribute__((ext_vector_type(16)));
typedef __bf16 bf16x32_t __attribute__((ext_vector_type(32)));

#define DI __device__ __forceinline__

constexpr int NTHR = 512;
constexpr int DM = 2048;
constexpr int TP = 8192;
constexpr int TS = 32768;
constexpr int TOK = TP + TS;
constexpr int LP = 256, LS = 4096;
constexpr float NORM_EPS = 1e-6f;
constexpr float LOG2E = 1.4426950408889634f;

enum { I_XP = 0, I_XS, I_C, I_CNK, I_CNV, I_CDK, I_CDV, I_S5RE, I_S5IM, I_CCTX, I_MODW, I_MODB, I_NMIXG, I_NFFNG, I_EVWIN, I_EVWOUT, I_NAQG, I_NAKG, I_RPB,
       I_HYCW, I_HYCB, I_HYW1, I_HYB1, I_HYF1, I_HYW2, I_HYB2, I_HYF2, I_HYW3, I_HYDEC, I_HYBIAS, I_ODWIN, I_ODWOUT, I_S5LRE, I_S5LIM, I_S5LDT, I_S5BRE, I_S5BIM,
       I_S5CRE, I_S5CIM, I_S5D, I_GLUW, I_GLUB, I_DQG, I_DKG, I_LQ1, I_LK1, I_LQ2, I_LK2, I_SUBG, I_PWQ, I_PKEYS, I_PU, I_PV, N_IN };

constexpr size_t O_Y = 0;
constexpr size_t O_NAK = 83886080, O_NAV = 92274688, O_DK = 100663296, O_DV = 109051904, O_SR = 117440512, O_SI = 117702656, O_END = 117964800;

constexpr size_t al256(size_t x) { return (x + 255) & ~(size_t)255; }
constexpr size_t WS_CTL = 0;
constexpr size_t WS_MODP = 65536;
constexpr size_t WS_MOD = WS_MODP + (size_t)2 * 16 * 9 * 12288 * 4;
constexpr size_t WS_WEVIN = al256(WS_MOD + (size_t)2 * 9 * 12288 * 4);
constexpr size_t WS_WEVOUT = WS_WEVIN + (size_t)6144 * 2048 * 2;
constexpr size_t WS_WODIN = WS_WEVOUT + (size_t)2048 * 2048 * 2;
constexpr size_t WS_WODOUT = WS_WODIN + (size_t)4096 * 2048 * 2;
constexpr size_t WS_WPQ = WS_WODOUT + (size_t)2048 * 2048 * 2;
constexpr size_t WS_WGLU = WS_WPQ + (size_t)2 * 2048 * 2048 * 2;
constexpr size_t WS_PKEYS = WS_WGLU + (size_t)1024 * 1024 * 2;
constexpr size_t WS_CNK = WS_PKEYS + (size_t)2 * 8 * 2 * 128 * 128 * 2;
constexpr size_t WS_CNVT = WS_CNK + (size_t)8 * 256 * 1024 * 2;
constexpr size_t WS_CDK = WS_CNVT + (size_t)8 * 256 * 1024 * 2;
constexpr size_t WS_CDVT = WS_CDK + (size_t)8 * 256 * 1024 * 2;
constexpr size_t WS_S5A = WS_CDVT + (size_t)8 * 256 * 1024 * 2;
constexpr size_t WS_S5BB = WS_S5A + (size_t)128 * 64 * 2 * 4;
constexpr size_t WS_S5CC = WS_S5BB + (size_t)128 * 128 * 16 * 2;
constexpr int KRL_S = 8208, KRL_P = 528;
constexpr size_t WS_KRS = WS_S5CC + (size_t)128 * 16 * 128 * 2;
constexpr size_t WS_KRP = al256(WS_KRS + (size_t)2 * 1024 * KRL_S * 2);
constexpr size_t WS_TBLU = al256(WS_KRP + (size_t)2 * 1024 * KRL_P * 2);
constexpr size_t WS_TBLV = WS_TBLU + (size_t)16384 * 2048 * 2;
constexpr size_t WS_HM = WS_TBLV + (size_t)16384 * 2048 * 2;
constexpr size_t WS_RA = WS_HM + (size_t)TOK * 2048 * 2;
constexpr size_t WS_RB = WS_RA + (size_t)TOK * 4096 * 2;
constexpr size_t WS_VT = WS_RB + (size_t)3072 * TOK * 2;
constexpr size_t WS_SC = WS_VT + (size_t)TOK * 1024 * 2;
constexpr size_t WS_END = WS_SC + (size_t)4 * 16384 * 4;
constexpr size_t RA_Q = 0;
constexpr size_t RA_SELI = (size_t)TOK * 2048 * 2;
constexpr size_t RA_SELW = RA_SELI + (size_t)TOK * 128 * 4;
constexpr size_t RA_CF = RA_SELW + (size_t)TOK * 128 * 4;
constexpr size_t RA_ZC = (size_t)TOK * 2048 * 2;
constexpr size_t RB_YF = 0, RB_YB = (size_t)TOK * 1024 * 2, RB_Y = (size_t)2 * TOK * 1024 * 2;
constexpr size_t VT_S = (size_t)TP * 1024 * 2;

constexpr int LDS_BYTES = 147456;

struct Params { const float* in[N_IN]; float* out; unsigned char* ws; int ph_lo, ph_hi; };

DI float bf2f(bf16_t b) { return __uint_as_float(((unsigned)b) << 16); }
DI float bflo(unsigned w) { return __uint_as_float(w << 16); }
DI float bfhi(unsigned w) { return __uint_as_float(w & 0xffff0000u); }
DI unsigned pk2(float a, float b) { f32x2 v = {a, b}; return __builtin_bit_cast(unsigned, __builtin_convertvector(v, bf16x2_t)); }
DI float dot2bf(unsigned a, unsigned b, float c) { return __builtin_amdgcn_fdot2_f32_bf16(__builtin_bit_cast(bf16x2_t, a), __builtin_bit_cast(bf16x2_t, b), c, false); }
DI bf16_t f2bf(float a) { return (bf16_t)(pk2(a, 0.f) & 0xffffu); }
DI float dpp_xor1(float v) { return __builtin_bit_cast(float, __builtin_amdgcn_update_dpp(0, __builtin_bit_cast(int, v), 0xB1, 0xF, 0xF, true)); }
DI float dpp_xor2(float v) { return __builtin_bit_cast(float, __builtin_amdgcn_update_dpp(0, __builtin_bit_cast(int, v), 0x4E, 0xF, 0xF, true)); }
DI float wave_sum(float v) {
    v += dpp_xor1(v); v += dpp_xor2(v);
    v += __builtin_bit_cast(float, __builtin_amdgcn_update_dpp(0, __builtin_bit_cast(int, v), 0x141, 0xF, 0xF, true));
    v += __builtin_bit_cast(float, __builtin_amdgcn_update_dpp(0, __builtin_bit_cast(int, v), 0x140, 0xF, 0xF, true));
    v += __builtin_bit_cast(float, __builtin_amdgcn_update_dpp(0, __builtin_bit_cast(int, v), 0x142, 0xA, 0xF, false));
    v += __builtin_bit_cast(float, __builtin_amdgcn_update_dpp(0, __builtin_bit_cast(int, v), 0x143, 0xC, 0xF, false));
    return __builtin_bit_cast(float, __builtin_amdgcn_readlane(__builtin_bit_cast(int, v), 63));
}
DI float gelu_tanh(float x) {
    const float u = 0.7978845608028654f * (x + 0.044715f * x * x * x);
    const float e = __expf(2.f * u);
    const float t = 1.f - 2.f / (e + 1.f);
    return 0.5f * x * (1.f + t);
}
DI float wave_max(float v) {
    v = fmaxf(v, dpp_xor1(v)); v = fmaxf(v, dpp_xor2(v));
    v = fmaxf(v, __builtin_bit_cast(float, __builtin_amdgcn_update_dpp(0, __builtin_bit_cast(int, v), 0x141, 0xF, 0xF, true)));
    v = fmaxf(v, __builtin_bit_cast(float, __builtin_amdgcn_update_dpp(0, __builtin_bit_cast(int, v), 0x140, 0xF, 0xF, true)));
    v = fmaxf(v, __builtin_bit_cast(float, __builtin_amdgcn_update_dpp(0, __builtin_bit_cast(int, v), 0x142, 0xA, 0xF, false)));
    v = fmaxf(v, __builtin_bit_cast(float, __builtin_amdgcn_update_dpp(0, __builtin_bit_cast(int, v), 0x143, 0xC, 0xF, false)));
    return __builtin_bit_cast(float, __builtin_amdgcn_readlane(__builtin_bit_cast(int, v), 63));
}
DI f32x2 fp8x2_lo(unsigned w) { return __builtin_amdgcn_cvt_pk_f32_fp8((int)w, false); }
DI f32x2 fp8x2_hi(unsigned w) { return __builtin_amdgcn_cvt_pk_f32_fp8((int)w, true); }
DI unsigned pk_fp8x4(float a, float b, float c, float d) { int r = 0; r = __builtin_amdgcn_cvt_pk_fp8_f32(a, b, r, false); r = __builtin_amdgcn_cvt_pk_fp8_f32(c, d, r, true); return (unsigned)r; }
DI int lane_id() { return (int)__builtin_amdgcn_mbcnt_hi(~0u, __builtin_amdgcn_mbcnt_lo(~0u, 0u)); }
DI int cond_of(int T) { return T < TP ? 0 : 1 + ((T - TP) >> 12); }
#define XB_TMO      128
#define XB_XCNT(j)  (256  + 64 * (j))
#define XB_XSUB(j)  (1280 + 64 * (j))
#define XB_XGEN(j)  (2304 + 64 * (j))
#define XB_TOP      3328
#define XB_TOPGEN   3392
#define XCD_BAR_WORDS 3456
#define XB_SPIN_CAP (1u << 26)
#define LAS __attribute__((address_space(3)))

__device__ __forceinline__ unsigned xb_ld(unsigned* p)              { return __hip_atomic_load(p, __ATOMIC_RELAXED, __HIP_MEMORY_SCOPE_AGENT); }
__device__ __forceinline__ unsigned xb_add(unsigned* p, unsigned v) { return __hip_atomic_fetch_add(p, v, __ATOMIC_RELAXED, __HIP_MEMORY_SCOPE_AGENT); }
__device__ __forceinline__ unsigned xb_xcc_id() { return (unsigned)__builtin_amdgcn_s_getreg((3 << 11) | 20) & 0xFu; }
#define XB_SPIN(cond, bar) do { unsigned _sp = 0; while (cond) { __builtin_amdgcn_s_sleep(1); \
    if ((++_sp & 255u) == 0u) { if (xb_ld(&(bar)[XB_TMO])) break; if (_sp > XB_SPIN_CAP) { atomicAdd(&(bar)[XB_TMO], 1u); break; } } } } while (0)

struct XcdBarrier {
    unsigned* bar; unsigned x;
    volatile LAS unsigned* st;
};

__device__ __forceinline__ XcdBarrier xcd_barrier_post(unsigned* bar, volatile LAS unsigned* st) {
    XcdBarrier b; b.bar = bar; b.x = xb_xcc_id(); b.st = st;
    if (threadIdx.x == 0) (void)xb_add(&bar[XB_XCNT(b.x)], 1u);
    return b;
}
__device__ __forceinline__ void xcd_barrier_complete(unsigned* bar, unsigned x, unsigned& nloc, unsigned& nx) {
    const unsigned G = gridDim.x * gridDim.y * gridDim.z;
    unsigned sum, cnt, mine, sp = 0u;
    for (;;) {
        sum = 0u; cnt = 0u; mine = 0u;
#pragma unroll
        for (unsigned j = 0; j < 16; ++j) { const unsigned c = xb_ld(&bar[XB_XCNT(j)]); sum += c; cnt += (c > 0u) ? 1u : 0u; mine = (j == x) ? c : mine; }
        if (sum == G) break;
        __builtin_amdgcn_s_sleep(1);
        if ((++sp & 255u) == 0u) { if (xb_ld(&bar[XB_TMO])) break; if (sp > XB_SPIN_CAP) { atomicAdd(&bar[XB_TMO], 1u); break; } }
    }
    nloc = mine > 0u ? mine : 1u; nx = cnt > 0u ? cnt : 1u;
}

__device__ __forceinline__ void xcd_barrier(const XcdBarrier& b) {
    asm volatile("s_waitcnt vmcnt(0)" ::: "memory");
    __syncthreads();
    if (threadIdx.x == 0) {
        unsigned* bar = b.bar;
        __builtin_amdgcn_s_waitcnt(0);
        unsigned nloc = b.st[0], nx = b.st[1];
        if (nloc == 0u) { xcd_barrier_complete(bar, b.x, nloc, nx); b.st[0] = nloc; b.st[1] = nx; }
        const unsigned old = xb_add(&bar[XB_XSUB(b.x)], 1u);
        const unsigned gen = old / nloc;
        if (old + 1u == (gen + 1u) * nloc) {
            __builtin_amdgcn_fence(__ATOMIC_RELEASE, "agent");
            asm volatile("s_waitcnt vmcnt(0)" ::: "memory");
            const unsigned og = xb_add(&bar[XB_TOP], 1u);
            const unsigned tg = og / nx;
            if (og + 1u == (tg + 1u) * nx) xb_add(&bar[XB_TOPGEN], 1u);
            else XB_SPIN(xb_ld(&bar[XB_TOPGEN]) == tg, bar);
            __builtin_amdgcn_fence(__ATOMIC_ACQUIRE, "agent");
            xb_add(&bar[XB_XGEN(b.x)], 1u);
            asm volatile("s_waitcnt vmcnt(0)" ::: "memory");
        } else {
            XB_SPIN(xb_ld(&bar[XB_XGEN(b.x)]) == gen, bar);
            __builtin_amdgcn_fence(__ATOMIC_ACQUIRE, "agent");
            asm volatile("s_waitcnt vmcnt(0)" ::: "memory");
        }
    }
    __syncthreads();
}
namespace pg8 {
#define PG8_LAS __attribute__((address_space(3)))
typedef unsigned short bf16_t;
typedef short bf16x8 __attribute__((ext_vector_type(8)));
typedef float f32x4 __attribute__((ext_vector_type(4)));
typedef unsigned u32x4 __attribute__((ext_vector_type(4)));
constexpr int BM = 256, BK = 64, HALF = 128, HTB = HALF * BK * 2  , STAGE_BYTES = 8 * HTB, NXCD = 8, WGM = 8;

__host__ __device__ __forceinline__ int lds_byte(int r, int c) { const int st = (r >> 4) * 2 + (c >> 5), rr = r & 15, cc = c & 31, ob = rr * 64 + cc * 2; return st * 1024 + (ob ^ (((ob >> 9) & 1) << 5)); }
__host__ __device__ __forceinline__ void stage_rc(int b, int& R, int& C) { const int st = b / 1024, sb = b % 1024, swz = sb ^ (((sb >> 9) & 1) << 5); R = (st >> 1) * 16 + swz / 64; C = (st & 1) * 32 + (swz % 64) / 2; }
__host__ __device__ __forceinline__ int perm32(int rho) { const int n = rho >> 4, i = rho & 15; return 8 * (i >> 2) + 4 * n + (i & 3); }

struct Unit { int pm, pn; };
struct Gemm { const bf16_t* A; const bf16_t* Bt; int M, N, K; };

struct StaticOrder {
    int nM, nN, nwg, G, c;
    __host__ __device__ void init(int M, int N, int G_, int c_) { nM = M / BM; nN = N / BM; nwg = nM * nN; G = G_; c = c_; }
    __host__ __device__ bool next(int i, Unit& u) const {
        const long L = (long)i * G + c; if (L >= nwg) return false;
        int wgid = (int)L; { const int q = nwg / NXCD, r = nwg % NXCD, xcd = wgid % NXCD, off = wgid / NXCD; wgid = (xcd < r ? xcd * (q + 1) : r * (q + 1) + (xcd - r) * q) + off; }
        const int nig = WGM * nN, gid = wgid / nig, fm = gid * WGM, gsz = (nM - fm) < WGM ? (nM - fm) : WGM;
        u.pm = fm + ((wgid % nig) % gsz); u.pn = (wgid % nig) / gsz; return true;
    }
    __device__ __forceinline__ void a_ready(const Unit&) const {}
    __device__ __forceinline__ void done(const Unit&) const {}
};
__device__ __forceinline__ unsigned cvt_pk_bf16(float lo, float hi) { unsigned r; asm volatile("v_cvt_pk_bf16_f32 %0, %1, %2" : "=v"(r) : "v"(lo), "v"(hi)); return r; }
template <class Epi, class Sched, bool STAMP = false>
__device__ __forceinline__ void gemm_phase(PG8_LAS unsigned char* lds, const Gemm g, const Sched& S, const Epi& E, unsigned long long* stamps) {
    const int tid = threadIdx.x, wid = __builtin_amdgcn_readfirstlane(tid >> 6), lane = tid & 63, wr = wid >> 2, wc = wid & 3, fr = lane & 15, fq = lane >> 4;
    const int K = g.K, nt = K / BK;
    int ts_lo = 0, ts_hi = 0, nts = 0; const unsigned long long rt_entry = STAMP ? (unsigned long long)wall_clock64() : 0ull;
#define PG8_STAMP() do { if (STAMP && wid == 0 && nts < 64) { const unsigned long long _c = (unsigned long long)clock64(); \
        ts_lo = (lane == nts) ? (int)(unsigned)_c : ts_lo; ts_hi = (lane == nts) ? (int)(unsigned)(_c >> 32) : ts_hi; ++nts; } } while (0)
    PG8_STAMP();
    unsigned voffA[2], voffB[2];
#pragma unroll
    for (int i = 0; i < 2; ++i) { int R, C; stage_rc(tid * 16 + i * 8192, R, C); const int Rb = Epi::PERM ? ((R & ~31) + perm32(R & 31)) : R;
        voffA[i] = (unsigned)(R * K + C) * 2u; voffB[i] = (unsigned)(Rb * K + C) * 2u; }
    const size_t kstep = (size_t)(BK * 2);
    const size_t hstep = (size_t)HALF * K * 2;
    const size_t tstep = 2 * hstep;
    const unsigned ldsw = (unsigned)wid * 1024u;
    const int aoff = lds_byte(wr * 64 + fr, fq * 8), boff = lds_byte(wc * 32 + fr, fq * 8);
#define PG8_SA(b, h) (((b) * 2 + (h)) * HTB)
#define PG8_SB(b, h) ((4 + (b) * 2 + (h)) * HTB)
#define PG8_STAGE(bufoff, gbase, voff) do { _Pragma("unroll") for (int _i = 0; _i < 2; ++_i) \
        __builtin_amdgcn_global_load_lds((const unsigned*)((const char*)(gbase) + (voff)[_i]), (PG8_LAS unsigned*)(lds + (bufoff) + ldsw + _i * 8192), 16, 0, 0); } while (0)
#define PG8_LDA(dst, b, h) do { _Pragma("unroll") for (int m = 0; m < 4; ++m) _Pragma("unroll") for (int k = 0; k < 2; ++k) dst[m][k] = *(const PG8_LAS bf16x8*)(lds + PG8_SA(b, h) + aoff + m * 2048 + k * 1024); } while (0)
#define PG8_LDB(dst, b, h) do { _Pragma("unroll") for (int n = 0; n < 2; ++n) _Pragma("unroll") for (int k = 0; k < 2; ++k) dst[n][k] = *(const PG8_LAS bf16x8*)(lds + PG8_SB(b, h) + boff + n * 2048 + k * 1024); } while (0)
#define PG8_MMA(ai, bj, At, Bt) do { __builtin_amdgcn_s_setprio(1); _Pragma("unroll") for (int m = 0; m < 4; ++m) _Pragma("unroll") for (int n = 0; n < 2; ++n) _Pragma("unroll") for (int k = 0; k < 2; ++k) \
        acc[ai][bj][m][n] = __builtin_amdgcn_mfma_f32_16x16x32_bf16(Bt[n][k], At[m][k], acc[ai][bj][m][n], 0, 0, 0); __builtin_amdgcn_s_setprio(0); } while (0)
#define PG8_WAIT_V(n) asm volatile("s_waitcnt vmcnt(" #n ")" ::: "memory")
#define PG8_WAIT_L(n) asm volatile("s_waitcnt lgkmcnt(" #n ")" ::: "memory")
#define PG8_BAR __builtin_amdgcn_s_barrier()
#define PG8_SCHED __builtin_amdgcn_sched_barrier(0)
    Unit cur, nxt; int ui = 0;
    if (!S.next(0, cur)) return;
    f32x4 acc[2][2][4][2];
#pragma unroll
    for (int a = 0; a < 2; ++a)
#pragma unroll
        for (int b = 0; b < 2; ++b)
#pragma unroll
            for (int m = 0; m < 4; ++m)
#pragma unroll
                for (int n = 0; n < 2; ++n) acc[a][b][m][n] = (f32x4){0.f, 0.f, 0.f, 0.f};
    bf16x8 At[4][2], B0[2][2], B1[2][2];
    const char* cA = (const char*)g.A + (size_t)cur.pm * tstep; const char* cB = (const char*)g.Bt + (size_t)cur.pn * tstep;
    S.a_ready(cur);
    PG8_STAGE(PG8_SB(0, 0), cB, voffB); PG8_STAGE(PG8_SA(0, 0), cA, voffA); PG8_STAGE(PG8_SB(0, 1), cB + hstep, voffB); PG8_STAGE(PG8_SA(0, 1), cA + hstep, voffA);
    if (wr == 1) PG8_BAR;
    PG8_WAIT_V(4); PG8_BAR;
    PG8_STAGE(PG8_SB(1, 0), cB + kstep, voffB); PG8_STAGE(PG8_SA(1, 0), cA + kstep, voffA); PG8_STAGE(PG8_SB(1, 1), cB + hstep + kstep, voffB);
    PG8_WAIT_V(6); PG8_BAR;
    PG8_STAMP();
    for (;;) {
        const bool has_next = S.next(ui + 1, nxt);
        const char* nA = has_next ? (const char*)g.A + (size_t)nxt.pm * tstep : cA; const char* nB = has_next ? (const char*)g.Bt + (size_t)nxt.pn * tstep : cB;
        for (int t = 0; t < nt; t += 2) {
            const bool last = (t == nt - 2);
            const char* a1 = cA + (size_t)(t + 1) * kstep;
            const char* a2 = last ? nA : cA + (size_t)(t + 2) * kstep; const char* b2 = last ? nB : cB + (size_t)(t + 2) * kstep;
            const char* a3 = a2 + kstep; const char* b3 = b2 + kstep;
            if (last && has_next) S.a_ready(nxt);
            PG8_LDB(B0, 0, 0); PG8_SCHED; PG8_LDA(At, 0, 0); PG8_STAGE(PG8_SA(1, 1), a1 + hstep, voffA);
            PG8_WAIT_L(8); PG8_BAR; PG8_WAIT_L(0); PG8_MMA(0, 0, At, B0); PG8_BAR; PG8_SCHED;
            PG8_LDB(B1, 0, 1); PG8_STAGE(PG8_SB(0, 0), b2, voffB);
            PG8_BAR; PG8_WAIT_L(0); PG8_MMA(0, 1, At, B1); PG8_BAR;
            PG8_LDA(At, 0, 1); PG8_STAGE(PG8_SA(0, 0), a2, voffA);
            PG8_BAR; PG8_WAIT_L(0); PG8_MMA(1, 0, At, B0); PG8_BAR; PG8_SCHED;
            PG8_STAGE(PG8_SB(0, 1), b2 + hstep, voffB);
            PG8_WAIT_V(6); PG8_BAR; PG8_MMA(1, 1, At, B1); PG8_BAR;
            PG8_LDB(B0, 1, 0); PG8_SCHED; PG8_LDA(At, 1, 0); PG8_STAGE(PG8_SA(0, 1), a2 + hstep, voffA);
            PG8_WAIT_L(8); PG8_BAR; PG8_WAIT_L(0); PG8_MMA(0, 0, At, B0); PG8_BAR; PG8_SCHED;
            PG8_LDB(B1, 1, 1); PG8_STAGE(PG8_SB(1, 0), b3, voffB);
            PG8_BAR; PG8_WAIT_L(0); PG8_MMA(0, 1, At, B1); PG8_BAR;
            PG8_LDA(At, 1, 1); PG8_STAGE(PG8_SA(1, 0), a3, voffA);
            PG8_BAR; PG8_WAIT_L(0); PG8_MMA(1, 0, At, B0); PG8_BAR; PG8_SCHED;
            PG8_STAGE(PG8_SB(1, 1), b3 + hstep, voffB);
            PG8_WAIT_V(6); PG8_BAR; PG8_MMA(1, 1, At, B1); PG8_BAR;
        }
        PG8_STAMP();
        if constexpr (!Epi::AFTER_DRAIN) { E(acc, cur, wr, wc, fr, fq); S.done(cur); }
        PG8_STAMP();
        if (!has_next) break;
#pragma unroll
        for (int a = 0; a < 2; ++a)
#pragma unroll
            for (int b = 0; b < 2; ++b)
#pragma unroll
                for (int m = 0; m < 4; ++m)
#pragma unroll
                    for (int n = 0; n < 2; ++n) acc[a][b][m][n] = (f32x4){0.f, 0.f, 0.f, 0.f};
        cur = nxt; cA = nA; cB = nB; ++ui;
    }
    PG8_WAIT_V(0);
    if (wr == 0) PG8_BAR;
    PG8_BAR;
    if constexpr (Epi::AFTER_DRAIN) { E.fused(acc, cur, wr, wc, fr, fq, lds, wid, lane); S.done(cur); }
    PG8_STAMP();
    if (STAMP && wid == 0) { stamps[lane] = lane < nts ? (((unsigned long long)(unsigned)ts_hi << 32) | (unsigned)ts_lo) : 0ull;
        if (lane == 62) stamps[62] = rt_entry; if (lane == 63) stamps[63] = (unsigned long long)wall_clock64(); }
#undef PG8_STAMP
#undef PG8_SA
#undef PG8_SB
#undef PG8_STAGE
#undef PG8_LDA
#undef PG8_LDB
#undef PG8_MMA
#undef PG8_WAIT_V
#undef PG8_WAIT_L
#undef PG8_BAR
#undef PG8_SCHED
}
}
struct Ctx {
    LAS unsigned char* lds; int tid, lane, wave, G, bid;
};

DI void cvt_rows(const Ctx& F, const float* src, bf16_t* dst, size_t n) {
    const size_t n8 = n >> 3;
    for (size_t i = (size_t)F.bid * NTHR + F.tid; i < n8; i += (size_t)F.G * NTHR) {
        const f32x4 a = *(const f32x4*)(src + i * 8), b = *(const f32x4*)(src + i * 8 + 4);
        u32x4 w; w.x = pk2(a.x, a.y); w.y = pk2(a.z, a.w); w.z = pk2(b.x, b.y); w.w = pk2(b.z, b.w);
        *(u32x4*)(dst + i * 8) = w;
    }
}

constexpr int TR_S = 68;
DI void tr_tile_out(const Ctx& F, bf16_t* dst, size_t ldd, const LAS bf16_t* tile) {
    const int n = F.tid >> 3, kc = (F.tid & 7) * 8;
    const LAS bf16_t* t = tile + kc * TR_S + n;
    u32x4 v;
    v.x = (unsigned)t[0] | ((unsigned)t[TR_S] << 16); v.y = (unsigned)t[2 * TR_S] | ((unsigned)t[3 * TR_S] << 16);
    v.z = (unsigned)t[4 * TR_S] | ((unsigned)t[5 * TR_S] << 16); v.w = (unsigned)t[6 * TR_S] | ((unsigned)t[7 * TR_S] << 16);
    *(u32x4*)(dst + (size_t)n * ldd + kc) = v;
}
DI void tr_tile_f32(const Ctx& F, const float* src, size_t lds_, bf16_t* dst, size_t ldd, LAS bf16_t* tile) {
#pragma unroll
    for (int j = 0; j < 2; ++j) {
        const int id = F.tid + NTHR * j, kr = id >> 4, nc = (id & 15) * 4;
        const f32x4 v = *(const f32x4*)(src + (size_t)kr * lds_ + nc);
        *(LAS u32x2*)(tile + kr * TR_S + nc) = (u32x2){pk2(v.x, v.y), pk2(v.z, v.w)};
    }
    __syncthreads();
    tr_tile_out(F, dst, ldd, tile);
    __syncthreads();
}
DI void tr_tile_bf16(const Ctx& F, const bf16_t* src, size_t lds_, bf16_t* dst, size_t ldd, LAS bf16_t* tile) {
    { const int kr = F.tid >> 3, nc = (F.tid & 7) * 8; const u32x4 v = *(const u32x4*)(src + (size_t)kr * lds_ + nc);
      *(LAS u32x2*)(tile + kr * TR_S + nc) = (u32x2){v.x, v.y}; *(LAS u32x2*)(tile + kr * TR_S + nc + 4) = (u32x2){v.z, v.w}; }
    __syncthreads();
    tr_tile_out(F, dst, ldd, tile);
    __syncthreads();
}
DI void transpose_weight(const Ctx& F, const float* W, int K, int N, bf16_t* Wt) {
    const int tk = K / 64, tn = N / 64;
    for (int t = F.bid; t < tk * tn; t += F.G) {
        const int k0 = (t / tn) * 64, n0 = (t % tn) * 64;
        tr_tile_f32(F, W + (size_t)k0 * N + n0, (size_t)N, Wt + (size_t)n0 * K + k0, (size_t)K, (LAS bf16_t*)F.lds);
    }
}
DI void transpose_cache_v(const Ctx& F, const float* V, bf16_t* VT) {
    for (int t = F.bid; t < 64 * 8; t += F.G) {
        const int bh = t >> 3, sub = t & 7, k0 = (sub >> 1) * 64, d0 = (sub & 1) * 64, b = bh >> 3, h = bh & 7;
        tr_tile_f32(F, V + ((size_t)b * 256 + k0) * 1024 + h * 128 + d0, 1024, VT + ((size_t)bh * 128 + d0) * 256 + k0, 256, (LAS bf16_t*)F.lds);
    }
}

DI void adaln_partials(const Ctx& F, const Params& P) {
    LAS float* s = (LAS float*)F.lds;
    const float* modw = P.in[I_MODW]; const float* cv = P.in[I_C]; const float* cctx = P.in[I_CCTX];
    float* modp = (float*)(P.ws + WS_MODP);
    for (int it = F.bid; it < 192; it += F.G) {
        const int i = it / 96, r = it % 96, ks = r / 6, cg = r % 6;
        __syncthreads();
        for (int e = F.tid; e < 9 * 128; e += NTHR) { const int j = e >> 7, k = e & 127; const float c = (j == 0) ? cctx[ks * 128 + k] : cv[(j - 1) * 2048 + ks * 128 + k]; s[e] = c / (1.f + __expf(-c)); }
        __syncthreads();
        f32x4 acc[9];
#pragma unroll
        for (int j = 0; j < 9; ++j) acc[j] = (f32x4){0.f, 0.f, 0.f, 0.f};
        const float* w = modw + ((size_t)i * 2048 + ks * 128) * 12288 + cg * 2048 + F.tid * 4;
#pragma unroll 8
        for (int k = 0; k < 128; ++k) {
            const f32x4 w4 = *(const f32x4*)(w + (size_t)k * 12288);
#pragma unroll
            for (int j = 0; j < 9; ++j) acc[j] += w4 * s[j * 128 + k];
        }
#pragma unroll
        for (int j = 0; j < 9; ++j) *(f32x4*)(modp + ((size_t)(i * 16 + ks) * 9 + j) * 12288 + cg * 2048 + F.tid * 4) = acc[j];
    }
    __syncthreads();
}
DI void adaln_reduce(const Ctx& F, const Params& P) {
    const float* modp = (const float*)(P.ws + WS_MODP); float* mod = (float*)(P.ws + WS_MOD); const float* modb = P.in[I_MODB];
    for (int e = F.bid * NTHR + F.tid; e < 2 * 9 * 12288; e += F.G * NTHR) {
        const int i = e / (9 * 12288), r = e % (9 * 12288), j = r / 12288, n = r % 12288;
        float a = modb[i * 12288 + n];
#pragma unroll
        for (int ks = 0; ks < 16; ++ks) a += modp[((size_t)(i * 16 + ks) * 9 + j) * 12288 + n];
        mod[e] = a;
    }
}

DI void hyena_filters(const Ctx& F, const Params& P) {
    LAS float* z = (LAS float*)F.lds;
    LAS float* h1 = z + 320;
    LAS float* h2 = h1 + 576;
    const float* w1 = P.in[I_HYW1]; const float* b1 = P.in[I_HYB1]; const float* f1 = P.in[I_HYF1];
    const float* w2 = P.in[I_HYW2]; const float* b2 = P.in[I_HYB2]; const float* f2 = P.in[I_HYF2];
    const float* w3 = P.in[I_HYW3]; const float* dec = P.in[I_HYDEC];
    for (int it = F.bid; it < 544; it += F.G) {
        const bool smp = it < 512; const int L = smp ? LS : LP, p0 = (smp ? it : it - 512) * 8, RL = smp ? KRL_S : KRL_P;
        bf16_t* KR = (bf16_t*)(P.ws + (smp ? WS_KRS : WS_KRP));
        __syncthreads();
        if (F.tid < 9 * 33) {
            const int ps = F.tid / 33, k = F.tid % 33, i = p0 + ps;
            const float t = (float)i / (float)(L - 1), wang = 6.283185307179586f * (float)i / (float)L;
            float val;
            if (k == 0) val = t;
            else { const int f = (k - 1) & 15; const float fr = 1e-4f + (float)f * ((15.0f - 1e-4f) / 15.0f); val = (k <= 16) ? cosf(fr * wang) : -sinf(fr * wang); }
            z[F.tid] = val;
        }
        __syncthreads();
        for (int e = F.tid; e < 9 * 64; e += NTHR) { const int ps = e >> 6, j = e & 63; float a = b1[j];
            for (int k = 0; k < 33; ++k) a += z[ps * 33 + k] * w1[k * 64 + j];
            h1[e] = sinf(f1[j] * a); }
        __syncthreads();
        for (int e = F.tid; e < 9 * 64; e += NTHR) { const int ps = e >> 6, j = e & 63; float a = b2[j];
            for (int k = 0; k < 64; ++k) a += h1[ps * 64 + k] * w2[k * 64 + j];
            h2[e] = sinf(f2[j] * a); }
        __syncthreads();
#pragma unroll 1
        for (int qh = 0; qh < 2; ++qh) {
            float acc[9][4];
#pragma unroll
            for (int ps = 0; ps < 9; ++ps)
#pragma unroll
                for (int q = 0; q < 4; ++q) acc[ps][q] = 0.f;
#pragma unroll 2
            for (int k = 0; k < 64; ++k) {
                float w[4];
#pragma unroll
                for (int q = 0; q < 4; ++q) w[q] = w3[k * 4096 + F.tid + NTHR * (qh * 4 + q)];
#pragma unroll
                for (int ps = 0; ps < 9; ++ps) { const float hv = h2[ps * 64 + k];
#pragma unroll
                    for (int q = 0; q < 4; ++q) acc[ps][q] += hv * w[q]; }
            }
#pragma unroll
            for (int q = 0; q < 4; ++q) {
                const int n = F.tid + NTHR * (qh * 4 + q), o = (n >> 10) & 1, c = n & 1023;
                const float dc = fabsf(dec[n]);
                bf16_t* row = KR + (size_t)(o * 1024 + c) * RL;
                float v[9];
#pragma unroll
                for (int ps = 0; ps < 9; ++ps) { const int i = p0 + ps; v[ps] = (i < L) ? acc[ps][q] * __expf(-((float)i / (float)(L - 1)) * dc) : 0.f; }
                if (qh == 0) {
                    u32x4 wv; wv.x = pk2(v[8], v[7]); wv.y = pk2(v[6], v[5]); wv.z = pk2(v[4], v[3]); wv.w = pk2(v[2], v[1]);
                    *(u32x4*)(row + (L - p0 - 8)) = wv;
                    if (p0 == 0) row[L] = f2bf(v[0]);
                } else if (p0 > 0) {
                    u32x4 wv; wv.x = pk2(v[0], v[1]); wv.y = pk2(v[2], v[3]); wv.z = pk2(v[4], v[5]); wv.w = pk2(v[6], v[7]);
                    *(u32x4*)(row + (L + p0)) = wv;
                } else {
#pragma unroll
                    for (int ps = 1; ps < 8; ++ps) row[L + ps] = f2bf(v[ps]);
                }
            }
        }
    }
    __syncthreads();
    for (int e = F.bid * NTHR + F.tid; e < 2 * 2048; e += F.G * NTHR) {
        const bool smp = e < 2048; const int r = e & 2047, L = smp ? LS : LP, RL = smp ? KRL_S : KRL_P;
        bf16_t* row = (bf16_t*)(P.ws + (smp ? WS_KRS : WS_KRP)) + (size_t)r * RL;
        for (int x = 2 * L; x < RL; ++x) row[x] = 0;
    }
}

DI void s5_consts(const Ctx& F, const Params& P) {
    float* S5A = (float*)(P.ws + WS_S5A); bf16_t* BB = (bf16_t*)(P.ws + WS_S5BB); bf16_t* CC = (bf16_t*)(P.ws + WS_S5CC);
    const float* lre = P.in[I_S5LRE]; const float* lim = P.in[I_S5LIM]; const float* ldt = P.in[I_S5LDT];
    const float* bre = P.in[I_S5BRE]; const float* bim = P.in[I_S5BIM]; const float* cre = P.in[I_S5CRE]; const float* cim = P.in[I_S5CIM];
    for (int e = F.bid * NTHR + F.tid; e < 8192; e += F.G * NTHR) {
        const int dg = e >> 6, n = e & 63;
        const float dt = expf(ldt[dg]), lr = lre[e], li = lim[e];
        const float mag = expf(lr * dt), ar = mag * cosf(li * dt), ai = mag * sinf(li * dt), den = lr * lr + li * li;
        const float cr = ((ar - 1.f) * lr + ai * li) / den, ci = (ai * lr - (ar - 1.f) * li) / den;
        S5A[e * 2] = ar; S5A[e * 2 + 1] = ai;
#pragma unroll
        for (int p = 0; p < 16; ++p) {
            const float br = bre[(size_t)e * 16 + p], bi = bim[(size_t)e * 16 + p];
            BB[((size_t)dg * 128 + n) * 16 + p] = f2bf(cr * br - ci * bi);
            BB[((size_t)dg * 128 + 64 + n) * 16 + p] = f2bf(cr * bi + ci * br);
            CC[((size_t)dg * 16 + p) * 128 + n] = f2bf(cre[((size_t)dg * 16 + p) * 64 + n]);
            CC[((size_t)dg * 16 + p) * 128 + 64 + n] = f2bf(-cim[((size_t)dg * 16 + p) * 64 + n]);
        }
    }
}

constexpr int PT_ROWB = 1536;
DI void cvt_table_fp6(const Ctx& F, const float* src, unsigned char* dst, float* scales, const int (&perm)[32]) {
    LAS float* scr = (LAS float*)(F.lds) + F.wave * 2048 + F.lane;
    for (int r = F.bid * 8 + F.wave; r < 16384; r += F.G * 8) {
        f32x4 v[8]; float m = 0.f;
#pragma unroll
        for (int j = 0; j < 8; ++j) { v[j] = *(const f32x4*)(src + (size_t)r * 2048 + F.lane * 32 + j * 4);
            m = fmaxf(m, fmaxf(fmaxf(fabsf(v[j].x), fabsf(v[j].y)), fmaxf(fabsf(v[j].z), fabsf(v[j].w)))); }
        m = wave_max(m);
        const float inv = (m > 0.f) ? 7.0f / m : 0.f, sc = (m > 0.f) ? m / 7.0f : 0.f;
#pragma unroll
        for (int j = 0; j < 8; ++j) { scr[perm[j * 4 + 0] * 64] = v[j].x * inv; scr[perm[j * 4 + 1] * 64] = v[j].y * inv; scr[perm[j * 4 + 2] * 64] = v[j].z * inv; scr[perm[j * 4 + 3] * 64] = v[j].w * inv; }
        asm volatile("" ::: "memory");
        f32x16 a, b;
#pragma unroll
        for (int i = 0; i < 16; ++i) { a[i] = scr[i * 64]; b[i] = scr[(16 + i) * 64]; }
        asm volatile("" ::: "memory");
        const u32x6 pk = __builtin_amdgcn_cvt_scalef32_2xpk16_fp6_f32(a, b, 1.0f);
        unsigned char* o = dst + (size_t)r * PT_ROWB;
        *(u32x4*)(o + F.lane * 16) = (u32x4){pk[0], pk[1], pk[2], pk[3]}; *(u32x2*)(o + 1024 + F.lane * 8) = (u32x2){pk[4], pk[5]};
        if (F.lane == 0) scales[r] = sc;
    }
}
DI void convert_peer_tables(const Ctx& F, const Params& P) {
    int perm[32];
    { f32x16 a, b;
#pragma unroll
      for (int j = 0; j < 16; ++j) { a[j] = 0.125f * (float)j; b[j] = (j < 8) ? 2.0f + 0.25f * (float)j : 4.0f + 0.5f * (float)(j - 8); }
      const u32x6 pk = __builtin_amdgcn_cvt_scalef32_2xpk16_fp6_f32(a, b, 1.0f);
      const f32x32 rt = __builtin_amdgcn_cvt_scalef32_pk32_f32_fp6(pk, 1.0f);
#pragma unroll
      for (int i = 0; i < 32; ++i) { const float x = rt[i]; const int o = (x < 2.0f) ? (int)(x * 8.0f + 0.5f) : ((x < 4.0f) ? 16 + (int)((x - 2.0f) * 4.0f + 0.5f) : 24 + (int)((x - 4.0f) * 2.0f + 0.5f)); perm[i] = min(max(o, 0), 31); } }
    float* SC = (float*)(P.ws + WS_SC);
    __syncthreads();
    for (int layer = 0; layer < 2; ++layer) {
        cvt_table_fp6(F, P.in[I_PU] + (size_t)layer * 16384 * 2048, P.ws + WS_TBLU + (size_t)layer * 16384 * PT_ROWB, SC + layer * 16384, perm);
        cvt_table_fp6(F, P.in[I_PV] + (size_t)layer * 16384 * 2048, P.ws + WS_TBLV + (size_t)layer * 16384 * PT_ROWB, SC + (2 + layer) * 16384, perm);
    }
    __syncthreads();
}

DI void prologue(const Ctx& F, const Params& P) {
    adaln_partials(F, P);
    transpose_weight(F, P.in[I_EVWIN], 2048, 6144, (bf16_t*)(P.ws + WS_WEVIN));
    transpose_weight(F, P.in[I_EVWOUT], 2048, 2048, (bf16_t*)(P.ws + WS_WEVOUT));
    transpose_weight(F, P.in[I_ODWIN], 2048, 4096, (bf16_t*)(P.ws + WS_WODIN));
    transpose_weight(F, P.in[I_ODWOUT], 2048, 2048, (bf16_t*)(P.ws + WS_WODOUT));
    transpose_weight(F, P.in[I_PWQ], 2048, 2048, (bf16_t*)(P.ws + WS_WPQ));
    transpose_weight(F, P.in[I_PWQ] + (size_t)2048 * 2048, 2048, 2048, (bf16_t*)(P.ws + WS_WPQ) + (size_t)2048 * 2048);
    transpose_weight(F, P.in[I_GLUW], 1024, 1024, (bf16_t*)(P.ws + WS_WGLU));
    cvt_rows(F, P.in[I_PKEYS], (bf16_t*)(P.ws + WS_PKEYS), (size_t)2 * 8 * 2 * 128 * 128);
    cvt_rows(F, P.in[I_CNK], (bf16_t*)(P.ws + WS_CNK), (size_t)8 * 256 * 1024);
    cvt_rows(F, P.in[I_CDK], (bf16_t*)(P.ws + WS_CDK), (size_t)8 * 256 * 1024);
    transpose_cache_v(F, P.in[I_CNV], (bf16_t*)(P.ws + WS_CNVT));
    transpose_cache_v(F, P.in[I_CDV], (bf16_t*)(P.ws + WS_CDVT));
    hyena_filters(F, P);
    s5_consts(F, P);
    convert_peer_tables(F, P);
}
DI void norm_phase(const Ctx& F, const float* xa, const float* xb, const float* gvec, const float* modl, int sidx, bf16_t* H) {
    for (int T = F.bid * 8 + F.wave; T < TOK; T += F.G * 8) {
        const float* xr = T < TP ? xa + (size_t)T * DM : xb + (size_t)(T - TP) * DM;
        f32x4 v[8]; float ss = 0.f;
#pragma unroll
        for (int j = 0; j < 8; ++j) { v[j] = *(const f32x4*)(xr + (j * 64 + F.lane) * 4); ss += v[j].x * v[j].x + v[j].y * v[j].y + v[j].z * v[j].z + v[j].w * v[j].w; }
        ss = wave_sum(ss);
        const float rstd = rsqrtf(ss * (1.f / DM) + NORM_EPS);
        const float* sh = modl + (size_t)(cond_of(T) * 6 + sidx) * DM; const float* sc = sh + DM;
#pragma unroll
        for (int j = 0; j < 8; ++j) {
            const int col = (j * 64 + F.lane) * 4;
            const f32x4 g4 = *(const f32x4*)(gvec + col), s4 = *(const f32x4*)(sc + col), h4 = *(const f32x4*)(sh + col);
            const f32x4 o = v[j] * rstd * g4 * (s4 + 1.f) + h4;
            u32x2 w; w.x = pk2(o.x, o.y); w.y = pk2(o.z, o.w);
            *(u32x2*)(H + (size_t)T * DM + col) = w;
        }
    }
}

struct EpiBf16 {
    static constexpr bool PERM = true, AFTER_DRAIN = false;
    bf16_t* O; int ldc;
    DI void operator()(const f32x4 (&acc)[2][2][4][2], const pg8::Unit& u, int wr, int wc, int fr, int fq) const {
        const int row0 = u.pm * 256 + wr * 64 + fr, col0 = u.pn * 256 + wc * 32 + 8 * fq;
#pragma unroll
        for (int ai = 0; ai < 2; ++ai)
#pragma unroll
            for (int m = 0; m < 4; ++m) { bf16_t* rowp = O + (size_t)(row0 + ai * 128 + m * 16) * ldc + col0;
#pragma unroll
                for (int bj = 0; bj < 2; ++bj) { const f32x4 v0 = acc[ai][bj][m][0], v1 = acc[ai][bj][m][1];
                    u32x4 w; w.x = pk2(v0[0], v0[1]); w.y = pk2(v0[2], v0[3]); w.z = pk2(v1[0], v1[1]); w.w = pk2(v1[2], v1[3]);
                    *(u32x4*)(rowp + bj * 128) = w; } }
    }
};
struct EpiResid {
    static constexpr bool PERM = false, AFTER_DRAIN = false;
    const float* xa; const float* xb; float* out; const float* modl; int gidx;
    DI void operator()(const f32x4 (&acc)[2][2][4][2], const pg8::Unit& u, int wr, int wc, int fr, int fq) const {
        const int row0 = u.pm * 256 + wr * 64 + fr, col0 = u.pn * 256 + wc * 32 + 4 * fq;
        const float* xbase = (u.pm < 32) ? xa : xb - (size_t)TP * DM;
        const float* gate = modl + (size_t)(cond_of(u.pm * 256) * 6 + gidx) * DM;
        f32x4 gv[2][2];
#pragma unroll
        for (int bj = 0; bj < 2; ++bj)
#pragma unroll
            for (int n = 0; n < 2; ++n) gv[bj][n] = *(const f32x4*)(gate + col0 + bj * 128 + n * 16);
#pragma unroll
        for (int ai = 0; ai < 2; ++ai)
#pragma unroll
            for (int m = 0; m < 4; ++m) { const size_t ro = (size_t)(row0 + ai * 128 + m * 16) * DM + col0;
#pragma unroll
                for (int bj = 0; bj < 2; ++bj)
#pragma unroll
                    for (int n = 0; n < 2; ++n) { const f32x4 x4 = *(const f32x4*)(xbase + ro + bj * 128 + n * 16);
                        *(f32x4*)(out + ro + bj * 128 + n * 16) = x4 + gv[bj][n] * acc[ai][bj][m][n]; } }
    }
};
struct EpiGlu {
    static constexpr bool PERM = true, AFTER_DRAIN = false;
    const bf16_t* Y; bf16_t* O; const float* bias;
    DI void operator()(const f32x4 (&acc)[2][2][4][2], const pg8::Unit& u, int wr, int wc, int fr, int fq) const {
        const int row0 = u.pm * 256 + wr * 64 + fr, col0 = u.pn * 256 + wc * 32 + 8 * fq;
#pragma unroll
        for (int bj = 0; bj < 2; ++bj) {
            const f32x4 b0 = *(const f32x4*)(bias + col0 + bj * 128), b1 = *(const f32x4*)(bias + col0 + bj * 128 + 4);
#pragma unroll
            for (int ai = 0; ai < 2; ++ai)
#pragma unroll
                for (int m = 0; m < 4; ++m) { const size_t r = (size_t)(row0 + ai * 128 + m * 16);
                    const u32x4 yv = *(const u32x4*)(Y + r * 1024 + col0 + bj * 128);
                    const f32x4 a0 = acc[ai][bj][m][0] + b0, a1 = acc[ai][bj][m][1] + b1;
                    float o[8];
                    o[0] = bflo(yv.x) / (1.f + __expf(-a0[0])); o[1] = bfhi(yv.x) / (1.f + __expf(-a0[1]));
                    o[2] = bflo(yv.y) / (1.f + __expf(-a0[2])); o[3] = bfhi(yv.y) / (1.f + __expf(-a0[3]));
                    o[4] = bflo(yv.z) / (1.f + __expf(-a1[0])); o[5] = bfhi(yv.z) / (1.f + __expf(-a1[1]));
                    o[6] = bflo(yv.w) / (1.f + __expf(-a1[2])); o[7] = bfhi(yv.w) / (1.f + __expf(-a1[3]));
                    u32x4 w; w.x = pk2(o[0], o[1]); w.y = pk2(o[2], o[3]); w.z = pk2(o[4], o[5]); w.w = pk2(o[6], o[7]);
                    *(u32x4*)(O + r * DM + col0 + bj * 128) = w; }
        }
    }
};
template <class Epi> DI void run_gemm(const Ctx& F, const bf16_t* A, const bf16_t* Bt, int N, int K, const Epi& E) {
    pg8::Gemm g{A, Bt, TOK, N, K}; pg8::StaticOrder S; S.init(TOK, N, F.G, F.bid);
    pg8::gemm_phase<Epi, pg8::StaticOrder, false>(F.lds, g, S, E, nullptr);
    __syncthreads();
}

DI void prep_a(const Ctx& F, const Params& P) {
    const bf16_t* T1 = (const bf16_t*)(P.ws + WS_RA);
    bf16_t* VTp = (bf16_t*)(P.ws + WS_VT); bf16_t* VTs = (bf16_t*)(P.ws + WS_VT + VT_S);
    for (int t = F.bid; t < 2048 + 8192; t += F.G) {
        if (t < 2048) { const int bh = t >> 3, sub = t & 7, tk = sub >> 1, dd = sub & 1, b = bh >> 3, h = bh & 7;
            tr_tile_bf16(F, T1 + ((size_t)(b * 256 + tk * 64)) * 4096 + h * 128 + dd * 64, 4096, VTp + ((size_t)bh * 128 + dd * 64) * 256 + tk * 64, 256, (LAS bf16_t*)F.lds); }
        else { const int u = t - 2048, bh = u >> 7, sub = u & 127, tk = sub >> 1, dd = sub & 1, b = bh >> 3, h = bh & 7;
            tr_tile_bf16(F, T1 + ((size_t)(TP + b * 4096 + tk * 64)) * 4096 + h * 128 + dd * 64, 4096, VTs + ((size_t)bh * 128 + dd * 64) * 4096 + tk * 64, 4096, (LAS bf16_t*)F.lds); }
    }
    { float* o = P.out + O_NAV;
      for (int e = F.bid * NTHR + F.tid; e < TP * 128; e += F.G * NTHR) { const int T = e >> 7, c8 = (e & 127) * 8;
          const u32x4 v = *(const u32x4*)(T1 + (size_t)T * 4096 + c8);
          *(f32x4*)(o + (size_t)T * 1024 + c8) = (f32x4){bflo(v.x), bfhi(v.x), bflo(v.y), bfhi(v.y)};
          *(f32x4*)(o + (size_t)T * 1024 + c8 + 4) = (f32x4){bflo(v.z), bfhi(v.z), bflo(v.w), bfhi(v.w)}; } }
    { LAS bf16_t* tl = (LAS bf16_t*)F.lds;
      bf16_t* CM = (bf16_t*)(P.ws + WS_RB);
      const float* cw = P.in[I_HYCW]; const float* cb = P.in[I_HYCB];
      for (int t = F.bid; t < 48 * 160; t += F.G) {
          const int cg = t % 48, tg = t / 48, ch0 = cg * 64, t0 = tg * 256;
          const bool lz = (t0 < TP) ? true : (((t0 - TP) & 4095) == 0);
          const bool rz = (t0 < TP) ? true : (((t0 + 256 - TP) & 4095) == 0);
          __syncthreads();
#pragma unroll
          for (int j = 0; j < 4; ++j) { const int id = F.tid + NTHR * j, tk = id >> 3, c8 = (id & 7) * 8;
              const u32x4 v = *(const u32x4*)(T1 + (size_t)(t0 + tk) * 4096 + 1024 + ch0 + c8);
              LAS bf16_t* d = tl + tk + 1;
              d[(c8 + 0) * 264] = (bf16_t)(v.x & 0xffff); d[(c8 + 1) * 264] = (bf16_t)(v.x >> 16); d[(c8 + 2) * 264] = (bf16_t)(v.y & 0xffff); d[(c8 + 3) * 264] = (bf16_t)(v.y >> 16);
              d[(c8 + 4) * 264] = (bf16_t)(v.z & 0xffff); d[(c8 + 5) * 264] = (bf16_t)(v.z >> 16); d[(c8 + 6) * 264] = (bf16_t)(v.w & 0xffff); d[(c8 + 7) * 264] = (bf16_t)(v.w >> 16); }
          if (F.tid < 16) { const int side = F.tid >> 3, c8 = (F.tid & 7) * 8; const bool zero = side ? rz : lz; const int tk = side ? t0 + 256 : t0 - 1;
              u32x4 v = (u32x4){0u, 0u, 0u, 0u};
              if (!zero) v = *(const u32x4*)(T1 + (size_t)tk * 4096 + 1024 + ch0 + c8);
              LAS bf16_t* d = tl + (side ? 257 : 0);
              d[(c8 + 0) * 264] = (bf16_t)(v.x & 0xffff); d[(c8 + 1) * 264] = (bf16_t)(v.x >> 16); d[(c8 + 2) * 264] = (bf16_t)(v.y & 0xffff); d[(c8 + 3) * 264] = (bf16_t)(v.y >> 16);
              d[(c8 + 4) * 264] = (bf16_t)(v.z & 0xffff); d[(c8 + 5) * 264] = (bf16_t)(v.z >> 16); d[(c8 + 6) * 264] = (bf16_t)(v.w & 0xffff); d[(c8 + 7) * 264] = (bf16_t)(v.w >> 16); }
          __syncthreads();
#pragma unroll
          for (int j = 0; j < 4; ++j) { const int id = F.tid + NTHR * j, ch = id >> 5, to = (id & 31) * 8, cgl = ch0 + ch;
              const float w0 = cw[cgl], w1 = cw[3072 + cgl], w2 = cw[6144 + cgl], bb = cb[cgl];
              const LAS bf16_t* s = tl + ch * 264 + to;
              float r[10];
#pragma unroll
              for (int i = 0; i < 10; ++i) r[i] = bf2f(s[i]);
              float o[8];
#pragma unroll
              for (int i = 0; i < 8; ++i) o[i] = w0 * r[i] + w1 * r[i + 1] + w2 * r[i + 2] + bb;
              u32x4 w; w.x = pk2(o[0], o[1]); w.y = pk2(o[2], o[3]); w.z = pk2(o[4], o[5]); w.w = pk2(o[6], o[7]);
              *(u32x4*)(CM + (size_t)cgl * TOK + t0 + to) = w; }
      }
      __syncthreads(); }
}

DI void prep_b(const Ctx& F, const Params& P) {
    bf16_t* Pq = (bf16_t*)(P.ws + WS_RA); const float* qg = P.in[I_NAQG]; const float* kg = P.in[I_NAKG]; float* ok = P.out + O_NAK;
    const float* gsrc = (F.lane < 32 ? qg : kg) + (F.lane & 3) * 32;
    float g[32];
#pragma unroll
    for (int i = 0; i < 32; ++i) g[i] = gsrc[i];
    for (int T = F.bid * 8 + F.wave; T < TOK; T += F.G * 8) {
        bf16_t* rp = Pq + (size_t)T * 2048 + F.lane * 32;
        u32x4 v[4]; float x[32]; float ss = 0.f;
#pragma unroll
        for (int j = 0; j < 4; ++j) { v[j] = *(const u32x4*)(rp + j * 8);
            x[j * 8 + 0] = bflo(v[j].x); x[j * 8 + 1] = bfhi(v[j].x); x[j * 8 + 2] = bflo(v[j].y); x[j * 8 + 3] = bfhi(v[j].y);
            x[j * 8 + 4] = bflo(v[j].z); x[j * 8 + 5] = bfhi(v[j].z); x[j * 8 + 6] = bflo(v[j].w); x[j * 8 + 7] = bfhi(v[j].w); }
#pragma unroll
        for (int i = 0; i < 32; ++i) ss += x[i] * x[i];
        ss += dpp_xor1(ss); ss += dpp_xor2(ss);
        const float rstd = rsqrtf(ss * (1.f / 128.f) + NORM_EPS);
#pragma unroll
        for (int i = 0; i < 32; ++i) x[i] = x[i] * rstd * g[i];
#pragma unroll
        for (int j = 0; j < 4; ++j) { u32x4 w; w.x = pk2(x[j * 8 + 0], x[j * 8 + 1]); w.y = pk2(x[j * 8 + 2], x[j * 8 + 3]); w.z = pk2(x[j * 8 + 4], x[j * 8 + 5]); w.w = pk2(x[j * 8 + 6], x[j * 8 + 7]);
            *(u32x4*)(rp + j * 8) = w; }
        if (T < TP && F.lane >= 32) { float* o = ok + (size_t)T * 1024 + (F.lane - 32) * 32;
#pragma unroll
            for (int j = 0; j < 8; ++j) *(f32x4*)(o + j * 4) = (f32x4){x[j * 4], x[j * 4 + 1], x[j * 4 + 2], x[j * 4 + 3]}; }
    }
}
constexpr int AT_KROW = 272, AT_VROW = 136, AT_KTB = 64 * AT_KROW, AT_VTB = 128 * AT_VROW;
constexpr int AT_K0 = 0, AT_V0 = 2 * AT_KTB, AT_RPB = AT_V0 + 2 * AT_VTB;

struct TileMap { const bf16_t* latK; int latKld; const bf16_t* latV; int latVld; int nlat; const bf16_t* ctxK; const bf16_t* ctxV; int ntiles; };
struct TileRegs { u32x4 k[2], v[2]; };

DI void tile_src(const TileMap& M, int j, const bf16_t*& kp, int& kld, const bf16_t*& vp, int& vld) {
    if (j < M.nlat) { kp = M.latK + (size_t)j * 64 * M.latKld; kld = M.latKld; vp = M.latV + j * 64; vld = M.latVld; }
    else { const int c = j - M.nlat; kp = M.ctxK + (size_t)c * 64 * 1024; kld = 1024; vp = M.ctxV + c * 64; vld = 256; }
}
DI void tile_load(const Ctx& F, TileRegs& R, const bf16_t* kp, int kld, const bf16_t* vp, int vld, bool withV = true) {
#pragma unroll
    for (int j = 0; j < 2; ++j) { const int id = F.tid + NTHR * j;
        const unsigned ko = (unsigned)((id >> 4) * kld + (id & 15) * 8) * 2u, vo = (unsigned)((id >> 3) * vld + (id & 7) * 8) * 2u;
        R.k[j] = *(const u32x4*)((const char*)kp + ko);
        if (withV) R.v[j] = *(const u32x4*)((const char*)vp + vo); }
}
DI void tile_store(const Ctx& F, const TileRegs& R, LAS unsigned char* kt, LAS unsigned char* vt, bool withV = true) {
#pragma unroll
    for (int j = 0; j < 2; ++j) { const int id = F.tid + NTHR * j;
        *(LAS u32x4*)(kt + (id >> 4) * AT_KROW + (id & 15) * 16) = R.k[j];
        if (withV) { LAS unsigned char* vp = vt + (id >> 3) * AT_VROW + (id & 7) * 16;
            *(LAS u32x2*)(vp) = (u32x2){R.v[j].x, R.v[j].y}; *(LAS u32x2*)(vp + 8) = (u32x2){R.v[j].z, R.v[j].w}; } }
}

DI void tile_norm_k(const Ctx& F, TileRegs& R, const LAS float* kgain, float* nk, int nkld) {
#pragma unroll
    for (int j = 0; j < 2; ++j) { const int id = F.tid + NTHR * j;
        float x[8] = {bflo(R.k[j].x), bfhi(R.k[j].x), bflo(R.k[j].y), bfhi(R.k[j].y), bflo(R.k[j].z), bfhi(R.k[j].z), bflo(R.k[j].w), bfhi(R.k[j].w)};
        float ss = 0.f;
#pragma unroll
        for (int i = 0; i < 8; ++i) ss += x[i] * x[i];
        ss += dpp_xor1(ss); ss += dpp_xor2(ss);
        ss += __builtin_bit_cast(float, __builtin_amdgcn_update_dpp(0, __builtin_bit_cast(int, ss), 0x141, 0xF, 0xF, true));
        ss += __builtin_bit_cast(float, __builtin_amdgcn_update_dpp(0, __builtin_bit_cast(int, ss), 0x140, 0xF, 0xF, true));
        const float rstd = rsqrtf(ss * (1.f / 128.f) + NORM_EPS);
        const f32x4 g0 = *(const LAS f32x4*)(kgain + (id & 15) * 8), g1 = *(const LAS f32x4*)(kgain + (id & 15) * 8 + 4);
        x[0] *= rstd * g0.x; x[1] *= rstd * g0.y; x[2] *= rstd * g0.z; x[3] *= rstd * g0.w; x[4] *= rstd * g1.x; x[5] *= rstd * g1.y; x[6] *= rstd * g1.z; x[7] *= rstd * g1.w;
        R.k[j] = (u32x4){pk2(x[0], x[1]), pk2(x[2], x[3]), pk2(x[4], x[5]), pk2(x[6], x[7])};
        if (nk) { float* o = nk + (size_t)(id >> 4) * nkld + (id & 15) * 8; *(f32x4*)(o) = (f32x4){x[0], x[1], x[2], x[3]}; *(f32x4*)(o + 4) = (f32x4){x[4], x[5], x[6], x[7]}; }
    }
}

template <int KS>
DI f32x16 qk_tile(LAS const unsigned char* kt, const bf16x8 (&Qf)[8], int kb, int kk0, int q, int hh) {
    f32x16 S;
#pragma unroll
    for (int i = 0; i < 16; ++i) S[i] = 0.f;
#pragma unroll
    for (int ks = 0; ks < KS; ++ks) { const int kk = kk0 + ks;
        const bf16x8 A = *(const LAS bf16x8*)(kt + (kb * 32 + q) * AT_KROW + (kk * 16 + hh * 8) * 2);
        S = __builtin_amdgcn_mfma_f32_32x32x16_bf16(A, Qf[kk], S, 0, 0, 0); }
    return S;
}
DI void pv_tile(LAS const unsigned char* vt, const float (&p)[16], f32x16 (&O)[4], int kb, int q, int hh) {
#pragma unroll
    for (int s = 0; s < 2; ++s) {
        u32x4 pw; pw.x = pk2(p[8 * s + 0], p[8 * s + 1]); pw.y = pk2(p[8 * s + 2], p[8 * s + 3]); pw.z = pk2(p[8 * s + 4], p[8 * s + 5]); pw.w = pk2(p[8 * s + 6], p[8 * s + 7]);
        const bf16x8 Pf = __builtin_bit_cast(bf16x8, pw);
#pragma unroll
        for (int db = 0; db < 4; ++db) {
            LAS const unsigned char* ap = vt + (db * 32 + q) * AT_VROW + (kb * 32 + 16 * s + 4 * hh) * 2;
            const u32x2 lo = *(const LAS u32x2*)(ap), hi = *(const LAS u32x2*)(ap + 16);
            const bf16x8 A2 = __builtin_bit_cast(bf16x8, (u32x4){lo.x, lo.y, hi.x, hi.y});
            O[db] = __builtin_amdgcn_mfma_f32_32x32x16_bf16(A2, Pf, O[db], 0, 0, 0);
        }
        asm volatile("" ::: "memory");
    }
}
template <bool LAT>
DI void attn_compute1(LAS const unsigned char* kt, LAS const unsigned char* vt, const bf16x8 (&Qf)[8], f32x16 (&O)[4], float& ls, int lane, const LAS float* blane, int mb) {
    const int q = lane & 31, hh = lane >> 5;
#pragma unroll 1
    for (int kb = 0; kb < 2; ++kb) {
        float bb[16];
        if (LAT) {
#pragma unroll
            for (int i = 0; i < 16; ++i) bb[i] = blane[kb * 32 + (i & 3) + 8 * (i >> 2)];
        }
        const f32x16 S = qk_tile<8>(kt, Qf, kb, 0, q, hh);
        float p[16];
#pragma unroll
        for (int i = 0; i < 16; ++i) {
            if (LAT) { const float e = __builtin_amdgcn_exp2f(S[i] + bb[i]);
                p[i] = ((unsigned)(kb * 32 + (i & 3) + 8 * (i >> 2) + mb) < 16u) ? e : 0.f; }
            else p[i] = __builtin_amdgcn_exp2f(S[i]);
            ls += p[i];
        }
        pv_tile(vt, p, O, kb, q, hh);
    }
}
DI void diff_pass1(LAS const unsigned char* kt, const bf16x8 (&Qf)[8], float (&ls)[2], int lane) {
    const int q = lane & 31, hh = lane >> 5;
#pragma unroll
    for (int kb = 0; kb < 2; ++kb) {
#pragma unroll
        for (int mp = 0; mp < 2; ++mp) { const f32x16 S = qk_tile<4>(kt, Qf, kb, mp * 4, q, hh);
#pragma unroll
            for (int i = 0; i < 16; ++i) ls[mp] += __builtin_amdgcn_exp2f(S[i]); }
    }
}
DI void diff_pass2(LAS const unsigned char* kt, LAS const unsigned char* vt, const bf16x8 (&Qf)[8], f32x16 (&O)[4], float w0, float w1, int lane) {
    const int q = lane & 31, hh = lane >> 5;
#pragma unroll
    for (int kb = 0; kb < 2; ++kb) {
        float p[16];
        { const f32x16 S0 = qk_tile<4>(kt, Qf, kb, 0, q, hh);
#pragma unroll
          for (int i = 0; i < 16; ++i) p[i] = __builtin_amdgcn_exp2f(S0[i]) * w0; }
        { const f32x16 S1 = qk_tile<4>(kt, Qf, kb, 4, q, hh);
#pragma unroll
          for (int i = 0; i < 16; ++i) p[i] -= __builtin_amdgcn_exp2f(S1[i]) * w1; }
        pv_tile(vt, p, O, kb, q, hh);
    }
}

template <int MODE>
DI void attn_phase(const Ctx& F, const Params& P) {
    constexpr bool DIFF = (MODE >= 2);
    constexpr bool NA = (MODE == 1);
    LAS unsigned char* lds = F.lds;
    LAS float* rpbl = (LAS float*)(lds + AT_RPB);
    LAS float* kgl = (LAS float*)(lds + AT_RPB + 2048);
    if (!DIFF) { __syncthreads(); if (F.tid < 128) kgl[F.tid] = P.in[I_NAKG][F.tid]; __syncthreads(); }
    const bf16_t* PA = (const bf16_t*)(P.ws + WS_RA);
    bf16_t* MIX = (bf16_t*)(P.ws + WS_HM);
    const bf16_t* VTp = (const bf16_t*)(P.ws + WS_VT); const bf16_t* VTs = (const bf16_t*)(P.ws + WS_VT + VT_S);
    const int q = F.lane & 31, hh = F.lane >> 5;
    const float c1 = (DIFF ? 0.125f : 0.08838834764831845f) * LOG2E;
    float lam = 0.f;
    if (DIFF) {
        const float a = wave_sum(P.in[I_LQ1][F.lane] * P.in[I_LK1][F.lane]), b = wave_sum(P.in[I_LQ2][F.lane] * P.in[I_LK2][F.lane]);
        lam = __expf(a) - __expf(b) + 0.35550906759096924f;
    }
    const int nunits = (MODE == 0 || MODE == 2) ? 256 : 1024;
    for (int u0 = F.bid; u0 < nunits; u0 += F.G) {
        int u = u0;
        if ((MODE == 1 || MODE == 3) && F.G == 256) { const int i = u0 >> 8, x = F.bid & 7, y = F.bid >> 3; u = ((2 * i + (y >> 4)) * 8 + x) * 16 + (y & 15); }
        int b, h, tok0, r = 0, rlo = 0; TileMap M;
        const bf16_t* qptr;
        if (MODE == 0) { b = u >> 3; h = u & 7; tok0 = b * 256 + F.wave * 32;
            qptr = PA + (size_t)(tok0 + q) * 2048 + h * 128;
            M.latK = PA + (size_t)(b * 256) * 2048 + 1024 + h * 128; M.latKld = 2048; M.latV = VTp + (size_t)(b * 8 + h) * 128 * 256; M.latVld = 256; M.nlat = 4; M.ctxK = nullptr; M.ctxV = nullptr; M.ntiles = 4; }
        else if (MODE == 1) { b = u >> 7; h = (u >> 4) & 7; const int rg = u & 15; r = 4 * rg + (F.wave >> 1);
            rlo = min(max(4 * rg - 4, 0), 56); const int rhi = min(max(4 * rg + 3 - 4, 0), 56) + 8;
            tok0 = TP + b * 4096 + r * 64 + (F.wave & 1) * 32;
            qptr = PA + (size_t)(tok0 + q) * 2048 + h * 128;
            M.latK = PA + (size_t)(TP + b * 4096 + rlo * 64) * 2048 + 1024 + h * 128; M.latKld = 2048; M.latV = VTs + (size_t)(b * 8 + h) * 128 * 4096 + rlo * 64; M.latVld = 4096; M.nlat = rhi - rlo;
            M.ctxK = (const bf16_t*)(P.ws + WS_CNK) + (size_t)b * 256 * 1024 + h * 128; M.ctxV = (const bf16_t*)(P.ws + WS_CNVT) + (size_t)(b * 8 + h) * 128 * 256; M.ntiles = M.nlat + 4;
            if (F.tid < 465) rpbl[F.tid] = P.in[I_RPB][h * 465 + F.tid] * LOG2E; }
        else if (MODE == 2) { b = u >> 3; h = u & 7; tok0 = b * 256 + F.wave * 32;
            qptr = PA + (size_t)(tok0 + q) * 4096 + 1024 + h * 128;
            M.latK = PA + (size_t)(b * 256) * 4096 + 2048 + h * 128; M.latKld = 4096; M.latV = VTp + (size_t)(b * 8 + h) * 128 * 256; M.latVld = 256; M.nlat = 4; M.ctxK = nullptr; M.ctxV = nullptr; M.ntiles = 4; }
        else { b = u >> 7; h = (u >> 4) & 7; const int qb = u & 15; tok0 = TP + b * 4096 + qb * 256 + F.wave * 32;
            qptr = PA + (size_t)(tok0 + q) * 4096 + 1024 + h * 128;
            M.latK = PA + (size_t)(TP + b * 4096) * 4096 + 2048 + h * 128; M.latKld = 4096; M.latV = VTs + (size_t)(b * 8 + h) * 128 * 4096; M.latVld = 4096; M.nlat = 64;
            M.ctxK = (const bf16_t*)(P.ws + WS_CDK) + (size_t)b * 256 * 1024 + h * 128; M.ctxV = (const bf16_t*)(P.ws + WS_CDVT) + (size_t)(b * 8 + h) * 128 * 256; M.ntiles = 68; }
        bf16x8 Qf[8];
        if constexpr (!DIFF) {
            u32x4 w[8]; float ss = 0.f;
#pragma unroll
            for (int ks = 0; ks < 8; ++ks) { w[ks] = *(const u32x4*)(qptr + ks * 16 + hh * 8);
                ss += bflo(w[ks].x) * bflo(w[ks].x) + bfhi(w[ks].x) * bfhi(w[ks].x) + bflo(w[ks].y) * bflo(w[ks].y) + bfhi(w[ks].y) * bfhi(w[ks].y)
                    + bflo(w[ks].z) * bflo(w[ks].z) + bfhi(w[ks].z) * bfhi(w[ks].z) + bflo(w[ks].w) * bflo(w[ks].w) + bfhi(w[ks].w) * bfhi(w[ks].w); }
            ss += __shfl_xor(ss, 32);
            const float qs = rsqrtf(ss * (1.f / 128.f) + NORM_EPS) * c1;
            const float* qg = P.in[I_NAQG];
#pragma unroll
            for (int ks = 0; ks < 8; ++ks) { const f32x4 g0 = *(const f32x4*)(qg + ks * 16 + hh * 8), g1 = *(const f32x4*)(qg + ks * 16 + hh * 8 + 4);
                const u32x4 ws = (u32x4){pk2(bflo(w[ks].x) * qs * g0.x, bfhi(w[ks].x) * qs * g0.y), pk2(bflo(w[ks].y) * qs * g0.z, bfhi(w[ks].y) * qs * g0.w),
                                         pk2(bflo(w[ks].z) * qs * g1.x, bfhi(w[ks].z) * qs * g1.y), pk2(bflo(w[ks].w) * qs * g1.z, bfhi(w[ks].w) * qs * g1.w)};
                Qf[ks] = __builtin_bit_cast(bf16x8, ws); }
        } else {
#pragma unroll
        for (int ks = 0; ks < 8; ++ks) { const u32x4 w = *(const u32x4*)(qptr + ks * 16 + hh * 8);
            const u32x4 ws = (u32x4){pk2(bflo(w.x) * c1, bfhi(w.x) * c1), pk2(bflo(w.y) * c1, bfhi(w.y) * c1), pk2(bflo(w.z) * c1, bfhi(w.z) * c1), pk2(bflo(w.w) * c1, bfhi(w.w) * c1)};
            Qf[ks] = __builtin_bit_cast(bf16x8, ws); }
        }
        f32x16 O[4]; float ls[2] = {0.f, 0.f}; float w0 = 0.f, w1 = 0.f;
#pragma unroll
        for (int db = 0; db < 4; ++db)
#pragma unroll
            for (int i = 0; i < 16; ++i) O[db][i] = 0.f;
        const int cq = (F.wave & 1) * 32 + q, cs = min(max(cq - 8, 0), 48);
        const int r0w = min(max(r - 4, 0), 56);
        const int nt = M.ntiles;
        TileRegs R;
        { const bf16_t* kp; const bf16_t* vp; int kld, vld; tile_src(M, 0, kp, kld, vp, vld); tile_load(F, R, kp, kld, vp, vld); }
        if constexpr (!DIFF) tile_norm_k(F, R, kgl, (MODE == 0) ? P.out + O_NAK + (size_t)(b * 256) * 1024 + h * 128 : nullptr, 1024);
        tile_store(F, R, lds + AT_K0, lds + AT_V0);
        __syncthreads();
        if constexpr (DIFF) {
#pragma unroll 1
            for (int j = 0; j < nt; ++j) {
                const int cur = j & 1, jn = (j + 1 < nt) ? j + 1 : 0;
                const bool wv = (j + 1 == nt);
                { const bf16_t* kp; const bf16_t* vp; int kld, vld; tile_src(M, jn, kp, kld, vp, vld); tile_load(F, R, kp, kld, vp, vld, wv); }
                diff_pass1(lds + AT_K0 + cur * AT_KTB, Qf, ls, F.lane);
                tile_store(F, R, lds + AT_K0 + (cur ^ 1) * AT_KTB, lds + AT_V0 + (cur ^ 1) * AT_VTB, wv);
                __syncthreads();
            }
            { const float l0 = ls[0] + __shfl_xor(ls[0], 32), l1 = ls[1] + __shfl_xor(ls[1], 32); w0 = 1.f / l0; w1 = lam / l1; }
#pragma unroll 1
            for (int j = 0; j < nt; ++j) {
                const int cur = (nt + j) & 1;
                if (j + 1 < nt) { const bf16_t* kp; const bf16_t* vp; int kld, vld; tile_src(M, j + 1, kp, kld, vp, vld); tile_load(F, R, kp, kld, vp, vld); }
                diff_pass2(lds + AT_K0 + cur * AT_KTB, lds + AT_V0 + cur * AT_VTB, Qf, O, w0, w1, F.lane);
                if (j + 1 < nt) tile_store(F, R, lds + AT_K0 + (cur ^ 1) * AT_KTB, lds + AT_V0 + (cur ^ 1) * AT_VTB);
                __syncthreads();
            }
        } else {
#pragma unroll 1
            for (int j = 0; j < nt; ++j) {
                const int cur = j & 1;
                if (j + 1 < nt) { const bf16_t* kp; const bf16_t* vp; int kld, vld; tile_src(M, j + 1, kp, kld, vp, vld); tile_load(F, R, kp, kld, vp, vld); }
                LAS const unsigned char* kt = lds + AT_K0 + cur * AT_KTB; LAS const unsigned char* vt = lds + AT_V0 + cur * AT_VTB;
                if constexpr (NA) {
                    if (j < M.nlat) { const int kr = rlo + j;
                        if (kr >= r0w && kr < r0w + 8) attn_compute1<true>(kt, vt, Qf, O, ls[0], F.lane, rpbl + (kr - r + 7) * 31 + (4 * hh - cq + 15), 4 * hh - cs); }
                    else attn_compute1<false>(kt, vt, Qf, O, ls[0], F.lane, rpbl, 0);
                } else attn_compute1<false>(kt, vt, Qf, O, ls[0], F.lane, rpbl, 0);
                if (j + 1 < nt) {
                    if (j + 1 < M.nlat) tile_norm_k(F, R, kgl, (MODE == 0) ? P.out + O_NAK + (size_t)(b * 256 + (j + 1) * 64) * 1024 + h * 128 : nullptr, 1024);
                    tile_store(F, R, lds + AT_K0 + (cur ^ 1) * AT_KTB, lds + AT_V0 + (cur ^ 1) * AT_VTB); }
                __syncthreads();
            }
        }
        if constexpr (!DIFF) {
            const float inv = 1.f / (ls[0] + __shfl_xor(ls[0], 32));
            bf16_t* op = MIX + (size_t)(tok0 + q) * DM + h * 128 + 4 * hh;
#pragma unroll
            for (int db = 0; db < 4; ++db)
#pragma unroll
                for (int g = 0; g < 4; ++g) { u32x2 w; w.x = pk2(O[db][4 * g] * inv, O[db][4 * g + 1] * inv); w.y = pk2(O[db][4 * g + 2] * inv, O[db][4 * g + 3] * inv);
                    *(u32x2*)(op + db * 32 + 8 * g) = w; }
        } else {
            float ss = 0.f;
#pragma unroll
            for (int db = 0; db < 4; ++db)
#pragma unroll
                for (int i = 0; i < 16; ++i) ss += O[db][i] * O[db][i];
            ss += __shfl_xor(ss, 32);
            const float sc = rsqrtf(ss * (1.f / 128.f) + NORM_EPS) * (1.f - 0.35550906759096924f);
            const float* sg = P.in[I_SUBG];
            bf16_t* op = MIX + (size_t)(tok0 + q) * DM + 1024 + h * 128 + 4 * hh;
#pragma unroll
            for (int db = 0; db < 4; ++db)
#pragma unroll
                for (int g = 0; g < 4; ++g) { const f32x4 g4 = *(const f32x4*)(sg + db * 32 + 8 * g + 4 * hh);
                    u32x2 w; w.x = pk2(O[db][4 * g] * sc * g4.x, O[db][4 * g + 1] * sc * g4.y); w.y = pk2(O[db][4 * g + 2] * sc * g4.z, O[db][4 * g + 3] * sc * g4.w);
                    *(u32x2*)(op + db * 32 + 8 * g) = w; }
        }
    }
}

DI float diff_lambda(const Ctx& F, const Params& P) {
    const float la = wave_sum(P.in[I_LQ1][F.lane] * P.in[I_LK1][F.lane]), lb = wave_sum(P.in[I_LQ2][F.lane] * P.in[I_LK2][F.lane]);
    return __expf(la) - __expf(lb) + 0.35550906759096924f;
}
template <bool SAMPLE>
DI void attn_diff_phase(const Ctx& F, const Params& P, const float lam) {
    LAS unsigned char* lds = F.lds;
    const bf16_t* PA = (const bf16_t*)(P.ws + WS_RA);
    bf16_t* MIX = (bf16_t*)(P.ws + WS_HM);
    const bf16_t* VTp = (const bf16_t*)(P.ws + WS_VT); const bf16_t* VTs = (const bf16_t*)(P.ws + WS_VT + VT_S);
    const int q = F.lane & 31, hh = F.lane >> 5, mp = F.wave >> 2, qg = F.wave & 3;
    const float c1 = 0.125f * LOG2E;
    const int nunits = SAMPLE ? 1024 : 256;
    for (int u0 = F.bid; u0 < nunits; u0 += F.G) {
        int u = u0;
        if (SAMPLE && F.G == 256) { const int i = u0 >> 8, x = F.bid & 7, y = F.bid >> 3; u = ((2 * i + (y >> 4)) * 8 + x) * 16 + (y & 15); }
        int b, h, tok0; TileMap M;
        if (!SAMPLE) { b = u >> 3; h = u & 7; tok0 = b * 256 + qg * 64;
            M.latK = PA + (size_t)(b * 256) * 4096 + 2048 + h * 128; M.latKld = 4096; M.latV = VTp + (size_t)(b * 8 + h) * 128 * 256; M.latVld = 256; M.nlat = 4; M.ctxK = nullptr; M.ctxV = nullptr; M.ntiles = 4; }
        else { b = u >> 7; h = (u >> 4) & 7; tok0 = TP + b * 4096 + (u & 15) * 256 + qg * 64;
            M.latK = PA + (size_t)(TP + b * 4096) * 4096 + 2048 + h * 128; M.latKld = 4096; M.latV = VTs + (size_t)(b * 8 + h) * 128 * 4096; M.latVld = 4096; M.nlat = 64;
            M.ctxK = (const bf16_t*)(P.ws + WS_CDK) + (size_t)b * 256 * 1024 + h * 128; M.ctxV = (const bf16_t*)(P.ws + WS_CDVT) + (size_t)(b * 8 + h) * 128 * 256; M.ntiles = 68; }
        LAS unsigned char* qst = lds + 73728 + F.wave * 8192 + F.lane * 16;
#pragma unroll
        for (int sb = 0; sb < 2; ++sb) { const bf16_t* qptr = PA + (size_t)(tok0 + sb * 32 + q) * 4096 + 1024 + h * 128 + mp * 64;
#pragma unroll
            for (int ks = 0; ks < 4; ++ks) { const u32x4 w = *(const u32x4*)(qptr + ks * 16 + hh * 8);
                const u32x4 ws = (u32x4){pk2(bflo(w.x) * c1, bfhi(w.x) * c1), pk2(bflo(w.y) * c1, bfhi(w.y) * c1), pk2(bflo(w.z) * c1, bfhi(w.z) * c1), pk2(bflo(w.w) * c1, bfhi(w.w) * c1)};
                *(LAS u32x4*)(qst + (sb * 4 + ks) * 1024) = ws; } }
        f32x16 O[2][4]; float ls[2] = {0.f, 0.f};
#pragma unroll
        for (int sb = 0; sb < 2; ++sb)
#pragma unroll
            for (int db = 0; db < 4; ++db)
#pragma unroll
                for (int i = 0; i < 16; ++i) O[sb][db][i] = 0.f;
        const int nt = M.ntiles;
        TileRegs R;
        { const bf16_t* kp; const bf16_t* vp; int kld, vld; tile_src(M, 0, kp, kld, vp, vld); tile_load(F, R, kp, kld, vp, vld); }
        tile_store(F, R, lds + AT_K0, lds + AT_V0);
        __syncthreads();
#pragma unroll 1
        for (int j = 0; j < nt; ++j) {
            const int cur = j & 1;
            if (j + 1 < nt) { const bf16_t* kp; const bf16_t* vp; int kld, vld; tile_src(M, j + 1, kp, kld, vp, vld); tile_load(F, R, kp, kld, vp, vld); }
            LAS const unsigned char* kt = lds + AT_K0 + cur * AT_KTB; LAS const unsigned char* vt = lds + AT_V0 + cur * AT_VTB;
#pragma unroll 1
            for (int kb = 0; kb < 2; ++kb) {
                f32x16 S0, S1;
#pragma unroll
                for (int i = 0; i < 16; ++i) { S0[i] = 0.f; S1[i] = 0.f; }
#pragma unroll
                for (int ks = 0; ks < 4; ++ks) { const bf16x8 A = *(const LAS bf16x8*)(kt + (kb * 32 + q) * AT_KROW + ((mp * 4 + ks) * 16 + hh * 8) * 2);
                    S0 = __builtin_amdgcn_mfma_f32_32x32x16_bf16(A, *(const LAS bf16x8*)(qst + ks * 1024), S0, 0, 0, 0);
                    S1 = __builtin_amdgcn_mfma_f32_32x32x16_bf16(A, *(const LAS bf16x8*)(qst + (4 + ks) * 1024), S1, 0, 0, 0); }
                u32x4 pa[2], pb[2];
                { float l0 = 0.f, l1 = 0.f;
#pragma unroll
                for (int sp = 0; sp < 2; ++sp) { float e0[8], e1[8];
#pragma unroll
                    for (int i = 0; i < 8; ++i) { e0[i] = __builtin_amdgcn_exp2f(S0[8 * sp + i]); e1[i] = __builtin_amdgcn_exp2f(S1[8 * sp + i]); l0 += e0[i]; l1 += e1[i]; }
                    pa[sp] = (u32x4){pk2(e0[0], e0[1]), pk2(e0[2], e0[3]), pk2(e0[4], e0[5]), pk2(e0[6], e0[7])};
                    pb[sp] = (u32x4){pk2(e1[0], e1[1]), pk2(e1[2], e1[3]), pk2(e1[4], e1[5]), pk2(e1[6], e1[7])}; }
                ls[0] += l0; ls[1] += l1; }
#pragma unroll
                for (int sp = 0; sp < 2; ++sp) {
                    const bf16x8 Pa = __builtin_bit_cast(bf16x8, pa[sp]), Pb = __builtin_bit_cast(bf16x8, pb[sp]);
#pragma unroll
                    for (int db = 0; db < 4; ++db) {
                        LAS const unsigned char* ap = vt + (db * 32 + q) * AT_VROW + (kb * 32 + 16 * sp + 4 * hh) * 2;
                        const u32x2 lo = *(const LAS u32x2*)(ap), hi = *(const LAS u32x2*)(ap + 16);
                        const bf16x8 A2 = __builtin_bit_cast(bf16x8, (u32x4){lo.x, lo.y, hi.x, hi.y});
                        O[0][db] = __builtin_amdgcn_mfma_f32_32x32x16_bf16(A2, Pa, O[0][db], 0, 0, 0);
                        O[1][db] = __builtin_amdgcn_mfma_f32_32x32x16_bf16(A2, Pb, O[1][db], 0, 0, 0);
                    }
                    asm volatile("" ::: "memory");
                }
            }
            if (j + 1 < nt) tile_store(F, R, lds + AT_K0 + (cur ^ 1) * AT_KTB, lds + AT_V0 + (cur ^ 1) * AT_VTB);
            __syncthreads();
        }
        LAS float* xch = (LAS float*)lds + qg * 8192 + F.lane;
        float lt[2];
#pragma unroll
        for (int sb = 0; sb < 2; ++sb) lt[sb] = ls[sb] + __shfl_xor(ls[sb], 32);
        if (mp == 1) {
#pragma unroll
            for (int sb = 0; sb < 2; ++sb) { const float w1 = lam / lt[sb];
#pragma unroll
                for (int db = 0; db < 4; ++db)
#pragma unroll
                    for (int i = 0; i < 16; ++i) xch[((sb * 4 + db) * 16 + i) * 64] = O[sb][db][i] * w1; } }
        __syncthreads();
        if (mp == 0) {
            const float* sg = P.in[I_SUBG];
#pragma unroll
            for (int sb = 0; sb < 2; ++sb) { const float w0 = 1.f / lt[sb]; float ss = 0.f;
#pragma unroll
                for (int db = 0; db < 4; ++db)
#pragma unroll
                    for (int i = 0; i < 16; ++i) { const float o = O[sb][db][i] * w0 - xch[((sb * 4 + db) * 16 + i) * 64]; O[sb][db][i] = o; ss += o * o; }
                ss += __shfl_xor(ss, 32);
                const float sc = rsqrtf(ss * (1.f / 128.f) + NORM_EPS) * (1.f - 0.35550906759096924f);
                bf16_t* op = MIX + (size_t)(tok0 + sb * 32 + q) * DM + 1024 + h * 128 + 4 * hh;
#pragma unroll
                for (int db = 0; db < 4; ++db)
#pragma unroll
                    for (int g = 0; g < 4; ++g) { const f32x4 g4 = *(const f32x4*)(sg + db * 32 + 8 * g + 4 * hh);
                        u32x2 w; w.x = pk2(O[sb][db][4 * g] * sc * g4.x, O[sb][db][4 * g + 1] * sc * g4.y); w.y = pk2(O[sb][db][4 * g + 2] * sc * g4.z, O[sb][db][4 * g + 3] * sc * g4.w);
                        *(u32x2*)(op + db * 32 + 8 * g) = w; } } }
        __syncthreads();
    }
}
template <int L, int BATCH> struct HyCfg {
    static constexpr int NB = L / 64, TPT = 32 / BATCH, NTILES = NB / TPT, LOGB = (BATCH == 8) ? 3 : 5;
    static constexpr int ZROWB = (L + 384) * 2 + 16, ZBYTES = BATCH * ZROWB, RL = 2 * L + 16;
    static constexpr int TPW = (NTILES + 7) / 8;
};
constexpr int HY_KR_OFF = 71808;

template <int L, int BATCH>
DI void hyena_part(const Ctx& F, const Params& P, int c, int tokbase  , const bf16_t* KRG  ) {
    typedef HyCfg<L, BATCH> C;
    LAS unsigned char* lds = F.lds;
    bf16_t* CM = (bf16_t*)(P.ws + WS_RB);
    const float* hbias = P.in[I_HYBIAS];
    const int q = F.lane & 31, hh = F.lane >> 5;
    __syncthreads();
    for (int id = F.tid; id < BATCH * (L / 8); id += NTHR) { const int b = id / (L / 8), s8 = (id % (L / 8)) * 8;
        *(LAS u32x4*)(lds + b * C::ZROWB + (192 + s8) * 2) = *(const u32x4*)(CM + (size_t)c * TOK + tokbase + b * L + s8); }
    for (int id = F.tid; id < BATCH * 48; id += NTHR) { const int b = id / 48, k = id % 48, e = (k < 24) ? k * 8 : (192 + L + (k - 24) * 8);
        *(LAS u32x4*)(lds + b * C::ZROWB + e * 2) = (u32x4){0u, 0u, 0u, 0u}; }
#pragma unroll 1
    for (int o = 0; o < 2; ++o) {
        { const bf16_t* src = KRG + (size_t)(o * 1024 + c) * C::RL;
          for (int id = F.tid; id < C::RL / 8; id += NTHR) { const u32x4 v = *(const u32x4*)(src + id * 8);
              *(LAS u32x4*)(lds + HY_KR_OFF + id * 16) = v;
              LAS bf16_t* c1 = (LAS bf16_t*)(lds + HY_KR_OFF + C::RL * 2) + id * 8 - 1;
              if (id > 0) c1[0] = (bf16_t)(v.x & 0xffff);
              c1[1] = (bf16_t)(v.x >> 16); c1[2] = (bf16_t)(v.y & 0xffff); c1[3] = (bf16_t)(v.y >> 16); c1[4] = (bf16_t)(v.z & 0xffff); c1[5] = (bf16_t)(v.z >> 16);
              c1[6] = (bf16_t)(v.w & 0xffff); c1[7] = (bf16_t)(v.w >> 16); } }
        __syncthreads();
        f32x16 acc[C::TPW][2];
#pragma unroll
        for (int t = 0; t < C::TPW; ++t)
#pragma unroll
            for (int mt = 0; mt < 2; ++mt)
#pragma unroll
                for (int i = 0; i < 16; ++i) acc[t][mt][i] = 0.f;
        const int tq0 = F.wave * C::TPW;
        if (tq0 < C::NTILES) {
            const int d1lo = C::TPT * tq0 - (C::NB - 1), d1hi = C::TPT * (tq0 + C::TPW - 1) + C::TPT - 1;
            const int abase = HY_KR_OFF + (F.lane & 1) * (C::RL * 2) + (L - (F.lane & 31) + 8 * hh - (F.lane & 1)) * 2;
            bf16x8 W0[6], W1[6], B0[C::TPW][4];
#define HY_LDW(Wv, d1v, i) do { LAS const unsigned* ap_ = (LAS const unsigned*)(lds + abase + (-4 * (d1v) - 2 + (i)) * 32); Wv[i] = __builtin_bit_cast(bf16x8, (u32x4){ap_[0], ap_[1], ap_[2], ap_[3]}); } while (0)
#define HY_LDB(Bv, d1v) do { _Pragma("unroll") for (int t_ = 0; t_ < C::TPW; ++t_) { const int tq_ = tq0 + t_; \
            const int t1_ = C::TPT * tq_ + (q >> C::LOGB), b_ = q & (BATCH - 1); int s1_ = t1_ - (d1v); s1_ = min(max(s1_, -3), C::NB + 2); \
            LAS const unsigned char* bp_ = lds + b_ * C::ZROWB + (192 + 64 * s1_ + 8 * hh) * 2; \
            _Pragma("unroll") for (int ks_ = 0; ks_ < 4; ++ks_) Bv[t_][ks_] = *(const LAS bf16x8*)(bp_ + ks_ * 32); } } while (0)
#define HY_MM(Wv, Bv, d1v) do { _Pragma("unroll") for (int t_ = 0; t_ < C::TPW; ++t_) { const int tq_ = tq0 + t_; \
            if ((d1v) >= C::TPT * tq_ - (C::NB - 1) && (d1v) <= C::TPT * tq_ + C::TPT - 1) { \
                _Pragma("unroll") for (int ks_ = 0; ks_ < 4; ++ks_) _Pragma("unroll") for (int mt_ = 0; mt_ < 2; ++mt_) \
                    acc[t_][mt_] = __builtin_amdgcn_mfma_f32_32x32x16_bf16(Wv[ks_ - 2 * mt_ + 2], Bv[t_][ks_], acc[t_][mt_], 0, 0, 0); } } } while (0)
#pragma unroll
            for (int i = 0; i < 6; ++i) HY_LDW(W0, d1lo, i);
            int d1 = d1lo;
#pragma unroll 1
            for (; d1 + 1 <= d1hi; d1 += 2) {
                HY_LDB(B0, d1);
#pragma unroll
                for (int i = 0; i < 4; ++i) HY_LDW(W1, d1 + 1, i);
                W1[4] = W0[0]; W1[5] = W0[1];
                HY_MM(W0, B0, d1);
                HY_LDB(B0, d1 + 1);
                if (d1 + 2 <= d1hi) {
#pragma unroll
                    for (int i = 0; i < 4; ++i) HY_LDW(W0, d1 + 2, i);
                    W0[4] = W1[0]; W0[5] = W1[1];
                }
                HY_MM(W1, B0, d1 + 1);
            }
            if (d1 <= d1hi) { HY_LDB(B0, d1); HY_MM(W0, B0, d1); }
#undef HY_LDW
#undef HY_LDB
#undef HY_MM
        }
        __syncthreads();
        if (tq0 < C::NTILES) {
            const float bo = hbias[o * 1024 + c];
            const bf16_t* gate = CM + (size_t)((1 + o) * 1024 + c) * TOK + tokbase;
            bf16_t* zout = (bf16_t*)(P.ws + WS_RA + RA_ZC) + (size_t)c * TOK + tokbase;
#pragma unroll
            for (int t = 0; t < C::TPW; ++t) { const int tq = tq0 + t, t1 = C::TPT * tq + (q >> C::LOGB), b = q & (BATCH - 1);
#pragma unroll
                for (int mt = 0; mt < 2; ++mt)
#pragma unroll
                    for (int g = 0; g < 4; ++g) { const int s = 64 * t1 + 32 * mt + 8 * g + 4 * hh;
                        LAS u32x2* zp = (LAS u32x2*)(lds + b * C::ZROWB + (192 + s) * 2);
                        const u32x2 zv = *zp, gv = *(const u32x2*)(gate + (size_t)b * L + s);
                        const float r0 = bflo(gv.x) * (acc[t][mt][4 * g] + bflo(zv.x) * bo), r1 = bfhi(gv.x) * (acc[t][mt][4 * g + 1] + bfhi(zv.x) * bo);
                        const float r2 = bflo(gv.y) * (acc[t][mt][4 * g + 2] + bflo(zv.y) * bo), r3 = bfhi(gv.y) * (acc[t][mt][4 * g + 3] + bfhi(zv.y) * bo);
                        const u32x2 w = (u32x2){pk2(r0, r1), pk2(r2, r3)};
                        if (o == 0) *zp = w; else *(u32x2*)(zout + (size_t)b * L + s) = w; } }
        }
        __syncthreads();
    }
}

DI void hyena_phase(const Ctx& F, const Params& P) {
    for (int c = F.bid; c < 1024; c += F.G) {
        hyena_part<LS, 8>(F, P, c, TP, (const bf16_t*)(P.ws + WS_KRS));
        hyena_part<LP, 32>(F, P, c, 0, (const bf16_t*)(P.ws + WS_KRP));
    }
}

DI void hyena_post(const Ctx& F, const Params& P) {
    const bf16_t* CM = (const bf16_t*)(P.ws + WS_RA + RA_ZC); bf16_t* MIX = (bf16_t*)(P.ws + WS_HM);
    for (int t = F.bid; t < 16 * 640; t += F.G) { const int cg = t & 15, tg = t >> 4;
        tr_tile_bf16(F, CM + (size_t)(cg * 64) * TOK + tg * 64, TOK, MIX + (size_t)(tg * 64) * DM + 1024 + cg * 64, DM, (LAS bf16_t*)F.lds); }
}
constexpr int PC_ROPE = 118784;
DI void prep_c(const Ctx& F, const Params& P) {
    bf16_t* PA = (bf16_t*)(P.ws + WS_RA);
    LAS float* rope = (LAS float*)(F.lds + PC_ROPE);
    __syncthreads();
    for (int e = F.tid; e < 1024; e += NTHR) { const int pos = e >> 4, f = e & 15; const float inv = exp2f(-(float)f * (13.287712379549449f / 16.f)); const float a = (float)pos * inv;
        rope[e * 2] = cosf(a); rope[e * 2 + 1] = sinf(a); }
    __syncthreads();
    bf16_t* VTp = (bf16_t*)(P.ws + WS_VT); bf16_t* VTs = (bf16_t*)(P.ws + WS_VT + VT_S);
    for (int t = F.bid; t < 2048 + 8192; t += F.G) {
        if (t < 2048) { const int bh = t >> 3, sub = t & 7, tk = sub >> 1, dd = sub & 1, b = bh >> 3, h = bh & 7;
            tr_tile_bf16(F, PA + ((size_t)(b * 256 + tk * 64)) * 4096 + 3072 + h * 128 + dd * 64, 4096, VTp + ((size_t)bh * 128 + dd * 64) * 256 + tk * 64, 256, (LAS bf16_t*)F.lds); }
        else { const int u = t - 2048, bh = u >> 7, sub = u & 127, tk = sub >> 1, dd = sub & 1, b = bh >> 3, h = bh & 7;
            tr_tile_bf16(F, PA + ((size_t)(TP + b * 4096 + tk * 64)) * 4096 + 3072 + h * 128 + dd * 64, 4096, VTs + ((size_t)bh * 128 + dd * 64) * 4096 + tk * 64, 4096, (LAS bf16_t*)F.lds); }
    }
    { float* o = P.out + O_DV;
      for (int e = F.bid * NTHR + F.tid; e < TP * 128; e += F.G * NTHR) { const int T = e >> 7, c8 = (e & 127) * 8;
          const u32x4 v = *(const u32x4*)(PA + (size_t)T * 4096 + 3072 + c8);
          *(f32x4*)(o + (size_t)T * 1024 + c8) = (f32x4){bflo(v.x), bfhi(v.x), bflo(v.y), bfhi(v.y)};
          *(f32x4*)(o + (size_t)T * 1024 + c8 + 4) = (f32x4){bflo(v.z), bfhi(v.z), bflo(v.w), bfhi(v.w)}; } }
}
DI void prep_c_tokens(const Ctx& F, const Params& P, int wv, int nw) {
    bf16_t* PA = (bf16_t*)(P.ws + WS_RA);
    const LAS float* rope = (const LAS float*)(F.lds + PC_ROPE);
    const float* gsrc = (F.lane < 32 ? P.in[I_DQG] : P.in[I_DKG]) + (F.lane & 1) * 32; float* ok = P.out + O_DK;
    float g[32];
#pragma unroll
    for (int i = 0; i < 32; ++i) g[i] = gsrc[i];
    for (int T = wv; T < TOK; T += nw) {
        bf16_t* rp = PA + (size_t)T * 4096 + 1024 + F.lane * 32;
        u32x4 v[4]; float x[32]; float ss = 0.f;
#pragma unroll
        for (int j = 0; j < 4; ++j) { v[j] = *(const u32x4*)(rp + j * 8);
            x[j * 8 + 0] = bflo(v[j].x); x[j * 8 + 1] = bfhi(v[j].x); x[j * 8 + 2] = bflo(v[j].y); x[j * 8 + 3] = bfhi(v[j].y);
            x[j * 8 + 4] = bflo(v[j].z); x[j * 8 + 5] = bfhi(v[j].z); x[j * 8 + 6] = bflo(v[j].w); x[j * 8 + 7] = bfhi(v[j].w); }
#pragma unroll
        for (int i = 0; i < 32; ++i) ss += x[i] * x[i];
        ss += dpp_xor1(ss);
        const float rstd = rsqrtf(ss * (1.f / 64.f) + NORM_EPS);
#pragma unroll
        for (int i = 0; i < 32; ++i) x[i] = x[i] * rstd * g[i];
        if (T < TP) { if (F.lane >= 32) { float* o = ok + (size_t)T * 1024 + (F.lane - 32) * 32;
#pragma unroll
                for (int j = 0; j < 8; ++j) *(f32x4*)(o + j * 4) = (f32x4){x[j * 4], x[j * 4 + 1], x[j * 4 + 2], x[j * 4 + 3]}; } }
        else { const int t = (T - TP) & 4095, pos = (F.lane & 1) ? (t & 63) : (t >> 6);
            const LAS float* rt = rope + pos * 32;
#pragma unroll
            for (int f = 0; f < 16; ++f) { const float cs = rt[2 * f], sn = rt[2 * f + 1], a = x[f], b = x[16 + f]; x[f] = a * cs - b * sn; x[16 + f] = b * cs + a * sn; } }
#pragma unroll
        for (int j = 0; j < 4; ++j) { u32x4 w; w.x = pk2(x[j * 8 + 0], x[j * 8 + 1]); w.y = pk2(x[j * 8 + 2], x[j * 8 + 3]); w.z = pk2(x[j * 8 + 4], x[j * 8 + 5]); w.w = pk2(x[j * 8 + 6], x[j * 8 + 7]);
            *(u32x4*)(rp + j * 8) = w; }
    }
}

constexpr int S5_BROW = 80, S5_BUB = 128 * S5_BROW, S5_HROW = 272, S5_WLDS = S5_BUB + 16 * S5_HROW;
DI void s5_chain(const Ctx& F, const Params& P, int dg, int tok0, int L, const float* h0re, const float* h0im, float* fre, float* fim, bf16_t* Yout) {
    LAS unsigned char* wl = F.lds + F.wave * S5_WLDS; LAS unsigned char* hl = wl + S5_BUB;
    const int g = dg & 63, dir = dg >> 6, lane = F.lane, st = lane & 15, gq = lane >> 4;
    const float* S5A = (const float*)(P.ws + WS_S5A); const bf16_t* BB = (const bf16_t*)(P.ws + WS_S5BB); const bf16_t* CC = (const bf16_t*)(P.ws + WS_S5CC);
    const bf16_t* PA = (const bf16_t*)(P.ws + WS_RA);
    const float ar = S5A[(dg * 64 + lane) * 2], ai = S5A[(dg * 64 + lane) * 2 + 1];
    float hr = h0re ? h0re[lane] : 0.f, hi = h0im ? h0im[lane] : 0.f;
    const bf16x8 zero8 = (bf16x8){0, 0, 0, 0, 0, 0, 0, 0};
    bf16x8 BBf[8], CCf[4];
#pragma unroll
    for (int mt = 0; mt < 8; ++mt) BBf[mt] = (gq < 2) ? *(const bf16x8*)(BB + ((size_t)dg * 128 + mt * 16 + st) * 16 + gq * 8) : zero8;
#pragma unroll
    for (int kk = 0; kk < 4; ++kk) CCf[kk] = *(const bf16x8*)(CC + ((size_t)dg * 16 + st) * 128 + kk * 32 + gq * 8);
    const int nch = L / 16;
    const int sgn = dir ? -1 : 1, tstart = dir ? tok0 + L - 1 : tok0;
    const bf16_t* ubase = PA + (size_t)tstart * 4096 + g * 16 + gq * 8;
    const long ustep = (long)sgn * 4096;
#define S5_LDU(c_) (((c_) < nch && gq < 2) ? *(const bf16x8*)(ubase + ustep * ((c_) * 16 + st)) : zero8)
#define S5_BU(Uv) do { _Pragma("unroll") for (int mt = 0; mt < 8; ++mt) { f32x4 d_ = (f32x4){0.f, 0.f, 0.f, 0.f}; \
        d_ = __builtin_amdgcn_mfma_f32_16x16x32_bf16(Uv, BBf[mt], d_, 0, 0, 0); *(LAS f32x4*)(wl + (mt * 16 + st) * S5_BROW + gq * 16) = d_; } } while (0)
#define S5_Y(c_) do { f32x4 y_ = (f32x4){0.f, 0.f, 0.f, 0.f}; \
        _Pragma("unroll") for (int kk = 0; kk < 4; ++kk) y_ = __builtin_amdgcn_mfma_f32_16x16x32_bf16(CCf[kk], Bh[kk], y_, 0, 0, 0);        \
        *(u32x2*)(Yout + (size_t)(tstart + sgn * ((c_) * 16 + st)) * 1024 + g * 16 + gq * 4) = (u32x2){pk2(y_[0], y_[1]), pk2(y_[2], y_[3])}; } while (0)
#define S5_ITER(DOY) do { \
        f32x4 br_[4], bi_[4]; \
        _Pragma("unroll") for (int j = 0; j < 4; ++j) { br_[j] = *(const LAS f32x4*)(wl + lane * S5_BROW + j * 16); bi_[j] = *(const LAS f32x4*)(wl + (64 + lane) * S5_BROW + j * 16); } \
        bf16x8 Bh[4]; \
        if (DOY) { _Pragma("unroll") for (int kk = 0; kk < 4; ++kk) Bh[kk] = *(const LAS bf16x8*)(hl + st * S5_HROW + (kk * 32 + gq * 8) * 2); } \
        const bf16x8 Un_ = S5_LDU(ch + 4); \
        S5_BU(Ua); \
        _Pragma("unroll") for (int s = 0; s < 16; ++s) { const float bur = br_[s >> 2][s & 3], bui = bi_[s >> 2][s & 3]; \
            float t0_ = __builtin_fmaf(-ai, hi, bur), t1_ = __builtin_fmaf(ai, hr, bui); \
            asm volatile("" : "+v"(t0_), "+v"(t1_));                       \
            const float nr = __builtin_fmaf(ar, hr, t0_), ni = __builtin_fmaf(ar, hi, t1_); hr = nr; hi = ni; \
            asm volatile("" : "+v"(hr), "+v"(hi)); \
            const unsigned hw_ = pk2(hr, hi); \
            *(LAS bf16_t*)(hl + s * S5_HROW + lane * 2) = (bf16_t)(hw_ & 0xffffu); *(LAS bf16_t*)(hl + s * S5_HROW + (64 + lane) * 2) = (bf16_t)(hw_ >> 16); } \
        if (DOY) S5_Y(ch - 1); \
        Ua = Ub; Ub = Uc; Uc = Un_; } while (0)
    bf16x8 Ua = S5_LDU(0), Ub = S5_LDU(1), Uc = S5_LDU(2);
    S5_BU(Ua);
    Ua = Ub; Ub = Uc; Uc = S5_LDU(3);
    int ch = 0;
    S5_ITER(false);
#pragma unroll 1
    for (ch = 1; ch < nch; ++ch) S5_ITER(true);
    { bf16x8 Bh[4];
#pragma unroll
      for (int kk = 0; kk < 4; ++kk) Bh[kk] = *(const LAS bf16x8*)(hl + st * S5_HROW + (kk * 32 + gq * 8) * 2);
      S5_Y(nch - 1); }
#undef S5_LDU
#undef S5_BU
#undef S5_Y
#undef S5_ITER
    if (fre) { fre[lane] = hr; fim[lane] = hi; }
}

DI void s5_phase(const Ctx& F, const Params& P) {
    bf16_t* YF = (bf16_t*)(P.ws + WS_RB + RB_YF); bf16_t* YB = (bf16_t*)(P.ws + WS_RB + RB_YB);
    for (int cs = F.bid; cs < 256; cs += F.G) {
        if (F.wave < 4) { const int sc = cs * 4 + F.wave, dg = sc & 127, b = sc >> 7;
            s5_chain(F, P, dg, TP + b * 4096, LS, P.in[I_S5RE] + (size_t)sc * 64, P.in[I_S5IM] + (size_t)sc * 64, nullptr, nullptr, (dg >> 6) ? YB : YF); }
        else { for (int k = 0; k < 4; ++k) { const int pc = (cs * 4 + (F.wave - 4)) * 4 + k, dg = pc & 127, b = pc >> 7;
            s5_chain(F, P, dg, b * 256, LP, nullptr, nullptr, P.out + O_SR + (size_t)pc * 64, P.out + O_SI + (size_t)pc * 64, (dg >> 6) ? YB : YF); } }
    }
    if (F.wave >= 4) prep_c_tokens(F, P, F.bid * 4 + (F.wave - 4), F.G * 4);
}

DI void s5_combine(const Ctx& F, const Params& P) {
    const bf16_t* PA = (const bf16_t*)(P.ws + WS_RA); const bf16_t* YF = (const bf16_t*)(P.ws + WS_RB + RB_YF); const bf16_t* YB = (const bf16_t*)(P.ws + WS_RB + RB_YB);
    bf16_t* Y = (bf16_t*)(P.ws + WS_RB + RB_Y); const float* dsk = P.in[I_S5D];
    for (size_t e = (size_t)F.bid * NTHR + F.tid; e < (size_t)TOK * 128; e += (size_t)F.G * NTHR) { const size_t T = e >> 7; const int c8 = (int)(e & 127) * 8;
        const u32x4 uv = *(const u32x4*)(PA + T * 4096 + c8), fv = *(const u32x4*)(YF + T * 1024 + c8), bv = *(const u32x4*)(YB + T * 1024 + c8);
        const f32x4 d0 = *(const f32x4*)(dsk + c8), d1 = *(const f32x4*)(dsk + c8 + 4);
        float o[8];
        o[0] = gelu_tanh(d0.x * bflo(uv.x) + bflo(fv.x) + bflo(bv.x)); o[1] = gelu_tanh(d0.y * bfhi(uv.x) + bfhi(fv.x) + bfhi(bv.x));
        o[2] = gelu_tanh(d0.z * bflo(uv.y) + bflo(fv.y) + bflo(bv.y)); o[3] = gelu_tanh(d0.w * bfhi(uv.y) + bfhi(fv.y) + bfhi(bv.y));
        o[4] = gelu_tanh(d1.x * bflo(uv.z) + bflo(fv.z) + bflo(bv.z)); o[5] = gelu_tanh(d1.y * bfhi(uv.z) + bfhi(fv.z) + bfhi(bv.z));
        o[6] = gelu_tanh(d1.z * bflo(uv.w) + bflo(fv.w) + bflo(bv.w)); o[7] = gelu_tanh(d1.w * bfhi(uv.w) + bfhi(fv.w) + bfhi(bv.w));
        u32x4 w; w.x = pk2(o[0], o[1]); w.y = pk2(o[2], o[3]); w.z = pk2(o[4], o[5]); w.w = pk2(o[6], o[7]);
        *(u32x4*)(Y + T * 1024 + c8) = w; }
}
constexpr int PS_KROW = 272;
constexpr int PS_IDX_OFF = 2 * 128 * PS_KROW;
constexpr int PS_TAB_OFF = PS_IDX_OFF + 512 * 32;

DI void topk_insert(float (&a)[16], float x) {
#pragma unroll
    for (int j = 15; j >= 1; --j) a[j] = __builtin_amdgcn_fmed3f(a[j - 1], a[j], x);
    a[0] = fmaxf(a[0], x);
}

DI void peer_select(const Ctx& F, const Params& P, int layer) {
    LAS unsigned char* lds = F.lds;
    const bf16_t* Q = (const bf16_t*)(P.ws + WS_RA + RA_Q);
    int* SELI = (int*)(P.ws + WS_RA + RA_SELI); float* SELW = (float*)(P.ws + WS_RA + RA_SELW);
    const bf16_t* KEYS = (const bf16_t*)(P.ws + WS_PKEYS) + (size_t)layer * 8 * 2 * 128 * 128;
    const int q = F.lane & 31, hh = F.lane >> 5;
    LAS unsigned char* myidx = lds + PS_IDX_OFF + F.tid * 32;
    LAS unsigned char* tab = lds + PS_TAB_OFF;
    for (int wu = F.bid; wu < 256; wu += F.G) {
        const int h = wu & 7, chunk = wu >> 3;
        __syncthreads();
        for (int id = F.tid; id < 2 * 128 * 16; id += NTHR) { const int row = id >> 4, c16 = id & 15;
            *(LAS u32x4*)(lds + row * PS_KROW + c16 * 16) = *(const u32x4*)(KEYS + ((size_t)h * 256 + row) * 128 + c16 * 8); }
        if (F.tid < 16) { int cnt = 0;
            for (int a = 0; a < F.tid; ++a) cnt += 16 / (a + 1);
            for (int b = 0; b < 16 / (F.tid + 1); ++b) { tab[(cnt + b) * 2] = (unsigned char)F.tid; tab[(cnt + b) * 2 + 1] = (unsigned char)b; } }
        __syncthreads();
        for (int blk = F.wave; blk < 40; blk += 8) {
            const int T0 = chunk * 1280 + blk * 32;
            float lst[2][16];
#pragma unroll
            for (int side = 0; side < 2; ++side) {
                bf16x8 Qf[8];
                const bf16_t* qp = Q + (size_t)(T0 + q) * 2048 + h * 256 + side * 128 + hh * 8;
#pragma unroll
                for (int ks = 0; ks < 8; ++ks) Qf[ks] = *(const bf16x8*)(qp + ks * 16);
                float a[16];
#pragma unroll
                for (int j = 0; j < 16; ++j) a[j] = -3.0e38f;
#pragma unroll
                for (int nt = 0; nt < 4; ++nt) {
                    f32x16 S;
#pragma unroll
                    for (int i = 0; i < 16; ++i) S[i] = 0.f;
#pragma unroll
                    for (int ks = 0; ks < 8; ++ks) { const bf16x8 A = *(const LAS bf16x8*)(lds + (side * 128 + nt * 32 + q) * PS_KROW + (ks * 16 + hh * 8) * 2);
                        S = __builtin_amdgcn_mfma_f32_32x32x16_bf16(A, Qf[ks], S, 0, 0, 0); }
#pragma unroll
                    for (int i = 0; i < 16; ++i) { const int n = nt * 32 + (i & 3) + 8 * (i >> 2) + 4 * hh;
                        topk_insert(a, __uint_as_float((__float_as_uint(S[i]) & 0xffffff80u) | (unsigned)n)); }
                }
                float pb[16];
#pragma unroll
                for (int j = 0; j < 16; ++j) pb[j] = __shfl_xor(a[j], 32);
#pragma unroll
                for (int j = 0; j < 16; ++j) topk_insert(a, pb[j]);
#pragma unroll
                for (int j = 0; j < 16; ++j) { lst[side][j] = a[j]; myidx[side * 16 + j] = (unsigned char)(__float_as_uint(a[j]) & 0x7fu); }
            }
            float cb[16];
#pragma unroll
            for (int j = 0; j < 16; ++j) cb[j] = -3.0e38f;
            { int cid = 0;
#pragma unroll
              for (int a = 0; a < 16; ++a)
#pragma unroll
                  for (int b = 0; b < 16 / (a + 1); ++b) {
                      const float sa = __uint_as_float(__float_as_uint(lst[0][a]) & 0xffffff80u), sb = __uint_as_float(__float_as_uint(lst[1][b]) & 0xffffff80u);
                      topk_insert(cb, __uint_as_float((__float_as_uint(sa + sb) & 0xffffffc0u) | (unsigned)cid)); ++cid; } }
            const float mx = __uint_as_float(__float_as_uint(cb[0]) & 0xffffffc0u);
            float e[16], den = 0.f;
#pragma unroll
            for (int j = 0; j < 16; ++j) { e[j] = __expf(__uint_as_float(__float_as_uint(cb[j]) & 0xffffffc0u) - mx); den += e[j]; }
            const float rden = 1.f / den;
#pragma unroll
            for (int j = 0; j < 16; ++j) {
                if ((j >> 3) == hh) { const int cid = (int)(__float_as_uint(cb[j]) & 0x3fu);
                    const int a = tab[cid * 2], b = tab[cid * 2 + 1];
                    const int eidx = (int)myidx[a] * 128 + (int)myidx[16 + b];
                    SELI[(size_t)(T0 + q) * 128 + h * 16 + j] = eidx; SELW[(size_t)(T0 + q) * 128 + h * 16 + j] = e[j] * rden; }
            }
        }
    }
    __syncthreads();
}

DI u32x16 fp6_unpack_bf16(u32x4 a, u32x2 b) { const u32x6 pk = {a.x, a.y, a.z, a.w, b.x, b.y}; return __builtin_bit_cast(u32x16, __builtin_amdgcn_cvt_scalef32_pk32_bf16_fp6(pk, 1.0f)); }
DI f32x32 fp6_unpack(u32x4 a, u32x2 b) { const u32x6 pk = {a.x, a.y, a.z, a.w, b.x, b.y}; return __builtin_amdgcn_cvt_scalef32_pk32_f32_fp6(pk, 1.0f); }
constexpr int GN = 4;
template <bool NEXTNORM>
DI void peer_gather(const Ctx& F, const Params& P, const float* modl, int layer, const float* ngain, const float* nmodl) {
    const bf16_t* H2 = (const bf16_t*)(P.ws + WS_HM);
    const unsigned char* TU = P.ws + WS_TBLU + (size_t)layer * 16384 * PT_ROWB; const unsigned char* TV = P.ws + WS_TBLV + (size_t)layer * 16384 * PT_ROWB;
    const float* SCU = (const float*)(P.ws + WS_SC) + layer * 16384; const float* SCV = (const float*)(P.ws + WS_SC) + (2 + layer) * 16384;
    const int* SELI = (const int*)(P.ws + WS_RA + RA_SELI); const float* SELW = (const float*)(P.ws + WS_RA + RA_SELW);
    float* X = P.out + O_Y;
    const int lane = lane_id();
    const int stride = F.G * 8;
    for (int T0 = F.bid * 8 + F.wave; T0 < TOK; T0 += 2 * stride) {
        const bool two = (T0 + stride < TOK);
        const int Tt[2] = {T0, two ? T0 + stride : T0};
        u32x4 xw[2][4]; int e0[2], e1[2]; float g0[2], g1[2], d0[2], d1[2];
#pragma unroll
        for (int t = 0; t < 2; ++t) {
#pragma unroll
            for (int q4 = 0; q4 < 4; ++q4) xw[t][q4] = *(const u32x4*)(H2 + (size_t)Tt[t] * DM + lane * 32 + q4 * 8);
            e0[t] = SELI[(size_t)Tt[t] * 128 + lane]; e1[t] = SELI[(size_t)Tt[t] * 128 + 64 + lane];
            g0[t] = SELW[(size_t)Tt[t] * 128 + lane]; g1[t] = SELW[(size_t)Tt[t] * 128 + 64 + lane]; d0[t] = 0.f; d1[t] = 0.f; }
#pragma unroll 1
        for (int kb = 0; kb < 128; kb += GN) {
            u32x4 ura[2][GN]; u32x2 urb[2][GN];
#pragma unroll
            for (int j = 0; j < GN; ++j)
#pragma unroll
                for (int t = 0; t < 2; ++t) { const int k = kb + j; const int e = __builtin_amdgcn_readlane(k < 64 ? e0[t] : e1[t], k & 63);
                    const unsigned char* up = TU + (size_t)e * PT_ROWB;
                    ura[t][j] = *(const u32x4*)(up + lane * 16); urb[t][j] = *(const u32x2*)(up + 1024 + lane * 8); }
#pragma unroll
            for (int j = 0; j < GN; ++j) { float pt[2];
#pragma unroll
                for (int t = 0; t < 2; ++t) { const u32x16 r = fp6_unpack_bf16(ura[t][j], urb[t][j]);
                    float sa = 0.f, sb = 0.f, sc2 = 0.f, sd = 0.f;
#pragma unroll
                    for (int i = 0; i < 4; ++i) { const unsigned x0 = xw[t][i].x, x1 = xw[t][i].y, x2 = xw[t][i].z, x3 = xw[t][i].w;
                        sa = dot2bf(r[4 * i], x0, sa); sb = dot2bf(r[4 * i + 1], x1, sb); sc2 = dot2bf(r[4 * i + 2], x2, sc2); sd = dot2bf(r[4 * i + 3], x3, sd); }
                    pt[t] = (sa + sb) + (sc2 + sd); }
                const float sm0 = wave_sum(pt[0]), sm1 = wave_sum(pt[1]); const int k = kb + j;
                if (k < 64) { if (lane == k) { d0[0] = sm0; d0[1] = sm1; } } else { if (lane == k - 64) { d1[0] = sm0; d1[1] = sm1; } } }
        }
        float cf0[2], cf1[2];
#pragma unroll
        for (int t = 0; t < 2; ++t) { cf0[t] = g0[t] * gelu_tanh(d0[t] * SCU[e0[t]]) * SCV[e0[t]]; cf1[t] = g1[t] * gelu_tanh(d1[t] * SCU[e1[t]]) * SCV[e1[t]]; }
        f32x2 acc[2][16];
#pragma unroll
        for (int t = 0; t < 2; ++t)
#pragma unroll
            for (int i = 0; i < 16; ++i) acc[t][i] = (f32x2){0.f, 0.f};
#pragma unroll 1
        for (int kb = 0; kb < 128; kb += GN) {
            u32x4 vra[2][GN]; u32x2 vrb[2][GN]; float cf[2][GN];
#pragma unroll
            for (int j = 0; j < GN; ++j)
#pragma unroll
                for (int t = 0; t < 2; ++t) { const int k = kb + j; const int e = __builtin_amdgcn_readlane(k < 64 ? e0[t] : e1[t], k & 63);
                    cf[t][j] = __builtin_bit_cast(float, __builtin_amdgcn_readlane(__builtin_bit_cast(int, k < 64 ? cf0[t] : cf1[t]), k & 63));
                    const unsigned char* vp = TV + (size_t)e * PT_ROWB;
                    vra[t][j] = *(const u32x4*)(vp + lane * 16); vrb[t][j] = *(const u32x2*)(vp + 1024 + lane * 8); }
#pragma unroll
            for (int j = 0; j < GN; ++j)
#pragma unroll
                for (int t = 0; t < 2; ++t) { const f32x32 r = fp6_unpack(vra[t][j], vrb[t][j]);
                    const f32x2 c2 = (f32x2){cf[t][j], cf[t][j]};
#pragma unroll
                    for (int i = 0; i < 16; ++i) acc[t][i] += c2 * (f32x2){r[2 * i], r[2 * i + 1]}; }
        }
#pragma unroll
        for (int t = 0; t < 2; ++t) {
            if (t == 1 && !two) break;
            const int T = Tt[t];
            const float* gate = modl + (size_t)(cond_of(T) * 6 + 5) * DM;
            f32x4 xn[8]; float ss = 0.f;
#pragma unroll
            for (int q4 = 0; q4 < 8; ++q4) { const int col = lane * 32 + q4 * 4; float* xp = X + (size_t)T * DM + col;
                const f32x4 gv = *(const f32x4*)(gate + col), x0 = *(const f32x4*)(xp);
                const f32x4 r = x0 + gv * (f32x4){acc[t][q4 * 2].x, acc[t][q4 * 2].y, acc[t][q4 * 2 + 1].x, acc[t][q4 * 2 + 1].y};
                *(f32x4*)(xp) = r; xn[q4] = r; ss += r.x * r.x + r.y * r.y + r.z * r.z + r.w * r.w; }
            if (NEXTNORM) {
                ss = wave_sum(ss);
                const float rstd = rsqrtf(ss * (1.f / DM) + NORM_EPS);
                const float* sh = nmodl + (size_t)(cond_of(T) * 6 + 0) * DM; const float* sc = sh + DM;
                bf16_t* H = (bf16_t*)(P.ws + WS_HM);
#pragma unroll
                for (int q4 = 0; q4 < 8; ++q4) { const int col = lane * 32 + q4 * 4;
                    const f32x4 g4 = *(const f32x4*)(ngain + col), s4 = *(const f32x4*)(sc + col), h4 = *(const f32x4*)(sh + col);
                    const f32x4 o = xn[q4] * rstd * g4 * (s4 + 1.f) + h4;
                    *(u32x2*)(H + (size_t)T * DM + col) = (u32x2){pk2(o.x, o.y), pk2(o.z, o.w)}; }
            }
        }
    }
}
constexpr int NPHASE = 22;

__global__ void __launch_bounds__(NTHR, 2) mega(Params P) {
    extern __shared__ __attribute__((aligned(16))) unsigned char lds_raw[];
    Ctx F;
    F.lds = (LAS unsigned char*)lds_raw; F.tid = threadIdx.x; F.lane = F.tid & 63; F.wave = __builtin_amdgcn_readfirstlane(F.tid >> 6); F.G = gridDim.x; F.bid = blockIdx.x;
    const int lo = P.ph_lo, hi = P.ph_hi;
    volatile LAS unsigned* xbw = (volatile LAS unsigned*)(F.lds + LDS_BYTES - 16);
    if (F.tid == 0) { xbw[0] = 0u; xbw[1] = 0u; xbw[2] = 0u; xbw[3] = 0u; }
    __syncthreads();
    if (hi - lo > 1) (void)xcd_barrier_post((unsigned*)(P.ws + WS_CTL), xbw);
#define GRID_BARRIER() do { XcdBarrier bar_; bar_.bar = (unsigned*)(P.ws + WS_CTL); bar_.x = xb_xcc_id(); bar_.st = (volatile LAS unsigned*)(F.lds + LDS_BYTES - 16); xcd_barrier(bar_); } while (0)
#define PH(k, ...) if (lo <= (k) && (k) < hi) { { __VA_ARGS__ } if ((k) + 1 < hi) GRID_BARRIER(); }
#define MOD0 ((const float*)(P.ws + WS_MOD))
#define MOD1 ((const float*)(P.ws + WS_MOD) + 9 * 12288)
#define HM ((bf16_t*)(P.ws + WS_HM))
#define RA ((bf16_t*)(P.ws + WS_RA))
#define X (P.out + O_Y)

    PH(0, prologue(F, P);)
    PH(1, adaln_reduce(F, P);)
    PH(2, norm_phase(F, P.in[I_XP], P.in[I_XS], P.in[I_NMIXG], MOD0, 0, HM);)
    PH(3, { EpiBf16 E{RA, 4096}; run_gemm(F, HM, (const bf16_t*)(P.ws + WS_WEVIN) + (size_t)2048 * 2048, 4096, 2048, E); })
    PH(4, prep_a(F, P);)
    PH(5, { EpiBf16 E{RA, 2048}; run_gemm(F, HM, (const bf16_t*)(P.ws + WS_WEVIN), 2048, 2048, E); })
    PH(6, attn_phase<0>(F, P); attn_phase<1>(F, P); hyena_phase(F, P);)
    PH(7, hyena_post(F, P);)
    PH(8, { EpiResid E{P.in[I_XP], P.in[I_XS], X, MOD0, 2}; run_gemm(F, HM, (const bf16_t*)(P.ws + WS_WEVOUT), 2048, 2048, E); })
    PH(9, norm_phase(F, X, X + (size_t)TP * DM, P.in[I_NFFNG], MOD0, 3, HM);)
    PH(10, { EpiBf16 E{RA, 2048}; run_gemm(F, HM, (const bf16_t*)(P.ws + WS_WPQ), 2048, 2048, E); })
    PH(11, peer_select(F, P, 0);)
    PH(12, peer_gather<true>(F, P, MOD0, 0, P.in[I_NMIXG] + DM, MOD1);)
    PH(13, { EpiBf16 E{RA, 4096}; run_gemm(F, HM, (const bf16_t*)(P.ws + WS_WODIN), 4096, 2048, E); })
    PH(14, prep_c(F, P); s5_phase(F, P);)
    PH(15, { const float lam = diff_lambda(F, P); attn_diff_phase<false>(F, P, lam); attn_diff_phase<true>(F, P, lam); } s5_combine(F, P);)
    PH(16, { EpiGlu E{(const bf16_t*)(P.ws + WS_RB + RB_Y), HM, P.in[I_GLUB]}; run_gemm(F, (const bf16_t*)(P.ws + WS_RB + RB_Y), (const bf16_t*)(P.ws + WS_WGLU), 1024, 1024, E); })
    PH(17, { EpiResid E{X, X + (size_t)TP * DM, X, MOD1, 2}; run_gemm(F, HM, (const bf16_t*)(P.ws + WS_WODOUT), 2048, 2048, E); })
    PH(18, norm_phase(F, X, X + (size_t)TP * DM, P.in[I_NFFNG] + DM, MOD1, 3, HM);)
    PH(19, { EpiBf16 E{RA, 2048}; run_gemm(F, HM, (const bf16_t*)(P.ws + WS_WPQ) + (size_t)2048 * 2048, 2048, 2048, E); })
    PH(20, peer_select(F, P, 1);)
    PH(21, peer_gather<false>(F, P, MOD1, 1, nullptr, nullptr);)
#undef MOD0
#undef MOD1
#undef HM
#undef RA
#undef X
#undef PH
#undef GRID_BARRIER
}

extern "C" void kernel_launch(void* const* d_in, const int* in_sizes, int n_in, void* d_out, int out_size, void* d_ws, size_t ws_size, hipStream_t stream) {
    static int grid = 0;
    if (grid == 0) {
        if (n_in != N_IN || (size_t)out_size != O_END || ws_size < WS_END) { fprintf(stderr, "kernel_launch: unexpected shapes (n_in %d, out %d, ws %zu, need %zu)\n", n_in, out_size, ws_size, (size_t)WS_END); grid = -1; return; }
        int dev = 0, cus = 0;
        if (hipGetDevice(&dev) != hipSuccess || hipDeviceGetAttribute(&cus, hipDeviceAttributeMultiprocessorCount, dev) != hipSuccess) { grid = -1; return; }
        if (hipFuncSetAttribute((const void*)mega, hipFuncAttributeMaxDynamicSharedMemorySize, LDS_BYTES) != hipSuccess) { fprintf(stderr, "kernel_launch: hipFuncSetAttribute failed\n"); grid = -1; return; }
        int per_cu = 0;
        if (hipOccupancyMaxActiveBlocksPerMultiprocessor(&per_cu, (const void*)mega, NTHR, LDS_BYTES) != hipSuccess || per_cu < 1) { fprintf(stderr, "kernel_launch: occupancy query says %d blocks per CU\n", per_cu); }
        (void)hipGetLastError();
        grid = cus;
    }
    if (grid < 0) return;
    (void)hipMemsetAsync((char*)d_ws + WS_CTL, 0, 65536, stream);
    Params p; memset(&p, 0, sizeof(p));
    for (int i = 0; i < N_IN; ++i) p.in[i] = (const float*)d_in[i];
    p.out = (float*)d_out; p.ws = (unsigned char*)d_ws;
    p.ph_lo = 0; p.ph_hi = NPHASE;
    hipLaunchKernelGGL(mega, dim3(grid), dim3(NTHR), LDS_BYTES, stream, p);
}
```

```cpp
#include <hip/hip_runtime.h>
#include <cstdio>
#include <cstring>
#include <cstdint>

typedef unsigned short bf16_t;
typedef short bf16x8 __attribute__((ext_vector_type(8)));
typedef short s16x4 __attribute__((ext_vector_type(4)));
typedef float f32x2 __attribute__((ext_vector_type(2)));
typedef float f32x4 __attribute__((ext_vector_type(4)));
typedef float f32x16 __attribute__((ext_vector_type(16)));
typedef unsigned u32x2 __attribute__((ext_vector_type(2)));
typedef unsigned u32x4 __attribute__((ext_vector_type(4)));
typedef __bf16 bf16x2_t __attribute__((ext_vector_type(2)));
typedef float f32x32 __attribute__((ext_vector_type(32)));
typedef unsigned u32x6 __attribute__((ext_vector_type(6)));
typedef unsigned u32x16 __attribute__((ext_vector_type(16)));
typedef __bf16 bf16x32_t __attribute__((ext_vector_type(32)));

#define DI __device__ __forceinline__

constexpr int NTHR = 512;
constexpr int DM = 2048;
constexpr int TP = 8192;
constexpr int TS = 32768;
constexpr int TOK = TP + TS;
constexpr int LP = 256, LS = 4096;
constexpr float NORM_EPS = 1e-6f;
constexpr float LOG2E = 1.4426950408889634f;

enum { I_XP = 0, I_XS, I_C, I_CNK, I_CNV, I_CDK, I_CDV, I_S5RE, I_S5IM, I_CCTX, I_MODW, I_MODB, I_NMIXG, I_NFFNG, I_EVWIN, I_EVWOUT, I_NAQG, I_NAKG, I_RPB,
       I_HYCW, I_HYCB, I_HYW1, I_HYB1, I_HYF1, I_HYW2, I_HYB2, I_HYF2, I_HYW3, I_HYDEC, I_HYBIAS, I_ODWIN, I_ODWOUT, I_S5LRE, I_S5LIM, I_S5LDT, I_S5BRE, I_S5BIM,
       I_S5CRE, I_S5CIM, I_S5D, I_GLUW, I_GLUB, I_DQG, I_DKG, I_LQ1, I_LK1, I_LQ2, I_LK2, I_SUBG, I_PWQ, I_PKEYS, I_PU, I_PV, N_IN };

constexpr size_t O_Y = 0;
constexpr size_t O_NAK = 83886080, O_NAV = 92274688, O_DK = 100663296, O_DV = 109051904, O_SR = 117440512, O_SI = 117702656, O_END = 117964800;

constexpr size_t al256(size_t x) { return (x + 255) & ~(size_t)255; }
constexpr size_t WS_CTL = 0;
constexpr size_t WS_MODP = 65536;
constexpr size_t WS_MOD = WS_MODP + (size_t)2 * 16 * 9 * 12288 * 4;
constexpr size_t WS_WEVIN = al256(WS_MOD + (size_t)2 * 9 * 12288 * 4);
constexpr size_t WS_WEVOUT = WS_WEVIN + (size_t)6144 * 2048 * 2;
constexpr size_t WS_WODIN = WS_WEVOUT + (size_t)2048 * 2048 * 2;
constexpr size_t WS_WODOUT = WS_WODIN + (size_t)4096 * 2048 * 2;
constexpr size_t WS_WPQ = WS_WODOUT + (size_t)2048 * 2048 * 2;
constexpr size_t WS_WGLU = WS_WPQ + (size_t)2 * 2048 * 2048 * 2;
constexpr size_t WS_PKEYS = WS_WGLU + (size_t)1024 * 1024 * 2;
constexpr size_t WS_CNK = WS_PKEYS + (size_t)2 * 8 * 2 * 128 * 128 * 2;
constexpr size_t WS_CNVT = WS_CNK + (size_t)8 * 256 * 1024 * 2;
constexpr size_t WS_CDK = WS_CNVT + (size_t)8 * 256 * 1024 * 2;
constexpr size_t WS_CDVT = WS_CDK + (size_t)8 * 256 * 1024 * 2;
constexpr size_t WS_S5A = WS_CDVT + (size_t)8 * 256 * 1024 * 2;
constexpr size_t WS_S5BB = WS_S5A + (size_t)128 * 64 * 2 * 4;
constexpr size_t WS_S5CC = WS_S5BB + (size_t)128 * 128 * 16 * 2;
constexpr int KRL_S = 8208, KRL_P = 528;
constexpr size_t WS_KRS = WS_S5CC + (size_t)128 * 16 * 128 * 2;
constexpr size_t WS_KRP = al256(WS_KRS + (size_t)2 * 1024 * KRL_S * 2);
constexpr size_t WS_TBLU = al256(WS_KRP + (size_t)2 * 1024 * KRL_P * 2);
constexpr size_t WS_TBLV = WS_TBLU + (size_t)16384 * 2048 * 2;
constexpr size_t WS_HM = WS_TBLV + (size_t)16384 * 2048 * 2;
constexpr size_t WS_RA = WS_HM + (size_t)TOK * 2048 * 2;
constexpr size_t WS_RB = WS_RA + (size_t)TOK * 4096 * 2;
constexpr size_t WS_VT = WS_RB + (size_t)3072 * TOK * 2;
constexpr size_t WS_SC = WS_VT + (size_t)TOK * 1024 * 2;
constexpr size_t WS_END = WS_SC + (size_t)4 * 16384 * 4;
constexpr size_t RA_Q = 0;
constexpr size_t RA_SELI = (size_t)TOK * 2048 * 2;
constexpr size_t RA_SELW = RA_SELI + (size_t)TOK * 128 * 4;
constexpr size_t RA_CF = RA_SELW + (size_t)TOK * 128 * 4;
constexpr size_t RA_ZC = (size_t)TOK * 2048 * 2;
constexpr size_t RB_YF = 0, RB_YB = (size_t)TOK * 1024 * 2, RB_Y = (size_t)2 * TOK * 1024 * 2;
constexpr size_t VT_S = (size_t)TP * 1024 * 2;

constexpr int LDS_BYTES = 147456;

struct Params { const float* in[N_IN]; float* out; unsigned char* ws; int ph_lo, ph_hi; };

DI float bf2f(bf16_t b) { return __uint_as_float(((unsigned)b) << 16); }
DI float bflo(unsigned w) { return __uint_as_float(w << 16); }
DI float bfhi(unsigned w) { return __uint_as_float(w & 0xffff0000u); }
DI unsigned pk2(float a, float b) { f32x2 v = {a, b}; return __builtin_bit_cast(unsigned, __builtin_convertvector(v, bf16x2_t)); }
DI float dot2bf(unsigned a, unsigned b, float c) { return __builtin_amdgcn_fdot2_f32_bf16(__builtin_bit_cast(bf16x2_t, a), __builtin_bit_cast(bf16x2_t, b), c, false); }
DI bf16_t f2bf(float a) { return (bf16_t)(pk2(a, 0.f) & 0xffffu); }
DI float dpp_xor1(float v) { return __builtin_bit_cast(float, __builtin_amdgcn_update_dpp(0, __builtin_bit_cast(int, v), 0xB1, 0xF, 0xF, true)); }
DI float dpp_xor2(float v) { return __builtin_bit_cast(float, __builtin_amdgcn_update_dpp(0, __builtin_bit_cast(int, v), 0x4E, 0xF, 0xF, true)); }
DI float wave_sum(float v) {
    v += dpp_xor1(v); v += dpp_xor2(v);
    v += __builtin_bit_cast(float, __builtin_amdgcn_update_dpp(0, __builtin_bit_cast(int, v), 0x141, 0xF, 0xF, true));
    v += __builtin_bit_cast(float, __builtin_amdgcn_update_dpp(0, __builtin_bit_cast(int, v), 0x140, 0xF, 0xF, true));
    v += __builtin_bit_cast(float, __builtin_amdgcn_update_dpp(0, __builtin_bit_cast(int, v), 0x142, 0xA, 0xF, false));
    v += __builtin_bit_cast(float, __builtin_amdgcn_update_dpp(0, __builtin_bit_cast(int, v), 0x143, 0xC, 0xF, false));
    return __builtin_bit_cast(float, __builtin_amdgcn_readlane(__builtin_bit_cast(int, v), 63));
}
DI float gelu_tanh(float x) {
    const float u = 0.7978845608028654f * (x + 0.044715f * x * x * x);
    const float e = __expf(2.f * u);
    const float t = 1.f - 2.f / (e + 1.f);
    return 0.5f * x * (1.f + t);
}
DI float wave_max(float v) {
    v = fmaxf(v, dpp_xor1(v)); v = fmaxf(v, dpp_xor2(v));
    v = fmaxf(v, __builtin_bit_cast(float, __builtin_amdgcn_update_dpp(0, __builtin_bit_cast(int, v), 0x141, 0xF, 0xF, true)));
    v = fmaxf(v, __builtin_bit_cast(float, __builtin_amdgcn_update_dpp(0, __builtin_bit_cast(int, v), 0x140, 0xF, 0xF, true)));
    v = fmaxf(v, __builtin_bit_cast(float, __builtin_amdgcn_update_dpp(0, __builtin_bit_cast(int, v), 0x142, 0xA, 0xF, false)));
    v = fmaxf(v, __builtin_bit_cast(float, __builtin_amdgcn_update_dpp(0, __builtin_bit_cast(int, v), 0x143, 0xC, 0xF, false)));
    return __builtin_bit_cast(float, __builtin_amdgcn_readlane(__builtin_bit_cast(int, v), 63));
}
DI f32x2 fp8x2_lo(unsigned w) { return __builtin_amdgcn_cvt_pk_f32_fp8((int)w, false); }
DI f32x2 fp8x2_hi(unsigned w) { return __builtin_amdgcn_cvt_pk_f32_fp8((int)w, true); }
DI unsigned pk_fp8x4(float a, float b, float c, float d) { int r = 0; r = __builtin_amdgcn_cvt_pk_fp8_f32(a, b, r, false); r = __builtin_amdgcn_cvt_pk_fp8_f32(c, d, r, true); return (unsigned)r; }
DI int lane_id() { return (int)__builtin_amdgcn_mbcnt_hi(~0u, __builtin_amdgcn_mbcnt_lo(~0u, 0u)); }
DI int cond_of(int T) { return T < TP ? 0 : 1 + ((T - TP) >> 12); }
#define XB_TMO      128
#define XB_XCNT(j)  (256  + 64 * (j))
#define XB_XSUB(j)  (1280 + 64 * (j))
#define XB_XGEN(j)  (2304 + 64 * (j))
#define XB_TOP      3328
#define XB_TOPGEN   3392
#define XCD_BAR_WORDS 3456
#define XB_SPIN_CAP (1u << 26)
#define LAS __attribute__((address_space(3)))

__device__ __forceinline__ unsigned xb_ld(unsigned* p)              { return __hip_atomic_load(p, __ATOMIC_RELAXED, __HIP_MEMORY_SCOPE_AGENT); }
__device__ __forceinline__ unsigned xb_add(unsigned* p, unsigned v) { return __hip_atomic_fetch_add(p, v, __ATOMIC_RELAXED, __HIP_MEMORY_SCOPE_AGENT); }
__device__ __forceinline__ unsigned xb_xcc_id() { return (unsigned)__builtin_amdgcn_s_getreg((3 << 11) | 20) & 0xFu; }
#define XB_SPIN(cond, bar) do { unsigned _sp = 0; while (cond) { __builtin_amdgcn_s_sleep(1); \
    if ((++_sp & 255u) == 0u) { if (xb_ld(&(bar)[XB_TMO])) break; if (_sp > XB_SPIN_CAP) { atomicAdd(&(bar)[XB_TMO], 1u); break; } } } } while (0)

struct XcdBarrier {
    unsigned* bar; unsigned x;
    volatile LAS unsigned* st;
};

__device__ __forceinline__ XcdBarrier xcd_barrier_post(unsigned* bar, volatile LAS unsigned* st) {
    XcdBarrier b; b.bar = bar; b.x = xb_xcc_id(); b.st = st;
    if (threadIdx.x == 0) (void)xb_add(&bar[XB_XCNT(b.x)], 1u);
    return b;
}
__device__ __forceinline__ void xcd_barrier_complete(unsigned* bar, unsigned x, unsigned& nloc, unsigned& nx) {
    const unsigned G = gridDim.x * gridDim.y * gridDim.z;
    unsigned sum, cnt, mine, sp = 0u;
    for (;;) {
        sum = 0u; cnt = 0u; mine = 0u;
#pragma unroll
        for (unsigned j = 0; j < 16; ++j) { const unsigned c = xb_ld(&bar[XB_XCNT(j)]); sum += c; cnt += (c > 0u) ? 1u : 0u; mine = (j == x) ? c : mine; }
        if (sum == G) break;
        __builtin_amdgcn_s_sleep(1);
        if ((++sp & 255u) == 0u) { if (xb_ld(&bar[XB_TMO])) break; if (sp > XB_SPIN_CAP) { atomicAdd(&bar[XB_TMO], 1u); break; } }
    }
    nloc = mine > 0u ? mine : 1u; nx = cnt > 0u ? cnt : 1u;
}

__device__ __forceinline__ void xcd_barrier(const XcdBarrier& b) {
    asm volatile("s_waitcnt vmcnt(0)" ::: "memory");
    __syncthreads();
    if (threadIdx.x == 0) {
        unsigned* bar = b.bar;
        __builtin_amdgcn_s_waitcnt(0);
        unsigned nloc = b.st[0], nx = b.st[1];
        if (nloc == 0u) { xcd_barrier_complete(bar, b.x, nloc, nx); b.st[0] = nloc; b.st[1] = nx; }
        const unsigned old = xb_add(&bar[XB_XSUB(b.x)], 1u);
        const unsigned gen = old / nloc;
        if (old + 1u == (gen + 1u) * nloc) {
            __builtin_amdgcn_fence(__ATOMIC_RELEASE, "agent");
            asm volatile("s_waitcnt vmcnt(0)" ::: "memory");
            const unsigned og = xb_add(&bar[XB_TOP], 1u);
            const unsigned tg = og / nx;
            if (og + 1u == (tg + 1u) * nx) xb_add(&bar[XB_TOPGEN], 1u);
            else XB_SPIN(xb_ld(&bar[XB_TOPGEN]) == tg, bar);
            __builtin_amdgcn_fence(__ATOMIC_ACQUIRE, "agent");
            xb_add(&bar[XB_XGEN(b.x)], 1u);
            asm volatile("s_waitcnt vmcnt(0)" ::: "memory");
        } else {
            XB_SPIN(xb_ld(&bar[XB_XGEN(b.x)]) == gen, bar);
            __builtin_amdgcn_fence(__ATOMIC_ACQUIRE, "agent");
            asm volatile("s_waitcnt vmcnt(0)" ::: "memory");
        }
    }
    __syncthreads();
}
namespace pg8 {
#define PG8_LAS __attribute__((address_space(3)))
typedef unsigned short bf16_t;
typedef short bf16x8 __attribute__((ext_vector_type(8)));
typedef float f32x4 __attribute__((ext_vector_type(4)));
typedef unsigned u32x4 __attribute__((ext_vector_type(4)));
constexpr int BM = 256, BK = 64, HALF = 128, HTB = HALF * BK * 2  , STAGE_BYTES = 8 * HTB, NXCD = 8, WGM = 8;

__host__ __device__ __forceinline__ int lds_byte(int r, int c) { const int st = (r >> 4) * 2 + (c >> 5), rr = r & 15, cc = c & 31, ob = rr * 64 + cc * 2; return st * 1024 + (ob ^ (((ob >> 9) & 1) << 5)); }
__host__ __device__ __forceinline__ void stage_rc(int b, int& R, int& C) { const int st = b / 1024, sb = b % 1024, swz = sb ^ (((sb >> 9) & 1) << 5); R = (st >> 1) * 16 + swz / 64; C = (st & 1) * 32 + (swz % 64) / 2; }
__host__ __device__ __forceinline__ int perm32(int rho) { const int n = rho >> 4, i = rho & 15; return 8 * (i >> 2) + 4 * n + (i & 3); }

struct Unit { int pm, pn; };
struct Gemm { const bf16_t* A; const bf16_t* Bt; int M, N, K; };

struct StaticOrder {
    int nM, nN, nwg, G, c;
    __host__ __device__ void init(int M, int N, int G_, int c_) { nM = M / BM; nN = N / BM; nwg = nM * nN; G = G_; c = c_; }
    __host__ __device__ bool next(int i, Unit& u) const {
        const long L = (long)i * G + c; if (L >= nwg) return false;
        int wgid = (int)L; { const int q = nwg / NXCD, r = nwg % NXCD, xcd = wgid % NXCD, off = wgid / NXCD; wgid = (xcd < r ? xcd * (q + 1) : r * (q + 1) + (xcd - r) * q) + off; }
        const int nig = WGM * nN, gid = wgid / nig, fm = gid * WGM, gsz = (nM - fm) < WGM ? (nM - fm) : WGM;
        u.pm = fm + ((wgid % nig) % gsz); u.pn = (wgid % nig) / gsz; return true;
    }
    __device__ __forceinline__ void a_ready(const Unit&) const {}
    __device__ __forceinline__ void done(const Unit&) const {}
};
__device__ __forceinline__ unsigned cvt_pk_bf16(float lo, float hi) { unsigned r; asm volatile("v_cvt_pk_bf16_f32 %0, %1, %2" : "=v"(r) : "v"(lo), "v"(hi)); return r; }
template <class Epi, class Sched, bool STAMP = false>
__device__ __forceinline__ void gemm_phase(PG8_LAS unsigned char* lds, const Gemm g, const Sched& S, const Epi& E, unsigned long long* stamps) {
    const int tid = threadIdx.x, wid = __builtin_amdgcn_readfirstlane(tid >> 6), lane = tid & 63, wr = wid >> 2, wc = wid & 3, fr = lane & 15, fq = lane >> 4;
    const int K = g.K, nt = K / BK;
    int ts_lo = 0, ts_hi = 0, nts = 0; const unsigned long long rt_entry = STAMP ? (unsigned long long)wall_clock64() : 0ull;
#define PG8_STAMP() do { if (STAMP && wid == 0 && nts < 64) { const unsigned long long _c = (unsigned long long)clock64(); \
        ts_lo = (lane == nts) ? (int)(unsigned)_c : ts_lo; ts_hi = (lane == nts) ? (int)(unsigned)(_c >> 32) : ts_hi; ++nts; } } while (0)
    PG8_STAMP();
    unsigned voffA[2], voffB[2];
#pragma unroll
    for (int i = 0; i < 2; ++i) { int R, C; stage_rc(tid * 16 + i * 8192, R, C); const int Rb = Epi::PERM ? ((R & ~31) + perm32(R & 31)) : R;
        voffA[i] = (unsigned)(R * K + C) * 2u; voffB[i] = (unsigned)(Rb * K + C) * 2u; }
    const size_t kstep = (size_t)(BK * 2);
    const size_t hstep = (size_t)HALF * K * 2;
    const size_t tstep = 2 * hstep;
    const unsigned ldsw = (unsigned)wid * 1024u;
    const int aoff = lds_byte(wr * 64 + fr, fq * 8), boff = lds_byte(wc * 32 + fr, fq * 8);
#define PG8_SA(b, h) (((b) * 2 + (h)) * HTB)
#define PG8_SB(b, h) ((4 + (b) * 2 + (h)) * HTB)
#define PG8_STAGE(bufoff, gbase, voff) do { _Pragma("unroll") for (int _i = 0; _i < 2; ++_i) \
        __builtin_amdgcn_global_load_lds((const unsigned*)((const char*)(gbase) + (voff)[_i]), (PG8_LAS unsigned*)(lds + (bufoff) + ldsw + _i * 8192), 16, 0, 0); } while (0)
#define PG8_LDA(dst, b, h) do { _Pragma("unroll") for (int m = 0; m < 4; ++m) _Pragma("unroll") for (int k = 0; k < 2; ++k) dst[m][k] = *(const PG8_LAS bf16x8*)(lds + PG8_SA(b, h) + aoff + m * 2048 + k * 1024); } while (0)
#define PG8_LDB(dst, b, h) do { _Pragma("unroll") for (int n = 0; n < 2; ++n) _Pragma("unroll") for (int k = 0; k < 2; ++k) dst[n][k] = *(const PG8_LAS bf16x8*)(lds + PG8_SB(b, h) + boff + n * 2048 + k * 1024); } while (0)
#define PG8_MMA(ai, bj, At, Bt) do { __builtin_amdgcn_s_setprio(1); _Pragma("unroll") for (int m = 0; m < 4; ++m) _Pragma("unroll") for (int n = 0; n < 2; ++n) _Pragma("unroll") for (int k = 0; k < 2; ++k) \
        acc[ai][bj][m][n] = __builtin_amdgcn_mfma_f32_16x16x32_bf16(Bt[n][k], At[m][k], acc[ai][bj][m][n], 0, 0, 0); __builtin_amdgcn_s_setprio(0); } while (0)
#define PG8_WAIT_V(n) asm volatile("s_waitcnt vmcnt(" #n ")" ::: "memory")
#define PG8_WAIT_L(n) asm volatile("s_waitcnt lgkmcnt(" #n ")" ::: "memory")
#define PG8_BAR __builtin_amdgcn_s_barrier()
#define PG8_SCHED __builtin_amdgcn_sched_barrier(0)
    Unit cur, nxt; int ui = 0;
    if (!S.next(0, cur)) return;
    f32x4 acc[2][2][4][2];
#pragma unroll
    for (int a = 0; a < 2; ++a)
#pragma unroll
        for (int b = 0; b < 2; ++b)
#pragma unroll
            for (int m = 0; m < 4; ++m)
#pragma unroll
                for (int n = 0; n < 2; ++n) acc[a][b][m][n] = (f32x4){0.f, 0.f, 0.f, 0.f};
    bf16x8 At[4][2], B0[2][2], B1[2][2];
    const char* cA = (const char*)g.A + (size_t)cur.pm * tstep; const char* cB = (const char*)g.Bt + (size_t)cur.pn * tstep;
    S.a_ready(cur);
    PG8_STAGE(PG8_SB(0, 0), cB, voffB); PG8_STAGE(PG8_SA(0, 0), cA, voffA); PG8_STAGE(PG8_SB(0, 1), cB + hstep, voffB); PG8_STAGE(PG8_SA(0, 1), cA + hstep, voffA);
    if (wr == 1) PG8_BAR;
    PG8_WAIT_V(4); PG8_BAR;
    PG8_STAGE(PG8_SB(1, 0), cB + kstep, voffB); PG8_STAGE(PG8_SA(1, 0), cA + kstep, voffA); PG8_STAGE(PG8_SB(1, 1), cB + hstep + kstep, voffB);
    PG8_WAIT_V(6); PG8_BAR;
    PG8_STAMP();
    for (;;) {
        const bool has_next = S.next(ui + 1, nxt);
        const char* nA = has_next ? (const char*)g.A + (size_t)nxt.pm * tstep : cA; const char* nB = has_next ? (const char*)g.Bt + (size_t)nxt.pn * tstep : cB;
        for (int t = 0; t < nt; t += 2) {
            const bool last = (t == nt - 2);
            const char* a1 = cA + (size_t)(t + 1) * kstep;
            const char* a2 = last ? nA : cA + (size_t)(t + 2) * kstep; const char* b2 = last ? nB : cB + (size_t)(t + 2) * kstep;
            const char* a3 = a2 + kstep; const char* b3 = b2 + kstep;
            if (last && has_next) S.a_ready(nxt);
            PG8_LDB(B0, 0, 0); PG8_SCHED; PG8_LDA(At, 0, 0); PG8_STAGE(PG8_SA(1, 1), a1 + hstep, voffA);
            PG8_WAIT_L(8); PG8_BAR; PG8_WAIT_L(0); PG8_MMA(0, 0, At, B0); PG8_BAR; PG8_SCHED;
            PG8_LDB(B1, 0, 1); PG8_STAGE(PG8_SB(0, 0), b2, voffB);
            PG8_BAR; PG8_WAIT_L(0); PG8_MMA(0, 1, At, B1); PG8_BAR;
            PG8_LDA(At, 0, 1); PG8_STAGE(PG8_SA(0, 0), a2, voffA);
            PG8_BAR; PG8_WAIT_L(0); PG8_MMA(1, 0, At, B0); PG8_BAR; PG8_SCHED;
            PG8_STAGE(PG8_SB(0, 1), b2 + hstep, voffB);
            PG8_WAIT_V(6); PG8_BAR; PG8_MMA(1, 1, At, B1); PG8_BAR;
            PG8_LDB(B0, 1, 0); PG8_SCHED; PG8_LDA(At, 1, 0); PG8_STAGE(PG8_SA(0, 1), a2 + hstep, voffA);
            PG8_WAIT_L(8); PG8_BAR; PG8_WAIT_L(0); PG8_MMA(0, 0, At, B0); PG8_BAR; PG8_SCHED;
            PG8_LDB(B1, 1, 1); PG8_STAGE(PG8_SB(1, 0), b3, voffB);
            PG8_BAR; PG8_WAIT_L(0); PG8_MMA(0, 1, At, B1); PG8_BAR;
            PG8_LDA(At, 1, 1); PG8_STAGE(PG8_SA(1, 0), a3, voffA);
            PG8_BAR; PG8_WAIT_L(0); PG8_MMA(1, 0, At, B0); PG8_BAR; PG8_SCHED;
            PG8_STAGE(PG8_SB(1, 1), b3 + hstep, voffB);
            PG8_WAIT_V(6); PG8_BAR; PG8_MMA(1, 1, At, B1); PG8_BAR;
        }
        PG8_STAMP();
        if constexpr (!Epi::AFTER_DRAIN) { E(acc, cur, wr, wc, fr, fq); S.done(cur); }
        PG8_STAMP();
        if (!has_next) break;
#pragma unroll
        for (int a = 0; a < 2; ++a)
#pragma unroll
            for (int b = 0; b < 2; ++b)
#pragma unroll
                for (int m = 0; m < 4; ++m)
#pragma unroll
                    for (int n = 0; n < 2; ++n) acc[a][b][m][n] = (f32x4){0.f, 0.f, 0.f, 0.f};
        cur = nxt; cA = nA; cB = nB; ++ui;
    }
    PG8_WAIT_V(0);
    if (wr == 0) PG8_BAR;
    PG8_BAR;
    if constexpr (Epi::AFTER_DRAIN) { E.fused(acc, cur, wr, wc, fr, fq, lds, wid, lane); S.done(cur); }
    PG8_STAMP();
    if (STAMP && wid == 0) { stamps[lane] = lane < nts ? (((unsigned long long)(unsigned)ts_hi << 32) | (unsigned)ts_lo) : 0ull;
        if (lane == 62) stamps[62] = rt_entry; if (lane == 63) stamps[63] = (unsigned long long)wall_clock64(); }
#undef PG8_STAMP
#undef PG8_SA
#undef PG8_SB
#undef PG8_STAGE
#undef PG8_LDA
#undef PG8_LDB
#undef PG8_MMA
#undef PG8_WAIT_V
#undef PG8_WAIT_L
#undef PG8_BAR
#undef PG8_SCHED
}
}
struct Ctx {
    LAS unsigned char* lds; int tid, lane, wave, G, bid;
};

DI void cvt_rows(const Ctx& F, const float* src, bf16_t* dst, size_t n) {
    const size_t n8 = n >> 3;
    for (size_t i = (size_t)F.bid * NTHR + F.tid; i < n8; i += (size_t)F.G * NTHR) {
        const f32x4 a = *(const f32x4*)(src + i * 8), b = *(const f32x4*)(src + i * 8 + 4);
        u32x4 w; w.x = pk2(a.x, a.y); w.y = pk2(a.z, a.w); w.z = pk2(b.x, b.y); w.w = pk2(b.z, b.w);
        *(u32x4*)(dst + i * 8) = w;
    }
}

constexpr int TR_S = 68;
DI void tr_tile_out(const Ctx& F, bf16_t* dst, size_t ldd, const LAS bf16_t* tile) {
    const int n = F.tid >> 3, kc = (F.tid & 7) * 8;
    const LAS bf16_t* t = tile + kc * TR_S + n;
    u32x4 v;
    v.x = (unsigned)t[0] | ((unsigned)t[TR_S] << 16); v.y = (unsigned)t[2 * TR_S] | ((unsigned)t[3 * TR_S] << 16);
    v.z = (unsigned)t[4 * TR_S] | ((unsigned)t[5 * TR_S] << 16); v.w = (unsigned)t[6 * TR_S] | ((unsigned)t[7 * TR_S] << 16);
    *(u32x4*)(dst + (size_t)n * ldd + kc) = v;
}
DI void tr_tile_f32(const Ctx& F, const float* src, size_t lds_, bf16_t* dst, size_t ldd, LAS bf16_t* tile) {
#pragma unroll
    for (int j = 0; j < 2; ++j) {
        const int id = F.tid + NTHR * j, kr = id >> 4, nc = (id & 15) * 4;
        const f32x4 v = *(const f32x4*)(src + (size_t)kr * lds_ + nc);
        *(LAS u32x2*)(tile + kr * TR_S + nc) = (u32x2){pk2(v.x, v.y), pk2(v.z, v.w)};
    }
    __syncthreads();
    tr_tile_out(F, dst, ldd, tile);
    __syncthreads();
}
DI void tr_tile_bf16(const Ctx& F, const bf16_t* src, size_t lds_, bf16_t* dst, size_t ldd, LAS bf16_t* tile) {
    { const int kr = F.tid >> 3, nc = (F.tid & 7) * 8; const u32x4 v = *(const u32x4*)(src + (size_t)kr * lds_ + nc);
      *(LAS u32x2*)(tile + kr * TR_S + nc) = (u32x2){v.x, v.y}; *(LAS u32x2*)(tile + kr * TR_S + nc + 4) = (u32x2){v.z, v.w}; }
    __syncthreads();
    tr_tile_out(F, dst, ldd, tile);
    __syncthreads();
}
struct TrJob { const bf16_t* src; size_t lds_; bf16_t* dst; size_t ldd; };
template <class Map>
DI void tr_pipeline_bf16(const Ctx& F, int nt, const Map& map, LAS bf16_t* tiles) {
    const int kr = F.tid >> 3, nc = (F.tid & 7) * 8;
    __syncthreads();
    u32x4 v[4];
#pragma unroll
    for (int u = 0; u < 4; ++u) { const int t = F.bid + u * F.G; v[u] = (u32x4){0u, 0u, 0u, 0u};
        if (t < nt) { const TrJob J = map(t); v[u] = *(const u32x4*)(J.src + (size_t)kr * J.lds_ + nc); } }
#pragma unroll 1
    for (int t0 = F.bid; t0 < nt; t0 += 4 * F.G) {
#pragma unroll
        for (int u = 0; u < 4; ++u) { const int t = t0 + u * F.G;
            if (t < nt) {
                LAS bf16_t* tile = tiles + (u & 1) * (64 * TR_S);
                *(LAS u32x2*)(tile + kr * TR_S + nc) = (u32x2){v[u].x, v[u].y}; *(LAS u32x2*)(tile + kr * TR_S + nc + 4) = (u32x2){v[u].z, v[u].w};
                const int tn = t + 4 * F.G;
                if (tn < nt) { const TrJob Jn = map(tn); v[u] = *(const u32x4*)(Jn.src + (size_t)kr * Jn.lds_ + nc); }
                __syncthreads();
                const TrJob J = map(t);
                tr_tile_out(F, J.dst, J.ldd, tile);
            } }
    }
    __syncthreads();
}
DI void transpose_weight(const Ctx& F, const float* W, int K, int N, bf16_t* Wt) {
    const int tk = K / 64, tn = N / 64;
    for (int t = F.bid; t < tk * tn; t += F.G) {
        const int k0 = (t / tn) * 64, n0 = (t % tn) * 64;
        tr_tile_f32(F, W + (size_t)k0 * N + n0, (size_t)N, Wt + (size_t)n0 * K + k0, (size_t)K, (LAS bf16_t*)F.lds);
    }
}
DI void transpose_cache_v(const Ctx& F, const float* V, bf16_t* VT) {
    for (int t = F.bid; t < 64 * 8; t += F.G) {
        const int bh = t >> 3, sub = t & 7, k0 = (sub >> 1) * 64, d0 = (sub & 1) * 64, b = bh >> 3, h = bh & 7;
        tr_tile_f32(F, V + ((size_t)b * 256 + k0) * 1024 + h * 128 + d0, 1024, VT + ((size_t)bh * 128 + d0) * 256 + k0, 256, (LAS bf16_t*)F.lds);
    }
}

DI void adaln_partials(const Ctx& F, const Params& P) {
    LAS float* s = (LAS float*)F.lds;
    const float* modw = P.in[I_MODW]; const float* cv = P.in[I_C]; const float* cctx = P.in[I_CCTX];
    float* modp = (float*)(P.ws + WS_MODP);
    for (int it = F.bid; it < 192; it += F.G) {
        const int i = it / 96, r = it % 96, ks = r / 6, cg = r % 6;
        __syncthreads();
        for (int e = F.tid; e < 9 * 128; e += NTHR) { const int j = e >> 7, k = e & 127; const float c = (j == 0) ? cctx[ks * 128 + k] : cv[(j - 1) * 2048 + ks * 128 + k]; s[e] = c / (1.f + __expf(-c)); }
        __syncthreads();
        f32x4 acc[9];
#pragma unroll
        for (int j = 0; j < 9; ++j) acc[j] = (f32x4){0.f, 0.f, 0.f, 0.f};
        const float* w = modw + ((size_t)i * 2048 + ks * 128) * 12288 + cg * 2048 + F.tid * 4;
#pragma unroll 8
        for (int k = 0; k < 128; ++k) {
            const f32x4 w4 = *(const f32x4*)(w + (size_t)k * 12288);
#pragma unroll
            for (int j = 0; j < 9; ++j) acc[j] += w4 * s[j * 128 + k];
        }
#pragma unroll
        for (int j = 0; j < 9; ++j) *(f32x4*)(modp + ((size_t)(i * 16 + ks) * 9 + j) * 12288 + cg * 2048 + F.tid * 4) = acc[j];
    }
    __syncthreads();
}
DI void adaln_reduce(const Ctx& F, const Params& P) {
    const float* modp = (const float*)(P.ws + WS_MODP); float* mod = (float*)(P.ws + WS_MOD); const float* modb = P.in[I_MODB];
    for (int e = F.bid * NTHR + F.tid; e < 2 * 9 * 12288; e += F.G * NTHR) {
        const int i = e / (9 * 12288), r = e % (9 * 12288), j = r / 12288, n = r % 12288;
        float a = modb[i * 12288 + n];
#pragma unroll
        for (int ks = 0; ks < 16; ++ks) a += modp[((size_t)(i * 16 + ks) * 9 + j) * 12288 + n];
        mod[e] = a;
    }
}

DI void hyena_filters(const Ctx& F, const Params& P) {
    LAS float* z = (LAS float*)F.lds;
    LAS float* h1 = z + 320;
    LAS float* h2 = h1 + 576;
    const float* w1 = P.in[I_HYW1]; const float* b1 = P.in[I_HYB1]; const float* f1 = P.in[I_HYF1];
    const float* w2 = P.in[I_HYW2]; const float* b2 = P.in[I_HYB2]; const float* f2 = P.in[I_HYF2];
    const float* w3 = P.in[I_HYW3]; const float* dec = P.in[I_HYDEC];
    for (int it = F.bid; it < 544; it += F.G) {
        const bool smp = it < 512; const int L = smp ? LS : LP, p0 = (smp ? it : it - 512) * 8, RL = smp ? KRL_S : KRL_P;
        bf16_t* KR = (bf16_t*)(P.ws + (smp ? WS_KRS : WS_KRP));
        __syncthreads();
        if (F.tid < 9 * 33) {
            const int ps = F.tid / 33, k = F.tid % 33, i = p0 + ps;
            const float t = (float)i / (float)(L - 1), wang = 6.283185307179586f * (float)i / (float)L;
            float val;
            if (k == 0) val = t;
            else { const int f = (k - 1) & 15; const float fr = 1e-4f + (float)f * ((15.0f - 1e-4f) / 15.0f); val = (k <= 16) ? cosf(fr * wang) : -sinf(fr * wang); }
            z[F.tid] = val;
        }
        __syncthreads();
        for (int e = F.tid; e < 9 * 64; e += NTHR) { const int ps = e >> 6, j = e & 63; float a = b1[j];
            for (int k = 0; k < 33; ++k) a += z[ps * 33 + k] * w1[k * 64 + j];
            h1[e] = sinf(f1[j] * a); }
        __syncthreads();
        for (int e = F.tid; e < 9 * 64; e += NTHR) { const int ps = e >> 6, j = e & 63; float a = b2[j];
            for (int k = 0; k < 64; ++k) a += h1[ps * 64 + k] * w2[k * 64 + j];
            h2[e] = sinf(f2[j] * a); }
        __syncthreads();
#pragma unroll 1
        for (int qh = 0; qh < 2; ++qh) {
            float acc[9][4];
#pragma unroll
            for (int ps = 0; ps < 9; ++ps)
#pragma unroll
                for (int q = 0; q < 4; ++q) acc[ps][q] = 0.f;
#pragma unroll 2
            for (int k = 0; k < 64; ++k) {
                float w[4];
#pragma unroll
                for (int q = 0; q < 4; ++q) w[q] = w3[k * 4096 + F.tid + NTHR * (qh * 4 + q)];
#pragma unroll
                for (int ps = 0; ps < 9; ++ps) { const float hv = h2[ps * 64 + k];
#pragma unroll
                    for (int q = 0; q < 4; ++q) acc[ps][q] += hv * w[q]; }
            }
#pragma unroll
            for (int q = 0; q < 4; ++q) {
                const int n = F.tid + NTHR * (qh * 4 + q), o = (n >> 10) & 1, c = n & 1023;
                const float dc = fabsf(dec[n]);
                bf16_t* row = KR + (size_t)(o * 1024 + c) * RL;
                float v[9];
#pragma unroll
                for (int ps = 0; ps < 9; ++ps) { const int i = p0 + ps; v[ps] = (i < L) ? acc[ps][q] * __expf(-((float)i / (float)(L - 1)) * dc) : 0.f; }
                if (qh == 0) {
                    u32x4 wv; wv.x = pk2(v[8], v[7]); wv.y = pk2(v[6], v[5]); wv.z = pk2(v[4], v[3]); wv.w = pk2(v[2], v[1]);
                    *(u32x4*)(row + (L - p0 - 8)) = wv;
                    if (p0 == 0) row[L] = f2bf(v[0]);
                } else if (p0 > 0) {
                    u32x4 wv; wv.x = pk2(v[0], v[1]); wv.y = pk2(v[2], v[3]); wv.z = pk2(v[4], v[5]); wv.w = pk2(v[6], v[7]);
                    *(u32x4*)(row + (L + p0)) = wv;
                } else {
#pragma unroll
                    for (int ps = 1; ps < 8; ++ps) row[L + ps] = f2bf(v[ps]);
                }
            }
        }
    }
    __syncthreads();
    for (int e = F.bid * NTHR + F.tid; e < 2 * 2048; e += F.G * NTHR) {
        const bool smp = e < 2048; const int r = e & 2047, L = smp ? LS : LP, RL = smp ? KRL_S : KRL_P;
        bf16_t* row = (bf16_t*)(P.ws + (smp ? WS_KRS : WS_KRP)) + (size_t)r * RL;
        for (int x = 2 * L; x < RL; ++x) row[x] = 0;
    }
}

DI void s5_consts(const Ctx& F, const Params& P) {
    float* S5A = (float*)(P.ws + WS_S5A); bf16_t* BB = (bf16_t*)(P.ws + WS_S5BB); bf16_t* CC = (bf16_t*)(P.ws + WS_S5CC);
    const float* lre = P.in[I_S5LRE]; const float* lim = P.in[I_S5LIM]; const float* ldt = P.in[I_S5LDT];
    const float* bre = P.in[I_S5BRE]; const float* bim = P.in[I_S5BIM]; const float* cre = P.in[I_S5CRE]; const float* cim = P.in[I_S5CIM];
    for (int e = F.bid * NTHR + F.tid; e < 8192; e += F.G * NTHR) {
        const int dg = e >> 6, n = e & 63;
        const float dt = expf(ldt[dg]), lr = lre[e], li = lim[e];
        const float mag = expf(lr * dt), ar = mag * cosf(li * dt), ai = mag * sinf(li * dt), den = lr * lr + li * li;
        const float cr = ((ar - 1.f) * lr + ai * li) / den, ci = (ai * lr - (ar - 1.f) * li) / den;
        S5A[e * 2] = ar; S5A[e * 2 + 1] = ai;
#pragma unroll
        for (int p = 0; p < 16; ++p) {
            const float br = bre[(size_t)e * 16 + p], bi = bim[(size_t)e * 16 + p];
            BB[((size_t)dg * 128 + n) * 16 + p] = f2bf(cr * br - ci * bi);
            BB[((size_t)dg * 128 + 64 + n) * 16 + p] = f2bf(cr * bi + ci * br);
            CC[((size_t)dg * 16 + p) * 128 + n] = f2bf(cre[((size_t)dg * 16 + p) * 64 + n]);
            CC[((size_t)dg * 16 + p) * 128 + 64 + n] = f2bf(-cim[((size_t)dg * 16 + p) * 64 + n]);
        }
    }
}

constexpr int PT_ROWB = 1536;
DI void cvt_table_fp6(const Ctx& F, const float* src, unsigned char* dst, float* scales, const int (&perm)[32]) {
    LAS float* scr = (LAS float*)(F.lds) + F.wave * 2048 + F.lane;
    for (int r = F.bid * 8 + F.wave; r < 16384; r += F.G * 8) {
        f32x4 v[8]; float m = 0.f;
#pragma unroll
        for (int j = 0; j < 8; ++j) { v[j] = *(const f32x4*)(src + (size_t)r * 2048 + F.lane * 32 + j * 4);
            m = fmaxf(m, fmaxf(fmaxf(fabsf(v[j].x), fabsf(v[j].y)), fmaxf(fabsf(v[j].z), fabsf(v[j].w)))); }
        m = wave_max(m);
        const float inv = (m > 0.f) ? 7.0f / m : 0.f, sc = (m > 0.f) ? m / 7.0f : 0.f;
#pragma unroll
        for (int j = 0; j < 8; ++j) { scr[perm[j * 4 + 0] * 64] = v[j].x * inv; scr[perm[j * 4 + 1] * 64] = v[j].y * inv; scr[perm[j * 4 + 2] * 64] = v[j].z * inv; scr[perm[j * 4 + 3] * 64] = v[j].w * inv; }
        asm volatile("" ::: "memory");
        f32x16 a, b;
#pragma unroll
        for (int i = 0; i < 16; ++i) { a[i] = scr[i * 64]; b[i] = scr[(16 + i) * 64]; }
        asm volatile("" ::: "memory");
        const u32x6 pk = __builtin_amdgcn_cvt_scalef32_2xpk16_fp6_f32(a, b, 1.0f);
        unsigned char* o = dst + (size_t)r * PT_ROWB;
        *(u32x4*)(o + F.lane * 16) = (u32x4){pk[0], pk[1], pk[2], pk[3]}; *(u32x2*)(o + 1024 + F.lane * 8) = (u32x2){pk[4], pk[5]};
        if (F.lane == 0) scales[r] = sc;
    }
}
DI void convert_peer_tables(const Ctx& F, const Params& P) {
    int perm[32];
    { f32x16 a, b;
#pragma unroll
      for (int j = 0; j < 16; ++j) { a[j] = 0.125f * (float)j; b[j] = (j < 8) ? 2.0f + 0.25f * (float)j : 4.0f + 0.5f * (float)(j - 8); }
      const u32x6 pk = __builtin_amdgcn_cvt_scalef32_2xpk16_fp6_f32(a, b, 1.0f);
      const f32x32 rt = __builtin_amdgcn_cvt_scalef32_pk32_f32_fp6(pk, 1.0f);
#pragma unroll
      for (int i = 0; i < 32; ++i) { const float x = rt[i]; const int o = (x < 2.0f) ? (int)(x * 8.0f + 0.5f) : ((x < 4.0f) ? 16 + (int)((x - 2.0f) * 4.0f + 0.5f) : 24 + (int)((x - 4.0f) * 2.0f + 0.5f)); perm[i] = min(max(o, 0), 31); } }
    float* SC = (float*)(P.ws + WS_SC);
    __syncthreads();
    for (int layer = 0; layer < 2; ++layer) {
        cvt_table_fp6(F, P.in[I_PU] + (size_t)layer * 16384 * 2048, P.ws + WS_TBLU + (size_t)layer * 16384 * PT_ROWB, SC + layer * 16384, perm);
        cvt_table_fp6(F, P.in[I_PV] + (size_t)layer * 16384 * 2048, P.ws + WS_TBLV + (size_t)layer * 16384 * PT_ROWB, SC + (2 + layer) * 16384, perm);
    }
    __syncthreads();
}

DI void prologue(const Ctx& F, const Params& P) {
    adaln_partials(F, P);
    transpose_weight(F, P.in[I_EVWIN], 2048, 6144, (bf16_t*)(P.ws + WS_WEVIN));
    transpose_weight(F, P.in[I_EVWOUT], 2048, 2048, (bf16_t*)(P.ws + WS_WEVOUT));
    transpose_weight(F, P.in[I_ODWIN], 2048, 4096, (bf16_t*)(P.ws + WS_WODIN));
    transpose_weight(F, P.in[I_ODWOUT], 2048, 2048, (bf16_t*)(P.ws + WS_WODOUT));
    transpose_weight(F, P.in[I_PWQ], 2048, 2048, (bf16_t*)(P.ws + WS_WPQ));
    transpose_weight(F, P.in[I_PWQ] + (size_t)2048 * 2048, 2048, 2048, (bf16_t*)(P.ws + WS_WPQ) + (size_t)2048 * 2048);
    transpose_weight(F, P.in[I_GLUW], 1024, 1024, (bf16_t*)(P.ws + WS_WGLU));
    cvt_rows(F, P.in[I_PKEYS], (bf16_t*)(P.ws + WS_PKEYS), (size_t)2 * 8 * 2 * 128 * 128);
    cvt_rows(F, P.in[I_CNK], (bf16_t*)(P.ws + WS_CNK), (size_t)8 * 256 * 1024);
    cvt_rows(F, P.in[I_CDK], (bf16_t*)(P.ws + WS_CDK), (size_t)8 * 256 * 1024);
    transpose_cache_v(F, P.in[I_CNV], (bf16_t*)(P.ws + WS_CNVT));
    transpose_cache_v(F, P.in[I_CDV], (bf16_t*)(P.ws + WS_CDVT));
    hyena_filters(F, P);
    s5_consts(F, P);
    convert_peer_tables(F, P);
}
DI void norm_phase(const Ctx& F, const float* xa, const float* xb, const float* gvec, const float* modl, int sidx, bf16_t* H) {
    for (int T = F.bid * 8 + F.wave; T < TOK; T += F.G * 8) {
        const float* xr = T < TP ? xa + (size_t)T * DM : xb + (size_t)(T - TP) * DM;
        f32x4 v[8]; float ss = 0.f;
#pragma unroll
        for (int j = 0; j < 8; ++j) { v[j] = *(const f32x4*)(xr + (j * 64 + F.lane) * 4); ss += v[j].x * v[j].x + v[j].y * v[j].y + v[j].z * v[j].z + v[j].w * v[j].w; }
        ss = wave_sum(ss);
        const float rstd = rsqrtf(ss * (1.f / DM) + NORM_EPS);
        const float* sh = modl + (size_t)(cond_of(T) * 6 + sidx) * DM; const float* sc = sh + DM;
#pragma unroll
        for (int j = 0; j < 8; ++j) {
            const int col = (j * 64 + F.lane) * 4;
            const f32x4 g4 = *(const f32x4*)(gvec + col), s4 = *(const f32x4*)(sc + col), h4 = *(const f32x4*)(sh + col);
            const f32x4 o = v[j] * rstd * g4 * (s4 + 1.f) + h4;
            u32x2 w; w.x = pk2(o.x, o.y); w.y = pk2(o.z, o.w);
            *(u32x2*)(H + (size_t)T * DM + col) = w;
        }
    }
}

struct EpiBf16 {
    static constexpr bool PERM = true, AFTER_DRAIN = false;
    bf16_t* O; int ldc;
    DI void operator()(const f32x4 (&acc)[2][2][4][2], const pg8::Unit& u, int wr, int wc, int fr, int fq) const {
        const int row0 = u.pm * 256 + wr * 64 + fr, col0 = u.pn * 256 + wc * 32 + 8 * fq;
#pragma unroll
        for (int ai = 0; ai < 2; ++ai)
#pragma unroll
            for (int m = 0; m < 4; ++m) { bf16_t* rowp = O + (size_t)(row0 + ai * 128 + m * 16) * ldc + col0;
#pragma unroll
                for (int bj = 0; bj < 2; ++bj) { const f32x4 v0 = acc[ai][bj][m][0], v1 = acc[ai][bj][m][1];
                    u32x4 w; w.x = pk2(v0[0], v0[1]); w.y = pk2(v0[2], v0[3]); w.z = pk2(v1[0], v1[1]); w.w = pk2(v1[2], v1[3]);
                    *(u32x4*)(rowp + bj * 128) = w; } }
    }
};
struct EpiResid {
    static constexpr bool PERM = false, AFTER_DRAIN = false;
    const float* xa; const float* xb; float* out; const float* modl; int gidx;
    DI void operator()(const f32x4 (&acc)[2][2][4][2], const pg8::Unit& u, int wr, int wc, int fr, int fq) const {
        const int row0 = u.pm * 256 + wr * 64 + fr, col0 = u.pn * 256 + wc * 32 + 4 * fq;
        const float* xbase = (u.pm < 32) ? xa : xb - (size_t)TP * DM;
        const float* gate = modl + (size_t)(cond_of(u.pm * 256) * 6 + gidx) * DM;
        f32x4 gv[2][2];
#pragma unroll
        for (int bj = 0; bj < 2; ++bj)
#pragma unroll
            for (int n = 0; n < 2; ++n) gv[bj][n] = *(const f32x4*)(gate + col0 + bj * 128 + n * 16);
#pragma unroll
        for (int ai = 0; ai < 2; ++ai)
#pragma unroll
            for (int m = 0; m < 4; ++m) { const size_t ro = (size_t)(row0 + ai * 128 + m * 16) * DM + col0;
#pragma unroll
                for (int bj = 0; bj < 2; ++bj)
#pragma unroll
                    for (int n = 0; n < 2; ++n) { const f32x4 x4 = *(const f32x4*)(xbase + ro + bj * 128 + n * 16);
                        *(f32x4*)(out + ro + bj * 128 + n * 16) = x4 + gv[bj][n] * acc[ai][bj][m][n]; } }
    }
};
struct EpiGlu {
    static constexpr bool PERM = true, AFTER_DRAIN = false;
    const bf16_t* Y; bf16_t* O; const float* bias;
    DI void operator()(const f32x4 (&acc)[2][2][4][2], const pg8::Unit& u, int wr, int wc, int fr, int fq) const {
        const int row0 = u.pm * 256 + wr * 64 + fr, col0 = u.pn * 256 + wc * 32 + 8 * fq;
#pragma unroll
        for (int bj = 0; bj < 2; ++bj) {
            const f32x4 b0 = *(const f32x4*)(bias + col0 + bj * 128), b1 = *(const f32x4*)(bias + col0 + bj * 128 + 4);
#pragma unroll
            for (int ai = 0; ai < 2; ++ai)
#pragma unroll
                for (int m = 0; m < 4; ++m) { const size_t r = (size_t)(row0 + ai * 128 + m * 16);
                    const u32x4 yv = *(const u32x4*)(Y + r * 1024 + col0 + bj * 128);
                    const f32x4 a0 = acc[ai][bj][m][0] + b0, a1 = acc[ai][bj][m][1] + b1;
                    float o[8];
                    o[0] = bflo(yv.x) / (1.f + __expf(-a0[0])); o[1] = bfhi(yv.x) / (1.f + __expf(-a0[1]));
                    o[2] = bflo(yv.y) / (1.f + __expf(-a0[2])); o[3] = bfhi(yv.y) / (1.f + __expf(-a0[3]));
                    o[4] = bflo(yv.z) / (1.f + __expf(-a1[0])); o[5] = bfhi(yv.z) / (1.f + __expf(-a1[1]));
                    o[6] = bflo(yv.w) / (1.f + __expf(-a1[2])); o[7] = bfhi(yv.w) / (1.f + __expf(-a1[3]));
                    u32x4 w; w.x = pk2(o[0], o[1]); w.y = pk2(o[2], o[3]); w.z = pk2(o[4], o[5]); w.w = pk2(o[6], o[7]);
                    *(u32x4*)(O + r * DM + col0 + bj * 128) = w; }
        }
    }
};
template <class Epi> DI void run_gemm(const Ctx& F, const bf16_t* A, const bf16_t* Bt, int N, int K, const Epi& E) {
    pg8::Gemm g{A, Bt, TOK, N, K}; pg8::StaticOrder S; S.init(TOK, N, F.G, F.bid);
    pg8::gemm_phase<Epi, pg8::StaticOrder, false>(F.lds, g, S, E, nullptr);
    __syncthreads();
}

DI void prep_a(const Ctx& F, const Params& P) {
    const bf16_t* T1 = (const bf16_t*)(P.ws + WS_RA);
    bf16_t* VTp = (bf16_t*)(P.ws + WS_VT); bf16_t* VTs = (bf16_t*)(P.ws + WS_VT + VT_S);
    { struct VtMap { const bf16_t* T1; bf16_t* VTp; bf16_t* VTs;
          DI TrJob operator()(int t) const {
              if (t < 2048) { const int bh = t >> 3, sub = t & 7, tk = sub >> 1, dd = sub & 1, b = bh >> 3, h = bh & 7;
                  return TrJob{T1 + ((size_t)(b * 256 + tk * 64)) * 4096 + h * 128 + dd * 64, 4096, VTp + ((size_t)bh * 128 + dd * 64) * 256 + tk * 64, 256}; }
              const int u = t - 2048, bh = u >> 7, sub = u & 127, tk = sub >> 1, dd = sub & 1, b = bh >> 3, h = bh & 7;
              return TrJob{T1 + ((size_t)(TP + b * 4096 + tk * 64)) * 4096 + h * 128 + dd * 64, 4096, VTs + ((size_t)bh * 128 + dd * 64) * 4096 + tk * 64, 4096}; } };
      tr_pipeline_bf16(F, 2048 + 8192, VtMap{T1, VTp, VTs}, (LAS bf16_t*)F.lds); }
    { float* o = P.out + O_NAV;
      for (int e = F.bid * NTHR + F.tid; e < TP * 128; e += F.G * NTHR) { const int T = e >> 7, c8 = (e & 127) * 8;
          const u32x4 v = *(const u32x4*)(T1 + (size_t)T * 4096 + c8);
          *(f32x4*)(o + (size_t)T * 1024 + c8) = (f32x4){bflo(v.x), bfhi(v.x), bflo(v.y), bfhi(v.y)};
          *(f32x4*)(o + (size_t)T * 1024 + c8 + 4) = (f32x4){bflo(v.z), bfhi(v.z), bflo(v.w), bfhi(v.w)}; } }
    { LAS bf16_t* tl = (LAS bf16_t*)F.lds;
      bf16_t* CM = (bf16_t*)(P.ws + WS_RB);
      const float* cw = P.in[I_HYCW]; const float* cb = P.in[I_HYCB];
      for (int t = F.bid; t < 48 * 160; t += F.G) {
          const int cg = t % 48, tg = t / 48, ch0 = cg * 64, t0 = tg * 256;
          const bool lz = (t0 < TP) ? true : (((t0 - TP) & 4095) == 0);
          const bool rz = (t0 < TP) ? true : (((t0 + 256 - TP) & 4095) == 0);
          __syncthreads();
#pragma unroll
          for (int j = 0; j < 4; ++j) { const int id = F.tid + NTHR * j, tk = id >> 3, c8 = (id & 7) * 8;
              const u32x4 v = *(const u32x4*)(T1 + (size_t)(t0 + tk) * 4096 + 1024 + ch0 + c8);
              LAS bf16_t* d = tl + tk + 1;
              d[(c8 + 0) * 264] = (bf16_t)(v.x & 0xffff); d[(c8 + 1) * 264] = (bf16_t)(v.x >> 16); d[(c8 + 2) * 264] = (bf16_t)(v.y & 0xffff); d[(c8 + 3) * 264] = (bf16_t)(v.y >> 16);
              d[(c8 + 4) * 264] = (bf16_t)(v.z & 0xffff); d[(c8 + 5) * 264] = (bf16_t)(v.z >> 16); d[(c8 + 6) * 264] = (bf16_t)(v.w & 0xffff); d[(c8 + 7) * 264] = (bf16_t)(v.w >> 16); }
          if (F.tid < 16) { const int side = F.tid >> 3, c8 = (F.tid & 7) * 8; const bool zero = side ? rz : lz; const int tk = side ? t0 + 256 : t0 - 1;
              u32x4 v = (u32x4){0u, 0u, 0u, 0u};
              if (!zero) v = *(const u32x4*)(T1 + (size_t)tk * 4096 + 1024 + ch0 + c8);
              LAS bf16_t* d = tl + (side ? 257 : 0);
              d[(c8 + 0) * 264] = (bf16_t)(v.x & 0xffff); d[(c8 + 1) * 264] = (bf16_t)(v.x >> 16); d[(c8 + 2) * 264] = (bf16_t)(v.y & 0xffff); d[(c8 + 3) * 264] = (bf16_t)(v.y >> 16);
              d[(c8 + 4) * 264] = (bf16_t)(v.z & 0xffff); d[(c8 + 5) * 264] = (bf16_t)(v.z >> 16); d[(c8 + 6) * 264] = (bf16_t)(v.w & 0xffff); d[(c8 + 7) * 264] = (bf16_t)(v.w >> 16); }
          __syncthreads();
#pragma unroll
          for (int j = 0; j < 4; ++j) { const int id = F.tid + NTHR * j, ch = id >> 5, to = (id & 31) * 8, cgl = ch0 + ch;
              const float w0 = cw[cgl], w1 = cw[3072 + cgl], w2 = cw[6144 + cgl], bb = cb[cgl];
              const LAS bf16_t* s = tl + ch * 264 + to;
              float r[10];
#pragma unroll
              for (int i = 0; i < 10; ++i) r[i] = bf2f(s[i]);
              float o[8];
#pragma unroll
              for (int i = 0; i < 8; ++i) o[i] = w0 * r[i] + w1 * r[i + 1] + w2 * r[i + 2] + bb;
              u32x4 w; w.x = pk2(o[0], o[1]); w.y = pk2(o[2], o[3]); w.z = pk2(o[4], o[5]); w.w = pk2(o[6], o[7]);
              *(u32x4*)(CM + (size_t)cgl * TOK + t0 + to) = w; }
      }
      __syncthreads(); }
}

DI void prep_b(const Ctx& F, const Params& P) {
    bf16_t* Pq = (bf16_t*)(P.ws + WS_RA); const float* qg = P.in[I_NAQG]; const float* kg = P.in[I_NAKG]; float* ok = P.out + O_NAK;
    const float* gsrc = (F.lane < 32 ? qg : kg) + (F.lane & 3) * 32;
    float g[32];
#pragma unroll
    for (int i = 0; i < 32; ++i) g[i] = gsrc[i];
    for (int T = F.bid * 8 + F.wave; T < TOK; T += F.G * 8) {
        bf16_t* rp = Pq + (size_t)T * 2048 + F.lane * 32;
        u32x4 v[4]; float x[32]; float ss = 0.f;
#pragma unroll
        for (int j = 0; j < 4; ++j) { v[j] = *(const u32x4*)(rp + j * 8);
            x[j * 8 + 0] = bflo(v[j].x); x[j * 8 + 1] = bfhi(v[j].x); x[j * 8 + 2] = bflo(v[j].y); x[j * 8 + 3] = bfhi(v[j].y);
            x[j * 8 + 4] = bflo(v[j].z); x[j * 8 + 5] = bfhi(v[j].z); x[j * 8 + 6] = bflo(v[j].w); x[j * 8 + 7] = bfhi(v[j].w); }
#pragma unroll
        for (int i = 0; i < 32; ++i) ss += x[i] * x[i];
        ss += dpp_xor1(ss); ss += dpp_xor2(ss);
        const float rstd = rsqrtf(ss * (1.f / 128.f) + NORM_EPS);
#pragma unroll
        for (int i = 0; i < 32; ++i) x[i] = x[i] * rstd * g[i];
#pragma unroll
        for (int j = 0; j < 4; ++j) { u32x4 w; w.x = pk2(x[j * 8 + 0], x[j * 8 + 1]); w.y = pk2(x[j * 8 + 2], x[j * 8 + 3]); w.z = pk2(x[j * 8 + 4], x[j * 8 + 5]); w.w = pk2(x[j * 8 + 6], x[j * 8 + 7]);
            *(u32x4*)(rp + j * 8) = w; }
        if (T < TP && F.lane >= 32) { float* o = ok + (size_t)T * 1024 + (F.lane - 32) * 32;
#pragma unroll
            for (int j = 0; j < 8; ++j) *(f32x4*)(o + j * 4) = (f32x4){x[j * 4], x[j * 4 + 1], x[j * 4 + 2], x[j * 4 + 3]}; }
    }
}
constexpr int AT_KROW = 272, AT_VROW = 136, AT_KTB = 64 * AT_KROW, AT_VTB = 128 * AT_VROW;
constexpr int AT_K0 = 0, AT_V0 = 2 * AT_KTB, AT_RPB = AT_V0 + 2 * AT_VTB;

struct TileMap { const bf16_t* latK; int latKld; const bf16_t* latV; int latVld; int nlat; const bf16_t* ctxK; const bf16_t* ctxV; int ntiles; };
struct TileRegs { u32x4 k[2], v[2]; };

DI void tile_src(const TileMap& M, int j, const bf16_t*& kp, int& kld, const bf16_t*& vp, int& vld) {
    if (j < M.nlat) { kp = M.latK + (size_t)j * 64 * M.latKld; kld = M.latKld; vp = M.latV + j * 64; vld = M.latVld; }
    else { const int c = j - M.nlat; kp = M.ctxK + (size_t)c * 64 * 1024; kld = 1024; vp = M.ctxV + c * 64; vld = 256; }
}
DI void tile_load(const Ctx& F, TileRegs& R, const bf16_t* kp, int kld, const bf16_t* vp, int vld, bool withV = true) {
#pragma unroll
    for (int j = 0; j < 2; ++j) { const int id = F.tid + NTHR * j;
        const unsigned ko = (unsigned)((id >> 4) * kld + (id & 15) * 8) * 2u, vo = (unsigned)((id >> 3) * vld + (id & 7) * 8) * 2u;
        R.k[j] = *(const u32x4*)((const char*)kp + ko);
        if (withV) R.v[j] = *(const u32x4*)((const char*)vp + vo); }
}
DI void tile_store(const Ctx& F, const TileRegs& R, LAS unsigned char* kt, LAS unsigned char* vt, bool withV = true) {
#pragma unroll
    for (int j = 0; j < 2; ++j) { const int id = F.tid + NTHR * j;
        *(LAS u32x4*)(kt + (id >> 4) * AT_KROW + (id & 15) * 16) = R.k[j];
        if (withV) { LAS unsigned char* vp = vt + (id >> 3) * AT_VROW + (id & 7) * 16;
            *(LAS u32x2*)(vp) = (u32x2){R.v[j].x, R.v[j].y}; *(LAS u32x2*)(vp + 8) = (u32x2){R.v[j].z, R.v[j].w}; } }
}

DI void tile_norm_k(const Ctx& F, TileRegs& R, const LAS float* kgain, float* nk, int nkld) {
#pragma unroll
    for (int j = 0; j < 2; ++j) { const int id = F.tid + NTHR * j;
        float x[8] = {bflo(R.k[j].x), bfhi(R.k[j].x), bflo(R.k[j].y), bfhi(R.k[j].y), bflo(R.k[j].z), bfhi(R.k[j].z), bflo(R.k[j].w), bfhi(R.k[j].w)};
        float ss = 0.f;
#pragma unroll
        for (int i = 0; i < 8; ++i) ss += x[i] * x[i];
        ss += dpp_xor1(ss); ss += dpp_xor2(ss);
        ss += __builtin_bit_cast(float, __builtin_amdgcn_update_dpp(0, __builtin_bit_cast(int, ss), 0x141, 0xF, 0xF, true));
        ss += __builtin_bit_cast(float, __builtin_amdgcn_update_dpp(0, __builtin_bit_cast(int, ss), 0x140, 0xF, 0xF, true));
        const float rstd = rsqrtf(ss * (1.f / 128.f) + NORM_EPS);
        const f32x4 g0 = *(const LAS f32x4*)(kgain + (id & 15) * 8), g1 = *(const LAS f32x4*)(kgain + (id & 15) * 8 + 4);
        x[0] *= rstd * g0.x; x[1] *= rstd * g0.y; x[2] *= rstd * g0.z; x[3] *= rstd * g0.w; x[4] *= rstd * g1.x; x[5] *= rstd * g1.y; x[6] *= rstd * g1.z; x[7] *= rstd * g1.w;
        R.k[j] = (u32x4){pk2(x[0], x[1]), pk2(x[2], x[3]), pk2(x[4], x[5]), pk2(x[6], x[7])};
        if (nk) { float* o = nk + (size_t)(id >> 4) * nkld + (id & 15) * 8; *(f32x4*)(o) = (f32x4){x[0], x[1], x[2], x[3]}; *(f32x4*)(o + 4) = (f32x4){x[4], x[5], x[6], x[7]}; }
    }
}

template <int KS>
DI f32x16 qk_tile(LAS const unsigned char* kt, const bf16x8 (&Qf)[8], int kb, int kk0, int q, int hh) {
    f32x16 S;
#pragma unroll
    for (int i = 0; i < 16; ++i) S[i] = 0.f;
#pragma unroll
    for (int ks = 0; ks < KS; ++ks) { const int kk = kk0 + ks;
        const bf16x8 A = *(const LAS bf16x8*)(kt + (kb * 32 + q) * AT_KROW + (kk * 16 + hh * 8) * 2);
        S = __builtin_amdgcn_mfma_f32_32x32x16_bf16(A, Qf[kk], S, 0, 0, 0); }
    return S;
}
DI void pv_tile(LAS const unsigned char* vt, const float (&p)[16], f32x16 (&O)[4], int kb, int q, int hh) {
#pragma unroll
    for (int s = 0; s < 2; ++s) {
        u32x4 pw; pw.x = pk2(p[8 * s + 0], p[8 * s + 1]); pw.y = pk2(p[8 * s + 2], p[8 * s + 3]); pw.z = pk2(p[8 * s + 4], p[8 * s + 5]); pw.w = pk2(p[8 * s + 6], p[8 * s + 7]);
        const bf16x8 Pf = __builtin_bit_cast(bf16x8, pw);
#pragma unroll
        for (int db = 0; db < 4; ++db) {
            LAS const unsigned char* ap = vt + (db * 32 + q) * AT_VROW + (kb * 32 + 16 * s + 4 * hh) * 2;
            const u32x2 lo = *(const LAS u32x2*)(ap), hi = *(const LAS u32x2*)(ap + 16);
            const bf16x8 A2 = __builtin_bit_cast(bf16x8, (u32x4){lo.x, lo.y, hi.x, hi.y});
            O[db] = __builtin_amdgcn_mfma_f32_32x32x16_bf16(A2, Pf, O[db], 0, 0, 0);
        }
        asm volatile("" ::: "memory");
    }
}
template <bool LAT>
DI void attn_compute1(LAS const unsigned char* kt, LAS const unsigned char* vt, const bf16x8 (&Qf)[8], f32x16 (&O)[4], float& ls, int lane, const LAS float* blane, int mb) {
    const int q = lane & 31, hh = lane >> 5;
#pragma unroll 1
    for (int kb = 0; kb < 2; ++kb) {
        float bb[16];
        if (LAT) {
#pragma unroll
            for (int i = 0; i < 16; ++i) bb[i] = blane[kb * 32 + (i & 3) + 8 * (i >> 2)];
        }
        const f32x16 S = qk_tile<8>(kt, Qf, kb, 0, q, hh);
        float p[16];
#pragma unroll
        for (int i = 0; i < 16; ++i) {
            if (LAT) { const float e = __builtin_amdgcn_exp2f(S[i] + bb[i]);
                p[i] = ((unsigned)(kb * 32 + (i & 3) + 8 * (i >> 2) + mb) < 16u) ? e : 0.f; }
            else p[i] = __builtin_amdgcn_exp2f(S[i]);
            ls += p[i];
        }
        pv_tile(vt, p, O, kb, q, hh);
    }
}
DI void diff_pass1(LAS const unsigned char* kt, const bf16x8 (&Qf)[8], float (&ls)[2], int lane) {
    const int q = lane & 31, hh = lane >> 5;
#pragma unroll
    for (int kb = 0; kb < 2; ++kb) {
#pragma unroll
        for (int mp = 0; mp < 2; ++mp) { const f32x16 S = qk_tile<4>(kt, Qf, kb, mp * 4, q, hh);
#pragma unroll
            for (int i = 0; i < 16; ++i) ls[mp] += __builtin_amdgcn_exp2f(S[i]); }
    }
}
DI void diff_pass2(LAS const unsigned char* kt, LAS const unsigned char* vt, const bf16x8 (&Qf)[8], f32x16 (&O)[4], float w0, float w1, int lane) {
    const int q = lane & 31, hh = lane >> 5;
#pragma unroll
    for (int kb = 0; kb < 2; ++kb) {
        float p[16];
        { const f32x16 S0 = qk_tile<4>(kt, Qf, kb, 0, q, hh);
#pragma unroll
          for (int i = 0; i < 16; ++i) p[i] = __builtin_amdgcn_exp2f(S0[i]) * w0; }
        { const f32x16 S1 = qk_tile<4>(kt, Qf, kb, 4, q, hh);
#pragma unroll
          for (int i = 0; i < 16; ++i) p[i] -= __builtin_amdgcn_exp2f(S1[i]) * w1; }
        pv_tile(vt, p, O, kb, q, hh);
    }
}

template <int MODE>
DI void attn_phase(const Ctx& F, const Params& P) {
    constexpr bool DIFF = (MODE >= 2);
    constexpr bool NA = (MODE == 1);
    LAS unsigned char* lds = F.lds;
    LAS float* rpbl = (LAS float*)(lds + AT_RPB);
    LAS float* kgl = (LAS float*)(lds + AT_RPB + 2048);
    if (!DIFF) { __syncthreads(); if (F.tid < 128) kgl[F.tid] = P.in[I_NAKG][F.tid]; __syncthreads(); }
    const bf16_t* PA = (const bf16_t*)(P.ws + WS_RA);
    bf16_t* MIX = (bf16_t*)(P.ws + WS_HM);
    const bf16_t* VTp = (const bf16_t*)(P.ws + WS_VT); const bf16_t* VTs = (const bf16_t*)(P.ws + WS_VT + VT_S);
    const int q = F.lane & 31, hh = F.lane >> 5;
    const float c1 = (DIFF ? 0.125f : 0.08838834764831845f) * LOG2E;
    float lam = 0.f;
    if (DIFF) {
        const float a = wave_sum(P.in[I_LQ1][F.lane] * P.in[I_LK1][F.lane]), b = wave_sum(P.in[I_LQ2][F.lane] * P.in[I_LK2][F.lane]);
        lam = __expf(a) - __expf(b) + 0.35550906759096924f;
    }
    const int nunits = (MODE == 0 || MODE == 2) ? 256 : 1024;
    for (int u0 = F.bid; u0 < nunits; u0 += F.G) {
        int u = u0;
        if ((MODE == 1 || MODE == 3) && F.G == 256) { const int i = u0 >> 8, x = F.bid & 7, y = F.bid >> 3; u = ((2 * i + (y >> 4)) * 8 + x) * 16 + (y & 15); }
        int b, h, tok0, r = 0, rlo = 0; TileMap M;
        const bf16_t* qptr;
        if (MODE == 0) { b = u >> 3; h = u & 7; tok0 = b * 256 + F.wave * 32;
            qptr = PA + (size_t)(tok0 + q) * 2048 + h * 128;
            M.latK = PA + (size_t)(b * 256) * 2048 + 1024 + h * 128; M.latKld = 2048; M.latV = VTp + (size_t)(b * 8 + h) * 128 * 256; M.latVld = 256; M.nlat = 4; M.ctxK = nullptr; M.ctxV = nullptr; M.ntiles = 4; }
        else if (MODE == 1) { b = u >> 7; h = (u >> 4) & 7; const int rg = u & 15; r = 4 * rg + (F.wave >> 1);
            rlo = min(max(4 * rg - 4, 0), 56); const int rhi = min(max(4 * rg + 3 - 4, 0), 56) + 8;
            tok0 = TP + b * 4096 + r * 64 + (F.wave & 1) * 32;
            qptr = PA + (size_t)(tok0 + q) * 2048 + h * 128;
            M.latK = PA + (size_t)(TP + b * 4096 + rlo * 64) * 2048 + 1024 + h * 128; M.latKld = 2048; M.latV = VTs + (size_t)(b * 8 + h) * 128 * 4096 + rlo * 64; M.latVld = 4096; M.nlat = rhi - rlo;
            M.ctxK = (const bf16_t*)(P.ws + WS_CNK) + (size_t)b * 256 * 1024 + h * 128; M.ctxV = (const bf16_t*)(P.ws + WS_CNVT) + (size_t)(b * 8 + h) * 128 * 256; M.ntiles = M.nlat + 4;
            if (F.tid < 465) rpbl[F.tid] = P.in[I_RPB][h * 465 + F.tid] * LOG2E; }
        else if (MODE == 2) { b = u >> 3; h = u & 7; tok0 = b * 256 + F.wave * 32;
            qptr = PA + (size_t)(tok0 + q) * 4096 + 1024 + h * 128;
            M.latK = PA + (size_t)(b * 256) * 4096 + 2048 + h * 128; M.latKld = 4096; M.latV = VTp + (size_t)(b * 8 + h) * 128 * 256; M.latVld = 256; M.nlat = 4; M.ctxK = nullptr; M.ctxV = nullptr; M.ntiles = 4; }
        else { b = u >> 7; h = (u >> 4) & 7; const int qb = u & 15; tok0 = TP + b * 4096 + qb * 256 + F.wave * 32;
            qptr = PA + (size_t)(tok0 + q) * 4096 + 1024 + h * 128;
            M.latK = PA + (size_t)(TP + b * 4096) * 4096 + 2048 + h * 128; M.latKld = 4096; M.latV = VTs + (size_t)(b * 8 + h) * 128 * 4096; M.latVld = 4096; M.nlat = 64;
            M.ctxK = (const bf16_t*)(P.ws + WS_CDK) + (size_t)b * 256 * 1024 + h * 128; M.ctxV = (const bf16_t*)(P.ws + WS_CDVT) + (size_t)(b * 8 + h) * 128 * 256; M.ntiles = 68; }
        bf16x8 Qf[8];
        if constexpr (!DIFF) {
            u32x4 w[8]; float ss = 0.f;
#pragma unroll
            for (int ks = 0; ks < 8; ++ks) { w[ks] = *(const u32x4*)(qptr + ks * 16 + hh * 8);
                ss += bflo(w[ks].x) * bflo(w[ks].x) + bfhi(w[ks].x) * bfhi(w[ks].x) + bflo(w[ks].y) * bflo(w[ks].y) + bfhi(w[ks].y) * bfhi(w[ks].y)
                    + bflo(w[ks].z) * bflo(w[ks].z) + bfhi(w[ks].z) * bfhi(w[ks].z) + bflo(w[ks].w) * bflo(w[ks].w) + bfhi(w[ks].w) * bfhi(w[ks].w); }
            ss += __shfl_xor(ss, 32);
            const float qs = rsqrtf(ss * (1.f / 128.f) + NORM_EPS) * c1;
            const float* qg = P.in[I_NAQG];
#pragma unroll
            for (int ks = 0; ks < 8; ++ks) { const f32x4 g0 = *(const f32x4*)(qg + ks * 16 + hh * 8), g1 = *(const f32x4*)(qg + ks * 16 + hh * 8 + 4);
                const u32x4 ws = (u32x4){pk2(bflo(w[ks].x) * qs * g0.x, bfhi(w[ks].x) * qs * g0.y), pk2(bflo(w[ks].y) * qs * g0.z, bfhi(w[ks].y) * qs * g0.w),
                                         pk2(bflo(w[ks].z) * qs * g1.x, bfhi(w[ks].z) * qs * g1.y), pk2(bflo(w[ks].w) * qs * g1.z, bfhi(w[ks].w) * qs * g1.w)};
                Qf[ks] = __builtin_bit_cast(bf16x8, ws); }
        } else {
#pragma unroll
        for (int ks = 0; ks < 8; ++ks) { const u32x4 w = *(const u32x4*)(qptr + ks * 16 + hh * 8);
            const u32x4 ws = (u32x4){pk2(bflo(w.x) * c1, bfhi(w.x) * c1), pk2(bflo(w.y) * c1, bfhi(w.y) * c1), pk2(bflo(w.z) * c1, bfhi(w.z) * c1), pk2(bflo(w.w) * c1, bfhi(w.w) * c1)};
            Qf[ks] = __builtin_bit_cast(bf16x8, ws); }
        }
        f32x16 O[4]; float ls[2] = {0.f, 0.f}; float w0 = 0.f, w1 = 0.f;
#pragma unroll
        for (int db = 0; db < 4; ++db)
#pragma unroll
            for (int i = 0; i < 16; ++i) O[db][i] = 0.f;
        const int cq = (F.wave & 1) * 32 + q, cs = min(max(cq - 8, 0), 48);
        const int r0w = min(max(r - 4, 0), 56);
        const int nt = M.ntiles;
        TileRegs R;
        { const bf16_t* kp; const bf16_t* vp; int kld, vld; tile_src(M, 0, kp, kld, vp, vld); tile_load(F, R, kp, kld, vp, vld); }
        if constexpr (!DIFF) tile_norm_k(F, R, kgl, (MODE == 0) ? P.out + O_NAK + (size_t)(b * 256) * 1024 + h * 128 : nullptr, 1024);
        tile_store(F, R, lds + AT_K0, lds + AT_V0);
        __syncthreads();
        if constexpr (DIFF) {
#pragma unroll 1
            for (int j = 0; j < nt; ++j) {
                const int cur = j & 1, jn = (j + 1 < nt) ? j + 1 : 0;
                const bool wv = (j + 1 == nt);
                { const bf16_t* kp; const bf16_t* vp; int kld, vld; tile_src(M, jn, kp, kld, vp, vld); tile_load(F, R, kp, kld, vp, vld, wv); }
                diff_pass1(lds + AT_K0 + cur * AT_KTB, Qf, ls, F.lane);
                tile_store(F, R, lds + AT_K0 + (cur ^ 1) * AT_KTB, lds + AT_V0 + (cur ^ 1) * AT_VTB, wv);
                __syncthreads();
            }
            { const float l0 = ls[0] + __shfl_xor(ls[0], 32), l1 = ls[1] + __shfl_xor(ls[1], 32); w0 = 1.f / l0; w1 = lam / l1; }
#pragma unroll 1
            for (int j = 0; j < nt; ++j) {
                const int cur = (nt + j) & 1;
                if (j + 1 < nt) { const bf16_t* kp; const bf16_t* vp; int kld, vld; tile_src(M, j + 1, kp, kld, vp, vld); tile_load(F, R, kp, kld, vp, vld); }
                diff_pass2(lds + AT_K0 + cur * AT_KTB, lds + AT_V0 + cur * AT_VTB, Qf, O, w0, w1, F.lane);
                if (j + 1 < nt) tile_store(F, R, lds + AT_K0 + (cur ^ 1) * AT_KTB, lds + AT_V0 + (cur ^ 1) * AT_VTB);
                __syncthreads();
            }
        } else {
#pragma unroll 1
            for (int j = 0; j < nt; ++j) {
                const int cur = j & 1;
                if (j + 1 < nt) { const bf16_t* kp; const bf16_t* vp; int kld, vld; tile_src(M, j + 1, kp, kld, vp, vld); tile_load(F, R, kp, kld, vp, vld); }
                LAS const unsigned char* kt = lds + AT_K0 + cur * AT_KTB; LAS const unsigned char* vt = lds + AT_V0 + cur * AT_VTB;
                if constexpr (NA) {
                    if (j < M.nlat) { const int kr = rlo + j;
                        if (kr >= r0w && kr < r0w + 8) attn_compute1<true>(kt, vt, Qf, O, ls[0], F.lane, rpbl + (kr - r + 7) * 31 + (4 * hh - cq + 15), 4 * hh - cs); }
                    else attn_compute1<false>(kt, vt, Qf, O, ls[0], F.lane, rpbl, 0);
                } else attn_compute1<false>(kt, vt, Qf, O, ls[0], F.lane, rpbl, 0);
                if (j + 1 < nt) {
                    if (j + 1 < M.nlat) tile_norm_k(F, R, kgl, (MODE == 0) ? P.out + O_NAK + (size_t)(b * 256 + (j + 1) * 64) * 1024 + h * 128 : nullptr, 1024);
                    tile_store(F, R, lds + AT_K0 + (cur ^ 1) * AT_KTB, lds + AT_V0 + (cur ^ 1) * AT_VTB); }
                __syncthreads();
            }
        }
        if constexpr (!DIFF) {
            const float inv = 1.f / (ls[0] + __shfl_xor(ls[0], 32));
            bf16_t* op = MIX + (size_t)(tok0 + q) * DM + h * 128 + 4 * hh;
#pragma unroll
            for (int db = 0; db < 4; ++db)
#pragma unroll
                for (int g = 0; g < 4; ++g) { u32x2 w; w.x = pk2(O[db][4 * g] * inv, O[db][4 * g + 1] * inv); w.y = pk2(O[db][4 * g + 2] * inv, O[db][4 * g + 3] * inv);
                    *(u32x2*)(op + db * 32 + 8 * g) = w; }
        } else {
            float ss = 0.f;
#pragma unroll
            for (int db = 0; db < 4; ++db)
#pragma unroll
                for (int i = 0; i < 16; ++i) ss += O[db][i] * O[db][i];
            ss += __shfl_xor(ss, 32);
            const float sc = rsqrtf(ss * (1.f / 128.f) + NORM_EPS) * (1.f - 0.35550906759096924f);
            const float* sg = P.in[I_SUBG];
            bf16_t* op = MIX + (size_t)(tok0 + q) * DM + 1024 + h * 128 + 4 * hh;
#pragma unroll
            for (int db = 0; db < 4; ++db)
#pragma unroll
                for (int g = 0; g < 4; ++g) { const f32x4 g4 = *(const f32x4*)(sg + db * 32 + 8 * g + 4 * hh);
                    u32x2 w; w.x = pk2(O[db][4 * g] * sc * g4.x, O[db][4 * g + 1] * sc * g4.y); w.y = pk2(O[db][4 * g + 2] * sc * g4.z, O[db][4 * g + 3] * sc * g4.w);
                    *(u32x2*)(op + db * 32 + 8 * g) = w; }
        }
    }
}

DI float diff_lambda(const Ctx& F, const Params& P) {
    const float la = wave_sum(P.in[I_LQ1][F.lane] * P.in[I_LK1][F.lane]), lb = wave_sum(P.in[I_LQ2][F.lane] * P.in[I_LK2][F.lane]);
    return __expf(la) - __expf(lb) + 0.35550906759096924f;
}
template <bool SAMPLE>
DI void attn_diff_phase(const Ctx& F, const Params& P, const float lam) {
    LAS unsigned char* lds = F.lds;
    const bf16_t* PA = (const bf16_t*)(P.ws + WS_RA);
    bf16_t* MIX = (bf16_t*)(P.ws + WS_HM);
    const bf16_t* VTp = (const bf16_t*)(P.ws + WS_VT); const bf16_t* VTs = (const bf16_t*)(P.ws + WS_VT + VT_S);
    const int q = F.lane & 31, hh = F.lane >> 5, mp = F.wave >> 2, qg = F.wave & 3;
    const float c1 = 0.125f * LOG2E;
    const int nunits = SAMPLE ? 1024 : 256;
    for (int u0 = F.bid; u0 < nunits; u0 += F.G) {
        int u = u0;
        if (SAMPLE && F.G == 256) { const int i = u0 >> 8, x = F.bid & 7, y = F.bid >> 3; u = ((2 * i + (y >> 4)) * 8 + x) * 16 + (y & 15); }
        int b, h, tok0; TileMap M;
        if (!SAMPLE) { b = u >> 3; h = u & 7; tok0 = b * 256 + qg * 64;
            M.latK = PA + (size_t)(b * 256) * 4096 + 2048 + h * 128; M.latKld = 4096; M.latV = VTp + (size_t)(b * 8 + h) * 128 * 256; M.latVld = 256; M.nlat = 4; M.ctxK = nullptr; M.ctxV = nullptr; M.ntiles = 4; }
        else { b = u >> 7; h = (u >> 4) & 7; tok0 = TP + b * 4096 + (u & 15) * 256 + qg * 64;
            M.latK = PA + (size_t)(TP + b * 4096) * 4096 + 2048 + h * 128; M.latKld = 4096; M.latV = VTs + (size_t)(b * 8 + h) * 128 * 4096; M.latVld = 4096; M.nlat = 64;
            M.ctxK = (const bf16_t*)(P.ws + WS_CDK) + (size_t)b * 256 * 1024 + h * 128; M.ctxV = (const bf16_t*)(P.ws + WS_CDVT) + (size_t)(b * 8 + h) * 128 * 256; M.ntiles = 68; }
        LAS unsigned char* qst = lds + 73728 + F.wave * 8192 + F.lane * 16;
#pragma unroll
        for (int sb = 0; sb < 2; ++sb) { const bf16_t* qptr = PA + (size_t)(tok0 + sb * 32 + q) * 4096 + 1024 + h * 128 + mp * 64;
#pragma unroll
            for (int ks = 0; ks < 4; ++ks) { const u32x4 w = *(const u32x4*)(qptr + ks * 16 + hh * 8);
                const u32x4 ws = (u32x4){pk2(bflo(w.x) * c1, bfhi(w.x) * c1), pk2(bflo(w.y) * c1, bfhi(w.y) * c1), pk2(bflo(w.z) * c1, bfhi(w.z) * c1), pk2(bflo(w.w) * c1, bfhi(w.w) * c1)};
                *(LAS u32x4*)(qst + (sb * 4 + ks) * 1024) = ws; } }
        f32x16 O[2][4]; float ls[2] = {0.f, 0.f};
#pragma unroll
        for (int sb = 0; sb < 2; ++sb)
#pragma unroll
            for (int db = 0; db < 4; ++db)
#pragma unroll
                for (int i = 0; i < 16; ++i) O[sb][db][i] = 0.f;
        const int nt = M.ntiles;
        TileRegs R;
        { const bf16_t* kp; const bf16_t* vp; int kld, vld; tile_src(M, 0, kp, kld, vp, vld); tile_load(F, R, kp, kld, vp, vld); }
        tile_store(F, R, lds + AT_K0, lds + AT_V0);
        __syncthreads();
#pragma unroll 1
        for (int j = 0; j < nt; ++j) {
            const int cur = j & 1;
            if (j + 1 < nt) { const bf16_t* kp; const bf16_t* vp; int kld, vld; tile_src(M, j + 1, kp, kld, vp, vld); tile_load(F, R, kp, kld, vp, vld); }
            LAS const unsigned char* kt = lds + AT_K0 + cur * AT_KTB; LAS const unsigned char* vt = lds + AT_V0 + cur * AT_VTB;
#pragma unroll 1
            for (int kb = 0; kb < 2; ++kb) {
                f32x16 S0, S1;
#pragma unroll
                for (int i = 0; i < 16; ++i) { S0[i] = 0.f; S1[i] = 0.f; }
#pragma unroll
                for (int ks = 0; ks < 4; ++ks) { const bf16x8 A = *(const LAS bf16x8*)(kt + (kb * 32 + q) * AT_KROW + ((mp * 4 + ks) * 16 + hh * 8) * 2);
                    S0 = __builtin_amdgcn_mfma_f32_32x32x16_bf16(A, *(const LAS bf16x8*)(qst + ks * 1024), S0, 0, 0, 0);
                    S1 = __builtin_amdgcn_mfma_f32_32x32x16_bf16(A, *(const LAS bf16x8*)(qst + (4 + ks) * 1024), S1, 0, 0, 0); }
                u32x4 pa[2], pb[2];
                { float l0 = 0.f, l1 = 0.f;
#pragma unroll
                for (int sp = 0; sp < 2; ++sp) { float e0[8], e1[8];
#pragma unroll
                    for (int i = 0; i < 8; ++i) { e0[i] = __builtin_amdgcn_exp2f(S0[8 * sp + i]); e1[i] = __builtin_amdgcn_exp2f(S1[8 * sp + i]); l0 += e0[i]; l1 += e1[i]; }
                    pa[sp] = (u32x4){pk2(e0[0], e0[1]), pk2(e0[2], e0[3]), pk2(e0[4], e0[5]), pk2(e0[6], e0[7])};
                    pb[sp] = (u32x4){pk2(e1[0], e1[1]), pk2(e1[2], e1[3]), pk2(e1[4], e1[5]), pk2(e1[6], e1[7])}; }
                ls[0] += l0; ls[1] += l1; }
#pragma unroll
                for (int sp = 0; sp < 2; ++sp) {
                    const bf16x8 Pa = __builtin_bit_cast(bf16x8, pa[sp]), Pb = __builtin_bit_cast(bf16x8, pb[sp]);
#pragma unroll
                    for (int db = 0; db < 4; ++db) {
                        LAS const unsigned char* ap = vt + (db * 32 + q) * AT_VROW + (kb * 32 + 16 * sp + 4 * hh) * 2;
                        const u32x2 lo = *(const LAS u32x2*)(ap), hi = *(const LAS u32x2*)(ap + 16);
                        const bf16x8 A2 = __builtin_bit_cast(bf16x8, (u32x4){lo.x, lo.y, hi.x, hi.y});
                        O[0][db] = __builtin_amdgcn_mfma_f32_32x32x16_bf16(A2, Pa, O[0][db], 0, 0, 0);
                        O[1][db] = __builtin_amdgcn_mfma_f32_32x32x16_bf16(A2, Pb, O[1][db], 0, 0, 0);
                    }
                    asm volatile("" ::: "memory");
                }
            }
            if (j + 1 < nt) tile_store(F, R, lds + AT_K0 + (cur ^ 1) * AT_KTB, lds + AT_V0 + (cur ^ 1) * AT_VTB);
            __syncthreads();
        }
        LAS float* xch = (LAS float*)lds + qg * 8192 + F.lane;
        float lt[2];
#pragma unroll
        for (int sb = 0; sb < 2; ++sb) lt[sb] = ls[sb] + __shfl_xor(ls[sb], 32);
        if (mp == 1) {
#pragma unroll
            for (int sb = 0; sb < 2; ++sb) { const float w1 = lam / lt[sb];
#pragma unroll
                for (int db = 0; db < 4; ++db)
#pragma unroll
                    for (int i = 0; i < 16; ++i) xch[((sb * 4 + db) * 16 + i) * 64] = O[sb][db][i] * w1; } }
        __syncthreads();
        if (mp == 0) {
            const float* sg = P.in[I_SUBG];
#pragma unroll
            for (int sb = 0; sb < 2; ++sb) { const float w0 = 1.f / lt[sb]; float ss = 0.f;
#pragma unroll
                for (int db = 0; db < 4; ++db)
#pragma unroll
                    for (int i = 0; i < 16; ++i) { const float o = O[sb][db][i] * w0 - xch[((sb * 4 + db) * 16 + i) * 64]; O[sb][db][i] = o; ss += o * o; }
                ss += __shfl_xor(ss, 32);
                const float sc = rsqrtf(ss * (1.f / 128.f) + NORM_EPS) * (1.f - 0.35550906759096924f);
                bf16_t* op = MIX + (size_t)(tok0 + sb * 32 + q) * DM + 1024 + h * 128 + 4 * hh;
#pragma unroll
                for (int db = 0; db < 4; ++db)
#pragma unroll
                    for (int g = 0; g < 4; ++g) { const f32x4 g4 = *(const f32x4*)(sg + db * 32 + 8 * g + 4 * hh);
                        u32x2 w; w.x = pk2(O[sb][db][4 * g] * sc * g4.x, O[sb][db][4 * g + 1] * sc * g4.y); w.y = pk2(O[sb][db][4 * g + 2] * sc * g4.z, O[sb][db][4 * g + 3] * sc * g4.w);
                        *(u32x2*)(op + db * 32 + 8 * g) = w; } } }
        __syncthreads();
    }
}
template <int L, int BATCH> struct HyCfg {
    static constexpr int NB = L / 64, TPT = 32 / BATCH, NTILES = NB / TPT, LOGB = (BATCH == 8) ? 3 : 5;
    static constexpr int ZROWB = (L + 384) * 2 + 16, ZBYTES = BATCH * ZROWB, RL = 2 * L + 16;
    static constexpr int TPW = (NTILES + 7) / 8;
};
constexpr int HY_KR_OFF = 71808;

template <int L, int BATCH>
DI void hyena_part(const Ctx& F, const Params& P, int c, int tokbase  , const bf16_t* KRG  ) {
    typedef HyCfg<L, BATCH> C;
    LAS unsigned char* lds = F.lds;
    bf16_t* CM = (bf16_t*)(P.ws + WS_RB);
    const float* hbias = P.in[I_HYBIAS];
    const int q = F.lane & 31, hh = F.lane >> 5;
    __syncthreads();
    for (int id = F.tid; id < BATCH * (L / 8); id += NTHR) { const int b = id / (L / 8), s8 = (id % (L / 8)) * 8;
        *(LAS u32x4*)(lds + b * C::ZROWB + (192 + s8) * 2) = *(const u32x4*)(CM + (size_t)c * TOK + tokbase + b * L + s8); }
    for (int id = F.tid; id < BATCH * 48; id += NTHR) { const int b = id / 48, k = id % 48, e = (k < 24) ? k * 8 : (192 + L + (k - 24) * 8);
        *(LAS u32x4*)(lds + b * C::ZROWB + e * 2) = (u32x4){0u, 0u, 0u, 0u}; }
#pragma unroll 1
    for (int o = 0; o < 2; ++o) {
        { const bf16_t* src = KRG + (size_t)(o * 1024 + c) * C::RL;
          for (int id = F.tid; id < C::RL / 8; id += NTHR) { const u32x4 v = *(const u32x4*)(src + id * 8);
              *(LAS u32x4*)(lds + HY_KR_OFF + id * 16) = v;
              LAS bf16_t* c1 = (LAS bf16_t*)(lds + HY_KR_OFF + C::RL * 2) + id * 8 - 1;
              if (id > 0) c1[0] = (bf16_t)(v.x & 0xffff);
              c1[1] = (bf16_t)(v.x >> 16); c1[2] = (bf16_t)(v.y & 0xffff); c1[3] = (bf16_t)(v.y >> 16); c1[4] = (bf16_t)(v.z & 0xffff); c1[5] = (bf16_t)(v.z >> 16);
              c1[6] = (bf16_t)(v.w & 0xffff); c1[7] = (bf16_t)(v.w >> 16); } }
        __syncthreads();
        f32x16 acc[C::TPW][2];
#pragma unroll
        for (int t = 0; t < C::TPW; ++t)
#pragma unroll
            for (int mt = 0; mt < 2; ++mt)
#pragma unroll
                for (int i = 0; i < 16; ++i) acc[t][mt][i] = 0.f;
        const int tq0 = F.wave * C::TPW;
        if (tq0 < C::NTILES) {
            const int d1lo = C::TPT * tq0 - (C::NB - 1), d1hi = C::TPT * (tq0 + C::TPW - 1) + C::TPT - 1;
            const int abase = HY_KR_OFF + (F.lane & 1) * (C::RL * 2) + (L - (F.lane & 31) + 8 * hh - (F.lane & 1)) * 2;
            bf16x8 W0[6], W1[6], B0[C::TPW][4];
#define HY_LDW(Wv, d1v, i) do { LAS const unsigned* ap_ = (LAS const unsigned*)(lds + abase + (-4 * (d1v) - 2 + (i)) * 32); Wv[i] = __builtin_bit_cast(bf16x8, (u32x4){ap_[0], ap_[1], ap_[2], ap_[3]}); } while (0)
#define HY_LDB(Bv, d1v) do { _Pragma("unroll") for (int t_ = 0; t_ < C::TPW; ++t_) { const int tq_ = tq0 + t_; \
            const int t1_ = C::TPT * tq_ + (q >> C::LOGB), b_ = q & (BATCH - 1); int s1_ = t1_ - (d1v); s1_ = min(max(s1_, -3), C::NB + 2); \
            LAS const unsigned char* bp_ = lds + b_ * C::ZROWB + (192 + 64 * s1_ + 8 * hh) * 2; \
            _Pragma("unroll") for (int ks_ = 0; ks_ < 4; ++ks_) Bv[t_][ks_] = *(const LAS bf16x8*)(bp_ + ks_ * 32); } } while (0)
#define HY_MM(Wv, Bv, d1v) do { _Pragma("unroll") for (int t_ = 0; t_ < C::TPW; ++t_) { const int tq_ = tq0 + t_; \
            if ((d1v) >= C::TPT * tq_ - (C::NB - 1) && (d1v) <= C::TPT * tq_ + C::TPT - 1) { \
                _Pragma("unroll") for (int ks_ = 0; ks_ < 4; ++ks_) _Pragma("unroll") for (int mt_ = 0; mt_ < 2; ++mt_) \
                    acc[t_][mt_] = __builtin_amdgcn_mfma_f32_32x32x16_bf16(Wv[ks_ - 2 * mt_ + 2], Bv[t_][ks_], acc[t_][mt_], 0, 0, 0); } } } while (0)
#pragma unroll
            for (int i = 0; i < 6; ++i) HY_LDW(W0, d1lo, i);
            int d1 = d1lo;
#pragma unroll 1
            for (; d1 + 1 <= d1hi; d1 += 2) {
                HY_LDB(B0, d1);
#pragma unroll
                for (int i = 0; i < 4; ++i) HY_LDW(W1, d1 + 1, i);
                W1[4] = W0[0]; W1[5] = W0[1];
                HY_MM(W0, B0, d1);
                HY_LDB(B0, d1 + 1);
                if (d1 + 2 <= d1hi) {
#pragma unroll
                    for (int i = 0; i < 4; ++i) HY_LDW(W0, d1 + 2, i);
                    W0[4] = W1[0]; W0[5] = W1[1];
                }
                HY_MM(W1, B0, d1 + 1);
            }
            if (d1 <= d1hi) { HY_LDB(B0, d1); HY_MM(W0, B0, d1); }
#undef HY_LDW
#undef HY_LDB
#undef HY_MM
        }
        __syncthreads();
        if (tq0 < C::NTILES) {
            const float bo = hbias[o * 1024 + c];
            const bf16_t* gate = CM + (size_t)((1 + o) * 1024 + c) * TOK + tokbase;
            bf16_t* zout = (bf16_t*)(P.ws + WS_RA + RA_ZC) + (size_t)c * TOK + tokbase;
#pragma unroll
            for (int t = 0; t < C::TPW; ++t) { const int tq = tq0 + t, t1 = C::TPT * tq + (q >> C::LOGB), b = q & (BATCH - 1);
#pragma unroll
                for (int mt = 0; mt < 2; ++mt)
#pragma unroll
                    for (int g = 0; g < 4; ++g) { const int s = 64 * t1 + 32 * mt + 8 * g + 4 * hh;
                        LAS u32x2* zp = (LAS u32x2*)(lds + b * C::ZROWB + (192 + s) * 2);
                        const u32x2 zv = *zp, gv = *(const u32x2*)(gate + (size_t)b * L + s);
                        const float r0 = bflo(gv.x) * (acc[t][mt][4 * g] + bflo(zv.x) * bo), r1 = bfhi(gv.x) * (acc[t][mt][4 * g + 1] + bfhi(zv.x) * bo);
                        const float r2 = bflo(gv.y) * (acc[t][mt][4 * g + 2] + bflo(zv.y) * bo), r3 = bfhi(gv.y) * (acc[t][mt][4 * g + 3] + bfhi(zv.y) * bo);
                        const u32x2 w = (u32x2){pk2(r0, r1), pk2(r2, r3)};
                        if (o == 0) *zp = w; else *(u32x2*)(zout + (size_t)b * L + s) = w; } }
        }
        __syncthreads();
    }
}

DI void hyena_phase(const Ctx& F, const Params& P) {
    for (int c = F.bid; c < 1024; c += F.G) {
        hyena_part<LS, 8>(F, P, c, TP, (const bf16_t*)(P.ws + WS_KRS));
        hyena_part<LP, 32>(F, P, c, 0, (const bf16_t*)(P.ws + WS_KRP));
    }
}

DI void hyena_post(const Ctx& F, const Params& P) {
    const bf16_t* CM = (const bf16_t*)(P.ws + WS_RA + RA_ZC); bf16_t* MIX = (bf16_t*)(P.ws + WS_HM);
    struct PostMap { const bf16_t* CM; bf16_t* MIX;
        DI TrJob operator()(int t) const { const int cg = t & 15, tg = t >> 4;
            return TrJob{CM + (size_t)(cg * 64) * TOK + tg * 64, (size_t)TOK, MIX + (size_t)(tg * 64) * DM + 1024 + cg * 64, (size_t)DM}; } };
    tr_pipeline_bf16(F, 16 * 640, PostMap{CM, MIX}, (LAS bf16_t*)F.lds);
}
constexpr int PC_ROPE = 118784;
DI void prep_c(const Ctx& F, const Params& P) {
    bf16_t* PA = (bf16_t*)(P.ws + WS_RA);
    LAS float* rope = (LAS float*)(F.lds + PC_ROPE);
    __syncthreads();
    for (int e = F.tid; e < 1024; e += NTHR) { const int pos = e >> 4, f = e & 15; const float inv = exp2f(-(float)f * (13.287712379549449f / 16.f)); const float a = (float)pos * inv;
        rope[e * 2] = cosf(a); rope[e * 2 + 1] = sinf(a); }
    __syncthreads();
    bf16_t* VTp = (bf16_t*)(P.ws + WS_VT); bf16_t* VTs = (bf16_t*)(P.ws + WS_VT + VT_S);
    { struct VtMap { const bf16_t* PA; bf16_t* VTp; bf16_t* VTs;
          DI TrJob operator()(int t) const {
              if (t < 2048) { const int bh = t >> 3, sub = t & 7, tk = sub >> 1, dd = sub & 1, b = bh >> 3, h = bh & 7;
                  return TrJob{PA + ((size_t)(b * 256 + tk * 64)) * 4096 + 3072 + h * 128 + dd * 64, 4096, VTp + ((size_t)bh * 128 + dd * 64) * 256 + tk * 64, 256}; }
              const int u = t - 2048, bh = u >> 7, sub = u & 127, tk = sub >> 1, dd = sub & 1, b = bh >> 3, h = bh & 7;
              return TrJob{PA + ((size_t)(TP + b * 4096 + tk * 64)) * 4096 + 3072 + h * 128 + dd * 64, 4096, VTs + ((size_t)bh * 128 + dd * 64) * 4096 + tk * 64, 4096}; } };
      tr_pipeline_bf16(F, 2048 + 8192, VtMap{PA, VTp, VTs}, (LAS bf16_t*)F.lds); }
    { float* o = P.out + O_DV;
      for (int e = F.bid * NTHR + F.tid; e < TP * 128; e += F.G * NTHR) { const int T = e >> 7, c8 = (e & 127) * 8;
          const u32x4 v = *(const u32x4*)(PA + (size_t)T * 4096 + 3072 + c8);
          *(f32x4*)(o + (size_t)T * 1024 + c8) = (f32x4){bflo(v.x), bfhi(v.x), bflo(v.y), bfhi(v.y)};
          *(f32x4*)(o + (size_t)T * 1024 + c8 + 4) = (f32x4){bflo(v.z), bfhi(v.z), bflo(v.w), bfhi(v.w)}; } }
}
DI void prep_c_tokens(const Ctx& F, const Params& P, int wv, int nw) {
    bf16_t* PA = (bf16_t*)(P.ws + WS_RA);
    const LAS float* rope = (const LAS float*)(F.lds + PC_ROPE);
    const float* gsrc = (F.lane < 32 ? P.in[I_DQG] : P.in[I_DKG]) + (F.lane & 1) * 32; float* ok = P.out + O_DK;
    float g[32];
#pragma unroll
    for (int i = 0; i < 32; ++i) g[i] = gsrc[i];
    for (int T = wv; T < TOK; T += nw) {
        bf16_t* rp = PA + (size_t)T * 4096 + 1024 + F.lane * 32;
        u32x4 v[4]; float x[32]; float ss = 0.f;
#pragma unroll
        for (int j = 0; j < 4; ++j) { v[j] = *(const u32x4*)(rp + j * 8);
            x[j * 8 + 0] = bflo(v[j].x); x[j * 8 + 1] = bfhi(v[j].x); x[j * 8 + 2] = bflo(v[j].y); x[j * 8 + 3] = bfhi(v[j].y);
            x[j * 8 + 4] = bflo(v[j].z); x[j * 8 + 5] = bfhi(v[j].z); x[j * 8 + 6] = bflo(v[j].w); x[j * 8 + 7] = bfhi(v[j].w); }
#pragma unroll
        for (int i = 0; i < 32; ++i) ss += x[i] * x[i];
        ss += dpp_xor1(ss);
        const float rstd = rsqrtf(ss * (1.f / 64.f) + NORM_EPS);
#pragma unroll
        for (int i = 0; i < 32; ++i) x[i] = x[i] * rstd * g[i];
        if (T < TP) { if (F.lane >= 32) { float* o = ok + (size_t)T * 1024 + (F.lane - 32) * 32;
#pragma unroll
                for (int j = 0; j < 8; ++j) *(f32x4*)(o + j * 4) = (f32x4){x[j * 4], x[j * 4 + 1], x[j * 4 + 2], x[j * 4 + 3]}; } }
        else { const int t = (T - TP) & 4095, pos = (F.lane & 1) ? (t & 63) : (t >> 6);
            const LAS float* rt = rope + pos * 32;
#pragma unroll
            for (int f = 0; f < 16; ++f) { const float cs = rt[2 * f], sn = rt[2 * f + 1], a = x[f], b = x[16 + f]; x[f] = a * cs - b * sn; x[16 + f] = b * cs + a * sn; } }
#pragma unroll
        for (int j = 0; j < 4; ++j) { u32x4 w; w.x = pk2(x[j * 8 + 0], x[j * 8 + 1]); w.y = pk2(x[j * 8 + 2], x[j * 8 + 3]); w.z = pk2(x[j * 8 + 4], x[j * 8 + 5]); w.w = pk2(x[j * 8 + 6], x[j * 8 + 7]);
            *(u32x4*)(rp + j * 8) = w; }
    }
}

constexpr int S5_BROW = 80, S5_BUB = 128 * S5_BROW, S5_HROW = 272, S5_WLDS = S5_BUB + 16 * S5_HROW;
DI void s5_chain(const Ctx& F, const Params& P, int dg, int tok0, int L, const float* h0re, const float* h0im, float* fre, float* fim, bf16_t* Yout) {
    LAS unsigned char* wl = F.lds + F.wave * S5_WLDS; LAS unsigned char* hl = wl + S5_BUB;
    const int g = dg & 63, dir = dg >> 6, lane = F.lane, st = lane & 15, gq = lane >> 4;
    const float* S5A = (const float*)(P.ws + WS_S5A); const bf16_t* BB = (const bf16_t*)(P.ws + WS_S5BB); const bf16_t* CC = (const bf16_t*)(P.ws + WS_S5CC);
    const bf16_t* PA = (const bf16_t*)(P.ws + WS_RA);
    const float ar = S5A[(dg * 64 + lane) * 2], ai = S5A[(dg * 64 + lane) * 2 + 1];
    float hr = h0re ? h0re[lane] : 0.f, hi = h0im ? h0im[lane] : 0.f;
    const bf16x8 zero8 = (bf16x8){0, 0, 0, 0, 0, 0, 0, 0};
    bf16x8 BBf[8], CCf[4];
#pragma unroll
    for (int mt = 0; mt < 8; ++mt) BBf[mt] = (gq < 2) ? *(const bf16x8*)(BB + ((size_t)dg * 128 + mt * 16 + st) * 16 + gq * 8) : zero8;
#pragma unroll
    for (int kk = 0; kk < 4; ++kk) CCf[kk] = *(const bf16x8*)(CC + ((size_t)dg * 16 + st) * 128 + kk * 32 + gq * 8);
    const int nch = L / 16;
    const int sgn = dir ? -1 : 1, tstart = dir ? tok0 + L - 1 : tok0;
    const bf16_t* ubase = PA + (size_t)tstart * 4096 + g * 16 + gq * 8;
    const long ustep = (long)sgn * 4096;
#define S5_LDU(c_) (((c_) < nch && gq < 2) ? *(const bf16x8*)(ubase + ustep * ((c_) * 16 + st)) : zero8)
#define S5_BU(Uv) do { _Pragma("unroll") for (int mt = 0; mt < 8; ++mt) { f32x4 d_ = (f32x4){0.f, 0.f, 0.f, 0.f}; \
        d_ = __builtin_amdgcn_mfma_f32_16x16x32_bf16(Uv, BBf[mt], d_, 0, 0, 0); *(LAS f32x4*)(wl + (mt * 16 + st) * S5_BROW + gq * 16) = d_; } } while (0)
#define S5_Y(c_) do { f32x4 y_ = (f32x4){0.f, 0.f, 0.f, 0.f}; \
        _Pragma("unroll") for (int kk = 0; kk < 4; ++kk) y_ = __builtin_amdgcn_mfma_f32_16x16x32_bf16(CCf[kk], Bh[kk], y_, 0, 0, 0);        \
        *(u32x2*)(Yout + (size_t)(tstart + sgn * ((c_) * 16 + st)) * 1024 + g * 16 + gq * 4) = (u32x2){pk2(y_[0], y_[1]), pk2(y_[2], y_[3])}; } while (0)
#define S5_ITER(DOY) do { \
        f32x4 br_[4], bi_[4]; \
        _Pragma("unroll") for (int j = 0; j < 4; ++j) { br_[j] = *(const LAS f32x4*)(wl + lane * S5_BROW + j * 16); bi_[j] = *(const LAS f32x4*)(wl + (64 + lane) * S5_BROW + j * 16); } \
        bf16x8 Bh[4]; \
        if (DOY) { _Pragma("unroll") for (int kk = 0; kk < 4; ++kk) Bh[kk] = *(const LAS bf16x8*)(hl + st * S5_HROW + (kk * 32 + gq * 8) * 2); } \
        const bf16x8 Un_ = S5_LDU(ch + 4); \
        S5_BU(Ua); \
        _Pragma("unroll") for (int s = 0; s < 16; ++s) { const float bur = br_[s >> 2][s & 3], bui = bi_[s >> 2][s & 3]; \
            float t0_ = __builtin_fmaf(-ai, hi, bur), t1_ = __builtin_fmaf(ai, hr, bui); \
            asm volatile("" : "+v"(t0_), "+v"(t1_));                       \
            const float nr = __builtin_fmaf(ar, hr, t0_), ni = __builtin_fmaf(ar, hi, t1_); hr = nr; hi = ni; \
            asm volatile("" : "+v"(hr), "+v"(hi)); \
            const unsigned hw_ = pk2(hr, hi); \
            *(LAS bf16_t*)(hl + s * S5_HROW + lane * 2) = (bf16_t)(hw_ & 0xffffu); *(LAS bf16_t*)(hl + s * S5_HROW + (64 + lane) * 2) = (bf16_t)(hw_ >> 16); } \
        if (DOY) S5_Y(ch - 1); \
        Ua = Ub; Ub = Uc; Uc = Un_; } while (0)
    bf16x8 Ua = S5_LDU(0), Ub = S5_LDU(1), Uc = S5_LDU(2);
    S5_BU(Ua);
    Ua = Ub; Ub = Uc; Uc = S5_LDU(3);
    int ch = 0;
    S5_ITER(false);
#pragma unroll 1
    for (ch = 1; ch < nch; ++ch) S5_ITER(true);
    { bf16x8 Bh[4];
#pragma unroll
      for (int kk = 0; kk < 4; ++kk) Bh[kk] = *(const LAS bf16x8*)(hl + st * S5_HROW + (kk * 32 + gq * 8) * 2);
      S5_Y(nch - 1); }
#undef S5_LDU
#undef S5_BU
#undef S5_Y
#undef S5_ITER
    if (fre) { fre[lane] = hr; fim[lane] = hi; }
}

DI void s5_phase(const Ctx& F, const Params& P) {
    bf16_t* YF = (bf16_t*)(P.ws + WS_RB + RB_YF); bf16_t* YB = (bf16_t*)(P.ws + WS_RB + RB_YB);
    for (int cs = F.bid; cs < 256; cs += F.G) {
        if (F.wave < 4) { const int sc = cs * 4 + F.wave, dg = sc & 127, b = sc >> 7;
            s5_chain(F, P, dg, TP + b * 4096, LS, P.in[I_S5RE] + (size_t)sc * 64, P.in[I_S5IM] + (size_t)sc * 64, nullptr, nullptr, (dg >> 6) ? YB : YF); }
        else { for (int k = 0; k < 4; ++k) { const int pc = (cs * 4 + (F.wave - 4)) * 4 + k, dg = pc & 127, b = pc >> 7;
            s5_chain(F, P, dg, b * 256, LP, nullptr, nullptr, P.out + O_SR + (size_t)pc * 64, P.out + O_SI + (size_t)pc * 64, (dg >> 6) ? YB : YF); } }
    }
    if (F.wave >= 4) prep_c_tokens(F, P, F.bid * 4 + (F.wave - 4), F.G * 4);
}

DI void s5_combine(const Ctx& F, const Params& P) {
    const bf16_t* PA = (const bf16_t*)(P.ws + WS_RA); const bf16_t* YF = (const bf16_t*)(P.ws + WS_RB + RB_YF); const bf16_t* YB = (const bf16_t*)(P.ws + WS_RB + RB_YB);
    bf16_t* Y = (bf16_t*)(P.ws + WS_RB + RB_Y); const float* dsk = P.in[I_S5D];
    for (size_t e = (size_t)F.bid * NTHR + F.tid; e < (size_t)TOK * 128; e += (size_t)F.G * NTHR) { const size_t T = e >> 7; const int c8 = (int)(e & 127) * 8;
        const u32x4 uv = *(const u32x4*)(PA + T * 4096 + c8), fv = *(const u32x4*)(YF + T * 1024 + c8), bv = *(const u32x4*)(YB + T * 1024 + c8);
        const f32x4 d0 = *(const f32x4*)(dsk + c8), d1 = *(const f32x4*)(dsk + c8 + 4);
        float o[8];
        o[0] = gelu_tanh(d0.x * bflo(uv.x) + bflo(fv.x) + bflo(bv.x)); o[1] = gelu_tanh(d0.y * bfhi(uv.x) + bfhi(fv.x) + bfhi(bv.x));
        o[2] = gelu_tanh(d0.z * bflo(uv.y) + bflo(fv.y) + bflo(bv.y)); o[3] = gelu_tanh(d0.w * bfhi(uv.y) + bfhi(fv.y) + bfhi(bv.y));
        o[4] = gelu_tanh(d1.x * bflo(uv.z) + bflo(fv.z) + bflo(bv.z)); o[5] = gelu_tanh(d1.y * bfhi(uv.z) + bfhi(fv.z) + bfhi(bv.z));
        o[6] = gelu_tanh(d1.z * bflo(uv.w) + bflo(fv.w) + bflo(bv.w)); o[7] = gelu_tanh(d1.w * bfhi(uv.w) + bfhi(fv.w) + bfhi(bv.w));
        u32x4 w; w.x = pk2(o[0], o[1]); w.y = pk2(o[2], o[3]); w.z = pk2(o[4], o[5]); w.w = pk2(o[6], o[7]);
        *(u32x4*)(Y + T * 1024 + c8) = w; }
}
constexpr int PS_KROW = 272;
constexpr int PS_IDX_OFF = 2 * 128 * PS_KROW;
constexpr int PS_TAB_OFF = PS_IDX_OFF + 512 * 32;

DI void topk_insert(float (&a)[16], float x) {
#pragma unroll
    for (int j = 15; j >= 1; --j) a[j] = __builtin_amdgcn_fmed3f(a[j - 1], a[j], x);
    a[0] = fmaxf(a[0], x);
}

DI void peer_select(const Ctx& F, const Params& P, int layer) {
    LAS unsigned char* lds = F.lds;
    const bf16_t* Q = (const bf16_t*)(P.ws + WS_RA + RA_Q);
    int* SELI = (int*)(P.ws + WS_RA + RA_SELI); float* SELW = (float*)(P.ws + WS_RA + RA_SELW);
    const bf16_t* KEYS = (const bf16_t*)(P.ws + WS_PKEYS) + (size_t)layer * 8 * 2 * 128 * 128;
    const int q = F.lane & 31, hh = F.lane >> 5;
    LAS unsigned char* myidx = lds + PS_IDX_OFF + F.tid * 32;
    LAS unsigned char* tab = lds + PS_TAB_OFF;
    for (int wu = F.bid; wu < 256; wu += F.G) {
        const int h = wu & 7, chunk = wu >> 3;
        __syncthreads();
        for (int id = F.tid; id < 2 * 128 * 16; id += NTHR) { const int row = id >> 4, c16 = id & 15;
            *(LAS u32x4*)(lds + row * PS_KROW + c16 * 16) = *(const u32x4*)(KEYS + ((size_t)h * 256 + row) * 128 + c16 * 8); }
        if (F.tid < 16) { int cnt = 0;
            for (int a = 0; a < F.tid; ++a) cnt += 16 / (a + 1);
            for (int b = 0; b < 16 / (F.tid + 1); ++b) { tab[(cnt + b) * 2] = (unsigned char)F.tid; tab[(cnt + b) * 2 + 1] = (unsigned char)b; } }
        __syncthreads();
        for (int blk = F.wave; blk < 40; blk += 8) {
            const int T0 = chunk * 1280 + blk * 32;
            float lst[2][16];
#pragma unroll
            for (int side = 0; side < 2; ++side) {
                bf16x8 Qf[8];
                const bf16_t* qp = Q + (size_t)(T0 + q) * 2048 + h * 256 + side * 128 + hh * 8;
#pragma unroll
                for (int ks = 0; ks < 8; ++ks) Qf[ks] = *(const bf16x8*)(qp + ks * 16);
                float a[16];
#pragma unroll
                for (int j = 0; j < 16; ++j) a[j] = -3.0e38f;
#pragma unroll
                for (int nt = 0; nt < 4; ++nt) {
                    f32x16 S;
#pragma unroll
                    for (int i = 0; i < 16; ++i) S[i] = 0.f;
#pragma unroll
                    for (int ks = 0; ks < 8; ++ks) { const bf16x8 A = *(const LAS bf16x8*)(lds + (side * 128 + nt * 32 + q) * PS_KROW + (ks * 16 + hh * 8) * 2);
                        S = __builtin_amdgcn_mfma_f32_32x32x16_bf16(A, Qf[ks], S, 0, 0, 0); }
#pragma unroll
                    for (int i = 0; i < 16; ++i) { const int n = nt * 32 + (i & 3) + 8 * (i >> 2) + 4 * hh;
                        topk_insert(a, __uint_as_float((__float_as_uint(S[i]) & 0xffffff80u) | (unsigned)n)); }
                }
                float pb[16];
#pragma unroll
                for (int j = 0; j < 16; ++j) pb[j] = __shfl_xor(a[j], 32);
#pragma unroll
                for (int j = 0; j < 16; ++j) topk_insert(a, pb[j]);
#pragma unroll
                for (int j = 0; j < 16; ++j) { lst[side][j] = a[j]; myidx[side * 16 + j] = (unsigned char)(__float_as_uint(a[j]) & 0x7fu); }
            }
            float cb[16];
#pragma unroll
            for (int j = 0; j < 16; ++j) cb[j] = -3.0e38f;
            { int cid = 0;
#pragma unroll
              for (int a = 0; a < 16; ++a)
#pragma unroll
                  for (int b = 0; b < 16 / (a + 1); ++b) {
                      const float sa = __uint_as_float(__float_as_uint(lst[0][a]) & 0xffffff80u), sb = __uint_as_float(__float_as_uint(lst[1][b]) & 0xffffff80u);
                      topk_insert(cb, __uint_as_float((__float_as_uint(sa + sb) & 0xffffffc0u) | (unsigned)cid)); ++cid; } }
            const float mx = __uint_as_float(__float_as_uint(cb[0]) & 0xffffffc0u);
            float e[16], den = 0.f;
#pragma unroll
            for (int j = 0; j < 16; ++j) { e[j] = __expf(__uint_as_float(__float_as_uint(cb[j]) & 0xffffffc0u) - mx); den += e[j]; }
            const float rden = 1.f / den;
#pragma unroll
            for (int j = 0; j < 16; ++j) {
                if ((j >> 3) == hh) { const int cid = (int)(__float_as_uint(cb[j]) & 0x3fu);
                    const int a = tab[cid * 2], b = tab[cid * 2 + 1];
                    const int eidx = (int)myidx[a] * 128 + (int)myidx[16 + b];
                    SELI[(size_t)(T0 + q) * 128 + h * 16 + j] = eidx; SELW[(size_t)(T0 + q) * 128 + h * 16 + j] = e[j] * rden; }
            }
        }
    }
    __syncthreads();
}

DI u32x16 fp6_unpack_bf16(u32x4 a, u32x2 b) { const u32x6 pk = {a.x, a.y, a.z, a.w, b.x, b.y}; return __builtin_bit_cast(u32x16, __builtin_amdgcn_cvt_scalef32_pk32_bf16_fp6(pk, 1.0f)); }
DI f32x32 fp6_unpack(u32x4 a, u32x2 b) { const u32x6 pk = {a.x, a.y, a.z, a.w, b.x, b.y}; return __builtin_amdgcn_cvt_scalef32_pk32_f32_fp6(pk, 1.0f); }
constexpr int GN = 4;
template <bool NEXTNORM>
DI void peer_gather(const Ctx& F, const Params& P, const float* modl, int layer, const float* ngain, const float* nmodl) {
    const bf16_t* H2 = (const bf16_t*)(P.ws + WS_HM);
    const unsigned char* TU = P.ws + WS_TBLU + (size_t)layer * 16384 * PT_ROWB; const unsigned char* TV = P.ws + WS_TBLV + (size_t)layer * 16384 * PT_ROWB;
    const float* SCU = (const float*)(P.ws + WS_SC) + layer * 16384; const float* SCV = (const float*)(P.ws + WS_SC) + (2 + layer) * 16384;
    const int* SELI = (const int*)(P.ws + WS_RA + RA_SELI); const float* SELW = (const float*)(P.ws + WS_RA + RA_SELW);
    float* X = P.out + O_Y;
    const int lane = lane_id();
    const int stride = F.G * 8;
    for (int T0 = F.bid * 8 + F.wave; T0 < TOK; T0 += 2 * stride) {
        const bool two = (T0 + stride < TOK);
        const int Tt[2] = {T0, two ? T0 + stride : T0};
        u32x4 xw[2][4]; int e0[2], e1[2]; float g0[2], g1[2], d0[2], d1[2];
#pragma unroll
        for (int t = 0; t < 2; ++t) {
#pragma unroll
            for (int q4 = 0; q4 < 4; ++q4) xw[t][q4] = *(const u32x4*)(H2 + (size_t)Tt[t] * DM + lane * 32 + q4 * 8);
            e0[t] = SELI[(size_t)Tt[t] * 128 + lane]; e1[t] = SELI[(size_t)Tt[t] * 128 + 64 + lane];
            g0[t] = SELW[(size_t)Tt[t] * 128 + lane]; g1[t] = SELW[(size_t)Tt[t] * 128 + 64 + lane]; d0[t] = 0.f; d1[t] = 0.f; }
#pragma unroll 1
        for (int kb = 0; kb < 128; kb += GN) {
            u32x4 ura[2][GN]; u32x2 urb[2][GN];
#pragma unroll
            for (int j = 0; j < GN; ++j)
#pragma unroll
                for (int t = 0; t < 2; ++t) { const int k = kb + j; const int e = __builtin_amdgcn_readlane(k < 64 ? e0[t] : e1[t], k & 63);
                    const unsigned char* up = TU + (size_t)e * PT_ROWB;
                    ura[t][j] = *(const u32x4*)(up + lane * 16); urb[t][j] = *(const u32x2*)(up + 1024 + lane * 8); }
#pragma unroll
            for (int j = 0; j < GN; ++j) { float pt[2];
#pragma unroll
                for (int t = 0; t < 2; ++t) { const u32x16 r = fp6_unpack_bf16(ura[t][j], urb[t][j]);
                    float sa = 0.f, sb = 0.f, sc2 = 0.f, sd = 0.f;
#pragma unroll
                    for (int i = 0; i < 4; ++i) { const unsigned x0 = xw[t][i].x, x1 = xw[t][i].y, x2 = xw[t][i].z, x3 = xw[t][i].w;
                        sa = dot2bf(r[4 * i], x0, sa); sb = dot2bf(r[4 * i + 1], x1, sb); sc2 = dot2bf(r[4 * i + 2], x2, sc2); sd = dot2bf(r[4 * i + 3], x3, sd); }
                    pt[t] = (sa + sb) + (sc2 + sd); }
                const float sm0 = wave_sum(pt[0]), sm1 = wave_sum(pt[1]); const int k = kb + j;
                if (k < 64) { if (lane == k) { d0[0] = sm0; d0[1] = sm1; } } else { if (lane == k - 64) { d1[0] = sm0; d1[1] = sm1; } } }
        }
        float cf0[2], cf1[2];
#pragma unroll
        for (int t = 0; t < 2; ++t) { cf0[t] = g0[t] * gelu_tanh(d0[t] * SCU[e0[t]]) * SCV[e0[t]]; cf1[t] = g1[t] * gelu_tanh(d1[t] * SCU[e1[t]]) * SCV[e1[t]]; }
        f32x2 acc[2][16];
#pragma unroll
        for (int t = 0; t < 2; ++t)
#pragma unroll
            for (int i = 0; i < 16; ++i) acc[t][i] = (f32x2){0.f, 0.f};
#pragma unroll 1
        for (int kb = 0; kb < 128; kb += GN) {
            u32x4 vra[2][GN]; u32x2 vrb[2][GN]; float cf[2][GN];
#pragma unroll
            for (int j = 0; j < GN; ++j)
#pragma unroll
                for (int t = 0; t < 2; ++t) { const int k = kb + j; const int e = __builtin_amdgcn_readlane(k < 64 ? e0[t] : e1[t], k & 63);
                    cf[t][j] = __builtin_bit_cast(float, __builtin_amdgcn_readlane(__builtin_bit_cast(int, k < 64 ? cf0[t] : cf1[t]), k & 63));
                    const unsigned char* vp = TV + (size_t)e * PT_ROWB;
                    vra[t][j] = *(const u32x4*)(vp + lane * 16); vrb[t][j] = *(const u32x2*)(vp + 1024 + lane * 8); }
#pragma unroll
            for (int j = 0; j < GN; ++j)
#pragma unroll
                for (int t = 0; t < 2; ++t) { const f32x32 r = fp6_unpack(vra[t][j], vrb[t][j]);
                    const f32x2 c2 = (f32x2){cf[t][j], cf[t][j]};
#pragma unroll
                    for (int i = 0; i < 16; ++i) acc[t][i] += c2 * (f32x2){r[2 * i], r[2 * i + 1]}; }
        }
#pragma unroll
        for (int t = 0; t < 2; ++t) {
            if (t == 1 && !two) break;
            const int T = Tt[t];
            const float* gate = modl + (size_t)(cond_of(T) * 6 + 5) * DM;
            f32x4 xn[8]; float ss = 0.f;
#pragma unroll
            for (int q4 = 0; q4 < 8; ++q4) { const int col = lane * 32 + q4 * 4; float* xp = X + (size_t)T * DM + col;
                const f32x4 gv = *(const f32x4*)(gate + col), x0 = *(const f32x4*)(xp);
                const f32x4 r = x0 + gv * (f32x4){acc[t][q4 * 2].x, acc[t][q4 * 2].y, acc[t][q4 * 2 + 1].x, acc[t][q4 * 2 + 1].y};
                *(f32x4*)(xp) = r; xn[q4] = r; ss += r.x * r.x + r.y * r.y + r.z * r.z + r.w * r.w; }
            if (NEXTNORM) {
                ss = wave_sum(ss);
                const float rstd = rsqrtf(ss * (1.f / DM) + NORM_EPS);
                const float* sh = nmodl + (size_t)(cond_of(T) * 6 + 0) * DM; const float* sc = sh + DM;
                bf16_t* H = (bf16_t*)(P.ws + WS_HM);
#pragma unroll
                for (int q4 = 0; q4 < 8; ++q4) { const int col = lane * 32 + q4 * 4;
                    const f32x4 g4 = *(const f32x4*)(ngain + col), s4 = *(const f32x4*)(sc + col), h4 = *(const f32x4*)(sh + col);
                    const f32x4 o = xn[q4] * rstd * g4 * (s4 + 1.f) + h4;
                    *(u32x2*)(H + (size_t)T * DM + col) = (u32x2){pk2(o.x, o.y), pk2(o.z, o.w)}; }
            }
        }
    }
}
constexpr int NPHASE = 22;

__global__ void __launch_bounds__(NTHR, 2) mega(Params P) {
    extern __shared__ __attribute__((aligned(16))) unsigned char lds_raw[];
    Ctx F;
    F.lds = (LAS unsigned char*)lds_raw; F.tid = threadIdx.x; F.lane = F.tid & 63; F.wave = __builtin_amdgcn_readfirstlane(F.tid >> 6); F.G = gridDim.x; F.bid = blockIdx.x;
    const int lo = P.ph_lo, hi = P.ph_hi;
    volatile LAS unsigned* xbw = (volatile LAS unsigned*)(F.lds + LDS_BYTES - 16);
    if (F.tid == 0) { xbw[0] = 0u; xbw[1] = 0u; xbw[2] = 0u; xbw[3] = 0u; }
    __syncthreads();
    if (hi - lo > 1) (void)xcd_barrier_post((unsigned*)(P.ws + WS_CTL), xbw);
#define GRID_BARRIER() do { XcdBarrier bar_; bar_.bar = (unsigned*)(P.ws + WS_CTL); bar_.x = xb_xcc_id(); bar_.st = (volatile LAS unsigned*)(F.lds + LDS_BYTES - 16); xcd_barrier(bar_); } while (0)
#define PH(k, ...) if (lo <= (k) && (k) < hi) { { __VA_ARGS__ } if ((k) + 1 < hi) GRID_BARRIER(); }
#define MOD0 ((const float*)(P.ws + WS_MOD))
#define MOD1 ((const float*)(P.ws + WS_MOD) + 9 * 12288)
#define HM ((bf16_t*)(P.ws + WS_HM))
#define RA ((bf16_t*)(P.ws + WS_RA))
#define X (P.out + O_Y)

    PH(0, prologue(F, P);)
    PH(1, adaln_reduce(F, P);)
    PH(2, norm_phase(F, P.in[I_XP], P.in[I_XS], P.in[I_NMIXG], MOD0, 0, HM);)
    PH(3, { EpiBf16 E{RA, 4096}; run_gemm(F, HM, (const bf16_t*)(P.ws + WS_WEVIN) + (size_t)2048 * 2048, 4096, 2048, E); })
    PH(4, prep_a(F, P);)
    PH(5, { EpiBf16 E{RA, 2048}; run_gemm(F, HM, (const bf16_t*)(P.ws + WS_WEVIN), 2048, 2048, E); })
    PH(6, attn_phase<0>(F, P); attn_phase<1>(F, P); hyena_phase(F, P);)
    PH(7, hyena_post(F, P);)
    PH(8, { EpiResid E{P.in[I_XP], P.in[I_XS], X, MOD0, 2}; run_gemm(F, HM, (const bf16_t*)(P.ws + WS_WEVOUT), 2048, 2048, E); })
    PH(9, norm_phase(F, X, X + (size_t)TP * DM, P.in[I_NFFNG], MOD0, 3, HM);)
    PH(10, { EpiBf16 E{RA, 2048}; run_gemm(F, HM, (const bf16_t*)(P.ws + WS_WPQ), 2048, 2048, E); })
    PH(11, peer_select(F, P, 0);)
    PH(12, peer_gather<true>(F, P, MOD0, 0, P.in[I_NMIXG] + DM, MOD1);)
    PH(13, { EpiBf16 E{RA, 4096}; run_gemm(F, HM, (const bf16_t*)(P.ws + WS_WODIN), 4096, 2048, E); })
    PH(14, prep_c(F, P); s5_phase(F, P);)
    PH(15, { const float lam = diff_lambda(F, P); attn_diff_phase<false>(F, P, lam); attn_diff_phase<true>(F, P, lam); } s5_combine(F, P);)
    PH(16, { EpiGlu E{(const bf16_t*)(P.ws + WS_RB + RB_Y), HM, P.in[I_GLUB]}; run_gemm(F, (const bf16_t*)(P.ws + WS_RB + RB_Y), (const bf16_t*)(P.ws + WS_WGLU), 1024, 1024, E); })
    PH(17, { EpiResid E{X, X + (size_t)TP * DM, X, MOD1, 2}; run_gemm(F, HM, (const bf16_t*)(P.ws + WS_WODOUT), 2048, 2048, E); })
    PH(18, norm_phase(F, X, X + (size_t)TP * DM, P.in[I_NFFNG] + DM, MOD1, 3, HM);)
    PH(19, { EpiBf16 E{RA, 2048}; run_gemm(F, HM, (const bf16_t*)(P.ws + WS_WPQ) + (size_t)2048 * 2048, 2048, 2048, E); })
    PH(20, peer_select(F, P, 1);)
    PH(21, peer_gather<false>(F, P, MOD1, 1, nullptr, nullptr);)
#undef MOD0
#undef MOD1
#undef HM
#undef RA
#undef X
#undef PH
#undef GRID_BARRIER
}

extern "C" void kernel_launch(void* const* d_in, const int* in_sizes, int n_in, void* d_out, int out_size, void* d_ws, size_t ws_size, hipStream_t stream) {
    static int grid = 0;
    if (grid == 0) {
        if (n_in != N_IN || (size_t)out_size != O_END || ws_size < WS_END) { fprintf(stderr, "kernel_launch: unexpected shapes (n_in %d, out %d, ws %zu, need %zu)\n", n_in, out_size, ws_size, (size_t)WS_END); grid = -1; return; }
        int dev = 0, cus = 0;
        if (hipGetDevice(&dev) != hipSuccess || hipDeviceGetAttribute(&cus, hipDeviceAttributeMultiprocessorCount, dev) != hipSuccess) { grid = -1; return; }
        if (hipFuncSetAttribute((const void*)mega, hipFuncAttributeMaxDynamicSharedMemorySize, LDS_BYTES) != hipSuccess) { fprintf(stderr, "kernel_launch: hipFuncSetAttribute failed\n"); grid = -1; return; }
        int per_cu = 0;
        if (hipOccupancyMaxActiveBlocksPerMultiprocessor(&per_cu, (const void*)mega, NTHR, LDS_BYTES) != hipSuccess || per_cu < 1) { fprintf(stderr, "kernel_launch: occupancy query says %d blocks per CU\n", per_cu); }
        (void)hipGetLastError();
        grid = cus;
    }
    if (grid < 0) return;
    (void)hipMemsetAsync((char*)d_ws + WS_CTL, 0, 65536, stream);
    Params p; memset(&p, 0, sizeof(p));
    for (int i = 0; i < N_IN; ++i) p.in[i] = (const float*)d_in[i];
    p.out = (float*)d_out; p.ws = (unsigned char*)d_ws;
    p.ph_lo = 0; p.ph_hi = NPHASE;
    hipLaunchKernelGGL(mega, dim3(grid), dim3(NTHR), LDS_BYTES, stream, p);
}
```

```cpp
#include <hip/hip_runtime.h>
#include <cstdio>
#include <cstring>
#include <cstdint>

typedef unsigned short bf16_t;
typedef short bf16x8 __attribute__((ext_vector_type(8)));
typedef short s16x4 __attribute__((ext_vector_type(4)));
typedef float f32x2 __attribute__((ext_vector_type(2)));
typedef float f32x4 __attribute__((ext_vector_type(4)));
typedef float f32x16 __attribute__((ext_vector_type(16)));
typedef unsigned u32x2 __attribute__((ext_vector_type(2)));
typedef unsigned u32x4 __attribute__((ext_vector_type(4)));
typedef __bf16 bf16x2_t __attribute__((ext_vector_type(2)));
typedef float f32x32 __attribute__((ext_vector_type(32)));
typedef unsigned u32x6 __attribute__((ext_vector_type(6)));
typedef unsigned u32x16 __attribute__((ext_vector_type(16)));
typedef __bf16 bf16x32_t __attribute__((ext_vector_type(32)));

#define DI __device__ __forceinline__

constexpr int NTHR = 512;
constexpr int DM = 2048;
constexpr int TP = 8192;
constexpr int TS = 32768;
constexpr int TOK = TP + TS;
constexpr int LP = 256, LS = 4096;
constexpr float NORM_EPS = 1e-6f;
constexpr float LOG2E = 1.4426950408889634f;

enum { I_XP = 0, I_XS, I_C, I_CNK, I_CNV, I_CDK, I_CDV, I_S5RE, I_S5IM, I_CCTX, I_MODW, I_MODB, I_NMIXG, I_NFFNG, I_EVWIN, I_EVWOUT, I_NAQG, I_NAKG, I_RPB,
       I_HYCW, I_HYCB, I_HYW1, I_HYB1, I_HYF1, I_HYW2, I_HYB2, I_HYF2, I_HYW3, I_HYDEC, I_HYBIAS, I_ODWIN, I_ODWOUT, I_S5LRE, I_S5LIM, I_S5LDT, I_S5BRE, I_S5BIM,
       I_S5CRE, I_S5CIM, I_S5D, I_GLUW, I_GLUB, I_DQG, I_DKG, I_LQ1, I_LK1, I_LQ2, I_LK2, I_SUBG, I_PWQ, I_PKEYS, I_PU, I_PV, N_IN };

constexpr size_t O_Y = 0;
constexpr size_t O_NAK = 83886080, O_NAV = 92274688, O_DK = 100663296, O_DV = 109051904, O_SR = 117440512, O_SI = 117702656, O_END = 117964800;

constexpr size_t al256(size_t x) { return (x + 255) & ~(size_t)255; }
constexpr size_t WS_CTL = 0;
constexpr size_t WS_MODP = 65536;
constexpr size_t WS_MOD = WS_MODP + (size_t)2 * 16 * 9 * 12288 * 4;
constexpr size_t WS_WEVIN = al256(WS_MOD + (size_t)2 * 9 * 12288 * 4);
constexpr size_t WS_WEVOUT = WS_WEVIN + (size_t)6144 * 2048 * 2;
constexpr size_t WS_WODIN = WS_WEVOUT + (size_t)2048 * 2048 * 2;
constexpr size_t WS_WODOUT = WS_WODIN + (size_t)4096 * 2048 * 2;
constexpr size_t WS_WPQ = WS_WODOUT + (size_t)2048 * 2048 * 2;
constexpr size_t WS_WGLU = WS_WPQ + (size_t)2 * 2048 * 2048 * 2;
constexpr size_t WS_PKEYS = WS_WGLU + (size_t)1024 * 1024 * 2;
constexpr size_t WS_CNK = WS_PKEYS + (size_t)2 * 8 * 2 * 128 * 128 * 2;
constexpr size_t WS_CNVT = WS_CNK + (size_t)8 * 256 * 1024 * 2;
constexpr size_t WS_CDK = WS_CNVT + (size_t)8 * 256 * 1024 * 2;
constexpr size_t WS_CDVT = WS_CDK + (size_t)8 * 256 * 1024 * 2;
constexpr size_t WS_S5A = WS_CDVT + (size_t)8 * 256 * 1024 * 2;
constexpr size_t WS_S5BB = WS_S5A + (size_t)128 * 64 * 2 * 4;
constexpr size_t WS_S5CC = WS_S5BB + (size_t)128 * 128 * 16 * 2;
constexpr int KRL_S = 8208, KRL_P = 528;
constexpr size_t WS_KRS = WS_S5CC + (size_t)128 * 16 * 128 * 2;
constexpr size_t WS_KRP = al256(WS_KRS + (size_t)2 * 1024 * KRL_S * 2);
constexpr size_t WS_TBLU = al256(WS_KRP + (size_t)2 * 1024 * KRL_P * 2);
constexpr size_t WS_TBLV = WS_TBLU + (size_t)16384 * 2048 * 2;
constexpr size_t WS_HM = WS_TBLV + (size_t)16384 * 2048 * 2;
constexpr size_t WS_RA = WS_HM + (size_t)TOK * 2048 * 2;
constexpr size_t WS_RB = WS_RA + (size_t)TOK * 4096 * 2;
constexpr size_t WS_VT = WS_RB + (size_t)3072 * TOK * 2;
constexpr size_t WS_SC = WS_VT + (size_t)TOK * 1024 * 2;
constexpr size_t WS_END = WS_SC + (size_t)4 * 16384 * 4;
constexpr size_t RA_Q = 0;
constexpr size_t RA_SELI = (size_t)TOK * 2048 * 2;
constexpr size_t RA_SELW = RA_SELI + (size_t)TOK * 128 * 4;
constexpr size_t RA_CF = RA_SELW + (size_t)TOK * 128 * 4;
constexpr size_t RA_ZC = (size_t)TOK * 2048 * 2;
constexpr size_t RB_YF = 0, RB_YB = (size_t)TOK * 1024 * 2, RB_Y = (size_t)2 * TOK * 1024 * 2;
constexpr size_t VT_S = (size_t)TP * 1024 * 2;

constexpr int LDS_BYTES = 147456;

struct Params { const float* in[N_IN]; float* out; unsigned char* ws; int ph_lo, ph_hi; };

DI float bf2f(bf16_t b) { return __uint_as_float(((unsigned)b) << 16); }
DI float bflo(unsigned w) { return __uint_as_float(w << 16); }
DI float bfhi(unsigned w) { return __uint_as_float(w & 0xffff0000u); }
DI unsigned pk2(float a, float b) { f32x2 v = {a, b}; return __builtin_bit_cast(unsigned, __builtin_convertvector(v, bf16x2_t)); }
DI float dot2bf(unsigned a, unsigned b, float c) { return __builtin_amdgcn_fdot2_f32_bf16(__builtin_bit_cast(bf16x2_t, a), __builtin_bit_cast(bf16x2_t, b), c, false); }
DI bf16_t f2bf(float a) { return (bf16_t)(pk2(a, 0.f) & 0xffffu); }
DI float dpp_xor1(float v) { return __builtin_bit_cast(float, __builtin_amdgcn_update_dpp(0, __builtin_bit_cast(int, v), 0xB1, 0xF, 0xF, true)); }
DI float dpp_xor2(float v) { return __builtin_bit_cast(float, __builtin_amdgcn_update_dpp(0, __builtin_bit_cast(int, v), 0x4E, 0xF, 0xF, true)); }
DI float wave_sum(float v) {
    v += dpp_xor1(v); v += dpp_xor2(v);
    v += __builtin_bit_cast(float, __builtin_amdgcn_update_dpp(0, __builtin_bit_cast(int, v), 0x141, 0xF, 0xF, true));
    v += __builtin_bit_cast(float, __builtin_amdgcn_update_dpp(0, __builtin_bit_cast(int, v), 0x140, 0xF, 0xF, true));
    v += __builtin_bit_cast(float, __builtin_amdgcn_update_dpp(0, __builtin_bit_cast(int, v), 0x142, 0xA, 0xF, false));
    v += __builtin_bit_cast(float, __builtin_amdgcn_update_dpp(0, __builtin_bit_cast(int, v), 0x143, 0xC, 0xF, false));
    return __builtin_bit_cast(float, __builtin_amdgcn_readlane(__builtin_bit_cast(int, v), 63));
}
DI float gelu_tanh(float x) {
    const float u = 0.7978845608028654f * (x + 0.044715f * x * x * x);
    const float e = __expf(2.f * u);
    const float t = 1.f - 2.f / (e + 1.f);
    return 0.5f * x * (1.f + t);
}
DI float wave_max(float v) {
    v = fmaxf(v, dpp_xor1(v)); v = fmaxf(v, dpp_xor2(v));
    v = fmaxf(v, __builtin_bit_cast(float, __builtin_amdgcn_update_dpp(0, __builtin_bit_cast(int, v), 0x141, 0xF, 0xF, true)));
    v = fmaxf(v, __builtin_bit_cast(float, __builtin_amdgcn_update_dpp(0, __builtin_bit_cast(int, v), 0x140, 0xF, 0xF, true)));
    v = fmaxf(v, __builtin_bit_cast(float, __builtin_amdgcn_update_dpp(0, __builtin_bit_cast(int, v), 0x142, 0xA, 0xF, false)));
    v = fmaxf(v, __builtin_bit_cast(float, __builtin_amdgcn_update_dpp(0, __builtin_bit_cast(int, v), 0x143, 0xC, 0xF, false)));
    return __builtin_bit_cast(float, __builtin_amdgcn_readlane(__builtin_bit_cast(int, v), 63));
}
DI f32x2 fp8x2_lo(unsigned w) { return __builtin_amdgcn_cvt_pk_f32_fp8((int)w, false); }
DI f32x2 fp8x2_hi(unsigned w) { return __builtin_amdgcn_cvt_pk_f32_fp8((int)w, true); }
DI unsigned pk_fp8x4(float a, float b, float c, float d) { int r = 0; r = __builtin_amdgcn_cvt_pk_fp8_f32(a, b, r, false); r = __builtin_amdgcn_cvt_pk_fp8_f32(c, d, r, true); return (unsigned)r; }
DI int lane_id() { return (int)__builtin_amdgcn_mbcnt_hi(~0u, __builtin_amdgcn_mbcnt_lo(~0u, 0u)); }
DI int cond_of(int T) { return T < TP ? 0 : 1 + ((T - TP) >> 12); }
#define XB_TMO      128
#define XB_XCNT(j)  (256  + 64 * (j))
#define XB_XSUB(j)  (1280 + 64 * (j))
#define XB_XGEN(j)  (2304 + 64 * (j))
#define XB_TOP      3328
#define XB_TOPGEN   3392
#define XCD_BAR_WORDS 3456
#define XB_SPIN_CAP (1u << 26)
#define LAS __attribute__((address_space(3)))

__device__ __forceinline__ unsigned xb_ld(unsigned* p)              { return __hip_atomic_load(p, __ATOMIC_RELAXED, __HIP_MEMORY_SCOPE_AGENT); }
__device__ __forceinline__ unsigned xb_add(unsigned* p, unsigned v) { return __hip_atomic_fetch_add(p, v, __ATOMIC_RELAXED, __HIP_MEMORY_SCOPE_AGENT); }
__device__ __forceinline__ unsigned xb_xcc_id() { return (unsigned)__builtin_amdgcn_s_getreg((3 << 11) | 20) & 0xFu; }
#define XB_SPIN(cond, bar) do { unsigned _sp = 0; while (cond) { __builtin_amdgcn_s_sleep(1); \
    if ((++_sp & 255u) == 0u) { if (xb_ld(&(bar)[XB_TMO])) break; if (_sp > XB_SPIN_CAP) { atomicAdd(&(bar)[XB_TMO], 1u); break; } } } } while (0)

struct XcdBarrier {
    unsigned* bar; unsigned x;
    volatile LAS unsigned* st;
};

__device__ __forceinline__ XcdBarrier xcd_barrier_post(unsigned* bar, volatile LAS unsigned* st) {
    XcdBarrier b; b.bar = bar; b.x = xb_xcc_id(); b.st = st;
    if (threadIdx.x == 0) (void)xb_add(&bar[XB_XCNT(b.x)], 1u);
    return b;
}
__device__ __forceinline__ void xcd_barrier_complete(unsigned* bar, unsigned x, unsigned& nloc, unsigned& nx) {
    const unsigned G = gridDim.x * gridDim.y * gridDim.z;
    unsigned sum, cnt, mine, sp = 0u;
    for (;;) {
        sum = 0u; cnt = 0u; mine = 0u;
#pragma unroll
        for (unsigned j = 0; j < 16; ++j) { const unsigned c = xb_ld(&bar[XB_XCNT(j)]); sum += c; cnt += (c > 0u) ? 1u : 0u; mine = (j == x) ? c : mine; }
        if (sum == G) break;
        __builtin_amdgcn_s_sleep(1);
        if ((++sp & 255u) == 0u) { if (xb_ld(&bar[XB_TMO])) break; if (sp > XB_SPIN_CAP) { atomicAdd(&bar[XB_TMO], 1u); break; } }
    }
    nloc = mine > 0u ? mine : 1u; nx = cnt > 0u ? cnt : 1u;
}

__device__ __forceinline__ void xcd_barrier(const XcdBarrier& b) {
    asm volatile("s_waitcnt vmcnt(0)" ::: "memory");
    __syncthreads();
    if (threadIdx.x == 0) {
        unsigned* bar = b.bar;
        __builtin_amdgcn_s_waitcnt(0);
        unsigned nloc = b.st[0], nx = b.st[1];
        if (nloc == 0u) { xcd_barrier_complete(bar, b.x, nloc, nx); b.st[0] = nloc; b.st[1] = nx; }
        const unsigned old = xb_add(&bar[XB_XSUB(b.x)], 1u);
        const unsigned gen = old / nloc;
        if (old + 1u == (gen + 1u) * nloc) {
            __builtin_amdgcn_fence(__ATOMIC_RELEASE, "agent");
            asm volatile("s_waitcnt vmcnt(0)" ::: "memory");
            const unsigned og = xb_add(&bar[XB_TOP], 1u);
            const unsigned tg = og / nx;
            if (og + 1u == (tg + 1u) * nx) xb_add(&bar[XB_TOPGEN], 1u);
            else XB_SPIN(xb_ld(&bar[XB_TOPGEN]) == tg, bar);
            __builtin_amdgcn_fence(__ATOMIC_ACQUIRE, "agent");
            xb_add(&bar[XB_XGEN(b.x)], 1u);
            asm volatile("s_waitcnt vmcnt(0)" ::: "memory");
        } else {
            XB_SPIN(xb_ld(&bar[XB_XGEN(b.x)]) == gen, bar);
            __builtin_amdgcn_fence(__ATOMIC_ACQUIRE, "agent");
            asm volatile("s_waitcnt vmcnt(0)" ::: "memory");
        }
    }
    __syncthreads();
}
namespace pg8 {
#define PG8_LAS __attribute__((address_space(3)))
typedef unsigned short bf16_t;
typedef short bf16x8 __attribute__((ext_vector_type(8)));
typedef float f32x4 __attribute__((ext_vector_type(4)));
typedef unsigned u32x4 __attribute__((ext_vector_type(4)));
constexpr int BM = 256, BK = 64, HALF = 128, HTB = HALF * BK * 2  , STAGE_BYTES = 8 * HTB, NXCD = 8, WGM = 8;

__host__ __device__ __forceinline__ int lds_byte(int r, int c) { const int st = (r >> 4) * 2 + (c >> 5), rr = r & 15, cc = c & 31, ob = rr * 64 + cc * 2; return st * 1024 + (ob ^ (((ob >> 9) & 1) << 5)); }
__host__ __device__ __forceinline__ void stage_rc(int b, int& R, int& C) { const int st = b / 1024, sb = b % 1024, swz = sb ^ (((sb >> 9) & 1) << 5); R = (st >> 1) * 16 + swz / 64; C = (st & 1) * 32 + (swz % 64) / 2; }
__host__ __device__ __forceinline__ int perm32(int rho) { const int n = rho >> 4, i = rho & 15; return 8 * (i >> 2) + 4 * n + (i & 3); }

struct Unit { int pm, pn; };
struct Gemm { const bf16_t* A; const bf16_t* Bt; int M, N, K; };

struct StaticOrder {
    int nM, nN, nwg, G, c;
    __host__ __device__ void init(int M, int N, int G_, int c_) { nM = M / BM; nN = N / BM; nwg = nM * nN; G = G_; c = c_; }
    __host__ __device__ bool next(int i, Unit& u) const {
        const long L = (long)i * G + c; if (L >= nwg) return false;
        int wgid = (int)L; { const int q = nwg / NXCD, r = nwg % NXCD, xcd = wgid % NXCD, off = wgid / NXCD; wgid = (xcd < r ? xcd * (q + 1) : r * (q + 1) + (xcd - r) * q) + off; }
        const int nig = WGM * nN, gid = wgid / nig, fm = gid * WGM, gsz = (nM - fm) < WGM ? (nM - fm) : WGM;
        u.pm = fm + ((wgid % nig) % gsz); u.pn = (wgid % nig) / gsz; return true;
    }
    __device__ __forceinline__ void a_ready(const Unit&) const {}
    __device__ __forceinline__ void done(const Unit&) const {}
};
__device__ __forceinline__ unsigned cvt_pk_bf16(float lo, float hi) { unsigned r; asm volatile("v_cvt_pk_bf16_f32 %0, %1, %2" : "=v"(r) : "v"(lo), "v"(hi)); return r; }
template <class Epi, class Sched, bool STAMP = false>
__device__ __forceinline__ void gemm_phase(PG8_LAS unsigned char* lds, const Gemm g, const Sched& S, const Epi& E, unsigned long long* stamps) {
    const int tid = threadIdx.x, wid = __builtin_amdgcn_readfirstlane(tid >> 6), lane = tid & 63, wr = wid >> 2, wc = wid & 3, fr = lane & 15, fq = lane >> 4;
    const int K = g.K, nt = K / BK;
    int ts_lo = 0, ts_hi = 0, nts = 0; const unsigned long long rt_entry = STAMP ? (unsigned long long)wall_clock64() : 0ull;
#define PG8_STAMP() do { if (STAMP && wid == 0 && nts < 64) { const unsigned long long _c = (unsigned long long)clock64(); \
        ts_lo = (lane == nts) ? (int)(unsigned)_c : ts_lo; ts_hi = (lane == nts) ? (int)(unsigned)(_c >> 32) : ts_hi; ++nts; } } while (0)
    PG8_STAMP();
    unsigned voffA[2], voffB[2];
#pragma unroll
    for (int i = 0; i < 2; ++i) { int R, C; stage_rc(tid * 16 + i * 8192, R, C); const int Rb = Epi::PERM ? ((R & ~31) + perm32(R & 31)) : R;
        voffA[i] = (unsigned)(R * K + C) * 2u; voffB[i] = (unsigned)(Rb * K + C) * 2u; }
    const size_t kstep = (size_t)(BK * 2);
    const size_t hstep = (size_t)HALF * K * 2;
    const size_t tstep = 2 * hstep;
    const unsigned ldsw = (unsigned)wid * 1024u;
    const int aoff = lds_byte(wr * 64 + fr, fq * 8), boff = lds_byte(wc * 32 + fr, fq * 8);
#define PG8_SA(b, h) (((b) * 2 + (h)) * HTB)
#define PG8_SB(b, h) ((4 + (b) * 2 + (h)) * HTB)
#define PG8_STAGE(bufoff, gbase, voff) do { _Pragma("unroll") for (int _i = 0; _i < 2; ++_i) \
        __builtin_amdgcn_global_load_lds((const unsigned*)((const char*)(gbase) + (voff)[_i]), (PG8_LAS unsigned*)(lds + (bufoff) + ldsw + _i * 8192), 16, 0, 0); } while (0)
#define PG8_LDA(dst, b, h) do { _Pragma("unroll") for (int m = 0; m < 4; ++m) _Pragma("unroll") for (int k = 0; k < 2; ++k) dst[m][k] = *(const PG8_LAS bf16x8*)(lds + PG8_SA(b, h) + aoff + m * 2048 + k * 1024); } while (0)
#define PG8_LDB(dst, b, h) do { _Pragma("unroll") for (int n = 0; n < 2; ++n) _Pragma("unroll") for (int k = 0; k < 2; ++k) dst[n][k] = *(const PG8_LAS bf16x8*)(lds + PG8_SB(b, h) + boff + n * 2048 + k * 1024); } while (0)
#define PG8_MMA(ai, bj, At, Bt) do { __builtin_amdgcn_s_setprio(1); _Pragma("unroll") for (int m = 0; m < 4; ++m) _Pragma("unroll") for (int n = 0; n < 2; ++n) _Pragma("unroll") for (int k = 0; k < 2; ++k) \
        acc[ai][bj][m][n] = __builtin_amdgcn_mfma_f32_16x16x32_bf16(Bt[n][k], At[m][k], acc[ai][bj][m][n], 0, 0, 0); __builtin_amdgcn_s_setprio(0); } while (0)
#define PG8_WAIT_V(n) asm volatile("s_waitcnt vmcnt(" #n ")" ::: "memory")
#define PG8_WAIT_L(n) asm volatile("s_waitcnt lgkmcnt(" #n ")" ::: "memory")
#define PG8_BAR __builtin_amdgcn_s_barrier()
#define PG8_SCHED __builtin_amdgcn_sched_barrier(0)
    Unit cur, nxt; int ui = 0;
    if (!S.next(0, cur)) return;
    f32x4 acc[2][2][4][2];
#pragma unroll
    for (int a = 0; a < 2; ++a)
#pragma unroll
        for (int b = 0; b < 2; ++b)
#pragma unroll
            for (int m = 0; m < 4; ++m)
#pragma unroll
                for (int n = 0; n < 2; ++n) acc[a][b][m][n] = (f32x4){0.f, 0.f, 0.f, 0.f};
    bf16x8 At[4][2], B0[2][2], B1[2][2];
    const char* cA = (const char*)g.A + (size_t)cur.pm * tstep; const char* cB = (const char*)g.Bt + (size_t)cur.pn * tstep;
    S.a_ready(cur);
    PG8_STAGE(PG8_SB(0, 0), cB, voffB); PG8_STAGE(PG8_SA(0, 0), cA, voffA); PG8_STAGE(PG8_SB(0, 1), cB + hstep, voffB); PG8_STAGE(PG8_SA(0, 1), cA + hstep, voffA);
    if (wr == 1) PG8_BAR;
    PG8_WAIT_V(4); PG8_BAR;
    PG8_STAGE(PG8_SB(1, 0), cB + kstep, voffB); PG8_STAGE(PG8_SA(1, 0), cA + kstep, voffA); PG8_STAGE(PG8_SB(1, 1), cB + hstep + kstep, voffB);
    PG8_WAIT_V(6); PG8_BAR;
    PG8_STAMP();
    for (;;) {
        const bool has_next = S.next(ui + 1, nxt);
        const char* nA = has_next ? (const char*)g.A + (size_t)nxt.pm * tstep : cA; const char* nB = has_next ? (const char*)g.Bt + (size_t)nxt.pn * tstep : cB;
        for (int t = 0; t < nt; t += 2) {
            const bool last = (t == nt - 2);
            const char* a1 = cA + (size_t)(t + 1) * kstep;
            const char* a2 = last ? nA : cA + (size_t)(t + 2) * kstep; const char* b2 = last ? nB : cB + (size_t)(t + 2) * kstep;
            const char* a3 = a2 + kstep; const char* b3 = b2 + kstep;
            if (last && has_next) S.a_ready(nxt);
            PG8_LDB(B0, 0, 0); PG8_SCHED; PG8_LDA(At, 0, 0); PG8_STAGE(PG8_SA(1, 1), a1 + hstep, voffA);
            PG8_WAIT_L(8); PG8_BAR; PG8_WAIT_L(0); PG8_MMA(0, 0, At, B0); PG8_BAR; PG8_SCHED;
            PG8_LDB(B1, 0, 1); PG8_STAGE(PG8_SB(0, 0), b2, voffB);
            PG8_BAR; PG8_WAIT_L(0); PG8_MMA(0, 1, At, B1); PG8_BAR;
            PG8_LDA(At, 0, 1); PG8_STAGE(PG8_SA(0, 0), a2, voffA);
            PG8_BAR; PG8_WAIT_L(0); PG8_MMA(1, 0, At, B0); PG8_BAR; PG8_SCHED;
            PG8_STAGE(PG8_SB(0, 1), b2 + hstep, voffB);
            PG8_WAIT_V(6); PG8_BAR; PG8_MMA(1, 1, At, B1); PG8_BAR;
            PG8_LDB(B0, 1, 0); PG8_SCHED; PG8_LDA(At, 1, 0); PG8_STAGE(PG8_SA(0, 1), a2 + hstep, voffA);
            PG8_WAIT_L(8); PG8_BAR; PG8_WAIT_L(0); PG8_MMA(0, 0, At, B0); PG8_BAR; PG8_SCHED;
            PG8_LDB(B1, 1, 1); PG8_STAGE(PG8_SB(1, 0), b3, voffB);
            PG8_BAR; PG8_WAIT_L(0); PG8_MMA(0, 1, At, B1); PG8_BAR;
            PG8_LDA(At, 1, 1); PG8_STAGE(PG8_SA(1, 0), a3, voffA);
            PG8_BAR; PG8_WAIT_L(0); PG8_MMA(1, 0, At, B0); PG8_BAR; PG8_SCHED;
            PG8_STAGE(PG8_SB(1, 1), b3 + hstep, voffB);
            PG8_WAIT_V(6); PG8_BAR; PG8_MMA(1, 1, At, B1); PG8_BAR;
        }
        PG8_STAMP();
        if constexpr (!Epi::AFTER_DRAIN) { E(acc, cur, wr, wc, fr, fq); S.done(cur); }
        PG8_STAMP();
        if (!has_next) break;
#pragma unroll
        for (int a = 0; a < 2; ++a)
#pragma unroll
            for (int b = 0; b < 2; ++b)
#pragma unroll
                for (int m = 0; m < 4; ++m)
#pragma unroll
                    for (int n = 0; n < 2; ++n) acc[a][b][m][n] = (f32x4){0.f, 0.f, 0.f, 0.f};
        cur = nxt; cA = nA; cB = nB; ++ui;
    }
    PG8_WAIT_V(0);
    if (wr == 0) PG8_BAR;
    PG8_BAR;
    if constexpr (Epi::AFTER_DRAIN) { E.fused(acc, cur, wr, wc, fr, fq, lds, wid, lane); S.done(cur); }
    PG8_STAMP();
    if (STAMP && wid == 0) { stamps[lane] = lane < nts ? (((unsigned long long)(unsigned)ts_hi << 32) | (unsigned)ts_lo) : 0ull;
        if (lane == 62) stamps[62] = rt_entry; if (lane == 63) stamps[63] = (unsigned long long)wall_clock64(); }
#undef PG8_STAMP
#undef PG8_SA
#undef PG8_SB
#undef PG8_STAGE
#undef PG8_LDA
#undef PG8_LDB
#undef PG8_MMA
#undef PG8_WAIT_V
#undef PG8_WAIT_L
#undef PG8_BAR
#undef PG8_SCHED
}
}
struct Ctx {
    LAS unsigned char* lds; int tid, lane, wave, G, bid;
};

DI void cvt_rows(const Ctx& F, const float* src, bf16_t* dst, size_t n) {
    const size_t n8 = n >> 3;
    for (size_t i = (size_t)F.bid * NTHR + F.tid; i < n8; i += (size_t)F.G * NTHR) {
        const f32x4 a = *(const f32x4*)(src + i * 8), b = *(const f32x4*)(src + i * 8 + 4);
        u32x4 w; w.x = pk2(a.x, a.y); w.y = pk2(a.z, a.w); w.z = pk2(b.x, b.y); w.w = pk2(b.z, b.w);
        *(u32x4*)(dst + i * 8) = w;
    }
}

constexpr int TR_S = 68;
DI void tr_tile_out(const Ctx& F, bf16_t* dst, size_t ldd, const LAS bf16_t* tile) {
    const int n = F.tid >> 3, kc = (F.tid & 7) * 8;
    const LAS bf16_t* t = tile + kc * TR_S + n;
    u32x4 v;
    v.x = (unsigned)t[0] | ((unsigned)t[TR_S] << 16); v.y = (unsigned)t[2 * TR_S] | ((unsigned)t[3 * TR_S] << 16);
    v.z = (unsigned)t[4 * TR_S] | ((unsigned)t[5 * TR_S] << 16); v.w = (unsigned)t[6 * TR_S] | ((unsigned)t[7 * TR_S] << 16);
    *(u32x4*)(dst + (size_t)n * ldd + kc) = v;
}
DI void tr_tile_f32(const Ctx& F, const float* src, size_t lds_, bf16_t* dst, size_t ldd, LAS bf16_t* tile) {
#pragma unroll
    for (int j = 0; j < 2; ++j) {
        const int id = F.tid + NTHR * j, kr = id >> 4, nc = (id & 15) * 4;
        const f32x4 v = *(const f32x4*)(src + (size_t)kr * lds_ + nc);
        *(LAS u32x2*)(tile + kr * TR_S + nc) = (u32x2){pk2(v.x, v.y), pk2(v.z, v.w)};
    }
    __syncthreads();
    tr_tile_out(F, dst, ldd, tile);
    __syncthreads();
}
DI void tr_tile_bf16(const Ctx& F, const bf16_t* src, size_t lds_, bf16_t* dst, size_t ldd, LAS bf16_t* tile) {
    { const int kr = F.tid >> 3, nc = (F.tid & 7) * 8; const u32x4 v = *(const u32x4*)(src + (size_t)kr * lds_ + nc);
      *(LAS u32x2*)(tile + kr * TR_S + nc) = (u32x2){v.x, v.y}; *(LAS u32x2*)(tile + kr * TR_S + nc + 4) = (u32x2){v.z, v.w}; }
    __syncthreads();
    tr_tile_out(F, dst, ldd, tile);
    __syncthreads();
}
struct TrJob { const bf16_t* src; size_t lds_; bf16_t* dst; size_t ldd; };
template <class Map>
DI void tr_pipeline_bf16(const Ctx& F, int nt, const Map& map, LAS bf16_t* tiles) {
    const int kr = F.tid >> 3, nc = (F.tid & 7) * 8;
    __syncthreads();
    u32x4 v[4];
#pragma unroll
    for (int u = 0; u < 4; ++u) { const int t = F.bid + u * F.G; v[u] = (u32x4){0u, 0u, 0u, 0u};
        if (t < nt) { const TrJob J = map(t); v[u] = *(const u32x4*)(J.src + (size_t)kr * J.lds_ + nc); } }
#pragma unroll 1
    for (int t0 = F.bid; t0 < nt; t0 += 4 * F.G) {
#pragma unroll
        for (int u = 0; u < 4; ++u) { const int t = t0 + u * F.G;
            if (t < nt) {
                LAS bf16_t* tile = tiles + (u & 1) * (64 * TR_S);
                *(LAS u32x2*)(tile + kr * TR_S + nc) = (u32x2){v[u].x, v[u].y}; *(LAS u32x2*)(tile + kr * TR_S + nc + 4) = (u32x2){v[u].z, v[u].w};
                const int tn = t + 4 * F.G;
                if (tn < nt) { const TrJob Jn = map(tn); v[u] = *(const u32x4*)(Jn.src + (size_t)kr * Jn.lds_ + nc); }
                __syncthreads();
                const TrJob J = map(t);
                tr_tile_out(F, J.dst, J.ldd, tile);
            } }
    }
    __syncthreads();
}
DI void transpose_weight(const Ctx& F, const float* W, int K, int N, bf16_t* Wt) {
    const int tk = K / 64, tn = N / 64;
    for (int t = F.bid; t < tk * tn; t += F.G) {
        const int k0 = (t / tn) * 64, n0 = (t % tn) * 64;
        tr_tile_f32(F, W + (size_t)k0 * N + n0, (size_t)N, Wt + (size_t)n0 * K + k0, (size_t)K, (LAS bf16_t*)F.lds);
    }
}
DI void transpose_cache_v(const Ctx& F, const float* V, bf16_t* VT) {
    for (int t = F.bid; t < 64 * 8; t += F.G) {
        const int bh = t >> 3, sub = t & 7, k0 = (sub >> 1) * 64, d0 = (sub & 1) * 64, b = bh >> 3, h = bh & 7;
        tr_tile_f32(F, V + ((size_t)b * 256 + k0) * 1024 + h * 128 + d0, 1024, VT + ((size_t)bh * 128 + d0) * 256 + k0, 256, (LAS bf16_t*)F.lds);
    }
}

DI void adaln_partials(const Ctx& F, const Params& P) {
    LAS float* s = (LAS float*)F.lds;
    const float* modw = P.in[I_MODW]; const float* cv = P.in[I_C]; const float* cctx = P.in[I_CCTX];
    float* modp = (float*)(P.ws + WS_MODP);
    for (int it = F.bid; it < 192; it += F.G) {
        const int i = it / 96, r = it % 96, ks = r / 6, cg = r % 6;
        __syncthreads();
        for (int e = F.tid; e < 9 * 128; e += NTHR) { const int j = e >> 7, k = e & 127; const float c = (j == 0) ? cctx[ks * 128 + k] : cv[(j - 1) * 2048 + ks * 128 + k]; s[e] = c / (1.f + __expf(-c)); }
        __syncthreads();
        f32x4 acc[9];
#pragma unroll
        for (int j = 0; j < 9; ++j) acc[j] = (f32x4){0.f, 0.f, 0.f, 0.f};
        const float* w = modw + ((size_t)i * 2048 + ks * 128) * 12288 + cg * 2048 + F.tid * 4;
#pragma unroll 8
        for (int k = 0; k < 128; ++k) {
            const f32x4 w4 = *(const f32x4*)(w + (size_t)k * 12288);
#pragma unroll
            for (int j = 0; j < 9; ++j) acc[j] += w4 * s[j * 128 + k];
        }
#pragma unroll
        for (int j = 0; j < 9; ++j) *(f32x4*)(modp + ((size_t)(i * 16 + ks) * 9 + j) * 12288 + cg * 2048 + F.tid * 4) = acc[j];
    }
    __syncthreads();
}
DI void adaln_reduce(const Ctx& F, const Params& P) {
    const float* modp = (const float*)(P.ws + WS_MODP); float* mod = (float*)(P.ws + WS_MOD); const float* modb = P.in[I_MODB];
    for (int e = F.bid * NTHR + F.tid; e < 2 * 9 * 12288; e += F.G * NTHR) {
        const int i = e / (9 * 12288), r = e % (9 * 12288), j = r / 12288, n = r % 12288;
        float a = modb[i * 12288 + n];
#pragma unroll
        for (int ks = 0; ks < 16; ++ks) a += modp[((size_t)(i * 16 + ks) * 9 + j) * 12288 + n];
        mod[e] = a;
    }
}

DI void hyena_filters(const Ctx& F, const Params& P) {
    LAS float* z = (LAS float*)F.lds;
    LAS float* h1 = z + 320;
    LAS float* h2 = h1 + 576;
    const float* w1 = P.in[I_HYW1]; const float* b1 = P.in[I_HYB1]; const float* f1 = P.in[I_HYF1];
    const float* w2 = P.in[I_HYW2]; const float* b2 = P.in[I_HYB2]; const float* f2 = P.in[I_HYF2];
    const float* w3 = P.in[I_HYW3]; const float* dec = P.in[I_HYDEC];
    for (int it = F.bid; it < 544; it += F.G) {
        const bool smp = it < 512; const int L = smp ? LS : LP, p0 = (smp ? it : it - 512) * 8, RL = smp ? KRL_S : KRL_P;
        bf16_t* KR = (bf16_t*)(P.ws + (smp ? WS_KRS : WS_KRP));
        __syncthreads();
        if (F.tid < 9 * 33) {
            const int ps = F.tid / 33, k = F.tid % 33, i = p0 + ps;
            const float t = (float)i / (float)(L - 1), wang = 6.283185307179586f * (float)i / (float)L;
            float val;
            if (k == 0) val = t;
            else { const int f = (k - 1) & 15; const float fr = 1e-4f + (float)f * ((15.0f - 1e-4f) / 15.0f); val = (k <= 16) ? cosf(fr * wang) : -sinf(fr * wang); }
            z[F.tid] = val;
        }
        __syncthreads();
        for (int e = F.tid; e < 9 * 64; e += NTHR) { const int ps = e >> 6, j = e & 63; float a = b1[j];
            for (int k = 0; k < 33; ++k) a += z[ps * 33 + k] * w1[k * 64 + j];
            h1[e] = sinf(f1[j] * a); }
        __syncthreads();
        for (int e = F.tid; e < 9 * 64; e += NTHR) { const int ps = e >> 6, j = e & 63; float a = b2[j];
            for (int k = 0; k < 64; ++k) a += h1[ps * 64 + k] * w2[k * 64 + j];
            h2[e] = sinf(f2[j] * a); }
        __syncthreads();
#pragma unroll 1
        for (int qh = 0; qh < 2; ++qh) {
            float acc[9][4];
#pragma unroll
            for (int ps = 0; ps < 9; ++ps)
#pragma unroll
                for (int q = 0; q < 4; ++q) acc[ps][q] = 0.f;
#pragma unroll 2
            for (int k = 0; k < 64; ++k) {
                float w[4];
#pragma unroll
                for (int q = 0; q < 4; ++q) w[q] = w3[k * 4096 + F.tid + NTHR * (qh * 4 + q)];
#pragma unroll
                for (int ps = 0; ps < 9; ++ps) { const float hv = h2[ps * 64 + k];
#pragma unroll
                    for (int q = 0; q < 4; ++q) acc[ps][q] += hv * w[q]; }
            }
#pragma unroll
            for (int q = 0; q < 4; ++q) {
                const int n = F.tid + NTHR * (qh * 4 + q), o = (n >> 10) & 1, c = n & 1023;
                const float dc = fabsf(dec[n]);
                bf16_t* row = KR + (size_t)(o * 1024 + c) * RL;
                float v[9];
#pragma unroll
                for (int ps = 0; ps < 9; ++ps) { const int i = p0 + ps; v[ps] = (i < L) ? acc[ps][q] * __expf(-((float)i / (float)(L - 1)) * dc) : 0.f; }
                if (qh == 0) {
                    u32x4 wv; wv.x = pk2(v[8], v[7]); wv.y = pk2(v[6], v[5]); wv.z = pk2(v[4], v[3]); wv.w = pk2(v[2], v[1]);
                    *(u32x4*)(row + (L - p0 - 8)) = wv;
                    if (p0 == 0) row[L] = f2bf(v[0]);
                } else if (p0 > 0) {
                    u32x4 wv; wv.x = pk2(v[0], v[1]); wv.y = pk2(v[2], v[3]); wv.z = pk2(v[4], v[5]); wv.w = pk2(v[6], v[7]);
                    *(u32x4*)(row + (L + p0)) = wv;
                } else {
#pragma unroll
                    for (int ps = 1; ps < 8; ++ps) row[L + ps] = f2bf(v[ps]);
                }
            }
        }
    }
    __syncthreads();
    for (int e = F.bid * NTHR + F.tid; e < 2 * 2048; e += F.G * NTHR) {
        const bool smp = e < 2048; const int r = e & 2047, L = smp ? LS : LP, RL = smp ? KRL_S : KRL_P;
        bf16_t* row = (bf16_t*)(P.ws + (smp ? WS_KRS : WS_KRP)) + (size_t)r * RL;
        for (int x = 2 * L; x < RL; ++x) row[x] = 0;
    }
}

DI void s5_consts(const Ctx& F, const Params& P) {
    float* S5A = (float*)(P.ws + WS_S5A); bf16_t* BB = (bf16_t*)(P.ws + WS_S5BB); bf16_t* CC = (bf16_t*)(P.ws + WS_S5CC);
    const float* lre = P.in[I_S5LRE]; const float* lim = P.in[I_S5LIM]; const float* ldt = P.in[I_S5LDT];
    const float* bre = P.in[I_S5BRE]; const float* bim = P.in[I_S5BIM]; const float* cre = P.in[I_S5CRE]; const float* cim = P.in[I_S5CIM];
    for (int e = F.bid * NTHR + F.tid; e < 8192; e += F.G * NTHR) {
        const int dg = e >> 6, n = e & 63;
        const float dt = expf(ldt[dg]), lr = lre[e], li = lim[e];
        const float mag = expf(lr * dt), ar = mag * cosf(li * dt), ai = mag * sinf(li * dt), den = lr * lr + li * li;
        const float cr = ((ar - 1.f) * lr + ai * li) / den, ci = (ai * lr - (ar - 1.f) * li) / den;
        S5A[e * 2] = ar; S5A[e * 2 + 1] = ai;
#pragma unroll
        for (int p = 0; p < 16; ++p) {
            const float br = bre[(size_t)e * 16 + p], bi = bim[(size_t)e * 16 + p];
            BB[((size_t)dg * 128 + n) * 16 + p] = f2bf(cr * br - ci * bi);
            BB[((size_t)dg * 128 + 64 + n) * 16 + p] = f2bf(cr * bi + ci * br);
            CC[((size_t)dg * 16 + p) * 128 + n] = f2bf(cre[((size_t)dg * 16 + p) * 64 + n]);
            CC[((size_t)dg * 16 + p) * 128 + 64 + n] = f2bf(-cim[((size_t)dg * 16 + p) * 64 + n]);
        }
    }
}

constexpr int PT_ROWB = 1536;
DI void cvt_table_fp6(const Ctx& F, const float* src, unsigned char* dst, float* scales, const int (&perm)[32]) {
    LAS float* scr = (LAS float*)(F.lds) + F.wave * 2048 + F.lane;
    for (int r = F.bid * 8 + F.wave; r < 16384; r += F.G * 8) {
        f32x4 v[8]; float m = 0.f;
#pragma unroll
        for (int j = 0; j < 8; ++j) { v[j] = *(const f32x4*)(src + (size_t)r * 2048 + F.lane * 32 + j * 4);
            m = fmaxf(m, fmaxf(fmaxf(fabsf(v[j].x), fabsf(v[j].y)), fmaxf(fabsf(v[j].z), fabsf(v[j].w)))); }
        m = wave_max(m);
        const float inv = (m > 0.f) ? 7.0f / m : 0.f, sc = (m > 0.f) ? m / 7.0f : 0.f;
#pragma unroll
        for (int j = 0; j < 8; ++j) { scr[perm[j * 4 + 0] * 64] = v[j].x * inv; scr[perm[j * 4 + 1] * 64] = v[j].y * inv; scr[perm[j * 4 + 2] * 64] = v[j].z * inv; scr[perm[j * 4 + 3] * 64] = v[j].w * inv; }
        asm volatile("" ::: "memory");
        f32x16 a, b;
#pragma unroll
        for (int i = 0; i < 16; ++i) { a[i] = scr[i * 64]; b[i] = scr[(16 + i) * 64]; }
        asm volatile("" ::: "memory");
        const u32x6 pk = __builtin_amdgcn_cvt_scalef32_2xpk16_fp6_f32(a, b, 1.0f);
        unsigned char* o = dst + (size_t)r * PT_ROWB;
        *(u32x4*)(o + F.lane * 16) = (u32x4){pk[0], pk[1], pk[2], pk[3]}; *(u32x2*)(o + 1024 + F.lane * 8) = (u32x2){pk[4], pk[5]};
        if (F.lane == 0) scales[r] = sc;
    }
}
DI void convert_peer_tables(const Ctx& F, const Params& P) {
    int perm[32];
    { f32x16 a, b;
#pragma unroll
      for (int j = 0; j < 16; ++j) { a[j] = 0.125f * (float)j; b[j] = (j < 8) ? 2.0f + 0.25f * (float)j : 4.0f + 0.5f * (float)(j - 8); }
      const u32x6 pk = __builtin_amdgcn_cvt_scalef32_2xpk16_fp6_f32(a, b, 1.0f);
      const f32x32 rt = __builtin_amdgcn_cvt_scalef32_pk32_f32_fp6(pk, 1.0f);
#pragma unroll
      for (int i = 0; i < 32; ++i) { const float x = rt[i]; const int o = (x < 2.0f) ? (int)(x * 8.0f + 0.5f) : ((x < 4.0f) ? 16 + (int)((x - 2.0f) * 4.0f + 0.5f) : 24 + (int)((x - 4.0f) * 2.0f + 0.5f)); perm[i] = min(max(o, 0), 31); } }
    float* SC = (float*)(P.ws + WS_SC);
    __syncthreads();
    for (int layer = 0; layer < 2; ++layer) {
        cvt_table_fp6(F, P.in[I_PU] + (size_t)layer * 16384 * 2048, P.ws + WS_TBLU + (size_t)layer * 16384 * PT_ROWB, SC + layer * 16384, perm);
        cvt_table_fp6(F, P.in[I_PV] + (size_t)layer * 16384 * 2048, P.ws + WS_TBLV + (size_t)layer * 16384 * PT_ROWB, SC + (2 + layer) * 16384, perm);
    }
    __syncthreads();
}

DI void prologue(const Ctx& F, const Params& P) {
    adaln_partials(F, P);
    transpose_weight(F, P.in[I_EVWIN], 2048, 6144, (bf16_t*)(P.ws + WS_WEVIN));
    transpose_weight(F, P.in[I_EVWOUT], 2048, 2048, (bf16_t*)(P.ws + WS_WEVOUT));
    transpose_weight(F, P.in[I_ODWIN], 2048, 4096, (bf16_t*)(P.ws + WS_WODIN));
    transpose_weight(F, P.in[I_ODWOUT], 2048, 2048, (bf16_t*)(P.ws + WS_WODOUT));
    transpose_weight(F, P.in[I_PWQ], 2048, 2048, (bf16_t*)(P.ws + WS_WPQ));
    transpose_weight(F, P.in[I_PWQ] + (size_t)2048 * 2048, 2048, 2048, (bf16_t*)(P.ws + WS_WPQ) + (size_t)2048 * 2048);
    transpose_weight(F, P.in[I_GLUW], 1024, 1024, (bf16_t*)(P.ws + WS_WGLU));
    cvt_rows(F, P.in[I_PKEYS], (bf16_t*)(P.ws + WS_PKEYS), (size_t)2 * 8 * 2 * 128 * 128);
    cvt_rows(F, P.in[I_CNK], (bf16_t*)(P.ws + WS_CNK), (size_t)8 * 256 * 1024);
    cvt_rows(F, P.in[I_CDK], (bf16_t*)(P.ws + WS_CDK), (size_t)8 * 256 * 1024);
    transpose_cache_v(F, P.in[I_CNV], (bf16_t*)(P.ws + WS_CNVT));
    transpose_cache_v(F, P.in[I_CDV], (bf16_t*)(P.ws + WS_CDVT));
    hyena_filters(F, P);
    s5_consts(F, P);
    convert_peer_tables(F, P);
}
DI void norm_phase(const Ctx& F, const float* xa, const float* xb, const float* gvec, const float* modl, int sidx, bf16_t* H) {
    for (int T = F.bid * 8 + F.wave; T < TOK; T += F.G * 8) {
        const float* xr = T < TP ? xa + (size_t)T * DM : xb + (size_t)(T - TP) * DM;
        f32x4 v[8]; float ss = 0.f;
#pragma unroll
        for (int j = 0; j < 8; ++j) { v[j] = *(const f32x4*)(xr + (j * 64 + F.lane) * 4); ss += v[j].x * v[j].x + v[j].y * v[j].y + v[j].z * v[j].z + v[j].w * v[j].w; }
        ss = wave_sum(ss);
        const float rstd = rsqrtf(ss * (1.f / DM) + NORM_EPS);
        const float* sh = modl + (size_t)(cond_of(T) * 6 + sidx) * DM; const float* sc = sh + DM;
#pragma unroll
        for (int j = 0; j < 8; ++j) {
            const int col = (j * 64 + F.lane) * 4;
            const f32x4 g4 = *(const f32x4*)(gvec + col), s4 = *(const f32x4*)(sc + col), h4 = *(const f32x4*)(sh + col);
            const f32x4 o = v[j] * rstd * g4 * (s4 + 1.f) + h4;
            u32x2 w; w.x = pk2(o.x, o.y); w.y = pk2(o.z, o.w);
            *(u32x2*)(H + (size_t)T * DM + col) = w;
        }
    }
}

struct EpiBf16 {
    static constexpr bool PERM = true, AFTER_DRAIN = false;
    bf16_t* O; int ldc;
    DI void operator()(const f32x4 (&acc)[2][2][4][2], const pg8::Unit& u, int wr, int wc, int fr, int fq) const {
        const int row0 = u.pm * 256 + wr * 64 + fr, col0 = u.pn * 256 + wc * 32 + 8 * fq;
#pragma unroll
        for (int ai = 0; ai < 2; ++ai)
#pragma unroll
            for (int m = 0; m < 4; ++m) { bf16_t* rowp = O + (size_t)(row0 + ai * 128 + m * 16) * ldc + col0;
#pragma unroll
                for (int bj = 0; bj < 2; ++bj) { const f32x4 v0 = acc[ai][bj][m][0], v1 = acc[ai][bj][m][1];
                    u32x4 w; w.x = pk2(v0[0], v0[1]); w.y = pk2(v0[2], v0[3]); w.z = pk2(v1[0], v1[1]); w.w = pk2(v1[2], v1[3]);
                    *(u32x4*)(rowp + bj * 128) = w; } }
    }
};
struct EpiResid {
    static constexpr bool PERM = false, AFTER_DRAIN = false;
    const float* xa; const float* xb; float* out; const float* modl; int gidx;
    DI void operator()(const f32x4 (&acc)[2][2][4][2], const pg8::Unit& u, int wr, int wc, int fr, int fq) const {
        const int row0 = u.pm * 256 + wr * 64 + fr, col0 = u.pn * 256 + wc * 32 + 4 * fq;
        const float* xbase = (u.pm < 32) ? xa : xb - (size_t)TP * DM;
        const float* gate = modl + (size_t)(cond_of(u.pm * 256) * 6 + gidx) * DM;
        f32x4 gv[2][2];
#pragma unroll
        for (int bj = 0; bj < 2; ++bj)
#pragma unroll
            for (int n = 0; n < 2; ++n) gv[bj][n] = *(const f32x4*)(gate + col0 + bj * 128 + n * 16);
#pragma unroll
        for (int ai = 0; ai < 2; ++ai)
#pragma unroll
            for (int m = 0; m < 4; ++m) { const size_t ro = (size_t)(row0 + ai * 128 + m * 16) * DM + col0;
#pragma unroll
                for (int bj = 0; bj < 2; ++bj)
#pragma unroll
                    for (int n = 0; n < 2; ++n) { const f32x4 x4 = *(const f32x4*)(xbase + ro + bj * 128 + n * 16);
                        *(f32x4*)(out + ro + bj * 128 + n * 16) = x4 + gv[bj][n] * acc[ai][bj][m][n]; } }
    }
};
struct EpiGlu {
    static constexpr bool PERM = true, AFTER_DRAIN = false;
    const bf16_t* Y; bf16_t* O; const float* bias;
    DI void operator()(const f32x4 (&acc)[2][2][4][2], const pg8::Unit& u, int wr, int wc, int fr, int fq) const {
        const int row0 = u.pm * 256 + wr * 64 + fr, col0 = u.pn * 256 + wc * 32 + 8 * fq;
#pragma unroll
        for (int bj = 0; bj < 2; ++bj) {
            const f32x4 b0 = *(const f32x4*)(bias + col0 + bj * 128), b1 = *(const f32x4*)(bias + col0 + bj * 128 + 4);
#pragma unroll
            for (int ai = 0; ai < 2; ++ai)
#pragma unroll
                for (int m = 0; m < 4; ++m) { const size_t r = (size_t)(row0 + ai * 128 + m * 16);
                    const u32x4 yv = *(const u32x4*)(Y + r * 1024 + col0 + bj * 128);
                    const f32x4 a0 = acc[ai][bj][m][0] + b0, a1 = acc[ai][bj][m][1] + b1;
                    float o[8];
                    o[0] = bflo(yv.x) / (1.f + __expf(-a0[0])); o[1] = bfhi(yv.x) / (1.f + __expf(-a0[1]));
                    o[2] = bflo(yv.y) / (1.f + __expf(-a0[2])); o[3] = bfhi(yv.y) / (1.f + __expf(-a0[3]));
                    o[4] = bflo(yv.z) / (1.f + __expf(-a1[0])); o[5] = bfhi(yv.z) / (1.f + __expf(-a1[1]));
                    o[6] = bflo(yv.w) / (1.f + __expf(-a1[2])); o[7] = bfhi(yv.w) / (1.f + __expf(-a1[3]));
                    u32x4 w; w.x = pk2(o[0], o[1]); w.y = pk2(o[2], o[3]); w.z = pk2(o[4], o[5]); w.w = pk2(o[6], o[7]);
                    *(u32x4*)(O + r * DM + col0 + bj * 128) = w; }
        }
    }
};
template <class Epi> DI void run_gemm(const Ctx& F, const bf16_t* A, const bf16_t* Bt, int N, int K, const Epi& E) {
    pg8::Gemm g{A, Bt, TOK, N, K}; pg8::StaticOrder S; S.init(TOK, N, F.G, F.bid);
    pg8::gemm_phase<Epi, pg8::StaticOrder, false>(F.lds, g, S, E, nullptr);
    __syncthreads();
}

DI void prep_a(const Ctx& F, const Params& P) {
    const bf16_t* T1 = (const bf16_t*)(P.ws + WS_RA);
    bf16_t* VTp = (bf16_t*)(P.ws + WS_VT); bf16_t* VTs = (bf16_t*)(P.ws + WS_VT + VT_S);
    { struct VtMap { const bf16_t* T1; bf16_t* VTp; bf16_t* VTs;
          DI TrJob operator()(int t) const {
              if (t < 2048) { const int bh = t >> 3, sub = t & 7, tk = sub >> 1, dd = sub & 1, b = bh >> 3, h = bh & 7;
                  return TrJob{T1 + ((size_t)(b * 256 + tk * 64)) * 4096 + h * 128 + dd * 64, 4096, VTp + ((size_t)bh * 128 + dd * 64) * 256 + tk * 64, 256}; }
              const int u = t - 2048, bh = u >> 7, sub = u & 127, tk = sub >> 1, dd = sub & 1, b = bh >> 3, h = bh & 7;
              return TrJob{T1 + ((size_t)(TP + b * 4096 + tk * 64)) * 4096 + h * 128 + dd * 64, 4096, VTs + ((size_t)bh * 128 + dd * 64) * 4096 + tk * 64, 4096}; } };
      tr_pipeline_bf16(F, 2048 + 8192, VtMap{T1, VTp, VTs}, (LAS bf16_t*)F.lds); }
    { float* o = P.out + O_NAV;
      for (int e = F.bid * NTHR + F.tid; e < TP * 128; e += F.G * NTHR) { const int T = e >> 7, c8 = (e & 127) * 8;
          const u32x4 v = *(const u32x4*)(T1 + (size_t)T * 4096 + c8);
          *(f32x4*)(o + (size_t)T * 1024 + c8) = (f32x4){bflo(v.x), bfhi(v.x), bflo(v.y), bfhi(v.y)};
          *(f32x4*)(o + (size_t)T * 1024 + c8 + 4) = (f32x4){bflo(v.z), bfhi(v.z), bflo(v.w), bfhi(v.w)}; } }
    { LAS bf16_t* tl = (LAS bf16_t*)F.lds;
      bf16_t* CM = (bf16_t*)(P.ws + WS_RB);
      const float* cw = P.in[I_HYCW]; const float* cb = P.in[I_HYCB];
      u32x4 vv[4], hv = (u32x4){0u, 0u, 0u, 0u};
#define PA_LOAD(t_) do { const int cg_ = (t_) % 48, tg_ = (t_) / 48, ch0_ = cg_ * 64, t0_ = tg_ * 256; \
          _Pragma("unroll") for (int j = 0; j < 4; ++j) { const int id = F.tid + NTHR * j, tk = id >> 3, c8 = (id & 7) * 8; \
              vv[j] = *(const u32x4*)(T1 + (size_t)(t0_ + tk) * 4096 + 1024 + ch0_ + c8); } \
          if (F.tid < 16) { const int side = F.tid >> 3, c8 = (F.tid & 7) * 8; \
              const bool lz_ = (t0_ < TP) ? true : (((t0_ - TP) & 4095) == 0), rz_ = (t0_ < TP) ? true : (((t0_ + 256 - TP) & 4095) == 0); \
              const bool zero = side ? rz_ : lz_; const int tk = side ? t0_ + 256 : t0_ - 1; \
              hv = (u32x4){0u, 0u, 0u, 0u}; \
              if (!zero) hv = *(const u32x4*)(T1 + (size_t)tk * 4096 + 1024 + ch0_ + c8); } } while (0)
      if (F.bid < 48 * 160) PA_LOAD(F.bid);
      for (int t = F.bid; t < 48 * 160; t += F.G) {
          const int cg = t % 48, tg = t / 48, ch0 = cg * 64, t0 = tg * 256;
          __syncthreads();
#pragma unroll
          for (int j = 0; j < 4; ++j) { const int id = F.tid + NTHR * j, tk = id >> 3, c8 = (id & 7) * 8;
              const u32x4 v = vv[j];
              LAS bf16_t* d = tl + tk + 1;
              d[(c8 + 0) * 264] = (bf16_t)(v.x & 0xffff); d[(c8 + 1) * 264] = (bf16_t)(v.x >> 16); d[(c8 + 2) * 264] = (bf16_t)(v.y & 0xffff); d[(c8 + 3) * 264] = (bf16_t)(v.y >> 16);
              d[(c8 + 4) * 264] = (bf16_t)(v.z & 0xffff); d[(c8 + 5) * 264] = (bf16_t)(v.z >> 16); d[(c8 + 6) * 264] = (bf16_t)(v.w & 0xffff); d[(c8 + 7) * 264] = (bf16_t)(v.w >> 16); }
          if (F.tid < 16) { const int side = F.tid >> 3, c8 = (F.tid & 7) * 8;
              const u32x4 v = hv;
              LAS bf16_t* d = tl + (side ? 257 : 0);
              d[(c8 + 0) * 264] = (bf16_t)(v.x & 0xffff); d[(c8 + 1) * 264] = (bf16_t)(v.x >> 16); d[(c8 + 2) * 264] = (bf16_t)(v.y & 0xffff); d[(c8 + 3) * 264] = (bf16_t)(v.y >> 16);
              d[(c8 + 4) * 264] = (bf16_t)(v.z & 0xffff); d[(c8 + 5) * 264] = (bf16_t)(v.z >> 16); d[(c8 + 6) * 264] = (bf16_t)(v.w & 0xffff); d[(c8 + 7) * 264] = (bf16_t)(v.w >> 16); }
          if (t + F.G < 48 * 160) PA_LOAD(t + F.G);
          __syncthreads();
#pragma unroll
          for (int j = 0; j < 4; ++j) { const int id = F.tid + NTHR * j, ch = id >> 5, to = (id & 31) * 8, cgl = ch0 + ch;
              const float w0 = cw[cgl], w1 = cw[3072 + cgl], w2 = cw[6144 + cgl], bb = cb[cgl];
              const LAS bf16_t* s = tl + ch * 264 + to;
              float r[10];
#pragma unroll
              for (int i = 0; i < 10; ++i) r[i] = bf2f(s[i]);
              float o[8];
#pragma unroll
              for (int i = 0; i < 8; ++i) o[i] = w0 * r[i] + w1 * r[i + 1] + w2 * r[i + 2] + bb;
              u32x4 w; w.x = pk2(o[0], o[1]); w.y = pk2(o[2], o[3]); w.z = pk2(o[4], o[5]); w.w = pk2(o[6], o[7]);
              *(u32x4*)(CM + (size_t)cgl * TOK + t0 + to) = w; }
      }
#undef PA_LOAD
      __syncthreads(); }
}

DI void prep_b(const Ctx& F, const Params& P) {
    bf16_t* Pq = (bf16_t*)(P.ws + WS_RA); const float* qg = P.in[I_NAQG]; const float* kg = P.in[I_NAKG]; float* ok = P.out + O_NAK;
    const float* gsrc = (F.lane < 32 ? qg : kg) + (F.lane & 3) * 32;
    float g[32];
#pragma unroll
    for (int i = 0; i < 32; ++i) g[i] = gsrc[i];
    for (int T = F.bid * 8 + F.wave; T < TOK; T += F.G * 8) {
        bf16_t* rp = Pq + (size_t)T * 2048 + F.lane * 32;
        u32x4 v[4]; float x[32]; float ss = 0.f;
#pragma unroll
        for (int j = 0; j < 4; ++j) { v[j] = *(const u32x4*)(rp + j * 8);
            x[j * 8 + 0] = bflo(v[j].x); x[j * 8 + 1] = bfhi(v[j].x); x[j * 8 + 2] = bflo(v[j].y); x[j * 8 + 3] = bfhi(v[j].y);
            x[j * 8 + 4] = bflo(v[j].z); x[j * 8 + 5] = bfhi(v[j].z); x[j * 8 + 6] = bflo(v[j].w); x[j * 8 + 7] = bfhi(v[j].w); }
#pragma unroll
        for (int i = 0; i < 32; ++i) ss += x[i] * x[i];
        ss += dpp_xor1(ss); ss += dpp_xor2(ss);
        const float rstd = rsqrtf(ss * (1.f / 128.f) + NORM_EPS);
#pragma unroll
        for (int i = 0; i < 32; ++i) x[i] = x[i] * rstd * g[i];
#pragma unroll
        for (int j = 0; j < 4; ++j) { u32x4 w; w.x = pk2(x[j * 8 + 0], x[j * 8 + 1]); w.y = pk2(x[j * 8 + 2], x[j * 8 + 3]); w.z = pk2(x[j * 8 + 4], x[j * 8 + 5]); w.w = pk2(x[j * 8 + 6], x[j * 8 + 7]);
            *(u32x4*)(rp + j * 8) = w; }
        if (T < TP && F.lane >= 32) { float* o = ok + (size_t)T * 1024 + (F.lane - 32) * 32;
#pragma unroll
            for (int j = 0; j < 8; ++j) *(f32x4*)(o + j * 4) = (f32x4){x[j * 4], x[j * 4 + 1], x[j * 4 + 2], x[j * 4 + 3]}; }
    }
}
constexpr int AT_KROW = 272, AT_VROW = 136, AT_KTB = 64 * AT_KROW, AT_VTB = 128 * AT_VROW;
constexpr int AT_K0 = 0, AT_V0 = 2 * AT_KTB, AT_RPB = AT_V0 + 2 * AT_VTB;

struct TileMap { const bf16_t* latK; int latKld; const bf16_t* latV; int latVld; int nlat; const bf16_t* ctxK; const bf16_t* ctxV; int ntiles; };
struct TileRegs { u32x4 k[2], v[2]; };

DI void tile_src(const TileMap& M, int j, const bf16_t*& kp, int& kld, const bf16_t*& vp, int& vld) {
    if (j < M.nlat) { kp = M.latK + (size_t)j * 64 * M.latKld; kld = M.latKld; vp = M.latV + j * 64; vld = M.latVld; }
    else { const int c = j - M.nlat; kp = M.ctxK + (size_t)c * 64 * 1024; kld = 1024; vp = M.ctxV + c * 64; vld = 256; }
}
DI void tile_load(const Ctx& F, TileRegs& R, const bf16_t* kp, int kld, const bf16_t* vp, int vld, bool withV = true) {
#pragma unroll
    for (int j = 0; j < 2; ++j) { const int id = F.tid + NTHR * j;
        const unsigned ko = (unsigned)((id >> 4) * kld + (id & 15) * 8) * 2u, vo = (unsigned)((id >> 3) * vld + (id & 7) * 8) * 2u;
        R.k[j] = *(const u32x4*)((const char*)kp + ko);
        if (withV) R.v[j] = *(const u32x4*)((const char*)vp + vo); }
}
DI void tile_store(const Ctx& F, const TileRegs& R, LAS unsigned char* kt, LAS unsigned char* vt, bool withV = true) {
#pragma unroll
    for (int j = 0; j < 2; ++j) { const int id = F.tid + NTHR * j;
        *(LAS u32x4*)(kt + (id >> 4) * AT_KROW + (id & 15) * 16) = R.k[j];
        if (withV) { LAS unsigned char* vp = vt + (id >> 3) * AT_VROW + (id & 7) * 16;
            *(LAS u32x2*)(vp) = (u32x2){R.v[j].x, R.v[j].y}; *(LAS u32x2*)(vp + 8) = (u32x2){R.v[j].z, R.v[j].w}; } }
}

DI void tile_norm_k(const Ctx& F, TileRegs& R, const LAS float* kgain, float* nk, int nkld) {
#pragma unroll
    for (int j = 0; j < 2; ++j) { const int id = F.tid + NTHR * j;
        float x[8] = {bflo(R.k[j].x), bfhi(R.k[j].x), bflo(R.k[j].y), bfhi(R.k[j].y), bflo(R.k[j].z), bfhi(R.k[j].z), bflo(R.k[j].w), bfhi(R.k[j].w)};
        float ss = 0.f;
#pragma unroll
        for (int i = 0; i < 8; ++i) ss += x[i] * x[i];
        ss += dpp_xor1(ss); ss += dpp_xor2(ss);
        ss += __builtin_bit_cast(float, __builtin_amdgcn_update_dpp(0, __builtin_bit_cast(int, ss), 0x141, 0xF, 0xF, true));
        ss += __builtin_bit_cast(float, __builtin_amdgcn_update_dpp(0, __builtin_bit_cast(int, ss), 0x140, 0xF, 0xF, true));
        const float rstd = rsqrtf(ss * (1.f / 128.f) + NORM_EPS);
        const f32x4 g0 = *(const LAS f32x4*)(kgain + (id & 15) * 8), g1 = *(const LAS f32x4*)(kgain + (id & 15) * 8 + 4);
        x[0] *= rstd * g0.x; x[1] *= rstd * g0.y; x[2] *= rstd * g0.z; x[3] *= rstd * g0.w; x[4] *= rstd * g1.x; x[5] *= rstd * g1.y; x[6] *= rstd * g1.z; x[7] *= rstd * g1.w;
        R.k[j] = (u32x4){pk2(x[0], x[1]), pk2(x[2], x[3]), pk2(x[4], x[5]), pk2(x[6], x[7])};
        if (nk) { float* o = nk + (size_t)(id >> 4) * nkld + (id & 15) * 8; *(f32x4*)(o) = (f32x4){x[0], x[1], x[2], x[3]}; *(f32x4*)(o + 4) = (f32x4){x[4], x[5], x[6], x[7]}; }
    }
}

template <int KS>
DI f32x16 qk_tile(LAS const unsigned char* kt, const bf16x8 (&Qf)[8], int kb, int kk0, int q, int hh) {
    f32x16 S;
#pragma unroll
    for (int i = 0; i < 16; ++i) S[i] = 0.f;
#pragma unroll
    for (int ks = 0; ks < KS; ++ks) { const int kk = kk0 + ks;
        const bf16x8 A = *(const LAS bf16x8*)(kt + (kb * 32 + q) * AT_KROW + (kk * 16 + hh * 8) * 2);
        S = __builtin_amdgcn_mfma_f32_32x32x16_bf16(A, Qf[kk], S, 0, 0, 0); }
    return S;
}
DI void pv_tile(LAS const unsigned char* vt, const float (&p)[16], f32x16 (&O)[4], int kb, int q, int hh) {
#pragma unroll
    for (int s = 0; s < 2; ++s) {
        u32x4 pw; pw.x = pk2(p[8 * s + 0], p[8 * s + 1]); pw.y = pk2(p[8 * s + 2], p[8 * s + 3]); pw.z = pk2(p[8 * s + 4], p[8 * s + 5]); pw.w = pk2(p[8 * s + 6], p[8 * s + 7]);
        const bf16x8 Pf = __builtin_bit_cast(bf16x8, pw);
#pragma unroll
        for (int db = 0; db < 4; ++db) {
            LAS const unsigned char* ap = vt + (db * 32 + q) * AT_VROW + (kb * 32 + 16 * s + 4 * hh) * 2;
            const u32x2 lo = *(const LAS u32x2*)(ap), hi = *(const LAS u32x2*)(ap + 16);
            const bf16x8 A2 = __builtin_bit_cast(bf16x8, (u32x4){lo.x, lo.y, hi.x, hi.y});
            O[db] = __builtin_amdgcn_mfma_f32_32x32x16_bf16(A2, Pf, O[db], 0, 0, 0);
        }
        asm volatile("" ::: "memory");
    }
}
template <bool LAT>
DI void attn_compute1(LAS const unsigned char* kt, LAS const unsigned char* vt, const bf16x8 (&Qf)[8], f32x16 (&O)[4], float& ls, int lane, const LAS float* blane, int mb) {
    const int q = lane & 31, hh = lane >> 5;
#pragma unroll 1
    for (int kb = 0; kb < 2; ++kb) {
        float bb[16];
        if (LAT) {
#pragma unroll
            for (int i = 0; i < 16; ++i) bb[i] = blane[kb * 32 + (i & 3) + 8 * (i >> 2)];
        }
        const f32x16 S = qk_tile<8>(kt, Qf, kb, 0, q, hh);
        float p[16];
#pragma unroll
        for (int i = 0; i < 16; ++i) {
            if (LAT) { const float e = __builtin_amdgcn_exp2f(S[i] + bb[i]);
                p[i] = ((unsigned)(kb * 32 + (i & 3) + 8 * (i >> 2) + mb) < 16u) ? e : 0.f; }
            else p[i] = __builtin_amdgcn_exp2f(S[i]);
            ls += p[i];
        }
        pv_tile(vt, p, O, kb, q, hh);
    }
}
DI void diff_pass1(LAS const unsigned char* kt, const bf16x8 (&Qf)[8], float (&ls)[2], int lane) {
    const int q = lane & 31, hh = lane >> 5;
#pragma unroll
    for (int kb = 0; kb < 2; ++kb) {
#pragma unroll
        for (int mp = 0; mp < 2; ++mp) { const f32x16 S = qk_tile<4>(kt, Qf, kb, mp * 4, q, hh);
#pragma unroll
            for (int i = 0; i < 16; ++i) ls[mp] += __builtin_amdgcn_exp2f(S[i]); }
    }
}
DI void diff_pass2(LAS const unsigned char* kt, LAS const unsigned char* vt, const bf16x8 (&Qf)[8], f32x16 (&O)[4], float w0, float w1, int lane) {
    const int q = lane & 31, hh = lane >> 5;
#pragma unroll
    for (int kb = 0; kb < 2; ++kb) {
        float p[16];
        { const f32x16 S0 = qk_tile<4>(kt, Qf, kb, 0, q, hh);
#pragma unroll
          for (int i = 0; i < 16; ++i) p[i] = __builtin_amdgcn_exp2f(S0[i]) * w0; }
        { const f32x16 S1 = qk_tile<4>(kt, Qf, kb, 4, q, hh);
#pragma unroll
          for (int i = 0; i < 16; ++i) p[i] -= __builtin_amdgcn_exp2f(S1[i]) * w1; }
        pv_tile(vt, p, O, kb, q, hh);
    }
}

template <int MODE>
DI void attn_phase(const Ctx& F, const Params& P) {
    constexpr bool DIFF = (MODE >= 2);
    constexpr bool NA = (MODE == 1);
    LAS unsigned char* lds = F.lds;
    LAS float* rpbl = (LAS float*)(lds + AT_RPB);
    LAS float* kgl = (LAS float*)(lds + AT_RPB + 2048);
    if (!DIFF) { __syncthreads(); if (F.tid < 128) kgl[F.tid] = P.in[I_NAKG][F.tid]; __syncthreads(); }
    const bf16_t* PA = (const bf16_t*)(P.ws + WS_RA);
    bf16_t* MIX = (bf16_t*)(P.ws + WS_HM);
    const bf16_t* VTp = (const bf16_t*)(P.ws + WS_VT); const bf16_t* VTs = (const bf16_t*)(P.ws + WS_VT + VT_S);
    const int q = F.lane & 31, hh = F.lane >> 5;
    const float c1 = (DIFF ? 0.125f : 0.08838834764831845f) * LOG2E;
    float lam = 0.f;
    if (DIFF) {
        const float a = wave_sum(P.in[I_LQ1][F.lane] * P.in[I_LK1][F.lane]), b = wave_sum(P.in[I_LQ2][F.lane] * P.in[I_LK2][F.lane]);
        lam = __expf(a) - __expf(b) + 0.35550906759096924f;
    }
    const int nunits = (MODE == 0 || MODE == 2) ? 256 : 1024;
    for (int u0 = F.bid; u0 < nunits; u0 += F.G) {
        int u = u0;
        if ((MODE == 1 || MODE == 3) && F.G == 256) { const int i = u0 >> 8, x = F.bid & 7, y = F.bid >> 3; u = ((2 * i + (y >> 4)) * 8 + x) * 16 + (y & 15); }
        int b, h, tok0, r = 0, rlo = 0; TileMap M;
        const bf16_t* qptr;
        if (MODE == 0) { b = u >> 3; h = u & 7; tok0 = b * 256 + F.wave * 32;
            qptr = PA + (size_t)(tok0 + q) * 2048 + h * 128;
            M.latK = PA + (size_t)(b * 256) * 2048 + 1024 + h * 128; M.latKld = 2048; M.latV = VTp + (size_t)(b * 8 + h) * 128 * 256; M.latVld = 256; M.nlat = 4; M.ctxK = nullptr; M.ctxV = nullptr; M.ntiles = 4; }
        else if (MODE == 1) { b = u >> 7; h = (u >> 4) & 7; const int rg = u & 15; r = 4 * rg + (F.wave >> 1);
            rlo = min(max(4 * rg - 4, 0), 56); const int rhi = min(max(4 * rg + 3 - 4, 0), 56) + 8;
            tok0 = TP + b * 4096 + r * 64 + (F.wave & 1) * 32;
            qptr = PA + (size_t)(tok0 + q) * 2048 + h * 128;
            M.latK = PA + (size_t)(TP + b * 4096 + rlo * 64) * 2048 + 1024 + h * 128; M.latKld = 2048; M.latV = VTs + (size_t)(b * 8 + h) * 128 * 4096 + rlo * 64; M.latVld = 4096; M.nlat = rhi - rlo;
            M.ctxK = (const bf16_t*)(P.ws + WS_CNK) + (size_t)b * 256 * 1024 + h * 128; M.ctxV = (const bf16_t*)(P.ws + WS_CNVT) + (size_t)(b * 8 + h) * 128 * 256; M.ntiles = M.nlat + 4;
            if (F.tid < 465) rpbl[F.tid] = P.in[I_RPB][h * 465 + F.tid] * LOG2E; }
        else if (MODE == 2) { b = u >> 3; h = u & 7; tok0 = b * 256 + F.wave * 32;
            qptr = PA + (size_t)(tok0 + q) * 4096 + 1024 + h * 128;
            M.latK = PA + (size_t)(b * 256) * 4096 + 2048 + h * 128; M.latKld = 4096; M.latV = VTp + (size_t)(b * 8 + h) * 128 * 256; M.latVld = 256; M.nlat = 4; M.ctxK = nullptr; M.ctxV = nullptr; M.ntiles = 4; }
        else { b = u >> 7; h = (u >> 4) & 7; const int qb = u & 15; tok0 = TP + b * 4096 + qb * 256 + F.wave * 32;
            qptr = PA + (size_t)(tok0 + q) * 4096 + 1024 + h * 128;
            M.latK = PA + (size_t)(TP + b * 4096) * 4096 + 2048 + h * 128; M.latKld = 4096; M.latV = VTs + (size_t)(b * 8 + h) * 128 * 4096; M.latVld = 4096; M.nlat = 64;
            M.ctxK = (const bf16_t*)(P.ws + WS_CDK) + (size_t)b * 256 * 1024 + h * 128; M.ctxV = (const bf16_t*)(P.ws + WS_CDVT) + (size_t)(b * 8 + h) * 128 * 256; M.ntiles = 68; }
        bf16x8 Qf[8];
        if constexpr (!DIFF) {
            u32x4 w[8]; float ss = 0.f;
#pragma unroll
            for (int ks = 0; ks < 8; ++ks) { w[ks] = *(const u32x4*)(qptr + ks * 16 + hh * 8);
                ss += bflo(w[ks].x) * bflo(w[ks].x) + bfhi(w[ks].x) * bfhi(w[ks].x) + bflo(w[ks].y) * bflo(w[ks].y) + bfhi(w[ks].y) * bfhi(w[ks].y)
                    + bflo(w[ks].z) * bflo(w[ks].z) + bfhi(w[ks].z) * bfhi(w[ks].z) + bflo(w[ks].w) * bflo(w[ks].w) + bfhi(w[ks].w) * bfhi(w[ks].w); }
            ss += __shfl_xor(ss, 32);
            const float qs = rsqrtf(ss * (1.f / 128.f) + NORM_EPS) * c1;
            const float* qg = P.in[I_NAQG];
#pragma unroll
            for (int ks = 0; ks < 8; ++ks) { const f32x4 g0 = *(const f32x4*)(qg + ks * 16 + hh * 8), g1 = *(const f32x4*)(qg + ks * 16 + hh * 8 + 4);
                const u32x4 ws = (u32x4){pk2(bflo(w[ks].x) * qs * g0.x, bfhi(w[ks].x) * qs * g0.y), pk2(bflo(w[ks].y) * qs * g0.z, bfhi(w[ks].y) * qs * g0.w),
                                         pk2(bflo(w[ks].z) * qs * g1.x, bfhi(w[ks].z) * qs * g1.y), pk2(bflo(w[ks].w) * qs * g1.z, bfhi(w[ks].w) * qs * g1.w)};
                Qf[ks] = __builtin_bit_cast(bf16x8, ws); }
        } else {
#pragma unroll
        for (int ks = 0; ks < 8; ++ks) { const u32x4 w = *(const u32x4*)(qptr + ks * 16 + hh * 8);
            const u32x4 ws = (u32x4){pk2(bflo(w.x) * c1, bfhi(w.x) * c1), pk2(bflo(w.y) * c1, bfhi(w.y) * c1), pk2(bflo(w.z) * c1, bfhi(w.z) * c1), pk2(bflo(w.w) * c1, bfhi(w.w) * c1)};
            Qf[ks] = __builtin_bit_cast(bf16x8, ws); }
        }
        f32x16 O[4]; float ls[2] = {0.f, 0.f}; float w0 = 0.f, w1 = 0.f;
#pragma unroll
        for (int db = 0; db < 4; ++db)
#pragma unroll
            for (int i = 0; i < 16; ++i) O[db][i] = 0.f;
        const int cq = (F.wave & 1) * 32 + q, cs = min(max(cq - 8, 0), 48);
        const int r0w = min(max(r - 4, 0), 56);
        const int nt = M.ntiles;
        TileRegs R;
        { const bf16_t* kp; const bf16_t* vp; int kld, vld; tile_src(M, 0, kp, kld, vp, vld); tile_load(F, R, kp, kld, vp, vld); }
        if constexpr (!DIFF) tile_norm_k(F, R, kgl, (MODE == 0) ? P.out + O_NAK + (size_t)(b * 256) * 1024 + h * 128 : nullptr, 1024);
        tile_store(F, R, lds + AT_K0, lds + AT_V0);
        __syncthreads();
        if constexpr (DIFF) {
#pragma unroll 1
            for (int j = 0; j < nt; ++j) {
                const int cur = j & 1, jn = (j + 1 < nt) ? j + 1 : 0;
                const bool wv = (j + 1 == nt);
                { const bf16_t* kp; const bf16_t* vp; int kld, vld; tile_src(M, jn, kp, kld, vp, vld); tile_load(F, R, kp, kld, vp, vld, wv); }
                diff_pass1(lds + AT_K0 + cur * AT_KTB, Qf, ls, F.lane);
                tile_store(F, R, lds + AT_K0 + (cur ^ 1) * AT_KTB, lds + AT_V0 + (cur ^ 1) * AT_VTB, wv);
                __syncthreads();
            }
            { const float l0 = ls[0] + __shfl_xor(ls[0], 32), l1 = ls[1] + __shfl_xor(ls[1], 32); w0 = 1.f / l0; w1 = lam / l1; }
#pragma unroll 1
            for (int j = 0; j < nt; ++j) {
                const int cur = (nt + j) & 1;
                if (j + 1 < nt) { const bf16_t* kp; const bf16_t* vp; int kld, vld; tile_src(M, j + 1, kp, kld, vp, vld); tile_load(F, R, kp, kld, vp, vld); }
                diff_pass2(lds + AT_K0 + cur * AT_KTB, lds + AT_V0 + cur * AT_VTB, Qf, O, w0, w1, F.lane);
                if (j + 1 < nt) tile_store(F, R, lds + AT_K0 + (cur ^ 1) * AT_KTB, lds + AT_V0 + (cur ^ 1) * AT_VTB);
                __syncthreads();
            }
        } else {
#pragma unroll 1
            for (int j = 0; j < nt; ++j) {
                const int cur = j & 1;
                if (j + 1 < nt) { const bf16_t* kp; const bf16_t* vp; int kld, vld; tile_src(M, j + 1, kp, kld, vp, vld); tile_load(F, R, kp, kld, vp, vld); }
                LAS const unsigned char* kt = lds + AT_K0 + cur * AT_KTB; LAS const unsigned char* vt = lds + AT_V0 + cur * AT_VTB;
                if constexpr (NA) {
                    if (j < M.nlat) { const int kr = rlo + j;
                        if (kr >= r0w && kr < r0w + 8) attn_compute1<true>(kt, vt, Qf, O, ls[0], F.lane, rpbl + (kr - r + 7) * 31 + (4 * hh - cq + 15), 4 * hh - cs); }
                    else attn_compute1<false>(kt, vt, Qf, O, ls[0], F.lane, rpbl, 0);
                } else attn_compute1<false>(kt, vt, Qf, O, ls[0], F.lane, rpbl, 0);
                if (j + 1 < nt) {
                    if (j + 1 < M.nlat) tile_norm_k(F, R, kgl, (MODE == 0) ? P.out + O_NAK + (size_t)(b * 256 + (j + 1) * 64) * 1024 + h * 128 : nullptr, 1024);
                    tile_store(F, R, lds + AT_K0 + (cur ^ 1) * AT_KTB, lds + AT_V0 + (cur ^ 1) * AT_VTB); }
                __syncthreads();
            }
        }
        if constexpr (!DIFF) {
            const float inv = 1.f / (ls[0] + __shfl_xor(ls[0], 32));
            bf16_t* op = MIX + (size_t)(tok0 + q) * DM + h * 128 + 4 * hh;
#pragma unroll
            for (int db = 0; db < 4; ++db)
#pragma unroll
                for (int g = 0; g < 4; ++g) { u32x2 w; w.x = pk2(O[db][4 * g] * inv, O[db][4 * g + 1] * inv); w.y = pk2(O[db][4 * g + 2] * inv, O[db][4 * g + 3] * inv);
                    *(u32x2*)(op + db * 32 + 8 * g) = w; }
        } else {
            float ss = 0.f;
#pragma unroll
            for (int db = 0; db < 4; ++db)
#pragma unroll
                for (int i = 0; i < 16; ++i) ss += O[db][i] * O[db][i];
            ss += __shfl_xor(ss, 32);
            const float sc = rsqrtf(ss * (1.f / 128.f) + NORM_EPS) * (1.f - 0.35550906759096924f);
            const float* sg = P.in[I_SUBG];
            bf16_t* op = MIX + (size_t)(tok0 + q) * DM + 1024 + h * 128 + 4 * hh;
#pragma unroll
            for (int db = 0; db < 4; ++db)
#pragma unroll
                for (int g = 0; g < 4; ++g) { const f32x4 g4 = *(const f32x4*)(sg + db * 32 + 8 * g + 4 * hh);
                    u32x2 w; w.x = pk2(O[db][4 * g] * sc * g4.x, O[db][4 * g + 1] * sc * g4.y); w.y = pk2(O[db][4 * g + 2] * sc * g4.z, O[db][4 * g + 3] * sc * g4.w);
                    *(u32x2*)(op + db * 32 + 8 * g) = w; }
        }
    }
}

DI float diff_lambda(const Ctx& F, const Params& P) {
    const float la = wave_sum(P.in[I_LQ1][F.lane] * P.in[I_LK1][F.lane]), lb = wave_sum(P.in[I_LQ2][F.lane] * P.in[I_LK2][F.lane]);
    return __expf(la) - __expf(lb) + 0.35550906759096924f;
}
template <bool SAMPLE>
DI void attn_diff_phase(const Ctx& F, const Params& P, const float lam) {
    LAS unsigned char* lds = F.lds;
    const bf16_t* PA = (const bf16_t*)(P.ws + WS_RA);
    bf16_t* MIX = (bf16_t*)(P.ws + WS_HM);
    const bf16_t* VTp = (const bf16_t*)(P.ws + WS_VT); const bf16_t* VTs = (const bf16_t*)(P.ws + WS_VT + VT_S);
    const int q = F.lane & 31, hh = F.lane >> 5, mp = F.wave >> 2, qg = F.wave & 3;
    const float c1 = 0.125f * LOG2E;
    const int nunits = SAMPLE ? 1024 : 256;
    for (int u0 = F.bid; u0 < nunits; u0 += F.G) {
        int u = u0;
        if (SAMPLE && F.G == 256) { const int i = u0 >> 8, x = F.bid & 7, y = F.bid >> 3; u = ((2 * i + (y >> 4)) * 8 + x) * 16 + (y & 15); }
        int b, h, tok0; TileMap M;
        if (!SAMPLE) { b = u >> 3; h = u & 7; tok0 = b * 256 + qg * 64;
            M.latK = PA + (size_t)(b * 256) * 4096 + 2048 + h * 128; M.latKld = 4096; M.latV = VTp + (size_t)(b * 8 + h) * 128 * 256; M.latVld = 256; M.nlat = 4; M.ctxK = nullptr; M.ctxV = nullptr; M.ntiles = 4; }
        else { b = u >> 7; h = (u >> 4) & 7; tok0 = TP + b * 4096 + (u & 15) * 256 + qg * 64;
            M.latK = PA + (size_t)(TP + b * 4096) * 4096 + 2048 + h * 128; M.latKld = 4096; M.latV = VTs + (size_t)(b * 8 + h) * 128 * 4096; M.latVld = 4096; M.nlat = 64;
            M.ctxK = (const bf16_t*)(P.ws + WS_CDK) + (size_t)b * 256 * 1024 + h * 128; M.ctxV = (const bf16_t*)(P.ws + WS_CDVT) + (size_t)(b * 8 + h) * 128 * 256; M.ntiles = 68; }
        LAS unsigned char* qst = lds + 73728 + F.wave * 8192 + F.lane * 16;
#pragma unroll
        for (int sb = 0; sb < 2; ++sb) { const bf16_t* qptr = PA + (size_t)(tok0 + sb * 32 + q) * 4096 + 1024 + h * 128 + mp * 64;
#pragma unroll
            for (int ks = 0; ks < 4; ++ks) { const u32x4 w = *(const u32x4*)(qptr + ks * 16 + hh * 8);
                const u32x4 ws = (u32x4){pk2(bflo(w.x) * c1, bfhi(w.x) * c1), pk2(bflo(w.y) * c1, bfhi(w.y) * c1), pk2(bflo(w.z) * c1, bfhi(w.z) * c1), pk2(bflo(w.w) * c1, bfhi(w.w) * c1)};
                *(LAS u32x4*)(qst + (sb * 4 + ks) * 1024) = ws; } }
        f32x16 O[2][4]; float ls[2] = {0.f, 0.f};
#pragma unroll
        for (int sb = 0; sb < 2; ++sb)
#pragma unroll
            for (int db = 0; db < 4; ++db)
#pragma unroll
                for (int i = 0; i < 16; ++i) O[sb][db][i] = 0.f;
        const int nt = M.ntiles;
        TileRegs R;
        { const bf16_t* kp; const bf16_t* vp; int kld, vld; tile_src(M, 0, kp, kld, vp, vld); tile_load(F, R, kp, kld, vp, vld); }
        tile_store(F, R, lds + AT_K0, lds + AT_V0);
        __syncthreads();
#pragma unroll 1
        for (int j = 0; j < nt; ++j) {
            const int cur = j & 1;
            if (j + 1 < nt) { const bf16_t* kp; const bf16_t* vp; int kld, vld; tile_src(M, j + 1, kp, kld, vp, vld); tile_load(F, R, kp, kld, vp, vld); }
            LAS const unsigned char* kt = lds + AT_K0 + cur * AT_KTB; LAS const unsigned char* vt = lds + AT_V0 + cur * AT_VTB;
#pragma unroll 1
            for (int kb = 0; kb < 2; ++kb) {
                f32x16 S0, S1;
#pragma unroll
                for (int i = 0; i < 16; ++i) { S0[i] = 0.f; S1[i] = 0.f; }
#pragma unroll
                for (int ks = 0; ks < 4; ++ks) { const bf16x8 A = *(const LAS bf16x8*)(kt + (kb * 32 + q) * AT_KROW + ((mp * 4 + ks) * 16 + hh * 8) * 2);
                    S0 = __builtin_amdgcn_mfma_f32_32x32x16_bf16(A, *(const LAS bf16x8*)(qst + ks * 1024), S0, 0, 0, 0);
                    S1 = __builtin_amdgcn_mfma_f32_32x32x16_bf16(A, *(const LAS bf16x8*)(qst + (4 + ks) * 1024), S1, 0, 0, 0); }
                u32x4 pa[2], pb[2];
                { float l0 = 0.f, l1 = 0.f;
#pragma unroll
                for (int sp = 0; sp < 2; ++sp) { float e0[8], e1[8];
#pragma unroll
                    for (int i = 0; i < 8; ++i) { e0[i] = __builtin_amdgcn_exp2f(S0[8 * sp + i]); e1[i] = __builtin_amdgcn_exp2f(S1[8 * sp + i]); l0 += e0[i]; l1 += e1[i]; }
                    pa[sp] = (u32x4){pk2(e0[0], e0[1]), pk2(e0[2], e0[3]), pk2(e0[4], e0[5]), pk2(e0[6], e0[7])};
                    pb[sp] = (u32x4){pk2(e1[0], e1[1]), pk2(e1[2], e1[3]), pk2(e1[4], e1[5]), pk2(e1[6], e1[7])}; }
                ls[0] += l0; ls[1] += l1; }
#pragma unroll
                for (int sp = 0; sp < 2; ++sp) {
                    const bf16x8 Pa = __builtin_bit_cast(bf16x8, pa[sp]), Pb = __builtin_bit_cast(bf16x8, pb[sp]);
#pragma unroll
                    for (int db = 0; db < 4; ++db) {
                        LAS const unsigned char* ap = vt + (db * 32 + q) * AT_VROW + (kb * 32 + 16 * sp + 4 * hh) * 2;
                        const u32x2 lo = *(const LAS u32x2*)(ap), hi = *(const LAS u32x2*)(ap + 16);
                        const bf16x8 A2 = __builtin_bit_cast(bf16x8, (u32x4){lo.x, lo.y, hi.x, hi.y});
                        O[0][db] = __builtin_amdgcn_mfma_f32_32x32x16_bf16(A2, Pa, O[0][db], 0, 0, 0);
                        O[1][db] = __builtin_amdgcn_mfma_f32_32x32x16_bf16(A2, Pb, O[1][db], 0, 0, 0);
                    }
                    asm volatile("" ::: "memory");
                }
            }
            if (j + 1 < nt) tile_store(F, R, lds + AT_K0 + (cur ^ 1) * AT_KTB, lds + AT_V0 + (cur ^ 1) * AT_VTB);
            __syncthreads();
        }
        LAS float* xch = (LAS float*)lds + qg * 8192 + F.lane;
        float lt[2];
#pragma unroll
        for (int sb = 0; sb < 2; ++sb) lt[sb] = ls[sb] + __shfl_xor(ls[sb], 32);
        if (mp == 1) {
#pragma unroll
            for (int sb = 0; sb < 2; ++sb) { const float w1 = lam / lt[sb];
#pragma unroll
                for (int db = 0; db < 4; ++db)
#pragma unroll
                    for (int i = 0; i < 16; ++i) xch[((sb * 4 + db) * 16 + i) * 64] = O[sb][db][i] * w1; } }
        __syncthreads();
        if (mp == 0) {
            const float* sg = P.in[I_SUBG];
#pragma unroll
            for (int sb = 0; sb < 2; ++sb) { const float w0 = 1.f / lt[sb]; float ss = 0.f;
#pragma unroll
                for (int db = 0; db < 4; ++db)
#pragma unroll
                    for (int i = 0; i < 16; ++i) { const float o = O[sb][db][i] * w0 - xch[((sb * 4 + db) * 16 + i) * 64]; O[sb][db][i] = o; ss += o * o; }
                ss += __shfl_xor(ss, 32);
                const float sc = rsqrtf(ss * (1.f / 128.f) + NORM_EPS) * (1.f - 0.35550906759096924f);
                bf16_t* op = MIX + (size_t)(tok0 + sb * 32 + q) * DM + 1024 + h * 128 + 4 * hh;
#pragma unroll
                for (int db = 0; db < 4; ++db)
#pragma unroll
                    for (int g = 0; g < 4; ++g) { const f32x4 g4 = *(const f32x4*)(sg + db * 32 + 8 * g + 4 * hh);
                        u32x2 w; w.x = pk2(O[sb][db][4 * g] * sc * g4.x, O[sb][db][4 * g + 1] * sc * g4.y); w.y = pk2(O[sb][db][4 * g + 2] * sc * g4.z, O[sb][db][4 * g + 3] * sc * g4.w);
                        *(u32x2*)(op + db * 32 + 8 * g) = w; } } }
        __syncthreads();
    }
}
template <int L, int BATCH> struct HyCfg {
    static constexpr int NB = L / 64, TPT = 32 / BATCH, NTILES = NB / TPT, LOGB = (BATCH == 8) ? 3 : 5;
    static constexpr int ZROWB = (L + 384) * 2 + 16, ZBYTES = BATCH * ZROWB, RL = 2 * L + 16;
    static constexpr int TPW = (NTILES + 7) / 8;
};
constexpr int HY_KR_OFF = 71808;

template <int L, int BATCH>
DI void hyena_part(const Ctx& F, const Params& P, int c, int tokbase  , const bf16_t* KRG  ) {
    typedef HyCfg<L, BATCH> C;
    LAS unsigned char* lds = F.lds;
    bf16_t* CM = (bf16_t*)(P.ws + WS_RB);
    const float* hbias = P.in[I_HYBIAS];
    const int q = F.lane & 31, hh = F.lane >> 5;
    __syncthreads();
    for (int id = F.tid; id < BATCH * (L / 8); id += NTHR) { const int b = id / (L / 8), s8 = (id % (L / 8)) * 8;
        *(LAS u32x4*)(lds + b * C::ZROWB + (192 + s8) * 2) = *(const u32x4*)(CM + (size_t)c * TOK + tokbase + b * L + s8); }
    for (int id = F.tid; id < BATCH * 48; id += NTHR) { const int b = id / 48, k = id % 48, e = (k < 24) ? k * 8 : (192 + L + (k - 24) * 8);
        *(LAS u32x4*)(lds + b * C::ZROWB + e * 2) = (u32x4){0u, 0u, 0u, 0u}; }
#pragma unroll 1
    for (int o = 0; o < 2; ++o) {
        { const bf16_t* src = KRG + (size_t)(o * 1024 + c) * C::RL;
          for (int id = F.tid; id < C::RL / 8; id += NTHR) { const u32x4 v = *(const u32x4*)(src + id * 8);
              *(LAS u32x4*)(lds + HY_KR_OFF + id * 16) = v;
              LAS bf16_t* c1 = (LAS bf16_t*)(lds + HY_KR_OFF + C::RL * 2) + id * 8 - 1;
              if (id > 0) c1[0] = (bf16_t)(v.x & 0xffff);
              c1[1] = (bf16_t)(v.x >> 16); c1[2] = (bf16_t)(v.y & 0xffff); c1[3] = (bf16_t)(v.y >> 16); c1[4] = (bf16_t)(v.z & 0xffff); c1[5] = (bf16_t)(v.z >> 16);
              c1[6] = (bf16_t)(v.w & 0xffff); c1[7] = (bf16_t)(v.w >> 16); } }
        __syncthreads();
        f32x16 acc[C::TPW][2];
#pragma unroll
        for (int t = 0; t < C::TPW; ++t)
#pragma unroll
            for (int mt = 0; mt < 2; ++mt)
#pragma unroll
                for (int i = 0; i < 16; ++i) acc[t][mt][i] = 0.f;
        const int tq0 = F.wave * C::TPW;
        if (tq0 < C::NTILES) {
            const int d1lo = C::TPT * tq0 - (C::NB - 1), d1hi = C::TPT * (tq0 + C::TPW - 1) + C::TPT - 1;
            const int abase = HY_KR_OFF + (F.lane & 1) * (C::RL * 2) + (L - (F.lane & 31) + 8 * hh - (F.lane & 1)) * 2;
            bf16x8 W0[6], W1[6], B0[C::TPW][4];
#define HY_LDW(Wv, d1v, i) do { LAS const unsigned* ap_ = (LAS const unsigned*)(lds + abase + (-4 * (d1v) - 2 + (i)) * 32); Wv[i] = __builtin_bit_cast(bf16x8, (u32x4){ap_[0], ap_[1], ap_[2], ap_[3]}); } while (0)
#define HY_LDB(Bv, d1v) do { _Pragma("unroll") for (int t_ = 0; t_ < C::TPW; ++t_) { const int tq_ = tq0 + t_; \
            const int t1_ = C::TPT * tq_ + (q >> C::LOGB), b_ = q & (BATCH - 1); int s1_ = t1_ - (d1v); s1_ = min(max(s1_, -3), C::NB + 2); \
            LAS const unsigned char* bp_ = lds + b_ * C::ZROWB + (192 + 64 * s1_ + 8 * hh) * 2; \
            _Pragma("unroll") for (int ks_ = 0; ks_ < 4; ++ks_) Bv[t_][ks_] = *(const LAS bf16x8*)(bp_ + ks_ * 32); } } while (0)
#define HY_MM(Wv, Bv, d1v) do { _Pragma("unroll") for (int t_ = 0; t_ < C::TPW; ++t_) { const int tq_ = tq0 + t_; \
            if ((d1v) >= C::TPT * tq_ - (C::NB - 1) && (d1v) <= C::TPT * tq_ + C::TPT - 1) { \
                _Pragma("unroll") for (int ks_ = 0; ks_ < 4; ++ks_) _Pragma("unroll") for (int mt_ = 0; mt_ < 2; ++mt_) \
                    acc[t_][mt_] = __builtin_amdgcn_mfma_f32_32x32x16_bf16(Wv[ks_ - 2 * mt_ + 2], Bv[t_][ks_], acc[t_][mt_], 0, 0, 0); } } } while (0)
#pragma unroll
            for (int i = 0; i < 6; ++i) HY_LDW(W0, d1lo, i);
            int d1 = d1lo;
#pragma unroll 1
            for (; d1 + 1 <= d1hi; d1 += 2) {
                HY_LDB(B0, d1);
#pragma unroll
                for (int i = 0; i < 4; ++i) HY_LDW(W1, d1 + 1, i);
                W1[4] = W0[0]; W1[5] = W0[1];
                HY_MM(W0, B0, d1);
                HY_LDB(B0, d1 + 1);
                if (d1 + 2 <= d1hi) {
#pragma unroll
                    for (int i = 0; i < 4; ++i) HY_LDW(W0, d1 + 2, i);
                    W0[4] = W1[0]; W0[5] = W1[1];
                }
                HY_MM(W1, B0, d1 + 1);
            }
            if (d1 <= d1hi) { HY_LDB(B0, d1); HY_MM(W0, B0, d1); }
#undef HY_LDW
#undef HY_LDB
#undef HY_MM
        }
        __syncthreads();
        if (tq0 < C::NTILES) {
            const float bo = hbias[o * 1024 + c];
            const bf16_t* gate = CM + (size_t)((1 + o) * 1024 + c) * TOK + tokbase;
            bf16_t* zout = (bf16_t*)(P.ws + WS_RA + RA_ZC) + (size_t)c * TOK + tokbase;
#pragma unroll
            for (int t = 0; t < C::TPW; ++t) { const int tq = tq0 + t, t1 = C::TPT * tq + (q >> C::LOGB), b = q & (BATCH - 1);
#pragma unroll
                for (int mt = 0; mt < 2; ++mt)
#pragma unroll
                    for (int g = 0; g < 4; ++g) { const int s = 64 * t1 + 32 * mt + 8 * g + 4 * hh;
                        LAS u32x2* zp = (LAS u32x2*)(lds + b * C::ZROWB + (192 + s) * 2);
                        const u32x2 zv = *zp, gv = *(const u32x2*)(gate + (size_t)b * L + s);
                        const float r0 = bflo(gv.x) * (acc[t][mt][4 * g] + bflo(zv.x) * bo), r1 = bfhi(gv.x) * (acc[t][mt][4 * g + 1] + bfhi(zv.x) * bo);
                        const float r2 = bflo(gv.y) * (acc[t][mt][4 * g + 2] + bflo(zv.y) * bo), r3 = bfhi(gv.y) * (acc[t][mt][4 * g + 3] + bfhi(zv.y) * bo);
                        const u32x2 w = (u32x2){pk2(r0, r1), pk2(r2, r3)};
                        if (o == 0) *zp = w; else *(u32x2*)(zout + (size_t)b * L + s) = w; } }
        }
        __syncthreads();
    }
}

DI void hyena_phase(const Ctx& F, const Params& P) {
    for (int c = F.bid; c < 1024; c += F.G) {
        hyena_part<LS, 8>(F, P, c, TP, (const bf16_t*)(P.ws + WS_KRS));
        hyena_part<LP, 32>(F, P, c, 0, (const bf16_t*)(P.ws + WS_KRP));
    }
}

DI void hyena_post(const Ctx& F, const Params& P) {
    const bf16_t* CM = (const bf16_t*)(P.ws + WS_RA + RA_ZC); bf16_t* MIX = (bf16_t*)(P.ws + WS_HM);
    struct PostMap { const bf16_t* CM; bf16_t* MIX;
        DI TrJob operator()(int t) const { const int cg = t & 15, tg = t >> 4;
            return TrJob{CM + (size_t)(cg * 64) * TOK + tg * 64, (size_t)TOK, MIX + (size_t)(tg * 64) * DM + 1024 + cg * 64, (size_t)DM}; } };
    tr_pipeline_bf16(F, 16 * 640, PostMap{CM, MIX}, (LAS bf16_t*)F.lds);
}
constexpr int PC_ROPE = 118784;
DI void prep_c(const Ctx& F, const Params& P) {
    bf16_t* PA = (bf16_t*)(P.ws + WS_RA);
    LAS float* rope = (LAS float*)(F.lds + PC_ROPE);
    __syncthreads();
    for (int e = F.tid; e < 1024; e += NTHR) { const int pos = e >> 4, f = e & 15; const float inv = exp2f(-(float)f * (13.287712379549449f / 16.f)); const float a = (float)pos * inv;
        rope[e * 2] = cosf(a); rope[e * 2 + 1] = sinf(a); }
    __syncthreads();
    bf16_t* VTp = (bf16_t*)(P.ws + WS_VT); bf16_t* VTs = (bf16_t*)(P.ws + WS_VT + VT_S);
    { struct VtMap { const bf16_t* PA; bf16_t* VTp; bf16_t* VTs;
          DI TrJob operator()(int t) const {
              if (t < 2048) { const int bh = t >> 3, sub = t & 7, tk = sub >> 1, dd = sub & 1, b = bh >> 3, h = bh & 7;
                  return TrJob{PA + ((size_t)(b * 256 + tk * 64)) * 4096 + 3072 + h * 128 + dd * 64, 4096, VTp + ((size_t)bh * 128 + dd * 64) * 256 + tk * 64, 256}; }
              const int u = t - 2048, bh = u >> 7, sub = u & 127, tk = sub >> 1, dd = sub & 1, b = bh >> 3, h = bh & 7;
              return TrJob{PA + ((size_t)(TP + b * 4096 + tk * 64)) * 4096 + 3072 + h * 128 + dd * 64, 4096, VTs + ((size_t)bh * 128 + dd * 64) * 4096 + tk * 64, 4096}; } };
      tr_pipeline_bf16(F, 2048 + 8192, VtMap{PA, VTp, VTs}, (LAS bf16_t*)F.lds); }
    { float* o = P.out + O_DV;
      for (int e = F.bid * NTHR + F.tid; e < TP * 128; e += F.G * NTHR) { const int T = e >> 7, c8 = (e & 127) * 8;
          const u32x4 v = *(const u32x4*)(PA + (size_t)T * 4096 + 3072 + c8);
          *(f32x4*)(o + (size_t)T * 1024 + c8) = (f32x4){bflo(v.x), bfhi(v.x), bflo(v.y), bfhi(v.y)};
          *(f32x4*)(o + (size_t)T * 1024 + c8 + 4) = (f32x4){bflo(v.z), bfhi(v.z), bflo(v.w), bfhi(v.w)}; } }
}
DI void prep_c_tokens(const Ctx& F, const Params& P, int wv, int nw) {
    bf16_t* PA = (bf16_t*)(P.ws + WS_RA);
    const LAS float* rope = (const LAS float*)(F.lds + PC_ROPE);
    const float* gsrc = (F.lane < 32 ? P.in[I_DQG] : P.in[I_DKG]) + (F.lane & 1) * 32; float* ok = P.out + O_DK;
    float g[32];
#pragma unroll
    for (int i = 0; i < 32; ++i) g[i] = gsrc[i];
    for (int T = wv; T < TOK; T += nw) {
        bf16_t* rp = PA + (size_t)T * 4096 + 1024 + F.lane * 32;
        u32x4 v[4]; float x[32]; float ss = 0.f;
#pragma unroll
        for (int j = 0; j < 4; ++j) { v[j] = *(const u32x4*)(rp + j * 8);
            x[j * 8 + 0] = bflo(v[j].x); x[j * 8 + 1] = bfhi(v[j].x); x[j * 8 + 2] = bflo(v[j].y); x[j * 8 + 3] = bfhi(v[j].y);
            x[j * 8 + 4] = bflo(v[j].z); x[j * 8 + 5] = bfhi(v[j].z); x[j * 8 + 6] = bflo(v[j].w); x[j * 8 + 7] = bfhi(v[j].w); }
#pragma unroll
        for (int i = 0; i < 32; ++i) ss += x[i] * x[i];
        ss += dpp_xor1(ss);
        const float rstd = rsqrtf(ss * (1.f / 64.f) + NORM_EPS);
#pragma unroll
        for (int i = 0; i < 32; ++i) x[i] = x[i] * rstd * g[i];
        if (T < TP) { if (F.lane >= 32) { float* o = ok + (size_t)T * 1024 + (F.lane - 32) * 32;
#pragma unroll
                for (int j = 0; j < 8; ++j) *(f32x4*)(o + j * 4) = (f32x4){x[j * 4], x[j * 4 + 1], x[j * 4 + 2], x[j * 4 + 3]}; } }
        else { const int t = (T - TP) & 4095, pos = (F.lane & 1) ? (t & 63) : (t >> 6);
            const LAS float* rt = rope + pos * 32;
#pragma unroll
            for (int f = 0; f < 16; ++f) { const float cs = rt[2 * f], sn = rt[2 * f + 1], a = x[f], b = x[16 + f]; x[f] = a * cs - b * sn; x[16 + f] = b * cs + a * sn; } }
#pragma unroll
        for (int j = 0; j < 4; ++j) { u32x4 w; w.x = pk2(x[j * 8 + 0], x[j * 8 + 1]); w.y = pk2(x[j * 8 + 2], x[j * 8 + 3]); w.z = pk2(x[j * 8 + 4], x[j * 8 + 5]); w.w = pk2(x[j * 8 + 6], x[j * 8 + 7]);
            *(u32x4*)(rp + j * 8) = w; }
    }
}

constexpr int S5_BROW = 80, S5_BUB = 128 * S5_BROW, S5_HROW = 272, S5_WLDS = S5_BUB + 16 * S5_HROW;
DI void s5_chain(const Ctx& F, const Params& P, int dg, int tok0, int L, const float* h0re, const float* h0im, float* fre, float* fim, bf16_t* Yout) {
    LAS unsigned char* wl = F.lds + F.wave * S5_WLDS; LAS unsigned char* hl = wl + S5_BUB;
    const int g = dg & 63, dir = dg >> 6, lane = F.lane, st = lane & 15, gq = lane >> 4;
    const float* S5A = (const float*)(P.ws + WS_S5A); const bf16_t* BB = (const bf16_t*)(P.ws + WS_S5BB); const bf16_t* CC = (const bf16_t*)(P.ws + WS_S5CC);
    const bf16_t* PA = (const bf16_t*)(P.ws + WS_RA);
    const float ar = S5A[(dg * 64 + lane) * 2], ai = S5A[(dg * 64 + lane) * 2 + 1];
    float hr = h0re ? h0re[lane] : 0.f, hi = h0im ? h0im[lane] : 0.f;
    const bf16x8 zero8 = (bf16x8){0, 0, 0, 0, 0, 0, 0, 0};
    bf16x8 BBf[8], CCf[4];
#pragma unroll
    for (int mt = 0; mt < 8; ++mt) BBf[mt] = (gq < 2) ? *(const bf16x8*)(BB + ((size_t)dg * 128 + mt * 16 + st) * 16 + gq * 8) : zero8;
#pragma unroll
    for (int kk = 0; kk < 4; ++kk) CCf[kk] = *(const bf16x8*)(CC + ((size_t)dg * 16 + st) * 128 + kk * 32 + gq * 8);
    const int nch = L / 16;
    const int sgn = dir ? -1 : 1, tstart = dir ? tok0 + L - 1 : tok0;
    const bf16_t* ubase = PA + (size_t)tstart * 4096 + g * 16 + gq * 8;
    const long ustep = (long)sgn * 4096;
#define S5_LDU(c_) (((c_) < nch && gq < 2) ? *(const bf16x8*)(ubase + ustep * ((c_) * 16 + st)) : zero8)
#define S5_BU(Uv) do { _Pragma("unroll") for (int mt = 0; mt < 8; ++mt) { f32x4 d_ = (f32x4){0.f, 0.f, 0.f, 0.f}; \
        d_ = __builtin_amdgcn_mfma_f32_16x16x32_bf16(Uv, BBf[mt], d_, 0, 0, 0); *(LAS f32x4*)(wl + (mt * 16 + st) * S5_BROW + gq * 16) = d_; } } while (0)
#define S5_Y(c_) do { f32x4 y_ = (f32x4){0.f, 0.f, 0.f, 0.f}; \
        _Pragma("unroll") for (int kk = 0; kk < 4; ++kk) y_ = __builtin_amdgcn_mfma_f32_16x16x32_bf16(CCf[kk], Bh[kk], y_, 0, 0, 0);        \
        *(u32x2*)(Yout + (size_t)(tstart + sgn * ((c_) * 16 + st)) * 1024 + g * 16 + gq * 4) = (u32x2){pk2(y_[0], y_[1]), pk2(y_[2], y_[3])}; } while (0)
#define S5_ITER(DOY) do { \
        f32x4 br_[4], bi_[4]; \
        _Pragma("unroll") for (int j = 0; j < 4; ++j) { br_[j] = *(const LAS f32x4*)(wl + lane * S5_BROW + j * 16); bi_[j] = *(const LAS f32x4*)(wl + (64 + lane) * S5_BROW + j * 16); } \
        bf16x8 Bh[4]; \
        if (DOY) { _Pragma("unroll") for (int kk = 0; kk < 4; ++kk) Bh[kk] = *(const LAS bf16x8*)(hl + st * S5_HROW + (kk * 32 + gq * 8) * 2); } \
        const bf16x8 Un_ = S5_LDU(ch + 4); \
        S5_BU(Ua); \
        _Pragma("unroll") for (int s = 0; s < 16; ++s) { const float bur = br_[s >> 2][s & 3], bui = bi_[s >> 2][s & 3]; \
            float t0_ = __builtin_fmaf(-ai, hi, bur), t1_ = __builtin_fmaf(ai, hr, bui); \
            asm volatile("" : "+v"(t0_), "+v"(t1_));                       \
            const float nr = __builtin_fmaf(ar, hr, t0_), ni = __builtin_fmaf(ar, hi, t1_); hr = nr; hi = ni; \
            asm volatile("" : "+v"(hr), "+v"(hi)); \
            const unsigned hw_ = pk2(hr, hi); \
            *(LAS bf16_t*)(hl + s * S5_HROW + lane * 2) = (bf16_t)(hw_ & 0xffffu); *(LAS bf16_t*)(hl + s * S5_HROW + (64 + lane) * 2) = (bf16_t)(hw_ >> 16); } \
        if (DOY) S5_Y(ch - 1); \
        Ua = Ub; Ub = Uc; Uc = Un_; } while (0)
    bf16x8 Ua = S5_LDU(0), Ub = S5_LDU(1), Uc = S5_LDU(2);
    S5_BU(Ua);
    Ua = Ub; Ub = Uc; Uc = S5_LDU(3);
    int ch = 0;
    S5_ITER(false);
#pragma unroll 1
    for (ch = 1; ch < nch; ++ch) S5_ITER(true);
    { bf16x8 Bh[4];
#pragma unroll
      for (int kk = 0; kk < 4; ++kk) Bh[kk] = *(const LAS bf16x8*)(hl + st * S5_HROW + (kk * 32 + gq * 8) * 2);
      S5_Y(nch - 1); }
#undef S5_LDU
#undef S5_BU
#undef S5_Y
#undef S5_ITER
    if (fre) { fre[lane] = hr; fim[lane] = hi; }
}

DI void s5_phase(const Ctx& F, const Params& P) {
    bf16_t* YF = (bf16_t*)(P.ws + WS_RB + RB_YF); bf16_t* YB = (bf16_t*)(P.ws + WS_RB + RB_YB);
    for (int cs = F.bid; cs < 256; cs += F.G) {
        if (F.wave < 4) { const int sc = cs * 4 + F.wave, dg = sc & 127, b = sc >> 7;
            s5_chain(F, P, dg, TP + b * 4096, LS, P.in[I_S5RE] + (size_t)sc * 64, P.in[I_S5IM] + (size_t)sc * 64, nullptr, nullptr, (dg >> 6) ? YB : YF); }
        else { for (int k = 0; k < 4; ++k) { const int pc = (cs * 4 + (F.wave - 4)) * 4 + k, dg = pc & 127, b = pc >> 7;
            s5_chain(F, P, dg, b * 256, LP, nullptr, nullptr, P.out + O_SR + (size_t)pc * 64, P.out + O_SI + (size_t)pc * 64, (dg >> 6) ? YB : YF); } }
    }
    if (F.wave >= 4) prep_c_tokens(F, P, F.bid * 4 + (F.wave - 4), F.G * 4);
}

DI void s5_combine(const Ctx& F, const Params& P) {
    const bf16_t* PA = (const bf16_t*)(P.ws + WS_RA); const bf16_t* YF = (const bf16_t*)(P.ws + WS_RB + RB_YF); const bf16_t* YB = (const bf16_t*)(P.ws + WS_RB + RB_YB);
    bf16_t* Y = (bf16_t*)(P.ws + WS_RB + RB_Y); const float* dsk = P.in[I_S5D];
    const size_t N = (size_t)TOK * 128, step = (size_t)F.G * NTHR;
    for (size_t e = (size_t)F.bid * NTHR + F.tid; e < N; e += 2 * step) {
        const size_t ee[2] = {e, (e + step < N) ? e + step : e};
        u32x4 uv[2], fv[2], bv[2];
#pragma unroll
        for (int r = 0; r < 2; ++r) { const size_t T = ee[r] >> 7; const int c8 = (int)(ee[r] & 127) * 8;
            uv[r] = *(const u32x4*)(PA + T * 4096 + c8); fv[r] = *(const u32x4*)(YF + T * 1024 + c8); bv[r] = *(const u32x4*)(YB + T * 1024 + c8); }
#pragma unroll
        for (int r = 0; r < 2; ++r) { const size_t T = ee[r] >> 7; const int c8 = (int)(ee[r] & 127) * 8;
            const f32x4 d0 = *(const f32x4*)(dsk + c8), d1 = *(const f32x4*)(dsk + c8 + 4);
            float o[8];
            o[0] = gelu_tanh(d0.x * bflo(uv[r].x) + bflo(fv[r].x) + bflo(bv[r].x)); o[1] = gelu_tanh(d0.y * bfhi(uv[r].x) + bfhi(fv[r].x) + bfhi(bv[r].x));
            o[2] = gelu_tanh(d0.z * bflo(uv[r].y) + bflo(fv[r].y) + bflo(bv[r].y)); o[3] = gelu_tanh(d0.w * bfhi(uv[r].y) + bfhi(fv[r].y) + bfhi(bv[r].y));
            o[4] = gelu_tanh(d1.x * bflo(uv[r].z) + bflo(fv[r].z) + bflo(bv[r].z)); o[5] = gelu_tanh(d1.y * bfhi(uv[r].z) + bfhi(fv[r].z) + bfhi(bv[r].z));
            o[6] = gelu_tanh(d1.z * bflo(uv[r].w) + bflo(fv[r].w) + bflo(bv[r].w)); o[7] = gelu_tanh(d1.w * bfhi(uv[r].w) + bfhi(fv[r].w) + bfhi(bv[r].w));
            u32x4 w; w.x = pk2(o[0], o[1]); w.y = pk2(o[2], o[3]); w.z = pk2(o[4], o[5]); w.w = pk2(o[6], o[7]);
            if (r == 0 || e + step < N) *(u32x4*)(Y + T * 1024 + c8) = w; }
    }
}
constexpr int PS_KROW = 272;
constexpr int PS_IDX_OFF = 2 * 128 * PS_KROW;
constexpr int PS_TAB_OFF = PS_IDX_OFF + 512 * 32;

DI void topk_insert(float (&a)[16], float x) {
#pragma unroll
    for (int j = 15; j >= 1; --j) a[j] = __builtin_amdgcn_fmed3f(a[j - 1], a[j], x);
    a[0] = fmaxf(a[0], x);
}

DI void peer_select(const Ctx& F, const Params& P, int layer) {
    LAS unsigned char* lds = F.lds;
    const bf16_t* Q = (const bf16_t*)(P.ws + WS_RA + RA_Q);
    int* SELI = (int*)(P.ws + WS_RA + RA_SELI); float* SELW = (float*)(P.ws + WS_RA + RA_SELW);
    const bf16_t* KEYS = (const bf16_t*)(P.ws + WS_PKEYS) + (size_t)layer * 8 * 2 * 128 * 128;
    const int q = F.lane & 31, hh = F.lane >> 5;
    LAS unsigned char* myidx = lds + PS_IDX_OFF + F.tid * 32;
    LAS unsigned char* tab = lds + PS_TAB_OFF;
    for (int wu = F.bid; wu < 256; wu += F.G) {
        const int h = wu & 7, chunk = wu >> 3;
        __syncthreads();
        for (int id = F.tid; id < 2 * 128 * 16; id += NTHR) { const int row = id >> 4, c16 = id & 15;
            *(LAS u32x4*)(lds + row * PS_KROW + c16 * 16) = *(const u32x4*)(KEYS + ((size_t)h * 256 + row) * 128 + c16 * 8); }
        if (F.tid < 16) { int cnt = 0;
            for (int a = 0; a < F.tid; ++a) cnt += 16 / (a + 1);
            for (int b = 0; b < 16 / (F.tid + 1); ++b) { tab[(cnt + b) * 2] = (unsigned char)F.tid; tab[(cnt + b) * 2 + 1] = (unsigned char)b; } }
        __syncthreads();
        for (int blk = F.wave; blk < 40; blk += 8) {
            const int T0 = chunk * 1280 + blk * 32;
            float lst[2][16];
#pragma unroll
            for (int side = 0; side < 2; ++side) {
                bf16x8 Qf[8];
                const bf16_t* qp = Q + (size_t)(T0 + q) * 2048 + h * 256 + side * 128 + hh * 8;
#pragma unroll
                for (int ks = 0; ks < 8; ++ks) Qf[ks] = *(const bf16x8*)(qp + ks * 16);
                float a[16];
#pragma unroll
                for (int j = 0; j < 16; ++j) a[j] = -3.0e38f;
#pragma unroll
                for (int nt = 0; nt < 4; ++nt) {
                    f32x16 S;
#pragma unroll
                    for (int i = 0; i < 16; ++i) S[i] = 0.f;
#pragma unroll
                    for (int ks = 0; ks < 8; ++ks) { const bf16x8 A = *(const LAS bf16x8*)(lds + (side * 128 + nt * 32 + q) * PS_KROW + (ks * 16 + hh * 8) * 2);
                        S = __builtin_amdgcn_mfma_f32_32x32x16_bf16(A, Qf[ks], S, 0, 0, 0); }
#pragma unroll
                    for (int i = 0; i < 16; ++i) { const int n = nt * 32 + (i & 3) + 8 * (i >> 2) + 4 * hh;
                        topk_insert(a, __uint_as_float((__float_as_uint(S[i]) & 0xffffff80u) | (unsigned)n)); }
                }
                float pb[16];
#pragma unroll
                for (int j = 0; j < 16; ++j) pb[j] = __shfl_xor(a[j], 32);
#pragma unroll
                for (int j = 0; j < 16; ++j) topk_insert(a, pb[j]);
#pragma unroll
                for (int j = 0; j < 16; ++j) { lst[side][j] = a[j]; myidx[side * 16 + j] = (unsigned char)(__float_as_uint(a[j]) & 0x7fu); }
            }
            float cb[16];
#pragma unroll
            for (int j = 0; j < 16; ++j) cb[j] = -3.0e38f;
            { int cid = 0;
#pragma unroll
              for (int a = 0; a < 16; ++a)
#pragma unroll
                  for (int b = 0; b < 16 / (a + 1); ++b) {
                      const float sa = __uint_as_float(__float_as_uint(lst[0][a]) & 0xffffff80u), sb = __uint_as_float(__float_as_uint(lst[1][b]) & 0xffffff80u);
                      topk_insert(cb, __uint_as_float((__float_as_uint(sa + sb) & 0xffffffc0u) | (unsigned)cid)); ++cid; } }
            const float mx = __uint_as_float(__float_as_uint(cb[0]) & 0xffffffc0u);
            float e[16], den = 0.f;
#pragma unroll
            for (int j = 0; j < 16; ++j) { e[j] = __expf(__uint_as_float(__float_as_uint(cb[j]) & 0xffffffc0u) - mx); den += e[j]; }
            const float rden = 1.f / den;
#pragma unroll
            for (int j = 0; j < 16; ++j) {
                if ((j >> 3) == hh) { const int cid = (int)(__float_as_uint(cb[j]) & 0x3fu);
                    const int a = tab[cid * 2], b = tab[cid * 2 + 1];
                    const int eidx = (int)myidx[a] * 128 + (int)myidx[16 + b];
                    SELI[(size_t)(T0 + q) * 128 + h * 16 + j] = eidx; SELW[(size_t)(T0 + q) * 128 + h * 16 + j] = e[j] * rden; }
            }
        }
    }
    __syncthreads();
}

DI u32x16 fp6_unpack_bf16(u32x4 a, u32x2 b) { const u32x6 pk = {a.x, a.y, a.z, a.w, b.x, b.y}; return __builtin_bit_cast(u32x16, __builtin_amdgcn_cvt_scalef32_pk32_bf16_fp6(pk, 1.0f)); }
DI f32x32 fp6_unpack(u32x4 a, u32x2 b) { const u32x6 pk = {a.x, a.y, a.z, a.w, b.x, b.y}; return __builtin_amdgcn_cvt_scalef32_pk32_f32_fp6(pk, 1.0f); }
constexpr int GN = 4;
template <bool NEXTNORM>
DI void peer_gather(const Ctx& F, const Params& P, const float* modl, int layer, const float* ngain, const float* nmodl) {
    const bf16_t* H2 = (const bf16_t*)(P.ws + WS_HM);
    const unsigned char* TU = P.ws + WS_TBLU + (size_t)layer * 16384 * PT_ROWB; const unsigned char* TV = P.ws + WS_TBLV + (size_t)layer * 16384 * PT_ROWB;
    const float* SCU = (const float*)(P.ws + WS_SC) + layer * 16384; const float* SCV = (const float*)(P.ws + WS_SC) + (2 + layer) * 16384;
    const int* SELI = (const int*)(P.ws + WS_RA + RA_SELI); const float* SELW = (const float*)(P.ws + WS_RA + RA_SELW);
    float* X = P.out + O_Y;
    const int lane = lane_id();
    const int stride = F.G * 8;
    for (int T0 = F.bid * 8 + F.wave; T0 < TOK; T0 += 2 * stride) {
        const bool two = (T0 + stride < TOK);
        const int Tt[2] = {T0, two ? T0 + stride : T0};
        u32x4 xw[2][4]; int e0[2], e1[2]; float g0[2], g1[2], d0[2], d1[2];
#pragma unroll
        for (int t = 0; t < 2; ++t) {
#pragma unroll
            for (int q4 = 0; q4 < 4; ++q4) xw[t][q4] = *(const u32x4*)(H2 + (size_t)Tt[t] * DM + lane * 32 + q4 * 8);
            e0[t] = SELI[(size_t)Tt[t] * 128 + lane]; e1[t] = SELI[(size_t)Tt[t] * 128 + 64 + lane];
            g0[t] = SELW[(size_t)Tt[t] * 128 + lane]; g1[t] = SELW[(size_t)Tt[t] * 128 + 64 + lane]; d0[t] = 0.f; d1[t] = 0.f; }
#pragma unroll 1
        for (int kb = 0; kb < 128; kb += GN) {
            u32x4 ura[2][GN]; u32x2 urb[2][GN];
#pragma unroll
            for (int j = 0; j < GN; ++j)
#pragma unroll
                for (int t = 0; t < 2; ++t) { const int k = kb + j; const int e = __builtin_amdgcn_readlane(k < 64 ? e0[t] : e1[t], k & 63);
                    const unsigned char* up = TU + (size_t)e * PT_ROWB;
                    ura[t][j] = *(const u32x4*)(up + lane * 16); urb[t][j] = *(const u32x2*)(up + 1024 + lane * 8); }
#pragma unroll
            for (int j = 0; j < GN; ++j) { float pt[2];
#pragma unroll
                for (int t = 0; t < 2; ++t) { const u32x16 r = fp6_unpack_bf16(ura[t][j], urb[t][j]);
                    float sa = 0.f, sb = 0.f, sc2 = 0.f, sd = 0.f;
#pragma unroll
                    for (int i = 0; i < 4; ++i) { const unsigned x0 = xw[t][i].x, x1 = xw[t][i].y, x2 = xw[t][i].z, x3 = xw[t][i].w;
                        sa = dot2bf(r[4 * i], x0, sa); sb = dot2bf(r[4 * i + 1], x1, sb); sc2 = dot2bf(r[4 * i + 2], x2, sc2); sd = dot2bf(r[4 * i + 3], x3, sd); }
                    pt[t] = (sa + sb) + (sc2 + sd); }
                const float sm0 = wave_sum(pt[0]), sm1 = wave_sum(pt[1]); const int k = kb + j;
                if (k < 64) { if (lane == k) { d0[0] = sm0; d0[1] = sm1; } } else { if (lane == k - 64) { d1[0] = sm0; d1[1] = sm1; } } }
        }
        float cf0[2], cf1[2];
#pragma unroll
        for (int t = 0; t < 2; ++t) { cf0[t] = g0[t] * gelu_tanh(d0[t] * SCU[e0[t]]) * SCV[e0[t]]; cf1[t] = g1[t] * gelu_tanh(d1[t] * SCU[e1[t]]) * SCV[e1[t]]; }
        f32x2 acc[2][16];
#pragma unroll
        for (int t = 0; t < 2; ++t)
#pragma unroll
            for (int i = 0; i < 16; ++i) acc[t][i] = (f32x2){0.f, 0.f};
#pragma unroll 1
        for (int kb = 0; kb < 128; kb += GN) {
            u32x4 vra[2][GN]; u32x2 vrb[2][GN]; float cf[2][GN];
#pragma unroll
            for (int j = 0; j < GN; ++j)
#pragma unroll
                for (int t = 0; t < 2; ++t) { const int k = kb + j; const int e = __builtin_amdgcn_readlane(k < 64 ? e0[t] : e1[t], k & 63);
                    cf[t][j] = __builtin_bit_cast(float, __builtin_amdgcn_readlane(__builtin_bit_cast(int, k < 64 ? cf0[t] : cf1[t]), k & 63));
                    const unsigned char* vp = TV + (size_t)e * PT_ROWB;
                    vra[t][j] = *(const u32x4*)(vp + lane * 16); vrb[t][j] = *(const u32x2*)(vp + 1024 + lane * 8); }
#pragma unroll
            for (int j = 0; j < GN; ++j)
#pragma unroll
                for (int t = 0; t < 2; ++t) { const f32x32 r = fp6_unpack(vra[t][j], vrb[t][j]);
                    const f32x2 c2 = (f32x2){cf[t][j], cf[t][j]};
#pragma unroll
                    for (int i = 0; i < 16; ++i) acc[t][i] += c2 * (f32x2){r[2 * i], r[2 * i + 1]}; }
        }
#pragma unroll
        for (int t = 0; t < 2; ++t) {
            if (t == 1 && !two) break;
            const int T = Tt[t];
            const float* gate = modl + (size_t)(cond_of(T) * 6 + 5) * DM;
            f32x4 xn[8]; float ss = 0.f;
#pragma unroll
            for (int q4 = 0; q4 < 8; ++q4) { const int col = lane * 32 + q4 * 4; float* xp = X + (size_t)T * DM + col;
                const f32x4 gv = *(const f32x4*)(gate + col), x0 = *(const f32x4*)(xp);
                const f32x4 r = x0 + gv * (f32x4){acc[t][q4 * 2].x, acc[t][q4 * 2].y, acc[t][q4 * 2 + 1].x, acc[t][q4 * 2 + 1].y};
                *(f32x4*)(xp) = r; xn[q4] = r; ss += r.x * r.x + r.y * r.y + r.z * r.z + r.w * r.w; }
            if (NEXTNORM) {
                ss = wave_sum(ss);
                const float rstd = rsqrtf(ss * (1.f / DM) + NORM_EPS);
                const float* sh = nmodl + (size_t)(cond_of(T) * 6 + 0) * DM; const float* sc = sh + DM;
                bf16_t* H = (bf16_t*)(P.ws + WS_HM);
#pragma unroll
                for (int q4 = 0; q4 < 8; ++q4) { const int col = lane * 32 + q4 * 4;
                    const f32x4 g4 = *(const f32x4*)(ngain + col), s4 = *(const f32x4*)(sc + col), h4 = *(const f32x4*)(sh + col);
                    const f32x4 o = xn[q4] * rstd * g4 * (s4 + 1.f) + h4;
                    *(u32x2*)(H + (size_t)T * DM + col) = (u32x2){pk2(o.x, o.y), pk2(o.z, o.w)}; }
            }
        }
    }
}
constexpr int NPHASE = 22;

__global__ void __launch_bounds__(NTHR, 2) mega(Params P) {
    extern __shared__ __attribute__((aligned(16))) unsigned char lds_raw[];
    Ctx F;
    F.lds = (LAS unsigned char*)lds_raw; F.tid = threadIdx.x; F.lane = F.tid & 63; F.wave = __builtin_amdgcn_readfirstlane(F.tid >> 6); F.G = gridDim.x; F.bid = blockIdx.x;
    const int lo = P.ph_lo, hi = P.ph_hi;
    volatile LAS unsigned* xbw = (volatile LAS unsigned*)(F.lds + LDS_BYTES - 16);
    if (F.tid == 0) { xbw[0] = 0u; xbw[1] = 0u; xbw[2] = 0u; xbw[3] = 0u; }
    __syncthreads();
    if (hi - lo > 1) (void)xcd_barrier_post((unsigned*)(P.ws + WS_CTL), xbw);
#define GRID_BARRIER() do { XcdBarrier bar_; bar_.bar = (unsigned*)(P.ws + WS_CTL); bar_.x = xb_xcc_id(); bar_.st = (volatile LAS unsigned*)(F.lds + LDS_BYTES - 16); xcd_barrier(bar_); } while (0)
#define PH(k, ...) if (lo <= (k) && (k) < hi) { { __VA_ARGS__ } if ((k) + 1 < hi) GRID_BARRIER(); }
#define MOD0 ((const float*)(P.ws + WS_MOD))
#define MOD1 ((const float*)(P.ws + WS_MOD) + 9 * 12288)
#define HM ((bf16_t*)(P.ws + WS_HM))
#define RA ((bf16_t*)(P.ws + WS_RA))
#define X (P.out + O_Y)

    PH(0, prologue(F, P);)
    PH(1, adaln_reduce(F, P);)
    PH(2, norm_phase(F, P.in[I_XP], P.in[I_XS], P.in[I_NMIXG], MOD0, 0, HM);)
    PH(3, { EpiBf16 E{RA, 4096}; run_gemm(F, HM, (const bf16_t*)(P.ws + WS_WEVIN) + (size_t)2048 * 2048, 4096, 2048, E); })
    PH(4, prep_a(F, P);)
    PH(5, { EpiBf16 E{RA, 2048}; run_gemm(F, HM, (const bf16_t*)(P.ws + WS_WEVIN), 2048, 2048, E); })
    PH(6, attn_phase<0>(F, P); attn_phase<1>(F, P); hyena_phase(F, P);)
    PH(7, hyena_post(F, P);)
    PH(8, { EpiResid E{P.in[I_XP], P.in[I_XS], X, MOD0, 2}; run_gemm(F, HM, (const bf16_t*)(P.ws + WS_WEVOUT), 2048, 2048, E); })
    PH(9, norm_phase(F, X, X + (size_t)TP * DM, P.in[I_NFFNG], MOD0, 3, HM);)
    PH(10, { EpiBf16 E{RA, 2048}; run_gemm(F, HM, (const bf16_t*)(P.ws + WS_WPQ), 2048, 2048, E); })
    PH(11, peer_select(F, P, 0);)
    PH(12, peer_gather<true>(F, P, MOD0, 0, P.in[I_NMIXG] + DM, MOD1);)
    PH(13, { EpiBf16 E{RA, 4096}; run_gemm(F, HM, (const bf16_t*)(P.ws + WS_WODIN), 4096, 2048, E); })
    PH(14, prep_c(F, P); s5_phase(F, P);)
    PH(15, { const float lam = diff_lambda(F, P); attn_diff_phase<false>(F, P, lam); attn_diff_phase<true>(F, P, lam); } s5_combine(F, P);)
    PH(16, { EpiGlu E{(const bf16_t*)(P.ws + WS_RB + RB_Y), HM, P.in[I_GLUB]}; run_gemm(F, (const bf16_t*)(P.ws + WS_RB + RB_Y), (const bf16_t*)(P.ws + WS_WGLU), 1024, 1024, E); })
    PH(17, { EpiResid E{X, X + (size_t)TP * DM, X, MOD1, 2}; run_gemm(F, HM, (const bf16_t*)(P.ws + WS_WODOUT), 2048, 2048, E); })
    PH(18, norm_phase(F, X, X + (size_t)TP * DM, P.in[I_NFFNG] + DM, MOD1, 3, HM);)
    PH(19, { EpiBf16 E{RA, 2048}; run_gemm(F, HM, (const bf16_t*)(P.ws + WS_WPQ) + (size_t)2048 * 2048, 2048, 2048, E); })
    PH(20, peer_select(F, P, 1);)
    PH(21, peer_gather<false>(F, P, MOD1, 1, nullptr, nullptr);)
#undef MOD0
#undef MOD1
#undef HM
#undef RA
#undef X
#undef PH
#undef GRID_BARRIER
}

extern "C" void kernel_launch(void* const* d_in, const int* in_sizes, int n_in, void* d_out, int out_size, void* d_ws, size_t ws_size, hipStream_t stream) {
    static int grid = 0;
    if (grid == 0) {
        if (n_in != N_IN || (size_t)out_size != O_END || ws_size < WS_END) { fprintf(stderr, "kernel_launch: unexpected shapes (n_in %d, out %d, ws %zu, need %zu)\n", n_in, out_size, ws_size, (size_t)WS_END); grid = -1; return; }
        int dev = 0, cus = 0;
        if (hipGetDevice(&dev) != hipSuccess || hipDeviceGetAttribute(&cus, hipDeviceAttributeMultiprocessorCount, dev) != hipSuccess) { grid = -1; return; }
        if (hipFuncSetAttribute((const void*)mega, hipFuncAttributeMaxDynamicSharedMemorySize, LDS_BYTES) != hipSuccess) { fprintf(stderr, "kernel_launch: hipFuncSetAttribute failed\n"); grid = -1; return; }
        int per_cu = 0;
        if (hipOccupancyMaxActiveBlocksPerMultiprocessor(&per_cu, (const void*)mega, NTHR, LDS_BYTES) != hipSuccess || per_cu < 1) { fprintf(stderr, "kernel_launch: occupancy query says %d blocks per CU\n", per_cu); }
        (void)hipGetLastError();
        grid = cus;
    }
    if (grid < 0) return;
    (void)hipMemsetAsync((char*)d_ws + WS_CTL, 0, 65536, stream);
    Params p; memset(&p, 0, sizeof(p));
    for (int i = 0; i < N_IN; ++i) p.in[i] = (const float*)d_in[i];
    p.out = (float*)d_out; p.ws = (unsigned char*)d_ws;
    p.ph_lo = 0; p.ph_hi = NPHASE;
    hipLaunchKernelGGL(mega, dim3(grid), dim3(NTHR), LDS_BYTES, stream, p);
}
```

```cpp
#include <hip/hip_runtime.h>
#include <cstdio>
#include <cstring>
#include <cstdint>

typedef unsigned short bf16_t;
typedef short bf16x8 __attribute__((ext_vector_type(8)));
typedef short s16x4 __attribute__((ext_vector_type(4)));
typedef float f32x2 __attribute__((ext_vector_type(2)));
typedef float f32x4 __attribute__((ext_vector_type(4)));
typedef float f32x16 __attribute__((ext_vector_type(16)));
typedef unsigned u32x2 __attribute__((ext_vector_type(2)));
typedef unsigned u32x4 __attribute__((ext_vector_type(4)));
typedef __bf16 bf16x2_t __attribute__((ext_vector_type(2)));
typedef float f32x32 __attribute__((ext_vector_type(32)));
typedef unsigned u32x6 __attribute__((ext_vector_type(6)));
typedef unsigned u32x16 __attribute__((ext_vector_type(16)));
typedef __bf16 bf16x32_t __attribute__((ext_vector_type(32)));

#define DI __device__ __forceinline__

constexpr int NTHR = 512;
constexpr int DM = 2048;
constexpr int TP = 8192;
constexpr int TS = 32768;
constexpr int TOK = TP + TS;
constexpr int LP = 256, LS = 4096;
constexpr float NORM_EPS = 1e-6f;
constexpr float LOG2E = 1.4426950408889634f;

enum { I_XP = 0, I_XS, I_C, I_CNK, I_CNV, I_CDK, I_CDV, I_S5RE, I_S5IM, I_CCTX, I_MODW, I_MODB, I_NMIXG, I_NFFNG, I_EVWIN, I_EVWOUT, I_NAQG, I_NAKG, I_RPB,
       I_HYCW, I_HYCB, I_HYW1, I_HYB1, I_HYF1, I_HYW2, I_HYB2, I_HYF2, I_HYW3, I_HYDEC, I_HYBIAS, I_ODWIN, I_ODWOUT, I_S5LRE, I_S5LIM, I_S5LDT, I_S5BRE, I_S5BIM,
       I_S5CRE, I_S5CIM, I_S5D, I_GLUW, I_GLUB, I_DQG, I_DKG, I_LQ1, I_LK1, I_LQ2, I_LK2, I_SUBG, I_PWQ, I_PKEYS, I_PU, I_PV, N_IN };

constexpr size_t O_Y = 0;
constexpr size_t O_NAK = 83886080, O_NAV = 92274688, O_DK = 100663296, O_DV = 109051904, O_SR = 117440512, O_SI = 117702656, O_END = 117964800;

constexpr size_t al256(size_t x) { return (x + 255) & ~(size_t)255; }
constexpr size_t WS_CTL = 0;
constexpr size_t WS_MODP = 65536;
constexpr size_t WS_MOD = WS_MODP + (size_t)2 * 16 * 9 * 12288 * 4;
constexpr size_t WS_WEVIN = al256(WS_MOD + (size_t)2 * 9 * 12288 * 4);
constexpr size_t WS_WEVOUT = WS_WEVIN + (size_t)6144 * 2048 * 2;
constexpr size_t WS_WODIN = WS_WEVOUT + (size_t)2048 * 2048 * 2;
constexpr size_t WS_WODOUT = WS_WODIN + (size_t)4096 * 2048 * 2;
constexpr size_t WS_WPQ = WS_WODOUT + (size_t)2048 * 2048 * 2;
constexpr size_t WS_WGLU = WS_WPQ + (size_t)2 * 2048 * 2048 * 2;
constexpr size_t WS_PKEYS = WS_WGLU + (size_t)1024 * 1024 * 2;
constexpr size_t WS_CNK = WS_PKEYS + (size_t)2 * 8 * 2 * 128 * 128 * 2;
constexpr size_t WS_CNVT = WS_CNK + (size_t)8 * 256 * 1024 * 2;
constexpr size_t WS_CDK = WS_CNVT + (size_t)8 * 256 * 1024 * 2;
constexpr size_t WS_CDVT = WS_CDK + (size_t)8 * 256 * 1024 * 2;
constexpr size_t WS_S5A = WS_CDVT + (size_t)8 * 256 * 1024 * 2;
constexpr size_t WS_S5BB = WS_S5A + (size_t)128 * 64 * 2 * 4;
constexpr size_t WS_S5CC = WS_S5BB + (size_t)128 * 128 * 16 * 2;
constexpr int KRL_S = 8208, KRL_P = 528;
constexpr size_t WS_KRS = WS_S5CC + (size_t)128 * 16 * 128 * 2;
constexpr size_t WS_KRP = al256(WS_KRS + (size_t)2 * 1024 * KRL_S * 2);
constexpr size_t WS_TBLU = al256(WS_KRP + (size_t)2 * 1024 * KRL_P * 2);
constexpr size_t WS_TBLV = WS_TBLU + (size_t)16384 * 2048 * 2;
constexpr size_t WS_HM = WS_TBLV + (size_t)16384 * 2048 * 2;
constexpr size_t WS_RA = WS_HM + (size_t)TOK * 2048 * 2;
constexpr size_t WS_RB = WS_RA + (size_t)TOK * 4096 * 2;
constexpr size_t WS_VT = WS_RB + (size_t)3072 * TOK * 2;
constexpr size_t WS_SC = WS_VT + (size_t)TOK * 1024 * 2;
constexpr size_t WS_END = WS_SC + (size_t)4 * 16384 * 4;
constexpr size_t RA_Q = 0;
constexpr size_t RA_SELI = (size_t)TOK * 2048 * 2;
constexpr size_t RA_SELW = RA_SELI + (size_t)TOK * 128 * 4;
constexpr size_t RA_CF = RA_SELW + (size_t)TOK * 128 * 4;
constexpr size_t RA_ZC = (size_t)TOK * 2048 * 2;
constexpr size_t RB_YF = 0, RB_YB = (size_t)TOK * 1024 * 2, RB_Y = (size_t)2 * TOK * 1024 * 2;
constexpr size_t VT_S = (size_t)TP * 1024 * 2;

constexpr int LDS_BYTES = 147456;

struct Params { const float* in[N_IN]; float* out; unsigned char* ws; int ph_lo, ph_hi; };

DI float bf2f(bf16_t b) { return __uint_as_float(((unsigned)b) << 16); }
DI float bflo(unsigned w) { return __uint_as_float(w << 16); }
DI float bfhi(unsigned w) { return __uint_as_float(w & 0xffff0000u); }
DI unsigned pk2(float a, float b) { f32x2 v = {a, b}; return __builtin_bit_cast(unsigned, __builtin_convertvector(v, bf16x2_t)); }
DI float dot2bf(unsigned a, unsigned b, float c) { return __builtin_amdgcn_fdot2_f32_bf16(__builtin_bit_cast(bf16x2_t, a), __builtin_bit_cast(bf16x2_t, b), c, false); }
DI bf16_t f2bf(float a) { return (bf16_t)(pk2(a, 0.f) & 0xffffu); }
DI float dpp_xor1(float v) { return __builtin_bit_cast(float, __builtin_amdgcn_update_dpp(0, __builtin_bit_cast(int, v), 0xB1, 0xF, 0xF, true)); }
DI float dpp_xor2(float v) { return __builtin_bit_cast(float, __builtin_amdgcn_update_dpp(0, __builtin_bit_cast(int, v), 0x4E, 0xF, 0xF, true)); }
DI float wave_sum(float v) {
    v += dpp_xor1(v); v += dpp_xor2(v);
    v += __builtin_bit_cast(float, __builtin_amdgcn_update_dpp(0, __builtin_bit_cast(int, v), 0x141, 0xF, 0xF, true));
    v += __builtin_bit_cast(float, __builtin_amdgcn_update_dpp(0, __builtin_bit_cast(int, v), 0x140, 0xF, 0xF, true));
    v += __builtin_bit_cast(float, __builtin_amdgcn_update_dpp(0, __builtin_bit_cast(int, v), 0x142, 0xA, 0xF, false));
    v += __builtin_bit_cast(float, __builtin_amdgcn_update_dpp(0, __builtin_bit_cast(int, v), 0x143, 0xC, 0xF, false));
    return __builtin_bit_cast(float, __builtin_amdgcn_readlane(__builtin_bit_cast(int, v), 63));
}
DI float gelu_tanh(float x) {
    const float u = 0.7978845608028654f * (x + 0.044715f * x * x * x);
    const float e = __expf(2.f * u);
    const float t = 1.f - 2.f / (e + 1.f);
    return 0.5f * x * (1.f + t);
}
DI float wave_max(float v) {
    v = fmaxf(v, dpp_xor1(v)); v = fmaxf(v, dpp_xor2(v));
    v = fmaxf(v, __builtin_bit_cast(float, __builtin_amdgcn_update_dpp(0, __builtin_bit_cast(int, v), 0x141, 0xF, 0xF, true)));
    v = fmaxf(v, __builtin_bit_cast(float, __builtin_amdgcn_update_dpp(0, __builtin_bit_cast(int, v), 0x140, 0xF, 0xF, true)));
    v = fmaxf(v, __builtin_bit_cast(float, __builtin_amdgcn_update_dpp(0, __builtin_bit_cast(int, v), 0x142, 0xA, 0xF, false)));
    v = fmaxf(v, __builtin_bit_cast(float, __builtin_amdgcn_update_dpp(0, __builtin_bit_cast(int, v), 0x143, 0xC, 0xF, false)));
    return __builtin_bit_cast(float, __builtin_amdgcn_readlane(__builtin_bit_cast(int, v), 63));
}
DI f32x2 fp8x2_lo(unsigned w) { return __builtin_amdgcn_cvt_pk_f32_fp8((int)w, false); }
DI f32x2 fp8x2_hi(unsigned w) { return __builtin_amdgcn_cvt_pk_f32_fp8((int)w, true); }
DI unsigned pk_fp8x4(float a, float b, float c, float d) { int r = 0; r = __builtin_amdgcn_cvt_pk_fp8_f32(a, b, r, false); r = __builtin_amdgcn_cvt_pk_fp8_f32(c, d, r, true); return (unsigned)r; }
DI int lane_id() { return (int)__builtin_amdgcn_mbcnt_hi(~0u, __builtin_amdgcn_mbcnt_lo(~0u, 0u)); }
DI int cond_of(int T) { return T < TP ? 0 : 1 + ((T - TP) >> 12); }
#define XB_TMO      128
#define XB_XCNT(j)  (256  + 64 * (j))
#define XB_XSUB(j)  (1280 + 64 * (j))
#define XB_XGEN(j)  (2304 + 64 * (j))
#define XB_TOP      3328
#define XB_TOPGEN   3392
#define XCD_BAR_WORDS 3456
#define XB_SPIN_CAP (1u << 26)
#define LAS __attribute__((address_space(3)))

__device__ __forceinline__ unsigned xb_ld(unsigned* p)              { return __hip_atomic_load(p, __ATOMIC_RELAXED, __HIP_MEMORY_SCOPE_AGENT); }
__device__ __forceinline__ unsigned xb_add(unsigned* p, unsigned v) { return __hip_atomic_fetch_add(p, v, __ATOMIC_RELAXED, __HIP_MEMORY_SCOPE_AGENT); }
__device__ __forceinline__ unsigned xb_xcc_id() { return (unsigned)__builtin_amdgcn_s_getreg((3 << 11) | 20) & 0xFu; }
#define XB_SPIN(cond, bar) do { unsigned _sp = 0; while (cond) { __builtin_amdgcn_s_sleep(1); \
    if ((++_sp & 255u) == 0u) { if (xb_ld(&(bar)[XB_TMO])) break; if (_sp > XB_SPIN_CAP) { atomicAdd(&(bar)[XB_TMO], 1u); break; } } } } while (0)

struct XcdBarrier {
    unsigned* bar; unsigned x;
    volatile LAS unsigned* st;
};

__device__ __forceinline__ XcdBarrier xcd_barrier_post(unsigned* bar, volatile LAS unsigned* st) {
    XcdBarrier b; b.bar = bar; b.x = xb_xcc_id(); b.st = st;
    if (threadIdx.x == 0) (void)xb_add(&bar[XB_XCNT(b.x)], 1u);
    return b;
}
__device__ __forceinline__ void xcd_barrier_complete(unsigned* bar, unsigned x, unsigned& nloc, unsigned& nx) {
    const unsigned G = gridDim.x * gridDim.y * gridDim.z;
    unsigned sum, cnt, mine, sp = 0u;
    for (;;) {
        sum = 0u; cnt = 0u; mine = 0u;
#pragma unroll
        for (unsigned j = 0; j < 16; ++j) { const unsigned c = xb_ld(&bar[XB_XCNT(j)]); sum += c; cnt += (c > 0u) ? 1u : 0u; mine = (j == x) ? c : mine; }
        if (sum == G) break;
        __builtin_amdgcn_s_sleep(1);
        if ((++sp & 255u) == 0u) { if (xb_ld(&bar[XB_TMO])) break; if (sp > XB_SPIN_CAP) { atomicAdd(&bar[XB_TMO], 1u); break; } }
    }
    nloc = mine > 0u ? mine : 1u; nx = cnt > 0u ? cnt : 1u;
}

__device__ __forceinline__ void xcd_barrier(const XcdBarrier& b) {
    asm volatile("s_waitcnt vmcnt(0)" ::: "memory");
    __syncthreads();
    if (threadIdx.x == 0) {
        unsigned* bar = b.bar;
        __builtin_amdgcn_s_waitcnt(0);
        unsigned nloc = b.st[0], nx = b.st[1];
        if (nloc == 0u) { xcd_barrier_complete(bar, b.x, nloc, nx); b.st[0] = nloc; b.st[1] = nx; }
        const unsigned old = xb_add(&bar[XB_XSUB(b.x)], 1u);
        const unsigned gen = old / nloc;
        if (old + 1u == (gen + 1u) * nloc) {
            __builtin_amdgcn_fence(__ATOMIC_RELEASE, "agent");
            asm volatile("s_waitcnt vmcnt(0)" ::: "memory");
            const unsigned og = xb_add(&bar[XB_TOP], 1u);
            const unsigned tg = og / nx;
            if (og + 1u == (tg + 1u) * nx) xb_add(&bar[XB_TOPGEN], 1u);
            else XB_SPIN(xb_ld(&bar[XB_TOPGEN]) == tg, bar);
            __builtin_amdgcn_fence(__ATOMIC_ACQUIRE, "agent");
            xb_add(&bar[XB_XGEN(b.x)], 1u);
            asm volatile("s_waitcnt vmcnt(0)" ::: "memory");
        } else {
            XB_SPIN(xb_ld(&bar[XB_XGEN(b.x)]) == gen, bar);
            __builtin_amdgcn_fence(__ATOMIC_ACQUIRE, "agent");
            asm volatile("s_waitcnt vmcnt(0)" ::: "memory");
        }
    }
    __syncthreads();
}
namespace pg8 {
#define PG8_LAS __attribute__((address_space(3)))
typedef unsigned short bf16_t;
typedef short bf16x8 __attribute__((ext_vector_type(8)));
typedef float f32x4 __attribute__((ext_vector_type(4)));
typedef unsigned u32x4 __attribute__((ext_vector_type(4)));
constexpr int BM = 256, BK = 64, HALF = 128, HTB = HALF * BK * 2  , STAGE_BYTES = 8 * HTB, NXCD = 8, WGM = 8;

__host__ __device__ __forceinline__ int lds_byte(int r, int c) { const int st = (r >> 4) * 2 + (c >> 5), rr = r & 15, cc = c & 31, ob = rr * 64 + cc * 2; return st * 1024 + (ob ^ (((ob >> 9) & 1) << 5)); }
__host__ __device__ __forceinline__ void stage_rc(int b, int& R, int& C) { const int st = b / 1024, sb = b % 1024, swz = sb ^ (((sb >> 9) & 1) << 5); R = (st >> 1) * 16 + swz / 64; C = (st & 1) * 32 + (swz % 64) / 2; }
__host__ __device__ __forceinline__ int perm32(int rho) { const int n = rho >> 4, i = rho & 15; return 8 * (i >> 2) + 4 * n + (i & 3); }

struct Unit { int pm, pn; };
struct Gemm { const bf16_t* A; const bf16_t* Bt; int M, N, K; };

struct StaticOrder {
    int nM, nN, nwg, G, c;
    __host__ __device__ void init(int M, int N, int G_, int c_) { nM = M / BM; nN = N / BM; nwg = nM * nN; G = G_; c = c_; }
    __host__ __device__ bool next(int i, Unit& u) const {
        const long L = (long)i * G + c; if (L >= nwg) return false;
        int wgid = (int)L; { const int q = nwg / NXCD, r = nwg % NXCD, xcd = wgid % NXCD, off = wgid / NXCD; wgid = (xcd < r ? xcd * (q + 1) : r * (q + 1) + (xcd - r) * q) + off; }
        const int nig = WGM * nN, gid = wgid / nig, fm = gid * WGM, gsz = (nM - fm) < WGM ? (nM - fm) : WGM;
        u.pm = fm + ((wgid % nig) % gsz); u.pn = (wgid % nig) / gsz; return true;
    }
    __device__ __forceinline__ void a_ready(const Unit&) const {}
    __device__ __forceinline__ void done(const Unit&) const {}
};
__device__ __forceinline__ unsigned cvt_pk_bf16(float lo, float hi) { unsigned r; asm volatile("v_cvt_pk_bf16_f32 %0, %1, %2" : "=v"(r) : "v"(lo), "v"(hi)); return r; }
template <class Epi, class Sched, bool STAMP = false>
__device__ __forceinline__ void gemm_phase(PG8_LAS unsigned char* lds, const Gemm g, const Sched& S, const Epi& E, unsigned long long* stamps) {
    const int tid = threadIdx.x, wid = __builtin_amdgcn_readfirstlane(tid >> 6), lane = tid & 63, wr = wid >> 2, wc = wid & 3, fr = lane & 15, fq = lane >> 4;
    const int K = g.K, nt = K / BK;
    int ts_lo = 0, ts_hi = 0, nts = 0; const unsigned long long rt_entry = STAMP ? (unsigned long long)wall_clock64() : 0ull;
#define PG8_STAMP() do { if (STAMP && wid == 0 && nts < 64) { const unsigned long long _c = (unsigned long long)clock64(); \
        ts_lo = (lane == nts) ? (int)(unsigned)_c : ts_lo; ts_hi = (lane == nts) ? (int)(unsigned)(_c >> 32) : ts_hi; ++nts; } } while (0)
    PG8_STAMP();
    unsigned voffA[2], voffB[2];
#pragma unroll
    for (int i = 0; i < 2; ++i) { int R, C; stage_rc(tid * 16 + i * 8192, R, C); const int Rb = Epi::PERM ? ((R & ~31) + perm32(R & 31)) : R;
        voffA[i] = (unsigned)(R * K + C) * 2u; voffB[i] = (unsigned)(Rb * K + C) * 2u; }
    const size_t kstep = (size_t)(BK * 2);
    const size_t hstep = (size_t)HALF * K * 2;
    const size_t tstep = 2 * hstep;
    const unsigned ldsw = (unsigned)wid * 1024u;
    const int aoff = lds_byte(wr * 64 + fr, fq * 8), boff = lds_byte(wc * 32 + fr, fq * 8);
#define PG8_SA(b, h) (((b) * 2 + (h)) * HTB)
#define PG8_SB(b, h) ((4 + (b) * 2 + (h)) * HTB)
#define PG8_STAGE(bufoff, gbase, voff) do { _Pragma("unroll") for (int _i = 0; _i < 2; ++_i) \
        __builtin_amdgcn_global_load_lds((const unsigned*)((const char*)(gbase) + (voff)[_i]), (PG8_LAS unsigned*)(lds + (bufoff) + ldsw + _i * 8192), 16, 0, 0); } while (0)
#define PG8_LDA(dst, b, h) do { _Pragma("unroll") for (int m = 0; m < 4; ++m) _Pragma("unroll") for (int k = 0; k < 2; ++k) dst[m][k] = *(const PG8_LAS bf16x8*)(lds + PG8_SA(b, h) + aoff + m * 2048 + k * 1024); } while (0)
#define PG8_LDB(dst, b, h) do { _Pragma("unroll") for (int n = 0; n < 2; ++n) _Pragma("unroll") for (int k = 0; k < 2; ++k) dst[n][k] = *(const PG8_LAS bf16x8*)(lds + PG8_SB(b, h) + boff + n * 2048 + k * 1024); } while (0)
#define PG8_MMA(ai, bj, At, Bt) do { __builtin_amdgcn_s_setprio(1); _Pragma("unroll") for (int m = 0; m < 4; ++m) _Pragma("unroll") for (int n = 0; n < 2; ++n) _Pragma("unroll") for (int k = 0; k < 2; ++k) \
        acc[ai][bj][m][n] = __builtin_amdgcn_mfma_f32_16x16x32_bf16(Bt[n][k], At[m][k], acc[ai][bj][m][n], 0, 0, 0); __builtin_amdgcn_s_setprio(0); } while (0)
#define PG8_WAIT_V(n) asm volatile("s_waitcnt vmcnt(" #n ")" ::: "memory")
#define PG8_WAIT_L(n) asm volatile("s_waitcnt lgkmcnt(" #n ")" ::: "memory")
#define PG8_BAR __builtin_amdgcn_s_barrier()
#define PG8_SCHED __builtin_amdgcn_sched_barrier(0)
    Unit cur, nxt; int ui = 0;
    if (!S.next(0, cur)) return;
    f32x4 acc[2][2][4][2];
#pragma unroll
    for (int a = 0; a < 2; ++a)
#pragma unroll
        for (int b = 0; b < 2; ++b)
#pragma unroll
            for (int m = 0; m < 4; ++m)
#pragma unroll
                for (int n = 0; n < 2; ++n) acc[a][b][m][n] = (f32x4){0.f, 0.f, 0.f, 0.f};
    bf16x8 At[4][2], B0[2][2], B1[2][2];
    const char* cA = (const char*)g.A + (size_t)cur.pm * tstep; const char* cB = (const char*)g.Bt + (size_t)cur.pn * tstep;
    S.a_ready(cur);
    PG8_STAGE(PG8_SB(0, 0), cB, voffB); PG8_STAGE(PG8_SA(0, 0), cA, voffA); PG8_STAGE(PG8_SB(0, 1), cB + hstep, voffB); PG8_STAGE(PG8_SA(0, 1), cA + hstep, voffA);
    if (wr == 1) PG8_BAR;
    PG8_WAIT_V(4); PG8_BAR;
    PG8_STAGE(PG8_SB(1, 0), cB + kstep, voffB); PG8_STAGE(PG8_SA(1, 0), cA + kstep, voffA); PG8_STAGE(PG8_SB(1, 1), cB + hstep + kstep, voffB);
    PG8_WAIT_V(6); PG8_BAR;
    PG8_STAMP();
    for (;;) {
        const bool has_next = S.next(ui + 1, nxt);
        const char* nA = has_next ? (const char*)g.A + (size_t)nxt.pm * tstep : cA; const char* nB = has_next ? (const char*)g.Bt + (size_t)nxt.pn * tstep : cB;
        for (int t = 0; t < nt; t += 2) {
            const bool last = (t == nt - 2);
            const char* a1 = cA + (size_t)(t + 1) * kstep;
            const char* a2 = last ? nA : cA + (size_t)(t + 2) * kstep; const char* b2 = last ? nB : cB + (size_t)(t + 2) * kstep;
            const char* a3 = a2 + kstep; const char* b3 = b2 + kstep;
            if (last && has_next) S.a_ready(nxt);
            PG8_LDB(B0, 0, 0); PG8_SCHED; PG8_LDA(At, 0, 0); PG8_STAGE(PG8_SA(1, 1), a1 + hstep, voffA);
            PG8_WAIT_L(8); PG8_BAR; PG8_WAIT_L(0); PG8_MMA(0, 0, At, B0); PG8_BAR; PG8_SCHED;
            PG8_LDB(B1, 0, 1); PG8_STAGE(PG8_SB(0, 0), b2, voffB);
            PG8_BAR; PG8_WAIT_L(0); PG8_MMA(0, 1, At, B1); PG8_BAR;
            PG8_LDA(At, 0, 1); PG8_STAGE(PG8_SA(0, 0), a2, voffA);
            PG8_BAR; PG8_WAIT_L(0); PG8_MMA(1, 0, At, B0); PG8_BAR; PG8_SCHED;
            PG8_STAGE(PG8_SB(0, 1), b2 + hstep, voffB);
            PG8_WAIT_V(6); PG8_BAR; PG8_MMA(1, 1, At, B1); PG8_BAR;
            PG8_LDB(B0, 1, 0); PG8_SCHED; PG8_LDA(At, 1, 0); PG8_STAGE(PG8_SA(0, 1), a2 + hstep, voffA);
            PG8_WAIT_L(8); PG8_BAR; PG8_WAIT_L(0); PG8_MMA(0, 0, At, B0); PG8_BAR; PG8_SCHED;
            PG8_LDB(B1, 1, 1); PG8_STAGE(PG8_SB(1, 0), b3, voffB);
            PG8_BAR; PG8_WAIT_L(0); PG8_MMA(0, 1, At, B1); PG8_BAR;
            PG8_LDA(At, 1, 1); PG8_STAGE(PG8_SA(1, 0), a3, voffA);
            PG8_BAR; PG8_WAIT_L(0); PG8_MMA(1, 0, At, B0); PG8_BAR; PG8_SCHED;
            PG8_STAGE(PG8_SB(1, 1), b3 + hstep, voffB);
            PG8_WAIT_V(6); PG8_BAR; PG8_MMA(1, 1, At, B1); PG8_BAR;
        }
        PG8_STAMP();
        if constexpr (!Epi::AFTER_DRAIN) { E(acc, cur, wr, wc, fr, fq); S.done(cur); }
        PG8_STAMP();
        if (!has_next) break;
#pragma unroll
        for (int a = 0; a < 2; ++a)
#pragma unroll
            for (int b = 0; b < 2; ++b)
#pragma unroll
                for (int m = 0; m < 4; ++m)
#pragma unroll
                    for (int n = 0; n < 2; ++n) acc[a][b][m][n] = (f32x4){0.f, 0.f, 0.f, 0.f};
        cur = nxt; cA = nA; cB = nB; ++ui;
    }
    PG8_WAIT_V(0);
    if (wr == 0) PG8_BAR;
    PG8_BAR;
    if constexpr (Epi::AFTER_DRAIN) { E.fused(acc, cur, wr, wc, fr, fq, lds, wid, lane); S.done(cur); }
    PG8_STAMP();
    if (STAMP && wid == 0) { stamps[lane] = lane < nts ? (((unsigned long long)(unsigned)ts_hi << 32) | (unsigned)ts_lo) : 0ull;
        if (lane == 62) stamps[62] = rt_entry; if (lane == 63) stamps[63] = (unsigned long long)wall_clock64(); }
#undef PG8_STAMP
#undef PG8_SA
#undef PG8_SB
#undef PG8_STAGE
#undef PG8_LDA
#undef PG8_LDB
#undef PG8_MMA
#undef PG8_WAIT_V
#undef PG8_WAIT_L
#undef PG8_BAR
#undef PG8_SCHED
}
}
struct Ctx {
    LAS unsigned char* lds; int tid, lane, wave, G, bid;
};

DI void cvt_rows(const Ctx& F, const float* src, bf16_t* dst, size_t n) {
    const size_t n8 = n >> 3;
    for (size_t i = (size_t)F.bid * NTHR + F.tid; i < n8; i += (size_t)F.G * NTHR) {
        const f32x4 a = *(const f32x4*)(src + i * 8), b = *(const f32x4*)(src + i * 8 + 4);
        u32x4 w; w.x = pk2(a.x, a.y); w.y = pk2(a.z, a.w); w.z = pk2(b.x, b.y); w.w = pk2(b.z, b.w);
        *(u32x4*)(dst + i * 8) = w;
    }
}

constexpr int TR_S = 68;
DI void tr_tile_out(const Ctx& F, bf16_t* dst, size_t ldd, const LAS bf16_t* tile) {
    const int n = F.tid >> 3, kc = (F.tid & 7) * 8;
    const LAS bf16_t* t = tile + kc * TR_S + n;
    u32x4 v;
    v.x = (unsigned)t[0] | ((unsigned)t[TR_S] << 16); v.y = (unsigned)t[2 * TR_S] | ((unsigned)t[3 * TR_S] << 16);
    v.z = (unsigned)t[4 * TR_S] | ((unsigned)t[5 * TR_S] << 16); v.w = (unsigned)t[6 * TR_S] | ((unsigned)t[7 * TR_S] << 16);
    *(u32x4*)(dst + (size_t)n * ldd + kc) = v;
}
DI void tr_tile_f32(const Ctx& F, const float* src, size_t lds_, bf16_t* dst, size_t ldd, LAS bf16_t* tile) {
#pragma unroll
    for (int j = 0; j < 2; ++j) {
        const int id = F.tid + NTHR * j, kr = id >> 4, nc = (id & 15) * 4;
        const f32x4 v = *(const f32x4*)(src + (size_t)kr * lds_ + nc);
        *(LAS u32x2*)(tile + kr * TR_S + nc) = (u32x2){pk2(v.x, v.y), pk2(v.z, v.w)};
    }
    __syncthreads();
    tr_tile_out(F, dst, ldd, tile);
    __syncthreads();
}
DI void tr_tile_bf16(const Ctx& F, const bf16_t* src, size_t lds_, bf16_t* dst, size_t ldd, LAS bf16_t* tile) {
    { const int kr = F.tid >> 3, nc = (F.tid & 7) * 8; const u32x4 v = *(const u32x4*)(src + (size_t)kr * lds_ + nc);
      *(LAS u32x2*)(tile + kr * TR_S + nc) = (u32x2){v.x, v.y}; *(LAS u32x2*)(tile + kr * TR_S + nc + 4) = (u32x2){v.z, v.w}; }
    __syncthreads();
    tr_tile_out(F, dst, ldd, tile);
    __syncthreads();
}
struct TrJob { const bf16_t* src; size_t lds_; bf16_t* dst; size_t ldd; };
template <class Map>
DI void tr_pipeline_bf16(const Ctx& F, int nt, const Map& map, LAS bf16_t* tiles) {
    const int kr = F.tid >> 3, nc = (F.tid & 7) * 8;
    __syncthreads();
    u32x4 v[4];
#pragma unroll
    for (int u = 0; u < 4; ++u) { const int t = F.bid + u * F.G; v[u] = (u32x4){0u, 0u, 0u, 0u};
        if (t < nt) { const TrJob J = map(t); v[u] = *(const u32x4*)(J.src + (size_t)kr * J.lds_ + nc); } }
#pragma unroll 1
    for (int t0 = F.bid; t0 < nt; t0 += 4 * F.G) {
#pragma unroll
        for (int u = 0; u < 4; ++u) { const int t = t0 + u * F.G;
            if (t < nt) {
                LAS bf16_t* tile = tiles + (u & 1) * (64 * TR_S);
                *(LAS u32x2*)(tile + kr * TR_S + nc) = (u32x2){v[u].x, v[u].y}; *(LAS u32x2*)(tile + kr * TR_S + nc + 4) = (u32x2){v[u].z, v[u].w};
                const int tn = t + 4 * F.G;
                if (tn < nt) { const TrJob Jn = map(tn); v[u] = *(const u32x4*)(Jn.src + (size_t)kr * Jn.lds_ + nc); }
                __syncthreads();
                const TrJob J = map(t);
                tr_tile_out(F, J.dst, J.ldd, tile);
            } }
    }
    __syncthreads();
}
DI void transpose_weight(const Ctx& F, const float* W, int K, int N, bf16_t* Wt) {
    const int tk = K / 64, tn = N / 64;
    for (int t = F.bid; t < tk * tn; t += F.G) {
        const int k0 = (t / tn) * 64, n0 = (t % tn) * 64;
        tr_tile_f32(F, W + (size_t)k0 * N + n0, (size_t)N, Wt + (size_t)n0 * K + k0, (size_t)K, (LAS bf16_t*)F.lds);
    }
}
DI void transpose_cache_v(const Ctx& F, const float* V, bf16_t* VT) {
    for (int t = F.bid; t < 64 * 8; t += F.G) {
        const int bh = t >> 3, sub = t & 7, k0 = (sub >> 1) * 64, d0 = (sub & 1) * 64, b = bh >> 3, h = bh & 7;
        tr_tile_f32(F, V + ((size_t)b * 256 + k0) * 1024 + h * 128 + d0, 1024, VT + ((size_t)bh * 128 + d0) * 256 + k0, 256, (LAS bf16_t*)F.lds);
    }
}

DI void adaln_partials(const Ctx& F, const Params& P) {
    LAS float* s = (LAS float*)F.lds;
    const float* modw = P.in[I_MODW]; const float* cv = P.in[I_C]; const float* cctx = P.in[I_CCTX];
    float* modp = (float*)(P.ws + WS_MODP);
    for (int it = F.bid; it < 192; it += F.G) {
        const int i = it / 96, r = it % 96, ks = r / 6, cg = r % 6;
        __syncthreads();
        for (int e = F.tid; e < 9 * 128; e += NTHR) { const int j = e >> 7, k = e & 127; const float c = (j == 0) ? cctx[ks * 128 + k] : cv[(j - 1) * 2048 + ks * 128 + k]; s[e] = c / (1.f + __expf(-c)); }
        __syncthreads();
        f32x4 acc[9];
#pragma unroll
        for (int j = 0; j < 9; ++j) acc[j] = (f32x4){0.f, 0.f, 0.f, 0.f};
        const float* w = modw + ((size_t)i * 2048 + ks * 128) * 12288 + cg * 2048 + F.tid * 4;
#pragma unroll 8
        for (int k = 0; k < 128; ++k) {
            const f32x4 w4 = *(const f32x4*)(w + (size_t)k * 12288);
#pragma unroll
            for (int j = 0; j < 9; ++j) acc[j] += w4 * s[j * 128 + k];
        }
#pragma unroll
        for (int j = 0; j < 9; ++j) *(f32x4*)(modp + ((size_t)(i * 16 + ks) * 9 + j) * 12288 + cg * 2048 + F.tid * 4) = acc[j];
    }
    __syncthreads();
}
DI void adaln_reduce(const Ctx& F, const Params& P) {
    const float* modp = (const float*)(P.ws + WS_MODP); float* mod = (float*)(P.ws + WS_MOD); const float* modb = P.in[I_MODB];
    for (int e = F.bid * NTHR + F.tid; e < 2 * 9 * 12288; e += F.G * NTHR) {
        const int i = e / (9 * 12288), r = e % (9 * 12288), j = r / 12288, n = r % 12288;
        float a = modb[i * 12288 + n];
#pragma unroll
        for (int ks = 0; ks < 16; ++ks) a += modp[((size_t)(i * 16 + ks) * 9 + j) * 12288 + n];
        mod[e] = a;
    }
}

DI void hyena_filters(const Ctx& F, const Params& P) {
    LAS float* z = (LAS float*)F.lds;
    LAS float* h1 = z + 320;
    LAS float* h2 = h1 + 576;
    const float* w1 = P.in[I_HYW1]; const float* b1 = P.in[I_HYB1]; const float* f1 = P.in[I_HYF1];
    const float* w2 = P.in[I_HYW2]; const float* b2 = P.in[I_HYB2]; const float* f2 = P.in[I_HYF2];
    const float* w3 = P.in[I_HYW3]; const float* dec = P.in[I_HYDEC];
    for (int it = F.bid; it < 544; it += F.G) {
        const bool smp = it < 512; const int L = smp ? LS : LP, p0 = (smp ? it : it - 512) * 8, RL = smp ? KRL_S : KRL_P;
        bf16_t* KR = (bf16_t*)(P.ws + (smp ? WS_KRS : WS_KRP));
        __syncthreads();
        if (F.tid < 9 * 33) {
            const int ps = F.tid / 33, k = F.tid % 33, i = p0 + ps;
            const float t = (float)i / (float)(L - 1), wang = 6.283185307179586f * (float)i / (float)L;
            float val;
            if (k == 0) val = t;
            else { const int f = (k - 1) & 15; const float fr = 1e-4f + (float)f * ((15.0f - 1e-4f) / 15.0f); val = (k <= 16) ? cosf(fr * wang) : -sinf(fr * wang); }
            z[F.tid] = val;
        }
        __syncthreads();
        for (int e = F.tid; e < 9 * 64; e += NTHR) { const int ps = e >> 6, j = e & 63; float a = b1[j];
            for (int k = 0; k < 33; ++k) a += z[ps * 33 + k] * w1[k * 64 + j];
            h1[e] = sinf(f1[j] * a); }
        __syncthreads();
        for (int e = F.tid; e < 9 * 64; e += NTHR) { const int ps = e >> 6, j = e & 63; float a = b2[j];
            for (int k = 0; k < 64; ++k) a += h1[ps * 64 + k] * w2[k * 64 + j];
            h2[e] = sinf(f2[j] * a); }
        __syncthreads();
#pragma unroll 1
        for (int qh = 0; qh < 2; ++qh) {
            float acc[9][4];
#pragma unroll
            for (int ps = 0; ps < 9; ++ps)
#pragma unroll
                for (int q = 0; q < 4; ++q) acc[ps][q] = 0.f;
#pragma unroll 2
            for (int k = 0; k < 64; ++k) {
                float w[4];
#pragma unroll
                for (int q = 0; q < 4; ++q) w[q] = w3[k * 4096 + F.tid + NTHR * (qh * 4 + q)];
#pragma unroll
                for (int ps = 0; ps < 9; ++ps) { const float hv = h2[ps * 64 + k];
#pragma unroll
                    for (int q = 0; q < 4; ++q) acc[ps][q] += hv * w[q]; }
            }
#pragma unroll
            for (int q = 0; q < 4; ++q) {
                const int n = F.tid + NTHR * (qh * 4 + q), o = (n >> 10) & 1, c = n & 1023;
                const float dc = fabsf(dec[n]);
                bf16_t* row = KR + (size_t)(o * 1024 + c) * RL;
                float v[9];
#pragma unroll
                for (int ps = 0; ps < 9; ++ps) { const int i = p0 + ps; v[ps] = (i < L) ? acc[ps][q] * __expf(-((float)i / (float)(L - 1)) * dc) : 0.f; }
                if (qh == 0) {
                    u32x4 wv; wv.x = pk2(v[8], v[7]); wv.y = pk2(v[6], v[5]); wv.z = pk2(v[4], v[3]); wv.w = pk2(v[2], v[1]);
                    *(u32x4*)(row + (L - p0 - 8)) = wv;
                    if (p0 == 0) row[L] = f2bf(v[0]);
                } else if (p0 > 0) {
                    u32x4 wv; wv.x = pk2(v[0], v[1]); wv.y = pk2(v[2], v[3]); wv.z = pk2(v[4], v[5]); wv.w = pk2(v[6], v[7]);
                    *(u32x4*)(row + (L + p0)) = wv;
                } else {
#pragma unroll
                    for (int ps = 1; ps < 8; ++ps) row[L + ps] = f2bf(v[ps]);
                }
            }
        }
    }
    __syncthreads();
    for (int e = F.bid * NTHR + F.tid; e < 2 * 2048; e += F.G * NTHR) {
        const bool smp = e < 2048; const int r = e & 2047, L = smp ? LS : LP, RL = smp ? KRL_S : KRL_P;
        bf16_t* row = (bf16_t*)(P.ws + (smp ? WS_KRS : WS_KRP)) + (size_t)r * RL;
        for (int x = 2 * L; x < RL; ++x) row[x] = 0;
    }
}

DI void s5_consts(const Ctx& F, const Params& P) {
    float* S5A = (float*)(P.ws + WS_S5A); bf16_t* BB = (bf16_t*)(P.ws + WS_S5BB); bf16_t* CC = (bf16_t*)(P.ws + WS_S5CC);
    const float* lre = P.in[I_S5LRE]; const float* lim = P.in[I_S5LIM]; const float* ldt = P.in[I_S5LDT];
    const float* bre = P.in[I_S5BRE]; const float* bim = P.in[I_S5BIM]; const float* cre = P.in[I_S5CRE]; const float* cim = P.in[I_S5CIM];
    for (int e = F.bid * NTHR + F.tid; e < 8192; e += F.G * NTHR) {
        const int dg = e >> 6, n = e & 63;
        const float dt = expf(ldt[dg]), lr = lre[e], li = lim[e];
        const float mag = expf(lr * dt), ar = mag * cosf(li * dt), ai = mag * sinf(li * dt), den = lr * lr + li * li;
        const float cr = ((ar - 1.f) * lr + ai * li) / den, ci = (ai * lr - (ar - 1.f) * li) / den;
        S5A[e * 2] = ar; S5A[e * 2 + 1] = ai;
#pragma unroll
        for (int p = 0; p < 16; ++p) {
            const float br = bre[(size_t)e * 16 + p], bi = bim[(size_t)e * 16 + p];
            BB[((size_t)dg * 128 + n) * 16 + p] = f2bf(cr * br - ci * bi);
            BB[((size_t)dg * 128 + 64 + n) * 16 + p] = f2bf(cr * bi + ci * br);
            CC[((size_t)dg * 16 + p) * 128 + n] = f2bf(cre[((size_t)dg * 16 + p) * 64 + n]);
            CC[((size_t)dg * 16 + p) * 128 + 64 + n] = f2bf(-cim[((size_t)dg * 16 + p) * 64 + n]);
        }
    }
}

constexpr int PT_ROWB = 1536;
DI void cvt_table_fp6(const Ctx& F, const float* src, unsigned char* dst, float* scales, const int (&perm)[32]) {
    LAS float* scr = (LAS float*)(F.lds) + F.wave * 2048 + F.lane;
    for (int r = F.bid * 8 + F.wave; r < 16384; r += F.G * 8) {
        f32x4 v[8]; float m = 0.f;
#pragma unroll
        for (int j = 0; j < 8; ++j) { v[j] = *(const f32x4*)(src + (size_t)r * 2048 + F.lane * 32 + j * 4);
            m = fmaxf(m, fmaxf(fmaxf(fabsf(v[j].x), fabsf(v[j].y)), fmaxf(fabsf(v[j].z), fabsf(v[j].w)))); }
        m = wave_max(m);
        const float inv = (m > 0.f) ? 7.0f / m : 0.f, sc = (m > 0.f) ? m / 7.0f : 0.f;
#pragma unroll
        for (int j = 0; j < 8; ++j) { scr[perm[j * 4 + 0] * 64] = v[j].x * inv; scr[perm[j * 4 + 1] * 64] = v[j].y * inv; scr[perm[j * 4 + 2] * 64] = v[j].z * inv; scr[perm[j * 4 + 3] * 64] = v[j].w * inv; }
        asm volatile("" ::: "memory");
        f32x16 a, b;
#pragma unroll
        for (int i = 0; i < 16; ++i) { a[i] = scr[i * 64]; b[i] = scr[(16 + i) * 64]; }
        asm volatile("" ::: "memory");
        const u32x6 pk = __builtin_amdgcn_cvt_scalef32_2xpk16_fp6_f32(a, b, 1.0f);
        unsigned char* o = dst + (size_t)r * PT_ROWB;
        *(u32x4*)(o + F.lane * 16) = (u32x4){pk[0], pk[1], pk[2], pk[3]}; *(u32x2*)(o + 1024 + F.lane * 8) = (u32x2){pk[4], pk[5]};
        if (F.lane == 0) scales[r] = sc;
    }
}
DI void convert_peer_tables(const Ctx& F, const Params& P) {
    int perm[32];
    { f32x16 a, b;
#pragma unroll
      for (int j = 0; j < 16; ++j) { a[j] = 0.125f * (float)j; b[j] = (j < 8) ? 2.0f + 0.25f * (float)j : 4.0f + 0.5f * (float)(j - 8); }
      const u32x6 pk = __builtin_amdgcn_cvt_scalef32_2xpk16_fp6_f32(a, b, 1.0f);
      const f32x32 rt = __builtin_amdgcn_cvt_scalef32_pk32_f32_fp6(pk, 1.0f);
#pragma unroll
      for (int i = 0; i < 32; ++i) { const float x = rt[i]; const int o = (x < 2.0f) ? (int)(x * 8.0f + 0.5f) : ((x < 4.0f) ? 16 + (int)((x - 2.0f) * 4.0f + 0.5f) : 24 + (int)((x - 4.0f) * 2.0f + 0.5f)); perm[i] = min(max(o, 0), 31); } }
    float* SC = (float*)(P.ws + WS_SC);
    __syncthreads();
    for (int layer = 0; layer < 2; ++layer) {
        cvt_table_fp6(F, P.in[I_PU] + (size_t)layer * 16384 * 2048, P.ws + WS_TBLU + (size_t)layer * 16384 * PT_ROWB, SC + layer * 16384, perm);
        cvt_table_fp6(F, P.in[I_PV] + (size_t)layer * 16384 * 2048, P.ws + WS_TBLV + (size_t)layer * 16384 * PT_ROWB, SC + (2 + layer) * 16384, perm);
    }
    __syncthreads();
}

DI void prologue(const Ctx& F, const Params& P) {
    adaln_partials(F, P);
    transpose_weight(F, P.in[I_EVWIN], 2048, 6144, (bf16_t*)(P.ws + WS_WEVIN));
    transpose_weight(F, P.in[I_EVWOUT], 2048, 2048, (bf16_t*)(P.ws + WS_WEVOUT));
    transpose_weight(F, P.in[I_ODWIN], 2048, 4096, (bf16_t*)(P.ws + WS_WODIN));
    transpose_weight(F, P.in[I_ODWOUT], 2048, 2048, (bf16_t*)(P.ws + WS_WODOUT));
    transpose_weight(F, P.in[I_PWQ], 2048, 2048, (bf16_t*)(P.ws + WS_WPQ));
    transpose_weight(F, P.in[I_PWQ] + (size_t)2048 * 2048, 2048, 2048, (bf16_t*)(P.ws + WS_WPQ) + (size_t)2048 * 2048);
    transpose_weight(F, P.in[I_GLUW], 1024, 1024, (bf16_t*)(P.ws + WS_WGLU));
    cvt_rows(F, P.in[I_PKEYS], (bf16_t*)(P.ws + WS_PKEYS), (size_t)2 * 8 * 2 * 128 * 128);
    cvt_rows(F, P.in[I_CNK], (bf16_t*)(P.ws + WS_CNK), (size_t)8 * 256 * 1024);
    cvt_rows(F, P.in[I_CDK], (bf16_t*)(P.ws + WS_CDK), (size_t)8 * 256 * 1024);
    transpose_cache_v(F, P.in[I_CNV], (bf16_t*)(P.ws + WS_CNVT));
    transpose_cache_v(F, P.in[I_CDV], (bf16_t*)(P.ws + WS_CDVT));
    hyena_filters(F, P);
    s5_consts(F, P);
    convert_peer_tables(F, P);
}
DI void norm_phase(const Ctx& F, const float* xa, const float* xb, const float* gvec, const float* modl, int sidx, bf16_t* H) {
    for (int T = F.bid * 8 + F.wave; T < TOK; T += F.G * 8) {
        const float* xr = T < TP ? xa + (size_t)T * DM : xb + (size_t)(T - TP) * DM;
        f32x4 v[8]; float ss = 0.f;
#pragma unroll
        for (int j = 0; j < 8; ++j) { v[j] = *(const f32x4*)(xr + (j * 64 + F.lane) * 4); ss += v[j].x * v[j].x + v[j].y * v[j].y + v[j].z * v[j].z + v[j].w * v[j].w; }
        ss = wave_sum(ss);
        const float rstd = rsqrtf(ss * (1.f / DM) + NORM_EPS);
        const float* sh = modl + (size_t)(cond_of(T) * 6 + sidx) * DM; const float* sc = sh + DM;
#pragma unroll
        for (int j = 0; j < 8; ++j) {
            const int col = (j * 64 + F.lane) * 4;
            const f32x4 g4 = *(const f32x4*)(gvec + col), s4 = *(const f32x4*)(sc + col), h4 = *(const f32x4*)(sh + col);
            const f32x4 o = v[j] * rstd * g4 * (s4 + 1.f) + h4;
            u32x2 w; w.x = pk2(o.x, o.y); w.y = pk2(o.z, o.w);
            *(u32x2*)(H + (size_t)T * DM + col) = w;
        }
    }
}

struct EpiBf16 {
    static constexpr bool PERM = true, AFTER_DRAIN = false;
    bf16_t* O; int ldc;
    DI void operator()(const f32x4 (&acc)[2][2][4][2], const pg8::Unit& u, int wr, int wc, int fr, int fq) const {
        const int row0 = u.pm * 256 + wr * 64 + fr, col0 = u.pn * 256 + wc * 32 + 8 * fq;
#pragma unroll
        for (int ai = 0; ai < 2; ++ai)
#pragma unroll
            for (int m = 0; m < 4; ++m) { bf16_t* rowp = O + (size_t)(row0 + ai * 128 + m * 16) * ldc + col0;
#pragma unroll
                for (int bj = 0; bj < 2; ++bj) { const f32x4 v0 = acc[ai][bj][m][0], v1 = acc[ai][bj][m][1];
                    u32x4 w; w.x = pk2(v0[0], v0[1]); w.y = pk2(v0[2], v0[3]); w.z = pk2(v1[0], v1[1]); w.w = pk2(v1[2], v1[3]);
                    *(u32x4*)(rowp + bj * 128) = w; } }
    }
};
struct EpiResid {
    static constexpr bool PERM = false, AFTER_DRAIN = false;
    const float* xa; const float* xb; float* out; const float* modl; int gidx;
    DI void operator()(const f32x4 (&acc)[2][2][4][2], const pg8::Unit& u, int wr, int wc, int fr, int fq) const {
        const int row0 = u.pm * 256 + wr * 64 + fr, col0 = u.pn * 256 + wc * 32 + 4 * fq;
        const float* xbase = (u.pm < 32) ? xa : xb - (size_t)TP * DM;
        const float* gate = modl + (size_t)(cond_of(u.pm * 256) * 6 + gidx) * DM;
        f32x4 gv[2][2];
#pragma unroll
        for (int bj = 0; bj < 2; ++bj)
#pragma unroll
            for (int n = 0; n < 2; ++n) gv[bj][n] = *(const f32x4*)(gate + col0 + bj * 128 + n * 16);
#pragma unroll
        for (int ai = 0; ai < 2; ++ai)
#pragma unroll
            for (int m = 0; m < 4; ++m) { const size_t ro = (size_t)(row0 + ai * 128 + m * 16) * DM + col0;
#pragma unroll
                for (int bj = 0; bj < 2; ++bj)
#pragma unroll
                    for (int n = 0; n < 2; ++n) { const f32x4 x4 = *(const f32x4*)(xbase + ro + bj * 128 + n * 16);
                        *(f32x4*)(out + ro + bj * 128 + n * 16) = x4 + gv[bj][n] * acc[ai][bj][m][n]; } }
    }
};
struct EpiGlu {
    static constexpr bool PERM = true, AFTER_DRAIN = false;
    const bf16_t* Y; bf16_t* O; const float* bias;
    DI void operator()(const f32x4 (&acc)[2][2][4][2], const pg8::Unit& u, int wr, int wc, int fr, int fq) const {
        const int row0 = u.pm * 256 + wr * 64 + fr, col0 = u.pn * 256 + wc * 32 + 8 * fq;
#pragma unroll
        for (int bj = 0; bj < 2; ++bj) {
            const f32x4 b0 = *(const f32x4*)(bias + col0 + bj * 128), b1 = *(const f32x4*)(bias + col0 + bj * 128 + 4);
#pragma unroll
            for (int ai = 0; ai < 2; ++ai)
#pragma unroll
                for (int m = 0; m < 4; ++m) { const size_t r = (size_t)(row0 + ai * 128 + m * 16);
                    const u32x4 yv = *(const u32x4*)(Y + r * 1024 + col0 + bj * 128);
                    const f32x4 a0 = acc[ai][bj][m][0] + b0, a1 = acc[ai][bj][m][1] + b1;
                    float o[8];
                    o[0] = bflo(yv.x) / (1.f + __expf(-a0[0])); o[1] = bfhi(yv.x) / (1.f + __expf(-a0[1]));
                    o[2] = bflo(yv.y) / (1.f + __expf(-a0[2])); o[3] = bfhi(yv.y) / (1.f + __expf(-a0[3]));
                    o[4] = bflo(yv.z) / (1.f + __expf(-a1[0])); o[5] = bfhi(yv.z) / (1.f + __expf(-a1[1]));
                    o[6] = bflo(yv.w) / (1.f + __expf(-a1[2])); o[7] = bfhi(yv.w) / (1.f + __expf(-a1[3]));
                    u32x4 w; w.x = pk2(o[0], o[1]); w.y = pk2(o[2], o[3]); w.z = pk2(o[4], o[5]); w.w = pk2(o[6], o[7]);
                    *(u32x4*)(O + r * DM + col0 + bj * 128) = w; }
        }
    }
};
template <class Epi> DI void run_gemm(const Ctx& F, const bf16_t* A, const bf16_t* Bt, int N, int K, const Epi& E) {
    pg8::Gemm g{A, Bt, TOK, N, K}; pg8::StaticOrder S; S.init(TOK, N, F.G, F.bid);
    pg8::gemm_phase<Epi, pg8::StaticOrder, false>(F.lds, g, S, E, nullptr);
    __syncthreads();
}

DI void prep_a(const Ctx& F, const Params& P) {
    const bf16_t* T1 = (const bf16_t*)(P.ws + WS_RA);
    bf16_t* VTp = (bf16_t*)(P.ws + WS_VT); bf16_t* VTs = (bf16_t*)(P.ws + WS_VT + VT_S);
    { struct VtMap { const bf16_t* T1; bf16_t* VTp; bf16_t* VTs;
          DI TrJob operator()(int t) const {
              if (t < 2048) { const int bh = t >> 3, sub = t & 7, tk = sub >> 1, dd = sub & 1, b = bh >> 3, h = bh & 7;
                  return TrJob{T1 + ((size_t)(b * 256 + tk * 64)) * 4096 + h * 128 + dd * 64, 4096, VTp + ((size_t)bh * 128 + dd * 64) * 256 + tk * 64, 256}; }
              const int u = t - 2048, bh = u >> 7, sub = u & 127, tk = sub >> 1, dd = sub & 1, b = bh >> 3, h = bh & 7;
              return TrJob{T1 + ((size_t)(TP + b * 4096 + tk * 64)) * 4096 + h * 128 + dd * 64, 4096, VTs + ((size_t)bh * 128 + dd * 64) * 4096 + tk * 64, 4096}; } };
      tr_pipeline_bf16(F, 2048 + 8192, VtMap{T1, VTp, VTs}, (LAS bf16_t*)F.lds); }
    { float* o = P.out + O_NAV;
      for (int e = F.bid * NTHR + F.tid; e < TP * 128; e += F.G * NTHR) { const int T = e >> 7, c8 = (e & 127) * 8;
          const u32x4 v = *(const u32x4*)(T1 + (size_t)T * 4096 + c8);
          *(f32x4*)(o + (size_t)T * 1024 + c8) = (f32x4){bflo(v.x), bfhi(v.x), bflo(v.y), bfhi(v.y)};
          *(f32x4*)(o + (size_t)T * 1024 + c8 + 4) = (f32x4){bflo(v.z), bfhi(v.z), bflo(v.w), bfhi(v.w)}; } }
    { LAS bf16_t* tl = (LAS bf16_t*)F.lds;
      bf16_t* CM = (bf16_t*)(P.ws + WS_RB);
      const float* cw = P.in[I_HYCW]; const float* cb = P.in[I_HYCB];
      u32x4 vv[4], hv = (u32x4){0u, 0u, 0u, 0u};
#define PA_LOAD(t_) do { const int cg_ = (t_) % 48, tg_ = (t_) / 48, ch0_ = cg_ * 64, t0_ = tg_ * 256; \
          _Pragma("unroll") for (int j = 0; j < 4; ++j) { const int id = F.tid + NTHR * j, tk = id >> 3, c8 = (id & 7) * 8; \
              vv[j] = *(const u32x4*)(T1 + (size_t)(t0_ + tk) * 4096 + 1024 + ch0_ + c8); } \
          if (F.tid < 16) { const int side = F.tid >> 3, c8 = (F.tid & 7) * 8; \
              const bool lz_ = (t0_ < TP) ? true : (((t0_ - TP) & 4095) == 0), rz_ = (t0_ < TP) ? true : (((t0_ + 256 - TP) & 4095) == 0); \
              const bool zero = side ? rz_ : lz_; const int tk = side ? t0_ + 256 : t0_ - 1; \
              hv = (u32x4){0u, 0u, 0u, 0u}; \
              if (!zero) hv = *(const u32x4*)(T1 + (size_t)tk * 4096 + 1024 + ch0_ + c8); } } while (0)
      if (F.bid < 48 * 160) PA_LOAD(F.bid);
      for (int t = F.bid; t < 48 * 160; t += F.G) {
          const int cg = t % 48, tg = t / 48, ch0 = cg * 64, t0 = tg * 256;
          __syncthreads();
#pragma unroll
          for (int j = 0; j < 4; ++j) { const int id = F.tid + NTHR * j, tk = id >> 3, c8 = (id & 7) * 8;
              const u32x4 v = vv[j];
              LAS bf16_t* d = tl + tk + 1;
              d[(c8 + 0) * 264] = (bf16_t)(v.x & 0xffff); d[(c8 + 1) * 264] = (bf16_t)(v.x >> 16); d[(c8 + 2) * 264] = (bf16_t)(v.y & 0xffff); d[(c8 + 3) * 264] = (bf16_t)(v.y >> 16);
              d[(c8 + 4) * 264] = (bf16_t)(v.z & 0xffff); d[(c8 + 5) * 264] = (bf16_t)(v.z >> 16); d[(c8 + 6) * 264] = (bf16_t)(v.w & 0xffff); d[(c8 + 7) * 264] = (bf16_t)(v.w >> 16); }
          if (F.tid < 16) { const int side = F.tid >> 3, c8 = (F.tid & 7) * 8;
              const u32x4 v = hv;
              LAS bf16_t* d = tl + (side ? 257 : 0);
              d[(c8 + 0) * 264] = (bf16_t)(v.x & 0xffff); d[(c8 + 1) * 264] = (bf16_t)(v.x >> 16); d[(c8 + 2) * 264] = (bf16_t)(v.y & 0xffff); d[(c8 + 3) * 264] = (bf16_t)(v.y >> 16);
              d[(c8 + 4) * 264] = (bf16_t)(v.z & 0xffff); d[(c8 + 5) * 264] = (bf16_t)(v.z >> 16); d[(c8 + 6) * 264] = (bf16_t)(v.w & 0xffff); d[(c8 + 7) * 264] = (bf16_t)(v.w >> 16); }
          if (t + F.G < 48 * 160) PA_LOAD(t + F.G);
          __syncthreads();
#pragma unroll
          for (int j = 0; j < 4; ++j) { const int id = F.tid + NTHR * j, ch = id >> 5, to = (id & 31) * 8, cgl = ch0 + ch;
              const float w0 = cw[cgl], w1 = cw[3072 + cgl], w2 = cw[6144 + cgl], bb = cb[cgl];
              const LAS bf16_t* s = tl + ch * 264 + to;
              float r[10];
#pragma unroll
              for (int i = 0; i < 10; ++i) r[i] = bf2f(s[i]);
              float o[8];
#pragma unroll
              for (int i = 0; i < 8; ++i) o[i] = w0 * r[i] + w1 * r[i + 1] + w2 * r[i + 2] + bb;
              u32x4 w; w.x = pk2(o[0], o[1]); w.y = pk2(o[2], o[3]); w.z = pk2(o[4], o[5]); w.w = pk2(o[6], o[7]);
              *(u32x4*)(CM + (size_t)cgl * TOK + t0 + to) = w; }
      }
#undef PA_LOAD
      __syncthreads(); }
}

DI void prep_b(const Ctx& F, const Params& P) {
    bf16_t* Pq = (bf16_t*)(P.ws + WS_RA); const float* qg = P.in[I_NAQG]; const float* kg = P.in[I_NAKG]; float* ok = P.out + O_NAK;
    const float* gsrc = (F.lane < 32 ? qg : kg) + (F.lane & 3) * 32;
    float g[32];
#pragma unroll
    for (int i = 0; i < 32; ++i) g[i] = gsrc[i];
    for (int T = F.bid * 8 + F.wave; T < TOK; T += F.G * 8) {
        bf16_t* rp = Pq + (size_t)T * 2048 + F.lane * 32;
        u32x4 v[4]; float x[32]; float ss = 0.f;
#pragma unroll
        for (int j = 0; j < 4; ++j) { v[j] = *(const u32x4*)(rp + j * 8);
            x[j * 8 + 0] = bflo(v[j].x); x[j * 8 + 1] = bfhi(v[j].x); x[j * 8 + 2] = bflo(v[j].y); x[j * 8 + 3] = bfhi(v[j].y);
            x[j * 8 + 4] = bflo(v[j].z); x[j * 8 + 5] = bfhi(v[j].z); x[j * 8 + 6] = bflo(v[j].w); x[j * 8 + 7] = bfhi(v[j].w); }
#pragma unroll
        for (int i = 0; i < 32; ++i) ss += x[i] * x[i];
        ss += dpp_xor1(ss); ss += dpp_xor2(ss);
        const float rstd = rsqrtf(ss * (1.f / 128.f) + NORM_EPS);
#pragma unroll
        for (int i = 0; i < 32; ++i) x[i] = x[i] * rstd * g[i];
#pragma unroll
        for (int j = 0; j < 4; ++j) { u32x4 w; w.x = pk2(x[j * 8 + 0], x[j * 8 + 1]); w.y = pk2(x[j * 8 + 2], x[j * 8 + 3]); w.z = pk2(x[j * 8 + 4], x[j * 8 + 5]); w.w = pk2(x[j * 8 + 6], x[j * 8 + 7]);
            *(u32x4*)(rp + j * 8) = w; }
        if (T < TP && F.lane >= 32) { float* o = ok + (size_t)T * 1024 + (F.lane - 32) * 32;
#pragma unroll
            for (int j = 0; j < 8; ++j) *(f32x4*)(o + j * 4) = (f32x4){x[j * 4], x[j * 4 + 1], x[j * 4 + 2], x[j * 4 + 3]}; }
    }
}
constexpr int AT_KROW = 272, AT_VROW = 136, AT_KTB = 64 * AT_KROW, AT_VTB = 128 * AT_VROW;
constexpr int AT_K0 = 0, AT_V0 = 2 * AT_KTB, AT_RPB = AT_V0 + 2 * AT_VTB;

struct TileMap { const bf16_t* latK; int latKld; const bf16_t* latV; int latVld; int nlat; const bf16_t* ctxK; const bf16_t* ctxV; int ntiles; };
struct TileRegs { u32x4 k[2], v[2]; };

DI void tile_src(const TileMap& M, int j, const bf16_t*& kp, int& kld, const bf16_t*& vp, int& vld) {
    if (j < M.nlat) { kp = M.latK + (size_t)j * 64 * M.latKld; kld = M.latKld; vp = M.latV + j * 64; vld = M.latVld; }
    else { const int c = j - M.nlat; kp = M.ctxK + (size_t)c * 64 * 1024; kld = 1024; vp = M.ctxV + c * 64; vld = 256; }
}
DI void tile_load(const Ctx& F, TileRegs& R, const bf16_t* kp, int kld, const bf16_t* vp, int vld, bool withV = true) {
#pragma unroll
    for (int j = 0; j < 2; ++j) { const int id = F.tid + NTHR * j;
        const unsigned ko = (unsigned)((id >> 4) * kld + (id & 15) * 8) * 2u, vo = (unsigned)((id >> 3) * vld + (id & 7) * 8) * 2u;
        R.k[j] = *(const u32x4*)((const char*)kp + ko);
        if (withV) R.v[j] = *(const u32x4*)((const char*)vp + vo); }
}
DI void tile_store(const Ctx& F, const TileRegs& R, LAS unsigned char* kt, LAS unsigned char* vt, bool withV = true) {
#pragma unroll
    for (int j = 0; j < 2; ++j) { const int id = F.tid + NTHR * j;
        *(LAS u32x4*)(kt + (id >> 4) * AT_KROW + (id & 15) * 16) = R.k[j];
        if (withV) { LAS unsigned char* vp = vt + (id >> 3) * AT_VROW + (id & 7) * 16;
            *(LAS u32x2*)(vp) = (u32x2){R.v[j].x, R.v[j].y}; *(LAS u32x2*)(vp + 8) = (u32x2){R.v[j].z, R.v[j].w}; } }
}

DI void tile_norm_k(const Ctx& F, TileRegs& R, const LAS float* kgain, float* nk, int nkld) {
#pragma unroll
    for (int j = 0; j < 2; ++j) { const int id = F.tid + NTHR * j;
        float x[8] = {bflo(R.k[j].x), bfhi(R.k[j].x), bflo(R.k[j].y), bfhi(R.k[j].y), bflo(R.k[j].z), bfhi(R.k[j].z), bflo(R.k[j].w), bfhi(R.k[j].w)};
        float ss = 0.f;
#pragma unroll
        for (int i = 0; i < 8; ++i) ss += x[i] * x[i];
        ss += dpp_xor1(ss); ss += dpp_xor2(ss);
        ss += __builtin_bit_cast(float, __builtin_amdgcn_update_dpp(0, __builtin_bit_cast(int, ss), 0x141, 0xF, 0xF, true));
        ss += __builtin_bit_cast(float, __builtin_amdgcn_update_dpp(0, __builtin_bit_cast(int, ss), 0x140, 0xF, 0xF, true));
        const float rstd = rsqrtf(ss * (1.f / 128.f) + NORM_EPS);
        const f32x4 g0 = *(const LAS f32x4*)(kgain + (id & 15) * 8), g1 = *(const LAS f32x4*)(kgain + (id & 15) * 8 + 4);
        x[0] *= rstd * g0.x; x[1] *= rstd * g0.y; x[2] *= rstd * g0.z; x[3] *= rstd * g0.w; x[4] *= rstd * g1.x; x[5] *= rstd * g1.y; x[6] *= rstd * g1.z; x[7] *= rstd * g1.w;
        R.k[j] = (u32x4){pk2(x[0], x[1]), pk2(x[2], x[3]), pk2(x[4], x[5]), pk2(x[6], x[7])};
        if (nk) { float* o = nk + (size_t)(id >> 4) * nkld + (id & 15) * 8; *(f32x4*)(o) = (f32x4){x[0], x[1], x[2], x[3]}; *(f32x4*)(o + 4) = (f32x4){x[4], x[5], x[6], x[7]}; }
    }
}

template <int KS>
DI f32x16 qk_tile(LAS const unsigned char* kt, const bf16x8 (&Qf)[8], int kb, int kk0, int q, int hh) {
    f32x16 S;
#pragma unroll
    for (int i = 0; i < 16; ++i) S[i] = 0.f;
#pragma unroll
    for (int ks = 0; ks < KS; ++ks) { const int kk = kk0 + ks;
        const bf16x8 A = *(const LAS bf16x8*)(kt + (kb * 32 + q) * AT_KROW + (kk * 16 + hh * 8) * 2);
        S = __builtin_amdgcn_mfma_f32_32x32x16_bf16(A, Qf[kk], S, 0, 0, 0); }
    return S;
}
DI void pv_tile(LAS const unsigned char* vt, const float (&p)[16], f32x16 (&O)[4], int kb, int q, int hh) {
#pragma unroll
    for (int s = 0; s < 2; ++s) {
        u32x4 pw; pw.x = pk2(p[8 * s + 0], p[8 * s + 1]); pw.y = pk2(p[8 * s + 2], p[8 * s + 3]); pw.z = pk2(p[8 * s + 4], p[8 * s + 5]); pw.w = pk2(p[8 * s + 6], p[8 * s + 7]);
        const bf16x8 Pf = __builtin_bit_cast(bf16x8, pw);
#pragma unroll
        for (int db = 0; db < 4; ++db) {
            LAS const unsigned char* ap = vt + (db * 32 + q) * AT_VROW + (kb * 32 + 16 * s + 4 * hh) * 2;
            const u32x2 lo = *(const LAS u32x2*)(ap), hi = *(const LAS u32x2*)(ap + 16);
            const bf16x8 A2 = __builtin_bit_cast(bf16x8, (u32x4){lo.x, lo.y, hi.x, hi.y});
            O[db] = __builtin_amdgcn_mfma_f32_32x32x16_bf16(A2, Pf, O[db], 0, 0, 0);
        }
        asm volatile("" ::: "memory");
    }
}
template <bool LAT>
DI void attn_compute1(LAS const unsigned char* kt, LAS const unsigned char* vt, const bf16x8 (&Qf)[8], f32x16 (&O)[4], float& ls, int lane, const LAS float* blane, int mb) {
    const int q = lane & 31, hh = lane >> 5;
#pragma unroll 1
    for (int kb = 0; kb < 2; ++kb) {
        float bb[16];
        if (LAT) {
#pragma unroll
            for (int i = 0; i < 16; ++i) bb[i] = blane[kb * 32 + (i & 3) + 8 * (i >> 2)];
        }
        const f32x16 S = qk_tile<8>(kt, Qf, kb, 0, q, hh);
        float p[16];
#pragma unroll
        for (int i = 0; i < 16; ++i) {
            if (LAT) { const float e = __builtin_amdgcn_exp2f(S[i] + bb[i]);
                p[i] = ((unsigned)(kb * 32 + (i & 3) + 8 * (i >> 2) + mb) < 16u) ? e : 0.f; }
            else p[i] = __builtin_amdgcn_exp2f(S[i]);
            ls += p[i];
        }
        pv_tile(vt, p, O, kb, q, hh);
    }
}
DI void diff_pass1(LAS const unsigned char* kt, const bf16x8 (&Qf)[8], float (&ls)[2], int lane) {
    const int q = lane & 31, hh = lane >> 5;
#pragma unroll
    for (int kb = 0; kb < 2; ++kb) {
#pragma unroll
        for (int mp = 0; mp < 2; ++mp) { const f32x16 S = qk_tile<4>(kt, Qf, kb, mp * 4, q, hh);
#pragma unroll
            for (int i = 0; i < 16; ++i) ls[mp] += __builtin_amdgcn_exp2f(S[i]); }
    }
}
DI void diff_pass2(LAS const unsigned char* kt, LAS const unsigned char* vt, const bf16x8 (&Qf)[8], f32x16 (&O)[4], float w0, float w1, int lane) {
    const int q = lane & 31, hh = lane >> 5;
#pragma unroll
    for (int kb = 0; kb < 2; ++kb) {
        float p[16];
        { const f32x16 S0 = qk_tile<4>(kt, Qf, kb, 0, q, hh);
#pragma unroll
          for (int i = 0; i < 16; ++i) p[i] = __builtin_amdgcn_exp2f(S0[i]) * w0; }
        { const f32x16 S1 = qk_tile<4>(kt, Qf, kb, 4, q, hh);
#pragma unroll
          for (int i = 0; i < 16; ++i) p[i] -= __builtin_amdgcn_exp2f(S1[i]) * w1; }
        pv_tile(vt, p, O, kb, q, hh);
    }
}

template <int MODE>
DI void attn_phase(const Ctx& F, const Params& P) {
    constexpr bool DIFF = (MODE >= 2);
    constexpr bool NA = (MODE == 1);
    LAS unsigned char* lds = F.lds;
    LAS float* rpbl = (LAS float*)(lds + AT_RPB);
    LAS float* kgl = (LAS float*)(lds + AT_RPB + 2048);
    if (!DIFF) { __syncthreads(); if (F.tid < 128) kgl[F.tid] = P.in[I_NAKG][F.tid]; __syncthreads(); }
    const bf16_t* PA = (const bf16_t*)(P.ws + WS_RA);
    bf16_t* MIX = (bf16_t*)(P.ws + WS_HM);
    const bf16_t* VTp = (const bf16_t*)(P.ws + WS_VT); const bf16_t* VTs = (const bf16_t*)(P.ws + WS_VT + VT_S);
    const int q = F.lane & 31, hh = F.lane >> 5;
    const float c1 = (DIFF ? 0.125f : 0.08838834764831845f) * LOG2E;
    float lam = 0.f;
    if (DIFF) {
        const float a = wave_sum(P.in[I_LQ1][F.lane] * P.in[I_LK1][F.lane]), b = wave_sum(P.in[I_LQ2][F.lane] * P.in[I_LK2][F.lane]);
        lam = __expf(a) - __expf(b) + 0.35550906759096924f;
    }
    const int nunits = (MODE == 0 || MODE == 2) ? 256 : 1024;
    for (int u0 = F.bid; u0 < nunits; u0 += F.G) {
        int u = u0;
        if ((MODE == 1 || MODE == 3) && F.G == 256) { const int i = u0 >> 8, x = F.bid & 7, y = F.bid >> 3; u = ((2 * i + (y >> 4)) * 8 + x) * 16 + (y & 15); }
        int b, h, tok0, r = 0, rlo = 0; TileMap M;
        const bf16_t* qptr;
        if (MODE == 0) { b = u >> 3; h = u & 7; tok0 = b * 256 + F.wave * 32;
            qptr = PA + (size_t)(tok0 + q) * 2048 + h * 128;
            M.latK = PA + (size_t)(b * 256) * 2048 + 1024 + h * 128; M.latKld = 2048; M.latV = VTp + (size_t)(b * 8 + h) * 128 * 256; M.latVld = 256; M.nlat = 4; M.ctxK = nullptr; M.ctxV = nullptr; M.ntiles = 4; }
        else if (MODE == 1) { b = u >> 7; h = (u >> 4) & 7; const int rg = u & 15; r = 4 * rg + (F.wave >> 1);
            rlo = min(max(4 * rg - 4, 0), 56); const int rhi = min(max(4 * rg + 3 - 4, 0), 56) + 8;
            tok0 = TP + b * 4096 + r * 64 + (F.wave & 1) * 32;
            qptr = PA + (size_t)(tok0 + q) * 2048 + h * 128;
            M.latK = PA + (size_t)(TP + b * 4096 + rlo * 64) * 2048 + 1024 + h * 128; M.latKld = 2048; M.latV = VTs + (size_t)(b * 8 + h) * 128 * 4096 + rlo * 64; M.latVld = 4096; M.nlat = rhi - rlo;
            M.ctxK = (const bf16_t*)(P.ws + WS_CNK) + (size_t)b * 256 * 1024 + h * 128; M.ctxV = (const bf16_t*)(P.ws + WS_CNVT) + (size_t)(b * 8 + h) * 128 * 256; M.ntiles = M.nlat + 4;
            if (F.tid < 465) rpbl[F.tid] = P.in[I_RPB][h * 465 + F.tid] * LOG2E; }
        else if (MODE == 2) { b = u >> 3; h = u & 7; tok0 = b * 256 + F.wave * 32;
            qptr = PA + (size_t)(tok0 + q) * 4096 + 1024 + h * 128;
            M.latK = PA + (size_t)(b * 256) * 4096 + 2048 + h * 128; M.latKld = 4096; M.latV = VTp + (size_t)(b * 8 + h) * 128 * 256; M.latVld = 256; M.nlat = 4; M.ctxK = nullptr; M.ctxV = nullptr; M.ntiles = 4; }
        else { b = u >> 7; h = (u >> 4) & 7; const int qb = u & 15; tok0 = TP + b * 4096 + qb * 256 + F.wave * 32;
            qptr = PA + (size_t)(tok0 + q) * 4096 + 1024 + h * 128;
            M.latK = PA + (size_t)(TP + b * 4096) * 4096 + 2048 + h * 128; M.latKld = 4096; M.latV = VTs + (size_t)(b * 8 + h) * 128 * 4096; M.latVld = 4096; M.nlat = 64;
            M.ctxK = (const bf16_t*)(P.ws + WS_CDK) + (size_t)b * 256 * 1024 + h * 128; M.ctxV = (const bf16_t*)(P.ws + WS_CDVT) + (size_t)(b * 8 + h) * 128 * 256; M.ntiles = 68; }
        bf16x8 Qf[8];
        if constexpr (!DIFF) {
            u32x4 w[8]; float ss = 0.f;
#pragma unroll
            for (int ks = 0; ks < 8; ++ks) { w[ks] = *(const u32x4*)(qptr + ks * 16 + hh * 8);
                ss += bflo(w[ks].x) * bflo(w[ks].x) + bfhi(w[ks].x) * bfhi(w[ks].x) + bflo(w[ks].y) * bflo(w[ks].y) + bfhi(w[ks].y) * bfhi(w[ks].y)
                    + bflo(w[ks].z) * bflo(w[ks].z) + bfhi(w[ks].z) * bfhi(w[ks].z) + bflo(w[ks].w) * bflo(w[ks].w) + bfhi(w[ks].w) * bfhi(w[ks].w); }
            ss += __shfl_xor(ss, 32);
            const float qs = rsqrtf(ss * (1.f / 128.f) + NORM_EPS) * c1;
            const float* qg = P.in[I_NAQG];
#pragma unroll
            for (int ks = 0; ks < 8; ++ks) { const f32x4 g0 = *(const f32x4*)(qg + ks * 16 + hh * 8), g1 = *(const f32x4*)(qg + ks * 16 + hh * 8 + 4);
                const u32x4 ws = (u32x4){pk2(bflo(w[ks].x) * qs * g0.x, bfhi(w[ks].x) * qs * g0.y), pk2(bflo(w[ks].y) * qs * g0.z, bfhi(w[ks].y) * qs * g0.w),
                                         pk2(bflo(w[ks].z) * qs * g1.x, bfhi(w[ks].z) * qs * g1.y), pk2(bflo(w[ks].w) * qs * g1.z, bfhi(w[ks].w) * qs * g1.w)};
                Qf[ks] = __builtin_bit_cast(bf16x8, ws); }
        } else {
#pragma unroll
        for (int ks = 0; ks < 8; ++ks) { const u32x4 w = *(const u32x4*)(qptr + ks * 16 + hh * 8);
            const u32x4 ws = (u32x4){pk2(bflo(w.x) * c1, bfhi(w.x) * c1), pk2(bflo(w.y) * c1, bfhi(w.y) * c1), pk2(bflo(w.z) * c1, bfhi(w.z) * c1), pk2(bflo(w.w) * c1, bfhi(w.w) * c1)};
            Qf[ks] = __builtin_bit_cast(bf16x8, ws); }
        }
        f32x16 O[4]; float ls[2] = {0.f, 0.f}; float w0 = 0.f, w1 = 0.f;
#pragma unroll
        for (int db = 0; db < 4; ++db)
#pragma unroll
            for (int i = 0; i < 16; ++i) O[db][i] = 0.f;
        const int cq = (F.wave & 1) * 32 + q, cs = min(max(cq - 8, 0), 48);
        const int r0w = min(max(r - 4, 0), 56);
        const int nt = M.ntiles;
        TileRegs R;
        { const bf16_t* kp; const bf16_t* vp; int kld, vld; tile_src(M, 0, kp, kld, vp, vld); tile_load(F, R, kp, kld, vp, vld); }
        if constexpr (!DIFF) tile_norm_k(F, R, kgl, (MODE == 0) ? P.out + O_NAK + (size_t)(b * 256) * 1024 + h * 128 : nullptr, 1024);
        tile_store(F, R, lds + AT_K0, lds + AT_V0);
        __syncthreads();
        if constexpr (DIFF) {
#pragma unroll 1
            for (int j = 0; j < nt; ++j) {
                const int cur = j & 1, jn = (j + 1 < nt) ? j + 1 : 0;
                const bool wv = (j + 1 == nt);
                { const bf16_t* kp; const bf16_t* vp; int kld, vld; tile_src(M, jn, kp, kld, vp, vld); tile_load(F, R, kp, kld, vp, vld, wv); }
                diff_pass1(lds + AT_K0 + cur * AT_KTB, Qf, ls, F.lane);
                tile_store(F, R, lds + AT_K0 + (cur ^ 1) * AT_KTB, lds + AT_V0 + (cur ^ 1) * AT_VTB, wv);
                __syncthreads();
            }
            { const float l0 = ls[0] + __shfl_xor(ls[0], 32), l1 = ls[1] + __shfl_xor(ls[1], 32); w0 = 1.f / l0; w1 = lam / l1; }
#pragma unroll 1
            for (int j = 0; j < nt; ++j) {
                const int cur = (nt + j) & 1;
                if (j + 1 < nt) { const bf16_t* kp; const bf16_t* vp; int kld, vld; tile_src(M, j + 1, kp, kld, vp, vld); tile_load(F, R, kp, kld, vp, vld); }
                diff_pass2(lds + AT_K0 + cur * AT_KTB, lds + AT_V0 + cur * AT_VTB, Qf, O, w0, w1, F.lane);
                if (j + 1 < nt) tile_store(F, R, lds + AT_K0 + (cur ^ 1) * AT_KTB, lds + AT_V0 + (cur ^ 1) * AT_VTB);
                __syncthreads();
            }
        } else {
#pragma unroll 1
            for (int j = 0; j < nt; ++j) {
                const int cur = j & 1;
                if (j + 1 < nt) { const bf16_t* kp; const bf16_t* vp; int kld, vld; tile_src(M, j + 1, kp, kld, vp, vld); tile_load(F, R, kp, kld, vp, vld); }
                LAS const unsigned char* kt = lds + AT_K0 + cur * AT_KTB; LAS const unsigned char* vt = lds + AT_V0 + cur * AT_VTB;
                if constexpr (NA) {
                    if (j < M.nlat) { const int kr = rlo + j;
                        if (kr >= r0w && kr < r0w + 8) attn_compute1<true>(kt, vt, Qf, O, ls[0], F.lane, rpbl + (kr - r + 7) * 31 + (4 * hh - cq + 15), 4 * hh - cs); }
                    else attn_compute1<false>(kt, vt, Qf, O, ls[0], F.lane, rpbl, 0);
                } else attn_compute1<false>(kt, vt, Qf, O, ls[0], F.lane, rpbl, 0);
                if (j + 1 < nt) {
                    if (j + 1 < M.nlat) tile_norm_k(F, R, kgl, (MODE == 0) ? P.out + O_NAK + (size_t)(b * 256 + (j + 1) * 64) * 1024 + h * 128 : nullptr, 1024);
                    tile_store(F, R, lds + AT_K0 + (cur ^ 1) * AT_KTB, lds + AT_V0 + (cur ^ 1) * AT_VTB); }
                __syncthreads();
            }
        }
        if constexpr (!DIFF) {
            const float inv = 1.f / (ls[0] + __shfl_xor(ls[0], 32));
            bf16_t* op = MIX + (size_t)(tok0 + q) * DM + h * 128 + 4 * hh;
#pragma unroll
            for (int db = 0; db < 4; ++db)
#pragma unroll
                for (int g = 0; g < 4; ++g) { u32x2 w; w.x = pk2(O[db][4 * g] * inv, O[db][4 * g + 1] * inv); w.y = pk2(O[db][4 * g + 2] * inv, O[db][4 * g + 3] * inv);
                    *(u32x2*)(op + db * 32 + 8 * g) = w; }
        } else {
            float ss = 0.f;
#pragma unroll
            for (int db = 0; db < 4; ++db)
#pragma unroll
                for (int i = 0; i < 16; ++i) ss += O[db][i] * O[db][i];
            ss += __shfl_xor(ss, 32);
            const float sc = rsqrtf(ss * (1.f / 128.f) + NORM_EPS) * (1.f - 0.35550906759096924f);
            const float* sg = P.in[I_SUBG];
            bf16_t* op = MIX + (size_t)(tok0 + q) * DM + 1024 + h * 128 + 4 * hh;
#pragma unroll
            for (int db = 0; db < 4; ++db)
#pragma unroll
                for (int g = 0; g < 4; ++g) { const f32x4 g4 = *(const f32x4*)(sg + db * 32 + 8 * g + 4 * hh);
                    u32x2 w; w.x = pk2(O[db][4 * g] * sc * g4.x, O[db][4 * g + 1] * sc * g4.y); w.y = pk2(O[db][4 * g + 2] * sc * g4.z, O[db][4 * g + 3] * sc * g4.w);
                    *(u32x2*)(op + db * 32 + 8 * g) = w; }
        }
    }
}

DI float diff_lambda(const Ctx& F, const Params& P) {
    const float la = wave_sum(P.in[I_LQ1][F.lane] * P.in[I_LK1][F.lane]), lb = wave_sum(P.in[I_LQ2][F.lane] * P.in[I_LK2][F.lane]);
    return __expf(la) - __expf(lb) + 0.35550906759096924f;
}
template <bool SAMPLE>
DI void attn_diff_phase(const Ctx& F, const Params& P, const float lam) {
    LAS unsigned char* lds = F.lds;
    const bf16_t* PA = (const bf16_t*)(P.ws + WS_RA);
    bf16_t* MIX = (bf16_t*)(P.ws + WS_HM);
    const bf16_t* VTp = (const bf16_t*)(P.ws + WS_VT); const bf16_t* VTs = (const bf16_t*)(P.ws + WS_VT + VT_S);
    const int q = F.lane & 31, hh = F.lane >> 5, mp = F.wave >> 2, qg = F.wave & 3;
    const float c1 = 0.125f * LOG2E;
    const int nunits = SAMPLE ? 1024 : 256;
    for (int u0 = F.bid; u0 < nunits; u0 += F.G) {
        int u = u0;
        if (SAMPLE && F.G == 256) { const int i = u0 >> 8, x = F.bid & 7, y = F.bid >> 3; u = ((2 * i + (y >> 4)) * 8 + x) * 16 + (y & 15); }
        int b, h, tok0; TileMap M;
        if (!SAMPLE) { b = u >> 3; h = u & 7; tok0 = b * 256 + qg * 64;
            M.latK = PA + (size_t)(b * 256) * 4096 + 2048 + h * 128; M.latKld = 4096; M.latV = VTp + (size_t)(b * 8 + h) * 128 * 256; M.latVld = 256; M.nlat = 4; M.ctxK = nullptr; M.ctxV = nullptr; M.ntiles = 4; }
        else { b = u >> 7; h = (u >> 4) & 7; tok0 = TP + b * 4096 + (u & 15) * 256 + qg * 64;
            M.latK = PA + (size_t)(TP + b * 4096) * 4096 + 2048 + h * 128; M.latKld = 4096; M.latV = VTs + (size_t)(b * 8 + h) * 128 * 4096; M.latVld = 4096; M.nlat = 64;
            M.ctxK = (const bf16_t*)(P.ws + WS_CDK) + (size_t)b * 256 * 1024 + h * 128; M.ctxV = (const bf16_t*)(P.ws + WS_CDVT) + (size_t)(b * 8 + h) * 128 * 256; M.ntiles = 68; }
        LAS unsigned char* qst = lds + 73728 + F.wave * 8192 + F.lane * 16;
#pragma unroll
        for (int sb = 0; sb < 2; ++sb) { const bf16_t* qptr = PA + (size_t)(tok0 + sb * 32 + q) * 4096 + 1024 + h * 128 + mp * 64;
#pragma unroll
            for (int ks = 0; ks < 4; ++ks) { const u32x4 w = *(const u32x4*)(qptr + ks * 16 + hh * 8);
                const u32x4 ws = (u32x4){pk2(bflo(w.x) * c1, bfhi(w.x) * c1), pk2(bflo(w.y) * c1, bfhi(w.y) * c1), pk2(bflo(w.z) * c1, bfhi(w.z) * c1), pk2(bflo(w.w) * c1, bfhi(w.w) * c1)};
                *(LAS u32x4*)(qst + (sb * 4 + ks) * 1024) = ws; } }
        f32x16 O[2][4]; float ls[2] = {0.f, 0.f};
#pragma unroll
        for (int sb = 0; sb < 2; ++sb)
#pragma unroll
            for (int db = 0; db < 4; ++db)
#pragma unroll
                for (int i = 0; i < 16; ++i) O[sb][db][i] = 0.f;
        const int nt = M.ntiles;
        TileRegs R;
        { const bf16_t* kp; const bf16_t* vp; int kld, vld; tile_src(M, 0, kp, kld, vp, vld); tile_load(F, R, kp, kld, vp, vld); }
        tile_store(F, R, lds + AT_K0, lds + AT_V0);
        __syncthreads();
#pragma unroll 1
        for (int j = 0; j < nt; ++j) {
            const int cur = j & 1;
            if (j + 1 < nt) { const bf16_t* kp; const bf16_t* vp; int kld, vld; tile_src(M, j + 1, kp, kld, vp, vld); tile_load(F, R, kp, kld, vp, vld); }
            LAS const unsigned char* kt = lds + AT_K0 + cur * AT_KTB; LAS const unsigned char* vt = lds + AT_V0 + cur * AT_VTB;
#pragma unroll 1
            for (int kb = 0; kb < 2; ++kb) {
                f32x16 S0, S1;
#pragma unroll
                for (int i = 0; i < 16; ++i) { S0[i] = 0.f; S1[i] = 0.f; }
#pragma unroll
                for (int ks = 0; ks < 4; ++ks) { const bf16x8 A = *(const LAS bf16x8*)(kt + (kb * 32 + q) * AT_KROW + ((mp * 4 + ks) * 16 + hh * 8) * 2);
                    S0 = __builtin_amdgcn_mfma_f32_32x32x16_bf16(A, *(const LAS bf16x8*)(qst + ks * 1024), S0, 0, 0, 0);
                    S1 = __builtin_amdgcn_mfma_f32_32x32x16_bf16(A, *(const LAS bf16x8*)(qst + (4 + ks) * 1024), S1, 0, 0, 0); }
                u32x4 pa[2], pb[2];
                { float l0 = 0.f, l1 = 0.f;
#pragma unroll
                for (int sp = 0; sp < 2; ++sp) { float e0[8], e1[8];
#pragma unroll
                    for (int i = 0; i < 8; ++i) { e0[i] = __builtin_amdgcn_exp2f(S0[8 * sp + i]); e1[i] = __builtin_amdgcn_exp2f(S1[8 * sp + i]); l0 += e0[i]; l1 += e1[i]; }
                    pa[sp] = (u32x4){pk2(e0[0], e0[1]), pk2(e0[2], e0[3]), pk2(e0[4], e0[5]), pk2(e0[6], e0[7])};
                    pb[sp] = (u32x4){pk2(e1[0], e1[1]), pk2(e1[2], e1[3]), pk2(e1[4], e1[5]), pk2(e1[6], e1[7])}; }
                ls[0] += l0; ls[1] += l1; }
#pragma unroll
                for (int sp = 0; sp < 2; ++sp) {
                    const bf16x8 Pa = __builtin_bit_cast(bf16x8, pa[sp]), Pb = __builtin_bit_cast(bf16x8, pb[sp]);
#pragma unroll
                    for (int db = 0; db < 4; ++db) {
                        LAS const unsigned char* ap = vt + (db * 32 + q) * AT_VROW + (kb * 32 + 16 * sp + 4 * hh) * 2;
                        const u32x2 lo = *(const LAS u32x2*)(ap), hi = *(const LAS u32x2*)(ap + 16);
                        const bf16x8 A2 = __builtin_bit_cast(bf16x8, (u32x4){lo.x, lo.y, hi.x, hi.y});
                        O[0][db] = __builtin_amdgcn_mfma_f32_32x32x16_bf16(A2, Pa, O[0][db], 0, 0, 0);
                        O[1][db] = __builtin_amdgcn_mfma_f32_32x32x16_bf16(A2, Pb, O[1][db], 0, 0, 0);
                    }
                    asm volatile("" ::: "memory");
                }
            }
            if (j + 1 < nt) tile_store(F, R, lds + AT_K0 + (cur ^ 1) * AT_KTB, lds + AT_V0 + (cur ^ 1) * AT_VTB);
            __syncthreads();
        }
        LAS float* xch = (LAS float*)lds + qg * 8192 + F.lane;
        float lt[2];
#pragma unroll
        for (int sb = 0; sb < 2; ++sb) lt[sb] = ls[sb] + __shfl_xor(ls[sb], 32);
        if (mp == 1) {
#pragma unroll
            for (int sb = 0; sb < 2; ++sb) { const float w1 = lam / lt[sb];
#pragma unroll
                for (int db = 0; db < 4; ++db)
#pragma unroll
                    for (int i = 0; i < 16; ++i) xch[((sb * 4 + db) * 16 + i) * 64] = O[sb][db][i] * w1; } }
        __syncthreads();
        if (mp == 0) {
            const float* sg = P.in[I_SUBG];
#pragma unroll
            for (int sb = 0; sb < 2; ++sb) { const float w0 = 1.f / lt[sb]; float ss = 0.f;
#pragma unroll
                for (int db = 0; db < 4; ++db)
#pragma unroll
                    for (int i = 0; i < 16; ++i) { const float o = O[sb][db][i] * w0 - xch[((sb * 4 + db) * 16 + i) * 64]; O[sb][db][i] = o; ss += o * o; }
                ss += __shfl_xor(ss, 32);
                const float sc = rsqrtf(ss * (1.f / 128.f) + NORM_EPS) * (1.f - 0.35550906759096924f);
                bf16_t* op = MIX + (size_t)(tok0 + sb * 32 + q) * DM + 1024 + h * 128 + 4 * hh;
#pragma unroll
                for (int db = 0; db < 4; ++db)
#pragma unroll
                    for (int g = 0; g < 4; ++g) { const f32x4 g4 = *(const f32x4*)(sg + db * 32 + 8 * g + 4 * hh);
                        u32x2 w; w.x = pk2(O[sb][db][4 * g] * sc * g4.x, O[sb][db][4 * g + 1] * sc * g4.y); w.y = pk2(O[sb][db][4 * g + 2] * sc * g4.z, O[sb][db][4 * g + 3] * sc * g4.w);
                        *(u32x2*)(op + db * 32 + 8 * g) = w; } } }
        __syncthreads();
    }
}
template <int L, int BATCH> struct HyCfg {
    static constexpr int NB = L / 64, TPT = 32 / BATCH, NTILES = NB / TPT, LOGB = (BATCH == 8) ? 3 : 5;
    static constexpr int ZROWB = (L + 384) * 2 + 16, ZBYTES = BATCH * ZROWB, RL = 2 * L + 16;
    static constexpr int TPW = (NTILES + 7) / 8;
};
constexpr int HY_KR_OFF = 71808;

template <int L, int BATCH>
DI void hyena_part(const Ctx& F, const Params& P, int c, int tokbase  , const bf16_t* KRG  ) {
    typedef HyCfg<L, BATCH> C;
    LAS unsigned char* lds = F.lds;
    bf16_t* CM = (bf16_t*)(P.ws + WS_RB);
    const float* hbias = P.in[I_HYBIAS];
    const int q = F.lane & 31, hh = F.lane >> 5;
    __syncthreads();
    for (int id = F.tid; id < BATCH * (L / 8); id += NTHR) { const int b = id / (L / 8), s8 = (id % (L / 8)) * 8;
        *(LAS u32x4*)(lds + b * C::ZROWB + (192 + s8) * 2) = *(const u32x4*)(CM + (size_t)c * TOK + tokbase + b * L + s8); }
    for (int id = F.tid; id < BATCH * 48; id += NTHR) { const int b = id / 48, k = id % 48, e = (k < 24) ? k * 8 : (192 + L + (k - 24) * 8);
        *(LAS u32x4*)(lds + b * C::ZROWB + e * 2) = (u32x4){0u, 0u, 0u, 0u}; }
#pragma unroll 1
    for (int o = 0; o < 2; ++o) {
        { const bf16_t* src = KRG + (size_t)(o * 1024 + c) * C::RL;
          for (int id = F.tid; id < C::RL / 8; id += NTHR) { const u32x4 v = *(const u32x4*)(src + id * 8);
              *(LAS u32x4*)(lds + HY_KR_OFF + id * 16) = v;
              LAS bf16_t* c1 = (LAS bf16_t*)(lds + HY_KR_OFF + C::RL * 2) + id * 8 - 1;
              if (id > 0) c1[0] = (bf16_t)(v.x & 0xffff);
              c1[1] = (bf16_t)(v.x >> 16); c1[2] = (bf16_t)(v.y & 0xffff); c1[3] = (bf16_t)(v.y >> 16); c1[4] = (bf16_t)(v.z & 0xffff); c1[5] = (bf16_t)(v.z >> 16);
              c1[6] = (bf16_t)(v.w & 0xffff); c1[7] = (bf16_t)(v.w >> 16); } }
        __syncthreads();
        f32x16 acc[C::TPW][2];
#pragma unroll
        for (int t = 0; t < C::TPW; ++t)
#pragma unroll
            for (int mt = 0; mt < 2; ++mt)
#pragma unroll
                for (int i = 0; i < 16; ++i) acc[t][mt][i] = 0.f;
        const int tq0 = F.wave * C::TPW;
        if (tq0 < C::NTILES) {
            const int d1lo = C::TPT * tq0 - (C::NB - 1), d1hi = C::TPT * (tq0 + C::TPW - 1) + C::TPT - 1;
            const int abase = HY_KR_OFF + (F.lane & 1) * (C::RL * 2) + (L - (F.lane & 31) + 8 * hh - (F.lane & 1)) * 2;
            bf16x8 W0[6], W1[6], B0[C::TPW][4];
#define HY_LDW(Wv, d1v, i) do { LAS const unsigned* ap_ = (LAS const unsigned*)(lds + abase + (-4 * (d1v) - 2 + (i)) * 32); Wv[i] = __builtin_bit_cast(bf16x8, (u32x4){ap_[0], ap_[1], ap_[2], ap_[3]}); } while (0)
#define HY_LDB(Bv, d1v) do { _Pragma("unroll") for (int t_ = 0; t_ < C::TPW; ++t_) { const int tq_ = tq0 + t_; \
            const int t1_ = C::TPT * tq_ + (q >> C::LOGB), b_ = q & (BATCH - 1); int s1_ = t1_ - (d1v); s1_ = min(max(s1_, -3), C::NB + 2); \
            LAS const unsigned char* bp_ = lds + b_ * C::ZROWB + (192 + 64 * s1_ + 8 * hh) * 2; \
            _Pragma("unroll") for (int ks_ = 0; ks_ < 4; ++ks_) Bv[t_][ks_] = *(const LAS bf16x8*)(bp_ + ks_ * 32); } } while (0)
#define HY_MM(Wv, Bv, d1v) do { _Pragma("unroll") for (int t_ = 0; t_ < C::TPW; ++t_) { const int tq_ = tq0 + t_; \
            if ((d1v) >= C::TPT * tq_ - (C::NB - 1) && (d1v) <= C::TPT * tq_ + C::TPT - 1) { \
                _Pragma("unroll") for (int ks_ = 0; ks_ < 4; ++ks_) _Pragma("unroll") for (int mt_ = 0; mt_ < 2; ++mt_) \
                    acc[t_][mt_] = __builtin_amdgcn_mfma_f32_32x32x16_bf16(Wv[ks_ - 2 * mt_ + 2], Bv[t_][ks_], acc[t_][mt_], 0, 0, 0); } } } while (0)
#pragma unroll
            for (int i = 0; i < 6; ++i) HY_LDW(W0, d1lo, i);
            int d1 = d1lo;
#pragma unroll 1
            for (; d1 + 1 <= d1hi; d1 += 2) {
                HY_LDB(B0, d1);
#pragma unroll
                for (int i = 0; i < 4; ++i) HY_LDW(W1, d1 + 1, i);
                W1[4] = W0[0]; W1[5] = W0[1];
                HY_MM(W0, B0, d1);
                HY_LDB(B0, d1 + 1);
                if (d1 + 2 <= d1hi) {
#pragma unroll
                    for (int i = 0; i < 4; ++i) HY_LDW(W0, d1 + 2, i);
                    W0[4] = W1[0]; W0[5] = W1[1];
                }
                HY_MM(W1, B0, d1 + 1);
            }
            if (d1 <= d1hi) { HY_LDB(B0, d1); HY_MM(W0, B0, d1); }
#undef HY_LDW
#undef HY_LDB
#undef HY_MM
        }
        __syncthreads();
        if (tq0 < C::NTILES) {
            const float bo = hbias[o * 1024 + c];
            const bf16_t* gate = CM + (size_t)((1 + o) * 1024 + c) * TOK + tokbase;
            bf16_t* zout = (bf16_t*)(P.ws + WS_RA + RA_ZC) + (size_t)c * TOK + tokbase;
#pragma unroll
            for (int t = 0; t < C::TPW; ++t) { const int tq = tq0 + t, t1 = C::TPT * tq + (q >> C::LOGB), b = q & (BATCH - 1);
#pragma unroll
                for (int mt = 0; mt < 2; ++mt)
#pragma unroll
                    for (int g = 0; g < 4; ++g) { const int s = 64 * t1 + 32 * mt + 8 * g + 4 * hh;
                        LAS u32x2* zp = (LAS u32x2*)(lds + b * C::ZROWB + (192 + s) * 2);
                        const u32x2 zv = *zp, gv = *(const u32x2*)(gate + (size_t)b * L + s);
                        const float r0 = bflo(gv.x) * (acc[t][mt][4 * g] + bflo(zv.x) * bo), r1 = bfhi(gv.x) * (acc[t][mt][4 * g + 1] + bfhi(zv.x) * bo);
                        const float r2 = bflo(gv.y) * (acc[t][mt][4 * g + 2] + bflo(zv.y) * bo), r3 = bfhi(gv.y) * (acc[t][mt][4 * g + 3] + bfhi(zv.y) * bo);
                        const u32x2 w = (u32x2){pk2(r0, r1), pk2(r2, r3)};
                        if (o == 0) *zp = w; else *(u32x2*)(zout + (size_t)b * L + s) = w; } }
        }
        __syncthreads();
    }
}

DI void hyena_phase(const Ctx& F, const Params& P) {
    for (int c = F.bid; c < 1024; c += F.G) {
        hyena_part<LS, 8>(F, P, c, TP, (const bf16_t*)(P.ws + WS_KRS));
        hyena_part<LP, 32>(F, P, c, 0, (const bf16_t*)(P.ws + WS_KRP));
    }
}

DI void hyena_post(const Ctx& F, const Params& P) {
    const bf16_t* CM = (const bf16_t*)(P.ws + WS_RA + RA_ZC); bf16_t* MIX = (bf16_t*)(P.ws + WS_HM);
    struct PostMap { const bf16_t* CM; bf16_t* MIX;
        DI TrJob operator()(int t) const { const int cg = t & 15, tg = t >> 4;
            return TrJob{CM + (size_t)(cg * 64) * TOK + tg * 64, (size_t)TOK, MIX + (size_t)(tg * 64) * DM + 1024 + cg * 64, (size_t)DM}; } };
    tr_pipeline_bf16(F, 16 * 640, PostMap{CM, MIX}, (LAS bf16_t*)F.lds);
}
constexpr int PC_ROPE = 118784;
DI void prep_c(const Ctx& F, const Params& P) {
    bf16_t* PA = (bf16_t*)(P.ws + WS_RA);
    LAS float* rope = (LAS float*)(F.lds + PC_ROPE);
    __syncthreads();
    for (int e = F.tid; e < 1024; e += NTHR) { const int pos = e >> 4, f = e & 15; const float inv = exp2f(-(float)f * (13.287712379549449f / 16.f)); const float a = (float)pos * inv;
        rope[e * 2] = cosf(a); rope[e * 2 + 1] = sinf(a); }
    __syncthreads();
    bf16_t* VTp = (bf16_t*)(P.ws + WS_VT); bf16_t* VTs = (bf16_t*)(P.ws + WS_VT + VT_S);
    { struct VtMap { const bf16_t* PA; bf16_t* VTp; bf16_t* VTs;
          DI TrJob operator()(int t) const {
              if (t < 2048) { const int bh = t >> 3, sub = t & 7, tk = sub >> 1, dd = sub & 1, b = bh >> 3, h = bh & 7;
                  return TrJob{PA + ((size_t)(b * 256 + tk * 64)) * 4096 + 3072 + h * 128 + dd * 64, 4096, VTp + ((size_t)bh * 128 + dd * 64) * 256 + tk * 64, 256}; }
              const int u = t - 2048, bh = u >> 7, sub = u & 127, tk = sub >> 1, dd = sub & 1, b = bh >> 3, h = bh & 7;
              return TrJob{PA + ((size_t)(TP + b * 4096 + tk * 64)) * 4096 + 3072 + h * 128 + dd * 64, 4096, VTs + ((size_t)bh * 128 + dd * 64) * 4096 + tk * 64, 4096}; } };
      tr_pipeline_bf16(F, 2048 + 8192, VtMap{PA, VTp, VTs}, (LAS bf16_t*)F.lds); }
    { float* o = P.out + O_DV;
      for (int e = F.bid * NTHR + F.tid; e < TP * 128; e += F.G * NTHR) { const int T = e >> 7, c8 = (e & 127) * 8;
          const u32x4 v = *(const u32x4*)(PA + (size_t)T * 4096 + 3072 + c8);
          *(f32x4*)(o + (size_t)T * 1024 + c8) = (f32x4){bflo(v.x), bfhi(v.x), bflo(v.y), bfhi(v.y)};
          *(f32x4*)(o + (size_t)T * 1024 + c8 + 4) = (f32x4){bflo(v.z), bfhi(v.z), bflo(v.w), bfhi(v.w)}; } }
}
DI void prep_c_tokens(const Ctx& F, const Params& P, int wv, int nw) {
    bf16_t* PA = (bf16_t*)(P.ws + WS_RA);
    const LAS float* rope = (const LAS float*)(F.lds + PC_ROPE);
    const float* gsrc = (F.lane < 32 ? P.in[I_DQG] : P.in[I_DKG]) + (F.lane & 1) * 32; float* ok = P.out + O_DK;
    float g[32];
#pragma unroll
    for (int i = 0; i < 32; ++i) g[i] = gsrc[i];
    for (int T = wv; T < TOK; T += nw) {
        bf16_t* rp = PA + (size_t)T * 4096 + 1024 + F.lane * 32;
        u32x4 v[4]; float x[32]; float ss = 0.f;
#pragma unroll
        for (int j = 0; j < 4; ++j) { v[j] = *(const u32x4*)(rp + j * 8);
            x[j * 8 + 0] = bflo(v[j].x); x[j * 8 + 1] = bfhi(v[j].x); x[j * 8 + 2] = bflo(v[j].y); x[j * 8 + 3] = bfhi(v[j].y);
            x[j * 8 + 4] = bflo(v[j].z); x[j * 8 + 5] = bfhi(v[j].z); x[j * 8 + 6] = bflo(v[j].w); x[j * 8 + 7] = bfhi(v[j].w); }
#pragma unroll
        for (int i = 0; i < 32; ++i) ss += x[i] * x[i];
        ss += dpp_xor1(ss);
        const float rstd = rsqrtf(ss * (1.f / 64.f) + NORM_EPS);
#pragma unroll
        for (int i = 0; i < 32; ++i) x[i] = x[i] * rstd * g[i];
        if (T < TP) { if (F.lane >= 32) { float* o = ok + (size_t)T * 1024 + (F.lane - 32) * 32;
#pragma unroll
                for (int j = 0; j < 8; ++j) *(f32x4*)(o + j * 4) = (f32x4){x[j * 4], x[j * 4 + 1], x[j * 4 + 2], x[j * 4 + 3]}; } }
        else { const int t = (T - TP) & 4095, pos = (F.lane & 1) ? (t & 63) : (t >> 6);
            const LAS float* rt = rope + pos * 32;
#pragma unroll
            for (int f = 0; f < 16; ++f) { const float cs = rt[2 * f], sn = rt[2 * f + 1], a = x[f], b = x[16 + f]; x[f] = a * cs - b * sn; x[16 + f] = b * cs + a * sn; } }
#pragma unroll
        for (int j = 0; j < 4; ++j) { u32x4 w; w.x = pk2(x[j * 8 + 0], x[j * 8 + 1]); w.y = pk2(x[j * 8 + 2], x[j * 8 + 3]); w.z = pk2(x[j * 8 + 4], x[j * 8 + 5]); w.w = pk2(x[j * 8 + 6], x[j * 8 + 7]);
            *(u32x4*)(rp + j * 8) = w; }
    }
}

constexpr int S5_BROW = 80, S5_BUB = 128 * S5_BROW, S5_HROW = 272, S5_WLDS = S5_BUB + 16 * S5_HROW;
DI void s5_chain(const Ctx& F, const Params& P, int dg, int tok0, int L, const float* h0re, const float* h0im, float* fre, float* fim, bf16_t* Yout) {
    LAS unsigned char* wl = F.lds + F.wave * S5_WLDS; LAS unsigned char* hl = wl + S5_BUB;
    const int g = dg & 63, dir = dg >> 6, lane = F.lane, st = lane & 15, gq = lane >> 4;
    const float* S5A = (const float*)(P.ws + WS_S5A); const bf16_t* BB = (const bf16_t*)(P.ws + WS_S5BB); const bf16_t* CC = (const bf16_t*)(P.ws + WS_S5CC);
    const bf16_t* PA = (const bf16_t*)(P.ws + WS_RA);
    const float ar = S5A[(dg * 64 + lane) * 2], ai = S5A[(dg * 64 + lane) * 2 + 1];
    float hr = h0re ? h0re[lane] : 0.f, hi = h0im ? h0im[lane] : 0.f;
    const bf16x8 zero8 = (bf16x8){0, 0, 0, 0, 0, 0, 0, 0};
    bf16x8 BBf[8], CCf[4];
#pragma unroll
    for (int mt = 0; mt < 8; ++mt) BBf[mt] = (gq < 2) ? *(const bf16x8*)(BB + ((size_t)dg * 128 + mt * 16 + st) * 16 + gq * 8) : zero8;
#pragma unroll
    for (int kk = 0; kk < 4; ++kk) CCf[kk] = *(const bf16x8*)(CC + ((size_t)dg * 16 + st) * 128 + kk * 32 + gq * 8);
    const int nch = L / 16;
    const int sgn = dir ? -1 : 1, tstart = dir ? tok0 + L - 1 : tok0;
    const bf16_t* ubase = PA + (size_t)tstart * 4096 + g * 16 + gq * 8;
    const long ustep = (long)sgn * 4096;
#define S5_LDU(c_) (((c_) < nch && gq < 2) ? *(const bf16x8*)(ubase + ustep * ((c_) * 16 + st)) : zero8)
#define S5_BU(Uv) do { _Pragma("unroll") for (int mt = 0; mt < 8; ++mt) { f32x4 d_ = (f32x4){0.f, 0.f, 0.f, 0.f}; \
        d_ = __builtin_amdgcn_mfma_f32_16x16x32_bf16(Uv, BBf[mt], d_, 0, 0, 0); *(LAS f32x4*)(wl + (mt * 16 + st) * S5_BROW + gq * 16) = d_; } } while (0)
#define S5_Y(c_) do { f32x4 y_ = (f32x4){0.f, 0.f, 0.f, 0.f}; \
        _Pragma("unroll") for (int kk = 0; kk < 4; ++kk) y_ = __builtin_amdgcn_mfma_f32_16x16x32_bf16(CCf[kk], Bh[kk], y_, 0, 0, 0);        \
        *(u32x2*)(Yout + (size_t)(tstart + sgn * ((c_) * 16 + st)) * 1024 + g * 16 + gq * 4) = (u32x2){pk2(y_[0], y_[1]), pk2(y_[2], y_[3])}; } while (0)
#define S5_ITER(DOY) do { \
        f32x4 br_[4], bi_[4]; \
        _Pragma("unroll") for (int j = 0; j < 4; ++j) { br_[j] = *(const LAS f32x4*)(wl + lane * S5_BROW + j * 16); bi_[j] = *(const LAS f32x4*)(wl + (64 + lane) * S5_BROW + j * 16); } \
        bf16x8 Bh[4]; \
        if (DOY) { _Pragma("unroll") for (int kk = 0; kk < 4; ++kk) Bh[kk] = *(const LAS bf16x8*)(hl + st * S5_HROW + (kk * 32 + gq * 8) * 2); } \
        const bf16x8 Un_ = S5_LDU(ch + 4); \
        S5_BU(Ua); \
        _Pragma("unroll") for (int s = 0; s < 16; ++s) { const float bur = br_[s >> 2][s & 3], bui = bi_[s >> 2][s & 3]; \
            float t0_ = __builtin_fmaf(-ai, hi, bur), t1_ = __builtin_fmaf(ai, hr, bui); \
            asm volatile("" : "+v"(t0_), "+v"(t1_));                       \
            const float nr = __builtin_fmaf(ar, hr, t0_), ni = __builtin_fmaf(ar, hi, t1_); hr = nr; hi = ni; \
            asm volatile("" : "+v"(hr), "+v"(hi)); \
            const unsigned hw_ = pk2(hr, hi); \
            *(LAS bf16_t*)(hl + s * S5_HROW + lane * 2) = (bf16_t)(hw_ & 0xffffu); *(LAS bf16_t*)(hl + s * S5_HROW + (64 + lane) * 2) = (bf16_t)(hw_ >> 16); } \
        if (DOY) S5_Y(ch - 1); \
        Ua = Ub; Ub = Uc; Uc = Un_; } while (0)
    bf16x8 Ua = S5_LDU(0), Ub = S5_LDU(1), Uc = S5_LDU(2);
    S5_BU(Ua);
    Ua = Ub; Ub = Uc; Uc = S5_LDU(3);
    int ch = 0;
    S5_ITER(false);
#pragma unroll 1
    for (ch = 1; ch < nch; ++ch) S5_ITER(true);
    { bf16x8 Bh[4];
#pragma unroll
      for (int kk = 0; kk < 4; ++kk) Bh[kk] = *(const LAS bf16x8*)(hl + st * S5_HROW + (kk * 32 + gq * 8) * 2);
      S5_Y(nch - 1); }
#undef S5_LDU
#undef S5_BU
#undef S5_Y
#undef S5_ITER
    if (fre) { fre[lane] = hr; fim[lane] = hi; }
}

DI void s5_phase(const Ctx& F, const Params& P) {
    bf16_t* YF = (bf16_t*)(P.ws + WS_RB + RB_YF); bf16_t* YB = (bf16_t*)(P.ws + WS_RB + RB_YB);
    for (int cs = F.bid; cs < 256; cs += F.G) {
        if (F.wave < 4) { const int sc = cs * 4 + F.wave, dg = sc & 127, b = sc >> 7;
            s5_chain(F, P, dg, TP + b * 4096, LS, P.in[I_S5RE] + (size_t)sc * 64, P.in[I_S5IM] + (size_t)sc * 64, nullptr, nullptr, (dg >> 6) ? YB : YF); }
        else { for (int k = 0; k < 4; ++k) { const int pc = (cs * 4 + (F.wave - 4)) * 4 + k, dg = pc & 127, b = pc >> 7;
            s5_chain(F, P, dg, b * 256, LP, nullptr, nullptr, P.out + O_SR + (size_t)pc * 64, P.out + O_SI + (size_t)pc * 64, (dg >> 6) ? YB : YF); } }
    }
    if (F.wave >= 4) prep_c_tokens(F, P, F.bid * 4 + (F.wave - 4), F.G * 4);
}

DI void s5_combine(const Ctx& F, const Params& P) {
    const bf16_t* PA = (const bf16_t*)(P.ws + WS_RA); const bf16_t* YF = (const bf16_t*)(P.ws + WS_RB + RB_YF); const bf16_t* YB = (const bf16_t*)(P.ws + WS_RB + RB_YB);
    bf16_t* Y = (bf16_t*)(P.ws + WS_RB + RB_Y); const float* dsk = P.in[I_S5D];
    const size_t N = (size_t)TOK * 128, step = (size_t)F.G * NTHR;
    for (size_t e = (size_t)F.bid * NTHR + F.tid; e < N; e += 2 * step) {
        const size_t ee[2] = {e, (e + step < N) ? e + step : e};
        u32x4 uv[2], fv[2], bv[2];
#pragma unroll
        for (int r = 0; r < 2; ++r) { const size_t T = ee[r] >> 7; const int c8 = (int)(ee[r] & 127) * 8;
            uv[r] = *(const u32x4*)(PA + T * 4096 + c8); fv[r] = *(const u32x4*)(YF + T * 1024 + c8); bv[r] = *(const u32x4*)(YB + T * 1024 + c8); }
#pragma unroll
        for (int r = 0; r < 2; ++r) { const size_t T = ee[r] >> 7; const int c8 = (int)(ee[r] & 127) * 8;
            const f32x4 d0 = *(const f32x4*)(dsk + c8), d1 = *(const f32x4*)(dsk + c8 + 4);
            float o[8];
            o[0] = gelu_tanh(d0.x * bflo(uv[r].x) + bflo(fv[r].x) + bflo(bv[r].x)); o[1] = gelu_tanh(d0.y * bfhi(uv[r].x) + bfhi(fv[r].x) + bfhi(bv[r].x));
            o[2] = gelu_tanh(d0.z * bflo(uv[r].y) + bflo(fv[r].y) + bflo(bv[r].y)); o[3] = gelu_tanh(d0.w * bfhi(uv[r].y) + bfhi(fv[r].y) + bfhi(bv[r].y));
            o[4] = gelu_tanh(d1.x * bflo(uv[r].z) + bflo(fv[r].z) + bflo(bv[r].z)); o[5] = gelu_tanh(d1.y * bfhi(uv[r].z) + bfhi(fv[r].z) + bfhi(bv[r].z));
            o[6] = gelu_tanh(d1.z * bflo(uv[r].w) + bflo(fv[r].w) + bflo(bv[r].w)); o[7] = gelu_tanh(d1.w * bfhi(uv[r].w) + bfhi(fv[r].w) + bfhi(bv[r].w));
            u32x4 w; w.x = pk2(o[0], o[1]); w.y = pk2(o[2], o[3]); w.z = pk2(o[4], o[5]); w.w = pk2(o[6], o[7]);
            if (r == 0 || e + step < N) *(u32x4*)(Y + T * 1024 + c8) = w; }
    }
}
constexpr int PS_KROW = 272;
constexpr int PS_IDX_OFF = 2 * 128 * PS_KROW;
constexpr int PS_TAB_OFF = PS_IDX_OFF + 512 * 32;

DI void topk_insert(float (&a)[16], float x) {
#pragma unroll
    for (int j = 15; j >= 1; --j) a[j] = __builtin_amdgcn_fmed3f(a[j - 1], a[j], x);
    a[0] = fmaxf(a[0], x);
}

DI void peer_select(const Ctx& F, const Params& P, int layer) {
    LAS unsigned char* lds = F.lds;
    const bf16_t* Q = (const bf16_t*)(P.ws + WS_RA + RA_Q);
    int* SELI = (int*)(P.ws + WS_RA + RA_SELI); float* SELW = (float*)(P.ws + WS_RA + RA_SELW);
    const bf16_t* KEYS = (const bf16_t*)(P.ws + WS_PKEYS) + (size_t)layer * 8 * 2 * 128 * 128;
    const int q = F.lane & 31, hh = F.lane >> 5;
    LAS unsigned char* myidx = lds + PS_IDX_OFF + F.tid * 32;
    LAS unsigned char* tab = lds + PS_TAB_OFF;
    for (int wu = F.bid; wu < 256; wu += F.G) {
        const int h = wu & 7, chunk = wu >> 3;
        __syncthreads();
        for (int id = F.tid; id < 2 * 128 * 16; id += NTHR) { const int row = id >> 4, c16 = id & 15;
            *(LAS u32x4*)(lds + row * PS_KROW + c16 * 16) = *(const u32x4*)(KEYS + ((size_t)h * 256 + row) * 128 + c16 * 8); }
        if (F.tid < 16) { int cnt = 0;
            for (int a = 0; a < F.tid; ++a) cnt += 16 / (a + 1);
            for (int b = 0; b < 16 / (F.tid + 1); ++b) { tab[(cnt + b) * 2] = (unsigned char)F.tid; tab[(cnt + b) * 2 + 1] = (unsigned char)b; } }
        __syncthreads();
        for (int blk = F.wave; blk < 40; blk += 8) {
            const int T0 = chunk * 1280 + blk * 32;
            float lst[2][16];
#pragma unroll
            for (int side = 0; side < 2; ++side) {
                bf16x8 Qf[8];
                const bf16_t* qp = Q + (size_t)(T0 + q) * 2048 + h * 256 + side * 128 + hh * 8;
#pragma unroll
                for (int ks = 0; ks < 8; ++ks) Qf[ks] = *(const bf16x8*)(qp + ks * 16);
                float a[16];
#pragma unroll
                for (int j = 0; j < 16; ++j) a[j] = -3.0e38f;
#pragma unroll
                for (int nt = 0; nt < 4; ++nt) {
                    f32x16 S;
#pragma unroll
                    for (int i = 0; i < 16; ++i) S[i] = 0.f;
#pragma unroll
                    for (int ks = 0; ks < 8; ++ks) { const bf16x8 A = *(const LAS bf16x8*)(lds + (side * 128 + nt * 32 + q) * PS_KROW + (ks * 16 + hh * 8) * 2);
                        S = __builtin_amdgcn_mfma_f32_32x32x16_bf16(A, Qf[ks], S, 0, 0, 0); }
#pragma unroll
                    for (int i = 0; i < 16; ++i) { const int n = nt * 32 + (i & 3) + 8 * (i >> 2) + 4 * hh;
                        topk_insert(a, __uint_as_float((__float_as_uint(S[i]) & 0xffffff80u) | (unsigned)n)); }
                }
                float pb[16];
#pragma unroll
                for (int j = 0; j < 16; ++j) pb[j] = __shfl_xor(a[j], 32);
#pragma unroll
                for (int j = 0; j < 16; ++j) topk_insert(a, pb[j]);
#pragma unroll
                for (int j = 0; j < 16; ++j) { lst[side][j] = a[j]; myidx[side * 16 + j] = (unsigned char)(__float_as_uint(a[j]) & 0x7fu); }
            }
            float cb[16];
#pragma unroll
            for (int j = 0; j < 16; ++j) cb[j] = -3.0e38f;
            { int cid = 0;
#pragma unroll
              for (int a = 0; a < 16; ++a)
#pragma unroll
                  for (int b = 0; b < 16 / (a + 1); ++b) {
                      const float sa = __uint_as_float(__float_as_uint(lst[0][a]) & 0xffffff80u), sb = __uint_as_float(__float_as_uint(lst[1][b]) & 0xffffff80u);
                      topk_insert(cb, __uint_as_float((__float_as_uint(sa + sb) & 0xffffffc0u) | (unsigned)cid)); ++cid; } }
            const float mx = __uint_as_float(__float_as_uint(cb[0]) & 0xffffffc0u);
            float e[16], den = 0.f;
#pragma unroll
            for (int j = 0; j < 16; ++j) { e[j] = __expf(__uint_as_float(__float_as_uint(cb[j]) & 0xffffffc0u) - mx); den += e[j]; }
            const float rden = 1.f / den;
#pragma unroll
            for (int j = 0; j < 16; ++j) {
                if ((j >> 3) == hh) { const int cid = (int)(__float_as_uint(cb[j]) & 0x3fu);
                    const int a = tab[cid * 2], b = tab[cid * 2 + 1];
                    const int eidx = (int)myidx[a] * 128 + (int)myidx[16 + b];
                    SELI[(size_t)(T0 + q) * 128 + h * 16 + j] = eidx; SELW[(size_t)(T0 + q) * 128 + h * 16 + j] = e[j] * rden; }
            }
        }
    }
    __syncthreads();
}

DI u32x16 fp6_unpack_bf16(u32x4 a, u32x2 b) { const u32x6 pk = {a.x, a.y, a.z, a.w, b.x, b.y}; return __builtin_bit_cast(u32x16, __builtin_amdgcn_cvt_scalef32_pk32_bf16_fp6(pk, 1.0f)); }
DI f32x32 fp6_unpack(u32x4 a, u32x2 b) { const u32x6 pk = {a.x, a.y, a.z, a.w, b.x, b.y}; return __builtin_amdgcn_cvt_scalef32_pk32_f32_fp6(pk, 1.0f); }
constexpr int GN = 4, GNU = 8;
template <bool NEXTNORM>
DI void peer_gather(const Ctx& F, const Params& P, const float* modl, int layer, const float* ngain, const float* nmodl) {
    const bf16_t* H2 = (const bf16_t*)(P.ws + WS_HM);
    const unsigned char* TU = P.ws + WS_TBLU + (size_t)layer * 16384 * PT_ROWB; const unsigned char* TV = P.ws + WS_TBLV + (size_t)layer * 16384 * PT_ROWB;
    const float* SCU = (const float*)(P.ws + WS_SC) + layer * 16384; const float* SCV = (const float*)(P.ws + WS_SC) + (2 + layer) * 16384;
    const int* SELI = (const int*)(P.ws + WS_RA + RA_SELI); const float* SELW = (const float*)(P.ws + WS_RA + RA_SELW);
    float* X = P.out + O_Y;
    const int lane = lane_id();
    const int stride = F.G * 8;
    for (int T0 = F.bid * 8 + F.wave; T0 < TOK; T0 += 2 * stride) {
        const bool two = (T0 + stride < TOK);
        const int Tt[2] = {T0, two ? T0 + stride : T0};
        u32x4 xw[2][4]; int e0[2], e1[2]; float g0[2], g1[2], d0[2], d1[2];
#pragma unroll
        for (int t = 0; t < 2; ++t) {
#pragma unroll
            for (int q4 = 0; q4 < 4; ++q4) xw[t][q4] = *(const u32x4*)(H2 + (size_t)Tt[t] * DM + lane * 32 + q4 * 8);
            e0[t] = SELI[(size_t)Tt[t] * 128 + lane]; e1[t] = SELI[(size_t)Tt[t] * 128 + 64 + lane];
            g0[t] = SELW[(size_t)Tt[t] * 128 + lane]; g1[t] = SELW[(size_t)Tt[t] * 128 + 64 + lane]; d0[t] = 0.f; d1[t] = 0.f; }
#pragma unroll 1
        for (int kb = 0; kb < 128; kb += GNU) {
            u32x4 ura[2][GNU]; u32x2 urb[2][GNU];
#pragma unroll
            for (int j = 0; j < GNU; ++j)
#pragma unroll
                for (int t = 0; t < 2; ++t) { const int k = kb + j; const int e = __builtin_amdgcn_readlane(k < 64 ? e0[t] : e1[t], k & 63);
                    const unsigned char* up = TU + (size_t)e * PT_ROWB;
                    ura[t][j] = *(const u32x4*)(up + lane * 16); urb[t][j] = *(const u32x2*)(up + 1024 + lane * 8); }
#pragma unroll
            for (int j = 0; j < GNU; ++j) { float pt[2];
#pragma unroll
                for (int t = 0; t < 2; ++t) { const u32x16 r = fp6_unpack_bf16(ura[t][j], urb[t][j]);
                    float sa = 0.f, sb = 0.f, sc2 = 0.f, sd = 0.f;
#pragma unroll
                    for (int i = 0; i < 4; ++i) { const unsigned x0 = xw[t][i].x, x1 = xw[t][i].y, x2 = xw[t][i].z, x3 = xw[t][i].w;
                        sa = dot2bf(r[4 * i], x0, sa); sb = dot2bf(r[4 * i + 1], x1, sb); sc2 = dot2bf(r[4 * i + 2], x2, sc2); sd = dot2bf(r[4 * i + 3], x3, sd); }
                    pt[t] = (sa + sb) + (sc2 + sd); }
                const float sm0 = wave_sum(pt[0]), sm1 = wave_sum(pt[1]); const int k = kb + j;
                if (k < 64) { if (lane == k) { d0[0] = sm0; d0[1] = sm1; } } else { if (lane == k - 64) { d1[0] = sm0; d1[1] = sm1; } } }
        }
        float cf0[2], cf1[2];
#pragma unroll
        for (int t = 0; t < 2; ++t) { cf0[t] = g0[t] * gelu_tanh(d0[t] * SCU[e0[t]]) * SCV[e0[t]]; cf1[t] = g1[t] * gelu_tanh(d1[t] * SCU[e1[t]]) * SCV[e1[t]]; }
        f32x2 acc[2][16];
#pragma unroll
        for (int t = 0; t < 2; ++t)
#pragma unroll
            for (int i = 0; i < 16; ++i) acc[t][i] = (f32x2){0.f, 0.f};
#pragma unroll 1
        for (int kb = 0; kb < 128; kb += GN) {
            u32x4 vra[2][GN]; u32x2 vrb[2][GN]; float cf[2][GN];
#pragma unroll
            for (int j = 0; j < GN; ++j)
#pragma unroll
                for (int t = 0; t < 2; ++t) { const int k = kb + j; const int e = __builtin_amdgcn_readlane(k < 64 ? e0[t] : e1[t], k & 63);
                    cf[t][j] = __builtin_bit_cast(float, __builtin_amdgcn_readlane(__builtin_bit_cast(int, k < 64 ? cf0[t] : cf1[t]), k & 63));
                    const unsigned char* vp = TV + (size_t)e * PT_ROWB;
                    vra[t][j] = *(const u32x4*)(vp + lane * 16); vrb[t][j] = *(const u32x2*)(vp + 1024 + lane * 8); }
#pragma unroll
            for (int j = 0; j < GN; ++j)
#pragma unroll
                for (int t = 0; t < 2; ++t) { const f32x32 r = fp6_unpack(vra[t][j], vrb[t][j]);
                    const f32x2 c2 = (f32x2){cf[t][j], cf[t][j]};
#pragma unroll
                    for (int i = 0; i < 16; ++i) acc[t][i] += c2 * (f32x2){r[2 * i], r[2 * i + 1]}; }
        }
#pragma unroll
        for (int t = 0; t < 2; ++t) {
            if (t == 1 && !two) break;
            const int T = Tt[t];
            const float* gate = modl + (size_t)(cond_of(T) * 6 + 5) * DM;
            f32x4 xn[8]; float ss = 0.f;
#pragma unroll
            for (int q4 = 0; q4 < 8; ++q4) { const int col = lane * 32 + q4 * 4; float* xp = X + (size_t)T * DM + col;
                const f32x4 gv = *(const f32x4*)(gate + col), x0 = *(const f32x4*)(xp);
                const f32x4 r = x0 + gv * (f32x4){acc[t][q4 * 2].x, acc[t][q4 * 2].y, acc[t][q4 * 2 + 1].x, acc[t][q4 * 2 + 1].y};
                *(f32x4*)(xp) = r; xn[q4] = r; ss += r.x * r.x + r.y * r.y + r.z * r.z + r.w * r.w; }
            if (NEXTNORM) {
                ss = wave_sum(ss);
                const float rstd = rsqrtf(ss * (1.f / DM) + NORM_EPS);
                const float* sh = nmodl + (size_t)(cond_of(T) * 6 + 0) * DM; const float* sc = sh + DM;
                bf16_t* H = (bf16_t*)(P.ws + WS_HM);
#pragma unroll
                for (int q4 = 0; q4 < 8; ++q4) { const int col = lane * 32 + q4 * 4;
                    const f32x4 g4 = *(const f32x4*)(ngain + col), s4 = *(const f32x4*)(sc + col), h4 = *(const f32x4*)(sh + col);
                    const f32x4 o = xn[q4] * rstd * g4 * (s4 + 1.f) + h4;
                    *(u32x2*)(H + (size_t)T * DM + col) = (u32x2){pk2(o.x, o.y), pk2(o.z, o.w)}; }
            }
        }
    }
}
constexpr int NPHASE = 22;

__global__ void __launch_bounds__(NTHR, 2) mega(Params P) {
    extern __shared__ __attribute__((aligned(16))) unsigned char lds_raw[];
    Ctx F;
    F.lds = (LAS unsigned char*)lds_raw; F.tid = threadIdx.x; F.lane = F.tid & 63; F.wave = __builtin_amdgcn_readfirstlane(F.tid >> 6); F.G = gridDim.x; F.bid = blockIdx.x;
    const int lo = P.ph_lo, hi = P.ph_hi;
    volatile LAS unsigned* xbw = (volatile LAS unsigned*)(F.lds + LDS_BYTES - 16);
    if (F.tid == 0) { xbw[0] = 0u; xbw[1] = 0u; xbw[2] = 0u; xbw[3] = 0u; }
    __syncthreads();
    if (hi - lo > 1) (void)xcd_barrier_post((unsigned*)(P.ws + WS_CTL), xbw);
#define GRID_BARRIER() do { XcdBarrier bar_; bar_.bar = (unsigned*)(P.ws + WS_CTL); bar_.x = xb_xcc_id(); bar_.st = (volatile LAS unsigned*)(F.lds + LDS_BYTES - 16); xcd_barrier(bar_); } while (0)
#define PH(k, ...) if (lo <= (k) && (k) < hi) { { __VA_ARGS__ } if ((k) + 1 < hi) GRID_BARRIER(); }
#define MOD0 ((const float*)(P.ws + WS_MOD))
#define MOD1 ((const float*)(P.ws + WS_MOD) + 9 * 12288)
#define HM ((bf16_t*)(P.ws + WS_HM))
#define RA ((bf16_t*)(P.ws + WS_RA))
#define X (P.out + O_Y)

    PH(0, prologue(F, P);)
    PH(1, adaln_reduce(F, P);)
    PH(2, norm_phase(F, P.in[I_XP], P.in[I_XS], P.in[I_NMIXG], MOD0, 0, HM);)
    PH(3, { EpiBf16 E{RA, 4096}; run_gemm(F, HM, (const bf16_t*)(P.ws + WS_WEVIN) + (size_t)2048 * 2048, 4096, 2048, E); })
    PH(4, prep_a(F, P);)
    PH(5, { EpiBf16 E{RA, 2048}; run_gemm(F, HM, (const bf16_t*)(P.ws + WS_WEVIN), 2048, 2048, E); })
    PH(6, attn_phase<0>(F, P); attn_phase<1>(F, P); hyena_phase(F, P);)
    PH(7, hyena_post(F, P);)
    PH(8, { EpiResid E{P.in[I_XP], P.in[I_XS], X, MOD0, 2}; run_gemm(F, HM, (const bf16_t*)(P.ws + WS_WEVOUT), 2048, 2048, E); })
    PH(9, norm_phase(F, X, X + (size_t)TP * DM, P.in[I_NFFNG], MOD0, 3, HM);)
    PH(10, { EpiBf16 E{RA, 2048}; run_gemm(F, HM, (const bf16_t*)(P.ws + WS_WPQ), 2048, 2048, E); })
    PH(11, peer_select(F, P, 0);)
    PH(12, peer_gather<true>(F, P, MOD0, 0, P.in[I_NMIXG] + DM, MOD1);)
    PH(13, { EpiBf16 E{RA, 4096}; run_gemm(F, HM, (const bf16_t*)(P.ws + WS_WODIN), 4096, 2048, E); })
    PH(14, prep_c(F, P); s5_phase(F, P);)
    PH(15, { const float lam = diff_lambda(F, P); attn_diff_phase<false>(F, P, lam); attn_diff_phase<true>(F, P, lam); } s5_combine(F, P);)
    PH(16, { EpiGlu E{(const bf16_t*)(P.ws + WS_RB + RB_Y), HM, P.in[I_GLUB]}; run_gemm(F, (const bf16_t*)(P.ws + WS_RB + RB_Y), (const bf16_t*)(P.ws + WS_WGLU), 1024, 1024, E); })
    PH(17, { EpiResid E{X, X + (size_t)TP * DM, X, MOD1, 2}; run_gemm(F, HM, (const bf16_t*)(P.ws + WS_WODOUT), 2048, 2048, E); })
    PH(18, norm_phase(F, X, X + (size_t)TP * DM, P.in[I_NFFNG] + DM, MOD1, 3, HM);)
    PH(19, { EpiBf16 E{RA, 2048}; run_gemm(F, HM, (const bf16_t*)(P.ws + WS_WPQ) + (size_t)2048 * 2048, 2048, 2048, E); })
    PH(20, peer_select(F, P, 1);)
    PH(21, peer_gather<false>(F, P, MOD1, 1, nullptr, nullptr);)
#undef MOD0
#undef MOD1
#undef HM
#undef RA
#undef X
#undef PH
#undef GRID_BARRIER
}

extern "C" void kernel_launch(void* const* d_in, const int* in_sizes, int n_in, void* d_out, int out_size, void* d_ws, size_t ws_size, hipStream_t stream) {
    static int grid = 0;
    if (grid == 0) {
        if (n_in != N_IN || (size_t)out_size != O_END || ws_size < WS_END) { fprintf(stderr, "kernel_launch: unexpected shapes (n_in %d, out %d, ws %zu, need %zu)\n", n_in, out_size, ws_size, (size_t)WS_END); grid = -1; return; }
        int dev = 0, cus = 0;
        if (hipGetDevice(&dev) != hipSuccess || hipDeviceGetAttribute(&cus, hipDeviceAttributeMultiprocessorCount, dev) != hipSuccess) { grid = -1; return; }
        if (hipFuncSetAttribute((const void*)mega, hipFuncAttributeMaxDynamicSharedMemorySize, LDS_BYTES) != hipSuccess) { fprintf(stderr, "kernel_launch: hipFuncSetAttribute failed\n"); grid = -1; return; }
        int per_cu = 0;
        if (hipOccupancyMaxActiveBlocksPerMultiprocessor(&per_cu, (const void*)mega, NTHR, LDS_BYTES) != hipSuccess || per_cu < 1) { fprintf(stderr, "kernel_launch: occupancy query says %d blocks per CU\n", per_cu); }
        (void)hipGetLastError();
        grid = cus;
    }
    if (grid < 0) return;
    (void)hipMemsetAsync((char*)d_ws + WS_CTL, 0, 65536, stream);
    Params p; memset(&p, 0, sizeof(p));
    for (int i = 0; i < N_IN; ++i) p.in[i] = (const float*)d_in[i];
    p.out = (float*)d_out; p.ws = (unsigned char*)d_ws;
    p.ph_lo = 0; p.ph_hi = NPHASE;
    hipLaunchKernelGGL(mega, dim3(grid), dim3(NTHR), LDS_BYTES, stream, p);
}
```

```cpp
#include <hip/hip_runtime.h>
#include <cstdio>
#include <cstring>
#include <cstdint>

typedef unsigned short bf16_t;
typedef short bf16x8 __attribute__((ext_vector_type(8)));
typedef short s16x4 __attribute__((ext_vector_type(4)));
typedef float f32x2 __attribute__((ext_vector_type(2)));
typedef float f32x4 __attribute__((ext_vector_type(4)));
typedef float f32x16 __attribute__((ext_vector_type(16)));
typedef unsigned u32x2 __attribute__((ext_vector_type(2)));
typedef unsigned u32x4 __attribute__((ext_vector_type(4)));
typedef __bf16 bf16x2_t __attribute__((ext_vector_type(2)));
typedef float f32x32 __attribute__((ext_vector_type(32)));
typedef unsigned u32x6 __attribute__((ext_vector_type(6)));
typedef unsigned u32x16 __attribute__((ext_vector_type(16)));
typedef __bf16 bf16x32_t __attribute__((ext_vector_type(32)));

#define DI __device__ __forceinline__

constexpr int NTHR = 512;
constexpr int DM = 2048;
constexpr int TP = 8192;
constexpr int TS = 32768;
constexpr int TOK = TP + TS;
constexpr int LP = 256, LS = 4096;
constexpr float NORM_EPS = 1e-6f;
constexpr float LOG2E = 1.4426950408889634f;

enum { I_XP = 0, I_XS, I_C, I_CNK, I_CNV, I_CDK, I_CDV, I_S5RE, I_S5IM, I_CCTX, I_MODW, I_MODB, I_NMIXG, I_NFFNG, I_EVWIN, I_EVWOUT, I_NAQG, I_NAKG, I_RPB,
       I_HYCW, I_HYCB, I_HYW1, I_HYB1, I_HYF1, I_HYW2, I_HYB2, I_HYF2, I_HYW3, I_HYDEC, I_HYBIAS, I_ODWIN, I_ODWOUT, I_S5LRE, I_S5LIM, I_S5LDT, I_S5BRE, I_S5BIM,
       I_S5CRE, I_S5CIM, I_S5D, I_GLUW, I_GLUB, I_DQG, I_DKG, I_LQ1, I_LK1, I_LQ2, I_LK2, I_SUBG, I_PWQ, I_PKEYS, I_PU, I_PV, N_IN };

constexpr size_t O_Y = 0;
constexpr size_t O_NAK = 83886080, O_NAV = 92274688, O_DK = 100663296, O_DV = 109051904, O_SR = 117440512, O_SI = 117702656, O_END = 117964800;

constexpr size_t al256(size_t x) { return (x + 255) & ~(size_t)255; }
constexpr size_t WS_CTL = 0;
constexpr size_t WS_MODP = 65536;
constexpr size_t WS_MOD = WS_MODP + (size_t)2 * 16 * 9 * 12288 * 4;
constexpr size_t WS_WEVIN = al256(WS_MOD + (size_t)2 * 9 * 12288 * 4);
constexpr size_t WS_WEVOUT = WS_WEVIN + (size_t)6144 * 2048 * 2;
constexpr size_t WS_WODIN = WS_WEVOUT + (size_t)2048 * 2048 * 2;
constexpr size_t WS_WODOUT = WS_WODIN + (size_t)4096 * 2048 * 2;
constexpr size_t WS_WPQ = WS_WODOUT + (size_t)2048 * 2048 * 2;
constexpr size_t WS_WGLU = WS_WPQ + (size_t)2 * 2048 * 2048 * 2;
constexpr size_t WS_PKEYS = WS_WGLU + (size_t)1024 * 1024 * 2;
constexpr size_t WS_CNK = WS_PKEYS + (size_t)2 * 8 * 2 * 128 * 128 * 2;
constexpr size_t WS_CNVT = WS_CNK + (size_t)8 * 256 * 1024 * 2;
constexpr size_t WS_CDK = WS_CNVT + (size_t)8 * 256 * 1024 * 2;
constexpr size_t WS_CDVT = WS_CDK + (size_t)8 * 256 * 1024 * 2;
constexpr size_t WS_S5A = WS_CDVT + (size_t)8 * 256 * 1024 * 2;
constexpr size_t WS_S5BB = WS_S5A + (size_t)128 * 64 * 2 * 4;
constexpr size_t WS_S5CC = WS_S5BB + (size_t)128 * 128 * 16 * 2;
constexpr int KRL_S = 8208, KRL_P = 528;
constexpr size_t WS_KRS = WS_S5CC + (size_t)128 * 16 * 128 * 2;
constexpr size_t WS_KRP = al256(WS_KRS + (size_t)2 * 1024 * KRL_S * 2);
constexpr size_t WS_TBLU = al256(WS_KRP + (size_t)2 * 1024 * KRL_P * 2);
constexpr size_t WS_TBLV = WS_TBLU + (size_t)16384 * 2048 * 2;
constexpr size_t WS_HM = WS_TBLV + (size_t)16384 * 2048 * 2;
constexpr size_t WS_RA = WS_HM + (size_t)TOK * 2048 * 2;
constexpr size_t WS_RB = WS_RA + (size_t)TOK * 4096 * 2;
constexpr size_t WS_VT = WS_RB + (size_t)3072 * TOK * 2;
constexpr size_t WS_SC = WS_VT + (size_t)TOK * 1024 * 2;
constexpr size_t WS_END = WS_SC + (size_t)4 * 16384 * 4;
constexpr size_t RA_Q = 0;
constexpr size_t RA_SELI = (size_t)TOK * 2048 * 2;
constexpr size_t RA_SELW = RA_SELI + (size_t)TOK * 128 * 4;
constexpr size_t RA_CF = RA_SELW + (size_t)TOK * 128 * 4;
constexpr size_t RA_ZC = (size_t)TOK * 2048 * 2;
constexpr size_t RB_YF = 0, RB_YB = (size_t)TOK * 1024 * 2, RB_Y = (size_t)2 * TOK * 1024 * 2;
constexpr size_t VT_S = (size_t)TP * 1024 * 2;

constexpr int LDS_BYTES = 147456;

struct Params { const float* in[N_IN]; float* out; unsigned char* ws; int ph_lo, ph_hi; };

DI float bf2f(bf16_t b) { return __uint_as_float(((unsigned)b) << 16); }
DI float bflo(unsigned w) { return __uint_as_float(w << 16); }
DI float bfhi(unsigned w) { return __uint_as_float(w & 0xffff0000u); }
DI unsigned pk2(float a, float b) { f32x2 v = {a, b}; return __builtin_bit_cast(unsigned, __builtin_convertvector(v, bf16x2_t)); }
DI float dot2bf(unsigned a, unsigned b, float c) { return __builtin_amdgcn_fdot2_f32_bf16(__builtin_bit_cast(bf16x2_t, a), __builtin_bit_cast(bf16x2_t, b), c, false); }
DI bf16_t f2bf(float a) { return (bf16_t)(pk2(a, 0.f) & 0xffffu); }
DI float dpp_xor1(float v) { return __builtin_bit_cast(float, __builtin_amdgcn_update_dpp(0, __builtin_bit_cast(int, v), 0xB1, 0xF, 0xF, true)); }
DI float dpp_xor2(float v) { return __builtin_bit_cast(float, __builtin_amdgcn_update_dpp(0, __builtin_bit_cast(int, v), 0x4E, 0xF, 0xF, true)); }
DI float wave_sum(float v) {
    v += dpp_xor1(v); v += dpp_xor2(v);
    v += __builtin_bit_cast(float, __builtin_amdgcn_update_dpp(0, __builtin_bit_cast(int, v), 0x141, 0xF, 0xF, true));
    v += __builtin_bit_cast(float, __builtin_amdgcn_update_dpp(0, __builtin_bit_cast(int, v), 0x140, 0xF, 0xF, true));
    v += __builtin_bit_cast(float, __builtin_amdgcn_update_dpp(0, __builtin_bit_cast(int, v), 0x142, 0xA, 0xF, false));
    v += __builtin_bit_cast(float, __builtin_amdgcn_update_dpp(0, __builtin_bit_cast(int, v), 0x143, 0xC, 0xF, false));
    return __builtin_bit_cast(float, __builtin_amdgcn_readlane(__builtin_bit_cast(int, v), 63));
}
DI float gelu_tanh(float x) {
    const float u = 0.7978845608028654f * (x + 0.044715f * x * x * x);
    const float e = __expf(2.f * u);
    const float t = 1.f - 2.f / (e + 1.f);
    return 0.5f * x * (1.f + t);
}
DI float wave_max(float v) {
    v = fmaxf(v, dpp_xor1(v)); v = fmaxf(v, dpp_xor2(v));
    v = fmaxf(v, __builtin_bit_cast(float, __builtin_amdgcn_update_dpp(0, __builtin_bit_cast(int, v), 0x141, 0xF, 0xF, true)));
    v = fmaxf(v, __builtin_bit_cast(float, __builtin_amdgcn_update_dpp(0, __builtin_bit_cast(int, v), 0x140, 0xF, 0xF, true)));
    v = fmaxf(v, __builtin_bit_cast(float, __builtin_amdgcn_update_dpp(0, __builtin_bit_cast(int, v), 0x142, 0xA, 0xF, false)));
    v = fmaxf(v, __builtin_bit_cast(float, __builtin_amdgcn_update_dpp(0, __builtin_bit_cast(int, v), 0x143, 0xC, 0xF, false)));
    return __builtin_bit_cast(float, __builtin_amdgcn_readlane(__builtin_bit_cast(int, v), 63));
}
DI f32x2 fp8x2_lo(unsigned w) { return __builtin_amdgcn_cvt_pk_f32_fp8((int)w, false); }
DI f32x2 fp8x2_hi(unsigned w) { return __builtin_amdgcn_cvt_pk_f32_fp8((int)w, true); }
DI unsigned pk_fp8x4(float a, float b, float c, float d) { int r = 0; r = __builtin_amdgcn_cvt_pk_fp8_f32(a, b, r, false); r = __builtin_amdgcn_cvt_pk_fp8_f32(c, d, r, true); return (unsigned)r; }
DI int lane_id() { return (int)__builtin_amdgcn_mbcnt_hi(~0u, __builtin_amdgcn_mbcnt_lo(~0u, 0u)); }
DI int cond_of(int T) { return T < TP ? 0 : 1 + ((T - TP) >> 12); }
#define XB_TMO      128
#define XB_XCNT(j)  (256  + 64 * (j))
#define XB_XSUB(j)  (1280 + 64 * (j))
#define XB_XGEN(j)  (2304 + 64 * (j))
#define XB_TOP      3328
#define XB_TOPGEN   3392
#define XCD_BAR_WORDS 3456
#define XB_SPIN_CAP (1u << 26)
#define LAS __attribute__((address_space(3)))

__device__ __forceinline__ unsigned xb_ld(unsigned* p)              { return __hip_atomic_load(p, __ATOMIC_RELAXED, __HIP_MEMORY_SCOPE_AGENT); }
__device__ __forceinline__ unsigned xb_add(unsigned* p, unsigned v) { return __hip_atomic_fetch_add(p, v, __ATOMIC_RELAXED, __HIP_MEMORY_SCOPE_AGENT); }
__device__ __forceinline__ unsigned xb_xcc_id() { return (unsigned)__builtin_amdgcn_s_getreg((3 << 11) | 20) & 0xFu; }
#define XB_SPIN(cond, bar) do { unsigned _sp = 0; while (cond) { __builtin_amdgcn_s_sleep(1); \
    if ((++_sp & 255u) == 0u) { if (xb_ld(&(bar)[XB_TMO])) break; if (_sp > XB_SPIN_CAP) { atomicAdd(&(bar)[XB_TMO], 1u); break; } } } } while (0)

struct XcdBarrier {
    unsigned* bar; unsigned x;
    volatile LAS unsigned* st;
};

__device__ __forceinline__ XcdBarrier xcd_barrier_post(unsigned* bar, volatile LAS unsigned* st) {
    XcdBarrier b; b.bar = bar; b.x = xb_xcc_id(); b.st = st;
    if (threadIdx.x == 0) (void)xb_add(&bar[XB_XCNT(b.x)], 1u);
    return b;
}
__device__ __forceinline__ void xcd_barrier_complete(unsigned* bar, unsigned x, unsigned& nloc, unsigned& nx) {
    const unsigned G = gridDim.x * gridDim.y * gridDim.z;
    unsigned sum, cnt, mine, sp = 0u;
    for (;;) {
        sum = 0u; cnt = 0u; mine = 0u;
#pragma unroll
        for (unsigned j = 0; j < 16; ++j) { const unsigned c = xb_ld(&bar[XB_XCNT(j)]); sum += c; cnt += (c > 0u) ? 1u : 0u; mine = (j == x) ? c : mine; }
        if (sum == G) break;
        __builtin_amdgcn_s_sleep(1);
        if ((++sp & 255u) == 0u) { if (xb_ld(&bar[XB_TMO])) break; if (sp > XB_SPIN_CAP) { atomicAdd(&bar[XB_TMO], 1u); break; } }
    }
    nloc = mine > 0u ? mine : 1u; nx = cnt > 0u ? cnt : 1u;
}

__device__ __forceinline__ void xcd_barrier(const XcdBarrier& b) {
    asm volatile("s_waitcnt vmcnt(0)" ::: "memory");
    __syncthreads();
    if (threadIdx.x == 0) {
        unsigned* bar = b.bar;
        __builtin_amdgcn_s_waitcnt(0);
        unsigned nloc = b.st[0], nx = b.st[1];
        if (nloc == 0u) { xcd_barrier_complete(bar, b.x, nloc, nx); b.st[0] = nloc; b.st[1] = nx; }
        const unsigned old = xb_add(&bar[XB_XSUB(b.x)], 1u);
        const unsigned gen = old / nloc;
        if (old + 1u == (gen + 1u) * nloc) {
            __builtin_amdgcn_fence(__ATOMIC_RELEASE, "agent");
            asm volatile("s_waitcnt vmcnt(0)" ::: "memory");
            const unsigned og = xb_add(&bar[XB_TOP], 1u);
            const unsigned tg = og / nx;
            if (og + 1u == (tg + 1u) * nx) xb_add(&bar[XB_TOPGEN], 1u);
            else XB_SPIN(xb_ld(&bar[XB_TOPGEN]) == tg, bar);
            __builtin_amdgcn_fence(__ATOMIC_ACQUIRE, "agent");
            xb_add(&bar[XB_XGEN(b.x)], 1u);
            asm volatile("s_waitcnt vmcnt(0)" ::: "memory");
        } else {
            XB_SPIN(xb_ld(&bar[XB_XGEN(b.x)]) == gen, bar);
            __builtin_amdgcn_fence(__ATOMIC_ACQUIRE, "agent");
            asm volatile("s_waitcnt vmcnt(0)" ::: "memory");
        }
    }
    __syncthreads();
}
namespace pg8 {
#define PG8_LAS __attribute__((address_space(3)))
typedef unsigned short bf16_t;
typedef short bf16x8 __attribute__((ext_vector_type(8)));
typedef float f32x4 __attribute__((ext_vector_type(4)));
typedef unsigned u32x4 __attribute__((ext_vector_type(4)));
constexpr int BM = 256, BK = 64, HALF = 128, HTB = HALF * BK * 2  , STAGE_BYTES = 8 * HTB, NXCD = 8, WGM = 8;

__host__ __device__ __forceinline__ int lds_byte(int r, int c) { const int st = (r >> 4) * 2 + (c >> 5), rr = r & 15, cc = c & 31, ob = rr * 64 + cc * 2; return st * 1024 + (ob ^ (((ob >> 9) & 1) << 5)); }
__host__ __device__ __forceinline__ void stage_rc(int b, int& R, int& C) { const int st = b / 1024, sb = b % 1024, swz = sb ^ (((sb >> 9) & 1) << 5); R = (st >> 1) * 16 + swz / 64; C = (st & 1) * 32 + (swz % 64) / 2; }
__host__ __device__ __forceinline__ int perm32(int rho) { const int n = rho >> 4, i = rho & 15; return 8 * (i >> 2) + 4 * n + (i & 3); }

struct Unit { int pm, pn; };
struct Gemm { const bf16_t* A; const bf16_t* Bt; int M, N, K; };

struct StaticOrder {
    int nM, nN, nwg, G, c;
    __host__ __device__ void init(int M, int N, int G_, int c_) { nM = M / BM; nN = N / BM; nwg = nM * nN; G = G_; c = c_; }
    __host__ __device__ bool next(int i, Unit& u) const {
        const long L = (long)i * G + c; if (L >= nwg) return false;
        int wgid = (int)L; { const int q = nwg / NXCD, r = nwg % NXCD, xcd = wgid % NXCD, off = wgid / NXCD; wgid = (xcd < r ? xcd * (q + 1) : r * (q + 1) + (xcd - r) * q) + off; }
        const int nig = WGM * nN, gid = wgid / nig, fm = gid * WGM, gsz = (nM - fm) < WGM ? (nM - fm) : WGM;
        u.pm = fm + ((wgid % nig) % gsz); u.pn = (wgid % nig) / gsz; return true;
    }
    __device__ __forceinline__ void a_ready(const Unit&) const {}
    __device__ __forceinline__ void done(const Unit&) const {}
};
__device__ __forceinline__ unsigned cvt_pk_bf16(float lo, float hi) { unsigned r; asm volatile("v_cvt_pk_bf16_f32 %0, %1, %2" : "=v"(r) : "v"(lo), "v"(hi)); return r; }
template <class Epi, class Sched, bool STAMP = false>
__device__ __forceinline__ void gemm_phase(PG8_LAS unsigned char* lds, const Gemm g, const Sched& S, const Epi& E, unsigned long long* stamps) {
    const int tid = threadIdx.x, wid = __builtin_amdgcn_readfirstlane(tid >> 6), lane = tid & 63, wr = wid >> 2, wc = wid & 3, fr = lane & 15, fq = lane >> 4;
    const int K = g.K, nt = K / BK;
    int ts_lo = 0, ts_hi = 0, nts = 0; const unsigned long long rt_entry = STAMP ? (unsigned long long)wall_clock64() : 0ull;
#define PG8_STAMP() do { if (STAMP && wid == 0 && nts < 64) { const unsigned long long _c = (unsigned long long)clock64(); \
        ts_lo = (lane == nts) ? (int)(unsigned)_c : ts_lo; ts_hi = (lane == nts) ? (int)(unsigned)(_c >> 32) : ts_hi; ++nts; } } while (0)
    PG8_STAMP();
    unsigned voffA[2], voffB[2];
#pragma unroll
    for (int i = 0; i < 2; ++i) { int R, C; stage_rc(tid * 16 + i * 8192, R, C); const int Rb = Epi::PERM ? ((R & ~31) + perm32(R & 31)) : R;
        voffA[i] = (unsigned)(R * K + C) * 2u; voffB[i] = (unsigned)(Rb * K + C) * 2u; }
    const size_t kstep = (size_t)(BK * 2);
    const size_t hstep = (size_t)HALF * K * 2;
    const size_t tstep = 2 * hstep;
    const unsigned ldsw = (unsigned)wid * 1024u;
    const int aoff = lds_byte(wr * 64 + fr, fq * 8), boff = lds_byte(wc * 32 + fr, fq * 8);
#define PG8_SA(b, h) (((b) * 2 + (h)) * HTB)
#define PG8_SB(b, h) ((4 + (b) * 2 + (h)) * HTB)
#define PG8_STAGE(bufoff, gbase, voff) do { _Pragma("unroll") for (int _i = 0; _i < 2; ++_i) \
        __builtin_amdgcn_global_load_lds((const unsigned*)((const char*)(gbase) + (voff)[_i]), (PG8_LAS unsigned*)(lds + (bufoff) + ldsw + _i * 8192), 16, 0, 0); } while (0)
#define PG8_LDA(dst, b, h) do { _Pragma("unroll") for (int m = 0; m < 4; ++m) _Pragma("unroll") for (int k = 0; k < 2; ++k) dst[m][k] = *(const PG8_LAS bf16x8*)(lds + PG8_SA(b, h) + aoff + m * 2048 + k * 1024); } while (0)
#define PG8_LDB(dst, b, h) do { _Pragma("unroll") for (int n = 0; n < 2; ++n) _Pragma("unroll") for (int k = 0; k < 2; ++k) dst[n][k] = *(const PG8_LAS bf16x8*)(lds + PG8_SB(b, h) + boff + n * 2048 + k * 1024); } while (0)
#define PG8_MMA(ai, bj, At, Bt) do { __builtin_amdgcn_s_setprio(1); _Pragma("unroll") for (int m = 0; m < 4; ++m) _Pragma("unroll") for (int n = 0; n < 2; ++n) _Pragma("unroll") for (int k = 0; k < 2; ++k) \
        acc[ai][bj][m][n] = __builtin_amdgcn_mfma_f32_16x16x32_bf16(Bt[n][k], At[m][k], acc[ai][bj][m][n], 0, 0, 0); __builtin_amdgcn_s_setprio(0); } while (0)
#define PG8_WAIT_V(n) asm volatile("s_waitcnt vmcnt(" #n ")" ::: "memory")
#define PG8_WAIT_L(n) asm volatile("s_waitcnt lgkmcnt(" #n ")" ::: "memory")
#define PG8_BAR __builtin_amdgcn_s_barrier()
#define PG8_SCHED __builtin_amdgcn_sched_barrier(0)
    Unit cur, nxt; int ui = 0;
    if (!S.next(0, cur)) return;
    f32x4 acc[2][2][4][2];
#pragma unroll
    for (int a = 0; a < 2; ++a)
#pragma unroll
        for (int b = 0; b < 2; ++b)
#pragma unroll
            for (int m = 0; m < 4; ++m)
#pragma unroll
                for (int n = 0; n < 2; ++n) acc[a][b][m][n] = (f32x4){0.f, 0.f, 0.f, 0.f};
    bf16x8 At[4][2], B0[2][2], B1[2][2];
    const char* cA = (const char*)g.A + (size_t)cur.pm * tstep; const char* cB = (const char*)g.Bt + (size_t)cur.pn * tstep;
    S.a_ready(cur);
    PG8_STAGE(PG8_SB(0, 0), cB, voffB); PG8_STAGE(PG8_SA(0, 0), cA, voffA); PG8_STAGE(PG8_SB(0, 1), cB + hstep, voffB); PG8_STAGE(PG8_SA(0, 1), cA + hstep, voffA);
    if (wr == 1) PG8_BAR;
    PG8_WAIT_V(4); PG8_BAR;
    PG8_STAGE(PG8_SB(1, 0), cB + kstep, voffB); PG8_STAGE(PG8_SA(1, 0), cA + kstep, voffA); PG8_STAGE(PG8_SB(1, 1), cB + hstep + kstep, voffB);
    PG8_WAIT_V(6); PG8_BAR;
    PG8_STAMP();
    for (;;) {
        const bool has_next = S.next(ui + 1, nxt);
        const char* nA = has_next ? (const char*)g.A + (size_t)nxt.pm * tstep : cA; const char* nB = has_next ? (const char*)g.Bt + (size_t)nxt.pn * tstep : cB;
        for (int t = 0; t < nt; t += 2) {
            const bool last = (t == nt - 2);
            const char* a1 = cA + (size_t)(t + 1) * kstep;
            const char* a2 = last ? nA : cA + (size_t)(t + 2) * kstep; const char* b2 = last ? nB : cB + (size_t)(t + 2) * kstep;
            const char* a3 = a2 + kstep; const char* b3 = b2 + kstep;
            if (last && has_next) S.a_ready(nxt);
            PG8_LDB(B0, 0, 0); PG8_SCHED; PG8_LDA(At, 0, 0); PG8_STAGE(PG8_SA(1, 1), a1 + hstep, voffA);
            PG8_WAIT_L(8); PG8_BAR; PG8_WAIT_L(0); PG8_MMA(0, 0, At, B0); PG8_BAR; PG8_SCHED;
            PG8_LDB(B1, 0, 1); PG8_STAGE(PG8_SB(0, 0), b2, voffB);
            PG8_BAR; PG8_WAIT_L(0); PG8_MMA(0, 1, At, B1); PG8_BAR;
            PG8_LDA(At, 0, 1); PG8_STAGE(PG8_SA(0, 0), a2, voffA);
            PG8_BAR; PG8_WAIT_L(0); PG8_MMA(1, 0, At, B0); PG8_BAR; PG8_SCHED;
            PG8_STAGE(PG8_SB(0, 1), b2 + hstep, voffB);
            PG8_WAIT_V(6); PG8_BAR; PG8_MMA(1, 1, At, B1); PG8_BAR;
            PG8_LDB(B0, 1, 0); PG8_SCHED; PG8_LDA(At, 1, 0); PG8_STAGE(PG8_SA(0, 1), a2 + hstep, voffA);
            PG8_WAIT_L(8); PG8_BAR; PG8_WAIT_L(0); PG8_MMA(0, 0, At, B0); PG8_BAR; PG8_SCHED;
            PG8_LDB(B1, 1, 1); PG8_STAGE(PG8_SB(1, 0), b3, voffB);
            PG8_BAR; PG8_WAIT_L(0); PG8_MMA(0, 1, At, B1); PG8_BAR;
            PG8_LDA(At, 1, 1); PG8_STAGE(PG8_SA(1, 0), a3, voffA);
            PG8_BAR; PG8_WAIT_L(0); PG8_MMA(1, 0, At, B0); PG8_BAR; PG8_SCHED;
            PG8_STAGE(PG8_SB(1, 1), b3 + hstep, voffB);
            PG8_WAIT_V(6); PG8_BAR; PG8_MMA(1, 1, At, B1); PG8_BAR;
        }
        PG8_STAMP();
        if constexpr (!Epi::AFTER_DRAIN) { E(acc, cur, wr, wc, fr, fq); S.done(cur); }
        PG8_STAMP();
        if (!has_next) break;
#pragma unroll
        for (int a = 0; a < 2; ++a)
#pragma unroll
            for (int b = 0; b < 2; ++b)
#pragma unroll
                for (int m = 0; m < 4; ++m)
#pragma unroll
                    for (int n = 0; n < 2; ++n) acc[a][b][m][n] = (f32x4){0.f, 0.f, 0.f, 0.f};
        cur = nxt; cA = nA; cB = nB; ++ui;
    }
    PG8_WAIT_V(0);
    if (wr == 0) PG8_BAR;
    PG8_BAR;
    if constexpr (Epi::AFTER_DRAIN) { E.fused(acc, cur, wr, wc, fr, fq, lds, wid, lane); S.done(cur); }
    PG8_STAMP();
    if (STAMP && wid == 0) { stamps[lane] = lane < nts ? (((unsigned long long)(unsigned)ts_hi << 32) | (unsigned)ts_lo) : 0ull;
        if (lane == 62) stamps[62] = rt_entry; if (lane == 63) stamps[63] = (unsigned long long)wall_clock64(); }
#undef PG8_STAMP
#undef PG8_SA
#undef PG8_SB
#undef PG8_STAGE
#undef PG8_LDA
#undef PG8_LDB
#undef PG8_MMA
#undef PG8_WAIT_V
#undef PG8_WAIT_L
#undef PG8_BAR
#undef PG8_SCHED
}
}
struct Ctx {
    LAS unsigned char* lds; int tid, lane, wave, G, bid;
};

DI void cvt_rows(const Ctx& F, const float* src, bf16_t* dst, size_t n) {
    const size_t n8 = n >> 3;
    for (size_t i = (size_t)F.bid * NTHR + F.tid; i < n8; i += (size_t)F.G * NTHR) {
        const f32x4 a = *(const f32x4*)(src + i * 8), b = *(const f32x4*)(src + i * 8 + 4);
        u32x4 w; w.x = pk2(a.x, a.y); w.y = pk2(a.z, a.w); w.z = pk2(b.x, b.y); w.w = pk2(b.z, b.w);
        *(u32x4*)(dst + i * 8) = w;
    }
}

constexpr int TR_S = 68;
DI void tr_tile_out(const Ctx& F, bf16_t* dst, size_t ldd, const LAS bf16_t* tile) {
    const int n = F.tid >> 3, kc = (F.tid & 7) * 8;
    const LAS bf16_t* t = tile + kc * TR_S + n;
    u32x4 v;
    v.x = (unsigned)t[0] | ((unsigned)t[TR_S] << 16); v.y = (unsigned)t[2 * TR_S] | ((unsigned)t[3 * TR_S] << 16);
    v.z = (unsigned)t[4 * TR_S] | ((unsigned)t[5 * TR_S] << 16); v.w = (unsigned)t[6 * TR_S] | ((unsigned)t[7 * TR_S] << 16);
    *(u32x4*)(dst + (size_t)n * ldd + kc) = v;
}
DI void tr_tile_f32(const Ctx& F, const float* src, size_t lds_, bf16_t* dst, size_t ldd, LAS bf16_t* tile) {
#pragma unroll
    for (int j = 0; j < 2; ++j) {
        const int id = F.tid + NTHR * j, kr = id >> 4, nc = (id & 15) * 4;
        const f32x4 v = *(const f32x4*)(src + (size_t)kr * lds_ + nc);
        *(LAS u32x2*)(tile + kr * TR_S + nc) = (u32x2){pk2(v.x, v.y), pk2(v.z, v.w)};
    }
    __syncthreads();
    tr_tile_out(F, dst, ldd, tile);
    __syncthreads();
}
DI void tr_tile_bf16(const Ctx& F, const bf16_t* src, size_t lds_, bf16_t* dst, size_t ldd, LAS bf16_t* tile) {
    { const int kr = F.tid >> 3, nc = (F.tid & 7) * 8; const u32x4 v = *(const u32x4*)(src + (size_t)kr * lds_ + nc);
      *(LAS u32x2*)(tile + kr * TR_S + nc) = (u32x2){v.x, v.y}; *(LAS u32x2*)(tile + kr * TR_S + nc + 4) = (u32x2){v.z, v.w}; }
    __syncthreads();
    tr_tile_out(F, dst, ldd, tile);
    __syncthreads();
}
struct TrJob { const bf16_t* src; size_t lds_; bf16_t* dst; size_t ldd; };
template <class Map>
DI void tr_pipeline_bf16(const Ctx& F, int nt, const Map& map, LAS bf16_t* tiles) {
    const int kr = F.tid >> 3, nc = (F.tid & 7) * 8;
    __syncthreads();
    u32x4 v[4];
#pragma unroll
    for (int u = 0; u < 4; ++u) { const int t = F.bid + u * F.G; v[u] = (u32x4){0u, 0u, 0u, 0u};
        if (t < nt) { const TrJob J = map(t); v[u] = *(const u32x4*)(J.src + (size_t)kr * J.lds_ + nc); } }
#pragma unroll 1
    for (int t0 = F.bid; t0 < nt; t0 += 4 * F.G) {
#pragma unroll
        for (int u = 0; u < 4; ++u) { const int t = t0 + u * F.G;
            if (t < nt) {
                LAS bf16_t* tile = tiles + (u & 1) * (64 * TR_S);
                *(LAS u32x2*)(tile + kr * TR_S + nc) = (u32x2){v[u].x, v[u].y}; *(LAS u32x2*)(tile + kr * TR_S + nc + 4) = (u32x2){v[u].z, v[u].w};
                const int tn = t + 4 * F.G;
                if (tn < nt) { const TrJob Jn = map(tn); v[u] = *(const u32x4*)(Jn.src + (size_t)kr * Jn.lds_ + nc); }
                __syncthreads();
                const TrJob J = map(t);
                tr_tile_out(F, J.dst, J.ldd, tile);
            } }
    }
    __syncthreads();
}
DI void transpose_weight(const Ctx& F, const float* W, int K, int N, bf16_t* Wt) {
    const int tk = K / 64, tn = N / 64;
    for (int t = F.bid; t < tk * tn; t += F.G) {
        const int k0 = (t / tn) * 64, n0 = (t % tn) * 64;
        tr_tile_f32(F, W + (size_t)k0 * N + n0, (size_t)N, Wt + (size_t)n0 * K + k0, (size_t)K, (LAS bf16_t*)F.lds);
    }
}
DI void transpose_cache_v(const Ctx& F, const float* V, bf16_t* VT) {
    for (int t = F.bid; t < 64 * 8; t += F.G) {
        const int bh = t >> 3, sub = t & 7, k0 = (sub >> 1) * 64, d0 = (sub & 1) * 64, b = bh >> 3, h = bh & 7;
        tr_tile_f32(F, V + ((size_t)b * 256 + k0) * 1024 + h * 128 + d0, 1024, VT + ((size_t)bh * 128 + d0) * 256 + k0, 256, (LAS bf16_t*)F.lds);
    }
}

DI void adaln_partials(const Ctx& F, const Params& P) {
    LAS float* s = (LAS float*)F.lds;
    const float* modw = P.in[I_MODW]; const float* cv = P.in[I_C]; const float* cctx = P.in[I_CCTX];
    float* modp = (float*)(P.ws + WS_MODP);
    for (int it = F.bid; it < 192; it += F.G) {
        const int i = it / 96, r = it % 96, ks = r / 6, cg = r % 6;
        __syncthreads();
        for (int e = F.tid; e < 9 * 128; e += NTHR) { const int j = e >> 7, k = e & 127; const float c = (j == 0) ? cctx[ks * 128 + k] : cv[(j - 1) * 2048 + ks * 128 + k]; s[e] = c / (1.f + __expf(-c)); }
        __syncthreads();
        f32x4 acc[9];
#pragma unroll
        for (int j = 0; j < 9; ++j) acc[j] = (f32x4){0.f, 0.f, 0.f, 0.f};
        const float* w = modw + ((size_t)i * 2048 + ks * 128) * 12288 + cg * 2048 + F.tid * 4;
#pragma unroll 8
        for (int k = 0; k < 128; ++k) {
            const f32x4 w4 = *(const f32x4*)(w + (size_t)k * 12288);
#pragma unroll
            for (int j = 0; j < 9; ++j) acc[j] += w4 * s[j * 128 + k];
        }
#pragma unroll
        for (int j = 0; j < 9; ++j) *(f32x4*)(modp + ((size_t)(i * 16 + ks) * 9 + j) * 12288 + cg * 2048 + F.tid * 4) = acc[j];
    }
    __syncthreads();
}
DI void adaln_reduce(const Ctx& F, const Params& P) {
    const float* modp = (const float*)(P.ws + WS_MODP); float* mod = (float*)(P.ws + WS_MOD); const float* modb = P.in[I_MODB];
    for (int e = F.bid * NTHR + F.tid; e < 2 * 9 * 12288; e += F.G * NTHR) {
        const int i = e / (9 * 12288), r = e % (9 * 12288), j = r / 12288, n = r % 12288;
        float a = modb[i * 12288 + n];
#pragma unroll
        for (int ks = 0; ks < 16; ++ks) a += modp[((size_t)(i * 16 + ks) * 9 + j) * 12288 + n];
        mod[e] = a;
    }
}

DI void hyena_filters(const Ctx& F, const Params& P) {
    LAS float* z = (LAS float*)F.lds;
    LAS float* h1 = z + 320;
    LAS float* h2 = h1 + 576;
    const float* w1 = P.in[I_HYW1]; const float* b1 = P.in[I_HYB1]; const float* f1 = P.in[I_HYF1];
    const float* w2 = P.in[I_HYW2]; const float* b2 = P.in[I_HYB2]; const float* f2 = P.in[I_HYF2];
    const float* w3 = P.in[I_HYW3]; const float* dec = P.in[I_HYDEC];
    for (int it = F.bid; it < 544; it += F.G) {
        const bool smp = it < 512; const int L = smp ? LS : LP, p0 = (smp ? it : it - 512) * 8, RL = smp ? KRL_S : KRL_P;
        bf16_t* KR = (bf16_t*)(P.ws + (smp ? WS_KRS : WS_KRP));
        __syncthreads();
        if (F.tid < 9 * 33) {
            const int ps = F.tid / 33, k = F.tid % 33, i = p0 + ps;
            const float t = (float)i / (float)(L - 1), wang = 6.283185307179586f * (float)i / (float)L;
            float val;
            if (k == 0) val = t;
            else { const int f = (k - 1) & 15; const float fr = 1e-4f + (float)f * ((15.0f - 1e-4f) / 15.0f); val = (k <= 16) ? cosf(fr * wang) : -sinf(fr * wang); }
            z[F.tid] = val;
        }
        __syncthreads();
        for (int e = F.tid; e < 9 * 64; e += NTHR) { const int ps = e >> 6, j = e & 63; float a = b1[j];
            for (int k = 0; k < 33; ++k) a += z[ps * 33 + k] * w1[k * 64 + j];
            h1[e] = sinf(f1[j] * a); }
        __syncthreads();
        for (int e = F.tid; e < 9 * 64; e += NTHR) { const int ps = e >> 6, j = e & 63; float a = b2[j];
            for (int k = 0; k < 64; ++k) a += h1[ps * 64 + k] * w2[k * 64 + j];
            h2[e] = sinf(f2[j] * a); }
        __syncthreads();
#pragma unroll 1
        for (int qh = 0; qh < 2; ++qh) {
            float acc[9][4];
#pragma unroll
            for (int ps = 0; ps < 9; ++ps)
#pragma unroll
                for (int q = 0; q < 4; ++q) acc[ps][q] = 0.f;
#pragma unroll 2
            for (int k = 0; k < 64; ++k) {
                float w[4];
#pragma unroll
                for (int q = 0; q < 4; ++q) w[q] = w3[k * 4096 + F.tid + NTHR * (qh * 4 + q)];
#pragma unroll
                for (int ps = 0; ps < 9; ++ps) { const float hv = h2[ps * 64 + k];
#pragma unroll
                    for (int q = 0; q < 4; ++q) acc[ps][q] += hv * w[q]; }
            }
#pragma unroll
            for (int q = 0; q < 4; ++q) {
                const int n = F.tid + NTHR * (qh * 4 + q), o = (n >> 10) & 1, c = n & 1023;
                const float dc = fabsf(dec[n]);
                bf16_t* row = KR + (size_t)(o * 1024 + c) * RL;
                float v[9];
#pragma unroll
                for (int ps = 0; ps < 9; ++ps) { const int i = p0 + ps; v[ps] = (i < L) ? acc[ps][q] * __expf(-((float)i / (float)(L - 1)) * dc) : 0.f; }
                if (qh == 0) {
                    u32x4 wv; wv.x = pk2(v[8], v[7]); wv.y = pk2(v[6], v[5]); wv.z = pk2(v[4], v[3]); wv.w = pk2(v[2], v[1]);
                    *(u32x4*)(row + (L - p0 - 8)) = wv;
                    if (p0 == 0) row[L] = f2bf(v[0]);
                } else if (p0 > 0) {
                    u32x4 wv; wv.x = pk2(v[0], v[1]); wv.y = pk2(v[2], v[3]); wv.z = pk2(v[4], v[5]); wv.w = pk2(v[6], v[7]);
                    *(u32x4*)(row + (L + p0)) = wv;
                } else {
#pragma unroll
                    for (int ps = 1; ps < 8; ++ps) row[L + ps] = f2bf(v[ps]);
                }
            }
        }
    }
    __syncthreads();
    for (int e = F.bid * NTHR + F.tid; e < 2 * 2048; e += F.G * NTHR) {
        const bool smp = e < 2048; const int r = e & 2047, L = smp ? LS : LP, RL = smp ? KRL_S : KRL_P;
        bf16_t* row = (bf16_t*)(P.ws + (smp ? WS_KRS : WS_KRP)) + (size_t)r * RL;
        for (int x = 2 * L; x < RL; ++x) row[x] = 0;
    }
}

DI void s5_consts(const Ctx& F, const Params& P) {
    float* S5A = (float*)(P.ws + WS_S5A); bf16_t* BB = (bf16_t*)(P.ws + WS_S5BB); bf16_t* CC = (bf16_t*)(P.ws + WS_S5CC);
    const float* lre = P.in[I_S5LRE]; const float* lim = P.in[I_S5LIM]; const float* ldt = P.in[I_S5LDT];
    const float* bre = P.in[I_S5BRE]; const float* bim = P.in[I_S5BIM]; const float* cre = P.in[I_S5CRE]; const float* cim = P.in[I_S5CIM];
    for (int e = F.bid * NTHR + F.tid; e < 8192; e += F.G * NTHR) {
        const int dg = e >> 6, n = e & 63;
        const float dt = expf(ldt[dg]), lr = lre[e], li = lim[e];
        const float mag = expf(lr * dt), ar = mag * cosf(li * dt), ai = mag * sinf(li * dt), den = lr * lr + li * li;
        const float cr = ((ar - 1.f) * lr + ai * li) / den, ci = (ai * lr - (ar - 1.f) * li) / den;
        S5A[e * 2] = ar; S5A[e * 2 + 1] = ai;
#pragma unroll
        for (int p = 0; p < 16; ++p) {
            const float br = bre[(size_t)e * 16 + p], bi = bim[(size_t)e * 16 + p];
            BB[((size_t)dg * 128 + n) * 16 + p] = f2bf(cr * br - ci * bi);
            BB[((size_t)dg * 128 + 64 + n) * 16 + p] = f2bf(cr * bi + ci * br);
            CC[((size_t)dg * 16 + p) * 128 + n] = f2bf(cre[((size_t)dg * 16 + p) * 64 + n]);
            CC[((size_t)dg * 16 + p) * 128 + 64 + n] = f2bf(-cim[((size_t)dg * 16 + p) * 64 + n]);
        }
    }
}

constexpr int PT_ROWB = 1536;
DI void cvt_table_fp6(const Ctx& F, const float* src, unsigned char* dst, float* scales, const int (&perm)[32]) {
    LAS float* scr = (LAS float*)(F.lds) + F.wave * 2048 + F.lane;
    for (int r = F.bid * 8 + F.wave; r < 16384; r += F.G * 8) {
        f32x4 v[8]; float m = 0.f;
#pragma unroll
        for (int j = 0; j < 8; ++j) { v[j] = *(const f32x4*)(src + (size_t)r * 2048 + F.lane * 32 + j * 4);
            m = fmaxf(m, fmaxf(fmaxf(fabsf(v[j].x), fabsf(v[j].y)), fmaxf(fabsf(v[j].z), fabsf(v[j].w)))); }
        m = wave_max(m);
        const float inv = (m > 0.f) ? 7.0f / m : 0.f, sc = (m > 0.f) ? m / 7.0f : 0.f;
#pragma unroll
        for (int j = 0; j < 8; ++j) { scr[perm[j * 4 + 0] * 64] = v[j].x * inv; scr[perm[j * 4 + 1] * 64] = v[j].y * inv; scr[perm[j * 4 + 2] * 64] = v[j].z * inv; scr[perm[j * 4 + 3] * 64] = v[j].w * inv; }
        asm volatile("" ::: "memory");
        f32x16 a, b;
#pragma unroll
        for (int i = 0; i < 16; ++i) { a[i] = scr[i * 64]; b[i] = scr[(16 + i) * 64]; }
        asm volatile("" ::: "memory");
        const u32x6 pk = __builtin_amdgcn_cvt_scalef32_2xpk16_fp6_f32(a, b, 1.0f);
        unsigned char* o = dst + (size_t)r * PT_ROWB;
        *(u32x4*)(o + F.lane * 16) = (u32x4){pk[0], pk[1], pk[2], pk[3]}; *(u32x2*)(o + 1024 + F.lane * 8) = (u32x2){pk[4], pk[5]};
        if (F.lane == 0) scales[r] = sc;
    }
}
DI void convert_peer_tables(const Ctx& F, const Params& P) {
    int perm[32];
    { f32x16 a, b;
#pragma unroll
      for (int j = 0; j < 16; ++j) { a[j] = 0.125f * (float)j; b[j] = (j < 8) ? 2.0f + 0.25f * (float)j : 4.0f + 0.5f * (float)(j - 8); }
      const u32x6 pk = __builtin_amdgcn_cvt_scalef32_2xpk16_fp6_f32(a, b, 1.0f);
      const f32x32 rt = __builtin_amdgcn_cvt_scalef32_pk32_f32_fp6(pk, 1.0f);
#pragma unroll
      for (int i = 0; i < 32; ++i) { const float x = rt[i]; const int o = (x < 2.0f) ? (int)(x * 8.0f + 0.5f) : ((x < 4.0f) ? 16 + (int)((x - 2.0f) * 4.0f + 0.5f) : 24 + (int)((x - 4.0f) * 2.0f + 0.5f)); perm[i] = min(max(o, 0), 31); } }
    float* SC = (float*)(P.ws + WS_SC);
    __syncthreads();
    for (int layer = 0; layer < 2; ++layer) {
        cvt_table_fp6(F, P.in[I_PU] + (size_t)layer * 16384 * 2048, P.ws + WS_TBLU + (size_t)layer * 16384 * PT_ROWB, SC + layer * 16384, perm);
        cvt_table_fp6(F, P.in[I_PV] + (size_t)layer * 16384 * 2048, P.ws + WS_TBLV + (size_t)layer * 16384 * PT_ROWB, SC + (2 + layer) * 16384, perm);
    }
    __syncthreads();
}

DI void prologue(const Ctx& F, const Params& P) {
    adaln_partials(F, P);
    transpose_weight(F, P.in[I_EVWIN], 2048, 6144, (bf16_t*)(P.ws + WS_WEVIN));
    transpose_weight(F, P.in[I_EVWOUT], 2048, 2048, (bf16_t*)(P.ws + WS_WEVOUT));
    transpose_weight(F, P.in[I_ODWIN], 2048, 4096, (bf16_t*)(P.ws + WS_WODIN));
    transpose_weight(F, P.in[I_ODWOUT], 2048, 2048, (bf16_t*)(P.ws + WS_WODOUT));
    transpose_weight(F, P.in[I_PWQ], 2048, 2048, (bf16_t*)(P.ws + WS_WPQ));
    transpose_weight(F, P.in[I_PWQ] + (size_t)2048 * 2048, 2048, 2048, (bf16_t*)(P.ws + WS_WPQ) + (size_t)2048 * 2048);
    transpose_weight(F, P.in[I_GLUW], 1024, 1024, (bf16_t*)(P.ws + WS_WGLU));
    cvt_rows(F, P.in[I_PKEYS], (bf16_t*)(P.ws + WS_PKEYS), (size_t)2 * 8 * 2 * 128 * 128);
    cvt_rows(F, P.in[I_CNK], (bf16_t*)(P.ws + WS_CNK), (size_t)8 * 256 * 1024);
    cvt_rows(F, P.in[I_CDK], (bf16_t*)(P.ws + WS_CDK), (size_t)8 * 256 * 1024);
    transpose_cache_v(F, P.in[I_CNV], (bf16_t*)(P.ws + WS_CNVT));
    transpose_cache_v(F, P.in[I_CDV], (bf16_t*)(P.ws + WS_CDVT));
    hyena_filters(F, P);
    s5_consts(F, P);
    convert_peer_tables(F, P);
}
DI void norm_phase(const Ctx& F, const float* xa, const float* xb, const float* gvec, const float* modl, int sidx, bf16_t* H) {
    const int step = F.G * 8;
    int T = F.bid * 8 + F.wave;
    f32x4 v[8];
    if (T < TOK) { const float* xr = T < TP ? xa + (size_t)T * DM : xb + (size_t)(T - TP) * DM;
#pragma unroll
        for (int j = 0; j < 8; ++j) v[j] = *(const f32x4*)(xr + (j * 64 + F.lane) * 4); }
    for (; T < TOK; T += step) {
        f32x4 vn[8];
        const int Tn = T + step;
        if (Tn < TOK) { const float* xr = Tn < TP ? xa + (size_t)Tn * DM : xb + (size_t)(Tn - TP) * DM;
#pragma unroll
            for (int j = 0; j < 8; ++j) vn[j] = *(const f32x4*)(xr + (j * 64 + F.lane) * 4); }
        float ss = 0.f;
#pragma unroll
        for (int j = 0; j < 8; ++j) ss += v[j].x * v[j].x + v[j].y * v[j].y + v[j].z * v[j].z + v[j].w * v[j].w;
        ss = wave_sum(ss);
        const float rstd = rsqrtf(ss * (1.f / DM) + NORM_EPS);
        const float* sh = modl + (size_t)(cond_of(T) * 6 + sidx) * DM; const float* sc = sh + DM;
#pragma unroll
        for (int j = 0; j < 8; ++j) {
            const int col = (j * 64 + F.lane) * 4;
            const f32x4 g4 = *(const f32x4*)(gvec + col), s4 = *(const f32x4*)(sc + col), h4 = *(const f32x4*)(sh + col);
            const f32x4 o = v[j] * rstd * g4 * (s4 + 1.f) + h4;
            u32x2 w; w.x = pk2(o.x, o.y); w.y = pk2(o.z, o.w);
            *(u32x2*)(H + (size_t)T * DM + col) = w;
        }
        if (Tn < TOK) {
#pragma unroll
            for (int j = 0; j < 8; ++j) v[j] = vn[j]; }
    }
}

struct EpiBf16 {
    static constexpr bool PERM = true, AFTER_DRAIN = false;
    bf16_t* O; int ldc;
    DI void operator()(const f32x4 (&acc)[2][2][4][2], const pg8::Unit& u, int wr, int wc, int fr, int fq) const {
        const int row0 = u.pm * 256 + wr * 64 + fr, col0 = u.pn * 256 + wc * 32 + 8 * fq;
#pragma unroll
        for (int ai = 0; ai < 2; ++ai)
#pragma unroll
            for (int m = 0; m < 4; ++m) { bf16_t* rowp = O + (size_t)(row0 + ai * 128 + m * 16) * ldc + col0;
#pragma unroll
                for (int bj = 0; bj < 2; ++bj) { const f32x4 v0 = acc[ai][bj][m][0], v1 = acc[ai][bj][m][1];
                    u32x4 w; w.x = pk2(v0[0], v0[1]); w.y = pk2(v0[2], v0[3]); w.z = pk2(v1[0], v1[1]); w.w = pk2(v1[2], v1[3]);
                    *(u32x4*)(rowp + bj * 128) = w; } }
    }
};
struct EpiResid {
    static constexpr bool PERM = false, AFTER_DRAIN = false;
    const float* xa; const float* xb; float* out; const float* modl; int gidx;
    DI void operator()(const f32x4 (&acc)[2][2][4][2], const pg8::Unit& u, int wr, int wc, int fr, int fq) const {
        const int row0 = u.pm * 256 + wr * 64 + fr, col0 = u.pn * 256 + wc * 32 + 4 * fq;
        const float* xbase = (u.pm < 32) ? xa : xb - (size_t)TP * DM;
        const float* gate = modl + (size_t)(cond_of(u.pm * 256) * 6 + gidx) * DM;
        f32x4 gv[2][2];
#pragma unroll
        for (int bj = 0; bj < 2; ++bj)
#pragma unroll
            for (int n = 0; n < 2; ++n) gv[bj][n] = *(const f32x4*)(gate + col0 + bj * 128 + n * 16);
#pragma unroll
        for (int ai = 0; ai < 2; ++ai)
#pragma unroll
            for (int m = 0; m < 4; ++m) { const size_t ro = (size_t)(row0 + ai * 128 + m * 16) * DM + col0;
#pragma unroll
                for (int bj = 0; bj < 2; ++bj)
#pragma unroll
                    for (int n = 0; n < 2; ++n) { const f32x4 x4 = *(const f32x4*)(xbase + ro + bj * 128 + n * 16);
                        *(f32x4*)(out + ro + bj * 128 + n * 16) = x4 + gv[bj][n] * acc[ai][bj][m][n]; } }
    }
};
struct EpiGlu {
    static constexpr bool PERM = true, AFTER_DRAIN = false;
    const bf16_t* Y; bf16_t* O; const float* bias;
    DI void operator()(const f32x4 (&acc)[2][2][4][2], const pg8::Unit& u, int wr, int wc, int fr, int fq) const {
        const int row0 = u.pm * 256 + wr * 64 + fr, col0 = u.pn * 256 + wc * 32 + 8 * fq;
#pragma unroll
        for (int bj = 0; bj < 2; ++bj) {
            const f32x4 b0 = *(const f32x4*)(bias + col0 + bj * 128), b1 = *(const f32x4*)(bias + col0 + bj * 128 + 4);
#pragma unroll
            for (int ai = 0; ai < 2; ++ai)
#pragma unroll
                for (int m = 0; m < 4; ++m) { const size_t r = (size_t)(row0 + ai * 128 + m * 16);
                    const u32x4 yv = *(const u32x4*)(Y + r * 1024 + col0 + bj * 128);
                    const f32x4 a0 = acc[ai][bj][m][0] + b0, a1 = acc[ai][bj][m][1] + b1;
                    float o[8];
                    o[0] = bflo(yv.x) / (1.f + __expf(-a0[0])); o[1] = bfhi(yv.x) / (1.f + __expf(-a0[1]));
                    o[2] = bflo(yv.y) / (1.f + __expf(-a0[2])); o[3] = bfhi(yv.y) / (1.f + __expf(-a0[3]));
                    o[4] = bflo(yv.z) / (1.f + __expf(-a1[0])); o[5] = bfhi(yv.z) / (1.f + __expf(-a1[1]));
                    o[6] = bflo(yv.w) / (1.f + __expf(-a1[2])); o[7] = bfhi(yv.w) / (1.f + __expf(-a1[3]));
                    u32x4 w; w.x = pk2(o[0], o[1]); w.y = pk2(o[2], o[3]); w.z = pk2(o[4], o[5]); w.w = pk2(o[6], o[7]);
                    *(u32x4*)(O + r * DM + col0 + bj * 128) = w; }
        }
    }
};
template <class Epi> DI void run_gemm(const Ctx& F, const bf16_t* A, const bf16_t* Bt, int N, int K, const Epi& E) {
    pg8::Gemm g{A, Bt, TOK, N, K}; pg8::StaticOrder S; S.init(TOK, N, F.G, F.bid);
    pg8::gemm_phase<Epi, pg8::StaticOrder, false>(F.lds, g, S, E, nullptr);
    __syncthreads();
}

DI void prep_a(const Ctx& F, const Params& P) {
    const bf16_t* T1 = (const bf16_t*)(P.ws + WS_RA);
    bf16_t* VTp = (bf16_t*)(P.ws + WS_VT); bf16_t* VTs = (bf16_t*)(P.ws + WS_VT + VT_S);
    { struct VtMap { const bf16_t* T1; bf16_t* VTp; bf16_t* VTs;
          DI TrJob operator()(int t) const {
              if (t < 2048) { const int bh = t >> 3, sub = t & 7, tk = sub >> 1, dd = sub & 1, b = bh >> 3, h = bh & 7;
                  return TrJob{T1 + ((size_t)(b * 256 + tk * 64)) * 4096 + h * 128 + dd * 64, 4096, VTp + ((size_t)bh * 128 + dd * 64) * 256 + tk * 64, 256}; }
              const int u = t - 2048, bh = u >> 7, sub = u & 127, tk = sub >> 1, dd = sub & 1, b = bh >> 3, h = bh & 7;
              return TrJob{T1 + ((size_t)(TP + b * 4096 + tk * 64)) * 4096 + h * 128 + dd * 64, 4096, VTs + ((size_t)bh * 128 + dd * 64) * 4096 + tk * 64, 4096}; } };
      tr_pipeline_bf16(F, 2048 + 8192, VtMap{T1, VTp, VTs}, (LAS bf16_t*)F.lds); }
    { float* o = P.out + O_NAV;
      for (int e = F.bid * NTHR + F.tid; e < TP * 128; e += F.G * NTHR) { const int T = e >> 7, c8 = (e & 127) * 8;
          const u32x4 v = *(const u32x4*)(T1 + (size_t)T * 4096 + c8);
          *(f32x4*)(o + (size_t)T * 1024 + c8) = (f32x4){bflo(v.x), bfhi(v.x), bflo(v.y), bfhi(v.y)};
          *(f32x4*)(o + (size_t)T * 1024 + c8 + 4) = (f32x4){bflo(v.z), bfhi(v.z), bflo(v.w), bfhi(v.w)}; } }
    { LAS bf16_t* tl = (LAS bf16_t*)F.lds;
      bf16_t* CM = (bf16_t*)(P.ws + WS_RB);
      const float* cw = P.in[I_HYCW]; const float* cb = P.in[I_HYCB];
      u32x4 vv[4], hv = (u32x4){0u, 0u, 0u, 0u};
#define PA_LOAD(t_) do { const int cg_ = (t_) % 48, tg_ = (t_) / 48, ch0_ = cg_ * 64, t0_ = tg_ * 256; \
          _Pragma("unroll") for (int j = 0; j < 4; ++j) { const int id = F.tid + NTHR * j, tk = id >> 3, c8 = (id & 7) * 8; \
              vv[j] = *(const u32x4*)(T1 + (size_t)(t0_ + tk) * 4096 + 1024 + ch0_ + c8); } \
          if (F.tid < 16) { const int side = F.tid >> 3, c8 = (F.tid & 7) * 8; \
              const bool lz_ = (t0_ < TP) ? true : (((t0_ - TP) & 4095) == 0), rz_ = (t0_ < TP) ? true : (((t0_ + 256 - TP) & 4095) == 0); \
              const bool zero = side ? rz_ : lz_; const int tk = side ? t0_ + 256 : t0_ - 1; \
              hv = (u32x4){0u, 0u, 0u, 0u}; \
              if (!zero) hv = *(const u32x4*)(T1 + (size_t)tk * 4096 + 1024 + ch0_ + c8); } } while (0)
      if (F.bid < 48 * 160) PA_LOAD(F.bid);
      for (int t = F.bid; t < 48 * 160; t += F.G) {
          const int cg = t % 48, tg = t / 48, ch0 = cg * 64, t0 = tg * 256;
          __syncthreads();
#pragma unroll
          for (int j = 0; j < 4; ++j) { const int id = F.tid + NTHR * j, tk = id >> 3, c8 = (id & 7) * 8;
              const u32x4 v = vv[j];
              LAS bf16_t* d = tl + tk + 1;
              d[(c8 + 0) * 264] = (bf16_t)(v.x & 0xffff); d[(c8 + 1) * 264] = (bf16_t)(v.x >> 16); d[(c8 + 2) * 264] = (bf16_t)(v.y & 0xffff); d[(c8 + 3) * 264] = (bf16_t)(v.y >> 16);
              d[(c8 + 4) * 264] = (bf16_t)(v.z & 0xffff); d[(c8 + 5) * 264] = (bf16_t)(v.z >> 16); d[(c8 + 6) * 264] = (bf16_t)(v.w & 0xffff); d[(c8 + 7) * 264] = (bf16_t)(v.w >> 16); }
          if (F.tid < 16) { const int side = F.tid >> 3, c8 = (F.tid & 7) * 8;
              const u32x4 v = hv;
              LAS bf16_t* d = tl + (side ? 257 : 0);
              d[(c8 + 0) * 264] = (bf16_t)(v.x & 0xffff); d[(c8 + 1) * 264] = (bf16_t)(v.x >> 16); d[(c8 + 2) * 264] = (bf16_t)(v.y & 0xffff); d[(c8 + 3) * 264] = (bf16_t)(v.y >> 16);
              d[(c8 + 4) * 264] = (bf16_t)(v.z & 0xffff); d[(c8 + 5) * 264] = (bf16_t)(v.z >> 16); d[(c8 + 6) * 264] = (bf16_t)(v.w & 0xffff); d[(c8 + 7) * 264] = (bf16_t)(v.w >> 16); }
          if (t + F.G < 48 * 160) PA_LOAD(t + F.G);
          __syncthreads();
#pragma unroll
          for (int j = 0; j < 4; ++j) { const int id = F.tid + NTHR * j, ch = id >> 5, to = (id & 31) * 8, cgl = ch0 + ch;
              const float w0 = cw[cgl], w1 = cw[3072 + cgl], w2 = cw[6144 + cgl], bb = cb[cgl];
              const LAS bf16_t* s = tl + ch * 264 + to;
              float r[10];
#pragma unroll
              for (int i = 0; i < 10; ++i) r[i] = bf2f(s[i]);
              float o[8];
#pragma unroll
              for (int i = 0; i < 8; ++i) o[i] = w0 * r[i] + w1 * r[i + 1] + w2 * r[i + 2] + bb;
              u32x4 w; w.x = pk2(o[0], o[1]); w.y = pk2(o[2], o[3]); w.z = pk2(o[4], o[5]); w.w = pk2(o[6], o[7]);
              *(u32x4*)(CM + (size_t)cgl * TOK + t0 + to) = w; }
      }
#undef PA_LOAD
      __syncthreads(); }
}

DI void prep_b(const Ctx& F, const Params& P) {
    bf16_t* Pq = (bf16_t*)(P.ws + WS_RA); const float* qg = P.in[I_NAQG]; const float* kg = P.in[I_NAKG]; float* ok = P.out + O_NAK;
    const float* gsrc = (F.lane < 32 ? qg : kg) + (F.lane & 3) * 32;
    float g[32];
#pragma unroll
    for (int i = 0; i < 32; ++i) g[i] = gsrc[i];
    for (int T = F.bid * 8 + F.wave; T < TOK; T += F.G * 8) {
        bf16_t* rp = Pq + (size_t)T * 2048 + F.lane * 32;
        u32x4 v[4]; float x[32]; float ss = 0.f;
#pragma unroll
        for (int j = 0; j < 4; ++j) { v[j] = *(const u32x4*)(rp + j * 8);
            x[j * 8 + 0] = bflo(v[j].x); x[j * 8 + 1] = bfhi(v[j].x); x[j * 8 + 2] = bflo(v[j].y); x[j * 8 + 3] = bfhi(v[j].y);
            x[j * 8 + 4] = bflo(v[j].z); x[j * 8 + 5] = bfhi(v[j].z); x[j * 8 + 6] = bflo(v[j].w); x[j * 8 + 7] = bfhi(v[j].w); }
#pragma unroll
        for (int i = 0; i < 32; ++i) ss += x[i] * x[i];
        ss += dpp_xor1(ss); ss += dpp_xor2(ss);
        const float rstd = rsqrtf(ss * (1.f / 128.f) + NORM_EPS);
#pragma unroll
        for (int i = 0; i < 32; ++i) x[i] = x[i] * rstd * g[i];
#pragma unroll
        for (int j = 0; j < 4; ++j) { u32x4 w; w.x = pk2(x[j * 8 + 0], x[j * 8 + 1]); w.y = pk2(x[j * 8 + 2], x[j * 8 + 3]); w.z = pk2(x[j * 8 + 4], x[j * 8 + 5]); w.w = pk2(x[j * 8 + 6], x[j * 8 + 7]);
            *(u32x4*)(rp + j * 8) = w; }
        if (T < TP && F.lane >= 32) { float* o = ok + (size_t)T * 1024 + (F.lane - 32) * 32;
#pragma unroll
            for (int j = 0; j < 8; ++j) *(f32x4*)(o + j * 4) = (f32x4){x[j * 4], x[j * 4 + 1], x[j * 4 + 2], x[j * 4 + 3]}; }
    }
}
constexpr int AT_KROW = 272, AT_VROW = 136, AT_KTB = 64 * AT_KROW, AT_VTB = 128 * AT_VROW;
constexpr int AT_K0 = 0, AT_V0 = 2 * AT_KTB, AT_RPB = AT_V0 + 2 * AT_VTB;

struct TileMap { const bf16_t* latK; int latKld; const bf16_t* latV; int latVld; int nlat; const bf16_t* ctxK; const bf16_t* ctxV; int ntiles; };
struct TileRegs { u32x4 k[2], v[2]; };

DI void tile_src(const TileMap& M, int j, const bf16_t*& kp, int& kld, const bf16_t*& vp, int& vld) {
    if (j < M.nlat) { kp = M.latK + (size_t)j * 64 * M.latKld; kld = M.latKld; vp = M.latV + j * 64; vld = M.latVld; }
    else { const int c = j - M.nlat; kp = M.ctxK + (size_t)c * 64 * 1024; kld = 1024; vp = M.ctxV + c * 64; vld = 256; }
}
DI void tile_load(const Ctx& F, TileRegs& R, const bf16_t* kp, int kld, const bf16_t* vp, int vld, bool withV = true) {
#pragma unroll
    for (int j = 0; j < 2; ++j) { const int id = F.tid + NTHR * j;
        const unsigned ko = (unsigned)((id >> 4) * kld + (id & 15) * 8) * 2u, vo = (unsigned)((id >> 3) * vld + (id & 7) * 8) * 2u;
        R.k[j] = *(const u32x4*)((const char*)kp + ko);
        if (withV) R.v[j] = *(const u32x4*)((const char*)vp + vo); }
}
DI void tile_store(const Ctx& F, const TileRegs& R, LAS unsigned char* kt, LAS unsigned char* vt, bool withV = true) {
#pragma unroll
    for (int j = 0; j < 2; ++j) { const int id = F.tid + NTHR * j;
        *(LAS u32x4*)(kt + (id >> 4) * AT_KROW + (id & 15) * 16) = R.k[j];
        if (withV) { LAS unsigned char* vp = vt + (id >> 3) * AT_VROW + (id & 7) * 16;
            *(LAS u32x2*)(vp) = (u32x2){R.v[j].x, R.v[j].y}; *(LAS u32x2*)(vp + 8) = (u32x2){R.v[j].z, R.v[j].w}; } }
}

DI void tile_norm_k(const Ctx& F, TileRegs& R, const LAS float* kgain, float* nk, int nkld) {
#pragma unroll
    for (int j = 0; j < 2; ++j) { const int id = F.tid + NTHR * j;
        float x[8] = {bflo(R.k[j].x), bfhi(R.k[j].x), bflo(R.k[j].y), bfhi(R.k[j].y), bflo(R.k[j].z), bfhi(R.k[j].z), bflo(R.k[j].w), bfhi(R.k[j].w)};
        float ss = 0.f;
#pragma unroll
        for (int i = 0; i < 8; ++i) ss += x[i] * x[i];
        ss += dpp_xor1(ss); ss += dpp_xor2(ss);
        ss += __builtin_bit_cast(float, __builtin_amdgcn_update_dpp(0, __builtin_bit_cast(int, ss), 0x141, 0xF, 0xF, true));
        ss += __builtin_bit_cast(float, __builtin_amdgcn_update_dpp(0, __builtin_bit_cast(int, ss), 0x140, 0xF, 0xF, true));
        const float rstd = rsqrtf(ss * (1.f / 128.f) + NORM_EPS);
        const f32x4 g0 = *(const LAS f32x4*)(kgain + (id & 15) * 8), g1 = *(const LAS f32x4*)(kgain + (id & 15) * 8 + 4);
        x[0] *= rstd * g0.x; x[1] *= rstd * g0.y; x[2] *= rstd * g0.z; x[3] *= rstd * g0.w; x[4] *= rstd * g1.x; x[5] *= rstd * g1.y; x[6] *= rstd * g1.z; x[7] *= rstd * g1.w;
        R.k[j] = (u32x4){pk2(x[0], x[1]), pk2(x[2], x[3]), pk2(x[4], x[5]), pk2(x[6], x[7])};
        if (nk) { float* o = nk + (size_t)(id >> 4) * nkld + (id & 15) * 8; *(f32x4*)(o) = (f32x4){x[0], x[1], x[2], x[3]}; *(f32x4*)(o + 4) = (f32x4){x[4], x[5], x[6], x[7]}; }
    }
}

template <int KS>
DI f32x16 qk_tile(LAS const unsigned char* kt, const bf16x8 (&Qf)[8], int kb, int kk0, int q, int hh) {
    f32x16 S;
#pragma unroll
    for (int i = 0; i < 16; ++i) S[i] = 0.f;
#pragma unroll
    for (int ks = 0; ks < KS; ++ks) { const int kk = kk0 + ks;
        const bf16x8 A = *(const LAS bf16x8*)(kt + (kb * 32 + q) * AT_KROW + (kk * 16 + hh * 8) * 2);
        S = __builtin_amdgcn_mfma_f32_32x32x16_bf16(A, Qf[kk], S, 0, 0, 0); }
    return S;
}
DI void pv_tile(LAS const unsigned char* vt, const float (&p)[16], f32x16 (&O)[4], int kb, int q, int hh) {
#pragma unroll
    for (int s = 0; s < 2; ++s) {
        u32x4 pw; pw.x = pk2(p[8 * s + 0], p[8 * s + 1]); pw.y = pk2(p[8 * s + 2], p[8 * s + 3]); pw.z = pk2(p[8 * s + 4], p[8 * s + 5]); pw.w = pk2(p[8 * s + 6], p[8 * s + 7]);
        const bf16x8 Pf = __builtin_bit_cast(bf16x8, pw);
#pragma unroll
        for (int db = 0; db < 4; ++db) {
            LAS const unsigned char* ap = vt + (db * 32 + q) * AT_VROW + (kb * 32 + 16 * s + 4 * hh) * 2;
            const u32x2 lo = *(const LAS u32x2*)(ap), hi = *(const LAS u32x2*)(ap + 16);
            const bf16x8 A2 = __builtin_bit_cast(bf16x8, (u32x4){lo.x, lo.y, hi.x, hi.y});
            O[db] = __builtin_amdgcn_mfma_f32_32x32x16_bf16(A2, Pf, O[db], 0, 0, 0);
        }
        asm volatile("" ::: "memory");
    }
}
template <bool LAT>
DI void attn_compute1(LAS const unsigned char* kt, LAS const unsigned char* vt, const bf16x8 (&Qf)[8], f32x16 (&O)[4], float& ls, int lane, const LAS float* blane, int mb) {
    const int q = lane & 31, hh = lane >> 5;
#pragma unroll 1
    for (int kb = 0; kb < 2; ++kb) {
        float bb[16];
        if (LAT) {
#pragma unroll
            for (int i = 0; i < 16; ++i) bb[i] = blane[kb * 32 + (i & 3) + 8 * (i >> 2)];
        }
        const f32x16 S = qk_tile<8>(kt, Qf, kb, 0, q, hh);
        float p[16];
#pragma unroll
        for (int i = 0; i < 16; ++i) {
            if (LAT) { const float e = __builtin_amdgcn_exp2f(S[i] + bb[i]);
                p[i] = ((unsigned)(kb * 32 + (i & 3) + 8 * (i >> 2) + mb) < 16u) ? e : 0.f; }
            else p[i] = __builtin_amdgcn_exp2f(S[i]);
            ls += p[i];
        }
        pv_tile(vt, p, O, kb, q, hh);
    }
}
DI void diff_pass1(LAS const unsigned char* kt, const bf16x8 (&Qf)[8], float (&ls)[2], int lane) {
    const int q = lane & 31, hh = lane >> 5;
#pragma unroll
    for (int kb = 0; kb < 2; ++kb) {
#pragma unroll
        for (int mp = 0; mp < 2; ++mp) { const f32x16 S = qk_tile<4>(kt, Qf, kb, mp * 4, q, hh);
#pragma unroll
            for (int i = 0; i < 16; ++i) ls[mp] += __builtin_amdgcn_exp2f(S[i]); }
    }
}
DI void diff_pass2(LAS const unsigned char* kt, LAS const unsigned char* vt, const bf16x8 (&Qf)[8], f32x16 (&O)[4], float w0, float w1, int lane) {
    const int q = lane & 31, hh = lane >> 5;
#pragma unroll
    for (int kb = 0; kb < 2; ++kb) {
        float p[16];
        { const f32x16 S0 = qk_tile<4>(kt, Qf, kb, 0, q, hh);
#pragma unroll
          for (int i = 0; i < 16; ++i) p[i] = __builtin_amdgcn_exp2f(S0[i]) * w0; }
        { const f32x16 S1 = qk_tile<4>(kt, Qf, kb, 4, q, hh);
#pragma unroll
          for (int i = 0; i < 16; ++i) p[i] -= __builtin_amdgcn_exp2f(S1[i]) * w1; }
        pv_tile(vt, p, O, kb, q, hh);
    }
}

template <int MODE>
DI void attn_phase(const Ctx& F, const Params& P) {
    constexpr bool DIFF = (MODE >= 2);
    constexpr bool NA = (MODE == 1);
    LAS unsigned char* lds = F.lds;
    LAS float* rpbl = (LAS float*)(lds + AT_RPB);
    LAS float* kgl = (LAS float*)(lds + AT_RPB + 2048);
    if (!DIFF) { __syncthreads(); if (F.tid < 128) kgl[F.tid] = P.in[I_NAKG][F.tid]; __syncthreads(); }
    const bf16_t* PA = (const bf16_t*)(P.ws + WS_RA);
    bf16_t* MIX = (bf16_t*)(P.ws + WS_HM);
    const bf16_t* VTp = (const bf16_t*)(P.ws + WS_VT); const bf16_t* VTs = (const bf16_t*)(P.ws + WS_VT + VT_S);
    const int q = F.lane & 31, hh = F.lane >> 5;
    const float c1 = (DIFF ? 0.125f : 0.08838834764831845f) * LOG2E;
    float lam = 0.f;
    if (DIFF) {
        const float a = wave_sum(P.in[I_LQ1][F.lane] * P.in[I_LK1][F.lane]), b = wave_sum(P.in[I_LQ2][F.lane] * P.in[I_LK2][F.lane]);
        lam = __expf(a) - __expf(b) + 0.35550906759096924f;
    }
    const int nunits = (MODE == 0 || MODE == 2) ? 256 : 1024;
    for (int u0 = F.bid; u0 < nunits; u0 += F.G) {
        int u = u0;
        if ((MODE == 1 || MODE == 3) && F.G == 256) { const int i = u0 >> 8, x = F.bid & 7, y = F.bid >> 3; u = ((2 * i + (y >> 4)) * 8 + x) * 16 + (y & 15); }
        int b, h, tok0, r = 0, rlo = 0; TileMap M;
        const bf16_t* qptr;
        if (MODE == 0) { b = u >> 3; h = u & 7; tok0 = b * 256 + F.wave * 32;
            qptr = PA + (size_t)(tok0 + q) * 2048 + h * 128;
            M.latK = PA + (size_t)(b * 256) * 2048 + 1024 + h * 128; M.latKld = 2048; M.latV = VTp + (size_t)(b * 8 + h) * 128 * 256; M.latVld = 256; M.nlat = 4; M.ctxK = nullptr; M.ctxV = nullptr; M.ntiles = 4; }
        else if (MODE == 1) { b = u >> 7; h = (u >> 4) & 7; const int rg = u & 15; r = 4 * rg + (F.wave >> 1);
            rlo = min(max(4 * rg - 4, 0), 56); const int rhi = min(max(4 * rg + 3 - 4, 0), 56) + 8;
            tok0 = TP + b * 4096 + r * 64 + (F.wave & 1) * 32;
            qptr = PA + (size_t)(tok0 + q) * 2048 + h * 128;
            M.latK = PA + (size_t)(TP + b * 4096 + rlo * 64) * 2048 + 1024 + h * 128; M.latKld = 2048; M.latV = VTs + (size_t)(b * 8 + h) * 128 * 4096 + rlo * 64; M.latVld = 4096; M.nlat = rhi - rlo;
            M.ctxK = (const bf16_t*)(P.ws + WS_CNK) + (size_t)b * 256 * 1024 + h * 128; M.ctxV = (const bf16_t*)(P.ws + WS_CNVT) + (size_t)(b * 8 + h) * 128 * 256; M.ntiles = M.nlat + 4;
            if (F.tid < 465) rpbl[F.tid] = P.in[I_RPB][h * 465 + F.tid] * LOG2E; }
        else if (MODE == 2) { b = u >> 3; h = u & 7; tok0 = b * 256 + F.wave * 32;
            qptr = PA + (size_t)(tok0 + q) * 4096 + 1024 + h * 128;
            M.latK = PA + (size_t)(b * 256) * 4096 + 2048 + h * 128; M.latKld = 4096; M.latV = VTp + (size_t)(b * 8 + h) * 128 * 256; M.latVld = 256; M.nlat = 4; M.ctxK = nullptr; M.ctxV = nullptr; M.ntiles = 4; }
        else { b = u >> 7; h = (u >> 4) & 7; const int qb = u & 15; tok0 = TP + b * 4096 + qb * 256 + F.wave * 32;
            qptr = PA + (size_t)(tok0 + q) * 4096 + 1024 + h * 128;
            M.latK = PA + (size_t)(TP + b * 4096) * 4096 + 2048 + h * 128; M.latKld = 4096; M.latV = VTs + (size_t)(b * 8 + h) * 128 * 4096; M.latVld = 4096; M.nlat = 64;
            M.ctxK = (const bf16_t*)(P.ws + WS_CDK) + (size_t)b * 256 * 1024 + h * 128; M.ctxV = (const bf16_t*)(P.ws + WS_CDVT) + (size_t)(b * 8 + h) * 128 * 256; M.ntiles = 68; }
        bf16x8 Qf[8];
        if constexpr (!DIFF) {
            u32x4 w[8]; float ss = 0.f;
#pragma unroll
            for (int ks = 0; ks < 8; ++ks) { w[ks] = *(const u32x4*)(qptr + ks * 16 + hh * 8);
                ss += bflo(w[ks].x) * bflo(w[ks].x) + bfhi(w[ks].x) * bfhi(w[ks].x) + bflo(w[ks].y) * bflo(w[ks].y) + bfhi(w[ks].y) * bfhi(w[ks].y)
                    + bflo(w[ks].z) * bflo(w[ks].z) + bfhi(w[ks].z) * bfhi(w[ks].z) + bflo(w[ks].w) * bflo(w[ks].w) + bfhi(w[ks].w) * bfhi(w[ks].w); }
            ss += __shfl_xor(ss, 32);
            const float qs = rsqrtf(ss * (1.f / 128.f) + NORM_EPS) * c1;
            const float* qg = P.in[I_NAQG];
#pragma unroll
            for (int ks = 0; ks < 8; ++ks) { const f32x4 g0 = *(const f32x4*)(qg + ks * 16 + hh * 8), g1 = *(const f32x4*)(qg + ks * 16 + hh * 8 + 4);
                const u32x4 ws = (u32x4){pk2(bflo(w[ks].x) * qs * g0.x, bfhi(w[ks].x) * qs * g0.y), pk2(bflo(w[ks].y) * qs * g0.z, bfhi(w[ks].y) * qs * g0.w),
                                         pk2(bflo(w[ks].z) * qs * g1.x, bfhi(w[ks].z) * qs * g1.y), pk2(bflo(w[ks].w) * qs * g1.z, bfhi(w[ks].w) * qs * g1.w)};
                Qf[ks] = __builtin_bit_cast(bf16x8, ws); }
        } else {
#pragma unroll
        for (int ks = 0; ks < 8; ++ks) { const u32x4 w = *(const u32x4*)(qptr + ks * 16 + hh * 8);
            const u32x4 ws = (u32x4){pk2(bflo(w.x) * c1, bfhi(w.x) * c1), pk2(bflo(w.y) * c1, bfhi(w.y) * c1), pk2(bflo(w.z) * c1, bfhi(w.z) * c1), pk2(bflo(w.w) * c1, bfhi(w.w) * c1)};
            Qf[ks] = __builtin_bit_cast(bf16x8, ws); }
        }
        f32x16 O[4]; float ls[2] = {0.f, 0.f}; float w0 = 0.f, w1 = 0.f;
#pragma unroll
        for (int db = 0; db < 4; ++db)
#pragma unroll
            for (int i = 0; i < 16; ++i) O[db][i] = 0.f;
        const int cq = (F.wave & 1) * 32 + q, cs = min(max(cq - 8, 0), 48);
        const int r0w = min(max(r - 4, 0), 56);
        const int nt = M.ntiles;
        TileRegs R;
        { const bf16_t* kp; const bf16_t* vp; int kld, vld; tile_src(M, 0, kp, kld, vp, vld); tile_load(F, R, kp, kld, vp, vld); }
        if constexpr (!DIFF) tile_norm_k(F, R, kgl, (MODE == 0) ? P.out + O_NAK + (size_t)(b * 256) * 1024 + h * 128 : nullptr, 1024);
        tile_store(F, R, lds + AT_K0, lds + AT_V0);
        __syncthreads();
        if constexpr (DIFF) {
#pragma unroll 1
            for (int j = 0; j < nt; ++j) {
                const int cur = j & 1, jn = (j + 1 < nt) ? j + 1 : 0;
                const bool wv = (j + 1 == nt);
                { const bf16_t* kp; const bf16_t* vp; int kld, vld; tile_src(M, jn, kp, kld, vp, vld); tile_load(F, R, kp, kld, vp, vld, wv); }
                diff_pass1(lds + AT_K0 + cur * AT_KTB, Qf, ls, F.lane);
                tile_store(F, R, lds + AT_K0 + (cur ^ 1) * AT_KTB, lds + AT_V0 + (cur ^ 1) * AT_VTB, wv);
                __syncthreads();
            }
            { const float l0 = ls[0] + __shfl_xor(ls[0], 32), l1 = ls[1] + __shfl_xor(ls[1], 32); w0 = 1.f / l0; w1 = lam / l1; }
#pragma unroll 1
            for (int j = 0; j < nt; ++j) {
                const int cur = (nt + j) & 1;
                if (j + 1 < nt) { const bf16_t* kp; const bf16_t* vp; int kld, vld; tile_src(M, j + 1, kp, kld, vp, vld); tile_load(F, R, kp, kld, vp, vld); }
                diff_pass2(lds + AT_K0 + cur * AT_KTB, lds + AT_V0 + cur * AT_VTB, Qf, O, w0, w1, F.lane);
                if (j + 1 < nt) tile_store(F, R, lds + AT_K0 + (cur ^ 1) * AT_KTB, lds + AT_V0 + (cur ^ 1) * AT_VTB);
                __syncthreads();
            }
        } else {
#pragma unroll 1
            for (int j = 0; j < nt; ++j) {
                const int cur = j & 1;
                if (j + 1 < nt) { const bf16_t* kp; const bf16_t* vp; int kld, vld; tile_src(M, j + 1, kp, kld, vp, vld); tile_load(F, R, kp, kld, vp, vld); }
                LAS const unsigned char* kt = lds + AT_K0 + cur * AT_KTB; LAS const unsigned char* vt = lds + AT_V0 + cur * AT_VTB;
                if constexpr (NA) {
                    if (j < M.nlat) { const int kr = rlo + j;
                        if (kr >= r0w && kr < r0w + 8) attn_compute1<true>(kt, vt, Qf, O, ls[0], F.lane, rpbl + (kr - r + 7) * 31 + (4 * hh - cq + 15), 4 * hh - cs); }
                    else attn_compute1<false>(kt, vt, Qf, O, ls[0], F.lane, rpbl, 0);
                } else attn_compute1<false>(kt, vt, Qf, O, ls[0], F.lane, rpbl, 0);
                if (j + 1 < nt) {
                    if (j + 1 < M.nlat) tile_norm_k(F, R, kgl, (MODE == 0) ? P.out + O_NAK + (size_t)(b * 256 + (j + 1) * 64) * 1024 + h * 128 : nullptr, 1024);
                    tile_store(F, R, lds + AT_K0 + (cur ^ 1) * AT_KTB, lds + AT_V0 + (cur ^ 1) * AT_VTB); }
                __syncthreads();
            }
        }
        if constexpr (!DIFF) {
            const float inv = 1.f / (ls[0] + __shfl_xor(ls[0], 32));
            bf16_t* op = MIX + (size_t)(tok0 + q) * DM + h * 128 + 4 * hh;
#pragma unroll
            for (int db = 0; db < 4; ++db)
#pragma unroll
                for (int g = 0; g < 4; ++g) { u32x2 w; w.x = pk2(O[db][4 * g] * inv, O[db][4 * g + 1] * inv); w.y = pk2(O[db][4 * g + 2] * inv, O[db][4 * g + 3] * inv);
                    *(u32x2*)(op + db * 32 + 8 * g) = w; }
        } else {
            float ss = 0.f;
#pragma unroll
            for (int db = 0; db < 4; ++db)
#pragma unroll
                for (int i = 0; i < 16; ++i) ss += O[db][i] * O[db][i];
            ss += __shfl_xor(ss, 32);
            const float sc = rsqrtf(ss * (1.f / 128.f) + NORM_EPS) * (1.f - 0.35550906759096924f);
            const float* sg = P.in[I_SUBG];
            bf16_t* op = MIX + (size_t)(tok0 + q) * DM + 1024 + h * 128 + 4 * hh;
#pragma unroll
            for (int db = 0; db < 4; ++db)
#pragma unroll
                for (int g = 0; g < 4; ++g) { const f32x4 g4 = *(const f32x4*)(sg + db * 32 + 8 * g + 4 * hh);
                    u32x2 w; w.x = pk2(O[db][4 * g] * sc * g4.x, O[db][4 * g + 1] * sc * g4.y); w.y = pk2(O[db][4 * g + 2] * sc * g4.z, O[db][4 * g + 3] * sc * g4.w);
                    *(u32x2*)(op + db * 32 + 8 * g) = w; }
        }
    }
}

DI float diff_lambda(const Ctx& F, const Params& P) {
    const float la = wave_sum(P.in[I_LQ1][F.lane] * P.in[I_LK1][F.lane]), lb = wave_sum(P.in[I_LQ2][F.lane] * P.in[I_LK2][F.lane]);
    return __expf(la) - __expf(lb) + 0.35550906759096924f;
}
template <bool SAMPLE>
DI void attn_diff_phase(const Ctx& F, const Params& P, const float lam) {
    LAS unsigned char* lds = F.lds;
    const bf16_t* PA = (const bf16_t*)(P.ws + WS_RA);
    bf16_t* MIX = (bf16_t*)(P.ws + WS_HM);
    const bf16_t* VTp = (const bf16_t*)(P.ws + WS_VT); const bf16_t* VTs = (const bf16_t*)(P.ws + WS_VT + VT_S);
    const int q = F.lane & 31, hh = F.lane >> 5, mp = F.wave >> 2, qg = F.wave & 3;
    const float c1 = 0.125f * LOG2E;
    const int nunits = SAMPLE ? 1024 : 256;
    for (int u0 = F.bid; u0 < nunits; u0 += F.G) {
        int u = u0;
        if (SAMPLE && F.G == 256) { const int i = u0 >> 8, x = F.bid & 7, y = F.bid >> 3; u = ((2 * i + (y >> 4)) * 8 + x) * 16 + (y & 15); }
        int b, h, tok0; TileMap M;
        if (!SAMPLE) { b = u >> 3; h = u & 7; tok0 = b * 256 + qg * 64;
            M.latK = PA + (size_t)(b * 256) * 4096 + 2048 + h * 128; M.latKld = 4096; M.latV = VTp + (size_t)(b * 8 + h) * 128 * 256; M.latVld = 256; M.nlat = 4; M.ctxK = nullptr; M.ctxV = nullptr; M.ntiles = 4; }
        else { b = u >> 7; h = (u >> 4) & 7; tok0 = TP + b * 4096 + (u & 15) * 256 + qg * 64;
            M.latK = PA + (size_t)(TP + b * 4096) * 4096 + 2048 + h * 128; M.latKld = 4096; M.latV = VTs + (size_t)(b * 8 + h) * 128 * 4096; M.latVld = 4096; M.nlat = 64;
            M.ctxK = (const bf16_t*)(P.ws + WS_CDK) + (size_t)b * 256 * 1024 + h * 128; M.ctxV = (const bf16_t*)(P.ws + WS_CDVT) + (size_t)(b * 8 + h) * 128 * 256; M.ntiles = 68; }
        LAS unsigned char* qst = lds + 73728 + F.wave * 8192 + F.lane * 16;
#pragma unroll
        for (int sb = 0; sb < 2; ++sb) { const bf16_t* qptr = PA + (size_t)(tok0 + sb * 32 + q) * 4096 + 1024 + h * 128 + mp * 64;
#pragma unroll
            for (int ks = 0; ks < 4; ++ks) { const u32x4 w = *(const u32x4*)(qptr + ks * 16 + hh * 8);
                const u32x4 ws = (u32x4){pk2(bflo(w.x) * c1, bfhi(w.x) * c1), pk2(bflo(w.y) * c1, bfhi(w.y) * c1), pk2(bflo(w.z) * c1, bfhi(w.z) * c1), pk2(bflo(w.w) * c1, bfhi(w.w) * c1)};
                *(LAS u32x4*)(qst + (sb * 4 + ks) * 1024) = ws; } }
        f32x16 O[2][4]; float ls[2] = {0.f, 0.f};
#pragma unroll
        for (int sb = 0; sb < 2; ++sb)
#pragma unroll
            for (int db = 0; db < 4; ++db)
#pragma unroll
                for (int i = 0; i < 16; ++i) O[sb][db][i] = 0.f;
        const int nt = M.ntiles;
        TileRegs R;
        { const bf16_t* kp; const bf16_t* vp; int kld, vld; tile_src(M, 0, kp, kld, vp, vld); tile_load(F, R, kp, kld, vp, vld); }
        tile_store(F, R, lds + AT_K0, lds + AT_V0);
        __syncthreads();
#pragma unroll 1
        for (int j = 0; j < nt; ++j) {
            const int cur = j & 1;
            if (j + 1 < nt) { const bf16_t* kp; const bf16_t* vp; int kld, vld; tile_src(M, j + 1, kp, kld, vp, vld); tile_load(F, R, kp, kld, vp, vld); }
            LAS const unsigned char* kt = lds + AT_K0 + cur * AT_KTB; LAS const unsigned char* vt = lds + AT_V0 + cur * AT_VTB;
#pragma unroll 1
            for (int kb = 0; kb < 2; ++kb) {
                f32x16 S0, S1;
#pragma unroll
                for (int i = 0; i < 16; ++i) { S0[i] = 0.f; S1[i] = 0.f; }
#pragma unroll
                for (int ks = 0; ks < 4; ++ks) { const bf16x8 A = *(const LAS bf16x8*)(kt + (kb * 32 + q) * AT_KROW + ((mp * 4 + ks) * 16 + hh * 8) * 2);
                    S0 = __builtin_amdgcn_mfma_f32_32x32x16_bf16(A, *(const LAS bf16x8*)(qst + ks * 1024), S0, 0, 0, 0);
                    S1 = __builtin_amdgcn_mfma_f32_32x32x16_bf16(A, *(const LAS bf16x8*)(qst + (4 + ks) * 1024), S1, 0, 0, 0); }
                u32x4 pa[2], pb[2];
                { float l0 = 0.f, l1 = 0.f;
#pragma unroll
                for (int sp = 0; sp < 2; ++sp) { float e0[8], e1[8];
#pragma unroll
                    for (int i = 0; i < 8; ++i) { e0[i] = __builtin_amdgcn_exp2f(S0[8 * sp + i]); e1[i] = __builtin_amdgcn_exp2f(S1[8 * sp + i]); l0 += e0[i]; l1 += e1[i]; }
                    pa[sp] = (u32x4){pk2(e0[0], e0[1]), pk2(e0[2], e0[3]), pk2(e0[4], e0[5]), pk2(e0[6], e0[7])};
                    pb[sp] = (u32x4){pk2(e1[0], e1[1]), pk2(e1[2], e1[3]), pk2(e1[4], e1[5]), pk2(e1[6], e1[7])}; }
                ls[0] += l0; ls[1] += l1; }
#pragma unroll
                for (int sp = 0; sp < 2; ++sp) {
                    const bf16x8 Pa = __builtin_bit_cast(bf16x8, pa[sp]), Pb = __builtin_bit_cast(bf16x8, pb[sp]);
#pragma unroll
                    for (int db = 0; db < 4; ++db) {
                        LAS const unsigned char* ap = vt + (db * 32 + q) * AT_VROW + (kb * 32 + 16 * sp + 4 * hh) * 2;
                        const u32x2 lo = *(const LAS u32x2*)(ap), hi = *(const LAS u32x2*)(ap + 16);
                        const bf16x8 A2 = __builtin_bit_cast(bf16x8, (u32x4){lo.x, lo.y, hi.x, hi.y});
                        O[0][db] = __builtin_amdgcn_mfma_f32_32x32x16_bf16(A2, Pa, O[0][db], 0, 0, 0);
                        O[1][db] = __builtin_amdgcn_mfma_f32_32x32x16_bf16(A2, Pb, O[1][db], 0, 0, 0);
                    }
                    asm volatile("" ::: "memory");
                }
            }
            if (j + 1 < nt) tile_store(F, R, lds + AT_K0 + (cur ^ 1) * AT_KTB, lds + AT_V0 + (cur ^ 1) * AT_VTB);
            __syncthreads();
        }
        LAS float* xch = (LAS float*)lds + qg * 8192 + F.lane;
        float lt[2];
#pragma unroll
        for (int sb = 0; sb < 2; ++sb) lt[sb] = ls[sb] + __shfl_xor(ls[sb], 32);
        if (mp == 1) {
#pragma unroll
            for (int sb = 0; sb < 2; ++sb) { const float w1 = lam / lt[sb];
#pragma unroll
                for (int db = 0; db < 4; ++db)
#pragma unroll
                    for (int i = 0; i < 16; ++i) xch[((sb * 4 + db) * 16 + i) * 64] = O[sb][db][i] * w1; } }
        __syncthreads();
        if (mp == 0) {
            const float* sg = P.in[I_SUBG];
#pragma unroll
            for (int sb = 0; sb < 2; ++sb) { const float w0 = 1.f / lt[sb]; float ss = 0.f;
#pragma unroll
                for (int db = 0; db < 4; ++db)
#pragma unroll
                    for (int i = 0; i < 16; ++i) { const float o = O[sb][db][i] * w0 - xch[((sb * 4 + db) * 16 + i) * 64]; O[sb][db][i] = o; ss += o * o; }
                ss += __shfl_xor(ss, 32);
                const float sc = rsqrtf(ss * (1.f / 128.f) + NORM_EPS) * (1.f - 0.35550906759096924f);
                bf16_t* op = MIX + (size_t)(tok0 + sb * 32 + q) * DM + 1024 + h * 128 + 4 * hh;
#pragma unroll
                for (int db = 0; db < 4; ++db)
#pragma unroll
                    for (int g = 0; g < 4; ++g) { const f32x4 g4 = *(const f32x4*)(sg + db * 32 + 8 * g + 4 * hh);
                        u32x2 w; w.x = pk2(O[sb][db][4 * g] * sc * g4.x, O[sb][db][4 * g + 1] * sc * g4.y); w.y = pk2(O[sb][db][4 * g + 2] * sc * g4.z, O[sb][db][4 * g + 3] * sc * g4.w);
                        *(u32x2*)(op + db * 32 + 8 * g) = w; } } }
        __syncthreads();
    }
}
template <int L, int BATCH> struct HyCfg {
    static constexpr int NB = L / 64, TPT = 32 / BATCH, NTILES = NB / TPT, LOGB = (BATCH == 8) ? 3 : 5;
    static constexpr int ZROWB = (L + 384) * 2 + 16, ZBYTES = BATCH * ZROWB, RL = 2 * L + 16;
    static constexpr int TPW = (NTILES + 7) / 8;
};
constexpr int HY_KR_OFF = 71808;

template <int L, int BATCH>
DI void hyena_part(const Ctx& F, const Params& P, int c, int tokbase  , const bf16_t* KRG  ) {
    typedef HyCfg<L, BATCH> C;
    LAS unsigned char* lds = F.lds;
    bf16_t* CM = (bf16_t*)(P.ws + WS_RB);
    const float* hbias = P.in[I_HYBIAS];
    const int q = F.lane & 31, hh = F.lane >> 5;
    __syncthreads();
    for (int id = F.tid; id < BATCH * (L / 8); id += NTHR) { const int b = id / (L / 8), s8 = (id % (L / 8)) * 8;
        *(LAS u32x4*)(lds + b * C::ZROWB + (192 + s8) * 2) = *(const u32x4*)(CM + (size_t)c * TOK + tokbase + b * L + s8); }
    for (int id = F.tid; id < BATCH * 48; id += NTHR) { const int b = id / 48, k = id % 48, e = (k < 24) ? k * 8 : (192 + L + (k - 24) * 8);
        *(LAS u32x4*)(lds + b * C::ZROWB + e * 2) = (u32x4){0u, 0u, 0u, 0u}; }
#pragma unroll 1
    for (int o = 0; o < 2; ++o) {
        { const bf16_t* src = KRG + (size_t)(o * 1024 + c) * C::RL;
          for (int id = F.tid; id < C::RL / 8; id += NTHR) { const u32x4 v = *(const u32x4*)(src + id * 8);
              *(LAS u32x4*)(lds + HY_KR_OFF + id * 16) = v;
              LAS bf16_t* c1 = (LAS bf16_t*)(lds + HY_KR_OFF + C::RL * 2) + id * 8 - 1;
              if (id > 0) c1[0] = (bf16_t)(v.x & 0xffff);
              c1[1] = (bf16_t)(v.x >> 16); c1[2] = (bf16_t)(v.y & 0xffff); c1[3] = (bf16_t)(v.y >> 16); c1[4] = (bf16_t)(v.z & 0xffff); c1[5] = (bf16_t)(v.z >> 16);
              c1[6] = (bf16_t)(v.w & 0xffff); c1[7] = (bf16_t)(v.w >> 16); } }
        __syncthreads();
        f32x16 acc[C::TPW][2];
#pragma unroll
        for (int t = 0; t < C::TPW; ++t)
#pragma unroll
            for (int mt = 0; mt < 2; ++mt)
#pragma unroll
                for (int i = 0; i < 16; ++i) acc[t][mt][i] = 0.f;
        const int tq0 = F.wave * C::TPW;
        if (tq0 < C::NTILES) {
            const int d1lo = C::TPT * tq0 - (C::NB - 1), d1hi = C::TPT * (tq0 + C::TPW - 1) + C::TPT - 1;
            const int abase = HY_KR_OFF + (F.lane & 1) * (C::RL * 2) + (L - (F.lane & 31) + 8 * hh - (F.lane & 1)) * 2;
            bf16x8 W0[6], W1[6], B0[C::TPW][4];
#define HY_LDW(Wv, d1v, i) do { LAS const unsigned* ap_ = (LAS const unsigned*)(lds + abase + (-4 * (d1v) - 2 + (i)) * 32); Wv[i] = __builtin_bit_cast(bf16x8, (u32x4){ap_[0], ap_[1], ap_[2], ap_[3]}); } while (0)
#define HY_LDB(Bv, d1v) do { _Pragma("unroll") for (int t_ = 0; t_ < C::TPW; ++t_) { const int tq_ = tq0 + t_; \
            const int t1_ = C::TPT * tq_ + (q >> C::LOGB), b_ = q & (BATCH - 1); int s1_ = t1_ - (d1v); s1_ = min(max(s1_, -3), C::NB + 2); \
            LAS const unsigned char* bp_ = lds + b_ * C::ZROWB + (192 + 64 * s1_ + 8 * hh) * 2; \
            _Pragma("unroll") for (int ks_ = 0; ks_ < 4; ++ks_) Bv[t_][ks_] = *(const LAS bf16x8*)(bp_ + ks_ * 32); } } while (0)
#define HY_MM(Wv, Bv, d1v) do { _Pragma("unroll") for (int t_ = 0; t_ < C::TPW; ++t_) { const int tq_ = tq0 + t_; \
            if ((d1v) >= C::TPT * tq_ - (C::NB - 1) && (d1v) <= C::TPT * tq_ + C::TPT - 1) { \
                _Pragma("unroll") for (int ks_ = 0; ks_ < 4; ++ks_) _Pragma("unroll") for (int mt_ = 0; mt_ < 2; ++mt_) \
                    acc[t_][mt_] = __builtin_amdgcn_mfma_f32_32x32x16_bf16(Wv[ks_ - 2 * mt_ + 2], Bv[t_][ks_], acc[t_][mt_], 0, 0, 0); } } } while (0)
#pragma unroll
            for (int i = 0; i < 6; ++i) HY_LDW(W0, d1lo, i);
            int d1 = d1lo;
#pragma unroll 1
            for (; d1 + 1 <= d1hi; d1 += 2) {
                HY_LDB(B0, d1);
#pragma unroll
                for (int i = 0; i < 4; ++i) HY_LDW(W1, d1 + 1, i);
                W1[4] = W0[0]; W1[5] = W0[1];
                HY_MM(W0, B0, d1);
                HY_LDB(B0, d1 + 1);
                if (d1 + 2 <= d1hi) {
#pragma unroll
                    for (int i = 0; i < 4; ++i) HY_LDW(W0, d1 + 2, i);
                    W0[4] = W1[0]; W0[5] = W1[1];
                }
                HY_MM(W1, B0, d1 + 1);
            }
            if (d1 <= d1hi) { HY_LDB(B0, d1); HY_MM(W0, B0, d1); }
#undef HY_LDW
#undef HY_LDB
#undef HY_MM
        }
        __syncthreads();
        if (tq0 < C::NTILES) {
            const float bo = hbias[o * 1024 + c];
            const bf16_t* gate = CM + (size_t)((1 + o) * 1024 + c) * TOK + tokbase;
            bf16_t* zout = (bf16_t*)(P.ws + WS_RA + RA_ZC) + (size_t)c * TOK + tokbase;
#pragma unroll
            for (int t = 0; t < C::TPW; ++t) { const int tq = tq0 + t, t1 = C::TPT * tq + (q >> C::LOGB), b = q & (BATCH - 1);
#pragma unroll
                for (int mt = 0; mt < 2; ++mt)
#pragma unroll
                    for (int g = 0; g < 4; ++g) { const int s = 64 * t1 + 32 * mt + 8 * g + 4 * hh;
                        LAS u32x2* zp = (LAS u32x2*)(lds + b * C::ZROWB + (192 + s) * 2);
                        const u32x2 zv = *zp, gv = *(const u32x2*)(gate + (size_t)b * L + s);
                        const float r0 = bflo(gv.x) * (acc[t][mt][4 * g] + bflo(zv.x) * bo), r1 = bfhi(gv.x) * (acc[t][mt][4 * g + 1] + bfhi(zv.x) * bo);
                        const float r2 = bflo(gv.y) * (acc[t][mt][4 * g + 2] + bflo(zv.y) * bo), r3 = bfhi(gv.y) * (acc[t][mt][4 * g + 3] + bfhi(zv.y) * bo);
                        const u32x2 w = (u32x2){pk2(r0, r1), pk2(r2, r3)};
                        if (o == 0) *zp = w; else *(u32x2*)(zout + (size_t)b * L + s) = w; } }
        }
        __syncthreads();
    }
}

DI void hyena_phase(const Ctx& F, const Params& P) {
    for (int c = F.bid; c < 1024; c += F.G) {
        hyena_part<LS, 8>(F, P, c, TP, (const bf16_t*)(P.ws + WS_KRS));
        hyena_part<LP, 32>(F, P, c, 0, (const bf16_t*)(P.ws + WS_KRP));
    }
}

DI void hyena_post(const Ctx& F, const Params& P) {
    const bf16_t* CM = (const bf16_t*)(P.ws + WS_RA + RA_ZC); bf16_t* MIX = (bf16_t*)(P.ws + WS_HM);
    struct PostMap { const bf16_t* CM; bf16_t* MIX;
        DI TrJob operator()(int t) const { const int cg = t & 15, tg = t >> 4;
            return TrJob{CM + (size_t)(cg * 64) * TOK + tg * 64, (size_t)TOK, MIX + (size_t)(tg * 64) * DM + 1024 + cg * 64, (size_t)DM}; } };
    tr_pipeline_bf16(F, 16 * 640, PostMap{CM, MIX}, (LAS bf16_t*)F.lds);
}
constexpr int PC_ROPE = 118784;
DI void prep_c(const Ctx& F, const Params& P) {
    bf16_t* PA = (bf16_t*)(P.ws + WS_RA);
    LAS float* rope = (LAS float*)(F.lds + PC_ROPE);
    __syncthreads();
    for (int e = F.tid; e < 1024; e += NTHR) { const int pos = e >> 4, f = e & 15; const float inv = exp2f(-(float)f * (13.287712379549449f / 16.f)); const float a = (float)pos * inv;
        rope[e * 2] = cosf(a); rope[e * 2 + 1] = sinf(a); }
    __syncthreads();
    bf16_t* VTp = (bf16_t*)(P.ws + WS_VT); bf16_t* VTs = (bf16_t*)(P.ws + WS_VT + VT_S);
    { struct VtMap { const bf16_t* PA; bf16_t* VTp; bf16_t* VTs;
          DI TrJob operator()(int t) const {
              if (t < 2048) { const int bh = t >> 3, sub = t & 7, tk = sub >> 1, dd = sub & 1, b = bh >> 3, h = bh & 7;
                  return TrJob{PA + ((size_t)(b * 256 + tk * 64)) * 4096 + 3072 + h * 128 + dd * 64, 4096, VTp + ((size_t)bh * 128 + dd * 64) * 256 + tk * 64, 256}; }
              const int u = t - 2048, bh = u >> 7, sub = u & 127, tk = sub >> 1, dd = sub & 1, b = bh >> 3, h = bh & 7;
              return TrJob{PA + ((size_t)(TP + b * 4096 + tk * 64)) * 4096 + 3072 + h * 128 + dd * 64, 4096, VTs + ((size_t)bh * 128 + dd * 64) * 4096 + tk * 64, 4096}; } };
      tr_pipeline_bf16(F, 2048 + 8192, VtMap{PA, VTp, VTs}, (LAS bf16_t*)F.lds); }
    { float* o = P.out + O_DV;
      for (int e = F.bid * NTHR + F.tid; e < TP * 128; e += F.G * NTHR) { const int T = e >> 7, c8 = (e & 127) * 8;
          const u32x4 v = *(const u32x4*)(PA + (size_t)T * 4096 + 3072 + c8);
          *(f32x4*)(o + (size_t)T * 1024 + c8) = (f32x4){bflo(v.x), bfhi(v.x), bflo(v.y), bfhi(v.y)};
          *(f32x4*)(o + (size_t)T * 1024 + c8 + 4) = (f32x4){bflo(v.z), bfhi(v.z), bflo(v.w), bfhi(v.w)}; } }
}
DI void prep_c_tokens(const Ctx& F, const Params& P, int wv, int nw) {
    bf16_t* PA = (bf16_t*)(P.ws + WS_RA);
    const LAS float* rope = (const LAS float*)(F.lds + PC_ROPE);
    const float* gsrc = (F.lane < 32 ? P.in[I_DQG] : P.in[I_DKG]) + (F.lane & 1) * 32; float* ok = P.out + O_DK;
    float g[32];
#pragma unroll
    for (int i = 0; i < 32; ++i) g[i] = gsrc[i];
    for (int T = wv; T < TOK; T += nw) {
        bf16_t* rp = PA + (size_t)T * 4096 + 1024 + F.lane * 32;
        u32x4 v[4]; float x[32]; float ss = 0.f;
#pragma unroll
        for (int j = 0; j < 4; ++j) { v[j] = *(const u32x4*)(rp + j * 8);
            x[j * 8 + 0] = bflo(v[j].x); x[j * 8 + 1] = bfhi(v[j].x); x[j * 8 + 2] = bflo(v[j].y); x[j * 8 + 3] = bfhi(v[j].y);
            x[j * 8 + 4] = bflo(v[j].z); x[j * 8 + 5] = bfhi(v[j].z); x[j * 8 + 6] = bflo(v[j].w); x[j * 8 + 7] = bfhi(v[j].w); }
#pragma unroll
        for (int i = 0; i < 32; ++i) ss += x[i] * x[i];
        ss += dpp_xor1(ss);
        const float rstd = rsqrtf(ss * (1.f / 64.f) + NORM_EPS);
#pragma unroll
        for (int i = 0; i < 32; ++i) x[i] = x[i] * rstd * g[i];
        if (T < TP) { if (F.lane >= 32) { float* o = ok + (size_t)T * 1024 + (F.lane - 32) * 32;
#pragma unroll
                for (int j = 0; j < 8; ++j) *(f32x4*)(o + j * 4) = (f32x4){x[j * 4], x[j * 4 + 1], x[j * 4 + 2], x[j * 4 + 3]}; } }
        else { const int t = (T - TP) & 4095, pos = (F.lane & 1) ? (t & 63) : (t >> 6);
            const LAS float* rt = rope + pos * 32;
#pragma unroll
            for (int f = 0; f < 16; ++f) { const float cs = rt[2 * f], sn = rt[2 * f + 1], a = x[f], b = x[16 + f]; x[f] = a * cs - b * sn; x[16 + f] = b * cs + a * sn; } }
#pragma unroll
        for (int j = 0; j < 4; ++j) { u32x4 w; w.x = pk2(x[j * 8 + 0], x[j * 8 + 1]); w.y = pk2(x[j * 8 + 2], x[j * 8 + 3]); w.z = pk2(x[j * 8 + 4], x[j * 8 + 5]); w.w = pk2(x[j * 8 + 6], x[j * 8 + 7]);
            *(u32x4*)(rp + j * 8) = w; }
    }
}

constexpr int S5_BROW = 80, S5_BUB = 128 * S5_BROW, S5_HROW = 272, S5_WLDS = S5_BUB + 16 * S5_HROW;
DI void s5_chain(const Ctx& F, const Params& P, int dg, int tok0, int L, const float* h0re, const float* h0im, float* fre, float* fim, bf16_t* Yout) {
    LAS unsigned char* wl = F.lds + F.wave * S5_WLDS; LAS unsigned char* hl = wl + S5_BUB;
    const int g = dg & 63, dir = dg >> 6, lane = F.lane, st = lane & 15, gq = lane >> 4;
    const float* S5A = (const float*)(P.ws + WS_S5A); const bf16_t* BB = (const bf16_t*)(P.ws + WS_S5BB); const bf16_t* CC = (const bf16_t*)(P.ws + WS_S5CC);
    const bf16_t* PA = (const bf16_t*)(P.ws + WS_RA);
    const float ar = S5A[(dg * 64 + lane) * 2], ai = S5A[(dg * 64 + lane) * 2 + 1];
    float hr = h0re ? h0re[lane] : 0.f, hi = h0im ? h0im[lane] : 0.f;
    const bf16x8 zero8 = (bf16x8){0, 0, 0, 0, 0, 0, 0, 0};
    bf16x8 BBf[8], CCf[4];
#pragma unroll
    for (int mt = 0; mt < 8; ++mt) BBf[mt] = (gq < 2) ? *(const bf16x8*)(BB + ((size_t)dg * 128 + mt * 16 + st) * 16 + gq * 8) : zero8;
#pragma unroll
    for (int kk = 0; kk < 4; ++kk) CCf[kk] = *(const bf16x8*)(CC + ((size_t)dg * 16 + st) * 128 + kk * 32 + gq * 8);
    const int nch = L / 16;
    const int sgn = dir ? -1 : 1, tstart = dir ? tok0 + L - 1 : tok0;
    const bf16_t* ubase = PA + (size_t)tstart * 4096 + g * 16 + gq * 8;
    const long ustep = (long)sgn * 4096;
#define S5_LDU(c_) (((c_) < nch && gq < 2) ? *(const bf16x8*)(ubase + ustep * ((c_) * 16 + st)) : zero8)
#define S5_BU(Uv) do { _Pragma("unroll") for (int mt = 0; mt < 8; ++mt) { f32x4 d_ = (f32x4){0.f, 0.f, 0.f, 0.f}; \
        d_ = __builtin_amdgcn_mfma_f32_16x16x32_bf16(Uv, BBf[mt], d_, 0, 0, 0); *(LAS f32x4*)(wl + (mt * 16 + st) * S5_BROW + gq * 16) = d_; } } while (0)
#define S5_Y(c_) do { f32x4 y_ = (f32x4){0.f, 0.f, 0.f, 0.f}; \
        _Pragma("unroll") for (int kk = 0; kk < 4; ++kk) y_ = __builtin_amdgcn_mfma_f32_16x16x32_bf16(CCf[kk], Bh[kk], y_, 0, 0, 0);        \
        *(u32x2*)(Yout + (size_t)(tstart + sgn * ((c_) * 16 + st)) * 1024 + g * 16 + gq * 4) = (u32x2){pk2(y_[0], y_[1]), pk2(y_[2], y_[3])}; } while (0)
#define S5_ITER(DOY) do { \
        f32x4 br_[4], bi_[4]; \
        _Pragma("unroll") for (int j = 0; j < 4; ++j) { br_[j] = *(const LAS f32x4*)(wl + lane * S5_BROW + j * 16); bi_[j] = *(const LAS f32x4*)(wl + (64 + lane) * S5_BROW + j * 16); } \
        bf16x8 Bh[4]; \
        if (DOY) { _Pragma("unroll") for (int kk = 0; kk < 4; ++kk) Bh[kk] = *(const LAS bf16x8*)(hl + st * S5_HROW + (kk * 32 + gq * 8) * 2); } \
        const bf16x8 Un_ = S5_LDU(ch + 4); \
        S5_BU(Ua); \
        _Pragma("unroll") for (int s = 0; s < 16; ++s) { const float bur = br_[s >> 2][s & 3], bui = bi_[s >> 2][s & 3]; \
            float t0_ = __builtin_fmaf(-ai, hi, bur), t1_ = __builtin_fmaf(ai, hr, bui); \
            asm volatile("" : "+v"(t0_), "+v"(t1_));                       \
            const float nr = __builtin_fmaf(ar, hr, t0_), ni = __builtin_fmaf(ar, hi, t1_); hr = nr; hi = ni; \
            asm volatile("" : "+v"(hr), "+v"(hi)); \
            const unsigned hw_ = pk2(hr, hi); \
            *(LAS bf16_t*)(hl + s * S5_HROW + lane * 2) = (bf16_t)(hw_ & 0xffffu); *(LAS bf16_t*)(hl + s * S5_HROW + (64 + lane) * 2) = (bf16_t)(hw_ >> 16); } \
        if (DOY) S5_Y(ch - 1); \
        Ua = Ub; Ub = Uc; Uc = Un_; } while (0)
    bf16x8 Ua = S5_LDU(0), Ub = S5_LDU(1), Uc = S5_LDU(2);
    S5_BU(Ua);
    Ua = Ub; Ub = Uc; Uc = S5_LDU(3);
    int ch = 0;
    S5_ITER(false);
#pragma unroll 1
    for (ch = 1; ch < nch; ++ch) S5_ITER(true);
    { bf16x8 Bh[4];
#pragma unroll
      for (int kk = 0; kk < 4; ++kk) Bh[kk] = *(const LAS bf16x8*)(hl + st * S5_HROW + (kk * 32 + gq * 8) * 2);
      S5_Y(nch - 1); }
#undef S5_LDU
#undef S5_BU
#undef S5_Y
#undef S5_ITER
    if (fre) { fre[lane] = hr; fim[lane] = hi; }
}

DI void s5_phase(const Ctx& F, const Params& P) {
    bf16_t* YF = (bf16_t*)(P.ws + WS_RB + RB_YF); bf16_t* YB = (bf16_t*)(P.ws + WS_RB + RB_YB);
    for (int cs = F.bid; cs < 256; cs += F.G) {
        if (F.wave < 4) { const int sc = cs * 4 + F.wave, dg = sc & 127, b = sc >> 7;
            s5_chain(F, P, dg, TP + b * 4096, LS, P.in[I_S5RE] + (size_t)sc * 64, P.in[I_S5IM] + (size_t)sc * 64, nullptr, nullptr, (dg >> 6) ? YB : YF); }
        else { for (int k = 0; k < 4; ++k) { const int pc = (cs * 4 + (F.wave - 4)) * 4 + k, dg = pc & 127, b = pc >> 7;
            s5_chain(F, P, dg, b * 256, LP, nullptr, nullptr, P.out + O_SR + (size_t)pc * 64, P.out + O_SI + (size_t)pc * 64, (dg >> 6) ? YB : YF); } }
    }
    if (F.wave >= 4) prep_c_tokens(F, P, F.bid * 4 + (F.wave - 4), F.G * 4);
}

DI void s5_combine(const Ctx& F, const Params& P) {
    const bf16_t* PA = (const bf16_t*)(P.ws + WS_RA); const bf16_t* YF = (const bf16_t*)(P.ws + WS_RB + RB_YF); const bf16_t* YB = (const bf16_t*)(P.ws + WS_RB + RB_YB);
    bf16_t* Y = (bf16_t*)(P.ws + WS_RB + RB_Y); const float* dsk = P.in[I_S5D];
    const size_t N = (size_t)TOK * 128, step = (size_t)F.G * NTHR;
    for (size_t e = (size_t)F.bid * NTHR + F.tid; e < N; e += 2 * step) {
        const size_t ee[2] = {e, (e + step < N) ? e + step : e};
        u32x4 uv[2], fv[2], bv[2];
#pragma unroll
        for (int r = 0; r < 2; ++r) { const size_t T = ee[r] >> 7; const int c8 = (int)(ee[r] & 127) * 8;
            uv[r] = *(const u32x4*)(PA + T * 4096 + c8); fv[r] = *(const u32x4*)(YF + T * 1024 + c8); bv[r] = *(const u32x4*)(YB + T * 1024 + c8); }
#pragma unroll
        for (int r = 0; r < 2; ++r) { const size_t T = ee[r] >> 7; const int c8 = (int)(ee[r] & 127) * 8;
            const f32x4 d0 = *(const f32x4*)(dsk + c8), d1 = *(const f32x4*)(dsk + c8 + 4);
            float o[8];
            o[0] = gelu_tanh(d0.x * bflo(uv[r].x) + bflo(fv[r].x) + bflo(bv[r].x)); o[1] = gelu_tanh(d0.y * bfhi(uv[r].x) + bfhi(fv[r].x) + bfhi(bv[r].x));
            o[2] = gelu_tanh(d0.z * bflo(uv[r].y) + bflo(fv[r].y) + bflo(bv[r].y)); o[3] = gelu_tanh(d0.w * bfhi(uv[r].y) + bfhi(fv[r].y) + bfhi(bv[r].y));
            o[4] = gelu_tanh(d1.x * bflo(uv[r].z) + bflo(fv[r].z) + bflo(bv[r].z)); o[5] = gelu_tanh(d1.y * bfhi(uv[r].z) + bfhi(fv[r].z) + bfhi(bv[r].z));
            o[6] = gelu_tanh(d1.z * bflo(uv[r].w) + bflo(fv[r].w) + bflo(bv[r].w)); o[7] = gelu_tanh(d1.w * bfhi(uv[r].w) + bfhi(fv[r].w) + bfhi(bv[r].w));
            u32x4 w; w.x = pk2(o[0], o[1]); w.y = pk2(o[2], o[3]); w.z = pk2(o[4], o[5]); w.w = pk2(o[6], o[7]);
            if (r == 0 || e + step < N) *(u32x4*)(Y + T * 1024 + c8) = w; }
    }
}
constexpr int PS_KROW = 272;
constexpr int PS_IDX_OFF = 2 * 128 * PS_KROW;
constexpr int PS_TAB_OFF = PS_IDX_OFF + 512 * 32;

DI void topk_insert(float (&a)[16], float x) {
#pragma unroll
    for (int j = 15; j >= 1; --j) a[j] = __builtin_amdgcn_fmed3f(a[j - 1], a[j], x);
    a[0] = fmaxf(a[0], x);
}

DI void peer_select(const Ctx& F, const Params& P, int layer) {
    LAS unsigned char* lds = F.lds;
    const bf16_t* Q = (const bf16_t*)(P.ws + WS_RA + RA_Q);
    int* SELI = (int*)(P.ws + WS_RA + RA_SELI); float* SELW = (float*)(P.ws + WS_RA + RA_SELW);
    const bf16_t* KEYS = (const bf16_t*)(P.ws + WS_PKEYS) + (size_t)layer * 8 * 2 * 128 * 128;
    const int q = F.lane & 31, hh = F.lane >> 5;
    LAS unsigned char* myidx = lds + PS_IDX_OFF + F.tid * 32;
    LAS unsigned char* tab = lds + PS_TAB_OFF;
    for (int wu = F.bid; wu < 256; wu += F.G) {
        const int h = wu & 7, chunk = wu >> 3;
        __syncthreads();
        for (int id = F.tid; id < 2 * 128 * 16; id += NTHR) { const int row = id >> 4, c16 = id & 15;
            *(LAS u32x4*)(lds + row * PS_KROW + c16 * 16) = *(const u32x4*)(KEYS + ((size_t)h * 256 + row) * 128 + c16 * 8); }
        if (F.tid < 16) { int cnt = 0;
            for (int a = 0; a < F.tid; ++a) cnt += 16 / (a + 1);
            for (int b = 0; b < 16 / (F.tid + 1); ++b) { tab[(cnt + b) * 2] = (unsigned char)F.tid; tab[(cnt + b) * 2 + 1] = (unsigned char)b; } }
        __syncthreads();
        for (int blk = F.wave; blk < 40; blk += 8) {
            const int T0 = chunk * 1280 + blk * 32;
            float lst[2][16];
#pragma unroll
            for (int side = 0; side < 2; ++side) {
                bf16x8 Qf[8];
                const bf16_t* qp = Q + (size_t)(T0 + q) * 2048 + h * 256 + side * 128 + hh * 8;
#pragma unroll
                for (int ks = 0; ks < 8; ++ks) Qf[ks] = *(const bf16x8*)(qp + ks * 16);
                float a[16];
#pragma unroll
                for (int j = 0; j < 16; ++j) a[j] = -3.0e38f;
#pragma unroll
                for (int nt = 0; nt < 4; ++nt) {
                    f32x16 S;
#pragma unroll
                    for (int i = 0; i < 16; ++i) S[i] = 0.f;
#pragma unroll
                    for (int ks = 0; ks < 8; ++ks) { const bf16x8 A = *(const LAS bf16x8*)(lds + (side * 128 + nt * 32 + q) * PS_KROW + (ks * 16 + hh * 8) * 2);
                        S = __builtin_amdgcn_mfma_f32_32x32x16_bf16(A, Qf[ks], S, 0, 0, 0); }
#pragma unroll
                    for (int i = 0; i < 16; ++i) { const int n = nt * 32 + (i & 3) + 8 * (i >> 2) + 4 * hh;
                        topk_insert(a, __uint_as_float((__float_as_uint(S[i]) & 0xffffff80u) | (unsigned)n)); }
                }
                float pb[16];
#pragma unroll
                for (int j = 0; j < 16; ++j) pb[j] = __shfl_xor(a[j], 32);
#pragma unroll
                for (int j = 0; j < 16; ++j) topk_insert(a, pb[j]);
#pragma unroll
                for (int j = 0; j < 16; ++j) { lst[side][j] = a[j]; myidx[side * 16 + j] = (unsigned char)(__float_as_uint(a[j]) & 0x7fu); }
            }
            float cb[16];
#pragma unroll
            for (int j = 0; j < 16; ++j) cb[j] = -3.0e38f;
            { int cid = 0;
#pragma unroll
              for (int a = 0; a < 16; ++a)
#pragma unroll
                  for (int b = 0; b < 16 / (a + 1); ++b) {
                      const float sa = __uint_as_float(__float_as_uint(lst[0][a]) & 0xffffff80u), sb = __uint_as_float(__float_as_uint(lst[1][b]) & 0xffffff80u);
                      topk_insert(cb, __uint_as_float((__float_as_uint(sa + sb) & 0xffffffc0u) | (unsigned)cid)); ++cid; } }
            const float mx = __uint_as_float(__float_as_uint(cb[0]) & 0xffffffc0u);
            float e[16], den = 0.f;
#pragma unroll
            for (int j = 0; j < 16; ++j) { e[j] = __expf(__uint_as_float(__float_as_uint(cb[j]) & 0xffffffc0u) - mx); den += e[j]; }
            const float rden = 1.f / den;
#pragma unroll
            for (int j = 0; j < 16; ++j) {
                if ((j >> 3) == hh) { const int cid = (int)(__float_as_uint(cb[j]) & 0x3fu);
                    const int a = tab[cid * 2], b = tab[cid * 2 + 1];
                    const int eidx = (int)myidx[a] * 128 + (int)myidx[16 + b];
                    SELI[(size_t)(T0 + q) * 128 + h * 16 + j] = eidx; SELW[(size_t)(T0 + q) * 128 + h * 16 + j] = e[j] * rden; }
            }
        }
    }
    __syncthreads();
}

DI u32x16 fp6_unpack_bf16(u32x4 a, u32x2 b) { const u32x6 pk = {a.x, a.y, a.z, a.w, b.x, b.y}; return __builtin_bit_cast(u32x16, __builtin_amdgcn_cvt_scalef32_pk32_bf16_fp6(pk, 1.0f)); }
DI f32x32 fp6_unpack(u32x4 a, u32x2 b) { const u32x6 pk = {a.x, a.y, a.z, a.w, b.x, b.y}; return __builtin_amdgcn_cvt_scalef32_pk32_f32_fp6(pk, 1.0f); }
constexpr int GN = 4, GNU = 8;
template <bool NEXTNORM>
DI void peer_gather(const Ctx& F, const Params& P, const float* modl, int layer, const float* ngain, const float* nmodl) {
    const bf16_t* H2 = (const bf16_t*)(P.ws + WS_HM);
    const unsigned char* TU = P.ws + WS_TBLU + (size_t)layer * 16384 * PT_ROWB; const unsigned char* TV = P.ws + WS_TBLV + (size_t)layer * 16384 * PT_ROWB;
    const float* SCU = (const float*)(P.ws + WS_SC) + layer * 16384; const float* SCV = (const float*)(P.ws + WS_SC) + (2 + layer) * 16384;
    const int* SELI = (const int*)(P.ws + WS_RA + RA_SELI); const float* SELW = (const float*)(P.ws + WS_RA + RA_SELW);
    float* X = P.out + O_Y;
    const int lane = lane_id();
    const int stride = F.G * 8;
    for (int T0 = F.bid * 8 + F.wave; T0 < TOK; T0 += 2 * stride) {
        const bool two = (T0 + stride < TOK);
        const int Tt[2] = {T0, two ? T0 + stride : T0};
        u32x4 xw[2][4]; int e0[2], e1[2]; float g0[2], g1[2], d0[2], d1[2];
#pragma unroll
        for (int t = 0; t < 2; ++t) {
#pragma unroll
            for (int q4 = 0; q4 < 4; ++q4) xw[t][q4] = *(const u32x4*)(H2 + (size_t)Tt[t] * DM + lane * 32 + q4 * 8);
            e0[t] = SELI[(size_t)Tt[t] * 128 + lane]; e1[t] = SELI[(size_t)Tt[t] * 128 + 64 + lane];
            g0[t] = SELW[(size_t)Tt[t] * 128 + lane]; g1[t] = SELW[(size_t)Tt[t] * 128 + 64 + lane]; d0[t] = 0.f; d1[t] = 0.f; }
#pragma unroll 1
        for (int kb = 0; kb < 128; kb += GNU) {
            u32x4 ura[2][GNU]; u32x2 urb[2][GNU];
#pragma unroll
            for (int j = 0; j < GNU; ++j)
#pragma unroll
                for (int t = 0; t < 2; ++t) { const int k = kb + j; const int e = __builtin_amdgcn_readlane(k < 64 ? e0[t] : e1[t], k & 63);
                    const unsigned char* up = TU + (size_t)e * PT_ROWB;
                    ura[t][j] = *(const u32x4*)(up + lane * 16); urb[t][j] = *(const u32x2*)(up + 1024 + lane * 8); }
#pragma unroll
            for (int j = 0; j < GNU; ++j) { float pt[2];
#pragma unroll
                for (int t = 0; t < 2; ++t) { const u32x16 r = fp6_unpack_bf16(ura[t][j], urb[t][j]);
                    float sa = 0.f, sb = 0.f, sc2 = 0.f, sd = 0.f;
#pragma unroll
                    for (int i = 0; i < 4; ++i) { const unsigned x0 = xw[t][i].x, x1 = xw[t][i].y, x2 = xw[t][i].z, x3 = xw[t][i].w;
                        sa = dot2bf(r[4 * i], x0, sa); sb = dot2bf(r[4 * i + 1], x1, sb); sc2 = dot2bf(r[4 * i + 2], x2, sc2); sd = dot2bf(r[4 * i + 3], x3, sd); }
                    pt[t] = (sa + sb) + (sc2 + sd); }
                const float sm0 = wave_sum(pt[0]), sm1 = wave_sum(pt[1]); const int k = kb + j;
                if (k < 64) { if (lane == k) { d0[0] = sm0; d0[1] = sm1; } } else { if (lane == k - 64) { d1[0] = sm0; d1[1] = sm1; } } }
        }
        float cf0[2], cf1[2];
#pragma unroll
        for (int t = 0; t < 2; ++t) { cf0[t] = g0[t] * gelu_tanh(d0[t] * SCU[e0[t]]) * SCV[e0[t]]; cf1[t] = g1[t] * gelu_tanh(d1[t] * SCU[e1[t]]) * SCV[e1[t]]; }
        f32x2 acc[2][16];
#pragma unroll
        for (int t = 0; t < 2; ++t)
#pragma unroll
            for (int i = 0; i < 16; ++i) acc[t][i] = (f32x2){0.f, 0.f};
#pragma unroll 1
        for (int kb = 0; kb < 128; kb += GN) {
            u32x4 vra[2][GN]; u32x2 vrb[2][GN]; float cf[2][GN];
#pragma unroll
            for (int j = 0; j < GN; ++j)
#pragma unroll
                for (int t = 0; t < 2; ++t) { const int k = kb + j; const int e = __builtin_amdgcn_readlane(k < 64 ? e0[t] : e1[t], k & 63);
                    cf[t][j] = __builtin_bit_cast(float, __builtin_amdgcn_readlane(__builtin_bit_cast(int, k < 64 ? cf0[t] : cf1[t]), k & 63));
                    const unsigned char* vp = TV + (size_t)e * PT_ROWB;
                    vra[t][j] = *(const u32x4*)(vp + lane * 16); vrb[t][j] = *(const u32x2*)(vp + 1024 + lane * 8); }
#pragma unroll
            for (int j = 0; j < GN; ++j)
#pragma unroll
                for (int t = 0; t < 2; ++t) { const f32x32 r = fp6_unpack(vra[t][j], vrb[t][j]);
                    const f32x2 c2 = (f32x2){cf[t][j], cf[t][j]};
#pragma unroll
                    for (int i = 0; i < 16; ++i) acc[t][i] += c2 * (f32x2){r[2 * i], r[2 * i + 1]}; }
        }
#pragma unroll
        for (int t = 0; t < 2; ++t) {
            if (t == 1 && !two) break;
            const int T = Tt[t];
            const float* gate = modl + (size_t)(cond_of(T) * 6 + 5) * DM;
            f32x4 xn[8]; float ss = 0.f;
#pragma unroll
            for (int q4 = 0; q4 < 8; ++q4) { const int col = lane * 32 + q4 * 4; float* xp = X + (size_t)T * DM + col;
                const f32x4 gv = *(const f32x4*)(gate + col), x0 = *(const f32x4*)(xp);
                const f32x4 r = x0 + gv * (f32x4){acc[t][q4 * 2].x, acc[t][q4 * 2].y, acc[t][q4 * 2 + 1].x, acc[t][q4 * 2 + 1].y};
                *(f32x4*)(xp) = r; xn[q4] = r; ss += r.x * r.x + r.y * r.y + r.z * r.z + r.w * r.w; }
            if (NEXTNORM) {
                ss = wave_sum(ss);
                const float rstd = rsqrtf(ss * (1.f / DM) + NORM_EPS);
                const float* sh = nmodl + (size_t)(cond_of(T) * 6 + 0) * DM; const float* sc = sh + DM;
                bf16_t* H = (bf16_t*)(P.ws + WS_HM);
#pragma unroll
                for (int q4 = 0; q4 < 8; ++q4) { const int col = lane * 32 + q4 * 4;
                    const f32x4 g4 = *(const f32x4*)(ngain + col), s4 = *(const f32x4*)(sc + col), h4 = *(const f32x4*)(sh + col);
                    const f32x4 o = xn[q4] * rstd * g4 * (s4 + 1.f) + h4;
                    *(u32x2*)(H + (size_t)T * DM + col) = (u32x2){pk2(o.x, o.y), pk2(o.z, o.w)}; }
            }
        }
    }
}
constexpr int NPHASE = 22;

__global__ void __launch_bounds__(NTHR, 2) mega(Params P) {
    extern __shared__ __attribute__((aligned(16))) unsigned char lds_raw[];
    Ctx F;
    F.lds = (LAS unsigned char*)lds_raw; F.tid = threadIdx.x; F.lane = F.tid & 63; F.wave = __builtin_amdgcn_readfirstlane(F.tid >> 6); F.G = gridDim.x; F.bid = blockIdx.x;
    const int lo = P.ph_lo, hi = P.ph_hi;
    volatile LAS unsigned* xbw = (volatile LAS unsigned*)(F.lds + LDS_BYTES - 16);
    if (F.tid == 0) { xbw[0] = 0u; xbw[1] = 0u; xbw[2] = 0u; xbw[3] = 0u; }
    __syncthreads();
    if (hi - lo > 1) (void)xcd_barrier_post((unsigned*)(P.ws + WS_CTL), xbw);
#define GRID_BARRIER() do { XcdBarrier bar_; bar_.bar = (unsigned*)(P.ws + WS_CTL); bar_.x = xb_xcc_id(); bar_.st = (volatile LAS unsigned*)(F.lds + LDS_BYTES - 16); xcd_barrier(bar_); } while (0)
#define PH(k, ...) if (lo <= (k) && (k) < hi) { { __VA_ARGS__ } if ((k) + 1 < hi) GRID_BARRIER(); }
#define MOD0 ((const float*)(P.ws + WS_MOD))
#define MOD1 ((const float*)(P.ws + WS_MOD) + 9 * 12288)
#define HM ((bf16_t*)(P.ws + WS_HM))
#define RA ((bf16_t*)(P.ws + WS_RA))
#define X (P.out + O_Y)

    PH(0, prologue(F, P);)
    PH(1, adaln_reduce(F, P);)
    PH(2, norm_phase(F, P.in[I_XP], P.in[I_XS], P.in[I_NMIXG], MOD0, 0, HM);)
    PH(3, { EpiBf16 E{RA, 4096}; run_gemm(F, HM, (const bf16_t*)(P.ws + WS_WEVIN) + (size_t)2048 * 2048, 4096, 2048, E); })
    PH(4, prep_a(F, P);)
    PH(5, { EpiBf16 E{RA, 2048}; run_gemm(F, HM, (const bf16_t*)(P.ws + WS_WEVIN), 2048, 2048, E); })
    PH(6, attn_phase<0>(F, P); attn_phase<1>(F, P); hyena_phase(F, P);)
    PH(7, hyena_post(F, P);)
    PH(8, { EpiResid E{P.in[I_XP], P.in[I_XS], X, MOD0, 2}; run_gemm(F, HM, (const bf16_t*)(P.ws + WS_WEVOUT), 2048, 2048, E); })
    PH(9, norm_phase(F, X, X + (size_t)TP * DM, P.in[I_NFFNG], MOD0, 3, HM);)
    PH(10, { EpiBf16 E{RA, 2048}; run_gemm(F, HM, (const bf16_t*)(P.ws + WS_WPQ), 2048, 2048, E); })
    PH(11, peer_select(F, P, 0);)
    PH(12, peer_gather<true>(F, P, MOD0, 0, P.in[I_NMIXG] + DM, MOD1);)
    PH(13, { EpiBf16 E{RA, 4096}; run_gemm(F, HM, (const bf16_t*)(P.ws + WS_WODIN), 4096, 2048, E); })
    PH(14, prep_c(F, P); s5_phase(F, P);)
    PH(15, { const float lam = diff_lambda(F, P); attn_diff_phase<false>(F, P, lam); attn_diff_phase<true>(F, P, lam); } s5_combine(F, P);)
    PH(16, { EpiGlu E{(const bf16_t*)(P.ws + WS_RB + RB_Y), HM, P.in[I_GLUB]}; run_gemm(F, (const bf16_t*)(P.ws + WS_RB + RB_Y), (const bf16_t*)(P.ws + WS_WGLU), 1024, 1024, E); })
    PH(17, { EpiResid E{X, X + (size_t)TP * DM, X, MOD1, 2}; run_gemm(F, HM, (const bf16_t*)(P.ws + WS_WODOUT), 2048, 2048, E); })
    PH(18, norm_phase(F, X, X + (size_t)TP * DM, P.in[I_NFFNG] + DM, MOD1, 3, HM);)
    PH(19, { EpiBf16 E{RA, 2048}; run_gemm(F, HM, (const bf16_t*)(P.ws + WS_WPQ) + (size_t)2048 * 2048, 2048, 2048, E); })
    PH(20, peer_select(F, P, 1);)
    PH(21, peer_gather<false>(F, P, MOD1, 1, nullptr, nullptr);)
#undef MOD0
#undef MOD1
#undef HM
#undef RA
#undef X
#undef PH
#undef GRID_BARRIER
}

extern "C" void kernel_launch(void* const* d_in, const int* in_sizes, int n_in, void* d_out, int out_size, void* d_ws, size_t ws_size, hipStream_t stream) {
    static int grid = 0;
    if (grid == 0) {
        if (n_in != N_IN || (size_t)out_size != O_END || ws_size < WS_END) { fprintf(stderr, "kernel_launch: unexpected shapes (n_in %d, out %d, ws %zu, need %zu)\n", n_in, out_size, ws_size, (size_t)WS_END); grid = -1; return; }
        int dev = 0, cus = 0;
        if (hipGetDevice(&dev) != hipSuccess || hipDeviceGetAttribute(&cus, hipDeviceAttributeMultiprocessorCount, dev) != hipSuccess) { grid = -1; return; }
        if (hipFuncSetAttribute((const void*)mega, hipFuncAttributeMaxDynamicSharedMemorySize, LDS_BYTES) != hipSuccess) { fprintf(stderr, "kernel_launch: hipFuncSetAttribute failed\n"); grid = -1; return; }
        int per_cu = 0;
        if (hipOccupancyMaxActiveBlocksPerMultiprocessor(&per_cu, (const void*)mega, NTHR, LDS_BYTES) != hipSuccess || per_cu < 1) { fprintf(stderr, "kernel_launch: occupancy query says %d blocks per CU\n", per_cu); }
        (void)hipGetLastError();
        grid = cus;
    }
    if (grid < 0) return;
    (void)hipMemsetAsync((char*)d_ws + WS_CTL, 0, 65536, stream);
    Params p; memset(&p, 0, sizeof(p));
    for (int i = 0; i < N_IN; ++i) p.in[i] = (const float*)d_in[i];
    p.out = (float*)d_out; p.ws = (unsigned char*)d_ws;
    p.ph_lo = 0; p.ph_hi = NPHASE;
    hipLaunchKernelGGL(mega, dim3(grid), dim3(NTHR), LDS_BYTES, stream, p);
}
```
